# Optimizing an MI355X kernel written in HIP

```python
import math
import jax, jax.numpy as jnp
from jax import lax
import numpy as np

D_MODEL = 1024
BATCH = 4
SEQ = 8192
DEPTH = 1

CONV_DIM = 1024
CONV_K = 31
HG_HEADS = 8
HG_DK = 128
HG_DV = 128
HG_CHUNK = 64
HG_KDIM = HG_HEADS * HG_DK
HG_VDIM = HG_HEADS * HG_DV
OFF_CA = 0
OFF_CB = OFF_CA + CONV_DIM
OFF_Q = OFF_CB + CONV_DIM
OFF_F = OFF_Q + HG_KDIM
OFF_I = OFF_F + HG_KDIM
OFF_G = OFF_I + HG_VDIM
OFF_GC = OFF_G + HG_VDIM
OFF_GH = OFF_GC + D_MODEL
IN_COLS = OFF_GH + D_MODEL
N_EXPERTS = 32
TOP_K = 4
D_FF = 1024
SWIGLU_ALPHA = 1.702
SWIGLU_LIMIT = 7.0
MOE_BLOCK = 256
EPS = 1e-6
N_MOD = 6

kernel_name = "hybrid_conv_hgrn2_moe_adaln_block"


def rmsnorm(x, g):
    xf = x.astype(jnp.float32)
    y = xf * lax.rsqrt(jnp.mean(xf * xf, axis=-1, keepdims=True) + EPS) * g.astype(jnp.float32)
    return y.astype(x.dtype)


def layernorm(x, g, b):
    xf = x.astype(jnp.float32)
    mu = jnp.mean(xf, axis=-1, keepdims=True)
    var = jnp.mean(jnp.square(xf - mu), axis=-1, keepdims=True)
    y = (xf - mu) * lax.rsqrt(var + EPS) * g.astype(jnp.float32) + b.astype(jnp.float32)
    return y.astype(x.dtype)


def conformer_conv(a, b, dw, dw_bias, ln_g, ln_b, w_proj):
    u = a * jax.nn.sigmoid(b)
    kern = dw.astype(u.dtype).reshape(CONV_K, 1, CONV_DIM)
    u = lax.conv_general_dilated(u, kern, window_strides=(1,), padding=[(CONV_K - 1, 0)],
                                 dimension_numbers=("NWC", "WIO", "NWC"),
                                 feature_group_count=CONV_DIM)
    u = u + dw_bias.astype(u.dtype)
    u = jax.nn.silu(layernorm(u, ln_g, ln_b))
    return u @ w_proj


def hgrn2_step(state, inp):
    q, k, v, logf = inp
    G = jnp.cumsum(logf, axis=2)
    C = q.shape[2]
    causal = jnp.tril(jnp.ones((C, C), dtype=bool))
    diff = G[:, :, :, None, :] - G[:, :, None, :, :]
    decay = jnp.exp(jnp.where(causal[None, None, :, :, None], diff, -jnp.inf))
    A = jnp.einsum("bhtk,bhsk,bhtsk->bhts", q, k, decay)
    o = jnp.einsum("bhts,bhsv->bhtv", A, v) + jnp.einsum("bhtk,bhkv->bhtv", q * jnp.exp(G), state)
    G_last = G[:, :, -1, :]
    k_dec = k * jnp.exp(G_last[:, :, None, :] - G)
    state = jnp.exp(G_last)[..., None] * state + jnp.einsum("bhsk,bhsv->bhkv", k_dec, v)
    return state, o


def hgrn2(q, fz, iv, og, lb, norm_g, w_proj):
    B, S, _ = q.shape
    n_chunks = S // HG_CHUNK
    qf = q.astype(jnp.float32).reshape(B, S, HG_HEADS, HG_DK) * (HG_DK ** -0.5)
    z = fz.astype(jnp.float32).reshape(B, S, HG_HEADS, HG_DK)
    lbh = lb.reshape(HG_HEADS, HG_DK)
    logf = jnp.logaddexp(jnp.log(lbh), jnp.log1p(-lbh) + jax.nn.log_sigmoid(z))
    k = (1.0 - lbh) * jax.nn.sigmoid(-z)
    v = iv.astype(jnp.float32).reshape(B, S, HG_HEADS, HG_DV)

    def to_chunks(t):
        return t.reshape(B, n_chunks, HG_CHUNK, HG_HEADS, t.shape[-1]).transpose(1, 0, 3, 2, 4)

    s0 = jnp.zeros((B, HG_HEADS, HG_DK, HG_DV), jnp.float32)
    _, o = lax.scan(hgrn2_step, s0, (to_chunks(qf), to_chunks(k), to_chunks(v), to_chunks(logf)))
    o = o.transpose(1, 0, 3, 2, 4).reshape(B, S, HG_HEADS, HG_DV)
    o = o * lax.rsqrt(jnp.mean(o * o, axis=-1, keepdims=True) + EPS) * norm_g.astype(jnp.float32)
    o = o * jax.nn.silu(og.astype(jnp.float32).reshape(B, S, HG_HEADS, HG_DV))
    return o.reshape(B, S, HG_VDIM).astype(q.dtype) @ w_proj


def clamped_swiglu(u):
    gl, lin = u[:, :D_FF], u[:, D_FF:]
    gl = jnp.minimum(gl, SWIGLU_LIMIT)
    lin = jnp.clip(lin, -SWIGLU_LIMIT, SWIGLU_LIMIT)
    return gl * jax.nn.sigmoid(SWIGLU_ALPHA * gl) * (lin + 1.0)


def moe(h, w_router, b_router, w1, b1, w2, b2):
    B, S, D = h.shape
    T = B * S
    TK = T * TOP_K
    hf = h.reshape(T, D)
    logits = hf.astype(jnp.float32) @ w_router.astype(jnp.float32) + b_router.astype(jnp.float32)
    top_val, top_idx = lax.top_k(logits, TOP_K)
    top_w = jax.nn.softmax(top_val, axis=-1)
    flat_e = top_idx.reshape(TK).astype(jnp.int32)
    flat_tok = jnp.arange(TK, dtype=jnp.int32) // TOP_K
    flat_w = top_w.reshape(TK)
    order = jnp.argsort(flat_e)
    se, stok, sw = flat_e[order], flat_tok[order], flat_w[order]
    counts = jnp.bincount(flat_e, length=N_EXPERTS).astype(jnp.int32)
    padded = (counts + MOE_BLOCK - 1) // MOE_BLOCK * MOE_BLOCK
    start = jnp.cumsum(counts) - counts
    pend = jnp.cumsum(padded)
    pstart = pend - padded
    dest = pstart[se] + jnp.arange(TK, dtype=jnp.int32) - start[se]
    n_blocks = -(-(TK + N_EXPERTS * (MOE_BLOCK - 1)) // MOE_BLOCK)
    R = n_blocks * MOE_BLOCK
    row_tok = jnp.zeros((R,), jnp.int32).at[dest].set(stok)
    row_w = jnp.zeros((R,), jnp.float32).at[dest].set(sw)
    block_e = jnp.minimum(
        jnp.searchsorted(pend, jnp.arange(n_blocks, dtype=jnp.int32) * MOE_BLOCK, side="right"),
        N_EXPERTS - 1).astype(jnp.int32)

    def block_fn(args):
        tok, e = args
        xb = hf[tok]
        u = xb @ w1[e] + b1[e]
        return clamped_swiglu(u) @ w2[e] + b2[e]

    ys = lax.map(block_fn, (row_tok.reshape(n_blocks, MOE_BLOCK), block_e))
    out = jnp.zeros((T, D), jnp.float32).at[row_tok].add(
        ys.reshape(R, D).astype(jnp.float32) * row_w[:, None])
    return out.reshape(B, S, D).astype(h.dtype)


def setup_inputs(seed: int = 0) -> dict:
    key = jax.random.key(seed)
    ks = jax.random.split(key, 24)
    n = jax.random.normal
    f32 = jnp.float32
    D, L = D_MODEL, DEPTH
    return {
        "x": n(ks[0], (BATCH, SEQ, D), f32),
        "c": n(ks[1], (BATCH, D), f32),
        "w_ada": n(ks[2], (L, D, N_MOD * D), f32) * (0.5 * D ** -0.5),
        "b_ada": n(ks[3], (L, N_MOD * D), f32) * 0.01,
        "g_mix": 1.0 + 0.02 * n(ks[4], (L, D), f32),
        "w_in": n(ks[5], (L, D, IN_COLS), f32) * D ** -0.5,
        "conv_dw": n(ks[6], (L, CONV_K, CONV_DIM), f32) * CONV_K ** -0.5,
        "conv_dw_bias": n(ks[7], (L, CONV_DIM), f32) * 0.01,
        "conv_ln_g": 1.0 + 0.02 * n(ks[8], (L, CONV_DIM), f32),
        "conv_ln_b": n(ks[9], (L, CONV_DIM), f32) * 0.01,
        "w_conv_out": n(ks[10], (L, CONV_DIM, D), f32) * CONV_DIM ** -0.5,
        "lb_param": n(ks[11], (L + 1, HG_KDIM), f32) * 0.5,
        "hgrn_norm_g": 1.0 + 0.02 * n(ks[12], (L, HG_DV), f32),
        "w_hgrn_out": n(ks[13], (L, HG_VDIM, D), f32) * HG_VDIM ** -0.5,
        "w_out": n(ks[14], (L, D, D), f32) * D ** -0.5,
        "g_ffn": 1.0 + 0.02 * n(ks[15], (L, D), f32),
        "w_router": n(ks[16], (L, D, N_EXPERTS), f32) * D ** -0.5,
        "b_router": n(ks[17], (L, N_EXPERTS), f32) * 0.01,
        "w1": n(ks[18], (L, N_EXPERTS, D, 2 * D_FF), f32) * D ** -0.5,
        "b1": n(ks[19], (L, N_EXPERTS, 2 * D_FF), f32) * 0.01,
        "w2": n(ks[20], (L, N_EXPERTS, D_FF, D), f32) * D_FF ** -0.5,
        "b2": n(ks[21], (L, N_EXPERTS, D), f32) * 0.01,
        "g_final": 1.0 + 0.02 * n(ks[22], (D,), f32),
    }


def reference(x, c, w_ada, b_ada, g_mix, w_in, conv_dw, conv_dw_bias, conv_ln_g, conv_ln_b,
              w_conv_out, lb_param, hgrn_norm_g, w_hgrn_out, w_out, g_ffn, w_router, b_router,
              w1, b1, w2, b2, g_final):
    dt = x.dtype
    lb_all = jnp.cumsum(jax.nn.softmax(lb_param.astype(jnp.float32), axis=0), axis=0)
    c_act = jax.nn.silu(c.astype(jnp.float32))
    for l in range(DEPTH):
        mod = c_act @ w_ada[l].astype(jnp.float32) + b_ada[l].astype(jnp.float32)
        sh1, sc1, ga1, sh2, sc2, ga2 = [m[:, None, :].astype(dt) for m in jnp.split(mod, N_MOD, axis=-1)]

        h = rmsnorm(x, g_mix[l]) * (1.0 + sc1) + sh1
        p = h @ w_in[l]
        y_conv = conformer_conv(p[..., OFF_CA:OFF_CB], p[..., OFF_CB:OFF_Q], conv_dw[l],
                                conv_dw_bias[l], conv_ln_g[l], conv_ln_b[l], w_conv_out[l])
        y_hg = hgrn2(p[..., OFF_Q:OFF_F], p[..., OFF_F:OFF_I], p[..., OFF_I:OFF_G],
                     p[..., OFF_G:OFF_GC], lb_all[l], hgrn_norm_g[l], w_hgrn_out[l])
        merged = (jax.nn.sigmoid(p[..., OFF_GC:OFF_GH]) * y_conv
                  + jax.nn.sigmoid(p[..., OFF_GH:IN_COLS]) * y_hg)
        x = x + ga1 * (merged @ w_out[l])

        h2 = rmsnorm(x, g_ffn[l]) * (1.0 + sc2) + sh2
        x = x + ga2 * moe(h2, w_router[l], b_router[l], w1[l], b1[l], w2[l], b2[l])
    return rmsnorm(x, g_final)
```

```cpp
#include <hip/hip_runtime.h>
#include <stdint.h>
#include <stdio.h>

typedef unsigned short bf16_t;
typedef short bf16x8 __attribute__((ext_vector_type(8)));
typedef float f32x4 __attribute__((ext_vector_type(4)));
typedef unsigned u32x4 __attribute__((ext_vector_type(4)));
typedef unsigned u32x2 __attribute__((ext_vector_type(2)));

constexpr int D = 1024, NBATCH = 4, SEQ = 8192, T = NBATCH * SEQ;
constexpr int NE = 32, TOPK = 4, DFF = 1024;
constexpr int NMOD = 6 * D;
constexpr int NBLK_MAX = 544, R_PAD = NBLK_MAX * 256;
constexpr int RT_TILE = 128, RT_NT = T / RT_TILE;
constexpr float EPS = 1e-6f;

constexpr size_t MiB = 1u << 20;
constexpr size_t WS_CTL = 0;
constexpr size_t WS_MOD = 1 * MiB;
constexpr size_t WS_HIST = 2 * MiB;
constexpr size_t WS_BLKE = WS_HIST + 64 * 1024;
constexpr size_t WS_TOPE = 3 * MiB;
constexpr size_t WS_TOPW = WS_TOPE + 512 * 1024;
constexpr size_t WS_RANK = WS_TOPW + 512 * 1024;
constexpr size_t WS_PROW = WS_RANK + 512 * 1024;
constexpr size_t WS_RTOK = 5 * MiB;
constexpr size_t WS_RW = 6 * MiB;
constexpr size_t WS_WT = 8 * MiB;
constexpr size_t WS_P = 224 * MiB;
constexpr size_t WS_E = WS_P + 512 * MiB;
constexpr size_t WS_D = WS_E + 128 * MiB;
constexpr size_t WS_END = WS_D + 128 * MiB;
constexpr size_t PG = (size_t)T * D;

__device__ __forceinline__ unsigned f2bf(float f) { unsigned u = __builtin_bit_cast(unsigned, f); return (u + 0x7fffu + ((u >> 16) & 1u)) >> 16; }
__device__ __forceinline__ unsigned pk2(float lo, float hi) { return f2bf(lo) | (f2bf(hi) << 16); }
__device__ __forceinline__ float bf2f(unsigned b) { return __builtin_bit_cast(float, b << 16); }
__device__ __forceinline__ float bflo(unsigned w) { return __builtin_bit_cast(float, w << 16); }
__device__ __forceinline__ float bfhi(unsigned w) { return __builtin_bit_cast(float, w & 0xffff0000u); }
__device__ __forceinline__ float sigmoidf_(float x) { return 1.0f / (1.0f + __expf(-x)); }
__device__ __forceinline__ float wave_sum(float v) {
#pragma unroll
    for (int o = 1; o < 64; o <<= 1) v += __shfl_xor(v, o);
    return v;
}

__global__ __launch_bounds__(256) void k_mod(const float* c, const float* w_ada, const float* b_ada, float* mod) {
    __shared__ float ca[4][1024];
    for (int i = threadIdx.x; i < 4096; i += 256) { const float v = c[i]; ca[i >> 10][i & 1023] = v * sigmoidf_(v); }
    __syncthreads();
    const int j = blockIdx.x * 256 + threadIdx.x;
    float a0 = b_ada[j], a1 = a0, a2 = a0, a3 = a0;
    for (int i = 0; i < 1024; ++i) { const float w = w_ada[(size_t)i * NMOD + j]; a0 += ca[0][i] * w; a1 += ca[1][i] * w; a2 += ca[2][i] * w; a3 += ca[3][i] * w; }
    mod[0 * NMOD + j] = a0; mod[1 * NMOD + j] = a1; mod[2 * NMOD + j] = a2; mod[3 * NMOD + j] = a3;
}

__global__ __launch_bounds__(256) void k_norm_mod(const float* x, const float* g, const float* mod, int sh_off, int sc_off, bf16_t* out) {
    const int lane = threadIdx.x & 63, t = blockIdx.x * 4 + (threadIdx.x >> 6), b = t / SEQ;
    const f32x4* xr = (const f32x4*)(x + (size_t)t * D) + lane;
    f32x4 v[4]; float ss = 0.f;
#pragma unroll
    for (int j = 0; j < 4; ++j) { v[j] = xr[64 * j]; ss += (v[j].x * v[j].x + v[j].y * v[j].y) + (v[j].z * v[j].z + v[j].w * v[j].w); }
    const float r = rsqrtf(wave_sum(ss) * (1.0f / D) + EPS);
    const float* sh = mod + (size_t)b * NMOD + sh_off; const float* sc = mod + (size_t)b * NMOD + sc_off;
#pragma unroll
    for (int j = 0; j < 4; ++j) {
        const int col = 4 * (lane + 64 * j);
        const f32x4 gg = *(const f32x4*)(g + col), s1 = *(const f32x4*)(sc + col), s0 = *(const f32x4*)(sh + col);
        const f32x4 y = v[j] * r * gg * (s1 + 1.0f) + s0;
        u32x2 w; w.x = pk2(y.x, y.y); w.y = pk2(y.z, y.w);
        *(u32x2*)(out + (size_t)t * D + col) = w;
    }
}

struct GemmArgs { const bf16_t* A; int lda; const int* rowmap; const float* B; int ldb; int K; };
template <bool SWIGLU, class Epi>
__device__ __forceinline__ void gemm_tile(const GemmArgs g, int tile_m, int tile_n, const Epi& epi) {
    __shared__ __attribute__((aligned(16))) bf16_t sA[128][40];
    __shared__ __attribute__((aligned(16))) bf16_t sB[128][40];
    const int tid = threadIdx.x, lane = tid & 63, wid = tid >> 6, wr = wid >> 1, wc = wid & 1, fr = lane & 15, fq = lane >> 4;
    const int m0 = tile_m * 128, n0 = tile_n * (SWIGLU ? 64 : 128);
    const bf16_t* arow[2]; int akc[2], ar[2];
#pragma unroll
    for (int i = 0; i < 2; ++i) { const int c = tid + 256 * i; ar[i] = c >> 2; akc[i] = (c & 3) * 8; const int r = m0 + ar[i]; const long src = g.rowmap ? (long)g.rowmap[r] : (long)r; arow[i] = g.A + src * g.lda + akc[i]; }
    const int bn = tid & 127, bk = (tid >> 7) * 16;
    const int bcol = SWIGLU ? (bn < 64 ? n0 + bn : 1024 + n0 + (bn - 64)) : n0 + bn;
    const float* bptr = g.B + (size_t)bk * g.ldb + bcol;
    f32x4 acc[4][4];
#pragma unroll
    for (int m = 0; m < 4; ++m)
#pragma unroll
        for (int n = 0; n < 4; ++n) acc[m][n] = (f32x4){0.f, 0.f, 0.f, 0.f};
    for (int k0 = 0; k0 < g.K; k0 += 32) {
        u32x4 av[2];
#pragma unroll
        for (int i = 0; i < 2; ++i) av[i] = *(const u32x4*)(arow[i] + k0);
        float bv[16];
#pragma unroll
        for (int i = 0; i < 16; ++i) bv[i] = bptr[(size_t)(k0 + i) * g.ldb];
        __syncthreads();
#pragma unroll
        for (int i = 0; i < 2; ++i) *(u32x4*)&sA[ar[i]][akc[i]] = av[i];
        u32x4 w0, w1;
        w0.x = pk2(bv[0], bv[1]); w0.y = pk2(bv[2], bv[3]); w0.z = pk2(bv[4], bv[5]); w0.w = pk2(bv[6], bv[7]);
        w1.x = pk2(bv[8], bv[9]); w1.y = pk2(bv[10], bv[11]); w1.z = pk2(bv[12], bv[13]); w1.w = pk2(bv[14], bv[15]);
        *(u32x4*)&sB[bn][bk] = w0; *(u32x4*)&sB[bn][bk + 8] = w1;
        __syncthreads();
        bf16x8 af[4], bfr[4];
#pragma unroll
        for (int m = 0; m < 4; ++m) af[m] = *(const bf16x8*)&sA[wr * 64 + m * 16 + fr][fq * 8];
#pragma unroll
        for (int n = 0; n < 4; ++n) { const int nr = SWIGLU ? ((n < 2) ? wc * 32 + n * 16 : 64 + wc * 32 + (n - 2) * 16) : wc * 64 + n * 16; bfr[n] = *(const bf16x8*)&sB[nr + fr][fq * 8]; }
#pragma unroll
        for (int m = 0; m < 4; ++m)
#pragma unroll
            for (int n = 0; n < 4; ++n) acc[m][n] = __builtin_amdgcn_mfma_f32_16x16x32_bf16(af[m], bfr[n], acc[m][n], 0, 0, 0);
    }
#pragma unroll
    for (int m = 0; m < 4; ++m)
#pragma unroll
        for (int j = 0; j < 4; ++j) {
            const int row = m0 + wr * 64 + m * 16 + fq * 4 + j;
            if constexpr (SWIGLU) {
#pragma unroll
                for (int n = 0; n < 2; ++n) epi.pair(row, n0 + wc * 32 + n * 16 + fr, acc[m][n][j], acc[m][n + 2][j]);
            } else {
#pragma unroll
                for (int n = 0; n < 4; ++n) epi(row, n0 + wc * 64 + n * 16 + fr, acc[m][n][j]);
            }
        }
}

struct EpiP { bf16_t* p; __device__ void operator()(int row, int col, float v) const { p[(size_t)(col >> 10) * PG + (size_t)row * D + (col & 1023)] = (bf16_t)f2bf(v); } };
struct EpiGate1 { const bf16_t* gate; float* tmp; __device__ void operator()(int row, int col, float v) const { const size_t o = (size_t)row * D + col; tmp[o] = sigmoidf_(bf2f(gate[o])) * v; } };
struct EpiGate2 { const bf16_t* gate; const float* tmp; bf16_t* out; __device__ void operator()(int row, int col, float v) const { const size_t o = (size_t)row * D + col; out[o] = (bf16_t)f2bf(tmp[o] + sigmoidf_(bf2f(gate[o])) * v); } };
struct EpiRes { const float* x; const float* ga; float* out; __device__ void operator()(int row, int col, float v) const { const size_t o = (size_t)row * D + col; out[o] = x[o] + ga[(size_t)(row / SEQ) * NMOD + col] * v; } };
struct EpiSwiglu { const float* b1; bf16_t* act; __device__ void pair(int row, int f, float gl, float lin) const {
        gl += b1[f]; lin += b1[1024 + f]; gl = fminf(gl, 7.0f); lin = fminf(fmaxf(lin, -7.0f), 7.0f);
        act[(size_t)row * DFF + f] = (bf16_t)f2bf(gl * sigmoidf_(1.702f * gl) * (lin + 1.0f)); } };
struct EpiY { const float* b2; const float* rw; bf16_t* y; __device__ void operator()(int row, int col, float v) const { y[(size_t)row * D + col] = (bf16_t)f2bf((v + b2[col]) * rw[row]); } };

template <class Epi> __global__ __launch_bounds__(256) void k_gemm(GemmArgs g, Epi epi) { gemm_tile<false>(g, blockIdx.x, blockIdx.y, epi); }
__global__ __launch_bounds__(256) void k_moe1(const bf16_t* h2, const int* row_tok, const int* blk_e, const float* w1, const float* b1, bf16_t* act) {
    const int e = blk_e[blockIdx.x >> 1]; if (e < 0) return;
    GemmArgs g{h2, D, row_tok, w1 + (size_t)e * D * 2 * DFF, 2 * DFF, D};
    EpiSwiglu epi{b1 + (size_t)e * 2 * DFF, act};
    gemm_tile<true>(g, blockIdx.x, blockIdx.y, epi);
}
__global__ __launch_bounds__(256) void k_moe2(const bf16_t* act, const float* row_w, const int* blk_e, const float* w2, const float* b2, bf16_t* y) {
    const int e = blk_e[blockIdx.x >> 1]; if (e < 0) return;
    GemmArgs g{act, DFF, nullptr, w2 + (size_t)e * DFF * D, D, DFF};
    EpiY epi{b2 + (size_t)e * D, row_w, y};
    gemm_tile<false>(g, blockIdx.x, blockIdx.y, epi);
}

__global__ __launch_bounds__(512) void k_conv(const bf16_t* pA, const bf16_t* pB, const float* dw, const float* dwb, const float* lng, const float* lnb, bf16_t* uc) {
    extern __shared__ __attribute__((aligned(16))) float sm[];
    const int tid = threadIdx.x, lane = tid & 63, wid = tid >> 6;
    const int b = blockIdx.x >> 8, s0 = (blockIdx.x & 255) * 32, c0 = 2 * tid;
    float w[31][2];
#pragma unroll
    for (int j = 0; j < 31; ++j) { w[j][0] = dw[j * 1024 + c0]; w[j][1] = dw[j * 1024 + c0 + 1]; }
    float u[62][2];
#pragma unroll
    for (int i = 0; i < 62; ++i) {
        const int s = s0 - 30 + i;
        if (s >= 0) {
            const size_t o = (size_t)(b * SEQ + s) * D + c0;
            const unsigned a2 = *(const unsigned*)(pA + o), b2 = *(const unsigned*)(pB + o);
            u[i][0] = bflo(a2) * sigmoidf_(bflo(b2)); u[i][1] = bfhi(a2) * sigmoidf_(bfhi(b2));
        } else { u[i][0] = 0.f; u[i][1] = 0.f; }
    }
    const float bias0 = dwb[c0], bias1 = dwb[c0 + 1];
#pragma unroll
    for (int t = 0; t < 32; ++t) {
        float a0 = bias0, a1 = bias1;
#pragma unroll
        for (int j = 0; j < 31; ++j) { a0 += w[j][0] * u[t + j][0]; a1 += w[j][1] * u[t + j][1]; }
        sm[t * 1024 + c0] = a0; sm[t * 1024 + c0 + 1] = a1;
    }
    __syncthreads();
#pragma unroll 1
    for (int i = 0; i < 4; ++i) {
        const int t = wid * 4 + i;
        f32x4 v[4]; float s = 0.f;
#pragma unroll
        for (int j = 0; j < 4; ++j) { v[j] = *(const f32x4*)(sm + t * 1024 + 4 * (lane + 64 * j)); s += (v[j].x + v[j].y) + (v[j].z + v[j].w); }
        const float mean = wave_sum(s) * (1.0f / D); float q = 0.f;
#pragma unroll
        for (int j = 0; j < 4; ++j) { v[j] = v[j] - mean; q += (v[j].x * v[j].x + v[j].y * v[j].y) + (v[j].z * v[j].z + v[j].w * v[j].w); }
        const float rstd = rsqrtf(wave_sum(q) * (1.0f / D) + EPS);
#pragma unroll
        for (int j = 0; j < 4; ++j) {
            const int col = 4 * (lane + 64 * j);
            const f32x4 gg = *(const f32x4*)(lng + col), bb = *(const f32x4*)(lnb + col);
            f32x4 y = v[j] * rstd * gg + bb;
            y.x *= sigmoidf_(y.x); y.y *= sigmoidf_(y.y); y.z *= sigmoidf_(y.z); y.w *= sigmoidf_(y.w);
            u32x2 o; o.x = pk2(y.x, y.y); o.y = pk2(y.z, y.w);
            *(u32x2*)(uc + (size_t)(b * SEQ + s0 + t) * D + col) = o;
        }
    }
}

__global__ __launch_bounds__(128) void k_hgrn_naive(const bf16_t* pQ, const bf16_t* pF, const bf16_t* pI, const bf16_t* pG, const float* lb_param, const float* norm_g, bf16_t* og) {
    __shared__ float sq[8][128], sf[8][128], sk[8][128], red[8][2];
    const int tid = threadIdx.x, b = blockIdx.x >> 3, h = blockIdx.x & 7, col = h * 128 + tid;
    const float lbk = 1.0f / (1.0f + __expf(lb_param[1024 + col] - lb_param[col]));
    const float ng = norm_g[tid];
    float S[128];
#pragma unroll
    for (int k = 0; k < 128; ++k) S[k] = 0.f;
    for (int t0 = 0; t0 < SEQ; t0 += 8) {
#pragma unroll
        for (int i = 0; i < 8; ++i) {
            const size_t o = (size_t)(b * SEQ + t0 + i) * D + col;
            const float z = bf2f(pF[o]), q = bf2f(pQ[o]) * 0.08838834764831845f;
            const float kk = (1.0f - lbk) * sigmoidf_(-z);
            sq[i][tid] = q; sf[i][tid] = 1.0f - kk; sk[i][tid] = kk;
        }
        __syncthreads();
        float o8[8];
#pragma unroll 1
        for (int i = 0; i < 8; ++i) {
            const float vv = bf2f(pI[(size_t)(b * SEQ + t0 + i) * D + col]);
            float a = 0.f;
#pragma unroll
            for (int k = 0; k < 128; ++k) { S[k] = sf[i][k] * S[k] + sk[i][k] * vv; a += sq[i][k] * S[k]; }
            const float ss = wave_sum(a * a);
            if ((tid & 63) == 0) red[i][tid >> 6] = ss;
#pragma unroll
            for (int ii = 0; ii < 8; ++ii) if (ii == i) o8[ii] = a;
        }
        __syncthreads();
#pragma unroll
        for (int i = 0; i < 8; ++i) {
            const size_t o = (size_t)(b * SEQ + t0 + i) * D + col;
            const float r = rsqrtf((red[i][0] + red[i][1]) * (1.0f / 128.0f) + EPS);
            const float gv = bf2f(pG[o]);
            og[o] = (bf16_t)f2bf(o8[i] * r * ng * gv * sigmoidf_(gv));
        }
        __syncthreads();
    }
}

__global__ __launch_bounds__(512) void k_route(const float* x1, const float* g_ffn, const float* mod, const float* w_router, const float* b_router,
                                               bf16_t* h2, int* top_e, float* top_w, int* rank, int* hist_g) {
    __shared__ __attribute__((aligned(16))) float hrow[8][1024];
    __shared__ int hist[32];
    const int tid = threadIdx.x, lane = tid & 63, wid = tid >> 6;
    if (tid < 32) hist[tid] = 0;
    __syncthreads();
    const int e = lane & 31, half = lane >> 5;
    const float be = b_router[e];
    for (int i = 0; i < 16; ++i) {
        const int t = blockIdx.x * RT_TILE + wid * 16 + i, b = t / SEQ;
        const f32x4* xr = (const f32x4*)(x1 + (size_t)t * D) + lane;
        f32x4 v[4]; float ss = 0.f;
#pragma unroll
        for (int j = 0; j < 4; ++j) { v[j] = xr[64 * j]; ss += (v[j].x * v[j].x + v[j].y * v[j].y) + (v[j].z * v[j].z + v[j].w * v[j].w); }
        const float r = rsqrtf(wave_sum(ss) * (1.0f / D) + EPS);
        const float* sh = mod + (size_t)b * NMOD + 3 * D; const float* sc = mod + (size_t)b * NMOD + 4 * D;
#pragma unroll
        for (int j = 0; j < 4; ++j) {
            const int col = 4 * (lane + 64 * j);
            const f32x4 gg = *(const f32x4*)(g_ffn + col), s1 = *(const f32x4*)(sc + col), s0 = *(const f32x4*)(sh + col);
            const f32x4 y = v[j] * r * gg * (s1 + 1.0f) + s0;
            *(f32x4*)&hrow[wid][col] = y;
            u32x2 w; w.x = pk2(y.x, y.y); w.y = pk2(y.z, y.w);
            *(u32x2*)(h2 + (size_t)t * D + col) = w;
        }
        __builtin_amdgcn_s_waitcnt(0xc07f);
        float a = 0.f;
        const float* wr_ = w_router + (size_t)(half * 512) * NE + e;
        const float* hr = &hrow[wid][half * 512];
#pragma unroll 8
        for (int k = 0; k < 512; ++k) a += hr[k] * wr_[(size_t)k * NE];
        a += __shfl_xor(a, 32);
        float logit = a + be;
        float sv[4]; int si[4];
#pragma unroll
        for (int rnd = 0; rnd < 4; ++rnd) {
            float bv = logit; int bi = e;
#pragma unroll
            for (int o = 16; o >= 1; o >>= 1) { const float ov = __shfl_xor(bv, o); const int oi = __shfl_xor(bi, o); if (ov > bv || (ov == bv && oi < bi)) { bv = ov; bi = oi; } }
            sv[rnd] = bv; si[rnd] = bi; if (e == bi) logit = -INFINITY;
        }
        const float e1 = __expf(sv[1] - sv[0]), e2 = __expf(sv[2] - sv[0]), e3 = __expf(sv[3] - sv[0]);
        const float inv = 1.0f / (1.0f + e1 + e2 + e3);
        if (lane == 0) {
            const float ww[4] = {inv, e1 * inv, e2 * inv, e3 * inv};
#pragma unroll
            for (int rnd = 0; rnd < 4; ++rnd) { top_e[t * 4 + rnd] = si[rnd]; top_w[t * 4 + rnd] = ww[rnd]; rank[t * 4 + rnd] = atomicAdd(&hist[si[rnd]], 1); }
        }
    }
    __syncthreads();
    if (tid < 32) hist_g[blockIdx.x * 32 + tid] = hist[tid];
}

__global__ __launch_bounds__(256) void k_sort(const int* hist_g, const int* top_e, const float* top_w, const int* rank, int* row_tok, float* row_w, int* pair_row, int* blk_e) {
    __shared__ int s_tot[32], s_pre[32], s_base[32], s_pstart[32], s_pend[32];
    const int tid = threadIdx.x, tile = blockIdx.x;
    if (tid < 32) { int tot = 0, pre = 0; for (int i = 0; i < RT_NT; ++i) { const int c = hist_g[i * 32 + tid]; tot += c; if (i < tile) pre += c; } s_tot[tid] = tot; s_pre[tid] = pre; }
    __syncthreads();
    if (tid == 0) { int acc = 0; for (int e = 0; e < 32; ++e) { const int padded = (s_tot[e] + 255) / 256 * 256; s_pstart[e] = acc; s_base[e] = acc + s_pre[e]; acc += padded; s_pend[e] = acc; } }
    __syncthreads();
    for (int i = tid; i < RT_TILE * 4; i += 256) {
        const int idx = tile * RT_TILE * 4 + i; const int e = top_e[idx]; const int row = s_base[e] + rank[idx];
        row_tok[row] = idx >> 2; row_w[row] = top_w[idx]; pair_row[idx] = row;
    }
    if (tile < 32) { const int e = tile; for (int r = s_pstart[e] + s_tot[e] + tid; r < s_pend[e]; r += 256) { row_tok[r] = 0; row_w[r] = 0.f; } }
    if (tile == 32) { for (int blk = tid; blk < NBLK_MAX; blk += 256) { int e = -1; const int r = blk * 256; for (int q = 0; q < 32; ++q) if (r >= s_pstart[q] && r < s_pend[q]) e = q; blk_e[blk] = e; } }
}

__global__ __launch_bounds__(256) void k_final(const float* x1, const bf16_t* y, const int* pair_row, const float* mod, const float* g_final, float* out) {
    const int lane = threadIdx.x & 63, t = blockIdx.x * 4 + (threadIdx.x >> 6), b = t / SEQ;
    const f32x4* xr = (const f32x4*)(x1 + (size_t)t * D) + lane;
    const float* ga = mod + (size_t)b * NMOD + 5 * D;
    int rows[4];
#pragma unroll
    for (int k = 0; k < 4; ++k) rows[k] = pair_row[t * 4 + k];
    f32x4 v[4]; float ss = 0.f;
#pragma unroll
    for (int j = 0; j < 4; ++j) {
        const int col = 4 * (lane + 64 * j);
        f32x4 m = (f32x4){0.f, 0.f, 0.f, 0.f};
#pragma unroll
        for (int k = 0; k < 4; ++k) { const u32x2 w = *(const u32x2*)(y + (size_t)rows[k] * D + col); m.x += bflo(w.x); m.y += bfhi(w.x); m.z += bflo(w.y); m.w += bfhi(w.y); }
        v[j] = xr[64 * j] + *(const f32x4*)(ga + col) * m;
        ss += (v[j].x * v[j].x + v[j].y * v[j].y) + (v[j].z * v[j].z + v[j].w * v[j].w);
    }
    const float r = rsqrtf(wave_sum(ss) * (1.0f / D) + EPS);
#pragma unroll
    for (int j = 0; j < 4; ++j) { const int col = 4 * (lane + 64 * j); *(f32x4*)(out + (size_t)t * D + col) = v[j] * r * *(const f32x4*)(g_final + col); }
}

extern "C" void kernel_launch(void* const* d_in, const int* in_sizes, int n_in, void* d_out, int out_size, void* d_ws, size_t ws_size, hipStream_t stream) {
    if (n_in != 23 || ws_size < WS_END) { fprintf(stderr, "kernel_launch: unexpected n_in %d or ws_size %zu (< %zu)\n", n_in, ws_size, (size_t)WS_END); return; }
    const float* x = (const float*)d_in[0]; const float* c = (const float*)d_in[1]; const float* w_ada = (const float*)d_in[2]; const float* b_ada = (const float*)d_in[3];
    const float* g_mix = (const float*)d_in[4]; const float* w_in = (const float*)d_in[5]; const float* conv_dw = (const float*)d_in[6]; const float* conv_dwb = (const float*)d_in[7];
    const float* conv_ln_g = (const float*)d_in[8]; const float* conv_ln_b = (const float*)d_in[9]; const float* w_conv_out = (const float*)d_in[10]; const float* lb_param = (const float*)d_in[11];
    const float* hgrn_norm_g = (const float*)d_in[12]; const float* w_hgrn_out = (const float*)d_in[13]; const float* w_out = (const float*)d_in[14]; const float* g_ffn = (const float*)d_in[15];
    const float* w_router = (const float*)d_in[16]; const float* b_router = (const float*)d_in[17]; const float* w1 = (const float*)d_in[18]; const float* b1 = (const float*)d_in[19];
    const float* w2 = (const float*)d_in[20]; const float* b2 = (const float*)d_in[21]; const float* g_final = (const float*)d_in[22];
    unsigned char* ws = (unsigned char*)d_ws; float* out = (float*)d_out;
    float* mod = (float*)(ws + WS_MOD);
    int* hist_g = (int*)(ws + WS_HIST); int* blk_e = (int*)(ws + WS_BLKE); int* top_e = (int*)(ws + WS_TOPE); float* top_w = (float*)(ws + WS_TOPW);
    int* rank = (int*)(ws + WS_RANK); int* pair_row = (int*)(ws + WS_PROW); int* row_tok = (int*)(ws + WS_RTOK); float* row_w = (float*)(ws + WS_RW);
    bf16_t* p = (bf16_t*)(ws + WS_P);
    bf16_t* h = (bf16_t*)(ws + WS_E); float* tmp = (float*)(ws + WS_E);
    bf16_t* uc = (bf16_t*)(ws + WS_D); bf16_t* og = uc + PG; float* x1 = (float*)(ws + WS_D);
    bf16_t* merged = p;
    bf16_t* h2 = p;
    bf16_t* act = p + PG;
    bf16_t* y = act + (size_t)R_PAD * D;

    static bool attr = false;
    if (!attr) { hipFuncSetAttribute((const void*)k_conv, hipFuncAttributeMaxDynamicSharedMemorySize, 131072); attr = true; }

    k_mod<<<NMOD / 256, 256, 0, stream>>>(c, w_ada, b_ada, mod);
    k_norm_mod<<<T / 4, 256, 0, stream>>>(x, g_mix, mod, 0, D, h);
    { GemmArgs g{h, D, nullptr, w_in, 8 * D, D}; k_gemm<EpiP><<<dim3(T / 128, 8 * D / 128), 256, 0, stream>>>(g, EpiP{p}); }
    k_conv<<<T / 32, 512, 131072, stream>>>(p + 0 * PG, p + 1 * PG, conv_dw, conv_dwb, conv_ln_g, conv_ln_b, uc);
    k_hgrn_naive<<<32, 128, 0, stream>>>(p + 2 * PG, p + 3 * PG, p + 4 * PG, p + 5 * PG, lb_param, hgrn_norm_g, og);
    { GemmArgs g{uc, D, nullptr, w_conv_out, D, D}; k_gemm<EpiGate1><<<dim3(T / 128, D / 128), 256, 0, stream>>>(g, EpiGate1{p + 6 * PG, tmp}); }
    { GemmArgs g{og, D, nullptr, w_hgrn_out, D, D}; k_gemm<EpiGate2><<<dim3(T / 128, D / 128), 256, 0, stream>>>(g, EpiGate2{p + 7 * PG, tmp, merged}); }
    { GemmArgs g{merged, D, nullptr, w_out, D, D}; k_gemm<EpiRes><<<dim3(T / 128, D / 128), 256, 0, stream>>>(g, EpiRes{x, mod + 2 * D, x1}); }
    k_route<<<RT_NT, 512, 0, stream>>>(x1, g_ffn, mod, w_router, b_router, h2, top_e, top_w, rank, hist_g);
    k_sort<<<RT_NT, 256, 0, stream>>>(hist_g, top_e, top_w, rank, row_tok, row_w, pair_row, blk_e);
    k_moe1<<<dim3(NBLK_MAX * 2, DFF / 64), 256, 0, stream>>>(h2, row_tok, blk_e, w1, b1, act);
    k_moe2<<<dim3(NBLK_MAX * 2, D / 128), 256, 0, stream>>>(act, row_w, blk_e, w2, b2, y);
    k_final<<<T / 4, 256, 0, stream>>>(x1, y, pair_row, mod, g_final, out);
}
```

```cpp
#include <hip/hip_runtime.h>
#include <stdint.h>
#include <stdio.h>

#define GAS __attribute__((address_space(1)))
#define LAS __attribute__((address_space(3)))
typedef unsigned short bf16_t;
typedef unsigned u32x4 __attribute__((ext_vector_type(4)));
typedef unsigned u32x2 __attribute__((ext_vector_type(2)));
typedef float f32x4 __attribute__((ext_vector_type(4)));

constexpr int D = 1024, NBATCH = 4, SEQ = 8192, T = NBATCH * SEQ;
constexpr int NE = 32, DFF = 1024;
constexpr int NMOD = 6 * D;
constexpr int NBLK_MAX = 544, R_PAD = NBLK_MAX * 256;
constexpr int RT_TILE = 128, RT_NT = T / RT_TILE;
constexpr float EPS = 1e-6f;

constexpr size_t MiB = 1u << 20;
constexpr size_t WS_CTL = 0, CTL_ZERO_BYTES = 64 * 1024;
constexpr size_t WS_MOD = 1 * MiB;
constexpr size_t WS_HIST = 2 * MiB;
constexpr size_t WS_BLKE = WS_HIST + 64 * 1024;
constexpr size_t WS_TOPE = 3 * MiB;
constexpr size_t WS_TOPW = WS_TOPE + 512 * 1024;
constexpr size_t WS_RANK = WS_TOPW + 512 * 1024;
constexpr size_t WS_PROW = WS_RANK + 512 * 1024;
constexpr size_t WS_RTOK = 5 * MiB;
constexpr size_t WS_RW = 6 * MiB;
constexpr size_t WS_WT = 8 * MiB;
constexpr size_t WS_WIN = WS_WT, WS_WC = WS_WT + 16 * MiB, WS_WH = WS_WT + 18 * MiB, WS_WO = WS_WT + 20 * MiB, WS_W1 = WS_WT + 22 * MiB, WS_W2 = WS_WT + 150 * MiB;
constexpr size_t WS_P = 224 * MiB;
constexpr size_t WS_E = WS_P + 512 * MiB;
constexpr size_t WS_D = WS_E + 128 * MiB;
constexpr size_t WS_END = WS_D + 128 * MiB;
constexpr size_t PG = (size_t)T * D;
constexpr int CW_BAR = 0;

constexpr int RING_BYTES = 131072, LDSCTL_OFF = RING_BYTES, LDS_BYTES = 147456;

__device__ __forceinline__ unsigned f2bf(float f) { unsigned u = __builtin_bit_cast(unsigned, f); return (u + 0x7fffu + ((u >> 16) & 1u)) >> 16; }
__device__ __forceinline__ unsigned pk2(float lo, float hi) { return f2bf(lo) | (f2bf(hi) << 16); }
__device__ __forceinline__ float bf2f(unsigned b) { return __builtin_bit_cast(float, b << 16); }
__device__ __forceinline__ float bflo(unsigned w) { return __builtin_bit_cast(float, w << 16); }
__device__ __forceinline__ float bfhi(unsigned w) { return __builtin_bit_cast(float, w & 0xffff0000u); }
__device__ __forceinline__ float sigmoidf_(float x) { return 1.0f / (1.0f + __expf(-x)); }
__device__ __forceinline__ float wave_sum(float v) {
#pragma unroll
    for (int o = 1; o < 64; o <<= 1) v += __shfl_xor(v, o);
    return v;
}
#define LDS_WAIT() asm volatile("s_waitcnt lgkmcnt(0)" ::: "memory")
#define VM_WAIT() asm volatile("s_waitcnt vmcnt(0)" ::: "memory")

namespace pg8 {
#define PG8_LAS __attribute__((address_space(3)))
typedef unsigned short bf16_t;
typedef short bf16x8 __attribute__((ext_vector_type(8)));
typedef float f32x4 __attribute__((ext_vector_type(4)));
typedef unsigned u32x4 __attribute__((ext_vector_type(4)));
constexpr int BM = 256, BK = 64, HALF = 128, HTB = HALF * BK * 2  , STAGE_BYTES = 8 * HTB, NXCD = 8, WGM = 8;

__host__ __device__ __forceinline__ int lds_byte(int r, int c) { const int st = (r >> 4) * 2 + (c >> 5), rr = r & 15, cc = c & 31, ob = rr * 64 + cc * 2; return st * 1024 + (ob ^ (((ob >> 9) & 1) << 5)); }
__host__ __device__ __forceinline__ void stage_rc(int b, int& R, int& C) { const int st = b / 1024, sb = b % 1024, swz = sb ^ (((sb >> 9) & 1) << 5); R = (st >> 1) * 16 + swz / 64; C = (st & 1) * 32 + (swz % 64) / 2; }
__host__ __device__ __forceinline__ int perm32(int rho) { const int n = rho >> 4, i = rho & 15; return 8 * (i >> 2) + 4 * n + (i & 3); }

struct Unit { int pm, pn; };
struct Gemm { const bf16_t* A; const bf16_t* Bt; int M, N, K; };

struct StaticOrder {
    int nM, nN, nwg, G, c;
    __host__ __device__ void init(int M, int N, int G_, int c_) { nM = M / BM; nN = N / BM; nwg = nM * nN; G = G_; c = c_; }
    __host__ __device__ bool next(int i, Unit& u) const {
        const long L = (long)i * G + c; if (L >= nwg) return false;
        int wgid = (int)L; { const int q = nwg / NXCD, r = nwg % NXCD, xcd = wgid % NXCD, off = wgid / NXCD; wgid = (xcd < r ? xcd * (q + 1) : r * (q + 1) + (xcd - r) * q) + off; }
        const int nig = WGM * nN, gid = wgid / nig, fm = gid * WGM, gsz = (nM - fm) < WGM ? (nM - fm) : WGM;
        u.pm = fm + ((wgid % nig) % gsz); u.pn = (wgid % nig) / gsz; return true;
    }
    __device__ __forceinline__ void a_ready(const Unit&) const {}
    __device__ __forceinline__ void done(const Unit&) const {}
};


struct MoeOrder {
    const int* blk_e; int nblk, G, c, lg;
    __device__ __forceinline__ bool next(int i, Unit& u) const {
        int blk, j;
        if (G == 256) { const int xcd = c & 7, idx = c >> 3, prb = 256 >> lg; blk = i * prb + xcd * (prb >> 3) + (idx >> lg); j = idx & ((1 << lg) - 1); }
        else { const long L = (long)i * G + c; blk = (int)(L >> lg); j = (int)(L & ((1 << lg) - 1)); }
        if (blk >= nblk) return false;
        const int e = blk_e[blk]; u.pm = blk; u.pn = (e << lg) + j; return true;
    }
    __device__ __forceinline__ void a_ready(const Unit&) const {}
    __device__ __forceinline__ void done(const Unit&) const {}
};

__device__ __forceinline__ unsigned cvt_pk_bf16(float lo, float hi) { unsigned r; asm volatile("v_cvt_pk_bf16_f32 %0, %1, %2" : "=v"(r) : "v"(lo), "v"(hi)); return r; }
__device__ __forceinline__ float sigm(float x) { return 1.0f / (1.0f + __expf(-x)); }
__device__ __forceinline__ float blo(unsigned w) { return __builtin_bit_cast(float, w << 16); }
__device__ __forceinline__ float bhi(unsigned w) { return __builtin_bit_cast(float, w & 0xffff0000u); }

struct EpiSplitBf16 {
    static constexpr bool PERM = true, AFTER_DRAIN = false;
    bf16_t* O; size_t split_stride;
    __device__ __forceinline__ void operator()(const f32x4 (&acc)[2][2][4][2], const Unit& u, int wr, int wc, int fr, int fq) const {
        const int row0 = u.pm * BM + wr * 64 + fr; const int colt = u.pn * BM; const int t = colt >> 10;
        bf16_t* base = O + (size_t)t * split_stride; const int col0 = (colt & 1023) + wc * 32 + 8 * fq;
#pragma unroll
        for (int ai = 0; ai < 2; ++ai)
#pragma unroll
            for (int m = 0; m < 4; ++m) { bf16_t* rowp = base + (size_t)(row0 + ai * HALF + m * 16) * 1024 + col0;
#pragma unroll
                for (int bj = 0; bj < 2; ++bj) { const f32x4 v0 = acc[ai][bj][m][0], v1 = acc[ai][bj][m][1];
                    u32x4 w; w.x = cvt_pk_bf16(v0[0], v0[1]); w.y = cvt_pk_bf16(v0[2], v0[3]); w.z = cvt_pk_bf16(v1[0], v1[1]); w.w = cvt_pk_bf16(v1[2], v1[3]);
                    *(u32x4*)(rowp + bj * HALF) = w; } }
    }
};
struct EpiGate1 {
    static constexpr bool PERM = true, AFTER_DRAIN = false;
    const bf16_t* gate; float* tmp;
    __device__ __forceinline__ void operator()(const f32x4 (&acc)[2][2][4][2], const Unit& u, int wr, int wc, int fr, int fq) const {
        const int row0 = u.pm * BM + wr * 64 + fr, col0 = u.pn * BM + wc * 32 + 8 * fq;
#pragma unroll
        for (int ai = 0; ai < 2; ++ai)
#pragma unroll
            for (int m = 0; m < 4; ++m) { const size_t o = (size_t)(row0 + ai * HALF + m * 16) * 1024 + col0;
#pragma unroll
                for (int bj = 0; bj < 2; ++bj) { const u32x4 g = *(const u32x4*)(gate + o + bj * HALF); f32x4 v0 = acc[ai][bj][m][0], v1 = acc[ai][bj][m][1];
                    v0[0] *= sigm(blo(g.x)); v0[1] *= sigm(bhi(g.x)); v0[2] *= sigm(blo(g.y)); v0[3] *= sigm(bhi(g.y));
                    v1[0] *= sigm(blo(g.z)); v1[1] *= sigm(bhi(g.z)); v1[2] *= sigm(blo(g.w)); v1[3] *= sigm(bhi(g.w));
                    *(f32x4*)(tmp + o + bj * HALF) = v0; *(f32x4*)(tmp + o + bj * HALF + 4) = v1; } }
    }
};
struct EpiGate2 {
    static constexpr bool PERM = true, AFTER_DRAIN = false;
    const bf16_t* gate; const float* tmp; bf16_t* out;
    __device__ __forceinline__ void operator()(const f32x4 (&acc)[2][2][4][2], const Unit& u, int wr, int wc, int fr, int fq) const {
        const int row0 = u.pm * BM + wr * 64 + fr, col0 = u.pn * BM + wc * 32 + 8 * fq;
#pragma unroll
        for (int ai = 0; ai < 2; ++ai)
#pragma unroll
            for (int m = 0; m < 4; ++m) { const size_t o = (size_t)(row0 + ai * HALF + m * 16) * 1024 + col0;
#pragma unroll
                for (int bj = 0; bj < 2; ++bj) { const u32x4 g = *(const u32x4*)(gate + o + bj * HALF); f32x4 v0 = acc[ai][bj][m][0], v1 = acc[ai][bj][m][1];
                    const f32x4 t0 = *(const f32x4*)(tmp + o + bj * HALF), t1 = *(const f32x4*)(tmp + o + bj * HALF + 4);
                    v0[0] = t0[0] + v0[0] * sigm(blo(g.x)); v0[1] = t0[1] + v0[1] * sigm(bhi(g.x)); v0[2] = t0[2] + v0[2] * sigm(blo(g.y)); v0[3] = t0[3] + v0[3] * sigm(bhi(g.y));
                    v1[0] = t1[0] + v1[0] * sigm(blo(g.z)); v1[1] = t1[1] + v1[1] * sigm(bhi(g.z)); v1[2] = t1[2] + v1[2] * sigm(blo(g.w)); v1[3] = t1[3] + v1[3] * sigm(bhi(g.w));
                    u32x4 w; w.x = cvt_pk_bf16(v0[0], v0[1]); w.y = cvt_pk_bf16(v0[2], v0[3]); w.z = cvt_pk_bf16(v1[0], v1[1]); w.w = cvt_pk_bf16(v1[2], v1[3]);
                    *(u32x4*)(out + o + bj * HALF) = w; } }
    }
};
struct EpiRes {
    static constexpr bool PERM = false, AFTER_DRAIN = false;
    const float* x; const float* ga; float* out; int mod_pitch, seq;
    __device__ __forceinline__ void operator()(const f32x4 (&acc)[2][2][4][2], const Unit& u, int wr, int wc, int fr, int fq) const {
        const int row0 = u.pm * BM + wr * 64 + fr, col0 = u.pn * BM + wc * 32 + 4 * fq;
        const float* gab = ga + (size_t)((u.pm * BM) / seq) * mod_pitch + col0;
        f32x4 gv[2][2];
#pragma unroll
        for (int bj = 0; bj < 2; ++bj)
#pragma unroll
            for (int n = 0; n < 2; ++n) gv[bj][n] = *(const f32x4*)(gab + bj * HALF + n * 16);
#pragma unroll
        for (int ai = 0; ai < 2; ++ai)
#pragma unroll
            for (int m = 0; m < 4; ++m) { const size_t o = (size_t)(row0 + ai * HALF + m * 16) * 1024 + col0;
#pragma unroll
                for (int bj = 0; bj < 2; ++bj)
#pragma unroll
                    for (int n = 0; n < 2; ++n) { const f32x4 xv = *(const f32x4*)(x + o + bj * HALF + n * 16); *(f32x4*)(out + o + bj * HALF + n * 16) = xv + gv[bj][n] * acc[ai][bj][m][n]; } }
    }
};
struct EpiSwiglu {
    static constexpr bool PERM = true, AFTER_DRAIN = false;
    const float* b1; bf16_t* act;
    __device__ __forceinline__ void operator()(const f32x4 (&acc)[2][2][4][2], const Unit& u, int wr, int wc, int fr, int fq) const {
        const int e = u.pn >> 3, j = u.pn & 7; const int row0 = u.pm * BM + wr * 64 + fr, f0 = 128 * j + wc * 32 + 8 * fq;
        const float* be = b1 + (size_t)e * 2048 + f0;
        const f32x4 bg0 = *(const f32x4*)(be), bg1 = *(const f32x4*)(be + 4), bl0 = *(const f32x4*)(be + 1024), bl1 = *(const f32x4*)(be + 1028);
#pragma unroll
        for (int ai = 0; ai < 2; ++ai)
#pragma unroll
            for (int m = 0; m < 4; ++m) {
                f32x4 g0 = acc[ai][0][m][0] + bg0, g1 = acc[ai][0][m][1] + bg1, l0 = acc[ai][1][m][0] + bl0, l1 = acc[ai][1][m][1] + bl1;
                float r[8];
#pragma unroll
                for (int q = 0; q < 4; ++q) { float gl = fminf(g0[q], 7.0f), li = fminf(fmaxf(l0[q], -7.0f), 7.0f); r[q] = gl * sigm(1.702f * gl) * (li + 1.0f);
                                              gl = fminf(g1[q], 7.0f); li = fminf(fmaxf(l1[q], -7.0f), 7.0f); r[4 + q] = gl * sigm(1.702f * gl) * (li + 1.0f); }
                u32x4 w; w.x = cvt_pk_bf16(r[0], r[1]); w.y = cvt_pk_bf16(r[2], r[3]); w.z = cvt_pk_bf16(r[4], r[5]); w.w = cvt_pk_bf16(r[6], r[7]);
                *(u32x4*)(act + (size_t)(row0 + ai * HALF + m * 16) * 1024 + f0) = w; }
    }
};
struct EpiY {
    static constexpr bool PERM = true, AFTER_DRAIN = false;
    const float* b2; const float* rw; bf16_t* y;
    __device__ __forceinline__ void operator()(const f32x4 (&acc)[2][2][4][2], const Unit& u, int wr, int wc, int fr, int fq) const {
        const int e = u.pn >> 2, j = u.pn & 3; const int row0 = u.pm * BM + wr * 64 + fr, col0 = 256 * j + wc * 32 + 8 * fq;
        const float* be = b2 + (size_t)e * 1024 + col0;
        f32x4 bv[2][2];
#pragma unroll
        for (int bj = 0; bj < 2; ++bj)
#pragma unroll
            for (int n = 0; n < 2; ++n) bv[bj][n] = *(const f32x4*)(be + bj * HALF + 4 * n);
#pragma unroll
        for (int ai = 0; ai < 2; ++ai)
#pragma unroll
            for (int m = 0; m < 4; ++m) { const int row = row0 + ai * HALF + m * 16; const float w_ = rw[row];
#pragma unroll
                for (int bj = 0; bj < 2; ++bj) { const f32x4 v0 = (acc[ai][bj][m][0] + bv[bj][0]) * w_, v1 = (acc[ai][bj][m][1] + bv[bj][1]) * w_;
                    u32x4 w; w.x = cvt_pk_bf16(v0[0], v0[1]); w.y = cvt_pk_bf16(v0[2], v0[3]); w.z = cvt_pk_bf16(v1[0], v1[1]); w.w = cvt_pk_bf16(v1[2], v1[3]);
                    *(u32x4*)(y + (size_t)row * 1024 + col0 + bj * HALF) = w; } }
    }
};

template <class Epi, class Sched, bool ALIGN_EPI = false, bool SP2 = false>
__device__ __forceinline__ void gemm_phase(PG8_LAS unsigned char* lds, const Gemm g, const Sched& S, const Epi& E) {
    const int tid = threadIdx.x, wid = __builtin_amdgcn_readfirstlane(tid >> 6), lane = tid & 63, wr = wid >> 2, wc = wid & 3, fr = lane & 15, fq = lane >> 4;
    const int K = g.K, nt = K / BK;
    unsigned voffA[2], voffB[2];
#pragma unroll
    for (int i = 0; i < 2; ++i) { int R, C; stage_rc(tid * 16 + i * 8192, R, C); const int Rb = Epi::PERM ? ((R & ~31) + perm32(R & 31)) : R;
        voffA[i] = (unsigned)(R * K + C) * 2u; voffB[i] = (unsigned)(Rb * K + C) * 2u; }
    const size_t kstep = (size_t)(BK * 2);
    const size_t hstep = (size_t)HALF * K * 2;
    const size_t tstep = 2 * hstep;
    const unsigned ldsw = (unsigned)wid * 1024u;
    const int aoff = lds_byte(wr * 64 + fr, fq * 8), boff = lds_byte(wc * 32 + fr, fq * 8);
#define PG8_SA(b, h) (((b) * 2 + (h)) * HTB)
#define PG8_SB(b, h) ((4 + (b) * 2 + (h)) * HTB)
#define PG8_STAGE(bufoff, gbase, voff) do { _Pragma("unroll") for (int _i = 0; _i < 2; ++_i) \
        __builtin_amdgcn_global_load_lds((const unsigned*)((const char*)(gbase) + (voff)[_i]), (PG8_LAS unsigned*)(lds + (bufoff) + ldsw + _i * 8192), 16, 0, 0); } while (0)
#define PG8_LDA(dst, b, h) do { _Pragma("unroll") for (int m = 0; m < 4; ++m) _Pragma("unroll") for (int k = 0; k < 2; ++k) dst[m][k] = *(const PG8_LAS bf16x8*)(lds + PG8_SA(b, h) + aoff + m * 2048 + k * 1024); } while (0)
#define PG8_LDB(dst, b, h) do { _Pragma("unroll") for (int n = 0; n < 2; ++n) _Pragma("unroll") for (int k = 0; k < 2; ++k) dst[n][k] = *(const PG8_LAS bf16x8*)(lds + PG8_SB(b, h) + boff + n * 2048 + k * 1024); } while (0)
#define PG8_MMA(ai, bj, At, Bt) do { __builtin_amdgcn_s_setprio(1); _Pragma("unroll") for (int m = 0; m < 4; ++m) _Pragma("unroll") for (int n = 0; n < 2; ++n) _Pragma("unroll") for (int k = 0; k < 2; ++k) \
        acc[ai][bj][m][n] = __builtin_amdgcn_mfma_f32_16x16x32_bf16(Bt[n][k], At[m][k], acc[ai][bj][m][n], 0, 0, 0); __builtin_amdgcn_s_setprio(0); } while (0)
#define PG8_WAIT_V(n) asm volatile("s_waitcnt vmcnt(" #n ")" ::: "memory")
#define PG8_WAIT_L(n) asm volatile("s_waitcnt lgkmcnt(" #n ")" ::: "memory")
#define PG8_BAR __builtin_amdgcn_s_barrier()
#define PG8_SCHED __builtin_amdgcn_sched_barrier(0)
    Unit cur, nxt; int ui = 0;
    if (!S.next(0, cur)) return;
    f32x4 acc[2][2][4][2];
#pragma unroll
    for (int a = 0; a < 2; ++a)
#pragma unroll
        for (int b = 0; b < 2; ++b)
#pragma unroll
            for (int m = 0; m < 4; ++m)
#pragma unroll
                for (int n = 0; n < 2; ++n) acc[a][b][m][n] = (f32x4){0.f, 0.f, 0.f, 0.f};
    bf16x8 At[4][2], B0[2][2], B1[2][2];
    const char* cA = (const char*)g.A + (size_t)cur.pm * tstep; const char* cB = (const char*)g.Bt + (size_t)cur.pn * tstep;
    S.a_ready(cur);
    if constexpr (SP2) {
        PG8_STAGE(PG8_SB(0, 0), cB, voffB); PG8_STAGE(PG8_SB(0, 1), cB + hstep, voffB); PG8_STAGE(PG8_SA(0, 0), cA, voffA); PG8_STAGE(PG8_SA(0, 1), cA + hstep, voffA);
        if (wr == 1) PG8_BAR;
        PG8_WAIT_V(2); PG8_BAR;
        PG8_STAGE(PG8_SB(1, 0), cB + kstep, voffB); PG8_STAGE(PG8_SA(1, 0), cA + kstep, voffA); PG8_STAGE(PG8_SB(1, 1), cB + hstep + kstep, voffB);
        PG8_WAIT_V(6); PG8_BAR;
    } else {
        PG8_STAGE(PG8_SB(0, 0), cB, voffB); PG8_STAGE(PG8_SA(0, 0), cA, voffA); PG8_STAGE(PG8_SB(0, 1), cB + hstep, voffB); PG8_STAGE(PG8_SA(0, 1), cA + hstep, voffA);
        if (wr == 1) PG8_BAR;
        PG8_WAIT_V(4); PG8_BAR;
        PG8_STAGE(PG8_SB(1, 0), cB + kstep, voffB); PG8_STAGE(PG8_SA(1, 0), cA + kstep, voffA); PG8_STAGE(PG8_SB(1, 1), cB + hstep + kstep, voffB);
        PG8_WAIT_V(6); PG8_BAR;
    }
    for (;;) {
        const bool has_next = S.next(ui + 1, nxt);
        const char* nA = has_next ? (const char*)g.A + (size_t)nxt.pm * tstep : cA; const char* nB = has_next ? (const char*)g.Bt + (size_t)nxt.pn * tstep : cB;
        for (int t = 0; t < nt; t += 2) {
            const bool last = (t == nt - 2);
            const char* a1 = cA + (size_t)(t + 1) * kstep;
            const char* a2 = last ? nA : cA + (size_t)(t + 2) * kstep; const char* b2 = last ? nB : cB + (size_t)(t + 2) * kstep;
            const char* a3 = a2 + kstep; const char* b3 = b2 + kstep;
            if (last && has_next) S.a_ready(nxt);
            if constexpr (SP2) {
            PG8_LDB(B0, 0, 0); PG8_LDB(B1, 0, 1); PG8_SCHED; PG8_LDA(At, 0, 0); PG8_STAGE(PG8_SA(1, 1), a1 + hstep, voffA);
            PG8_WAIT_V(8); PG8_WAIT_L(0); PG8_BAR; PG8_MMA(0, 0, At, B0); PG8_MMA(0, 1, At, B1); PG8_BAR; PG8_SCHED;
            PG8_LDA(At, 0, 1); PG8_STAGE(PG8_SB(0, 0), b2, voffB); PG8_STAGE(PG8_SB(0, 1), b2 + hstep, voffB); PG8_STAGE(PG8_SA(0, 0), a2, voffA);
            PG8_WAIT_V(8); PG8_WAIT_L(0); PG8_BAR; PG8_MMA(1, 0, At, B0); PG8_MMA(1, 1, At, B1); PG8_BAR; PG8_SCHED;
            PG8_LDB(B0, 1, 0); PG8_LDB(B1, 1, 1); PG8_SCHED; PG8_LDA(At, 1, 0); PG8_STAGE(PG8_SA(0, 1), a2 + hstep, voffA);
            PG8_WAIT_V(8); PG8_WAIT_L(0); PG8_BAR; PG8_MMA(0, 0, At, B0); PG8_MMA(0, 1, At, B1); PG8_BAR; PG8_SCHED;
            PG8_LDA(At, 1, 1); PG8_STAGE(PG8_SB(1, 0), b3, voffB); PG8_STAGE(PG8_SB(1, 1), b3 + hstep, voffB); PG8_STAGE(PG8_SA(1, 0), a3, voffA);
            PG8_WAIT_V(8); PG8_WAIT_L(0); PG8_BAR; PG8_MMA(1, 0, At, B0); PG8_MMA(1, 1, At, B1); PG8_BAR; PG8_SCHED;
            } else {
            PG8_LDB(B0, 0, 0); PG8_SCHED; PG8_LDA(At, 0, 0); PG8_STAGE(PG8_SA(1, 1), a1 + hstep, voffA);
            PG8_WAIT_L(8); PG8_BAR; PG8_WAIT_L(0); PG8_MMA(0, 0, At, B0); PG8_BAR; PG8_SCHED;
            PG8_LDB(B1, 0, 1); PG8_STAGE(PG8_SB(0, 0), b2, voffB);
            PG8_BAR; PG8_WAIT_L(0); PG8_MMA(0, 1, At, B1); PG8_BAR;
            PG8_LDA(At, 0, 1); PG8_STAGE(PG8_SA(0, 0), a2, voffA);
            PG8_BAR; PG8_WAIT_L(0); PG8_MMA(1, 0, At, B0); PG8_BAR; PG8_SCHED;
            PG8_STAGE(PG8_SB(0, 1), b2 + hstep, voffB);
            PG8_WAIT_V(6); PG8_BAR; PG8_MMA(1, 1, At, B1); PG8_BAR;
            PG8_LDB(B0, 1, 0); PG8_SCHED; PG8_LDA(At, 1, 0); PG8_STAGE(PG8_SA(0, 1), a2 + hstep, voffA);
            PG8_WAIT_L(8); PG8_BAR; PG8_WAIT_L(0); PG8_MMA(0, 0, At, B0); PG8_BAR; PG8_SCHED;
            PG8_LDB(B1, 1, 1); PG8_STAGE(PG8_SB(1, 0), b3, voffB);
            PG8_BAR; PG8_WAIT_L(0); PG8_MMA(0, 1, At, B1); PG8_BAR;
            PG8_LDA(At, 1, 1); PG8_STAGE(PG8_SA(1, 0), a3, voffA);
            PG8_BAR; PG8_WAIT_L(0); PG8_MMA(1, 0, At, B0); PG8_BAR; PG8_SCHED;
            PG8_STAGE(PG8_SB(1, 1), b3 + hstep, voffB);
            PG8_WAIT_V(6); PG8_BAR; PG8_MMA(1, 1, At, B1); PG8_BAR;
            }
        }
        if constexpr (ALIGN_EPI) { if (wr == 0) PG8_BAR; }
        if constexpr (!Epi::AFTER_DRAIN) { E(acc, cur, wr, wc, fr, fq); S.done(cur); }
        if (!has_next) break;
#pragma unroll
        for (int a = 0; a < 2; ++a)
#pragma unroll
            for (int b = 0; b < 2; ++b)
#pragma unroll
                for (int m = 0; m < 4; ++m)
#pragma unroll
                    for (int n = 0; n < 2; ++n) acc[a][b][m][n] = (f32x4){0.f, 0.f, 0.f, 0.f};
        cur = nxt; cA = nA; cB = nB; ++ui;
        if constexpr (ALIGN_EPI) { if (wr == 1) PG8_BAR; }
    }
    PG8_WAIT_V(0);
    if constexpr (!ALIGN_EPI) { if (wr == 0) PG8_BAR; }
    PG8_BAR;
    if constexpr (Epi::AFTER_DRAIN) { E.fused(acc, cur, wr, wc, fr, fq, lds, wid, lane); S.done(cur); }
#undef PG8_SA
#undef PG8_SB
#undef PG8_STAGE
#undef PG8_LDA
#undef PG8_LDB
#undef PG8_MMA
#undef PG8_WAIT_V
#undef PG8_WAIT_L
#undef PG8_BAR
#undef PG8_SCHED
}
}
#define XB_TMO      128
#define XB_XCNT(j)  (256  + 64 * (j))
#define XB_XSUB(j)  (1280 + 64 * (j))
#define XB_XGEN(j)  (2304 + 64 * (j))
#define XB_TOP      3328
#define XB_TOPGEN   3392
#define XCD_BAR_WORDS 3456
#define XB_SPIN_CAP (1u << 18)

__device__ __forceinline__ unsigned xb_ld(unsigned* p)              { return __hip_atomic_load(p, __ATOMIC_RELAXED, __HIP_MEMORY_SCOPE_AGENT); }
__device__ __forceinline__ unsigned xb_add(unsigned* p, unsigned v) { return __hip_atomic_fetch_add(p, v, __ATOMIC_RELAXED, __HIP_MEMORY_SCOPE_AGENT); }
__device__ __forceinline__ unsigned xb_xcc_id() { return (unsigned)__builtin_amdgcn_s_getreg((3 << 11) | 20) & 0xFu; }
#define XB_SPIN(cond, bar) do { unsigned _sp = 0; while (cond) { __builtin_amdgcn_s_sleep(1); \
    if ((++_sp & 255u) == 0u) { if (xb_ld(&(bar)[XB_TMO])) break; if (_sp > XB_SPIN_CAP) { atomicAdd(&(bar)[XB_TMO], 1u); break; } } } } while (0)

struct XcdBarrier {
    unsigned* bar; unsigned x;
    volatile LAS unsigned* st;
};

__device__ __forceinline__ XcdBarrier xcd_barrier_post(unsigned* bar, volatile LAS unsigned* st) {
    XcdBarrier b; b.bar = bar; b.x = xb_xcc_id(); b.st = st;
    if (threadIdx.x == 0) (void)xb_add(&bar[XB_XCNT(b.x)], 1u);
    return b;
}
__device__ __forceinline__ void xcd_barrier_complete(unsigned* bar, unsigned x, unsigned& nloc, unsigned& nx) {
    const unsigned G = gridDim.x * gridDim.y * gridDim.z;
    unsigned sum, cnt, mine, sp = 0u;
    for (;;) {
        sum = 0u; cnt = 0u; mine = 0u;
#pragma unroll
        for (unsigned j = 0; j < 16; ++j) { const unsigned c = xb_ld(&bar[XB_XCNT(j)]); sum += c; cnt += (c > 0u) ? 1u : 0u; mine = (j == x) ? c : mine; }
        if (sum == G) break;
        __builtin_amdgcn_s_sleep(1);
        if ((++sp & 255u) == 0u) { if (xb_ld(&bar[XB_TMO])) break; if (sp > XB_SPIN_CAP) { atomicAdd(&bar[XB_TMO], 1u); break; } }
    }
    nloc = mine > 0u ? mine : 1u; nx = cnt > 0u ? cnt : 1u;
}

__device__ __forceinline__ void xcd_barrier(const XcdBarrier& b) {
    asm volatile("s_waitcnt vmcnt(0)" ::: "memory");
    __syncthreads();
    if (threadIdx.x == 0) {
        unsigned* bar = b.bar;
        __builtin_amdgcn_s_waitcnt(0);
        unsigned nloc = b.st[0], nx = b.st[1];
        if (nloc == 0u) { xcd_barrier_complete(bar, b.x, nloc, nx); b.st[0] = nloc; b.st[1] = nx; }
        const unsigned old = xb_add(&bar[XB_XSUB(b.x)], 1u);
        const unsigned gen = old / nloc;
        if (old + 1u == (gen + 1u) * nloc) {
            __builtin_amdgcn_fence(__ATOMIC_RELEASE, "agent");
            asm volatile("s_waitcnt vmcnt(0)" ::: "memory");
            const unsigned og = xb_add(&bar[XB_TOP], 1u);
            const unsigned tg = og / nx;
            if (og + 1u == (tg + 1u) * nx) xb_add(&bar[XB_TOPGEN], 1u);
            else XB_SPIN(xb_ld(&bar[XB_TOPGEN]) == tg, bar);
            __builtin_amdgcn_fence(__ATOMIC_ACQUIRE, "agent");
            xb_add(&bar[XB_XGEN(b.x)], 1u);
            asm volatile("s_waitcnt vmcnt(0)" ::: "memory");
        } else {
            XB_SPIN(xb_ld(&bar[XB_XGEN(b.x)]) == gen, bar);
            __builtin_amdgcn_fence(__ATOMIC_ACQUIRE, "agent");
            asm volatile("s_waitcnt vmcnt(0)" ::: "memory");
        }
    }
    __syncthreads();
}

struct Ctx { LAS unsigned char* lds; int tid, lane, wave, vcu, G; };

__device__ __forceinline__ void transpose_item(const float* W, int ldw, int K, bf16_t* dst, int k0, int n0, LAS float* scr, int lane) {
#pragma unroll 8
    for (int i = 0; i < 32; ++i) { const int kk = 2 * i + (lane >> 5); scr[kk * 33 + (lane & 31)] = W[(size_t)(k0 + kk) * ldw + n0 + (lane & 31)]; }
    LDS_WAIT();
    const int c = lane & 7;
#pragma unroll
    for (int j = 0; j < 4; ++j) { const int n = (lane >> 3) + 8 * j; const LAS float* s = scr + (8 * c) * 33 + n;
        u32x4 o; o.x = pk2(s[0 * 33], s[1 * 33]); o.y = pk2(s[2 * 33], s[3 * 33]); o.z = pk2(s[4 * 33], s[5 * 33]); o.w = pk2(s[6 * 33], s[7 * 33]);
        *(u32x4*)(dst + (size_t)n * K + k0 + 8 * c) = o; }
    LDS_WAIT();
}

__device__ __forceinline__ void ph_prologue(const Ctx& X, const float* c, const float* w_ada, const float* b_ada, float* mod,
                                            const float* w_in, const float* w_conv_out, const float* w_hgrn_out, const float* w_out, const float* w1, const float* w2, unsigned char* ws) {
    if (X.vcu < 48) {
        LAS float* ca = (LAS float*)X.lds;
        LAS float* red = (LAS float*)(X.lds + 16384);
        for (int i = X.tid; i < 4096; i += 512) { const float v = c[i]; ca[i] = v * sigmoidf_(v); }
        __syncthreads();
        const int jj = X.tid & 127, kq = X.tid >> 7, j = X.vcu * 128 + jj;
        float a0 = 0.f, a1 = 0.f, a2 = 0.f, a3 = 0.f;
#pragma unroll 8
        for (int i = kq * 256; i < kq * 256 + 256; ++i) { const float w = w_ada[(size_t)i * NMOD + j]; a0 += ca[i] * w; a1 += ca[1024 + i] * w; a2 += ca[2048 + i] * w; a3 += ca[3072 + i] * w; }
        red[(kq * 4 + 0) * 128 + jj] = a0; red[(kq * 4 + 1) * 128 + jj] = a1; red[(kq * 4 + 2) * 128 + jj] = a2; red[(kq * 4 + 3) * 128 + jj] = a3;
        __syncthreads();
        { const int b = X.tid >> 7; mod[(size_t)b * NMOD + j] = b_ada[j] + red[(0 * 4 + b) * 128 + jj] + red[(1 * 4 + b) * 128 + jj] + red[(2 * 4 + b) * 128 + jj] + red[(3 * 4 + b) * 128 + jj]; }
        __syncthreads();
    }
    LAS float* scr = (LAS float*)(X.lds + X.wave * 16384);
    const int gw = X.vcu * 8 + X.wave, NGW = X.G * 8;
    constexpr int I_IN = 16 * 256, I_SQ = 16 * 32, I_W1 = 32 * 16 * 64, I_W2 = 32 * 16 * 32, NITEMS = I_IN + 3 * I_SQ + I_W1 + I_W2;
    for (int it = gw; it < NITEMS; it += NGW) {
        int r = it;
        if (r < I_IN) { const int kb = r >> 8, nb = r & 255; transpose_item(w_in, 8192, 1024, (bf16_t*)(ws + WS_WIN) + (size_t)(32 * nb) * 1024, 64 * kb, 32 * nb, scr, X.lane); continue; } r -= I_IN;
        if (r < 3 * I_SQ) { const int which = r / I_SQ, q = r % I_SQ, kb = q >> 5, nb = q & 31;
            const float* W = which == 0 ? w_conv_out : (which == 1 ? w_hgrn_out : w_out); bf16_t* WT = (bf16_t*)(ws + (which == 0 ? WS_WC : (which == 1 ? WS_WH : WS_WO)));
            transpose_item(W, 1024, 1024, WT + (size_t)(32 * nb) * 1024, 64 * kb, 32 * nb, scr, X.lane); continue; } r -= 3 * I_SQ;
        if (r < I_W1) { const int e = r >> 10, q = r & 1023, kb = q >> 6, nb = q & 63, n0 = 32 * nb;
            const int rho0 = (n0 < 1024) ? 256 * (n0 >> 7) + (n0 & 127) : 256 * ((n0 - 1024) >> 7) + 128 + ((n0 - 1024) & 127);
            transpose_item(w1 + (size_t)e * 1024 * 2048, 2048, 1024, (bf16_t*)(ws + WS_W1) + ((size_t)e * 2048 + rho0) * 1024, 64 * kb, n0, scr, X.lane); continue; } r -= I_W1;
        { const int e = r >> 9, q = r & 511, kb = q >> 5, nb = q & 31;
            transpose_item(w2 + (size_t)e * 1024 * 1024, 1024, 1024, (bf16_t*)(ws + WS_W2) + ((size_t)e * 1024 + 32 * nb) * 1024, 64 * kb, 32 * nb, scr, X.lane); }
    }
}

__device__ __forceinline__ void ph_norm_mod(const Ctx& X, const float* x, const float* g, const float* mod, int sh_off, int sc_off, bf16_t* out) {
    for (int t = X.vcu * 8 + X.wave; t < T; t += X.G * 8) {
        const int b = t / SEQ, lane = X.lane;
        const f32x4* xr = (const f32x4*)(x + (size_t)t * D) + lane;
        f32x4 v[4]; float ss = 0.f;
#pragma unroll
        for (int j = 0; j < 4; ++j) { v[j] = xr[64 * j]; ss += (v[j].x * v[j].x + v[j].y * v[j].y) + (v[j].z * v[j].z + v[j].w * v[j].w); }
        const float r = rsqrtf(wave_sum(ss) * (1.0f / D) + EPS);
        const float* sh = mod + (size_t)b * NMOD + sh_off; const float* sc = mod + (size_t)b * NMOD + sc_off;
#pragma unroll
        for (int j = 0; j < 4; ++j) {
            const int col = 4 * (lane + 64 * j);
            const f32x4 gg = *(const f32x4*)(g + col), s1 = *(const f32x4*)(sc + col), s0 = *(const f32x4*)(sh + col);
            const f32x4 y = v[j] * r * gg * (s1 + 1.0f) + s0;
            u32x2 w; w.x = pk2(y.x, y.y); w.y = pk2(y.z, y.w);
            *(u32x2*)(out + (size_t)t * D + col) = w;
        }
    }
}

__device__ __forceinline__ void ph_conv(const Ctx& X, const bf16_t* pA, const bf16_t* pB, const float* dw, const float* dwb, const float* lng, const float* lnb, bf16_t* uc) {
    LAS float* sm = (LAS float*)X.lds;
    const int tid = X.tid, lane = X.lane, wid = X.wave, c0 = 2 * tid;
    float w[31][2];
#pragma unroll
    for (int j = 0; j < 31; ++j) { w[j][0] = dw[j * 1024 + c0]; w[j][1] = dw[j * 1024 + c0 + 1]; }
    const float bias0 = dwb[c0], bias1 = dwb[c0 + 1];
    for (int task = X.vcu; task < T / 32; task += X.G) {
        const int b = task >> 8, s0 = (task & 255) * 32;
        const bf16_t* qa = pA + (size_t)(b * SEQ) * D + c0; const bf16_t* qb = pB + (size_t)(b * SEQ) * D + c0;
        float u[38][2];
#pragma unroll
        for (int st = 0; st < 4; ++st) {
#pragma unroll
            for (int i = (st == 0 ? 0 : 8 * st + 30); i < 8 * st + 38; ++i) {
                const int s = s0 - 30 + i;
                float u0 = 0.f, u1 = 0.f;
                if (s >= 0) { const unsigned a2 = *(const unsigned*)(qa + (size_t)s * D), b2 = *(const unsigned*)(qb + (size_t)s * D);
                              u0 = bflo(a2) * sigmoidf_(bflo(b2)); u1 = bfhi(a2) * sigmoidf_(bfhi(b2)); }
                u[i % 38][0] = u0; u[i % 38][1] = u1;
            }
#pragma unroll
            for (int t = 8 * st; t < 8 * st + 8; ++t) {
                float a0 = bias0, a1 = bias1;
#pragma unroll
                for (int j = 0; j < 31; ++j) { a0 += w[j][0] * u[(t + j) % 38][0]; a1 += w[j][1] * u[(t + j) % 38][1]; }
                sm[t * 1024 + c0] = a0; sm[t * 1024 + c0 + 1] = a1;
            }
        }
        __syncthreads();
#pragma unroll 1
        for (int i = 0; i < 4; ++i) {
            const int t = wid * 4 + i;
            f32x4 v[4]; float s = 0.f;
#pragma unroll
            for (int j = 0; j < 4; ++j) { v[j] = *(const LAS f32x4*)(sm + t * 1024 + 4 * (lane + 64 * j)); s += (v[j].x + v[j].y) + (v[j].z + v[j].w); }
            const float mean = wave_sum(s) * (1.0f / D); float q = 0.f;
#pragma unroll
            for (int j = 0; j < 4; ++j) { v[j] = v[j] - mean; q += (v[j].x * v[j].x + v[j].y * v[j].y) + (v[j].z * v[j].z + v[j].w * v[j].w); }
            const float rstd = rsqrtf(wave_sum(q) * (1.0f / D) + EPS);
#pragma unroll
            for (int j = 0; j < 4; ++j) {
                const int col = 4 * (lane + 64 * j);
                const f32x4 gg = *(const f32x4*)(lng + col), bb = *(const f32x4*)(lnb + col);
                f32x4 y = v[j] * rstd * gg + bb;
                y.x *= sigmoidf_(y.x); y.y *= sigmoidf_(y.y); y.z *= sigmoidf_(y.z); y.w *= sigmoidf_(y.w);
                u32x2 o; o.x = pk2(y.x, y.y); o.y = pk2(y.z, y.w);
                *(u32x2*)(uc + (size_t)(b * SEQ + s0 + t) * D + col) = o;
            }
        }
        __syncthreads();
    }
}

__device__ __forceinline__ void ph_hgrn_naive(const Ctx& X, const bf16_t* pQ, const bf16_t* pF, const bf16_t* pI, const bf16_t* pG, const float* lb_param, const float* norm_g, bf16_t* og) {
    LAS float* sq = (LAS float*)X.lds; LAS float* sf = sq + 1024; LAS float* sk = sf + 1024; LAS float* red = sk + 1024;
    const int tid = X.tid; const bool act = tid < 128;
    for (int bh = X.vcu; bh < 32; bh += X.G) {
        const int b = bh >> 3, h = bh & 7, col = h * 128 + (tid & 127);
        const float lbk = 1.0f / (1.0f + __expf(lb_param[1024 + col] - lb_param[col]));
        const float ng = norm_g[tid & 127];
        float S[128];
#pragma unroll
        for (int k = 0; k < 128; ++k) S[k] = 0.f;
        for (int t0 = 0; t0 < SEQ; t0 += 8) {
            if (act) {
#pragma unroll
                for (int i = 0; i < 8; ++i) {
                    const size_t o = (size_t)(b * SEQ + t0 + i) * D + col;
                    const float z = bf2f(pF[o]), q = bf2f(pQ[o]) * 0.08838834764831845f;
                    const float kk = (1.0f - lbk) * sigmoidf_(-z);
                    sq[i * 128 + tid] = q; sf[i * 128 + tid] = 1.0f - kk; sk[i * 128 + tid] = kk;
                }
            }
            __syncthreads();
            float o8[8];
            if (act) {
#pragma unroll 1
                for (int i = 0; i < 8; ++i) {
                    const float vv = bf2f(pI[(size_t)(b * SEQ + t0 + i) * D + col]);
                    float a = 0.f;
#pragma unroll
                    for (int k = 0; k < 128; ++k) { S[k] = sf[i * 128 + k] * S[k] + sk[i * 128 + k] * vv; a += sq[i * 128 + k] * S[k]; }
                    const float ss = wave_sum(a * a);
                    if ((tid & 63) == 0) red[i * 2 + (tid >> 6)] = ss;
#pragma unroll
                    for (int ii = 0; ii < 8; ++ii) if (ii == i) o8[ii] = a;
                }
            }
            __syncthreads();
            if (act) {
#pragma unroll
                for (int i = 0; i < 8; ++i) {
                    const size_t o = (size_t)(b * SEQ + t0 + i) * D + col;
                    const float r = rsqrtf((red[i * 2] + red[i * 2 + 1]) * (1.0f / 128.0f) + EPS);
                    const float gv = bf2f(pG[o]);
                    og[o] = (bf16_t)f2bf(o8[i] * r * ng * gv * sigmoidf_(gv));
                }
            }
            __syncthreads();
        }
    }
}

__device__ __forceinline__ void ph_route(const Ctx& X, const float* x1, const float* g_ffn, const float* mod, const float* w_router, const float* b_router,
                                         bf16_t* h2, int* top_e, float* top_w, int* rank, int* hist_g) {
    LAS float* hrow = (LAS float*)X.lds + X.wave * 1024;
    LAS int* hist = (LAS int*)(X.lds + LDSCTL_OFF + 64);
    const int tid = X.tid, lane = X.lane;
    const int e = lane & 31, half = lane >> 5;
    const float be = b_router[e];
    for (int tile = X.vcu; tile < RT_NT; tile += X.G) {
        if (tid < 32) hist[tid] = 0;
        __syncthreads();
        for (int i = 0; i < 16; ++i) {
            const int t = tile * RT_TILE + X.wave * 16 + i, b = t / SEQ;
            const f32x4* xr = (const f32x4*)(x1 + (size_t)t * D) + lane;
            f32x4 v[4]; float ss = 0.f;
#pragma unroll
            for (int j = 0; j < 4; ++j) { v[j] = xr[64 * j]; ss += (v[j].x * v[j].x + v[j].y * v[j].y) + (v[j].z * v[j].z + v[j].w * v[j].w); }
            const float r = rsqrtf(wave_sum(ss) * (1.0f / D) + EPS);
            const float* sh = mod + (size_t)b * NMOD + 3 * D; const float* sc = mod + (size_t)b * NMOD + 4 * D;
#pragma unroll
            for (int j = 0; j < 4; ++j) {
                const int col = 4 * (lane + 64 * j);
                const f32x4 gg = *(const f32x4*)(g_ffn + col), s1 = *(const f32x4*)(sc + col), s0 = *(const f32x4*)(sh + col);
                const f32x4 y = v[j] * r * gg * (s1 + 1.0f) + s0;
                *(LAS f32x4*)(hrow + col) = y;
                u32x2 w; w.x = pk2(y.x, y.y); w.y = pk2(y.z, y.w);
                *(u32x2*)(h2 + (size_t)t * D + col) = w;
            }
            LDS_WAIT();
            float a = 0.f;
            const float* wr_ = w_router + (size_t)(half * 512) * NE + e;
            const LAS float* hr = hrow + half * 512;
#pragma unroll 8
            for (int k = 0; k < 512; ++k) a += hr[k] * wr_[(size_t)k * NE];
            a += __shfl_xor(a, 32);
            float logit = a + be;
            float sv[4]; int si[4];
#pragma unroll
            for (int rnd = 0; rnd < 4; ++rnd) {
                float bv = logit; int bi = e;
#pragma unroll
                for (int o = 16; o >= 1; o >>= 1) { const float ov = __shfl_xor(bv, o); const int oi = __shfl_xor(bi, o); if (ov > bv || (ov == bv && oi < bi)) { bv = ov; bi = oi; } }
                sv[rnd] = bv; si[rnd] = bi; if (e == bi) logit = -INFINITY;
            }
            const float e1 = __expf(sv[1] - sv[0]), e2 = __expf(sv[2] - sv[0]), e3 = __expf(sv[3] - sv[0]);
            const float inv = 1.0f / (1.0f + e1 + e2 + e3);
            if (lane == 0) {
                const float ww[4] = {inv, e1 * inv, e2 * inv, e3 * inv};
#pragma unroll
                for (int rnd = 0; rnd < 4; ++rnd) { top_e[t * 4 + rnd] = si[rnd]; top_w[t * 4 + rnd] = ww[rnd]; rank[t * 4 + rnd] = atomicAdd((int*)&hist[si[rnd]], 1); }
            }
        }
        __syncthreads();
        if (tid < 32) hist_g[tile * 32 + tid] = hist[tid];
        __syncthreads();
    }
}

__device__ __forceinline__ void ph_sort(const Ctx& X, const int* hist_g, const int* top_e, const float* top_w, const int* rank, int* row_tok, float* row_w, int* pair_row, int* blk_e) {
    LAS int* s_tot = (LAS int*)X.lds; LAS int* s_pre = s_tot + 32; LAS int* s_base = s_pre + 32; LAS int* s_pstart = s_base + 32; LAS int* s_pend = s_pstart + 32;
    const int tid = X.tid;
    for (int tile = X.vcu; tile < RT_NT; tile += X.G) {
        if (tid < 32) { int tot = 0, pre = 0; for (int i = 0; i < RT_NT; ++i) { const int c = hist_g[i * 32 + tid]; tot += c; if (i < tile) pre += c; } s_tot[tid] = tot; s_pre[tid] = pre; }
        __syncthreads();
        if (tid == 0) { int acc = 0; for (int e = 0; e < 32; ++e) { const int padded = (s_tot[e] + 255) / 256 * 256; s_pstart[e] = acc; s_base[e] = acc + s_pre[e]; acc += padded; s_pend[e] = acc; } }
        __syncthreads();
        { const int i = tid; const int idx = tile * RT_TILE * 4 + i; const int e = top_e[idx]; const int row = s_base[e] + rank[idx];
          row_tok[row] = idx >> 2; row_w[row] = top_w[idx]; pair_row[idx] = row; }
        if (tile < 32) { const int e = tile; for (int r = s_pstart[e] + s_tot[e] + tid; r < s_pend[e]; r += 512) { row_tok[r] = 0; row_w[r] = 0.f; } }
        if (tile == 32) { for (int blk = tid; blk < NBLK_MAX; blk += 512) { int e = -1; const int r = blk * 256; for (int q = 0; q < 32; ++q) if (r >= s_pstart[q] && r < s_pend[q]) e = q; blk_e[blk] = e; }
                          if (tid == 0) blk_e[NBLK_MAX] = s_pend[31] / 256; }
        __syncthreads();
    }
}

__device__ __forceinline__ void ph_gather(const Ctx& X, const bf16_t* h2, const int* row_tok, int nrows, bf16_t* hs) {
    for (int row = X.vcu * 8 + X.wave; row < nrows; row += X.G * 8) {
        const int tok = row_tok[row];
        const u32x4* s = (const u32x4*)(h2 + (size_t)tok * D); u32x4* d = (u32x4*)(hs + (size_t)row * D);
        const u32x4 a = s[X.lane], b = s[X.lane + 64]; d[X.lane] = a; d[X.lane + 64] = b;
    }
}

__device__ __forceinline__ void ph_final(const Ctx& X, const float* x1, const bf16_t* y, const int* pair_row, const float* mod, const float* g_final, float* out) {
    const int lane = X.lane;
    for (int t = X.vcu * 8 + X.wave; t < T; t += X.G * 8) {
        const int b = t / SEQ;
        const f32x4* xr = (const f32x4*)(x1 + (size_t)t * D) + lane;
        const float* ga = mod + (size_t)b * NMOD + 5 * D;
        int rows[4];
#pragma unroll
        for (int k = 0; k < 4; ++k) rows[k] = pair_row[t * 4 + k];
        f32x4 v[4]; float ss = 0.f;
#pragma unroll
        for (int j = 0; j < 4; ++j) {
            const int col = 4 * (lane + 64 * j);
            f32x4 m = (f32x4){0.f, 0.f, 0.f, 0.f};
#pragma unroll
            for (int k = 0; k < 4; ++k) { const u32x2 w = *(const u32x2*)(y + (size_t)rows[k] * D + col); m.x += bflo(w.x); m.y += bfhi(w.x); m.z += bflo(w.y); m.w += bfhi(w.y); }
            v[j] = xr[64 * j] + *(const f32x4*)(ga + col) * m;
            ss += (v[j].x * v[j].x + v[j].y * v[j].y) + (v[j].z * v[j].z + v[j].w * v[j].w);
        }
        const float r = rsqrtf(wave_sum(ss) * (1.0f / D) + EPS);
#pragma unroll
        for (int j = 0; j < 4; ++j) { const int col = 4 * (lane + 64 * j); *(f32x4*)(out + (size_t)t * D + col) = v[j] * r * *(const f32x4*)(g_final + col); }
    }
}

constexpr int N_PHASES = 12;
struct Args { const float* in[23]; float* out; unsigned char* ws; int ph_lo, ph_hi; };
__global__ void __launch_bounds__(512, 2) fwd(Args a) {
    extern __shared__ __attribute__((aligned(16))) unsigned char lds_raw[];
    Ctx X; X.lds = (LAS unsigned char*)lds_raw; X.tid = threadIdx.x; X.lane = X.tid & 63; X.wave = __builtin_amdgcn_readfirstlane(X.tid >> 6);
    X.G = gridDim.x; { const int bx = blockIdx.x; X.vcu = (X.G % 8 == 0) ? (bx % 8) * (X.G / 8) + bx / 8 : bx; }
    unsigned char* ws = a.ws;
    for (int u = X.tid; u < (LDS_BYTES - LDSCTL_OFF) / 4; u += 512) ((LAS unsigned*)(X.lds + LDSCTL_OFF))[u] = 0u;
    __syncthreads();
    XcdBarrier bar = xcd_barrier_post((unsigned*)(ws + WS_CTL) + CW_BAR, (volatile LAS unsigned*)(X.lds + LDSCTL_OFF));
    const int lo = a.ph_lo, hi = a.ph_hi;
#define IN(k) (lo <= (k) && (k) < hi)
#define SEAM(k) do { if (IN(k) && IN((k) + 1)) xcd_barrier(bar); } while (0)
    const float* x = a.in[0]; const float* c = a.in[1]; const float* w_ada = a.in[2]; const float* b_ada = a.in[3];
    const float* g_mix = a.in[4]; const float* w_in = a.in[5]; const float* conv_dw = a.in[6]; const float* conv_dwb = a.in[7];
    const float* conv_ln_g = a.in[8]; const float* conv_ln_b = a.in[9]; const float* w_conv_out = a.in[10]; const float* lb_param = a.in[11];
    const float* hgrn_norm_g = a.in[12]; const float* w_hgrn_out = a.in[13]; const float* w_out = a.in[14]; const float* g_ffn = a.in[15];
    const float* w_router = a.in[16]; const float* b_router = a.in[17]; const float* w1 = a.in[18]; const float* b1 = a.in[19];
    const float* w2 = a.in[20]; const float* b2 = a.in[21]; const float* g_final = a.in[22];
    float* mod = (float*)(ws + WS_MOD);
    int* hist_g = (int*)(ws + WS_HIST); int* blk_e = (int*)(ws + WS_BLKE); int* top_e = (int*)(ws + WS_TOPE); float* top_w = (float*)(ws + WS_TOPW);
    int* rank = (int*)(ws + WS_RANK); int* pair_row = (int*)(ws + WS_PROW); int* row_tok = (int*)(ws + WS_RTOK); float* row_w = (float*)(ws + WS_RW);
    bf16_t* p = (bf16_t*)(ws + WS_P);
    bf16_t* h = (bf16_t*)(ws + WS_E); float* tmp = (float*)(ws + WS_E);
    bf16_t* uc = (bf16_t*)(ws + WS_D); bf16_t* og = uc + PG; float* x1 = (float*)(ws + WS_D);
    bf16_t* merged = p;
    bf16_t* h2 = p;
    bf16_t* hs = p + PG;
    bf16_t* act = hs + (size_t)R_PAD * D;
    bf16_t* y = hs;
    PG8_LAS unsigned char* ring = (PG8_LAS unsigned char*)lds_raw;

    if (IN(0)) ph_prologue(X, c, w_ada, b_ada, mod, w_in, w_conv_out, w_hgrn_out, w_out, w1, w2, ws);
    SEAM(0);
    if (IN(1)) ph_norm_mod(X, x, g_mix, mod, 0, D, h);
    SEAM(1);
    if (IN(2)) { pg8::Gemm g{h, (const bf16_t*)(ws + WS_WIN), T, 8 * D, D}; pg8::StaticOrder S; S.init(T, 8 * D, X.G, (int)blockIdx.x);
        pg8::EpiSplitBf16 E{p, PG}; pg8::gemm_phase<pg8::EpiSplitBf16, pg8::StaticOrder, true, true>(ring, g, S, E); }
    SEAM(2);
    if (IN(3)) { ph_conv(X, p + 0 * PG, p + 1 * PG, conv_dw, conv_dwb, conv_ln_g, conv_ln_b, uc);
                 ph_hgrn_naive(X, p + 2 * PG, p + 3 * PG, p + 4 * PG, p + 5 * PG, lb_param, hgrn_norm_g, og); }
    SEAM(3);
    if (IN(4)) { pg8::StaticOrder S; S.init(T, D, X.G, (int)blockIdx.x);
        { pg8::Gemm g{uc, (const bf16_t*)(ws + WS_WC), T, D, D}; pg8::EpiGate1 E{p + 6 * PG, tmp}; pg8::gemm_phase<pg8::EpiGate1, pg8::StaticOrder, true, true>(ring, g, S, E); }
        { pg8::Gemm g{og, (const bf16_t*)(ws + WS_WH), T, D, D}; pg8::EpiGate2 E{p + 7 * PG, tmp, merged}; pg8::gemm_phase<pg8::EpiGate2, pg8::StaticOrder, true, true>(ring, g, S, E); } }
    SEAM(4);
    if (IN(5)) { pg8::Gemm g{merged, (const bf16_t*)(ws + WS_WO), T, D, D}; pg8::StaticOrder S; S.init(T, D, X.G, (int)blockIdx.x);
        pg8::EpiRes E{x, mod + 2 * D, x1, NMOD, SEQ}; pg8::gemm_phase<pg8::EpiRes, pg8::StaticOrder, true, true>(ring, g, S, E); }
    SEAM(5);
    if (IN(6)) ph_route(X, x1, g_ffn, mod, w_router, b_router, h2, top_e, top_w, rank, hist_g);
    SEAM(6);
    if (IN(7)) ph_sort(X, hist_g, top_e, top_w, rank, row_tok, row_w, pair_row, blk_e);
    SEAM(7);
    if (IN(8)) { const int nblk = blk_e[NBLK_MAX]; ph_gather(X, h2, row_tok, nblk * 256, hs); }
    SEAM(8);
    if (IN(9)) { const int nblk = blk_e[NBLK_MAX]; pg8::Gemm g{hs, (const bf16_t*)(ws + WS_W1), R_PAD, 32 * 2048, D}; pg8::MoeOrder S{blk_e, nblk, X.G, (int)blockIdx.x, 3};
        pg8::EpiSwiglu E{b1, act}; pg8::gemm_phase<pg8::EpiSwiglu, pg8::MoeOrder, true, true>(ring, g, S, E); }
    SEAM(9);
    if (IN(10)) { const int nblk = blk_e[NBLK_MAX]; pg8::Gemm g{act, (const bf16_t*)(ws + WS_W2), R_PAD, 32 * 1024, DFF}; pg8::MoeOrder S{blk_e, nblk, X.G, (int)blockIdx.x, 2};
        pg8::EpiY E{b2, row_w, y}; pg8::gemm_phase<pg8::EpiY, pg8::MoeOrder, true, true>(ring, g, S, E); }
    SEAM(10);
    if (IN(11)) ph_final(X, x1, y, pair_row, mod, g_final, a.out);
#undef IN
#undef SEAM
}

#ifndef MK_N_LAUNCHES
#define MK_N_LAUNCHES 1
#endif
extern "C" void kernel_launch(void* const* d_in, const int* in_sizes, int n_in, void* d_out, int out_size, void* d_ws, size_t ws_size, hipStream_t stream) {
    static int grid = 0;
    if (grid == 0) {
        if (n_in != 23 || out_size != T * D || ws_size < WS_END) { fprintf(stderr, "kernel_launch: unexpected n_in %d / out_size %d / ws_size %zu (< %zu); nothing launched\n", n_in, out_size, ws_size, (size_t)WS_END); grid = -1; return; }
        int dev = 0, cus = 0, per_cu = 0;
        if (hipGetDevice(&dev) != hipSuccess || hipDeviceGetAttribute(&cus, hipDeviceAttributeMultiprocessorCount, dev) != hipSuccess) { grid = -1; return; }
        if (hipFuncSetAttribute((const void*)fwd, hipFuncAttributeMaxDynamicSharedMemorySize, LDS_BYTES) != hipSuccess) { fprintf(stderr, "kernel_launch: hipFuncSetAttribute failed\n"); grid = -1; return; }
        if (hipOccupancyMaxActiveBlocksPerMultiprocessor(&per_cu, (const void*)fwd, 512, LDS_BYTES) != hipSuccess || per_cu < 1) { fprintf(stderr, "kernel_launch: occupancy query says %d blocks per CU\n", per_cu); }
        (void)hipGetLastError();
        grid = cus;
    }
    if (grid < 0) return;
    if (hipMemsetAsync((char*)d_ws + WS_CTL, 0, CTL_ZERO_BYTES, stream) != hipSuccess) return;
    Args a{};
    for (int i = 0; i < 23; ++i) a.in[i] = (const float*)d_in[i];
    a.out = (float*)d_out; a.ws = (unsigned char*)d_ws;
    if (MK_N_LAUNCHES == 1) { a.ph_lo = 0; a.ph_hi = N_PHASES; hipLaunchKernelGGL(fwd, dim3(grid), dim3(512), LDS_BYTES, stream, a); }
    else for (int ph = 0; ph < N_PHASES; ++ph) { a.ph_lo = ph; a.ph_hi = ph + 1; hipLaunchKernelGGL(fwd, dim3(grid), dim3(512), LDS_BYTES, stream, a); }
}
```

```cpp
#include <hip/hip_runtime.h>
#include <stdint.h>
#include <stdio.h>

#define GAS __attribute__((address_space(1)))
#define LAS __attribute__((address_space(3)))
typedef unsigned short bf16_t;
typedef unsigned u32x4 __attribute__((ext_vector_type(4)));
typedef unsigned u32x2 __attribute__((ext_vector_type(2)));
typedef float f32x4 __attribute__((ext_vector_type(4)));

constexpr int D = 1024, NBATCH = 4, SEQ = 8192, T = NBATCH * SEQ;
constexpr int NE = 32, DFF = 1024;
constexpr int NMOD = 6 * D;
constexpr int NBLK_MAX = 544, R_PAD = NBLK_MAX * 256;
constexpr int RT_TILE = 128, RT_NT = T / RT_TILE;
constexpr float EPS = 1e-6f;

constexpr size_t MiB = 1u << 20;
constexpr size_t WS_CTL = 0, CTL_ZERO_BYTES = 64 * 1024;
constexpr size_t WS_MOD = 1 * MiB;
constexpr size_t WS_HIST = 2 * MiB;
constexpr size_t WS_BLKE = WS_HIST + 64 * 1024;
constexpr size_t WS_TOPE = 3 * MiB;
constexpr size_t WS_TOPW = WS_TOPE + 512 * 1024;
constexpr size_t WS_RANK = WS_TOPW + 512 * 1024;
constexpr size_t WS_PROW = WS_RANK + 512 * 1024;
constexpr size_t WS_RTOK = 5 * MiB;
constexpr size_t WS_RW = 6 * MiB;
constexpr size_t WS_HGD = 7 * MiB;
constexpr size_t WS_WT = 8 * MiB;
constexpr size_t WS_WIN = WS_WT, WS_WC = WS_WT + 16 * MiB, WS_WH = WS_WT + 18 * MiB, WS_WO = WS_WT + 20 * MiB, WS_W1 = WS_WT + 22 * MiB, WS_W2 = WS_WT + 150 * MiB;
constexpr size_t WS_P = 224 * MiB;
constexpr size_t WS_E = WS_P + 512 * MiB;
constexpr size_t WS_D = WS_E + 128 * MiB;
constexpr size_t WS_END = WS_D + 128 * MiB;
constexpr size_t PG = (size_t)T * D;
constexpr int CW_BAR = 0;

constexpr int RING_BYTES = 131072, LDSCTL_OFF = RING_BYTES, LDS_BYTES = 147456;

__device__ __forceinline__ unsigned f2bf(float f) { unsigned u = __builtin_bit_cast(unsigned, f); return (u + 0x7fffu + ((u >> 16) & 1u)) >> 16; }
__device__ __forceinline__ unsigned pk2(float lo, float hi) { return f2bf(lo) | (f2bf(hi) << 16); }
__device__ __forceinline__ float bf2f(unsigned b) { return __builtin_bit_cast(float, b << 16); }
__device__ __forceinline__ float bflo(unsigned w) { return __builtin_bit_cast(float, w << 16); }
__device__ __forceinline__ float bfhi(unsigned w) { return __builtin_bit_cast(float, w & 0xffff0000u); }
__device__ __forceinline__ float sigmoidf_(float x) { return 1.0f / (1.0f + __expf(-x)); }
__device__ __forceinline__ float wave_sum(float v) {
#pragma unroll
    for (int o = 1; o < 64; o <<= 1) v += __shfl_xor(v, o);
    return v;
}
#define LDS_WAIT() asm volatile("s_waitcnt lgkmcnt(0)" ::: "memory")
#define VM_WAIT() asm volatile("s_waitcnt vmcnt(0)" ::: "memory")

namespace pg8 {
#define PG8_LAS __attribute__((address_space(3)))
typedef unsigned short bf16_t;
typedef short bf16x8 __attribute__((ext_vector_type(8)));
typedef float f32x4 __attribute__((ext_vector_type(4)));
typedef unsigned u32x4 __attribute__((ext_vector_type(4)));
constexpr int BM = 256, BK = 64, HALF = 128, HTB = HALF * BK * 2  , STAGE_BYTES = 8 * HTB, NXCD = 8, WGM = 8;

__host__ __device__ __forceinline__ int lds_byte(int r, int c) { const int st = (r >> 4) * 2 + (c >> 5), rr = r & 15, cc = c & 31, ob = rr * 64 + cc * 2; return st * 1024 + (ob ^ (((ob >> 9) & 1) << 5)); }
__host__ __device__ __forceinline__ void stage_rc(int b, int& R, int& C) { const int st = b / 1024, sb = b % 1024, swz = sb ^ (((sb >> 9) & 1) << 5); R = (st >> 1) * 16 + swz / 64; C = (st & 1) * 32 + (swz % 64) / 2; }
__host__ __device__ __forceinline__ int perm32(int rho) { const int n = rho >> 4, i = rho & 15; return 8 * (i >> 2) + 4 * n + (i & 3); }

struct Unit { int pm, pn; };
struct Gemm { const bf16_t* A; const bf16_t* Bt; int M, N, K; };

struct StaticOrder {
    int nM, nN, nwg, G, c;
    __host__ __device__ void init(int M, int N, int G_, int c_) { nM = M / BM; nN = N / BM; nwg = nM * nN; G = G_; c = c_; }
    __host__ __device__ bool next(int i, Unit& u) const {
        const long L = (long)i * G + c; if (L >= nwg) return false;
        int wgid = (int)L; { const int q = nwg / NXCD, r = nwg % NXCD, xcd = wgid % NXCD, off = wgid / NXCD; wgid = (xcd < r ? xcd * (q + 1) : r * (q + 1) + (xcd - r) * q) + off; }
        const int nig = WGM * nN, gid = wgid / nig, fm = gid * WGM, gsz = (nM - fm) < WGM ? (nM - fm) : WGM;
        u.pm = fm + ((wgid % nig) % gsz); u.pn = (wgid % nig) / gsz; return true;
    }
    __device__ __forceinline__ void a_ready(const Unit&) const {}
    __device__ __forceinline__ void done(const Unit&) const {}
};


struct MoeOrder {
    const int* blk_e; int nblk, G, c, lg;
    __device__ __forceinline__ bool next(int i, Unit& u) const {
        int blk, j;
        if (G == 256) { const int xcd = c & 7, idx = c >> 3, prb = 256 >> lg; blk = i * prb + xcd * (prb >> 3) + (idx >> lg); j = idx & ((1 << lg) - 1); }
        else { const long L = (long)i * G + c; blk = (int)(L >> lg); j = (int)(L & ((1 << lg) - 1)); }
        if (blk >= nblk) return false;
        const int e = blk_e[blk]; u.pm = blk; u.pn = (e << lg) + j; return true;
    }
    __device__ __forceinline__ void a_ready(const Unit&) const {}
    __device__ __forceinline__ void done(const Unit&) const {}
};

__device__ __forceinline__ unsigned cvt_pk_bf16(float lo, float hi) { unsigned r; asm volatile("v_cvt_pk_bf16_f32 %0, %1, %2" : "=v"(r) : "v"(lo), "v"(hi)); return r; }
__device__ __forceinline__ float sigm(float x) { return 1.0f / (1.0f + __expf(-x)); }
__device__ __forceinline__ float blo(unsigned w) { return __builtin_bit_cast(float, w << 16); }
__device__ __forceinline__ float bhi(unsigned w) { return __builtin_bit_cast(float, w & 0xffff0000u); }

struct EpiSplitBf16 {
    static constexpr bool PERM = true, AFTER_DRAIN = false;
    bf16_t* O; size_t split_stride;
    __device__ __forceinline__ void operator()(const f32x4 (&acc)[2][2][4][2], const Unit& u, int wr, int wc, int fr, int fq) const {
        const int row0 = u.pm * BM + wr * 64 + fr; const int colt = u.pn * BM; const int t = colt >> 10;
        bf16_t* base = O + (size_t)t * split_stride; const int col0 = (colt & 1023) + wc * 32 + 8 * fq;
#pragma unroll
        for (int ai = 0; ai < 2; ++ai)
#pragma unroll
            for (int m = 0; m < 4; ++m) { bf16_t* rowp = base + (size_t)(row0 + ai * HALF + m * 16) * 1024 + col0;
#pragma unroll
                for (int bj = 0; bj < 2; ++bj) { const f32x4 v0 = acc[ai][bj][m][0], v1 = acc[ai][bj][m][1];
                    u32x4 w; w.x = cvt_pk_bf16(v0[0], v0[1]); w.y = cvt_pk_bf16(v0[2], v0[3]); w.z = cvt_pk_bf16(v1[0], v1[1]); w.w = cvt_pk_bf16(v1[2], v1[3]);
                    *(u32x4*)(rowp + bj * HALF) = w; } }
    }
};
struct EpiGate1 {
    static constexpr bool PERM = true, AFTER_DRAIN = false;
    const bf16_t* gate; float* tmp;
    __device__ __forceinline__ void operator()(const f32x4 (&acc)[2][2][4][2], const Unit& u, int wr, int wc, int fr, int fq) const {
        const int row0 = u.pm * BM + wr * 64 + fr, col0 = u.pn * BM + wc * 32 + 8 * fq;
#pragma unroll
        for (int ai = 0; ai < 2; ++ai)
#pragma unroll
            for (int m = 0; m < 4; ++m) { const size_t o = (size_t)(row0 + ai * HALF + m * 16) * 1024 + col0;
#pragma unroll
                for (int bj = 0; bj < 2; ++bj) { const u32x4 g = *(const u32x4*)(gate + o + bj * HALF); f32x4 v0 = acc[ai][bj][m][0], v1 = acc[ai][bj][m][1];
                    v0[0] *= sigm(blo(g.x)); v0[1] *= sigm(bhi(g.x)); v0[2] *= sigm(blo(g.y)); v0[3] *= sigm(bhi(g.y));
                    v1[0] *= sigm(blo(g.z)); v1[1] *= sigm(bhi(g.z)); v1[2] *= sigm(blo(g.w)); v1[3] *= sigm(bhi(g.w));
                    *(f32x4*)(tmp + o + bj * HALF) = v0; *(f32x4*)(tmp + o + bj * HALF + 4) = v1; } }
    }
};
struct EpiGate2 {
    static constexpr bool PERM = true, AFTER_DRAIN = false;
    const bf16_t* gate; const float* tmp; bf16_t* out;
    __device__ __forceinline__ void operator()(const f32x4 (&acc)[2][2][4][2], const Unit& u, int wr, int wc, int fr, int fq) const {
        const int row0 = u.pm * BM + wr * 64 + fr, col0 = u.pn * BM + wc * 32 + 8 * fq;
#pragma unroll
        for (int ai = 0; ai < 2; ++ai)
#pragma unroll
            for (int m = 0; m < 4; ++m) { const size_t o = (size_t)(row0 + ai * HALF + m * 16) * 1024 + col0;
#pragma unroll
                for (int bj = 0; bj < 2; ++bj) { const u32x4 g = *(const u32x4*)(gate + o + bj * HALF); f32x4 v0 = acc[ai][bj][m][0], v1 = acc[ai][bj][m][1];
                    const f32x4 t0 = *(const f32x4*)(tmp + o + bj * HALF), t1 = *(const f32x4*)(tmp + o + bj * HALF + 4);
                    v0[0] = t0[0] + v0[0] * sigm(blo(g.x)); v0[1] = t0[1] + v0[1] * sigm(bhi(g.x)); v0[2] = t0[2] + v0[2] * sigm(blo(g.y)); v0[3] = t0[3] + v0[3] * sigm(bhi(g.y));
                    v1[0] = t1[0] + v1[0] * sigm(blo(g.z)); v1[1] = t1[1] + v1[1] * sigm(bhi(g.z)); v1[2] = t1[2] + v1[2] * sigm(blo(g.w)); v1[3] = t1[3] + v1[3] * sigm(bhi(g.w));
                    u32x4 w; w.x = cvt_pk_bf16(v0[0], v0[1]); w.y = cvt_pk_bf16(v0[2], v0[3]); w.z = cvt_pk_bf16(v1[0], v1[1]); w.w = cvt_pk_bf16(v1[2], v1[3]);
                    *(u32x4*)(out + o + bj * HALF) = w; } }
    }
};
struct EpiRes {
    static constexpr bool PERM = false, AFTER_DRAIN = false;
    const float* x; const float* ga; float* out; int mod_pitch, seq;
    __device__ __forceinline__ void operator()(const f32x4 (&acc)[2][2][4][2], const Unit& u, int wr, int wc, int fr, int fq) const {
        const int row0 = u.pm * BM + wr * 64 + fr, col0 = u.pn * BM + wc * 32 + 4 * fq;
        const float* gab = ga + (size_t)((u.pm * BM) / seq) * mod_pitch + col0;
        f32x4 gv[2][2];
#pragma unroll
        for (int bj = 0; bj < 2; ++bj)
#pragma unroll
            for (int n = 0; n < 2; ++n) gv[bj][n] = *(const f32x4*)(gab + bj * HALF + n * 16);
#pragma unroll
        for (int ai = 0; ai < 2; ++ai)
#pragma unroll
            for (int m = 0; m < 4; ++m) { const size_t o = (size_t)(row0 + ai * HALF + m * 16) * 1024 + col0;
#pragma unroll
                for (int bj = 0; bj < 2; ++bj)
#pragma unroll
                    for (int n = 0; n < 2; ++n) { const f32x4 xv = *(const f32x4*)(x + o + bj * HALF + n * 16); *(f32x4*)(out + o + bj * HALF + n * 16) = xv + gv[bj][n] * acc[ai][bj][m][n]; } }
    }
};
struct EpiSwiglu {
    static constexpr bool PERM = true, AFTER_DRAIN = false;
    const float* b1; bf16_t* act;
    __device__ __forceinline__ void operator()(const f32x4 (&acc)[2][2][4][2], const Unit& u, int wr, int wc, int fr, int fq) const {
        const int e = u.pn >> 3, j = u.pn & 7; const int row0 = u.pm * BM + wr * 64 + fr, f0 = 128 * j + wc * 32 + 8 * fq;
        const float* be = b1 + (size_t)e * 2048 + f0;
        const f32x4 bg0 = *(const f32x4*)(be), bg1 = *(const f32x4*)(be + 4), bl0 = *(const f32x4*)(be + 1024), bl1 = *(const f32x4*)(be + 1028);
#pragma unroll
        for (int ai = 0; ai < 2; ++ai)
#pragma unroll
            for (int m = 0; m < 4; ++m) {
                f32x4 g0 = acc[ai][0][m][0] + bg0, g1 = acc[ai][0][m][1] + bg1, l0 = acc[ai][1][m][0] + bl0, l1 = acc[ai][1][m][1] + bl1;
                float r[8];
#pragma unroll
                for (int q = 0; q < 4; ++q) { float gl = fminf(g0[q], 7.0f), li = fminf(fmaxf(l0[q], -7.0f), 7.0f); r[q] = gl * sigm(1.702f * gl) * (li + 1.0f);
                                              gl = fminf(g1[q], 7.0f); li = fminf(fmaxf(l1[q], -7.0f), 7.0f); r[4 + q] = gl * sigm(1.702f * gl) * (li + 1.0f); }
                u32x4 w; w.x = cvt_pk_bf16(r[0], r[1]); w.y = cvt_pk_bf16(r[2], r[3]); w.z = cvt_pk_bf16(r[4], r[5]); w.w = cvt_pk_bf16(r[6], r[7]);
                *(u32x4*)(act + (size_t)(row0 + ai * HALF + m * 16) * 1024 + f0) = w; }
    }
};
struct EpiY {
    static constexpr bool PERM = true, AFTER_DRAIN = false;
    const float* b2; const float* rw; bf16_t* y;
    __device__ __forceinline__ void operator()(const f32x4 (&acc)[2][2][4][2], const Unit& u, int wr, int wc, int fr, int fq) const {
        const int e = u.pn >> 2, j = u.pn & 3; const int row0 = u.pm * BM + wr * 64 + fr, col0 = 256 * j + wc * 32 + 8 * fq;
        const float* be = b2 + (size_t)e * 1024 + col0;
        f32x4 bv[2][2];
#pragma unroll
        for (int bj = 0; bj < 2; ++bj)
#pragma unroll
            for (int n = 0; n < 2; ++n) bv[bj][n] = *(const f32x4*)(be + bj * HALF + 4 * n);
#pragma unroll
        for (int ai = 0; ai < 2; ++ai)
#pragma unroll
            for (int m = 0; m < 4; ++m) { const int row = row0 + ai * HALF + m * 16; const float w_ = rw[row];
#pragma unroll
                for (int bj = 0; bj < 2; ++bj) { const f32x4 v0 = (acc[ai][bj][m][0] + bv[bj][0]) * w_, v1 = (acc[ai][bj][m][1] + bv[bj][1]) * w_;
                    u32x4 w; w.x = cvt_pk_bf16(v0[0], v0[1]); w.y = cvt_pk_bf16(v0[2], v0[3]); w.z = cvt_pk_bf16(v1[0], v1[1]); w.w = cvt_pk_bf16(v1[2], v1[3]);
                    *(u32x4*)(y + (size_t)row * 1024 + col0 + bj * HALF) = w; } }
    }
};

template <class Epi, class Sched, bool ALIGN_EPI = false, bool SP2 = false>
__device__ __forceinline__ void gemm_phase(PG8_LAS unsigned char* lds, const Gemm g, const Sched& S, const Epi& E) {
    const int tid = threadIdx.x, wid = __builtin_amdgcn_readfirstlane(tid >> 6), lane = tid & 63, wr = wid >> 2, wc = wid & 3, fr = lane & 15, fq = lane >> 4;
    const int K = g.K, nt = K / BK;
    unsigned voffA[2], voffB[2];
#pragma unroll
    for (int i = 0; i < 2; ++i) { int R, C; stage_rc(tid * 16 + i * 8192, R, C); const int Rb = Epi::PERM ? ((R & ~31) + perm32(R & 31)) : R;
        voffA[i] = (unsigned)(R * K + C) * 2u; voffB[i] = (unsigned)(Rb * K + C) * 2u; }
    const size_t kstep = (size_t)(BK * 2);
    const size_t hstep = (size_t)HALF * K * 2;
    const size_t tstep = 2 * hstep;
    const unsigned ldsw = (unsigned)wid * 1024u;
    const int aoff = lds_byte(wr * 64 + fr, fq * 8), boff = lds_byte(wc * 32 + fr, fq * 8);
#define PG8_SA(b, h) (((b) * 2 + (h)) * HTB)
#define PG8_SB(b, h) ((4 + (b) * 2 + (h)) * HTB)
#define PG8_STAGE(bufoff, gbase, voff) do { _Pragma("unroll") for (int _i = 0; _i < 2; ++_i) \
        __builtin_amdgcn_global_load_lds((const unsigned*)((const char*)(gbase) + (voff)[_i]), (PG8_LAS unsigned*)(lds + (bufoff) + ldsw + _i * 8192), 16, 0, 0); } while (0)
#define PG8_LDA(dst, b, h) do { _Pragma("unroll") for (int m = 0; m < 4; ++m) _Pragma("unroll") for (int k = 0; k < 2; ++k) dst[m][k] = *(const PG8_LAS bf16x8*)(lds + PG8_SA(b, h) + aoff + m * 2048 + k * 1024); } while (0)
#define PG8_LDB(dst, b, h) do { _Pragma("unroll") for (int n = 0; n < 2; ++n) _Pragma("unroll") for (int k = 0; k < 2; ++k) dst[n][k] = *(const PG8_LAS bf16x8*)(lds + PG8_SB(b, h) + boff + n * 2048 + k * 1024); } while (0)
#define PG8_MMA(ai, bj, At, Bt) do { __builtin_amdgcn_s_setprio(1); _Pragma("unroll") for (int m = 0; m < 4; ++m) _Pragma("unroll") for (int n = 0; n < 2; ++n) _Pragma("unroll") for (int k = 0; k < 2; ++k) \
        acc[ai][bj][m][n] = __builtin_amdgcn_mfma_f32_16x16x32_bf16(Bt[n][k], At[m][k], acc[ai][bj][m][n], 0, 0, 0); __builtin_amdgcn_s_setprio(0); } while (0)
#define PG8_WAIT_V(n) asm volatile("s_waitcnt vmcnt(" #n ")" ::: "memory")
#define PG8_WAIT_L(n) asm volatile("s_waitcnt lgkmcnt(" #n ")" ::: "memory")
#define PG8_BAR __builtin_amdgcn_s_barrier()
#define PG8_SCHED __builtin_amdgcn_sched_barrier(0)
    Unit cur, nxt; int ui = 0;
    if (!S.next(0, cur)) return;
    f32x4 acc[2][2][4][2];
#pragma unroll
    for (int a = 0; a < 2; ++a)
#pragma unroll
        for (int b = 0; b < 2; ++b)
#pragma unroll
            for (int m = 0; m < 4; ++m)
#pragma unroll
                for (int n = 0; n < 2; ++n) acc[a][b][m][n] = (f32x4){0.f, 0.f, 0.f, 0.f};
    bf16x8 At[4][2], B0[2][2], B1[2][2];
    const char* cA = (const char*)g.A + (size_t)cur.pm * tstep; const char* cB = (const char*)g.Bt + (size_t)cur.pn * tstep;
    S.a_ready(cur);
    if constexpr (SP2) {
        PG8_STAGE(PG8_SB(0, 0), cB, voffB); PG8_STAGE(PG8_SB(0, 1), cB + hstep, voffB); PG8_STAGE(PG8_SA(0, 0), cA, voffA); PG8_STAGE(PG8_SA(0, 1), cA + hstep, voffA);
        if (wr == 1) PG8_BAR;
        PG8_WAIT_V(2); PG8_BAR;
        PG8_STAGE(PG8_SB(1, 0), cB + kstep, voffB); PG8_STAGE(PG8_SA(1, 0), cA + kstep, voffA); PG8_STAGE(PG8_SB(1, 1), cB + hstep + kstep, voffB);
        PG8_WAIT_V(6); PG8_BAR;
    } else {
        PG8_STAGE(PG8_SB(0, 0), cB, voffB); PG8_STAGE(PG8_SA(0, 0), cA, voffA); PG8_STAGE(PG8_SB(0, 1), cB + hstep, voffB); PG8_STAGE(PG8_SA(0, 1), cA + hstep, voffA);
        if (wr == 1) PG8_BAR;
        PG8_WAIT_V(4); PG8_BAR;
        PG8_STAGE(PG8_SB(1, 0), cB + kstep, voffB); PG8_STAGE(PG8_SA(1, 0), cA + kstep, voffA); PG8_STAGE(PG8_SB(1, 1), cB + hstep + kstep, voffB);
        PG8_WAIT_V(6); PG8_BAR;
    }
    for (;;) {
        const bool has_next = S.next(ui + 1, nxt);
        const char* nA = has_next ? (const char*)g.A + (size_t)nxt.pm * tstep : cA; const char* nB = has_next ? (const char*)g.Bt + (size_t)nxt.pn * tstep : cB;
        for (int t = 0; t < nt; t += 2) {
            const bool last = (t == nt - 2);
            const char* a1 = cA + (size_t)(t + 1) * kstep;
            const char* a2 = last ? nA : cA + (size_t)(t + 2) * kstep; const char* b2 = last ? nB : cB + (size_t)(t + 2) * kstep;
            const char* a3 = a2 + kstep; const char* b3 = b2 + kstep;
            if (last && has_next) S.a_ready(nxt);
            if constexpr (SP2) {
            PG8_LDB(B0, 0, 0); PG8_LDB(B1, 0, 1); PG8_SCHED; PG8_LDA(At, 0, 0); PG8_STAGE(PG8_SA(1, 1), a1 + hstep, voffA);
            PG8_WAIT_V(8); PG8_WAIT_L(0); PG8_BAR; PG8_MMA(0, 0, At, B0); PG8_MMA(0, 1, At, B1); PG8_BAR; PG8_SCHED;
            PG8_LDA(At, 0, 1); PG8_STAGE(PG8_SB(0, 0), b2, voffB); PG8_STAGE(PG8_SB(0, 1), b2 + hstep, voffB); PG8_STAGE(PG8_SA(0, 0), a2, voffA);
            PG8_WAIT_V(8); PG8_WAIT_L(0); PG8_BAR; PG8_MMA(1, 0, At, B0); PG8_MMA(1, 1, At, B1); PG8_BAR; PG8_SCHED;
            PG8_LDB(B0, 1, 0); PG8_LDB(B1, 1, 1); PG8_SCHED; PG8_LDA(At, 1, 0); PG8_STAGE(PG8_SA(0, 1), a2 + hstep, voffA);
            PG8_WAIT_V(8); PG8_WAIT_L(0); PG8_BAR; PG8_MMA(0, 0, At, B0); PG8_MMA(0, 1, At, B1); PG8_BAR; PG8_SCHED;
            PG8_LDA(At, 1, 1); PG8_STAGE(PG8_SB(1, 0), b3, voffB); PG8_STAGE(PG8_SB(1, 1), b3 + hstep, voffB); PG8_STAGE(PG8_SA(1, 0), a3, voffA);
            PG8_WAIT_V(8); PG8_WAIT_L(0); PG8_BAR; PG8_MMA(1, 0, At, B0); PG8_MMA(1, 1, At, B1); PG8_BAR; PG8_SCHED;
            } else {
            PG8_LDB(B0, 0, 0); PG8_SCHED; PG8_LDA(At, 0, 0); PG8_STAGE(PG8_SA(1, 1), a1 + hstep, voffA);
            PG8_WAIT_L(8); PG8_BAR; PG8_WAIT_L(0); PG8_MMA(0, 0, At, B0); PG8_BAR; PG8_SCHED;
            PG8_LDB(B1, 0, 1); PG8_STAGE(PG8_SB(0, 0), b2, voffB);
            PG8_BAR; PG8_WAIT_L(0); PG8_MMA(0, 1, At, B1); PG8_BAR;
            PG8_LDA(At, 0, 1); PG8_STAGE(PG8_SA(0, 0), a2, voffA);
            PG8_BAR; PG8_WAIT_L(0); PG8_MMA(1, 0, At, B0); PG8_BAR; PG8_SCHED;
            PG8_STAGE(PG8_SB(0, 1), b2 + hstep, voffB);
            PG8_WAIT_V(6); PG8_BAR; PG8_MMA(1, 1, At, B1); PG8_BAR;
            PG8_LDB(B0, 1, 0); PG8_SCHED; PG8_LDA(At, 1, 0); PG8_STAGE(PG8_SA(0, 1), a2 + hstep, voffA);
            PG8_WAIT_L(8); PG8_BAR; PG8_WAIT_L(0); PG8_MMA(0, 0, At, B0); PG8_BAR; PG8_SCHED;
            PG8_LDB(B1, 1, 1); PG8_STAGE(PG8_SB(1, 0), b3, voffB);
            PG8_BAR; PG8_WAIT_L(0); PG8_MMA(0, 1, At, B1); PG8_BAR;
            PG8_LDA(At, 1, 1); PG8_STAGE(PG8_SA(1, 0), a3, voffA);
            PG8_BAR; PG8_WAIT_L(0); PG8_MMA(1, 0, At, B0); PG8_BAR; PG8_SCHED;
            PG8_STAGE(PG8_SB(1, 1), b3 + hstep, voffB);
            PG8_WAIT_V(6); PG8_BAR; PG8_MMA(1, 1, At, B1); PG8_BAR;
            }
        }
        if constexpr (ALIGN_EPI) { if (wr == 0) PG8_BAR; }
        if constexpr (!Epi::AFTER_DRAIN) { E(acc, cur, wr, wc, fr, fq); S.done(cur); }
        if (!has_next) break;
#pragma unroll
        for (int a = 0; a < 2; ++a)
#pragma unroll
            for (int b = 0; b < 2; ++b)
#pragma unroll
                for (int m = 0; m < 4; ++m)
#pragma unroll
                    for (int n = 0; n < 2; ++n) acc[a][b][m][n] = (f32x4){0.f, 0.f, 0.f, 0.f};
        cur = nxt; cA = nA; cB = nB; ++ui;
        if constexpr (ALIGN_EPI) { if (wr == 1) PG8_BAR; }
    }
    PG8_WAIT_V(0);
    if constexpr (!ALIGN_EPI) { if (wr == 0) PG8_BAR; }
    PG8_BAR;
    if constexpr (Epi::AFTER_DRAIN) { E.fused(acc, cur, wr, wc, fr, fq, lds, wid, lane); S.done(cur); }
#undef PG8_SA
#undef PG8_SB
#undef PG8_STAGE
#undef PG8_LDA
#undef PG8_LDB
#undef PG8_MMA
#undef PG8_WAIT_V
#undef PG8_WAIT_L
#undef PG8_BAR
#undef PG8_SCHED
}
}
#define XB_TMO      128
#define XB_XCNT(j)  (256  + 64 * (j))
#define XB_XSUB(j)  (1280 + 64 * (j))
#define XB_XGEN(j)  (2304 + 64 * (j))
#define XB_TOP      3328
#define XB_TOPGEN   3392
#define XCD_BAR_WORDS 3456
#define XB_SPIN_CAP (1u << 18)

__device__ __forceinline__ unsigned xb_ld(unsigned* p)              { return __hip_atomic_load(p, __ATOMIC_RELAXED, __HIP_MEMORY_SCOPE_AGENT); }
__device__ __forceinline__ unsigned xb_add(unsigned* p, unsigned v) { return __hip_atomic_fetch_add(p, v, __ATOMIC_RELAXED, __HIP_MEMORY_SCOPE_AGENT); }
__device__ __forceinline__ unsigned xb_xcc_id() { return (unsigned)__builtin_amdgcn_s_getreg((3 << 11) | 20) & 0xFu; }
#define XB_SPIN(cond, bar) do { unsigned _sp = 0; while (cond) { __builtin_amdgcn_s_sleep(1); \
    if ((++_sp & 255u) == 0u) { if (xb_ld(&(bar)[XB_TMO])) break; if (_sp > XB_SPIN_CAP) { atomicAdd(&(bar)[XB_TMO], 1u); break; } } } } while (0)

struct XcdBarrier {
    unsigned* bar; unsigned x;
    volatile LAS unsigned* st;
};

__device__ __forceinline__ XcdBarrier xcd_barrier_post(unsigned* bar, volatile LAS unsigned* st) {
    XcdBarrier b; b.bar = bar; b.x = xb_xcc_id(); b.st = st;
    if (threadIdx.x == 0) (void)xb_add(&bar[XB_XCNT(b.x)], 1u);
    return b;
}
__device__ __forceinline__ void xcd_barrier_complete(unsigned* bar, unsigned x, unsigned& nloc, unsigned& nx) {
    const unsigned G = gridDim.x * gridDim.y * gridDim.z;
    unsigned sum, cnt, mine, sp = 0u;
    for (;;) {
        sum = 0u; cnt = 0u; mine = 0u;
#pragma unroll
        for (unsigned j = 0; j < 16; ++j) { const unsigned c = xb_ld(&bar[XB_XCNT(j)]); sum += c; cnt += (c > 0u) ? 1u : 0u; mine = (j == x) ? c : mine; }
        if (sum == G) break;
        __builtin_amdgcn_s_sleep(1);
        if ((++sp & 255u) == 0u) { if (xb_ld(&bar[XB_TMO])) break; if (sp > XB_SPIN_CAP) { atomicAdd(&bar[XB_TMO], 1u); break; } }
    }
    nloc = mine > 0u ? mine : 1u; nx = cnt > 0u ? cnt : 1u;
}

__device__ __forceinline__ void xcd_barrier(const XcdBarrier& b) {
    asm volatile("s_waitcnt vmcnt(0)" ::: "memory");
    __syncthreads();
    if (threadIdx.x == 0) {
        unsigned* bar = b.bar;
        __builtin_amdgcn_s_waitcnt(0);
        unsigned nloc = b.st[0], nx = b.st[1];
        if (nloc == 0u) { xcd_barrier_complete(bar, b.x, nloc, nx); b.st[0] = nloc; b.st[1] = nx; }
        const unsigned old = xb_add(&bar[XB_XSUB(b.x)], 1u);
        const unsigned gen = old / nloc;
        if (old + 1u == (gen + 1u) * nloc) {
            __builtin_amdgcn_fence(__ATOMIC_RELEASE, "agent");
            asm volatile("s_waitcnt vmcnt(0)" ::: "memory");
            const unsigned og = xb_add(&bar[XB_TOP], 1u);
            const unsigned tg = og / nx;
            if (og + 1u == (tg + 1u) * nx) xb_add(&bar[XB_TOPGEN], 1u);
            else XB_SPIN(xb_ld(&bar[XB_TOPGEN]) == tg, bar);
            __builtin_amdgcn_fence(__ATOMIC_ACQUIRE, "agent");
            xb_add(&bar[XB_XGEN(b.x)], 1u);
            asm volatile("s_waitcnt vmcnt(0)" ::: "memory");
        } else {
            XB_SPIN(xb_ld(&bar[XB_XGEN(b.x)]) == gen, bar);
            __builtin_amdgcn_fence(__ATOMIC_ACQUIRE, "agent");
            asm volatile("s_waitcnt vmcnt(0)" ::: "memory");
        }
    }
    __syncthreads();
}

struct Ctx { LAS unsigned char* lds; int tid, lane, wave, vcu, G; };

__device__ __forceinline__ void transpose_item(const float* W, int ldw, int K, bf16_t* dst, int k0, int n0, LAS float* scr, int lane) {
#pragma unroll 8
    for (int i = 0; i < 32; ++i) { const int kk = 2 * i + (lane >> 5); scr[kk * 33 + (lane & 31)] = W[(size_t)(k0 + kk) * ldw + n0 + (lane & 31)]; }
    LDS_WAIT();
    const int c = lane & 7;
#pragma unroll
    for (int j = 0; j < 4; ++j) { const int n = (lane >> 3) + 8 * j; const LAS float* s = scr + (8 * c) * 33 + n;
        u32x4 o; o.x = pk2(s[0 * 33], s[1 * 33]); o.y = pk2(s[2 * 33], s[3 * 33]); o.z = pk2(s[4 * 33], s[5 * 33]); o.w = pk2(s[6 * 33], s[7 * 33]);
        *(u32x4*)(dst + (size_t)n * K + k0 + 8 * c) = o; }
    LDS_WAIT();
}

__device__ __forceinline__ void ph_prologue(const Ctx& X, const float* c, const float* w_ada, const float* b_ada, float* mod,
                                            const float* w_in, const float* w_conv_out, const float* w_hgrn_out, const float* w_out, const float* w1, const float* w2, unsigned char* ws) {
    if (X.vcu < 48) {
        LAS float* ca = (LAS float*)X.lds;
        LAS float* red = (LAS float*)(X.lds + 16384);
        for (int i = X.tid; i < 4096; i += 512) { const float v = c[i]; ca[i] = v * sigmoidf_(v); }
        __syncthreads();
        const int jj = X.tid & 127, kq = X.tid >> 7, j = X.vcu * 128 + jj;
        float a0 = 0.f, a1 = 0.f, a2 = 0.f, a3 = 0.f;
#pragma unroll 8
        for (int i = kq * 256; i < kq * 256 + 256; ++i) { const float w = w_ada[(size_t)i * NMOD + j]; a0 += ca[i] * w; a1 += ca[1024 + i] * w; a2 += ca[2048 + i] * w; a3 += ca[3072 + i] * w; }
        red[(kq * 4 + 0) * 128 + jj] = a0; red[(kq * 4 + 1) * 128 + jj] = a1; red[(kq * 4 + 2) * 128 + jj] = a2; red[(kq * 4 + 3) * 128 + jj] = a3;
        __syncthreads();
        { const int b = X.tid >> 7; mod[(size_t)b * NMOD + j] = b_ada[j] + red[(0 * 4 + b) * 128 + jj] + red[(1 * 4 + b) * 128 + jj] + red[(2 * 4 + b) * 128 + jj] + red[(3 * 4 + b) * 128 + jj]; }
        __syncthreads();
    }
    LAS float* scr = (LAS float*)(X.lds + X.wave * 16384);
    const int gw = X.vcu * 8 + X.wave, NGW = X.G * 8;
    constexpr int I_IN = 16 * 256, I_SQ = 16 * 32, I_W1 = 32 * 16 * 64, I_W2 = 32 * 16 * 32, NITEMS = I_IN + 3 * I_SQ + I_W1 + I_W2;
    for (int it = gw; it < NITEMS; it += NGW) {
        int r = it;
        if (r < I_IN) { const int kb = r >> 8, nb = r & 255; transpose_item(w_in, 8192, 1024, (bf16_t*)(ws + WS_WIN) + (size_t)(32 * nb) * 1024, 64 * kb, 32 * nb, scr, X.lane); continue; } r -= I_IN;
        if (r < 3 * I_SQ) { const int which = r / I_SQ, q = r % I_SQ, kb = q >> 5, nb = q & 31;
            const float* W = which == 0 ? w_conv_out : (which == 1 ? w_hgrn_out : w_out); bf16_t* WT = (bf16_t*)(ws + (which == 0 ? WS_WC : (which == 1 ? WS_WH : WS_WO)));
            transpose_item(W, 1024, 1024, WT + (size_t)(32 * nb) * 1024, 64 * kb, 32 * nb, scr, X.lane); continue; } r -= 3 * I_SQ;
        if (r < I_W1) { const int e = r >> 10, q = r & 1023, kb = q >> 6, nb = q & 63, n0 = 32 * nb;
            const int rho0 = (n0 < 1024) ? 256 * (n0 >> 7) + (n0 & 127) : 256 * ((n0 - 1024) >> 7) + 128 + ((n0 - 1024) & 127);
            transpose_item(w1 + (size_t)e * 1024 * 2048, 2048, 1024, (bf16_t*)(ws + WS_W1) + ((size_t)e * 2048 + rho0) * 1024, 64 * kb, n0, scr, X.lane); continue; } r -= I_W1;
        { const int e = r >> 9, q = r & 511, kb = q >> 5, nb = q & 31;
            transpose_item(w2 + (size_t)e * 1024 * 1024, 1024, 1024, (bf16_t*)(ws + WS_W2) + ((size_t)e * 1024 + 32 * nb) * 1024, 64 * kb, 32 * nb, scr, X.lane); }
    }
}

__device__ __forceinline__ void ph_norm_mod(const Ctx& X, const float* x, const float* g, const float* mod, int sh_off, int sc_off, bf16_t* out) {
    for (int t = X.vcu * 8 + X.wave; t < T; t += X.G * 8) {
        const int b = t / SEQ, lane = X.lane;
        const f32x4* xr = (const f32x4*)(x + (size_t)t * D) + lane;
        f32x4 v[4]; float ss = 0.f;
#pragma unroll
        for (int j = 0; j < 4; ++j) { v[j] = xr[64 * j]; ss += (v[j].x * v[j].x + v[j].y * v[j].y) + (v[j].z * v[j].z + v[j].w * v[j].w); }
        const float r = rsqrtf(wave_sum(ss) * (1.0f / D) + EPS);
        const float* sh = mod + (size_t)b * NMOD + sh_off; const float* sc = mod + (size_t)b * NMOD + sc_off;
#pragma unroll
        for (int j = 0; j < 4; ++j) {
            const int col = 4 * (lane + 64 * j);
            const f32x4 gg = *(const f32x4*)(g + col), s1 = *(const f32x4*)(sc + col), s0 = *(const f32x4*)(sh + col);
            const f32x4 y = v[j] * r * gg * (s1 + 1.0f) + s0;
            u32x2 w; w.x = pk2(y.x, y.y); w.y = pk2(y.z, y.w);
            *(u32x2*)(out + (size_t)t * D + col) = w;
        }
    }
}

__device__ __forceinline__ void ph_conv(const Ctx& X, const bf16_t* pA, const bf16_t* pB, const float* dw, const float* dwb, const float* lng, const float* lnb, bf16_t* uc) {
    LAS float* sm = (LAS float*)X.lds;
    const int tid = X.tid, lane = X.lane, wid = X.wave, c0 = 2 * tid;
    float w[31][2];
#pragma unroll
    for (int j = 0; j < 31; ++j) { w[j][0] = dw[j * 1024 + c0]; w[j][1] = dw[j * 1024 + c0 + 1]; }
    const float bias0 = dwb[c0], bias1 = dwb[c0 + 1];
    for (int task = X.vcu; task < T / 32; task += X.G) {
        const int b = task >> 8, s0 = (task & 255) * 32;
        const bf16_t* qa = pA + (size_t)(b * SEQ) * D + c0; const bf16_t* qb = pB + (size_t)(b * SEQ) * D + c0;
        float u[38][2];
#pragma unroll
        for (int st = 0; st < 4; ++st) {
#pragma unroll
            for (int i = (st == 0 ? 0 : 8 * st + 30); i < 8 * st + 38; ++i) {
                const int s = s0 - 30 + i;
                float u0 = 0.f, u1 = 0.f;
                if (s >= 0) { const unsigned a2 = *(const unsigned*)(qa + (size_t)s * D), b2 = *(const unsigned*)(qb + (size_t)s * D);
                              u0 = bflo(a2) * sigmoidf_(bflo(b2)); u1 = bfhi(a2) * sigmoidf_(bfhi(b2)); }
                u[i % 38][0] = u0; u[i % 38][1] = u1;
            }
#pragma unroll
            for (int t = 8 * st; t < 8 * st + 8; ++t) {
                float a0 = bias0, a1 = bias1;
#pragma unroll
                for (int j = 0; j < 31; ++j) { a0 += w[j][0] * u[(t + j) % 38][0]; a1 += w[j][1] * u[(t + j) % 38][1]; }
                sm[t * 1024 + c0] = a0; sm[t * 1024 + c0 + 1] = a1;
            }
        }
        __syncthreads();
#pragma unroll 1
        for (int i = 0; i < 4; ++i) {
            const int t = wid * 4 + i;
            f32x4 v[4]; float s = 0.f;
#pragma unroll
            for (int j = 0; j < 4; ++j) { v[j] = *(const LAS f32x4*)(sm + t * 1024 + 4 * (lane + 64 * j)); s += (v[j].x + v[j].y) + (v[j].z + v[j].w); }
            const float mean = wave_sum(s) * (1.0f / D); float q = 0.f;
#pragma unroll
            for (int j = 0; j < 4; ++j) { v[j] = v[j] - mean; q += (v[j].x * v[j].x + v[j].y * v[j].y) + (v[j].z * v[j].z + v[j].w * v[j].w); }
            const float rstd = rsqrtf(wave_sum(q) * (1.0f / D) + EPS);
#pragma unroll
            for (int j = 0; j < 4; ++j) {
                const int col = 4 * (lane + 64 * j);
                const f32x4 gg = *(const f32x4*)(lng + col), bb = *(const f32x4*)(lnb + col);
                f32x4 y = v[j] * rstd * gg + bb;
                y.x *= sigmoidf_(y.x); y.y *= sigmoidf_(y.y); y.z *= sigmoidf_(y.z); y.w *= sigmoidf_(y.w);
                u32x2 o; o.x = pk2(y.x, y.y); o.y = pk2(y.z, y.w);
                *(u32x2*)(uc + (size_t)(b * SEQ + s0 + t) * D + col) = o;
            }
        }
        __syncthreads();
    }
}

typedef short bf16x8 __attribute__((ext_vector_type(8)));
constexpr int HG_QA = 0, HG_KA = 17408, HG_KAT = 34816, HG_VT = 53248, HG_AB = 71680, HG_SPT = 80896, HG_SEG = 115712, HG_RED = 117760;
template <bool OUT>
__device__ __forceinline__ void hgrn_task(const Ctx& X, int b, int h, int sc, const bf16_t* pQ, const bf16_t* pF, const bf16_t* pI, const bf16_t* pG,
                                          const float* lb_param, const float* norm_g, const float* S0in, float* dS_out, float* D_out, bf16_t* og) {
    LAS unsigned char* L = X.lds;
    LAS float* seg_s = (LAS float*)(L + HG_SEG); LAS float* red = (LAS float*)(L + HG_RED);
    const int tid = X.tid, lane = X.lane, wave = X.wave, fr = lane & 15, fq = lane >> 4, wr = wave >> 1, wc = wave & 1;
    const int k = tid & 127, seg = tid >> 7;
    const int colk = h * 128 + k;
    const float oml = 1.0f - 1.0f / (1.0f + __expf(lb_param[1024 + colk] - lb_param[colk]));
    f32x4 S[8];
    if (OUT && sc > 0) {
#pragma unroll
        for (int vt = 0; vt < 8; ++vt)
#pragma unroll
            for (int j = 0; j < 4; ++j) S[vt][j] = S0in[(size_t)(16 * wave + fq * 4 + j) * 128 + vt * 16 + fr];
    } else {
#pragma unroll
        for (int vt = 0; vt < 8; ++vt) S[vt] = (f32x4){0.f, 0.f, 0.f, 0.f};
    }
    float gsum = 0.f;
#pragma unroll 1
    for (int ch = 0; ch < 4; ++ch) {
        const int t0 = sc * 256 + ch * 64;
        float lf[16], kkv[16], qv[16];
        {
            const size_t rb = (size_t)(b * SEQ + t0 + 16 * seg) * D + colk;
#pragma unroll
            for (int i = 0; i < 16; ++i) { const float z = bf2f(pF[rb + (size_t)i * D]); const float kk = oml / (1.0f + __expf(z)); kkv[i] = kk; lf[i] = __logf(1.0f - kk);
                                           if (OUT) qv[i] = bf2f(pQ[rb + (size_t)i * D]) * 0.08838834764831845f; }
            float c = 0.f;
#pragma unroll
            for (int i = 0; i < 16; ++i) { c += lf[i]; lf[i] = c; }
            seg_s[seg * 128 + k] = c;
        }
        {
            const int t = tid >> 3, vc = tid & 7;
            const u32x4* src = (const u32x4*)(pI + (size_t)(b * SEQ + t0 + t) * D + h * 128 + vc * 16);
            const u32x4 a = src[0], c2 = src[1];
            LAS bf16_t* vt = (LAS bf16_t*)(L + HG_VT) + (size_t)(vc * 16) * 72 + t;
            const unsigned wv[8] = {a.x, a.y, a.z, a.w, c2.x, c2.y, c2.z, c2.w};
#pragma unroll
            for (int i = 0; i < 8; ++i) { vt[(2 * i) * 72] = (bf16_t)(wv[i] & 0xffffu); vt[(2 * i + 1) * 72] = (bf16_t)(wv[i] >> 16); }
        }
        __syncthreads();
        {
            const float s0 = seg_s[k], s1 = seg_s[128 + k], s2 = seg_s[256 + k], s3 = seg_s[384 + k];
            const float off = (seg > 0 ? s0 : 0.f) + (seg > 1 ? s1 : 0.f) + (seg > 2 ? s2 : 0.f), R = s0 + s1;
            if (seg == 0) gsum += R + s2 + s3;
            unsigned kp[8];
#pragma unroll
            for (int i = 0; i < 16; ++i) {
                const float G = off + lf[i];
                const float ka = kkv[i] * __expf(fminf(R - G, 80.0f));
                const unsigned kb = f2bf(ka);
                if (i & 1) kp[i >> 1] |= kb << 16; else kp[i >> 1] = kb;
                if (OUT) { const float qa = qv[i] * __expf(fminf(G - R, 80.0f));
                    *((LAS bf16_t*)(L + HG_QA) + (16 * seg + i) * 136 + k) = (bf16_t)f2bf(qa);
                    *((LAS bf16_t*)(L + HG_KA) + (16 * seg + i) * 136 + k) = (bf16_t)kb; }
            }
            LAS u32x4* kt = (LAS u32x4*)(L + HG_KAT + k * 144 + seg * 32);
            kt[0] = (u32x4){kp[0], kp[1], kp[2], kp[3]}; kt[1] = (u32x4){kp[4], kp[5], kp[6], kp[7]};
        }
        float eR[4], eL[4];
#pragma unroll
        for (int j = 0; j < 4; ++j) { const int kr = 16 * wave + 4 * fq + j; eR[j] = __expf(fmaxf(seg_s[kr] + seg_s[128 + kr], -80.0f)); eL[j] = __expf(seg_s[256 + kr] + seg_s[384 + kr]); }
#pragma unroll
        for (int vt = 0; vt < 8; ++vt) {
#pragma unroll
            for (int j = 0; j < 4; ++j) S[vt][j] *= eR[j];
            if (OUT) { u32x2 w; w.x = pk2(S[vt][0], S[vt][1]); w.y = pk2(S[vt][2], S[vt][3]);
                       *(LAS u32x2*)(L + HG_SPT + (vt * 16 + fr) * 272 + (16 * wave + 4 * fq) * 2) = w; }
        }
        __syncthreads();
        if (OUT) {
#pragma unroll
            for (int q2 = 0; q2 < 2; ++q2) {
                const int st = 2 * wc + q2;
                f32x4 acc = (f32x4){0.f, 0.f, 0.f, 0.f};
                if (st <= wr) {
#pragma unroll
                    for (int kq = 0; kq < 4; ++kq) {
                        const bf16x8 af = *(const LAS bf16x8*)(L + HG_KA + (st * 16 + fr) * 272 + kq * 64 + fq * 16);
                        const bf16x8 bq = *(const LAS bf16x8*)(L + HG_QA + (wr * 16 + fr) * 272 + kq * 64 + fq * 16);
                        acc = __builtin_amdgcn_mfma_f32_16x16x32_bf16(af, bq, acc, 0, 0, 0);
                    }
                    const int tt = wr * 16 + fr;
#pragma unroll
                    for (int j = 0; j < 4; ++j) { const int ss = st * 16 + fq * 4 + j; acc[j] = (ss <= tt) ? acc[j] : 0.f; }
                }
                u32x2 w; w.x = pk2(acc[0], acc[1]); w.y = pk2(acc[2], acc[3]);
                *(LAS u32x2*)(L + HG_AB + (wr * 16 + fr) * 144 + (st * 16 + fq * 4) * 2) = w;
            }
        }
        {
            bf16x8 aK[2];
#pragma unroll
            for (int ks = 0; ks < 2; ++ks) aK[ks] = *(const LAS bf16x8*)(L + HG_KAT + (16 * wave + fr) * 144 + ks * 64 + fq * 16);
#pragma unroll
            for (int vt = 0; vt < 8; ++vt) {
#pragma unroll
                for (int ks = 0; ks < 2; ++ks) { const bf16x8 bv = *(const LAS bf16x8*)(L + HG_VT + (vt * 16 + fr) * 144 + ks * 64 + fq * 16); S[vt] = __builtin_amdgcn_mfma_f32_16x16x32_bf16(aK[ks], bv, S[vt], 0, 0, 0); }
#pragma unroll
                for (int j = 0; j < 4; ++j) S[vt][j] *= eL[j];
            }
        }
        if (OUT) {
            __syncthreads();
            f32x4 o[4];
            bf16x8 aA[2], aQ[4];
#pragma unroll
            for (int ks = 0; ks < 2; ++ks) aA[ks] = *(const LAS bf16x8*)(L + HG_AB + (wr * 16 + fr) * 144 + ks * 64 + fq * 16);
#pragma unroll
            for (int kq = 0; kq < 4; ++kq) aQ[kq] = *(const LAS bf16x8*)(L + HG_QA + (wr * 16 + fr) * 272 + kq * 64 + fq * 16);
            float gate[4][4];
#pragma unroll
            for (int n = 0; n < 4; ++n) {
                const int vt = wc * 4 + n;
                o[n] = (f32x4){0.f, 0.f, 0.f, 0.f};
#pragma unroll
                for (int ks = 0; ks < 2; ++ks) { const bf16x8 bv = *(const LAS bf16x8*)(L + HG_VT + (vt * 16 + fr) * 144 + ks * 64 + fq * 16); o[n] = __builtin_amdgcn_mfma_f32_16x16x32_bf16(aA[ks], bv, o[n], 0, 0, 0); }
#pragma unroll
                for (int kq = 0; kq < 4; ++kq) { const bf16x8 bs = *(const LAS bf16x8*)(L + HG_SPT + (vt * 16 + fr) * 272 + kq * 64 + fq * 16); o[n] = __builtin_amdgcn_mfma_f32_16x16x32_bf16(aQ[kq], bs, o[n], 0, 0, 0); }
#pragma unroll
                for (int j = 0; j < 4; ++j) gate[n][j] = bf2f(pG[(size_t)(b * SEQ + t0 + wr * 16 + fq * 4 + j) * D + h * 128 + vt * 16 + fr]);
            }
#pragma unroll
            for (int j = 0; j < 4; ++j) {
                float ss = o[0][j] * o[0][j] + o[1][j] * o[1][j] + o[2][j] * o[2][j] + o[3][j] * o[3][j];
                ss += __shfl_xor(ss, 1); ss += __shfl_xor(ss, 2); ss += __shfl_xor(ss, 4); ss += __shfl_xor(ss, 8);
                if (fr == 0) red[(wr * 16 + fq * 4 + j) * 2 + wc] = ss;
            }
            __syncthreads();
#pragma unroll
            for (int j = 0; j < 4; ++j) {
                const int tt = wr * 16 + fq * 4 + j;
                const float rstd = rsqrtf((red[tt * 2] + red[tt * 2 + 1]) * (1.0f / 128.0f) + EPS);
#pragma unroll
                for (int n = 0; n < 4; ++n) { const int v = (wc * 4 + n) * 16 + fr; const float gv = gate[n][j];
                    og[(size_t)(b * SEQ + t0 + tt) * D + h * 128 + v] = (bf16_t)f2bf(o[n][j] * rstd * norm_g[v] * gv * sigmoidf_(gv)); }
            }
        }
        __syncthreads();
    }
    if (!OUT) {
#pragma unroll
        for (int vt = 0; vt < 8; ++vt)
#pragma unroll
            for (int j = 0; j < 4; ++j) dS_out[(size_t)(16 * wave + fq * 4 + j) * 128 + vt * 16 + fr] = S[vt][j];
        if (seg == 0) D_out[k] = __expf(gsum);
    }
}

__device__ __forceinline__ void ph_hg1(const Ctx& X, const bf16_t* p, const float* lb_param, float* dS, float* Dd) {
    for (int idx = X.vcu; idx < 31 * 32; idx += X.G) { const int sc = idx >> 5, bh = idx & 31;
        hgrn_task<false>(X, bh >> 3, bh & 7, sc, p + 2 * PG, p + 3 * PG, p + 4 * PG, p + 5 * PG, lb_param, nullptr, nullptr, dS + (size_t)(bh * 32 + sc) * 16384, Dd + (size_t)(bh * 32 + sc) * 128, nullptr); }
}
__device__ __forceinline__ void ph_hg2(const Ctx& X, const float* dS, const float* Dd, float* S0) {
    for (int idx = X.vcu * 512 + X.tid; idx < 32 * 4096; idx += X.G * 512) {
        const int bh = idx >> 12, e4 = idx & 4095, k = e4 >> 5, v4 = (e4 & 31) * 4;
        f32x4 s = (f32x4){0.f, 0.f, 0.f, 0.f};
#pragma unroll 4
        for (int sc = 0; sc < 31; ++sc) { const float d = Dd[(size_t)(bh * 32 + sc) * 128 + k]; const f32x4 ds = *(const f32x4*)(dS + (size_t)(bh * 32 + sc) * 16384 + k * 128 + v4);
            s = s * d + ds; *(f32x4*)(S0 + (size_t)(bh * 32 + sc + 1) * 16384 + k * 128 + v4) = s; }
    }
}
__device__ __forceinline__ void ph_hg3(const Ctx& X, const bf16_t* p, const float* lb_param, const float* norm_g, const float* S0, bf16_t* og) {
    for (int idx = X.vcu; idx < 32 * 32; idx += X.G) { const int sc = idx >> 5, bh = idx & 31;
        hgrn_task<true>(X, bh >> 3, bh & 7, sc, p + 2 * PG, p + 3 * PG, p + 4 * PG, p + 5 * PG, lb_param, norm_g, S0 + (size_t)(bh * 32 + sc) * 16384, nullptr, nullptr, og); }
}

__device__ __forceinline__ void ph_route(const Ctx& X, const float* x1, const float* g_ffn, const float* mod, const float* w_router, const float* b_router,
                                         bf16_t* h2, int* top_e, float* top_w, int* rank, int* hist_g) {
    LAS float* hrow = (LAS float*)X.lds + X.wave * 1024;
    LAS int* hist = (LAS int*)(X.lds + LDSCTL_OFF + 64);
    const int tid = X.tid, lane = X.lane;
    const int e = lane & 31, half = lane >> 5;
    const float be = b_router[e];
    for (int tile = X.vcu; tile < RT_NT; tile += X.G) {
        if (tid < 32) hist[tid] = 0;
        __syncthreads();
        for (int i = 0; i < 16; ++i) {
            const int t = tile * RT_TILE + X.wave * 16 + i, b = t / SEQ;
            const f32x4* xr = (const f32x4*)(x1 + (size_t)t * D) + lane;
            f32x4 v[4]; float ss = 0.f;
#pragma unroll
            for (int j = 0; j < 4; ++j) { v[j] = xr[64 * j]; ss += (v[j].x * v[j].x + v[j].y * v[j].y) + (v[j].z * v[j].z + v[j].w * v[j].w); }
            const float r = rsqrtf(wave_sum(ss) * (1.0f / D) + EPS);
            const float* sh = mod + (size_t)b * NMOD + 3 * D; const float* sc = mod + (size_t)b * NMOD + 4 * D;
#pragma unroll
            for (int j = 0; j < 4; ++j) {
                const int col = 4 * (lane + 64 * j);
                const f32x4 gg = *(const f32x4*)(g_ffn + col), s1 = *(const f32x4*)(sc + col), s0 = *(const f32x4*)(sh + col);
                const f32x4 y = v[j] * r * gg * (s1 + 1.0f) + s0;
                *(LAS f32x4*)(hrow + col) = y;
                u32x2 w; w.x = pk2(y.x, y.y); w.y = pk2(y.z, y.w);
                *(u32x2*)(h2 + (size_t)t * D + col) = w;
            }
            LDS_WAIT();
            float a = 0.f;
            const float* wr_ = w_router + (size_t)(half * 512) * NE + e;
            const LAS float* hr = hrow + half * 512;
#pragma unroll 8
            for (int k = 0; k < 512; ++k) a += hr[k] * wr_[(size_t)k * NE];
            a += __shfl_xor(a, 32);
            float logit = a + be;
            float sv[4]; int si[4];
#pragma unroll
            for (int rnd = 0; rnd < 4; ++rnd) {
                float bv = logit; int bi = e;
#pragma unroll
                for (int o = 16; o >= 1; o >>= 1) { const float ov = __shfl_xor(bv, o); const int oi = __shfl_xor(bi, o); if (ov > bv || (ov == bv && oi < bi)) { bv = ov; bi = oi; } }
                sv[rnd] = bv; si[rnd] = bi; if (e == bi) logit = -INFINITY;
            }
            const float e1 = __expf(sv[1] - sv[0]), e2 = __expf(sv[2] - sv[0]), e3 = __expf(sv[3] - sv[0]);
            const float inv = 1.0f / (1.0f + e1 + e2 + e3);
            if (lane == 0) {
                const float ww[4] = {inv, e1 * inv, e2 * inv, e3 * inv};
#pragma unroll
                for (int rnd = 0; rnd < 4; ++rnd) { top_e[t * 4 + rnd] = si[rnd]; top_w[t * 4 + rnd] = ww[rnd]; rank[t * 4 + rnd] = atomicAdd((int*)&hist[si[rnd]], 1); }
            }
        }
        __syncthreads();
        if (tid < 32) hist_g[tile * 32 + tid] = hist[tid];
        __syncthreads();
    }
}

__device__ __forceinline__ void ph_sort(const Ctx& X, const int* hist_g, const int* top_e, const float* top_w, const int* rank, int* row_tok, float* row_w, int* pair_row, int* blk_e) {
    LAS int* s_tot = (LAS int*)X.lds; LAS int* s_pre = s_tot + 32; LAS int* s_base = s_pre + 32; LAS int* s_pstart = s_base + 32; LAS int* s_pend = s_pstart + 32;
    const int tid = X.tid;
    for (int tile = X.vcu; tile < RT_NT; tile += X.G) {
        if (tid < 32) { int tot = 0, pre = 0; for (int i = 0; i < RT_NT; ++i) { const int c = hist_g[i * 32 + tid]; tot += c; if (i < tile) pre += c; } s_tot[tid] = tot; s_pre[tid] = pre; }
        __syncthreads();
        if (tid == 0) { int acc = 0; for (int e = 0; e < 32; ++e) { const int padded = (s_tot[e] + 255) / 256 * 256; s_pstart[e] = acc; s_base[e] = acc + s_pre[e]; acc += padded; s_pend[e] = acc; } }
        __syncthreads();
        { const int i = tid; const int idx = tile * RT_TILE * 4 + i; const int e = top_e[idx]; const int row = s_base[e] + rank[idx];
          row_tok[row] = idx >> 2; row_w[row] = top_w[idx]; pair_row[idx] = row; }
        if (tile < 32) { const int e = tile; for (int r = s_pstart[e] + s_tot[e] + tid; r < s_pend[e]; r += 512) { row_tok[r] = 0; row_w[r] = 0.f; } }
        if (tile == 32) { for (int blk = tid; blk < NBLK_MAX; blk += 512) { int e = -1; const int r = blk * 256; for (int q = 0; q < 32; ++q) if (r >= s_pstart[q] && r < s_pend[q]) e = q; blk_e[blk] = e; }
                          if (tid == 0) blk_e[NBLK_MAX] = s_pend[31] / 256; }
        __syncthreads();
    }
}

__device__ __forceinline__ void ph_gather(const Ctx& X, const bf16_t* h2, const int* row_tok, int nrows, bf16_t* hs) {
    for (int row = X.vcu * 8 + X.wave; row < nrows; row += X.G * 8) {
        const int tok = row_tok[row];
        const u32x4* s = (const u32x4*)(h2 + (size_t)tok * D); u32x4* d = (u32x4*)(hs + (size_t)row * D);
        const u32x4 a = s[X.lane], b = s[X.lane + 64]; d[X.lane] = a; d[X.lane + 64] = b;
    }
}

__device__ __forceinline__ void ph_final(const Ctx& X, const float* x1, const bf16_t* y, const int* pair_row, const float* mod, const float* g_final, float* out) {
    const int lane = X.lane;
    for (int t = X.vcu * 8 + X.wave; t < T; t += X.G * 8) {
        const int b = t / SEQ;
        const f32x4* xr = (const f32x4*)(x1 + (size_t)t * D) + lane;
        const float* ga = mod + (size_t)b * NMOD + 5 * D;
        int rows[4];
#pragma unroll
        for (int k = 0; k < 4; ++k) rows[k] = pair_row[t * 4 + k];
        f32x4 v[4]; float ss = 0.f;
#pragma unroll
        for (int j = 0; j < 4; ++j) {
            const int col = 4 * (lane + 64 * j);
            f32x4 m = (f32x4){0.f, 0.f, 0.f, 0.f};
#pragma unroll
            for (int k = 0; k < 4; ++k) { const u32x2 w = *(const u32x2*)(y + (size_t)rows[k] * D + col); m.x += bflo(w.x); m.y += bfhi(w.x); m.z += bflo(w.y); m.w += bfhi(w.y); }
            v[j] = xr[64 * j] + *(const f32x4*)(ga + col) * m;
            ss += (v[j].x * v[j].x + v[j].y * v[j].y) + (v[j].z * v[j].z + v[j].w * v[j].w);
        }
        const float r = rsqrtf(wave_sum(ss) * (1.0f / D) + EPS);
#pragma unroll
        for (int j = 0; j < 4; ++j) { const int col = 4 * (lane + 64 * j); *(f32x4*)(out + (size_t)t * D + col) = v[j] * r * *(const f32x4*)(g_final + col); }
    }
}

constexpr int N_PHASES = 14;
struct Args { const float* in[23]; float* out; unsigned char* ws; int ph_lo, ph_hi; };
__global__ void __launch_bounds__(512, 2) fwd(Args a) {
    extern __shared__ __attribute__((aligned(16))) unsigned char lds_raw[];
    Ctx X; X.lds = (LAS unsigned char*)lds_raw; X.tid = threadIdx.x; X.lane = X.tid & 63; X.wave = __builtin_amdgcn_readfirstlane(X.tid >> 6);
    X.G = gridDim.x; { const int bx = blockIdx.x; X.vcu = (X.G % 8 == 0) ? (bx % 8) * (X.G / 8) + bx / 8 : bx; }
    unsigned char* ws = a.ws;
    for (int u = X.tid; u < (LDS_BYTES - LDSCTL_OFF) / 4; u += 512) ((LAS unsigned*)(X.lds + LDSCTL_OFF))[u] = 0u;
    __syncthreads();
    XcdBarrier bar = xcd_barrier_post((unsigned*)(ws + WS_CTL) + CW_BAR, (volatile LAS unsigned*)(X.lds + LDSCTL_OFF));
    const int lo = a.ph_lo, hi = a.ph_hi;
#define IN(k) (lo <= (k) && (k) < hi)
#define SEAM(k) do { if (IN(k) && IN((k) + 1)) xcd_barrier(bar); } while (0)
    const float* x = a.in[0]; const float* c = a.in[1]; const float* w_ada = a.in[2]; const float* b_ada = a.in[3];
    const float* g_mix = a.in[4]; const float* w_in = a.in[5]; const float* conv_dw = a.in[6]; const float* conv_dwb = a.in[7];
    const float* conv_ln_g = a.in[8]; const float* conv_ln_b = a.in[9]; const float* w_conv_out = a.in[10]; const float* lb_param = a.in[11];
    const float* hgrn_norm_g = a.in[12]; const float* w_hgrn_out = a.in[13]; const float* w_out = a.in[14]; const float* g_ffn = a.in[15];
    const float* w_router = a.in[16]; const float* b_router = a.in[17]; const float* w1 = a.in[18]; const float* b1 = a.in[19];
    const float* w2 = a.in[20]; const float* b2 = a.in[21]; const float* g_final = a.in[22];
    float* mod = (float*)(ws + WS_MOD);
    int* hist_g = (int*)(ws + WS_HIST); int* blk_e = (int*)(ws + WS_BLKE); int* top_e = (int*)(ws + WS_TOPE); float* top_w = (float*)(ws + WS_TOPW);
    int* rank = (int*)(ws + WS_RANK); int* pair_row = (int*)(ws + WS_PROW); int* row_tok = (int*)(ws + WS_RTOK); float* row_w = (float*)(ws + WS_RW);
    bf16_t* p = (bf16_t*)(ws + WS_P);
    bf16_t* h = (bf16_t*)(ws + WS_E); float* tmp = (float*)(ws + WS_E);
    float* hg_dS = (float*)(ws + WS_E); float* hg_S0 = (float*)(ws + WS_E + 64 * MiB); float* hg_D = (float*)(ws + WS_HGD);
    bf16_t* uc = (bf16_t*)(ws + WS_D); bf16_t* og = uc + PG; float* x1 = (float*)(ws + WS_D);
    bf16_t* merged = p;
    bf16_t* h2 = p;
    bf16_t* hs = p + PG;
    bf16_t* act = hs + (size_t)R_PAD * D;
    bf16_t* y = hs;
    PG8_LAS unsigned char* ring = (PG8_LAS unsigned char*)lds_raw;

    if (IN(0)) ph_prologue(X, c, w_ada, b_ada, mod, w_in, w_conv_out, w_hgrn_out, w_out, w1, w2, ws);
    SEAM(0);
    if (IN(1)) ph_norm_mod(X, x, g_mix, mod, 0, D, h);
    SEAM(1);
    if (IN(2)) { pg8::Gemm g{h, (const bf16_t*)(ws + WS_WIN), T, 8 * D, D}; pg8::StaticOrder S; S.init(T, 8 * D, X.G, (int)blockIdx.x);
        pg8::EpiSplitBf16 E{p, PG}; pg8::gemm_phase<pg8::EpiSplitBf16, pg8::StaticOrder, true, true>(ring, g, S, E); }
    SEAM(2);
    if (IN(3)) { ph_conv(X, p + 0 * PG, p + 1 * PG, conv_dw, conv_dwb, conv_ln_g, conv_ln_b, uc);
                 ph_hg1(X, p, lb_param, hg_dS, hg_D); }
    SEAM(3);
    if (IN(4)) ph_hg2(X, hg_dS, hg_D, hg_S0);
    SEAM(4);
    if (IN(5)) ph_hg3(X, p, lb_param, hgrn_norm_g, hg_S0, og);
    SEAM(5);
    if (IN(6)) { pg8::StaticOrder S; S.init(T, D, X.G, (int)blockIdx.x);
        { pg8::Gemm g{uc, (const bf16_t*)(ws + WS_WC), T, D, D}; pg8::EpiGate1 E{p + 6 * PG, tmp}; pg8::gemm_phase<pg8::EpiGate1, pg8::StaticOrder, true, true>(ring, g, S, E); }
        { pg8::Gemm g{og, (const bf16_t*)(ws + WS_WH), T, D, D}; pg8::EpiGate2 E{p + 7 * PG, tmp, merged}; pg8::gemm_phase<pg8::EpiGate2, pg8::StaticOrder, true, true>(ring, g, S, E); } }
    SEAM(6);
    if (IN(7)) { pg8::Gemm g{merged, (const bf16_t*)(ws + WS_WO), T, D, D}; pg8::StaticOrder S; S.init(T, D, X.G, (int)blockIdx.x);
        pg8::EpiRes E{x, mod + 2 * D, x1, NMOD, SEQ}; pg8::gemm_phase<pg8::EpiRes, pg8::StaticOrder, true, true>(ring, g, S, E); }
    SEAM(7);
    if (IN(8)) ph_route(X, x1, g_ffn, mod, w_router, b_router, h2, top_e, top_w, rank, hist_g);
    SEAM(8);
    if (IN(9)) ph_sort(X, hist_g, top_e, top_w, rank, row_tok, row_w, pair_row, blk_e);
    SEAM(9);
    if (IN(10)) { const int nblk = blk_e[NBLK_MAX]; ph_gather(X, h2, row_tok, nblk * 256, hs); }
    SEAM(10);
    if (IN(11)) { const int nblk = blk_e[NBLK_MAX]; pg8::Gemm g{hs, (const bf16_t*)(ws + WS_W1), R_PAD, 32 * 2048, D}; pg8::MoeOrder S{blk_e, nblk, X.G, (int)blockIdx.x, 3};
        pg8::EpiSwiglu E{b1, act}; pg8::gemm_phase<pg8::EpiSwiglu, pg8::MoeOrder, true, true>(ring, g, S, E); }
    SEAM(11);
    if (IN(12)) { const int nblk = blk_e[NBLK_MAX]; pg8::Gemm g{act, (const bf16_t*)(ws + WS_W2), R_PAD, 32 * 1024, DFF}; pg8::MoeOrder S{blk_e, nblk, X.G, (int)blockIdx.x, 2};
        pg8::EpiY E{b2, row_w, y}; pg8::gemm_phase<pg8::EpiY, pg8::MoeOrder, true, true>(ring, g, S, E); }
    SEAM(12);
    if (IN(13)) ph_final(X, x1, y, pair_row, mod, g_final, a.out);
#undef IN
#undef SEAM
}

#ifndef MK_N_LAUNCHES
#define MK_N_LAUNCHES 1
#endif
extern "C" void kernel_launch(void* const* d_in, const int* in_sizes, int n_in, void* d_out, int out_size, void* d_ws, size_t ws_size, hipStream_t stream) {
    static int grid = 0;
    if (grid == 0) {
        if (n_in != 23 || out_size != T * D || ws_size < WS_END) { fprintf(stderr, "kernel_launch: unexpected n_in %d / out_size %d / ws_size %zu (< %zu); nothing launched\n", n_in, out_size, ws_size, (size_t)WS_END); grid = -1; return; }
        int dev = 0, cus = 0, per_cu = 0;
        if (hipGetDevice(&dev) != hipSuccess || hipDeviceGetAttribute(&cus, hipDeviceAttributeMultiprocessorCount, dev) != hipSuccess) { grid = -1; return; }
        if (hipFuncSetAttribute((const void*)fwd, hipFuncAttributeMaxDynamicSharedMemorySize, LDS_BYTES) != hipSuccess) { fprintf(stderr, "kernel_launch: hipFuncSetAttribute failed\n"); grid = -1; return; }
        if (hipOccupancyMaxActiveBlocksPerMultiprocessor(&per_cu, (const void*)fwd, 512, LDS_BYTES) != hipSuccess || per_cu < 1) { fprintf(stderr, "kernel_launch: occupancy query says %d blocks per CU\n", per_cu); }
        (void)hipGetLastError();
        grid = cus;
    }
    if (grid < 0) return;
    if (hipMemsetAsync((char*)d_ws + WS_CTL, 0, CTL_ZERO_BYTES, stream) != hipSuccess) return;
    Args a{};
    for (int i = 0; i < 23; ++i) a.in[i] = (const float*)d_in[i];
    a.out = (float*)d_out; a.ws = (unsigned char*)d_ws;
    if (MK_N_LAUNCHES == 1) { a.ph_lo = 0; a.ph_hi = N_PHASES; hipLaunchKernelGGL(fwd, dim3(grid), dim3(512), LDS_BYTES, stream, a); }
    else for (int ph = 0; ph < N_PHASES; ++ph) { a.ph_lo = ph; a.ph_hi = ph + 1; hipLaunchKernelGGL(fwd, dim3(grid), dim3(512), LDS_BYTES, stream, a); }
}
```

```cpp
#include <hip/hip_runtime.h>
#include <stdint.h>
#include <stdio.h>

#define GAS __attribute__((address_space(1)))
#define LAS __attribute__((address_space(3)))
typedef unsigned short bf16_t;
typedef unsigned u32x4 __attribute__((ext_vector_type(4)));
typedef unsigned u32x2 __attribute__((ext_vector_type(2)));
typedef float f32x4 __attribute__((ext_vector_type(4)));

constexpr int D = 1024, NBATCH = 4, SEQ = 8192, T = NBATCH * SEQ;
constexpr int NE = 32, DFF = 1024;
constexpr int NMOD = 6 * D;
constexpr int NBLK_MAX = 544, R_PAD = NBLK_MAX * 256;
constexpr int RT_TILE = 128, RT_NT = T / RT_TILE;
constexpr float EPS = 1e-6f;

constexpr size_t MiB = 1u << 20;
constexpr size_t WS_CTL = 0, CTL_ZERO_BYTES = 64 * 1024;
constexpr size_t WS_MOD = 1 * MiB;
constexpr size_t WS_CB = WS_MOD + 112 * 1024, WS_BP = WS_MOD + 128 * 1024;
constexpr size_t WS_HIST = 2 * MiB;
constexpr size_t WS_BLKE = WS_HIST + 64 * 1024;
constexpr size_t WS_TOPE = 3 * MiB;
constexpr size_t WS_TOPW = WS_TOPE + 512 * 1024;
constexpr size_t WS_RANK = WS_TOPW + 512 * 1024;
constexpr size_t WS_PROW = WS_RANK + 512 * 1024;
constexpr size_t WS_RTOK = 5 * MiB;
constexpr size_t WS_RW = 6 * MiB;
constexpr size_t WS_HGD = 7 * MiB;
constexpr size_t WS_WT = 8 * MiB;
constexpr size_t WS_WIN = WS_WT, WS_WC = WS_WT + 16 * MiB, WS_WH = WS_WT + 18 * MiB, WS_WO = WS_WT + 20 * MiB, WS_W1 = WS_WT + 22 * MiB, WS_W2 = WS_WT + 150 * MiB;
constexpr size_t WS_P = 224 * MiB;
constexpr size_t WS_E = WS_P + 512 * MiB;
constexpr size_t WS_D = WS_E + 128 * MiB;
constexpr size_t WS_END = WS_D + 128 * MiB;
constexpr size_t PG = (size_t)T * D;
constexpr int CW_BAR = 0;

constexpr int RING_BYTES = 135168, LDSCTL_OFF = RING_BYTES, LDS_BYTES = 147456;

__device__ __forceinline__ unsigned f2bf(float f) { unsigned u = __builtin_bit_cast(unsigned, f); return (u + 0x7fffu + ((u >> 16) & 1u)) >> 16; }
__device__ __forceinline__ unsigned pk2(float lo, float hi) { return f2bf(lo) | (f2bf(hi) << 16); }
__device__ __forceinline__ float bf2f(unsigned b) { return __builtin_bit_cast(float, b << 16); }
__device__ __forceinline__ float bflo(unsigned w) { return __builtin_bit_cast(float, w << 16); }
__device__ __forceinline__ float bfhi(unsigned w) { return __builtin_bit_cast(float, w & 0xffff0000u); }
__device__ __forceinline__ float sigmoidf_(float x) { return 1.0f / (1.0f + __expf(-x)); }
__device__ __forceinline__ float wave_sum(float v) {
#pragma unroll
    for (int o = 1; o < 64; o <<= 1) v += __shfl_xor(v, o);
    return v;
}
#define LDS_WAIT() asm volatile("s_waitcnt lgkmcnt(0)" ::: "memory")
#define VM_WAIT() asm volatile("s_waitcnt vmcnt(0)" ::: "memory")

namespace pg8 {
#define PG8_LAS __attribute__((address_space(3)))
typedef unsigned short bf16_t;
typedef short bf16x8 __attribute__((ext_vector_type(8)));
typedef float f32x4 __attribute__((ext_vector_type(4)));
typedef unsigned u32x4 __attribute__((ext_vector_type(4)));
constexpr int BM = 256, BK = 64, HALF = 128, HTB = HALF * BK * 2  , STAGE_BYTES = 8 * HTB, NXCD = 8, WGM = 8;

__host__ __device__ __forceinline__ int lds_byte(int r, int c) { const int st = (r >> 4) * 2 + (c >> 5), rr = r & 15, cc = c & 31, ob = rr * 64 + cc * 2; return st * 1024 + (ob ^ (((ob >> 9) & 1) << 5)); }
__host__ __device__ __forceinline__ void stage_rc(int b, int& R, int& C) { const int st = b / 1024, sb = b % 1024, swz = sb ^ (((sb >> 9) & 1) << 5); R = (st >> 1) * 16 + swz / 64; C = (st & 1) * 32 + (swz % 64) / 2; }
__host__ __device__ __forceinline__ int perm32(int rho) { const int n = rho >> 4, i = rho & 15; return 8 * (i >> 2) + 4 * n + (i & 3); }

struct Unit { int pm, pn; };
struct Gemm { const bf16_t* A; const bf16_t* Bt; int M, N, K; };

struct StaticOrder {
    int nM, nN, nwg, G, c;
    __host__ __device__ void init(int M, int N, int G_, int c_) { nM = M / BM; nN = N / BM; nwg = nM * nN; G = G_; c = c_; }
    __host__ __device__ bool next(int i, Unit& u) const {
        const long L = (long)i * G + c; if (L >= nwg) return false;
        int wgid = (int)L; { const int q = nwg / NXCD, r = nwg % NXCD, xcd = wgid % NXCD, off = wgid / NXCD; wgid = (xcd < r ? xcd * (q + 1) : r * (q + 1) + (xcd - r) * q) + off; }
        const int nig = WGM * nN, gid = wgid / nig, fm = gid * WGM, gsz = (nM - fm) < WGM ? (nM - fm) : WGM;
        u.pm = fm + ((wgid % nig) % gsz); u.pn = (wgid % nig) / gsz; return true;
    }
    __device__ __forceinline__ void a_ready(const Unit&) const {}
    __device__ __forceinline__ void done(const Unit&) const {}
};


struct MoeOrder {
    const int* blk_e; int nblk, G, c, lg;
    __device__ __forceinline__ bool next(int i, Unit& u) const {
        int blk, j;
        if (G == 256) { const int xcd = c & 7, idx = c >> 3, prb = 256 >> lg; blk = i * prb + xcd * (prb >> 3) + (idx >> lg); j = idx & ((1 << lg) - 1); }
        else { const long L = (long)i * G + c; blk = (int)(L >> lg); j = (int)(L & ((1 << lg) - 1)); }
        if (blk >= nblk) return false;
        const int e = blk_e[blk]; u.pm = blk; u.pn = (e << lg) + j; return true;
    }
    __device__ __forceinline__ void a_ready(const Unit&) const {}
    __device__ __forceinline__ void done(const Unit&) const {}
};

__device__ __forceinline__ unsigned cvt_pk_bf16(float lo, float hi) { unsigned r; asm volatile("v_cvt_pk_bf16_f32 %0, %1, %2" : "=v"(r) : "v"(lo), "v"(hi)); return r; }
__device__ __forceinline__ float sigm(float x) { return 1.0f / (1.0f + __expf(-x)); }
__device__ __forceinline__ float blo(unsigned w) { return __builtin_bit_cast(float, w << 16); }
__device__ __forceinline__ float bhi(unsigned w) { return __builtin_bit_cast(float, w & 0xffff0000u); }

struct EpiSplitBf16 {
    static constexpr bool PERM = true, AFTER_DRAIN = false;
    bf16_t* O; size_t split_stride; unsigned hm_mask; int seq;
    __device__ __forceinline__ void operator()(const f32x4 (&acc)[2][2][4][2], const Unit& u, int wr, int wc, int fr, int fq) const {
        const int row0 = u.pm * BM + wr * 64 + fr; const int colt = u.pn * BM; const int t = colt >> 10;
        bf16_t* base = O + (size_t)t * split_stride; const int cg = colt & 1023;
        const bool hm = (hm_mask >> t) & 1u;
        const int bb = (u.pm * BM) / seq;
#pragma unroll
        for (int ai = 0; ai < 2; ++ai)
#pragma unroll
            for (int m = 0; m < 4; ++m) { const int row = row0 + ai * HALF + m * 16;
#pragma unroll
                for (int bj = 0; bj < 2; ++bj) { const f32x4 v0 = acc[ai][bj][m][0], v1 = acc[ai][bj][m][1];
                    u32x4 w; w.x = cvt_pk_bf16(v0[0], v0[1]); w.y = cvt_pk_bf16(v0[2], v0[3]); w.z = cvt_pk_bf16(v1[0], v1[1]); w.w = cvt_pk_bf16(v1[2], v1[3]);
                    const size_t o = hm ? ((size_t)(bb * 8 + (cg >> 7) + bj) * seq + (row - bb * seq)) * 128 + wc * 32 + 8 * fq
                                        : (size_t)row * 1024 + cg + bj * HALF + wc * 32 + 8 * fq;
                    *(u32x4*)(base + o) = w; } }
    }
};
struct EpiGate1 {
    static constexpr bool PERM = true, AFTER_DRAIN = false;
    const bf16_t* gate; float* tmp;
    __device__ __forceinline__ void operator()(const f32x4 (&acc)[2][2][4][2], const Unit& u, int wr, int wc, int fr, int fq) const {
        const int row0 = u.pm * BM + wr * 64 + fr, col0 = u.pn * BM + wc * 32 + 8 * fq;
#pragma unroll
        for (int ai = 0; ai < 2; ++ai)
#pragma unroll
            for (int m = 0; m < 4; ++m) { const size_t o = (size_t)(row0 + ai * HALF + m * 16) * 1024 + col0;
#pragma unroll
                for (int bj = 0; bj < 2; ++bj) { const u32x4 g = *(const u32x4*)(gate + o + bj * HALF); f32x4 v0 = acc[ai][bj][m][0], v1 = acc[ai][bj][m][1];
                    v0[0] *= sigm(blo(g.x)); v0[1] *= sigm(bhi(g.x)); v0[2] *= sigm(blo(g.y)); v0[3] *= sigm(bhi(g.y));
                    v1[0] *= sigm(blo(g.z)); v1[1] *= sigm(bhi(g.z)); v1[2] *= sigm(blo(g.w)); v1[3] *= sigm(bhi(g.w));
                    *(f32x4*)(tmp + o + bj * HALF) = v0; *(f32x4*)(tmp + o + bj * HALF + 4) = v1; } }
    }
};
struct EpiGate2 {
    static constexpr bool PERM = true, AFTER_DRAIN = false;
    const bf16_t* gate; const float* tmp; bf16_t* out;
    __device__ __forceinline__ void operator()(const f32x4 (&acc)[2][2][4][2], const Unit& u, int wr, int wc, int fr, int fq) const {
        const int row0 = u.pm * BM + wr * 64 + fr, col0 = u.pn * BM + wc * 32 + 8 * fq;
#pragma unroll
        for (int ai = 0; ai < 2; ++ai)
#pragma unroll
            for (int m = 0; m < 4; ++m) { const size_t o = (size_t)(row0 + ai * HALF + m * 16) * 1024 + col0;
#pragma unroll
                for (int bj = 0; bj < 2; ++bj) { const u32x4 g = *(const u32x4*)(gate + o + bj * HALF); f32x4 v0 = acc[ai][bj][m][0], v1 = acc[ai][bj][m][1];
                    const f32x4 t0 = *(const f32x4*)(tmp + o + bj * HALF), t1 = *(const f32x4*)(tmp + o + bj * HALF + 4);
                    v0[0] = t0[0] + v0[0] * sigm(blo(g.x)); v0[1] = t0[1] + v0[1] * sigm(bhi(g.x)); v0[2] = t0[2] + v0[2] * sigm(blo(g.y)); v0[3] = t0[3] + v0[3] * sigm(bhi(g.y));
                    v1[0] = t1[0] + v1[0] * sigm(blo(g.z)); v1[1] = t1[1] + v1[1] * sigm(bhi(g.z)); v1[2] = t1[2] + v1[2] * sigm(blo(g.w)); v1[3] = t1[3] + v1[3] * sigm(bhi(g.w));
                    u32x4 w; w.x = cvt_pk_bf16(v0[0], v0[1]); w.y = cvt_pk_bf16(v0[2], v0[3]); w.z = cvt_pk_bf16(v1[0], v1[1]); w.w = cvt_pk_bf16(v1[2], v1[3]);
                    *(u32x4*)(out + o + bj * HALF) = w; } }
    }
};
struct EpiRes {
    static constexpr bool PERM = false, AFTER_DRAIN = false;
    const float* x; const float* ga; float* out; int mod_pitch, seq;
    __device__ __forceinline__ void operator()(const f32x4 (&acc)[2][2][4][2], const Unit& u, int wr, int wc, int fr, int fq) const {
        const int row0 = u.pm * BM + wr * 64 + fr, col0 = u.pn * BM + wc * 32 + 4 * fq;
        const float* gab = ga + (size_t)((u.pm * BM) / seq) * mod_pitch + col0;
        f32x4 gv[2][2];
#pragma unroll
        for (int bj = 0; bj < 2; ++bj)
#pragma unroll
            for (int n = 0; n < 2; ++n) gv[bj][n] = *(const f32x4*)(gab + bj * HALF + n * 16);
#pragma unroll
        for (int ai = 0; ai < 2; ++ai)
#pragma unroll
            for (int m = 0; m < 4; ++m) { const size_t o = (size_t)(row0 + ai * HALF + m * 16) * 1024 + col0;
#pragma unroll
                for (int bj = 0; bj < 2; ++bj)
#pragma unroll
                    for (int n = 0; n < 2; ++n) { const f32x4 xv = *(const f32x4*)(x + o + bj * HALF + n * 16); *(f32x4*)(out + o + bj * HALF + n * 16) = xv + gv[bj][n] * acc[ai][bj][m][n]; } }
    }
};
struct EpiSwiglu {
    static constexpr bool PERM = true, AFTER_DRAIN = false;
    const float* b1; bf16_t* act;
    __device__ __forceinline__ void operator()(const f32x4 (&acc)[2][2][4][2], const Unit& u, int wr, int wc, int fr, int fq) const {
        const int e = u.pn >> 3, j = u.pn & 7; const int row0 = u.pm * BM + wr * 64 + fr, f0 = 128 * j + wc * 32 + 8 * fq;
        const float* be = b1 + (size_t)e * 2048 + f0;
        const f32x4 bg0 = *(const f32x4*)(be), bg1 = *(const f32x4*)(be + 4), bl0 = *(const f32x4*)(be + 1024), bl1 = *(const f32x4*)(be + 1028);
#pragma unroll
        for (int ai = 0; ai < 2; ++ai)
#pragma unroll
            for (int m = 0; m < 4; ++m) {
                f32x4 g0 = acc[ai][0][m][0] + bg0, g1 = acc[ai][0][m][1] + bg1, l0 = acc[ai][1][m][0] + bl0, l1 = acc[ai][1][m][1] + bl1;
                float r[8];
#pragma unroll
                for (int q = 0; q < 4; ++q) { float gl = fminf(g0[q], 7.0f), li = fminf(fmaxf(l0[q], -7.0f), 7.0f); r[q] = gl * sigm(1.702f * gl) * (li + 1.0f);
                                              gl = fminf(g1[q], 7.0f); li = fminf(fmaxf(l1[q], -7.0f), 7.0f); r[4 + q] = gl * sigm(1.702f * gl) * (li + 1.0f); }
                u32x4 w; w.x = cvt_pk_bf16(r[0], r[1]); w.y = cvt_pk_bf16(r[2], r[3]); w.z = cvt_pk_bf16(r[4], r[5]); w.w = cvt_pk_bf16(r[6], r[7]);
                *(u32x4*)(act + (size_t)(row0 + ai * HALF + m * 16) * 1024 + f0) = w; }
    }
};
struct EpiY {
    static constexpr bool PERM = true, AFTER_DRAIN = false;
    const float* b2; const float* rw; bf16_t* y;
    __device__ __forceinline__ void operator()(const f32x4 (&acc)[2][2][4][2], const Unit& u, int wr, int wc, int fr, int fq) const {
        const int e = u.pn >> 2, j = u.pn & 3; const int row0 = u.pm * BM + wr * 64 + fr, col0 = 256 * j + wc * 32 + 8 * fq;
        const float* be = b2 + (size_t)e * 1024 + col0;
        f32x4 bv[2][2];
#pragma unroll
        for (int bj = 0; bj < 2; ++bj)
#pragma unroll
            for (int n = 0; n < 2; ++n) bv[bj][n] = *(const f32x4*)(be + bj * HALF + 4 * n);
#pragma unroll
        for (int ai = 0; ai < 2; ++ai)
#pragma unroll
            for (int m = 0; m < 4; ++m) { const int row = row0 + ai * HALF + m * 16; const float w_ = rw[row];
#pragma unroll
                for (int bj = 0; bj < 2; ++bj) { const f32x4 v0 = (acc[ai][bj][m][0] + bv[bj][0]) * w_, v1 = (acc[ai][bj][m][1] + bv[bj][1]) * w_;
                    u32x4 w; w.x = cvt_pk_bf16(v0[0], v0[1]); w.y = cvt_pk_bf16(v0[2], v0[3]); w.z = cvt_pk_bf16(v1[0], v1[1]); w.w = cvt_pk_bf16(v1[2], v1[3]);
                    *(u32x4*)(y + (size_t)row * 1024 + col0 + bj * HALF) = w; } }
    }
};

template <class Epi, class Sched, bool ALIGN_EPI = false, bool SP2 = false, bool GATHER = false>
__device__ __forceinline__ void gemm_phase(PG8_LAS unsigned char* lds, const Gemm g, const Sched& S, const Epi& E, const PG8_LAS unsigned short* gtab = nullptr) {
    static_assert(!GATHER || SP2, "GATHER needs the SP2 loop");
    const int tid = threadIdx.x, wid = __builtin_amdgcn_readfirstlane(tid >> 6), lane = tid & 63, wr = wid >> 2, wc = wid & 3, fr = lane & 15, fq = lane >> 4;
    const int K = g.K, nt = K / BK;
    unsigned voffA[2], voffB[2], gC[2]; int gR[2];
#pragma unroll
    for (int i = 0; i < 2; ++i) { int R, C; stage_rc(tid * 16 + i * 8192, R, C); const int Rb = Epi::PERM ? ((R & ~31) + perm32(R & 31)) : R;
        voffA[i] = (unsigned)(R * K + C) * 2u; voffB[i] = (unsigned)(Rb * K + C) * 2u; gR[i] = R; gC[i] = (unsigned)C * 2u; }
    unsigned vA0[2] = {0u, 0u}, vA1[2] = {0u, 0u}, nA0[2] = {0u, 0u}, nA1[2] = {0u, 0u};
#define PG8_GLOAD(d0, d1, ui_) do { _Pragma("unroll") for (int _i = 0; _i < 2; ++_i) { d0[_i] = (unsigned)gtab[256 * (ui_) + gR[_i]] * (unsigned)(K * 2) + gC[_i]; d1[_i] = (unsigned)gtab[256 * (ui_) + 128 + gR[_i]] * (unsigned)(K * 2) + gC[_i]; } } while (0)
    const size_t kstep = (size_t)(BK * 2);
    const size_t hstep = (size_t)HALF * K * 2;
    const size_t tstep = 2 * hstep;
    const unsigned ldsw = (unsigned)wid * 1024u;
    const int aoff = lds_byte(wr * 64 + fr, fq * 8), boff = lds_byte(wc * 32 + fr, fq * 8);
#define PG8_SA(b, h) (((b) * 2 + (h)) * HTB)
#define PG8_SB(b, h) ((4 + (b) * 2 + (h)) * HTB)
#define PG8_STAGE(bufoff, gbase, voff) do { _Pragma("unroll") for (int _i = 0; _i < 2; ++_i) \
        __builtin_amdgcn_global_load_lds((const unsigned*)((const char*)(gbase) + (voff)[_i]), (PG8_LAS unsigned*)(lds + (bufoff) + ldsw + _i * 8192), 16, 0, 0); } while (0)
#define PG8_LDA(dst, b, h) do { _Pragma("unroll") for (int m = 0; m < 4; ++m) _Pragma("unroll") for (int k = 0; k < 2; ++k) dst[m][k] = *(const PG8_LAS bf16x8*)(lds + PG8_SA(b, h) + aoff + m * 2048 + k * 1024); } while (0)
#define PG8_LDB(dst, b, h) do { _Pragma("unroll") for (int n = 0; n < 2; ++n) _Pragma("unroll") for (int k = 0; k < 2; ++k) dst[n][k] = *(const PG8_LAS bf16x8*)(lds + PG8_SB(b, h) + boff + n * 2048 + k * 1024); } while (0)
#define PG8_MMA(ai, bj, At, Bt) do { __builtin_amdgcn_s_setprio(1); _Pragma("unroll") for (int m = 0; m < 4; ++m) _Pragma("unroll") for (int n = 0; n < 2; ++n) _Pragma("unroll") for (int k = 0; k < 2; ++k) \
        acc[ai][bj][m][n] = __builtin_amdgcn_mfma_f32_16x16x32_bf16(Bt[n][k], At[m][k], acc[ai][bj][m][n], 0, 0, 0); __builtin_amdgcn_s_setprio(0); } while (0)
#define PG8_WAIT_V(n) asm volatile("s_waitcnt vmcnt(" #n ")" ::: "memory")
#define PG8_WAIT_L(n) asm volatile("s_waitcnt lgkmcnt(" #n ")" ::: "memory")
#define PG8_BAR __builtin_amdgcn_s_barrier()
#define PG8_SCHED __builtin_amdgcn_sched_barrier(0)
    Unit cur, nxt; int ui = 0;
    if (!S.next(0, cur)) return;
    f32x4 acc[2][2][4][2];
#pragma unroll
    for (int a = 0; a < 2; ++a)
#pragma unroll
        for (int b = 0; b < 2; ++b)
#pragma unroll
            for (int m = 0; m < 4; ++m)
#pragma unroll
                for (int n = 0; n < 2; ++n) acc[a][b][m][n] = (f32x4){0.f, 0.f, 0.f, 0.f};
    bf16x8 At[4][2], B0[2][2], B1[2][2];
    const char* cA = GATHER ? (const char*)g.A : (const char*)g.A + (size_t)cur.pm * tstep; const char* cB = (const char*)g.Bt + (size_t)cur.pn * tstep;
    S.a_ready(cur);
    if constexpr (GATHER) { PG8_GLOAD(vA0, vA1, 0); }
    if constexpr (SP2) {
        PG8_STAGE(PG8_SB(0, 0), cB, voffB); PG8_STAGE(PG8_SB(0, 1), cB + hstep, voffB);
        if constexpr (GATHER) { PG8_STAGE(PG8_SA(0, 0), cA, vA0); PG8_STAGE(PG8_SA(0, 1), cA, vA1); } else { PG8_STAGE(PG8_SA(0, 0), cA, voffA); PG8_STAGE(PG8_SA(0, 1), cA + hstep, voffA); }
        if (wr == 1) PG8_BAR;
        PG8_WAIT_V(2); PG8_BAR;
        PG8_STAGE(PG8_SB(1, 0), cB + kstep, voffB); if constexpr (GATHER) { PG8_STAGE(PG8_SA(1, 0), cA + kstep, vA0); } else { PG8_STAGE(PG8_SA(1, 0), cA + kstep, voffA); } PG8_STAGE(PG8_SB(1, 1), cB + hstep + kstep, voffB);
        PG8_WAIT_V(6); PG8_BAR;
    } else {
        PG8_STAGE(PG8_SB(0, 0), cB, voffB); PG8_STAGE(PG8_SA(0, 0), cA, voffA); PG8_STAGE(PG8_SB(0, 1), cB + hstep, voffB); PG8_STAGE(PG8_SA(0, 1), cA + hstep, voffA);
        if (wr == 1) PG8_BAR;
        PG8_WAIT_V(4); PG8_BAR;
        PG8_STAGE(PG8_SB(1, 0), cB + kstep, voffB); PG8_STAGE(PG8_SA(1, 0), cA + kstep, voffA); PG8_STAGE(PG8_SB(1, 1), cB + hstep + kstep, voffB);
        PG8_WAIT_V(6); PG8_BAR;
    }
    for (;;) {
        const bool has_next = S.next(ui + 1, nxt);
        const char* nA = GATHER ? cA : (has_next ? (const char*)g.A + (size_t)nxt.pm * tstep : cA); const char* nB = has_next ? (const char*)g.Bt + (size_t)nxt.pn * tstep : cB;
        for (int t = 0; t < nt; t += 2) {
            const bool last = (t == nt - 2);
            const char* a1 = cA + (size_t)(t + 1) * kstep;
            const char* a2 = last ? nA : cA + (size_t)(t + 2) * kstep; const char* b2 = last ? nB : cB + (size_t)(t + 2) * kstep;
            const char* a3 = a2 + kstep; const char* b3 = b2 + kstep;
            if (last && has_next) S.a_ready(nxt);
            unsigned s0[2], s1[2];
            if constexpr (GATHER) { if (last) { if (has_next) { PG8_GLOAD(nA0, nA1, ui + 1); } else { nA0[0] = vA0[0]; nA0[1] = vA0[1]; nA1[0] = vA1[0]; nA1[1] = vA1[1]; } }
                s0[0] = last ? nA0[0] : vA0[0]; s0[1] = last ? nA0[1] : vA0[1]; s1[0] = last ? nA1[0] : vA1[0]; s1[1] = last ? nA1[1] : vA1[1]; }
            if constexpr (SP2) {
            PG8_LDB(B0, 0, 0); PG8_LDB(B1, 0, 1); PG8_SCHED; PG8_LDA(At, 0, 0); if constexpr (GATHER) { PG8_STAGE(PG8_SA(1, 1), a1, vA1); } else { PG8_STAGE(PG8_SA(1, 1), a1 + hstep, voffA); }
            PG8_WAIT_V(8); PG8_WAIT_L(0); PG8_BAR; PG8_MMA(0, 0, At, B0); PG8_MMA(0, 1, At, B1); PG8_BAR; PG8_SCHED;
            PG8_LDA(At, 0, 1); PG8_STAGE(PG8_SB(0, 0), b2, voffB); PG8_STAGE(PG8_SB(0, 1), b2 + hstep, voffB); if constexpr (GATHER) { PG8_STAGE(PG8_SA(0, 0), a2, s0); } else { PG8_STAGE(PG8_SA(0, 0), a2, voffA); }
            PG8_WAIT_V(8); PG8_WAIT_L(0); PG8_BAR; PG8_MMA(1, 0, At, B0); PG8_MMA(1, 1, At, B1); PG8_BAR; PG8_SCHED;
            PG8_LDB(B0, 1, 0); PG8_LDB(B1, 1, 1); PG8_SCHED; PG8_LDA(At, 1, 0); if constexpr (GATHER) { PG8_STAGE(PG8_SA(0, 1), a2, s1); } else { PG8_STAGE(PG8_SA(0, 1), a2 + hstep, voffA); }
            PG8_WAIT_V(8); PG8_WAIT_L(0); PG8_BAR; PG8_MMA(0, 0, At, B0); PG8_MMA(0, 1, At, B1); PG8_BAR; PG8_SCHED;
            PG8_LDA(At, 1, 1); PG8_STAGE(PG8_SB(1, 0), b3, voffB); PG8_STAGE(PG8_SB(1, 1), b3 + hstep, voffB); if constexpr (GATHER) { PG8_STAGE(PG8_SA(1, 0), a3, s0); } else { PG8_STAGE(PG8_SA(1, 0), a3, voffA); }
            PG8_WAIT_V(8); PG8_WAIT_L(0); PG8_BAR; PG8_MMA(1, 0, At, B0); PG8_MMA(1, 1, At, B1); PG8_BAR; PG8_SCHED;
            } else {
            PG8_LDB(B0, 0, 0); PG8_SCHED; PG8_LDA(At, 0, 0); PG8_STAGE(PG8_SA(1, 1), a1 + hstep, voffA);
            PG8_WAIT_L(8); PG8_BAR; PG8_WAIT_L(0); PG8_MMA(0, 0, At, B0); PG8_BAR; PG8_SCHED;
            PG8_LDB(B1, 0, 1); PG8_STAGE(PG8_SB(0, 0), b2, voffB);
            PG8_BAR; PG8_WAIT_L(0); PG8_MMA(0, 1, At, B1); PG8_BAR;
            PG8_LDA(At, 0, 1); PG8_STAGE(PG8_SA(0, 0), a2, voffA);
            PG8_BAR; PG8_WAIT_L(0); PG8_MMA(1, 0, At, B0); PG8_BAR; PG8_SCHED;
            PG8_STAGE(PG8_SB(0, 1), b2 + hstep, voffB);
            PG8_WAIT_V(6); PG8_BAR; PG8_MMA(1, 1, At, B1); PG8_BAR;
            PG8_LDB(B0, 1, 0); PG8_SCHED; PG8_LDA(At, 1, 0); PG8_STAGE(PG8_SA(0, 1), a2 + hstep, voffA);
            PG8_WAIT_L(8); PG8_BAR; PG8_WAIT_L(0); PG8_MMA(0, 0, At, B0); PG8_BAR; PG8_SCHED;
            PG8_LDB(B1, 1, 1); PG8_STAGE(PG8_SB(1, 0), b3, voffB);
            PG8_BAR; PG8_WAIT_L(0); PG8_MMA(0, 1, At, B1); PG8_BAR;
            PG8_LDA(At, 1, 1); PG8_STAGE(PG8_SA(1, 0), a3, voffA);
            PG8_BAR; PG8_WAIT_L(0); PG8_MMA(1, 0, At, B0); PG8_BAR; PG8_SCHED;
            PG8_STAGE(PG8_SB(1, 1), b3 + hstep, voffB);
            PG8_WAIT_V(6); PG8_BAR; PG8_MMA(1, 1, At, B1); PG8_BAR;
            }
        }
        if constexpr (ALIGN_EPI) { if (wr == 0) PG8_BAR; }
        if constexpr (!Epi::AFTER_DRAIN) { E(acc, cur, wr, wc, fr, fq); S.done(cur); }
        if (!has_next) break;
#pragma unroll
        for (int a = 0; a < 2; ++a)
#pragma unroll
            for (int b = 0; b < 2; ++b)
#pragma unroll
                for (int m = 0; m < 4; ++m)
#pragma unroll
                    for (int n = 0; n < 2; ++n) acc[a][b][m][n] = (f32x4){0.f, 0.f, 0.f, 0.f};
        cur = nxt; cA = nA; cB = nB; ++ui;
        if constexpr (GATHER) { vA0[0] = nA0[0]; vA0[1] = nA0[1]; vA1[0] = nA1[0]; vA1[1] = nA1[1]; }
        if constexpr (ALIGN_EPI) { if (wr == 1) PG8_BAR; }
    }
    PG8_WAIT_V(0);
    if constexpr (!ALIGN_EPI) { if (wr == 0) PG8_BAR; }
    PG8_BAR;
    if constexpr (Epi::AFTER_DRAIN) { E.fused(acc, cur, wr, wc, fr, fq, lds, wid, lane); S.done(cur); }
#undef PG8_GLOAD
#undef PG8_SA
#undef PG8_SB
#undef PG8_STAGE
#undef PG8_LDA
#undef PG8_LDB
#undef PG8_MMA
#undef PG8_WAIT_V
#undef PG8_WAIT_L
#undef PG8_BAR
#undef PG8_SCHED
}
}
#define XB_TMO      128
#define XB_XCNT(j)  (256  + 64 * (j))
#define XB_XSUB(j)  (1280 + 64 * (j))
#define XB_XGEN(j)  (2304 + 64 * (j))
#define XB_TOP      3328
#define XB_TOPGEN   3392
#define XCD_BAR_WORDS 3456
#define XB_SPIN_CAP (1u << 18)

__device__ __forceinline__ unsigned xb_ld(unsigned* p)              { return __hip_atomic_load(p, __ATOMIC_RELAXED, __HIP_MEMORY_SCOPE_AGENT); }
__device__ __forceinline__ unsigned xb_add(unsigned* p, unsigned v) { return __hip_atomic_fetch_add(p, v, __ATOMIC_RELAXED, __HIP_MEMORY_SCOPE_AGENT); }
__device__ __forceinline__ unsigned xb_xcc_id() { return (unsigned)__builtin_amdgcn_s_getreg((3 << 11) | 20) & 0xFu; }
#define XB_SPIN(cond, bar) do { unsigned _sp = 0; while (cond) { __builtin_amdgcn_s_sleep(1); \
    if ((++_sp & 255u) == 0u) { if (xb_ld(&(bar)[XB_TMO])) break; if (_sp > XB_SPIN_CAP) { atomicAdd(&(bar)[XB_TMO], 1u); break; } } } } while (0)

struct XcdBarrier {
    unsigned* bar; unsigned x;
    volatile LAS unsigned* st;
};

__device__ __forceinline__ XcdBarrier xcd_barrier_post(unsigned* bar, volatile LAS unsigned* st) {
    XcdBarrier b; b.bar = bar; b.x = xb_xcc_id(); b.st = st;
    if (threadIdx.x == 0) (void)xb_add(&bar[XB_XCNT(b.x)], 1u);
    return b;
}
__device__ __forceinline__ void xcd_barrier_complete(unsigned* bar, unsigned x, unsigned& nloc, unsigned& nx) {
    const unsigned G = gridDim.x * gridDim.y * gridDim.z;
    unsigned sum, cnt, mine, sp = 0u;
    for (;;) {
        sum = 0u; cnt = 0u; mine = 0u;
#pragma unroll
        for (unsigned j = 0; j < 16; ++j) { const unsigned c = xb_ld(&bar[XB_XCNT(j)]); sum += c; cnt += (c > 0u) ? 1u : 0u; mine = (j == x) ? c : mine; }
        if (sum == G) break;
        __builtin_amdgcn_s_sleep(1);
        if ((++sp & 255u) == 0u) { if (xb_ld(&bar[XB_TMO])) break; if (sp > XB_SPIN_CAP) { atomicAdd(&bar[XB_TMO], 1u); break; } }
    }
    nloc = mine > 0u ? mine : 1u; nx = cnt > 0u ? cnt : 1u;
}

__device__ __forceinline__ void xcd_barrier(const XcdBarrier& b) {
    asm volatile("s_waitcnt vmcnt(0)" ::: "memory");
    __syncthreads();
    if (threadIdx.x == 0) {
        unsigned* bar = b.bar;
        __builtin_amdgcn_s_waitcnt(0);
        unsigned nloc = b.st[0], nx = b.st[1];
        if (nloc == 0u) { xcd_barrier_complete(bar, b.x, nloc, nx); b.st[0] = nloc; b.st[1] = nx; }
        const unsigned old = xb_add(&bar[XB_XSUB(b.x)], 1u);
        const unsigned gen = old / nloc;
        if (old + 1u == (gen + 1u) * nloc) {
            __builtin_amdgcn_fence(__ATOMIC_RELEASE, "agent");
            asm volatile("s_waitcnt vmcnt(0)" ::: "memory");
            const unsigned og = xb_add(&bar[XB_TOP], 1u);
            const unsigned tg = og / nx;
            if (og + 1u == (tg + 1u) * nx) xb_add(&bar[XB_TOPGEN], 1u);
            else XB_SPIN(xb_ld(&bar[XB_TOPGEN]) == tg, bar);
            __builtin_amdgcn_fence(__ATOMIC_ACQUIRE, "agent");
            xb_add(&bar[XB_XGEN(b.x)], 1u);
            asm volatile("s_waitcnt vmcnt(0)" ::: "memory");
        } else {
            XB_SPIN(xb_ld(&bar[XB_XGEN(b.x)]) == gen, bar);
            __builtin_amdgcn_fence(__ATOMIC_ACQUIRE, "agent");
            asm volatile("s_waitcnt vmcnt(0)" ::: "memory");
        }
    }
    __syncthreads();
}

struct Ctx { LAS unsigned char* lds; int tid, lane, wave, vcu, G; };

__device__ __forceinline__ void transpose_item(const float* W, int ldw, int K, bf16_t* dst, int k0, int n0, LAS float* scr, int lane) {
#pragma unroll 8
    for (int i = 0; i < 32; ++i) { const int kk = 2 * i + (lane >> 5); scr[kk * 33 + (lane & 31)] = W[(size_t)(k0 + kk) * ldw + n0 + (lane & 31)]; }
    LDS_WAIT();
    const int c = lane & 7;
#pragma unroll
    for (int j = 0; j < 4; ++j) { const int n = (lane >> 3) + 8 * j; const LAS float* s = scr + (8 * c) * 33 + n;
        u32x4 o; o.x = pk2(s[0 * 33], s[1 * 33]); o.y = pk2(s[2 * 33], s[3 * 33]); o.z = pk2(s[4 * 33], s[5 * 33]); o.w = pk2(s[6 * 33], s[7 * 33]);
        *(u32x4*)(dst + (size_t)n * K + k0 + 8 * c) = o; }
    LDS_WAIT();
}

__device__ __forceinline__ void ph_prologue(const Ctx& X, const float* c, const float* w_ada, const float* b_ada, float* mod,
                                            const float* w_in, const float* w_conv_out, const float* w_hgrn_out, const float* w_out, const float* w1, const float* w2, unsigned char* ws) {
    if (X.vcu < 48) {
        LAS float* ca = (LAS float*)X.lds;
        LAS float* red = (LAS float*)(X.lds + 16384);
        for (int i = X.tid; i < 4096; i += 512) { const float v = c[i]; ca[i] = v * sigmoidf_(v); }
        __syncthreads();
        const int jj = X.tid & 127, kq = X.tid >> 7, j = X.vcu * 128 + jj;
        float a0 = 0.f, a1 = 0.f, a2 = 0.f, a3 = 0.f;
#pragma unroll 8
        for (int i = kq * 256; i < kq * 256 + 256; ++i) { const float w = w_ada[(size_t)i * NMOD + j]; a0 += ca[i] * w; a1 += ca[1024 + i] * w; a2 += ca[2048 + i] * w; a3 += ca[3072 + i] * w; }
        red[(kq * 4 + 0) * 128 + jj] = a0; red[(kq * 4 + 1) * 128 + jj] = a1; red[(kq * 4 + 2) * 128 + jj] = a2; red[(kq * 4 + 3) * 128 + jj] = a3;
        __syncthreads();
        { const int b = X.tid >> 7; mod[(size_t)b * NMOD + j] = b_ada[j] + red[(0 * 4 + b) * 128 + jj] + red[(1 * 4 + b) * 128 + jj] + red[(2 * 4 + b) * 128 + jj] + red[(3 * 4 + b) * 128 + jj]; }
        __syncthreads();
    }
    LAS float* scr = (LAS float*)(X.lds + X.wave * 16384);
    const int gw = X.vcu * 8 + X.wave, NGW = X.G * 8;
    constexpr int I_IN = 16 * 256, I_SQ = 16 * 32, I_W1 = 32 * 16 * 64, I_W2 = 32 * 16 * 32, NITEMS = I_IN + 3 * I_SQ + I_W1 + I_W2;
    for (int it = gw; it < NITEMS; it += NGW) {
        int r = it;
        if (r < I_IN) { const int kb = r >> 8, nb = r & 255; transpose_item(w_in, 8192, 1024, (bf16_t*)(ws + WS_WIN) + (size_t)(32 * nb) * 1024, 64 * kb, 32 * nb, scr, X.lane); continue; } r -= I_IN;
        if (r < 3 * I_SQ) { const int which = r / I_SQ, q = r % I_SQ, kb = q >> 5, nb = q & 31;
            const float* W = which == 0 ? w_conv_out : (which == 1 ? w_hgrn_out : w_out); bf16_t* WT = (bf16_t*)(ws + (which == 0 ? WS_WC : (which == 1 ? WS_WH : WS_WO)));
            transpose_item(W, 1024, 1024, WT + (size_t)(32 * nb) * 1024, 64 * kb, 32 * nb, scr, X.lane); continue; } r -= 3 * I_SQ;
        if (r < I_W1) { const int e = r >> 10, q = r & 1023, kb = q >> 6, nb = q & 63, n0 = 32 * nb;
            const int rho0 = (n0 < 1024) ? 256 * (n0 >> 7) + (n0 & 127) : 256 * ((n0 - 1024) >> 7) + 128 + ((n0 - 1024) & 127);
            transpose_item(w1 + (size_t)e * 1024 * 2048, 2048, 1024, (bf16_t*)(ws + WS_W1) + ((size_t)e * 2048 + rho0) * 1024, 64 * kb, n0, scr, X.lane); continue; } r -= I_W1;
        { const int e = r >> 9, q = r & 511, kb = q >> 5, nb = q & 31;
            transpose_item(w2 + (size_t)e * 1024 * 1024, 1024, 1024, (bf16_t*)(ws + WS_W2) + ((size_t)e * 1024 + 32 * nb) * 1024, 64 * kb, 32 * nb, scr, X.lane); }
    }
}

__device__ __forceinline__ void ph_norm_mod(const Ctx& X, const float* x, const float* g, const float* mod, int sh_off, int sc_off, bf16_t* out) {
    for (int t = X.vcu * 8 + X.wave; t < T; t += X.G * 8) {
        const int b = t / SEQ, lane = X.lane;
        const f32x4* xr = (const f32x4*)(x + (size_t)t * D) + lane;
        f32x4 v[4]; float ss = 0.f;
#pragma unroll
        for (int j = 0; j < 4; ++j) { v[j] = xr[64 * j]; ss += (v[j].x * v[j].x + v[j].y * v[j].y) + (v[j].z * v[j].z + v[j].w * v[j].w); }
        const float r = rsqrtf(wave_sum(ss) * (1.0f / D) + EPS);
        const float* sh = mod + (size_t)b * NMOD + sh_off; const float* sc = mod + (size_t)b * NMOD + sc_off;
#pragma unroll
        for (int j = 0; j < 4; ++j) {
            const int col = 4 * (lane + 64 * j);
            const f32x4 gg = *(const f32x4*)(g + col), s1 = *(const f32x4*)(sc + col), s0 = *(const f32x4*)(sh + col);
            const f32x4 y = v[j] * r * gg * (s1 + 1.0f) + s0;
            u32x2 w; w.x = pk2(y.x, y.y); w.y = pk2(y.z, y.w);
            *(u32x2*)(out + (size_t)t * D + col) = w;
        }
    }
}

__device__ __forceinline__ void ph_conv(const Ctx& X, const bf16_t* pA, const bf16_t* pB, const float* dw, const float* dwb, const float* lng, const float* lnb, bf16_t* uc) {
    LAS float* sm = (LAS float*)X.lds;
    const int tid = X.tid, lane = X.lane, wid = X.wave, c0 = 2 * tid;
    float w[31][2];
#pragma unroll
    for (int j = 0; j < 31; ++j) { w[j][0] = dw[j * 1024 + c0]; w[j][1] = dw[j * 1024 + c0 + 1]; }
    const float bias0 = dwb[c0], bias1 = dwb[c0 + 1];
    for (int task = X.vcu; task < T / 32; task += X.G) {
        const int b = task >> 8, s0 = (task & 255) * 32;
        const bf16_t* qa = pA + (size_t)(b * SEQ) * D + c0; const bf16_t* qb = pB + (size_t)(b * SEQ) * D + c0;
        float u[38][2];
#pragma unroll
        for (int st = 0; st < 4; ++st) {
#pragma unroll
            for (int i = (st == 0 ? 0 : 8 * st + 30); i < 8 * st + 38; ++i) {
                const int s = s0 - 30 + i;
                float u0 = 0.f, u1 = 0.f;
                if (s >= 0) { const unsigned a2 = *(const unsigned*)(qa + (size_t)s * D), b2 = *(const unsigned*)(qb + (size_t)s * D);
                              u0 = bflo(a2) * sigmoidf_(bflo(b2)); u1 = bfhi(a2) * sigmoidf_(bfhi(b2)); }
                u[i % 38][0] = u0; u[i % 38][1] = u1;
            }
#pragma unroll
            for (int t = 8 * st; t < 8 * st + 8; ++t) {
                float a0 = bias0, a1 = bias1;
#pragma unroll
                for (int j = 0; j < 31; ++j) { a0 += w[j][0] * u[(t + j) % 38][0]; a1 += w[j][1] * u[(t + j) % 38][1]; }
                sm[t * 1024 + c0] = a0; sm[t * 1024 + c0 + 1] = a1;
            }
        }
        __syncthreads();
#pragma unroll 1
        for (int i = 0; i < 4; ++i) {
            const int t = wid * 4 + i;
            f32x4 v[4]; float s = 0.f;
#pragma unroll
            for (int j = 0; j < 4; ++j) { v[j] = *(const LAS f32x4*)(sm + t * 1024 + 4 * (lane + 64 * j)); s += (v[j].x + v[j].y) + (v[j].z + v[j].w); }
            const float mean = wave_sum(s) * (1.0f / D); float q = 0.f;
#pragma unroll
            for (int j = 0; j < 4; ++j) { v[j] = v[j] - mean; q += (v[j].x * v[j].x + v[j].y * v[j].y) + (v[j].z * v[j].z + v[j].w * v[j].w); }
            const float rstd = rsqrtf(wave_sum(q) * (1.0f / D) + EPS);
#pragma unroll
            for (int j = 0; j < 4; ++j) {
                const int col = 4 * (lane + 64 * j);
                const f32x4 gg = *(const f32x4*)(lng + col), bb = *(const f32x4*)(lnb + col);
                f32x4 y = v[j] * rstd * gg + bb;
                y.x *= sigmoidf_(y.x); y.y *= sigmoidf_(y.y); y.z *= sigmoidf_(y.z); y.w *= sigmoidf_(y.w);
                u32x2 o; o.x = pk2(y.x, y.y); o.y = pk2(y.z, y.w);
                *(u32x2*)(uc + (size_t)(b * SEQ + s0 + t) * D + col) = o;
            }
        }
        __syncthreads();
    }
}

typedef short bf16x8 __attribute__((ext_vector_type(8)));
typedef short s16x4 __attribute__((ext_vector_type(4)));
typedef float f32x2 __attribute__((ext_vector_type(2)));
constexpr int HG_QA = 0, HG_KA = 17408, HG_VR = 34816, HG_AB = 52224, HG_SPT = 61440, HG_O = 96256, HG_SEG = 130048;
constexpr size_t HM = (size_t)SEQ * 128;
__device__ __forceinline__ bf16x8 tr_frag(LAS unsigned char* base, int rs, int ks, int c16, int lane) {
    const int g = lane >> 4, q = (lane & 15) >> 2, p = lane & 3;
    LAS unsigned char* a = base + (32 * ks + 8 * g + q) * rs + (16 * c16 + 4 * p) * 2;
    const s16x4 lo = __builtin_amdgcn_ds_read_tr16_b64_v4i16((LAS s16x4*)a);
    const s16x4 hi = __builtin_amdgcn_ds_read_tr16_b64_v4i16((LAS s16x4*)(a + 4 * rs));
    return __builtin_shufflevector(lo, hi, 0, 1, 2, 3, 4, 5, 6, 7);
}
template <bool OUT>
__device__ __forceinline__ void ph_hgrn(const Ctx& X, int ntask, const bf16_t* pQ, const bf16_t* pF, const bf16_t* pI, const bf16_t* pG,
                                        const float* lb_param, const float* norm_g, const float* S0, float* dS, float* Dd, bf16_t* og) {
    LAS unsigned char* L = X.lds;
    LAS float* seg_s = (LAS float*)(L + HG_SEG);
    const int tid = X.tid, lane = X.lane, wave = X.wave, fr = lane & 15, fq = lane >> 4, wr = wave >> 1, wc = wave & 1;
    const int cp = tid & 63, seg = wave, tv = tid >> 3, vc = tid & 7;
    int idx = X.vcu; if (idx >= ntask) return;
    int ch = 0;
    unsigned zr[8], qr[8]; u32x4 vr0, vr1, gn0, gn1, gc0, gc1;
#define HG_LOAD(idx_, ch_) do { const int bh_ = (idx_) & 31, sc_ = (idx_) >> 5; const size_t tb_ = (size_t)bh_ * HM + (size_t)(sc_ * 256 + (ch_) * 64) * 128; \
        _Pragma("unroll") for (int i = 0; i < 8; ++i) { zr[i] = *(const unsigned*)(pF + tb_ + (size_t)(8 * seg + i) * 128 + 2 * cp); if (OUT) qr[i] = *(const unsigned*)(pQ + tb_ + (size_t)(8 * seg + i) * 128 + 2 * cp); } \
        { const u32x4* s_ = (const u32x4*)(pI + tb_ + (size_t)tv * 128 + vc * 16); vr0 = s_[0]; vr1 = s_[1]; } \
        if (OUT) { const u32x4* s_ = (const u32x4*)(pG + tb_ + (size_t)tv * 128 + vc * 16); gn0 = s_[0]; gn1 = s_[1]; } } while (0)
    HG_LOAD(idx, 0);
    float ngv[16];
    if (OUT) {
#pragma unroll
        for (int i = 0; i < 16; ++i) ngv[i] = norm_g[vc * 16 + i];
    }
    f32x4 S[8]; float oml0 = 0.f, oml1 = 0.f, gsum0 = 0.f, gsum1 = 0.f;
#pragma unroll 1
    for (;;) {
        const int sc = idx >> 5, bh = idx & 31, b = bh >> 3, h = bh & 7;
        if (ch == 0) {
            const int c0 = h * 128 + 2 * cp;
            oml0 = 1.0f - 1.0f / (1.0f + __expf(lb_param[1024 + c0] - lb_param[c0])); oml1 = 1.0f - 1.0f / (1.0f + __expf(lb_param[1025 + c0] - lb_param[c0 + 1]));
            gsum0 = 0.f; gsum1 = 0.f;
            if (OUT && sc > 0) { const float* s0 = S0 + (size_t)(bh * 32 + sc) * 16384;
#pragma unroll
                for (int vt = 0; vt < 8; ++vt)
#pragma unroll
                    for (int j = 0; j < 4; ++j) S[vt][j] = s0[(size_t)(16 * wave + fq * 4 + j) * 128 + vt * 16 + fr];
            } else {
#pragma unroll
                for (int vt = 0; vt < 8; ++vt) S[vt] = (f32x4){0.f, 0.f, 0.f, 0.f};
            }
        }
        float kk0[8], kk1[8], lf0[8], lf1[8], q0[8], q1[8];
        {
            float c0 = 0.f, c1 = 0.f;
#pragma unroll
            for (int i = 0; i < 8; ++i) {
                kk0[i] = oml0 * __builtin_amdgcn_rcpf(1.0f + __expf(bflo(zr[i]))); kk1[i] = oml1 * __builtin_amdgcn_rcpf(1.0f + __expf(bfhi(zr[i])));
                c0 += __logf(1.0f - kk0[i]); c1 += __logf(1.0f - kk1[i]); lf0[i] = c0; lf1[i] = c1;
                if (OUT) { q0[i] = bflo(qr[i]) * 0.08838834764831845f; q1[i] = bfhi(qr[i]) * 0.08838834764831845f; }
            }
            *(LAS f32x2*)(seg_s + seg * 128 + 2 * cp) = (f32x2){c0, c1};
        }
        if (OUT) { gc0 = gn0; gc1 = gn1; }
        const u32x4 vcur0 = vr0, vcur1 = vr1;
        __syncthreads();
        { LAS u32x4* d = (LAS u32x4*)(L + HG_VR + tv * 272 + vc * 32); d[0] = vcur0; d[1] = vcur1; }
        { int idx2 = idx, ch2 = ch + 1; if (ch2 == 4) { ch2 = 0; idx2 = idx + X.G; } if (idx2 < ntask) HG_LOAD(idx2, ch2); }
        {
            f32x2 ss[8];
#pragma unroll
            for (int s = 0; s < 8; ++s) ss[s] = *(const LAS f32x2*)(seg_s + s * 128 + 2 * cp);
            float off0 = 0.f, off1 = 0.f;
#pragma unroll
            for (int s = 0; s < 8; ++s) { off0 += (s < seg) ? ss[s].x : 0.f; off1 += (s < seg) ? ss[s].y : 0.f; }
            const float R0 = (ss[0].x + ss[1].x) + (ss[2].x + ss[3].x), R1 = (ss[0].y + ss[1].y) + (ss[2].y + ss[3].y);
            if (!OUT && seg == 0) { gsum0 += R0 + (ss[4].x + ss[5].x) + (ss[6].x + ss[7].x); gsum1 += R1 + (ss[4].y + ss[5].y) + (ss[6].y + ss[7].y); }
#pragma unroll
            for (int i = 0; i < 8; ++i) {
                const float G0 = off0 + lf0[i], G1 = off1 + lf1[i];
                const float ka0 = kk0[i] * __expf(fminf(R0 - G0, 80.0f)), ka1 = kk1[i] * __expf(fminf(R1 - G1, 80.0f));
                *(LAS unsigned*)(L + HG_KA + (8 * seg + i) * 272 + 4 * cp) = pk2(ka0, ka1);
                if (OUT) { const float qa0 = q0[i] * __expf(fminf(G0 - R0, 80.0f)), qa1 = q1[i] * __expf(fminf(G1 - R1, 80.0f));
                           *(LAS unsigned*)(L + HG_QA + (8 * seg + i) * 272 + 4 * cp) = pk2(qa0, qa1); }
            }
        }
        float eR[4], eL[4];
        {
            f32x4 r4 = (f32x4){0.f, 0.f, 0.f, 0.f}, l4 = (f32x4){0.f, 0.f, 0.f, 0.f};
#pragma unroll
            for (int s = 0; s < 4; ++s) { r4 += *(const LAS f32x4*)(seg_s + s * 128 + 16 * wave + 4 * fq); l4 += *(const LAS f32x4*)(seg_s + (s + 4) * 128 + 16 * wave + 4 * fq); }
#pragma unroll
            for (int j = 0; j < 4; ++j) { eR[j] = __expf(fmaxf(r4[j], -80.0f)); eL[j] = __expf(l4[j]); }
        }
#pragma unroll
        for (int vt = 0; vt < 8; ++vt) {
#pragma unroll
            for (int j = 0; j < 4; ++j) S[vt][j] *= eR[j];
            if (OUT) { u32x2 w; w.x = pk2(S[vt][0], S[vt][1]); w.y = pk2(S[vt][2], S[vt][3]);
                       *(LAS u32x2*)(L + HG_SPT + (vt * 16 + fr) * 272 + (16 * wave + 4 * fq) * 2) = w; }
        }
        __syncthreads();
        if (OUT) {
#pragma unroll
            for (int q2 = 0; q2 < 2; ++q2) {
                const int st = 2 * wc + q2;
                f32x4 acc = (f32x4){0.f, 0.f, 0.f, 0.f};
                if (st <= wr) {
#pragma unroll
                    for (int kq = 0; kq < 4; ++kq) {
                        const bf16x8 af = *(const LAS bf16x8*)(L + HG_KA + (st * 16 + fr) * 272 + kq * 64 + fq * 16);
                        const bf16x8 bq = *(const LAS bf16x8*)(L + HG_QA + (wr * 16 + fr) * 272 + kq * 64 + fq * 16);
                        acc = __builtin_amdgcn_mfma_f32_16x16x32_bf16(af, bq, acc, 0, 0, 0);
                    }
                    const int tt = wr * 16 + fr;
#pragma unroll
                    for (int j = 0; j < 4; ++j) { const int s_ = st * 16 + fq * 4 + j; acc[j] = (s_ <= tt) ? acc[j] : 0.f; }
                }
                u32x2 w; w.x = pk2(acc[0], acc[1]); w.y = pk2(acc[2], acc[3]);
                *(LAS u32x2*)(L + HG_AB + (wr * 16 + fr) * 144 + (st * 16 + fq * 4) * 2) = w;
            }
        }
        {
            bf16x8 aK[2];
#pragma unroll
            for (int ks = 0; ks < 2; ++ks) aK[ks] = tr_frag(L + HG_KA, 272, ks, wave, lane);
#pragma unroll
            for (int vt = 0; vt < 8; ++vt) {
#pragma unroll
                for (int ks = 0; ks < 2; ++ks) { const bf16x8 bv = tr_frag(L + HG_VR, 272, ks, vt, lane); S[vt] = __builtin_amdgcn_mfma_f32_16x16x32_bf16(aK[ks], bv, S[vt], 0, 0, 0); }
#pragma unroll
                for (int j = 0; j < 4; ++j) S[vt][j] *= eL[j];
            }
        }
        if (OUT) {
            __syncthreads();
            bf16x8 aA[2], aQ[4];
#pragma unroll
            for (int ks = 0; ks < 2; ++ks) aA[ks] = *(const LAS bf16x8*)(L + HG_AB + (wr * 16 + fr) * 144 + ks * 64 + fq * 16);
#pragma unroll
            for (int kq = 0; kq < 4; ++kq) aQ[kq] = *(const LAS bf16x8*)(L + HG_QA + (wr * 16 + fr) * 272 + kq * 64 + fq * 16);
#pragma unroll
            for (int n = 0; n < 4; ++n) {
                const int vt = wc * 4 + n;
                f32x4 o = (f32x4){0.f, 0.f, 0.f, 0.f};
#pragma unroll
                for (int ks = 0; ks < 2; ++ks) { const bf16x8 bv = tr_frag(L + HG_VR, 272, ks, vt, lane); o = __builtin_amdgcn_mfma_f32_16x16x32_bf16(aA[ks], bv, o, 0, 0, 0); }
#pragma unroll
                for (int kq = 0; kq < 4; ++kq) { const bf16x8 bs = *(const LAS bf16x8*)(L + HG_SPT + (vt * 16 + fr) * 272 + kq * 64 + fq * 16); o = __builtin_amdgcn_mfma_f32_16x16x32_bf16(aQ[kq], bs, o, 0, 0, 0); }
#pragma unroll
                for (int j = 0; j < 4; ++j) *(LAS float*)(L + HG_O + (wr * 16 + fq * 4 + j) * 528 + (vt * 16 + fr) * 4) = o[j];
            }
            __syncthreads();
            {
                f32x4 ov[4]; float ssq = 0.f;
#pragma unroll
                for (int i = 0; i < 4; ++i) { ov[i] = *(const LAS f32x4*)(L + HG_O + tv * 528 + vc * 64 + i * 16); ssq += (ov[i].x * ov[i].x + ov[i].y * ov[i].y) + (ov[i].z * ov[i].z + ov[i].w * ov[i].w); }
                ssq += __shfl_xor(ssq, 1); ssq += __shfl_xor(ssq, 2); ssq += __shfl_xor(ssq, 4);
                const float rstd = rsqrtf(ssq * (1.0f / 128.0f) + EPS);
                const unsigned gw[8] = {gc0.x, gc0.y, gc0.z, gc0.w, gc1.x, gc1.y, gc1.z, gc1.w};
                unsigned ow[8];
#pragma unroll
                for (int i = 0; i < 8; ++i) { const float g0 = bflo(gw[i]), g1 = bfhi(gw[i]);
                    const float y0 = ov[i >> 1][(2 * i) & 3] * rstd * ngv[2 * i] * g0 * __builtin_amdgcn_rcpf(1.0f + __expf(-g0));
                    const float y1 = ov[i >> 1][(2 * i + 1) & 3] * rstd * ngv[2 * i + 1] * g1 * __builtin_amdgcn_rcpf(1.0f + __expf(-g1));
                    ow[i] = pk2(y0, y1); }
                u32x4* d = (u32x4*)(og + (size_t)(b * SEQ + sc * 256 + ch * 64 + tv) * D + h * 128 + vc * 16);
                d[0] = (u32x4){ow[0], ow[1], ow[2], ow[3]}; d[1] = (u32x4){ow[4], ow[5], ow[6], ow[7]};
            }
        }
        if (ch == 3) {
            if (!OUT) {
                float* ds = dS + (size_t)(bh * 32 + sc) * 16384;
#pragma unroll
                for (int vt = 0; vt < 8; ++vt)
#pragma unroll
                    for (int j = 0; j < 4; ++j) ds[(size_t)(16 * wave + fq * 4 + j) * 128 + vt * 16 + fr] = S[vt][j];
                if (seg == 0) *(f32x2*)(Dd + (size_t)(bh * 32 + sc) * 128 + 2 * cp) = (f32x2){__expf(gsum0), __expf(gsum1)};
            }
            idx += X.G; ch = 0; if (idx >= ntask) break;
        } else ++ch;
    }
#undef HG_LOAD
    __syncthreads();
}

__device__ __forceinline__ void ph_hg2(const Ctx& X, const float* dS, const float* Dd, float* S0) {
    for (int idx = X.vcu * 512 + X.tid; idx < 32 * 4096; idx += X.G * 512) {
        const int bh = idx >> 12, e4 = idx & 4095, k = e4 >> 5, v4 = (e4 & 31) * 4;
        f32x4 s = (f32x4){0.f, 0.f, 0.f, 0.f};
#pragma unroll 4
        for (int sc = 0; sc < 31; ++sc) { const float d = Dd[(size_t)(bh * 32 + sc) * 128 + k]; const f32x4 ds = *(const f32x4*)(dS + (size_t)(bh * 32 + sc) * 16384 + k * 128 + v4);
            s = s * d + ds; *(f32x4*)(S0 + (size_t)(bh * 32 + sc + 1) * 16384 + k * 128 + v4) = s; }
    }
}

__device__ __forceinline__ void ph_router_tables(const Ctx& X, const float* g_ffn, const float* mod, const float* w_router, const float* b_router, float* Bp, float* cb) {
    for (int i = X.vcu * 512 + X.tid; i < 4 * 1024 * 32; i += X.G * 512) { const int b = i >> 15, k = (i >> 5) & 1023;
        Bp[i] = g_ffn[k] * (1.0f + mod[(size_t)b * NMOD + 4 * D + k]) * w_router[i & 32767]; }
    const int gw = X.vcu * 8 + X.wave;
    if (gw < 128) { const int b = gw >> 5, e = gw & 31; float a = 0.f;
        for (int k = X.lane; k < 1024; k += 64) a += mod[(size_t)b * NMOD + 3 * D + k] * w_router[k * 32 + e];
        a = wave_sum(a); if (X.lane == 0) cb[gw] = a + b_router[e]; }
}

__device__ __forceinline__ void ph_route(const Ctx& X, const float* x1, const float* g_ffn, const float* mod, const float* Bp, const float* cb,
                                         bf16_t* h2, int* top_e, float* top_w, int* rank, int* hist_g) {
    LAS int* hist = (LAS int*)(X.lds + LDSCTL_OFF + 64);
    const int tid = X.tid, lane = X.lane, c = lane & 15, q = lane >> 4;
    for (int tile = X.vcu; tile < RT_NT; tile += X.G) {
        if (tid < 32) hist[tid] = 0;
        __syncthreads();
        const int tw = tile * RT_TILE + X.wave * 16, b = tw / SEQ;
        const float* xa = x1 + (size_t)(tw + c) * D + 4 * q;
        const float* bp = Bp + ((size_t)b * 1024 + 4 * q) * 32 + c;
        f32x4 acc0 = (f32x4){0.f, 0.f, 0.f, 0.f}, acc1 = acc0; float ss = 0.f;
#pragma unroll 2
        for (int m = 0; m < 64; ++m) {
            const f32x4 a4 = *(const f32x4*)(xa + 16 * m);
            float bv[8];
#pragma unroll
            for (int j = 0; j < 4; ++j) { bv[2 * j] = bp[(size_t)(16 * m + j) * 32]; bv[2 * j + 1] = bp[(size_t)(16 * m + j) * 32 + 16]; }
            ss += (a4.x * a4.x + a4.y * a4.y) + (a4.z * a4.z + a4.w * a4.w);
#pragma unroll
            for (int j = 0; j < 4; ++j) { acc0 = __builtin_amdgcn_mfma_f32_16x16x4f32(a4[j], bv[2 * j], acc0, 0, 0, 0); acc1 = __builtin_amdgcn_mfma_f32_16x16x4f32(a4[j], bv[2 * j + 1], acc1, 0, 0, 0); }
        }
        ss += __shfl_xor(ss, 16); ss += __shfl_xor(ss, 32);
        const float rs = rsqrtf(ss * (1.0f / D) + EPS);
        const float cb0 = cb[b * 32 + c], cb1 = cb[b * 32 + 16 + c];
#pragma unroll
        for (int reg = 0; reg < 4; ++reg) {
            const float rt = __shfl(rs, 4 * q + reg);
            float v0 = acc0[reg] * rt + cb0, v1 = acc1[reg] * rt + cb1;
            float sv[4]; int si[4];
#pragma unroll
            for (int rnd = 0; rnd < 4; ++rnd) {
                float bvv = v0; int bi = c; if (v1 > bvv) { bvv = v1; bi = 16 + c; }
#pragma unroll
                for (int o = 1; o < 16; o <<= 1) { const float ov = __shfl_xor(bvv, o); const int oi = __shfl_xor(bi, o); if (ov > bvv || (ov == bvv && oi < bi)) { bvv = ov; bi = oi; } }
                sv[rnd] = bvv; si[rnd] = bi; if (bi == c) v0 = -INFINITY; if (bi == 16 + c) v1 = -INFINITY;
            }
            const float e1 = __expf(sv[1] - sv[0]), e2 = __expf(sv[2] - sv[0]), e3 = __expf(sv[3] - sv[0]);
            const float inv = 1.0f / (1.0f + e1 + e2 + e3);
            if (c == 0) { const int t = tw + 4 * q + reg;
                const float ww[4] = {inv, e1 * inv, e2 * inv, e3 * inv};
#pragma unroll
                for (int rnd = 0; rnd < 4; ++rnd) { top_e[t * 4 + rnd] = si[rnd]; top_w[t * 4 + rnd] = ww[rnd]; rank[t * 4 + rnd] = atomicAdd((int*)&hist[si[rnd]], 1); }
            }
        }
        const float* sh = mod + (size_t)b * NMOD + 3 * D; const float* sc = mod + (size_t)b * NMOD + 4 * D;
#pragma unroll 1
        for (int i = 0; i < 16; ++i) {
            const float r = __shfl(rs, i);
            const f32x4* xr = (const f32x4*)(x1 + (size_t)(tw + i) * D) + lane;
#pragma unroll
            for (int j = 0; j < 4; ++j) {
                const int col = 4 * (lane + 64 * j);
                const f32x4 gg = *(const f32x4*)(g_ffn + col), s1 = *(const f32x4*)(sc + col), s0 = *(const f32x4*)(sh + col);
                const f32x4 y = xr[64 * j] * r * gg * (s1 + 1.0f) + s0;
                u32x2 w; w.x = pk2(y.x, y.y); w.y = pk2(y.z, y.w);
                *(u32x2*)(h2 + (size_t)(tw + i) * D + col) = w;
            }
        }
        __syncthreads();
        if (tid < 32) hist_g[tile * 32 + tid] = hist[tid];
        __syncthreads();
    }
}

__device__ __forceinline__ void ph_sort(const Ctx& X, const int* hist_g, const int* top_e, const float* top_w, const int* rank, int* row_tok, float* row_w, int* pair_row, int* blk_e) {
    LAS int* s_hist = (LAS int*)X.lds;
    LAS int* s_tot = s_hist + RT_NT * 32; LAS int* s_pre = s_tot + 32; LAS int* s_base = s_pre + 32; LAS int* s_pstart = s_base + 32; LAS int* s_pend = s_pstart + 32;
    const int tid = X.tid;
    for (int i = tid; i < RT_NT * 32; i += 512) s_hist[i] = hist_g[i];
    __syncthreads();
    for (int tile = X.vcu; tile < RT_NT; tile += X.G) {
        if (tid < 32) { int tot = 0, pre = 0; for (int i = 0; i < RT_NT; ++i) { const int c = s_hist[i * 32 + tid]; tot += c; if (i < tile) pre += c; } s_tot[tid] = tot; s_pre[tid] = pre; }
        __syncthreads();
        if (tid == 0) { int acc = 0; for (int e = 0; e < 32; ++e) { const int padded = (s_tot[e] + 255) / 256 * 256; s_pstart[e] = acc; s_base[e] = acc + s_pre[e]; acc += padded; s_pend[e] = acc; } }
        __syncthreads();
        { const int i = tid; const int idx = tile * RT_TILE * 4 + i; const int e = top_e[idx]; const int row = s_base[e] + rank[idx];
          row_tok[row] = idx >> 2; row_w[row] = top_w[idx]; pair_row[idx] = row; }
        if (tile < 32) { const int e = tile; for (int r = s_pstart[e] + s_tot[e] + tid; r < s_pend[e]; r += 512) { row_tok[r] = 0; row_w[r] = 0.f; } }
        if (tile == 32) { for (int blk = tid; blk < NBLK_MAX; blk += 512) { int e = -1; const int r = blk * 256; for (int q = 0; q < 32; ++q) if (r >= s_pstart[q] && r < s_pend[q]) e = q; blk_e[blk] = e; }
                          if (tid == 0) blk_e[NBLK_MAX] = s_pend[31] / 256; }
        __syncthreads();
    }
}

__device__ __forceinline__ void ph_final(const Ctx& X, const float* x1, const bf16_t* y, const int* pair_row, const float* mod, const float* g_final, float* out) {
    const int lane = X.lane;
    for (int t = X.vcu * 8 + X.wave; t < T; t += X.G * 8) {
        const int b = t / SEQ;
        const f32x4* xr = (const f32x4*)(x1 + (size_t)t * D) + lane;
        const float* ga = mod + (size_t)b * NMOD + 5 * D;
        int rows[4];
#pragma unroll
        for (int k = 0; k < 4; ++k) rows[k] = pair_row[t * 4 + k];
        f32x4 v[4]; float ss = 0.f;
#pragma unroll
        for (int j = 0; j < 4; ++j) {
            const int col = 4 * (lane + 64 * j);
            f32x4 m = (f32x4){0.f, 0.f, 0.f, 0.f};
#pragma unroll
            for (int k = 0; k < 4; ++k) { const u32x2 w = *(const u32x2*)(y + (size_t)rows[k] * D + col); m.x += bflo(w.x); m.y += bfhi(w.x); m.z += bflo(w.y); m.w += bfhi(w.y); }
            v[j] = xr[64 * j] + *(const f32x4*)(ga + col) * m;
            ss += (v[j].x * v[j].x + v[j].y * v[j].y) + (v[j].z * v[j].z + v[j].w * v[j].w);
        }
        const float r = rsqrtf(wave_sum(ss) * (1.0f / D) + EPS);
#pragma unroll
        for (int j = 0; j < 4; ++j) { const int col = 4 * (lane + 64 * j); *(f32x4*)(out + (size_t)t * D + col) = v[j] * r * *(const f32x4*)(g_final + col); }
    }
}

constexpr int N_PHASES = 13;
struct Args { const float* in[23]; float* out; unsigned char* ws; int ph_lo, ph_hi; };
__global__ void __launch_bounds__(512, 2) fwd(Args a) {
    extern __shared__ __attribute__((aligned(16))) unsigned char lds_raw[];
    Ctx X; X.lds = (LAS unsigned char*)lds_raw; X.tid = threadIdx.x; X.lane = X.tid & 63; X.wave = __builtin_amdgcn_readfirstlane(X.tid >> 6);
    X.G = gridDim.x; { const int bx = blockIdx.x; X.vcu = (X.G % 8 == 0) ? (bx % 8) * (X.G / 8) + bx / 8 : bx; }
    unsigned char* ws = a.ws;
    for (int u = X.tid; u < (LDS_BYTES - LDSCTL_OFF) / 4; u += 512) ((LAS unsigned*)(X.lds + LDSCTL_OFF))[u] = 0u;
    __syncthreads();
    XcdBarrier bar = xcd_barrier_post((unsigned*)(ws + WS_CTL) + CW_BAR, (volatile LAS unsigned*)(X.lds + LDSCTL_OFF));
    const int lo = a.ph_lo, hi = a.ph_hi;
#define IN(k) (lo <= (k) && (k) < hi)
#define SEAM(k) do { if (IN(k) && IN((k) + 1)) xcd_barrier(bar); } while (0)
    const float* x = a.in[0]; const float* c = a.in[1]; const float* w_ada = a.in[2]; const float* b_ada = a.in[3];
    const float* g_mix = a.in[4]; const float* w_in = a.in[5]; const float* conv_dw = a.in[6]; const float* conv_dwb = a.in[7];
    const float* conv_ln_g = a.in[8]; const float* conv_ln_b = a.in[9]; const float* w_conv_out = a.in[10]; const float* lb_param = a.in[11];
    const float* hgrn_norm_g = a.in[12]; const float* w_hgrn_out = a.in[13]; const float* w_out = a.in[14]; const float* g_ffn = a.in[15];
    const float* w_router = a.in[16]; const float* b_router = a.in[17]; const float* w1 = a.in[18]; const float* b1 = a.in[19];
    const float* w2 = a.in[20]; const float* b2 = a.in[21]; const float* g_final = a.in[22];
    float* mod = (float*)(ws + WS_MOD); float* rt_bp = (float*)(ws + WS_BP); float* rt_cb = (float*)(ws + WS_CB);
    int* hist_g = (int*)(ws + WS_HIST); int* blk_e = (int*)(ws + WS_BLKE); int* top_e = (int*)(ws + WS_TOPE); float* top_w = (float*)(ws + WS_TOPW);
    int* rank = (int*)(ws + WS_RANK); int* pair_row = (int*)(ws + WS_PROW); int* row_tok = (int*)(ws + WS_RTOK); float* row_w = (float*)(ws + WS_RW);
    bf16_t* p = (bf16_t*)(ws + WS_P);
    bf16_t* h = (bf16_t*)(ws + WS_E); float* tmp = (float*)(ws + WS_E);
    float* hg_dS = (float*)(ws + WS_E); float* hg_S0 = (float*)(ws + WS_E + 64 * MiB); float* hg_D = (float*)(ws + WS_HGD);
    bf16_t* uc = (bf16_t*)(ws + WS_D); bf16_t* og = uc + PG; float* x1 = (float*)(ws + WS_D);
    bf16_t* merged = p;
    bf16_t* h2 = p;
    bf16_t* act = p + PG;
    bf16_t* y = act + (size_t)R_PAD * D;
    PG8_LAS unsigned char* ring = (PG8_LAS unsigned char*)lds_raw;

#ifndef REPMASK
#define REPMASK 0
#endif
#ifndef REPN
#define REPN 1
#endif
#define PH(k, ...) do { if (IN(k)) { __VA_ARGS__ if ((REPMASK >> (k)) & 1) { _Pragma("unroll 1") for (int rep_ = 0; rep_ < REPN; ++rep_) { __syncthreads(); __VA_ARGS__ } } } SEAM(k); } while (0)
    PH(0, ph_prologue(X, c, w_ada, b_ada, mod, w_in, w_conv_out, w_hgrn_out, w_out, w1, w2, ws););
    PH(1, ph_norm_mod(X, x, g_mix, mod, 0, D, h); ph_router_tables(X, g_ffn, mod, w_router, b_router, rt_bp, rt_cb););
    PH(2, { pg8::Gemm g{h, (const bf16_t*)(ws + WS_WIN), T, 8 * D, D}; pg8::StaticOrder S; S.init(T, 8 * D, X.G, (int)blockIdx.x);
        pg8::EpiSplitBf16 E{p, PG, 0x3cu, SEQ}; pg8::gemm_phase<pg8::EpiSplitBf16, pg8::StaticOrder, true, true>(ring, g, S, E); });
    PH(3, ph_conv(X, p + 0 * PG, p + 1 * PG, conv_dw, conv_dwb, conv_ln_g, conv_ln_b, uc);
          if ((REPMASK >> 14) & 1) { __syncthreads(); ph_conv(X, p + 0 * PG, p + 1 * PG, conv_dw, conv_dwb, conv_ln_g, conv_ln_b, uc); }
          ph_hgrn<false>(X, 31 * 32, p + 2 * PG, p + 3 * PG, p + 4 * PG, p + 5 * PG, lb_param, nullptr, nullptr, hg_dS, hg_D, nullptr);
          if ((REPMASK >> 15) & 1) { __syncthreads(); ph_hgrn<false>(X, 31 * 32, p + 2 * PG, p + 3 * PG, p + 4 * PG, p + 5 * PG, lb_param, nullptr, nullptr, hg_dS, hg_D, nullptr); });
    PH(4, ph_hg2(X, hg_dS, hg_D, hg_S0););
    PH(5, ph_hgrn<true>(X, 32 * 32, p + 2 * PG, p + 3 * PG, p + 4 * PG, p + 5 * PG, lb_param, hgrn_norm_g, hg_S0, nullptr, nullptr, og););
    PH(6, { pg8::StaticOrder S; S.init(T, D, X.G, (int)blockIdx.x);
        { pg8::Gemm g{uc, (const bf16_t*)(ws + WS_WC), T, D, D}; pg8::EpiGate1 E{p + 6 * PG, tmp}; pg8::gemm_phase<pg8::EpiGate1, pg8::StaticOrder, true, true>(ring, g, S, E); }
        { pg8::Gemm g{og, (const bf16_t*)(ws + WS_WH), T, D, D}; pg8::EpiGate2 E{p + 7 * PG, tmp, merged}; pg8::gemm_phase<pg8::EpiGate2, pg8::StaticOrder, true, true>(ring, g, S, E); } });
    PH(7, { pg8::Gemm g{merged, (const bf16_t*)(ws + WS_WO), T, D, D}; pg8::StaticOrder S; S.init(T, D, X.G, (int)blockIdx.x);
        pg8::EpiRes E{x, mod + 2 * D, x1, NMOD, SEQ}; pg8::gemm_phase<pg8::EpiRes, pg8::StaticOrder, true, true>(ring, g, S, E); });
    PH(8, ph_route(X, x1, g_ffn, mod, rt_bp, rt_cb, h2, top_e, top_w, rank, hist_g););
    PH(9, ph_sort(X, hist_g, top_e, top_w, rank, row_tok, row_w, pair_row, blk_e););
    PH(10, { const int nblk = blk_e[NBLK_MAX]; pg8::Gemm g{h2, (const bf16_t*)(ws + WS_W1), T, 32 * 2048, D}; pg8::MoeOrder S{blk_e, nblk, X.G, (int)blockIdx.x, 3};
        LAS unsigned short* gt = (LAS unsigned short*)(X.lds + LDSCTL_OFF + 256);
        for (int i = 0; i < 23; ++i) { pg8::Unit u; if (!S.next(i, u)) break; if (X.tid < 256) gt[256 * i + X.tid] = (unsigned short)row_tok[u.pm * 256 + X.tid]; }
        __syncthreads();
        pg8::EpiSwiglu E{b1, act}; pg8::gemm_phase<pg8::EpiSwiglu, pg8::MoeOrder, true, true, true>(ring, g, S, E, (const PG8_LAS unsigned short*)gt); });
    PH(11, { const int nblk = blk_e[NBLK_MAX]; pg8::Gemm g{act, (const bf16_t*)(ws + WS_W2), R_PAD, 32 * 1024, DFF}; pg8::MoeOrder S{blk_e, nblk, X.G, (int)blockIdx.x, 2};
        pg8::EpiY E{b2, row_w, y}; pg8::gemm_phase<pg8::EpiY, pg8::MoeOrder, true, true>(ring, g, S, E); });
    PH(12, ph_final(X, x1, y, pair_row, mod, g_final, a.out););
#undef PH
#undef IN
#undef SEAM
}

#ifndef MK_N_LAUNCHES
#define MK_N_LAUNCHES 1
#endif
extern "C" void kernel_launch(void* const* d_in, const int* in_sizes, int n_in, void* d_out, int out_size, void* d_ws, size_t ws_size, hipStream_t stream) {
    static int grid = 0;
    if (grid == 0) {
        if (n_in != 23 || out_size != T * D || ws_size < WS_END) { fprintf(stderr, "kernel_launch: unexpected n_in %d / out_size %d / ws_size %zu (< %zu); nothing launched\n", n_in, out_size, ws_size, (size_t)WS_END); grid = -1; return; }
        int dev = 0, cus = 0, per_cu = 0;
        if (hipGetDevice(&dev) != hipSuccess || hipDeviceGetAttribute(&cus, hipDeviceAttributeMultiprocessorCount, dev) != hipSuccess) { grid = -1; return; }
        if (hipFuncSetAttribute((const void*)fwd, hipFuncAttributeMaxDynamicSharedMemorySize, LDS_BYTES) != hipSuccess) { fprintf(stderr, "kernel_launch: hipFuncSetAttribute failed\n"); grid = -1; return; }
        if (hipOccupancyMaxActiveBlocksPerMultiprocessor(&per_cu, (const void*)fwd, 512, LDS_BYTES) != hipSuccess || per_cu < 1) { fprintf(stderr, "kernel_launch: occupancy query says %d blocks per CU\n", per_cu); }
        (void)hipGetLastError();
        grid = cus;
    }
    if (grid < 0) return;
    if (hipMemsetAsync((char*)d_ws + WS_CTL, 0, CTL_ZERO_BYTES, stream) != hipSuccess) return;
    Args a{};
    for (int i = 0; i < 23; ++i) a.in[i] = (const float*)d_in[i];
    a.out = (float*)d_out; a.ws = (unsigned char*)d_ws;
    if (MK_N_LAUNCHES == 1) { a.ph_lo = 0; a.ph_hi = N_PHASES; hipLaunchKernelGGL(fwd, dim3(grid), dim3(512), LDS_BYTES, stream, a); }
    else for (int ph = 0; ph < N_PHASES; ++ph) { a.ph_lo = ph; a.ph_hi = ph + 1; hipLaunchKernelGGL(fwd, dim3(grid), dim3(512), LDS_BYTES, stream, a); }
}
```

```cpp
#include <hip/hip_runtime.h>
#include <stdint.h>
#include <stdio.h>

#define GAS __attribute__((address_space(1)))
#define LAS __attribute__((address_space(3)))
typedef unsigned short bf16_t;
typedef unsigned u32x4 __attribute__((ext_vector_type(4)));
typedef unsigned u32x2 __attribute__((ext_vector_type(2)));
typedef float f32x4 __attribute__((ext_vector_type(4)));

constexpr int D = 1024, NBATCH = 4, SEQ = 8192, T = NBATCH * SEQ;
constexpr int NE = 32, DFF = 1024;
constexpr int NMOD = 6 * D;
constexpr int NBLK_MAX = 544, R_PAD = NBLK_MAX * 256;
constexpr int RT_TILE = 128, RT_NT = T / RT_TILE;
constexpr float EPS = 1e-6f;

constexpr size_t MiB = 1u << 20;
constexpr size_t WS_CTL = 0, CTL_ZERO_BYTES = 64 * 1024;
constexpr size_t WS_MOD = 1 * MiB;
constexpr size_t WS_CB = WS_MOD + 112 * 1024, WS_BP = WS_MOD + 128 * 1024;
constexpr size_t WS_HIST = 2 * MiB;
constexpr size_t WS_BLKE = WS_HIST + 64 * 1024;
constexpr size_t WS_TOPE = 3 * MiB;
constexpr size_t WS_TOPW = WS_TOPE + 512 * 1024;
constexpr size_t WS_RANK = WS_TOPW + 512 * 1024;
constexpr size_t WS_PROW = WS_RANK + 512 * 1024;
constexpr size_t WS_RTOK = 5 * MiB;
constexpr size_t WS_RW = 6 * MiB;
constexpr size_t WS_HGD = 7 * MiB;
constexpr size_t WS_WT = 8 * MiB;
constexpr size_t WS_WIN = WS_WT, WS_WC = WS_WT + 16 * MiB, WS_WH = WS_WT + 18 * MiB, WS_WO = WS_WT + 20 * MiB, WS_W1 = WS_WT + 22 * MiB, WS_W2 = WS_WT + 150 * MiB;
constexpr size_t WS_P = 224 * MiB;
constexpr size_t WS_E = WS_P + 512 * MiB;
constexpr size_t WS_D = WS_E + 128 * MiB;
constexpr size_t WS_END = WS_D + 128 * MiB;
constexpr size_t PG = (size_t)T * D;
constexpr int CW_BAR = 0;

constexpr int RING_BYTES = 135168, LDSCTL_OFF = RING_BYTES, LDS_BYTES = 147456;

__device__ __forceinline__ unsigned f2bf(float f) { unsigned u = __builtin_bit_cast(unsigned, f); return (u + 0x7fffu + ((u >> 16) & 1u)) >> 16; }
__device__ __forceinline__ unsigned pk2(float lo, float hi) { return f2bf(lo) | (f2bf(hi) << 16); }
__device__ __forceinline__ float bf2f(unsigned b) { return __builtin_bit_cast(float, b << 16); }
__device__ __forceinline__ float bflo(unsigned w) { return __builtin_bit_cast(float, w << 16); }
__device__ __forceinline__ float bfhi(unsigned w) { return __builtin_bit_cast(float, w & 0xffff0000u); }
__device__ __forceinline__ float sigmoidf_(float x) { return 1.0f / (1.0f + __expf(-x)); }
__device__ __forceinline__ float wave_sum(float v) {
#pragma unroll
    for (int o = 1; o < 64; o <<= 1) v += __shfl_xor(v, o);
    return v;
}
__device__ __forceinline__ unsigned cvt4_fp8(float a, float b, float c, float d) {
    a = fminf(fmaxf(a, -448.f), 448.f); b = fminf(fmaxf(b, -448.f), 448.f); c = fminf(fmaxf(c, -448.f), 448.f); d = fminf(fmaxf(d, -448.f), 448.f);
    int w = 0; w = __builtin_amdgcn_cvt_pk_fp8_f32(a, b, w, false); w = __builtin_amdgcn_cvt_pk_fp8_f32(c, d, w, true); return (unsigned)w; }
#define LDS_WAIT() asm volatile("s_waitcnt lgkmcnt(0)" ::: "memory")
#define VM_WAIT() asm volatile("s_waitcnt vmcnt(0)" ::: "memory")

namespace pg8 {
#define PG8_LAS __attribute__((address_space(3)))
typedef unsigned short bf16_t;
typedef short bf16x8 __attribute__((ext_vector_type(8)));
typedef float f32x4 __attribute__((ext_vector_type(4)));
typedef unsigned u32x4 __attribute__((ext_vector_type(4)));
constexpr int BM = 256, BK = 64, HALF = 128, HTB = HALF * BK * 2  , STAGE_BYTES = 8 * HTB, NXCD = 8, WGM = 8;

__host__ __device__ __forceinline__ int lds_byte(int r, int c) { const int st = (r >> 4) * 2 + (c >> 5), rr = r & 15, cc = c & 31, ob = rr * 64 + cc * 2; return st * 1024 + (ob ^ (((ob >> 9) & 1) << 5)); }
__host__ __device__ __forceinline__ void stage_rc(int b, int& R, int& C) { const int st = b / 1024, sb = b % 1024, swz = sb ^ (((sb >> 9) & 1) << 5); R = (st >> 1) * 16 + swz / 64; C = (st & 1) * 32 + (swz % 64) / 2; }
__host__ __device__ __forceinline__ int perm32(int rho) { const int n = rho >> 4, i = rho & 15; return 8 * (i >> 2) + 4 * n + (i & 3); }

struct Unit { int pm, pn; };
struct Gemm { const bf16_t* A; const bf16_t* Bt; int M, N, K; };

struct StaticOrder {
    int nM, nN, nwg, G, c;
    __host__ __device__ void init(int M, int N, int G_, int c_) { nM = M / BM; nN = N / BM; nwg = nM * nN; G = G_; c = c_; }
    __host__ __device__ bool next(int i, Unit& u) const {
        const long L = (long)i * G + c; if (L >= nwg) return false;
        int wgid = (int)L; { const int q = nwg / NXCD, r = nwg % NXCD, xcd = wgid % NXCD, off = wgid / NXCD; wgid = (xcd < r ? xcd * (q + 1) : r * (q + 1) + (xcd - r) * q) + off; }
        const int nig = WGM * nN, gid = wgid / nig, fm = gid * WGM, gsz = (nM - fm) < WGM ? (nM - fm) : WGM;
        u.pm = fm + ((wgid % nig) % gsz); u.pn = (wgid % nig) / gsz; return true;
    }
    __device__ __forceinline__ void a_ready(const Unit&) const {}
    __device__ __forceinline__ void done(const Unit&) const {}
};


struct MoeOrder {
    const int* blk_e; int nblk, G, c, lg;
    __device__ __forceinline__ bool next(int i, Unit& u) const {
        int blk, j;
        if (G == 256) { const int xcd = c & 7, idx = c >> 3, prb = 256 >> lg; blk = i * prb + xcd * (prb >> 3) + (idx >> lg); j = idx & ((1 << lg) - 1); }
        else { const long L = (long)i * G + c; blk = (int)(L >> lg); j = (int)(L & ((1 << lg) - 1)); }
        if (blk >= nblk) return false;
        const int e = blk_e[blk]; u.pm = blk; u.pn = (e << lg) + j; return true;
    }
    __device__ __forceinline__ void a_ready(const Unit&) const {}
    __device__ __forceinline__ void done(const Unit&) const {}
};

__device__ __forceinline__ unsigned cvt_pk_bf16(float lo, float hi) { unsigned r; asm volatile("v_cvt_pk_bf16_f32 %0, %1, %2" : "=v"(r) : "v"(lo), "v"(hi)); return r; }
__device__ __forceinline__ float sigm(float x) { return 1.0f / (1.0f + __expf(-x)); }
__device__ __forceinline__ float blo(unsigned w) { return __builtin_bit_cast(float, w << 16); }
__device__ __forceinline__ float bhi(unsigned w) { return __builtin_bit_cast(float, w & 0xffff0000u); }

struct EpiSplitBf16 {
    static constexpr bool PERM = true, AFTER_DRAIN = false;
    bf16_t* O; size_t split_stride; unsigned hm_mask; int seq;
    __device__ __forceinline__ void operator()(const f32x4 (&acc)[2][2][4][2], const Unit& u, int wr, int wc, int fr, int fq) const {
        const int row0 = u.pm * BM + wr * 64 + fr; const int colt = u.pn * BM; const int t = colt >> 10;
        bf16_t* base = O + (size_t)t * split_stride; const int cg = colt & 1023;
        const bool hm = (hm_mask >> t) & 1u;
        const int bb = (u.pm * BM) / seq;
#pragma unroll
        for (int ai = 0; ai < 2; ++ai)
#pragma unroll
            for (int m = 0; m < 4; ++m) { const int row = row0 + ai * HALF + m * 16;
#pragma unroll
                for (int bj = 0; bj < 2; ++bj) { const f32x4 v0 = acc[ai][bj][m][0], v1 = acc[ai][bj][m][1];
                    u32x4 w; w.x = cvt_pk_bf16(v0[0], v0[1]); w.y = cvt_pk_bf16(v0[2], v0[3]); w.z = cvt_pk_bf16(v1[0], v1[1]); w.w = cvt_pk_bf16(v1[2], v1[3]);
                    const size_t o = hm ? ((size_t)(bb * 8 + (cg >> 7) + bj) * seq + (row - bb * seq)) * 128 + wc * 32 + 8 * fq
                                        : (size_t)row * 1024 + cg + bj * HALF + wc * 32 + 8 * fq;
                    *(u32x4*)(base + o) = w; } }
    }
};
struct EpiGate1 {
    static constexpr bool PERM = true, AFTER_DRAIN = false;
    const bf16_t* gate; float* tmp;
    __device__ __forceinline__ void operator()(const f32x4 (&acc)[2][2][4][2], const Unit& u, int wr, int wc, int fr, int fq) const {
        const int row0 = u.pm * BM + wr * 64 + fr, col0 = u.pn * BM + wc * 32 + 8 * fq;
#pragma unroll
        for (int ai = 0; ai < 2; ++ai)
#pragma unroll
            for (int m = 0; m < 4; ++m) { const size_t o = (size_t)(row0 + ai * HALF + m * 16) * 1024 + col0;
#pragma unroll
                for (int bj = 0; bj < 2; ++bj) { const u32x4 g = *(const u32x4*)(gate + o + bj * HALF); f32x4 v0 = acc[ai][bj][m][0], v1 = acc[ai][bj][m][1];
                    v0[0] *= sigm(blo(g.x)); v0[1] *= sigm(bhi(g.x)); v0[2] *= sigm(blo(g.y)); v0[3] *= sigm(bhi(g.y));
                    v1[0] *= sigm(blo(g.z)); v1[1] *= sigm(bhi(g.z)); v1[2] *= sigm(blo(g.w)); v1[3] *= sigm(bhi(g.w));
                    *(f32x4*)(tmp + o + bj * HALF) = v0; *(f32x4*)(tmp + o + bj * HALF + 4) = v1; } }
    }
};
struct EpiGate2 {
    static constexpr bool PERM = true, AFTER_DRAIN = false;
    const bf16_t* gate; const float* tmp; bf16_t* out;
    __device__ __forceinline__ void operator()(const f32x4 (&acc)[2][2][4][2], const Unit& u, int wr, int wc, int fr, int fq) const {
        const int row0 = u.pm * BM + wr * 64 + fr, col0 = u.pn * BM + wc * 32 + 8 * fq;
#pragma unroll
        for (int ai = 0; ai < 2; ++ai)
#pragma unroll
            for (int m = 0; m < 4; ++m) { const size_t o = (size_t)(row0 + ai * HALF + m * 16) * 1024 + col0;
#pragma unroll
                for (int bj = 0; bj < 2; ++bj) { const u32x4 g = *(const u32x4*)(gate + o + bj * HALF); f32x4 v0 = acc[ai][bj][m][0], v1 = acc[ai][bj][m][1];
                    const f32x4 t0 = *(const f32x4*)(tmp + o + bj * HALF), t1 = *(const f32x4*)(tmp + o + bj * HALF + 4);
                    v0[0] = t0[0] + v0[0] * sigm(blo(g.x)); v0[1] = t0[1] + v0[1] * sigm(bhi(g.x)); v0[2] = t0[2] + v0[2] * sigm(blo(g.y)); v0[3] = t0[3] + v0[3] * sigm(bhi(g.y));
                    v1[0] = t1[0] + v1[0] * sigm(blo(g.z)); v1[1] = t1[1] + v1[1] * sigm(bhi(g.z)); v1[2] = t1[2] + v1[2] * sigm(blo(g.w)); v1[3] = t1[3] + v1[3] * sigm(bhi(g.w));
                    u32x4 w; w.x = cvt_pk_bf16(v0[0], v0[1]); w.y = cvt_pk_bf16(v0[2], v0[3]); w.z = cvt_pk_bf16(v1[0], v1[1]); w.w = cvt_pk_bf16(v1[2], v1[3]);
                    *(u32x4*)(out + o + bj * HALF) = w; } }
    }
};
struct EpiRes {
    static constexpr bool PERM = false, AFTER_DRAIN = false;
    const float* x; const float* ga; float* out; int mod_pitch, seq;
    __device__ __forceinline__ void operator()(const f32x4 (&acc)[2][2][4][2], const Unit& u, int wr, int wc, int fr, int fq) const {
        const int row0 = u.pm * BM + wr * 64 + fr, col0 = u.pn * BM + wc * 32 + 4 * fq;
        const float* gab = ga + (size_t)((u.pm * BM) / seq) * mod_pitch + col0;
        f32x4 gv[2][2];
#pragma unroll
        for (int bj = 0; bj < 2; ++bj)
#pragma unroll
            for (int n = 0; n < 2; ++n) gv[bj][n] = *(const f32x4*)(gab + bj * HALF + n * 16);
#pragma unroll
        for (int ai = 0; ai < 2; ++ai)
#pragma unroll
            for (int m = 0; m < 4; ++m) { const size_t o = (size_t)(row0 + ai * HALF + m * 16) * 1024 + col0;
#pragma unroll
                for (int bj = 0; bj < 2; ++bj)
#pragma unroll
                    for (int n = 0; n < 2; ++n) { const f32x4 xv = *(const f32x4*)(x + o + bj * HALF + n * 16); *(f32x4*)(out + o + bj * HALF + n * 16) = xv + gv[bj][n] * acc[ai][bj][m][n]; } }
    }
};
struct EpiSwiglu {
    static constexpr bool PERM = true, AFTER_DRAIN = false;
    const float* b1; bf16_t* act;
    __device__ __forceinline__ void operator()(const f32x4 (&acc)[2][2][4][2], const Unit& u, int wr, int wc, int fr, int fq) const {
        const int e = u.pn >> 3, j = u.pn & 7; const int row0 = u.pm * BM + wr * 64 + fr, f0 = 128 * j + wc * 32 + 8 * fq;
        const float* be = b1 + (size_t)e * 2048 + f0;
        const f32x4 bg0 = *(const f32x4*)(be), bg1 = *(const f32x4*)(be + 4), bl0 = *(const f32x4*)(be + 1024), bl1 = *(const f32x4*)(be + 1028);
#pragma unroll
        for (int ai = 0; ai < 2; ++ai)
#pragma unroll
            for (int m = 0; m < 4; ++m) {
                f32x4 g0 = acc[ai][0][m][0] + bg0, g1 = acc[ai][0][m][1] + bg1, l0 = acc[ai][1][m][0] + bl0, l1 = acc[ai][1][m][1] + bl1;
                float r[8];
#pragma unroll
                for (int q = 0; q < 4; ++q) { float gl = fminf(g0[q], 7.0f), li = fminf(fmaxf(l0[q], -7.0f), 7.0f); r[q] = gl * sigm(1.702f * gl) * (li + 1.0f);
                                              gl = fminf(g1[q], 7.0f); li = fminf(fmaxf(l1[q], -7.0f), 7.0f); r[4 + q] = gl * sigm(1.702f * gl) * (li + 1.0f); }
                u32x4 w; w.x = cvt_pk_bf16(r[0], r[1]); w.y = cvt_pk_bf16(r[2], r[3]); w.z = cvt_pk_bf16(r[4], r[5]); w.w = cvt_pk_bf16(r[6], r[7]);
                *(u32x4*)(act + (size_t)(row0 + ai * HALF + m * 16) * 1024 + f0) = w; }
    }
};
struct EpiY {
    static constexpr bool PERM = true, AFTER_DRAIN = false;
    const float* b2; const float* rw; bf16_t* y;
    __device__ __forceinline__ void operator()(const f32x4 (&acc)[2][2][4][2], const Unit& u, int wr, int wc, int fr, int fq) const {
        const int e = u.pn >> 2, j = u.pn & 3; const int row0 = u.pm * BM + wr * 64 + fr, col0 = 256 * j + wc * 32 + 8 * fq;
        const float* be = b2 + (size_t)e * 1024 + col0;
        f32x4 bv[2][2];
#pragma unroll
        for (int bj = 0; bj < 2; ++bj)
#pragma unroll
            for (int n = 0; n < 2; ++n) bv[bj][n] = *(const f32x4*)(be + bj * HALF + 4 * n);
#pragma unroll
        for (int ai = 0; ai < 2; ++ai)
#pragma unroll
            for (int m = 0; m < 4; ++m) { const int row = row0 + ai * HALF + m * 16; const float w_ = rw[row];
#pragma unroll
                for (int bj = 0; bj < 2; ++bj) { const f32x4 v0 = (acc[ai][bj][m][0] + bv[bj][0]) * w_, v1 = (acc[ai][bj][m][1] + bv[bj][1]) * w_;
                    u32x4 w; w.x = cvt_pk_bf16(v0[0], v0[1]); w.y = cvt_pk_bf16(v0[2], v0[3]); w.z = cvt_pk_bf16(v1[0], v1[1]); w.w = cvt_pk_bf16(v1[2], v1[3]);
                    *(u32x4*)(y + (size_t)row * 1024 + col0 + bj * HALF) = w; } }
    }
};


struct EpiSwiglu8 {
    static constexpr bool PERM = true, AFTER_DRAIN = false;
    const float* b1; unsigned char* act; float dq;
    __device__ __forceinline__ void operator()(const f32x4 (&acc)[2][2][4][2], const Unit& u, int wr, int wc, int fr, int fq) const {
        const int e = u.pn >> 3, j = u.pn & 7; const int row0 = u.pm * BM + wr * 64 + fr, f0 = 128 * j + wc * 32 + 8 * fq;
        const float* be = b1 + (size_t)e * 2048 + f0;
        const f32x4 bg0 = *(const f32x4*)(be), bg1 = *(const f32x4*)(be + 4), bl0 = *(const f32x4*)(be + 1024), bl1 = *(const f32x4*)(be + 1028);
#pragma unroll
        for (int ai = 0; ai < 2; ++ai)
#pragma unroll
            for (int m = 0; m < 4; ++m) {
                f32x4 g0 = acc[ai][0][m][0] * dq + bg0, g1 = acc[ai][0][m][1] * dq + bg1, l0 = acc[ai][1][m][0] * dq + bl0, l1 = acc[ai][1][m][1] * dq + bl1;
                float r[8];
#pragma unroll
                for (int q = 0; q < 4; ++q) { float gl = fminf(g0[q], 7.0f), li = fminf(fmaxf(l0[q], -7.0f), 7.0f); r[q] = 4.0f * gl * sigm(1.702f * gl) * (li + 1.0f);
                                              gl = fminf(g1[q], 7.0f); li = fminf(fmaxf(l1[q], -7.0f), 7.0f); r[4 + q] = 4.0f * gl * sigm(1.702f * gl) * (li + 1.0f); }
                u32x2 w; w.x = cvt4_fp8(r[0], r[1], r[2], r[3]); w.y = cvt4_fp8(r[4], r[5], r[6], r[7]);
                *(u32x2*)(act + (size_t)(row0 + ai * HALF + m * 16) * 1024 + f0) = w; }
    }
};
struct EpiY8 {
    static constexpr bool PERM = true, AFTER_DRAIN = false;
    const float* b2; const float* rw; bf16_t* y; float dq;
    __device__ __forceinline__ void operator()(const f32x4 (&acc)[2][2][4][2], const Unit& u, int wr, int wc, int fr, int fq) const {
        const int e = u.pn >> 2, j = u.pn & 3; const int row0 = u.pm * BM + wr * 64 + fr, col0 = 256 * j + wc * 32 + 8 * fq;
        const float* be = b2 + (size_t)e * 1024 + col0;
        f32x4 bv[2][2];
#pragma unroll
        for (int bj = 0; bj < 2; ++bj)
#pragma unroll
            for (int n = 0; n < 2; ++n) bv[bj][n] = *(const f32x4*)(be + bj * HALF + 4 * n);
#pragma unroll
        for (int ai = 0; ai < 2; ++ai)
#pragma unroll
            for (int m = 0; m < 4; ++m) { const int row = row0 + ai * HALF + m * 16; const float w_ = rw[row];
#pragma unroll
                for (int bj = 0; bj < 2; ++bj) { const f32x4 v0 = (acc[ai][bj][m][0] * dq + bv[bj][0]) * w_, v1 = (acc[ai][bj][m][1] * dq + bv[bj][1]) * w_;
                    u32x4 w; w.x = cvt_pk_bf16(v0[0], v0[1]); w.y = cvt_pk_bf16(v0[2], v0[3]); w.z = cvt_pk_bf16(v1[0], v1[1]); w.w = cvt_pk_bf16(v1[2], v1[3]);
                    *(u32x4*)(y + (size_t)row * 1024 + col0 + bj * HALF) = w; } }
    }
};

template <class Epi, class Sched, bool ALIGN_EPI = false, bool SP2 = false, bool GATHER = false, bool FP8 = false>
__device__ __forceinline__ void gemm_phase(PG8_LAS unsigned char* lds, const Gemm g, const Sched& S, const Epi& E, const int wave_id, const PG8_LAS unsigned short* gtab = nullptr) {
    typedef int i32x4 __attribute__((ext_vector_type(4))); typedef int i32x8 __attribute__((ext_vector_type(8)));
    static_assert(!GATHER || SP2, "GATHER needs the SP2 loop");
    int lane = (int)__builtin_amdgcn_mbcnt_hi(~0u, __builtin_amdgcn_mbcnt_lo(~0u, 0u)); asm volatile("" : "+v"(lane));
    const int wid = wave_id, tid = wid * 64 + lane, wr = wid >> 2, wc = wid & 3, fr = lane & 15, fq = lane >> 4;
    const int K = g.K, nt = K / BK;
    unsigned voffA[2], voffB[2];
#pragma unroll
    for (int i = 0; i < 2; ++i) { int R, C; stage_rc(tid * 16 + i * 8192, R, C); const int Rb = Epi::PERM ? ((R & ~31) + perm32(R & 31)) : R;
        voffA[i] = (unsigned)(R * K + C) * 2u; voffB[i] = (unsigned)(Rb * K + C) * 2u; }
    unsigned vA0[2] = {0u, 0u}, vA1[2] = {0u, 0u}, xA0[2] = {0u, 0u}, xA1[2] = {0u, 0u};
#define PG8_GLOAD(d0, d1, ui_) do { int tz_ = wid * 64 + (int)__builtin_amdgcn_mbcnt_hi(~0u, __builtin_amdgcn_mbcnt_lo(~0u, 0u)); asm volatile("" : "+v"(tz_)); _Pragma("unroll") for (int _i = 0; _i < 2; ++_i) { int R_, C_; stage_rc(tz_ * 16 + _i * 8192, R_, C_); \
        d0[_i] = (unsigned)gtab[256 * (ui_) + R_] * (unsigned)(K * 2) + (unsigned)C_ * 2u; d1[_i] = (unsigned)gtab[256 * (ui_) + 128 + R_] * (unsigned)(K * 2) + (unsigned)C_ * 2u; } } while (0)
    const unsigned kstep = (unsigned)(BK * 2);
    const unsigned hstep = (unsigned)HALF * K * 2;
    const unsigned tstep = 2 * hstep;
    const __amdgpu_buffer_rsrc_t rsA = __builtin_amdgcn_make_buffer_rsrc((void*)g.A, 0, 0x7fffffff, 0x00020000), rsB = __builtin_amdgcn_make_buffer_rsrc((void*)g.Bt, 0, 0x7fffffff, 0x00020000);
    const unsigned ldsw = (unsigned)wid * 1024u;
    const int aoff = lds_byte(wr * 64 + fr, fq * 8), boff = lds_byte(wc * 32 + fr, fq * 8);
#define PG8_SA(b, h) (((b) * 2 + (h)) * HTB)
#define PG8_SB(b, h) ((4 + (b) * 2 + (h)) * HTB)
#define PG8_STAGE(bufoff, rs, soff, voff) do { _Pragma("unroll") for (int _i = 0; _i < 2; ++_i) \
        __builtin_amdgcn_raw_ptr_buffer_load_lds(rs, (PG8_LAS void*)(lds + (bufoff) + ldsw + _i * 8192), 16, (int)(voff)[_i], (int)(soff), 0, 0); } while (0)
#define PG8_LDA(dst, b, h) do { if constexpr (FP8) { _Pragma("unroll") for (int m = 0; m < 4; ++m) dst##_8[m] = __builtin_shufflevector(*(const PG8_LAS i32x4*)(lds + PG8_SA(b, h) + aoff + m * 2048), *(const PG8_LAS i32x4*)(lds + PG8_SA(b, h) + aoff + m * 2048 + 1024), 0, 1, 2, 3, 4, 5, 6, 7); } \
        else { _Pragma("unroll") for (int m = 0; m < 4; ++m) _Pragma("unroll") for (int k = 0; k < 2; ++k) dst[m][k] = *(const PG8_LAS bf16x8*)(lds + PG8_SA(b, h) + aoff + m * 2048 + k * 1024); } } while (0)
#define PG8_LDB(dst, b, h) do { if constexpr (FP8) { _Pragma("unroll") for (int n = 0; n < 2; ++n) dst##_8[n] = __builtin_shufflevector(*(const PG8_LAS i32x4*)(lds + PG8_SB(b, h) + boff + n * 2048), *(const PG8_LAS i32x4*)(lds + PG8_SB(b, h) + boff + n * 2048 + 1024), 0, 1, 2, 3, 4, 5, 6, 7); } \
        else { _Pragma("unroll") for (int n = 0; n < 2; ++n) _Pragma("unroll") for (int k = 0; k < 2; ++k) dst[n][k] = *(const PG8_LAS bf16x8*)(lds + PG8_SB(b, h) + boff + n * 2048 + k * 1024); } } while (0)
#define PG8_PIN(ai, bj) asm volatile("" : "+v"(acc[ai][bj][0][0]), "+v"(acc[ai][bj][0][1]), "+v"(acc[ai][bj][1][0]), "+v"(acc[ai][bj][1][1]), "+v"(acc[ai][bj][2][0]), "+v"(acc[ai][bj][2][1]), "+v"(acc[ai][bj][3][0]), "+v"(acc[ai][bj][3][1]))
#define PG8_MMA(ai, bj, At, Bt) do { if constexpr (FP8) { __builtin_amdgcn_sched_barrier(0); __builtin_amdgcn_s_setprio(1); _Pragma("unroll") for (int m = 0; m < 4; ++m) _Pragma("unroll") for (int n = 0; n < 2; ++n) \
        acc[ai][bj][m][n] = __builtin_amdgcn_mfma_scale_f32_16x16x128_f8f6f4(Bt##_8[n], At##_8[m], acc[ai][bj][m][n], 0, 0, 0, 0x7f7f7f7f, 0, 0x7f7f7f7f); \
        __builtin_amdgcn_s_setprio(0); PG8_PIN(ai, bj); __builtin_amdgcn_sched_barrier(0); } else { __builtin_amdgcn_s_setprio(1); \
        _Pragma("unroll") for (int m = 0; m < 4; ++m) _Pragma("unroll") for (int n = 0; n < 2; ++n) _Pragma("unroll") for (int k = 0; k < 2; ++k) \
        acc[ai][bj][m][n] = __builtin_amdgcn_mfma_f32_16x16x32_bf16(Bt[n][k], At[m][k], acc[ai][bj][m][n], 0, 0, 0); __builtin_amdgcn_s_setprio(0); } } while (0)
#define PG8_WAIT_V(n) asm volatile("s_waitcnt vmcnt(" #n ")" ::: "memory")
#define PG8_WAIT_L(n) asm volatile("s_waitcnt lgkmcnt(" #n ")" ::: "memory")
#define PG8_BAR __builtin_amdgcn_s_barrier()
#define PG8_SCHED __builtin_amdgcn_sched_barrier(0)
    Unit cur, nxt; int ui = 0;
    if (!S.next(0, cur)) return;
    f32x4 acc[2][2][4][2];
#pragma unroll
    for (int a = 0; a < 2; ++a)
#pragma unroll
        for (int b = 0; b < 2; ++b)
#pragma unroll
            for (int m = 0; m < 4; ++m)
#pragma unroll
                for (int n = 0; n < 2; ++n) acc[a][b][m][n] = (f32x4){0.f, 0.f, 0.f, 0.f};
    bf16x8 At[4][2], B0[2][2], B1[2][2]; i32x8 At_8[4], B0_8[2], B1_8[2];
    unsigned cA = GATHER ? 0u : (unsigned)cur.pm * tstep, cB = (unsigned)cur.pn * tstep;
    S.a_ready(cur);
    if constexpr (GATHER) { PG8_GLOAD(vA0, vA1, 0); xA0[0] = vA0[0]; xA0[1] = vA0[1]; xA1[0] = vA1[0]; xA1[1] = vA1[1]; }
    if constexpr (SP2) {
        PG8_STAGE(PG8_SB(0, 0), rsB, cB, voffB); PG8_STAGE(PG8_SB(0, 1), rsB, cB + hstep, voffB);
        if constexpr (GATHER) { PG8_STAGE(PG8_SA(0, 0), rsA, cA, vA0); PG8_STAGE(PG8_SA(0, 1), rsA, cA, vA1); } else { PG8_STAGE(PG8_SA(0, 0), rsA, cA, voffA); PG8_STAGE(PG8_SA(0, 1), rsA, cA + hstep, voffA); }
        if (wr == 1) PG8_BAR;
        PG8_WAIT_V(2); PG8_BAR;
        PG8_STAGE(PG8_SB(1, 0), rsB, cB + kstep, voffB); if constexpr (GATHER) { PG8_STAGE(PG8_SA(1, 0), rsA, cA + kstep, vA0); } else { PG8_STAGE(PG8_SA(1, 0), rsA, cA + kstep, voffA); } PG8_STAGE(PG8_SB(1, 1), rsB, cB + hstep + kstep, voffB);
        PG8_WAIT_V(6); PG8_BAR;
    } else {
        PG8_STAGE(PG8_SB(0, 0), rsB, cB, voffB); PG8_STAGE(PG8_SA(0, 0), rsA, cA, voffA); PG8_STAGE(PG8_SB(0, 1), rsB, cB + hstep, voffB); PG8_STAGE(PG8_SA(0, 1), rsA, cA + hstep, voffA);
        if (wr == 1) PG8_BAR;
        PG8_WAIT_V(4); PG8_BAR;
        PG8_STAGE(PG8_SB(1, 0), rsB, cB + kstep, voffB); PG8_STAGE(PG8_SA(1, 0), rsA, cA + kstep, voffA); PG8_STAGE(PG8_SB(1, 1), rsB, cB + hstep + kstep, voffB);
        PG8_WAIT_V(6); PG8_BAR;
    }
    for (;;) {
        const bool has_next = S.next(ui + 1, nxt);
        const unsigned nA = GATHER ? cA : (has_next ? (unsigned)nxt.pm * tstep : cA), nB = has_next ? (unsigned)nxt.pn * tstep : cB;
        for (int t = 0; t < nt; t += 2) {
            const bool last = (t == nt - 2);
            const unsigned a1 = cA + (unsigned)(t + 1) * kstep;
            const unsigned a2 = last ? nA : cA + (unsigned)(t + 2) * kstep, b2 = last ? nB : cB + (unsigned)(t + 2) * kstep;
            const unsigned a3 = a2 + kstep, b3 = b2 + kstep;
            if (last && has_next) S.a_ready(nxt);
            if constexpr (GATHER) { if (last && has_next) { PG8_GLOAD(xA0, xA1, ui + 1); } }
            if constexpr (SP2) {
            PG8_LDB(B0, 0, 0); PG8_LDB(B1, 0, 1); PG8_SCHED; PG8_LDA(At, 0, 0); if constexpr (GATHER) { PG8_STAGE(PG8_SA(1, 1), rsA, a1, vA1); } else { PG8_STAGE(PG8_SA(1, 1), rsA, a1 + hstep, voffA); }
            PG8_WAIT_V(8); PG8_WAIT_L(0); PG8_BAR; PG8_MMA(0, 0, At, B0); PG8_MMA(0, 1, At, B1); PG8_BAR; PG8_SCHED;
            PG8_LDA(At, 0, 1); PG8_STAGE(PG8_SB(0, 0), rsB, b2, voffB); PG8_STAGE(PG8_SB(0, 1), rsB, b2 + hstep, voffB); if constexpr (GATHER) { PG8_STAGE(PG8_SA(0, 0), rsA, a2, xA0); } else { PG8_STAGE(PG8_SA(0, 0), rsA, a2, voffA); }
            PG8_WAIT_V(8); PG8_WAIT_L(0); PG8_BAR; PG8_MMA(1, 0, At, B0); PG8_MMA(1, 1, At, B1); PG8_BAR; PG8_SCHED;
            PG8_LDB(B0, 1, 0); PG8_LDB(B1, 1, 1); PG8_SCHED; PG8_LDA(At, 1, 0); if constexpr (GATHER) { PG8_STAGE(PG8_SA(0, 1), rsA, a2, xA1); } else { PG8_STAGE(PG8_SA(0, 1), rsA, a2 + hstep, voffA); }
            PG8_WAIT_V(8); PG8_WAIT_L(0); PG8_BAR; PG8_MMA(0, 0, At, B0); PG8_MMA(0, 1, At, B1); PG8_BAR; PG8_SCHED;
            PG8_LDA(At, 1, 1); PG8_STAGE(PG8_SB(1, 0), rsB, b3, voffB); PG8_STAGE(PG8_SB(1, 1), rsB, b3 + hstep, voffB); if constexpr (GATHER) { PG8_STAGE(PG8_SA(1, 0), rsA, a3, xA0); } else { PG8_STAGE(PG8_SA(1, 0), rsA, a3, voffA); }
            PG8_WAIT_V(8); PG8_WAIT_L(0); PG8_BAR; PG8_MMA(1, 0, At, B0); PG8_MMA(1, 1, At, B1); PG8_BAR; PG8_SCHED;
            } else {
            PG8_LDB(B0, 0, 0); PG8_SCHED; PG8_LDA(At, 0, 0); PG8_STAGE(PG8_SA(1, 1), rsA, a1 + hstep, voffA);
            PG8_WAIT_L(8); PG8_BAR; PG8_WAIT_L(0); PG8_MMA(0, 0, At, B0); PG8_BAR; PG8_SCHED;
            PG8_LDB(B1, 0, 1); PG8_STAGE(PG8_SB(0, 0), rsB, b2, voffB);
            PG8_BAR; PG8_WAIT_L(0); PG8_MMA(0, 1, At, B1); PG8_BAR;
            PG8_LDA(At, 0, 1); PG8_STAGE(PG8_SA(0, 0), rsA, a2, voffA);
            PG8_BAR; PG8_WAIT_L(0); PG8_MMA(1, 0, At, B0); PG8_BAR; PG8_SCHED;
            PG8_STAGE(PG8_SB(0, 1), rsB, b2 + hstep, voffB);
            PG8_WAIT_V(6); PG8_BAR; PG8_MMA(1, 1, At, B1); PG8_BAR;
            PG8_LDB(B0, 1, 0); PG8_SCHED; PG8_LDA(At, 1, 0); PG8_STAGE(PG8_SA(0, 1), rsA, a2 + hstep, voffA);
            PG8_WAIT_L(8); PG8_BAR; PG8_WAIT_L(0); PG8_MMA(0, 0, At, B0); PG8_BAR; PG8_SCHED;
            PG8_LDB(B1, 1, 1); PG8_STAGE(PG8_SB(1, 0), rsB, b3, voffB);
            PG8_BAR; PG8_WAIT_L(0); PG8_MMA(0, 1, At, B1); PG8_BAR;
            PG8_LDA(At, 1, 1); PG8_STAGE(PG8_SA(1, 0), rsA, a3, voffA);
            PG8_BAR; PG8_WAIT_L(0); PG8_MMA(1, 0, At, B0); PG8_BAR; PG8_SCHED;
            PG8_STAGE(PG8_SB(1, 1), rsB, b3 + hstep, voffB);
            PG8_WAIT_V(6); PG8_BAR; PG8_MMA(1, 1, At, B1); PG8_BAR;
            }
        }
        if constexpr (ALIGN_EPI) { if (wr == 0) PG8_BAR; }
        if constexpr (!Epi::AFTER_DRAIN) { int l2_ = (int)__builtin_amdgcn_mbcnt_hi(~0u, __builtin_amdgcn_mbcnt_lo(~0u, 0u)); asm volatile("" : "+v"(l2_));
            E(acc, cur, wr, wc, l2_ & 15, l2_ >> 4); S.done(cur); }
        if (!has_next) break;
#pragma unroll
        for (int a = 0; a < 2; ++a)
#pragma unroll
            for (int b = 0; b < 2; ++b)
#pragma unroll
                for (int m = 0; m < 4; ++m)
#pragma unroll
                    for (int n = 0; n < 2; ++n) acc[a][b][m][n] = (f32x4){0.f, 0.f, 0.f, 0.f};
        cur = nxt; cA = nA; cB = nB; ++ui;
        if constexpr (GATHER) { vA0[0] = xA0[0]; vA0[1] = xA0[1]; vA1[0] = xA1[0]; vA1[1] = xA1[1]; }
        if constexpr (ALIGN_EPI) { if (wr == 1) PG8_BAR; }
    }
    PG8_WAIT_V(0);
    if constexpr (!ALIGN_EPI) { if (wr == 0) PG8_BAR; }
    PG8_BAR;
    if constexpr (Epi::AFTER_DRAIN) { E.fused(acc, cur, wr, wc, fr, fq, lds, wid, lane); S.done(cur); }
#undef PG8_GLOAD
#undef PG8_SA
#undef PG8_SB
#undef PG8_STAGE
#undef PG8_LDA
#undef PG8_LDB
#undef PG8_MMA
#undef PG8_PIN
#undef PG8_WAIT_V
#undef PG8_WAIT_L
#undef PG8_BAR
#undef PG8_SCHED
}
}
#define XB_TMO      128
#define XB_XCNT(j)  (256  + 64 * (j))
#define XB_XSUB(j)  (1280 + 64 * (j))
#define XB_XGEN(j)  (2304 + 64 * (j))
#define XB_TOP      3328
#define XB_TOPGEN   3392
#define XCD_BAR_WORDS 3456
#define XB_SPIN_CAP (1u << 18)

__device__ __forceinline__ unsigned xb_ld(unsigned* p)              { return __hip_atomic_load(p, __ATOMIC_RELAXED, __HIP_MEMORY_SCOPE_AGENT); }
__device__ __forceinline__ unsigned xb_add(unsigned* p, unsigned v) { return __hip_atomic_fetch_add(p, v, __ATOMIC_RELAXED, __HIP_MEMORY_SCOPE_AGENT); }
__device__ __forceinline__ unsigned xb_xcc_id() { return (unsigned)__builtin_amdgcn_s_getreg((3 << 11) | 20) & 0xFu; }
#define XB_SPIN(cond, bar) do { unsigned _sp = 0; while (cond) { __builtin_amdgcn_s_sleep(1); \
    if ((++_sp & 255u) == 0u) { if (xb_ld(&(bar)[XB_TMO])) break; if (_sp > XB_SPIN_CAP) { atomicAdd(&(bar)[XB_TMO], 1u); break; } } } } while (0)

struct XcdBarrier {
    unsigned* bar; unsigned x;
    volatile LAS unsigned* st;
};

__device__ __forceinline__ XcdBarrier xcd_barrier_post(unsigned* bar, volatile LAS unsigned* st, const bool leader  ) {
    XcdBarrier b; b.bar = bar; b.x = xb_xcc_id(); b.st = st;
    if (leader) (void)xb_add(&bar[XB_XCNT(b.x)], 1u);
    return b;
}
__device__ __forceinline__ void xcd_barrier_complete(unsigned* bar, unsigned x, unsigned& nloc, unsigned& nx) {
    const unsigned G = gridDim.x * gridDim.y * gridDim.z;
    unsigned sum, cnt, mine, sp = 0u;
    for (;;) {
        sum = 0u; cnt = 0u; mine = 0u;
#pragma unroll
        for (unsigned j = 0; j < 16; ++j) { const unsigned c = xb_ld(&bar[XB_XCNT(j)]); sum += c; cnt += (c > 0u) ? 1u : 0u; mine = (j == x) ? c : mine; }
        if (sum == G) break;
        __builtin_amdgcn_s_sleep(1);
        if ((++sp & 255u) == 0u) { if (xb_ld(&bar[XB_TMO])) break; if (sp > XB_SPIN_CAP) { atomicAdd(&bar[XB_TMO], 1u); break; } }
    }
    nloc = mine > 0u ? mine : 1u; nx = cnt > 0u ? cnt : 1u;
}

__device__ __forceinline__ void xcd_barrier(const XcdBarrier& b, const bool leader  ) {
    asm volatile("s_waitcnt vmcnt(0)" ::: "memory");
    __syncthreads();
    if (leader) {
        unsigned* bar = b.bar;
        __builtin_amdgcn_s_waitcnt(0);
        unsigned nloc = b.st[0], nx = b.st[1];
        if (nloc == 0u) { xcd_barrier_complete(bar, b.x, nloc, nx); b.st[0] = nloc; b.st[1] = nx; }
        const unsigned old = xb_add(&bar[XB_XSUB(b.x)], 1u);
        const unsigned gen = old / nloc;
        if (old + 1u == (gen + 1u) * nloc) {
            __builtin_amdgcn_fence(__ATOMIC_RELEASE, "agent");
            asm volatile("s_waitcnt vmcnt(0)" ::: "memory");
            const unsigned og = xb_add(&bar[XB_TOP], 1u);
            const unsigned tg = og / nx;
            if (og + 1u == (tg + 1u) * nx) xb_add(&bar[XB_TOPGEN], 1u);
            else XB_SPIN(xb_ld(&bar[XB_TOPGEN]) == tg, bar);
            __builtin_amdgcn_fence(__ATOMIC_ACQUIRE, "agent");
            xb_add(&bar[XB_XGEN(b.x)], 1u);
            asm volatile("s_waitcnt vmcnt(0)" ::: "memory");
        } else {
            XB_SPIN(xb_ld(&bar[XB_XGEN(b.x)]) == gen, bar);
            __builtin_amdgcn_fence(__ATOMIC_ACQUIRE, "agent");
            asm volatile("s_waitcnt vmcnt(0)" ::: "memory");
        }
    }
    __syncthreads();
}

struct Ctx { LAS unsigned char* lds; int tid, lane, wave, vcu, G; };

__device__ __forceinline__ void transpose_item(const float* W, int ldw, int K, bf16_t* dst, int k0, int n0, LAS float* scr, int lane) {
#pragma unroll 8
    for (int i = 0; i < 32; ++i) { const int kk = 2 * i + (lane >> 5); scr[kk * 33 + (lane & 31)] = W[(size_t)(k0 + kk) * ldw + n0 + (lane & 31)]; }
    LDS_WAIT();
    const int c = lane & 7;
#pragma unroll
    for (int j = 0; j < 4; ++j) { const int n = (lane >> 3) + 8 * j; const LAS float* s = scr + (8 * c) * 33 + n;
        u32x4 o; o.x = pk2(s[0 * 33], s[1 * 33]); o.y = pk2(s[2 * 33], s[3 * 33]); o.z = pk2(s[4 * 33], s[5 * 33]); o.w = pk2(s[6 * 33], s[7 * 33]);
        *(u32x4*)(dst + (size_t)n * K + k0 + 8 * c) = o; }
    LDS_WAIT();
}

__device__ __forceinline__ void transpose_item8(const float* W, int ldw, int K, unsigned char* dst, int k0, int n0, float scale, LAS float* scr, int lane) {
#pragma unroll 8
    for (int i = 0; i < 32; ++i) { const int kk = 2 * i + (lane >> 5); scr[kk * 33 + (lane & 31)] = W[(size_t)(k0 + kk) * ldw + n0 + (lane & 31)]; }
    LDS_WAIT();
    const int c = lane & 3;
#pragma unroll
    for (int j = 0; j < 2; ++j) { const int n = (lane >> 2) + 16 * j; const LAS float* s = scr + (16 * c) * 33 + n;
        u32x4 o; o.x = cvt4_fp8(s[0 * 33] * scale, s[1 * 33] * scale, s[2 * 33] * scale, s[3 * 33] * scale); o.y = cvt4_fp8(s[4 * 33] * scale, s[5 * 33] * scale, s[6 * 33] * scale, s[7 * 33] * scale);
        o.z = cvt4_fp8(s[8 * 33] * scale, s[9 * 33] * scale, s[10 * 33] * scale, s[11 * 33] * scale); o.w = cvt4_fp8(s[12 * 33] * scale, s[13 * 33] * scale, s[14 * 33] * scale, s[15 * 33] * scale);
        *(u32x4*)(dst + (size_t)n * K + k0 + 16 * c) = o; }
    LDS_WAIT();
}

__device__ __forceinline__ void ph_prologue(const Ctx& X, const float* c, const float* w_ada, const float* b_ada, float* mod,
                                            const float* w_in, const float* w_conv_out, const float* w_hgrn_out, const float* w_out, const float* w1, const float* w2, unsigned char* ws) {
    if (X.vcu < 48) {
        LAS float* ca = (LAS float*)X.lds;
        LAS float* red = (LAS float*)(X.lds + 16384);
        for (int i = X.tid; i < 4096; i += 512) { const float v = c[i]; ca[i] = v * sigmoidf_(v); }
        __syncthreads();
        const int jj = X.tid & 127, kq = X.tid >> 7, j = X.vcu * 128 + jj;
        float a0 = 0.f, a1 = 0.f, a2 = 0.f, a3 = 0.f;
#pragma unroll 8
        for (int i = kq * 256; i < kq * 256 + 256; ++i) { const float w = w_ada[(size_t)i * NMOD + j]; a0 += ca[i] * w; a1 += ca[1024 + i] * w; a2 += ca[2048 + i] * w; a3 += ca[3072 + i] * w; }
        red[(kq * 4 + 0) * 128 + jj] = a0; red[(kq * 4 + 1) * 128 + jj] = a1; red[(kq * 4 + 2) * 128 + jj] = a2; red[(kq * 4 + 3) * 128 + jj] = a3;
        __syncthreads();
        { const int b = X.tid >> 7; mod[(size_t)b * NMOD + j] = b_ada[j] + red[(0 * 4 + b) * 128 + jj] + red[(1 * 4 + b) * 128 + jj] + red[(2 * 4 + b) * 128 + jj] + red[(3 * 4 + b) * 128 + jj]; }
        __syncthreads();
    }
    LAS float* scr = (LAS float*)(X.lds + X.wave * 16384);
    const int gw = X.vcu * 8 + X.wave, NGW = X.G * 8;
    constexpr int I_IN = 16 * 256, I_SQ = 16 * 32, I_W1 = 32 * 16 * 64, I_W2 = 32 * 16 * 32, NITEMS = I_IN + 3 * I_SQ + I_W1 + I_W2;
    for (int it = gw; it < NITEMS; it += NGW) {
        int r = it;
        if (r < I_IN) { const int kb = r >> 8, nb = r & 255; transpose_item(w_in, 8192, 1024, (bf16_t*)(ws + WS_WIN) + (size_t)(32 * nb) * 1024, 64 * kb, 32 * nb, scr, X.lane); continue; } r -= I_IN;
        if (r < 3 * I_SQ) { const int which = r / I_SQ, q = r % I_SQ, kb = q >> 5, nb = q & 31;
            const float* W = which == 0 ? w_conv_out : (which == 1 ? w_hgrn_out : w_out); bf16_t* WT = (bf16_t*)(ws + (which == 0 ? WS_WC : (which == 1 ? WS_WH : WS_WO)));
            transpose_item(W, 1024, 1024, WT + (size_t)(32 * nb) * 1024, 64 * kb, 32 * nb, scr, X.lane); continue; } r -= 3 * I_SQ;
        if (r < I_W1) { const int e = r >> 10, q = r & 1023, kb = q >> 6, nb = q & 63, n0 = 32 * nb;
            const int rho0 = (n0 < 1024) ? 256 * (n0 >> 7) + (n0 & 127) : 256 * ((n0 - 1024) >> 7) + 128 + ((n0 - 1024) & 127);
            transpose_item8(w1 + (size_t)e * 1024 * 2048, 2048, 1024, (unsigned char*)(ws + WS_W1) + ((size_t)e * 2048 + rho0) * 1024, 64 * kb, n0, 256.0f, scr, X.lane); continue; } r -= I_W1;
        { const int e = r >> 9, q = r & 511, kb = q >> 5, nb = q & 31;
            transpose_item8(w2 + (size_t)e * 1024 * 1024, 1024, 1024, (unsigned char*)(ws + WS_W2) + ((size_t)e * 1024 + 32 * nb) * 1024, 64 * kb, 32 * nb, 256.0f, scr, X.lane); }
    }
}

__device__ __forceinline__ void ph_norm_mod(const Ctx& X, const float* x, const float* g, const float* mod, int sh_off, int sc_off, bf16_t* out) {
    for (int t = X.vcu * 8 + X.wave; t < T; t += X.G * 8) {
        const int b = t / SEQ, lane = X.lane;
        const f32x4* xr = (const f32x4*)(x + (size_t)t * D) + lane;
        f32x4 v[4]; float ss = 0.f;
#pragma unroll
        for (int j = 0; j < 4; ++j) { v[j] = xr[64 * j]; ss += (v[j].x * v[j].x + v[j].y * v[j].y) + (v[j].z * v[j].z + v[j].w * v[j].w); }
        const float r = rsqrtf(wave_sum(ss) * (1.0f / D) + EPS);
        const float* sh = mod + (size_t)b * NMOD + sh_off; const float* sc = mod + (size_t)b * NMOD + sc_off;
#pragma unroll
        for (int j = 0; j < 4; ++j) {
            const int col = 4 * (lane + 64 * j);
            const f32x4 gg = *(const f32x4*)(g + col), s1 = *(const f32x4*)(sc + col), s0 = *(const f32x4*)(sh + col);
            const f32x4 y = v[j] * r * gg * (s1 + 1.0f) + s0;
            u32x2 w; w.x = pk2(y.x, y.y); w.y = pk2(y.z, y.w);
            *(u32x2*)(out + (size_t)t * D + col) = w;
        }
    }
}

__device__ __forceinline__ void ph_conv(const Ctx& X, const bf16_t* pA, const bf16_t* pB, const float* dw, const float* dwb, const float* lng, const float* lnb, bf16_t* uc) {
    LAS float* sm = (LAS float*)X.lds;
    const int tid = X.tid, lane = X.lane, wid = X.wave, c0 = 2 * tid;
    float w[31][2];
#pragma unroll
    for (int j = 0; j < 31; ++j) { w[j][0] = dw[j * 1024 + c0]; w[j][1] = dw[j * 1024 + c0 + 1]; }
    const float bias0 = dwb[c0], bias1 = dwb[c0 + 1];
    for (int task = X.vcu; task < T / 32; task += X.G) {
        const int b = task >> 8, s0 = (task & 255) * 32;
        const bf16_t* qa = pA + (size_t)(b * SEQ) * D + c0; const bf16_t* qb = pB + (size_t)(b * SEQ) * D + c0;
        float u[38][2];
#pragma unroll
        for (int st = 0; st < 4; ++st) {
#pragma unroll
            for (int i = (st == 0 ? 0 : 8 * st + 30); i < 8 * st + 38; ++i) {
                const int s = s0 - 30 + i;
                float u0 = 0.f, u1 = 0.f;
                if (s >= 0) { const unsigned a2 = *(const unsigned*)(qa + (size_t)s * D), b2 = *(const unsigned*)(qb + (size_t)s * D);
                              u0 = bflo(a2) * sigmoidf_(bflo(b2)); u1 = bfhi(a2) * sigmoidf_(bfhi(b2)); }
                u[i % 38][0] = u0; u[i % 38][1] = u1;
            }
#pragma unroll
            for (int t = 8 * st; t < 8 * st + 8; ++t) {
                float a0 = bias0, a1 = bias1;
#pragma unroll
                for (int j = 0; j < 31; ++j) { a0 += w[j][0] * u[(t + j) % 38][0]; a1 += w[j][1] * u[(t + j) % 38][1]; }
                sm[t * 1024 + c0] = a0; sm[t * 1024 + c0 + 1] = a1;
            }
        }
        __syncthreads();
#pragma unroll 1
        for (int i = 0; i < 4; ++i) {
            const int t = wid * 4 + i;
            f32x4 v[4]; float s = 0.f;
#pragma unroll
            for (int j = 0; j < 4; ++j) { v[j] = *(const LAS f32x4*)(sm + t * 1024 + 4 * (lane + 64 * j)); s += (v[j].x + v[j].y) + (v[j].z + v[j].w); }
            const float mean = wave_sum(s) * (1.0f / D); float q = 0.f;
#pragma unroll
            for (int j = 0; j < 4; ++j) { v[j] = v[j] - mean; q += (v[j].x * v[j].x + v[j].y * v[j].y) + (v[j].z * v[j].z + v[j].w * v[j].w); }
            const float rstd = rsqrtf(wave_sum(q) * (1.0f / D) + EPS);
#pragma unroll
            for (int j = 0; j < 4; ++j) {
                const int col = 4 * (lane + 64 * j);
                const f32x4 gg = *(const f32x4*)(lng + col), bb = *(const f32x4*)(lnb + col);
                f32x4 y = v[j] * rstd * gg + bb;
                y.x *= sigmoidf_(y.x); y.y *= sigmoidf_(y.y); y.z *= sigmoidf_(y.z); y.w *= sigmoidf_(y.w);
                u32x2 o; o.x = pk2(y.x, y.y); o.y = pk2(y.z, y.w);
                *(u32x2*)(uc + (size_t)(b * SEQ + s0 + t) * D + col) = o;
            }
        }
        __syncthreads();
    }
}

typedef short bf16x8 __attribute__((ext_vector_type(8)));
typedef short s16x4 __attribute__((ext_vector_type(4)));
typedef float f32x2 __attribute__((ext_vector_type(2)));
constexpr int HG_QA = 0, HG_KA = 17408, HG_VR = 34816, HG_AB = 52224, HG_SPT = 61440, HG_O = 96256, HG_SEG = 130048;
constexpr size_t HM = (size_t)SEQ * 128;
__device__ __forceinline__ bf16x8 tr_frag(LAS unsigned char* base, int rs, int ks, int c16, int lane) {
    const int g = lane >> 4, q = (lane & 15) >> 2, p = lane & 3;
    LAS unsigned char* a = base + (32 * ks + 8 * g + q) * rs + (16 * c16 + 4 * p) * 2;
    const s16x4 lo = __builtin_amdgcn_ds_read_tr16_b64_v4i16((LAS s16x4*)a);
    const s16x4 hi = __builtin_amdgcn_ds_read_tr16_b64_v4i16((LAS s16x4*)(a + 4 * rs));
    return __builtin_shufflevector(lo, hi, 0, 1, 2, 3, 4, 5, 6, 7);
}
template <bool OUT>
__device__ __forceinline__ void ph_hgrn(const Ctx& X, int ntask, const bf16_t* pQ, const bf16_t* pF, const bf16_t* pI, const bf16_t* pG,
                                        const float* lb_param, const float* norm_g, const float* S0, float* dS, float* Dd, bf16_t* og) {
    LAS unsigned char* L = X.lds;
    LAS float* seg_s = (LAS float*)(L + HG_SEG);
    const int tid = X.tid, lane = X.lane, wave = X.wave, fr = lane & 15, fq = lane >> 4, wr = wave >> 1, wc = wave & 1;
    const int cp = tid & 63, seg = wave, tv = tid >> 3, vc = tid & 7;
    int idx = X.vcu; if (idx >= ntask) return;
    int ch = 0;
    unsigned zr[8], qr[8]; u32x4 vr0, vr1, gn0, gn1, gc0, gc1;
#define HG_LOAD(idx_, ch_) do { const int bh_ = (idx_) & 31, sc_ = (idx_) >> 5; const size_t tb_ = (size_t)bh_ * HM + (size_t)(sc_ * 256 + (ch_) * 64) * 128; \
        _Pragma("unroll") for (int i = 0; i < 8; ++i) { zr[i] = *(const unsigned*)(pF + tb_ + (size_t)(8 * seg + i) * 128 + 2 * cp); if (OUT) qr[i] = *(const unsigned*)(pQ + tb_ + (size_t)(8 * seg + i) * 128 + 2 * cp); } \
        { const u32x4* s_ = (const u32x4*)(pI + tb_ + (size_t)tv * 128 + vc * 16); vr0 = s_[0]; vr1 = s_[1]; } \
        if (OUT) { const u32x4* s_ = (const u32x4*)(pG + tb_ + (size_t)tv * 128 + vc * 16); gn0 = s_[0]; gn1 = s_[1]; } } while (0)
    HG_LOAD(idx, 0);
    float ngv[16];
    if (OUT) {
#pragma unroll
        for (int i = 0; i < 16; ++i) ngv[i] = norm_g[vc * 16 + i];
    }
    f32x4 S[8]; float oml0 = 0.f, oml1 = 0.f, gsum0 = 0.f, gsum1 = 0.f;
#pragma unroll 1
    for (;;) {
        const int sc = idx >> 5, bh = idx & 31, b = bh >> 3, h = bh & 7;
        if (ch == 0) {
            const int c0 = h * 128 + 2 * cp;
            oml0 = 1.0f - 1.0f / (1.0f + __expf(lb_param[1024 + c0] - lb_param[c0])); oml1 = 1.0f - 1.0f / (1.0f + __expf(lb_param[1025 + c0] - lb_param[c0 + 1]));
            gsum0 = 0.f; gsum1 = 0.f;
            if (OUT && sc > 0) { const float* s0 = S0 + (size_t)(bh * 32 + sc) * 16384;
#pragma unroll
                for (int vt = 0; vt < 8; ++vt)
#pragma unroll
                    for (int j = 0; j < 4; ++j) S[vt][j] = s0[(size_t)(16 * wave + fq * 4 + j) * 128 + vt * 16 + fr];
            } else {
#pragma unroll
                for (int vt = 0; vt < 8; ++vt) S[vt] = (f32x4){0.f, 0.f, 0.f, 0.f};
            }
        }
        float kk0[8], kk1[8], lf0[8], lf1[8], q0[8], q1[8];
        {
            float c0 = 0.f, c1 = 0.f;
#pragma unroll
            for (int i = 0; i < 8; ++i) {
                kk0[i] = oml0 * __builtin_amdgcn_rcpf(1.0f + __expf(bflo(zr[i]))); kk1[i] = oml1 * __builtin_amdgcn_rcpf(1.0f + __expf(bfhi(zr[i])));
                c0 += __logf(1.0f - kk0[i]); c1 += __logf(1.0f - kk1[i]); lf0[i] = c0; lf1[i] = c1;
                if (OUT) { q0[i] = bflo(qr[i]) * 0.08838834764831845f; q1[i] = bfhi(qr[i]) * 0.08838834764831845f; }
            }
            *(LAS f32x2*)(seg_s + seg * 128 + 2 * cp) = (f32x2){c0, c1};
        }
        if (OUT) { gc0 = gn0; gc1 = gn1; }
        const u32x4 vcur0 = vr0, vcur1 = vr1;
        __syncthreads();
        { LAS u32x4* d = (LAS u32x4*)(L + HG_VR + tv * 272 + vc * 32); d[0] = vcur0; d[1] = vcur1; }
        { int idx2 = idx, ch2 = ch + 1; if (ch2 == 4) { ch2 = 0; idx2 = idx + X.G; } if (idx2 < ntask) HG_LOAD(idx2, ch2); }
        {
            f32x2 ss[8];
#pragma unroll
            for (int s = 0; s < 8; ++s) ss[s] = *(const LAS f32x2*)(seg_s + s * 128 + 2 * cp);
            float off0 = 0.f, off1 = 0.f;
#pragma unroll
            for (int s = 0; s < 8; ++s) { off0 += (s < seg) ? ss[s].x : 0.f; off1 += (s < seg) ? ss[s].y : 0.f; }
            const float R0 = (ss[0].x + ss[1].x) + (ss[2].x + ss[3].x), R1 = (ss[0].y + ss[1].y) + (ss[2].y + ss[3].y);
            if (!OUT && seg == 0) { gsum0 += R0 + (ss[4].x + ss[5].x) + (ss[6].x + ss[7].x); gsum1 += R1 + (ss[4].y + ss[5].y) + (ss[6].y + ss[7].y); }
#pragma unroll
            for (int i = 0; i < 8; ++i) {
                const float G0 = off0 + lf0[i], G1 = off1 + lf1[i];
                const float ka0 = kk0[i] * __expf(fminf(R0 - G0, 80.0f)), ka1 = kk1[i] * __expf(fminf(R1 - G1, 80.0f));
                *(LAS unsigned*)(L + HG_KA + (8 * seg + i) * 272 + 4 * cp) = pk2(ka0, ka1);
                if (OUT) { const float qa0 = q0[i] * __expf(fminf(G0 - R0, 80.0f)), qa1 = q1[i] * __expf(fminf(G1 - R1, 80.0f));
                           *(LAS unsigned*)(L + HG_QA + (8 * seg + i) * 272 + 4 * cp) = pk2(qa0, qa1); }
            }
        }
        float eR[4], eL[4];
        {
            f32x4 r4 = (f32x4){0.f, 0.f, 0.f, 0.f}, l4 = (f32x4){0.f, 0.f, 0.f, 0.f};
#pragma unroll
            for (int s = 0; s < 4; ++s) { r4 += *(const LAS f32x4*)(seg_s + s * 128 + 16 * wave + 4 * fq); l4 += *(const LAS f32x4*)(seg_s + (s + 4) * 128 + 16 * wave + 4 * fq); }
#pragma unroll
            for (int j = 0; j < 4; ++j) { eR[j] = __expf(fmaxf(r4[j], -80.0f)); eL[j] = __expf(l4[j]); }
        }
#pragma unroll
        for (int vt = 0; vt < 8; ++vt) {
#pragma unroll
            for (int j = 0; j < 4; ++j) S[vt][j] *= eR[j];
            if (OUT) { u32x2 w; w.x = pk2(S[vt][0], S[vt][1]); w.y = pk2(S[vt][2], S[vt][3]);
                       *(LAS u32x2*)(L + HG_SPT + (vt * 16 + fr) * 272 + (16 * wave + 4 * fq) * 2) = w; }
        }
        __syncthreads();
        if (OUT) {
#pragma unroll
            for (int q2 = 0; q2 < 2; ++q2) {
                const int st = 2 * wc + q2;
                f32x4 acc = (f32x4){0.f, 0.f, 0.f, 0.f};
                if (st <= wr) {
#pragma unroll
                    for (int kq = 0; kq < 4; ++kq) {
                        const bf16x8 af = *(const LAS bf16x8*)(L + HG_KA + (st * 16 + fr) * 272 + kq * 64 + fq * 16);
                        const bf16x8 bq = *(const LAS bf16x8*)(L + HG_QA + (wr * 16 + fr) * 272 + kq * 64 + fq * 16);
                        acc = __builtin_amdgcn_mfma_f32_16x16x32_bf16(af, bq, acc, 0, 0, 0);
                    }
                    const int tt = wr * 16 + fr;
#pragma unroll
                    for (int j = 0; j < 4; ++j) { const int s_ = st * 16 + fq * 4 + j; acc[j] = (s_ <= tt) ? acc[j] : 0.f; }
                }
                u32x2 w; w.x = pk2(acc[0], acc[1]); w.y = pk2(acc[2], acc[3]);
                *(LAS u32x2*)(L + HG_AB + (wr * 16 + fr) * 144 + (st * 16 + fq * 4) * 2) = w;
            }
        }
        {
            bf16x8 aK[2];
#pragma unroll
            for (int ks = 0; ks < 2; ++ks) aK[ks] = tr_frag(L + HG_KA, 272, ks, wave, lane);
#pragma unroll
            for (int vt = 0; vt < 8; ++vt) {
#pragma unroll
                for (int ks = 0; ks < 2; ++ks) { const bf16x8 bv = tr_frag(L + HG_VR, 272, ks, vt, lane); S[vt] = __builtin_amdgcn_mfma_f32_16x16x32_bf16(aK[ks], bv, S[vt], 0, 0, 0); }
#pragma unroll
                for (int j = 0; j < 4; ++j) S[vt][j] *= eL[j];
            }
        }
        if (OUT) {
            __syncthreads();
            bf16x8 aA[2], aQ[4];
#pragma unroll
            for (int ks = 0; ks < 2; ++ks) aA[ks] = *(const LAS bf16x8*)(L + HG_AB + (wr * 16 + fr) * 144 + ks * 64 + fq * 16);
#pragma unroll
            for (int kq = 0; kq < 4; ++kq) aQ[kq] = *(const LAS bf16x8*)(L + HG_QA + (wr * 16 + fr) * 272 + kq * 64 + fq * 16);
#pragma unroll
            for (int n = 0; n < 4; ++n) {
                const int vt = wc * 4 + n;
                f32x4 o = (f32x4){0.f, 0.f, 0.f, 0.f};
#pragma unroll
                for (int ks = 0; ks < 2; ++ks) { const bf16x8 bv = tr_frag(L + HG_VR, 272, ks, vt, lane); o = __builtin_amdgcn_mfma_f32_16x16x32_bf16(aA[ks], bv, o, 0, 0, 0); }
#pragma unroll
                for (int kq = 0; kq < 4; ++kq) { const bf16x8 bs = *(const LAS bf16x8*)(L + HG_SPT + (vt * 16 + fr) * 272 + kq * 64 + fq * 16); o = __builtin_amdgcn_mfma_f32_16x16x32_bf16(aQ[kq], bs, o, 0, 0, 0); }
#pragma unroll
                for (int j = 0; j < 4; ++j) *(LAS float*)(L + HG_O + (wr * 16 + fq * 4 + j) * 528 + (vt * 16 + fr) * 4) = o[j];
            }
            __syncthreads();
            {
                f32x4 ov[4]; float ssq = 0.f;
#pragma unroll
                for (int i = 0; i < 4; ++i) { ov[i] = *(const LAS f32x4*)(L + HG_O + tv * 528 + vc * 64 + i * 16); ssq += (ov[i].x * ov[i].x + ov[i].y * ov[i].y) + (ov[i].z * ov[i].z + ov[i].w * ov[i].w); }
                ssq += __shfl_xor(ssq, 1); ssq += __shfl_xor(ssq, 2); ssq += __shfl_xor(ssq, 4);
                const float rstd = rsqrtf(ssq * (1.0f / 128.0f) + EPS);
                const unsigned gw[8] = {gc0.x, gc0.y, gc0.z, gc0.w, gc1.x, gc1.y, gc1.z, gc1.w};
                unsigned ow[8];
#pragma unroll
                for (int i = 0; i < 8; ++i) { const float g0 = bflo(gw[i]), g1 = bfhi(gw[i]);
                    const float y0 = ov[i >> 1][(2 * i) & 3] * rstd * ngv[2 * i] * g0 * __builtin_amdgcn_rcpf(1.0f + __expf(-g0));
                    const float y1 = ov[i >> 1][(2 * i + 1) & 3] * rstd * ngv[2 * i + 1] * g1 * __builtin_amdgcn_rcpf(1.0f + __expf(-g1));
                    ow[i] = pk2(y0, y1); }
                u32x4* d = (u32x4*)(og + (size_t)(b * SEQ + sc * 256 + ch * 64 + tv) * D + h * 128 + vc * 16);
                d[0] = (u32x4){ow[0], ow[1], ow[2], ow[3]}; d[1] = (u32x4){ow[4], ow[5], ow[6], ow[7]};
            }
        }
        if (ch == 3) {
            if (!OUT) {
                float* ds = dS + (size_t)(bh * 32 + sc) * 16384;
#pragma unroll
                for (int vt = 0; vt < 8; ++vt)
#pragma unroll
                    for (int j = 0; j < 4; ++j) ds[(size_t)(16 * wave + fq * 4 + j) * 128 + vt * 16 + fr] = S[vt][j];
                if (seg == 0) *(f32x2*)(Dd + (size_t)(bh * 32 + sc) * 128 + 2 * cp) = (f32x2){__expf(gsum0), __expf(gsum1)};
            }
            idx += X.G; ch = 0; if (idx >= ntask) break;
        } else ++ch;
    }
#undef HG_LOAD
    __syncthreads();
}

__device__ __forceinline__ void ph_hg2(const Ctx& X, const float* dS, const float* Dd, float* S0) {
    for (int idx = X.vcu * 512 + X.tid; idx < 32 * 4096; idx += X.G * 512) {
        const int bh = idx >> 12, e4 = idx & 4095, k = e4 >> 5, v4 = (e4 & 31) * 4;
        f32x4 s = (f32x4){0.f, 0.f, 0.f, 0.f};
#pragma unroll 4
        for (int sc = 0; sc < 31; ++sc) { const float d = Dd[(size_t)(bh * 32 + sc) * 128 + k]; const f32x4 ds = *(const f32x4*)(dS + (size_t)(bh * 32 + sc) * 16384 + k * 128 + v4);
            s = s * d + ds; *(f32x4*)(S0 + (size_t)(bh * 32 + sc + 1) * 16384 + k * 128 + v4) = s; }
    }
}

__device__ __forceinline__ void ph_router_tables(const Ctx& X, const float* g_ffn, const float* mod, const float* w_router, const float* b_router, float* Bp, float* cb) {
    for (int i = X.vcu * 512 + X.tid; i < 4 * 1024 * 32; i += X.G * 512) { const int b = i >> 15, k = (i >> 5) & 1023;
        Bp[i] = g_ffn[k] * (1.0f + mod[(size_t)b * NMOD + 4 * D + k]) * w_router[i & 32767]; }
    const int gw = X.vcu * 8 + X.wave;
    if (gw < 128) { const int b = gw >> 5, e = gw & 31; float a = 0.f;
        for (int k = X.lane; k < 1024; k += 64) a += mod[(size_t)b * NMOD + 3 * D + k] * w_router[k * 32 + e];
        a = wave_sum(a); if (X.lane == 0) cb[gw] = a + b_router[e]; }
}

__device__ __forceinline__ void ph_route(const Ctx& X, const float* x1, const float* g_ffn, const float* mod, const float* Bp, const float* cb,
                                         unsigned char* h2, int* top_e, float* top_w, int* rank, int* hist_g) {
    LAS int* hist = (LAS int*)(X.lds + LDSCTL_OFF + 64);
    const int tid = X.tid, lane = X.lane, c = lane & 15, q = lane >> 4;
    for (int tile = X.vcu; tile < RT_NT; tile += X.G) {
        if (tid < 32) hist[tid] = 0;
        __syncthreads();
        const int tw = tile * RT_TILE + X.wave * 16, b = tw / SEQ;
        const float* xa = x1 + (size_t)(tw + c) * D + 4 * q;
        const float* bp = Bp + ((size_t)b * 1024 + 4 * q) * 32 + c;
        f32x4 acc0 = (f32x4){0.f, 0.f, 0.f, 0.f}, acc1 = acc0; float ss = 0.f;
#pragma unroll 2
        for (int m = 0; m < 64; ++m) {
            const f32x4 a4 = *(const f32x4*)(xa + 16 * m);
            float bv[8];
#pragma unroll
            for (int j = 0; j < 4; ++j) { bv[2 * j] = bp[(size_t)(16 * m + j) * 32]; bv[2 * j + 1] = bp[(size_t)(16 * m + j) * 32 + 16]; }
            ss += (a4.x * a4.x + a4.y * a4.y) + (a4.z * a4.z + a4.w * a4.w);
#pragma unroll
            for (int j = 0; j < 4; ++j) { acc0 = __builtin_amdgcn_mfma_f32_16x16x4f32(a4[j], bv[2 * j], acc0, 0, 0, 0); acc1 = __builtin_amdgcn_mfma_f32_16x16x4f32(a4[j], bv[2 * j + 1], acc1, 0, 0, 0); }
        }
        ss += __shfl_xor(ss, 16); ss += __shfl_xor(ss, 32);
        const float rs = rsqrtf(ss * (1.0f / D) + EPS);
        const float cb0 = cb[b * 32 + c], cb1 = cb[b * 32 + 16 + c];
#pragma unroll
        for (int reg = 0; reg < 4; ++reg) {
            const float rt = __shfl(rs, 4 * q + reg);
            float v0 = acc0[reg] * rt + cb0, v1 = acc1[reg] * rt + cb1;
            float sv[4]; int si[4];
#pragma unroll
            for (int rnd = 0; rnd < 4; ++rnd) {
                float bvv = v0; int bi = c; if (v1 > bvv) { bvv = v1; bi = 16 + c; }
#pragma unroll
                for (int o = 1; o < 16; o <<= 1) { const float ov = __shfl_xor(bvv, o); const int oi = __shfl_xor(bi, o); if (ov > bvv || (ov == bvv && oi < bi)) { bvv = ov; bi = oi; } }
                sv[rnd] = bvv; si[rnd] = bi; if (bi == c) v0 = -INFINITY; if (bi == 16 + c) v1 = -INFINITY;
            }
            const float e1 = __expf(sv[1] - sv[0]), e2 = __expf(sv[2] - sv[0]), e3 = __expf(sv[3] - sv[0]);
            const float inv = 1.0f / (1.0f + e1 + e2 + e3);
            if (c == 0) { const int t = tw + 4 * q + reg;
                const float ww[4] = {inv, e1 * inv, e2 * inv, e3 * inv};
#pragma unroll
                for (int rnd = 0; rnd < 4; ++rnd) { top_e[t * 4 + rnd] = si[rnd]; top_w[t * 4 + rnd] = ww[rnd]; rank[t * 4 + rnd] = atomicAdd((int*)&hist[si[rnd]], 1); }
            }
        }
        const float* sh = mod + (size_t)b * NMOD + 3 * D; const float* sc = mod + (size_t)b * NMOD + 4 * D;
#pragma unroll 1
        for (int i = 0; i < 16; ++i) {
            const float r = __shfl(rs, i);
            const f32x4* xr = (const f32x4*)(x1 + (size_t)(tw + i) * D) + lane;
#pragma unroll
            for (int j = 0; j < 4; ++j) {
                const int col = 4 * (lane + 64 * j);
                const f32x4 gg = *(const f32x4*)(g_ffn + col), s1 = *(const f32x4*)(sc + col), s0 = *(const f32x4*)(sh + col);
                const f32x4 y = (xr[64 * j] * r * gg * (s1 + 1.0f) + s0) * 16.0f;
                *(unsigned*)(h2 + (size_t)(tw + i) * D + col) = cvt4_fp8(y.x, y.y, y.z, y.w);
            }
        }
        __syncthreads();
        if (tid < 32) hist_g[tile * 32 + tid] = hist[tid];
        __syncthreads();
    }
}

__device__ __forceinline__ void ph_sort(const Ctx& X, const int* hist_g, const int* top_e, const float* top_w, const int* rank, int* row_tok, float* row_w, int* pair_row, int* blk_e) {
    LAS int* s_hist = (LAS int*)X.lds;
    LAS int* s_tot = s_hist + RT_NT * 32; LAS int* s_pre = s_tot + 32; LAS int* s_base = s_pre + 32; LAS int* s_pstart = s_base + 32; LAS int* s_pend = s_pstart + 32;
    const int tid = X.tid;
    for (int i = tid; i < RT_NT * 32; i += 512) s_hist[i] = hist_g[i];
    __syncthreads();
    for (int tile = X.vcu; tile < RT_NT; tile += X.G) {
        if (tid < 32) { int tot = 0, pre = 0; for (int i = 0; i < RT_NT; ++i) { const int c = s_hist[i * 32 + tid]; tot += c; if (i < tile) pre += c; } s_tot[tid] = tot; s_pre[tid] = pre; }
        __syncthreads();
        if (tid == 0) { int acc = 0; for (int e = 0; e < 32; ++e) { const int padded = (s_tot[e] + 255) / 256 * 256; s_pstart[e] = acc; s_base[e] = acc + s_pre[e]; acc += padded; s_pend[e] = acc; } }
        __syncthreads();
        { const int i = tid; const int idx = tile * RT_TILE * 4 + i; const int e = top_e[idx]; const int row = s_base[e] + rank[idx];
          row_tok[row] = idx >> 2; row_w[row] = top_w[idx]; pair_row[idx] = row; }
        if (tile < 32) { const int e = tile; for (int r = s_pstart[e] + s_tot[e] + tid; r < s_pend[e]; r += 512) { row_tok[r] = 0; row_w[r] = 0.f; } }
        if (tile == 32) { for (int blk = tid; blk < NBLK_MAX; blk += 512) { int e = -1; const int r = blk * 256; for (int q = 0; q < 32; ++q) if (r >= s_pstart[q] && r < s_pend[q]) e = q; blk_e[blk] = e; }
                          if (tid == 0) blk_e[NBLK_MAX] = s_pend[31] / 256; }
        __syncthreads();
    }
}

__device__ __forceinline__ void ph_final(const Ctx& X, const float* x1, const bf16_t* y, const int* pair_row, const float* mod, const float* g_final, float* out) {
    const int lane = X.lane;
    for (int t = X.vcu * 8 + X.wave; t < T; t += X.G * 8) {
        const int b = t / SEQ;
        const f32x4* xr = (const f32x4*)(x1 + (size_t)t * D) + lane;
        const float* ga = mod + (size_t)b * NMOD + 5 * D;
        int rows[4];
#pragma unroll
        for (int k = 0; k < 4; ++k) rows[k] = pair_row[t * 4 + k];
        f32x4 v[4]; float ss = 0.f;
#pragma unroll
        for (int j = 0; j < 4; ++j) {
            const int col = 4 * (lane + 64 * j);
            f32x4 m = (f32x4){0.f, 0.f, 0.f, 0.f};
#pragma unroll
            for (int k = 0; k < 4; ++k) { const u32x2 w = *(const u32x2*)(y + (size_t)rows[k] * D + col); m.x += bflo(w.x); m.y += bfhi(w.x); m.z += bflo(w.y); m.w += bfhi(w.y); }
            v[j] = xr[64 * j] + *(const f32x4*)(ga + col) * m;
            ss += (v[j].x * v[j].x + v[j].y * v[j].y) + (v[j].z * v[j].z + v[j].w * v[j].w);
        }
        const float r = rsqrtf(wave_sum(ss) * (1.0f / D) + EPS);
#pragma unroll
        for (int j = 0; j < 4; ++j) { const int col = 4 * (lane + 64 * j); *(f32x4*)(out + (size_t)t * D + col) = v[j] * r * *(const f32x4*)(g_final + col); }
    }
}

constexpr int N_PHASES = 13;
struct Args { const float* in[23]; float* out; unsigned char* ws; int ph_lo, ph_hi; };
__global__ void __launch_bounds__(512, 2) fwd(Args a) {
    extern __shared__ __attribute__((aligned(16))) unsigned char lds_raw[];
    Ctx X; X.lds = (LAS unsigned char*)lds_raw; X.tid = threadIdx.x; X.lane = X.tid & 63; X.wave = __builtin_amdgcn_readfirstlane(X.tid >> 6);
    X.G = gridDim.x; { const int bx = blockIdx.x; X.vcu = (X.G % 8 == 0) ? (bx % 8) * (X.G / 8) + bx / 8 : bx; }
    unsigned char* ws = a.ws;
    for (int u = X.tid; u < (LDS_BYTES - LDSCTL_OFF) / 4; u += 512) ((LAS unsigned*)(X.lds + LDSCTL_OFF))[u] = 0u;
    __syncthreads();
    XcdBarrier bar = xcd_barrier_post((unsigned*)(ws + WS_CTL) + CW_BAR, (volatile LAS unsigned*)(X.lds + LDSCTL_OFF), X.tid == 0);
    const int lo = a.ph_lo, hi = a.ph_hi;
#define IN(k) (lo <= (k) && (k) < hi)
#define SEAM(k) do { if (IN(k) && IN((k) + 1)) xcd_barrier(bar, X.wave == 0 && (int)__builtin_amdgcn_mbcnt_hi(~0u, __builtin_amdgcn_mbcnt_lo(~0u, 0u)) == 0); } while (0)
    const float* x = a.in[0]; const float* c = a.in[1]; const float* w_ada = a.in[2]; const float* b_ada = a.in[3];
    const float* g_mix = a.in[4]; const float* w_in = a.in[5]; const float* conv_dw = a.in[6]; const float* conv_dwb = a.in[7];
    const float* conv_ln_g = a.in[8]; const float* conv_ln_b = a.in[9]; const float* w_conv_out = a.in[10]; const float* lb_param = a.in[11];
    const float* hgrn_norm_g = a.in[12]; const float* w_hgrn_out = a.in[13]; const float* w_out = a.in[14]; const float* g_ffn = a.in[15];
    const float* w_router = a.in[16]; const float* b_router = a.in[17]; const float* w1 = a.in[18]; const float* b1 = a.in[19];
    const float* w2 = a.in[20]; const float* b2 = a.in[21]; const float* g_final = a.in[22];
    float* mod = (float*)(ws + WS_MOD); float* rt_bp = (float*)(ws + WS_BP); float* rt_cb = (float*)(ws + WS_CB);
    int* hist_g = (int*)(ws + WS_HIST); int* blk_e = (int*)(ws + WS_BLKE); int* top_e = (int*)(ws + WS_TOPE); float* top_w = (float*)(ws + WS_TOPW);
    int* rank = (int*)(ws + WS_RANK); int* pair_row = (int*)(ws + WS_PROW); int* row_tok = (int*)(ws + WS_RTOK); float* row_w = (float*)(ws + WS_RW);
    bf16_t* p = (bf16_t*)(ws + WS_P);
    bf16_t* h = (bf16_t*)(ws + WS_E); float* tmp = (float*)(ws + WS_E);
    float* hg_dS = (float*)(ws + WS_E); float* hg_S0 = (float*)(ws + WS_E + 64 * MiB); float* hg_D = (float*)(ws + WS_HGD);
    bf16_t* uc = (bf16_t*)(ws + WS_D); bf16_t* og = uc + PG; float* x1 = (float*)(ws + WS_D);
    bf16_t* merged = p;
    unsigned char* h2 = (unsigned char*)p;
    unsigned char* act = (unsigned char*)(p + PG);
    bf16_t* y = p + PG + (size_t)R_PAD * D / 2;
    PG8_LAS unsigned char* ring = (PG8_LAS unsigned char*)lds_raw;

#ifndef REPMASK
#define REPMASK 0
#endif
#ifndef REPN
#define REPN 1
#endif
#define PH(k, ...) do { if (IN(k)) { { int ln_ = (int)__builtin_amdgcn_mbcnt_hi(~0u, __builtin_amdgcn_mbcnt_lo(~0u, 0u)); asm volatile("" : "+v"(ln_)); X.lane = ln_; X.tid = X.wave * 64 + ln_; } __VA_ARGS__ if ((REPMASK >> (k)) & 1) { _Pragma("unroll 1") for (int rep_ = 0; rep_ < REPN; ++rep_) { __syncthreads(); __VA_ARGS__ } } } SEAM(k); } while (0)
    PH(0, ph_prologue(X, c, w_ada, b_ada, mod, w_in, w_conv_out, w_hgrn_out, w_out, w1, w2, ws););
    PH(1, ph_norm_mod(X, x, g_mix, mod, 0, D, h); ph_router_tables(X, g_ffn, mod, w_router, b_router, rt_bp, rt_cb););
    PH(2, { pg8::Gemm g{h, (const bf16_t*)(ws + WS_WIN), T, 8 * D, D}; pg8::StaticOrder S; S.init(T, 8 * D, X.G, (int)blockIdx.x);
        pg8::EpiSplitBf16 E{p, PG, 0x3cu, SEQ}; pg8::gemm_phase<pg8::EpiSplitBf16, pg8::StaticOrder, true, true>(ring, g, S, E, X.wave); });
    PH(3, ph_conv(X, p + 0 * PG, p + 1 * PG, conv_dw, conv_dwb, conv_ln_g, conv_ln_b, uc);
          if ((REPMASK >> 14) & 1) { __syncthreads(); ph_conv(X, p + 0 * PG, p + 1 * PG, conv_dw, conv_dwb, conv_ln_g, conv_ln_b, uc); }
          ph_hgrn<false>(X, 31 * 32, p + 2 * PG, p + 3 * PG, p + 4 * PG, p + 5 * PG, lb_param, nullptr, nullptr, hg_dS, hg_D, nullptr);
          if ((REPMASK >> 15) & 1) { __syncthreads(); ph_hgrn<false>(X, 31 * 32, p + 2 * PG, p + 3 * PG, p + 4 * PG, p + 5 * PG, lb_param, nullptr, nullptr, hg_dS, hg_D, nullptr); });
    PH(4, ph_hg2(X, hg_dS, hg_D, hg_S0););
    PH(5, ph_hgrn<true>(X, 32 * 32, p + 2 * PG, p + 3 * PG, p + 4 * PG, p + 5 * PG, lb_param, hgrn_norm_g, hg_S0, nullptr, nullptr, og););
    PH(6, { pg8::StaticOrder S; S.init(T, D, X.G, (int)blockIdx.x);
        { pg8::Gemm g{uc, (const bf16_t*)(ws + WS_WC), T, D, D}; pg8::EpiGate1 E{p + 6 * PG, tmp}; pg8::gemm_phase<pg8::EpiGate1, pg8::StaticOrder, true, true>(ring, g, S, E, X.wave); }
        { pg8::Gemm g{og, (const bf16_t*)(ws + WS_WH), T, D, D}; pg8::EpiGate2 E{p + 7 * PG, tmp, merged}; pg8::gemm_phase<pg8::EpiGate2, pg8::StaticOrder, true, true>(ring, g, S, E, X.wave); } });
    PH(7, { pg8::Gemm g{merged, (const bf16_t*)(ws + WS_WO), T, D, D}; pg8::StaticOrder S; S.init(T, D, X.G, (int)blockIdx.x);
        pg8::EpiRes E{x, mod + 2 * D, x1, NMOD, SEQ}; pg8::gemm_phase<pg8::EpiRes, pg8::StaticOrder, true, true>(ring, g, S, E, X.wave); });
    PH(8, ph_route(X, x1, g_ffn, mod, rt_bp, rt_cb, h2, top_e, top_w, rank, hist_g););
    PH(9, ph_sort(X, hist_g, top_e, top_w, rank, row_tok, row_w, pair_row, blk_e););
    PH(10, { const int nblk = blk_e[NBLK_MAX]; pg8::Gemm g{(const bf16_t*)h2, (const bf16_t*)(ws + WS_W1), T, 32 * 2048, D / 2}; pg8::MoeOrder S{blk_e, nblk, X.G, (int)blockIdx.x, 3};
        LAS unsigned short* gt = (LAS unsigned short*)(X.lds + LDSCTL_OFF + 256);
        _Pragma("unroll 1") for (int i = 0; i < 23; ++i) { pg8::Unit u; if (!S.next(i, u)) break; if (X.tid < 256) gt[256 * i + X.tid] = (unsigned short)row_tok[u.pm * 256 + X.tid]; }
        __syncthreads();
        pg8::EpiSwiglu8 E{b1, act, 1.0f / 4096.0f}; pg8::gemm_phase<pg8::EpiSwiglu8, pg8::MoeOrder, true, true, true, true>(ring, g, S, E, X.wave, (const PG8_LAS unsigned short*)gt); });
    PH(11, { const int nblk = blk_e[NBLK_MAX]; pg8::Gemm g{(const bf16_t*)act, (const bf16_t*)(ws + WS_W2), R_PAD, 32 * 1024, DFF / 2}; pg8::MoeOrder S{blk_e, nblk, X.G, (int)blockIdx.x, 2};
        pg8::EpiY8 E{b2, row_w, y, 1.0f / 1024.0f}; pg8::gemm_phase<pg8::EpiY8, pg8::MoeOrder, true, true, false, true>(ring, g, S, E, X.wave); });
    PH(12, ph_final(X, x1, y, pair_row, mod, g_final, a.out););
#undef PH
#undef IN
#undef SEAM
}

#ifndef MK_N_LAUNCHES
#define MK_N_LAUNCHES 1
#endif
extern "C" void kernel_launch(void* const* d_in, const int* in_sizes, int n_in, void* d_out, int out_size, void* d_ws, size_t ws_size, hipStream_t stream) {
    static int grid = 0;
    if (grid == 0) {
        if (n_in != 23 || out_size != T * D || ws_size < WS_END) { fprintf(stderr, "kernel_launch: unexpected n_in %d / out_size %d / ws_size %zu (< %zu); nothing launched\n", n_in, out_size, ws_size, (size_t)WS_END); grid = -1; return; }
        int dev = 0, cus = 0, per_cu = 0;
        if (hipGetDevice(&dev) != hipSuccess || hipDeviceGetAttribute(&cus, hipDeviceAttributeMultiprocessorCount, dev) != hipSuccess) { grid = -1; return; }
        if (hipFuncSetAttribute((const void*)fwd, hipFuncAttributeMaxDynamicSharedMemorySize, LDS_BYTES) != hipSuccess) { fprintf(stderr, "kernel_launch: hipFuncSetAttribute failed\n"); grid = -1; return; }
        if (hipOccupancyMaxActiveBlocksPerMultiprocessor(&per_cu, (const void*)fwd, 512, LDS_BYTES) != hipSuccess || per_cu < 1) { fprintf(stderr, "kernel_launch: occupancy query says %d blocks per CU\n", per_cu); }
        (void)hipGetLastError();
        grid = cus;
    }
    if (grid < 0) return;
    if (hipMemsetAsync((char*)d_ws + WS_CTL, 0, CTL_ZERO_BYTES, stream) != hipSuccess) return;
    Args a{};
    for (int i = 0; i < 23; ++i) a.in[i] = (const float*)d_in[i];
    a.out = (float*)d_out; a.ws = (unsigned char*)d_ws;
    if (MK_N_LAUNCHES == 1) { a.ph_lo = 0; a.ph_hi = N_PHASES; hipLaunchKernelGGL(fwd, dim3(grid), dim3(512), LDS_BYTES, stream, a); }
    else for (int ph = 0; ph < N_PHASES; ++ph) { a.ph_lo = ph; a.ph_hi = ph + 1; hipLaunchKernelGGL(fwd, dim3(grid), dim3(512), LDS_BYTES, stream, a); }
}
```

```cpp
#include <hip/hip_runtime.h>
#include <stdint.h>
#include <stdio.h>

#define GAS __attribute__((address_space(1)))
#define LAS __attribute__((address_space(3)))
typedef unsigned short bf16_t;
typedef unsigned u32x4 __attribute__((ext_vector_type(4)));
typedef unsigned u32x2 __attribute__((ext_vector_type(2)));
typedef float f32x4 __attribute__((ext_vector_type(4)));

constexpr int D = 1024, NBATCH = 4, SEQ = 8192, T = NBATCH * SEQ;
constexpr int NE = 32, DFF = 1024;
constexpr int NMOD = 6 * D;
constexpr int NBLK_MAX = 544, R_PAD = NBLK_MAX * 256;
constexpr int RT_TILE = 128, RT_NT = T / RT_TILE;
constexpr float EPS = 1e-6f;

constexpr size_t MiB = 1u << 20;
constexpr size_t WS_CTL = 0, CTL_ZERO_BYTES = 64 * 1024;
constexpr size_t WS_MOD = 1 * MiB;
constexpr size_t WS_CB = WS_MOD + 112 * 1024, WS_BP = WS_MOD + 128 * 1024;
constexpr size_t WS_HIST = 2 * MiB;
constexpr size_t WS_BLKE = WS_HIST + 64 * 1024;
constexpr size_t WS_TOPE = 3 * MiB;
constexpr size_t WS_TOPW = WS_TOPE + 512 * 1024;
constexpr size_t WS_RANK = WS_TOPW + 512 * 1024;
constexpr size_t WS_PROW = WS_RANK + 512 * 1024;
constexpr size_t WS_RTOK = 5 * MiB;
constexpr size_t WS_RW = 6 * MiB;
constexpr size_t WS_HGD = 7 * MiB;
constexpr size_t WS_WT = 8 * MiB;
constexpr size_t WS_WIN = WS_WT, WS_WC = WS_WT + 16 * MiB, WS_WH = WS_WT + 18 * MiB, WS_WO = WS_WT + 20 * MiB, WS_W1 = WS_WT + 22 * MiB, WS_W2 = WS_WT + 150 * MiB;
constexpr size_t WS_P = 224 * MiB;
constexpr size_t WS_E = WS_P + 512 * MiB;
constexpr size_t WS_D = WS_E + 128 * MiB;
constexpr size_t WS_END = WS_D + 128 * MiB;
constexpr size_t PG = (size_t)T * D;
constexpr int CW_BAR = 0;

constexpr int RING_BYTES = 135168, LDSCTL_OFF = RING_BYTES, LDS_BYTES = 147456;

__device__ __forceinline__ unsigned f2bf(float f) { unsigned u = __builtin_bit_cast(unsigned, f); return (u + 0x7fffu + ((u >> 16) & 1u)) >> 16; }
__device__ __forceinline__ unsigned pk2(float lo, float hi) { return f2bf(lo) | (f2bf(hi) << 16); }
__device__ __forceinline__ float bf2f(unsigned b) { return __builtin_bit_cast(float, b << 16); }
__device__ __forceinline__ float bflo(unsigned w) { return __builtin_bit_cast(float, w << 16); }
__device__ __forceinline__ float bfhi(unsigned w) { return __builtin_bit_cast(float, w & 0xffff0000u); }
__device__ __forceinline__ float sigmoidf_(float x) { return 1.0f / (1.0f + __expf(-x)); }
__device__ __forceinline__ float wave_sum(float v) {
#pragma unroll
    for (int o = 1; o < 64; o <<= 1) v += __shfl_xor(v, o);
    return v;
}
__device__ __forceinline__ unsigned cvt4_fp8(float a, float b, float c, float d) {
    a = fminf(fmaxf(a, -448.f), 448.f); b = fminf(fmaxf(b, -448.f), 448.f); c = fminf(fmaxf(c, -448.f), 448.f); d = fminf(fmaxf(d, -448.f), 448.f);
    int w = 0; w = __builtin_amdgcn_cvt_pk_fp8_f32(a, b, w, false); w = __builtin_amdgcn_cvt_pk_fp8_f32(c, d, w, true); return (unsigned)w; }
#define LDS_WAIT() asm volatile("s_waitcnt lgkmcnt(0)" ::: "memory")
#define VM_WAIT() asm volatile("s_waitcnt vmcnt(0)" ::: "memory")

namespace pg8 {
#define PG8_LAS __attribute__((address_space(3)))
typedef unsigned short bf16_t;
typedef short bf16x8 __attribute__((ext_vector_type(8)));
typedef float f32x4 __attribute__((ext_vector_type(4)));
typedef unsigned u32x4 __attribute__((ext_vector_type(4)));
constexpr int BM = 256, BK = 64, HALF = 128, HTB = HALF * BK * 2  , STAGE_BYTES = 8 * HTB, NXCD = 8, WGM = 8;

__host__ __device__ __forceinline__ int lds_byte(int r, int c) { const int st = (r >> 4) * 2 + (c >> 5), rr = r & 15, cc = c & 31, ob = rr * 64 + cc * 2; return st * 1024 + (ob ^ (((ob >> 9) & 1) << 5)); }
__host__ __device__ __forceinline__ void stage_rc(int b, int& R, int& C) { const int st = b / 1024, sb = b % 1024, swz = sb ^ (((sb >> 9) & 1) << 5); R = (st >> 1) * 16 + swz / 64; C = (st & 1) * 32 + (swz % 64) / 2; }
__host__ __device__ __forceinline__ int perm32(int rho) { const int n = rho >> 4, i = rho & 15; return 8 * (i >> 2) + 4 * n + (i & 3); }

struct Unit { int pm, pn; };
struct Gemm { const bf16_t* A; const bf16_t* Bt; int M, N, K; };

struct StaticOrder {
    int nM, nN, nwg, G, c;
    __host__ __device__ void init(int M, int N, int G_, int c_) { nM = M / BM; nN = N / BM; nwg = nM * nN; G = G_; c = c_; }
    __host__ __device__ bool next(int i, Unit& u) const {
        const long L = (long)i * G + c; if (L >= nwg) return false;
        int wgid = (int)L; { const int q = nwg / NXCD, r = nwg % NXCD, xcd = wgid % NXCD, off = wgid / NXCD; wgid = (xcd < r ? xcd * (q + 1) : r * (q + 1) + (xcd - r) * q) + off; }
        const int nig = WGM * nN, gid = wgid / nig, fm = gid * WGM, gsz = (nM - fm) < WGM ? (nM - fm) : WGM;
        u.pm = fm + ((wgid % nig) % gsz); u.pn = (wgid % nig) / gsz; return true;
    }
    __device__ __forceinline__ void a_ready(const Unit&) const {}
    __device__ __forceinline__ void done(const Unit&) const {}
};


struct MoeOrder {
    const int* blk_e; int nblk, G, c, lg;
    __device__ __forceinline__ bool next(int i, Unit& u) const {
        int blk, j;
        if (G == 256) { const int xcd = c & 7, idx = c >> 3, prb = 256 >> lg; blk = i * prb + xcd * (prb >> 3) + (idx >> lg); j = idx & ((1 << lg) - 1); }
        else { const long L = (long)i * G + c; blk = (int)(L >> lg); j = (int)(L & ((1 << lg) - 1)); }
        if (blk >= nblk) return false;
        const int e = blk_e[blk]; u.pm = blk; u.pn = (e << lg) + j; return true;
    }
    __device__ __forceinline__ void a_ready(const Unit&) const {}
    __device__ __forceinline__ void done(const Unit&) const {}
};

__device__ __forceinline__ unsigned cvt_pk_bf16(float lo, float hi) { unsigned r; asm volatile("v_cvt_pk_bf16_f32 %0, %1, %2" : "=v"(r) : "v"(lo), "v"(hi)); return r; }
__device__ __forceinline__ float sigm(float x) { return 1.0f / (1.0f + __expf(-x)); }
__device__ __forceinline__ float blo(unsigned w) { return __builtin_bit_cast(float, w << 16); }
__device__ __forceinline__ float bhi(unsigned w) { return __builtin_bit_cast(float, w & 0xffff0000u); }

struct EpiSplitBf16 {
    static constexpr bool PERM = true, AFTER_DRAIN = false;
    bf16_t* O; size_t split_stride; unsigned hm_mask; int seq;
    __device__ __forceinline__ void operator()(const f32x4 (&acc)[2][2][4][2], const Unit& u, int wr, int wc, int fr, int fq) const {
        const int row0 = u.pm * BM + wr * 64 + fr; const int colt = u.pn * BM; const int t = colt >> 10;
        if (u.pn < 8) {
#pragma unroll
            for (int ai = 0; ai < 2; ++ai)
#pragma unroll
                for (int m = 0; m < 4; ++m) { const int row = row0 + ai * HALF + m * 16; float r[8];
#pragma unroll
                    for (int q = 0; q < 4; ++q) { r[q] = acc[ai][0][m][0][q] * sigm(acc[ai][1][m][0][q]); r[4 + q] = acc[ai][0][m][1][q] * sigm(acc[ai][1][m][1][q]); }
                    u32x4 w; w.x = cvt_pk_bf16(r[0], r[1]); w.y = cvt_pk_bf16(r[2], r[3]); w.z = cvt_pk_bf16(r[4], r[5]); w.w = cvt_pk_bf16(r[6], r[7]);
                    *(u32x4*)(O + (size_t)row * 1024 + 128 * u.pn + wc * 32 + 8 * fq) = w; }
            return;
        }
        bf16_t* base = O + (size_t)t * split_stride; const int cg = colt & 1023;
        const bool hm = (hm_mask >> t) & 1u;
        const int bb = (u.pm * BM) / seq;
#pragma unroll
        for (int ai = 0; ai < 2; ++ai)
#pragma unroll
            for (int m = 0; m < 4; ++m) { const int row = row0 + ai * HALF + m * 16;
#pragma unroll
                for (int bj = 0; bj < 2; ++bj) { const f32x4 v0 = acc[ai][bj][m][0], v1 = acc[ai][bj][m][1];
                    u32x4 w; w.x = cvt_pk_bf16(v0[0], v0[1]); w.y = cvt_pk_bf16(v0[2], v0[3]); w.z = cvt_pk_bf16(v1[0], v1[1]); w.w = cvt_pk_bf16(v1[2], v1[3]);
                    const size_t o = hm ? ((size_t)(bb * 8 + (cg >> 7) + bj) * seq + (row - bb * seq)) * 128 + wc * 32 + 8 * fq
                                        : (size_t)row * 1024 + cg + bj * HALF + wc * 32 + 8 * fq;
                    *(u32x4*)(base + o) = w; } }
    }
};
struct EpiGate1 {
    static constexpr bool PERM = true, AFTER_DRAIN = false;
    const bf16_t* gate; float* tmp;
    __device__ __forceinline__ void operator()(const f32x4 (&acc)[2][2][4][2], const Unit& u, int wr, int wc, int fr, int fq) const {
        const int row0 = u.pm * BM + wr * 64 + fr, col0 = u.pn * BM + wc * 32 + 8 * fq;
#pragma unroll
        for (int ai = 0; ai < 2; ++ai)
#pragma unroll
            for (int m = 0; m < 4; ++m) { const size_t o = (size_t)(row0 + ai * HALF + m * 16) * 1024 + col0;
#pragma unroll
                for (int bj = 0; bj < 2; ++bj) { const u32x4 g = *(const u32x4*)(gate + o + bj * HALF); f32x4 v0 = acc[ai][bj][m][0], v1 = acc[ai][bj][m][1];
                    v0[0] *= sigm(blo(g.x)); v0[1] *= sigm(bhi(g.x)); v0[2] *= sigm(blo(g.y)); v0[3] *= sigm(bhi(g.y));
                    v1[0] *= sigm(blo(g.z)); v1[1] *= sigm(bhi(g.z)); v1[2] *= sigm(blo(g.w)); v1[3] *= sigm(bhi(g.w));
                    *(f32x4*)(tmp + o + bj * HALF) = v0; *(f32x4*)(tmp + o + bj * HALF + 4) = v1; } }
    }
};
struct EpiGate2 {
    static constexpr bool PERM = true, AFTER_DRAIN = false;
    const bf16_t* gate; const float* tmp; bf16_t* out;
    __device__ __forceinline__ void operator()(const f32x4 (&acc)[2][2][4][2], const Unit& u, int wr, int wc, int fr, int fq) const {
        const int row0 = u.pm * BM + wr * 64 + fr, col0 = u.pn * BM + wc * 32 + 8 * fq;
#pragma unroll
        for (int ai = 0; ai < 2; ++ai)
#pragma unroll
            for (int m = 0; m < 4; ++m) { const size_t o = (size_t)(row0 + ai * HALF + m * 16) * 1024 + col0;
#pragma unroll
                for (int bj = 0; bj < 2; ++bj) { const u32x4 g = *(const u32x4*)(gate + o + bj * HALF); f32x4 v0 = acc[ai][bj][m][0], v1 = acc[ai][bj][m][1];
                    const f32x4 t0 = *(const f32x4*)(tmp + o + bj * HALF), t1 = *(const f32x4*)(tmp + o + bj * HALF + 4);
                    v0[0] = t0[0] + v0[0] * sigm(blo(g.x)); v0[1] = t0[1] + v0[1] * sigm(bhi(g.x)); v0[2] = t0[2] + v0[2] * sigm(blo(g.y)); v0[3] = t0[3] + v0[3] * sigm(bhi(g.y));
                    v1[0] = t1[0] + v1[0] * sigm(blo(g.z)); v1[1] = t1[1] + v1[1] * sigm(bhi(g.z)); v1[2] = t1[2] + v1[2] * sigm(blo(g.w)); v1[3] = t1[3] + v1[3] * sigm(bhi(g.w));
                    u32x4 w; w.x = cvt_pk_bf16(v0[0], v0[1]); w.y = cvt_pk_bf16(v0[2], v0[3]); w.z = cvt_pk_bf16(v1[0], v1[1]); w.w = cvt_pk_bf16(v1[2], v1[3]);
                    *(u32x4*)(out + o + bj * HALF) = w; } }
    }
};
struct EpiRes {
    static constexpr bool PERM = false, AFTER_DRAIN = false;
    const float* x; const float* ga; float* out; int mod_pitch, seq;
    __device__ __forceinline__ void operator()(const f32x4 (&acc)[2][2][4][2], const Unit& u, int wr, int wc, int fr, int fq) const {
        const int row0 = u.pm * BM + wr * 64 + fr, col0 = u.pn * BM + wc * 32 + 4 * fq;
        const float* gab = ga + (size_t)((u.pm * BM) / seq) * mod_pitch + col0;
        f32x4 gv[2][2];
#pragma unroll
        for (int bj = 0; bj < 2; ++bj)
#pragma unroll
            for (int n = 0; n < 2; ++n) gv[bj][n] = *(const f32x4*)(gab + bj * HALF + n * 16);
#pragma unroll
        for (int ai = 0; ai < 2; ++ai)
#pragma unroll
            for (int m = 0; m < 4; ++m) { const size_t o = (size_t)(row0 + ai * HALF + m * 16) * 1024 + col0;
#pragma unroll
                for (int bj = 0; bj < 2; ++bj)
#pragma unroll
                    for (int n = 0; n < 2; ++n) { const f32x4 xv = *(const f32x4*)(x + o + bj * HALF + n * 16); *(f32x4*)(out + o + bj * HALF + n * 16) = xv + gv[bj][n] * acc[ai][bj][m][n]; } }
    }
};
struct EpiSwiglu {
    static constexpr bool PERM = true, AFTER_DRAIN = false;
    const float* b1; bf16_t* act;
    __device__ __forceinline__ void operator()(const f32x4 (&acc)[2][2][4][2], const Unit& u, int wr, int wc, int fr, int fq) const {
        const int e = u.pn >> 3, j = u.pn & 7; const int row0 = u.pm * BM + wr * 64 + fr, f0 = 128 * j + wc * 32 + 8 * fq;
        const float* be = b1 + (size_t)e * 2048 + f0;
        const f32x4 bg0 = *(const f32x4*)(be), bg1 = *(const f32x4*)(be + 4), bl0 = *(const f32x4*)(be + 1024), bl1 = *(const f32x4*)(be + 1028);
#pragma unroll
        for (int ai = 0; ai < 2; ++ai)
#pragma unroll
            for (int m = 0; m < 4; ++m) {
                f32x4 g0 = acc[ai][0][m][0] + bg0, g1 = acc[ai][0][m][1] + bg1, l0 = acc[ai][1][m][0] + bl0, l1 = acc[ai][1][m][1] + bl1;
                float r[8];
#pragma unroll
                for (int q = 0; q < 4; ++q) { float gl = fminf(g0[q], 7.0f), li = fminf(fmaxf(l0[q], -7.0f), 7.0f); r[q] = gl * sigm(1.702f * gl) * (li + 1.0f);
                                              gl = fminf(g1[q], 7.0f); li = fminf(fmaxf(l1[q], -7.0f), 7.0f); r[4 + q] = gl * sigm(1.702f * gl) * (li + 1.0f); }
                u32x4 w; w.x = cvt_pk_bf16(r[0], r[1]); w.y = cvt_pk_bf16(r[2], r[3]); w.z = cvt_pk_bf16(r[4], r[5]); w.w = cvt_pk_bf16(r[6], r[7]);
                *(u32x4*)(act + (size_t)(row0 + ai * HALF + m * 16) * 1024 + f0) = w; }
    }
};
struct EpiY {
    static constexpr bool PERM = true, AFTER_DRAIN = false;
    const float* b2; const float* rw; bf16_t* y;
    __device__ __forceinline__ void operator()(const f32x4 (&acc)[2][2][4][2], const Unit& u, int wr, int wc, int fr, int fq) const {
        const int e = u.pn >> 2, j = u.pn & 3; const int row0 = u.pm * BM + wr * 64 + fr, col0 = 256 * j + wc * 32 + 8 * fq;
        const float* be = b2 + (size_t)e * 1024 + col0;
        f32x4 bv[2][2];
#pragma unroll
        for (int bj = 0; bj < 2; ++bj)
#pragma unroll
            for (int n = 0; n < 2; ++n) bv[bj][n] = *(const f32x4*)(be + bj * HALF + 4 * n);
#pragma unroll
        for (int ai = 0; ai < 2; ++ai)
#pragma unroll
            for (int m = 0; m < 4; ++m) { const int row = row0 + ai * HALF + m * 16; const float w_ = rw[row];
#pragma unroll
                for (int bj = 0; bj < 2; ++bj) { const f32x4 v0 = (acc[ai][bj][m][0] + bv[bj][0]) * w_, v1 = (acc[ai][bj][m][1] + bv[bj][1]) * w_;
                    u32x4 w; w.x = cvt_pk_bf16(v0[0], v0[1]); w.y = cvt_pk_bf16(v0[2], v0[3]); w.z = cvt_pk_bf16(v1[0], v1[1]); w.w = cvt_pk_bf16(v1[2], v1[3]);
                    *(u32x4*)(y + (size_t)row * 1024 + col0 + bj * HALF) = w; } }
    }
};


struct EpiSwiglu8 {
    static constexpr bool PERM = true, AFTER_DRAIN = false;
    const float* b1; unsigned char* act; float dq;
    __device__ __forceinline__ void operator()(const f32x4 (&acc)[2][2][4][2], const Unit& u, int wr, int wc, int fr, int fq) const {
        const int e = u.pn >> 3, j = u.pn & 7; const int row0 = u.pm * BM + wr * 64 + fr, f0 = 128 * j + wc * 32 + 8 * fq;
        const float* be = b1 + (size_t)e * 2048 + f0;
        const f32x4 bg0 = *(const f32x4*)(be), bg1 = *(const f32x4*)(be + 4), bl0 = *(const f32x4*)(be + 1024), bl1 = *(const f32x4*)(be + 1028);
#pragma unroll
        for (int ai = 0; ai < 2; ++ai)
#pragma unroll
            for (int m = 0; m < 4; ++m) {
                f32x4 g0 = acc[ai][0][m][0] * dq + bg0, g1 = acc[ai][0][m][1] * dq + bg1, l0 = acc[ai][1][m][0] * dq + bl0, l1 = acc[ai][1][m][1] * dq + bl1;
                float r[8];
#pragma unroll
                for (int q = 0; q < 4; ++q) { float gl = fminf(g0[q], 7.0f), li = fminf(fmaxf(l0[q], -7.0f), 7.0f); r[q] = 4.0f * gl * sigm(1.702f * gl) * (li + 1.0f);
                                              gl = fminf(g1[q], 7.0f); li = fminf(fmaxf(l1[q], -7.0f), 7.0f); r[4 + q] = 4.0f * gl * sigm(1.702f * gl) * (li + 1.0f); }
                u32x2 w; w.x = cvt4_fp8(r[0], r[1], r[2], r[3]); w.y = cvt4_fp8(r[4], r[5], r[6], r[7]);
                *(u32x2*)(act + (size_t)(row0 + ai * HALF + m * 16) * 1024 + f0) = w; }
    }
};
struct EpiY8 {
    static constexpr bool PERM = true, AFTER_DRAIN = false;
    const float* b2; const float* rw; bf16_t* y; float dq;
    __device__ __forceinline__ void operator()(const f32x4 (&acc)[2][2][4][2], const Unit& u, int wr, int wc, int fr, int fq) const {
        const int e = u.pn >> 2, j = u.pn & 3; const int row0 = u.pm * BM + wr * 64 + fr, col0 = 256 * j + wc * 32 + 8 * fq;
        const float* be = b2 + (size_t)e * 1024 + col0;
        f32x4 bv[2][2];
#pragma unroll
        for (int bj = 0; bj < 2; ++bj)
#pragma unroll
            for (int n = 0; n < 2; ++n) bv[bj][n] = *(const f32x4*)(be + bj * HALF + 4 * n);
#pragma unroll
        for (int ai = 0; ai < 2; ++ai)
#pragma unroll
            for (int m = 0; m < 4; ++m) { const int row = row0 + ai * HALF + m * 16; const float w_ = rw[row];
#pragma unroll
                for (int bj = 0; bj < 2; ++bj) { const f32x4 v0 = (acc[ai][bj][m][0] * dq + bv[bj][0]) * w_, v1 = (acc[ai][bj][m][1] * dq + bv[bj][1]) * w_;
                    u32x4 w; w.x = cvt_pk_bf16(v0[0], v0[1]); w.y = cvt_pk_bf16(v0[2], v0[3]); w.z = cvt_pk_bf16(v1[0], v1[1]); w.w = cvt_pk_bf16(v1[2], v1[3]);
                    *(u32x4*)(y + (size_t)row * 1024 + col0 + bj * HALF) = w; } }
    }
};


struct EpiGateFused {
    static constexpr bool PERM = true, AFTER_DRAIN = false, HAS_MID = true;
    const bf16_t* gc; const bf16_t* gh; bf16_t* out;
    __device__ __forceinline__ void mid(f32x4 (&acc)[2][2][4][2], const Unit& u, int wr, int wc, int fr, int fq) const {
        const int row0 = u.pm * BM + wr * 64 + fr, col0 = u.pn * BM + wc * 32 + 8 * fq;
#pragma unroll
        for (int ai = 0; ai < 2; ++ai)
#pragma unroll
            for (int m = 0; m < 4; ++m) { const size_t o = (size_t)(row0 + ai * HALF + m * 16) * 1024 + col0;
#pragma unroll
                for (int bj = 0; bj < 2; ++bj) { const u32x4 a = *(const u32x4*)(gc + o + bj * HALF), b = *(const u32x4*)(gh + o + bj * HALF);
                    const unsigned aw[4] = {a.x, a.y, a.z, a.w}, bw[4] = {b.x, b.y, b.z, b.w};
#pragma unroll
                    for (int q = 0; q < 4; ++q) { const float r0 = (1.0f + __expf(-blo(bw[q]))) * __builtin_amdgcn_rcpf(1.0f + __expf(-blo(aw[q]))), r1 = (1.0f + __expf(-bhi(bw[q]))) * __builtin_amdgcn_rcpf(1.0f + __expf(-bhi(aw[q])));
                        acc[ai][bj][m][q >> 1][(2 * q) & 3] *= r0; acc[ai][bj][m][q >> 1][(2 * q + 1) & 3] *= r1; } } }
    }
    __device__ __forceinline__ void operator()(const f32x4 (&acc)[2][2][4][2], const Unit& u, int wr, int wc, int fr, int fq) const {
        const int row0 = u.pm * BM + wr * 64 + fr, col0 = u.pn * BM + wc * 32 + 8 * fq;
#pragma unroll
        for (int ai = 0; ai < 2; ++ai)
#pragma unroll
            for (int m = 0; m < 4; ++m) { const size_t o = (size_t)(row0 + ai * HALF + m * 16) * 1024 + col0;
#pragma unroll
                for (int bj = 0; bj < 2; ++bj) { const u32x4 g = *(const u32x4*)(gh + o + bj * HALF); f32x4 v0 = acc[ai][bj][m][0], v1 = acc[ai][bj][m][1];
                    v0[0] *= sigm(blo(g.x)); v0[1] *= sigm(bhi(g.x)); v0[2] *= sigm(blo(g.y)); v0[3] *= sigm(bhi(g.y));
                    v1[0] *= sigm(blo(g.z)); v1[1] *= sigm(bhi(g.z)); v1[2] *= sigm(blo(g.w)); v1[3] *= sigm(bhi(g.w));
                    u32x4 w; w.x = cvt_pk_bf16(v0[0], v0[1]); w.y = cvt_pk_bf16(v0[2], v0[3]); w.z = cvt_pk_bf16(v1[0], v1[1]); w.w = cvt_pk_bf16(v1[2], v1[3]);
                    *(u32x4*)(out + o + bj * HALF) = w; } }
    }
};

template <class T, class = void> struct has_mid { static constexpr bool value = false; };
template <class T> struct has_mid<T, decltype((void)T::HAS_MID)> { static constexpr bool value = true; };
template <class Epi, class Sched, bool ALIGN_EPI = false, bool SP2 = false, bool GATHER = false, bool FP8 = false>
__device__ __forceinline__ void gemm_phase(PG8_LAS unsigned char* lds, const Gemm g, const Sched& S, const Epi& E, const int wave_id, const PG8_LAS unsigned short* gtab = nullptr) {
    typedef int i32x4 __attribute__((ext_vector_type(4))); typedef int i32x8 __attribute__((ext_vector_type(8)));
    static_assert(!GATHER || SP2, "GATHER needs the SP2 loop");
    int lane = (int)__builtin_amdgcn_mbcnt_hi(~0u, __builtin_amdgcn_mbcnt_lo(~0u, 0u)); asm volatile("" : "+v"(lane));
    const int wid = wave_id, tid = wid * 64 + lane, wr = wid >> 2, wc = wid & 3, fr = lane & 15, fq = lane >> 4;
    const int K = g.K, nt = K / BK;
    unsigned voffA[2], voffB[2];
#pragma unroll
    for (int i = 0; i < 2; ++i) { int R, C; stage_rc(tid * 16 + i * 8192, R, C); const int Rb = Epi::PERM ? ((R & ~31) + perm32(R & 31)) : R;
        voffA[i] = (unsigned)(R * K + C) * 2u; voffB[i] = (unsigned)(Rb * K + C) * 2u; }
    unsigned vA0[2] = {0u, 0u}, vA1[2] = {0u, 0u}, xA0[2] = {0u, 0u}, xA1[2] = {0u, 0u};
#define PG8_GLOAD(d0, d1, ui_) do { int tz_ = wid * 64 + (int)__builtin_amdgcn_mbcnt_hi(~0u, __builtin_amdgcn_mbcnt_lo(~0u, 0u)); asm volatile("" : "+v"(tz_)); _Pragma("unroll") for (int _i = 0; _i < 2; ++_i) { int R_, C_; stage_rc(tz_ * 16 + _i * 8192, R_, C_); \
        d0[_i] = (unsigned)gtab[256 * (ui_) + R_] * (unsigned)(K * 2) + (unsigned)C_ * 2u; d1[_i] = (unsigned)gtab[256 * (ui_) + 128 + R_] * (unsigned)(K * 2) + (unsigned)C_ * 2u; } } while (0)
    const unsigned kstep = (unsigned)(BK * 2);
    const unsigned hstep = (unsigned)HALF * K * 2;
    const unsigned tstep = 2 * hstep;
    const __amdgpu_buffer_rsrc_t rsA = __builtin_amdgcn_make_buffer_rsrc((void*)g.A, 0, 0x7fffffff, 0x00020000), rsB = __builtin_amdgcn_make_buffer_rsrc((void*)g.Bt, 0, 0x7fffffff, 0x00020000);
    const unsigned ldsw = (unsigned)wid * 1024u;
    const int aoff = lds_byte(wr * 64 + fr, fq * 8), boff = lds_byte(wc * 32 + fr, fq * 8);
#define PG8_SA(b, h) (((b) * 2 + (h)) * HTB)
#define PG8_SB(b, h) ((4 + (b) * 2 + (h)) * HTB)
#define PG8_STAGE(bufoff, rs, soff, voff) do { _Pragma("unroll") for (int _i = 0; _i < 2; ++_i) \
        __builtin_amdgcn_raw_ptr_buffer_load_lds(rs, (PG8_LAS void*)(lds + (bufoff) + ldsw + _i * 8192), 16, (int)(voff)[_i], (int)(soff), 0, 0); } while (0)
#define PG8_LDA(dst, b, h) do { if constexpr (FP8) { _Pragma("unroll") for (int m = 0; m < 4; ++m) dst##_8[m] = __builtin_shufflevector(*(const PG8_LAS i32x4*)(lds + PG8_SA(b, h) + aoff + m * 2048), *(const PG8_LAS i32x4*)(lds + PG8_SA(b, h) + aoff + m * 2048 + 1024), 0, 1, 2, 3, 4, 5, 6, 7); } \
        else { _Pragma("unroll") for (int m = 0; m < 4; ++m) _Pragma("unroll") for (int k = 0; k < 2; ++k) dst[m][k] = *(const PG8_LAS bf16x8*)(lds + PG8_SA(b, h) + aoff + m * 2048 + k * 1024); } } while (0)
#define PG8_LDB(dst, b, h) do { if constexpr (FP8) { _Pragma("unroll") for (int n = 0; n < 2; ++n) dst##_8[n] = __builtin_shufflevector(*(const PG8_LAS i32x4*)(lds + PG8_SB(b, h) + boff + n * 2048), *(const PG8_LAS i32x4*)(lds + PG8_SB(b, h) + boff + n * 2048 + 1024), 0, 1, 2, 3, 4, 5, 6, 7); } \
        else { _Pragma("unroll") for (int n = 0; n < 2; ++n) _Pragma("unroll") for (int k = 0; k < 2; ++k) dst[n][k] = *(const PG8_LAS bf16x8*)(lds + PG8_SB(b, h) + boff + n * 2048 + k * 1024); } } while (0)
#define PG8_PIN(ai, bj) asm volatile("" : "+v"(acc[ai][bj][0][0]), "+v"(acc[ai][bj][0][1]), "+v"(acc[ai][bj][1][0]), "+v"(acc[ai][bj][1][1]), "+v"(acc[ai][bj][2][0]), "+v"(acc[ai][bj][2][1]), "+v"(acc[ai][bj][3][0]), "+v"(acc[ai][bj][3][1]))
#define PG8_MMA(ai, bj, At, Bt) do { if constexpr (FP8) { __builtin_amdgcn_sched_barrier(0); __builtin_amdgcn_s_setprio(1); _Pragma("unroll") for (int m = 0; m < 4; ++m) _Pragma("unroll") for (int n = 0; n < 2; ++n) \
        acc[ai][bj][m][n] = __builtin_amdgcn_mfma_scale_f32_16x16x128_f8f6f4(Bt##_8[n], At##_8[m], acc[ai][bj][m][n], 0, 0, 0, 0x7f7f7f7f, 0, 0x7f7f7f7f); \
        __builtin_amdgcn_s_setprio(0); PG8_PIN(ai, bj); __builtin_amdgcn_sched_barrier(0); } else { __builtin_amdgcn_s_setprio(1); \
        _Pragma("unroll") for (int m = 0; m < 4; ++m) _Pragma("unroll") for (int n = 0; n < 2; ++n) _Pragma("unroll") for (int k = 0; k < 2; ++k) \
        acc[ai][bj][m][n] = __builtin_amdgcn_mfma_f32_16x16x32_bf16(Bt[n][k], At[m][k], acc[ai][bj][m][n], 0, 0, 0); __builtin_amdgcn_s_setprio(0); } } while (0)
#define PG8_WAIT_V(n) asm volatile("s_waitcnt vmcnt(" #n ")" ::: "memory")
#define PG8_WAIT_L(n) asm volatile("s_waitcnt lgkmcnt(" #n ")" ::: "memory")
#define PG8_BAR __builtin_amdgcn_s_barrier()
#define PG8_SCHED __builtin_amdgcn_sched_barrier(0)
    Unit cur, nxt; int ui = 0;
    if (!S.next(0, cur)) return;
    f32x4 acc[2][2][4][2];
#pragma unroll
    for (int a = 0; a < 2; ++a)
#pragma unroll
        for (int b = 0; b < 2; ++b)
#pragma unroll
            for (int m = 0; m < 4; ++m)
#pragma unroll
                for (int n = 0; n < 2; ++n) acc[a][b][m][n] = (f32x4){0.f, 0.f, 0.f, 0.f};
    bf16x8 At[4][2], B0[2][2], B1[2][2]; i32x8 At_8[4], B0_8[2], B1_8[2];
    unsigned cA = GATHER ? 0u : (unsigned)cur.pm * tstep, cB = (unsigned)cur.pn * tstep;
    S.a_ready(cur);
    if constexpr (GATHER) { PG8_GLOAD(vA0, vA1, 0); xA0[0] = vA0[0]; xA0[1] = vA0[1]; xA1[0] = vA1[0]; xA1[1] = vA1[1]; }
    if constexpr (SP2) {
        PG8_STAGE(PG8_SB(0, 0), rsB, cB, voffB); PG8_STAGE(PG8_SB(0, 1), rsB, cB + hstep, voffB);
        if constexpr (GATHER) { PG8_STAGE(PG8_SA(0, 0), rsA, cA, vA0); PG8_STAGE(PG8_SA(0, 1), rsA, cA, vA1); } else { PG8_STAGE(PG8_SA(0, 0), rsA, cA, voffA); PG8_STAGE(PG8_SA(0, 1), rsA, cA + hstep, voffA); }
        if (wr == 1) PG8_BAR;
        PG8_WAIT_V(2); PG8_BAR;
        PG8_STAGE(PG8_SB(1, 0), rsB, cB + kstep, voffB); if constexpr (GATHER) { PG8_STAGE(PG8_SA(1, 0), rsA, cA + kstep, vA0); } else { PG8_STAGE(PG8_SA(1, 0), rsA, cA + kstep, voffA); } PG8_STAGE(PG8_SB(1, 1), rsB, cB + hstep + kstep, voffB);
        PG8_WAIT_V(6); PG8_BAR;
    } else {
        PG8_STAGE(PG8_SB(0, 0), rsB, cB, voffB); PG8_STAGE(PG8_SA(0, 0), rsA, cA, voffA); PG8_STAGE(PG8_SB(0, 1), rsB, cB + hstep, voffB); PG8_STAGE(PG8_SA(0, 1), rsA, cA + hstep, voffA);
        if (wr == 1) PG8_BAR;
        PG8_WAIT_V(4); PG8_BAR;
        PG8_STAGE(PG8_SB(1, 0), rsB, cB + kstep, voffB); PG8_STAGE(PG8_SA(1, 0), rsA, cA + kstep, voffA); PG8_STAGE(PG8_SB(1, 1), rsB, cB + hstep + kstep, voffB);
        PG8_WAIT_V(6); PG8_BAR;
    }
    for (;;) {
        const bool has_next = S.next(ui + 1, nxt);
        const unsigned nA = GATHER ? cA : (has_next ? (unsigned)nxt.pm * tstep : cA), nB = has_next ? (unsigned)nxt.pn * tstep : cB;
        for (int t = 0; t < nt; t += 2) {
            const bool last = (t == nt - 2);
            const unsigned a1 = cA + (unsigned)(t + 1) * kstep;
            const unsigned a2 = last ? nA : cA + (unsigned)(t + 2) * kstep, b2 = last ? nB : cB + (unsigned)(t + 2) * kstep;
            const unsigned a3 = a2 + kstep, b3 = b2 + kstep;
            if (last && has_next) S.a_ready(nxt);
            if constexpr (has_mid<Epi>::value) { if (t == nt / 2) { int l3_ = (int)__builtin_amdgcn_mbcnt_hi(~0u, __builtin_amdgcn_mbcnt_lo(~0u, 0u)); asm volatile("" : "+v"(l3_)); E.mid(acc, cur, wr, wc, l3_ & 15, l3_ >> 4); } }
            if constexpr (GATHER) { if (last && has_next) { PG8_GLOAD(xA0, xA1, ui + 1); } }
            if constexpr (SP2) {
            PG8_LDB(B0, 0, 0); PG8_LDB(B1, 0, 1); PG8_SCHED; PG8_LDA(At, 0, 0); if constexpr (GATHER) { PG8_STAGE(PG8_SA(1, 1), rsA, a1, vA1); } else { PG8_STAGE(PG8_SA(1, 1), rsA, a1 + hstep, voffA); }
            PG8_WAIT_V(8); PG8_WAIT_L(0); PG8_BAR; PG8_MMA(0, 0, At, B0); PG8_MMA(0, 1, At, B1); PG8_BAR; PG8_SCHED;
            PG8_LDA(At, 0, 1); PG8_STAGE(PG8_SB(0, 0), rsB, b2, voffB); PG8_STAGE(PG8_SB(0, 1), rsB, b2 + hstep, voffB); if constexpr (GATHER) { PG8_STAGE(PG8_SA(0, 0), rsA, a2, xA0); } else { PG8_STAGE(PG8_SA(0, 0), rsA, a2, voffA); }
            PG8_WAIT_V(8); PG8_WAIT_L(0); PG8_BAR; PG8_MMA(1, 0, At, B0); PG8_MMA(1, 1, At, B1); PG8_BAR; PG8_SCHED;
            PG8_LDB(B0, 1, 0); PG8_LDB(B1, 1, 1); PG8_SCHED; PG8_LDA(At, 1, 0); if constexpr (GATHER) { PG8_STAGE(PG8_SA(0, 1), rsA, a2, xA1); } else { PG8_STAGE(PG8_SA(0, 1), rsA, a2 + hstep, voffA); }
            PG8_WAIT_V(8); PG8_WAIT_L(0); PG8_BAR; PG8_MMA(0, 0, At, B0); PG8_MMA(0, 1, At, B1); PG8_BAR; PG8_SCHED;
            PG8_LDA(At, 1, 1); PG8_STAGE(PG8_SB(1, 0), rsB, b3, voffB); PG8_STAGE(PG8_SB(1, 1), rsB, b3 + hstep, voffB); if constexpr (GATHER) { PG8_STAGE(PG8_SA(1, 0), rsA, a3, xA0); } else { PG8_STAGE(PG8_SA(1, 0), rsA, a3, voffA); }
            PG8_WAIT_V(8); PG8_WAIT_L(0); PG8_BAR; PG8_MMA(1, 0, At, B0); PG8_MMA(1, 1, At, B1); PG8_BAR; PG8_SCHED;
            } else {
            PG8_LDB(B0, 0, 0); PG8_SCHED; PG8_LDA(At, 0, 0); PG8_STAGE(PG8_SA(1, 1), rsA, a1 + hstep, voffA);
            PG8_WAIT_L(8); PG8_BAR; PG8_WAIT_L(0); PG8_MMA(0, 0, At, B0); PG8_BAR; PG8_SCHED;
            PG8_LDB(B1, 0, 1); PG8_STAGE(PG8_SB(0, 0), rsB, b2, voffB);
            PG8_BAR; PG8_WAIT_L(0); PG8_MMA(0, 1, At, B1); PG8_BAR;
            PG8_LDA(At, 0, 1); PG8_STAGE(PG8_SA(0, 0), rsA, a2, voffA);
            PG8_BAR; PG8_WAIT_L(0); PG8_MMA(1, 0, At, B0); PG8_BAR; PG8_SCHED;
            PG8_STAGE(PG8_SB(0, 1), rsB, b2 + hstep, voffB);
            PG8_WAIT_V(6); PG8_BAR; PG8_MMA(1, 1, At, B1); PG8_BAR;
            PG8_LDB(B0, 1, 0); PG8_SCHED; PG8_LDA(At, 1, 0); PG8_STAGE(PG8_SA(0, 1), rsA, a2 + hstep, voffA);
            PG8_WAIT_L(8); PG8_BAR; PG8_WAIT_L(0); PG8_MMA(0, 0, At, B0); PG8_BAR; PG8_SCHED;
            PG8_LDB(B1, 1, 1); PG8_STAGE(PG8_SB(1, 0), rsB, b3, voffB);
            PG8_BAR; PG8_WAIT_L(0); PG8_MMA(0, 1, At, B1); PG8_BAR;
            PG8_LDA(At, 1, 1); PG8_STAGE(PG8_SA(1, 0), rsA, a3, voffA);
            PG8_BAR; PG8_WAIT_L(0); PG8_MMA(1, 0, At, B0); PG8_BAR; PG8_SCHED;
            PG8_STAGE(PG8_SB(1, 1), rsB, b3 + hstep, voffB);
            PG8_WAIT_V(6); PG8_BAR; PG8_MMA(1, 1, At, B1); PG8_BAR;
            }
        }
        if constexpr (ALIGN_EPI) { if (wr == 0) PG8_BAR; }
        if constexpr (!Epi::AFTER_DRAIN) { int l2_ = (int)__builtin_amdgcn_mbcnt_hi(~0u, __builtin_amdgcn_mbcnt_lo(~0u, 0u)); asm volatile("" : "+v"(l2_));
            E(acc, cur, wr, wc, l2_ & 15, l2_ >> 4); S.done(cur); }
        if (!has_next) break;
#pragma unroll
        for (int a = 0; a < 2; ++a)
#pragma unroll
            for (int b = 0; b < 2; ++b)
#pragma unroll
                for (int m = 0; m < 4; ++m)
#pragma unroll
                    for (int n = 0; n < 2; ++n) acc[a][b][m][n] = (f32x4){0.f, 0.f, 0.f, 0.f};
        cur = nxt; cA = nA; cB = nB; ++ui;
        if constexpr (GATHER) { vA0[0] = xA0[0]; vA0[1] = xA0[1]; vA1[0] = xA1[0]; vA1[1] = xA1[1]; }
        if constexpr (ALIGN_EPI) { if (wr == 1) PG8_BAR; }
    }
    PG8_WAIT_V(0);
    if constexpr (!ALIGN_EPI) { if (wr == 0) PG8_BAR; }
    PG8_BAR;
    if constexpr (Epi::AFTER_DRAIN) { E.fused(acc, cur, wr, wc, fr, fq, lds, wid, lane); S.done(cur); }
#undef PG8_GLOAD
#undef PG8_SA
#undef PG8_SB
#undef PG8_STAGE
#undef PG8_LDA
#undef PG8_LDB
#undef PG8_MMA
#undef PG8_PIN
#undef PG8_WAIT_V
#undef PG8_WAIT_L
#undef PG8_BAR
#undef PG8_SCHED
}
}
#define XB_TMO      128
#define XB_XCNT(j)  (256  + 64 * (j))
#define XB_XSUB(j)  (1280 + 64 * (j))
#define XB_XGEN(j)  (2304 + 64 * (j))
#define XB_TOP      3328
#define XB_TOPGEN   3392
#define XCD_BAR_WORDS 3456
#define XB_SPIN_CAP (1u << 18)

__device__ __forceinline__ unsigned xb_ld(unsigned* p)              { return __hip_atomic_load(p, __ATOMIC_RELAXED, __HIP_MEMORY_SCOPE_AGENT); }
__device__ __forceinline__ unsigned xb_add(unsigned* p, unsigned v) { return __hip_atomic_fetch_add(p, v, __ATOMIC_RELAXED, __HIP_MEMORY_SCOPE_AGENT); }
__device__ __forceinline__ unsigned xb_xcc_id() { return (unsigned)__builtin_amdgcn_s_getreg((3 << 11) | 20) & 0xFu; }
#define XB_SPIN(cond, bar) do { unsigned _sp = 0; while (cond) { __builtin_amdgcn_s_sleep(1); \
    if ((++_sp & 255u) == 0u) { if (xb_ld(&(bar)[XB_TMO])) break; if (_sp > XB_SPIN_CAP) { atomicAdd(&(bar)[XB_TMO], 1u); break; } } } } while (0)

struct XcdBarrier {
    unsigned* bar; unsigned x;
    volatile LAS unsigned* st;
};

__device__ __forceinline__ XcdBarrier xcd_barrier_post(unsigned* bar, volatile LAS unsigned* st, const bool leader  ) {
    XcdBarrier b; b.bar = bar; b.x = xb_xcc_id(); b.st = st;
    if (leader) (void)xb_add(&bar[XB_XCNT(b.x)], 1u);
    return b;
}
__device__ __forceinline__ void xcd_barrier_complete(unsigned* bar, unsigned x, unsigned& nloc, unsigned& nx) {
    const unsigned G = gridDim.x * gridDim.y * gridDim.z;
    unsigned sum, cnt, mine, sp = 0u;
    for (;;) {
        sum = 0u; cnt = 0u; mine = 0u;
#pragma unroll
        for (unsigned j = 0; j < 16; ++j) { const unsigned c = xb_ld(&bar[XB_XCNT(j)]); sum += c; cnt += (c > 0u) ? 1u : 0u; mine = (j == x) ? c : mine; }
        if (sum == G) break;
        __builtin_amdgcn_s_sleep(1);
        if ((++sp & 255u) == 0u) { if (xb_ld(&bar[XB_TMO])) break; if (sp > XB_SPIN_CAP) { atomicAdd(&bar[XB_TMO], 1u); break; } }
    }
    nloc = mine > 0u ? mine : 1u; nx = cnt > 0u ? cnt : 1u;
}

__device__ __forceinline__ void xcd_barrier(const XcdBarrier& b, const bool leader  ) {
    asm volatile("s_waitcnt vmcnt(0)" ::: "memory");
    __syncthreads();
    if (leader) {
        unsigned* bar = b.bar;
        __builtin_amdgcn_s_waitcnt(0);
        unsigned nloc = b.st[0], nx = b.st[1];
        if (nloc == 0u) { xcd_barrier_complete(bar, b.x, nloc, nx); b.st[0] = nloc; b.st[1] = nx; }
        const unsigned old = xb_add(&bar[XB_XSUB(b.x)], 1u);
        const unsigned gen = old / nloc;
        if (old + 1u == (gen + 1u) * nloc) {
            __builtin_amdgcn_fence(__ATOMIC_RELEASE, "agent");
            asm volatile("s_waitcnt vmcnt(0)" ::: "memory");
            const unsigned og = xb_add(&bar[XB_TOP], 1u);
            const unsigned tg = og / nx;
            if (og + 1u == (tg + 1u) * nx) xb_add(&bar[XB_TOPGEN], 1u);
            else XB_SPIN(xb_ld(&bar[XB_TOPGEN]) == tg, bar);
            __builtin_amdgcn_fence(__ATOMIC_ACQUIRE, "agent");
            xb_add(&bar[XB_XGEN(b.x)], 1u);
            asm volatile("s_waitcnt vmcnt(0)" ::: "memory");
        } else {
            XB_SPIN(xb_ld(&bar[XB_XGEN(b.x)]) == gen, bar);
            __builtin_amdgcn_fence(__ATOMIC_ACQUIRE, "agent");
            asm volatile("s_waitcnt vmcnt(0)" ::: "memory");
        }
    }
    __syncthreads();
}

struct Ctx { LAS unsigned char* lds; int tid, lane, wave, vcu, G; };

__device__ __forceinline__ void transpose_load64(const float* W, int ldw, int k0, int n0, LAS float* scr, int lane) {
#pragma unroll 8
    for (int i = 0; i < 16; ++i) { const int kk = 4 * i + (lane >> 4), nn = 4 * (lane & 15); const f32x4 v = *(const f32x4*)(W + (size_t)(k0 + kk) * ldw + n0 + nn);
        LAS float* d = scr + kk * 65 + nn; d[0] = v.x; d[1] = v.y; d[2] = v.z; d[3] = v.w; }
    LDS_WAIT();
}
__device__ __forceinline__ void transpose_item(const float* W, int ldw, int K, bf16_t* dst, int k0, int n0, LAS float* scr, int lane) {
    transpose_load64(W, ldw, k0, n0, scr, lane);
    const int c = lane & 7;
#pragma unroll
    for (int j = 0; j < 8; ++j) { const int n = (lane >> 3) + 8 * j; const LAS float* s = scr + (8 * c) * 65 + n;
        u32x4 o; o.x = pk2(s[0 * 65], s[1 * 65]); o.y = pk2(s[2 * 65], s[3 * 65]); o.z = pk2(s[4 * 65], s[5 * 65]); o.w = pk2(s[6 * 65], s[7 * 65]);
        *(u32x4*)(dst + (size_t)n * K + k0 + 8 * c) = o; }
    LDS_WAIT();
}
__device__ __forceinline__ void transpose_item8(const float* W, int ldw, int K, unsigned char* dst, int k0, int n0, float scale, LAS float* scr, int lane) {
    transpose_load64(W, ldw, k0, n0, scr, lane);
    const int c = lane & 3;
#pragma unroll
    for (int j = 0; j < 4; ++j) { const int n = (lane >> 2) + 16 * j; const LAS float* s = scr + (16 * c) * 65 + n;
        u32x4 o; o.x = cvt4_fp8(s[0 * 65] * scale, s[1 * 65] * scale, s[2 * 65] * scale, s[3 * 65] * scale); o.y = cvt4_fp8(s[4 * 65] * scale, s[5 * 65] * scale, s[6 * 65] * scale, s[7 * 65] * scale);
        o.z = cvt4_fp8(s[8 * 65] * scale, s[9 * 65] * scale, s[10 * 65] * scale, s[11 * 65] * scale); o.w = cvt4_fp8(s[12 * 65] * scale, s[13 * 65] * scale, s[14 * 65] * scale, s[15 * 65] * scale);
        *(u32x4*)(dst + (size_t)n * K + k0 + 16 * c) = o; }
    LDS_WAIT();
}

__device__ __forceinline__ void ph_prologue(const Ctx& X, const float* c, const float* w_ada, const float* b_ada, float* mod,
                                            const float* w_in, const float* w_conv_out, const float* w_hgrn_out, const float* w_out, const float* w1, const float* w2, unsigned char* ws) {
    if (X.vcu < 48) {
        LAS float* ca = (LAS float*)X.lds;
        LAS float* red = (LAS float*)(X.lds + 16384);
        for (int i = X.tid; i < 4096; i += 512) { const float v = c[i]; ca[i] = v * sigmoidf_(v); }
        __syncthreads();
        const int jj = X.tid & 127, kq = X.tid >> 7, j = X.vcu * 128 + jj;
        float a0 = 0.f, a1 = 0.f, a2 = 0.f, a3 = 0.f;
#pragma unroll 8
        for (int i = kq * 256; i < kq * 256 + 256; ++i) { const float w = w_ada[(size_t)i * NMOD + j]; a0 += ca[i] * w; a1 += ca[1024 + i] * w; a2 += ca[2048 + i] * w; a3 += ca[3072 + i] * w; }
        red[(kq * 4 + 0) * 128 + jj] = a0; red[(kq * 4 + 1) * 128 + jj] = a1; red[(kq * 4 + 2) * 128 + jj] = a2; red[(kq * 4 + 3) * 128 + jj] = a3;
        __syncthreads();
        { const int b = X.tid >> 7; mod[(size_t)b * NMOD + j] = b_ada[j] + red[(0 * 4 + b) * 128 + jj] + red[(1 * 4 + b) * 128 + jj] + red[(2 * 4 + b) * 128 + jj] + red[(3 * 4 + b) * 128 + jj]; }
        __syncthreads();
    }
    LAS float* scr = (LAS float*)(X.lds + X.wave * 16640);
    const int gw = X.vcu * 8 + X.wave, NGW = X.G * 8;
    constexpr int I_IN = 16 * 128, I_SQ = 16 * 16, I_W1 = 32 * 16 * 32, I_W2 = 32 * 16 * 16, NITEMS = I_IN + 3 * I_SQ + I_W1 + I_W2;
    for (int it = gw; it < NITEMS; it += NGW) {
        int r = it;
        if (r < I_IN) { const int kb = r >> 7, nb = r & 127, n0 = 64 * nb;
            const int rho0 = (n0 < 2048) ? 256 * ((n0 & 1023) >> 7) + 128 * (n0 >> 10) + (n0 & 127) : n0;
            transpose_item(w_in, 8192, 1024, (bf16_t*)(ws + WS_WIN) + (size_t)rho0 * 1024, 64 * kb, n0, scr, X.lane); continue; } r -= I_IN;
        if (r < 3 * I_SQ) { const int which = r / I_SQ, q = r % I_SQ, kb = q >> 4, nb = q & 15;
            const float* W = which == 0 ? w_conv_out : (which == 1 ? w_hgrn_out : w_out);
            if (which == 2) transpose_item(W, 1024, 1024, (bf16_t*)(ws + WS_WO) + (size_t)(64 * nb) * 1024, 64 * kb, 64 * nb, scr, X.lane);
            else transpose_item(W, 1024, 2048, (bf16_t*)(ws + WS_WC) + (size_t)(64 * nb) * 2048 + which * 1024, 64 * kb, 64 * nb, scr, X.lane);
            continue; } r -= 3 * I_SQ;
        if (r < I_W1) { const int e = r >> 9, q = r & 511, kb = q >> 5, nb = q & 31, n0 = 64 * nb;
            const int rho0 = (n0 < 1024) ? 256 * (n0 >> 7) + (n0 & 127) : 256 * ((n0 - 1024) >> 7) + 128 + ((n0 - 1024) & 127);
            transpose_item8(w1 + (size_t)e * 1024 * 2048, 2048, 1024, (unsigned char*)(ws + WS_W1) + ((size_t)e * 2048 + rho0) * 1024, 64 * kb, n0, 256.0f, scr, X.lane); continue; } r -= I_W1;
        { const int e = r >> 8, q = r & 255, kb = q >> 4, nb = q & 15;
            transpose_item8(w2 + (size_t)e * 1024 * 1024, 1024, 1024, (unsigned char*)(ws + WS_W2) + ((size_t)e * 1024 + 64 * nb) * 1024, 64 * kb, 64 * nb, 256.0f, scr, X.lane); }
    }
}

__device__ __forceinline__ void ph_norm_mod(const Ctx& X, const float* x, const float* g, const float* mod, int sh_off, int sc_off, bf16_t* out) {
    for (int t = X.vcu * 8 + X.wave; t < T; t += X.G * 8) {
        const int b = t / SEQ, lane = X.lane;
        const f32x4* xr = (const f32x4*)(x + (size_t)t * D) + lane;
        f32x4 v[4]; float ss = 0.f;
#pragma unroll
        for (int j = 0; j < 4; ++j) { v[j] = xr[64 * j]; ss += (v[j].x * v[j].x + v[j].y * v[j].y) + (v[j].z * v[j].z + v[j].w * v[j].w); }
        const float r = rsqrtf(wave_sum(ss) * (1.0f / D) + EPS);
        const float* sh = mod + (size_t)b * NMOD + sh_off; const float* sc = mod + (size_t)b * NMOD + sc_off;
#pragma unroll
        for (int j = 0; j < 4; ++j) {
            const int col = 4 * (lane + 64 * j);
            const f32x4 gg = *(const f32x4*)(g + col), s1 = *(const f32x4*)(sc + col), s0 = *(const f32x4*)(sh + col);
            const f32x4 y = v[j] * r * gg * (s1 + 1.0f) + s0;
            u32x2 w; w.x = pk2(y.x, y.y); w.y = pk2(y.z, y.w);
            *(u32x2*)(out + (size_t)t * D + col) = w;
        }
    }
}

__device__ __forceinline__ void ph_conv(const Ctx& X, const bf16_t* pU, const float* dw, const float* dwb, const float* lng, const float* lnb, bf16_t* uc) {
    LAS float* sm = (LAS float*)X.lds;
    const int tid = X.tid, lane = X.lane, wid = X.wave, c0 = 2 * tid;
    float w[31][2];
#pragma unroll
    for (int j = 0; j < 31; ++j) { w[j][0] = dw[j * 1024 + c0]; w[j][1] = dw[j * 1024 + c0 + 1]; }
    const float bias0 = dwb[c0], bias1 = dwb[c0 + 1];
    for (int task = X.vcu; task < T / 32; task += X.G) {
        const int b = task >> 8, s0 = (task & 255) * 32;
        const bf16_t* qu = pU + (size_t)(b * SEQ) * D + c0;
        float u[38][2];
#pragma unroll
        for (int st = 0; st < 4; ++st) {
#pragma unroll
            for (int i = (st == 0 ? 0 : 8 * st + 30); i < 8 * st + 38; ++i) {
                const int s = s0 - 30 + i;
                float u0 = 0.f, u1 = 0.f;
                if (s >= 0) { const unsigned u2 = *(const unsigned*)(qu + (size_t)s * D); u0 = bflo(u2); u1 = bfhi(u2); }
                u[i % 38][0] = u0; u[i % 38][1] = u1;
            }
#pragma unroll
            for (int t = 8 * st; t < 8 * st + 8; ++t) {
                float a0 = bias0, a1 = bias1;
#pragma unroll
                for (int j = 0; j < 31; ++j) { a0 += w[j][0] * u[(t + j) % 38][0]; a1 += w[j][1] * u[(t + j) % 38][1]; }
                sm[t * 1024 + c0] = a0; sm[t * 1024 + c0 + 1] = a1;
            }
        }
        __syncthreads();
#pragma unroll 1
        for (int i = 0; i < 4; ++i) {
            const int t = wid * 4 + i;
            f32x4 v[4]; float s = 0.f;
#pragma unroll
            for (int j = 0; j < 4; ++j) { v[j] = *(const LAS f32x4*)(sm + t * 1024 + 4 * (lane + 64 * j)); s += (v[j].x + v[j].y) + (v[j].z + v[j].w); }
            const float mean = wave_sum(s) * (1.0f / D); float q = 0.f;
#pragma unroll
            for (int j = 0; j < 4; ++j) { v[j] = v[j] - mean; q += (v[j].x * v[j].x + v[j].y * v[j].y) + (v[j].z * v[j].z + v[j].w * v[j].w); }
            const float rstd = rsqrtf(wave_sum(q) * (1.0f / D) + EPS);
#pragma unroll
            for (int j = 0; j < 4; ++j) {
                const int col = 4 * (lane + 64 * j);
                const f32x4 gg = *(const f32x4*)(lng + col), bb = *(const f32x4*)(lnb + col);
                f32x4 y = v[j] * rstd * gg + bb;
                y.x *= sigmoidf_(y.x); y.y *= sigmoidf_(y.y); y.z *= sigmoidf_(y.z); y.w *= sigmoidf_(y.w);
                u32x2 o; o.x = pk2(y.x, y.y); o.y = pk2(y.z, y.w);
                *(u32x2*)(uc + (size_t)(b * SEQ + s0 + t) * (2 * D) + col) = o;
            }
        }
        __syncthreads();
    }
}

typedef short bf16x8 __attribute__((ext_vector_type(8)));
typedef short s16x4 __attribute__((ext_vector_type(4)));
typedef float f32x2 __attribute__((ext_vector_type(2)));
constexpr int HG_QA = 0, HG_KA = 17408, HG_VR = 34816, HG_AB = 52224, HG_SPT = 61440, HG_O = 96256, HG_SEG = 130048;
constexpr size_t HM = (size_t)SEQ * 128;
__device__ __forceinline__ bf16x8 tr_frag(LAS unsigned char* base, int rs, int ks, int c16, int lane) {
    const int g = lane >> 4, q = (lane & 15) >> 2, p = lane & 3;
    LAS unsigned char* a = base + (32 * ks + 8 * g + q) * rs + (16 * c16 + 4 * p) * 2;
    const s16x4 lo = __builtin_amdgcn_ds_read_tr16_b64_v4i16((LAS s16x4*)a);
    const s16x4 hi = __builtin_amdgcn_ds_read_tr16_b64_v4i16((LAS s16x4*)(a + 4 * rs));
    return __builtin_shufflevector(lo, hi, 0, 1, 2, 3, 4, 5, 6, 7);
}
template <bool OUT>
__device__ __forceinline__ void ph_hgrn(const Ctx& X, int ntask, const bf16_t* pQ, const bf16_t* pF, const bf16_t* pI, const bf16_t* pG,
                                        const float* lb_param, const float* norm_g, const float* S0, float* dS, float* Dd, bf16_t* og) {
    LAS unsigned char* L = X.lds;
    LAS float* seg_s = (LAS float*)(L + HG_SEG);
    const int tid = X.tid, lane = X.lane, wave = X.wave, fr = lane & 15, fq = lane >> 4, wr = wave >> 1, wc = wave & 1;
    const int cp = tid & 63, seg = wave, tv = tid >> 3, vc = tid & 7;
    int idx = X.vcu; if (idx >= ntask) return;
    int ch = 0;
    unsigned zr[8], qr[8]; u32x4 vr0, vr1, gn0, gn1, gc0, gc1;
#define HG_LOAD(idx_, ch_) do { const int bh_ = (idx_) & 31, sc_ = (idx_) >> 5; const size_t tb_ = (size_t)bh_ * HM + (size_t)(sc_ * 256 + (ch_) * 64) * 128; \
        _Pragma("unroll") for (int i = 0; i < 8; ++i) { zr[i] = *(const unsigned*)(pF + tb_ + (size_t)(8 * seg + i) * 128 + 2 * cp); if (OUT) qr[i] = *(const unsigned*)(pQ + tb_ + (size_t)(8 * seg + i) * 128 + 2 * cp); } \
        { const u32x4* s_ = (const u32x4*)(pI + tb_ + (size_t)tv * 128 + vc * 16); vr0 = s_[0]; vr1 = s_[1]; } \
        if (OUT) { const u32x4* s_ = (const u32x4*)(pG + tb_ + (size_t)tv * 128 + vc * 16); gn0 = s_[0]; gn1 = s_[1]; } } while (0)
    HG_LOAD(idx, 0);
    float ngv[16];
    if (OUT) {
#pragma unroll
        for (int i = 0; i < 16; ++i) ngv[i] = norm_g[vc * 16 + i];
    }
    f32x4 S[8]; float oml0 = 0.f, oml1 = 0.f, gsum0 = 0.f, gsum1 = 0.f;
#pragma unroll 1
    for (;;) {
        const int sc = idx >> 5, bh = idx & 31, b = bh >> 3, h = bh & 7;
        if (ch == 0) {
            const int c0 = h * 128 + 2 * cp;
            oml0 = 1.0f - 1.0f / (1.0f + __expf(lb_param[1024 + c0] - lb_param[c0])); oml1 = 1.0f - 1.0f / (1.0f + __expf(lb_param[1025 + c0] - lb_param[c0 + 1]));
            gsum0 = 0.f; gsum1 = 0.f;
            if (OUT && sc > 0) { const float* s0 = S0 + (size_t)(bh * 32 + sc) * 16384;
#pragma unroll
                for (int vt = 0; vt < 8; ++vt)
#pragma unroll
                    for (int j = 0; j < 4; ++j) S[vt][j] = s0[(size_t)(16 * wave + fq * 4 + j) * 128 + vt * 16 + fr];
            } else {
#pragma unroll
                for (int vt = 0; vt < 8; ++vt) S[vt] = (f32x4){0.f, 0.f, 0.f, 0.f};
            }
        }
        float kk0[8], kk1[8], lf0[8], lf1[8], q0[8], q1[8];
        {
            float c0 = 0.f, c1 = 0.f;
#pragma unroll
            for (int i = 0; i < 8; ++i) {
                kk0[i] = oml0 * __builtin_amdgcn_rcpf(1.0f + __expf(bflo(zr[i]))); kk1[i] = oml1 * __builtin_amdgcn_rcpf(1.0f + __expf(bfhi(zr[i])));
                c0 += __logf(1.0f - kk0[i]); c1 += __logf(1.0f - kk1[i]); lf0[i] = c0; lf1[i] = c1;
                if (OUT) { q0[i] = bflo(qr[i]) * 0.08838834764831845f; q1[i] = bfhi(qr[i]) * 0.08838834764831845f; }
            }
            *(LAS f32x2*)(seg_s + seg * 128 + 2 * cp) = (f32x2){c0, c1};
        }
        if (OUT) { gc0 = gn0; gc1 = gn1; }
        const u32x4 vcur0 = vr0, vcur1 = vr1;
        __syncthreads();
        { LAS u32x4* d = (LAS u32x4*)(L + HG_VR + tv * 272 + vc * 32); d[0] = vcur0; d[1] = vcur1; }
        { int idx2 = idx, ch2 = ch + 1; if (ch2 == 4) { ch2 = 0; idx2 = idx + X.G; } if (idx2 < ntask) HG_LOAD(idx2, ch2); }
        {
            f32x2 ss[8];
#pragma unroll
            for (int s = 0; s < 8; ++s) ss[s] = *(const LAS f32x2*)(seg_s + s * 128 + 2 * cp);
            float off0 = 0.f, off1 = 0.f;
#pragma unroll
            for (int s = 0; s < 8; ++s) { off0 += (s < seg) ? ss[s].x : 0.f; off1 += (s < seg) ? ss[s].y : 0.f; }
            const float R0 = (ss[0].x + ss[1].x) + (ss[2].x + ss[3].x), R1 = (ss[0].y + ss[1].y) + (ss[2].y + ss[3].y);
            if (!OUT && seg == 0) { gsum0 += R0 + (ss[4].x + ss[5].x) + (ss[6].x + ss[7].x); gsum1 += R1 + (ss[4].y + ss[5].y) + (ss[6].y + ss[7].y); }
#pragma unroll
            for (int i = 0; i < 8; ++i) {
                const float G0 = off0 + lf0[i], G1 = off1 + lf1[i];
                const float ka0 = kk0[i] * __expf(fminf(R0 - G0, 80.0f)), ka1 = kk1[i] * __expf(fminf(R1 - G1, 80.0f));
                *(LAS unsigned*)(L + HG_KA + (8 * seg + i) * 272 + 4 * cp) = pk2(ka0, ka1);
                if (OUT) { const float qa0 = q0[i] * __expf(fminf(G0 - R0, 80.0f)), qa1 = q1[i] * __expf(fminf(G1 - R1, 80.0f));
                           *(LAS unsigned*)(L + HG_QA + (8 * seg + i) * 272 + 4 * cp) = pk2(qa0, qa1); }
            }
        }
        float eR[4], eL[4];
        {
            f32x4 r4 = (f32x4){0.f, 0.f, 0.f, 0.f}, l4 = (f32x4){0.f, 0.f, 0.f, 0.f};
#pragma unroll
            for (int s = 0; s < 4; ++s) { r4 += *(const LAS f32x4*)(seg_s + s * 128 + 16 * wave + 4 * fq); l4 += *(const LAS f32x4*)(seg_s + (s + 4) * 128 + 16 * wave + 4 * fq); }
#pragma unroll
            for (int j = 0; j < 4; ++j) { eR[j] = __expf(fmaxf(r4[j], -80.0f)); eL[j] = __expf(l4[j]); }
        }
#pragma unroll
        for (int vt = 0; vt < 8; ++vt) {
#pragma unroll
            for (int j = 0; j < 4; ++j) S[vt][j] *= eR[j];
            if (OUT) { u32x2 w; w.x = pk2(S[vt][0], S[vt][1]); w.y = pk2(S[vt][2], S[vt][3]);
                       *(LAS u32x2*)(L + HG_SPT + (vt * 16 + fr) * 272 + (16 * wave + 4 * fq) * 2) = w; }
        }
        __syncthreads();
        if (OUT) {
#pragma unroll
            for (int q2 = 0; q2 < 2; ++q2) {
                const int st = 2 * wc + q2;
                f32x4 acc = (f32x4){0.f, 0.f, 0.f, 0.f};
                if (st <= wr) {
#pragma unroll
                    for (int kq = 0; kq < 4; ++kq) {
                        const bf16x8 af = *(const LAS bf16x8*)(L + HG_KA + (st * 16 + fr) * 272 + kq * 64 + fq * 16);
                        const bf16x8 bq = *(const LAS bf16x8*)(L + HG_QA + (wr * 16 + fr) * 272 + kq * 64 + fq * 16);
                        acc = __builtin_amdgcn_mfma_f32_16x16x32_bf16(af, bq, acc, 0, 0, 0);
                    }
                    const int tt = wr * 16 + fr;
#pragma unroll
                    for (int j = 0; j < 4; ++j) { const int s_ = st * 16 + fq * 4 + j; acc[j] = (s_ <= tt) ? acc[j] : 0.f; }
                }
                u32x2 w; w.x = pk2(acc[0], acc[1]); w.y = pk2(acc[2], acc[3]);
                *(LAS u32x2*)(L + HG_AB + (wr * 16 + fr) * 144 + (st * 16 + fq * 4) * 2) = w;
            }
        }
        {
            bf16x8 aK[2];
#pragma unroll
            for (int ks = 0; ks < 2; ++ks) aK[ks] = tr_frag(L + HG_KA, 272, ks, wave, lane);
#pragma unroll
            for (int vt = 0; vt < 8; ++vt) {
#pragma unroll
                for (int ks = 0; ks < 2; ++ks) { const bf16x8 bv = tr_frag(L + HG_VR, 272, ks, vt, lane); S[vt] = __builtin_amdgcn_mfma_f32_16x16x32_bf16(aK[ks], bv, S[vt], 0, 0, 0); }
#pragma unroll
                for (int j = 0; j < 4; ++j) S[vt][j] *= eL[j];
            }
        }
        if (OUT) {
            __syncthreads();
            bf16x8 aA[2], aQ[4];
#pragma unroll
            for (int ks = 0; ks < 2; ++ks) aA[ks] = *(const LAS bf16x8*)(L + HG_AB + (wr * 16 + fr) * 144 + ks * 64 + fq * 16);
#pragma unroll
            for (int kq = 0; kq < 4; ++kq) aQ[kq] = *(const LAS bf16x8*)(L + HG_QA + (wr * 16 + fr) * 272 + kq * 64 + fq * 16);
#pragma unroll
            for (int n = 0; n < 4; ++n) {
                const int vt = wc * 4 + n;
                f32x4 o = (f32x4){0.f, 0.f, 0.f, 0.f};
#pragma unroll
                for (int ks = 0; ks < 2; ++ks) { const bf16x8 bv = tr_frag(L + HG_VR, 272, ks, vt, lane); o = __builtin_amdgcn_mfma_f32_16x16x32_bf16(aA[ks], bv, o, 0, 0, 0); }
#pragma unroll
                for (int kq = 0; kq < 4; ++kq) { const bf16x8 bs = *(const LAS bf16x8*)(L + HG_SPT + (vt * 16 + fr) * 272 + kq * 64 + fq * 16); o = __builtin_amdgcn_mfma_f32_16x16x32_bf16(aQ[kq], bs, o, 0, 0, 0); }
#pragma unroll
                for (int j = 0; j < 4; ++j) *(LAS float*)(L + HG_O + (wr * 16 + fq * 4 + j) * 528 + (vt * 16 + fr) * 4) = o[j];
            }
            __syncthreads();
            {
                f32x4 ov[4]; float ssq = 0.f;
#pragma unroll
                for (int i = 0; i < 4; ++i) { ov[i] = *(const LAS f32x4*)(L + HG_O + tv * 528 + vc * 64 + i * 16); ssq += (ov[i].x * ov[i].x + ov[i].y * ov[i].y) + (ov[i].z * ov[i].z + ov[i].w * ov[i].w); }
                ssq += __shfl_xor(ssq, 1); ssq += __shfl_xor(ssq, 2); ssq += __shfl_xor(ssq, 4);
                const float rstd = rsqrtf(ssq * (1.0f / 128.0f) + EPS);
                const unsigned gw[8] = {gc0.x, gc0.y, gc0.z, gc0.w, gc1.x, gc1.y, gc1.z, gc1.w};
                unsigned ow[8];
#pragma unroll
                for (int i = 0; i < 8; ++i) { const float g0 = bflo(gw[i]), g1 = bfhi(gw[i]);
                    const float y0 = ov[i >> 1][(2 * i) & 3] * rstd * ngv[2 * i] * g0 * __builtin_amdgcn_rcpf(1.0f + __expf(-g0));
                    const float y1 = ov[i >> 1][(2 * i + 1) & 3] * rstd * ngv[2 * i + 1] * g1 * __builtin_amdgcn_rcpf(1.0f + __expf(-g1));
                    ow[i] = pk2(y0, y1); }
                u32x4* d = (u32x4*)(og + (size_t)(b * SEQ + sc * 256 + ch * 64 + tv) * (2 * D) + h * 128 + vc * 16);
                d[0] = (u32x4){ow[0], ow[1], ow[2], ow[3]}; d[1] = (u32x4){ow[4], ow[5], ow[6], ow[7]};
            }
        }
        if (ch == 3) {
            if (!OUT) {
                float* ds = dS + (size_t)(bh * 32 + sc) * 16384;
#pragma unroll
                for (int vt = 0; vt < 8; ++vt)
#pragma unroll
                    for (int j = 0; j < 4; ++j) ds[(size_t)(16 * wave + fq * 4 + j) * 128 + vt * 16 + fr] = S[vt][j];
                if (seg == 0) *(f32x2*)(Dd + (size_t)(bh * 32 + sc) * 128 + 2 * cp) = (f32x2){__expf(gsum0), __expf(gsum1)};
            }
            idx += X.G; ch = 0; if (idx >= ntask) break;
        } else ++ch;
    }
#undef HG_LOAD
    __syncthreads();
}

__device__ __forceinline__ void ph_hg2(const Ctx& X, const float* dS, const float* Dd, float* S0) {
    for (int idx = X.vcu * 512 + X.tid; idx < 32 * 4096; idx += X.G * 512) {
        const int bh = idx >> 12, e4 = idx & 4095, k = e4 >> 5, v4 = (e4 & 31) * 4;
        f32x4 s = (f32x4){0.f, 0.f, 0.f, 0.f};
#pragma unroll 4
        for (int sc = 0; sc < 31; ++sc) { const float d = Dd[(size_t)(bh * 32 + sc) * 128 + k]; const f32x4 ds = *(const f32x4*)(dS + (size_t)(bh * 32 + sc) * 16384 + k * 128 + v4);
            s = s * d + ds; *(f32x4*)(S0 + (size_t)(bh * 32 + sc + 1) * 16384 + k * 128 + v4) = s; }
    }
}

__device__ __forceinline__ void ph_router_tables(const Ctx& X, const float* g_ffn, const float* mod, const float* w_router, const float* b_router, float* Bp, float* cb) {
    for (int i = X.vcu * 512 + X.tid; i < 4 * 1024 * 32; i += X.G * 512) { const int b = i >> 15, k = (i >> 5) & 1023;
        Bp[i] = g_ffn[k] * (1.0f + mod[(size_t)b * NMOD + 4 * D + k]) * w_router[i & 32767]; }
    const int gw = X.vcu * 8 + X.wave;
    if (gw < 128) { const int b = gw >> 5, e = gw & 31; float a = 0.f;
        for (int k = X.lane; k < 1024; k += 64) a += mod[(size_t)b * NMOD + 3 * D + k] * w_router[k * 32 + e];
        a = wave_sum(a); if (X.lane == 0) cb[gw] = a + b_router[e]; }
}

__device__ __forceinline__ void ph_route(const Ctx& X, const float* x1, const float* g_ffn, const float* mod, const float* Bp, const float* cb,
                                         unsigned char* h2, int* top_e, float* top_w, int* rank, int* hist_g) {
    LAS int* hist = (LAS int*)(X.lds + LDSCTL_OFF + 64);
    const int tid = X.tid, lane = X.lane, c = lane & 15, q = lane >> 4;
    for (int tile = X.vcu; tile < RT_NT; tile += X.G) {
        if (tid < 32) hist[tid] = 0;
        __syncthreads();
        const int tw = tile * RT_TILE + X.wave * 16, b = tw / SEQ;
        const float* xa = x1 + (size_t)(tw + c) * D + 4 * q;
        const float* bp = Bp + ((size_t)b * 1024 + 4 * q) * 32 + c;
        f32x4 acc0 = (f32x4){0.f, 0.f, 0.f, 0.f}, acc1 = acc0; float ss = 0.f;
#pragma unroll 4
        for (int m = 0; m < 64; ++m) {
            const f32x4 a4 = *(const f32x4*)(xa + 16 * m);
            float bv[8];
#pragma unroll
            for (int j = 0; j < 4; ++j) { bv[2 * j] = bp[(size_t)(16 * m + j) * 32]; bv[2 * j + 1] = bp[(size_t)(16 * m + j) * 32 + 16]; }
            ss += (a4.x * a4.x + a4.y * a4.y) + (a4.z * a4.z + a4.w * a4.w);
#pragma unroll
            for (int j = 0; j < 4; ++j) { acc0 = __builtin_amdgcn_mfma_f32_16x16x4f32(a4[j], bv[2 * j], acc0, 0, 0, 0); acc1 = __builtin_amdgcn_mfma_f32_16x16x4f32(a4[j], bv[2 * j + 1], acc1, 0, 0, 0); }
        }
        ss += __shfl_xor(ss, 16); ss += __shfl_xor(ss, 32);
        const float rs = rsqrtf(ss * (1.0f / D) + EPS);
        const float cb0 = cb[b * 32 + c], cb1 = cb[b * 32 + 16 + c];
#pragma unroll
        for (int reg = 0; reg < 4; ++reg) {
            const float rt = __shfl(rs, 4 * q + reg);
            float v0 = acc0[reg] * rt + cb0, v1 = acc1[reg] * rt + cb1;
            float sv[4]; int si[4];
#pragma unroll
            for (int rnd = 0; rnd < 4; ++rnd) {
                float bvv = v0; int bi = c; if (v1 > bvv) { bvv = v1; bi = 16 + c; }
#pragma unroll
                for (int o = 1; o < 16; o <<= 1) { const float ov = __shfl_xor(bvv, o); const int oi = __shfl_xor(bi, o); if (ov > bvv || (ov == bvv && oi < bi)) { bvv = ov; bi = oi; } }
                sv[rnd] = bvv; si[rnd] = bi; if (bi == c) v0 = -INFINITY; if (bi == 16 + c) v1 = -INFINITY;
            }
            const float e1 = __expf(sv[1] - sv[0]), e2 = __expf(sv[2] - sv[0]), e3 = __expf(sv[3] - sv[0]);
            const float inv = 1.0f / (1.0f + e1 + e2 + e3);
            if (c == 0) { const int t = tw + 4 * q + reg;
                const float ww[4] = {inv, e1 * inv, e2 * inv, e3 * inv};
#pragma unroll
                for (int rnd = 0; rnd < 4; ++rnd) { top_e[t * 4 + rnd] = si[rnd]; top_w[t * 4 + rnd] = ww[rnd]; rank[t * 4 + rnd] = atomicAdd((int*)&hist[si[rnd]], 1); }
            }
        }
        const float* sh = mod + (size_t)b * NMOD + 3 * D; const float* sc = mod + (size_t)b * NMOD + 4 * D;
#pragma unroll 4
        for (int i = 0; i < 16; ++i) {
            const float r = __shfl(rs, i);
            const f32x4* xr = (const f32x4*)(x1 + (size_t)(tw + i) * D) + lane;
#pragma unroll
            for (int j = 0; j < 4; ++j) {
                const int col = 4 * (lane + 64 * j);
                const f32x4 gg = *(const f32x4*)(g_ffn + col), s1 = *(const f32x4*)(sc + col), s0 = *(const f32x4*)(sh + col);
                const f32x4 y = (xr[64 * j] * r * gg * (s1 + 1.0f) + s0) * 16.0f;
                *(unsigned*)(h2 + (size_t)(tw + i) * D + col) = cvt4_fp8(y.x, y.y, y.z, y.w);
            }
        }
        __syncthreads();
        if (tid < 32) hist_g[tile * 32 + tid] = hist[tid];
        __syncthreads();
    }
}

__device__ __forceinline__ void ph_sort(const Ctx& X, const int* hist_g, const int* top_e, const float* top_w, const int* rank, int* row_tok, float* row_w, int* pair_row, int* blk_e) {
    LAS int* s_hist = (LAS int*)X.lds;
    LAS int* s_tot = s_hist + RT_NT * 32; LAS int* s_pre = s_tot + 32; LAS int* s_base = s_pre + 32; LAS int* s_pstart = s_base + 32; LAS int* s_pend = s_pstart + 32;
    const int tid = X.tid;
    for (int i = tid; i < RT_NT * 32; i += 512) s_hist[i] = hist_g[i];
    __syncthreads();
    for (int tile = X.vcu; tile < RT_NT; tile += X.G) {
        if (tid < 32) { int tot = 0, pre = 0; for (int i = 0; i < RT_NT; ++i) { const int c = s_hist[i * 32 + tid]; tot += c; if (i < tile) pre += c; } s_tot[tid] = tot; s_pre[tid] = pre; }
        __syncthreads();
        if (tid == 0) { int acc = 0; for (int e = 0; e < 32; ++e) { const int padded = (s_tot[e] + 255) / 256 * 256; s_pstart[e] = acc; s_base[e] = acc + s_pre[e]; acc += padded; s_pend[e] = acc; } }
        __syncthreads();
        { const int i = tid; const int idx = tile * RT_TILE * 4 + i; const int e = top_e[idx]; const int row = s_base[e] + rank[idx];
          row_tok[row] = idx >> 2; row_w[row] = top_w[idx]; pair_row[idx] = row; }
        if (tile < 32) { const int e = tile; for (int r = s_pstart[e] + s_tot[e] + tid; r < s_pend[e]; r += 512) { row_tok[r] = 0; row_w[r] = 0.f; } }
        if (tile == 32) { for (int blk = tid; blk < NBLK_MAX; blk += 512) { int e = -1; const int r = blk * 256; for (int q = 0; q < 32; ++q) if (r >= s_pstart[q] && r < s_pend[q]) e = q; blk_e[blk] = e; }
                          if (tid == 0) blk_e[NBLK_MAX] = s_pend[31] / 256; }
        __syncthreads();
    }
}

__device__ __forceinline__ void ph_final(const Ctx& X, const float* x1, const bf16_t* y, const int* pair_row, const float* mod, const float* g_final, float* out, const float oscale) {
    const int lane = X.lane;
    for (int t = X.vcu * 8 + X.wave; t < T; t += X.G * 8) {
        const int b = t / SEQ;
        const f32x4* xr = (const f32x4*)(x1 + (size_t)t * D) + lane;
        const float* ga = mod + (size_t)b * NMOD + 5 * D;
        int rows[4];
#pragma unroll
        for (int k = 0; k < 4; ++k) rows[k] = pair_row[t * 4 + k];
        f32x4 v[4]; float ss = 0.f;
#pragma unroll
        for (int j = 0; j < 4; ++j) {
            const int col = 4 * (lane + 64 * j);
            f32x4 m = (f32x4){0.f, 0.f, 0.f, 0.f};
#pragma unroll
            for (int k = 0; k < 4; ++k) { const u32x2 w = *(const u32x2*)(y + (size_t)rows[k] * D + col); m.x += bflo(w.x); m.y += bfhi(w.x); m.z += bflo(w.y); m.w += bfhi(w.y); }
            v[j] = xr[64 * j] + *(const f32x4*)(ga + col) * m;
            ss += (v[j].x * v[j].x + v[j].y * v[j].y) + (v[j].z * v[j].z + v[j].w * v[j].w);
        }
        const float r = rsqrtf(wave_sum(ss) * (1.0f / D) + EPS);
#pragma unroll
        for (int j = 0; j < 4; ++j) { const int col = 4 * (lane + 64 * j); *(f32x4*)(out + (size_t)t * D + col) = v[j] * (r * oscale) * *(const f32x4*)(g_final + col); }
    }
}

constexpr int N_PHASES = 13;
struct Args { const float* in[23]; float* out; unsigned char* ws; int ph_lo, ph_hi; };
__global__ void __launch_bounds__(512, 2) fwd(Args a) {
    extern __shared__ __attribute__((aligned(16))) unsigned char lds_raw[];
    Ctx X; X.lds = (LAS unsigned char*)lds_raw; X.tid = threadIdx.x; X.lane = X.tid & 63; X.wave = __builtin_amdgcn_readfirstlane(X.tid >> 6);
    X.G = gridDim.x; { const int bx = blockIdx.x; X.vcu = (X.G % 8 == 0) ? (bx % 8) * (X.G / 8) + bx / 8 : bx; }
    unsigned char* ws = a.ws;
    for (int u = X.tid; u < (LDS_BYTES - LDSCTL_OFF) / 4; u += 512) ((LAS unsigned*)(X.lds + LDSCTL_OFF))[u] = 0u;
    __syncthreads();
    XcdBarrier bar = xcd_barrier_post((unsigned*)(ws + WS_CTL) + CW_BAR, (volatile LAS unsigned*)(X.lds + LDSCTL_OFF), X.tid == 0);
    const int lo = a.ph_lo, hi = a.ph_hi; float probe_scale = 1.0f;
#define IN(k) (lo <= (k) && (k) < hi)
#define SEAM(k) do { if (IN(k) && IN((k) + 1)) xcd_barrier(bar, X.wave == 0 && (int)__builtin_amdgcn_mbcnt_hi(~0u, __builtin_amdgcn_mbcnt_lo(~0u, 0u)) == 0); } while (0)
#ifdef PROBE_PH
    unsigned long long* stamps = (unsigned long long*)(ws + WS_CTL + 32768);
    if (blockIdx.x == 0 && X.tid == 0) stamps[0] = __builtin_amdgcn_s_memrealtime();
#undef SEAM
#define SEAM(k) do { if (IN(k) && IN((k) + 1)) { xcd_barrier(bar, X.wave == 0 && (int)__builtin_amdgcn_mbcnt_hi(~0u, __builtin_amdgcn_mbcnt_lo(~0u, 0u)) == 0); \
        if (blockIdx.x == 0 && X.wave == 0 && (int)__builtin_amdgcn_mbcnt_hi(~0u, __builtin_amdgcn_mbcnt_lo(~0u, 0u)) == 0) stamps[(k) + 1] = __builtin_amdgcn_s_memrealtime(); } } while (0)
#endif
    const float* x = a.in[0]; const float* c = a.in[1]; const float* w_ada = a.in[2]; const float* b_ada = a.in[3];
    const float* g_mix = a.in[4]; const float* w_in = a.in[5]; const float* conv_dw = a.in[6]; const float* conv_dwb = a.in[7];
    const float* conv_ln_g = a.in[8]; const float* conv_ln_b = a.in[9]; const float* w_conv_out = a.in[10]; const float* lb_param = a.in[11];
    const float* hgrn_norm_g = a.in[12]; const float* w_hgrn_out = a.in[13]; const float* w_out = a.in[14]; const float* g_ffn = a.in[15];
    const float* w_router = a.in[16]; const float* b_router = a.in[17]; const float* w1 = a.in[18]; const float* b1 = a.in[19];
    const float* w2 = a.in[20]; const float* b2 = a.in[21]; const float* g_final = a.in[22];
    float* mod = (float*)(ws + WS_MOD); float* rt_bp = (float*)(ws + WS_BP); float* rt_cb = (float*)(ws + WS_CB);
    int* hist_g = (int*)(ws + WS_HIST); int* blk_e = (int*)(ws + WS_BLKE); int* top_e = (int*)(ws + WS_TOPE); float* top_w = (float*)(ws + WS_TOPW);
    int* rank = (int*)(ws + WS_RANK); int* pair_row = (int*)(ws + WS_PROW); int* row_tok = (int*)(ws + WS_RTOK); float* row_w = (float*)(ws + WS_RW);
    bf16_t* p = (bf16_t*)(ws + WS_P);
    bf16_t* h = (bf16_t*)(ws + WS_E); float* tmp = (float*)(ws + WS_E);
    float* hg_dS = (float*)(ws + WS_E); float* hg_S0 = (float*)(ws + WS_E + 64 * MiB); float* hg_D = (float*)(ws + WS_HGD);
    bf16_t* uc = (bf16_t*)(ws + WS_D); bf16_t* og = uc + D;   float* x1 = (float*)(ws + WS_D);
    bf16_t* merged = p;
    unsigned char* h2 = (unsigned char*)p;
    unsigned char* act = (unsigned char*)(p + PG);
    bf16_t* y = p + PG + (size_t)R_PAD * D / 2;
    PG8_LAS unsigned char* ring = (PG8_LAS unsigned char*)lds_raw;

#ifndef REPMASK
#define REPMASK 0
#endif
#ifndef REPN
#define REPN 1
#endif
#define PH(k, ...) do { if (IN(k)) { _Pragma("unroll 1") for (int rep_ = 0; rep_ < ((((REPMASK) >> (k)) & 1) ? 1 + REPN : 1); ++rep_) { if (rep_) __syncthreads(); { int ln_ = (int)__builtin_amdgcn_mbcnt_hi(~0u, __builtin_amdgcn_mbcnt_lo(~0u, 0u)); asm volatile("" : "+v"(ln_)); X.lane = ln_; X.tid = X.wave * 64 + ln_; } __VA_ARGS__ } } SEAM(k); } while (0)
    PH(0, ph_prologue(X, c, w_ada, b_ada, mod, w_in, w_conv_out, w_hgrn_out, w_out, w1, w2, ws););
    PH(1, ph_norm_mod(X, x, g_mix, mod, 0, D, h); ph_router_tables(X, g_ffn, mod, w_router, b_router, rt_bp, rt_cb););
#ifndef STAGGER_TICKS
#define STAGGER_TICKS 0
#endif
    PH(2, { if (STAGGER_TICKS) { const unsigned long long t0_ = __builtin_amdgcn_s_memrealtime(), wait_ = (unsigned long long)(X.vcu & 3) * STAGGER_TICKS;
                while (__builtin_amdgcn_s_memrealtime() - t0_ < wait_) __builtin_amdgcn_s_sleep(8); }
        pg8::Gemm g{h, (const bf16_t*)(ws + WS_WIN), T, 8 * D, D}; pg8::StaticOrder S; S.init(T, 8 * D, X.G, (int)blockIdx.x);
        pg8::EpiSplitBf16 E{p, PG, 0x3cu, SEQ}; pg8::gemm_phase<pg8::EpiSplitBf16, pg8::StaticOrder, true, true>(ring, g, S, E, X.wave); });
    PH(3, ph_conv(X, p + 0 * PG, conv_dw, conv_dwb, conv_ln_g, conv_ln_b, uc);
          if ((REPMASK >> 14) & 1) { __syncthreads(); ph_conv(X, p + 0 * PG, conv_dw, conv_dwb, conv_ln_g, conv_ln_b, uc); }
          ph_hgrn<false>(X, 31 * 32, p + 2 * PG, p + 3 * PG, p + 4 * PG, p + 5 * PG, lb_param, nullptr, nullptr, hg_dS, hg_D, nullptr);
          if ((REPMASK >> 15) & 1) { __syncthreads(); ph_hgrn<false>(X, 31 * 32, p + 2 * PG, p + 3 * PG, p + 4 * PG, p + 5 * PG, lb_param, nullptr, nullptr, hg_dS, hg_D, nullptr); });
    PH(4, ph_hg2(X, hg_dS, hg_D, hg_S0););
    PH(5, ph_hgrn<true>(X, 32 * 32, p + 2 * PG, p + 3 * PG, p + 4 * PG, p + 5 * PG, lb_param, hgrn_norm_g, hg_S0, nullptr, nullptr, og););
    PH(6, { pg8::Gemm g{uc, (const bf16_t*)(ws + WS_WC), T, D, 2 * D}; pg8::StaticOrder S; S.init(T, D, X.G, (int)blockIdx.x);
        pg8::EpiGateFused E{p + 6 * PG, p + 7 * PG, merged}; pg8::gemm_phase<pg8::EpiGateFused, pg8::StaticOrder, true, true>(ring, g, S, E, X.wave); });
    PH(7, { pg8::Gemm g{merged, (const bf16_t*)(ws + WS_WO), T, D, D}; pg8::StaticOrder S; S.init(T, D, X.G, (int)blockIdx.x);
        pg8::EpiRes E{x, mod + 2 * D, x1, NMOD, SEQ}; pg8::gemm_phase<pg8::EpiRes, pg8::StaticOrder, true, true>(ring, g, S, E, X.wave); });
    PH(8, ph_route(X, x1, g_ffn, mod, rt_bp, rt_cb, h2, top_e, top_w, rank, hist_g););
    PH(9, ph_sort(X, hist_g, top_e, top_w, rank, row_tok, row_w, pair_row, blk_e););
    PH(10, { const int nblk = blk_e[NBLK_MAX]; pg8::Gemm g{(const bf16_t*)h2, (const bf16_t*)(ws + WS_W1), T, 32 * 2048, D / 2}; pg8::MoeOrder S{blk_e, nblk, X.G, (int)blockIdx.x, 3};
        LAS unsigned short* gt = (LAS unsigned short*)(X.lds + LDSCTL_OFF + 256);
        _Pragma("unroll 1") for (int i = 0; i < 23; ++i) { pg8::Unit u; if (!S.next(i, u)) break; if (X.tid < 256) gt[256 * i + X.tid] = (unsigned short)row_tok[u.pm * 256 + X.tid]; }
        __syncthreads();
        pg8::EpiSwiglu8 E{b1, act, 1.0f / 4096.0f}; pg8::gemm_phase<pg8::EpiSwiglu8, pg8::MoeOrder, true, true, true, true>(ring, g, S, E, X.wave, (const PG8_LAS unsigned short*)gt); });
    PH(11, { const int nblk = blk_e[NBLK_MAX]; pg8::Gemm g{(const bf16_t*)act, (const bf16_t*)(ws + WS_W2), R_PAD, 32 * 1024, DFF / 2}; pg8::MoeOrder S{blk_e, nblk, X.G, (int)blockIdx.x, 2};
        pg8::EpiY8 E{b2, row_w, y, 1.0f / 1024.0f}; pg8::gemm_phase<pg8::EpiY8, pg8::MoeOrder, true, true, false, true>(ring, g, S, E, X.wave); });
#ifdef PROBE_PH
    { const unsigned long long* st_ = (const unsigned long long*)(ws + WS_CTL + 32768); const float dt_ = (float)(long long)(st_[PROBE_PH + 1] - st_[PROBE_PH]);
      probe_scale = 1.0f + dt_ * (1.0f / 200000.0f); }
#endif
    PH(12, ph_final(X, x1, y, pair_row, mod, g_final, a.out, probe_scale););
#undef PH
#undef IN
#undef SEAM
}

#ifndef MK_N_LAUNCHES
#define MK_N_LAUNCHES 1
#endif
extern "C" void kernel_launch(void* const* d_in, const int* in_sizes, int n_in, void* d_out, int out_size, void* d_ws, size_t ws_size, hipStream_t stream) {
    static int grid = 0;
    if (grid == 0) {
        if (n_in != 23 || out_size != T * D || ws_size < WS_END) { fprintf(stderr, "kernel_launch: unexpected n_in %d / out_size %d / ws_size %zu (< %zu); nothing launched\n", n_in, out_size, ws_size, (size_t)WS_END); grid = -1; return; }
        int dev = 0, cus = 0, per_cu = 0;
        if (hipGetDevice(&dev) != hipSuccess || hipDeviceGetAttribute(&cus, hipDeviceAttributeMultiprocessorCount, dev) != hipSuccess) { grid = -1; return; }
        if (hipFuncSetAttribute((const void*)fwd, hipFuncAttributeMaxDynamicSharedMemorySize, LDS_BYTES) != hipSuccess) { fprintf(stderr, "kernel_launch: hipFuncSetAttribute failed\n"); grid = -1; return; }
        if (hipOccupancyMaxActiveBlocksPerMultiprocessor(&per_cu, (const void*)fwd, 512, LDS_BYTES) != hipSuccess || per_cu < 1) { fprintf(stderr, "kernel_launch: occupancy query says %d blocks per CU\n", per_cu); }
        (void)hipGetLastError();
        grid = cus;
    }
    if (grid < 0) return;
    if (hipMemsetAsync((char*)d_ws + WS_CTL, 0, CTL_ZERO_BYTES, stream) != hipSuccess) return;
    Args a{};
    for (int i = 0; i < 23; ++i) a.in[i] = (const float*)d_in[i];
    a.out = (float*)d_out; a.ws = (unsigned char*)d_ws;
    if (MK_N_LAUNCHES == 1) { a.ph_lo = 0; a.ph_hi = N_PHASES; hipLaunchKernelGGL(fwd, dim3(grid), dim3(512), LDS_BYTES, stream, a); }
    else for (int ph = 0; ph < N_PHASES; ++ph) { a.ph_lo = ph; a.ph_hi = ph + 1; hipLaunchKernelGGL(fwd, dim3(grid), dim3(512), LDS_BYTES, stream, a); }
}
```

```cpp
#include <hip/hip_runtime.h>
#include <stdint.h>
#include <stdio.h>

#define GAS __attribute__((address_space(1)))
#define LAS __attribute__((address_space(3)))
typedef unsigned short bf16_t;
typedef unsigned u32x4 __attribute__((ext_vector_type(4)));
typedef unsigned u32x2 __attribute__((ext_vector_type(2)));
typedef float f32x4 __attribute__((ext_vector_type(4)));

constexpr int D = 1024, NBATCH = 4, SEQ = 8192, T = NBATCH * SEQ;
constexpr int NE = 32, DFF = 1024;
constexpr int NMOD = 6 * D;
constexpr int NBLK_MAX = 544, R_PAD = NBLK_MAX * 256;
constexpr int RT_TILE = 128, RT_NT = T / RT_TILE;
constexpr float EPS = 1e-6f;

constexpr size_t MiB = 1u << 20;
constexpr size_t WS_CTL = 0, CTL_ZERO_BYTES = 64 * 1024;
constexpr size_t WS_MOD = 1 * MiB;
constexpr size_t WS_CB = WS_MOD + 112 * 1024, WS_BP = WS_MOD + 128 * 1024;
constexpr size_t WS_HIST = 2 * MiB;
constexpr size_t WS_BLKE = WS_HIST + 64 * 1024;
constexpr size_t WS_TOPE = 3 * MiB;
constexpr size_t WS_TOPW = WS_TOPE + 512 * 1024;
constexpr size_t WS_RANK = WS_TOPW + 512 * 1024;
constexpr size_t WS_PROW = WS_RANK + 512 * 1024;
constexpr size_t WS_RTOK = 5 * MiB;
constexpr size_t WS_RW = 6 * MiB;
constexpr size_t WS_HGD = 7 * MiB;
constexpr size_t WS_WT = 8 * MiB;
constexpr size_t WS_WIN = WS_WT, WS_WC = WS_WT + 16 * MiB, WS_WH = WS_WT + 18 * MiB, WS_WO = WS_WT + 20 * MiB, WS_W1 = WS_WT + 22 * MiB, WS_W2 = WS_WT + 150 * MiB;
constexpr size_t WS_P = 224 * MiB;
constexpr size_t WS_E = WS_P + 512 * MiB;
constexpr size_t WS_D = WS_E + 128 * MiB;
constexpr size_t WS_END = WS_D + 128 * MiB;
constexpr size_t PG = (size_t)T * D;
constexpr int CW_BAR = 0;

constexpr int RING_BYTES = 135168, LDSCTL_OFF = RING_BYTES, LDS_BYTES = 147456;

__device__ __forceinline__ unsigned f2bf(float f) { unsigned u = __builtin_bit_cast(unsigned, f); return (u + 0x7fffu + ((u >> 16) & 1u)) >> 16; }
__device__ __forceinline__ unsigned pk2(float lo, float hi) { return f2bf(lo) | (f2bf(hi) << 16); }
__device__ __forceinline__ float bf2f(unsigned b) { return __builtin_bit_cast(float, b << 16); }
__device__ __forceinline__ float bflo(unsigned w) { return __builtin_bit_cast(float, w << 16); }
__device__ __forceinline__ float bfhi(unsigned w) { return __builtin_bit_cast(float, w & 0xffff0000u); }
__device__ __forceinline__ float sigmoidf_(float x) { return 1.0f / (1.0f + __expf(-x)); }
__device__ __forceinline__ float wave_sum(float v) {
#pragma unroll
    for (int o = 1; o < 64; o <<= 1) v += __shfl_xor(v, o);
    return v;
}
__device__ __forceinline__ unsigned cvt4_fp8(float a, float b, float c, float d) {
    a = fminf(fmaxf(a, -448.f), 448.f); b = fminf(fmaxf(b, -448.f), 448.f); c = fminf(fmaxf(c, -448.f), 448.f); d = fminf(fmaxf(d, -448.f), 448.f);
    int w = 0; w = __builtin_amdgcn_cvt_pk_fp8_f32(a, b, w, false); w = __builtin_amdgcn_cvt_pk_fp8_f32(c, d, w, true); return (unsigned)w; }
#define LDS_WAIT() asm volatile("s_waitcnt lgkmcnt(0)" ::: "memory")
#define VM_WAIT() asm volatile("s_waitcnt vmcnt(0)" ::: "memory")

namespace pg8 {
#define PG8_LAS __attribute__((address_space(3)))
typedef unsigned short bf16_t;
typedef short bf16x8 __attribute__((ext_vector_type(8)));
typedef float f32x4 __attribute__((ext_vector_type(4)));
typedef unsigned u32x4 __attribute__((ext_vector_type(4)));
constexpr int BM = 256, BK = 64, HALF = 128, HTB = HALF * BK * 2  , STAGE_BYTES = 8 * HTB, NXCD = 8, WGM = 8;

__host__ __device__ __forceinline__ int lds_byte(int r, int c) { const int st = (r >> 4) * 2 + (c >> 5), rr = r & 15, cc = c & 31, ob = rr * 64 + cc * 2; return st * 1024 + (ob ^ (((ob >> 9) & 1) << 5)); }
__host__ __device__ __forceinline__ void stage_rc(int b, int& R, int& C) { const int st = b / 1024, sb = b % 1024, swz = sb ^ (((sb >> 9) & 1) << 5); R = (st >> 1) * 16 + swz / 64; C = (st & 1) * 32 + (swz % 64) / 2; }
__host__ __device__ __forceinline__ int perm32(int rho) { const int n = rho >> 4, i = rho & 15; return 8 * (i >> 2) + 4 * n + (i & 3); }

struct Unit { int pm, pn; };
struct Gemm { const bf16_t* A; const bf16_t* Bt; int M, N, K; };

struct StaticOrder {
    int nM, nN, nwg, G, c;
    __host__ __device__ void init(int M, int N, int G_, int c_) { nM = M / BM; nN = N / BM; nwg = nM * nN; G = G_; c = c_; }
    __host__ __device__ bool next(int i, Unit& u) const {
        const long L = (long)i * G + c; if (L >= nwg) return false;
        int wgid = (int)L; { const int q = nwg / NXCD, r = nwg % NXCD, xcd = wgid % NXCD, off = wgid / NXCD; wgid = (xcd < r ? xcd * (q + 1) : r * (q + 1) + (xcd - r) * q) + off; }
        const int nig = WGM * nN, gid = wgid / nig, fm = gid * WGM, gsz = (nM - fm) < WGM ? (nM - fm) : WGM;
        u.pm = fm + ((wgid % nig) % gsz); u.pn = (wgid % nig) / gsz; return true;
    }
    __device__ __forceinline__ void a_ready(const Unit&) const {}
    __device__ __forceinline__ void done(const Unit&) const {}
};


struct MoeOrder {
    const int* blk_e; int nblk, G, c, lg;
    __device__ __forceinline__ bool next(int i, Unit& u) const {
        int blk, j;
        if (G == 256) { const int xcd = c & 7, idx = c >> 3, prb = 256 >> lg; blk = i * prb + xcd * (prb >> 3) + (idx >> lg); j = idx & ((1 << lg) - 1); }
        else { const long L = (long)i * G + c; blk = (int)(L >> lg); j = (int)(L & ((1 << lg) - 1)); }
        if (blk >= nblk) return false;
        const int e = blk_e[blk]; u.pm = blk; u.pn = (e << lg) + j; return true;
    }
    __device__ __forceinline__ void a_ready(const Unit&) const {}
    __device__ __forceinline__ void done(const Unit&) const {}
};

__device__ __forceinline__ unsigned cvt_pk_bf16(float lo, float hi) { unsigned r; asm volatile("v_cvt_pk_bf16_f32 %0, %1, %2" : "=v"(r) : "v"(lo), "v"(hi)); return r; }
__device__ __forceinline__ float sigm(float x) { return 1.0f / (1.0f + __expf(-x)); }
__device__ __forceinline__ float blo(unsigned w) { return __builtin_bit_cast(float, w << 16); }
__device__ __forceinline__ float bhi(unsigned w) { return __builtin_bit_cast(float, w & 0xffff0000u); }

struct EpiSplitBf16 {
    static constexpr bool PERM = true, AFTER_DRAIN = false;
    bf16_t* O; size_t split_stride; unsigned hm_mask; int seq;
    __device__ __forceinline__ void operator()(const f32x4 (&acc)[2][2][4][2], const Unit& u, int wr, int wc, int fr, int fq) const {
        const int row0 = u.pm * BM + wr * 64 + fr; const int colt = u.pn * BM; const int t = colt >> 10;
        if (u.pn < 8) {
#pragma unroll
            for (int ai = 0; ai < 2; ++ai)
#pragma unroll
                for (int m = 0; m < 4; ++m) { const int row = row0 + ai * HALF + m * 16; float r[8];
#pragma unroll
                    for (int q = 0; q < 4; ++q) { r[q] = acc[ai][0][m][0][q] * sigm(acc[ai][1][m][0][q]); r[4 + q] = acc[ai][0][m][1][q] * sigm(acc[ai][1][m][1][q]); }
                    u32x4 w; w.x = cvt_pk_bf16(r[0], r[1]); w.y = cvt_pk_bf16(r[2], r[3]); w.z = cvt_pk_bf16(r[4], r[5]); w.w = cvt_pk_bf16(r[6], r[7]);
                    *(u32x4*)(O + (size_t)row * 1024 + 128 * u.pn + wc * 32 + 8 * fq) = w; }
            return;
        }
        bf16_t* base = O + (size_t)t * split_stride; const int cg = colt & 1023;
        const bool hm = (hm_mask >> t) & 1u;
        const int bb = (u.pm * BM) / seq;
#pragma unroll
        for (int ai = 0; ai < 2; ++ai)
#pragma unroll
            for (int m = 0; m < 4; ++m) { const int row = row0 + ai * HALF + m * 16;
#pragma unroll
                for (int bj = 0; bj < 2; ++bj) { const f32x4 v0 = acc[ai][bj][m][0], v1 = acc[ai][bj][m][1];
                    u32x4 w; w.x = cvt_pk_bf16(v0[0], v0[1]); w.y = cvt_pk_bf16(v0[2], v0[3]); w.z = cvt_pk_bf16(v1[0], v1[1]); w.w = cvt_pk_bf16(v1[2], v1[3]);
                    const size_t o = hm ? ((size_t)(bb * 8 + (cg >> 7) + bj) * seq + (row - bb * seq)) * 128 + wc * 32 + 8 * fq
                                        : (size_t)row * 1024 + cg + bj * HALF + wc * 32 + 8 * fq;
                    *(u32x4*)(base + o) = w; } }
    }
};
struct EpiGate1 {
    static constexpr bool PERM = true, AFTER_DRAIN = false;
    const bf16_t* gate; float* tmp;
    __device__ __forceinline__ void operator()(const f32x4 (&acc)[2][2][4][2], const Unit& u, int wr, int wc, int fr, int fq) const {
        const int row0 = u.pm * BM + wr * 64 + fr, col0 = u.pn * BM + wc * 32 + 8 * fq;
#pragma unroll
        for (int ai = 0; ai < 2; ++ai)
#pragma unroll
            for (int m = 0; m < 4; ++m) { const size_t o = (size_t)(row0 + ai * HALF + m * 16) * 1024 + col0;
#pragma unroll
                for (int bj = 0; bj < 2; ++bj) { const u32x4 g = *(const u32x4*)(gate + o + bj * HALF); f32x4 v0 = acc[ai][bj][m][0], v1 = acc[ai][bj][m][1];
                    v0[0] *= sigm(blo(g.x)); v0[1] *= sigm(bhi(g.x)); v0[2] *= sigm(blo(g.y)); v0[3] *= sigm(bhi(g.y));
                    v1[0] *= sigm(blo(g.z)); v1[1] *= sigm(bhi(g.z)); v1[2] *= sigm(blo(g.w)); v1[3] *= sigm(bhi(g.w));
                    *(f32x4*)(tmp + o + bj * HALF) = v0; *(f32x4*)(tmp + o + bj * HALF + 4) = v1; } }
    }
};
struct EpiGate2 {
    static constexpr bool PERM = true, AFTER_DRAIN = false;
    const bf16_t* gate; const float* tmp; bf16_t* out;
    __device__ __forceinline__ void operator()(const f32x4 (&acc)[2][2][4][2], const Unit& u, int wr, int wc, int fr, int fq) const {
        const int row0 = u.pm * BM + wr * 64 + fr, col0 = u.pn * BM + wc * 32 + 8 * fq;
#pragma unroll
        for (int ai = 0; ai < 2; ++ai)
#pragma unroll
            for (int m = 0; m < 4; ++m) { const size_t o = (size_t)(row0 + ai * HALF + m * 16) * 1024 + col0;
#pragma unroll
                for (int bj = 0; bj < 2; ++bj) { const u32x4 g = *(const u32x4*)(gate + o + bj * HALF); f32x4 v0 = acc[ai][bj][m][0], v1 = acc[ai][bj][m][1];
                    const f32x4 t0 = *(const f32x4*)(tmp + o + bj * HALF), t1 = *(const f32x4*)(tmp + o + bj * HALF + 4);
                    v0[0] = t0[0] + v0[0] * sigm(blo(g.x)); v0[1] = t0[1] + v0[1] * sigm(bhi(g.x)); v0[2] = t0[2] + v0[2] * sigm(blo(g.y)); v0[3] = t0[3] + v0[3] * sigm(bhi(g.y));
                    v1[0] = t1[0] + v1[0] * sigm(blo(g.z)); v1[1] = t1[1] + v1[1] * sigm(bhi(g.z)); v1[2] = t1[2] + v1[2] * sigm(blo(g.w)); v1[3] = t1[3] + v1[3] * sigm(bhi(g.w));
                    u32x4 w; w.x = cvt_pk_bf16(v0[0], v0[1]); w.y = cvt_pk_bf16(v0[2], v0[3]); w.z = cvt_pk_bf16(v1[0], v1[1]); w.w = cvt_pk_bf16(v1[2], v1[3]);
                    *(u32x4*)(out + o + bj * HALF) = w; } }
    }
};
struct EpiRes {
    static constexpr bool PERM = true, AFTER_DRAIN = false;
    const float* x; const float* ga; bf16_t* out; int mod_pitch, seq;
    __device__ __forceinline__ void operator()(const f32x4 (&acc)[2][2][4][2], const Unit& u, int wr, int wc, int fr, int fq) const {
        const int row0 = u.pm * BM + wr * 64 + fr, col0 = u.pn * BM + wc * 32 + 8 * fq;
        const float* gab = ga + (size_t)((u.pm * BM) / seq) * mod_pitch + col0;
        f32x4 gv[2][2];
#pragma unroll
        for (int bj = 0; bj < 2; ++bj)
#pragma unroll
            for (int n = 0; n < 2; ++n) gv[bj][n] = *(const f32x4*)(gab + bj * HALF + 4 * n);
#pragma unroll
        for (int ai = 0; ai < 2; ++ai)
#pragma unroll
            for (int m = 0; m < 4; ++m) { const size_t o = (size_t)(row0 + ai * HALF + m * 16) * 1024 + col0;
#pragma unroll
                for (int bj = 0; bj < 2; ++bj) { const f32x4 x0 = *(const f32x4*)(x + o + bj * HALF), x1_ = *(const f32x4*)(x + o + bj * HALF + 4);
                    const f32x4 v0 = x0 + gv[bj][0] * acc[ai][bj][m][0], v1 = x1_ + gv[bj][1] * acc[ai][bj][m][1];
                    u32x4 w; w.x = cvt_pk_bf16(v0[0], v0[1]); w.y = cvt_pk_bf16(v0[2], v0[3]); w.z = cvt_pk_bf16(v1[0], v1[1]); w.w = cvt_pk_bf16(v1[2], v1[3]);
                    *(u32x4*)(out + o + bj * HALF) = w; } }
    }
};
struct EpiSwiglu {
    static constexpr bool PERM = true, AFTER_DRAIN = false;
    const float* b1; bf16_t* act;
    __device__ __forceinline__ void operator()(const f32x4 (&acc)[2][2][4][2], const Unit& u, int wr, int wc, int fr, int fq) const {
        const int e = u.pn >> 3, j = u.pn & 7; const int row0 = u.pm * BM + wr * 64 + fr, f0 = 128 * j + wc * 32 + 8 * fq;
        const float* be = b1 + (size_t)e * 2048 + f0;
        const f32x4 bg0 = *(const f32x4*)(be), bg1 = *(const f32x4*)(be + 4), bl0 = *(const f32x4*)(be + 1024), bl1 = *(const f32x4*)(be + 1028);
#pragma unroll
        for (int ai = 0; ai < 2; ++ai)
#pragma unroll
            for (int m = 0; m < 4; ++m) {
                f32x4 g0 = acc[ai][0][m][0] + bg0, g1 = acc[ai][0][m][1] + bg1, l0 = acc[ai][1][m][0] + bl0, l1 = acc[ai][1][m][1] + bl1;
                float r[8];
#pragma unroll
                for (int q = 0; q < 4; ++q) { float gl = fminf(g0[q], 7.0f), li = fminf(fmaxf(l0[q], -7.0f), 7.0f); r[q] = gl * sigm(1.702f * gl) * (li + 1.0f);
                                              gl = fminf(g1[q], 7.0f); li = fminf(fmaxf(l1[q], -7.0f), 7.0f); r[4 + q] = gl * sigm(1.702f * gl) * (li + 1.0f); }
                u32x4 w; w.x = cvt_pk_bf16(r[0], r[1]); w.y = cvt_pk_bf16(r[2], r[3]); w.z = cvt_pk_bf16(r[4], r[5]); w.w = cvt_pk_bf16(r[6], r[7]);
                *(u32x4*)(act + (size_t)(row0 + ai * HALF + m * 16) * 1024 + f0) = w; }
    }
};
struct EpiY {
    static constexpr bool PERM = true, AFTER_DRAIN = false;
    const float* b2; const float* rw; bf16_t* y;
    __device__ __forceinline__ void operator()(const f32x4 (&acc)[2][2][4][2], const Unit& u, int wr, int wc, int fr, int fq) const {
        const int e = u.pn >> 2, j = u.pn & 3; const int row0 = u.pm * BM + wr * 64 + fr, col0 = 256 * j + wc * 32 + 8 * fq;
        const float* be = b2 + (size_t)e * 1024 + col0;
        f32x4 bv[2][2];
#pragma unroll
        for (int bj = 0; bj < 2; ++bj)
#pragma unroll
            for (int n = 0; n < 2; ++n) bv[bj][n] = *(const f32x4*)(be + bj * HALF + 4 * n);
#pragma unroll
        for (int ai = 0; ai < 2; ++ai)
#pragma unroll
            for (int m = 0; m < 4; ++m) { const int row = row0 + ai * HALF + m * 16; const float w_ = rw[row];
#pragma unroll
                for (int bj = 0; bj < 2; ++bj) { const f32x4 v0 = (acc[ai][bj][m][0] + bv[bj][0]) * w_, v1 = (acc[ai][bj][m][1] + bv[bj][1]) * w_;
                    u32x4 w; w.x = cvt_pk_bf16(v0[0], v0[1]); w.y = cvt_pk_bf16(v0[2], v0[3]); w.z = cvt_pk_bf16(v1[0], v1[1]); w.w = cvt_pk_bf16(v1[2], v1[3]);
                    *(u32x4*)(y + (size_t)row * 1024 + col0 + bj * HALF) = w; } }
    }
};


struct EpiSwiglu8 {
    static constexpr bool PERM = true, AFTER_DRAIN = false;
    const float* b1; unsigned char* act; float dq;
    __device__ __forceinline__ void operator()(const f32x4 (&acc)[2][2][4][2], const Unit& u, int wr, int wc, int fr, int fq) const {
        const int e = u.pn >> 3, j = u.pn & 7; const int row0 = u.pm * BM + wr * 64 + fr, f0 = 128 * j + wc * 32 + 8 * fq;
        const float* be = b1 + (size_t)e * 2048 + f0;
        const f32x4 bg0 = *(const f32x4*)(be), bg1 = *(const f32x4*)(be + 4), bl0 = *(const f32x4*)(be + 1024), bl1 = *(const f32x4*)(be + 1028);
#pragma unroll
        for (int ai = 0; ai < 2; ++ai)
#pragma unroll
            for (int m = 0; m < 4; ++m) {
                f32x4 g0 = acc[ai][0][m][0] * dq + bg0, g1 = acc[ai][0][m][1] * dq + bg1, l0 = acc[ai][1][m][0] * dq + bl0, l1 = acc[ai][1][m][1] * dq + bl1;
                float r[8];
#pragma unroll
                for (int q = 0; q < 4; ++q) { float gl = fminf(g0[q], 7.0f), li = fminf(fmaxf(l0[q], -7.0f), 7.0f); r[q] = 4.0f * gl * sigm(1.702f * gl) * (li + 1.0f);
                                              gl = fminf(g1[q], 7.0f); li = fminf(fmaxf(l1[q], -7.0f), 7.0f); r[4 + q] = 4.0f * gl * sigm(1.702f * gl) * (li + 1.0f); }
                u32x2 w; w.x = cvt4_fp8(r[0], r[1], r[2], r[3]); w.y = cvt4_fp8(r[4], r[5], r[6], r[7]);
                *(u32x2*)(act + (size_t)(row0 + ai * HALF + m * 16) * 1024 + f0) = w; }
    }
};
struct EpiY8 {
    static constexpr bool PERM = true, AFTER_DRAIN = false;
    const float* b2; const float* rw; bf16_t* y; float dq;
    __device__ __forceinline__ void operator()(const f32x4 (&acc)[2][2][4][2], const Unit& u, int wr, int wc, int fr, int fq) const {
        const int e = u.pn >> 2, j = u.pn & 3; const int row0 = u.pm * BM + wr * 64 + fr, col0 = 256 * j + wc * 32 + 8 * fq;
        const float* be = b2 + (size_t)e * 1024 + col0;
        f32x4 bv[2][2];
#pragma unroll
        for (int bj = 0; bj < 2; ++bj)
#pragma unroll
            for (int n = 0; n < 2; ++n) bv[bj][n] = *(const f32x4*)(be + bj * HALF + 4 * n);
#pragma unroll
        for (int ai = 0; ai < 2; ++ai)
#pragma unroll
            for (int m = 0; m < 4; ++m) { const int row = row0 + ai * HALF + m * 16; const float w_ = rw[row];
#pragma unroll
                for (int bj = 0; bj < 2; ++bj) { const f32x4 v0 = (acc[ai][bj][m][0] * dq + bv[bj][0]) * w_, v1 = (acc[ai][bj][m][1] * dq + bv[bj][1]) * w_;
                    u32x4 w; w.x = cvt_pk_bf16(v0[0], v0[1]); w.y = cvt_pk_bf16(v0[2], v0[3]); w.z = cvt_pk_bf16(v1[0], v1[1]); w.w = cvt_pk_bf16(v1[2], v1[3]);
                    *(u32x4*)(y + (size_t)row * 1024 + col0 + bj * HALF) = w; } }
    }
};


struct EpiGateFused {
    static constexpr bool PERM = true, AFTER_DRAIN = false, HAS_MID = true;
    const bf16_t* gc; const bf16_t* gh; bf16_t* out;
    __device__ __forceinline__ void mid(f32x4 (&acc)[2][2][4][2], const Unit& u, int wr, int wc, int fr, int fq) const {
        const int row0 = u.pm * BM + wr * 64 + fr, col0 = u.pn * BM + wc * 32 + 8 * fq;
#pragma unroll
        for (int ai = 0; ai < 2; ++ai)
#pragma unroll
            for (int m = 0; m < 4; ++m) { const size_t o = (size_t)(row0 + ai * HALF + m * 16) * 1024 + col0;
#pragma unroll
                for (int bj = 0; bj < 2; ++bj) { const u32x4 a = *(const u32x4*)(gc + o + bj * HALF), b = *(const u32x4*)(gh + o + bj * HALF);
                    const unsigned aw[4] = {a.x, a.y, a.z, a.w}, bw[4] = {b.x, b.y, b.z, b.w};
#pragma unroll
                    for (int q = 0; q < 4; ++q) { const float r0 = (1.0f + __expf(-blo(bw[q]))) * __builtin_amdgcn_rcpf(1.0f + __expf(-blo(aw[q]))), r1 = (1.0f + __expf(-bhi(bw[q]))) * __builtin_amdgcn_rcpf(1.0f + __expf(-bhi(aw[q])));
                        acc[ai][bj][m][q >> 1][(2 * q) & 3] *= r0; acc[ai][bj][m][q >> 1][(2 * q + 1) & 3] *= r1; } } }
    }
    __device__ __forceinline__ void operator()(const f32x4 (&acc)[2][2][4][2], const Unit& u, int wr, int wc, int fr, int fq) const {
        const int row0 = u.pm * BM + wr * 64 + fr, col0 = u.pn * BM + wc * 32 + 8 * fq;
#pragma unroll
        for (int ai = 0; ai < 2; ++ai)
#pragma unroll
            for (int m = 0; m < 4; ++m) { const size_t o = (size_t)(row0 + ai * HALF + m * 16) * 1024 + col0;
#pragma unroll
                for (int bj = 0; bj < 2; ++bj) { const u32x4 g = *(const u32x4*)(gh + o + bj * HALF); f32x4 v0 = acc[ai][bj][m][0], v1 = acc[ai][bj][m][1];
                    v0[0] *= sigm(blo(g.x)); v0[1] *= sigm(bhi(g.x)); v0[2] *= sigm(blo(g.y)); v0[3] *= sigm(bhi(g.y));
                    v1[0] *= sigm(blo(g.z)); v1[1] *= sigm(bhi(g.z)); v1[2] *= sigm(blo(g.w)); v1[3] *= sigm(bhi(g.w));
                    u32x4 w; w.x = cvt_pk_bf16(v0[0], v0[1]); w.y = cvt_pk_bf16(v0[2], v0[3]); w.z = cvt_pk_bf16(v1[0], v1[1]); w.w = cvt_pk_bf16(v1[2], v1[3]);
                    *(u32x4*)(out + o + bj * HALF) = w; } }
    }
};

template <class T, class = void> struct has_mid { static constexpr bool value = false; };
template <class T> struct has_mid<T, decltype((void)T::HAS_MID)> { static constexpr bool value = true; };
template <class Epi, class Sched, bool ALIGN_EPI = false, bool SP2 = false, bool GATHER = false, bool FP8 = false>
__device__ __forceinline__ void gemm_phase(PG8_LAS unsigned char* lds, const Gemm g, const Sched& S, const Epi& E, const int wave_id, const PG8_LAS unsigned short* gtab = nullptr) {
    typedef int i32x4 __attribute__((ext_vector_type(4))); typedef int i32x8 __attribute__((ext_vector_type(8)));
    static_assert(!GATHER || SP2, "GATHER needs the SP2 loop");
    int lane = (int)__builtin_amdgcn_mbcnt_hi(~0u, __builtin_amdgcn_mbcnt_lo(~0u, 0u)); asm volatile("" : "+v"(lane));
    const int wid = wave_id, tid = wid * 64 + lane, wr = wid >> 2, wc = wid & 3, fr = lane & 15, fq = lane >> 4;
    const int K = g.K, nt = K / BK;
    unsigned voffA[2], voffB[2];
#pragma unroll
    for (int i = 0; i < 2; ++i) { int R, C; stage_rc(tid * 16 + i * 8192, R, C); const int Rb = Epi::PERM ? ((R & ~31) + perm32(R & 31)) : R;
        voffA[i] = (unsigned)(R * K + C) * 2u; voffB[i] = (unsigned)(Rb * K + C) * 2u; }
    unsigned vA0[2] = {0u, 0u}, vA1[2] = {0u, 0u}, xA0[2] = {0u, 0u}, xA1[2] = {0u, 0u};
#define PG8_GLOAD(d0, d1, ui_) do { int tz_ = wid * 64 + (int)__builtin_amdgcn_mbcnt_hi(~0u, __builtin_amdgcn_mbcnt_lo(~0u, 0u)); asm volatile("" : "+v"(tz_)); _Pragma("unroll") for (int _i = 0; _i < 2; ++_i) { int R_, C_; stage_rc(tz_ * 16 + _i * 8192, R_, C_); \
        d0[_i] = (unsigned)gtab[256 * (ui_) + R_] * (unsigned)(K * 2) + (unsigned)C_ * 2u; d1[_i] = (unsigned)gtab[256 * (ui_) + 128 + R_] * (unsigned)(K * 2) + (unsigned)C_ * 2u; } } while (0)
    const unsigned kstep = (unsigned)(BK * 2);
    const unsigned hstep = (unsigned)HALF * K * 2;
    const unsigned tstep = 2 * hstep;
    const __amdgpu_buffer_rsrc_t rsA = __builtin_amdgcn_make_buffer_rsrc((void*)g.A, 0, 0x7fffffff, 0x00020000), rsB = __builtin_amdgcn_make_buffer_rsrc((void*)g.Bt, 0, 0x7fffffff, 0x00020000);
    const unsigned ldsw = (unsigned)wid * 1024u;
    const int aoff = lds_byte(wr * 64 + fr, fq * 8), boff = lds_byte(wc * 32 + fr, fq * 8);
#define PG8_SA(b, h) (((b) * 2 + (h)) * HTB)
#define PG8_SB(b, h) ((4 + (b) * 2 + (h)) * HTB)
#define PG8_STAGE(bufoff, rs, soff, voff) do { _Pragma("unroll") for (int _i = 0; _i < 2; ++_i) \
        __builtin_amdgcn_raw_ptr_buffer_load_lds(rs, (PG8_LAS void*)(lds + (bufoff) + ldsw + _i * 8192), 16, (int)(voff)[_i], (int)(soff), 0, 0); } while (0)
#define PG8_LDA(dst, b, h) do { if constexpr (FP8) { _Pragma("unroll") for (int m = 0; m < 4; ++m) dst##_8[m] = __builtin_shufflevector(*(const PG8_LAS i32x4*)(lds + PG8_SA(b, h) + aoff + m * 2048), *(const PG8_LAS i32x4*)(lds + PG8_SA(b, h) + aoff + m * 2048 + 1024), 0, 1, 2, 3, 4, 5, 6, 7); } \
        else { _Pragma("unroll") for (int m = 0; m < 4; ++m) _Pragma("unroll") for (int k = 0; k < 2; ++k) dst[m][k] = *(const PG8_LAS bf16x8*)(lds + PG8_SA(b, h) + aoff + m * 2048 + k * 1024); } } while (0)
#define PG8_LDB(dst, b, h) do { if constexpr (FP8) { _Pragma("unroll") for (int n = 0; n < 2; ++n) dst##_8[n] = __builtin_shufflevector(*(const PG8_LAS i32x4*)(lds + PG8_SB(b, h) + boff + n * 2048), *(const PG8_LAS i32x4*)(lds + PG8_SB(b, h) + boff + n * 2048 + 1024), 0, 1, 2, 3, 4, 5, 6, 7); } \
        else { _Pragma("unroll") for (int n = 0; n < 2; ++n) _Pragma("unroll") for (int k = 0; k < 2; ++k) dst[n][k] = *(const PG8_LAS bf16x8*)(lds + PG8_SB(b, h) + boff + n * 2048 + k * 1024); } } while (0)
#define PG8_PIN(ai, bj) asm volatile("" : "+v"(acc[ai][bj][0][0]), "+v"(acc[ai][bj][0][1]), "+v"(acc[ai][bj][1][0]), "+v"(acc[ai][bj][1][1]), "+v"(acc[ai][bj][2][0]), "+v"(acc[ai][bj][2][1]), "+v"(acc[ai][bj][3][0]), "+v"(acc[ai][bj][3][1]))
#define PG8_MMA(ai, bj, At, Bt) do { if constexpr (FP8) { __builtin_amdgcn_sched_barrier(0); __builtin_amdgcn_s_setprio(1); _Pragma("unroll") for (int m = 0; m < 4; ++m) _Pragma("unroll") for (int n = 0; n < 2; ++n) \
        acc[ai][bj][m][n] = __builtin_amdgcn_mfma_scale_f32_16x16x128_f8f6f4(Bt##_8[n], At##_8[m], acc[ai][bj][m][n], 0, 0, 0, 0x7f7f7f7f, 0, 0x7f7f7f7f); \
        __builtin_amdgcn_s_setprio(0); PG8_PIN(ai, bj); __builtin_amdgcn_sched_barrier(0); } else { __builtin_amdgcn_s_setprio(1); \
        _Pragma("unroll") for (int m = 0; m < 4; ++m) _Pragma("unroll") for (int n = 0; n < 2; ++n) _Pragma("unroll") for (int k = 0; k < 2; ++k) \
        acc[ai][bj][m][n] = __builtin_amdgcn_mfma_f32_16x16x32_bf16(Bt[n][k], At[m][k], acc[ai][bj][m][n], 0, 0, 0); __builtin_amdgcn_s_setprio(0); } } while (0)
#define PG8_WAIT_V(n) asm volatile("s_waitcnt vmcnt(" #n ")" ::: "memory")
#define PG8_WAIT_L(n) asm volatile("s_waitcnt lgkmcnt(" #n ")" ::: "memory")
#define PG8_BAR __builtin_amdgcn_s_barrier()
#define PG8_SCHED __builtin_amdgcn_sched_barrier(0)
    Unit cur, nxt; int ui = 0;
    if (!S.next(0, cur)) return;
    f32x4 acc[2][2][4][2];
#pragma unroll
    for (int a = 0; a < 2; ++a)
#pragma unroll
        for (int b = 0; b < 2; ++b)
#pragma unroll
            for (int m = 0; m < 4; ++m)
#pragma unroll
                for (int n = 0; n < 2; ++n) acc[a][b][m][n] = (f32x4){0.f, 0.f, 0.f, 0.f};
    bf16x8 At[4][2], B0[2][2], B1[2][2]; i32x8 At_8[4], B0_8[2], B1_8[2];
    unsigned cA = GATHER ? 0u : (unsigned)cur.pm * tstep, cB = (unsigned)cur.pn * tstep;
    S.a_ready(cur);
    if constexpr (GATHER) { PG8_GLOAD(vA0, vA1, 0); xA0[0] = vA0[0]; xA0[1] = vA0[1]; xA1[0] = vA1[0]; xA1[1] = vA1[1]; }
    if constexpr (SP2) {
        PG8_STAGE(PG8_SB(0, 0), rsB, cB, voffB); PG8_STAGE(PG8_SB(0, 1), rsB, cB + hstep, voffB);
        if constexpr (GATHER) { PG8_STAGE(PG8_SA(0, 0), rsA, cA, vA0); PG8_STAGE(PG8_SA(0, 1), rsA, cA, vA1); } else { PG8_STAGE(PG8_SA(0, 0), rsA, cA, voffA); PG8_STAGE(PG8_SA(0, 1), rsA, cA + hstep, voffA); }
        if (wr == 1) PG8_BAR;
        PG8_WAIT_V(2); PG8_BAR;
        PG8_STAGE(PG8_SB(1, 0), rsB, cB + kstep, voffB); if constexpr (GATHER) { PG8_STAGE(PG8_SA(1, 0), rsA, cA + kstep, vA0); } else { PG8_STAGE(PG8_SA(1, 0), rsA, cA + kstep, voffA); } PG8_STAGE(PG8_SB(1, 1), rsB, cB + hstep + kstep, voffB);
        PG8_WAIT_V(6); PG8_BAR;
    } else {
        PG8_STAGE(PG8_SB(0, 0), rsB, cB, voffB); PG8_STAGE(PG8_SA(0, 0), rsA, cA, voffA); PG8_STAGE(PG8_SB(0, 1), rsB, cB + hstep, voffB); PG8_STAGE(PG8_SA(0, 1), rsA, cA + hstep, voffA);
        if (wr == 1) PG8_BAR;
        PG8_WAIT_V(4); PG8_BAR;
        PG8_STAGE(PG8_SB(1, 0), rsB, cB + kstep, voffB); PG8_STAGE(PG8_SA(1, 0), rsA, cA + kstep, voffA); PG8_STAGE(PG8_SB(1, 1), rsB, cB + hstep + kstep, voffB);
        PG8_WAIT_V(6); PG8_BAR;
    }
    for (;;) {
        const bool has_next = S.next(ui + 1, nxt);
        const unsigned nA = GATHER ? cA : (has_next ? (unsigned)nxt.pm * tstep : cA), nB = has_next ? (unsigned)nxt.pn * tstep : cB;
        for (int t = 0; t < nt; t += 2) {
            const bool last = (t == nt - 2);
            const unsigned a1 = cA + (unsigned)(t + 1) * kstep;
            const unsigned a2 = last ? nA : cA + (unsigned)(t + 2) * kstep, b2 = last ? nB : cB + (unsigned)(t + 2) * kstep;
            const unsigned a3 = a2 + kstep, b3 = b2 + kstep;
            if (last && has_next) S.a_ready(nxt);
            if constexpr (has_mid<Epi>::value) { if (t == nt / 2) { int l3_ = (int)__builtin_amdgcn_mbcnt_hi(~0u, __builtin_amdgcn_mbcnt_lo(~0u, 0u)); asm volatile("" : "+v"(l3_)); E.mid(acc, cur, wr, wc, l3_ & 15, l3_ >> 4); } }
            if constexpr (GATHER) { if (last && has_next) { PG8_GLOAD(xA0, xA1, ui + 1); } }
            if constexpr (SP2) {
            PG8_LDB(B0, 0, 0); PG8_LDB(B1, 0, 1); PG8_SCHED; PG8_LDA(At, 0, 0); if constexpr (GATHER) { PG8_STAGE(PG8_SA(1, 1), rsA, a1, vA1); } else { PG8_STAGE(PG8_SA(1, 1), rsA, a1 + hstep, voffA); }
            PG8_WAIT_V(8); PG8_WAIT_L(0); PG8_BAR; PG8_MMA(0, 0, At, B0); PG8_MMA(0, 1, At, B1); PG8_BAR; PG8_SCHED;
            PG8_LDA(At, 0, 1); PG8_STAGE(PG8_SB(0, 0), rsB, b2, voffB); PG8_STAGE(PG8_SB(0, 1), rsB, b2 + hstep, voffB); if constexpr (GATHER) { PG8_STAGE(PG8_SA(0, 0), rsA, a2, xA0); } else { PG8_STAGE(PG8_SA(0, 0), rsA, a2, voffA); }
            PG8_WAIT_V(8); PG8_WAIT_L(0); PG8_BAR; PG8_MMA(1, 0, At, B0); PG8_MMA(1, 1, At, B1); PG8_BAR; PG8_SCHED;
            PG8_LDB(B0, 1, 0); PG8_LDB(B1, 1, 1); PG8_SCHED; PG8_LDA(At, 1, 0); if constexpr (GATHER) { PG8_STAGE(PG8_SA(0, 1), rsA, a2, xA1); } else { PG8_STAGE(PG8_SA(0, 1), rsA, a2 + hstep, voffA); }
            PG8_WAIT_V(8); PG8_WAIT_L(0); PG8_BAR; PG8_MMA(0, 0, At, B0); PG8_MMA(0, 1, At, B1); PG8_BAR; PG8_SCHED;
            PG8_LDA(At, 1, 1); PG8_STAGE(PG8_SB(1, 0), rsB, b3, voffB); PG8_STAGE(PG8_SB(1, 1), rsB, b3 + hstep, voffB); if constexpr (GATHER) { PG8_STAGE(PG8_SA(1, 0), rsA, a3, xA0); } else { PG8_STAGE(PG8_SA(1, 0), rsA, a3, voffA); }
            PG8_WAIT_V(8); PG8_WAIT_L(0); PG8_BAR; PG8_MMA(1, 0, At, B0); PG8_MMA(1, 1, At, B1); PG8_BAR; PG8_SCHED;
            } else {
            PG8_LDB(B0, 0, 0); PG8_SCHED; PG8_LDA(At, 0, 0); PG8_STAGE(PG8_SA(1, 1), rsA, a1 + hstep, voffA);
            PG8_WAIT_L(8); PG8_BAR; PG8_WAIT_L(0); PG8_MMA(0, 0, At, B0); PG8_BAR; PG8_SCHED;
            PG8_LDB(B1, 0, 1); PG8_STAGE(PG8_SB(0, 0), rsB, b2, voffB);
            PG8_BAR; PG8_WAIT_L(0); PG8_MMA(0, 1, At, B1); PG8_BAR;
            PG8_LDA(At, 0, 1); PG8_STAGE(PG8_SA(0, 0), rsA, a2, voffA);
            PG8_BAR; PG8_WAIT_L(0); PG8_MMA(1, 0, At, B0); PG8_BAR; PG8_SCHED;
            PG8_STAGE(PG8_SB(0, 1), rsB, b2 + hstep, voffB);
            PG8_WAIT_V(6); PG8_BAR; PG8_MMA(1, 1, At, B1); PG8_BAR;
            PG8_LDB(B0, 1, 0); PG8_SCHED; PG8_LDA(At, 1, 0); PG8_STAGE(PG8_SA(0, 1), rsA, a2 + hstep, voffA);
            PG8_WAIT_L(8); PG8_BAR; PG8_WAIT_L(0); PG8_MMA(0, 0, At, B0); PG8_BAR; PG8_SCHED;
            PG8_LDB(B1, 1, 1); PG8_STAGE(PG8_SB(1, 0), rsB, b3, voffB);
            PG8_BAR; PG8_WAIT_L(0); PG8_MMA(0, 1, At, B1); PG8_BAR;
            PG8_LDA(At, 1, 1); PG8_STAGE(PG8_SA(1, 0), rsA, a3, voffA);
            PG8_BAR; PG8_WAIT_L(0); PG8_MMA(1, 0, At, B0); PG8_BAR; PG8_SCHED;
            PG8_STAGE(PG8_SB(1, 1), rsB, b3 + hstep, voffB);
            PG8_WAIT_V(6); PG8_BAR; PG8_MMA(1, 1, At, B1); PG8_BAR;
            }
        }
        if constexpr (ALIGN_EPI) { if (wr == 0) PG8_BAR; }
        if constexpr (!Epi::AFTER_DRAIN) { int l2_ = (int)__builtin_amdgcn_mbcnt_hi(~0u, __builtin_amdgcn_mbcnt_lo(~0u, 0u)); asm volatile("" : "+v"(l2_));
            E(acc, cur, wr, wc, l2_ & 15, l2_ >> 4); S.done(cur); }
        if (!has_next) break;
#pragma unroll
        for (int a = 0; a < 2; ++a)
#pragma unroll
            for (int b = 0; b < 2; ++b)
#pragma unroll
                for (int m = 0; m < 4; ++m)
#pragma unroll
                    for (int n = 0; n < 2; ++n) acc[a][b][m][n] = (f32x4){0.f, 0.f, 0.f, 0.f};
        cur = nxt; cA = nA; cB = nB; ++ui;
        if constexpr (GATHER) { vA0[0] = xA0[0]; vA0[1] = xA0[1]; vA1[0] = xA1[0]; vA1[1] = xA1[1]; }
        if constexpr (ALIGN_EPI) { if (wr == 1) PG8_BAR; }
    }
    PG8_WAIT_V(0);
    if constexpr (!ALIGN_EPI) { if (wr == 0) PG8_BAR; }
    PG8_BAR;
    if constexpr (Epi::AFTER_DRAIN) { E.fused(acc, cur, wr, wc, fr, fq, lds, wid, lane); S.done(cur); }
#undef PG8_GLOAD
#undef PG8_SA
#undef PG8_SB
#undef PG8_STAGE
#undef PG8_LDA
#undef PG8_LDB
#undef PG8_MMA
#undef PG8_PIN
#undef PG8_WAIT_V
#undef PG8_WAIT_L
#undef PG8_BAR
#undef PG8_SCHED
}
}
#define XB_TMO      128
#define XB_XCNT(j)  (256  + 64 * (j))
#define XB_XSUB(j)  (1280 + 64 * (j))
#define XB_XGEN(j)  (2304 + 64 * (j))
#define XB_TOP      3328
#define XB_TOPGEN   3392
#define XCD_BAR_WORDS 3456
#define XB_SPIN_CAP (1u << 18)

__device__ __forceinline__ unsigned xb_ld(unsigned* p)              { return __hip_atomic_load(p, __ATOMIC_RELAXED, __HIP_MEMORY_SCOPE_AGENT); }
__device__ __forceinline__ unsigned xb_add(unsigned* p, unsigned v) { return __hip_atomic_fetch_add(p, v, __ATOMIC_RELAXED, __HIP_MEMORY_SCOPE_AGENT); }
__device__ __forceinline__ unsigned xb_xcc_id() { return (unsigned)__builtin_amdgcn_s_getreg((3 << 11) | 20) & 0xFu; }
#define XB_SPIN(cond, bar) do { unsigned _sp = 0; while (cond) { __builtin_amdgcn_s_sleep(1); \
    if ((++_sp & 255u) == 0u) { if (xb_ld(&(bar)[XB_TMO])) break; if (_sp > XB_SPIN_CAP) { atomicAdd(&(bar)[XB_TMO], 1u); break; } } } } while (0)

struct XcdBarrier {
    unsigned* bar; unsigned x;
    volatile LAS unsigned* st;
};

__device__ __forceinline__ XcdBarrier xcd_barrier_post(unsigned* bar, volatile LAS unsigned* st, const bool leader  ) {
    XcdBarrier b; b.bar = bar; b.x = xb_xcc_id(); b.st = st;
    if (leader) (void)xb_add(&bar[XB_XCNT(b.x)], 1u);
    return b;
}
__device__ __forceinline__ void xcd_barrier_complete(unsigned* bar, unsigned x, unsigned& nloc, unsigned& nx) {
    const unsigned G = gridDim.x * gridDim.y * gridDim.z;
    unsigned sum, cnt, mine, sp = 0u;
    for (;;) {
        sum = 0u; cnt = 0u; mine = 0u;
#pragma unroll
        for (unsigned j = 0; j < 16; ++j) { const unsigned c = xb_ld(&bar[XB_XCNT(j)]); sum += c; cnt += (c > 0u) ? 1u : 0u; mine = (j == x) ? c : mine; }
        if (sum == G) break;
        __builtin_amdgcn_s_sleep(1);
        if ((++sp & 255u) == 0u) { if (xb_ld(&bar[XB_TMO])) break; if (sp > XB_SPIN_CAP) { atomicAdd(&bar[XB_TMO], 1u); break; } }
    }
    nloc = mine > 0u ? mine : 1u; nx = cnt > 0u ? cnt : 1u;
}

__device__ __forceinline__ void xcd_barrier(const XcdBarrier& b, const bool leader  ) {
    asm volatile("s_waitcnt vmcnt(0)" ::: "memory");
    __syncthreads();
    if (leader) {
        unsigned* bar = b.bar;
        __builtin_amdgcn_s_waitcnt(0);
        unsigned nloc = b.st[0], nx = b.st[1];
        if (nloc == 0u) { xcd_barrier_complete(bar, b.x, nloc, nx); b.st[0] = nloc; b.st[1] = nx; }
        const unsigned old = xb_add(&bar[XB_XSUB(b.x)], 1u);
        const unsigned gen = old / nloc;
        if (old + 1u == (gen + 1u) * nloc) {
            __builtin_amdgcn_fence(__ATOMIC_RELEASE, "agent");
            asm volatile("s_waitcnt vmcnt(0)" ::: "memory");
            const unsigned og = xb_add(&bar[XB_TOP], 1u);
            const unsigned tg = og / nx;
            if (og + 1u == (tg + 1u) * nx) xb_add(&bar[XB_TOPGEN], 1u);
            else XB_SPIN(xb_ld(&bar[XB_TOPGEN]) == tg, bar);
            __builtin_amdgcn_fence(__ATOMIC_ACQUIRE, "agent");
            xb_add(&bar[XB_XGEN(b.x)], 1u);
            asm volatile("s_waitcnt vmcnt(0)" ::: "memory");
        } else {
            XB_SPIN(xb_ld(&bar[XB_XGEN(b.x)]) == gen, bar);
            __builtin_amdgcn_fence(__ATOMIC_ACQUIRE, "agent");
            asm volatile("s_waitcnt vmcnt(0)" ::: "memory");
        }
    }
    __syncthreads();
}

struct Ctx { LAS unsigned char* lds; int tid, lane, wave, vcu, G; };

__device__ __forceinline__ void transpose_load64(const float* W, int ldw, int k0, int n0, LAS float* scr, int lane) {
#pragma unroll 8
    for (int i = 0; i < 16; ++i) { const int kk = 4 * i + (lane >> 4), nn = 4 * (lane & 15); const f32x4 v = *(const f32x4*)(W + (size_t)(k0 + kk) * ldw + n0 + nn);
        LAS float* d = scr + kk * 65 + nn; d[0] = v.x; d[1] = v.y; d[2] = v.z; d[3] = v.w; }
    LDS_WAIT();
}
__device__ __forceinline__ void transpose_item(const float* W, int ldw, int K, bf16_t* dst, int k0, int n0, LAS float* scr, int lane) {
    transpose_load64(W, ldw, k0, n0, scr, lane);
    const int c = lane & 7;
#pragma unroll
    for (int j = 0; j < 8; ++j) { const int n = (lane >> 3) + 8 * j; const LAS float* s = scr + (8 * c) * 65 + n;
        u32x4 o; o.x = pk2(s[0 * 65], s[1 * 65]); o.y = pk2(s[2 * 65], s[3 * 65]); o.z = pk2(s[4 * 65], s[5 * 65]); o.w = pk2(s[6 * 65], s[7 * 65]);
        *(u32x4*)(dst + (size_t)n * K + k0 + 8 * c) = o; }
    LDS_WAIT();
}
__device__ __forceinline__ void transpose_item8(const float* W, int ldw, int K, unsigned char* dst, int k0, int n0, float scale, LAS float* scr, int lane) {
    transpose_load64(W, ldw, k0, n0, scr, lane);
    const int c = lane & 3;
#pragma unroll
    for (int j = 0; j < 4; ++j) { const int n = (lane >> 2) + 16 * j; const LAS float* s = scr + (16 * c) * 65 + n;
        u32x4 o; o.x = cvt4_fp8(s[0 * 65] * scale, s[1 * 65] * scale, s[2 * 65] * scale, s[3 * 65] * scale); o.y = cvt4_fp8(s[4 * 65] * scale, s[5 * 65] * scale, s[6 * 65] * scale, s[7 * 65] * scale);
        o.z = cvt4_fp8(s[8 * 65] * scale, s[9 * 65] * scale, s[10 * 65] * scale, s[11 * 65] * scale); o.w = cvt4_fp8(s[12 * 65] * scale, s[13 * 65] * scale, s[14 * 65] * scale, s[15 * 65] * scale);
        *(u32x4*)(dst + (size_t)n * K + k0 + 16 * c) = o; }
    LDS_WAIT();
}

template <int PART>
__device__ __forceinline__ void ph_prologue(const Ctx& X, const float* c, const float* w_ada, const float* b_ada, float* mod,
                                            const float* w_in, const float* w_conv_out, const float* w_hgrn_out, const float* w_out, const float* w1, const float* w2, unsigned char* ws) {
    if (PART == 0 && X.vcu < 48) {
        LAS float* ca = (LAS float*)X.lds;
        LAS float* red = (LAS float*)(X.lds + 16384);
        for (int i = X.tid; i < 4096; i += 512) { const float v = c[i]; ca[i] = v * sigmoidf_(v); }
        __syncthreads();
        const int jj = X.tid & 127, kq = X.tid >> 7, j = X.vcu * 128 + jj;
        float a0 = 0.f, a1 = 0.f, a2 = 0.f, a3 = 0.f;
#pragma unroll 8
        for (int i = kq * 256; i < kq * 256 + 256; ++i) { const float w = w_ada[(size_t)i * NMOD + j]; a0 += ca[i] * w; a1 += ca[1024 + i] * w; a2 += ca[2048 + i] * w; a3 += ca[3072 + i] * w; }
        red[(kq * 4 + 0) * 128 + jj] = a0; red[(kq * 4 + 1) * 128 + jj] = a1; red[(kq * 4 + 2) * 128 + jj] = a2; red[(kq * 4 + 3) * 128 + jj] = a3;
        __syncthreads();
        { const int b = X.tid >> 7; mod[(size_t)b * NMOD + j] = b_ada[j] + red[(0 * 4 + b) * 128 + jj] + red[(1 * 4 + b) * 128 + jj] + red[(2 * 4 + b) * 128 + jj] + red[(3 * 4 + b) * 128 + jj]; }
        __syncthreads();
    }
    LAS float* scr = (LAS float*)(X.lds + X.wave * 16640);
    const int gw = X.vcu * 8 + X.wave, NGW = X.G * 8;
    constexpr int I_IN = 16 * 128, I_SQ = 16 * 16, I_W1 = 32 * 16 * 32, I_W2 = 32 * 16 * 16, NITEMS = I_IN + 3 * I_SQ + I_W1 + I_W2;
    constexpr int I_DENSE = I_IN + 3 * I_SQ;
    for (int it = (PART == 0 ? 0 : I_DENSE) + gw; it < (PART == 0 ? I_DENSE : NITEMS); it += NGW) {
        int r = it;
        if (r < I_IN) { const int kb = r >> 7, nb = r & 127, n0 = 64 * nb;
            const int rho0 = (n0 < 2048) ? 256 * ((n0 & 1023) >> 7) + 128 * (n0 >> 10) + (n0 & 127) : n0;
            transpose_item(w_in, 8192, 1024, (bf16_t*)(ws + WS_WIN) + (size_t)rho0 * 1024, 64 * kb, n0, scr, X.lane); continue; } r -= I_IN;
        if (r < 3 * I_SQ) { const int which = r / I_SQ, q = r % I_SQ, kb = q >> 4, nb = q & 15;
            const float* W = which == 0 ? w_conv_out : (which == 1 ? w_hgrn_out : w_out);
            if (which == 2) transpose_item(W, 1024, 1024, (bf16_t*)(ws + WS_WO) + (size_t)(64 * nb) * 1024, 64 * kb, 64 * nb, scr, X.lane);
            else transpose_item(W, 1024, 2048, (bf16_t*)(ws + WS_WC) + (size_t)(64 * nb) * 2048 + which * 1024, 64 * kb, 64 * nb, scr, X.lane);
            continue; } r -= 3 * I_SQ;
        if (r < I_W1) { const int e = r >> 9, q = r & 511, kb = q >> 5, nb = q & 31, n0 = 64 * nb;
            const int rho0 = (n0 < 1024) ? 256 * (n0 >> 7) + (n0 & 127) : 256 * ((n0 - 1024) >> 7) + 128 + ((n0 - 1024) & 127);
            transpose_item8(w1 + (size_t)e * 1024 * 2048, 2048, 1024, (unsigned char*)(ws + WS_W1) + ((size_t)e * 2048 + rho0) * 1024, 64 * kb, n0, 256.0f, scr, X.lane); continue; } r -= I_W1;
        { const int e = r >> 8, q = r & 255, kb = q >> 4, nb = q & 15;
            transpose_item8(w2 + (size_t)e * 1024 * 1024, 1024, 1024, (unsigned char*)(ws + WS_W2) + ((size_t)e * 1024 + 64 * nb) * 1024, 64 * kb, 64 * nb, 256.0f, scr, X.lane); }
    }
    __syncthreads();
}

__device__ __forceinline__ void ph_norm_mod(const Ctx& X, const float* x, const float* g, const float* mod, int sh_off, int sc_off, bf16_t* out) {
    for (int t = X.vcu * 8 + X.wave; t < T; t += X.G * 8) {
        const int b = t / SEQ, lane = X.lane;
        const f32x4* xr = (const f32x4*)(x + (size_t)t * D) + lane;
        f32x4 v[4]; float ss = 0.f;
#pragma unroll
        for (int j = 0; j < 4; ++j) { v[j] = xr[64 * j]; ss += (v[j].x * v[j].x + v[j].y * v[j].y) + (v[j].z * v[j].z + v[j].w * v[j].w); }
        const float r = rsqrtf(wave_sum(ss) * (1.0f / D) + EPS);
        const float* sh = mod + (size_t)b * NMOD + sh_off; const float* sc = mod + (size_t)b * NMOD + sc_off;
#pragma unroll
        for (int j = 0; j < 4; ++j) {
            const int col = 4 * (lane + 64 * j);
            const f32x4 gg = *(const f32x4*)(g + col), s1 = *(const f32x4*)(sc + col), s0 = *(const f32x4*)(sh + col);
            const f32x4 y = v[j] * r * gg * (s1 + 1.0f) + s0;
            u32x2 w; w.x = pk2(y.x, y.y); w.y = pk2(y.z, y.w);
            *(u32x2*)(out + (size_t)t * D + col) = w;
        }
    }
}

__device__ __forceinline__ void ph_conv(const Ctx& X, const bf16_t* pU, const float* dw, const float* dwb, const float* lng, const float* lnb, bf16_t* uc) {
    LAS float* sm = (LAS float*)X.lds;
    const int tid = X.tid, lane = X.lane, wid = X.wave, c0 = 2 * tid;
    float w[31][2];
#pragma unroll
    for (int j = 0; j < 31; ++j) { w[j][0] = dw[j * 1024 + c0]; w[j][1] = dw[j * 1024 + c0 + 1]; }
    const float bias0 = dwb[c0], bias1 = dwb[c0 + 1];
    for (int task = X.vcu; task < T / 32; task += X.G) {
        const int b = task >> 8, s0 = (task & 255) * 32;
        const bf16_t* qu = pU + (size_t)(b * SEQ) * D + c0;
        float u[38][2];
#pragma unroll
        for (int st = 0; st < 4; ++st) {
#pragma unroll
            for (int i = (st == 0 ? 0 : 8 * st + 30); i < 8 * st + 38; ++i) {
                const int s = s0 - 30 + i;
                float u0 = 0.f, u1 = 0.f;
                if (s >= 0) { const unsigned u2 = *(const unsigned*)(qu + (size_t)s * D); u0 = bflo(u2); u1 = bfhi(u2); }
                u[i % 38][0] = u0; u[i % 38][1] = u1;
            }
#pragma unroll
            for (int t = 8 * st; t < 8 * st + 8; ++t) {
                float a0 = bias0, a1 = bias1;
#pragma unroll
                for (int j = 0; j < 31; ++j) { a0 += w[j][0] * u[(t + j) % 38][0]; a1 += w[j][1] * u[(t + j) % 38][1]; }
                sm[t * 1024 + c0] = a0; sm[t * 1024 + c0 + 1] = a1;
            }
        }
        __syncthreads();
#pragma unroll 1
        for (int i = 0; i < 4; ++i) {
            const int t = wid * 4 + i;
            f32x4 v[4]; float s = 0.f;
#pragma unroll
            for (int j = 0; j < 4; ++j) { v[j] = *(const LAS f32x4*)(sm + t * 1024 + 4 * (lane + 64 * j)); s += (v[j].x + v[j].y) + (v[j].z + v[j].w); }
            const float mean = wave_sum(s) * (1.0f / D); float q = 0.f;
#pragma unroll
            for (int j = 0; j < 4; ++j) { v[j] = v[j] - mean; q += (v[j].x * v[j].x + v[j].y * v[j].y) + (v[j].z * v[j].z + v[j].w * v[j].w); }
            const float rstd = rsqrtf(wave_sum(q) * (1.0f / D) + EPS);
#pragma unroll
            for (int j = 0; j < 4; ++j) {
                const int col = 4 * (lane + 64 * j);
                const f32x4 gg = *(const f32x4*)(lng + col), bb = *(const f32x4*)(lnb + col);
                f32x4 y = v[j] * rstd * gg + bb;
                y.x *= sigmoidf_(y.x); y.y *= sigmoidf_(y.y); y.z *= sigmoidf_(y.z); y.w *= sigmoidf_(y.w);
                u32x2 o; o.x = pk2(y.x, y.y); o.y = pk2(y.z, y.w);
                *(u32x2*)(uc + (size_t)(b * SEQ + s0 + t) * (2 * D) + col) = o;
            }
        }
        __syncthreads();
    }
}

typedef short bf16x8 __attribute__((ext_vector_type(8)));
typedef short s16x4 __attribute__((ext_vector_type(4)));
typedef float f32x2 __attribute__((ext_vector_type(2)));
constexpr int HG_QA = 0, HG_KA = 17408, HG_VR = 34816, HG_AB = 52224, HG_SPT = 61440, HG_O = 96256, HG_SEG = 130048;
constexpr size_t HM = (size_t)SEQ * 128;
__device__ __forceinline__ bf16x8 tr_frag(LAS unsigned char* base, int rs, int ks, int c16, int lane) {
    const int g = lane >> 4, q = (lane & 15) >> 2, p = lane & 3;
    LAS unsigned char* a = base + (32 * ks + 8 * g + q) * rs + (16 * c16 + 4 * p) * 2;
    const s16x4 lo = __builtin_amdgcn_ds_read_tr16_b64_v4i16((LAS s16x4*)a);
    const s16x4 hi = __builtin_amdgcn_ds_read_tr16_b64_v4i16((LAS s16x4*)(a + 4 * rs));
    return __builtin_shufflevector(lo, hi, 0, 1, 2, 3, 4, 5, 6, 7);
}
template <bool OUT>
__device__ __forceinline__ void ph_hgrn(const Ctx& X, int ntask, const bf16_t* pQ, const bf16_t* pF, const bf16_t* pI, const bf16_t* pG,
                                        const float* lb_param, const float* norm_g, const float* S0, float* dS, float* Dd, bf16_t* og) {
    LAS unsigned char* L = X.lds;
    LAS float* seg_s = (LAS float*)(L + HG_SEG);
    const int tid = X.tid, lane = X.lane, wave = X.wave, fr = lane & 15, fq = lane >> 4, wr = wave >> 1, wc = wave & 1;
    const int cp = tid & 63, seg = wave, tv = tid >> 3, vc = tid & 7;
    int idx = X.vcu; if (idx >= ntask) return;
    int ch = 0;
    unsigned zr[8], qr[8]; u32x4 vr0, vr1, gn0, gn1, gc0, gc1;
#define HG_LOAD(idx_, ch_) do { const int bh_ = (idx_) & 31, sc_ = (idx_) >> 5; const size_t tb_ = (size_t)bh_ * HM + (size_t)(sc_ * 256 + (ch_) * 64) * 128; \
        _Pragma("unroll") for (int i = 0; i < 8; ++i) { zr[i] = *(const unsigned*)(pF + tb_ + (size_t)(8 * seg + i) * 128 + 2 * cp); if (OUT) qr[i] = *(const unsigned*)(pQ + tb_ + (size_t)(8 * seg + i) * 128 + 2 * cp); } \
        { const u32x4* s_ = (const u32x4*)(pI + tb_ + (size_t)tv * 128 + vc * 16); vr0 = s_[0]; vr1 = s_[1]; } \
        if (OUT) { const u32x4* s_ = (const u32x4*)(pG + tb_ + (size_t)tv * 128 + vc * 16); gn0 = s_[0]; gn1 = s_[1]; } } while (0)
    HG_LOAD(idx, 0);
    float ngv[16];
    if (OUT) {
#pragma unroll
        for (int i = 0; i < 16; ++i) ngv[i] = norm_g[vc * 16 + i];
    }
    f32x4 S[8]; float oml0 = 0.f, oml1 = 0.f, gsum0 = 0.f, gsum1 = 0.f;
#pragma unroll 1
    for (;;) {
        const int sc = idx >> 5, bh = idx & 31, b = bh >> 3, h = bh & 7;
        if (ch == 0) {
            const int c0 = h * 128 + 2 * cp;
            oml0 = 1.0f - 1.0f / (1.0f + __expf(lb_param[1024 + c0] - lb_param[c0])); oml1 = 1.0f - 1.0f / (1.0f + __expf(lb_param[1025 + c0] - lb_param[c0 + 1]));
            gsum0 = 0.f; gsum1 = 0.f;
            if (OUT && sc > 0) { const float* s0 = S0 + (size_t)(bh * 32 + sc) * 16384;
#pragma unroll
                for (int vt = 0; vt < 8; ++vt)
#pragma unroll
                    for (int j = 0; j < 4; ++j) S[vt][j] = s0[(size_t)(16 * wave + fq * 4 + j) * 128 + vt * 16 + fr];
            } else {
#pragma unroll
                for (int vt = 0; vt < 8; ++vt) S[vt] = (f32x4){0.f, 0.f, 0.f, 0.f};
            }
        }
        float kk0[8], kk1[8], lf0[8], lf1[8], q0[8], q1[8];
        {
            float c0 = 0.f, c1 = 0.f;
#pragma unroll
            for (int i = 0; i < 8; ++i) {
                kk0[i] = oml0 * __builtin_amdgcn_rcpf(1.0f + __expf(bflo(zr[i]))); kk1[i] = oml1 * __builtin_amdgcn_rcpf(1.0f + __expf(bfhi(zr[i])));
                c0 += __logf(1.0f - kk0[i]); c1 += __logf(1.0f - kk1[i]); lf0[i] = c0; lf1[i] = c1;
                if (OUT) { q0[i] = bflo(qr[i]) * 0.08838834764831845f; q1[i] = bfhi(qr[i]) * 0.08838834764831845f; }
            }
            *(LAS f32x2*)(seg_s + seg * 128 + 2 * cp) = (f32x2){c0, c1};
        }
        if (OUT) { gc0 = gn0; gc1 = gn1; }
        const u32x4 vcur0 = vr0, vcur1 = vr1;
        __syncthreads();
        { LAS u32x4* d = (LAS u32x4*)(L + HG_VR + tv * 272 + vc * 32); d[0] = vcur0; d[1] = vcur1; }
        { int idx2 = idx, ch2 = ch + 1; if (ch2 == 4) { ch2 = 0; idx2 = idx + X.G; } if (idx2 < ntask) HG_LOAD(idx2, ch2); }
        {
            f32x2 ss[8];
#pragma unroll
            for (int s = 0; s < 8; ++s) ss[s] = *(const LAS f32x2*)(seg_s + s * 128 + 2 * cp);
            float off0 = 0.f, off1 = 0.f;
#pragma unroll
            for (int s = 0; s < 8; ++s) { off0 += (s < seg) ? ss[s].x : 0.f; off1 += (s < seg) ? ss[s].y : 0.f; }
            const float R0 = (ss[0].x + ss[1].x) + (ss[2].x + ss[3].x), R1 = (ss[0].y + ss[1].y) + (ss[2].y + ss[3].y);
            if (!OUT && seg == 0) { gsum0 += R0 + (ss[4].x + ss[5].x) + (ss[6].x + ss[7].x); gsum1 += R1 + (ss[4].y + ss[5].y) + (ss[6].y + ss[7].y); }
#pragma unroll
            for (int i = 0; i < 8; ++i) {
                const float G0 = off0 + lf0[i], G1 = off1 + lf1[i];
                const float ka0 = kk0[i] * __expf(fminf(R0 - G0, 80.0f)), ka1 = kk1[i] * __expf(fminf(R1 - G1, 80.0f));
                *(LAS unsigned*)(L + HG_KA + (8 * seg + i) * 272 + 4 * cp) = pk2(ka0, ka1);
                if (OUT) { const float qa0 = q0[i] * __expf(fminf(G0 - R0, 80.0f)), qa1 = q1[i] * __expf(fminf(G1 - R1, 80.0f));
                           *(LAS unsigned*)(L + HG_QA + (8 * seg + i) * 272 + 4 * cp) = pk2(qa0, qa1); }
            }
        }
        float eR[4], eL[4];
        {
            f32x4 r4 = (f32x4){0.f, 0.f, 0.f, 0.f}, l4 = (f32x4){0.f, 0.f, 0.f, 0.f};
#pragma unroll
            for (int s = 0; s < 4; ++s) { r4 += *(const LAS f32x4*)(seg_s + s * 128 + 16 * wave + 4 * fq); l4 += *(const LAS f32x4*)(seg_s + (s + 4) * 128 + 16 * wave + 4 * fq); }
#pragma unroll
            for (int j = 0; j < 4; ++j) { eR[j] = __expf(fmaxf(r4[j], -80.0f)); eL[j] = __expf(l4[j]); }
        }
#pragma unroll
        for (int vt = 0; vt < 8; ++vt) {
#pragma unroll
            for (int j = 0; j < 4; ++j) S[vt][j] *= eR[j];
            if (OUT) { u32x2 w; w.x = pk2(S[vt][0], S[vt][1]); w.y = pk2(S[vt][2], S[vt][3]);
                       *(LAS u32x2*)(L + HG_SPT + (vt * 16 + fr) * 272 + (16 * wave + 4 * fq) * 2) = w; }
        }
        __syncthreads();
        if (OUT) {
#pragma unroll
            for (int q2 = 0; q2 < 2; ++q2) {
                const int st = 2 * wc + q2;
                f32x4 acc = (f32x4){0.f, 0.f, 0.f, 0.f};
                if (st <= wr) {
#pragma unroll
                    for (int kq = 0; kq < 4; ++kq) {
                        const bf16x8 af = *(const LAS bf16x8*)(L + HG_KA + (st * 16 + fr) * 272 + kq * 64 + fq * 16);
                        const bf16x8 bq = *(const LAS bf16x8*)(L + HG_QA + (wr * 16 + fr) * 272 + kq * 64 + fq * 16);
                        acc = __builtin_amdgcn_mfma_f32_16x16x32_bf16(af, bq, acc, 0, 0, 0);
                    }
                    const int tt = wr * 16 + fr;
#pragma unroll
                    for (int j = 0; j < 4; ++j) { const int s_ = st * 16 + fq * 4 + j; acc[j] = (s_ <= tt) ? acc[j] : 0.f; }
                }
                u32x2 w; w.x = pk2(acc[0], acc[1]); w.y = pk2(acc[2], acc[3]);
                *(LAS u32x2*)(L + HG_AB + (wr * 16 + fr) * 144 + (st * 16 + fq * 4) * 2) = w;
            }
        }
        {
            bf16x8 aK[2];
#pragma unroll
            for (int ks = 0; ks < 2; ++ks) aK[ks] = tr_frag(L + HG_KA, 272, ks, wave, lane);
#pragma unroll
            for (int vt = 0; vt < 8; ++vt) {
#pragma unroll
                for (int ks = 0; ks < 2; ++ks) { const bf16x8 bv = tr_frag(L + HG_VR, 272, ks, vt, lane); S[vt] = __builtin_amdgcn_mfma_f32_16x16x32_bf16(aK[ks], bv, S[vt], 0, 0, 0); }
#pragma unroll
                for (int j = 0; j < 4; ++j) S[vt][j] *= eL[j];
            }
        }
        if (OUT) {
            __syncthreads();
            bf16x8 aA[2], aQ[4];
#pragma unroll
            for (int ks = 0; ks < 2; ++ks) aA[ks] = *(const LAS bf16x8*)(L + HG_AB + (wr * 16 + fr) * 144 + ks * 64 + fq * 16);
#pragma unroll
            for (int kq = 0; kq < 4; ++kq) aQ[kq] = *(const LAS bf16x8*)(L + HG_QA + (wr * 16 + fr) * 272 + kq * 64 + fq * 16);
#pragma unroll
            for (int n = 0; n < 4; ++n) {
                const int vt = wc * 4 + n;
                f32x4 o = (f32x4){0.f, 0.f, 0.f, 0.f};
#pragma unroll
                for (int ks = 0; ks < 2; ++ks) { const bf16x8 bv = tr_frag(L + HG_VR, 272, ks, vt, lane); o = __builtin_amdgcn_mfma_f32_16x16x32_bf16(aA[ks], bv, o, 0, 0, 0); }
#pragma unroll
                for (int kq = 0; kq < 4; ++kq) { const bf16x8 bs = *(const LAS bf16x8*)(L + HG_SPT + (vt * 16 + fr) * 272 + kq * 64 + fq * 16); o = __builtin_amdgcn_mfma_f32_16x16x32_bf16(aQ[kq], bs, o, 0, 0, 0); }
#pragma unroll
                for (int j = 0; j < 4; ++j) *(LAS float*)(L + HG_O + (wr * 16 + fq * 4 + j) * 528 + (vt * 16 + fr) * 4) = o[j];
            }
            __syncthreads();
            {
                f32x4 ov[4]; float ssq = 0.f;
#pragma unroll
                for (int i = 0; i < 4; ++i) { ov[i] = *(const LAS f32x4*)(L + HG_O + tv * 528 + vc * 64 + i * 16); ssq += (ov[i].x * ov[i].x + ov[i].y * ov[i].y) + (ov[i].z * ov[i].z + ov[i].w * ov[i].w); }
                ssq += __shfl_xor(ssq, 1); ssq += __shfl_xor(ssq, 2); ssq += __shfl_xor(ssq, 4);
                const float rstd = rsqrtf(ssq * (1.0f / 128.0f) + EPS);
                const unsigned gw[8] = {gc0.x, gc0.y, gc0.z, gc0.w, gc1.x, gc1.y, gc1.z, gc1.w};
                unsigned ow[8];
#pragma unroll
                for (int i = 0; i < 8; ++i) { const float g0 = bflo(gw[i]), g1 = bfhi(gw[i]);
                    const float y0 = ov[i >> 1][(2 * i) & 3] * rstd * ngv[2 * i] * g0 * __builtin_amdgcn_rcpf(1.0f + __expf(-g0));
                    const float y1 = ov[i >> 1][(2 * i + 1) & 3] * rstd * ngv[2 * i + 1] * g1 * __builtin_amdgcn_rcpf(1.0f + __expf(-g1));
                    ow[i] = pk2(y0, y1); }
                u32x4* d = (u32x4*)(og + (size_t)(b * SEQ + sc * 256 + ch * 64 + tv) * (2 * D) + h * 128 + vc * 16);
                d[0] = (u32x4){ow[0], ow[1], ow[2], ow[3]}; d[1] = (u32x4){ow[4], ow[5], ow[6], ow[7]};
            }
        }
        if (ch == 3) {
            if (!OUT) {
                float* ds = dS + (size_t)(bh * 32 + sc) * 16384;
#pragma unroll
                for (int vt = 0; vt < 8; ++vt)
#pragma unroll
                    for (int j = 0; j < 4; ++j) ds[(size_t)(16 * wave + fq * 4 + j) * 128 + vt * 16 + fr] = S[vt][j];
                if (seg == 0) *(f32x2*)(Dd + (size_t)(bh * 32 + sc) * 128 + 2 * cp) = (f32x2){__expf(gsum0), __expf(gsum1)};
            }
            idx += X.G; ch = 0; if (idx >= ntask) break;
        } else ++ch;
    }
#undef HG_LOAD
    __syncthreads();
}

__device__ __forceinline__ void ph_hg2(const Ctx& X, const float* dS, const float* Dd, float* S0) {
    for (int idx = X.vcu * 512 + X.tid; idx < 32 * 4096; idx += X.G * 512) {
        const int bh = idx >> 12, e4 = idx & 4095, k = e4 >> 5, v4 = (e4 & 31) * 4;
        f32x4 s = (f32x4){0.f, 0.f, 0.f, 0.f};
#pragma unroll 4
        for (int sc = 0; sc < 31; ++sc) { const float d = Dd[(size_t)(bh * 32 + sc) * 128 + k]; const f32x4 ds = *(const f32x4*)(dS + (size_t)(bh * 32 + sc) * 16384 + k * 128 + v4);
            s = s * d + ds; *(f32x4*)(S0 + (size_t)(bh * 32 + sc + 1) * 16384 + k * 128 + v4) = s; }
    }
}

__device__ __forceinline__ void ph_router_tables(const Ctx& X, const float* g_ffn, const float* mod, const float* w_router, const float* b_router, float* Bp, float* cb) {
    for (int i = X.vcu * 512 + X.tid; i < 4 * 1024 * 32; i += X.G * 512) { const int b = i >> 15, k = (i >> 5) & 1023;
        Bp[i] = g_ffn[k] * (1.0f + mod[(size_t)b * NMOD + 4 * D + k]) * w_router[i & 32767]; }
    const int gw = X.vcu * 8 + X.wave;
    if (gw < 128) { const int b = gw >> 5, e = gw & 31; float a = 0.f;
        for (int k = X.lane; k < 1024; k += 64) a += mod[(size_t)b * NMOD + 3 * D + k] * w_router[k * 32 + e];
        a = wave_sum(a); if (X.lane == 0) cb[gw] = a + b_router[e]; }
}

__device__ __forceinline__ void ph_route(const Ctx& X, const bf16_t* x1, const float* g_ffn, const float* mod, const float* Bp, const float* cb,
                                         unsigned char* h2, int* top_e, float* top_w, int* rank, int* hist_g) {
    LAS int* hist = (LAS int*)(X.lds + LDSCTL_OFF + 64);
    const int tid = X.tid, lane = X.lane, c = lane & 15, q = lane >> 4;
    for (int tile = X.vcu; tile < RT_NT; tile += X.G) {
        if (tid < 32) hist[tid] = 0;
        __syncthreads();
        const int tw = tile * RT_TILE + X.wave * 16, b = tw / SEQ;
        const bf16_t* xa = x1 + (size_t)(tw + c) * D + 4 * q;
        const float* bp = Bp + ((size_t)b * 1024 + 4 * q) * 32 + c;
        f32x4 acc0 = (f32x4){0.f, 0.f, 0.f, 0.f}, acc1 = acc0; float ss = 0.f;
#pragma unroll 4
        for (int m = 0; m < 64; ++m) {
            const u32x2 a2_ = *(const u32x2*)(xa + 16 * m); const f32x4 a4 = (f32x4){bflo(a2_.x), bfhi(a2_.x), bflo(a2_.y), bfhi(a2_.y)};
            float bv[8];
#pragma unroll
            for (int j = 0; j < 4; ++j) { bv[2 * j] = bp[(size_t)(16 * m + j) * 32]; bv[2 * j + 1] = bp[(size_t)(16 * m + j) * 32 + 16]; }
            ss += (a4.x * a4.x + a4.y * a4.y) + (a4.z * a4.z + a4.w * a4.w);
#pragma unroll
            for (int j = 0; j < 4; ++j) { acc0 = __builtin_amdgcn_mfma_f32_16x16x4f32(a4[j], bv[2 * j], acc0, 0, 0, 0); acc1 = __builtin_amdgcn_mfma_f32_16x16x4f32(a4[j], bv[2 * j + 1], acc1, 0, 0, 0); }
        }
        ss += __shfl_xor(ss, 16); ss += __shfl_xor(ss, 32);
        const float rs = rsqrtf(ss * (1.0f / D) + EPS);
        const float cb0 = cb[b * 32 + c], cb1 = cb[b * 32 + 16 + c];
#pragma unroll
        for (int reg = 0; reg < 4; ++reg) {
            const float rt = __shfl(rs, 4 * q + reg);
            float v0 = acc0[reg] * rt + cb0, v1 = acc1[reg] * rt + cb1;
            float sv[4]; int si[4];
#pragma unroll
            for (int rnd = 0; rnd < 4; ++rnd) {
                float bvv = v0; int bi = c; if (v1 > bvv) { bvv = v1; bi = 16 + c; }
#pragma unroll
                for (int o = 1; o < 16; o <<= 1) { const float ov = __shfl_xor(bvv, o); const int oi = __shfl_xor(bi, o); if (ov > bvv || (ov == bvv && oi < bi)) { bvv = ov; bi = oi; } }
                sv[rnd] = bvv; si[rnd] = bi; if (bi == c) v0 = -INFINITY; if (bi == 16 + c) v1 = -INFINITY;
            }
            const float e1 = __expf(sv[1] - sv[0]), e2 = __expf(sv[2] - sv[0]), e3 = __expf(sv[3] - sv[0]);
            const float inv = 1.0f / (1.0f + e1 + e2 + e3);
            if (c == 0) { const int t = tw + 4 * q + reg;
                const float ww[4] = {inv, e1 * inv, e2 * inv, e3 * inv};
#pragma unroll
                for (int rnd = 0; rnd < 4; ++rnd) { top_e[t * 4 + rnd] = si[rnd]; top_w[t * 4 + rnd] = ww[rnd]; rank[t * 4 + rnd] = atomicAdd((int*)&hist[si[rnd]], 1); }
            }
        }
        const float* sh = mod + (size_t)b * NMOD + 3 * D; const float* sc = mod + (size_t)b * NMOD + 4 * D;
#pragma unroll 4
        for (int i = 0; i < 16; ++i) {
            const float r = __shfl(rs, i);
            const u32x2* xr = (const u32x2*)(x1 + (size_t)(tw + i) * D) + lane;
#pragma unroll
            for (int j = 0; j < 4; ++j) {
                const int col = 4 * (lane + 64 * j);
                const f32x4 gg = *(const f32x4*)(g_ffn + col), s1 = *(const f32x4*)(sc + col), s0 = *(const f32x4*)(sh + col);
                const u32x2 xw = xr[64 * j]; const f32x4 xv = (f32x4){bflo(xw.x), bfhi(xw.x), bflo(xw.y), bfhi(xw.y)};
                const f32x4 y = (xv * r * gg * (s1 + 1.0f) + s0) * 16.0f;
                *(unsigned*)(h2 + (size_t)(tw + i) * D + col) = cvt4_fp8(y.x, y.y, y.z, y.w);
            }
        }
        __syncthreads();
        if (tid < 32) hist_g[tile * 32 + tid] = hist[tid];
        __syncthreads();
    }
}

__device__ __forceinline__ void ph_sort(const Ctx& X, const int* hist_g, const int* top_e, const float* top_w, const int* rank, int* row_tok, float* row_w, int* pair_row, int* blk_e) {
    LAS int* s_hist = (LAS int*)X.lds;
    LAS int* s_tot = s_hist + RT_NT * 32; LAS int* s_pre = s_tot + 32; LAS int* s_base = s_pre + 32; LAS int* s_pstart = s_base + 32; LAS int* s_pend = s_pstart + 32;
    const int tid = X.tid;
    for (int i = tid; i < RT_NT * 32; i += 512) s_hist[i] = hist_g[i];
    __syncthreads();
    for (int tile = X.vcu; tile < RT_NT; tile += X.G) {
        if (tid < 32) { int tot = 0, pre = 0; for (int i = 0; i < RT_NT; ++i) { const int c = s_hist[i * 32 + tid]; tot += c; if (i < tile) pre += c; } s_tot[tid] = tot; s_pre[tid] = pre; }
        __syncthreads();
        if (tid == 0) { int acc = 0; for (int e = 0; e < 32; ++e) { const int padded = (s_tot[e] + 255) / 256 * 256; s_pstart[e] = acc; s_base[e] = acc + s_pre[e]; acc += padded; s_pend[e] = acc; } }
        __syncthreads();
        { const int i = tid; const int idx = tile * RT_TILE * 4 + i; const int e = top_e[idx]; const int row = s_base[e] + rank[idx];
          row_tok[row] = idx >> 2; row_w[row] = top_w[idx]; pair_row[idx] = row; }
        if (tile < 32) { const int e = tile; for (int r = s_pstart[e] + s_tot[e] + tid; r < s_pend[e]; r += 512) { row_tok[r] = 0; row_w[r] = 0.f; } }
        if (tile == 32) { for (int blk = tid; blk < NBLK_MAX; blk += 512) { int e = -1; const int r = blk * 256; for (int q = 0; q < 32; ++q) if (r >= s_pstart[q] && r < s_pend[q]) e = q; blk_e[blk] = e; }
                          if (tid == 0) blk_e[NBLK_MAX] = s_pend[31] / 256; }
        __syncthreads();
    }
}

__device__ __forceinline__ void ph_final(const Ctx& X, const bf16_t* x1, const bf16_t* y, const int* pair_row, const float* mod, const float* g_final, float* out, const float oscale) {
    const int lane = X.lane;
    for (int t = X.vcu * 8 + X.wave; t < T; t += X.G * 8) {
        const int b = t / SEQ;
        const u32x2* xr = (const u32x2*)(x1 + (size_t)t * D) + lane;
        const float* ga = mod + (size_t)b * NMOD + 5 * D;
        int rows[4];
#pragma unroll
        for (int k = 0; k < 4; ++k) rows[k] = pair_row[t * 4 + k];
        f32x4 v[4]; float ss = 0.f;
#pragma unroll
        for (int j = 0; j < 4; ++j) {
            const int col = 4 * (lane + 64 * j);
            f32x4 m = (f32x4){0.f, 0.f, 0.f, 0.f};
#pragma unroll
            for (int k = 0; k < 4; ++k) { const u32x2 w = *(const u32x2*)(y + (size_t)rows[k] * D + col); m.x += bflo(w.x); m.y += bfhi(w.x); m.z += bflo(w.y); m.w += bfhi(w.y); }
            const u32x2 xw = xr[64 * j];
            v[j] = (f32x4){bflo(xw.x), bfhi(xw.x), bflo(xw.y), bfhi(xw.y)} + *(const f32x4*)(ga + col) * m;
            ss += (v[j].x * v[j].x + v[j].y * v[j].y) + (v[j].z * v[j].z + v[j].w * v[j].w);
        }
        const float r = rsqrtf(wave_sum(ss) * (1.0f / D) + EPS);
#pragma unroll
        for (int j = 0; j < 4; ++j) { const int col = 4 * (lane + 64 * j); *(f32x4*)(out + (size_t)t * D + col) = v[j] * (r * oscale) * *(const f32x4*)(g_final + col); }
    }
}

constexpr int N_PHASES = 13;
struct Args { const float* in[23]; float* out; unsigned char* ws; int ph_lo, ph_hi; };
__global__ void __launch_bounds__(512, 2) fwd(Args a) {
    extern __shared__ __attribute__((aligned(16))) unsigned char lds_raw[];
    Ctx X; X.lds = (LAS unsigned char*)lds_raw; X.tid = threadIdx.x; X.lane = X.tid & 63; X.wave = __builtin_amdgcn_readfirstlane(X.tid >> 6);
    X.G = gridDim.x; { const int bx = blockIdx.x; X.vcu = (X.G % 8 == 0) ? (bx % 8) * (X.G / 8) + bx / 8 : bx; }
    unsigned char* ws = a.ws;
    for (int u = X.tid; u < (LDS_BYTES - LDSCTL_OFF) / 4; u += 512) ((LAS unsigned*)(X.lds + LDSCTL_OFF))[u] = 0u;
    __syncthreads();
    XcdBarrier bar = xcd_barrier_post((unsigned*)(ws + WS_CTL) + CW_BAR, (volatile LAS unsigned*)(X.lds + LDSCTL_OFF), X.tid == 0);
    const int lo = a.ph_lo, hi = a.ph_hi; float probe_scale = 1.0f;
#define IN(k) (lo <= (k) && (k) < hi)
#define SEAM(k) do { if (IN(k) && IN((k) + 1)) xcd_barrier(bar, X.wave == 0 && (int)__builtin_amdgcn_mbcnt_hi(~0u, __builtin_amdgcn_mbcnt_lo(~0u, 0u)) == 0); } while (0)
#ifdef PROBE_PH
    unsigned long long* stamps = (unsigned long long*)(ws + WS_CTL + 32768);
    if (blockIdx.x == 0 && X.tid == 0) stamps[0] = __builtin_amdgcn_s_memrealtime();
#undef SEAM
#define SEAM(k) do { if (IN(k) && IN((k) + 1)) { xcd_barrier(bar, X.wave == 0 && (int)__builtin_amdgcn_mbcnt_hi(~0u, __builtin_amdgcn_mbcnt_lo(~0u, 0u)) == 0); \
        if (blockIdx.x == 0 && X.wave == 0 && (int)__builtin_amdgcn_mbcnt_hi(~0u, __builtin_amdgcn_mbcnt_lo(~0u, 0u)) == 0) stamps[(k) + 1] = __builtin_amdgcn_s_memrealtime(); } } while (0)
#endif
    const float* x = a.in[0]; const float* c = a.in[1]; const float* w_ada = a.in[2]; const float* b_ada = a.in[3];
    const float* g_mix = a.in[4]; const float* w_in = a.in[5]; const float* conv_dw = a.in[6]; const float* conv_dwb = a.in[7];
    const float* conv_ln_g = a.in[8]; const float* conv_ln_b = a.in[9]; const float* w_conv_out = a.in[10]; const float* lb_param = a.in[11];
    const float* hgrn_norm_g = a.in[12]; const float* w_hgrn_out = a.in[13]; const float* w_out = a.in[14]; const float* g_ffn = a.in[15];
    const float* w_router = a.in[16]; const float* b_router = a.in[17]; const float* w1 = a.in[18]; const float* b1 = a.in[19];
    const float* w2 = a.in[20]; const float* b2 = a.in[21]; const float* g_final = a.in[22];
    float* mod = (float*)(ws + WS_MOD); float* rt_bp = (float*)(ws + WS_BP); float* rt_cb = (float*)(ws + WS_CB);
    int* hist_g = (int*)(ws + WS_HIST); int* blk_e = (int*)(ws + WS_BLKE); int* top_e = (int*)(ws + WS_TOPE); float* top_w = (float*)(ws + WS_TOPW);
    int* rank = (int*)(ws + WS_RANK); int* pair_row = (int*)(ws + WS_PROW); int* row_tok = (int*)(ws + WS_RTOK); float* row_w = (float*)(ws + WS_RW);
    bf16_t* p = (bf16_t*)(ws + WS_P);
    bf16_t* h = (bf16_t*)(ws + WS_E); float* tmp = (float*)(ws + WS_E);
    float* hg_dS = (float*)(ws + WS_E); float* hg_S0 = (float*)(ws + WS_E + 64 * MiB); float* hg_D = (float*)(ws + WS_HGD);
    bf16_t* uc = (bf16_t*)(ws + WS_D); bf16_t* og = uc + D;   bf16_t* x1 = (bf16_t*)(ws + WS_D);
    bf16_t* merged = p;
    unsigned char* h2 = (unsigned char*)p;
    unsigned char* act = (unsigned char*)(p + PG);
    bf16_t* y = p + PG + (size_t)R_PAD * D / 2;
    PG8_LAS unsigned char* ring = (PG8_LAS unsigned char*)lds_raw;

#ifndef REPMASK
#define REPMASK 0
#endif
#ifndef REPN
#define REPN 1
#endif
#define PH(k, ...) do { if (IN(k)) { _Pragma("unroll 1") for (int rep_ = 0; rep_ < ((((REPMASK) >> (k)) & 1) ? 1 + REPN : 1); ++rep_) { if (rep_) __syncthreads(); { int ln_ = (int)__builtin_amdgcn_mbcnt_hi(~0u, __builtin_amdgcn_mbcnt_lo(~0u, 0u)); asm volatile("" : "+v"(ln_)); X.lane = ln_; X.tid = X.wave * 64 + ln_; } __VA_ARGS__ } } SEAM(k); } while (0)
    PH(0, ph_prologue<0>(X, c, w_ada, b_ada, mod, w_in, w_conv_out, w_hgrn_out, w_out, w1, w2, ws););
    PH(1, ph_norm_mod(X, x, g_mix, mod, 0, D, h); ph_router_tables(X, g_ffn, mod, w_router, b_router, rt_bp, rt_cb););
#ifndef STAGGER_TICKS
#define STAGGER_TICKS 0
#endif
    PH(2, { if (STAGGER_TICKS) { const unsigned long long t0_ = __builtin_amdgcn_s_memrealtime(), wait_ = (unsigned long long)(X.vcu & 3) * STAGGER_TICKS;
                while (__builtin_amdgcn_s_memrealtime() - t0_ < wait_) __builtin_amdgcn_s_sleep(8); }
        pg8::Gemm g{h, (const bf16_t*)(ws + WS_WIN), T, 8 * D, D}; pg8::StaticOrder S; S.init(T, 8 * D, X.G, (int)blockIdx.x);
        pg8::EpiSplitBf16 E{p, PG, 0x3cu, SEQ}; pg8::gemm_phase<pg8::EpiSplitBf16, pg8::StaticOrder, true, true>(ring, g, S, E, X.wave); });
    PH(3, ph_conv(X, p + 0 * PG, conv_dw, conv_dwb, conv_ln_g, conv_ln_b, uc);
          if ((REPMASK >> 14) & 1) { __syncthreads(); ph_conv(X, p + 0 * PG, conv_dw, conv_dwb, conv_ln_g, conv_ln_b, uc); }
          ph_hgrn<false>(X, 31 * 32, p + 2 * PG, p + 3 * PG, p + 4 * PG, p + 5 * PG, lb_param, nullptr, nullptr, hg_dS, hg_D, nullptr);
          if ((REPMASK >> 15) & 1) { __syncthreads(); ph_hgrn<false>(X, 31 * 32, p + 2 * PG, p + 3 * PG, p + 4 * PG, p + 5 * PG, lb_param, nullptr, nullptr, hg_dS, hg_D, nullptr); });
    PH(4, ph_hg2(X, hg_dS, hg_D, hg_S0););
    PH(5, if ((X.vcu & 1) == 0) ph_prologue<1>(X, c, w_ada, b_ada, mod, w_in, w_conv_out, w_hgrn_out, w_out, w1, w2, ws);
          ph_hgrn<true>(X, 32 * 32, p + 2 * PG, p + 3 * PG, p + 4 * PG, p + 5 * PG, lb_param, hgrn_norm_g, hg_S0, nullptr, nullptr, og);
          if ((X.vcu & 1) != 0) ph_prologue<1>(X, c, w_ada, b_ada, mod, w_in, w_conv_out, w_hgrn_out, w_out, w1, w2, ws););
    PH(6, { pg8::Gemm g{uc, (const bf16_t*)(ws + WS_WC), T, D, 2 * D}; pg8::StaticOrder S; S.init(T, D, X.G, (int)blockIdx.x);
        pg8::EpiGateFused E{p + 6 * PG, p + 7 * PG, merged}; pg8::gemm_phase<pg8::EpiGateFused, pg8::StaticOrder, true, true>(ring, g, S, E, X.wave); });
    PH(7, { pg8::Gemm g{merged, (const bf16_t*)(ws + WS_WO), T, D, D}; pg8::StaticOrder S; S.init(T, D, X.G, (int)blockIdx.x);
        pg8::EpiRes E{x, mod + 2 * D, x1, NMOD, SEQ}; pg8::gemm_phase<pg8::EpiRes, pg8::StaticOrder, true, true>(ring, g, S, E, X.wave); });
    PH(8, ph_route(X, x1, g_ffn, mod, rt_bp, rt_cb, h2, top_e, top_w, rank, hist_g););
    PH(9, ph_sort(X, hist_g, top_e, top_w, rank, row_tok, row_w, pair_row, blk_e););
    PH(10, { const int nblk = blk_e[NBLK_MAX]; pg8::Gemm g{(const bf16_t*)h2, (const bf16_t*)(ws + WS_W1), T, 32 * 2048, D / 2}; pg8::MoeOrder S{blk_e, nblk, X.G, (int)blockIdx.x, 3};
        LAS unsigned short* gt = (LAS unsigned short*)(X.lds + LDSCTL_OFF + 256);
        _Pragma("unroll 1") for (int i = 0; i < 23; ++i) { pg8::Unit u; if (!S.next(i, u)) break; if (X.tid < 256) gt[256 * i + X.tid] = (unsigned short)row_tok[u.pm * 256 + X.tid]; }
        __syncthreads();
        pg8::EpiSwiglu8 E{b1, act, 1.0f / 4096.0f}; pg8::gemm_phase<pg8::EpiSwiglu8, pg8::MoeOrder, true, true, true, true>(ring, g, S, E, X.wave, (const PG8_LAS unsigned short*)gt); });
    PH(11, { const int nblk = blk_e[NBLK_MAX]; pg8::Gemm g{(const bf16_t*)act, (const bf16_t*)(ws + WS_W2), R_PAD, 32 * 1024, DFF / 2}; pg8::MoeOrder S{blk_e, nblk, X.G, (int)blockIdx.x, 2};
        pg8::EpiY8 E{b2, row_w, y, 1.0f / 1024.0f}; pg8::gemm_phase<pg8::EpiY8, pg8::MoeOrder, true, true, false, true>(ring, g, S, E, X.wave); });
#ifdef PROBE_PH
    { const unsigned long long* st_ = (const unsigned long long*)(ws + WS_CTL + 32768); const float dt_ = (float)(long long)(st_[PROBE_PH + 1] - st_[PROBE_PH]);
      probe_scale = 1.0f + dt_ * (1.0f / 200000.0f); }
#endif
    PH(12, ph_final(X, x1, y, pair_row, mod, g_final, a.out, probe_scale););
#undef PH
#undef IN
#undef SEAM
}

#ifndef MK_N_LAUNCHES
#define MK_N_LAUNCHES 1
#endif
extern "C" void kernel_launch(void* const* d_in, const int* in_sizes, int n_in, void* d_out, int out_size, void* d_ws, size_t ws_size, hipStream_t stream) {
    static int grid = 0;
    if (grid == 0) {
        if (n_in != 23 || out_size != T * D || ws_size < WS_END) { fprintf(stderr, "kernel_launch: unexpected n_in %d / out_size %d / ws_size %zu (< %zu); nothing launched\n", n_in, out_size, ws_size, (size_t)WS_END); grid = -1; return; }
        int dev = 0, cus = 0, per_cu = 0;
        if (hipGetDevice(&dev) != hipSuccess || hipDeviceGetAttribute(&cus, hipDeviceAttributeMultiprocessorCount, dev) != hipSuccess) { grid = -1; return; }
        if (hipFuncSetAttribute((const void*)fwd, hipFuncAttributeMaxDynamicSharedMemorySize, LDS_BYTES) != hipSuccess) { fprintf(stderr, "kernel_launch: hipFuncSetAttribute failed\n"); grid = -1; return; }
        if (hipOccupancyMaxActiveBlocksPerMultiprocessor(&per_cu, (const void*)fwd, 512, LDS_BYTES) != hipSuccess || per_cu < 1) { fprintf(stderr, "kernel_launch: occupancy query says %d blocks per CU\n", per_cu); }
        (void)hipGetLastError();
        grid = cus;
    }
    if (grid < 0) return;
    if (hipMemsetAsync((char*)d_ws + WS_CTL, 0, CTL_ZERO_BYTES, stream) != hipSuccess) return;
    Args a{};
    for (int i = 0; i < 23; ++i) a.in[i] = (const float*)d_in[i];
    a.out = (float*)d_out; a.ws = (unsigned char*)d_ws;
    if (MK_N_LAUNCHES == 1) { a.ph_lo = 0; a.ph_hi = N_PHASES; hipLaunchKernelGGL(fwd, dim3(grid), dim3(512), LDS_BYTES, stream, a); }
    else for (int ph = 0; ph < N_PHASES; ++ph) { a.ph_lo = ph; a.ph_hi = ph + 1; hipLaunchKernelGGL(fwd, dim3(grid), dim3(512), LDS_BYTES, stream, a); }
}
```

```cpp
#include <hip/hip_runtime.h>
#include <stdint.h>
#include <stdio.h>

#define GAS __attribute__((address_space(1)))
#define LAS __attribute__((address_space(3)))
typedef unsigned short bf16_t;
typedef unsigned u32x4 __attribute__((ext_vector_type(4)));
typedef unsigned u32x2 __attribute__((ext_vector_type(2)));
typedef float f32x4 __attribute__((ext_vector_type(4)));

constexpr int D = 1024, NBATCH = 4, SEQ = 8192, T = NBATCH * SEQ;
constexpr int NE = 32, DFF = 1024;
constexpr int NMOD = 6 * D;
constexpr int NBLK_MAX = 544, R_PAD = NBLK_MAX * 256;
constexpr int RT_TILE = 128, RT_NT = T / RT_TILE;
constexpr float EPS = 1e-6f;

constexpr size_t MiB = 1u << 20;
constexpr size_t WS_CTL = 0, CTL_ZERO_BYTES = 64 * 1024;
constexpr size_t WS_MOD = 1 * MiB;
constexpr size_t WS_CB = WS_MOD + 112 * 1024, WS_BP = WS_MOD + 128 * 1024;
constexpr size_t WS_HIST = 2 * MiB;
constexpr size_t WS_BLKE = WS_HIST + 64 * 1024;
constexpr size_t WS_TOPE = 3 * MiB;
constexpr size_t WS_TOPW = WS_TOPE + 512 * 1024;
constexpr size_t WS_RANK = WS_TOPW + 512 * 1024;
constexpr size_t WS_PROW = WS_RANK + 512 * 1024;
constexpr size_t WS_RTOK = 5 * MiB;
constexpr size_t WS_RW = 6 * MiB;
constexpr size_t WS_HGD = 7 * MiB;
constexpr size_t WS_WT = 8 * MiB;
constexpr size_t WS_WIN = WS_WT, WS_WC = WS_WT + 16 * MiB, WS_WH = WS_WT + 18 * MiB, WS_WO = WS_WT + 20 * MiB, WS_W1 = WS_WT + 22 * MiB, WS_W2 = WS_WT + 150 * MiB;
constexpr size_t WS_P = 224 * MiB;
constexpr size_t WS_E = WS_P + 512 * MiB;
constexpr size_t WS_D = WS_E + 128 * MiB;
constexpr size_t WS_END = WS_D + 128 * MiB;
constexpr size_t PG = (size_t)T * D;
constexpr int CW_BAR = 0;

constexpr int RING_BYTES = 135168, LDSCTL_OFF = RING_BYTES, LDS_BYTES = 147456;

__device__ __forceinline__ unsigned f2bf(float f) { unsigned u = __builtin_bit_cast(unsigned, f); return (u + 0x7fffu + ((u >> 16) & 1u)) >> 16; }
__device__ __forceinline__ unsigned pk2(float lo, float hi) { return f2bf(lo) | (f2bf(hi) << 16); }
__device__ __forceinline__ float bf2f(unsigned b) { return __builtin_bit_cast(float, b << 16); }
__device__ __forceinline__ float bflo(unsigned w) { return __builtin_bit_cast(float, w << 16); }
__device__ __forceinline__ float bfhi(unsigned w) { return __builtin_bit_cast(float, w & 0xffff0000u); }
__device__ __forceinline__ float sigmoidf_(float x) { return __builtin_amdgcn_rcpf(1.0f + __expf(-x)); }
__device__ __forceinline__ float wave_sum(float v) {
#pragma unroll
    for (int o = 1; o < 64; o <<= 1) v += __shfl_xor(v, o);
    return v;
}
__device__ __forceinline__ unsigned cvt4_fp8(float a, float b, float c, float d) {
    a = fminf(fmaxf(a, -448.f), 448.f); b = fminf(fmaxf(b, -448.f), 448.f); c = fminf(fmaxf(c, -448.f), 448.f); d = fminf(fmaxf(d, -448.f), 448.f);
    int w = 0; w = __builtin_amdgcn_cvt_pk_fp8_f32(a, b, w, false); w = __builtin_amdgcn_cvt_pk_fp8_f32(c, d, w, true); return (unsigned)w; }
#define LDS_WAIT() asm volatile("s_waitcnt lgkmcnt(0)" ::: "memory")
#define VM_WAIT() asm volatile("s_waitcnt vmcnt(0)" ::: "memory")

namespace pg8 {
#define PG8_LAS __attribute__((address_space(3)))
typedef unsigned short bf16_t;
typedef short bf16x8 __attribute__((ext_vector_type(8)));
typedef float f32x4 __attribute__((ext_vector_type(4)));
typedef unsigned u32x4 __attribute__((ext_vector_type(4)));
constexpr int BM = 256, BK = 64, HALF = 128, HTB = HALF * BK * 2  , STAGE_BYTES = 8 * HTB, NXCD = 8, WGM = 8;

__host__ __device__ __forceinline__ int lds_byte(int r, int c) { const int st = (r >> 4) * 2 + (c >> 5), rr = r & 15, cc = c & 31, ob = rr * 64 + cc * 2; return st * 1024 + (ob ^ (((ob >> 9) & 1) << 5)); }
__host__ __device__ __forceinline__ void stage_rc(int b, int& R, int& C) { const int st = b / 1024, sb = b % 1024, swz = sb ^ (((sb >> 9) & 1) << 5); R = (st >> 1) * 16 + swz / 64; C = (st & 1) * 32 + (swz % 64) / 2; }
__host__ __device__ __forceinline__ int perm32(int rho) { const int n = rho >> 4, i = rho & 15; return 8 * (i >> 2) + 4 * n + (i & 3); }

struct Unit { int pm, pn; };
struct Gemm { const bf16_t* A; const bf16_t* Bt; int M, N, K; };

struct StaticOrder {
    int nM, nN, nwg, G, c;
    __host__ __device__ void init(int M, int N, int G_, int c_) { nM = M / BM; nN = N / BM; nwg = nM * nN; G = G_; c = c_; }
    __host__ __device__ bool next(int i, Unit& u) const {
        const long L = (long)i * G + c; if (L >= nwg) return false;
        int wgid = (int)L; { const int q = nwg / NXCD, r = nwg % NXCD, xcd = wgid % NXCD, off = wgid / NXCD; wgid = (xcd < r ? xcd * (q + 1) : r * (q + 1) + (xcd - r) * q) + off; }
        const int nig = WGM * nN, gid = wgid / nig, fm = gid * WGM, gsz = (nM - fm) < WGM ? (nM - fm) : WGM;
        u.pm = fm + ((wgid % nig) % gsz); u.pn = (wgid % nig) / gsz; return true;
    }
    __device__ __forceinline__ void a_ready(const Unit&) const {}
    __device__ __forceinline__ void done(const Unit&) const {}
};


struct MoeOrder {
    const int* blk_e; int nblk, G, c, lg;
    __device__ __forceinline__ bool next(int i, Unit& u) const {
        int blk, j;
        if (G == 256) { const int xcd = c & 7, idx = c >> 3, prb = 256 >> lg; blk = i * prb + xcd * (prb >> 3) + (idx >> lg); j = idx & ((1 << lg) - 1); }
        else { const long L = (long)i * G + c; blk = (int)(L >> lg); j = (int)(L & ((1 << lg) - 1)); }
        if (blk >= nblk) return false;
        const int e = blk_e[blk]; u.pm = blk; u.pn = (e << lg) + j; return true;
    }
    __device__ __forceinline__ void a_ready(const Unit&) const {}
    __device__ __forceinline__ void done(const Unit&) const {}
};

__device__ __forceinline__ unsigned cvt_pk_bf16(float lo, float hi) { unsigned r; asm volatile("v_cvt_pk_bf16_f32 %0, %1, %2" : "=v"(r) : "v"(lo), "v"(hi)); return r; }
__device__ __forceinline__ float sigm(float x) { return __builtin_amdgcn_rcpf(1.0f + __expf(-x)); }
__device__ __forceinline__ float blo(unsigned w) { return __builtin_bit_cast(float, w << 16); }
__device__ __forceinline__ float bhi(unsigned w) { return __builtin_bit_cast(float, w & 0xffff0000u); }

struct EpiSplitBf16 {
    static constexpr bool PERM = true, AFTER_DRAIN = false;
    bf16_t* O; size_t split_stride; unsigned hm_mask; int seq;
    __device__ __forceinline__ void operator()(const f32x4 (&acc)[2][2][4][2], const Unit& u, int wr, int wc, int fr, int fq) const {
        const int row0 = u.pm * BM + wr * 64 + fr; const int colt = u.pn * BM; const int t = colt >> 10;
        if (u.pn < 8) {
#pragma unroll
            for (int ai = 0; ai < 2; ++ai)
#pragma unroll
                for (int m = 0; m < 4; ++m) { const int row = row0 + ai * HALF + m * 16; float r[8];
#pragma unroll
                    for (int q = 0; q < 4; ++q) { r[q] = acc[ai][0][m][0][q] * sigm(acc[ai][1][m][0][q]); r[4 + q] = acc[ai][0][m][1][q] * sigm(acc[ai][1][m][1][q]); }
                    u32x4 w; w.x = cvt_pk_bf16(r[0], r[1]); w.y = cvt_pk_bf16(r[2], r[3]); w.z = cvt_pk_bf16(r[4], r[5]); w.w = cvt_pk_bf16(r[6], r[7]);
                    *(u32x4*)(O + (size_t)row * 1024 + 128 * u.pn + wc * 32 + 8 * fq) = w; }
            return;
        }
        bf16_t* base = O + (size_t)t * split_stride; const int cg = colt & 1023;
        const bool hm = (hm_mask >> t) & 1u;
        const int bb = (u.pm * BM) / seq;
#pragma unroll
        for (int ai = 0; ai < 2; ++ai)
#pragma unroll
            for (int m = 0; m < 4; ++m) { const int row = row0 + ai * HALF + m * 16;
#pragma unroll
                for (int bj = 0; bj < 2; ++bj) { const f32x4 v0 = acc[ai][bj][m][0], v1 = acc[ai][bj][m][1];
                    u32x4 w; w.x = cvt_pk_bf16(v0[0], v0[1]); w.y = cvt_pk_bf16(v0[2], v0[3]); w.z = cvt_pk_bf16(v1[0], v1[1]); w.w = cvt_pk_bf16(v1[2], v1[3]);
                    const size_t o = hm ? ((size_t)(bb * 8 + (cg >> 7) + bj) * seq + (row - bb * seq)) * 128 + wc * 32 + 8 * fq
                                        : (size_t)row * 1024 + cg + bj * HALF + wc * 32 + 8 * fq;
                    *(u32x4*)(base + o) = w; } }
    }
};
struct EpiGate1 {
    static constexpr bool PERM = true, AFTER_DRAIN = false;
    const bf16_t* gate; float* tmp;
    __device__ __forceinline__ void operator()(const f32x4 (&acc)[2][2][4][2], const Unit& u, int wr, int wc, int fr, int fq) const {
        const int row0 = u.pm * BM + wr * 64 + fr, col0 = u.pn * BM + wc * 32 + 8 * fq;
#pragma unroll
        for (int ai = 0; ai < 2; ++ai)
#pragma unroll
            for (int m = 0; m < 4; ++m) { const size_t o = (size_t)(row0 + ai * HALF + m * 16) * 1024 + col0;
#pragma unroll
                for (int bj = 0; bj < 2; ++bj) { const u32x4 g = *(const u32x4*)(gate + o + bj * HALF); f32x4 v0 = acc[ai][bj][m][0], v1 = acc[ai][bj][m][1];
                    v0[0] *= sigm(blo(g.x)); v0[1] *= sigm(bhi(g.x)); v0[2] *= sigm(blo(g.y)); v0[3] *= sigm(bhi(g.y));
                    v1[0] *= sigm(blo(g.z)); v1[1] *= sigm(bhi(g.z)); v1[2] *= sigm(blo(g.w)); v1[3] *= sigm(bhi(g.w));
                    *(f32x4*)(tmp + o + bj * HALF) = v0; *(f32x4*)(tmp + o + bj * HALF + 4) = v1; } }
    }
};
struct EpiGate2 {
    static constexpr bool PERM = true, AFTER_DRAIN = false;
    const bf16_t* gate; const float* tmp; bf16_t* out;
    __device__ __forceinline__ void operator()(const f32x4 (&acc)[2][2][4][2], const Unit& u, int wr, int wc, int fr, int fq) const {
        const int row0 = u.pm * BM + wr * 64 + fr, col0 = u.pn * BM + wc * 32 + 8 * fq;
#pragma unroll
        for (int ai = 0; ai < 2; ++ai)
#pragma unroll
            for (int m = 0; m < 4; ++m) { const size_t o = (size_t)(row0 + ai * HALF + m * 16) * 1024 + col0;
#pragma unroll
                for (int bj = 0; bj < 2; ++bj) { const u32x4 g = *(const u32x4*)(gate + o + bj * HALF); f32x4 v0 = acc[ai][bj][m][0], v1 = acc[ai][bj][m][1];
                    const f32x4 t0 = *(const f32x4*)(tmp + o + bj * HALF), t1 = *(const f32x4*)(tmp + o + bj * HALF + 4);
                    v0[0] = t0[0] + v0[0] * sigm(blo(g.x)); v0[1] = t0[1] + v0[1] * sigm(bhi(g.x)); v0[2] = t0[2] + v0[2] * sigm(blo(g.y)); v0[3] = t0[3] + v0[3] * sigm(bhi(g.y));
                    v1[0] = t1[0] + v1[0] * sigm(blo(g.z)); v1[1] = t1[1] + v1[1] * sigm(bhi(g.z)); v1[2] = t1[2] + v1[2] * sigm(blo(g.w)); v1[3] = t1[3] + v1[3] * sigm(bhi(g.w));
                    u32x4 w; w.x = cvt_pk_bf16(v0[0], v0[1]); w.y = cvt_pk_bf16(v0[2], v0[3]); w.z = cvt_pk_bf16(v1[0], v1[1]); w.w = cvt_pk_bf16(v1[2], v1[3]);
                    *(u32x4*)(out + o + bj * HALF) = w; } }
    }
};
struct EpiRes {
    static constexpr bool PERM = true, AFTER_DRAIN = false;
    const float* x; const float* ga; bf16_t* out; int mod_pitch, seq;
    __device__ __forceinline__ void operator()(const f32x4 (&acc)[2][2][4][2], const Unit& u, int wr, int wc, int fr, int fq) const {
        const int row0 = u.pm * BM + wr * 64 + fr, col0 = u.pn * BM + wc * 32 + 8 * fq;
        const float* gab = ga + (size_t)((u.pm * BM) / seq) * mod_pitch + col0;
        f32x4 gv[2][2];
#pragma unroll
        for (int bj = 0; bj < 2; ++bj)
#pragma unroll
            for (int n = 0; n < 2; ++n) gv[bj][n] = *(const f32x4*)(gab + bj * HALF + 4 * n);
#pragma unroll
        for (int ai = 0; ai < 2; ++ai)
#pragma unroll
            for (int m = 0; m < 4; ++m) { const size_t o = (size_t)(row0 + ai * HALF + m * 16) * 1024 + col0;
#pragma unroll
                for (int bj = 0; bj < 2; ++bj) { const f32x4 x0 = *(const f32x4*)(x + o + bj * HALF), x1_ = *(const f32x4*)(x + o + bj * HALF + 4);
                    const f32x4 v0 = x0 + gv[bj][0] * acc[ai][bj][m][0], v1 = x1_ + gv[bj][1] * acc[ai][bj][m][1];
                    u32x4 w; w.x = cvt_pk_bf16(v0[0], v0[1]); w.y = cvt_pk_bf16(v0[2], v0[3]); w.z = cvt_pk_bf16(v1[0], v1[1]); w.w = cvt_pk_bf16(v1[2], v1[3]);
                    *(u32x4*)(out + o + bj * HALF) = w; } }
    }
};
struct EpiSwiglu {
    static constexpr bool PERM = true, AFTER_DRAIN = false;
    const float* b1; bf16_t* act;
    __device__ __forceinline__ void operator()(const f32x4 (&acc)[2][2][4][2], const Unit& u, int wr, int wc, int fr, int fq) const {
        const int e = u.pn >> 3, j = u.pn & 7; const int row0 = u.pm * BM + wr * 64 + fr, f0 = 128 * j + wc * 32 + 8 * fq;
        const float* be = b1 + (size_t)e * 2048 + f0;
        const f32x4 bg0 = *(const f32x4*)(be), bg1 = *(const f32x4*)(be + 4), bl0 = *(const f32x4*)(be + 1024), bl1 = *(const f32x4*)(be + 1028);
#pragma unroll
        for (int ai = 0; ai < 2; ++ai)
#pragma unroll
            for (int m = 0; m < 4; ++m) {
                f32x4 g0 = acc[ai][0][m][0] + bg0, g1 = acc[ai][0][m][1] + bg1, l0 = acc[ai][1][m][0] + bl0, l1 = acc[ai][1][m][1] + bl1;
                float r[8];
#pragma unroll
                for (int q = 0; q < 4; ++q) { float gl = fminf(g0[q], 7.0f), li = fminf(fmaxf(l0[q], -7.0f), 7.0f); r[q] = gl * sigm(1.702f * gl) * (li + 1.0f);
                                              gl = fminf(g1[q], 7.0f); li = fminf(fmaxf(l1[q], -7.0f), 7.0f); r[4 + q] = gl * sigm(1.702f * gl) * (li + 1.0f); }
                u32x4 w; w.x = cvt_pk_bf16(r[0], r[1]); w.y = cvt_pk_bf16(r[2], r[3]); w.z = cvt_pk_bf16(r[4], r[5]); w.w = cvt_pk_bf16(r[6], r[7]);
                *(u32x4*)(act + (size_t)(row0 + ai * HALF + m * 16) * 1024 + f0) = w; }
    }
};
struct EpiY {
    static constexpr bool PERM = true, AFTER_DRAIN = false;
    const float* b2; const float* rw; bf16_t* y;
    __device__ __forceinline__ void operator()(const f32x4 (&acc)[2][2][4][2], const Unit& u, int wr, int wc, int fr, int fq) const {
        const int e = u.pn >> 2, j = u.pn & 3; const int row0 = u.pm * BM + wr * 64 + fr, col0 = 256 * j + wc * 32 + 8 * fq;
        const float* be = b2 + (size_t)e * 1024 + col0;
        f32x4 bv[2][2];
#pragma unroll
        for (int bj = 0; bj < 2; ++bj)
#pragma unroll
            for (int n = 0; n < 2; ++n) bv[bj][n] = *(const f32x4*)(be + bj * HALF + 4 * n);
#pragma unroll
        for (int ai = 0; ai < 2; ++ai)
#pragma unroll
            for (int m = 0; m < 4; ++m) { const int row = row0 + ai * HALF + m * 16; const float w_ = rw[row];
#pragma unroll
                for (int bj = 0; bj < 2; ++bj) { const f32x4 v0 = (acc[ai][bj][m][0] + bv[bj][0]) * w_, v1 = (acc[ai][bj][m][1] + bv[bj][1]) * w_;
                    u32x4 w; w.x = cvt_pk_bf16(v0[0], v0[1]); w.y = cvt_pk_bf16(v0[2], v0[3]); w.z = cvt_pk_bf16(v1[0], v1[1]); w.w = cvt_pk_bf16(v1[2], v1[3]);
                    *(u32x4*)(y + (size_t)row * 1024 + col0 + bj * HALF) = w; } }
    }
};


struct EpiSwiglu8 {
    static constexpr bool PERM = true, AFTER_DRAIN = false;
    const float* b1; unsigned char* act; float dq;
    __device__ __forceinline__ void operator()(const f32x4 (&acc)[2][2][4][2], const Unit& u, int wr, int wc, int fr, int fq) const {
        const int e = u.pn >> 3, j = u.pn & 7; const int row0 = u.pm * BM + wr * 64 + fr, f0 = 128 * j + wc * 32 + 8 * fq;
        const float* be = b1 + (size_t)e * 2048 + f0;
        const f32x4 bg0 = *(const f32x4*)(be), bg1 = *(const f32x4*)(be + 4), bl0 = *(const f32x4*)(be + 1024), bl1 = *(const f32x4*)(be + 1028);
#pragma unroll
        for (int ai = 0; ai < 2; ++ai)
#pragma unroll
            for (int m = 0; m < 4; ++m) {
                f32x4 g0 = acc[ai][0][m][0] * dq + bg0, g1 = acc[ai][0][m][1] * dq + bg1, l0 = acc[ai][1][m][0] * dq + bl0, l1 = acc[ai][1][m][1] * dq + bl1;
                float r[8];
#pragma unroll
                for (int q = 0; q < 4; ++q) { float gl = fminf(g0[q], 7.0f), li = fminf(fmaxf(l0[q], -7.0f), 7.0f); r[q] = 4.0f * gl * sigm(1.702f * gl) * (li + 1.0f);
                                              gl = fminf(g1[q], 7.0f); li = fminf(fmaxf(l1[q], -7.0f), 7.0f); r[4 + q] = 4.0f * gl * sigm(1.702f * gl) * (li + 1.0f); }
                u32x2 w; w.x = cvt4_fp8(r[0], r[1], r[2], r[3]); w.y = cvt4_fp8(r[4], r[5], r[6], r[7]);
                *(u32x2*)(act + (size_t)(row0 + ai * HALF + m * 16) * 1024 + f0) = w; }
    }
};
struct EpiY8 {
    static constexpr bool PERM = true, AFTER_DRAIN = false;
    const float* b2; const float* rw; bf16_t* y; float dq;
    __device__ __forceinline__ void operator()(const f32x4 (&acc)[2][2][4][2], const Unit& u, int wr, int wc, int fr, int fq) const {
        const int e = u.pn >> 2, j = u.pn & 3; const int row0 = u.pm * BM + wr * 64 + fr, col0 = 256 * j + wc * 32 + 8 * fq;
        const float* be = b2 + (size_t)e * 1024 + col0;
        f32x4 bv[2][2];
#pragma unroll
        for (int bj = 0; bj < 2; ++bj)
#pragma unroll
            for (int n = 0; n < 2; ++n) bv[bj][n] = *(const f32x4*)(be + bj * HALF + 4 * n);
#pragma unroll
        for (int ai = 0; ai < 2; ++ai)
#pragma unroll
            for (int m = 0; m < 4; ++m) { const int row = row0 + ai * HALF + m * 16; const float w_ = rw[row];
#pragma unroll
                for (int bj = 0; bj < 2; ++bj) { const f32x4 v0 = (acc[ai][bj][m][0] * dq + bv[bj][0]) * w_, v1 = (acc[ai][bj][m][1] * dq + bv[bj][1]) * w_;
                    u32x4 w; w.x = cvt_pk_bf16(v0[0], v0[1]); w.y = cvt_pk_bf16(v0[2], v0[3]); w.z = cvt_pk_bf16(v1[0], v1[1]); w.w = cvt_pk_bf16(v1[2], v1[3]);
                    *(u32x4*)(y + (size_t)row * 1024 + col0 + bj * HALF) = w; } }
    }
};


struct EpiGateFused {
    static constexpr bool PERM = true, AFTER_DRAIN = false, HAS_MID = true;
    const bf16_t* gc; const bf16_t* gh; bf16_t* out;
    __device__ __forceinline__ void mid(f32x4 (&acc)[2][2][4][2], const Unit& u, int wr, int wc, int fr, int fq) const {
        const int row0 = u.pm * BM + wr * 64 + fr, col0 = u.pn * BM + wc * 32 + 8 * fq;
#pragma unroll
        for (int ai = 0; ai < 2; ++ai)
#pragma unroll
            for (int m = 0; m < 4; ++m) { const size_t o = (size_t)(row0 + ai * HALF + m * 16) * 1024 + col0;
#pragma unroll
                for (int bj = 0; bj < 2; ++bj) { const u32x4 a = *(const u32x4*)(gc + o + bj * HALF), b = *(const u32x4*)(gh + o + bj * HALF);
                    const unsigned aw[4] = {a.x, a.y, a.z, a.w}, bw[4] = {b.x, b.y, b.z, b.w};
#pragma unroll
                    for (int q = 0; q < 4; ++q) { const float r0 = (1.0f + __expf(-blo(bw[q]))) * __builtin_amdgcn_rcpf(1.0f + __expf(-blo(aw[q]))), r1 = (1.0f + __expf(-bhi(bw[q]))) * __builtin_amdgcn_rcpf(1.0f + __expf(-bhi(aw[q])));
                        acc[ai][bj][m][q >> 1][(2 * q) & 3] *= r0; acc[ai][bj][m][q >> 1][(2 * q + 1) & 3] *= r1; } } }
    }
    __device__ __forceinline__ void operator()(const f32x4 (&acc)[2][2][4][2], const Unit& u, int wr, int wc, int fr, int fq) const {
        const int row0 = u.pm * BM + wr * 64 + fr, col0 = u.pn * BM + wc * 32 + 8 * fq;
#pragma unroll
        for (int ai = 0; ai < 2; ++ai)
#pragma unroll
            for (int m = 0; m < 4; ++m) { const size_t o = (size_t)(row0 + ai * HALF + m * 16) * 1024 + col0;
#pragma unroll
                for (int bj = 0; bj < 2; ++bj) { const u32x4 g = *(const u32x4*)(gh + o + bj * HALF); f32x4 v0 = acc[ai][bj][m][0], v1 = acc[ai][bj][m][1];
                    v0[0] *= sigm(blo(g.x)); v0[1] *= sigm(bhi(g.x)); v0[2] *= sigm(blo(g.y)); v0[3] *= sigm(bhi(g.y));
                    v1[0] *= sigm(blo(g.z)); v1[1] *= sigm(bhi(g.z)); v1[2] *= sigm(blo(g.w)); v1[3] *= sigm(bhi(g.w));
                    u32x4 w; w.x = cvt_pk_bf16(v0[0], v0[1]); w.y = cvt_pk_bf16(v0[2], v0[3]); w.z = cvt_pk_bf16(v1[0], v1[1]); w.w = cvt_pk_bf16(v1[2], v1[3]);
                    *(u32x4*)(out + o + bj * HALF) = w; } }
    }
};

template <class T, class = void> struct has_mid { static constexpr bool value = false; };
template <class T> struct has_mid<T, decltype((void)T::HAS_MID)> { static constexpr bool value = true; };
template <class Epi, class Sched, bool ALIGN_EPI = false, bool SP2 = false, bool GATHER = false, bool FP8 = false>
__device__ __forceinline__ void gemm_phase(PG8_LAS unsigned char* lds, const Gemm g, const Sched& S, const Epi& E, const int wave_id, const PG8_LAS unsigned short* gtab = nullptr) {
    typedef int i32x4 __attribute__((ext_vector_type(4))); typedef int i32x8 __attribute__((ext_vector_type(8)));
    static_assert(!GATHER || SP2, "GATHER needs the SP2 loop");
    int lane = (int)__builtin_amdgcn_mbcnt_hi(~0u, __builtin_amdgcn_mbcnt_lo(~0u, 0u)); asm volatile("" : "+v"(lane));
    const int wid = wave_id, tid = wid * 64 + lane, wr = wid >> 2, wc = wid & 3, fr = lane & 15, fq = lane >> 4;
    const int K = g.K, nt = K / BK;
    unsigned voffA[2], voffB[2];
#pragma unroll
    for (int i = 0; i < 2; ++i) { int R, C; stage_rc(tid * 16 + i * 8192, R, C); const int Rb = Epi::PERM ? ((R & ~31) + perm32(R & 31)) : R;
        voffA[i] = (unsigned)(R * K + C) * 2u; voffB[i] = (unsigned)(Rb * K + C) * 2u; }
    unsigned vA0[2] = {0u, 0u}, vA1[2] = {0u, 0u}, xA0[2] = {0u, 0u}, xA1[2] = {0u, 0u};
#define PG8_GLOAD(d0, d1, ui_) do { int tz_ = wid * 64 + (int)__builtin_amdgcn_mbcnt_hi(~0u, __builtin_amdgcn_mbcnt_lo(~0u, 0u)); asm volatile("" : "+v"(tz_)); _Pragma("unroll") for (int _i = 0; _i < 2; ++_i) { int R_, C_; stage_rc(tz_ * 16 + _i * 8192, R_, C_); \
        d0[_i] = (unsigned)gtab[256 * (ui_) + R_] * (unsigned)(K * 2) + (unsigned)C_ * 2u; d1[_i] = (unsigned)gtab[256 * (ui_) + 128 + R_] * (unsigned)(K * 2) + (unsigned)C_ * 2u; } } while (0)
    const unsigned kstep = (unsigned)(BK * 2);
    const unsigned hstep = (unsigned)HALF * K * 2;
    const unsigned tstep = 2 * hstep;
    const __amdgpu_buffer_rsrc_t rsA = __builtin_amdgcn_make_buffer_rsrc((void*)g.A, 0, 0x7fffffff, 0x00020000), rsB = __builtin_amdgcn_make_buffer_rsrc((void*)g.Bt, 0, 0x7fffffff, 0x00020000);
    const unsigned ldsw = (unsigned)wid * 1024u;
    const int aoff = lds_byte(wr * 64 + fr, fq * 8), boff = lds_byte(wc * 32 + fr, fq * 8);
#define PG8_SA(b, h) (((b) * 2 + (h)) * HTB)
#define PG8_SB(b, h) ((4 + (b) * 2 + (h)) * HTB)
#define PG8_STAGE(bufoff, rs, soff, voff) do { _Pragma("unroll") for (int _i = 0; _i < 2; ++_i) \
        __builtin_amdgcn_raw_ptr_buffer_load_lds(rs, (PG8_LAS void*)(lds + (bufoff) + ldsw + _i * 8192), 16, (int)(voff)[_i], (int)(soff), 0, 0); } while (0)
#define PG8_LDA(dst, b, h) do { if constexpr (FP8) { _Pragma("unroll") for (int m = 0; m < 4; ++m) dst##_8[m] = __builtin_shufflevector(*(const PG8_LAS i32x4*)(lds + PG8_SA(b, h) + aoff + m * 2048), *(const PG8_LAS i32x4*)(lds + PG8_SA(b, h) + aoff + m * 2048 + 1024), 0, 1, 2, 3, 4, 5, 6, 7); } \
        else { _Pragma("unroll") for (int m = 0; m < 4; ++m) _Pragma("unroll") for (int k = 0; k < 2; ++k) dst[m][k] = *(const PG8_LAS bf16x8*)(lds + PG8_SA(b, h) + aoff + m * 2048 + k * 1024); } } while (0)
#define PG8_LDB(dst, b, h) do { if constexpr (FP8) { _Pragma("unroll") for (int n = 0; n < 2; ++n) dst##_8[n] = __builtin_shufflevector(*(const PG8_LAS i32x4*)(lds + PG8_SB(b, h) + boff + n * 2048), *(const PG8_LAS i32x4*)(lds + PG8_SB(b, h) + boff + n * 2048 + 1024), 0, 1, 2, 3, 4, 5, 6, 7); } \
        else { _Pragma("unroll") for (int n = 0; n < 2; ++n) _Pragma("unroll") for (int k = 0; k < 2; ++k) dst[n][k] = *(const PG8_LAS bf16x8*)(lds + PG8_SB(b, h) + boff + n * 2048 + k * 1024); } } while (0)
#define PG8_MMA(ai, bj, At, Bt) do { __builtin_amdgcn_s_setprio(1); if constexpr (FP8) { _Pragma("unroll") for (int m = 0; m < 4; ++m) _Pragma("unroll") for (int n = 0; n < 2; ++n) \
        asm volatile("v_mfma_scale_f32_16x16x128_f8f6f4 %0, %1, %2, %0, %3, %3 op_sel_hi:[0,0,0]" : "+v"(acc[ai][bj][m][n]) : "v"(Bt##_8[n]), "v"(At##_8[m]), "v"(sc8));     \
        } else { _Pragma("unroll") for (int m = 0; m < 4; ++m) _Pragma("unroll") for (int n = 0; n < 2; ++n) _Pragma("unroll") for (int k = 0; k < 2; ++k) \
        acc[ai][bj][m][n] = __builtin_amdgcn_mfma_f32_16x16x32_bf16(Bt[n][k], At[m][k], acc[ai][bj][m][n], 0, 0, 0); } __builtin_amdgcn_s_setprio(0); } while (0)
#define PG8_WAIT_V(n) asm volatile("s_waitcnt vmcnt(" #n ")" ::: "memory")
#define PG8_WAIT_L(n) asm volatile("s_waitcnt lgkmcnt(" #n ")" ::: "memory")
#define PG8_BAR __builtin_amdgcn_s_barrier()
#define PG8_SCHED __builtin_amdgcn_sched_barrier(0)
    Unit cur, nxt; int ui = 0;
    if (!S.next(0, cur)) return;
    f32x4 acc[2][2][4][2];
#pragma unroll
    for (int a = 0; a < 2; ++a)
#pragma unroll
        for (int b = 0; b < 2; ++b)
#pragma unroll
            for (int m = 0; m < 4; ++m)
#pragma unroll
                for (int n = 0; n < 2; ++n) acc[a][b][m][n] = (f32x4){0.f, 0.f, 0.f, 0.f};
    int sc8 = 0x7f7f7f7f; asm volatile("" : "+v"(sc8));
    bf16x8 At[4][2], B0[2][2], B1[2][2]; i32x8 At_8[4], B0_8[2], B1_8[2];
    unsigned cA = GATHER ? 0u : (unsigned)cur.pm * tstep, cB = (unsigned)cur.pn * tstep;
    S.a_ready(cur);
    if constexpr (GATHER) { PG8_GLOAD(vA0, vA1, 0); xA0[0] = vA0[0]; xA0[1] = vA0[1]; xA1[0] = vA1[0]; xA1[1] = vA1[1]; }
    if constexpr (SP2) {
        PG8_STAGE(PG8_SB(0, 0), rsB, cB, voffB); PG8_STAGE(PG8_SB(0, 1), rsB, cB + hstep, voffB);
        if constexpr (GATHER) { PG8_STAGE(PG8_SA(0, 0), rsA, cA, vA0); PG8_STAGE(PG8_SA(0, 1), rsA, cA, vA1); } else { PG8_STAGE(PG8_SA(0, 0), rsA, cA, voffA); PG8_STAGE(PG8_SA(0, 1), rsA, cA + hstep, voffA); }
        if (wr == 1) PG8_BAR;
        PG8_WAIT_V(2); PG8_BAR;
        PG8_STAGE(PG8_SB(1, 0), rsB, cB + kstep, voffB); if constexpr (GATHER) { PG8_STAGE(PG8_SA(1, 0), rsA, cA + kstep, vA0); } else { PG8_STAGE(PG8_SA(1, 0), rsA, cA + kstep, voffA); } PG8_STAGE(PG8_SB(1, 1), rsB, cB + hstep + kstep, voffB);
        PG8_WAIT_V(6); PG8_BAR;
    } else {
        PG8_STAGE(PG8_SB(0, 0), rsB, cB, voffB); PG8_STAGE(PG8_SA(0, 0), rsA, cA, voffA); PG8_STAGE(PG8_SB(0, 1), rsB, cB + hstep, voffB); PG8_STAGE(PG8_SA(0, 1), rsA, cA + hstep, voffA);
        if (wr == 1) PG8_BAR;
        PG8_WAIT_V(4); PG8_BAR;
        PG8_STAGE(PG8_SB(1, 0), rsB, cB + kstep, voffB); PG8_STAGE(PG8_SA(1, 0), rsA, cA + kstep, voffA); PG8_STAGE(PG8_SB(1, 1), rsB, cB + hstep + kstep, voffB);
        PG8_WAIT_V(6); PG8_BAR;
    }
    for (;;) {
        const bool has_next = S.next(ui + 1, nxt);
        const unsigned nA = GATHER ? cA : (has_next ? (unsigned)nxt.pm * tstep : cA), nB = has_next ? (unsigned)nxt.pn * tstep : cB;
        for (int t = 0; t < nt; t += 2) {
            const bool last = (t == nt - 2);
            const unsigned a1 = cA + (unsigned)(t + 1) * kstep;
            const unsigned a2 = last ? nA : cA + (unsigned)(t + 2) * kstep, b2 = last ? nB : cB + (unsigned)(t + 2) * kstep;
            const unsigned a3 = a2 + kstep, b3 = b2 + kstep;
            if (last && has_next) S.a_ready(nxt);
            if constexpr (has_mid<Epi>::value) { if (t == nt / 2) { int l3_ = (int)__builtin_amdgcn_mbcnt_hi(~0u, __builtin_amdgcn_mbcnt_lo(~0u, 0u)); asm volatile("" : "+v"(l3_)); E.mid(acc, cur, wr, wc, l3_ & 15, l3_ >> 4); } }
            if constexpr (GATHER) { if (last && has_next) { PG8_GLOAD(xA0, xA1, ui + 1); } }
            if constexpr (SP2) {
            PG8_LDB(B0, 0, 0); PG8_LDB(B1, 0, 1); PG8_SCHED; PG8_LDA(At, 0, 0); if constexpr (GATHER) { PG8_STAGE(PG8_SA(1, 1), rsA, a1, vA1); } else { PG8_STAGE(PG8_SA(1, 1), rsA, a1 + hstep, voffA); }
            PG8_WAIT_V(8); PG8_WAIT_L(0); PG8_BAR; PG8_MMA(0, 0, At, B0); PG8_MMA(0, 1, At, B1); PG8_BAR; PG8_SCHED;
            PG8_LDA(At, 0, 1); PG8_STAGE(PG8_SB(0, 0), rsB, b2, voffB); PG8_STAGE(PG8_SB(0, 1), rsB, b2 + hstep, voffB); if constexpr (GATHER) { PG8_STAGE(PG8_SA(0, 0), rsA, a2, xA0); } else { PG8_STAGE(PG8_SA(0, 0), rsA, a2, voffA); }
            PG8_WAIT_V(8); PG8_WAIT_L(0); PG8_BAR; PG8_MMA(1, 0, At, B0); PG8_MMA(1, 1, At, B1); PG8_BAR; PG8_SCHED;
            PG8_LDB(B0, 1, 0); PG8_LDB(B1, 1, 1); PG8_SCHED; PG8_LDA(At, 1, 0); if constexpr (GATHER) { PG8_STAGE(PG8_SA(0, 1), rsA, a2, xA1); } else { PG8_STAGE(PG8_SA(0, 1), rsA, a2 + hstep, voffA); }
            PG8_WAIT_V(8); PG8_WAIT_L(0); PG8_BAR; PG8_MMA(0, 0, At, B0); PG8_MMA(0, 1, At, B1); PG8_BAR; PG8_SCHED;
            PG8_LDA(At, 1, 1); PG8_STAGE(PG8_SB(1, 0), rsB, b3, voffB); PG8_STAGE(PG8_SB(1, 1), rsB, b3 + hstep, voffB); if constexpr (GATHER) { PG8_STAGE(PG8_SA(1, 0), rsA, a3, xA0); } else { PG8_STAGE(PG8_SA(1, 0), rsA, a3, voffA); }
            PG8_WAIT_V(8); PG8_WAIT_L(0); PG8_BAR; PG8_MMA(1, 0, At, B0); PG8_MMA(1, 1, At, B1); PG8_BAR; PG8_SCHED;
            } else {
            PG8_LDB(B0, 0, 0); PG8_SCHED; PG8_LDA(At, 0, 0); PG8_STAGE(PG8_SA(1, 1), rsA, a1 + hstep, voffA);
            PG8_WAIT_L(8); PG8_BAR; PG8_WAIT_L(0); PG8_MMA(0, 0, At, B0); PG8_BAR; PG8_SCHED;
            PG8_LDB(B1, 0, 1); PG8_STAGE(PG8_SB(0, 0), rsB, b2, voffB);
            PG8_BAR; PG8_WAIT_L(0); PG8_MMA(0, 1, At, B1); PG8_BAR;
            PG8_LDA(At, 0, 1); PG8_STAGE(PG8_SA(0, 0), rsA, a2, voffA);
            PG8_BAR; PG8_WAIT_L(0); PG8_MMA(1, 0, At, B0); PG8_BAR; PG8_SCHED;
            PG8_STAGE(PG8_SB(0, 1), rsB, b2 + hstep, voffB);
            PG8_WAIT_V(6); PG8_BAR; PG8_MMA(1, 1, At, B1); PG8_BAR;
            PG8_LDB(B0, 1, 0); PG8_SCHED; PG8_LDA(At, 1, 0); PG8_STAGE(PG8_SA(0, 1), rsA, a2 + hstep, voffA);
            PG8_WAIT_L(8); PG8_BAR; PG8_WAIT_L(0); PG8_MMA(0, 0, At, B0); PG8_BAR; PG8_SCHED;
            PG8_LDB(B1, 1, 1); PG8_STAGE(PG8_SB(1, 0), rsB, b3, voffB);
            PG8_BAR; PG8_WAIT_L(0); PG8_MMA(0, 1, At, B1); PG8_BAR;
            PG8_LDA(At, 1, 1); PG8_STAGE(PG8_SA(1, 0), rsA, a3, voffA);
            PG8_BAR; PG8_WAIT_L(0); PG8_MMA(1, 0, At, B0); PG8_BAR; PG8_SCHED;
            PG8_STAGE(PG8_SB(1, 1), rsB, b3 + hstep, voffB);
            PG8_WAIT_V(6); PG8_BAR; PG8_MMA(1, 1, At, B1); PG8_BAR;
            }
        }
        if constexpr (ALIGN_EPI) { if (wr == 0) PG8_BAR; }
        if constexpr (!Epi::AFTER_DRAIN) { int l2_ = (int)__builtin_amdgcn_mbcnt_hi(~0u, __builtin_amdgcn_mbcnt_lo(~0u, 0u)); asm volatile("" : "+v"(l2_));
            E(acc, cur, wr, wc, l2_ & 15, l2_ >> 4); S.done(cur); }
        if (!has_next) break;
#pragma unroll
        for (int a = 0; a < 2; ++a)
#pragma unroll
            for (int b = 0; b < 2; ++b)
#pragma unroll
                for (int m = 0; m < 4; ++m)
#pragma unroll
                    for (int n = 0; n < 2; ++n) acc[a][b][m][n] = (f32x4){0.f, 0.f, 0.f, 0.f};
        cur = nxt; cA = nA; cB = nB; ++ui;
        if constexpr (GATHER) { vA0[0] = xA0[0]; vA0[1] = xA0[1]; vA1[0] = xA1[0]; vA1[1] = xA1[1]; }
        if constexpr (ALIGN_EPI) { if (wr == 1) PG8_BAR; }
    }
    PG8_WAIT_V(0);
    if constexpr (!ALIGN_EPI) { if (wr == 0) PG8_BAR; }
    PG8_BAR;
    if constexpr (Epi::AFTER_DRAIN) { E.fused(acc, cur, wr, wc, fr, fq, lds, wid, lane); S.done(cur); }
#undef PG8_GLOAD
#undef PG8_SA
#undef PG8_SB
#undef PG8_STAGE
#undef PG8_LDA
#undef PG8_LDB
#undef PG8_MMA
#undef PG8_WAIT_V
#undef PG8_WAIT_L
#undef PG8_BAR
#undef PG8_SCHED
}
}
#define XB_TMO      128
#define XB_XCNT(j)  (256  + 64 * (j))
#define XB_XSUB(j)  (1280 + 64 * (j))
#define XB_XGEN(j)  (2304 + 64 * (j))
#define XB_TOP      3328
#define XB_TOPGEN   3392
#define XCD_BAR_WORDS 3456
#define XB_SPIN_CAP (1u << 18)

__device__ __forceinline__ unsigned xb_ld(unsigned* p)              { return __hip_atomic_load(p, __ATOMIC_RELAXED, __HIP_MEMORY_SCOPE_AGENT); }
__device__ __forceinline__ unsigned xb_add(unsigned* p, unsigned v) { return __hip_atomic_fetch_add(p, v, __ATOMIC_RELAXED, __HIP_MEMORY_SCOPE_AGENT); }
__device__ __forceinline__ unsigned xb_xcc_id() { return (unsigned)__builtin_amdgcn_s_getreg((3 << 11) | 20) & 0xFu; }
#define XB_SPIN(cond, bar) do { unsigned _sp = 0; while (cond) { __builtin_amdgcn_s_sleep(1); \
    if ((++_sp & 255u) == 0u) { if (xb_ld(&(bar)[XB_TMO])) break; if (_sp > XB_SPIN_CAP) { atomicAdd(&(bar)[XB_TMO], 1u); break; } } } } while (0)

struct XcdBarrier {
    unsigned* bar; unsigned x;
    volatile LAS unsigned* st;
};

__device__ __forceinline__ XcdBarrier xcd_barrier_post(unsigned* bar, volatile LAS unsigned* st, const bool leader  ) {
    XcdBarrier b; b.bar = bar; b.x = xb_xcc_id(); b.st = st;
    if (leader) (void)xb_add(&bar[XB_XCNT(b.x)], 1u);
    return b;
}
__device__ __forceinline__ void xcd_barrier_complete(unsigned* bar, unsigned x, unsigned& nloc, unsigned& nx) {
    const unsigned G = gridDim.x * gridDim.y * gridDim.z;
    unsigned sum, cnt, mine, sp = 0u;
    for (;;) {
        sum = 0u; cnt = 0u; mine = 0u;
#pragma unroll
        for (unsigned j = 0; j < 16; ++j) { const unsigned c = xb_ld(&bar[XB_XCNT(j)]); sum += c; cnt += (c > 0u) ? 1u : 0u; mine = (j == x) ? c : mine; }
        if (sum == G) break;
        __builtin_amdgcn_s_sleep(1);
        if ((++sp & 255u) == 0u) { if (xb_ld(&bar[XB_TMO])) break; if (sp > XB_SPIN_CAP) { atomicAdd(&bar[XB_TMO], 1u); break; } }
    }
    nloc = mine > 0u ? mine : 1u; nx = cnt > 0u ? cnt : 1u;
}

__device__ __forceinline__ void xcd_barrier(const XcdBarrier& b, const bool leader  ) {
    asm volatile("s_waitcnt vmcnt(0)" ::: "memory");
    __syncthreads();
    if (leader) {
        unsigned* bar = b.bar;
        __builtin_amdgcn_s_waitcnt(0);
        unsigned nloc = b.st[0], nx = b.st[1];
        if (nloc == 0u) { xcd_barrier_complete(bar, b.x, nloc, nx); b.st[0] = nloc; b.st[1] = nx; }
        const unsigned old = xb_add(&bar[XB_XSUB(b.x)], 1u);
        const unsigned gen = old / nloc;
        if (old + 1u == (gen + 1u) * nloc) {
            __builtin_amdgcn_fence(__ATOMIC_RELEASE, "agent");
            asm volatile("s_waitcnt vmcnt(0)" ::: "memory");
            const unsigned og = xb_add(&bar[XB_TOP], 1u);
            const unsigned tg = og / nx;
            if (og + 1u == (tg + 1u) * nx) xb_add(&bar[XB_TOPGEN], 1u);
            else XB_SPIN(xb_ld(&bar[XB_TOPGEN]) == tg, bar);
            __builtin_amdgcn_fence(__ATOMIC_ACQUIRE, "agent");
            xb_add(&bar[XB_XGEN(b.x)], 1u);
            asm volatile("s_waitcnt vmcnt(0)" ::: "memory");
        } else {
            XB_SPIN(xb_ld(&bar[XB_XGEN(b.x)]) == gen, bar);
            __builtin_amdgcn_fence(__ATOMIC_ACQUIRE, "agent");
            asm volatile("s_waitcnt vmcnt(0)" ::: "memory");
        }
    }
    __syncthreads();
}

struct Ctx { LAS unsigned char* lds; int tid, lane, wave, vcu, G; };

__device__ __forceinline__ void transpose_load64(const float* W, int ldw, int k0, int n0, LAS float* scr, int lane) {
#pragma unroll 8
    for (int i = 0; i < 16; ++i) { const int kk = 4 * i + (lane >> 4), nn = 4 * (lane & 15); const f32x4 v = *(const f32x4*)(W + (size_t)(k0 + kk) * ldw + n0 + nn);
        LAS float* d = scr + kk * 65 + nn; d[0] = v.x; d[1] = v.y; d[2] = v.z; d[3] = v.w; }
    LDS_WAIT();
}
__device__ __forceinline__ void transpose_item(const float* W, int ldw, int K, bf16_t* dst, int k0, int n0, LAS float* scr, int lane) {
    transpose_load64(W, ldw, k0, n0, scr, lane);
    const int c = lane & 7;
#pragma unroll
    for (int j = 0; j < 8; ++j) { const int n = (lane >> 3) + 8 * j; const LAS float* s = scr + (8 * c) * 65 + n;
        u32x4 o; o.x = pk2(s[0 * 65], s[1 * 65]); o.y = pk2(s[2 * 65], s[3 * 65]); o.z = pk2(s[4 * 65], s[5 * 65]); o.w = pk2(s[6 * 65], s[7 * 65]);
        *(u32x4*)(dst + (size_t)n * K + k0 + 8 * c) = o; }
    LDS_WAIT();
}
__device__ __forceinline__ void transpose_item8(const float* W, int ldw, int K, unsigned char* dst, int k0, int n0, float scale, LAS float* scr, int lane) {
    transpose_load64(W, ldw, k0, n0, scr, lane);
    const int c = lane & 3;
#pragma unroll
    for (int j = 0; j < 4; ++j) { const int n = (lane >> 2) + 16 * j; const LAS float* s = scr + (16 * c) * 65 + n;
        u32x4 o; o.x = cvt4_fp8(s[0 * 65] * scale, s[1 * 65] * scale, s[2 * 65] * scale, s[3 * 65] * scale); o.y = cvt4_fp8(s[4 * 65] * scale, s[5 * 65] * scale, s[6 * 65] * scale, s[7 * 65] * scale);
        o.z = cvt4_fp8(s[8 * 65] * scale, s[9 * 65] * scale, s[10 * 65] * scale, s[11 * 65] * scale); o.w = cvt4_fp8(s[12 * 65] * scale, s[13 * 65] * scale, s[14 * 65] * scale, s[15 * 65] * scale);
        *(u32x4*)(dst + (size_t)n * K + k0 + 16 * c) = o; }
    LDS_WAIT();
}

template <int PART>
__device__ __forceinline__ void ph_prologue(const Ctx& X, const float* c, const float* w_ada, const float* b_ada, float* mod,
                                            const float* w_in, const float* w_conv_out, const float* w_hgrn_out, const float* w_out, const float* w1, const float* w2, unsigned char* ws) {
    if (PART == 0 && X.vcu < 48) {
        LAS float* ca = (LAS float*)X.lds;
        LAS float* red = (LAS float*)(X.lds + 16384);
        for (int i = X.tid; i < 4096; i += 512) { const float v = c[i]; ca[i] = v * sigmoidf_(v); }
        __syncthreads();
        const int jj = X.tid & 127, kq = X.tid >> 7, j = X.vcu * 128 + jj;
        float a0 = 0.f, a1 = 0.f, a2 = 0.f, a3 = 0.f;
#pragma unroll 8
        for (int i = kq * 256; i < kq * 256 + 256; ++i) { const float w = w_ada[(size_t)i * NMOD + j]; a0 += ca[i] * w; a1 += ca[1024 + i] * w; a2 += ca[2048 + i] * w; a3 += ca[3072 + i] * w; }
        red[(kq * 4 + 0) * 128 + jj] = a0; red[(kq * 4 + 1) * 128 + jj] = a1; red[(kq * 4 + 2) * 128 + jj] = a2; red[(kq * 4 + 3) * 128 + jj] = a3;
        __syncthreads();
        { const int b = X.tid >> 7; mod[(size_t)b * NMOD + j] = b_ada[j] + red[(0 * 4 + b) * 128 + jj] + red[(1 * 4 + b) * 128 + jj] + red[(2 * 4 + b) * 128 + jj] + red[(3 * 4 + b) * 128 + jj]; }
        __syncthreads();
    }
    LAS float* scr = (LAS float*)(X.lds + X.wave * 16640);
    const int gw = X.vcu * 8 + X.wave, NGW = X.G * 8;
    constexpr int I_IN = 16 * 128, I_SQ = 16 * 16, I_W1 = 32 * 16 * 32, I_W2 = 32 * 16 * 16, NITEMS = I_IN + 3 * I_SQ + I_W1 + I_W2;
    constexpr int I_DENSE = I_IN + 3 * I_SQ;
    for (int it = (PART == 0 ? 0 : I_DENSE) + gw; it < (PART == 0 ? I_DENSE : NITEMS); it += NGW) {
        int r = it;
        if (r < I_IN) { const int kb = r >> 7, nb = r & 127, n0 = 64 * nb;
            const int rho0 = (n0 < 2048) ? 256 * ((n0 & 1023) >> 7) + 128 * (n0 >> 10) + (n0 & 127) : n0;
            transpose_item(w_in, 8192, 1024, (bf16_t*)(ws + WS_WIN) + (size_t)rho0 * 1024, 64 * kb, n0, scr, X.lane); continue; } r -= I_IN;
        if (r < 3 * I_SQ) { const int which = r / I_SQ, q = r % I_SQ, kb = q >> 4, nb = q & 15;
            const float* W = which == 0 ? w_conv_out : (which == 1 ? w_hgrn_out : w_out);
            if (which == 2) transpose_item(W, 1024, 1024, (bf16_t*)(ws + WS_WO) + (size_t)(64 * nb) * 1024, 64 * kb, 64 * nb, scr, X.lane);
            else transpose_item(W, 1024, 2048, (bf16_t*)(ws + WS_WC) + (size_t)(64 * nb) * 2048 + which * 1024, 64 * kb, 64 * nb, scr, X.lane);
            continue; } r -= 3 * I_SQ;
        if (r < I_W1) { const int e = r >> 9, q = r & 511, kb = q >> 5, nb = q & 31, n0 = 64 * nb;
            const int rho0 = (n0 < 1024) ? 256 * (n0 >> 7) + (n0 & 127) : 256 * ((n0 - 1024) >> 7) + 128 + ((n0 - 1024) & 127);
            transpose_item8(w1 + (size_t)e * 1024 * 2048, 2048, 1024, (unsigned char*)(ws + WS_W1) + ((size_t)e * 2048 + rho0) * 1024, 64 * kb, n0, 256.0f, scr, X.lane); continue; } r -= I_W1;
        { const int e = r >> 8, q = r & 255, kb = q >> 4, nb = q & 15;
            transpose_item8(w2 + (size_t)e * 1024 * 1024, 1024, 1024, (unsigned char*)(ws + WS_W2) + ((size_t)e * 1024 + 64 * nb) * 1024, 64 * kb, 64 * nb, 256.0f, scr, X.lane); }
    }
    __syncthreads();
}

__device__ __forceinline__ void ph_norm_mod(const Ctx& X, const float* x, const float* g, const float* mod, int sh_off, int sc_off, bf16_t* out) {
    for (int t = X.vcu * 8 + X.wave; t < T; t += X.G * 8) {
        const int b = t / SEQ, lane = X.lane;
        const f32x4* xr = (const f32x4*)(x + (size_t)t * D) + lane;
        f32x4 v[4]; float ss = 0.f;
#pragma unroll
        for (int j = 0; j < 4; ++j) { v[j] = xr[64 * j]; ss += (v[j].x * v[j].x + v[j].y * v[j].y) + (v[j].z * v[j].z + v[j].w * v[j].w); }
        const float r = rsqrtf(wave_sum(ss) * (1.0f / D) + EPS);
        const float* sh = mod + (size_t)b * NMOD + sh_off; const float* sc = mod + (size_t)b * NMOD + sc_off;
#pragma unroll
        for (int j = 0; j < 4; ++j) {
            const int col = 4 * (lane + 64 * j);
            const f32x4 gg = *(const f32x4*)(g + col), s1 = *(const f32x4*)(sc + col), s0 = *(const f32x4*)(sh + col);
            const f32x4 y = v[j] * r * gg * (s1 + 1.0f) + s0;
            u32x2 w; w.x = pk2(y.x, y.y); w.y = pk2(y.z, y.w);
            *(u32x2*)(out + (size_t)t * D + col) = w;
        }
    }
}

__device__ __forceinline__ void ph_conv(const Ctx& X, const bf16_t* pU, const float* dw, const float* dwb, const float* lng, const float* lnb, bf16_t* uc) {
    LAS float* sm = (LAS float*)X.lds;
    const int tid = X.tid, lane = X.lane, wid = X.wave, c0 = 2 * tid;
    float w[31][2];
#pragma unroll
    for (int j = 0; j < 31; ++j) { w[j][0] = dw[j * 1024 + c0]; w[j][1] = dw[j * 1024 + c0 + 1]; }
    const float bias0 = dwb[c0], bias1 = dwb[c0 + 1];
    for (int task = X.vcu; task < T / 32; task += X.G) {
        const int b = task >> 8, s0 = (task & 255) * 32;
        const bf16_t* qu = pU + (size_t)(b * SEQ) * D + c0;
        float u[38][2];
#pragma unroll
        for (int st = 0; st < 4; ++st) {
#pragma unroll
            for (int i = (st == 0 ? 0 : 8 * st + 30); i < 8 * st + 38; ++i) {
                const int s = s0 - 30 + i;
                float u0 = 0.f, u1 = 0.f;
                if (s >= 0) { const unsigned u2 = *(const unsigned*)(qu + (size_t)s * D); u0 = bflo(u2); u1 = bfhi(u2); }
                u[i % 38][0] = u0; u[i % 38][1] = u1;
            }
#pragma unroll
            for (int t = 8 * st; t < 8 * st + 8; ++t) {
                float a0 = bias0, a1 = bias1;
#pragma unroll
                for (int j = 0; j < 31; ++j) { a0 += w[j][0] * u[(t + j) % 38][0]; a1 += w[j][1] * u[(t + j) % 38][1]; }
                sm[t * 1024 + c0] = a0; sm[t * 1024 + c0 + 1] = a1;
            }
        }
        __syncthreads();
#pragma unroll 1
        for (int i = 0; i < 4; ++i) {
            const int t = wid * 4 + i;
            f32x4 v[4]; float s = 0.f;
#pragma unroll
            for (int j = 0; j < 4; ++j) { v[j] = *(const LAS f32x4*)(sm + t * 1024 + 4 * (lane + 64 * j)); s += (v[j].x + v[j].y) + (v[j].z + v[j].w); }
            const float mean = wave_sum(s) * (1.0f / D); float q = 0.f;
#pragma unroll
            for (int j = 0; j < 4; ++j) { v[j] = v[j] - mean; q += (v[j].x * v[j].x + v[j].y * v[j].y) + (v[j].z * v[j].z + v[j].w * v[j].w); }
            const float rstd = rsqrtf(wave_sum(q) * (1.0f / D) + EPS);
#pragma unroll
            for (int j = 0; j < 4; ++j) {
                const int col = 4 * (lane + 64 * j);
                const f32x4 gg = *(const f32x4*)(lng + col), bb = *(const f32x4*)(lnb + col);
                f32x4 y = v[j] * rstd * gg + bb;
                y.x *= sigmoidf_(y.x); y.y *= sigmoidf_(y.y); y.z *= sigmoidf_(y.z); y.w *= sigmoidf_(y.w);
                u32x2 o; o.x = pk2(y.x, y.y); o.y = pk2(y.z, y.w);
                *(u32x2*)(uc + (size_t)(b * SEQ + s0 + t) * (2 * D) + col) = o;
            }
        }
        __syncthreads();
    }
}

typedef short bf16x8 __attribute__((ext_vector_type(8)));
typedef short s16x4 __attribute__((ext_vector_type(4)));
typedef float f32x2 __attribute__((ext_vector_type(2)));
constexpr int HG_QA = 0, HG_KA = 17408, HG_VR = 34816, HG_AB = 52224, HG_SPT = 61440, HG_O = 96256, HG_SEG = 130048;
constexpr size_t HM = (size_t)SEQ * 128;
__device__ __forceinline__ bf16x8 tr_frag(LAS unsigned char* base, int rs, int ks, int c16, int lane) {
    const int g = lane >> 4, q = (lane & 15) >> 2, p = lane & 3;
    LAS unsigned char* a = base + (32 * ks + 8 * g + q) * rs + (16 * c16 + 4 * p) * 2;
    const s16x4 lo = __builtin_amdgcn_ds_read_tr16_b64_v4i16((LAS s16x4*)a);
    const s16x4 hi = __builtin_amdgcn_ds_read_tr16_b64_v4i16((LAS s16x4*)(a + 4 * rs));
    return __builtin_shufflevector(lo, hi, 0, 1, 2, 3, 4, 5, 6, 7);
}
template <bool OUT>
__device__ __forceinline__ void ph_hgrn(const Ctx& X, int ntask, const bf16_t* pQ, const bf16_t* pF, const bf16_t* pI, const bf16_t* pG,
                                        const float* lb_param, const float* norm_g, const float* S0, float* dS, float* Dd, bf16_t* og) {
    LAS unsigned char* L = X.lds;
    LAS float* seg_s = (LAS float*)(L + HG_SEG);
    const int tid = X.tid, lane = X.lane, wave = X.wave, fr = lane & 15, fq = lane >> 4, wr = wave >> 1, wc = wave & 1;
    const int cp = tid & 63, seg = wave, tv = tid >> 3, vc = tid & 7;
    int idx = X.vcu; if (idx >= ntask) return;
    int ch = 0;
    unsigned zr[8], qr[8]; u32x4 vr0, vr1, gn0, gn1, gc0, gc1;
#define HG_LOAD(idx_, ch_) do { const int bh_ = (idx_) & 31, sc_ = (idx_) >> 5; const size_t tb_ = (size_t)bh_ * HM + (size_t)(sc_ * 256 + (ch_) * 64) * 128; \
        _Pragma("unroll") for (int i = 0; i < 8; ++i) { zr[i] = *(const unsigned*)(pF + tb_ + (size_t)(8 * seg + i) * 128 + 2 * cp); if (OUT) qr[i] = *(const unsigned*)(pQ + tb_ + (size_t)(8 * seg + i) * 128 + 2 * cp); } \
        { const u32x4* s_ = (const u32x4*)(pI + tb_ + (size_t)tv * 128 + vc * 16); vr0 = s_[0]; vr1 = s_[1]; } \
        if (OUT) { const u32x4* s_ = (const u32x4*)(pG + tb_ + (size_t)tv * 128 + vc * 16); gn0 = s_[0]; gn1 = s_[1]; } } while (0)
    HG_LOAD(idx, 0);
    float ngv[16];
    if (OUT) {
#pragma unroll
        for (int i = 0; i < 16; ++i) ngv[i] = norm_g[vc * 16 + i];
    }
    f32x4 S[8]; float oml0 = 0.f, oml1 = 0.f, gsum0 = 0.f, gsum1 = 0.f;
#pragma unroll 1
    for (;;) {
        const int sc = idx >> 5, bh = idx & 31, b = bh >> 3, h = bh & 7;
        if (ch == 0) {
            const int c0 = h * 128 + 2 * cp;
            oml0 = 1.0f - 1.0f / (1.0f + __expf(lb_param[1024 + c0] - lb_param[c0])); oml1 = 1.0f - 1.0f / (1.0f + __expf(lb_param[1025 + c0] - lb_param[c0 + 1]));
            gsum0 = 0.f; gsum1 = 0.f;
            if (OUT && sc > 0) { const float* s0 = S0 + (size_t)(bh * 32 + sc) * 16384;
#pragma unroll
                for (int vt = 0; vt < 8; ++vt)
#pragma unroll
                    for (int j = 0; j < 4; ++j) S[vt][j] = s0[(size_t)(16 * wave + fq * 4 + j) * 128 + vt * 16 + fr];
            } else {
#pragma unroll
                for (int vt = 0; vt < 8; ++vt) S[vt] = (f32x4){0.f, 0.f, 0.f, 0.f};
            }
        }
        float kk0[8], kk1[8], lf0[8], lf1[8], q0[8], q1[8];
        {
            float c0 = 0.f, c1 = 0.f;
#pragma unroll
            for (int i = 0; i < 8; ++i) {
                kk0[i] = oml0 * __builtin_amdgcn_rcpf(1.0f + __expf(bflo(zr[i]))); kk1[i] = oml1 * __builtin_amdgcn_rcpf(1.0f + __expf(bfhi(zr[i])));
                c0 += __logf(1.0f - kk0[i]); c1 += __logf(1.0f - kk1[i]); lf0[i] = c0; lf1[i] = c1;
                if (OUT) { q0[i] = bflo(qr[i]) * 0.08838834764831845f; q1[i] = bfhi(qr[i]) * 0.08838834764831845f; }
            }
            *(LAS f32x2*)(seg_s + seg * 128 + 2 * cp) = (f32x2){c0, c1};
        }
        if (OUT) { gc0 = gn0; gc1 = gn1; }
        const u32x4 vcur0 = vr0, vcur1 = vr1;
        __syncthreads();
        { LAS u32x4* d = (LAS u32x4*)(L + HG_VR + tv * 272 + vc * 32); d[0] = vcur0; d[1] = vcur1; }
        { int idx2 = idx, ch2 = ch + 1; if (ch2 == 4) { ch2 = 0; idx2 = idx + X.G; } if (idx2 < ntask) HG_LOAD(idx2, ch2); }
        {
            f32x2 ss[8];
#pragma unroll
            for (int s = 0; s < 8; ++s) ss[s] = *(const LAS f32x2*)(seg_s + s * 128 + 2 * cp);
            float off0 = 0.f, off1 = 0.f;
#pragma unroll
            for (int s = 0; s < 8; ++s) { off0 += (s < seg) ? ss[s].x : 0.f; off1 += (s < seg) ? ss[s].y : 0.f; }
            const float R0 = (ss[0].x + ss[1].x) + (ss[2].x + ss[3].x), R1 = (ss[0].y + ss[1].y) + (ss[2].y + ss[3].y);
            if (!OUT && seg == 0) { gsum0 += R0 + (ss[4].x + ss[5].x) + (ss[6].x + ss[7].x); gsum1 += R1 + (ss[4].y + ss[5].y) + (ss[6].y + ss[7].y); }
#pragma unroll
            for (int i = 0; i < 8; ++i) {
                const float G0 = off0 + lf0[i], G1 = off1 + lf1[i];
                const float ka0 = kk0[i] * __expf(fminf(R0 - G0, 80.0f)), ka1 = kk1[i] * __expf(fminf(R1 - G1, 80.0f));
                *(LAS unsigned*)(L + HG_KA + (8 * seg + i) * 272 + 4 * cp) = pk2(ka0, ka1);
                if (OUT) { const float qa0 = q0[i] * __expf(fminf(G0 - R0, 80.0f)), qa1 = q1[i] * __expf(fminf(G1 - R1, 80.0f));
                           *(LAS unsigned*)(L + HG_QA + (8 * seg + i) * 272 + 4 * cp) = pk2(qa0, qa1); }
            }
        }
        float eR[4], eL[4];
        {
            f32x4 r4 = (f32x4){0.f, 0.f, 0.f, 0.f}, l4 = (f32x4){0.f, 0.f, 0.f, 0.f};
#pragma unroll
            for (int s = 0; s < 4; ++s) { r4 += *(const LAS f32x4*)(seg_s + s * 128 + 16 * wave + 4 * fq); l4 += *(const LAS f32x4*)(seg_s + (s + 4) * 128 + 16 * wave + 4 * fq); }
#pragma unroll
            for (int j = 0; j < 4; ++j) { eR[j] = __expf(fmaxf(r4[j], -80.0f)); eL[j] = __expf(l4[j]); }
        }
#pragma unroll
        for (int vt = 0; vt < 8; ++vt) {
#pragma unroll
            for (int j = 0; j < 4; ++j) S[vt][j] *= eR[j];
            if (OUT) { u32x2 w; w.x = pk2(S[vt][0], S[vt][1]); w.y = pk2(S[vt][2], S[vt][3]);
                       *(LAS u32x2*)(L + HG_SPT + (vt * 16 + fr) * 272 + (16 * wave + 4 * fq) * 2) = w; }
        }
        __syncthreads();
        if (OUT) {
#pragma unroll
            for (int q2 = 0; q2 < 2; ++q2) {
                const int st = 2 * wc + q2;
                f32x4 acc = (f32x4){0.f, 0.f, 0.f, 0.f};
                if (st <= wr) {
#pragma unroll
                    for (int kq = 0; kq < 4; ++kq) {
                        const bf16x8 af = *(const LAS bf16x8*)(L + HG_KA + (st * 16 + fr) * 272 + kq * 64 + fq * 16);
                        const bf16x8 bq = *(const LAS bf16x8*)(L + HG_QA + (wr * 16 + fr) * 272 + kq * 64 + fq * 16);
                        acc = __builtin_amdgcn_mfma_f32_16x16x32_bf16(af, bq, acc, 0, 0, 0);
                    }
                    const int tt = wr * 16 + fr;
#pragma unroll
                    for (int j = 0; j < 4; ++j) { const int s_ = st * 16 + fq * 4 + j; acc[j] = (s_ <= tt) ? acc[j] : 0.f; }
                }
                u32x2 w; w.x = pk2(acc[0], acc[1]); w.y = pk2(acc[2], acc[3]);
                *(LAS u32x2*)(L + HG_AB + (wr * 16 + fr) * 144 + (st * 16 + fq * 4) * 2) = w;
            }
        }
        {
            bf16x8 aK[2];
#pragma unroll
            for (int ks = 0; ks < 2; ++ks) aK[ks] = tr_frag(L + HG_KA, 272, ks, wave, lane);
#pragma unroll
            for (int vt = 0; vt < 8; ++vt) {
#pragma unroll
                for (int ks = 0; ks < 2; ++ks) { const bf16x8 bv = tr_frag(L + HG_VR, 272, ks, vt, lane); S[vt] = __builtin_amdgcn_mfma_f32_16x16x32_bf16(aK[ks], bv, S[vt], 0, 0, 0); }
#pragma unroll
                for (int j = 0; j < 4; ++j) S[vt][j] *= eL[j];
            }
        }
        if (OUT) {
            __syncthreads();
            bf16x8 aA[2], aQ[4];
#pragma unroll
            for (int ks = 0; ks < 2; ++ks) aA[ks] = *(const LAS bf16x8*)(L + HG_AB + (wr * 16 + fr) * 144 + ks * 64 + fq * 16);
#pragma unroll
            for (int kq = 0; kq < 4; ++kq) aQ[kq] = *(const LAS bf16x8*)(L + HG_QA + (wr * 16 + fr) * 272 + kq * 64 + fq * 16);
#pragma unroll
            for (int n = 0; n < 4; ++n) {
                const int vt = wc * 4 + n;
                f32x4 o = (f32x4){0.f, 0.f, 0.f, 0.f};
#pragma unroll
                for (int ks = 0; ks < 2; ++ks) { const bf16x8 bv = tr_frag(L + HG_VR, 272, ks, vt, lane); o = __builtin_amdgcn_mfma_f32_16x16x32_bf16(aA[ks], bv, o, 0, 0, 0); }
#pragma unroll
                for (int kq = 0; kq < 4; ++kq) { const bf16x8 bs = *(const LAS bf16x8*)(L + HG_SPT + (vt * 16 + fr) * 272 + kq * 64 + fq * 16); o = __builtin_amdgcn_mfma_f32_16x16x32_bf16(aQ[kq], bs, o, 0, 0, 0); }
#pragma unroll
                for (int j = 0; j < 4; ++j) *(LAS float*)(L + HG_O + (wr * 16 + fq * 4 + j) * 528 + (vt * 16 + fr) * 4) = o[j];
            }
            __syncthreads();
            {
                f32x4 ov[4]; float ssq = 0.f;
#pragma unroll
                for (int i = 0; i < 4; ++i) { ov[i] = *(const LAS f32x4*)(L + HG_O + tv * 528 + vc * 64 + i * 16); ssq += (ov[i].x * ov[i].x + ov[i].y * ov[i].y) + (ov[i].z * ov[i].z + ov[i].w * ov[i].w); }
                ssq += __shfl_xor(ssq, 1); ssq += __shfl_xor(ssq, 2); ssq += __shfl_xor(ssq, 4);
                const float rstd = rsqrtf(ssq * (1.0f / 128.0f) + EPS);
                const unsigned gw[8] = {gc0.x, gc0.y, gc0.z, gc0.w, gc1.x, gc1.y, gc1.z, gc1.w};
                unsigned ow[8];
#pragma unroll
                for (int i = 0; i < 8; ++i) { const float g0 = bflo(gw[i]), g1 = bfhi(gw[i]);
                    const float y0 = ov[i >> 1][(2 * i) & 3] * rstd * ngv[2 * i] * g0 * __builtin_amdgcn_rcpf(1.0f + __expf(-g0));
                    const float y1 = ov[i >> 1][(2 * i + 1) & 3] * rstd * ngv[2 * i + 1] * g1 * __builtin_amdgcn_rcpf(1.0f + __expf(-g1));
                    ow[i] = pk2(y0, y1); }
                u32x4* d = (u32x4*)(og + (size_t)(b * SEQ + sc * 256 + ch * 64 + tv) * (2 * D) + h * 128 + vc * 16);
                d[0] = (u32x4){ow[0], ow[1], ow[2], ow[3]}; d[1] = (u32x4){ow[4], ow[5], ow[6], ow[7]};
            }
        }
        if (ch == 3) {
            if (!OUT) {
                float* ds = dS + (size_t)(bh * 32 + sc) * 16384;
#pragma unroll
                for (int vt = 0; vt < 8; ++vt)
#pragma unroll
                    for (int j = 0; j < 4; ++j) ds[(size_t)(16 * wave + fq * 4 + j) * 128 + vt * 16 + fr] = S[vt][j];
                if (seg == 0) *(f32x2*)(Dd + (size_t)(bh * 32 + sc) * 128 + 2 * cp) = (f32x2){__expf(gsum0), __expf(gsum1)};
            }
            idx += X.G; ch = 0; if (idx >= ntask) break;
        } else ++ch;
    }
#undef HG_LOAD
    __syncthreads();
}

__device__ __forceinline__ void ph_hg2(const Ctx& X, const float* dS, const float* Dd, float* S0) {
    for (int idx = X.vcu * 512 + X.tid; idx < 32 * 4096; idx += X.G * 512) {
        const int bh = idx >> 12, e4 = idx & 4095, k = e4 >> 5, v4 = (e4 & 31) * 4;
        f32x4 s = (f32x4){0.f, 0.f, 0.f, 0.f};
#pragma unroll 4
        for (int sc = 0; sc < 31; ++sc) { const float d = Dd[(size_t)(bh * 32 + sc) * 128 + k]; const f32x4 ds = *(const f32x4*)(dS + (size_t)(bh * 32 + sc) * 16384 + k * 128 + v4);
            s = s * d + ds; *(f32x4*)(S0 + (size_t)(bh * 32 + sc + 1) * 16384 + k * 128 + v4) = s; }
    }
}

__device__ __forceinline__ void ph_router_tables(const Ctx& X, const float* g_ffn, const float* mod, const float* w_router, const float* b_router, float* Bp, float* cb) {
    for (int i = X.vcu * 512 + X.tid; i < 4 * 1024 * 32; i += X.G * 512) { const int b = i >> 15, k = (i >> 5) & 1023;
        Bp[i] = g_ffn[k] * (1.0f + mod[(size_t)b * NMOD + 4 * D + k]) * w_router[i & 32767]; }
    const int gw = X.vcu * 8 + X.wave;
    if (gw < 128) { const int b = gw >> 5, e = gw & 31; float a = 0.f;
        for (int k = X.lane; k < 1024; k += 64) a += mod[(size_t)b * NMOD + 3 * D + k] * w_router[k * 32 + e];
        a = wave_sum(a); if (X.lane == 0) cb[gw] = a + b_router[e]; }
}

__device__ __forceinline__ void ph_route(const Ctx& X, const bf16_t* x1, const float* g_ffn, const float* mod, const float* Bp, const float* cb,
                                         unsigned char* h2, int* top_e, float* top_w, int* rank, int* hist_g) {
    LAS int* hist = (LAS int*)(X.lds + LDSCTL_OFF + 64);
    const int tid = X.tid, lane = X.lane, c = lane & 15, q = lane >> 4;
    for (int tile = X.vcu; tile < RT_NT; tile += X.G) {
        if (tid < 32) hist[tid] = 0;
        __syncthreads();
        const int tw = tile * RT_TILE + X.wave * 16, b = tw / SEQ;
        const bf16_t* xa = x1 + (size_t)(tw + c) * D + 4 * q;
        const float* bp = Bp + ((size_t)b * 1024 + 4 * q) * 32 + c;
        f32x4 acc0 = (f32x4){0.f, 0.f, 0.f, 0.f}, acc1 = acc0; float ss = 0.f;
#pragma unroll 4
        for (int m = 0; m < 64; ++m) {
            const u32x2 a2_ = *(const u32x2*)(xa + 16 * m); const f32x4 a4 = (f32x4){bflo(a2_.x), bfhi(a2_.x), bflo(a2_.y), bfhi(a2_.y)};
            float bv[8];
#pragma unroll
            for (int j = 0; j < 4; ++j) { bv[2 * j] = bp[(size_t)(16 * m + j) * 32]; bv[2 * j + 1] = bp[(size_t)(16 * m + j) * 32 + 16]; }
            ss += (a4.x * a4.x + a4.y * a4.y) + (a4.z * a4.z + a4.w * a4.w);
#pragma unroll
            for (int j = 0; j < 4; ++j) { acc0 = __builtin_amdgcn_mfma_f32_16x16x4f32(a4[j], bv[2 * j], acc0, 0, 0, 0); acc1 = __builtin_amdgcn_mfma_f32_16x16x4f32(a4[j], bv[2 * j + 1], acc1, 0, 0, 0); }
        }
        ss += __shfl_xor(ss, 16); ss += __shfl_xor(ss, 32);
        const float rs = rsqrtf(ss * (1.0f / D) + EPS);
        const float cb0 = cb[b * 32 + c], cb1 = cb[b * 32 + 16 + c];
#pragma unroll
        for (int reg = 0; reg < 4; ++reg) {
            const float rt = __shfl(rs, 4 * q + reg);
            float v0 = acc0[reg] * rt + cb0, v1 = acc1[reg] * rt + cb1;
            float sv[4]; int si[4];
#pragma unroll
            for (int rnd = 0; rnd < 4; ++rnd) {
                float bvv = v0; int bi = c; if (v1 > bvv) { bvv = v1; bi = 16 + c; }
#pragma unroll
                for (int o = 1; o < 16; o <<= 1) { const float ov = __shfl_xor(bvv, o); const int oi = __shfl_xor(bi, o); if (ov > bvv || (ov == bvv && oi < bi)) { bvv = ov; bi = oi; } }
                sv[rnd] = bvv; si[rnd] = bi; if (bi == c) v0 = -INFINITY; if (bi == 16 + c) v1 = -INFINITY;
            }
            const float e1 = __expf(sv[1] - sv[0]), e2 = __expf(sv[2] - sv[0]), e3 = __expf(sv[3] - sv[0]);
            const float inv = 1.0f / (1.0f + e1 + e2 + e3);
            if (c == 0) { const int t = tw + 4 * q + reg;
                const float ww[4] = {inv, e1 * inv, e2 * inv, e3 * inv};
#pragma unroll
                for (int rnd = 0; rnd < 4; ++rnd) { top_e[t * 4 + rnd] = si[rnd]; top_w[t * 4 + rnd] = ww[rnd]; rank[t * 4 + rnd] = atomicAdd((int*)&hist[si[rnd]], 1); }
            }
        }
        const float* sh = mod + (size_t)b * NMOD + 3 * D; const float* sc = mod + (size_t)b * NMOD + 4 * D;
#pragma unroll 4
        for (int i = 0; i < 16; ++i) {
            const float r = __shfl(rs, i);
            const u32x2* xr = (const u32x2*)(x1 + (size_t)(tw + i) * D) + lane;
#pragma unroll
            for (int j = 0; j < 4; ++j) {
                const int col = 4 * (lane + 64 * j);
                const f32x4 gg = *(const f32x4*)(g_ffn + col), s1 = *(const f32x4*)(sc + col), s0 = *(const f32x4*)(sh + col);
                const u32x2 xw = xr[64 * j]; const f32x4 xv = (f32x4){bflo(xw.x), bfhi(xw.x), bflo(xw.y), bfhi(xw.y)};
                const f32x4 y = (xv * r * gg * (s1 + 1.0f) + s0) * 16.0f;
                *(unsigned*)(h2 + (size_t)(tw + i) * D + col) = cvt4_fp8(y.x, y.y, y.z, y.w);
            }
        }
        __syncthreads();
        if (tid < 32) hist_g[tile * 32 + tid] = hist[tid];
        __syncthreads();
    }
}

__device__ __forceinline__ void ph_sort(const Ctx& X, const int* hist_g, const int* top_e, const float* top_w, const int* rank, int* row_tok, float* row_w, int* pair_row, int* blk_e) {
    LAS int* s_hist = (LAS int*)X.lds;
    LAS int* s_tot = s_hist + RT_NT * 32; LAS int* s_pre = s_tot + 32; LAS int* s_base = s_pre + 32; LAS int* s_pstart = s_base + 32; LAS int* s_pend = s_pstart + 32;
    const int tid = X.tid;
    for (int i = tid; i < RT_NT * 32; i += 512) s_hist[i] = hist_g[i];
    __syncthreads();
    for (int tile = X.vcu; tile < RT_NT; tile += X.G) {
        if (tid < 32) { int tot = 0, pre = 0; for (int i = 0; i < RT_NT; ++i) { const int c = s_hist[i * 32 + tid]; tot += c; if (i < tile) pre += c; } s_tot[tid] = tot; s_pre[tid] = pre; }
        __syncthreads();
        if (tid == 0) { int acc = 0; for (int e = 0; e < 32; ++e) { const int padded = (s_tot[e] + 255) / 256 * 256; s_pstart[e] = acc; s_base[e] = acc + s_pre[e]; acc += padded; s_pend[e] = acc; } }
        __syncthreads();
        { const int i = tid; const int idx = tile * RT_TILE * 4 + i; const int e = top_e[idx]; const int row = s_base[e] + rank[idx];
          row_tok[row] = idx >> 2; row_w[row] = top_w[idx]; pair_row[idx] = row; }
        if (tile < 32) { const int e = tile; for (int r = s_pstart[e] + s_tot[e] + tid; r < s_pend[e]; r += 512) { row_tok[r] = 0; row_w[r] = 0.f; } }
        if (tile == 32) { for (int blk = tid; blk < NBLK_MAX; blk += 512) { int e = -1; const int r = blk * 256; for (int q = 0; q < 32; ++q) if (r >= s_pstart[q] && r < s_pend[q]) e = q; blk_e[blk] = e; }
                          if (tid == 0) blk_e[NBLK_MAX] = s_pend[31] / 256; }
        __syncthreads();
    }
}

__device__ __forceinline__ void ph_final(const Ctx& X, const bf16_t* x1, const bf16_t* y, const int* pair_row, const float* mod, const float* g_final, float* out, const float oscale) {
    const int lane = X.lane;
    for (int t = X.vcu * 8 + X.wave; t < T; t += X.G * 8) {
        const int b = t / SEQ;
        const u32x2* xr = (const u32x2*)(x1 + (size_t)t * D) + lane;
        const float* ga = mod + (size_t)b * NMOD + 5 * D;
        int rows[4];
#pragma unroll
        for (int k = 0; k < 4; ++k) rows[k] = pair_row[t * 4 + k];
        f32x4 v[4]; float ss = 0.f;
#pragma unroll
        for (int j = 0; j < 4; ++j) {
            const int col = 4 * (lane + 64 * j);
            f32x4 m = (f32x4){0.f, 0.f, 0.f, 0.f};
#pragma unroll
            for (int k = 0; k < 4; ++k) { const u32x2 w = *(const u32x2*)(y + (size_t)rows[k] * D + col); m.x += bflo(w.x); m.y += bfhi(w.x); m.z += bflo(w.y); m.w += bfhi(w.y); }
            const u32x2 xw = xr[64 * j];
            v[j] = (f32x4){bflo(xw.x), bfhi(xw.x), bflo(xw.y), bfhi(xw.y)} + *(const f32x4*)(ga + col) * m;
            ss += (v[j].x * v[j].x + v[j].y * v[j].y) + (v[j].z * v[j].z + v[j].w * v[j].w);
        }
        const float r = rsqrtf(wave_sum(ss) * (1.0f / D) + EPS);
#pragma unroll
        for (int j = 0; j < 4; ++j) { const int col = 4 * (lane + 64 * j); *(f32x4*)(out + (size_t)t * D + col) = v[j] * (r * oscale) * *(const f32x4*)(g_final + col); }
    }
}

constexpr int N_PHASES = 13;
struct Args { const float* in[23]; float* out; unsigned char* ws; int ph_lo, ph_hi; };
__global__ void __launch_bounds__(512, 2) fwd(Args a) {
    extern __shared__ __attribute__((aligned(16))) unsigned char lds_raw[];
    Ctx X; X.lds = (LAS unsigned char*)lds_raw; X.tid = threadIdx.x; X.lane = X.tid & 63; X.wave = __builtin_amdgcn_readfirstlane(X.tid >> 6);
    X.G = gridDim.x; { const int bx = blockIdx.x; X.vcu = (X.G % 8 == 0) ? (bx % 8) * (X.G / 8) + bx / 8 : bx; }
    unsigned char* ws = a.ws;
    for (int u = X.tid; u < (LDS_BYTES - LDSCTL_OFF) / 4; u += 512) ((LAS unsigned*)(X.lds + LDSCTL_OFF))[u] = 0u;
    __syncthreads();
    XcdBarrier bar = xcd_barrier_post((unsigned*)(ws + WS_CTL) + CW_BAR, (volatile LAS unsigned*)(X.lds + LDSCTL_OFF), X.tid == 0);
    const int lo = a.ph_lo, hi = a.ph_hi; float probe_scale = 1.0f;
#define IN(k) (lo <= (k) && (k) < hi)
#define SEAM(k) do { if (IN(k) && IN((k) + 1)) xcd_barrier(bar, X.wave == 0 && (int)__builtin_amdgcn_mbcnt_hi(~0u, __builtin_amdgcn_mbcnt_lo(~0u, 0u)) == 0); } while (0)
#ifdef PROBE_PH
    unsigned long long* stamps = (unsigned long long*)(ws + WS_CTL + 32768);
    if (blockIdx.x == 0 && X.tid == 0) stamps[0] = __builtin_amdgcn_s_memrealtime();
#undef SEAM
#define SEAM(k) do { if (IN(k) && IN((k) + 1)) { xcd_barrier(bar, X.wave == 0 && (int)__builtin_amdgcn_mbcnt_hi(~0u, __builtin_amdgcn_mbcnt_lo(~0u, 0u)) == 0); \
        if (blockIdx.x == 0 && X.wave == 0 && (int)__builtin_amdgcn_mbcnt_hi(~0u, __builtin_amdgcn_mbcnt_lo(~0u, 0u)) == 0) stamps[(k) + 1] = __builtin_amdgcn_s_memrealtime(); } } while (0)
#endif
    const float* x = a.in[0]; const float* c = a.in[1]; const float* w_ada = a.in[2]; const float* b_ada = a.in[3];
    const float* g_mix = a.in[4]; const float* w_in = a.in[5]; const float* conv_dw = a.in[6]; const float* conv_dwb = a.in[7];
    const float* conv_ln_g = a.in[8]; const float* conv_ln_b = a.in[9]; const float* w_conv_out = a.in[10]; const float* lb_param = a.in[11];
    const float* hgrn_norm_g = a.in[12]; const float* w_hgrn_out = a.in[13]; const float* w_out = a.in[14]; const float* g_ffn = a.in[15];
    const float* w_router = a.in[16]; const float* b_router = a.in[17]; const float* w1 = a.in[18]; const float* b1 = a.in[19];
    const float* w2 = a.in[20]; const float* b2 = a.in[21]; const float* g_final = a.in[22];
    float* mod = (float*)(ws + WS_MOD); float* rt_bp = (float*)(ws + WS_BP); float* rt_cb = (float*)(ws + WS_CB);
    int* hist_g = (int*)(ws + WS_HIST); int* blk_e = (int*)(ws + WS_BLKE); int* top_e = (int*)(ws + WS_TOPE); float* top_w = (float*)(ws + WS_TOPW);
    int* rank = (int*)(ws + WS_RANK); int* pair_row = (int*)(ws + WS_PROW); int* row_tok = (int*)(ws + WS_RTOK); float* row_w = (float*)(ws + WS_RW);
    bf16_t* p = (bf16_t*)(ws + WS_P);
    bf16_t* h = (bf16_t*)(ws + WS_E); float* tmp = (float*)(ws + WS_E);
    float* hg_dS = (float*)(ws + WS_E); float* hg_S0 = (float*)(ws + WS_E + 64 * MiB); float* hg_D = (float*)(ws + WS_HGD);
    bf16_t* uc = (bf16_t*)(ws + WS_D); bf16_t* og = uc + D;   bf16_t* x1 = (bf16_t*)(ws + WS_D);
    bf16_t* merged = p;
    unsigned char* h2 = (unsigned char*)p;
    unsigned char* act = (unsigned char*)(p + PG);
    bf16_t* y = p + PG + (size_t)R_PAD * D / 2;
    PG8_LAS unsigned char* ring = (PG8_LAS unsigned char*)lds_raw;

#ifndef REPMASK
#define REPMASK 0
#endif
#ifndef REPN
#define REPN 1
#endif
#define PH(k, ...) do { if (IN(k)) { _Pragma("unroll 1") for (int rep_ = 0; rep_ < ((((REPMASK) >> (k)) & 1) ? 1 + REPN : 1); ++rep_) { if (rep_) __syncthreads(); { int ln_ = (int)__builtin_amdgcn_mbcnt_hi(~0u, __builtin_amdgcn_mbcnt_lo(~0u, 0u)); asm volatile("" : "+v"(ln_)); X.lane = ln_; X.tid = X.wave * 64 + ln_; } __VA_ARGS__ } } SEAM(k); } while (0)
    PH(0, ph_prologue<0>(X, c, w_ada, b_ada, mod, w_in, w_conv_out, w_hgrn_out, w_out, w1, w2, ws););
    PH(1, ph_norm_mod(X, x, g_mix, mod, 0, D, h); ph_router_tables(X, g_ffn, mod, w_router, b_router, rt_bp, rt_cb););
#ifndef STAGGER_TICKS
#define STAGGER_TICKS 0
#endif
    PH(2, { if (STAGGER_TICKS) { const unsigned long long t0_ = __builtin_amdgcn_s_memrealtime(), wait_ = (unsigned long long)(X.vcu & 3) * STAGGER_TICKS;
                while (__builtin_amdgcn_s_memrealtime() - t0_ < wait_) __builtin_amdgcn_s_sleep(8); }
        pg8::Gemm g{h, (const bf16_t*)(ws + WS_WIN), T, 8 * D, D}; pg8::StaticOrder S; S.init(T, 8 * D, X.G, (int)blockIdx.x);
        pg8::EpiSplitBf16 E{p, PG, 0x3cu, SEQ}; pg8::gemm_phase<pg8::EpiSplitBf16, pg8::StaticOrder, true, true>(ring, g, S, E, X.wave); });
    PH(3, ph_conv(X, p + 0 * PG, conv_dw, conv_dwb, conv_ln_g, conv_ln_b, uc);
          if ((REPMASK >> 14) & 1) { __syncthreads(); ph_conv(X, p + 0 * PG, conv_dw, conv_dwb, conv_ln_g, conv_ln_b, uc); }
          ph_hgrn<false>(X, 31 * 32, p + 2 * PG, p + 3 * PG, p + 4 * PG, p + 5 * PG, lb_param, nullptr, nullptr, hg_dS, hg_D, nullptr);
          if ((REPMASK >> 15) & 1) { __syncthreads(); ph_hgrn<false>(X, 31 * 32, p + 2 * PG, p + 3 * PG, p + 4 * PG, p + 5 * PG, lb_param, nullptr, nullptr, hg_dS, hg_D, nullptr); });
    PH(4, ph_hg2(X, hg_dS, hg_D, hg_S0););
    PH(5, if ((X.vcu & 1) == 0) ph_prologue<1>(X, c, w_ada, b_ada, mod, w_in, w_conv_out, w_hgrn_out, w_out, w1, w2, ws);
          ph_hgrn<true>(X, 32 * 32, p + 2 * PG, p + 3 * PG, p + 4 * PG, p + 5 * PG, lb_param, hgrn_norm_g, hg_S0, nullptr, nullptr, og);
          if ((X.vcu & 1) != 0) ph_prologue<1>(X, c, w_ada, b_ada, mod, w_in, w_conv_out, w_hgrn_out, w_out, w1, w2, ws););
    PH(6, { pg8::Gemm g{uc, (const bf16_t*)(ws + WS_WC), T, D, 2 * D}; pg8::StaticOrder S; S.init(T, D, X.G, (int)blockIdx.x);
        pg8::EpiGateFused E{p + 6 * PG, p + 7 * PG, merged}; pg8::gemm_phase<pg8::EpiGateFused, pg8::StaticOrder, true, true>(ring, g, S, E, X.wave); });
    PH(7, { pg8::Gemm g{merged, (const bf16_t*)(ws + WS_WO), T, D, D}; pg8::StaticOrder S; S.init(T, D, X.G, (int)blockIdx.x);
        pg8::EpiRes E{x, mod + 2 * D, x1, NMOD, SEQ}; pg8::gemm_phase<pg8::EpiRes, pg8::StaticOrder, true, true>(ring, g, S, E, X.wave); });
    PH(8, ph_route(X, x1, g_ffn, mod, rt_bp, rt_cb, h2, top_e, top_w, rank, hist_g););
    PH(9, ph_sort(X, hist_g, top_e, top_w, rank, row_tok, row_w, pair_row, blk_e););
    PH(10, { const int nblk = blk_e[NBLK_MAX]; pg8::Gemm g{(const bf16_t*)h2, (const bf16_t*)(ws + WS_W1), T, 32 * 2048, D / 2}; pg8::MoeOrder S{blk_e, nblk, X.G, (int)blockIdx.x, 3};
        LAS unsigned short* gt = (LAS unsigned short*)(X.lds + LDSCTL_OFF + 256);
        _Pragma("unroll 1") for (int i = 0; i < 23; ++i) { pg8::Unit u; if (!S.next(i, u)) break; if (X.tid < 256) gt[256 * i + X.tid] = (unsigned short)row_tok[u.pm * 256 + X.tid]; }
        __syncthreads();
        pg8::EpiSwiglu8 E{b1, act, 1.0f / 4096.0f}; pg8::gemm_phase<pg8::EpiSwiglu8, pg8::MoeOrder, true, true, true, true>(ring, g, S, E, X.wave, (const PG8_LAS unsigned short*)gt); });
    PH(11, { const int nblk = blk_e[NBLK_MAX]; pg8::Gemm g{(const bf16_t*)act, (const bf16_t*)(ws + WS_W2), R_PAD, 32 * 1024, DFF / 2}; pg8::MoeOrder S{blk_e, nblk, X.G, (int)blockIdx.x, 2};
        pg8::EpiY8 E{b2, row_w, y, 1.0f / 1024.0f}; pg8::gemm_phase<pg8::EpiY8, pg8::MoeOrder, true, true, false, true>(ring, g, S, E, X.wave); });
#ifdef PROBE_PH
    { const unsigned long long* st_ = (const unsigned long long*)(ws + WS_CTL + 32768); const float dt_ = (float)(long long)(st_[PROBE_PH + 1] - st_[PROBE_PH]);
      probe_scale = 1.0f + dt_ * (1.0f / 200000.0f); }
#endif
    PH(12, ph_final(X, x1, y, pair_row, mod, g_final, a.out, probe_scale););
#undef PH
#undef IN
#undef SEAM
}

#ifndef MK_N_LAUNCHES
#define MK_N_LAUNCHES 1
#endif
extern "C" void kernel_launch(void* const* d_in, const int* in_sizes, int n_in, void* d_out, int out_size, void* d_ws, size_t ws_size, hipStream_t stream) {
    static int grid = 0;
    if (grid == 0) {
        if (n_in != 23 || out_size != T * D || ws_size < WS_END) { fprintf(stderr, "kernel_launch: unexpected n_in %d / out_size %d / ws_size %zu (< %zu); nothing launched\n", n_in, out_size, ws_size, (size_t)WS_END); grid = -1; return; }
        int dev = 0, cus = 0, per_cu = 0;
        if (hipGetDevice(&dev) != hipSuccess || hipDeviceGetAttribute(&cus, hipDeviceAttributeMultiprocessorCount, dev) != hipSuccess) { grid = -1; return; }
        if (hipFuncSetAttribute((const void*)fwd, hipFuncAttributeMaxDynamicSharedMemorySize, LDS_BYTES) != hipSuccess) { fprintf(stderr, "kernel_launch: hipFuncSetAttribute failed\n"); grid = -1; return; }
        if (hipOccupancyMaxActiveBlocksPerMultiprocessor(&per_cu, (const void*)fwd, 512, LDS_BYTES) != hipSuccess || per_cu < 1) { fprintf(stderr, "kernel_launch: occupancy query says %d blocks per CU\n", per_cu); }
        (void)hipGetLastError();
        grid = cus;
    }
    if (grid < 0) return;
    if (hipMemsetAsync((char*)d_ws + WS_CTL, 0, CTL_ZERO_BYTES, stream) != hipSuccess) return;
    Args a{};
    for (int i = 0; i < 23; ++i) a.in[i] = (const float*)d_in[i];
    a.out = (float*)d_out; a.ws = (unsigned char*)d_ws;
    if (MK_N_LAUNCHES == 1) { a.ph_lo = 0; a.ph_hi = N_PHASES; hipLaunchKernelGGL(fwd, dim3(grid), dim3(512), LDS_BYTES, stream, a); }
    else for (int ph = 0; ph < N_PHASES; ++ph) { a.ph_lo = ph; a.ph_hi = ph + 1; hipLaunchKernelGGL(fwd, dim3(grid), dim3(512), LDS_BYTES, stream, a); }
}
```

```cpp
#include <hip/hip_runtime.h>
#include <stdint.h>
#include <stdio.h>

#define GAS __attribute__((address_space(1)))
#define LAS __attribute__((address_space(3)))
typedef unsigned short bf16_t;
typedef unsigned u32x4 __attribute__((ext_vector_type(4)));
typedef unsigned u32x2 __attribute__((ext_vector_type(2)));
typedef float f32x4 __attribute__((ext_vector_type(4)));

constexpr int D = 1024, NBATCH = 4, SEQ = 8192, T = NBATCH * SEQ;
constexpr int NE = 32, DFF = 1024;
constexpr int NMOD = 6 * D;
constexpr int NBLK_MAX = 544, R_PAD = NBLK_MAX * 256;
constexpr int RT_TILE = 128, RT_NT = T / RT_TILE;
constexpr float EPS = 1e-6f;

constexpr size_t MiB = 1u << 20;
constexpr size_t WS_CTL = 0, CTL_ZERO_BYTES = 64 * 1024;
constexpr size_t WS_MOD = 1 * MiB;
constexpr size_t WS_CB = WS_MOD + 112 * 1024, WS_BP = WS_MOD + 128 * 1024;
constexpr size_t WS_HIST = 2 * MiB;
constexpr size_t WS_BLKE = WS_HIST + 64 * 1024;
constexpr size_t WS_TOPE = 3 * MiB;
constexpr size_t WS_TOPW = WS_TOPE + 512 * 1024;
constexpr size_t WS_RANK = WS_TOPW + 512 * 1024;
constexpr size_t WS_PROW = WS_RANK + 512 * 1024;
constexpr size_t WS_RTOK = 5 * MiB;
constexpr size_t WS_RW = 6 * MiB;
constexpr size_t WS_HGD = 7 * MiB;
constexpr size_t WS_WT = 8 * MiB;
constexpr size_t WS_WIN = WS_WT, WS_WC = WS_WT + 16 * MiB, WS_WH = WS_WT + 18 * MiB, WS_WO = WS_WT + 20 * MiB, WS_W1 = WS_WT + 22 * MiB, WS_W2 = WS_WT + 150 * MiB;
constexpr size_t WS_P = 224 * MiB;
constexpr size_t WS_E = WS_P + 512 * MiB;
constexpr size_t WS_D = WS_E + 128 * MiB;
constexpr size_t WS_END = WS_D + 128 * MiB;
constexpr size_t PG = (size_t)T * D;
constexpr int CW_BAR = 0;

constexpr int RING_BYTES = 135168, LDSCTL_OFF = RING_BYTES, LDS_BYTES = 147456;

__device__ __forceinline__ unsigned f2bf(float f) { unsigned u = __builtin_bit_cast(unsigned, f); return (u + 0x7fffu + ((u >> 16) & 1u)) >> 16; }
__device__ __forceinline__ unsigned pk2(float lo, float hi) { return f2bf(lo) | (f2bf(hi) << 16); }
__device__ __forceinline__ float bf2f(unsigned b) { return __builtin_bit_cast(float, b << 16); }
__device__ __forceinline__ float bflo(unsigned w) { return __builtin_bit_cast(float, w << 16); }
__device__ __forceinline__ float bfhi(unsigned w) { return __builtin_bit_cast(float, w & 0xffff0000u); }
__device__ __forceinline__ float sigmoidf_(float x) { return __builtin_amdgcn_rcpf(1.0f + __expf(-x)); }
__device__ __forceinline__ float wave_sum(float v) {
#pragma unroll
    for (int o = 1; o < 64; o <<= 1) v += __shfl_xor(v, o);
    return v;
}
__device__ __forceinline__ unsigned cvt4_fp8(float a, float b, float c, float d) {
    a = fminf(fmaxf(a, -448.f), 448.f); b = fminf(fmaxf(b, -448.f), 448.f); c = fminf(fmaxf(c, -448.f), 448.f); d = fminf(fmaxf(d, -448.f), 448.f);
    int w = 0; w = __builtin_amdgcn_cvt_pk_fp8_f32(a, b, w, false); w = __builtin_amdgcn_cvt_pk_fp8_f32(c, d, w, true); return (unsigned)w; }
#define LDS_WAIT() asm volatile("s_waitcnt lgkmcnt(0)" ::: "memory")
#define VM_WAIT() asm volatile("s_waitcnt vmcnt(0)" ::: "memory")

namespace pg8 {
#define PG8_LAS __attribute__((address_space(3)))
typedef unsigned short bf16_t;
typedef short bf16x8 __attribute__((ext_vector_type(8)));
typedef float f32x4 __attribute__((ext_vector_type(4)));
typedef unsigned u32x4 __attribute__((ext_vector_type(4)));
constexpr int BM = 256, BK = 64, HALF = 128, HTB = HALF * BK * 2  , STAGE_BYTES = 8 * HTB, NXCD = 8, WGM = 8;

__host__ __device__ __forceinline__ int lds_byte(int r, int c) { const int st = (r >> 4) * 2 + (c >> 5), rr = r & 15, cc = c & 31, ob = rr * 64 + cc * 2; return st * 1024 + (ob ^ (((ob >> 9) & 1) << 5)); }
__host__ __device__ __forceinline__ void stage_rc(int b, int& R, int& C) { const int st = b / 1024, sb = b % 1024, swz = sb ^ (((sb >> 9) & 1) << 5); R = (st >> 1) * 16 + swz / 64; C = (st & 1) * 32 + (swz % 64) / 2; }
__host__ __device__ __forceinline__ int perm32(int rho) { const int n = rho >> 4, i = rho & 15; return 8 * (i >> 2) + 4 * n + (i & 3); }

struct Unit { int pm, pn; };
struct Gemm { const bf16_t* A; const bf16_t* Bt; int M, N, K; };

struct StaticOrder {
    int nM, nN, nwg, G, c;
    __host__ __device__ void init(int M, int N, int G_, int c_) { nM = M / BM; nN = N / BM; nwg = nM * nN; G = G_; c = c_; }
    __host__ __device__ bool next(int i, Unit& u) const {
        const long L = (long)i * G + c; if (L >= nwg) return false;
        int wgid = (int)L; { const int q = nwg / NXCD, r = nwg % NXCD, xcd = wgid % NXCD, off = wgid / NXCD; wgid = (xcd < r ? xcd * (q + 1) : r * (q + 1) + (xcd - r) * q) + off; }
        const int nig = WGM * nN, gid = wgid / nig, fm = gid * WGM, gsz = (nM - fm) < WGM ? (nM - fm) : WGM;
        u.pm = fm + ((wgid % nig) % gsz); u.pn = (wgid % nig) / gsz; return true;
    }
    __device__ __forceinline__ void a_ready(const Unit&) const {}
    __device__ __forceinline__ void done(const Unit&) const {}
};


struct MoeOrder {
    const int* blk_e; int nblk, G, c, lg;
    __device__ __forceinline__ bool next(int i, Unit& u) const {
        int blk, j;
        if (G == 256) { const int xcd = c & 7, idx = c >> 3, prb = 256 >> lg; blk = i * prb + xcd * (prb >> 3) + (idx >> lg); j = idx & ((1 << lg) - 1); }
        else { const long L = (long)i * G + c; blk = (int)(L >> lg); j = (int)(L & ((1 << lg) - 1)); }
        if (blk >= nblk) return false;
        const int e = blk_e[blk]; u.pm = blk; u.pn = (e << lg) + j; return true;
    }
    __device__ __forceinline__ void a_ready(const Unit&) const {}
    __device__ __forceinline__ void done(const Unit&) const {}
};

__device__ __forceinline__ unsigned cvt_pk_bf16(float lo, float hi) { unsigned r; asm volatile("v_cvt_pk_bf16_f32 %0, %1, %2" : "=v"(r) : "v"(lo), "v"(hi)); return r; }
__device__ __forceinline__ float sigm(float x) { return __builtin_amdgcn_rcpf(1.0f + __expf(-x)); }
__device__ __forceinline__ float blo(unsigned w) { return __builtin_bit_cast(float, w << 16); }
__device__ __forceinline__ float bhi(unsigned w) { return __builtin_bit_cast(float, w & 0xffff0000u); }

struct EpiSplitBf16 {
    static constexpr bool PERM = true, AFTER_DRAIN = false;
    bf16_t* O; size_t split_stride; unsigned hm_mask; int seq;
    __device__ __forceinline__ void operator()(const f32x4 (&acc)[2][2][4][2], const Unit& u, int wr, int wc, int fr, int fq) const {
        const int row0 = u.pm * BM + wr * 64 + fr; const int colt = u.pn * BM; const int t = colt >> 10;
        if (u.pn < 8) {
#pragma unroll
            for (int ai = 0; ai < 2; ++ai)
#pragma unroll
                for (int m = 0; m < 4; ++m) { const int row = row0 + ai * HALF + m * 16; float r[8];
#pragma unroll
                    for (int q = 0; q < 4; ++q) { r[q] = acc[ai][0][m][0][q] * sigm(acc[ai][1][m][0][q]); r[4 + q] = acc[ai][0][m][1][q] * sigm(acc[ai][1][m][1][q]); }
                    u32x4 w; w.x = cvt_pk_bf16(r[0], r[1]); w.y = cvt_pk_bf16(r[2], r[3]); w.z = cvt_pk_bf16(r[4], r[5]); w.w = cvt_pk_bf16(r[6], r[7]);
                    __builtin_nontemporal_store(w, (u32x4*)(O + (size_t)row * 1024 + 128 * u.pn + wc * 32 + 8 * fq)); }
            return;
        }
        bf16_t* base = O + (size_t)t * split_stride; const int cg = colt & 1023;
        const bool hm = (hm_mask >> t) & 1u;
        const int bb = (u.pm * BM) / seq;
#pragma unroll
        for (int ai = 0; ai < 2; ++ai)
#pragma unroll
            for (int m = 0; m < 4; ++m) { const int row = row0 + ai * HALF + m * 16;
#pragma unroll
                for (int bj = 0; bj < 2; ++bj) { const f32x4 v0 = acc[ai][bj][m][0], v1 = acc[ai][bj][m][1];
                    u32x4 w; w.x = cvt_pk_bf16(v0[0], v0[1]); w.y = cvt_pk_bf16(v0[2], v0[3]); w.z = cvt_pk_bf16(v1[0], v1[1]); w.w = cvt_pk_bf16(v1[2], v1[3]);
                    const size_t o = hm ? ((size_t)(bb * 8 + (cg >> 7) + bj) * seq + (row - bb * seq)) * 128 + wc * 32 + 8 * fq
                                        : (size_t)row * 1024 + cg + bj * HALF + wc * 32 + 8 * fq;
                    __builtin_nontemporal_store(w, (u32x4*)(base + o)); } }
    }
};
struct EpiGate1 {
    static constexpr bool PERM = true, AFTER_DRAIN = false;
    const bf16_t* gate; float* tmp;
    __device__ __forceinline__ void operator()(const f32x4 (&acc)[2][2][4][2], const Unit& u, int wr, int wc, int fr, int fq) const {
        const int row0 = u.pm * BM + wr * 64 + fr, col0 = u.pn * BM + wc * 32 + 8 * fq;
#pragma unroll
        for (int ai = 0; ai < 2; ++ai)
#pragma unroll
            for (int m = 0; m < 4; ++m) { const size_t o = (size_t)(row0 + ai * HALF + m * 16) * 1024 + col0;
#pragma unroll
                for (int bj = 0; bj < 2; ++bj) { const u32x4 g = *(const u32x4*)(gate + o + bj * HALF); f32x4 v0 = acc[ai][bj][m][0], v1 = acc[ai][bj][m][1];
                    v0[0] *= sigm(blo(g.x)); v0[1] *= sigm(bhi(g.x)); v0[2] *= sigm(blo(g.y)); v0[3] *= sigm(bhi(g.y));
                    v1[0] *= sigm(blo(g.z)); v1[1] *= sigm(bhi(g.z)); v1[2] *= sigm(blo(g.w)); v1[3] *= sigm(bhi(g.w));
                    *(f32x4*)(tmp + o + bj * HALF) = v0; *(f32x4*)(tmp + o + bj * HALF + 4) = v1; } }
    }
};
struct EpiGate2 {
    static constexpr bool PERM = true, AFTER_DRAIN = false;
    const bf16_t* gate; const float* tmp; bf16_t* out;
    __device__ __forceinline__ void operator()(const f32x4 (&acc)[2][2][4][2], const Unit& u, int wr, int wc, int fr, int fq) const {
        const int row0 = u.pm * BM + wr * 64 + fr, col0 = u.pn * BM + wc * 32 + 8 * fq;
#pragma unroll
        for (int ai = 0; ai < 2; ++ai)
#pragma unroll
            for (int m = 0; m < 4; ++m) { const size_t o = (size_t)(row0 + ai * HALF + m * 16) * 1024 + col0;
#pragma unroll
                for (int bj = 0; bj < 2; ++bj) { const u32x4 g = *(const u32x4*)(gate + o + bj * HALF); f32x4 v0 = acc[ai][bj][m][0], v1 = acc[ai][bj][m][1];
                    const f32x4 t0 = *(const f32x4*)(tmp + o + bj * HALF), t1 = *(const f32x4*)(tmp + o + bj * HALF + 4);
                    v0[0] = t0[0] + v0[0] * sigm(blo(g.x)); v0[1] = t0[1] + v0[1] * sigm(bhi(g.x)); v0[2] = t0[2] + v0[2] * sigm(blo(g.y)); v0[3] = t0[3] + v0[3] * sigm(bhi(g.y));
                    v1[0] = t1[0] + v1[0] * sigm(blo(g.z)); v1[1] = t1[1] + v1[1] * sigm(bhi(g.z)); v1[2] = t1[2] + v1[2] * sigm(blo(g.w)); v1[3] = t1[3] + v1[3] * sigm(bhi(g.w));
                    u32x4 w; w.x = cvt_pk_bf16(v0[0], v0[1]); w.y = cvt_pk_bf16(v0[2], v0[3]); w.z = cvt_pk_bf16(v1[0], v1[1]); w.w = cvt_pk_bf16(v1[2], v1[3]);
                    *(u32x4*)(out + o + bj * HALF) = w; } }
    }
};
struct EpiRes {
    static constexpr bool PERM = true, AFTER_DRAIN = false;
    const float* x; const float* ga; bf16_t* out; int mod_pitch, seq;
    __device__ __forceinline__ void operator()(const f32x4 (&acc)[2][2][4][2], const Unit& u, int wr, int wc, int fr, int fq) const {
        const int row0 = u.pm * BM + wr * 64 + fr, col0 = u.pn * BM + wc * 32 + 8 * fq;
        const float* gab = ga + (size_t)((u.pm * BM) / seq) * mod_pitch + col0;
        f32x4 gv[2][2];
#pragma unroll
        for (int bj = 0; bj < 2; ++bj)
#pragma unroll
            for (int n = 0; n < 2; ++n) gv[bj][n] = *(const f32x4*)(gab + bj * HALF + 4 * n);
#pragma unroll
        for (int ai = 0; ai < 2; ++ai)
#pragma unroll
            for (int m = 0; m < 4; ++m) { const size_t o = (size_t)(row0 + ai * HALF + m * 16) * 1024 + col0;
#pragma unroll
                for (int bj = 0; bj < 2; ++bj) { const f32x4 x0 = *(const f32x4*)(x + o + bj * HALF), x1_ = *(const f32x4*)(x + o + bj * HALF + 4);
                    const f32x4 v0 = x0 + gv[bj][0] * acc[ai][bj][m][0], v1 = x1_ + gv[bj][1] * acc[ai][bj][m][1];
                    u32x4 w; w.x = cvt_pk_bf16(v0[0], v0[1]); w.y = cvt_pk_bf16(v0[2], v0[3]); w.z = cvt_pk_bf16(v1[0], v1[1]); w.w = cvt_pk_bf16(v1[2], v1[3]);
                    *(u32x4*)(out + o + bj * HALF) = w; } }
    }
};
struct EpiSwiglu {
    static constexpr bool PERM = true, AFTER_DRAIN = false;
    const float* b1; bf16_t* act;
    __device__ __forceinline__ void operator()(const f32x4 (&acc)[2][2][4][2], const Unit& u, int wr, int wc, int fr, int fq) const {
        const int e = u.pn >> 3, j = u.pn & 7; const int row0 = u.pm * BM + wr * 64 + fr, f0 = 128 * j + wc * 32 + 8 * fq;
        const float* be = b1 + (size_t)e * 2048 + f0;
        const f32x4 bg0 = *(const f32x4*)(be), bg1 = *(const f32x4*)(be + 4), bl0 = *(const f32x4*)(be + 1024), bl1 = *(const f32x4*)(be + 1028);
#pragma unroll
        for (int ai = 0; ai < 2; ++ai)
#pragma unroll
            for (int m = 0; m < 4; ++m) {
                f32x4 g0 = acc[ai][0][m][0] + bg0, g1 = acc[ai][0][m][1] + bg1, l0 = acc[ai][1][m][0] + bl0, l1 = acc[ai][1][m][1] + bl1;
                float r[8];
#pragma unroll
                for (int q = 0; q < 4; ++q) { float gl = fminf(g0[q], 7.0f), li = fminf(fmaxf(l0[q], -7.0f), 7.0f); r[q] = gl * sigm(1.702f * gl) * (li + 1.0f);
                                              gl = fminf(g1[q], 7.0f); li = fminf(fmaxf(l1[q], -7.0f), 7.0f); r[4 + q] = gl * sigm(1.702f * gl) * (li + 1.0f); }
                u32x4 w; w.x = cvt_pk_bf16(r[0], r[1]); w.y = cvt_pk_bf16(r[2], r[3]); w.z = cvt_pk_bf16(r[4], r[5]); w.w = cvt_pk_bf16(r[6], r[7]);
                *(u32x4*)(act + (size_t)(row0 + ai * HALF + m * 16) * 1024 + f0) = w; }
    }
};
struct EpiY {
    static constexpr bool PERM = true, AFTER_DRAIN = false;
    const float* b2; const float* rw; bf16_t* y;
    __device__ __forceinline__ void operator()(const f32x4 (&acc)[2][2][4][2], const Unit& u, int wr, int wc, int fr, int fq) const {
        const int e = u.pn >> 2, j = u.pn & 3; const int row0 = u.pm * BM + wr * 64 + fr, col0 = 256 * j + wc * 32 + 8 * fq;
        const float* be = b2 + (size_t)e * 1024 + col0;
        f32x4 bv[2][2];
#pragma unroll
        for (int bj = 0; bj < 2; ++bj)
#pragma unroll
            for (int n = 0; n < 2; ++n) bv[bj][n] = *(const f32x4*)(be + bj * HALF + 4 * n);
#pragma unroll
        for (int ai = 0; ai < 2; ++ai)
#pragma unroll
            for (int m = 0; m < 4; ++m) { const int row = row0 + ai * HALF + m * 16; const float w_ = rw[row];
#pragma unroll
                for (int bj = 0; bj < 2; ++bj) { const f32x4 v0 = (acc[ai][bj][m][0] + bv[bj][0]) * w_, v1 = (acc[ai][bj][m][1] + bv[bj][1]) * w_;
                    u32x4 w; w.x = cvt_pk_bf16(v0[0], v0[1]); w.y = cvt_pk_bf16(v0[2], v0[3]); w.z = cvt_pk_bf16(v1[0], v1[1]); w.w = cvt_pk_bf16(v1[2], v1[3]);
                    *(u32x4*)(y + (size_t)row * 1024 + col0 + bj * HALF) = w; } }
    }
};


struct EpiSwiglu8 {
    static constexpr bool PERM = true, AFTER_DRAIN = false;
    const float* b1; unsigned char* act; float dq;
    __device__ __forceinline__ void operator()(const f32x4 (&acc)[2][2][4][2], const Unit& u, int wr, int wc, int fr, int fq) const {
        const int e = u.pn >> 3, j = u.pn & 7; const int row0 = u.pm * BM + wr * 64 + fr, f0 = 128 * j + wc * 32 + 8 * fq;
        const float* be = b1 + (size_t)e * 2048 + f0;
        const f32x4 bg0 = *(const f32x4*)(be), bg1 = *(const f32x4*)(be + 4), bl0 = *(const f32x4*)(be + 1024), bl1 = *(const f32x4*)(be + 1028);
#pragma unroll
        for (int ai = 0; ai < 2; ++ai)
#pragma unroll
            for (int m = 0; m < 4; ++m) {
                f32x4 g0 = acc[ai][0][m][0] * dq + bg0, g1 = acc[ai][0][m][1] * dq + bg1, l0 = acc[ai][1][m][0] * dq + bl0, l1 = acc[ai][1][m][1] * dq + bl1;
                float r[8];
#pragma unroll
                for (int q = 0; q < 4; ++q) { float gl = fminf(g0[q], 7.0f), li = fminf(fmaxf(l0[q], -7.0f), 7.0f); r[q] = 4.0f * gl * sigm(1.702f * gl) * (li + 1.0f);
                                              gl = fminf(g1[q], 7.0f); li = fminf(fmaxf(l1[q], -7.0f), 7.0f); r[4 + q] = 4.0f * gl * sigm(1.702f * gl) * (li + 1.0f); }
                u32x2 w; w.x = cvt4_fp8(r[0], r[1], r[2], r[3]); w.y = cvt4_fp8(r[4], r[5], r[6], r[7]);
                *(u32x2*)(act + (size_t)(row0 + ai * HALF + m * 16) * 1024 + f0) = w; }
    }
};
struct EpiY8 {
    static constexpr bool PERM = true, AFTER_DRAIN = false;
    const float* b2; const float* rw; bf16_t* y; float dq;
    __device__ __forceinline__ void operator()(const f32x4 (&acc)[2][2][4][2], const Unit& u, int wr, int wc, int fr, int fq) const {
        const int e = u.pn >> 2, j = u.pn & 3; const int row0 = u.pm * BM + wr * 64 + fr, col0 = 256 * j + wc * 32 + 8 * fq;
        const float* be = b2 + (size_t)e * 1024 + col0;
        f32x4 bv[2][2];
#pragma unroll
        for (int bj = 0; bj < 2; ++bj)
#pragma unroll
            for (int n = 0; n < 2; ++n) bv[bj][n] = *(const f32x4*)(be + bj * HALF + 4 * n);
#pragma unroll
        for (int ai = 0; ai < 2; ++ai)
#pragma unroll
            for (int m = 0; m < 4; ++m) { const int row = row0 + ai * HALF + m * 16; const float w_ = rw[row];
#pragma unroll
                for (int bj = 0; bj < 2; ++bj) { const f32x4 v0 = (acc[ai][bj][m][0] * dq + bv[bj][0]) * w_, v1 = (acc[ai][bj][m][1] * dq + bv[bj][1]) * w_;
                    u32x4 w; w.x = cvt_pk_bf16(v0[0], v0[1]); w.y = cvt_pk_bf16(v0[2], v0[3]); w.z = cvt_pk_bf16(v1[0], v1[1]); w.w = cvt_pk_bf16(v1[2], v1[3]);
                    *(u32x4*)(y + (size_t)row * 1024 + col0 + bj * HALF) = w; } }
    }
};


struct EpiGateFused {
    static constexpr bool PERM = true, AFTER_DRAIN = false, HAS_MID = true;
    const bf16_t* gc; const bf16_t* gh; bf16_t* out;
    __device__ __forceinline__ void mid(f32x4 (&acc)[2][2][4][2], const Unit& u, int wr, int wc, int fr, int fq) const {
        const int row0 = u.pm * BM + wr * 64 + fr, col0 = u.pn * BM + wc * 32 + 8 * fq;
#pragma unroll
        for (int ai = 0; ai < 2; ++ai)
#pragma unroll
            for (int m = 0; m < 4; ++m) { const size_t o = (size_t)(row0 + ai * HALF + m * 16) * 1024 + col0;
#pragma unroll
                for (int bj = 0; bj < 2; ++bj) { const u32x4 a = *(const u32x4*)(gc + o + bj * HALF), b = *(const u32x4*)(gh + o + bj * HALF);
                    const unsigned aw[4] = {a.x, a.y, a.z, a.w}, bw[4] = {b.x, b.y, b.z, b.w};
#pragma unroll
                    for (int q = 0; q < 4; ++q) { const float r0 = (1.0f + __expf(-blo(bw[q]))) * __builtin_amdgcn_rcpf(1.0f + __expf(-blo(aw[q]))), r1 = (1.0f + __expf(-bhi(bw[q]))) * __builtin_amdgcn_rcpf(1.0f + __expf(-bhi(aw[q])));
                        acc[ai][bj][m][q >> 1][(2 * q) & 3] *= r0; acc[ai][bj][m][q >> 1][(2 * q + 1) & 3] *= r1; } } }
    }
    __device__ __forceinline__ void operator()(const f32x4 (&acc)[2][2][4][2], const Unit& u, int wr, int wc, int fr, int fq) const {
        const int row0 = u.pm * BM + wr * 64 + fr, col0 = u.pn * BM + wc * 32 + 8 * fq;
#pragma unroll
        for (int ai = 0; ai < 2; ++ai)
#pragma unroll
            for (int m = 0; m < 4; ++m) { const size_t o = (size_t)(row0 + ai * HALF + m * 16) * 1024 + col0;
#pragma unroll
                for (int bj = 0; bj < 2; ++bj) { const u32x4 g = *(const u32x4*)(gh + o + bj * HALF); f32x4 v0 = acc[ai][bj][m][0], v1 = acc[ai][bj][m][1];
                    v0[0] *= sigm(blo(g.x)); v0[1] *= sigm(bhi(g.x)); v0[2] *= sigm(blo(g.y)); v0[3] *= sigm(bhi(g.y));
                    v1[0] *= sigm(blo(g.z)); v1[1] *= sigm(bhi(g.z)); v1[2] *= sigm(blo(g.w)); v1[3] *= sigm(bhi(g.w));
                    u32x4 w; w.x = cvt_pk_bf16(v0[0], v0[1]); w.y = cvt_pk_bf16(v0[2], v0[3]); w.z = cvt_pk_bf16(v1[0], v1[1]); w.w = cvt_pk_bf16(v1[2], v1[3]);
                    *(u32x4*)(out + o + bj * HALF) = w; } }
    }
};

template <class T, class = void> struct has_mid { static constexpr bool value = false; };
template <class T> struct has_mid<T, decltype((void)T::HAS_MID)> { static constexpr bool value = true; };
template <class Epi, class Sched, bool ALIGN_EPI = false, bool SP2 = false, bool GATHER = false, bool FP8 = false>
__device__ __forceinline__ void gemm_phase(PG8_LAS unsigned char* lds, const Gemm g, const Sched& S, const Epi& E, const int wave_id, const PG8_LAS unsigned short* gtab = nullptr) {
    typedef int i32x4 __attribute__((ext_vector_type(4))); typedef int i32x8 __attribute__((ext_vector_type(8)));
    static_assert(!GATHER || SP2, "GATHER needs the SP2 loop");
    int lane = (int)__builtin_amdgcn_mbcnt_hi(~0u, __builtin_amdgcn_mbcnt_lo(~0u, 0u)); asm volatile("" : "+v"(lane));
    const int wid = wave_id, tid = wid * 64 + lane, wr = wid >> 2, wc = wid & 3, fr = lane & 15, fq = lane >> 4;
    const int K = g.K, nt = K / BK;
    unsigned voffA[2], voffB[2];
#pragma unroll
    for (int i = 0; i < 2; ++i) { int R, C; stage_rc(tid * 16 + i * 8192, R, C); const int Rb = Epi::PERM ? ((R & ~31) + perm32(R & 31)) : R;
        voffA[i] = (unsigned)(R * K + C) * 2u; voffB[i] = (unsigned)(Rb * K + C) * 2u; }
    unsigned vA0[2] = {0u, 0u}, vA1[2] = {0u, 0u}, xA0[2] = {0u, 0u}, xA1[2] = {0u, 0u};
#define PG8_GLOAD(d0, d1, ui_) do { int tz_ = wid * 64 + (int)__builtin_amdgcn_mbcnt_hi(~0u, __builtin_amdgcn_mbcnt_lo(~0u, 0u)); asm volatile("" : "+v"(tz_)); _Pragma("unroll") for (int _i = 0; _i < 2; ++_i) { int R_, C_; stage_rc(tz_ * 16 + _i * 8192, R_, C_); \
        d0[_i] = (unsigned)gtab[256 * (ui_) + R_] * (unsigned)(K * 2) + (unsigned)C_ * 2u; d1[_i] = (unsigned)gtab[256 * (ui_) + 128 + R_] * (unsigned)(K * 2) + (unsigned)C_ * 2u; } } while (0)
    const unsigned kstep = (unsigned)(BK * 2);
    const unsigned hstep = (unsigned)HALF * K * 2;
    const unsigned tstep = 2 * hstep;
    const __amdgpu_buffer_rsrc_t rsA = __builtin_amdgcn_make_buffer_rsrc((void*)g.A, 0, 0x7fffffff, 0x00020000), rsB = __builtin_amdgcn_make_buffer_rsrc((void*)g.Bt, 0, 0x7fffffff, 0x00020000);
    const unsigned ldsw = (unsigned)wid * 1024u;
    const int aoff = lds_byte(wr * 64 + fr, fq * 8), boff = lds_byte(wc * 32 + fr, fq * 8);
#define PG8_SA(b, h) (((b) * 2 + (h)) * HTB)
#define PG8_SB(b, h) ((4 + (b) * 2 + (h)) * HTB)
#define PG8_STAGE(bufoff, rs, soff, voff) do { _Pragma("unroll") for (int _i = 0; _i < 2; ++_i) \
        __builtin_amdgcn_raw_ptr_buffer_load_lds(rs, (PG8_LAS void*)(lds + (bufoff) + ldsw + _i * 8192), 16, (int)(voff)[_i], (int)(soff), 0, 0); } while (0)
#define PG8_LDA(dst, b, h) do { if constexpr (FP8) { _Pragma("unroll") for (int m = 0; m < 4; ++m) dst##_8[m] = __builtin_shufflevector(*(const PG8_LAS i32x4*)(lds + PG8_SA(b, h) + aoff + m * 2048), *(const PG8_LAS i32x4*)(lds + PG8_SA(b, h) + aoff + m * 2048 + 1024), 0, 1, 2, 3, 4, 5, 6, 7); } \
        else { _Pragma("unroll") for (int m = 0; m < 4; ++m) _Pragma("unroll") for (int k = 0; k < 2; ++k) dst[m][k] = *(const PG8_LAS bf16x8*)(lds + PG8_SA(b, h) + aoff + m * 2048 + k * 1024); } } while (0)
#define PG8_LDB(dst, b, h) do { if constexpr (FP8) { _Pragma("unroll") for (int n = 0; n < 2; ++n) dst##_8[n] = __builtin_shufflevector(*(const PG8_LAS i32x4*)(lds + PG8_SB(b, h) + boff + n * 2048), *(const PG8_LAS i32x4*)(lds + PG8_SB(b, h) + boff + n * 2048 + 1024), 0, 1, 2, 3, 4, 5, 6, 7); } \
        else { _Pragma("unroll") for (int n = 0; n < 2; ++n) _Pragma("unroll") for (int k = 0; k < 2; ++k) dst[n][k] = *(const PG8_LAS bf16x8*)(lds + PG8_SB(b, h) + boff + n * 2048 + k * 1024); } } while (0)
#define PG8_MMA(ai, bj, At, Bt) do { __builtin_amdgcn_s_setprio(1); if constexpr (FP8) { _Pragma("unroll") for (int m = 0; m < 4; ++m) _Pragma("unroll") for (int n = 0; n < 2; ++n) \
        asm volatile("v_mfma_scale_f32_16x16x128_f8f6f4 %0, %1, %2, %0, %3, %3 op_sel_hi:[0,0,0]" : "+v"(acc[ai][bj][m][n]) : "v"(Bt##_8[n]), "v"(At##_8[m]), "v"(sc8));     \
        } else { _Pragma("unroll") for (int m = 0; m < 4; ++m) _Pragma("unroll") for (int n = 0; n < 2; ++n) _Pragma("unroll") for (int k = 0; k < 2; ++k) \
        acc[ai][bj][m][n] = __builtin_amdgcn_mfma_f32_16x16x32_bf16(Bt[n][k], At[m][k], acc[ai][bj][m][n], 0, 0, 0); } __builtin_amdgcn_s_setprio(0); } while (0)
#define PG8_WAIT_V(n) asm volatile("s_waitcnt vmcnt(" #n ")" ::: "memory")
#define PG8_WAIT_L(n) asm volatile("s_waitcnt lgkmcnt(" #n ")" ::: "memory")
#define PG8_BAR __builtin_amdgcn_s_barrier()
#define PG8_SCHED __builtin_amdgcn_sched_barrier(0)
    Unit cur, nxt; int ui = 0;
    if (!S.next(0, cur)) return;
    f32x4 acc[2][2][4][2];
#pragma unroll
    for (int a = 0; a < 2; ++a)
#pragma unroll
        for (int b = 0; b < 2; ++b)
#pragma unroll
            for (int m = 0; m < 4; ++m)
#pragma unroll
                for (int n = 0; n < 2; ++n) acc[a][b][m][n] = (f32x4){0.f, 0.f, 0.f, 0.f};
    int sc8 = 0x7f7f7f7f; asm volatile("" : "+v"(sc8));
    bf16x8 At[4][2], B0[2][2], B1[2][2]; i32x8 At_8[4], B0_8[2], B1_8[2];
    unsigned cA = GATHER ? 0u : (unsigned)cur.pm * tstep, cB = (unsigned)cur.pn * tstep;
    S.a_ready(cur);
    if constexpr (GATHER) { PG8_GLOAD(vA0, vA1, 0); xA0[0] = vA0[0]; xA0[1] = vA0[1]; xA1[0] = vA1[0]; xA1[1] = vA1[1]; }
    if constexpr (SP2) {
        PG8_STAGE(PG8_SB(0, 0), rsB, cB, voffB); PG8_STAGE(PG8_SB(0, 1), rsB, cB + hstep, voffB);
        if constexpr (GATHER) { PG8_STAGE(PG8_SA(0, 0), rsA, cA, vA0); PG8_STAGE(PG8_SA(0, 1), rsA, cA, vA1); } else { PG8_STAGE(PG8_SA(0, 0), rsA, cA, voffA); PG8_STAGE(PG8_SA(0, 1), rsA, cA + hstep, voffA); }
        if (wr == 1) PG8_BAR;
        PG8_WAIT_V(2); PG8_BAR;
        PG8_STAGE(PG8_SB(1, 0), rsB, cB + kstep, voffB); if constexpr (GATHER) { PG8_STAGE(PG8_SA(1, 0), rsA, cA + kstep, vA0); } else { PG8_STAGE(PG8_SA(1, 0), rsA, cA + kstep, voffA); } PG8_STAGE(PG8_SB(1, 1), rsB, cB + hstep + kstep, voffB);
        PG8_WAIT_V(6); PG8_BAR;
    } else {
        PG8_STAGE(PG8_SB(0, 0), rsB, cB, voffB); PG8_STAGE(PG8_SA(0, 0), rsA, cA, voffA); PG8_STAGE(PG8_SB(0, 1), rsB, cB + hstep, voffB); PG8_STAGE(PG8_SA(0, 1), rsA, cA + hstep, voffA);
        if (wr == 1) PG8_BAR;
        PG8_WAIT_V(4); PG8_BAR;
        PG8_STAGE(PG8_SB(1, 0), rsB, cB + kstep, voffB); PG8_STAGE(PG8_SA(1, 0), rsA, cA + kstep, voffA); PG8_STAGE(PG8_SB(1, 1), rsB, cB + hstep + kstep, voffB);
        PG8_WAIT_V(6); PG8_BAR;
    }
    for (;;) {
        const bool has_next = S.next(ui + 1, nxt);
        const unsigned nA = GATHER ? cA : (has_next ? (unsigned)nxt.pm * tstep : cA), nB = has_next ? (unsigned)nxt.pn * tstep : cB;
        for (int t = 0; t < nt; t += 2) {
            const bool last = (t == nt - 2);
            const unsigned a1 = cA + (unsigned)(t + 1) * kstep;
            const unsigned a2 = last ? nA : cA + (unsigned)(t + 2) * kstep, b2 = last ? nB : cB + (unsigned)(t + 2) * kstep;
            const unsigned a3 = a2 + kstep, b3 = b2 + kstep;
            if (last && has_next) S.a_ready(nxt);
            if constexpr (has_mid<Epi>::value) { if (t == nt / 2) { int l3_ = (int)__builtin_amdgcn_mbcnt_hi(~0u, __builtin_amdgcn_mbcnt_lo(~0u, 0u)); asm volatile("" : "+v"(l3_)); E.mid(acc, cur, wr, wc, l3_ & 15, l3_ >> 4); } }
            if constexpr (GATHER) { if (last && has_next) { PG8_GLOAD(xA0, xA1, ui + 1); } }
            if constexpr (SP2) {
            PG8_LDB(B0, 0, 0); PG8_LDB(B1, 0, 1); PG8_SCHED; PG8_LDA(At, 0, 0); if constexpr (GATHER) { PG8_STAGE(PG8_SA(1, 1), rsA, a1, vA1); } else { PG8_STAGE(PG8_SA(1, 1), rsA, a1 + hstep, voffA); }
            PG8_WAIT_V(8); PG8_WAIT_L(0); PG8_BAR; PG8_MMA(0, 0, At, B0); PG8_MMA(0, 1, At, B1); PG8_BAR; PG8_SCHED;
            PG8_LDA(At, 0, 1); PG8_STAGE(PG8_SB(0, 0), rsB, b2, voffB); PG8_STAGE(PG8_SB(0, 1), rsB, b2 + hstep, voffB); if constexpr (GATHER) { PG8_STAGE(PG8_SA(0, 0), rsA, a2, xA0); } else { PG8_STAGE(PG8_SA(0, 0), rsA, a2, voffA); }
            PG8_WAIT_V(8); PG8_WAIT_L(0); PG8_BAR; PG8_MMA(1, 0, At, B0); PG8_MMA(1, 1, At, B1); PG8_BAR; PG8_SCHED;
            PG8_LDB(B0, 1, 0); PG8_LDB(B1, 1, 1); PG8_SCHED; PG8_LDA(At, 1, 0); if constexpr (GATHER) { PG8_STAGE(PG8_SA(0, 1), rsA, a2, xA1); } else { PG8_STAGE(PG8_SA(0, 1), rsA, a2 + hstep, voffA); }
            PG8_WAIT_V(8); PG8_WAIT_L(0); PG8_BAR; PG8_MMA(0, 0, At, B0); PG8_MMA(0, 1, At, B1); PG8_BAR; PG8_SCHED;
            PG8_LDA(At, 1, 1); PG8_STAGE(PG8_SB(1, 0), rsB, b3, voffB); PG8_STAGE(PG8_SB(1, 1), rsB, b3 + hstep, voffB); if constexpr (GATHER) { PG8_STAGE(PG8_SA(1, 0), rsA, a3, xA0); } else { PG8_STAGE(PG8_SA(1, 0), rsA, a3, voffA); }
            PG8_WAIT_V(8); PG8_WAIT_L(0); PG8_BAR; PG8_MMA(1, 0, At, B0); PG8_MMA(1, 1, At, B1); PG8_BAR; PG8_SCHED;
            } else {
            PG8_LDB(B0, 0, 0); PG8_SCHED; PG8_LDA(At, 0, 0); PG8_STAGE(PG8_SA(1, 1), rsA, a1 + hstep, voffA);
            PG8_WAIT_L(8); PG8_BAR; PG8_WAIT_L(0); PG8_MMA(0, 0, At, B0); PG8_BAR; PG8_SCHED;
            PG8_LDB(B1, 0, 1); PG8_STAGE(PG8_SB(0, 0), rsB, b2, voffB);
            PG8_BAR; PG8_WAIT_L(0); PG8_MMA(0, 1, At, B1); PG8_BAR;
            PG8_LDA(At, 0, 1); PG8_STAGE(PG8_SA(0, 0), rsA, a2, voffA);
            PG8_BAR; PG8_WAIT_L(0); PG8_MMA(1, 0, At, B0); PG8_BAR; PG8_SCHED;
            PG8_STAGE(PG8_SB(0, 1), rsB, b2 + hstep, voffB);
            PG8_WAIT_V(6); PG8_BAR; PG8_MMA(1, 1, At, B1); PG8_BAR;
            PG8_LDB(B0, 1, 0); PG8_SCHED; PG8_LDA(At, 1, 0); PG8_STAGE(PG8_SA(0, 1), rsA, a2 + hstep, voffA);
            PG8_WAIT_L(8); PG8_BAR; PG8_WAIT_L(0); PG8_MMA(0, 0, At, B0); PG8_BAR; PG8_SCHED;
            PG8_LDB(B1, 1, 1); PG8_STAGE(PG8_SB(1, 0), rsB, b3, voffB);
            PG8_BAR; PG8_WAIT_L(0); PG8_MMA(0, 1, At, B1); PG8_BAR;
            PG8_LDA(At, 1, 1); PG8_STAGE(PG8_SA(1, 0), rsA, a3, voffA);
            PG8_BAR; PG8_WAIT_L(0); PG8_MMA(1, 0, At, B0); PG8_BAR; PG8_SCHED;
            PG8_STAGE(PG8_SB(1, 1), rsB, b3 + hstep, voffB);
            PG8_WAIT_V(6); PG8_BAR; PG8_MMA(1, 1, At, B1); PG8_BAR;
            }
        }
        if constexpr (ALIGN_EPI) { if (wr == 0) PG8_BAR; }
        if constexpr (!Epi::AFTER_DRAIN) { int l2_ = (int)__builtin_amdgcn_mbcnt_hi(~0u, __builtin_amdgcn_mbcnt_lo(~0u, 0u)); asm volatile("" : "+v"(l2_));
            E(acc, cur, wr, wc, l2_ & 15, l2_ >> 4); S.done(cur); }
        if (!has_next) break;
#pragma unroll
        for (int a = 0; a < 2; ++a)
#pragma unroll
            for (int b = 0; b < 2; ++b)
#pragma unroll
                for (int m = 0; m < 4; ++m)
#pragma unroll
                    for (int n = 0; n < 2; ++n) acc[a][b][m][n] = (f32x4){0.f, 0.f, 0.f, 0.f};
        cur = nxt; cA = nA; cB = nB; ++ui;
        if constexpr (GATHER) { vA0[0] = xA0[0]; vA0[1] = xA0[1]; vA1[0] = xA1[0]; vA1[1] = xA1[1]; }
        if constexpr (ALIGN_EPI) { if (wr == 1) PG8_BAR; }
    }
    PG8_WAIT_V(0);
    if constexpr (!ALIGN_EPI) { if (wr == 0) PG8_BAR; }
    PG8_BAR;
    if constexpr (Epi::AFTER_DRAIN) { E.fused(acc, cur, wr, wc, fr, fq, lds, wid, lane); S.done(cur); }
#undef PG8_GLOAD
#undef PG8_SA
#undef PG8_SB
#undef PG8_STAGE
#undef PG8_LDA
#undef PG8_LDB
#undef PG8_MMA
#undef PG8_WAIT_V
#undef PG8_WAIT_L
#undef PG8_BAR
#undef PG8_SCHED
}
}
#define XB_TMO      128
#define XB_XCNT(j)  (256  + 64 * (j))
#define XB_XSUB(j)  (1280 + 64 * (j))
#define XB_XGEN(j)  (2304 + 64 * (j))
#define XB_TOP      3328
#define XB_TOPGEN   3392
#define XCD_BAR_WORDS 3456
#define XB_SPIN_CAP (1u << 18)

__device__ __forceinline__ unsigned xb_ld(unsigned* p)              { return __hip_atomic_load(p, __ATOMIC_RELAXED, __HIP_MEMORY_SCOPE_AGENT); }
__device__ __forceinline__ unsigned xb_add(unsigned* p, unsigned v) { return __hip_atomic_fetch_add(p, v, __ATOMIC_RELAXED, __HIP_MEMORY_SCOPE_AGENT); }
__device__ __forceinline__ unsigned xb_xcc_id() { return (unsigned)__builtin_amdgcn_s_getreg((3 << 11) | 20) & 0xFu; }
#define XB_SPIN(cond, bar) do { unsigned _sp = 0; while (cond) { __builtin_amdgcn_s_sleep(1); \
    if ((++_sp & 255u) == 0u) { if (xb_ld(&(bar)[XB_TMO])) break; if (_sp > XB_SPIN_CAP) { atomicAdd(&(bar)[XB_TMO], 1u); break; } } } } while (0)

struct XcdBarrier {
    unsigned* bar; unsigned x;
    volatile LAS unsigned* st;
};

__device__ __forceinline__ XcdBarrier xcd_barrier_post(unsigned* bar, volatile LAS unsigned* st, const bool leader  ) {
    XcdBarrier b; b.bar = bar; b.x = xb_xcc_id(); b.st = st;
    if (leader) (void)xb_add(&bar[XB_XCNT(b.x)], 1u);
    return b;
}
__device__ __forceinline__ void xcd_barrier_complete(unsigned* bar, unsigned x, unsigned& nloc, unsigned& nx) {
    const unsigned G = gridDim.x * gridDim.y * gridDim.z;
    unsigned sum, cnt, mine, sp = 0u;
    for (;;) {
        sum = 0u; cnt = 0u; mine = 0u;
#pragma unroll
        for (unsigned j = 0; j < 16; ++j) { const unsigned c = xb_ld(&bar[XB_XCNT(j)]); sum += c; cnt += (c > 0u) ? 1u : 0u; mine = (j == x) ? c : mine; }
        if (sum == G) break;
        __builtin_amdgcn_s_sleep(1);
        if ((++sp & 255u) == 0u) { if (xb_ld(&bar[XB_TMO])) break; if (sp > XB_SPIN_CAP) { atomicAdd(&bar[XB_TMO], 1u); break; } }
    }
    nloc = mine > 0u ? mine : 1u; nx = cnt > 0u ? cnt : 1u;
}

__device__ __forceinline__ void xcd_barrier(const XcdBarrier& b, const bool leader  ) {
    asm volatile("s_waitcnt vmcnt(0)" ::: "memory");
    __syncthreads();
    if (leader) {
        unsigned* bar = b.bar;
        __builtin_amdgcn_s_waitcnt(0);
        unsigned nloc = b.st[0], nx = b.st[1];
        if (nloc == 0u) { xcd_barrier_complete(bar, b.x, nloc, nx); b.st[0] = nloc; b.st[1] = nx; }
        const unsigned old = xb_add(&bar[XB_XSUB(b.x)], 1u);
        const unsigned gen = old / nloc;
        if (old + 1u == (gen + 1u) * nloc) {
            __builtin_amdgcn_fence(__ATOMIC_RELEASE, "agent");
            asm volatile("s_waitcnt vmcnt(0)" ::: "memory");
            const unsigned og = xb_add(&bar[XB_TOP], 1u);
            const unsigned tg = og / nx;
            if (og + 1u == (tg + 1u) * nx) xb_add(&bar[XB_TOPGEN], 1u);
            else XB_SPIN(xb_ld(&bar[XB_TOPGEN]) == tg, bar);
            __builtin_amdgcn_fence(__ATOMIC_ACQUIRE, "agent");
            xb_add(&bar[XB_XGEN(b.x)], 1u);
            asm volatile("s_waitcnt vmcnt(0)" ::: "memory");
        } else {
            XB_SPIN(xb_ld(&bar[XB_XGEN(b.x)]) == gen, bar);
            __builtin_amdgcn_fence(__ATOMIC_ACQUIRE, "agent");
            asm volatile("s_waitcnt vmcnt(0)" ::: "memory");
        }
    }
    __syncthreads();
}

struct Ctx { LAS unsigned char* lds; int tid, lane, wave, vcu, G; };

__device__ __forceinline__ void transpose_load64(const float* W, int ldw, int k0, int n0, LAS float* scr, int lane) {
#pragma unroll 8
    for (int i = 0; i < 16; ++i) { const int kk = 4 * i + (lane >> 4), nn = 4 * (lane & 15); const f32x4 v = *(const f32x4*)(W + (size_t)(k0 + kk) * ldw + n0 + nn);
        LAS float* d = scr + kk * 65 + nn; d[0] = v.x; d[1] = v.y; d[2] = v.z; d[3] = v.w; }
    LDS_WAIT();
}
__device__ __forceinline__ void transpose_item(const float* W, int ldw, int K, bf16_t* dst, int k0, int n0, LAS float* scr, int lane) {
    transpose_load64(W, ldw, k0, n0, scr, lane);
    const int c = lane & 7;
#pragma unroll
    for (int j = 0; j < 8; ++j) { const int n = (lane >> 3) + 8 * j; const LAS float* s = scr + (8 * c) * 65 + n;
        u32x4 o; o.x = pk2(s[0 * 65], s[1 * 65]); o.y = pk2(s[2 * 65], s[3 * 65]); o.z = pk2(s[4 * 65], s[5 * 65]); o.w = pk2(s[6 * 65], s[7 * 65]);
        *(u32x4*)(dst + (size_t)n * K + k0 + 8 * c) = o; }
    LDS_WAIT();
}
__device__ __forceinline__ void transpose_item8(const float* W, int ldw, int K, unsigned char* dst, int k0, int n0, float scale, LAS float* scr, int lane) {
    transpose_load64(W, ldw, k0, n0, scr, lane);
    const int c = lane & 3;
#pragma unroll
    for (int j = 0; j < 4; ++j) { const int n = (lane >> 2) + 16 * j; const LAS float* s = scr + (16 * c) * 65 + n;
        u32x4 o; o.x = cvt4_fp8(s[0 * 65] * scale, s[1 * 65] * scale, s[2 * 65] * scale, s[3 * 65] * scale); o.y = cvt4_fp8(s[4 * 65] * scale, s[5 * 65] * scale, s[6 * 65] * scale, s[7 * 65] * scale);
        o.z = cvt4_fp8(s[8 * 65] * scale, s[9 * 65] * scale, s[10 * 65] * scale, s[11 * 65] * scale); o.w = cvt4_fp8(s[12 * 65] * scale, s[13 * 65] * scale, s[14 * 65] * scale, s[15 * 65] * scale);
        *(u32x4*)(dst + (size_t)n * K + k0 + 16 * c) = o; }
    LDS_WAIT();
}

template <int PART>
__device__ __forceinline__ void ph_prologue(const Ctx& X, const float* c, const float* w_ada, const float* b_ada, float* mod,
                                            const float* w_in, const float* w_conv_out, const float* w_hgrn_out, const float* w_out, const float* w1, const float* w2, unsigned char* ws) {
    if (PART == 0 && X.vcu < 48) {
        LAS float* ca = (LAS float*)X.lds;
        LAS float* red = (LAS float*)(X.lds + 16384);
        for (int i = X.tid; i < 4096; i += 512) { const float v = c[i]; ca[i] = v * sigmoidf_(v); }
        __syncthreads();
        const int jj = X.tid & 127, kq = X.tid >> 7, j = X.vcu * 128 + jj;
        float a0 = 0.f, a1 = 0.f, a2 = 0.f, a3 = 0.f;
#pragma unroll 8
        for (int i = kq * 256; i < kq * 256 + 256; ++i) { const float w = w_ada[(size_t)i * NMOD + j]; a0 += ca[i] * w; a1 += ca[1024 + i] * w; a2 += ca[2048 + i] * w; a3 += ca[3072 + i] * w; }
        red[(kq * 4 + 0) * 128 + jj] = a0; red[(kq * 4 + 1) * 128 + jj] = a1; red[(kq * 4 + 2) * 128 + jj] = a2; red[(kq * 4 + 3) * 128 + jj] = a3;
        __syncthreads();
        { const int b = X.tid >> 7; mod[(size_t)b * NMOD + j] = b_ada[j] + red[(0 * 4 + b) * 128 + jj] + red[(1 * 4 + b) * 128 + jj] + red[(2 * 4 + b) * 128 + jj] + red[(3 * 4 + b) * 128 + jj]; }
        __syncthreads();
    }
    LAS float* scr = (LAS float*)(X.lds + X.wave * 16640);
    const int gw = X.vcu * 8 + X.wave, NGW = X.G * 8;
    constexpr int I_IN = 16 * 128, I_SQ = 16 * 16, I_W1 = 32 * 16 * 32, I_W2 = 32 * 16 * 16, NITEMS = I_IN + 3 * I_SQ + I_W1 + I_W2;
    constexpr int I_DENSE = I_IN + 3 * I_SQ;
    for (int it = (PART == 0 ? 0 : I_DENSE) + gw; it < (PART == 0 ? I_DENSE : NITEMS); it += NGW) {
        int r = it;
        if (r < I_IN) { const int kb = r >> 7, nb = r & 127, n0 = 64 * nb;
            const int rho0 = (n0 < 2048) ? 256 * ((n0 & 1023) >> 7) + 128 * (n0 >> 10) + (n0 & 127) : n0;
            transpose_item(w_in, 8192, 1024, (bf16_t*)(ws + WS_WIN) + (size_t)rho0 * 1024, 64 * kb, n0, scr, X.lane); continue; } r -= I_IN;
        if (r < 3 * I_SQ) { const int which = r / I_SQ, q = r % I_SQ, kb = q >> 4, nb = q & 15;
            const float* W = which == 0 ? w_conv_out : (which == 1 ? w_hgrn_out : w_out);
            if (which == 2) transpose_item(W, 1024, 1024, (bf16_t*)(ws + WS_WO) + (size_t)(64 * nb) * 1024, 64 * kb, 64 * nb, scr, X.lane);
            else transpose_item(W, 1024, 2048, (bf16_t*)(ws + WS_WC) + (size_t)(64 * nb) * 2048 + which * 1024, 64 * kb, 64 * nb, scr, X.lane);
            continue; } r -= 3 * I_SQ;
        if (r < I_W1) { const int e = r >> 9, q = r & 511, kb = q >> 5, nb = q & 31, n0 = 64 * nb;
            const int rho0 = (n0 < 1024) ? 256 * (n0 >> 7) + (n0 & 127) : 256 * ((n0 - 1024) >> 7) + 128 + ((n0 - 1024) & 127);
            transpose_item8(w1 + (size_t)e * 1024 * 2048, 2048, 1024, (unsigned char*)(ws + WS_W1) + ((size_t)e * 2048 + rho0) * 1024, 64 * kb, n0, 256.0f, scr, X.lane); continue; } r -= I_W1;
        { const int e = r >> 8, q = r & 255, kb = q >> 4, nb = q & 15;
            transpose_item8(w2 + (size_t)e * 1024 * 1024, 1024, 1024, (unsigned char*)(ws + WS_W2) + ((size_t)e * 1024 + 64 * nb) * 1024, 64 * kb, 64 * nb, 256.0f, scr, X.lane); }
    }
    __syncthreads();
}

__device__ __forceinline__ void ph_norm_mod(const Ctx& X, const float* x, const float* g, const float* mod, int sh_off, int sc_off, bf16_t* out) {
    for (int t = X.vcu * 8 + X.wave; t < T; t += X.G * 8) {
        const int b = t / SEQ, lane = X.lane;
        const f32x4* xr = (const f32x4*)(x + (size_t)t * D) + lane;
        f32x4 v[4]; float ss = 0.f;
#pragma unroll
        for (int j = 0; j < 4; ++j) { v[j] = xr[64 * j]; ss += (v[j].x * v[j].x + v[j].y * v[j].y) + (v[j].z * v[j].z + v[j].w * v[j].w); }
        const float r = rsqrtf(wave_sum(ss) * (1.0f / D) + EPS);
        const float* sh = mod + (size_t)b * NMOD + sh_off; const float* sc = mod + (size_t)b * NMOD + sc_off;
#pragma unroll
        for (int j = 0; j < 4; ++j) {
            const int col = 4 * (lane + 64 * j);
            const f32x4 gg = *(const f32x4*)(g + col), s1 = *(const f32x4*)(sc + col), s0 = *(const f32x4*)(sh + col);
            const f32x4 y = v[j] * r * gg * (s1 + 1.0f) + s0;
            u32x2 w; w.x = pk2(y.x, y.y); w.y = pk2(y.z, y.w);
            *(u32x2*)(out + (size_t)t * D + col) = w;
        }
    }
}

__device__ __forceinline__ void ph_conv(const Ctx& X, const bf16_t* pU, const float* dw, const float* dwb, const float* lng, const float* lnb, bf16_t* uc) {
    LAS float* sm = (LAS float*)X.lds;
    const int tid = X.tid, lane = X.lane, wid = X.wave, c0 = 2 * tid;
    float w[31][2];
#pragma unroll
    for (int j = 0; j < 31; ++j) { w[j][0] = dw[j * 1024 + c0]; w[j][1] = dw[j * 1024 + c0 + 1]; }
    const float bias0 = dwb[c0], bias1 = dwb[c0 + 1];
    for (int task = X.vcu; task < T / 32; task += X.G) {
        const int b = task >> 8, s0 = (task & 255) * 32;
        const bf16_t* qu = pU + (size_t)(b * SEQ) * D + c0;
        float u[38][2];
#pragma unroll
        for (int st = 0; st < 4; ++st) {
#pragma unroll
            for (int i = (st == 0 ? 0 : 8 * st + 30); i < 8 * st + 38; ++i) {
                const int s = s0 - 30 + i;
                float u0 = 0.f, u1 = 0.f;
                if (s >= 0) { const unsigned u2 = *(const unsigned*)(qu + (size_t)s * D); u0 = bflo(u2); u1 = bfhi(u2); }
                u[i % 38][0] = u0; u[i % 38][1] = u1;
            }
#pragma unroll
            for (int t = 8 * st; t < 8 * st + 8; ++t) {
                float a0 = bias0, a1 = bias1;
#pragma unroll
                for (int j = 0; j < 31; ++j) { a0 += w[j][0] * u[(t + j) % 38][0]; a1 += w[j][1] * u[(t + j) % 38][1]; }
                sm[t * 1024 + c0] = a0; sm[t * 1024 + c0 + 1] = a1;
            }
        }
        __syncthreads();
#pragma unroll 1
        for (int i = 0; i < 4; ++i) {
            const int t = wid * 4 + i;
            f32x4 v[4]; float s = 0.f;
#pragma unroll
            for (int j = 0; j < 4; ++j) { v[j] = *(const LAS f32x4*)(sm + t * 1024 + 4 * (lane + 64 * j)); s += (v[j].x + v[j].y) + (v[j].z + v[j].w); }
            const float mean = wave_sum(s) * (1.0f / D); float q = 0.f;
#pragma unroll
            for (int j = 0; j < 4; ++j) { v[j] = v[j] - mean; q += (v[j].x * v[j].x + v[j].y * v[j].y) + (v[j].z * v[j].z + v[j].w * v[j].w); }
            const float rstd = rsqrtf(wave_sum(q) * (1.0f / D) + EPS);
#pragma unroll
            for (int j = 0; j < 4; ++j) {
                const int col = 4 * (lane + 64 * j);
                const f32x4 gg = *(const f32x4*)(lng + col), bb = *(const f32x4*)(lnb + col);
                f32x4 y = v[j] * rstd * gg + bb;
                y.x *= sigmoidf_(y.x); y.y *= sigmoidf_(y.y); y.z *= sigmoidf_(y.z); y.w *= sigmoidf_(y.w);
                u32x2 o; o.x = pk2(y.x, y.y); o.y = pk2(y.z, y.w);
                *(u32x2*)(uc + (size_t)(b * SEQ + s0 + t) * (2 * D) + col) = o;
            }
        }
        __syncthreads();
    }
}

typedef short bf16x8 __attribute__((ext_vector_type(8)));
typedef short s16x4 __attribute__((ext_vector_type(4)));
typedef float f32x2 __attribute__((ext_vector_type(2)));
constexpr int HG_QA = 0, HG_KA = 17408, HG_VR = 34816, HG_AB = 52224, HG_SPT = 61440, HG_O = 96256, HG_SEG = 130048;
constexpr size_t HM = (size_t)SEQ * 128;
__device__ __forceinline__ bf16x8 tr_frag(LAS unsigned char* base, int rs, int ks, int c16, int lane) {
    const int g = lane >> 4, q = (lane & 15) >> 2, p = lane & 3;
    LAS unsigned char* a = base + (32 * ks + 8 * g + q) * rs + (16 * c16 + 4 * p) * 2;
    const s16x4 lo = __builtin_amdgcn_ds_read_tr16_b64_v4i16((LAS s16x4*)a);
    const s16x4 hi = __builtin_amdgcn_ds_read_tr16_b64_v4i16((LAS s16x4*)(a + 4 * rs));
    return __builtin_shufflevector(lo, hi, 0, 1, 2, 3, 4, 5, 6, 7);
}
template <bool OUT>
__device__ __forceinline__ void ph_hgrn(const Ctx& X, int ntask, const bf16_t* pQ, const bf16_t* pF, const bf16_t* pI, const bf16_t* pG,
                                        const float* lb_param, const float* norm_g, const float* S0, float* dS, float* Dd, bf16_t* og) {
    LAS unsigned char* L = X.lds;
    LAS float* seg_s = (LAS float*)(L + HG_SEG);
    const int tid = X.tid, lane = X.lane, wave = X.wave, fr = lane & 15, fq = lane >> 4, wr = wave >> 1, wc = wave & 1;
    const int cp = tid & 63, seg = wave, tv = tid >> 3, vc = tid & 7;
    int idx = X.vcu; if (idx >= ntask) return;
    int ch = 0;
    unsigned zr[8], qr[8]; u32x4 vr0, vr1, gn0, gn1, gc0, gc1;
#define HG_LOAD(idx_, ch_) do { const int bh_ = (idx_) & 31, sc_ = (idx_) >> 5; const size_t tb_ = (size_t)bh_ * HM + (size_t)(sc_ * 256 + (ch_) * 64) * 128; \
        _Pragma("unroll") for (int i = 0; i < 8; ++i) { zr[i] = *(const unsigned*)(pF + tb_ + (size_t)(8 * seg + i) * 128 + 2 * cp); if (OUT) qr[i] = *(const unsigned*)(pQ + tb_ + (size_t)(8 * seg + i) * 128 + 2 * cp); } \
        { const u32x4* s_ = (const u32x4*)(pI + tb_ + (size_t)tv * 128 + vc * 16); vr0 = s_[0]; vr1 = s_[1]; } \
        if (OUT) { const u32x4* s_ = (const u32x4*)(pG + tb_ + (size_t)tv * 128 + vc * 16); gn0 = s_[0]; gn1 = s_[1]; } } while (0)
    HG_LOAD(idx, 0);
    float ngv[16];
    if (OUT) {
#pragma unroll
        for (int i = 0; i < 16; ++i) ngv[i] = norm_g[vc * 16 + i];
    }
    f32x4 S[8]; float oml0 = 0.f, oml1 = 0.f, gsum0 = 0.f, gsum1 = 0.f;
#pragma unroll 1
    for (;;) {
        const int sc = idx >> 5, bh = idx & 31, b = bh >> 3, h = bh & 7;
        if (ch == 0) {
            const int c0 = h * 128 + 2 * cp;
            oml0 = 1.0f - 1.0f / (1.0f + __expf(lb_param[1024 + c0] - lb_param[c0])); oml1 = 1.0f - 1.0f / (1.0f + __expf(lb_param[1025 + c0] - lb_param[c0 + 1]));
            gsum0 = 0.f; gsum1 = 0.f;
            if (OUT && sc > 0) { const float* s0 = S0 + (size_t)(bh * 32 + sc) * 16384;
#pragma unroll
                for (int vt = 0; vt < 8; ++vt)
#pragma unroll
                    for (int j = 0; j < 4; ++j) S[vt][j] = s0[(size_t)(16 * wave + fq * 4 + j) * 128 + vt * 16 + fr];
            } else {
#pragma unroll
                for (int vt = 0; vt < 8; ++vt) S[vt] = (f32x4){0.f, 0.f, 0.f, 0.f};
            }
        }
        float kk0[8], kk1[8], lf0[8], lf1[8], q0[8], q1[8];
        {
            float c0 = 0.f, c1 = 0.f;
#pragma unroll
            for (int i = 0; i < 8; ++i) {
                kk0[i] = oml0 * __builtin_amdgcn_rcpf(1.0f + __expf(bflo(zr[i]))); kk1[i] = oml1 * __builtin_amdgcn_rcpf(1.0f + __expf(bfhi(zr[i])));
                c0 += __logf(1.0f - kk0[i]); c1 += __logf(1.0f - kk1[i]); lf0[i] = c0; lf1[i] = c1;
                if (OUT) { q0[i] = bflo(qr[i]) * 0.08838834764831845f; q1[i] = bfhi(qr[i]) * 0.08838834764831845f; }
            }
            *(LAS f32x2*)(seg_s + seg * 128 + 2 * cp) = (f32x2){c0, c1};
        }
        if (OUT) { gc0 = gn0; gc1 = gn1; }
        const u32x4 vcur0 = vr0, vcur1 = vr1;
        __syncthreads();
        { LAS u32x4* d = (LAS u32x4*)(L + HG_VR + tv * 272 + vc * 32); d[0] = vcur0; d[1] = vcur1; }
        { int idx2 = idx, ch2 = ch + 1; if (ch2 == 4) { ch2 = 0; idx2 = idx + X.G; } if (idx2 < ntask) HG_LOAD(idx2, ch2); }
        {
            f32x2 ss[8];
#pragma unroll
            for (int s = 0; s < 8; ++s) ss[s] = *(const LAS f32x2*)(seg_s + s * 128 + 2 * cp);
            float off0 = 0.f, off1 = 0.f;
#pragma unroll
            for (int s = 0; s < 8; ++s) { off0 += (s < seg) ? ss[s].x : 0.f; off1 += (s < seg) ? ss[s].y : 0.f; }
            const float R0 = (ss[0].x + ss[1].x) + (ss[2].x + ss[3].x), R1 = (ss[0].y + ss[1].y) + (ss[2].y + ss[3].y);
            if (!OUT && seg == 0) { gsum0 += R0 + (ss[4].x + ss[5].x) + (ss[6].x + ss[7].x); gsum1 += R1 + (ss[4].y + ss[5].y) + (ss[6].y + ss[7].y); }
#pragma unroll
            for (int i = 0; i < 8; ++i) {
                const float G0 = off0 + lf0[i], G1 = off1 + lf1[i];
                const float ka0 = kk0[i] * __expf(fminf(R0 - G0, 80.0f)), ka1 = kk1[i] * __expf(fminf(R1 - G1, 80.0f));
                *(LAS unsigned*)(L + HG_KA + (8 * seg + i) * 272 + 4 * cp) = pk2(ka0, ka1);
                if (OUT) { const float qa0 = q0[i] * __expf(fminf(G0 - R0, 80.0f)), qa1 = q1[i] * __expf(fminf(G1 - R1, 80.0f));
                           *(LAS unsigned*)(L + HG_QA + (8 * seg + i) * 272 + 4 * cp) = pk2(qa0, qa1); }
            }
        }
        float eR[4], eL[4];
        {
            f32x4 r4 = (f32x4){0.f, 0.f, 0.f, 0.f}, l4 = (f32x4){0.f, 0.f, 0.f, 0.f};
#pragma unroll
            for (int s = 0; s < 4; ++s) { r4 += *(const LAS f32x4*)(seg_s + s * 128 + 16 * wave + 4 * fq); l4 += *(const LAS f32x4*)(seg_s + (s + 4) * 128 + 16 * wave + 4 * fq); }
#pragma unroll
            for (int j = 0; j < 4; ++j) { eR[j] = __expf(fmaxf(r4[j], -80.0f)); eL[j] = __expf(l4[j]); }
        }
#pragma unroll
        for (int vt = 0; vt < 8; ++vt) {
#pragma unroll
            for (int j = 0; j < 4; ++j) S[vt][j] *= eR[j];
            if (OUT) { u32x2 w; w.x = pk2(S[vt][0], S[vt][1]); w.y = pk2(S[vt][2], S[vt][3]);
                       *(LAS u32x2*)(L + HG_SPT + (vt * 16 + fr) * 272 + (16 * wave + 4 * fq) * 2) = w; }
        }
        __syncthreads();
        if (OUT) {
#pragma unroll
            for (int q2 = 0; q2 < 2; ++q2) {
                const int st = 2 * wc + q2;
                f32x4 acc = (f32x4){0.f, 0.f, 0.f, 0.f};
                if (st <= wr) {
#pragma unroll
                    for (int kq = 0; kq < 4; ++kq) {
                        const bf16x8 af = *(const LAS bf16x8*)(L + HG_KA + (st * 16 + fr) * 272 + kq * 64 + fq * 16);
                        const bf16x8 bq = *(const LAS bf16x8*)(L + HG_QA + (wr * 16 + fr) * 272 + kq * 64 + fq * 16);
                        acc = __builtin_amdgcn_mfma_f32_16x16x32_bf16(af, bq, acc, 0, 0, 0);
                    }
                    const int tt = wr * 16 + fr;
#pragma unroll
                    for (int j = 0; j < 4; ++j) { const int s_ = st * 16 + fq * 4 + j; acc[j] = (s_ <= tt) ? acc[j] : 0.f; }
                }
                u32x2 w; w.x = pk2(acc[0], acc[1]); w.y = pk2(acc[2], acc[3]);
                *(LAS u32x2*)(L + HG_AB + (wr * 16 + fr) * 144 + (st * 16 + fq * 4) * 2) = w;
            }
        }
        {
            bf16x8 aK[2];
#pragma unroll
            for (int ks = 0; ks < 2; ++ks) aK[ks] = tr_frag(L + HG_KA, 272, ks, wave, lane);
#pragma unroll
            for (int vt = 0; vt < 8; ++vt) {
#pragma unroll
                for (int ks = 0; ks < 2; ++ks) { const bf16x8 bv = tr_frag(L + HG_VR, 272, ks, vt, lane); S[vt] = __builtin_amdgcn_mfma_f32_16x16x32_bf16(aK[ks], bv, S[vt], 0, 0, 0); }
#pragma unroll
                for (int j = 0; j < 4; ++j) S[vt][j] *= eL[j];
            }
        }
        if (OUT) {
            __syncthreads();
            bf16x8 aA[2], aQ[4];
#pragma unroll
            for (int ks = 0; ks < 2; ++ks) aA[ks] = *(const LAS bf16x8*)(L + HG_AB + (wr * 16 + fr) * 144 + ks * 64 + fq * 16);
#pragma unroll
            for (int kq = 0; kq < 4; ++kq) aQ[kq] = *(const LAS bf16x8*)(L + HG_QA + (wr * 16 + fr) * 272 + kq * 64 + fq * 16);
#pragma unroll
            for (int n = 0; n < 4; ++n) {
                const int vt = wc * 4 + n;
                f32x4 o = (f32x4){0.f, 0.f, 0.f, 0.f};
#pragma unroll
                for (int ks = 0; ks < 2; ++ks) { const bf16x8 bv = tr_frag(L + HG_VR, 272, ks, vt, lane); o = __builtin_amdgcn_mfma_f32_16x16x32_bf16(aA[ks], bv, o, 0, 0, 0); }
#pragma unroll
                for (int kq = 0; kq < 4; ++kq) { const bf16x8 bs = *(const LAS bf16x8*)(L + HG_SPT + (vt * 16 + fr) * 272 + kq * 64 + fq * 16); o = __builtin_amdgcn_mfma_f32_16x16x32_bf16(aQ[kq], bs, o, 0, 0, 0); }
#pragma unroll
                for (int j = 0; j < 4; ++j) *(LAS float*)(L + HG_O + (wr * 16 + fq * 4 + j) * 528 + (vt * 16 + fr) * 4) = o[j];
            }
            __syncthreads();
            {
                f32x4 ov[4]; float ssq = 0.f;
#pragma unroll
                for (int i = 0; i < 4; ++i) { ov[i] = *(const LAS f32x4*)(L + HG_O + tv * 528 + vc * 64 + i * 16); ssq += (ov[i].x * ov[i].x + ov[i].y * ov[i].y) + (ov[i].z * ov[i].z + ov[i].w * ov[i].w); }
                ssq += __shfl_xor(ssq, 1); ssq += __shfl_xor(ssq, 2); ssq += __shfl_xor(ssq, 4);
                const float rstd = rsqrtf(ssq * (1.0f / 128.0f) + EPS);
                const unsigned gw[8] = {gc0.x, gc0.y, gc0.z, gc0.w, gc1.x, gc1.y, gc1.z, gc1.w};
                unsigned ow[8];
#pragma unroll
                for (int i = 0; i < 8; ++i) { const float g0 = bflo(gw[i]), g1 = bfhi(gw[i]);
                    const float y0 = ov[i >> 1][(2 * i) & 3] * rstd * ngv[2 * i] * g0 * __builtin_amdgcn_rcpf(1.0f + __expf(-g0));
                    const float y1 = ov[i >> 1][(2 * i + 1) & 3] * rstd * ngv[2 * i + 1] * g1 * __builtin_amdgcn_rcpf(1.0f + __expf(-g1));
                    ow[i] = pk2(y0, y1); }
                u32x4* d = (u32x4*)(og + (size_t)(b * SEQ + sc * 256 + ch * 64 + tv) * (2 * D) + h * 128 + vc * 16);
                d[0] = (u32x4){ow[0], ow[1], ow[2], ow[3]}; d[1] = (u32x4){ow[4], ow[5], ow[6], ow[7]};
            }
        }
        if (ch == 3) {
            if (!OUT) {
                float* ds = dS + (size_t)(bh * 32 + sc) * 16384;
#pragma unroll
                for (int vt = 0; vt < 8; ++vt)
#pragma unroll
                    for (int j = 0; j < 4; ++j) ds[(size_t)(16 * wave + fq * 4 + j) * 128 + vt * 16 + fr] = S[vt][j];
                if (seg == 0) *(f32x2*)(Dd + (size_t)(bh * 32 + sc) * 128 + 2 * cp) = (f32x2){__expf(gsum0), __expf(gsum1)};
            }
            idx += X.G; ch = 0; if (idx >= ntask) break;
        } else ++ch;
    }
#undef HG_LOAD
    __syncthreads();
}

__device__ __forceinline__ void ph_hg2(const Ctx& X, const float* dS, const float* Dd, float* S0) {
    for (int idx = X.vcu * 512 + X.tid; idx < 32 * 4096; idx += X.G * 512) {
        const int bh = idx >> 12, e4 = idx & 4095, k = e4 >> 5, v4 = (e4 & 31) * 4;
        f32x4 s = (f32x4){0.f, 0.f, 0.f, 0.f};
#pragma unroll 4
        for (int sc = 0; sc < 31; ++sc) { const float d = Dd[(size_t)(bh * 32 + sc) * 128 + k]; const f32x4 ds = *(const f32x4*)(dS + (size_t)(bh * 32 + sc) * 16384 + k * 128 + v4);
            s = s * d + ds; *(f32x4*)(S0 + (size_t)(bh * 32 + sc + 1) * 16384 + k * 128 + v4) = s; }
    }
}

__device__ __forceinline__ void ph_router_tables(const Ctx& X, const float* g_ffn, const float* mod, const float* w_router, const float* b_router, float* Bp, float* cb) {
    for (int i = X.vcu * 512 + X.tid; i < 4 * 1024 * 32; i += X.G * 512) { const int b = i >> 15, k = (i >> 5) & 1023;
        Bp[i] = g_ffn[k] * (1.0f + mod[(size_t)b * NMOD + 4 * D + k]) * w_router[i & 32767]; }
    const int gw = X.vcu * 8 + X.wave;
    if (gw < 128) { const int b = gw >> 5, e = gw & 31; float a = 0.f;
        for (int k = X.lane; k < 1024; k += 64) a += mod[(size_t)b * NMOD + 3 * D + k] * w_router[k * 32 + e];
        a = wave_sum(a); if (X.lane == 0) cb[gw] = a + b_router[e]; }
}

__device__ __forceinline__ void ph_route(const Ctx& X, const bf16_t* x1, const float* g_ffn, const float* mod, const float* Bp, const float* cb,
                                         unsigned char* h2, int* top_e, float* top_w, int* rank, int* hist_g) {
    LAS int* hist = (LAS int*)(X.lds + LDSCTL_OFF + 64);
    const int tid = X.tid, lane = X.lane, c = lane & 15, q = lane >> 4;
    for (int tile = X.vcu; tile < RT_NT; tile += X.G) {
        if (tid < 32) hist[tid] = 0;
        __syncthreads();
        const int tw = tile * RT_TILE + X.wave * 16, b = tw / SEQ;
        const bf16_t* xa = x1 + (size_t)(tw + c) * D + 4 * q;
        const float* bp = Bp + ((size_t)b * 1024 + 4 * q) * 32 + c;
        f32x4 acc0 = (f32x4){0.f, 0.f, 0.f, 0.f}, acc1 = acc0; float ss = 0.f;
#pragma unroll 4
        for (int m = 0; m < 64; ++m) {
            const u32x2 a2_ = *(const u32x2*)(xa + 16 * m); const f32x4 a4 = (f32x4){bflo(a2_.x), bfhi(a2_.x), bflo(a2_.y), bfhi(a2_.y)};
            float bv[8];
#pragma unroll
            for (int j = 0; j < 4; ++j) { bv[2 * j] = bp[(size_t)(16 * m + j) * 32]; bv[2 * j + 1] = bp[(size_t)(16 * m + j) * 32 + 16]; }
            ss += (a4.x * a4.x + a4.y * a4.y) + (a4.z * a4.z + a4.w * a4.w);
#pragma unroll
            for (int j = 0; j < 4; ++j) { acc0 = __builtin_amdgcn_mfma_f32_16x16x4f32(a4[j], bv[2 * j], acc0, 0, 0, 0); acc1 = __builtin_amdgcn_mfma_f32_16x16x4f32(a4[j], bv[2 * j + 1], acc1, 0, 0, 0); }
        }
        ss += __shfl_xor(ss, 16); ss += __shfl_xor(ss, 32);
        const float rs = rsqrtf(ss * (1.0f / D) + EPS);
        const float cb0 = cb[b * 32 + c], cb1 = cb[b * 32 + 16 + c];
#pragma unroll
        for (int reg = 0; reg < 4; ++reg) {
            const float rt = __shfl(rs, 4 * q + reg);
            float v0 = acc0[reg] * rt + cb0, v1 = acc1[reg] * rt + cb1;
            float sv[4]; int si[4];
#pragma unroll
            for (int rnd = 0; rnd < 4; ++rnd) {
                float bvv = v0; int bi = c; if (v1 > bvv) { bvv = v1; bi = 16 + c; }
#pragma unroll
                for (int o = 1; o < 16; o <<= 1) { const float ov = __shfl_xor(bvv, o); const int oi = __shfl_xor(bi, o); if (ov > bvv || (ov == bvv && oi < bi)) { bvv = ov; bi = oi; } }
                sv[rnd] = bvv; si[rnd] = bi; if (bi == c) v0 = -INFINITY; if (bi == 16 + c) v1 = -INFINITY;
            }
            const float e1 = __expf(sv[1] - sv[0]), e2 = __expf(sv[2] - sv[0]), e3 = __expf(sv[3] - sv[0]);
            const float inv = 1.0f / (1.0f + e1 + e2 + e3);
            if (c == 0) { const int t = tw + 4 * q + reg;
                const float ww[4] = {inv, e1 * inv, e2 * inv, e3 * inv};
#pragma unroll
                for (int rnd = 0; rnd < 4; ++rnd) { top_e[t * 4 + rnd] = si[rnd]; top_w[t * 4 + rnd] = ww[rnd]; rank[t * 4 + rnd] = atomicAdd((int*)&hist[si[rnd]], 1); }
            }
        }
        const float* sh = mod + (size_t)b * NMOD + 3 * D; const float* sc = mod + (size_t)b * NMOD + 4 * D;
#pragma unroll 4
        for (int i = 0; i < 16; ++i) {
            const float r = __shfl(rs, i);
            const u32x2* xr = (const u32x2*)(x1 + (size_t)(tw + i) * D) + lane;
#pragma unroll
            for (int j = 0; j < 4; ++j) {
                const int col = 4 * (lane + 64 * j);
                const f32x4 gg = *(const f32x4*)(g_ffn + col), s1 = *(const f32x4*)(sc + col), s0 = *(const f32x4*)(sh + col);
                const u32x2 xw = xr[64 * j]; const f32x4 xv = (f32x4){bflo(xw.x), bfhi(xw.x), bflo(xw.y), bfhi(xw.y)};
                const f32x4 y = (xv * r * gg * (s1 + 1.0f) + s0) * 16.0f;
                *(unsigned*)(h2 + (size_t)(tw + i) * D + col) = cvt4_fp8(y.x, y.y, y.z, y.w);
            }
        }
        __syncthreads();
        if (tid < 32) hist_g[tile * 32 + tid] = hist[tid];
        __syncthreads();
    }
}

__device__ __forceinline__ void ph_sort(const Ctx& X, const int* hist_g, const int* top_e, const float* top_w, const int* rank, int* row_tok, float* row_w, int* pair_row, int* blk_e) {
    LAS int* s_hist = (LAS int*)X.lds;
    LAS int* s_tot = s_hist + RT_NT * 32; LAS int* s_pre = s_tot + 32; LAS int* s_base = s_pre + 32; LAS int* s_pstart = s_base + 32; LAS int* s_pend = s_pstart + 32;
    const int tid = X.tid;
    for (int i = tid; i < RT_NT * 32; i += 512) s_hist[i] = hist_g[i];
    __syncthreads();
    for (int tile = X.vcu; tile < RT_NT; tile += X.G) {
        if (tid < 32) { int tot = 0, pre = 0; for (int i = 0; i < RT_NT; ++i) { const int c = s_hist[i * 32 + tid]; tot += c; if (i < tile) pre += c; } s_tot[tid] = tot; s_pre[tid] = pre; }
        __syncthreads();
        if (tid == 0) { int acc = 0; for (int e = 0; e < 32; ++e) { const int padded = (s_tot[e] + 255) / 256 * 256; s_pstart[e] = acc; s_base[e] = acc + s_pre[e]; acc += padded; s_pend[e] = acc; } }
        __syncthreads();
        { const int i = tid; const int idx = tile * RT_TILE * 4 + i; const int e = top_e[idx]; const int row = s_base[e] + rank[idx];
          row_tok[row] = idx >> 2; row_w[row] = top_w[idx]; pair_row[idx] = row; }
        if (tile < 32) { const int e = tile; for (int r = s_pstart[e] + s_tot[e] + tid; r < s_pend[e]; r += 512) { row_tok[r] = 0; row_w[r] = 0.f; } }
        if (tile == 32) { for (int blk = tid; blk < NBLK_MAX; blk += 512) { int e = -1; const int r = blk * 256; for (int q = 0; q < 32; ++q) if (r >= s_pstart[q] && r < s_pend[q]) e = q; blk_e[blk] = e; }
                          if (tid == 0) blk_e[NBLK_MAX] = s_pend[31] / 256; }
        __syncthreads();
    }
}

__device__ __forceinline__ void ph_final(const Ctx& X, const bf16_t* x1, const bf16_t* y, const int* pair_row, const float* mod, const float* g_final, float* out, const float oscale) {
    const int lane = X.lane;
    for (int t = X.vcu * 8 + X.wave; t < T; t += X.G * 8) {
        const int b = t / SEQ;
        const u32x2* xr = (const u32x2*)(x1 + (size_t)t * D) + lane;
        const float* ga = mod + (size_t)b * NMOD + 5 * D;
        int rows[4];
#pragma unroll
        for (int k = 0; k < 4; ++k) rows[k] = pair_row[t * 4 + k];
        f32x4 v[4]; float ss = 0.f;
#pragma unroll
        for (int j = 0; j < 4; ++j) {
            const int col = 4 * (lane + 64 * j);
            f32x4 m = (f32x4){0.f, 0.f, 0.f, 0.f};
#pragma unroll
            for (int k = 0; k < 4; ++k) { const u32x2 w = *(const u32x2*)(y + (size_t)rows[k] * D + col); m.x += bflo(w.x); m.y += bfhi(w.x); m.z += bflo(w.y); m.w += bfhi(w.y); }
            const u32x2 xw = xr[64 * j];
            v[j] = (f32x4){bflo(xw.x), bfhi(xw.x), bflo(xw.y), bfhi(xw.y)} + *(const f32x4*)(ga + col) * m;
            ss += (v[j].x * v[j].x + v[j].y * v[j].y) + (v[j].z * v[j].z + v[j].w * v[j].w);
        }
        const float r = rsqrtf(wave_sum(ss) * (1.0f / D) + EPS);
#pragma unroll
        for (int j = 0; j < 4; ++j) { const int col = 4 * (lane + 64 * j); *(f32x4*)(out + (size_t)t * D + col) = v[j] * (r * oscale) * *(const f32x4*)(g_final + col); }
    }
}

constexpr int N_PHASES = 13;
struct Args { const float* in[23]; float* out; unsigned char* ws; int ph_lo, ph_hi; };
__global__ void __launch_bounds__(512, 2) fwd(Args a) {
    extern __shared__ __attribute__((aligned(16))) unsigned char lds_raw[];
    Ctx X; X.lds = (LAS unsigned char*)lds_raw; X.tid = threadIdx.x; X.lane = X.tid & 63; X.wave = __builtin_amdgcn_readfirstlane(X.tid >> 6);
    X.G = gridDim.x; { const int bx = blockIdx.x; X.vcu = (X.G % 8 == 0) ? (bx % 8) * (X.G / 8) + bx / 8 : bx; }
    unsigned char* ws = a.ws;
    for (int u = X.tid; u < (LDS_BYTES - LDSCTL_OFF) / 4; u += 512) ((LAS unsigned*)(X.lds + LDSCTL_OFF))[u] = 0u;
    __syncthreads();
    XcdBarrier bar = xcd_barrier_post((unsigned*)(ws + WS_CTL) + CW_BAR, (volatile LAS unsigned*)(X.lds + LDSCTL_OFF), X.tid == 0);
    const int lo = a.ph_lo, hi = a.ph_hi; float probe_scale = 1.0f;
#define IN(k) (lo <= (k) && (k) < hi)
#define SEAM(k) do { if (IN(k) && IN((k) + 1)) xcd_barrier(bar, X.wave == 0 && (int)__builtin_amdgcn_mbcnt_hi(~0u, __builtin_amdgcn_mbcnt_lo(~0u, 0u)) == 0); } while (0)
#ifdef PROBE_PH
    unsigned long long* stamps = (unsigned long long*)(ws + WS_CTL + 32768);
    if (blockIdx.x == 0 && X.tid == 0) stamps[0] = __builtin_amdgcn_s_memrealtime();
#undef SEAM
#define SEAM(k) do { if (IN(k) && IN((k) + 1)) { xcd_barrier(bar, X.wave == 0 && (int)__builtin_amdgcn_mbcnt_hi(~0u, __builtin_amdgcn_mbcnt_lo(~0u, 0u)) == 0); \
        if (blockIdx.x == 0 && X.wave == 0 && (int)__builtin_amdgcn_mbcnt_hi(~0u, __builtin_amdgcn_mbcnt_lo(~0u, 0u)) == 0) stamps[(k) + 1] = __builtin_amdgcn_s_memrealtime(); } } while (0)
#endif
    const float* x = a.in[0]; const float* c = a.in[1]; const float* w_ada = a.in[2]; const float* b_ada = a.in[3];
    const float* g_mix = a.in[4]; const float* w_in = a.in[5]; const float* conv_dw = a.in[6]; const float* conv_dwb = a.in[7];
    const float* conv_ln_g = a.in[8]; const float* conv_ln_b = a.in[9]; const float* w_conv_out = a.in[10]; const float* lb_param = a.in[11];
    const float* hgrn_norm_g = a.in[12]; const float* w_hgrn_out = a.in[13]; const float* w_out = a.in[14]; const float* g_ffn = a.in[15];
    const float* w_router = a.in[16]; const float* b_router = a.in[17]; const float* w1 = a.in[18]; const float* b1 = a.in[19];
    const float* w2 = a.in[20]; const float* b2 = a.in[21]; const float* g_final = a.in[22];
    float* mod = (float*)(ws + WS_MOD); float* rt_bp = (float*)(ws + WS_BP); float* rt_cb = (float*)(ws + WS_CB);
    int* hist_g = (int*)(ws + WS_HIST); int* blk_e = (int*)(ws + WS_BLKE); int* top_e = (int*)(ws + WS_TOPE); float* top_w = (float*)(ws + WS_TOPW);
    int* rank = (int*)(ws + WS_RANK); int* pair_row = (int*)(ws + WS_PROW); int* row_tok = (int*)(ws + WS_RTOK); float* row_w = (float*)(ws + WS_RW);
    bf16_t* p = (bf16_t*)(ws + WS_P);
    bf16_t* h = (bf16_t*)(ws + WS_E); float* tmp = (float*)(ws + WS_E);
    float* hg_dS = (float*)(ws + WS_E); float* hg_S0 = (float*)(ws + WS_E + 64 * MiB); float* hg_D = (float*)(ws + WS_HGD);
    bf16_t* uc = (bf16_t*)(ws + WS_D); bf16_t* og = uc + D;   bf16_t* x1 = (bf16_t*)(ws + WS_D);
    bf16_t* merged = p;
    unsigned char* h2 = (unsigned char*)p;
    unsigned char* act = (unsigned char*)(p + PG);
    bf16_t* y = p + PG + (size_t)R_PAD * D / 2;
    PG8_LAS unsigned char* ring = (PG8_LAS unsigned char*)lds_raw;

#ifndef REPMASK
#define REPMASK 0
#endif
#ifndef REPN
#define REPN 1
#endif
#define PH(k, ...) do { if (IN(k)) { _Pragma("unroll 1") for (int rep_ = 0; rep_ < ((((REPMASK) >> (k)) & 1) ? 1 + REPN : 1); ++rep_) { if (rep_) __syncthreads(); { int ln_ = (int)__builtin_amdgcn_mbcnt_hi(~0u, __builtin_amdgcn_mbcnt_lo(~0u, 0u)); asm volatile("" : "+v"(ln_)); X.lane = ln_; X.tid = X.wave * 64 + ln_; } __VA_ARGS__ } } SEAM(k); } while (0)
    PH(0, ph_prologue<0>(X, c, w_ada, b_ada, mod, w_in, w_conv_out, w_hgrn_out, w_out, w1, w2, ws););
    PH(1, ph_norm_mod(X, x, g_mix, mod, 0, D, h); ph_router_tables(X, g_ffn, mod, w_router, b_router, rt_bp, rt_cb););
#ifndef STAGGER_TICKS
#define STAGGER_TICKS 0
#endif
    PH(2, { if (STAGGER_TICKS) { const unsigned long long t0_ = __builtin_amdgcn_s_memrealtime(), wait_ = (unsigned long long)(X.vcu & 3) * STAGGER_TICKS;
                while (__builtin_amdgcn_s_memrealtime() - t0_ < wait_) __builtin_amdgcn_s_sleep(8); }
        pg8::Gemm g{h, (const bf16_t*)(ws + WS_WIN), T, 8 * D, D}; pg8::StaticOrder S; S.init(T, 8 * D, X.G, (int)blockIdx.x);
        pg8::EpiSplitBf16 E{p, PG, 0x3cu, SEQ}; pg8::gemm_phase<pg8::EpiSplitBf16, pg8::StaticOrder, true, true>(ring, g, S, E, X.wave); });
    PH(3, ph_conv(X, p + 0 * PG, conv_dw, conv_dwb, conv_ln_g, conv_ln_b, uc);
          if ((REPMASK >> 14) & 1) { __syncthreads(); ph_conv(X, p + 0 * PG, conv_dw, conv_dwb, conv_ln_g, conv_ln_b, uc); }
          ph_hgrn<false>(X, 31 * 32, p + 2 * PG, p + 3 * PG, p + 4 * PG, p + 5 * PG, lb_param, nullptr, nullptr, hg_dS, hg_D, nullptr);
          if ((REPMASK >> 15) & 1) { __syncthreads(); ph_hgrn<false>(X, 31 * 32, p + 2 * PG, p + 3 * PG, p + 4 * PG, p + 5 * PG, lb_param, nullptr, nullptr, hg_dS, hg_D, nullptr); });
    PH(4, ph_hg2(X, hg_dS, hg_D, hg_S0););
    PH(5, if ((X.vcu & 1) == 0) ph_prologue<1>(X, c, w_ada, b_ada, mod, w_in, w_conv_out, w_hgrn_out, w_out, w1, w2, ws);
          ph_hgrn<true>(X, 32 * 32, p + 2 * PG, p + 3 * PG, p + 4 * PG, p + 5 * PG, lb_param, hgrn_norm_g, hg_S0, nullptr, nullptr, og);
          if ((X.vcu & 1) != 0) ph_prologue<1>(X, c, w_ada, b_ada, mod, w_in, w_conv_out, w_hgrn_out, w_out, w1, w2, ws););
    PH(6, { pg8::Gemm g{uc, (const bf16_t*)(ws + WS_WC), T, D, 2 * D}; pg8::StaticOrder S; S.init(T, D, X.G, (int)blockIdx.x);
        pg8::EpiGateFused E{p + 6 * PG, p + 7 * PG, merged}; pg8::gemm_phase<pg8::EpiGateFused, pg8::StaticOrder, true, true>(ring, g, S, E, X.wave); });
    PH(7, { pg8::Gemm g{merged, (const bf16_t*)(ws + WS_WO), T, D, D}; pg8::StaticOrder S; S.init(T, D, X.G, (int)blockIdx.x);
        pg8::EpiRes E{x, mod + 2 * D, x1, NMOD, SEQ}; pg8::gemm_phase<pg8::EpiRes, pg8::StaticOrder, true, true>(ring, g, S, E, X.wave); });
    PH(8, ph_route(X, x1, g_ffn, mod, rt_bp, rt_cb, h2, top_e, top_w, rank, hist_g););
    PH(9, ph_sort(X, hist_g, top_e, top_w, rank, row_tok, row_w, pair_row, blk_e););
    PH(10, { const int nblk = blk_e[NBLK_MAX]; pg8::Gemm g{(const bf16_t*)h2, (const bf16_t*)(ws + WS_W1), T, 32 * 2048, D / 2}; pg8::MoeOrder S{blk_e, nblk, X.G, (int)blockIdx.x, 3};
        LAS unsigned short* gt = (LAS unsigned short*)(X.lds + LDSCTL_OFF + 256);
        _Pragma("unroll 1") for (int i = 0; i < 23; ++i) { pg8::Unit u; if (!S.next(i, u)) break; if (X.tid < 256) gt[256 * i + X.tid] = (unsigned short)row_tok[u.pm * 256 + X.tid]; }
        __syncthreads();
        pg8::EpiSwiglu8 E{b1, act, 1.0f / 4096.0f}; pg8::gemm_phase<pg8::EpiSwiglu8, pg8::MoeOrder, true, true, true, true>(ring, g, S, E, X.wave, (const PG8_LAS unsigned short*)gt); });
    PH(11, { const int nblk = blk_e[NBLK_MAX]; pg8::Gemm g{(const bf16_t*)act, (const bf16_t*)(ws + WS_W2), R_PAD, 32 * 1024, DFF / 2}; pg8::MoeOrder S{blk_e, nblk, X.G, (int)blockIdx.x, 2};
        pg8::EpiY8 E{b2, row_w, y, 1.0f / 1024.0f}; pg8::gemm_phase<pg8::EpiY8, pg8::MoeOrder, true, true, false, true>(ring, g, S, E, X.wave); });
#ifdef PROBE_PH
    { const unsigned long long* st_ = (const unsigned long long*)(ws + WS_CTL + 32768); const float dt_ = (float)(long long)(st_[PROBE_PH + 1] - st_[PROBE_PH]);
      probe_scale = 1.0f + dt_ * (1.0f / 200000.0f); }
#endif
    PH(12, ph_final(X, x1, y, pair_row, mod, g_final, a.out, probe_scale););
#undef PH
#undef IN
#undef SEAM
}

#ifndef MK_N_LAUNCHES
#define MK_N_LAUNCHES 1
#endif
extern "C" void kernel_launch(void* const* d_in, const int* in_sizes, int n_in, void* d_out, int out_size, void* d_ws, size_t ws_size, hipStream_t stream) {
    static int grid = 0;
    if (grid == 0) {
        if (n_in != 23 || out_size != T * D || ws_size < WS_END) { fprintf(stderr, "kernel_launch: unexpected n_in %d / out_size %d / ws_size %zu (< %zu); nothing launched\n", n_in, out_size, ws_size, (size_t)WS_END); grid = -1; return; }
        int dev = 0, cus = 0, per_cu = 0;
        if (hipGetDevice(&dev) != hipSuccess || hipDeviceGetAttribute(&cus, hipDeviceAttributeMultiprocessorCount, dev) != hipSuccess) { grid = -1; return; }
        if (hipFuncSetAttribute((const void*)fwd, hipFuncAttributeMaxDynamicSharedMemorySize, LDS_BYTES) != hipSuccess) { fprintf(stderr, "kernel_launch: hipFuncSetAttribute failed\n"); grid = -1; return; }
        if (hipOccupancyMaxActiveBlocksPerMultiprocessor(&per_cu, (const void*)fwd, 512, LDS_BYTES) != hipSuccess || per_cu < 1) { fprintf(stderr, "kernel_launch: occupancy query says %d blocks per CU\n", per_cu); }
        (void)hipGetLastError();
        grid = cus;
    }
    if (grid < 0) return;
    if (hipMemsetAsync((char*)d_ws + WS_CTL, 0, CTL_ZERO_BYTES, stream) != hipSuccess) return;
    Args a{};
    for (int i = 0; i < 23; ++i) a.in[i] = (const float*)d_in[i];
    a.out = (float*)d_out; a.ws = (unsigned char*)d_ws;
    if (MK_N_LAUNCHES == 1) { a.ph_lo = 0; a.ph_hi = N_PHASES; hipLaunchKernelGGL(fwd, dim3(grid), dim3(512), LDS_BYTES, stream, a); }
    else for (int ph = 0; ph < N_PHASES; ++ph) { a.ph_lo = ph; a.ph_hi = ph + 1; hipLaunchKernelGGL(fwd, dim3(grid), dim3(512), LDS_BYTES, stream, a); }
}
```

```cpp
#include <hip/hip_runtime.h>
#include <stdint.h>
#include <stdio.h>

#define GAS __attribute__((address_space(1)))
#define LAS __attribute__((address_space(3)))
typedef unsigned short bf16_t;
typedef unsigned u32x4 __attribute__((ext_vector_type(4)));
typedef unsigned u32x2 __attribute__((ext_vector_type(2)));
typedef float f32x4 __attribute__((ext_vector_type(4)));

constexpr int D = 1024, NBATCH = 4, SEQ = 8192, T = NBATCH * SEQ;
constexpr int NE = 32, DFF = 1024;
constexpr int NMOD = 6 * D;
constexpr int NBLK_MAX = 544, R_PAD = NBLK_MAX * 256;
constexpr int RT_TILE = 128, RT_NT = T / RT_TILE;
constexpr float EPS = 1e-6f;

constexpr size_t MiB = 1u << 20;
constexpr size_t WS_CTL = 0, CTL_ZERO_BYTES = 64 * 1024;
constexpr size_t WS_MOD = 1 * MiB;
constexpr size_t WS_CB = WS_MOD + 112 * 1024, WS_BP = WS_MOD + 128 * 1024;
constexpr size_t WS_HIST = 2 * MiB;
constexpr size_t WS_BLKE = WS_HIST + 64 * 1024;
constexpr size_t WS_TOPE = 3 * MiB;
constexpr size_t WS_TOPW = WS_TOPE + 512 * 1024;
constexpr size_t WS_RANK = WS_TOPW + 512 * 1024;
constexpr size_t WS_PROW = WS_RANK + 512 * 1024;
constexpr size_t WS_RTOK = 5 * MiB;
constexpr size_t WS_RW = 6 * MiB;
constexpr size_t WS_HGD = 7 * MiB;
constexpr size_t WS_WT = 8 * MiB;
constexpr size_t WS_WIN = WS_WT, WS_WC = WS_WT + 16 * MiB, WS_WH = WS_WT + 18 * MiB, WS_WO = WS_WT + 20 * MiB, WS_W1 = WS_WT + 22 * MiB, WS_WIN8 = WS_WT + 96 * MiB  , WS_W2 = WS_WT + 150 * MiB;
constexpr size_t WS_P = 224 * MiB;
constexpr size_t WS_E = WS_P + 512 * MiB;
constexpr size_t WS_D = WS_E + 128 * MiB;
constexpr size_t WS_END = WS_D + 128 * MiB;
constexpr size_t PG = (size_t)T * D;
constexpr int CW_BAR = 0;

constexpr int RING_BYTES = 135168, LDSCTL_OFF = RING_BYTES, LDS_BYTES = 147456;

__device__ __forceinline__ unsigned f2bf(float f) { unsigned u = __builtin_bit_cast(unsigned, f); return (u + 0x7fffu + ((u >> 16) & 1u)) >> 16; }
__device__ __forceinline__ unsigned pk2(float lo, float hi) { return f2bf(lo) | (f2bf(hi) << 16); }
__device__ __forceinline__ float bf2f(unsigned b) { return __builtin_bit_cast(float, b << 16); }
__device__ __forceinline__ float bflo(unsigned w) { return __builtin_bit_cast(float, w << 16); }
__device__ __forceinline__ float bfhi(unsigned w) { return __builtin_bit_cast(float, w & 0xffff0000u); }
__device__ __forceinline__ float sigmoidf_(float x) { return __builtin_amdgcn_rcpf(1.0f + __expf(-x)); }
__device__ __forceinline__ float wave_sum(float v) {
#pragma unroll
    for (int o = 1; o < 64; o <<= 1) v += __shfl_xor(v, o);
    return v;
}
__device__ __forceinline__ unsigned cvt4_fp8(float a, float b, float c, float d) {
    a = fminf(fmaxf(a, -448.f), 448.f); b = fminf(fmaxf(b, -448.f), 448.f); c = fminf(fmaxf(c, -448.f), 448.f); d = fminf(fmaxf(d, -448.f), 448.f);
    int w = 0; w = __builtin_amdgcn_cvt_pk_fp8_f32(a, b, w, false); w = __builtin_amdgcn_cvt_pk_fp8_f32(c, d, w, true); return (unsigned)w; }
#define LDS_WAIT() asm volatile("s_waitcnt lgkmcnt(0)" ::: "memory")
#define VM_WAIT() asm volatile("s_waitcnt vmcnt(0)" ::: "memory")

namespace pg8 {
#define PG8_LAS __attribute__((address_space(3)))
typedef unsigned short bf16_t;
typedef short bf16x8 __attribute__((ext_vector_type(8)));
typedef float f32x4 __attribute__((ext_vector_type(4)));
typedef unsigned u32x4 __attribute__((ext_vector_type(4)));
constexpr int BM = 256, BK = 64, HALF = 128, HTB = HALF * BK * 2  , STAGE_BYTES = 8 * HTB, NXCD = 8, WGM = 8;

__host__ __device__ __forceinline__ int lds_byte(int r, int c) { const int st = (r >> 4) * 2 + (c >> 5), rr = r & 15, cc = c & 31, ob = rr * 64 + cc * 2; return st * 1024 + (ob ^ (((ob >> 9) & 1) << 5)); }
__host__ __device__ __forceinline__ void stage_rc(int b, int& R, int& C) { const int st = b / 1024, sb = b % 1024, swz = sb ^ (((sb >> 9) & 1) << 5); R = (st >> 1) * 16 + swz / 64; C = (st & 1) * 32 + (swz % 64) / 2; }
__host__ __device__ __forceinline__ int perm32(int rho) { const int n = rho >> 4, i = rho & 15; return 8 * (i >> 2) + 4 * n + (i & 3); }

struct Unit { int pm, pn; };
struct Gemm { const bf16_t* A; const bf16_t* Bt; int M, N, K; };

struct StaticOrder {
    int nM, nN, nwg, G, c;
    __host__ __device__ void init(int M, int N, int G_, int c_) { nM = M / BM; nN = N / BM; nwg = nM * nN; G = G_; c = c_; }
    __host__ __device__ bool next(int i, Unit& u) const {
        const long L = (long)i * G + c; if (L >= nwg) return false;
        int wgid = (int)L; { const int q = nwg / NXCD, r = nwg % NXCD, xcd = wgid % NXCD, off = wgid / NXCD; wgid = (xcd < r ? xcd * (q + 1) : r * (q + 1) + (xcd - r) * q) + off; }
        const int nig = WGM * nN, gid = wgid / nig, fm = gid * WGM, gsz = (nM - fm) < WGM ? (nM - fm) : WGM;
        u.pm = fm + ((wgid % nig) % gsz); u.pn = (wgid % nig) / gsz; return true;
    }
    __device__ __forceinline__ void a_ready(const Unit&) const {}
    __device__ __forceinline__ void done(const Unit&) const {}
};


struct MaskOrder {
    StaticOrder base; unsigned mask;
    __device__ __forceinline__ bool next(int i, Unit& u) const {
        if (!base.next(i, u)) return false;
        unsigned m = mask; for (int k = 0; k < u.pn; ++k) m &= m - 1;
        u.pn = __builtin_ctz(m); return true;
    }
    __device__ __forceinline__ void a_ready(const Unit&) const {}
    __device__ __forceinline__ void done(const Unit&) const {}
};
struct MoeOrder {
    const int* blk_e; int nblk, G, c, lg;
    __device__ __forceinline__ bool next(int i, Unit& u) const {
        int blk, j;
        if (G == 256) { const int xcd = c & 7, idx = c >> 3, prb = 256 >> lg; blk = i * prb + xcd * (prb >> 3) + (idx >> lg); j = idx & ((1 << lg) - 1); }
        else { const long L = (long)i * G + c; blk = (int)(L >> lg); j = (int)(L & ((1 << lg) - 1)); }
        if (blk >= nblk) return false;
        const int e = blk_e[blk]; u.pm = blk; u.pn = (e << lg) + j; return true;
    }
    __device__ __forceinline__ void a_ready(const Unit&) const {}
    __device__ __forceinline__ void done(const Unit&) const {}
};

__device__ __forceinline__ unsigned cvt_pk_bf16(float lo, float hi) { unsigned r; asm volatile("v_cvt_pk_bf16_f32 %0, %1, %2" : "=v"(r) : "v"(lo), "v"(hi)); return r; }
__device__ __forceinline__ float sigm(float x) { return __builtin_amdgcn_rcpf(1.0f + __expf(-x)); }
__device__ __forceinline__ float blo(unsigned w) { return __builtin_bit_cast(float, w << 16); }
__device__ __forceinline__ float bhi(unsigned w) { return __builtin_bit_cast(float, w & 0xffff0000u); }

struct EpiSplitBf16 {
    static constexpr bool PERM = true, AFTER_DRAIN = false;
    bf16_t* O; size_t split_stride; unsigned hm_mask; int seq; float dq;
    __device__ __forceinline__ void operator()(const f32x4 (&acc)[2][2][4][2], const Unit& u, int wr, int wc, int fr, int fq) const {
        const int row0 = u.pm * BM + wr * 64 + fr; const int colt = u.pn * BM; const int t = colt >> 10;
        if (u.pn < 8) {
#pragma unroll
            for (int ai = 0; ai < 2; ++ai)
#pragma unroll
                for (int m = 0; m < 4; ++m) { const int row = row0 + ai * HALF + m * 16; float r[8];
#pragma unroll
                    for (int q = 0; q < 4; ++q) { r[q] = acc[ai][0][m][0][q] * dq * sigm(acc[ai][1][m][0][q] * dq); r[4 + q] = acc[ai][0][m][1][q] * dq * sigm(acc[ai][1][m][1][q] * dq); }
                    u32x4 w; w.x = cvt_pk_bf16(r[0], r[1]); w.y = cvt_pk_bf16(r[2], r[3]); w.z = cvt_pk_bf16(r[4], r[5]); w.w = cvt_pk_bf16(r[6], r[7]);
                    __builtin_nontemporal_store(w, (u32x4*)(O + (size_t)row * 1024 + 128 * u.pn + wc * 32 + 8 * fq)); }
            return;
        }
        bf16_t* base = O + (size_t)t * split_stride; const int cg = colt & 1023;
        const bool hm = (hm_mask >> t) & 1u;
        const int bb = (u.pm * BM) / seq;
#pragma unroll
        for (int ai = 0; ai < 2; ++ai)
#pragma unroll
            for (int m = 0; m < 4; ++m) { const int row = row0 + ai * HALF + m * 16;
#pragma unroll
                for (int bj = 0; bj < 2; ++bj) { const f32x4 v0 = acc[ai][bj][m][0] * dq, v1 = acc[ai][bj][m][1] * dq;
                    u32x4 w; w.x = cvt_pk_bf16(v0[0], v0[1]); w.y = cvt_pk_bf16(v0[2], v0[3]); w.z = cvt_pk_bf16(v1[0], v1[1]); w.w = cvt_pk_bf16(v1[2], v1[3]);
                    const size_t o = hm ? ((size_t)(bb * 8 + (cg >> 7) + bj) * seq + (row - bb * seq)) * 128 + wc * 32 + 8 * fq
                                        : (size_t)row * 1024 + cg + bj * HALF + wc * 32 + 8 * fq;
                    __builtin_nontemporal_store(w, (u32x4*)(base + o)); } }
    }
};
struct EpiGate1 {
    static constexpr bool PERM = true, AFTER_DRAIN = false;
    const bf16_t* gate; float* tmp;
    __device__ __forceinline__ void operator()(const f32x4 (&acc)[2][2][4][2], const Unit& u, int wr, int wc, int fr, int fq) const {
        const int row0 = u.pm * BM + wr * 64 + fr, col0 = u.pn * BM + wc * 32 + 8 * fq;
#pragma unroll
        for (int ai = 0; ai < 2; ++ai)
#pragma unroll
            for (int m = 0; m < 4; ++m) { const size_t o = (size_t)(row0 + ai * HALF + m * 16) * 1024 + col0;
#pragma unroll
                for (int bj = 0; bj < 2; ++bj) { const u32x4 g = *(const u32x4*)(gate + o + bj * HALF); f32x4 v0 = acc[ai][bj][m][0], v1 = acc[ai][bj][m][1];
                    v0[0] *= sigm(blo(g.x)); v0[1] *= sigm(bhi(g.x)); v0[2] *= sigm(blo(g.y)); v0[3] *= sigm(bhi(g.y));
                    v1[0] *= sigm(blo(g.z)); v1[1] *= sigm(bhi(g.z)); v1[2] *= sigm(blo(g.w)); v1[3] *= sigm(bhi(g.w));
                    *(f32x4*)(tmp + o + bj * HALF) = v0; *(f32x4*)(tmp + o + bj * HALF + 4) = v1; } }
    }
};
struct EpiGate2 {
    static constexpr bool PERM = true, AFTER_DRAIN = false;
    const bf16_t* gate; const float* tmp; bf16_t* out;
    __device__ __forceinline__ void operator()(const f32x4 (&acc)[2][2][4][2], const Unit& u, int wr, int wc, int fr, int fq) const {
        const int row0 = u.pm * BM + wr * 64 + fr, col0 = u.pn * BM + wc * 32 + 8 * fq;
#pragma unroll
        for (int ai = 0; ai < 2; ++ai)
#pragma unroll
            for (int m = 0; m < 4; ++m) { const size_t o = (size_t)(row0 + ai * HALF + m * 16) * 1024 + col0;
#pragma unroll
                for (int bj = 0; bj < 2; ++bj) { const u32x4 g = *(const u32x4*)(gate + o + bj * HALF); f32x4 v0 = acc[ai][bj][m][0], v1 = acc[ai][bj][m][1];
                    const f32x4 t0 = *(const f32x4*)(tmp + o + bj * HALF), t1 = *(const f32x4*)(tmp + o + bj * HALF + 4);
                    v0[0] = t0[0] + v0[0] * sigm(blo(g.x)); v0[1] = t0[1] + v0[1] * sigm(bhi(g.x)); v0[2] = t0[2] + v0[2] * sigm(blo(g.y)); v0[3] = t0[3] + v0[3] * sigm(bhi(g.y));
                    v1[0] = t1[0] + v1[0] * sigm(blo(g.z)); v1[1] = t1[1] + v1[1] * sigm(bhi(g.z)); v1[2] = t1[2] + v1[2] * sigm(blo(g.w)); v1[3] = t1[3] + v1[3] * sigm(bhi(g.w));
                    u32x4 w; w.x = cvt_pk_bf16(v0[0], v0[1]); w.y = cvt_pk_bf16(v0[2], v0[3]); w.z = cvt_pk_bf16(v1[0], v1[1]); w.w = cvt_pk_bf16(v1[2], v1[3]);
                    *(u32x4*)(out + o + bj * HALF) = w; } }
    }
};
struct EpiRes {
    static constexpr bool PERM = true, AFTER_DRAIN = false;
    const float* x; const float* ga; bf16_t* out; int mod_pitch, seq;
    __device__ __forceinline__ void operator()(const f32x4 (&acc)[2][2][4][2], const Unit& u, int wr, int wc, int fr, int fq) const {
        const int row0 = u.pm * BM + wr * 64 + fr, col0 = u.pn * BM + wc * 32 + 8 * fq;
        const float* gab = ga + (size_t)((u.pm * BM) / seq) * mod_pitch + col0;
        f32x4 gv[2][2];
#pragma unroll
        for (int bj = 0; bj < 2; ++bj)
#pragma unroll
            for (int n = 0; n < 2; ++n) gv[bj][n] = *(const f32x4*)(gab + bj * HALF + 4 * n);
#pragma unroll
        for (int ai = 0; ai < 2; ++ai)
#pragma unroll
            for (int m = 0; m < 4; ++m) { const size_t o = (size_t)(row0 + ai * HALF + m * 16) * 1024 + col0;
#pragma unroll
                for (int bj = 0; bj < 2; ++bj) { const f32x4 x0 = *(const f32x4*)(x + o + bj * HALF), x1_ = *(const f32x4*)(x + o + bj * HALF + 4);
                    const f32x4 v0 = x0 + gv[bj][0] * acc[ai][bj][m][0], v1 = x1_ + gv[bj][1] * acc[ai][bj][m][1];
                    u32x4 w; w.x = cvt_pk_bf16(v0[0], v0[1]); w.y = cvt_pk_bf16(v0[2], v0[3]); w.z = cvt_pk_bf16(v1[0], v1[1]); w.w = cvt_pk_bf16(v1[2], v1[3]);
                    *(u32x4*)(out + o + bj * HALF) = w; } }
    }
};
struct EpiSwiglu {
    static constexpr bool PERM = true, AFTER_DRAIN = false;
    const float* b1; bf16_t* act;
    __device__ __forceinline__ void operator()(const f32x4 (&acc)[2][2][4][2], const Unit& u, int wr, int wc, int fr, int fq) const {
        const int e = u.pn >> 3, j = u.pn & 7; const int row0 = u.pm * BM + wr * 64 + fr, f0 = 128 * j + wc * 32 + 8 * fq;
        const float* be = b1 + (size_t)e * 2048 + f0;
        const f32x4 bg0 = *(const f32x4*)(be), bg1 = *(const f32x4*)(be + 4), bl0 = *(const f32x4*)(be + 1024), bl1 = *(const f32x4*)(be + 1028);
#pragma unroll
        for (int ai = 0; ai < 2; ++ai)
#pragma unroll
            for (int m = 0; m < 4; ++m) {
                f32x4 g0 = acc[ai][0][m][0] + bg0, g1 = acc[ai][0][m][1] + bg1, l0 = acc[ai][1][m][0] + bl0, l1 = acc[ai][1][m][1] + bl1;
                float r[8];
#pragma unroll
                for (int q = 0; q < 4; ++q) { float gl = fminf(g0[q], 7.0f), li = fminf(fmaxf(l0[q], -7.0f), 7.0f); r[q] = gl * sigm(1.702f * gl) * (li + 1.0f);
                                              gl = fminf(g1[q], 7.0f); li = fminf(fmaxf(l1[q], -7.0f), 7.0f); r[4 + q] = gl * sigm(1.702f * gl) * (li + 1.0f); }
                u32x4 w; w.x = cvt_pk_bf16(r[0], r[1]); w.y = cvt_pk_bf16(r[2], r[3]); w.z = cvt_pk_bf16(r[4], r[5]); w.w = cvt_pk_bf16(r[6], r[7]);
                *(u32x4*)(act + (size_t)(row0 + ai * HALF + m * 16) * 1024 + f0) = w; }
    }
};
struct EpiY {
    static constexpr bool PERM = true, AFTER_DRAIN = false;
    const float* b2; const float* rw; bf16_t* y;
    __device__ __forceinline__ void operator()(const f32x4 (&acc)[2][2][4][2], const Unit& u, int wr, int wc, int fr, int fq) const {
        const int e = u.pn >> 2, j = u.pn & 3; const int row0 = u.pm * BM + wr * 64 + fr, col0 = 256 * j + wc * 32 + 8 * fq;
        const float* be = b2 + (size_t)e * 1024 + col0;
        f32x4 bv[2][2];
#pragma unroll
        for (int bj = 0; bj < 2; ++bj)
#pragma unroll
            for (int n = 0; n < 2; ++n) bv[bj][n] = *(const f32x4*)(be + bj * HALF + 4 * n);
#pragma unroll
        for (int ai = 0; ai < 2; ++ai)
#pragma unroll
            for (int m = 0; m < 4; ++m) { const int row = row0 + ai * HALF + m * 16; const float w_ = rw[row];
#pragma unroll
                for (int bj = 0; bj < 2; ++bj) { const f32x4 v0 = (acc[ai][bj][m][0] + bv[bj][0]) * w_, v1 = (acc[ai][bj][m][1] + bv[bj][1]) * w_;
                    u32x4 w; w.x = cvt_pk_bf16(v0[0], v0[1]); w.y = cvt_pk_bf16(v0[2], v0[3]); w.z = cvt_pk_bf16(v1[0], v1[1]); w.w = cvt_pk_bf16(v1[2], v1[3]);
                    *(u32x4*)(y + (size_t)row * 1024 + col0 + bj * HALF) = w; } }
    }
};


struct EpiSwiglu8 {
    static constexpr bool PERM = true, AFTER_DRAIN = false;
    const float* b1; unsigned char* act; float dq;
    __device__ __forceinline__ void operator()(const f32x4 (&acc)[2][2][4][2], const Unit& u, int wr, int wc, int fr, int fq) const {
        const int e = u.pn >> 3, j = u.pn & 7; const int row0 = u.pm * BM + wr * 64 + fr, f0 = 128 * j + wc * 32 + 8 * fq;
        const float* be = b1 + (size_t)e * 2048 + f0;
        const f32x4 bg0 = *(const f32x4*)(be), bg1 = *(const f32x4*)(be + 4), bl0 = *(const f32x4*)(be + 1024), bl1 = *(const f32x4*)(be + 1028);
#pragma unroll
        for (int ai = 0; ai < 2; ++ai)
#pragma unroll
            for (int m = 0; m < 4; ++m) {
                f32x4 g0 = acc[ai][0][m][0] * dq + bg0, g1 = acc[ai][0][m][1] * dq + bg1, l0 = acc[ai][1][m][0] * dq + bl0, l1 = acc[ai][1][m][1] * dq + bl1;
                float r[8];
#pragma unroll
                for (int q = 0; q < 4; ++q) { float gl = fminf(g0[q], 7.0f), li = fminf(fmaxf(l0[q], -7.0f), 7.0f); r[q] = 4.0f * gl * sigm(1.702f * gl) * (li + 1.0f);
                                              gl = fminf(g1[q], 7.0f); li = fminf(fmaxf(l1[q], -7.0f), 7.0f); r[4 + q] = 4.0f * gl * sigm(1.702f * gl) * (li + 1.0f); }
                u32x2 w; w.x = cvt4_fp8(r[0], r[1], r[2], r[3]); w.y = cvt4_fp8(r[4], r[5], r[6], r[7]);
                *(u32x2*)(act + (size_t)(row0 + ai * HALF + m * 16) * 1024 + f0) = w; }
    }
};
struct EpiY8 {
    static constexpr bool PERM = true, AFTER_DRAIN = false;
    const float* b2; const float* rw; bf16_t* y; float dq;
    __device__ __forceinline__ void operator()(const f32x4 (&acc)[2][2][4][2], const Unit& u, int wr, int wc, int fr, int fq) const {
        const int e = u.pn >> 2, j = u.pn & 3; const int row0 = u.pm * BM + wr * 64 + fr, col0 = 256 * j + wc * 32 + 8 * fq;
        const float* be = b2 + (size_t)e * 1024 + col0;
        f32x4 bv[2][2];
#pragma unroll
        for (int bj = 0; bj < 2; ++bj)
#pragma unroll
            for (int n = 0; n < 2; ++n) bv[bj][n] = *(const f32x4*)(be + bj * HALF + 4 * n);
#pragma unroll
        for (int ai = 0; ai < 2; ++ai)
#pragma unroll
            for (int m = 0; m < 4; ++m) { const int row = row0 + ai * HALF + m * 16; const float w_ = rw[row];
#pragma unroll
                for (int bj = 0; bj < 2; ++bj) { const f32x4 v0 = (acc[ai][bj][m][0] * dq + bv[bj][0]) * w_, v1 = (acc[ai][bj][m][1] * dq + bv[bj][1]) * w_;
                    u32x4 w; w.x = cvt_pk_bf16(v0[0], v0[1]); w.y = cvt_pk_bf16(v0[2], v0[3]); w.z = cvt_pk_bf16(v1[0], v1[1]); w.w = cvt_pk_bf16(v1[2], v1[3]);
                    *(u32x4*)(y + (size_t)row * 1024 + col0 + bj * HALF) = w; } }
    }
};


struct EpiGateFused {
    static constexpr bool PERM = true, AFTER_DRAIN = false, HAS_MID = true;
    const bf16_t* gc; const bf16_t* gh; bf16_t* out;
    __device__ __forceinline__ void mid(f32x4 (&acc)[2][2][4][2], const Unit& u, int wr, int wc, int fr, int fq) const {
        const int row0 = u.pm * BM + wr * 64 + fr, col0 = u.pn * BM + wc * 32 + 8 * fq;
#pragma unroll
        for (int ai = 0; ai < 2; ++ai)
#pragma unroll
            for (int m = 0; m < 4; ++m) { const size_t o = (size_t)(row0 + ai * HALF + m * 16) * 1024 + col0;
#pragma unroll
                for (int bj = 0; bj < 2; ++bj) { const u32x4 a = *(const u32x4*)(gc + o + bj * HALF), b = *(const u32x4*)(gh + o + bj * HALF);
                    const unsigned aw[4] = {a.x, a.y, a.z, a.w}, bw[4] = {b.x, b.y, b.z, b.w};
#pragma unroll
                    for (int q = 0; q < 4; ++q) { const float r0 = (1.0f + __expf(-blo(bw[q]))) * __builtin_amdgcn_rcpf(1.0f + __expf(-blo(aw[q]))), r1 = (1.0f + __expf(-bhi(bw[q]))) * __builtin_amdgcn_rcpf(1.0f + __expf(-bhi(aw[q])));
                        acc[ai][bj][m][q >> 1][(2 * q) & 3] *= r0; acc[ai][bj][m][q >> 1][(2 * q + 1) & 3] *= r1; } } }
    }
    __device__ __forceinline__ void operator()(const f32x4 (&acc)[2][2][4][2], const Unit& u, int wr, int wc, int fr, int fq) const {
        const int row0 = u.pm * BM + wr * 64 + fr, col0 = u.pn * BM + wc * 32 + 8 * fq;
#pragma unroll
        for (int ai = 0; ai < 2; ++ai)
#pragma unroll
            for (int m = 0; m < 4; ++m) { const size_t o = (size_t)(row0 + ai * HALF + m * 16) * 1024 + col0;
#pragma unroll
                for (int bj = 0; bj < 2; ++bj) { const u32x4 g = *(const u32x4*)(gh + o + bj * HALF); f32x4 v0 = acc[ai][bj][m][0], v1 = acc[ai][bj][m][1];
                    v0[0] *= sigm(blo(g.x)); v0[1] *= sigm(bhi(g.x)); v0[2] *= sigm(blo(g.y)); v0[3] *= sigm(bhi(g.y));
                    v1[0] *= sigm(blo(g.z)); v1[1] *= sigm(bhi(g.z)); v1[2] *= sigm(blo(g.w)); v1[3] *= sigm(bhi(g.w));
                    u32x4 w; w.x = cvt_pk_bf16(v0[0], v0[1]); w.y = cvt_pk_bf16(v0[2], v0[3]); w.z = cvt_pk_bf16(v1[0], v1[1]); w.w = cvt_pk_bf16(v1[2], v1[3]);
                    *(u32x4*)(out + o + bj * HALF) = w; } }
    }
};

template <class T, class = void> struct has_mid { static constexpr bool value = false; };
template <class T> struct has_mid<T, decltype((void)T::HAS_MID)> { static constexpr bool value = true; };
template <class Epi, class Sched, bool ALIGN_EPI = false, bool SP2 = false, bool GATHER = false, bool FP8 = false>
__device__ __forceinline__ void gemm_phase(PG8_LAS unsigned char* lds, const Gemm g, const Sched& S, const Epi& E, const int wave_id, const PG8_LAS unsigned short* gtab = nullptr) {
    typedef int i32x4 __attribute__((ext_vector_type(4))); typedef int i32x8 __attribute__((ext_vector_type(8)));
    static_assert(!GATHER || SP2, "GATHER needs the SP2 loop");
    int lane = (int)__builtin_amdgcn_mbcnt_hi(~0u, __builtin_amdgcn_mbcnt_lo(~0u, 0u)); asm volatile("" : "+v"(lane));
    const int wid = wave_id, tid = wid * 64 + lane, wr = wid >> 2, wc = wid & 3, fr = lane & 15, fq = lane >> 4;
    const int K = g.K, nt = K / BK;
    unsigned voffA[2], voffB[2];
#pragma unroll
    for (int i = 0; i < 2; ++i) { int R, C; stage_rc(tid * 16 + i * 8192, R, C); const int Rb = Epi::PERM ? ((R & ~31) + perm32(R & 31)) : R;
        voffA[i] = (unsigned)(R * K + C) * 2u; voffB[i] = (unsigned)(Rb * K + C) * 2u; }
    unsigned vA0[2] = {0u, 0u}, vA1[2] = {0u, 0u}, xA0[2] = {0u, 0u}, xA1[2] = {0u, 0u};
#define PG8_GLOAD(d0, d1, ui_) do { int tz_ = wid * 64 + (int)__builtin_amdgcn_mbcnt_hi(~0u, __builtin_amdgcn_mbcnt_lo(~0u, 0u)); asm volatile("" : "+v"(tz_)); _Pragma("unroll") for (int _i = 0; _i < 2; ++_i) { int R_, C_; stage_rc(tz_ * 16 + _i * 8192, R_, C_); \
        d0[_i] = (unsigned)gtab[256 * (ui_) + R_] * (unsigned)(K * 2) + (unsigned)C_ * 2u; d1[_i] = (unsigned)gtab[256 * (ui_) + 128 + R_] * (unsigned)(K * 2) + (unsigned)C_ * 2u; } } while (0)
    const unsigned kstep = (unsigned)(BK * 2);
    const unsigned hstep = (unsigned)HALF * K * 2;
    const unsigned tstep = 2 * hstep;
    const __amdgpu_buffer_rsrc_t rsA = __builtin_amdgcn_make_buffer_rsrc((void*)g.A, 0, 0x7fffffff, 0x00020000), rsB = __builtin_amdgcn_make_buffer_rsrc((void*)g.Bt, 0, 0x7fffffff, 0x00020000);
    const unsigned ldsw = (unsigned)wid * 1024u;
    const int aoff = lds_byte(wr * 64 + fr, fq * 8), boff = lds_byte(wc * 32 + fr, fq * 8);
#define PG8_SA(b, h) (((b) * 2 + (h)) * HTB)
#define PG8_SB(b, h) ((4 + (b) * 2 + (h)) * HTB)
#define PG8_STAGE(bufoff, rs, soff, voff) do { _Pragma("unroll") for (int _i = 0; _i < 2; ++_i) \
        __builtin_amdgcn_raw_ptr_buffer_load_lds(rs, (PG8_LAS void*)(lds + (bufoff) + ldsw + _i * 8192), 16, (int)(voff)[_i], (int)(soff), 0, 0); } while (0)
#define PG8_LDA(dst, b, h) do { if constexpr (FP8) { _Pragma("unroll") for (int m = 0; m < 4; ++m) dst##_8[m] = __builtin_shufflevector(*(const PG8_LAS i32x4*)(lds + PG8_SA(b, h) + aoff + m * 2048), *(const PG8_LAS i32x4*)(lds + PG8_SA(b, h) + aoff + m * 2048 + 1024), 0, 1, 2, 3, 4, 5, 6, 7); } \
        else { _Pragma("unroll") for (int m = 0; m < 4; ++m) _Pragma("unroll") for (int k = 0; k < 2; ++k) dst[m][k] = *(const PG8_LAS bf16x8*)(lds + PG8_SA(b, h) + aoff + m * 2048 + k * 1024); } } while (0)
#define PG8_LDB(dst, b, h) do { if constexpr (FP8) { _Pragma("unroll") for (int n = 0; n < 2; ++n) dst##_8[n] = __builtin_shufflevector(*(const PG8_LAS i32x4*)(lds + PG8_SB(b, h) + boff + n * 2048), *(const PG8_LAS i32x4*)(lds + PG8_SB(b, h) + boff + n * 2048 + 1024), 0, 1, 2, 3, 4, 5, 6, 7); } \
        else { _Pragma("unroll") for (int n = 0; n < 2; ++n) _Pragma("unroll") for (int k = 0; k < 2; ++k) dst[n][k] = *(const PG8_LAS bf16x8*)(lds + PG8_SB(b, h) + boff + n * 2048 + k * 1024); } } while (0)
#define PG8_MMA(ai, bj, At, Bt) do { __builtin_amdgcn_s_setprio(1); if constexpr (FP8) { _Pragma("unroll") for (int m = 0; m < 4; ++m) _Pragma("unroll") for (int n = 0; n < 2; ++n) \
        asm volatile("v_mfma_scale_f32_16x16x128_f8f6f4 %0, %1, %2, %0, %3, %3 op_sel_hi:[0,0,0]" : "+v"(acc[ai][bj][m][n]) : "v"(Bt##_8[n]), "v"(At##_8[m]), "v"(sc8));     \
        } else { _Pragma("unroll") for (int m = 0; m < 4; ++m) _Pragma("unroll") for (int n = 0; n < 2; ++n) _Pragma("unroll") for (int k = 0; k < 2; ++k) \
        acc[ai][bj][m][n] = __builtin_amdgcn_mfma_f32_16x16x32_bf16(Bt[n][k], At[m][k], acc[ai][bj][m][n], 0, 0, 0); } __builtin_amdgcn_s_setprio(0); } while (0)
#define PG8_WAIT_V(n) asm volatile("s_waitcnt vmcnt(" #n ")" ::: "memory")
#define PG8_WAIT_L(n) asm volatile("s_waitcnt lgkmcnt(" #n ")" ::: "memory")
#define PG8_BAR __builtin_amdgcn_s_barrier()
#define PG8_SCHED __builtin_amdgcn_sched_barrier(0)
    Unit cur, nxt; int ui = 0;
    if (!S.next(0, cur)) return;
    f32x4 acc[2][2][4][2];
#pragma unroll
    for (int a = 0; a < 2; ++a)
#pragma unroll
        for (int b = 0; b < 2; ++b)
#pragma unroll
            for (int m = 0; m < 4; ++m)
#pragma unroll
                for (int n = 0; n < 2; ++n) acc[a][b][m][n] = (f32x4){0.f, 0.f, 0.f, 0.f};
    int sc8 = 0x7f7f7f7f; asm volatile("" : "+v"(sc8));
    bf16x8 At[4][2], B0[2][2], B1[2][2]; i32x8 At_8[4], B0_8[2], B1_8[2];
    unsigned cA = GATHER ? 0u : (unsigned)cur.pm * tstep, cB = (unsigned)cur.pn * tstep;
    S.a_ready(cur);
    if constexpr (GATHER) { PG8_GLOAD(vA0, vA1, 0); xA0[0] = vA0[0]; xA0[1] = vA0[1]; xA1[0] = vA1[0]; xA1[1] = vA1[1]; }
    if constexpr (SP2) {
        PG8_STAGE(PG8_SB(0, 0), rsB, cB, voffB); PG8_STAGE(PG8_SB(0, 1), rsB, cB + hstep, voffB);
        if constexpr (GATHER) { PG8_STAGE(PG8_SA(0, 0), rsA, cA, vA0); PG8_STAGE(PG8_SA(0, 1), rsA, cA, vA1); } else { PG8_STAGE(PG8_SA(0, 0), rsA, cA, voffA); PG8_STAGE(PG8_SA(0, 1), rsA, cA + hstep, voffA); }
        if (wr == 1) PG8_BAR;
        PG8_WAIT_V(2); PG8_BAR;
        PG8_STAGE(PG8_SB(1, 0), rsB, cB + kstep, voffB); if constexpr (GATHER) { PG8_STAGE(PG8_SA(1, 0), rsA, cA + kstep, vA0); } else { PG8_STAGE(PG8_SA(1, 0), rsA, cA + kstep, voffA); } PG8_STAGE(PG8_SB(1, 1), rsB, cB + hstep + kstep, voffB);
        PG8_WAIT_V(6); PG8_BAR;
    } else {
        PG8_STAGE(PG8_SB(0, 0), rsB, cB, voffB); PG8_STAGE(PG8_SA(0, 0), rsA, cA, voffA); PG8_STAGE(PG8_SB(0, 1), rsB, cB + hstep, voffB); PG8_STAGE(PG8_SA(0, 1), rsA, cA + hstep, voffA);
        if (wr == 1) PG8_BAR;
        PG8_WAIT_V(4); PG8_BAR;
        PG8_STAGE(PG8_SB(1, 0), rsB, cB + kstep, voffB); PG8_STAGE(PG8_SA(1, 0), rsA, cA + kstep, voffA); PG8_STAGE(PG8_SB(1, 1), rsB, cB + hstep + kstep, voffB);
        PG8_WAIT_V(6); PG8_BAR;
    }
    for (;;) {
        const bool has_next = S.next(ui + 1, nxt);
        const unsigned nA = GATHER ? cA : (has_next ? (unsigned)nxt.pm * tstep : cA), nB = has_next ? (unsigned)nxt.pn * tstep : cB;
        for (int t = 0; t < nt; t += 2) {
            const bool last = (t == nt - 2);
            const unsigned a1 = cA + (unsigned)(t + 1) * kstep;
            const unsigned a2 = last ? nA : cA + (unsigned)(t + 2) * kstep, b2 = last ? nB : cB + (unsigned)(t + 2) * kstep;
            const unsigned a3 = a2 + kstep, b3 = b2 + kstep;
            if (last && has_next) S.a_ready(nxt);
            if constexpr (has_mid<Epi>::value) { if (t == nt / 2) { int l3_ = (int)__builtin_amdgcn_mbcnt_hi(~0u, __builtin_amdgcn_mbcnt_lo(~0u, 0u)); asm volatile("" : "+v"(l3_)); E.mid(acc, cur, wr, wc, l3_ & 15, l3_ >> 4); } }
            if constexpr (GATHER) { if (last && has_next) { PG8_GLOAD(xA0, xA1, ui + 1); } }
            if constexpr (SP2) {
            PG8_LDB(B0, 0, 0); PG8_LDB(B1, 0, 1); PG8_SCHED; PG8_LDA(At, 0, 0); if constexpr (GATHER) { PG8_STAGE(PG8_SA(1, 1), rsA, a1, vA1); } else { PG8_STAGE(PG8_SA(1, 1), rsA, a1 + hstep, voffA); }
            PG8_WAIT_V(8); PG8_WAIT_L(0); PG8_BAR; PG8_MMA(0, 0, At, B0); PG8_MMA(0, 1, At, B1); PG8_BAR; PG8_SCHED;
            PG8_LDA(At, 0, 1); PG8_STAGE(PG8_SB(0, 0), rsB, b2, voffB); PG8_STAGE(PG8_SB(0, 1), rsB, b2 + hstep, voffB); if constexpr (GATHER) { PG8_STAGE(PG8_SA(0, 0), rsA, a2, xA0); } else { PG8_STAGE(PG8_SA(0, 0), rsA, a2, voffA); }
            PG8_WAIT_V(8); PG8_WAIT_L(0); PG8_BAR; PG8_MMA(1, 0, At, B0); PG8_MMA(1, 1, At, B1); PG8_BAR; PG8_SCHED;
            PG8_LDB(B0, 1, 0); PG8_LDB(B1, 1, 1); PG8_SCHED; PG8_LDA(At, 1, 0); if constexpr (GATHER) { PG8_STAGE(PG8_SA(0, 1), rsA, a2, xA1); } else { PG8_STAGE(PG8_SA(0, 1), rsA, a2 + hstep, voffA); }
            PG8_WAIT_V(8); PG8_WAIT_L(0); PG8_BAR; PG8_MMA(0, 0, At, B0); PG8_MMA(0, 1, At, B1); PG8_BAR; PG8_SCHED;
            PG8_LDA(At, 1, 1); PG8_STAGE(PG8_SB(1, 0), rsB, b3, voffB); PG8_STAGE(PG8_SB(1, 1), rsB, b3 + hstep, voffB); if constexpr (GATHER) { PG8_STAGE(PG8_SA(1, 0), rsA, a3, xA0); } else { PG8_STAGE(PG8_SA(1, 0), rsA, a3, voffA); }
            PG8_WAIT_V(8); PG8_WAIT_L(0); PG8_BAR; PG8_MMA(1, 0, At, B0); PG8_MMA(1, 1, At, B1); PG8_BAR; PG8_SCHED;
            } else {
            PG8_LDB(B0, 0, 0); PG8_SCHED; PG8_LDA(At, 0, 0); PG8_STAGE(PG8_SA(1, 1), rsA, a1 + hstep, voffA);
            PG8_WAIT_L(8); PG8_BAR; PG8_WAIT_L(0); PG8_MMA(0, 0, At, B0); PG8_BAR; PG8_SCHED;
            PG8_LDB(B1, 0, 1); PG8_STAGE(PG8_SB(0, 0), rsB, b2, voffB);
            PG8_BAR; PG8_WAIT_L(0); PG8_MMA(0, 1, At, B1); PG8_BAR;
            PG8_LDA(At, 0, 1); PG8_STAGE(PG8_SA(0, 0), rsA, a2, voffA);
            PG8_BAR; PG8_WAIT_L(0); PG8_MMA(1, 0, At, B0); PG8_BAR; PG8_SCHED;
            PG8_STAGE(PG8_SB(0, 1), rsB, b2 + hstep, voffB);
            PG8_WAIT_V(6); PG8_BAR; PG8_MMA(1, 1, At, B1); PG8_BAR;
            PG8_LDB(B0, 1, 0); PG8_SCHED; PG8_LDA(At, 1, 0); PG8_STAGE(PG8_SA(0, 1), rsA, a2 + hstep, voffA);
            PG8_WAIT_L(8); PG8_BAR; PG8_WAIT_L(0); PG8_MMA(0, 0, At, B0); PG8_BAR; PG8_SCHED;
            PG8_LDB(B1, 1, 1); PG8_STAGE(PG8_SB(1, 0), rsB, b3, voffB);
            PG8_BAR; PG8_WAIT_L(0); PG8_MMA(0, 1, At, B1); PG8_BAR;
            PG8_LDA(At, 1, 1); PG8_STAGE(PG8_SA(1, 0), rsA, a3, voffA);
            PG8_BAR; PG8_WAIT_L(0); PG8_MMA(1, 0, At, B0); PG8_BAR; PG8_SCHED;
            PG8_STAGE(PG8_SB(1, 1), rsB, b3 + hstep, voffB);
            PG8_WAIT_V(6); PG8_BAR; PG8_MMA(1, 1, At, B1); PG8_BAR;
            }
        }
        if constexpr (ALIGN_EPI) { if (wr == 0) PG8_BAR; }
        if constexpr (!Epi::AFTER_DRAIN) { int l2_ = (int)__builtin_amdgcn_mbcnt_hi(~0u, __builtin_amdgcn_mbcnt_lo(~0u, 0u)); asm volatile("" : "+v"(l2_));
            E(acc, cur, wr, wc, l2_ & 15, l2_ >> 4); S.done(cur); }
        if (!has_next) break;
#pragma unroll
        for (int a = 0; a < 2; ++a)
#pragma unroll
            for (int b = 0; b < 2; ++b)
#pragma unroll
                for (int m = 0; m < 4; ++m)
#pragma unroll
                    for (int n = 0; n < 2; ++n) acc[a][b][m][n] = (f32x4){0.f, 0.f, 0.f, 0.f};
        cur = nxt; cA = nA; cB = nB; ++ui;
        if constexpr (GATHER) { vA0[0] = xA0[0]; vA0[1] = xA0[1]; vA1[0] = xA1[0]; vA1[1] = xA1[1]; }
        if constexpr (ALIGN_EPI) { if (wr == 1) PG8_BAR; }
    }
    PG8_WAIT_V(0);
    if constexpr (!ALIGN_EPI) { if (wr == 0) PG8_BAR; }
    PG8_BAR;
    if constexpr (Epi::AFTER_DRAIN) { E.fused(acc, cur, wr, wc, fr, fq, lds, wid, lane); S.done(cur); }
#undef PG8_GLOAD
#undef PG8_SA
#undef PG8_SB
#undef PG8_STAGE
#undef PG8_LDA
#undef PG8_LDB
#undef PG8_MMA
#undef PG8_WAIT_V
#undef PG8_WAIT_L
#undef PG8_BAR
#undef PG8_SCHED
}
}
#define XB_TMO      128
#define XB_XCNT(j)  (256  + 64 * (j))
#define XB_XSUB(j)  (1280 + 64 * (j))
#define XB_XGEN(j)  (2304 + 64 * (j))
#define XB_TOP      3328
#define XB_TOPGEN   3392
#define XCD_BAR_WORDS 3456
#define XB_SPIN_CAP (1u << 18)

__device__ __forceinline__ unsigned xb_ld(unsigned* p)              { return __hip_atomic_load(p, __ATOMIC_RELAXED, __HIP_MEMORY_SCOPE_AGENT); }
__device__ __forceinline__ unsigned xb_add(unsigned* p, unsigned v) { return __hip_atomic_fetch_add(p, v, __ATOMIC_RELAXED, __HIP_MEMORY_SCOPE_AGENT); }
__device__ __forceinline__ unsigned xb_xcc_id() { return (unsigned)__builtin_amdgcn_s_getreg((3 << 11) | 20) & 0xFu; }
#define XB_SPIN(cond, bar) do { unsigned _sp = 0; while (cond) { __builtin_amdgcn_s_sleep(1); \
    if ((++_sp & 255u) == 0u) { if (xb_ld(&(bar)[XB_TMO])) break; if (_sp > XB_SPIN_CAP) { atomicAdd(&(bar)[XB_TMO], 1u); break; } } } } while (0)

struct XcdBarrier {
    unsigned* bar; unsigned x;
    volatile LAS unsigned* st;
};

__device__ __forceinline__ XcdBarrier xcd_barrier_post(unsigned* bar, volatile LAS unsigned* st, const bool leader  ) {
    XcdBarrier b; b.bar = bar; b.x = xb_xcc_id(); b.st = st;
    if (leader) (void)xb_add(&bar[XB_XCNT(b.x)], 1u);
    return b;
}
__device__ __forceinline__ void xcd_barrier_complete(unsigned* bar, unsigned x, unsigned& nloc, unsigned& nx) {
    const unsigned G = gridDim.x * gridDim.y * gridDim.z;
    unsigned sum, cnt, mine, sp = 0u;
    for (;;) {
        sum = 0u; cnt = 0u; mine = 0u;
#pragma unroll
        for (unsigned j = 0; j < 16; ++j) { const unsigned c = xb_ld(&bar[XB_XCNT(j)]); sum += c; cnt += (c > 0u) ? 1u : 0u; mine = (j == x) ? c : mine; }
        if (sum == G) break;
        __builtin_amdgcn_s_sleep(1);
        if ((++sp & 255u) == 0u) { if (xb_ld(&bar[XB_TMO])) break; if (sp > XB_SPIN_CAP) { atomicAdd(&bar[XB_TMO], 1u); break; } }
    }
    nloc = mine > 0u ? mine : 1u; nx = cnt > 0u ? cnt : 1u;
}

__device__ __forceinline__ void xcd_barrier(const XcdBarrier& b, const bool leader  ) {
    asm volatile("s_waitcnt vmcnt(0)" ::: "memory");
    __syncthreads();
    if (leader) {
        unsigned* bar = b.bar;
        __builtin_amdgcn_s_waitcnt(0);
        unsigned nloc = b.st[0], nx = b.st[1];
        if (nloc == 0u) { xcd_barrier_complete(bar, b.x, nloc, nx); b.st[0] = nloc; b.st[1] = nx; }
        const unsigned old = xb_add(&bar[XB_XSUB(b.x)], 1u);
        const unsigned gen = old / nloc;
        if (old + 1u == (gen + 1u) * nloc) {
            __builtin_amdgcn_fence(__ATOMIC_RELEASE, "agent");
            asm volatile("s_waitcnt vmcnt(0)" ::: "memory");
            const unsigned og = xb_add(&bar[XB_TOP], 1u);
            const unsigned tg = og / nx;
            if (og + 1u == (tg + 1u) * nx) xb_add(&bar[XB_TOPGEN], 1u);
            else XB_SPIN(xb_ld(&bar[XB_TOPGEN]) == tg, bar);
            __builtin_amdgcn_fence(__ATOMIC_ACQUIRE, "agent");
            xb_add(&bar[XB_XGEN(b.x)], 1u);
            asm volatile("s_waitcnt vmcnt(0)" ::: "memory");
        } else {
            XB_SPIN(xb_ld(&bar[XB_XGEN(b.x)]) == gen, bar);
            __builtin_amdgcn_fence(__ATOMIC_ACQUIRE, "agent");
            asm volatile("s_waitcnt vmcnt(0)" ::: "memory");
        }
    }
    __syncthreads();
}

#ifndef P_FP8_MASK
#define P_FP8_MASK 0xFFFFFFFFu
#endif =======================================================
struct Ctx { LAS unsigned char* lds; int tid, lane, wave, vcu, G; };

__device__ __forceinline__ void transpose_load64(const float* W, int ldw, int k0, int n0, LAS float* scr, int lane) {
#pragma unroll 8
    for (int i = 0; i < 16; ++i) { const int kk = 4 * i + (lane >> 4), nn = 4 * (lane & 15); const f32x4 v = *(const f32x4*)(W + (size_t)(k0 + kk) * ldw + n0 + nn);
        LAS float* d = scr + kk * 65 + nn; d[0] = v.x; d[1] = v.y; d[2] = v.z; d[3] = v.w; }
    LDS_WAIT();
}
__device__ __forceinline__ void transpose_item(const float* W, int ldw, int K, bf16_t* dst, int k0, int n0, LAS float* scr, int lane) {
    transpose_load64(W, ldw, k0, n0, scr, lane);
    const int c = lane & 7;
#pragma unroll
    for (int j = 0; j < 8; ++j) { const int n = (lane >> 3) + 8 * j; const LAS float* s = scr + (8 * c) * 65 + n;
        u32x4 o; o.x = pk2(s[0 * 65], s[1 * 65]); o.y = pk2(s[2 * 65], s[3 * 65]); o.z = pk2(s[4 * 65], s[5 * 65]); o.w = pk2(s[6 * 65], s[7 * 65]);
        *(u32x4*)(dst + (size_t)n * K + k0 + 8 * c) = o; }
    LDS_WAIT();
}
__device__ __forceinline__ void transpose_item8(const float* W, int ldw, int K, unsigned char* dst, int k0, int n0, float scale, LAS float* scr, int lane) {
    transpose_load64(W, ldw, k0, n0, scr, lane);
    const int c = lane & 3;
#pragma unroll
    for (int j = 0; j < 4; ++j) { const int n = (lane >> 2) + 16 * j; const LAS float* s = scr + (16 * c) * 65 + n;
        u32x4 o; o.x = cvt4_fp8(s[0 * 65] * scale, s[1 * 65] * scale, s[2 * 65] * scale, s[3 * 65] * scale); o.y = cvt4_fp8(s[4 * 65] * scale, s[5 * 65] * scale, s[6 * 65] * scale, s[7 * 65] * scale);
        o.z = cvt4_fp8(s[8 * 65] * scale, s[9 * 65] * scale, s[10 * 65] * scale, s[11 * 65] * scale); o.w = cvt4_fp8(s[12 * 65] * scale, s[13 * 65] * scale, s[14 * 65] * scale, s[15 * 65] * scale);
        *(u32x4*)(dst + (size_t)n * K + k0 + 16 * c) = o; }
    LDS_WAIT();
}

template <int PART>
__device__ __forceinline__ void ph_prologue(const Ctx& X, const float* c, const float* w_ada, const float* b_ada, float* mod,
                                            const float* w_in, const float* w_conv_out, const float* w_hgrn_out, const float* w_out, const float* w1, const float* w2, unsigned char* ws) {
    if (PART == 0 && X.vcu < 48) {
        LAS float* ca = (LAS float*)X.lds;
        LAS float* red = (LAS float*)(X.lds + 16384);
        for (int i = X.tid; i < 4096; i += 512) { const float v = c[i]; ca[i] = v * sigmoidf_(v); }
        __syncthreads();
        const int jj = X.tid & 127, kq = X.tid >> 7, j = X.vcu * 128 + jj;
        float a0 = 0.f, a1 = 0.f, a2 = 0.f, a3 = 0.f;
#pragma unroll 8
        for (int i = kq * 256; i < kq * 256 + 256; ++i) { const float w = w_ada[(size_t)i * NMOD + j]; a0 += ca[i] * w; a1 += ca[1024 + i] * w; a2 += ca[2048 + i] * w; a3 += ca[3072 + i] * w; }
        red[(kq * 4 + 0) * 128 + jj] = a0; red[(kq * 4 + 1) * 128 + jj] = a1; red[(kq * 4 + 2) * 128 + jj] = a2; red[(kq * 4 + 3) * 128 + jj] = a3;
        __syncthreads();
        { const int b = X.tid >> 7; mod[(size_t)b * NMOD + j] = b_ada[j] + red[(0 * 4 + b) * 128 + jj] + red[(1 * 4 + b) * 128 + jj] + red[(2 * 4 + b) * 128 + jj] + red[(3 * 4 + b) * 128 + jj]; }
        __syncthreads();
    }
    LAS float* scr = (LAS float*)(X.lds + X.wave * 16640);
    const int gw = X.vcu * 8 + X.wave, NGW = X.G * 8;
    constexpr int I_IN = 16 * 128, I_SQ = 16 * 16, I_W1 = 32 * 16 * 32, I_W2 = 32 * 16 * 16, NITEMS = I_IN + 3 * I_SQ + I_W1 + I_W2;
    constexpr int I_DENSE = I_IN + 3 * I_SQ;
    for (int it = (PART == 0 ? 0 : I_DENSE) + gw; it < (PART == 0 ? I_DENSE : NITEMS); it += NGW) {
        int r = it;
        if (r < I_IN) { const int kb = r >> 7, nb = r & 127, n0 = 64 * nb;
            const int rho0 = (n0 < 2048) ? 256 * ((n0 & 1023) >> 7) + 128 * (n0 >> 10) + (n0 & 127) : n0;
            if ((P_FP8_MASK >> (rho0 >> 8)) & 1u) transpose_item8(w_in, 8192, 1024, (unsigned char*)(ws + WS_WIN8) + (size_t)rho0 * 1024, 64 * kb, n0, 256.0f, scr, X.lane);
            else transpose_item(w_in, 8192, 1024, (bf16_t*)(ws + WS_WIN) + (size_t)rho0 * 1024, 64 * kb, n0, scr, X.lane);
            continue; } r -= I_IN;
        if (r < 3 * I_SQ) { const int which = r / I_SQ, q = r % I_SQ, kb = q >> 4, nb = q & 15;
            const float* W = which == 0 ? w_conv_out : (which == 1 ? w_hgrn_out : w_out);
            if (which == 2) transpose_item(W, 1024, 1024, (bf16_t*)(ws + WS_WO) + (size_t)(64 * nb) * 1024, 64 * kb, 64 * nb, scr, X.lane);
            else transpose_item(W, 1024, 2048, (bf16_t*)(ws + WS_WC) + (size_t)(64 * nb) * 2048 + which * 1024, 64 * kb, 64 * nb, scr, X.lane);
            continue; } r -= 3 * I_SQ;
        if (r < I_W1) { const int e = r >> 9, q = r & 511, kb = q >> 5, nb = q & 31, n0 = 64 * nb;
            const int rho0 = (n0 < 1024) ? 256 * (n0 >> 7) + (n0 & 127) : 256 * ((n0 - 1024) >> 7) + 128 + ((n0 - 1024) & 127);
            transpose_item8(w1 + (size_t)e * 1024 * 2048, 2048, 1024, (unsigned char*)(ws + WS_W1) + ((size_t)e * 2048 + rho0) * 1024, 64 * kb, n0, 256.0f, scr, X.lane); continue; } r -= I_W1;
        { const int e = r >> 8, q = r & 255, kb = q >> 4, nb = q & 15;
            transpose_item8(w2 + (size_t)e * 1024 * 1024, 1024, 1024, (unsigned char*)(ws + WS_W2) + ((size_t)e * 1024 + 64 * nb) * 1024, 64 * kb, 64 * nb, 256.0f, scr, X.lane); }
    }
    __syncthreads();
}

__device__ __forceinline__ void ph_norm_mod(const Ctx& X, const float* x, const float* g, const float* mod, int sh_off, int sc_off, bf16_t* out, unsigned char* out8) {
    for (int t = X.vcu * 8 + X.wave; t < T; t += X.G * 8) {
        const int b = t / SEQ, lane = X.lane;
        const f32x4* xr = (const f32x4*)(x + (size_t)t * D) + lane;
        f32x4 v[4]; float ss = 0.f;
#pragma unroll
        for (int j = 0; j < 4; ++j) { v[j] = xr[64 * j]; ss += (v[j].x * v[j].x + v[j].y * v[j].y) + (v[j].z * v[j].z + v[j].w * v[j].w); }
        const float r = rsqrtf(wave_sum(ss) * (1.0f / D) + EPS);
        const float* sh = mod + (size_t)b * NMOD + sh_off; const float* sc = mod + (size_t)b * NMOD + sc_off;
#pragma unroll
        for (int j = 0; j < 4; ++j) {
            const int col = 4 * (lane + 64 * j);
            const f32x4 gg = *(const f32x4*)(g + col), s1 = *(const f32x4*)(sc + col), s0 = *(const f32x4*)(sh + col);
            const f32x4 y = v[j] * r * gg * (s1 + 1.0f) + s0;
            if (P_FP8_MASK != 0xFFFFFFFFu) { u32x2 w; w.x = pk2(y.x, y.y); w.y = pk2(y.z, y.w); *(u32x2*)(out + (size_t)t * D + col) = w; }
            if (P_FP8_MASK != 0u) *(unsigned*)(out8 + (size_t)t * D + col) = cvt4_fp8(y.x * 16.0f, y.y * 16.0f, y.z * 16.0f, y.w * 16.0f);
        }
    }
}

__device__ __forceinline__ void ph_conv(const Ctx& X, const bf16_t* pU, const float* dw, const float* dwb, const float* lng, const float* lnb, bf16_t* uc) {
    LAS float* sm = (LAS float*)X.lds;
    const int tid = X.tid, lane = X.lane, wid = X.wave, c0 = 2 * tid;
    float w[31][2];
#pragma unroll
    for (int j = 0; j < 31; ++j) { w[j][0] = dw[j * 1024 + c0]; w[j][1] = dw[j * 1024 + c0 + 1]; }
    const float bias0 = dwb[c0], bias1 = dwb[c0 + 1];
    for (int task = X.vcu; task < T / 32; task += X.G) {
        const int b = task >> 8, s0 = (task & 255) * 32;
        const bf16_t* qu = pU + (size_t)(b * SEQ) * D + c0;
        float u[38][2];
#pragma unroll
        for (int st = 0; st < 4; ++st) {
#pragma unroll
            for (int i = (st == 0 ? 0 : 8 * st + 30); i < 8 * st + 38; ++i) {
                const int s = s0 - 30 + i;
                float u0 = 0.f, u1 = 0.f;
                if (s >= 0) { const unsigned u2 = *(const unsigned*)(qu + (size_t)s * D); u0 = bflo(u2); u1 = bfhi(u2); }
                u[i % 38][0] = u0; u[i % 38][1] = u1;
            }
#pragma unroll
            for (int t = 8 * st; t < 8 * st + 8; ++t) {
                float a0 = bias0, a1 = bias1;
#pragma unroll
                for (int j = 0; j < 31; ++j) { a0 += w[j][0] * u[(t + j) % 38][0]; a1 += w[j][1] * u[(t + j) % 38][1]; }
                sm[t * 1024 + c0] = a0; sm[t * 1024 + c0 + 1] = a1;
            }
        }
        __syncthreads();
#pragma unroll 1
        for (int i = 0; i < 4; ++i) {
            const int t = wid * 4 + i;
            f32x4 v[4]; float s = 0.f;
#pragma unroll
            for (int j = 0; j < 4; ++j) { v[j] = *(const LAS f32x4*)(sm + t * 1024 + 4 * (lane + 64 * j)); s += (v[j].x + v[j].y) + (v[j].z + v[j].w); }
            const float mean = wave_sum(s) * (1.0f / D); float q = 0.f;
#pragma unroll
            for (int j = 0; j < 4; ++j) { v[j] = v[j] - mean; q += (v[j].x * v[j].x + v[j].y * v[j].y) + (v[j].z * v[j].z + v[j].w * v[j].w); }
            const float rstd = rsqrtf(wave_sum(q) * (1.0f / D) + EPS);
#pragma unroll
            for (int j = 0; j < 4; ++j) {
                const int col = 4 * (lane + 64 * j);
                const f32x4 gg = *(const f32x4*)(lng + col), bb = *(const f32x4*)(lnb + col);
                f32x4 y = v[j] * rstd * gg + bb;
                y.x *= sigmoidf_(y.x); y.y *= sigmoidf_(y.y); y.z *= sigmoidf_(y.z); y.w *= sigmoidf_(y.w);
                u32x2 o; o.x = pk2(y.x, y.y); o.y = pk2(y.z, y.w);
                *(u32x2*)(uc + (size_t)(b * SEQ + s0 + t) * (2 * D) + col) = o;
            }
        }
        __syncthreads();
    }
}

typedef short bf16x8 __attribute__((ext_vector_type(8)));
typedef short s16x4 __attribute__((ext_vector_type(4)));
typedef float f32x2 __attribute__((ext_vector_type(2)));
constexpr int HG_QA = 0, HG_KA = 17408, HG_VR = 34816, HG_AB = 52224, HG_SPT = 61440, HG_O = 96256, HG_SEG = 130048;
constexpr size_t HM = (size_t)SEQ * 128;
__device__ __forceinline__ bf16x8 tr_frag(LAS unsigned char* base, int rs, int ks, int c16, int lane) {
    const int g = lane >> 4, q = (lane & 15) >> 2, p = lane & 3;
    LAS unsigned char* a = base + (32 * ks + 8 * g + q) * rs + (16 * c16 + 4 * p) * 2;
    const s16x4 lo = __builtin_amdgcn_ds_read_tr16_b64_v4i16((LAS s16x4*)a);
    const s16x4 hi = __builtin_amdgcn_ds_read_tr16_b64_v4i16((LAS s16x4*)(a + 4 * rs));
    return __builtin_shufflevector(lo, hi, 0, 1, 2, 3, 4, 5, 6, 7);
}
template <bool OUT>
__device__ __forceinline__ void ph_hgrn(const Ctx& X, int ntask, const bf16_t* pQ, const bf16_t* pF, const bf16_t* pI, const bf16_t* pG,
                                        const float* lb_param, const float* norm_g, const float* S0, float* dS, float* Dd, bf16_t* og) {
    LAS unsigned char* L = X.lds;
    LAS float* seg_s = (LAS float*)(L + HG_SEG);
    const int tid = X.tid, lane = X.lane, wave = X.wave, fr = lane & 15, fq = lane >> 4, wr = wave >> 1, wc = wave & 1;
    const int cp = tid & 63, seg = wave, tv = tid >> 3, vc = tid & 7;
    int idx = X.vcu; if (idx >= ntask) return;
    int ch = 0;
    unsigned zr[8], qr[8]; u32x4 vr0, vr1, gn0, gn1, gc0, gc1;
#define HG_LOAD(idx_, ch_) do { const int bh_ = (idx_) & 31, sc_ = (idx_) >> 5; const size_t tb_ = (size_t)bh_ * HM + (size_t)(sc_ * 256 + (ch_) * 64) * 128; \
        _Pragma("unroll") for (int i = 0; i < 8; ++i) { zr[i] = *(const unsigned*)(pF + tb_ + (size_t)(8 * seg + i) * 128 + 2 * cp); if (OUT) qr[i] = *(const unsigned*)(pQ + tb_ + (size_t)(8 * seg + i) * 128 + 2 * cp); } \
        { const u32x4* s_ = (const u32x4*)(pI + tb_ + (size_t)tv * 128 + vc * 16); vr0 = s_[0]; vr1 = s_[1]; } \
        if (OUT) { const u32x4* s_ = (const u32x4*)(pG + tb_ + (size_t)tv * 128 + vc * 16); gn0 = s_[0]; gn1 = s_[1]; } } while (0)
    HG_LOAD(idx, 0);
    float ngv[16];
    if (OUT) {
#pragma unroll
        for (int i = 0; i < 16; ++i) ngv[i] = norm_g[vc * 16 + i];
    }
    f32x4 S[8]; float oml0 = 0.f, oml1 = 0.f, gsum0 = 0.f, gsum1 = 0.f;
#pragma unroll 1
    for (;;) {
        const int sc = idx >> 5, bh = idx & 31, b = bh >> 3, h = bh & 7;
        if (ch == 0) {
            const int c0 = h * 128 + 2 * cp;
            oml0 = 1.0f - 1.0f / (1.0f + __expf(lb_param[1024 + c0] - lb_param[c0])); oml1 = 1.0f - 1.0f / (1.0f + __expf(lb_param[1025 + c0] - lb_param[c0 + 1]));
            gsum0 = 0.f; gsum1 = 0.f;
            if (OUT && sc > 0) { const float* s0 = S0 + (size_t)(bh * 32 + sc) * 16384;
#pragma unroll
                for (int vt = 0; vt < 8; ++vt)
#pragma unroll
                    for (int j = 0; j < 4; ++j) S[vt][j] = s0[(size_t)(16 * wave + fq * 4 + j) * 128 + vt * 16 + fr];
            } else {
#pragma unroll
                for (int vt = 0; vt < 8; ++vt) S[vt] = (f32x4){0.f, 0.f, 0.f, 0.f};
            }
        }
        float kk0[8], kk1[8], lf0[8], lf1[8], q0[8], q1[8];
        {
            float c0 = 0.f, c1 = 0.f;
#pragma unroll
            for (int i = 0; i < 8; ++i) {
                kk0[i] = oml0 * __builtin_amdgcn_rcpf(1.0f + __expf(bflo(zr[i]))); kk1[i] = oml1 * __builtin_amdgcn_rcpf(1.0f + __expf(bfhi(zr[i])));
                c0 += __logf(1.0f - kk0[i]); c1 += __logf(1.0f - kk1[i]); lf0[i] = c0; lf1[i] = c1;
                if (OUT) { q0[i] = bflo(qr[i]) * 0.08838834764831845f; q1[i] = bfhi(qr[i]) * 0.08838834764831845f; }
            }
            *(LAS f32x2*)(seg_s + seg * 128 + 2 * cp) = (f32x2){c0, c1};
        }
        if (OUT) { gc0 = gn0; gc1 = gn1; }
        const u32x4 vcur0 = vr0, vcur1 = vr1;
        __syncthreads();
        { LAS u32x4* d = (LAS u32x4*)(L + HG_VR + tv * 272 + vc * 32); d[0] = vcur0; d[1] = vcur1; }
        { int idx2 = idx, ch2 = ch + 1; if (ch2 == 4) { ch2 = 0; idx2 = idx + X.G; } if (idx2 < ntask) HG_LOAD(idx2, ch2); }
        {
            f32x2 ss[8];
#pragma unroll
            for (int s = 0; s < 8; ++s) ss[s] = *(const LAS f32x2*)(seg_s + s * 128 + 2 * cp);
            float off0 = 0.f, off1 = 0.f;
#pragma unroll
            for (int s = 0; s < 8; ++s) { off0 += (s < seg) ? ss[s].x : 0.f; off1 += (s < seg) ? ss[s].y : 0.f; }
            const float R0 = (ss[0].x + ss[1].x) + (ss[2].x + ss[3].x), R1 = (ss[0].y + ss[1].y) + (ss[2].y + ss[3].y);
            if (!OUT && seg == 0) { gsum0 += R0 + (ss[4].x + ss[5].x) + (ss[6].x + ss[7].x); gsum1 += R1 + (ss[4].y + ss[5].y) + (ss[6].y + ss[7].y); }
#pragma unroll
            for (int i = 0; i < 8; ++i) {
                const float G0 = off0 + lf0[i], G1 = off1 + lf1[i];
                const float ka0 = kk0[i] * __expf(fminf(R0 - G0, 80.0f)), ka1 = kk1[i] * __expf(fminf(R1 - G1, 80.0f));
                *(LAS unsigned*)(L + HG_KA + (8 * seg + i) * 272 + 4 * cp) = pk2(ka0, ka1);
                if (OUT) { const float qa0 = q0[i] * __expf(fminf(G0 - R0, 80.0f)), qa1 = q1[i] * __expf(fminf(G1 - R1, 80.0f));
                           *(LAS unsigned*)(L + HG_QA + (8 * seg + i) * 272 + 4 * cp) = pk2(qa0, qa1); }
            }
        }
        float eR[4], eL[4];
        {
            f32x4 r4 = (f32x4){0.f, 0.f, 0.f, 0.f}, l4 = (f32x4){0.f, 0.f, 0.f, 0.f};
#pragma unroll
            for (int s = 0; s < 4; ++s) { r4 += *(const LAS f32x4*)(seg_s + s * 128 + 16 * wave + 4 * fq); l4 += *(const LAS f32x4*)(seg_s + (s + 4) * 128 + 16 * wave + 4 * fq); }
#pragma unroll
            for (int j = 0; j < 4; ++j) { eR[j] = __expf(fmaxf(r4[j], -80.0f)); eL[j] = __expf(l4[j]); }
        }
#pragma unroll
        for (int vt = 0; vt < 8; ++vt) {
#pragma unroll
            for (int j = 0; j < 4; ++j) S[vt][j] *= eR[j];
            if (OUT) { u32x2 w; w.x = pk2(S[vt][0], S[vt][1]); w.y = pk2(S[vt][2], S[vt][3]);
                       *(LAS u32x2*)(L + HG_SPT + (vt * 16 + fr) * 272 + (16 * wave + 4 * fq) * 2) = w; }
        }
        __syncthreads();
        if (OUT) {
#pragma unroll
            for (int q2 = 0; q2 < 2; ++q2) {
                const int st = 2 * wc + q2;
                f32x4 acc = (f32x4){0.f, 0.f, 0.f, 0.f};
                if (st <= wr) {
#pragma unroll
                    for (int kq = 0; kq < 4; ++kq) {
                        const bf16x8 af = *(const LAS bf16x8*)(L + HG_KA + (st * 16 + fr) * 272 + kq * 64 + fq * 16);
                        const bf16x8 bq = *(const LAS bf16x8*)(L + HG_QA + (wr * 16 + fr) * 272 + kq * 64 + fq * 16);
                        acc = __builtin_amdgcn_mfma_f32_16x16x32_bf16(af, bq, acc, 0, 0, 0);
                    }
                    const int tt = wr * 16 + fr;
#pragma unroll
                    for (int j = 0; j < 4; ++j) { const int s_ = st * 16 + fq * 4 + j; acc[j] = (s_ <= tt) ? acc[j] : 0.f; }
                }
                u32x2 w; w.x = pk2(acc[0], acc[1]); w.y = pk2(acc[2], acc[3]);
                *(LAS u32x2*)(L + HG_AB + (wr * 16 + fr) * 144 + (st * 16 + fq * 4) * 2) = w;
            }
        }
        {
            bf16x8 aK[2];
#pragma unroll
            for (int ks = 0; ks < 2; ++ks) aK[ks] = tr_frag(L + HG_KA, 272, ks, wave, lane);
#pragma unroll
            for (int vt = 0; vt < 8; ++vt) {
#pragma unroll
                for (int ks = 0; ks < 2; ++ks) { const bf16x8 bv = tr_frag(L + HG_VR, 272, ks, vt, lane); S[vt] = __builtin_amdgcn_mfma_f32_16x16x32_bf16(aK[ks], bv, S[vt], 0, 0, 0); }
#pragma unroll
                for (int j = 0; j < 4; ++j) S[vt][j] *= eL[j];
            }
        }
        if (OUT) {
            __syncthreads();
            bf16x8 aA[2], aQ[4];
#pragma unroll
            for (int ks = 0; ks < 2; ++ks) aA[ks] = *(const LAS bf16x8*)(L + HG_AB + (wr * 16 + fr) * 144 + ks * 64 + fq * 16);
#pragma unroll
            for (int kq = 0; kq < 4; ++kq) aQ[kq] = *(const LAS bf16x8*)(L + HG_QA + (wr * 16 + fr) * 272 + kq * 64 + fq * 16);
#pragma unroll
            for (int n = 0; n < 4; ++n) {
                const int vt = wc * 4 + n;
                f32x4 o = (f32x4){0.f, 0.f, 0.f, 0.f};
#pragma unroll
                for (int ks = 0; ks < 2; ++ks) { const bf16x8 bv = tr_frag(L + HG_VR, 272, ks, vt, lane); o = __builtin_amdgcn_mfma_f32_16x16x32_bf16(aA[ks], bv, o, 0, 0, 0); }
#pragma unroll
                for (int kq = 0; kq < 4; ++kq) { const bf16x8 bs = *(const LAS bf16x8*)(L + HG_SPT + (vt * 16 + fr) * 272 + kq * 64 + fq * 16); o = __builtin_amdgcn_mfma_f32_16x16x32_bf16(aQ[kq], bs, o, 0, 0, 0); }
#pragma unroll
                for (int j = 0; j < 4; ++j) *(LAS float*)(L + HG_O + (wr * 16 + fq * 4 + j) * 528 + (vt * 16 + fr) * 4) = o[j];
            }
            __syncthreads();
            {
                f32x4 ov[4]; float ssq = 0.f;
#pragma unroll
                for (int i = 0; i < 4; ++i) { ov[i] = *(const LAS f32x4*)(L + HG_O + tv * 528 + vc * 64 + i * 16); ssq += (ov[i].x * ov[i].x + ov[i].y * ov[i].y) + (ov[i].z * ov[i].z + ov[i].w * ov[i].w); }
                ssq += __shfl_xor(ssq, 1); ssq += __shfl_xor(ssq, 2); ssq += __shfl_xor(ssq, 4);
                const float rstd = rsqrtf(ssq * (1.0f / 128.0f) + EPS);
                const unsigned gw[8] = {gc0.x, gc0.y, gc0.z, gc0.w, gc1.x, gc1.y, gc1.z, gc1.w};
                unsigned ow[8];
#pragma unroll
                for (int i = 0; i < 8; ++i) { const float g0 = bflo(gw[i]), g1 = bfhi(gw[i]);
                    const float y0 = ov[i >> 1][(2 * i) & 3] * rstd * ngv[2 * i] * g0 * __builtin_amdgcn_rcpf(1.0f + __expf(-g0));
                    const float y1 = ov[i >> 1][(2 * i + 1) & 3] * rstd * ngv[2 * i + 1] * g1 * __builtin_amdgcn_rcpf(1.0f + __expf(-g1));
                    ow[i] = pk2(y0, y1); }
                u32x4* d = (u32x4*)(og + (size_t)(b * SEQ + sc * 256 + ch * 64 + tv) * (2 * D) + h * 128 + vc * 16);
                d[0] = (u32x4){ow[0], ow[1], ow[2], ow[3]}; d[1] = (u32x4){ow[4], ow[5], ow[6], ow[7]};
            }
        }
        if (ch == 3) {
            if (!OUT) {
                float* ds = dS + (size_t)(bh * 32 + sc) * 16384;
#pragma unroll
                for (int vt = 0; vt < 8; ++vt)
#pragma unroll
                    for (int j = 0; j < 4; ++j) ds[(size_t)(16 * wave + fq * 4 + j) * 128 + vt * 16 + fr] = S[vt][j];
                if (seg == 0) *(f32x2*)(Dd + (size_t)(bh * 32 + sc) * 128 + 2 * cp) = (f32x2){__expf(gsum0), __expf(gsum1)};
            }
            idx += X.G; ch = 0; if (idx >= ntask) break;
        } else ++ch;
    }
#undef HG_LOAD
    __syncthreads();
}

__device__ __forceinline__ void ph_hg2(const Ctx& X, const float* dS, const float* Dd, float* S0) {
    for (int idx = X.vcu * 512 + X.tid; idx < 32 * 4096; idx += X.G * 512) {
        const int bh = idx >> 12, e4 = idx & 4095, k = e4 >> 5, v4 = (e4 & 31) * 4;
        f32x4 s = (f32x4){0.f, 0.f, 0.f, 0.f};
#pragma unroll 4
        for (int sc = 0; sc < 31; ++sc) { const float d = Dd[(size_t)(bh * 32 + sc) * 128 + k]; const f32x4 ds = *(const f32x4*)(dS + (size_t)(bh * 32 + sc) * 16384 + k * 128 + v4);
            s = s * d + ds; *(f32x4*)(S0 + (size_t)(bh * 32 + sc + 1) * 16384 + k * 128 + v4) = s; }
    }
}

__device__ __forceinline__ void ph_router_tables(const Ctx& X, const float* g_ffn, const float* mod, const float* w_router, const float* b_router, float* Bp, float* cb) {
    for (int i = X.vcu * 512 + X.tid; i < 4 * 1024 * 32; i += X.G * 512) { const int b = i >> 15, k = (i >> 5) & 1023;
        Bp[i] = g_ffn[k] * (1.0f + mod[(size_t)b * NMOD + 4 * D + k]) * w_router[i & 32767]; }
    const int gw = X.vcu * 8 + X.wave;
    if (gw < 128) { const int b = gw >> 5, e = gw & 31; float a = 0.f;
        for (int k = X.lane; k < 1024; k += 64) a += mod[(size_t)b * NMOD + 3 * D + k] * w_router[k * 32 + e];
        a = wave_sum(a); if (X.lane == 0) cb[gw] = a + b_router[e]; }
}

__device__ __forceinline__ void ph_route(const Ctx& X, const bf16_t* x1, const float* g_ffn, const float* mod, const float* Bp, const float* cb,
                                         unsigned char* h2, int* top_e, float* top_w, int* rank, int* hist_g) {
    LAS int* hist = (LAS int*)(X.lds + LDSCTL_OFF + 64);
    const int tid = X.tid, lane = X.lane, c = lane & 15, q = lane >> 4;
    for (int tile = X.vcu; tile < RT_NT; tile += X.G) {
        if (tid < 32) hist[tid] = 0;
        __syncthreads();
        const int tw = tile * RT_TILE + X.wave * 16, b = tw / SEQ;
        const bf16_t* xa = x1 + (size_t)(tw + c) * D + 4 * q;
        const float* bp = Bp + ((size_t)b * 1024 + 4 * q) * 32 + c;
        f32x4 acc0 = (f32x4){0.f, 0.f, 0.f, 0.f}, acc1 = acc0; float ss = 0.f;
#pragma unroll 4
        for (int m = 0; m < 64; ++m) {
            const u32x2 a2_ = *(const u32x2*)(xa + 16 * m); const f32x4 a4 = (f32x4){bflo(a2_.x), bfhi(a2_.x), bflo(a2_.y), bfhi(a2_.y)};
            float bv[8];
#pragma unroll
            for (int j = 0; j < 4; ++j) { bv[2 * j] = bp[(size_t)(16 * m + j) * 32]; bv[2 * j + 1] = bp[(size_t)(16 * m + j) * 32 + 16]; }
            ss += (a4.x * a4.x + a4.y * a4.y) + (a4.z * a4.z + a4.w * a4.w);
#pragma unroll
            for (int j = 0; j < 4; ++j) { acc0 = __builtin_amdgcn_mfma_f32_16x16x4f32(a4[j], bv[2 * j], acc0, 0, 0, 0); acc1 = __builtin_amdgcn_mfma_f32_16x16x4f32(a4[j], bv[2 * j + 1], acc1, 0, 0, 0); }
        }
        ss += __shfl_xor(ss, 16); ss += __shfl_xor(ss, 32);
        const float rs = rsqrtf(ss * (1.0f / D) + EPS);
        const float cb0 = cb[b * 32 + c], cb1 = cb[b * 32 + 16 + c];
#pragma unroll
        for (int reg = 0; reg < 4; ++reg) {
            const float rt = __shfl(rs, 4 * q + reg);
            float v0 = acc0[reg] * rt + cb0, v1 = acc1[reg] * rt + cb1;
            float sv[4]; int si[4];
#pragma unroll
            for (int rnd = 0; rnd < 4; ++rnd) {
                float bvv = v0; int bi = c; if (v1 > bvv) { bvv = v1; bi = 16 + c; }
#pragma unroll
                for (int o = 1; o < 16; o <<= 1) { const float ov = __shfl_xor(bvv, o); const int oi = __shfl_xor(bi, o); if (ov > bvv || (ov == bvv && oi < bi)) { bvv = ov; bi = oi; } }
                sv[rnd] = bvv; si[rnd] = bi; if (bi == c) v0 = -INFINITY; if (bi == 16 + c) v1 = -INFINITY;
            }
            const float e1 = __expf(sv[1] - sv[0]), e2 = __expf(sv[2] - sv[0]), e3 = __expf(sv[3] - sv[0]);
            const float inv = 1.0f / (1.0f + e1 + e2 + e3);
            if (c == 0) { const int t = tw + 4 * q + reg;
                const float ww[4] = {inv, e1 * inv, e2 * inv, e3 * inv};
#pragma unroll
                for (int rnd = 0; rnd < 4; ++rnd) { top_e[t * 4 + rnd] = si[rnd]; top_w[t * 4 + rnd] = ww[rnd]; rank[t * 4 + rnd] = atomicAdd((int*)&hist[si[rnd]], 1); }
            }
        }
        const float* sh = mod + (size_t)b * NMOD + 3 * D; const float* sc = mod + (size_t)b * NMOD + 4 * D;
#pragma unroll 4
        for (int i = 0; i < 16; ++i) {
            const float r = __shfl(rs, i);
            const u32x2* xr = (const u32x2*)(x1 + (size_t)(tw + i) * D) + lane;
#pragma unroll
            for (int j = 0; j < 4; ++j) {
                const int col = 4 * (lane + 64 * j);
                const f32x4 gg = *(const f32x4*)(g_ffn + col), s1 = *(const f32x4*)(sc + col), s0 = *(const f32x4*)(sh + col);
                const u32x2 xw = xr[64 * j]; const f32x4 xv = (f32x4){bflo(xw.x), bfhi(xw.x), bflo(xw.y), bfhi(xw.y)};
                const f32x4 y = (xv * r * gg * (s1 + 1.0f) + s0) * 16.0f;
                *(unsigned*)(h2 + (size_t)(tw + i) * D + col) = cvt4_fp8(y.x, y.y, y.z, y.w);
            }
        }
        __syncthreads();
        if (tid < 32) hist_g[tile * 32 + tid] = hist[tid];
        __syncthreads();
    }
}

__device__ __forceinline__ void ph_sort(const Ctx& X, const int* hist_g, const int* top_e, const float* top_w, const int* rank, int* row_tok, float* row_w, int* pair_row, int* blk_e) {
    LAS int* s_hist = (LAS int*)X.lds;
    LAS int* s_tot = s_hist + RT_NT * 32; LAS int* s_pre = s_tot + 32; LAS int* s_base = s_pre + 32; LAS int* s_pstart = s_base + 32; LAS int* s_pend = s_pstart + 32;
    const int tid = X.tid;
    for (int i = tid; i < RT_NT * 32; i += 512) s_hist[i] = hist_g[i];
    __syncthreads();
    for (int tile = X.vcu; tile < RT_NT; tile += X.G) {
        if (tid < 32) { int tot = 0, pre = 0; for (int i = 0; i < RT_NT; ++i) { const int c = s_hist[i * 32 + tid]; tot += c; if (i < tile) pre += c; } s_tot[tid] = tot; s_pre[tid] = pre; }
        __syncthreads();
        if (tid == 0) { int acc = 0; for (int e = 0; e < 32; ++e) { const int padded = (s_tot[e] + 255) / 256 * 256; s_pstart[e] = acc; s_base[e] = acc + s_pre[e]; acc += padded; s_pend[e] = acc; } }
        __syncthreads();
        { const int i = tid; const int idx = tile * RT_TILE * 4 + i; const int e = top_e[idx]; const int row = s_base[e] + rank[idx];
          row_tok[row] = idx >> 2; row_w[row] = top_w[idx]; pair_row[idx] = row; }
        if (tile < 32) { const int e = tile; for (int r = s_pstart[e] + s_tot[e] + tid; r < s_pend[e]; r += 512) { row_tok[r] = 0; row_w[r] = 0.f; } }
        if (tile == 32) { for (int blk = tid; blk < NBLK_MAX; blk += 512) { int e = -1; const int r = blk * 256; for (int q = 0; q < 32; ++q) if (r >= s_pstart[q] && r < s_pend[q]) e = q; blk_e[blk] = e; }
                          if (tid == 0) blk_e[NBLK_MAX] = s_pend[31] / 256; }
        __syncthreads();
    }
}

__device__ __forceinline__ void ph_final(const Ctx& X, const bf16_t* x1, const bf16_t* y, const int* pair_row, const float* mod, const float* g_final, float* out, const float oscale) {
    const int lane = X.lane;
    for (int t = X.vcu * 8 + X.wave; t < T; t += X.G * 8) {
        const int b = t / SEQ;
        const u32x2* xr = (const u32x2*)(x1 + (size_t)t * D) + lane;
        const float* ga = mod + (size_t)b * NMOD + 5 * D;
        int rows[4];
#pragma unroll
        for (int k = 0; k < 4; ++k) rows[k] = pair_row[t * 4 + k];
        f32x4 v[4]; float ss = 0.f;
#pragma unroll
        for (int j = 0; j < 4; ++j) {
            const int col = 4 * (lane + 64 * j);
            f32x4 m = (f32x4){0.f, 0.f, 0.f, 0.f};
#pragma unroll
            for (int k = 0; k < 4; ++k) { const u32x2 w = *(const u32x2*)(y + (size_t)rows[k] * D + col); m.x += bflo(w.x); m.y += bfhi(w.x); m.z += bflo(w.y); m.w += bfhi(w.y); }
            const u32x2 xw = xr[64 * j];
            v[j] = (f32x4){bflo(xw.x), bfhi(xw.x), bflo(xw.y), bfhi(xw.y)} + *(const f32x4*)(ga + col) * m;
            ss += (v[j].x * v[j].x + v[j].y * v[j].y) + (v[j].z * v[j].z + v[j].w * v[j].w);
        }
        const float r = rsqrtf(wave_sum(ss) * (1.0f / D) + EPS);
#pragma unroll
        for (int j = 0; j < 4; ++j) { const int col = 4 * (lane + 64 * j); *(f32x4*)(out + (size_t)t * D + col) = v[j] * (r * oscale) * *(const f32x4*)(g_final + col); }
    }
}

constexpr int N_PHASES = 13;
struct Args { const float* in[23]; float* out; unsigned char* ws; int ph_lo, ph_hi; };
__global__ void __launch_bounds__(512, 2) fwd(Args a) {
    extern __shared__ __attribute__((aligned(16))) unsigned char lds_raw[];
    Ctx X; X.lds = (LAS unsigned char*)lds_raw; X.tid = threadIdx.x; X.lane = X.tid & 63; X.wave = __builtin_amdgcn_readfirstlane(X.tid >> 6);
    X.G = gridDim.x; { const int bx = blockIdx.x; X.vcu = (X.G % 8 == 0) ? (bx % 8) * (X.G / 8) + bx / 8 : bx; }
    unsigned char* ws = a.ws;
    for (int u = X.tid; u < (LDS_BYTES - LDSCTL_OFF) / 4; u += 512) ((LAS unsigned*)(X.lds + LDSCTL_OFF))[u] = 0u;
    __syncthreads();
    XcdBarrier bar = xcd_barrier_post((unsigned*)(ws + WS_CTL) + CW_BAR, (volatile LAS unsigned*)(X.lds + LDSCTL_OFF), X.tid == 0);
    const int lo = a.ph_lo, hi = a.ph_hi; float probe_scale = 1.0f;
#define IN(k) (lo <= (k) && (k) < hi)
#define SEAM(k) do { if (IN(k) && IN((k) + 1)) xcd_barrier(bar, X.wave == 0 && (int)__builtin_amdgcn_mbcnt_hi(~0u, __builtin_amdgcn_mbcnt_lo(~0u, 0u)) == 0); } while (0)
#ifdef PROBE_PH
    unsigned long long* stamps = (unsigned long long*)(ws + WS_CTL + 32768);
    if (blockIdx.x == 0 && X.tid == 0) stamps[0] = __builtin_amdgcn_s_memrealtime();
#undef SEAM
#define SEAM(k) do { if (IN(k) && IN((k) + 1)) { xcd_barrier(bar, X.wave == 0 && (int)__builtin_amdgcn_mbcnt_hi(~0u, __builtin_amdgcn_mbcnt_lo(~0u, 0u)) == 0); \
        if (blockIdx.x == 0 && X.wave == 0 && (int)__builtin_amdgcn_mbcnt_hi(~0u, __builtin_amdgcn_mbcnt_lo(~0u, 0u)) == 0) stamps[(k) + 1] = __builtin_amdgcn_s_memrealtime(); } } while (0)
#endif
    const float* x = a.in[0]; const float* c = a.in[1]; const float* w_ada = a.in[2]; const float* b_ada = a.in[3];
    const float* g_mix = a.in[4]; const float* w_in = a.in[5]; const float* conv_dw = a.in[6]; const float* conv_dwb = a.in[7];
    const float* conv_ln_g = a.in[8]; const float* conv_ln_b = a.in[9]; const float* w_conv_out = a.in[10]; const float* lb_param = a.in[11];
    const float* hgrn_norm_g = a.in[12]; const float* w_hgrn_out = a.in[13]; const float* w_out = a.in[14]; const float* g_ffn = a.in[15];
    const float* w_router = a.in[16]; const float* b_router = a.in[17]; const float* w1 = a.in[18]; const float* b1 = a.in[19];
    const float* w2 = a.in[20]; const float* b2 = a.in[21]; const float* g_final = a.in[22];
    float* mod = (float*)(ws + WS_MOD); float* rt_bp = (float*)(ws + WS_BP); float* rt_cb = (float*)(ws + WS_CB);
    int* hist_g = (int*)(ws + WS_HIST); int* blk_e = (int*)(ws + WS_BLKE); int* top_e = (int*)(ws + WS_TOPE); float* top_w = (float*)(ws + WS_TOPW);
    int* rank = (int*)(ws + WS_RANK); int* pair_row = (int*)(ws + WS_PROW); int* row_tok = (int*)(ws + WS_RTOK); float* row_w = (float*)(ws + WS_RW);
    bf16_t* p = (bf16_t*)(ws + WS_P);
    bf16_t* h = (bf16_t*)(ws + WS_E); unsigned char* h8 = ws + WS_E + 64 * MiB; float* tmp = (float*)(ws + WS_E);
    float* hg_dS = (float*)(ws + WS_E); float* hg_S0 = (float*)(ws + WS_E + 64 * MiB); float* hg_D = (float*)(ws + WS_HGD);
    bf16_t* uc = (bf16_t*)(ws + WS_D); bf16_t* og = uc + D;   bf16_t* x1 = (bf16_t*)(ws + WS_D);
    bf16_t* merged = p;
    unsigned char* h2 = (unsigned char*)p;
    unsigned char* act = (unsigned char*)(p + PG);
    bf16_t* y = p + PG + (size_t)R_PAD * D / 2;
    PG8_LAS unsigned char* ring = (PG8_LAS unsigned char*)lds_raw;

#ifndef REPMASK
#define REPMASK 0
#endif
#ifndef REPN
#define REPN 1
#endif
#define PH(k, ...) do { if (IN(k)) { _Pragma("unroll 1") for (int rep_ = 0; rep_ < ((((REPMASK) >> (k)) & 1) ? 1 + REPN : 1); ++rep_) { if (rep_) __syncthreads(); { int ln_ = (int)__builtin_amdgcn_mbcnt_hi(~0u, __builtin_amdgcn_mbcnt_lo(~0u, 0u)); asm volatile("" : "+v"(ln_)); X.lane = ln_; X.tid = X.wave * 64 + ln_; } __VA_ARGS__ } } SEAM(k); } while (0)
    PH(0, ph_prologue<0>(X, c, w_ada, b_ada, mod, w_in, w_conv_out, w_hgrn_out, w_out, w1, w2, ws););
    PH(1, ph_norm_mod(X, x, g_mix, mod, 0, D, h, h8); ph_router_tables(X, g_ffn, mod, w_router, b_router, rt_bp, rt_cb););
#ifndef STAGGER_TICKS
#define STAGGER_TICKS 0
#endif
    PH(2, { if (STAGGER_TICKS) { const unsigned long long t0_ = __builtin_amdgcn_s_memrealtime(), wait_ = (unsigned long long)(X.vcu & 3) * STAGGER_TICKS;
                while (__builtin_amdgcn_s_memrealtime() - t0_ < wait_) __builtin_amdgcn_s_sleep(8); }
        constexpr unsigned m8 = P_FP8_MASK; constexpr int n8 = __builtin_popcount(m8);
        if (n8 > 0) { pg8::Gemm g{(const bf16_t*)h8, (const bf16_t*)(ws + WS_WIN8), T, 8 * D, D / 2}; pg8::MaskOrder S; S.base.init(T, n8 * 256, X.G, (int)blockIdx.x); S.mask = m8;
            pg8::EpiSplitBf16 E{p, PG, 0x3cu, SEQ, 1.0f / 4096.0f}; pg8::gemm_phase<pg8::EpiSplitBf16, pg8::MaskOrder, true, true, false, true>(ring, g, S, E, X.wave); }
        if (n8 < 32) { pg8::Gemm g{h, (const bf16_t*)(ws + WS_WIN), T, 8 * D, D}; pg8::MaskOrder S; S.base.init(T, (32 - n8) * 256, X.G, (int)blockIdx.x); S.mask = ~m8;
            pg8::EpiSplitBf16 E{p, PG, 0x3cu, SEQ, 1.0f}; pg8::gemm_phase<pg8::EpiSplitBf16, pg8::MaskOrder, true, true>(ring, g, S, E, X.wave); } });
    PH(3, ph_conv(X, p + 0 * PG, conv_dw, conv_dwb, conv_ln_g, conv_ln_b, uc);
          if ((REPMASK >> 14) & 1) { __syncthreads(); ph_conv(X, p + 0 * PG, conv_dw, conv_dwb, conv_ln_g, conv_ln_b, uc); }
          ph_hgrn<false>(X, 31 * 32, p + 2 * PG, p + 3 * PG, p + 4 * PG, p + 5 * PG, lb_param, nullptr, nullptr, hg_dS, hg_D, nullptr);
          if ((REPMASK >> 15) & 1) { __syncthreads(); ph_hgrn<false>(X, 31 * 32, p + 2 * PG, p + 3 * PG, p + 4 * PG, p + 5 * PG, lb_param, nullptr, nullptr, hg_dS, hg_D, nullptr); });
    PH(4, ph_hg2(X, hg_dS, hg_D, hg_S0););
    PH(5, if ((X.vcu & 1) == 0) ph_prologue<1>(X, c, w_ada, b_ada, mod, w_in, w_conv_out, w_hgrn_out, w_out, w1, w2, ws);
          ph_hgrn<true>(X, 32 * 32, p + 2 * PG, p + 3 * PG, p + 4 * PG, p + 5 * PG, lb_param, hgrn_norm_g, hg_S0, nullptr, nullptr, og);
          if ((X.vcu & 1) != 0) ph_prologue<1>(X, c, w_ada, b_ada, mod, w_in, w_conv_out, w_hgrn_out, w_out, w1, w2, ws););
    PH(6, { pg8::Gemm g{uc, (const bf16_t*)(ws + WS_WC), T, D, 2 * D}; pg8::StaticOrder S; S.init(T, D, X.G, (int)blockIdx.x);
        pg8::EpiGateFused E{p + 6 * PG, p + 7 * PG, merged}; pg8::gemm_phase<pg8::EpiGateFused, pg8::StaticOrder, true, true>(ring, g, S, E, X.wave); });
    PH(7, { pg8::Gemm g{merged, (const bf16_t*)(ws + WS_WO), T, D, D}; pg8::StaticOrder S; S.init(T, D, X.G, (int)blockIdx.x);
        pg8::EpiRes E{x, mod + 2 * D, x1, NMOD, SEQ}; pg8::gemm_phase<pg8::EpiRes, pg8::StaticOrder, true, true>(ring, g, S, E, X.wave); });
    PH(8, ph_route(X, x1, g_ffn, mod, rt_bp, rt_cb, h2, top_e, top_w, rank, hist_g););
    PH(9, ph_sort(X, hist_g, top_e, top_w, rank, row_tok, row_w, pair_row, blk_e););
    PH(10, { const int nblk = blk_e[NBLK_MAX]; pg8::Gemm g{(const bf16_t*)h2, (const bf16_t*)(ws + WS_W1), T, 32 * 2048, D / 2}; pg8::MoeOrder S{blk_e, nblk, X.G, (int)blockIdx.x, 3};
        LAS unsigned short* gt = (LAS unsigned short*)(X.lds + LDSCTL_OFF + 256);
        _Pragma("unroll 1") for (int i = 0; i < 23; ++i) { pg8::Unit u; if (!S.next(i, u)) break; if (X.tid < 256) gt[256 * i + X.tid] = (unsigned short)row_tok[u.pm * 256 + X.tid]; }
        __syncthreads();
        pg8::EpiSwiglu8 E{b1, act, 1.0f / 4096.0f}; pg8::gemm_phase<pg8::EpiSwiglu8, pg8::MoeOrder, true, true, true, true>(ring, g, S, E, X.wave, (const PG8_LAS unsigned short*)gt); });
    PH(11, { const int nblk = blk_e[NBLK_MAX]; pg8::Gemm g{(const bf16_t*)act, (const bf16_t*)(ws + WS_W2), R_PAD, 32 * 1024, DFF / 2}; pg8::MoeOrder S{blk_e, nblk, X.G, (int)blockIdx.x, 2};
        pg8::EpiY8 E{b2, row_w, y, 1.0f / 1024.0f}; pg8::gemm_phase<pg8::EpiY8, pg8::MoeOrder, true, true, false, true>(ring, g, S, E, X.wave); });
#ifdef PROBE_PH
    { const unsigned long long* st_ = (const unsigned long long*)(ws + WS_CTL + 32768); const float dt_ = (float)(long long)(st_[PROBE_PH + 1] - st_[PROBE_PH]);
      probe_scale = 1.0f + dt_ * (1.0f / 200000.0f); }
#endif
    PH(12, ph_final(X, x1, y, pair_row, mod, g_final, a.out, probe_scale););
#undef PH
#undef IN
#undef SEAM
}

#ifndef MK_N_LAUNCHES
#define MK_N_LAUNCHES 1
#endif
extern "C" void kernel_launch(void* const* d_in, const int* in_sizes, int n_in, void* d_out, int out_size, void* d_ws, size_t ws_size, hipStream_t stream) {
    static int grid = 0;
    if (grid == 0) {
        if (n_in != 23 || out_size != T * D || ws_size < WS_END) { fprintf(stderr, "kernel_launch: unexpected n_in %d / out_size %d / ws_size %zu (< %zu); nothing launched\n", n_in, out_size, ws_size, (size_t)WS_END); grid = -1; return; }
        int dev = 0, cus = 0, per_cu = 0;
        if (hipGetDevice(&dev) != hipSuccess || hipDeviceGetAttribute(&cus, hipDeviceAttributeMultiprocessorCount, dev) != hipSuccess) { grid = -1; return; }
        if (hipFuncSetAttribute((const void*)fwd, hipFuncAttributeMaxDynamicSharedMemorySize, LDS_BYTES) != hipSuccess) { fprintf(stderr, "kernel_launch: hipFuncSetAttribute failed\n"); grid = -1; return; }
        if (hipOccupancyMaxActiveBlocksPerMultiprocessor(&per_cu, (const void*)fwd, 512, LDS_BYTES) != hipSuccess || per_cu < 1) { fprintf(stderr, "kernel_launch: occupancy query says %d blocks per CU\n", per_cu); }
        (void)hipGetLastError();
        grid = cus;
    }
    if (grid < 0) return;
    if (hipMemsetAsync((char*)d_ws + WS_CTL, 0, CTL_ZERO_BYTES, stream) != hipSuccess) return;
    Args a{};
    for (int i = 0; i < 23; ++i) a.in[i] = (const float*)d_in[i];
    a.out = (float*)d_out; a.ws = (unsigned char*)d_ws;
    if (MK_N_LAUNCHES == 1) { a.ph_lo = 0; a.ph_hi = N_PHASES; hipLaunchKernelGGL(fwd, dim3(grid), dim3(512), LDS_BYTES, stream, a); }
    else for (int ph = 0; ph < N_PHASES; ++ph) { a.ph_lo = ph; a.ph_hi = ph + 1; hipLaunchKernelGGL(fwd, dim3(grid), dim3(512), LDS_BYTES, stream, a); }
}
```

```cpp
#include <hip/hip_runtime.h>
#include <stdint.h>
#include <stdio.h>

#define GAS __attribute__((address_space(1)))
#define LAS __attribute__((address_space(3)))
typedef unsigned short bf16_t;
typedef unsigned u32x4 __attribute__((ext_vector_type(4)));
typedef unsigned u32x2 __attribute__((ext_vector_type(2)));
typedef float f32x4 __attribute__((ext_vector_type(4)));

constexpr int D = 1024, NBATCH = 4, SEQ = 8192, T = NBATCH * SEQ;
constexpr int NE = 32, DFF = 1024;
constexpr int NMOD = 6 * D;
constexpr int NBLK_MAX = 544, R_PAD = NBLK_MAX * 256;
constexpr int RT_TILE = 128, RT_NT = T / RT_TILE;
constexpr float EPS = 1e-6f;

constexpr size_t MiB = 1u << 20;
constexpr size_t WS_CTL = 0, CTL_ZERO_BYTES = 64 * 1024;
constexpr size_t WS_MOD = 1 * MiB;
constexpr size_t WS_CB = WS_MOD + 112 * 1024, WS_BP = WS_MOD + 128 * 1024;
constexpr size_t WS_HIST = 2 * MiB;
constexpr size_t WS_BLKE = WS_HIST + 64 * 1024;
constexpr size_t WS_TOPE = 3 * MiB;
constexpr size_t WS_TOPW = WS_TOPE + 512 * 1024;
constexpr size_t WS_RANK = WS_TOPW + 512 * 1024;
constexpr size_t WS_PROW = WS_RANK + 512 * 1024;
constexpr size_t WS_RTOK = 5 * MiB;
constexpr size_t WS_RW = 6 * MiB;
constexpr size_t WS_HGD = 7 * MiB;
constexpr size_t WS_WT = 8 * MiB;
constexpr size_t WS_WIN = WS_WT, WS_WC = WS_WT + 16 * MiB, WS_WH = WS_WT + 18 * MiB, WS_WO = WS_WT + 20 * MiB, WS_W1 = WS_WT + 22 * MiB, WS_WIN8 = WS_WT + 96 * MiB  , WS_W2 = WS_WT + 150 * MiB;
constexpr size_t WS_P = 224 * MiB;
constexpr size_t WS_E = WS_P + 512 * MiB;
constexpr size_t WS_D = WS_E + 128 * MiB;
constexpr size_t WS_END = WS_D + 128 * MiB;
constexpr size_t PG = (size_t)T * D;
constexpr int CW_BAR = 0;

constexpr int RING_BYTES = 135168, LDSCTL_OFF = RING_BYTES, LDS_BYTES = 147456;

__device__ __forceinline__ unsigned f2bf(float f) { unsigned u = __builtin_bit_cast(unsigned, f); return (u + 0x7fffu + ((u >> 16) & 1u)) >> 16; }
__device__ __forceinline__ unsigned pk2(float lo, float hi) { return f2bf(lo) | (f2bf(hi) << 16); }
__device__ __forceinline__ float bf2f(unsigned b) { return __builtin_bit_cast(float, b << 16); }
__device__ __forceinline__ float bflo(unsigned w) { return __builtin_bit_cast(float, w << 16); }
__device__ __forceinline__ float bfhi(unsigned w) { return __builtin_bit_cast(float, w & 0xffff0000u); }
__device__ __forceinline__ float sigmoidf_(float x) { return __builtin_amdgcn_rcpf(1.0f + __expf(-x)); }
__device__ __forceinline__ float wave_sum(float v) {
#pragma unroll
    for (int o = 1; o < 64; o <<= 1) v += __shfl_xor(v, o);
    return v;
}
__device__ __forceinline__ unsigned cvt4_fp8(float a, float b, float c, float d) {
    a = fminf(fmaxf(a, -448.f), 448.f); b = fminf(fmaxf(b, -448.f), 448.f); c = fminf(fmaxf(c, -448.f), 448.f); d = fminf(fmaxf(d, -448.f), 448.f);
    int w = 0; w = __builtin_amdgcn_cvt_pk_fp8_f32(a, b, w, false); w = __builtin_amdgcn_cvt_pk_fp8_f32(c, d, w, true); return (unsigned)w; }
#define LDS_WAIT() asm volatile("s_waitcnt lgkmcnt(0)" ::: "memory")
#define VM_WAIT() asm volatile("s_waitcnt vmcnt(0)" ::: "memory")

namespace pg8 {
#define PG8_LAS __attribute__((address_space(3)))
typedef unsigned short bf16_t;
typedef short bf16x8 __attribute__((ext_vector_type(8)));
typedef float f32x4 __attribute__((ext_vector_type(4)));
typedef unsigned u32x4 __attribute__((ext_vector_type(4)));
constexpr int BM = 256, BK = 64, HALF = 128, HTB = HALF * BK * 2  , STAGE_BYTES = 8 * HTB, NXCD = 8, WGM = 8;

__host__ __device__ __forceinline__ int lds_byte(int r, int c) { const int st = (r >> 4) * 2 + (c >> 5), rr = r & 15, cc = c & 31, ob = rr * 64 + cc * 2; return st * 1024 + (ob ^ (((ob >> 9) & 1) << 5)); }
__host__ __device__ __forceinline__ void stage_rc(int b, int& R, int& C) { const int st = b / 1024, sb = b % 1024, swz = sb ^ (((sb >> 9) & 1) << 5); R = (st >> 1) * 16 + swz / 64; C = (st & 1) * 32 + (swz % 64) / 2; }
__host__ __device__ __forceinline__ int perm32(int rho) { const int n = rho >> 4, i = rho & 15; return 8 * (i >> 2) + 4 * n + (i & 3); }

struct Unit { int pm, pn; };
struct Gemm { const bf16_t* A; const bf16_t* Bt; int M, N, K; };

struct StaticOrder {
    int nM, nN, nwg, G, c;
    __host__ __device__ void init(int M, int N, int G_, int c_) { nM = M / BM; nN = N / BM; nwg = nM * nN; G = G_; c = c_; }
    __host__ __device__ bool next(int i, Unit& u) const {
        const long L = (long)i * G + c; if (L >= nwg) return false;
        int wgid = (int)L; { const int q = nwg / NXCD, r = nwg % NXCD, xcd = wgid % NXCD, off = wgid / NXCD; wgid = (xcd < r ? xcd * (q + 1) : r * (q + 1) + (xcd - r) * q) + off; }
        const int nig = WGM * nN, gid = wgid / nig, fm = gid * WGM, gsz = (nM - fm) < WGM ? (nM - fm) : WGM;
        u.pm = fm + ((wgid % nig) % gsz); u.pn = (wgid % nig) / gsz; return true;
    }
    __device__ __forceinline__ void a_ready(const Unit&) const {}
    __device__ __forceinline__ void done(const Unit&) const {}
};


struct MaskOrder {
    StaticOrder base; unsigned mask;
    __device__ __forceinline__ bool next(int i, Unit& u) const {
        if (!base.next(i, u)) return false;
        unsigned m = mask; for (int k = 0; k < u.pn; ++k) m &= m - 1;
        u.pn = __builtin_ctz(m); return true;
    }
    __device__ __forceinline__ void a_ready(const Unit&) const {}
    __device__ __forceinline__ void done(const Unit&) const {}
};
struct MoeOrder {
    const int* blk_e; int nblk, G, c, lg;
    __device__ __forceinline__ bool next(int i, Unit& u) const {
        int blk, j;
        if (G == 256) { const int xcd = c & 7, idx = c >> 3, prb = 256 >> lg; blk = i * prb + xcd * (prb >> 3) + (idx >> lg); j = idx & ((1 << lg) - 1); }
        else { const long L = (long)i * G + c; blk = (int)(L >> lg); j = (int)(L & ((1 << lg) - 1)); }
        if (blk >= nblk) return false;
        const int e = blk_e[blk]; u.pm = blk; u.pn = (e << lg) + j; return true;
    }
    __device__ __forceinline__ void a_ready(const Unit&) const {}
    __device__ __forceinline__ void done(const Unit&) const {}
};

__device__ __forceinline__ unsigned cvt_pk_bf16(float lo, float hi) { unsigned r; asm volatile("v_cvt_pk_bf16_f32 %0, %1, %2" : "=v"(r) : "v"(lo), "v"(hi)); return r; }
__device__ __forceinline__ float sigm(float x) { return __builtin_amdgcn_rcpf(1.0f + __expf(-x)); }
__device__ __forceinline__ float blo(unsigned w) { return __builtin_bit_cast(float, w << 16); }
__device__ __forceinline__ float bhi(unsigned w) { return __builtin_bit_cast(float, w & 0xffff0000u); }

struct EpiSplitBf16 {
    static constexpr bool PERM = true, AFTER_DRAIN = false;
    bf16_t* O; size_t split_stride; unsigned hm_mask; int seq; float dq;
    __device__ __forceinline__ void operator()(const f32x4 (&acc)[2][2][4][2], const Unit& u, int wr, int wc, int fr, int fq) const {
        const int row0 = u.pm * BM + wr * 64 + fr; const int colt = u.pn * BM; const int t = colt >> 10;
        if (u.pn < 8) {
#pragma unroll
            for (int ai = 0; ai < 2; ++ai)
#pragma unroll
                for (int m = 0; m < 4; ++m) { const int row = row0 + ai * HALF + m * 16; float r[8];
#pragma unroll
                    for (int q = 0; q < 4; ++q) { r[q] = acc[ai][0][m][0][q] * dq * sigm(acc[ai][1][m][0][q] * dq); r[4 + q] = acc[ai][0][m][1][q] * dq * sigm(acc[ai][1][m][1][q] * dq); }
                    u32x4 w; w.x = cvt_pk_bf16(r[0], r[1]); w.y = cvt_pk_bf16(r[2], r[3]); w.z = cvt_pk_bf16(r[4], r[5]); w.w = cvt_pk_bf16(r[6], r[7]);
                    __builtin_nontemporal_store(w, (u32x4*)(O + (size_t)row * 1024 + 128 * u.pn + wc * 32 + 8 * fq)); }
            return;
        }
        bf16_t* base = O + (size_t)t * split_stride; const int cg = colt & 1023;
        const bool hm = (hm_mask >> t) & 1u;
        const int bb = (u.pm * BM) / seq;
#pragma unroll
        for (int ai = 0; ai < 2; ++ai)
#pragma unroll
            for (int m = 0; m < 4; ++m) { const int row = row0 + ai * HALF + m * 16;
#pragma unroll
                for (int bj = 0; bj < 2; ++bj) { const f32x4 v0 = acc[ai][bj][m][0] * dq, v1 = acc[ai][bj][m][1] * dq;
                    u32x4 w; w.x = cvt_pk_bf16(v0[0], v0[1]); w.y = cvt_pk_bf16(v0[2], v0[3]); w.z = cvt_pk_bf16(v1[0], v1[1]); w.w = cvt_pk_bf16(v1[2], v1[3]);
                    const size_t o = hm ? ((size_t)(bb * 8 + (cg >> 7) + bj) * seq + (row - bb * seq)) * 128 + wc * 32 + 8 * fq
                                        : (size_t)row * 1024 + cg + bj * HALF + wc * 32 + 8 * fq;
                    __builtin_nontemporal_store(w, (u32x4*)(base + o)); } }
    }
};
struct EpiGate1 {
    static constexpr bool PERM = true, AFTER_DRAIN = false;
    const bf16_t* gate; float* tmp;
    __device__ __forceinline__ void operator()(const f32x4 (&acc)[2][2][4][2], const Unit& u, int wr, int wc, int fr, int fq) const {
        const int row0 = u.pm * BM + wr * 64 + fr, col0 = u.pn * BM + wc * 32 + 8 * fq;
#pragma unroll
        for (int ai = 0; ai < 2; ++ai)
#pragma unroll
            for (int m = 0; m < 4; ++m) { const size_t o = (size_t)(row0 + ai * HALF + m * 16) * 1024 + col0;
#pragma unroll
                for (int bj = 0; bj < 2; ++bj) { const u32x4 g = *(const u32x4*)(gate + o + bj * HALF); f32x4 v0 = acc[ai][bj][m][0], v1 = acc[ai][bj][m][1];
                    v0[0] *= sigm(blo(g.x)); v0[1] *= sigm(bhi(g.x)); v0[2] *= sigm(blo(g.y)); v0[3] *= sigm(bhi(g.y));
                    v1[0] *= sigm(blo(g.z)); v1[1] *= sigm(bhi(g.z)); v1[2] *= sigm(blo(g.w)); v1[3] *= sigm(bhi(g.w));
                    *(f32x4*)(tmp + o + bj * HALF) = v0; *(f32x4*)(tmp + o + bj * HALF + 4) = v1; } }
    }
};
struct EpiGate2 {
    static constexpr bool PERM = true, AFTER_DRAIN = false;
    const bf16_t* gate; const float* tmp; bf16_t* out;
    __device__ __forceinline__ void operator()(const f32x4 (&acc)[2][2][4][2], const Unit& u, int wr, int wc, int fr, int fq) const {
        const int row0 = u.pm * BM + wr * 64 + fr, col0 = u.pn * BM + wc * 32 + 8 * fq;
#pragma unroll
        for (int ai = 0; ai < 2; ++ai)
#pragma unroll
            for (int m = 0; m < 4; ++m) { const size_t o = (size_t)(row0 + ai * HALF + m * 16) * 1024 + col0;
#pragma unroll
                for (int bj = 0; bj < 2; ++bj) { const u32x4 g = *(const u32x4*)(gate + o + bj * HALF); f32x4 v0 = acc[ai][bj][m][0], v1 = acc[ai][bj][m][1];
                    const f32x4 t0 = *(const f32x4*)(tmp + o + bj * HALF), t1 = *(const f32x4*)(tmp + o + bj * HALF + 4);
                    v0[0] = t0[0] + v0[0] * sigm(blo(g.x)); v0[1] = t0[1] + v0[1] * sigm(bhi(g.x)); v0[2] = t0[2] + v0[2] * sigm(blo(g.y)); v0[3] = t0[3] + v0[3] * sigm(bhi(g.y));
                    v1[0] = t1[0] + v1[0] * sigm(blo(g.z)); v1[1] = t1[1] + v1[1] * sigm(bhi(g.z)); v1[2] = t1[2] + v1[2] * sigm(blo(g.w)); v1[3] = t1[3] + v1[3] * sigm(bhi(g.w));
                    u32x4 w; w.x = cvt_pk_bf16(v0[0], v0[1]); w.y = cvt_pk_bf16(v0[2], v0[3]); w.z = cvt_pk_bf16(v1[0], v1[1]); w.w = cvt_pk_bf16(v1[2], v1[3]);
                    *(u32x4*)(out + o + bj * HALF) = w; } }
    }
};
struct EpiRes {
    static constexpr bool PERM = true, AFTER_DRAIN = false;
    const float* x; const float* ga; bf16_t* out; int mod_pitch, seq;
    __device__ __forceinline__ void operator()(const f32x4 (&acc)[2][2][4][2], const Unit& u, int wr, int wc, int fr, int fq) const {
        const int row0 = u.pm * BM + wr * 64 + fr, col0 = u.pn * BM + wc * 32 + 8 * fq;
        const float* gab = ga + (size_t)((u.pm * BM) / seq) * mod_pitch + col0;
        f32x4 gv[2][2];
#pragma unroll
        for (int bj = 0; bj < 2; ++bj)
#pragma unroll
            for (int n = 0; n < 2; ++n) gv[bj][n] = *(const f32x4*)(gab + bj * HALF + 4 * n);
#pragma unroll
        for (int ai = 0; ai < 2; ++ai)
#pragma unroll
            for (int m = 0; m < 4; ++m) { const size_t o = (size_t)(row0 + ai * HALF + m * 16) * 1024 + col0;
#pragma unroll
                for (int bj = 0; bj < 2; ++bj) { const f32x4 x0 = *(const f32x4*)(x + o + bj * HALF), x1_ = *(const f32x4*)(x + o + bj * HALF + 4);
                    const f32x4 v0 = x0 + gv[bj][0] * acc[ai][bj][m][0], v1 = x1_ + gv[bj][1] * acc[ai][bj][m][1];
                    u32x4 w; w.x = cvt_pk_bf16(v0[0], v0[1]); w.y = cvt_pk_bf16(v0[2], v0[3]); w.z = cvt_pk_bf16(v1[0], v1[1]); w.w = cvt_pk_bf16(v1[2], v1[3]);
                    *(u32x4*)(out + o + bj * HALF) = w; } }
    }
};
struct EpiSwiglu {
    static constexpr bool PERM = true, AFTER_DRAIN = false;
    const float* b1; bf16_t* act;
    __device__ __forceinline__ void operator()(const f32x4 (&acc)[2][2][4][2], const Unit& u, int wr, int wc, int fr, int fq) const {
        const int e = u.pn >> 3, j = u.pn & 7; const int row0 = u.pm * BM + wr * 64 + fr, f0 = 128 * j + wc * 32 + 8 * fq;
        const float* be = b1 + (size_t)e * 2048 + f0;
        const f32x4 bg0 = *(const f32x4*)(be), bg1 = *(const f32x4*)(be + 4), bl0 = *(const f32x4*)(be + 1024), bl1 = *(const f32x4*)(be + 1028);
#pragma unroll
        for (int ai = 0; ai < 2; ++ai)
#pragma unroll
            for (int m = 0; m < 4; ++m) {
                f32x4 g0 = acc[ai][0][m][0] + bg0, g1 = acc[ai][0][m][1] + bg1, l0 = acc[ai][1][m][0] + bl0, l1 = acc[ai][1][m][1] + bl1;
                float r[8];
#pragma unroll
                for (int q = 0; q < 4; ++q) { float gl = fminf(g0[q], 7.0f), li = fminf(fmaxf(l0[q], -7.0f), 7.0f); r[q] = gl * sigm(1.702f * gl) * (li + 1.0f);
                                              gl = fminf(g1[q], 7.0f); li = fminf(fmaxf(l1[q], -7.0f), 7.0f); r[4 + q] = gl * sigm(1.702f * gl) * (li + 1.0f); }
                u32x4 w; w.x = cvt_pk_bf16(r[0], r[1]); w.y = cvt_pk_bf16(r[2], r[3]); w.z = cvt_pk_bf16(r[4], r[5]); w.w = cvt_pk_bf16(r[6], r[7]);
                *(u32x4*)(act + (size_t)(row0 + ai * HALF + m * 16) * 1024 + f0) = w; }
    }
};
struct EpiY {
    static constexpr bool PERM = true, AFTER_DRAIN = false;
    const float* b2; const float* rw; bf16_t* y;
    __device__ __forceinline__ void operator()(const f32x4 (&acc)[2][2][4][2], const Unit& u, int wr, int wc, int fr, int fq) const {
        const int e = u.pn >> 2, j = u.pn & 3; const int row0 = u.pm * BM + wr * 64 + fr, col0 = 256 * j + wc * 32 + 8 * fq;
        const float* be = b2 + (size_t)e * 1024 + col0;
        f32x4 bv[2][2];
#pragma unroll
        for (int bj = 0; bj < 2; ++bj)
#pragma unroll
            for (int n = 0; n < 2; ++n) bv[bj][n] = *(const f32x4*)(be + bj * HALF + 4 * n);
#pragma unroll
        for (int ai = 0; ai < 2; ++ai)
#pragma unroll
            for (int m = 0; m < 4; ++m) { const int row = row0 + ai * HALF + m * 16; const float w_ = rw[row];
#pragma unroll
                for (int bj = 0; bj < 2; ++bj) { const f32x4 v0 = (acc[ai][bj][m][0] + bv[bj][0]) * w_, v1 = (acc[ai][bj][m][1] + bv[bj][1]) * w_;
                    u32x4 w; w.x = cvt_pk_bf16(v0[0], v0[1]); w.y = cvt_pk_bf16(v0[2], v0[3]); w.z = cvt_pk_bf16(v1[0], v1[1]); w.w = cvt_pk_bf16(v1[2], v1[3]);
                    *(u32x4*)(y + (size_t)row * 1024 + col0 + bj * HALF) = w; } }
    }
};


struct EpiSwiglu8 {
    static constexpr bool PERM = true, AFTER_DRAIN = false;
    const float* b1; unsigned char* act; float dq;
    __device__ __forceinline__ void operator()(const f32x4 (&acc)[2][2][4][2], const Unit& u, int wr, int wc, int fr, int fq) const {
        const int e = u.pn >> 3, j = u.pn & 7; const int row0 = u.pm * BM + wr * 64 + fr, f0 = 128 * j + wc * 32 + 8 * fq;
        const float* be = b1 + (size_t)e * 2048 + f0;
        const f32x4 bg0 = *(const f32x4*)(be), bg1 = *(const f32x4*)(be + 4), bl0 = *(const f32x4*)(be + 1024), bl1 = *(const f32x4*)(be + 1028);
#pragma unroll
        for (int ai = 0; ai < 2; ++ai)
#pragma unroll
            for (int m = 0; m < 4; ++m) {
                f32x4 g0 = acc[ai][0][m][0] * dq + bg0, g1 = acc[ai][0][m][1] * dq + bg1, l0 = acc[ai][1][m][0] * dq + bl0, l1 = acc[ai][1][m][1] * dq + bl1;
                float r[8];
#pragma unroll
                for (int q = 0; q < 4; ++q) { float gl = fminf(g0[q], 7.0f), li = fminf(fmaxf(l0[q], -7.0f), 7.0f); r[q] = 4.0f * gl * sigm(1.702f * gl) * (li + 1.0f);
                                              gl = fminf(g1[q], 7.0f); li = fminf(fmaxf(l1[q], -7.0f), 7.0f); r[4 + q] = 4.0f * gl * sigm(1.702f * gl) * (li + 1.0f); }
                u32x2 w; w.x = cvt4_fp8(r[0], r[1], r[2], r[3]); w.y = cvt4_fp8(r[4], r[5], r[6], r[7]);
                *(u32x2*)(act + (size_t)(row0 + ai * HALF + m * 16) * 1024 + f0) = w; }
    }
};
struct EpiY8 {
    static constexpr bool PERM = true, AFTER_DRAIN = false;
    const float* b2; const float* rw; unsigned char* y; float dq;
    __device__ __forceinline__ void operator()(const f32x4 (&acc)[2][2][4][2], const Unit& u, int wr, int wc, int fr, int fq) const {
        const int e = u.pn >> 2, j = u.pn & 3; const int row0 = u.pm * BM + wr * 64 + fr, col0 = 256 * j + wc * 32 + 8 * fq;
        const float* be = b2 + (size_t)e * 1024 + col0;
        f32x4 bv[2][2];
#pragma unroll
        for (int bj = 0; bj < 2; ++bj)
#pragma unroll
            for (int n = 0; n < 2; ++n) bv[bj][n] = *(const f32x4*)(be + bj * HALF + 4 * n);
#pragma unroll
        for (int ai = 0; ai < 2; ++ai)
#pragma unroll
            for (int m = 0; m < 4; ++m) { const int row = row0 + ai * HALF + m * 16; const float w_ = rw[row] * 32.0f;
#pragma unroll
                for (int bj = 0; bj < 2; ++bj) { const f32x4 v0 = (acc[ai][bj][m][0] * dq + bv[bj][0]) * w_, v1 = (acc[ai][bj][m][1] * dq + bv[bj][1]) * w_;
                    u32x2 w; w.x = cvt4_fp8(v0[0], v0[1], v0[2], v0[3]); w.y = cvt4_fp8(v1[0], v1[1], v1[2], v1[3]);
                    *(u32x2*)(y + (size_t)row * 1024 + col0 + bj * HALF) = w; } }
    }
};

struct EpiGateFused {
    static constexpr bool PERM = true, AFTER_DRAIN = false, HAS_MID = true;
    const bf16_t* gc; const bf16_t* gh; bf16_t* out;
    __device__ __forceinline__ void mid(f32x4 (&acc)[2][2][4][2], const Unit& u, int wr, int wc, int fr, int fq) const {
        const int row0 = u.pm * BM + wr * 64 + fr, col0 = u.pn * BM + wc * 32 + 8 * fq;
#pragma unroll
        for (int ai = 0; ai < 2; ++ai)
#pragma unroll
            for (int m = 0; m < 4; ++m) { const size_t o = (size_t)(row0 + ai * HALF + m * 16) * 1024 + col0;
#pragma unroll
                for (int bj = 0; bj < 2; ++bj) { const u32x4 a = *(const u32x4*)(gc + o + bj * HALF), b = *(const u32x4*)(gh + o + bj * HALF);
                    const unsigned aw[4] = {a.x, a.y, a.z, a.w}, bw[4] = {b.x, b.y, b.z, b.w};
#pragma unroll
                    for (int q = 0; q < 4; ++q) { const float r0 = (1.0f + __expf(-blo(bw[q]))) * __builtin_amdgcn_rcpf(1.0f + __expf(-blo(aw[q]))), r1 = (1.0f + __expf(-bhi(bw[q]))) * __builtin_amdgcn_rcpf(1.0f + __expf(-bhi(aw[q])));
                        acc[ai][bj][m][q >> 1][(2 * q) & 3] *= r0; acc[ai][bj][m][q >> 1][(2 * q + 1) & 3] *= r1; } } }
    }
    __device__ __forceinline__ void operator()(const f32x4 (&acc)[2][2][4][2], const Unit& u, int wr, int wc, int fr, int fq) const {
        const int row0 = u.pm * BM + wr * 64 + fr, col0 = u.pn * BM + wc * 32 + 8 * fq;
#pragma unroll
        for (int ai = 0; ai < 2; ++ai)
#pragma unroll
            for (int m = 0; m < 4; ++m) { const size_t o = (size_t)(row0 + ai * HALF + m * 16) * 1024 + col0;
#pragma unroll
                for (int bj = 0; bj < 2; ++bj) { const u32x4 g = *(const u32x4*)(gh + o + bj * HALF); f32x4 v0 = acc[ai][bj][m][0], v1 = acc[ai][bj][m][1];
                    v0[0] *= sigm(blo(g.x)); v0[1] *= sigm(bhi(g.x)); v0[2] *= sigm(blo(g.y)); v0[3] *= sigm(bhi(g.y));
                    v1[0] *= sigm(blo(g.z)); v1[1] *= sigm(bhi(g.z)); v1[2] *= sigm(blo(g.w)); v1[3] *= sigm(bhi(g.w));
                    u32x4 w; w.x = cvt_pk_bf16(v0[0], v0[1]); w.y = cvt_pk_bf16(v0[2], v0[3]); w.z = cvt_pk_bf16(v1[0], v1[1]); w.w = cvt_pk_bf16(v1[2], v1[3]);
                    *(u32x4*)(out + o + bj * HALF) = w; } }
    }
};

template <class T, class = void> struct has_mid { static constexpr bool value = false; };
template <class T> struct has_mid<T, decltype((void)T::HAS_MID)> { static constexpr bool value = true; };
template <class Epi, class Sched, bool ALIGN_EPI = false, bool SP2 = false, bool GATHER = false, bool FP8 = false>
__device__ __forceinline__ void gemm_phase(PG8_LAS unsigned char* lds, const Gemm g, const Sched& S, const Epi& E, const int wave_id, const PG8_LAS unsigned short* gtab = nullptr) {
    typedef int i32x4 __attribute__((ext_vector_type(4))); typedef int i32x8 __attribute__((ext_vector_type(8)));
    static_assert(!GATHER || SP2, "GATHER needs the SP2 loop");
    int lane = (int)__builtin_amdgcn_mbcnt_hi(~0u, __builtin_amdgcn_mbcnt_lo(~0u, 0u)); asm volatile("" : "+v"(lane));
    const int wid = wave_id, tid = wid * 64 + lane, wr = wid >> 2, wc = wid & 3, fr = lane & 15, fq = lane >> 4;
    const int K = g.K, nt = K / BK;
    unsigned voffA[2], voffB[2];
#pragma unroll
    for (int i = 0; i < 2; ++i) { int R, C; stage_rc(tid * 16 + i * 8192, R, C); const int Rb = Epi::PERM ? ((R & ~31) + perm32(R & 31)) : R;
        voffA[i] = (unsigned)(R * K + C) * 2u; voffB[i] = (unsigned)(Rb * K + C) * 2u; }
    unsigned vA0[2] = {0u, 0u}, vA1[2] = {0u, 0u}, xA0[2] = {0u, 0u}, xA1[2] = {0u, 0u};
#define PG8_GLOAD(d0, d1, ui_) do { int tz_ = wid * 64 + (int)__builtin_amdgcn_mbcnt_hi(~0u, __builtin_amdgcn_mbcnt_lo(~0u, 0u)); asm volatile("" : "+v"(tz_)); _Pragma("unroll") for (int _i = 0; _i < 2; ++_i) { int R_, C_; stage_rc(tz_ * 16 + _i * 8192, R_, C_); \
        d0[_i] = (unsigned)gtab[256 * (ui_) + R_] * (unsigned)(K * 2) + (unsigned)C_ * 2u; d1[_i] = (unsigned)gtab[256 * (ui_) + 128 + R_] * (unsigned)(K * 2) + (unsigned)C_ * 2u; } } while (0)
    const unsigned kstep = (unsigned)(BK * 2);
    const unsigned hstep = (unsigned)HALF * K * 2;
    const unsigned tstep = 2 * hstep;
    const __amdgpu_buffer_rsrc_t rsA = __builtin_amdgcn_make_buffer_rsrc((void*)g.A, 0, 0x7fffffff, 0x00020000), rsB = __builtin_amdgcn_make_buffer_rsrc((void*)g.Bt, 0, 0x7fffffff, 0x00020000);
    const unsigned ldsw = (unsigned)wid * 1024u;
    const int aoff = lds_byte(wr * 64 + fr, fq * 8), boff = lds_byte(wc * 32 + fr, fq * 8);
#define PG8_SA(b, h) (((b) * 2 + (h)) * HTB)
#define PG8_SB(b, h) ((4 + (b) * 2 + (h)) * HTB)
#define PG8_STAGE(bufoff, rs, soff, voff) do { _Pragma("unroll") for (int _i = 0; _i < 2; ++_i) \
        __builtin_amdgcn_raw_ptr_buffer_load_lds(rs, (PG8_LAS void*)(lds + (bufoff) + ldsw + _i * 8192), 16, (int)(voff)[_i], (int)(soff), 0, 0); } while (0)
#define PG8_LDA(dst, b, h) do { if constexpr (FP8) { _Pragma("unroll") for (int m = 0; m < 4; ++m) dst##_8[m] = __builtin_shufflevector(*(const PG8_LAS i32x4*)(lds + PG8_SA(b, h) + aoff + m * 2048), *(const PG8_LAS i32x4*)(lds + PG8_SA(b, h) + aoff + m * 2048 + 1024), 0, 1, 2, 3, 4, 5, 6, 7); } \
        else { _Pragma("unroll") for (int m = 0; m < 4; ++m) _Pragma("unroll") for (int k = 0; k < 2; ++k) dst[m][k] = *(const PG8_LAS bf16x8*)(lds + PG8_SA(b, h) + aoff + m * 2048 + k * 1024); } } while (0)
#define PG8_LDB(dst, b, h) do { if constexpr (FP8) { _Pragma("unroll") for (int n = 0; n < 2; ++n) dst##_8[n] = __builtin_shufflevector(*(const PG8_LAS i32x4*)(lds + PG8_SB(b, h) + boff + n * 2048), *(const PG8_LAS i32x4*)(lds + PG8_SB(b, h) + boff + n * 2048 + 1024), 0, 1, 2, 3, 4, 5, 6, 7); } \
        else { _Pragma("unroll") for (int n = 0; n < 2; ++n) _Pragma("unroll") for (int k = 0; k < 2; ++k) dst[n][k] = *(const PG8_LAS bf16x8*)(lds + PG8_SB(b, h) + boff + n * 2048 + k * 1024); } } while (0)
#define PG8_MMA(ai, bj, At, Bt) do { __builtin_amdgcn_s_setprio(1); if constexpr (FP8) { _Pragma("unroll") for (int m = 0; m < 4; ++m) _Pragma("unroll") for (int n = 0; n < 2; ++n) \
        asm volatile("v_mfma_scale_f32_16x16x128_f8f6f4 %0, %1, %2, %0, %3, %3 op_sel_hi:[0,0,0]" : "+v"(acc[ai][bj][m][n]) : "v"(Bt##_8[n]), "v"(At##_8[m]), "v"(sc8));     \
        } else { _Pragma("unroll") for (int m = 0; m < 4; ++m) _Pragma("unroll") for (int n = 0; n < 2; ++n) _Pragma("unroll") for (int k = 0; k < 2; ++k) \
        acc[ai][bj][m][n] = __builtin_amdgcn_mfma_f32_16x16x32_bf16(Bt[n][k], At[m][k], acc[ai][bj][m][n], 0, 0, 0); } __builtin_amdgcn_s_setprio(0); } while (0)
#define PG8_WAIT_V(n) asm volatile("s_waitcnt vmcnt(" #n ")" ::: "memory")
#define PG8_WAIT_L(n) asm volatile("s_waitcnt lgkmcnt(" #n ")" ::: "memory")
#define PG8_BAR __builtin_amdgcn_s_barrier()
#define PG8_SCHED __builtin_amdgcn_sched_barrier(0)
    Unit cur, nxt; int ui = 0;
    if (!S.next(0, cur)) return;
    f32x4 acc[2][2][4][2];
#pragma unroll
    for (int a = 0; a < 2; ++a)
#pragma unroll
        for (int b = 0; b < 2; ++b)
#pragma unroll
            for (int m = 0; m < 4; ++m)
#pragma unroll
                for (int n = 0; n < 2; ++n) acc[a][b][m][n] = (f32x4){0.f, 0.f, 0.f, 0.f};
    int sc8 = 0x7f7f7f7f; asm volatile("" : "+v"(sc8));
    bf16x8 At[4][2], B0[2][2], B1[2][2]; i32x8 At_8[4], B0_8[2], B1_8[2];
    unsigned cA = GATHER ? 0u : (unsigned)cur.pm * tstep, cB = (unsigned)cur.pn * tstep;
    S.a_ready(cur);
    if constexpr (GATHER) { PG8_GLOAD(vA0, vA1, 0); xA0[0] = vA0[0]; xA0[1] = vA0[1]; xA1[0] = vA1[0]; xA1[1] = vA1[1]; }
    if constexpr (SP2) {
        PG8_STAGE(PG8_SB(0, 0), rsB, cB, voffB); PG8_STAGE(PG8_SB(0, 1), rsB, cB + hstep, voffB);
        if constexpr (GATHER) { PG8_STAGE(PG8_SA(0, 0), rsA, cA, vA0); PG8_STAGE(PG8_SA(0, 1), rsA, cA, vA1); } else { PG8_STAGE(PG8_SA(0, 0), rsA, cA, voffA); PG8_STAGE(PG8_SA(0, 1), rsA, cA + hstep, voffA); }
        if (wr == 1) PG8_BAR;
        PG8_WAIT_V(2); PG8_BAR;
        PG8_STAGE(PG8_SB(1, 0), rsB, cB + kstep, voffB); if constexpr (GATHER) { PG8_STAGE(PG8_SA(1, 0), rsA, cA + kstep, vA0); } else { PG8_STAGE(PG8_SA(1, 0), rsA, cA + kstep, voffA); } PG8_STAGE(PG8_SB(1, 1), rsB, cB + hstep + kstep, voffB);
        PG8_WAIT_V(6); PG8_BAR;
    } else {
        PG8_STAGE(PG8_SB(0, 0), rsB, cB, voffB); PG8_STAGE(PG8_SA(0, 0), rsA, cA, voffA); PG8_STAGE(PG8_SB(0, 1), rsB, cB + hstep, voffB); PG8_STAGE(PG8_SA(0, 1), rsA, cA + hstep, voffA);
        if (wr == 1) PG8_BAR;
        PG8_WAIT_V(4); PG8_BAR;
        PG8_STAGE(PG8_SB(1, 0), rsB, cB + kstep, voffB); PG8_STAGE(PG8_SA(1, 0), rsA, cA + kstep, voffA); PG8_STAGE(PG8_SB(1, 1), rsB, cB + hstep + kstep, voffB);
        PG8_WAIT_V(6); PG8_BAR;
    }
    for (;;) {
        const bool has_next = S.next(ui + 1, nxt);
        const unsigned nA = GATHER ? cA : (has_next ? (unsigned)nxt.pm * tstep : cA), nB = has_next ? (unsigned)nxt.pn * tstep : cB;
        for (int t = 0; t < nt; t += 2) {
            const bool last = (t == nt - 2);
            const unsigned a1 = cA + (unsigned)(t + 1) * kstep;
            const unsigned a2 = last ? nA : cA + (unsigned)(t + 2) * kstep, b2 = last ? nB : cB + (unsigned)(t + 2) * kstep;
            const unsigned a3 = a2 + kstep, b3 = b2 + kstep;
            if (last && has_next) S.a_ready(nxt);
            if constexpr (has_mid<Epi>::value) { if (t == nt / 2) { int l3_ = (int)__builtin_amdgcn_mbcnt_hi(~0u, __builtin_amdgcn_mbcnt_lo(~0u, 0u)); asm volatile("" : "+v"(l3_)); E.mid(acc, cur, wr, wc, l3_ & 15, l3_ >> 4); } }
            if constexpr (GATHER) { if (last && has_next) { PG8_GLOAD(xA0, xA1, ui + 1); } }
            if constexpr (SP2) {
            PG8_LDB(B0, 0, 0); PG8_LDB(B1, 0, 1); PG8_SCHED; PG8_LDA(At, 0, 0); if constexpr (GATHER) { PG8_STAGE(PG8_SA(1, 1), rsA, a1, vA1); } else { PG8_STAGE(PG8_SA(1, 1), rsA, a1 + hstep, voffA); }
            PG8_WAIT_V(8); PG8_WAIT_L(0); PG8_BAR; PG8_MMA(0, 0, At, B0); PG8_MMA(0, 1, At, B1); PG8_BAR; PG8_SCHED;
            PG8_LDA(At, 0, 1); PG8_STAGE(PG8_SB(0, 0), rsB, b2, voffB); PG8_STAGE(PG8_SB(0, 1), rsB, b2 + hstep, voffB); if constexpr (GATHER) { PG8_STAGE(PG8_SA(0, 0), rsA, a2, xA0); } else { PG8_STAGE(PG8_SA(0, 0), rsA, a2, voffA); }
            PG8_WAIT_V(8); PG8_WAIT_L(0); PG8_BAR; PG8_MMA(1, 0, At, B0); PG8_MMA(1, 1, At, B1); PG8_BAR; PG8_SCHED;
            PG8_LDB(B0, 1, 0); PG8_LDB(B1, 1, 1); PG8_SCHED; PG8_LDA(At, 1, 0); if constexpr (GATHER) { PG8_STAGE(PG8_SA(0, 1), rsA, a2, xA1); } else { PG8_STAGE(PG8_SA(0, 1), rsA, a2 + hstep, voffA); }
            PG8_WAIT_V(8); PG8_WAIT_L(0); PG8_BAR; PG8_MMA(0, 0, At, B0); PG8_MMA(0, 1, At, B1); PG8_BAR; PG8_SCHED;
            PG8_LDA(At, 1, 1); PG8_STAGE(PG8_SB(1, 0), rsB, b3, voffB); PG8_STAGE(PG8_SB(1, 1), rsB, b3 + hstep, voffB); if constexpr (GATHER) { PG8_STAGE(PG8_SA(1, 0), rsA, a3, xA0); } else { PG8_STAGE(PG8_SA(1, 0), rsA, a3, voffA); }
            PG8_WAIT_V(8); PG8_WAIT_L(0); PG8_BAR; PG8_MMA(1, 0, At, B0); PG8_MMA(1, 1, At, B1); PG8_BAR; PG8_SCHED;
            } else {
            PG8_LDB(B0, 0, 0); PG8_SCHED; PG8_LDA(At, 0, 0); PG8_STAGE(PG8_SA(1, 1), rsA, a1 + hstep, voffA);
            PG8_WAIT_L(8); PG8_BAR; PG8_WAIT_L(0); PG8_MMA(0, 0, At, B0); PG8_BAR; PG8_SCHED;
            PG8_LDB(B1, 0, 1); PG8_STAGE(PG8_SB(0, 0), rsB, b2, voffB);
            PG8_BAR; PG8_WAIT_L(0); PG8_MMA(0, 1, At, B1); PG8_BAR;
            PG8_LDA(At, 0, 1); PG8_STAGE(PG8_SA(0, 0), rsA, a2, voffA);
            PG8_BAR; PG8_WAIT_L(0); PG8_MMA(1, 0, At, B0); PG8_BAR; PG8_SCHED;
            PG8_STAGE(PG8_SB(0, 1), rsB, b2 + hstep, voffB);
            PG8_WAIT_V(6); PG8_BAR; PG8_MMA(1, 1, At, B1); PG8_BAR;
            PG8_LDB(B0, 1, 0); PG8_SCHED; PG8_LDA(At, 1, 0); PG8_STAGE(PG8_SA(0, 1), rsA, a2 + hstep, voffA);
            PG8_WAIT_L(8); PG8_BAR; PG8_WAIT_L(0); PG8_MMA(0, 0, At, B0); PG8_BAR; PG8_SCHED;
            PG8_LDB(B1, 1, 1); PG8_STAGE(PG8_SB(1, 0), rsB, b3, voffB);
            PG8_BAR; PG8_WAIT_L(0); PG8_MMA(0, 1, At, B1); PG8_BAR;
            PG8_LDA(At, 1, 1); PG8_STAGE(PG8_SA(1, 0), rsA, a3, voffA);
            PG8_BAR; PG8_WAIT_L(0); PG8_MMA(1, 0, At, B0); PG8_BAR; PG8_SCHED;
            PG8_STAGE(PG8_SB(1, 1), rsB, b3 + hstep, voffB);
            PG8_WAIT_V(6); PG8_BAR; PG8_MMA(1, 1, At, B1); PG8_BAR;
            }
        }
        if constexpr (ALIGN_EPI) { if (wr == 0) PG8_BAR; }
        if constexpr (!Epi::AFTER_DRAIN) { int l2_ = (int)__builtin_amdgcn_mbcnt_hi(~0u, __builtin_amdgcn_mbcnt_lo(~0u, 0u)); asm volatile("" : "+v"(l2_));
            E(acc, cur, wr, wc, l2_ & 15, l2_ >> 4); S.done(cur); }
        if (!has_next) break;
#pragma unroll
        for (int a = 0; a < 2; ++a)
#pragma unroll
            for (int b = 0; b < 2; ++b)
#pragma unroll
                for (int m = 0; m < 4; ++m)
#pragma unroll
                    for (int n = 0; n < 2; ++n) acc[a][b][m][n] = (f32x4){0.f, 0.f, 0.f, 0.f};
        cur = nxt; cA = nA; cB = nB; ++ui;
        if constexpr (GATHER) { vA0[0] = xA0[0]; vA0[1] = xA0[1]; vA1[0] = xA1[0]; vA1[1] = xA1[1]; }
        if constexpr (ALIGN_EPI) { if (wr == 1) PG8_BAR; }
    }
    PG8_WAIT_V(0);
    if constexpr (!ALIGN_EPI) { if (wr == 0) PG8_BAR; }
    PG8_BAR;
    if constexpr (Epi::AFTER_DRAIN) { E.fused(acc, cur, wr, wc, fr, fq, lds, wid, lane); S.done(cur); }
#undef PG8_GLOAD
#undef PG8_SA
#undef PG8_SB
#undef PG8_STAGE
#undef PG8_LDA
#undef PG8_LDB
#undef PG8_MMA
#undef PG8_WAIT_V
#undef PG8_WAIT_L
#undef PG8_BAR
#undef PG8_SCHED
}
}
#define XB_TMO      128
#define XB_XCNT(j)  (256  + 64 * (j))
#define XB_XSUB(j)  (1280 + 64 * (j))
#define XB_XGEN(j)  (2304 + 64 * (j))
#define XB_TOP      3328
#define XB_TOPGEN   3392
#define XCD_BAR_WORDS 3456
#define XB_SPIN_CAP (1u << 18)

__device__ __forceinline__ unsigned xb_ld(unsigned* p)              { return __hip_atomic_load(p, __ATOMIC_RELAXED, __HIP_MEMORY_SCOPE_AGENT); }
__device__ __forceinline__ unsigned xb_add(unsigned* p, unsigned v) { return __hip_atomic_fetch_add(p, v, __ATOMIC_RELAXED, __HIP_MEMORY_SCOPE_AGENT); }
__device__ __forceinline__ unsigned xb_xcc_id() { return (unsigned)__builtin_amdgcn_s_getreg((3 << 11) | 20) & 0xFu; }
#define XB_SPIN(cond, bar) do { unsigned _sp = 0; while (cond) { __builtin_amdgcn_s_sleep(1); \
    if ((++_sp & 255u) == 0u) { if (xb_ld(&(bar)[XB_TMO])) break; if (_sp > XB_SPIN_CAP) { atomicAdd(&(bar)[XB_TMO], 1u); break; } } } } while (0)

struct XcdBarrier {
    unsigned* bar; unsigned x;
    volatile LAS unsigned* st;
};

__device__ __forceinline__ XcdBarrier xcd_barrier_post(unsigned* bar, volatile LAS unsigned* st, const bool leader  ) {
    XcdBarrier b; b.bar = bar; b.x = xb_xcc_id(); b.st = st;
    if (leader) (void)xb_add(&bar[XB_XCNT(b.x)], 1u);
    return b;
}
__device__ __forceinline__ void xcd_barrier_complete(unsigned* bar, unsigned x, unsigned& nloc, unsigned& nx) {
    const unsigned G = gridDim.x * gridDim.y * gridDim.z;
    unsigned sum, cnt, mine, sp = 0u;
    for (;;) {
        sum = 0u; cnt = 0u; mine = 0u;
#pragma unroll
        for (unsigned j = 0; j < 16; ++j) { const unsigned c = xb_ld(&bar[XB_XCNT(j)]); sum += c; cnt += (c > 0u) ? 1u : 0u; mine = (j == x) ? c : mine; }
        if (sum == G) break;
        __builtin_amdgcn_s_sleep(1);
        if ((++sp & 255u) == 0u) { if (xb_ld(&bar[XB_TMO])) break; if (sp > XB_SPIN_CAP) { atomicAdd(&bar[XB_TMO], 1u); break; } }
    }
    nloc = mine > 0u ? mine : 1u; nx = cnt > 0u ? cnt : 1u;
}

__device__ __forceinline__ void xcd_barrier(const XcdBarrier& b, const bool leader  ) {
    asm volatile("s_waitcnt vmcnt(0)" ::: "memory");
    __syncthreads();
    if (leader) {
        unsigned* bar = b.bar;
        __builtin_amdgcn_s_waitcnt(0);
        unsigned nloc = b.st[0], nx = b.st[1];
        if (nloc == 0u) { xcd_barrier_complete(bar, b.x, nloc, nx); b.st[0] = nloc; b.st[1] = nx; }
        const unsigned old = xb_add(&bar[XB_XSUB(b.x)], 1u);
        const unsigned gen = old / nloc;
        if (old + 1u == (gen + 1u) * nloc) {
            __builtin_amdgcn_fence(__ATOMIC_RELEASE, "agent");
            asm volatile("s_waitcnt vmcnt(0)" ::: "memory");
            const unsigned og = xb_add(&bar[XB_TOP], 1u);
            const unsigned tg = og / nx;
            if (og + 1u == (tg + 1u) * nx) xb_add(&bar[XB_TOPGEN], 1u);
            else XB_SPIN(xb_ld(&bar[XB_TOPGEN]) == tg, bar);
            __builtin_amdgcn_fence(__ATOMIC_ACQUIRE, "agent");
            xb_add(&bar[XB_XGEN(b.x)], 1u);
            asm volatile("s_waitcnt vmcnt(0)" ::: "memory");
        } else {
            XB_SPIN(xb_ld(&bar[XB_XGEN(b.x)]) == gen, bar);
            __builtin_amdgcn_fence(__ATOMIC_ACQUIRE, "agent");
            asm volatile("s_waitcnt vmcnt(0)" ::: "memory");
        }
    }
    __syncthreads();
}

#ifndef P_FP8_MASK
#define P_FP8_MASK 0xFFFFFFFFu
#endif =======================================================
struct Ctx { LAS unsigned char* lds; int tid, lane, wave, vcu, G; };

__device__ __forceinline__ void transpose_load64(const float* W, int ldw, int k0, int n0, LAS float* scr, int lane) {
#pragma unroll 8
    for (int i = 0; i < 16; ++i) { const int kk = 4 * i + (lane >> 4), nn = 4 * (lane & 15); const f32x4 v = *(const f32x4*)(W + (size_t)(k0 + kk) * ldw + n0 + nn);
        LAS float* d = scr + kk * 65 + nn; d[0] = v.x; d[1] = v.y; d[2] = v.z; d[3] = v.w; }
    LDS_WAIT();
}
__device__ __forceinline__ void transpose_item(const float* W, int ldw, int K, bf16_t* dst, int k0, int n0, LAS float* scr, int lane) {
    transpose_load64(W, ldw, k0, n0, scr, lane);
    const int c = lane & 7;
#pragma unroll
    for (int j = 0; j < 8; ++j) { const int n = (lane >> 3) + 8 * j; const LAS float* s = scr + (8 * c) * 65 + n;
        u32x4 o; o.x = pk2(s[0 * 65], s[1 * 65]); o.y = pk2(s[2 * 65], s[3 * 65]); o.z = pk2(s[4 * 65], s[5 * 65]); o.w = pk2(s[6 * 65], s[7 * 65]);
        *(u32x4*)(dst + (size_t)n * K + k0 + 8 * c) = o; }
    LDS_WAIT();
}
__device__ __forceinline__ void transpose_item8(const float* W, int ldw, int K, unsigned char* dst, int k0, int n0, float scale, LAS float* scr, int lane) {
    transpose_load64(W, ldw, k0, n0, scr, lane);
    const int c = lane & 3;
#pragma unroll
    for (int j = 0; j < 4; ++j) { const int n = (lane >> 2) + 16 * j; const LAS float* s = scr + (16 * c) * 65 + n;
        u32x4 o; o.x = cvt4_fp8(s[0 * 65] * scale, s[1 * 65] * scale, s[2 * 65] * scale, s[3 * 65] * scale); o.y = cvt4_fp8(s[4 * 65] * scale, s[5 * 65] * scale, s[6 * 65] * scale, s[7 * 65] * scale);
        o.z = cvt4_fp8(s[8 * 65] * scale, s[9 * 65] * scale, s[10 * 65] * scale, s[11 * 65] * scale); o.w = cvt4_fp8(s[12 * 65] * scale, s[13 * 65] * scale, s[14 * 65] * scale, s[15 * 65] * scale);
        *(u32x4*)(dst + (size_t)n * K + k0 + 16 * c) = o; }
    LDS_WAIT();
}

template <int PART>
__device__ __forceinline__ void ph_prologue(const Ctx& X, const float* c, const float* w_ada, const float* b_ada, float* mod,
                                            const float* w_in, const float* w_conv_out, const float* w_hgrn_out, const float* w_out, const float* w1, const float* w2, unsigned char* ws) {
    if (PART == 0 && X.vcu < 48) {
        LAS float* ca = (LAS float*)X.lds;
        LAS float* red = (LAS float*)(X.lds + 16384);
        for (int i = X.tid; i < 4096; i += 512) { const float v = c[i]; ca[i] = v * sigmoidf_(v); }
        __syncthreads();
        const int jj = X.tid & 127, kq = X.tid >> 7, j = X.vcu * 128 + jj;
        float a0 = 0.f, a1 = 0.f, a2 = 0.f, a3 = 0.f;
#pragma unroll 8
        for (int i = kq * 256; i < kq * 256 + 256; ++i) { const float w = w_ada[(size_t)i * NMOD + j]; a0 += ca[i] * w; a1 += ca[1024 + i] * w; a2 += ca[2048 + i] * w; a3 += ca[3072 + i] * w; }
        red[(kq * 4 + 0) * 128 + jj] = a0; red[(kq * 4 + 1) * 128 + jj] = a1; red[(kq * 4 + 2) * 128 + jj] = a2; red[(kq * 4 + 3) * 128 + jj] = a3;
        __syncthreads();
        { const int b = X.tid >> 7; mod[(size_t)b * NMOD + j] = b_ada[j] + red[(0 * 4 + b) * 128 + jj] + red[(1 * 4 + b) * 128 + jj] + red[(2 * 4 + b) * 128 + jj] + red[(3 * 4 + b) * 128 + jj]; }
        __syncthreads();
    }
    LAS float* scr = (LAS float*)(X.lds + X.wave * 16640);
    const int gw = X.vcu * 8 + X.wave, NGW = X.G * 8;
    constexpr int I_IN = 16 * 128, I_SQ = 16 * 16, I_W1 = 32 * 16 * 32, I_W2 = 32 * 16 * 16, NITEMS = I_IN + 3 * I_SQ + I_W1 + I_W2;
    constexpr int I_DENSE = I_IN + 3 * I_SQ;
    for (int it = (PART == 0 ? 0 : I_DENSE) + gw; it < (PART == 0 ? I_DENSE : NITEMS); it += NGW) {
        int r = it;
        if (r < I_IN) { const int kb = r >> 7, nb = r & 127, n0 = 64 * nb;
            const int rho0 = (n0 < 2048) ? 256 * ((n0 & 1023) >> 7) + 128 * (n0 >> 10) + (n0 & 127) : n0;
            if ((P_FP8_MASK >> (rho0 >> 8)) & 1u) transpose_item8(w_in, 8192, 1024, (unsigned char*)(ws + WS_WIN8) + (size_t)rho0 * 1024, 64 * kb, n0, 256.0f, scr, X.lane);
            else transpose_item(w_in, 8192, 1024, (bf16_t*)(ws + WS_WIN) + (size_t)rho0 * 1024, 64 * kb, n0, scr, X.lane);
            continue; } r -= I_IN;
        if (r < 3 * I_SQ) { const int which = r / I_SQ, q = r % I_SQ, kb = q >> 4, nb = q & 15;
            const float* W = which == 0 ? w_conv_out : (which == 1 ? w_hgrn_out : w_out);
            if (which == 2) transpose_item(W, 1024, 1024, (bf16_t*)(ws + WS_WO) + (size_t)(64 * nb) * 1024, 64 * kb, 64 * nb, scr, X.lane);
            else transpose_item(W, 1024, 2048, (bf16_t*)(ws + WS_WC) + (size_t)(64 * nb) * 2048 + which * 1024, 64 * kb, 64 * nb, scr, X.lane);
            continue; } r -= 3 * I_SQ;
        if (r < I_W1) { const int e = r >> 9, q = r & 511, kb = q >> 5, nb = q & 31, n0 = 64 * nb;
            const int rho0 = (n0 < 1024) ? 256 * (n0 >> 7) + (n0 & 127) : 256 * ((n0 - 1024) >> 7) + 128 + ((n0 - 1024) & 127);
            transpose_item8(w1 + (size_t)e * 1024 * 2048, 2048, 1024, (unsigned char*)(ws + WS_W1) + ((size_t)e * 2048 + rho0) * 1024, 64 * kb, n0, 256.0f, scr, X.lane); continue; } r -= I_W1;
        { const int e = r >> 8, q = r & 255, kb = q >> 4, nb = q & 15;
            transpose_item8(w2 + (size_t)e * 1024 * 1024, 1024, 1024, (unsigned char*)(ws + WS_W2) + ((size_t)e * 1024 + 64 * nb) * 1024, 64 * kb, 64 * nb, 256.0f, scr, X.lane); }
    }
    __syncthreads();
}

__device__ __forceinline__ void ph_norm_mod(const Ctx& X, const float* x, const float* g, const float* mod, int sh_off, int sc_off, bf16_t* out, unsigned char* out8) {
    for (int t = X.vcu * 8 + X.wave; t < T; t += X.G * 8) {
        const int b = t / SEQ, lane = X.lane;
        const f32x4* xr = (const f32x4*)(x + (size_t)t * D) + lane;
        f32x4 v[4]; float ss = 0.f;
#pragma unroll
        for (int j = 0; j < 4; ++j) { v[j] = xr[64 * j]; ss += (v[j].x * v[j].x + v[j].y * v[j].y) + (v[j].z * v[j].z + v[j].w * v[j].w); }
        const float r = rsqrtf(wave_sum(ss) * (1.0f / D) + EPS);
        const float* sh = mod + (size_t)b * NMOD + sh_off; const float* sc = mod + (size_t)b * NMOD + sc_off;
#pragma unroll
        for (int j = 0; j < 4; ++j) {
            const int col = 4 * (lane + 64 * j);
            const f32x4 gg = *(const f32x4*)(g + col), s1 = *(const f32x4*)(sc + col), s0 = *(const f32x4*)(sh + col);
            const f32x4 y = v[j] * r * gg * (s1 + 1.0f) + s0;
            if (P_FP8_MASK != 0xFFFFFFFFu) { u32x2 w; w.x = pk2(y.x, y.y); w.y = pk2(y.z, y.w); *(u32x2*)(out + (size_t)t * D + col) = w; }
            if (P_FP8_MASK != 0u) *(unsigned*)(out8 + (size_t)t * D + col) = cvt4_fp8(y.x * 16.0f, y.y * 16.0f, y.z * 16.0f, y.w * 16.0f);
        }
    }
}

__device__ __forceinline__ void ph_conv(const Ctx& X, const bf16_t* pU, const float* dw, const float* dwb, const float* lng, const float* lnb, bf16_t* uc) {
    LAS float* sm = (LAS float*)X.lds;
    const int tid = X.tid, lane = X.lane, wid = X.wave, c0 = 2 * tid;
    float w[31][2];
#pragma unroll
    for (int j = 0; j < 31; ++j) { w[j][0] = dw[j * 1024 + c0]; w[j][1] = dw[j * 1024 + c0 + 1]; }
    const float bias0 = dwb[c0], bias1 = dwb[c0 + 1];
    for (int task = X.vcu; task < T / 32; task += X.G) {
        const int b = task >> 8, s0 = (task & 255) * 32;
        const bf16_t* qu = pU + (size_t)(b * SEQ) * D + c0;
        float u[38][2];
#pragma unroll
        for (int st = 0; st < 4; ++st) {
#pragma unroll
            for (int i = (st == 0 ? 0 : 8 * st + 30); i < 8 * st + 38; ++i) {
                const int s = s0 - 30 + i;
                float u0 = 0.f, u1 = 0.f;
                if (s >= 0) { const unsigned u2 = *(const unsigned*)(qu + (size_t)s * D); u0 = bflo(u2); u1 = bfhi(u2); }
                u[i % 38][0] = u0; u[i % 38][1] = u1;
            }
#pragma unroll
            for (int t = 8 * st; t < 8 * st + 8; ++t) {
                float a0 = bias0, a1 = bias1;
#pragma unroll
                for (int j = 0; j < 31; ++j) { a0 += w[j][0] * u[(t + j) % 38][0]; a1 += w[j][1] * u[(t + j) % 38][1]; }
                sm[t * 1024 + c0] = a0; sm[t * 1024 + c0 + 1] = a1;
            }
        }
        __syncthreads();
#pragma unroll 1
        for (int i = 0; i < 4; ++i) {
            const int t = wid * 4 + i;
            f32x4 v[4]; float s = 0.f;
#pragma unroll
            for (int j = 0; j < 4; ++j) { v[j] = *(const LAS f32x4*)(sm + t * 1024 + 4 * (lane + 64 * j)); s += (v[j].x + v[j].y) + (v[j].z + v[j].w); }
            const float mean = wave_sum(s) * (1.0f / D); float q = 0.f;
#pragma unroll
            for (int j = 0; j < 4; ++j) { v[j] = v[j] - mean; q += (v[j].x * v[j].x + v[j].y * v[j].y) + (v[j].z * v[j].z + v[j].w * v[j].w); }
            const float rstd = rsqrtf(wave_sum(q) * (1.0f / D) + EPS);
#pragma unroll
            for (int j = 0; j < 4; ++j) {
                const int col = 4 * (lane + 64 * j);
                const f32x4 gg = *(const f32x4*)(lng + col), bb = *(const f32x4*)(lnb + col);
                f32x4 y = v[j] * rstd * gg + bb;
                y.x *= sigmoidf_(y.x); y.y *= sigmoidf_(y.y); y.z *= sigmoidf_(y.z); y.w *= sigmoidf_(y.w);
                u32x2 o; o.x = pk2(y.x, y.y); o.y = pk2(y.z, y.w);
                *(u32x2*)(uc + (size_t)(b * SEQ + s0 + t) * (2 * D) + col) = o;
            }
        }
        __syncthreads();
    }
}

typedef short bf16x8 __attribute__((ext_vector_type(8)));
typedef short s16x4 __attribute__((ext_vector_type(4)));
typedef float f32x2 __attribute__((ext_vector_type(2)));
constexpr int HG_QA = 0, HG_KA = 17408, HG_VR = 34816, HG_AB = 52224, HG_SPT = 61440, HG_O = 96256, HG_SEG = 130048;
constexpr size_t HM = (size_t)SEQ * 128;
__device__ __forceinline__ bf16x8 tr_frag(LAS unsigned char* base, int rs, int ks, int c16, int lane) {
    const int g = lane >> 4, q = (lane & 15) >> 2, p = lane & 3;
    LAS unsigned char* a = base + (32 * ks + 8 * g + q) * rs + (16 * c16 + 4 * p) * 2;
    const s16x4 lo = __builtin_amdgcn_ds_read_tr16_b64_v4i16((LAS s16x4*)a);
    const s16x4 hi = __builtin_amdgcn_ds_read_tr16_b64_v4i16((LAS s16x4*)(a + 4 * rs));
    return __builtin_shufflevector(lo, hi, 0, 1, 2, 3, 4, 5, 6, 7);
}
template <bool OUT>
__device__ __forceinline__ void ph_hgrn(const Ctx& X, int ntask, const bf16_t* pQ, const bf16_t* pF, const bf16_t* pI, const bf16_t* pG,
                                        const float* lb_param, const float* norm_g, const float* S0, float* dS, float* Dd, bf16_t* og) {
    LAS unsigned char* L = X.lds;
    LAS float* seg_s = (LAS float*)(L + HG_SEG);
    const int tid = X.tid, lane = X.lane, wave = X.wave, fr = lane & 15, fq = lane >> 4, wr = wave >> 1, wc = wave & 1;
    const int cp = tid & 63, seg = wave, tv = tid >> 3, vc = tid & 7;
    int idx = X.vcu; if (idx >= ntask) return;
    int ch = 0;
    unsigned zr[8], qr[8]; u32x4 vr0, vr1, gn0, gn1, gc0, gc1;
#define HG_LOAD(idx_, ch_) do { const int bh_ = (idx_) & 31, sc_ = (idx_) >> 5; const size_t tb_ = (size_t)bh_ * HM + (size_t)(sc_ * 256 + (ch_) * 64) * 128; \
        _Pragma("unroll") for (int i = 0; i < 8; ++i) { zr[i] = *(const unsigned*)(pF + tb_ + (size_t)(8 * seg + i) * 128 + 2 * cp); if (OUT) qr[i] = *(const unsigned*)(pQ + tb_ + (size_t)(8 * seg + i) * 128 + 2 * cp); } \
        { const u32x4* s_ = (const u32x4*)(pI + tb_ + (size_t)tv * 128 + vc * 16); vr0 = s_[0]; vr1 = s_[1]; } \
        if (OUT) { const u32x4* s_ = (const u32x4*)(pG + tb_ + (size_t)tv * 128 + vc * 16); gn0 = s_[0]; gn1 = s_[1]; } } while (0)
    HG_LOAD(idx, 0);
    float ngv[16];
    if (OUT) {
#pragma unroll
        for (int i = 0; i < 16; ++i) ngv[i] = norm_g[vc * 16 + i];
    }
    f32x4 S[8]; float oml0 = 0.f, oml1 = 0.f, gsum0 = 0.f, gsum1 = 0.f;
#pragma unroll 1
    for (;;) {
        const int sc = idx >> 5, bh = idx & 31, b = bh >> 3, h = bh & 7;
        if (ch == 0) {
            const int c0 = h * 128 + 2 * cp;
            oml0 = 1.0f - 1.0f / (1.0f + __expf(lb_param[1024 + c0] - lb_param[c0])); oml1 = 1.0f - 1.0f / (1.0f + __expf(lb_param[1025 + c0] - lb_param[c0 + 1]));
            gsum0 = 0.f; gsum1 = 0.f;
            if (OUT && sc > 0) { const float* s0 = S0 + (size_t)(bh * 32 + sc) * 16384;
#pragma unroll
                for (int vt = 0; vt < 8; ++vt)
#pragma unroll
                    for (int j = 0; j < 4; ++j) S[vt][j] = s0[(size_t)(16 * wave + fq * 4 + j) * 128 + vt * 16 + fr];
            } else {
#pragma unroll
                for (int vt = 0; vt < 8; ++vt) S[vt] = (f32x4){0.f, 0.f, 0.f, 0.f};
            }
        }
        float kk0[8], kk1[8], lf0[8], lf1[8], q0[8], q1[8];
        {
            float c0 = 0.f, c1 = 0.f;
#pragma unroll
            for (int i = 0; i < 8; ++i) {
                kk0[i] = oml0 * __builtin_amdgcn_rcpf(1.0f + __expf(bflo(zr[i]))); kk1[i] = oml1 * __builtin_amdgcn_rcpf(1.0f + __expf(bfhi(zr[i])));
                c0 += __logf(1.0f - kk0[i]); c1 += __logf(1.0f - kk1[i]); lf0[i] = c0; lf1[i] = c1;
                if (OUT) { q0[i] = bflo(qr[i]) * 0.08838834764831845f; q1[i] = bfhi(qr[i]) * 0.08838834764831845f; }
            }
            *(LAS f32x2*)(seg_s + seg * 128 + 2 * cp) = (f32x2){c0, c1};
        }
        if (OUT) { gc0 = gn0; gc1 = gn1; }
        const u32x4 vcur0 = vr0, vcur1 = vr1;
        __syncthreads();
        { LAS u32x4* d = (LAS u32x4*)(L + HG_VR + tv * 272 + vc * 32); d[0] = vcur0; d[1] = vcur1; }
        { int idx2 = idx, ch2 = ch + 1; if (ch2 == 4) { ch2 = 0; idx2 = idx + X.G; } if (idx2 < ntask) HG_LOAD(idx2, ch2); }
        {
            f32x2 ss[8];
#pragma unroll
            for (int s = 0; s < 8; ++s) ss[s] = *(const LAS f32x2*)(seg_s + s * 128 + 2 * cp);
            float off0 = 0.f, off1 = 0.f;
#pragma unroll
            for (int s = 0; s < 8; ++s) { off0 += (s < seg) ? ss[s].x : 0.f; off1 += (s < seg) ? ss[s].y : 0.f; }
            const float R0 = (ss[0].x + ss[1].x) + (ss[2].x + ss[3].x), R1 = (ss[0].y + ss[1].y) + (ss[2].y + ss[3].y);
            if (!OUT && seg == 0) { gsum0 += R0 + (ss[4].x + ss[5].x) + (ss[6].x + ss[7].x); gsum1 += R1 + (ss[4].y + ss[5].y) + (ss[6].y + ss[7].y); }
#pragma unroll
            for (int i = 0; i < 8; ++i) {
                const float G0 = off0 + lf0[i], G1 = off1 + lf1[i];
                const float ka0 = kk0[i] * __expf(fminf(R0 - G0, 80.0f)), ka1 = kk1[i] * __expf(fminf(R1 - G1, 80.0f));
                *(LAS unsigned*)(L + HG_KA + (8 * seg + i) * 272 + 4 * cp) = pk2(ka0, ka1);
                if (OUT) { const float qa0 = q0[i] * __expf(fminf(G0 - R0, 80.0f)), qa1 = q1[i] * __expf(fminf(G1 - R1, 80.0f));
                           *(LAS unsigned*)(L + HG_QA + (8 * seg + i) * 272 + 4 * cp) = pk2(qa0, qa1); }
            }
        }
        float eR[4], eL[4];
        {
            f32x4 r4 = (f32x4){0.f, 0.f, 0.f, 0.f}, l4 = (f32x4){0.f, 0.f, 0.f, 0.f};
#pragma unroll
            for (int s = 0; s < 4; ++s) { r4 += *(const LAS f32x4*)(seg_s + s * 128 + 16 * wave + 4 * fq); l4 += *(const LAS f32x4*)(seg_s + (s + 4) * 128 + 16 * wave + 4 * fq); }
#pragma unroll
            for (int j = 0; j < 4; ++j) { eR[j] = __expf(fmaxf(r4[j], -80.0f)); eL[j] = __expf(l4[j]); }
        }
#pragma unroll
        for (int vt = 0; vt < 8; ++vt) {
#pragma unroll
            for (int j = 0; j < 4; ++j) S[vt][j] *= eR[j];
            if (OUT) { u32x2 w; w.x = pk2(S[vt][0], S[vt][1]); w.y = pk2(S[vt][2], S[vt][3]);
                       *(LAS u32x2*)(L + HG_SPT + (vt * 16 + fr) * 272 + (16 * wave + 4 * fq) * 2) = w; }
        }
        __syncthreads();
        if (OUT) {
#pragma unroll
            for (int q2 = 0; q2 < 2; ++q2) {
                const int st = 2 * wc + q2;
                f32x4 acc = (f32x4){0.f, 0.f, 0.f, 0.f};
                if (st <= wr) {
#pragma unroll
                    for (int kq = 0; kq < 4; ++kq) {
                        const bf16x8 af = *(const LAS bf16x8*)(L + HG_KA + (st * 16 + fr) * 272 + kq * 64 + fq * 16);
                        const bf16x8 bq = *(const LAS bf16x8*)(L + HG_QA + (wr * 16 + fr) * 272 + kq * 64 + fq * 16);
                        acc = __builtin_amdgcn_mfma_f32_16x16x32_bf16(af, bq, acc, 0, 0, 0);
                    }
                    const int tt = wr * 16 + fr;
#pragma unroll
                    for (int j = 0; j < 4; ++j) { const int s_ = st * 16 + fq * 4 + j; acc[j] = (s_ <= tt) ? acc[j] : 0.f; }
                }
                u32x2 w; w.x = pk2(acc[0], acc[1]); w.y = pk2(acc[2], acc[3]);
                *(LAS u32x2*)(L + HG_AB + (wr * 16 + fr) * 144 + (st * 16 + fq * 4) * 2) = w;
            }
        }
        {
            bf16x8 aK[2];
#pragma unroll
            for (int ks = 0; ks < 2; ++ks) aK[ks] = tr_frag(L + HG_KA, 272, ks, wave, lane);
#pragma unroll
            for (int vt = 0; vt < 8; ++vt) {
#pragma unroll
                for (int ks = 0; ks < 2; ++ks) { const bf16x8 bv = tr_frag(L + HG_VR, 272, ks, vt, lane); S[vt] = __builtin_amdgcn_mfma_f32_16x16x32_bf16(aK[ks], bv, S[vt], 0, 0, 0); }
#pragma unroll
                for (int j = 0; j < 4; ++j) S[vt][j] *= eL[j];
            }
        }
        if (OUT) {
            __syncthreads();
            bf16x8 aA[2], aQ[4];
#pragma unroll
            for (int ks = 0; ks < 2; ++ks) aA[ks] = *(const LAS bf16x8*)(L + HG_AB + (wr * 16 + fr) * 144 + ks * 64 + fq * 16);
#pragma unroll
            for (int kq = 0; kq < 4; ++kq) aQ[kq] = *(const LAS bf16x8*)(L + HG_QA + (wr * 16 + fr) * 272 + kq * 64 + fq * 16);
#pragma unroll
            for (int n = 0; n < 4; ++n) {
                const int vt = wc * 4 + n;
                f32x4 o = (f32x4){0.f, 0.f, 0.f, 0.f};
#pragma unroll
                for (int ks = 0; ks < 2; ++ks) { const bf16x8 bv = tr_frag(L + HG_VR, 272, ks, vt, lane); o = __builtin_amdgcn_mfma_f32_16x16x32_bf16(aA[ks], bv, o, 0, 0, 0); }
#pragma unroll
                for (int kq = 0; kq < 4; ++kq) { const bf16x8 bs = *(const LAS bf16x8*)(L + HG_SPT + (vt * 16 + fr) * 272 + kq * 64 + fq * 16); o = __builtin_amdgcn_mfma_f32_16x16x32_bf16(aQ[kq], bs, o, 0, 0, 0); }
#pragma unroll
                for (int j = 0; j < 4; ++j) *(LAS float*)(L + HG_O + (wr * 16 + fq * 4 + j) * 528 + (vt * 16 + fr) * 4) = o[j];
            }
            __syncthreads();
            {
                f32x4 ov[4]; float ssq = 0.f;
#pragma unroll
                for (int i = 0; i < 4; ++i) { ov[i] = *(const LAS f32x4*)(L + HG_O + tv * 528 + vc * 64 + i * 16); ssq += (ov[i].x * ov[i].x + ov[i].y * ov[i].y) + (ov[i].z * ov[i].z + ov[i].w * ov[i].w); }
                ssq += __shfl_xor(ssq, 1); ssq += __shfl_xor(ssq, 2); ssq += __shfl_xor(ssq, 4);
                const float rstd = rsqrtf(ssq * (1.0f / 128.0f) + EPS);
                const unsigned gw[8] = {gc0.x, gc0.y, gc0.z, gc0.w, gc1.x, gc1.y, gc1.z, gc1.w};
                unsigned ow[8];
#pragma unroll
                for (int i = 0; i < 8; ++i) { const float g0 = bflo(gw[i]), g1 = bfhi(gw[i]);
                    const float y0 = ov[i >> 1][(2 * i) & 3] * rstd * ngv[2 * i] * g0 * __builtin_amdgcn_rcpf(1.0f + __expf(-g0));
                    const float y1 = ov[i >> 1][(2 * i + 1) & 3] * rstd * ngv[2 * i + 1] * g1 * __builtin_amdgcn_rcpf(1.0f + __expf(-g1));
                    ow[i] = pk2(y0, y1); }
                u32x4* d = (u32x4*)(og + (size_t)(b * SEQ + sc * 256 + ch * 64 + tv) * (2 * D) + h * 128 + vc * 16);
                d[0] = (u32x4){ow[0], ow[1], ow[2], ow[3]}; d[1] = (u32x4){ow[4], ow[5], ow[6], ow[7]};
            }
        }
        if (ch == 3) {
            if (!OUT) {
                float* ds = dS + (size_t)(bh * 32 + sc) * 16384;
#pragma unroll
                for (int vt = 0; vt < 8; ++vt)
#pragma unroll
                    for (int j = 0; j < 4; ++j) ds[(size_t)(16 * wave + fq * 4 + j) * 128 + vt * 16 + fr] = S[vt][j];
                if (seg == 0) *(f32x2*)(Dd + (size_t)(bh * 32 + sc) * 128 + 2 * cp) = (f32x2){__expf(gsum0), __expf(gsum1)};
            }
            idx += X.G; ch = 0; if (idx >= ntask) break;
        } else ++ch;
    }
#undef HG_LOAD
    __syncthreads();
}

__device__ __forceinline__ void ph_hg2(const Ctx& X, const float* dS, const float* Dd, float* S0) {
    for (int idx = X.vcu * 512 + X.tid; idx < 32 * 4096; idx += X.G * 512) {
        const int bh = idx >> 12, e4 = idx & 4095, k = e4 >> 5, v4 = (e4 & 31) * 4;
        f32x4 s = (f32x4){0.f, 0.f, 0.f, 0.f};
#pragma unroll 4
        for (int sc = 0; sc < 31; ++sc) { const float d = Dd[(size_t)(bh * 32 + sc) * 128 + k]; const f32x4 ds = *(const f32x4*)(dS + (size_t)(bh * 32 + sc) * 16384 + k * 128 + v4);
            s = s * d + ds; *(f32x4*)(S0 + (size_t)(bh * 32 + sc + 1) * 16384 + k * 128 + v4) = s; }
    }
}

__device__ __forceinline__ void ph_router_tables(const Ctx& X, const float* g_ffn, const float* mod, const float* w_router, const float* b_router, float* Bp, float* cb) {
    for (int i = X.vcu * 512 + X.tid; i < 4 * 1024 * 32; i += X.G * 512) { const int b = i >> 15, k = (i >> 5) & 1023;
        Bp[i] = g_ffn[k] * (1.0f + mod[(size_t)b * NMOD + 4 * D + k]) * w_router[i & 32767]; }
    const int gw = X.vcu * 8 + X.wave;
    if (gw < 128) { const int b = gw >> 5, e = gw & 31; float a = 0.f;
        for (int k = X.lane; k < 1024; k += 64) a += mod[(size_t)b * NMOD + 3 * D + k] * w_router[k * 32 + e];
        a = wave_sum(a); if (X.lane == 0) cb[gw] = a + b_router[e]; }
}

__device__ __forceinline__ void ph_route(const Ctx& X, const bf16_t* x1, const float* g_ffn, const float* mod, const float* Bp, const float* cb,
                                         unsigned char* h2, int* top_e, float* top_w, int* rank, int* hist_g) {
    LAS int* hist = (LAS int*)(X.lds + LDSCTL_OFF + 64);
    const int tid = X.tid, lane = X.lane, c = lane & 15, q = lane >> 4;
    for (int tile = X.vcu; tile < RT_NT; tile += X.G) {
        if (tid < 32) hist[tid] = 0;
        __syncthreads();
        const int tw = tile * RT_TILE + X.wave * 16, b = tw / SEQ;
        const bf16_t* xa = x1 + (size_t)(tw + c) * D + 4 * q;
        const float* bp = Bp + ((size_t)b * 1024 + 4 * q) * 32 + c;
        f32x4 acc0 = (f32x4){0.f, 0.f, 0.f, 0.f}, acc1 = acc0; float ss = 0.f;
#pragma unroll 4
        for (int m = 0; m < 64; ++m) {
            const u32x2 a2_ = *(const u32x2*)(xa + 16 * m); const f32x4 a4 = (f32x4){bflo(a2_.x), bfhi(a2_.x), bflo(a2_.y), bfhi(a2_.y)};
            float bv[8];
#pragma unroll
            for (int j = 0; j < 4; ++j) { bv[2 * j] = bp[(size_t)(16 * m + j) * 32]; bv[2 * j + 1] = bp[(size_t)(16 * m + j) * 32 + 16]; }
            ss += (a4.x * a4.x + a4.y * a4.y) + (a4.z * a4.z + a4.w * a4.w);
#pragma unroll
            for (int j = 0; j < 4; ++j) { acc0 = __builtin_amdgcn_mfma_f32_16x16x4f32(a4[j], bv[2 * j], acc0, 0, 0, 0); acc1 = __builtin_amdgcn_mfma_f32_16x16x4f32(a4[j], bv[2 * j + 1], acc1, 0, 0, 0); }
        }
        ss += __shfl_xor(ss, 16); ss += __shfl_xor(ss, 32);
        const float rs = rsqrtf(ss * (1.0f / D) + EPS);
        const float cb0 = cb[b * 32 + c], cb1 = cb[b * 32 + 16 + c];
#pragma unroll
        for (int reg = 0; reg < 4; ++reg) {
            const float rt = __shfl(rs, 4 * q + reg);
            float v0 = acc0[reg] * rt + cb0, v1 = acc1[reg] * rt + cb1;
            float sv[4]; int si[4];
#pragma unroll
            for (int rnd = 0; rnd < 4; ++rnd) {
                float bvv = v0; int bi = c; if (v1 > bvv) { bvv = v1; bi = 16 + c; }
#pragma unroll
                for (int o = 1; o < 16; o <<= 1) { const float ov = __shfl_xor(bvv, o); const int oi = __shfl_xor(bi, o); if (ov > bvv || (ov == bvv && oi < bi)) { bvv = ov; bi = oi; } }
                sv[rnd] = bvv; si[rnd] = bi; if (bi == c) v0 = -INFINITY; if (bi == 16 + c) v1 = -INFINITY;
            }
            const float e1 = __expf(sv[1] - sv[0]), e2 = __expf(sv[2] - sv[0]), e3 = __expf(sv[3] - sv[0]);
            const float inv = 1.0f / (1.0f + e1 + e2 + e3);
            if (c == 0) { const int t = tw + 4 * q + reg;
                const float ww[4] = {inv, e1 * inv, e2 * inv, e3 * inv};
#pragma unroll
                for (int rnd = 0; rnd < 4; ++rnd) { top_e[t * 4 + rnd] = si[rnd]; top_w[t * 4 + rnd] = ww[rnd]; rank[t * 4 + rnd] = atomicAdd((int*)&hist[si[rnd]], 1); }
            }
        }
        const float* sh = mod + (size_t)b * NMOD + 3 * D; const float* sc = mod + (size_t)b * NMOD + 4 * D;
#pragma unroll 4
        for (int i = 0; i < 16; ++i) {
            const float r = __shfl(rs, i);
            const u32x2* xr = (const u32x2*)(x1 + (size_t)(tw + i) * D) + lane;
#pragma unroll
            for (int j = 0; j < 4; ++j) {
                const int col = 4 * (lane + 64 * j);
                const f32x4 gg = *(const f32x4*)(g_ffn + col), s1 = *(const f32x4*)(sc + col), s0 = *(const f32x4*)(sh + col);
                const u32x2 xw = xr[64 * j]; const f32x4 xv = (f32x4){bflo(xw.x), bfhi(xw.x), bflo(xw.y), bfhi(xw.y)};
                const f32x4 y = (xv * r * gg * (s1 + 1.0f) + s0) * 16.0f;
                *(unsigned*)(h2 + (size_t)(tw + i) * D + col) = cvt4_fp8(y.x, y.y, y.z, y.w);
            }
        }
        __syncthreads();
        if (tid < 32) hist_g[tile * 32 + tid] = hist[tid];
        __syncthreads();
    }
}

__device__ __forceinline__ void ph_sort(const Ctx& X, const int* hist_g, const int* top_e, const float* top_w, const int* rank, int* row_tok, float* row_w, int* pair_row, int* blk_e) {
    LAS int* s_hist = (LAS int*)X.lds;
    LAS int* s_tot = s_hist + RT_NT * 32; LAS int* s_pre = s_tot + 32; LAS int* s_base = s_pre + 32; LAS int* s_pstart = s_base + 32; LAS int* s_pend = s_pstart + 32;
    const int tid = X.tid;
    for (int i = tid; i < RT_NT * 32; i += 512) s_hist[i] = hist_g[i];
    __syncthreads();
    for (int tile = X.vcu; tile < RT_NT; tile += X.G) {
        if (tid < 32) { int tot = 0, pre = 0; for (int i = 0; i < RT_NT; ++i) { const int c = s_hist[i * 32 + tid]; tot += c; if (i < tile) pre += c; } s_tot[tid] = tot; s_pre[tid] = pre; }
        __syncthreads();
        if (tid == 0) { int acc = 0; for (int e = 0; e < 32; ++e) { const int padded = (s_tot[e] + 255) / 256 * 256; s_pstart[e] = acc; s_base[e] = acc + s_pre[e]; acc += padded; s_pend[e] = acc; } }
        __syncthreads();
        { const int i = tid; const int idx = tile * RT_TILE * 4 + i; const int e = top_e[idx]; const int row = s_base[e] + rank[idx];
          row_tok[row] = idx >> 2; row_w[row] = top_w[idx]; pair_row[idx] = row; }
        if (tile < 32) { const int e = tile; for (int r = s_pstart[e] + s_tot[e] + tid; r < s_pend[e]; r += 512) { row_tok[r] = 0; row_w[r] = 0.f; } }
        if (tile == 32) { for (int blk = tid; blk < NBLK_MAX; blk += 512) { int e = -1; const int r = blk * 256; for (int q = 0; q < 32; ++q) if (r >= s_pstart[q] && r < s_pend[q]) e = q; blk_e[blk] = e; }
                          if (tid == 0) blk_e[NBLK_MAX] = s_pend[31] / 256; }
        __syncthreads();
    }
}

__device__ __forceinline__ void ph_final(const Ctx& X, const bf16_t* x1, const unsigned char* y, const int* pair_row, const float* mod, const float* g_final, float* out, const float oscale) {
    const int lane = X.lane;
    for (int t = X.vcu * 8 + X.wave; t < T; t += X.G * 8) {
        const int b = t / SEQ;
        const u32x2* xr = (const u32x2*)(x1 + (size_t)t * D) + lane;
        const float* ga = mod + (size_t)b * NMOD + 5 * D;
        int rows[4];
#pragma unroll
        for (int k = 0; k < 4; ++k) rows[k] = pair_row[t * 4 + k];
        f32x4 v[4]; float ss = 0.f;
#pragma unroll
        for (int j = 0; j < 4; ++j) {
            const int col = 4 * (lane + 64 * j);
            f32x4 m = (f32x4){0.f, 0.f, 0.f, 0.f};
#pragma unroll
            for (int k = 0; k < 4; ++k) { const int w = *(const int*)(y + (size_t)rows[k] * D + col); const f32x2 lo = __builtin_amdgcn_cvt_pk_f32_fp8(w, false), hi = __builtin_amdgcn_cvt_pk_f32_fp8(w, true); m.x += lo.x; m.y += lo.y; m.z += hi.x; m.w += hi.y; }
            const u32x2 xw = xr[64 * j];
            v[j] = (f32x4){bflo(xw.x), bfhi(xw.x), bflo(xw.y), bfhi(xw.y)} + *(const f32x4*)(ga + col) * (m * (1.0f / 32.0f));
            ss += (v[j].x * v[j].x + v[j].y * v[j].y) + (v[j].z * v[j].z + v[j].w * v[j].w);
        }
        const float r = rsqrtf(wave_sum(ss) * (1.0f / D) + EPS);
#pragma unroll
        for (int j = 0; j < 4; ++j) { const int col = 4 * (lane + 64 * j); *(f32x4*)(out + (size_t)t * D + col) = v[j] * (r * oscale) * *(const f32x4*)(g_final + col); }
    }
}

constexpr int N_PHASES = 13;
struct Args { const float* in[23]; float* out; unsigned char* ws; int ph_lo, ph_hi; };
__global__ void __launch_bounds__(512, 2) fwd(Args a) {
    extern __shared__ __attribute__((aligned(16))) unsigned char lds_raw[];
    Ctx X; X.lds = (LAS unsigned char*)lds_raw; X.tid = threadIdx.x; X.lane = X.tid & 63; X.wave = __builtin_amdgcn_readfirstlane(X.tid >> 6);
    X.G = gridDim.x; { const int bx = blockIdx.x; X.vcu = (X.G % 8 == 0) ? (bx % 8) * (X.G / 8) + bx / 8 : bx; }
    unsigned char* ws = a.ws;
    for (int u = X.tid; u < (LDS_BYTES - LDSCTL_OFF) / 4; u += 512) ((LAS unsigned*)(X.lds + LDSCTL_OFF))[u] = 0u;
    __syncthreads();
    XcdBarrier bar = xcd_barrier_post((unsigned*)(ws + WS_CTL) + CW_BAR, (volatile LAS unsigned*)(X.lds + LDSCTL_OFF), X.tid == 0);
    const int lo = a.ph_lo, hi = a.ph_hi; float probe_scale = 1.0f;
#define IN(k) (lo <= (k) && (k) < hi)
#define SEAM(k) do { if (IN(k) && IN((k) + 1)) xcd_barrier(bar, X.wave == 0 && (int)__builtin_amdgcn_mbcnt_hi(~0u, __builtin_amdgcn_mbcnt_lo(~0u, 0u)) == 0); } while (0)
#ifdef PROBE_PH
    unsigned long long* stamps = (unsigned long long*)(ws + WS_CTL + 32768);
    if (blockIdx.x == 0 && X.tid == 0) stamps[0] = __builtin_amdgcn_s_memrealtime();
#undef SEAM
#define SEAM(k) do { if (IN(k) && IN((k) + 1)) { xcd_barrier(bar, X.wave == 0 && (int)__builtin_amdgcn_mbcnt_hi(~0u, __builtin_amdgcn_mbcnt_lo(~0u, 0u)) == 0); \
        if (blockIdx.x == 0 && X.wave == 0 && (int)__builtin_amdgcn_mbcnt_hi(~0u, __builtin_amdgcn_mbcnt_lo(~0u, 0u)) == 0) stamps[(k) + 1] = __builtin_amdgcn_s_memrealtime(); } } while (0)
#endif
    const float* x = a.in[0]; const float* c = a.in[1]; const float* w_ada = a.in[2]; const float* b_ada = a.in[3];
    const float* g_mix = a.in[4]; const float* w_in = a.in[5]; const float* conv_dw = a.in[6]; const float* conv_dwb = a.in[7];
    const float* conv_ln_g = a.in[8]; const float* conv_ln_b = a.in[9]; const float* w_conv_out = a.in[10]; const float* lb_param = a.in[11];
    const float* hgrn_norm_g = a.in[12]; const float* w_hgrn_out = a.in[13]; const float* w_out = a.in[14]; const float* g_ffn = a.in[15];
    const float* w_router = a.in[16]; const float* b_router = a.in[17]; const float* w1 = a.in[18]; const float* b1 = a.in[19];
    const float* w2 = a.in[20]; const float* b2 = a.in[21]; const float* g_final = a.in[22];
    float* mod = (float*)(ws + WS_MOD); float* rt_bp = (float*)(ws + WS_BP); float* rt_cb = (float*)(ws + WS_CB);
    int* hist_g = (int*)(ws + WS_HIST); int* blk_e = (int*)(ws + WS_BLKE); int* top_e = (int*)(ws + WS_TOPE); float* top_w = (float*)(ws + WS_TOPW);
    int* rank = (int*)(ws + WS_RANK); int* pair_row = (int*)(ws + WS_PROW); int* row_tok = (int*)(ws + WS_RTOK); float* row_w = (float*)(ws + WS_RW);
    bf16_t* p = (bf16_t*)(ws + WS_P);
    bf16_t* h = (bf16_t*)(ws + WS_E); unsigned char* h8 = ws + WS_E + 64 * MiB; float* tmp = (float*)(ws + WS_E);
    float* hg_dS = (float*)(ws + WS_E); float* hg_S0 = (float*)(ws + WS_E + 64 * MiB); float* hg_D = (float*)(ws + WS_HGD);
    bf16_t* uc = (bf16_t*)(ws + WS_D); bf16_t* og = uc + D;   bf16_t* x1 = (bf16_t*)(ws + WS_D);
    bf16_t* merged = p;
    unsigned char* h2 = (unsigned char*)p;
    unsigned char* act = (unsigned char*)(p + PG);
    unsigned char* y = (unsigned char*)(p + PG) + (size_t)R_PAD * D;
    PG8_LAS unsigned char* ring = (PG8_LAS unsigned char*)lds_raw;

#ifndef REPMASK
#define REPMASK 0
#endif
#ifndef REPN
#define REPN 1
#endif
#define PH(k, ...) do { if (IN(k)) { _Pragma("unroll 1") for (int rep_ = 0; rep_ < ((((REPMASK) >> (k)) & 1) ? 1 + REPN : 1); ++rep_) { if (rep_) __syncthreads(); { int ln_ = (int)__builtin_amdgcn_mbcnt_hi(~0u, __builtin_amdgcn_mbcnt_lo(~0u, 0u)); asm volatile("" : "+v"(ln_)); X.lane = ln_; X.tid = X.wave * 64 + ln_; } __VA_ARGS__ } } SEAM(k); } while (0)
    PH(0, ph_prologue<0>(X, c, w_ada, b_ada, mod, w_in, w_conv_out, w_hgrn_out, w_out, w1, w2, ws););
    PH(1, ph_norm_mod(X, x, g_mix, mod, 0, D, h, h8); ph_router_tables(X, g_ffn, mod, w_router, b_router, rt_bp, rt_cb););
#ifndef STAGGER_TICKS
#define STAGGER_TICKS 0
#endif
    PH(2, { if (STAGGER_TICKS) { const unsigned long long t0_ = __builtin_amdgcn_s_memrealtime(), wait_ = (unsigned long long)(X.vcu & 3) * STAGGER_TICKS;
                while (__builtin_amdgcn_s_memrealtime() - t0_ < wait_) __builtin_amdgcn_s_sleep(8); }
        constexpr unsigned m8 = P_FP8_MASK; constexpr int n8 = __builtin_popcount(m8);
        if (n8 > 0) { pg8::Gemm g{(const bf16_t*)h8, (const bf16_t*)(ws + WS_WIN8), T, 8 * D, D / 2}; pg8::MaskOrder S; S.base.init(T, n8 * 256, X.G, (int)blockIdx.x); S.mask = m8;
            pg8::EpiSplitBf16 E{p, PG, 0x3cu, SEQ, 1.0f / 4096.0f}; pg8::gemm_phase<pg8::EpiSplitBf16, pg8::MaskOrder, true, true, false, true>(ring, g, S, E, X.wave); }
        if (n8 < 32) { pg8::Gemm g{h, (const bf16_t*)(ws + WS_WIN), T, 8 * D, D}; pg8::MaskOrder S; S.base.init(T, (32 - n8) * 256, X.G, (int)blockIdx.x); S.mask = ~m8;
            pg8::EpiSplitBf16 E{p, PG, 0x3cu, SEQ, 1.0f}; pg8::gemm_phase<pg8::EpiSplitBf16, pg8::MaskOrder, true, true>(ring, g, S, E, X.wave); } });
    PH(3, ph_conv(X, p + 0 * PG, conv_dw, conv_dwb, conv_ln_g, conv_ln_b, uc);
          if ((REPMASK >> 14) & 1) { __syncthreads(); ph_conv(X, p + 0 * PG, conv_dw, conv_dwb, conv_ln_g, conv_ln_b, uc); }
          ph_hgrn<false>(X, 31 * 32, p + 2 * PG, p + 3 * PG, p + 4 * PG, p + 5 * PG, lb_param, nullptr, nullptr, hg_dS, hg_D, nullptr);
          if ((REPMASK >> 15) & 1) { __syncthreads(); ph_hgrn<false>(X, 31 * 32, p + 2 * PG, p + 3 * PG, p + 4 * PG, p + 5 * PG, lb_param, nullptr, nullptr, hg_dS, hg_D, nullptr); });
    PH(4, ph_hg2(X, hg_dS, hg_D, hg_S0););
    PH(5, if ((X.vcu & 1) == 0) ph_prologue<1>(X, c, w_ada, b_ada, mod, w_in, w_conv_out, w_hgrn_out, w_out, w1, w2, ws);
          ph_hgrn<true>(X, 32 * 32, p + 2 * PG, p + 3 * PG, p + 4 * PG, p + 5 * PG, lb_param, hgrn_norm_g, hg_S0, nullptr, nullptr, og);
          if ((X.vcu & 1) != 0) ph_prologue<1>(X, c, w_ada, b_ada, mod, w_in, w_conv_out, w_hgrn_out, w_out, w1, w2, ws););
    PH(6, { pg8::Gemm g{uc, (const bf16_t*)(ws + WS_WC), T, D, 2 * D}; pg8::StaticOrder S; S.init(T, D, X.G, (int)blockIdx.x);
        pg8::EpiGateFused E{p + 6 * PG, p + 7 * PG, merged}; pg8::gemm_phase<pg8::EpiGateFused, pg8::StaticOrder, true, true>(ring, g, S, E, X.wave); });
    PH(7, { pg8::Gemm g{merged, (const bf16_t*)(ws + WS_WO), T, D, D}; pg8::StaticOrder S; S.init(T, D, X.G, (int)blockIdx.x);
        pg8::EpiRes E{x, mod + 2 * D, x1, NMOD, SEQ}; pg8::gemm_phase<pg8::EpiRes, pg8::StaticOrder, true, true>(ring, g, S, E, X.wave); });
    PH(8, ph_route(X, x1, g_ffn, mod, rt_bp, rt_cb, h2, top_e, top_w, rank, hist_g););
    PH(9, ph_sort(X, hist_g, top_e, top_w, rank, row_tok, row_w, pair_row, blk_e););
    PH(10, { const int nblk = blk_e[NBLK_MAX]; pg8::Gemm g{(const bf16_t*)h2, (const bf16_t*)(ws + WS_W1), T, 32 * 2048, D / 2}; pg8::MoeOrder S{blk_e, nblk, X.G, (int)blockIdx.x, 3};
        LAS unsigned short* gt = (LAS unsigned short*)(X.lds + LDSCTL_OFF + 256);
        _Pragma("unroll 1") for (int i = 0; i < 23; ++i) { pg8::Unit u; if (!S.next(i, u)) break; if (X.tid < 256) gt[256 * i + X.tid] = (unsigned short)row_tok[u.pm * 256 + X.tid]; }
        __syncthreads();
        pg8::EpiSwiglu8 E{b1, act, 1.0f / 4096.0f}; pg8::gemm_phase<pg8::EpiSwiglu8, pg8::MoeOrder, true, true, true, true>(ring, g, S, E, X.wave, (const PG8_LAS unsigned short*)gt); });
    PH(11, { const int nblk = blk_e[NBLK_MAX]; pg8::Gemm g{(const bf16_t*)act, (const bf16_t*)(ws + WS_W2), R_PAD, 32 * 1024, DFF / 2}; pg8::MoeOrder S{blk_e, nblk, X.G, (int)blockIdx.x, 2};
        pg8::EpiY8 E{b2, row_w, y, 1.0f / 1024.0f}; pg8::gemm_phase<pg8::EpiY8, pg8::MoeOrder, true, true, false, true>(ring, g, S, E, X.wave); });
#ifdef PROBE_PH
    { const unsigned long long* st_ = (const unsigned long long*)(ws + WS_CTL + 32768); const float dt_ = (float)(long long)(st_[PROBE_PH + 1] - st_[PROBE_PH]);
      probe_scale = 1.0f + dt_ * (1.0f / 200000.0f); }
#endif
    PH(12, ph_final(X, x1, y, pair_row, mod, g_final, a.out, probe_scale););
#undef PH
#undef IN
#undef SEAM
}

#ifndef MK_N_LAUNCHES
#define MK_N_LAUNCHES 1
#endif
extern "C" void kernel_launch(void* const* d_in, const int* in_sizes, int n_in, void* d_out, int out_size, void* d_ws, size_t ws_size, hipStream_t stream) {
    static int grid = 0;
    if (grid == 0) {
        if (n_in != 23 || out_size != T * D || ws_size < WS_END) { fprintf(stderr, "kernel_launch: unexpected n_in %d / out_size %d / ws_size %zu (< %zu); nothing launched\n", n_in, out_size, ws_size, (size_t)WS_END); grid = -1; return; }
        int dev = 0, cus = 0, per_cu = 0;
        if (hipGetDevice(&dev) != hipSuccess || hipDeviceGetAttribute(&cus, hipDeviceAttributeMultiprocessorCount, dev) != hipSuccess) { grid = -1; return; }
        if (hipFuncSetAttribute((const void*)fwd, hipFuncAttributeMaxDynamicSharedMemorySize, LDS_BYTES) != hipSuccess) { fprintf(stderr, "kernel_launch: hipFuncSetAttribute failed\n"); grid = -1; return; }
        if (hipOccupancyMaxActiveBlocksPerMultiprocessor(&per_cu, (const void*)fwd, 512, LDS_BYTES) != hipSuccess || per_cu < 1) { fprintf(stderr, "kernel_launch: occupancy query says %d blocks per CU\n", per_cu); }
        (void)hipGetLastError();
        grid = cus;
    }
    if (grid < 0) return;
    if (hipMemsetAsync((char*)d_ws + WS_CTL, 0, CTL_ZERO_BYTES, stream) != hipSuccess) return;
    Args a{};
    for (int i = 0; i < 23; ++i) a.in[i] = (const float*)d_in[i];
    a.out = (float*)d_out; a.ws = (unsigned char*)d_ws;
    if (MK_N_LAUNCHES == 1) { a.ph_lo = 0; a.ph_hi = N_PHASES; hipLaunchKernelGGL(fwd, dim3(grid), dim3(512), LDS_BYTES, stream, a); }
    else for (int ph = 0; ph < N_PHASES; ++ph) { a.ph_lo = ph; a.ph_hi = ph + 1; hipLaunchKernelGGL(fwd, dim3(grid), dim3(512), LDS_BYTES, stream, a); }
}
```

```cpp
#include <hip/hip_runtime.h>
#include <stdint.h>
#include <stdio.h>

#define GAS __attribute__((address_space(1)))
#define LAS __attribute__((address_space(3)))
typedef unsigned short bf16_t;
typedef unsigned u32x4 __attribute__((ext_vector_type(4)));
typedef unsigned u32x2 __attribute__((ext_vector_type(2)));
typedef float f32x4 __attribute__((ext_vector_type(4)));

constexpr int D = 1024, NBATCH = 4, SEQ = 8192, T = NBATCH * SEQ;
constexpr int NE = 32, DFF = 1024;
constexpr int NMOD = 6 * D;
constexpr int NBLK_MAX = 544, R_PAD = NBLK_MAX * 256;
constexpr int RT_TILE = 128, RT_NT = T / RT_TILE;
constexpr float EPS = 1e-6f;

constexpr size_t MiB = 1u << 20;
constexpr size_t WS_CTL = 0, CTL_ZERO_BYTES = 64 * 1024;
constexpr size_t WS_MOD = 1 * MiB;
constexpr size_t WS_CB = WS_MOD + 112 * 1024, WS_BP = WS_MOD + 128 * 1024;
constexpr size_t WS_HIST = 2 * MiB;
constexpr size_t WS_BLKE = WS_HIST + 64 * 1024;
constexpr size_t WS_TOPE = 3 * MiB;
constexpr size_t WS_TOPW = WS_TOPE + 512 * 1024;
constexpr size_t WS_RANK = WS_TOPW + 512 * 1024;
constexpr size_t WS_PROW = WS_RANK + 512 * 1024;
constexpr size_t WS_RTOK = 5 * MiB;
constexpr size_t WS_RW = 6 * MiB;
constexpr size_t WS_HGD = 7 * MiB;
constexpr size_t WS_WT = 8 * MiB;
constexpr size_t WS_WIN = WS_WT, WS_WC = WS_WT + 16 * MiB, WS_WH = WS_WT + 18 * MiB, WS_WO = WS_WT + 20 * MiB, WS_W1 = WS_WT + 22 * MiB, WS_WIN8 = WS_WT + 96 * MiB  , WS_W2 = WS_WT + 150 * MiB;
constexpr size_t WS_P = 224 * MiB;
constexpr size_t WS_E = WS_P + 512 * MiB;
constexpr size_t WS_D = WS_E + 128 * MiB;
constexpr size_t WS_END = WS_D + 128 * MiB;
constexpr size_t PG = (size_t)T * D;
constexpr int CW_BAR = 0;

constexpr int RING_BYTES = 135168, LDSCTL_OFF = RING_BYTES, LDS_BYTES = 147456;

__device__ __forceinline__ unsigned f2bf(float f) { unsigned u = __builtin_bit_cast(unsigned, f); return (u + 0x7fffu + ((u >> 16) & 1u)) >> 16; }
__device__ __forceinline__ unsigned pk2(float lo, float hi) { return f2bf(lo) | (f2bf(hi) << 16); }
__device__ __forceinline__ float bf2f(unsigned b) { return __builtin_bit_cast(float, b << 16); }
__device__ __forceinline__ float bflo(unsigned w) { return __builtin_bit_cast(float, w << 16); }
__device__ __forceinline__ float bfhi(unsigned w) { return __builtin_bit_cast(float, w & 0xffff0000u); }
__device__ __forceinline__ float sigmoidf_(float x) { return __builtin_amdgcn_rcpf(1.0f + __expf(-x)); }
__device__ __forceinline__ float wave_sum(float v) {
#pragma unroll
    for (int o = 1; o < 64; o <<= 1) v += __shfl_xor(v, o);
    return v;
}
__device__ __forceinline__ unsigned cvt4_fp8(float a, float b, float c, float d) {
    a = fminf(fmaxf(a, -448.f), 448.f); b = fminf(fmaxf(b, -448.f), 448.f); c = fminf(fmaxf(c, -448.f), 448.f); d = fminf(fmaxf(d, -448.f), 448.f);
    int w = 0; w = __builtin_amdgcn_cvt_pk_fp8_f32(a, b, w, false); w = __builtin_amdgcn_cvt_pk_fp8_f32(c, d, w, true); return (unsigned)w; }
#define LDS_WAIT() asm volatile("s_waitcnt lgkmcnt(0)" ::: "memory")
#define VM_WAIT() asm volatile("s_waitcnt vmcnt(0)" ::: "memory")

namespace pg8 {
#define PG8_LAS __attribute__((address_space(3)))
typedef unsigned short bf16_t;
typedef short bf16x8 __attribute__((ext_vector_type(8)));
typedef float f32x4 __attribute__((ext_vector_type(4)));
typedef unsigned u32x4 __attribute__((ext_vector_type(4)));
constexpr int BM = 256, BK = 64, HALF = 128, HTB = HALF * BK * 2  , STAGE_BYTES = 8 * HTB, NXCD = 8, WGM = 8;

__host__ __device__ __forceinline__ int lds_byte(int r, int c) { const int st = (r >> 4) * 2 + (c >> 5), rr = r & 15, cc = c & 31, ob = rr * 64 + cc * 2; return st * 1024 + (ob ^ (((ob >> 9) & 1) << 5)); }
__host__ __device__ __forceinline__ void stage_rc(int b, int& R, int& C) { const int st = b / 1024, sb = b % 1024, swz = sb ^ (((sb >> 9) & 1) << 5); R = (st >> 1) * 16 + swz / 64; C = (st & 1) * 32 + (swz % 64) / 2; }
__host__ __device__ __forceinline__ int perm32(int rho) { const int n = rho >> 4, i = rho & 15; return 8 * (i >> 2) + 4 * n + (i & 3); }

struct Unit { int pm, pn; };
struct Gemm { const bf16_t* A; const bf16_t* Bt; int M, N, K; };

struct StaticOrder {
    int nM, nN, nwg, G, c;
    __host__ __device__ void init(int M, int N, int G_, int c_) { nM = M / BM; nN = N / BM; nwg = nM * nN; G = G_; c = c_; }
    __host__ __device__ bool next(int i, Unit& u) const {
        const long L = (long)i * G + c; if (L >= nwg) return false;
        int wgid = (int)L; { const int q = nwg / NXCD, r = nwg % NXCD, xcd = wgid % NXCD, off = wgid / NXCD; wgid = (xcd < r ? xcd * (q + 1) : r * (q + 1) + (xcd - r) * q) + off; }
        const int nig = WGM * nN, gid = wgid / nig, fm = gid * WGM, gsz = (nM - fm) < WGM ? (nM - fm) : WGM;
        u.pm = fm + ((wgid % nig) % gsz); u.pn = (wgid % nig) / gsz; return true;
    }
    __device__ __forceinline__ void a_ready(const Unit&) const {}
    __device__ __forceinline__ void done(const Unit&) const {}
};


struct MaskOrder {
    StaticOrder base; unsigned mask;
    __device__ __forceinline__ bool next(int i, Unit& u) const {
        if (!base.next(i, u)) return false;
        unsigned m = mask; for (int k = 0; k < u.pn; ++k) m &= m - 1;
        u.pn = __builtin_ctz(m); return true;
    }
    __device__ __forceinline__ void a_ready(const Unit&) const {}
    __device__ __forceinline__ void done(const Unit&) const {}
};
struct MoeOrder {
    const int* blk_e; int nblk, G, c, lg;
    __device__ __forceinline__ bool next(int i, Unit& u) const {
        int blk, j;
        if (G == 256) { const int xcd = c & 7, idx = c >> 3, prb = 256 >> lg; blk = i * prb + xcd * (prb >> 3) + (idx >> lg); j = idx & ((1 << lg) - 1); }
        else { const long L = (long)i * G + c; blk = (int)(L >> lg); j = (int)(L & ((1 << lg) - 1)); }
        if (blk >= nblk) return false;
        const int e = blk_e[blk]; u.pm = blk; u.pn = (e << lg) + j; return true;
    }
    __device__ __forceinline__ void a_ready(const Unit&) const {}
    __device__ __forceinline__ void done(const Unit&) const {}
};

__device__ __forceinline__ unsigned cvt_pk_bf16(float lo, float hi) { unsigned r; asm volatile("v_cvt_pk_bf16_f32 %0, %1, %2" : "=v"(r) : "v"(lo), "v"(hi)); return r; }
__device__ __forceinline__ float sigm(float x) { return __builtin_amdgcn_rcpf(1.0f + __expf(-x)); }
__device__ __forceinline__ float blo(unsigned w) { return __builtin_bit_cast(float, w << 16); }
__device__ __forceinline__ float bhi(unsigned w) { return __builtin_bit_cast(float, w & 0xffff0000u); }

struct EpiSplitBf16 {
    static constexpr bool PERM = true, AFTER_DRAIN = false;
    bf16_t* O; size_t split_stride; unsigned hm_mask; int seq; float dq;
    __device__ __forceinline__ void operator()(const f32x4 (&acc)[2][2][4][2], const Unit& u, int wr, int wc, int fr, int fq) const {
        const int row0 = u.pm * BM + wr * 64 + fr; const int colt = u.pn * BM; const int t = colt >> 10;
        if (u.pn < 8) {
#pragma unroll
            for (int ai = 0; ai < 2; ++ai)
#pragma unroll
                for (int m = 0; m < 4; ++m) { const int row = row0 + ai * HALF + m * 16; float r[8];
#pragma unroll
                    for (int q = 0; q < 4; ++q) { r[q] = acc[ai][0][m][0][q] * dq * sigm(acc[ai][1][m][0][q] * dq); r[4 + q] = acc[ai][0][m][1][q] * dq * sigm(acc[ai][1][m][1][q] * dq); }
                    u32x4 w; w.x = cvt_pk_bf16(r[0], r[1]); w.y = cvt_pk_bf16(r[2], r[3]); w.z = cvt_pk_bf16(r[4], r[5]); w.w = cvt_pk_bf16(r[6], r[7]);
                    __builtin_nontemporal_store(w, (u32x4*)(O + (size_t)row * 1024 + 128 * u.pn + wc * 32 + 8 * fq)); }
            return;
        }
        bf16_t* base = O + (size_t)t * split_stride; const int cg = colt & 1023;
        const bool hm = (hm_mask >> t) & 1u;
        const int bb = (u.pm * BM) / seq;
#pragma unroll
        for (int ai = 0; ai < 2; ++ai)
#pragma unroll
            for (int m = 0; m < 4; ++m) { const int row = row0 + ai * HALF + m * 16;
#pragma unroll
                for (int bj = 0; bj < 2; ++bj) { const f32x4 v0 = acc[ai][bj][m][0] * dq, v1 = acc[ai][bj][m][1] * dq;
                    u32x4 w; w.x = cvt_pk_bf16(v0[0], v0[1]); w.y = cvt_pk_bf16(v0[2], v0[3]); w.z = cvt_pk_bf16(v1[0], v1[1]); w.w = cvt_pk_bf16(v1[2], v1[3]);
                    const size_t o = hm ? ((size_t)(bb * 8 + (cg >> 7) + bj) * seq + (row - bb * seq)) * 128 + wc * 32 + 8 * fq
                                        : (size_t)row * 1024 + cg + bj * HALF + wc * 32 + 8 * fq;
                    __builtin_nontemporal_store(w, (u32x4*)(base + o)); } }
    }
};
struct EpiGate1 {
    static constexpr bool PERM = true, AFTER_DRAIN = false;
    const bf16_t* gate; float* tmp;
    __device__ __forceinline__ void operator()(const f32x4 (&acc)[2][2][4][2], const Unit& u, int wr, int wc, int fr, int fq) const {
        const int row0 = u.pm * BM + wr * 64 + fr, col0 = u.pn * BM + wc * 32 + 8 * fq;
#pragma unroll
        for (int ai = 0; ai < 2; ++ai)
#pragma unroll
            for (int m = 0; m < 4; ++m) { const size_t o = (size_t)(row0 + ai * HALF + m * 16) * 1024 + col0;
#pragma unroll
                for (int bj = 0; bj < 2; ++bj) { const u32x4 g = *(const u32x4*)(gate + o + bj * HALF); f32x4 v0 = acc[ai][bj][m][0], v1 = acc[ai][bj][m][1];
                    v0[0] *= sigm(blo(g.x)); v0[1] *= sigm(bhi(g.x)); v0[2] *= sigm(blo(g.y)); v0[3] *= sigm(bhi(g.y));
                    v1[0] *= sigm(blo(g.z)); v1[1] *= sigm(bhi(g.z)); v1[2] *= sigm(blo(g.w)); v1[3] *= sigm(bhi(g.w));
                    *(f32x4*)(tmp + o + bj * HALF) = v0; *(f32x4*)(tmp + o + bj * HALF + 4) = v1; } }
    }
};
struct EpiGate2 {
    static constexpr bool PERM = true, AFTER_DRAIN = false;
    const bf16_t* gate; const float* tmp; bf16_t* out;
    __device__ __forceinline__ void operator()(const f32x4 (&acc)[2][2][4][2], const Unit& u, int wr, int wc, int fr, int fq) const {
        const int row0 = u.pm * BM + wr * 64 + fr, col0 = u.pn * BM + wc * 32 + 8 * fq;
#pragma unroll
        for (int ai = 0; ai < 2; ++ai)
#pragma unroll
            for (int m = 0; m < 4; ++m) { const size_t o = (size_t)(row0 + ai * HALF + m * 16) * 1024 + col0;
#pragma unroll
                for (int bj = 0; bj < 2; ++bj) { const u32x4 g = *(const u32x4*)(gate + o + bj * HALF); f32x4 v0 = acc[ai][bj][m][0], v1 = acc[ai][bj][m][1];
                    const f32x4 t0 = *(const f32x4*)(tmp + o + bj * HALF), t1 = *(const f32x4*)(tmp + o + bj * HALF + 4);
                    v0[0] = t0[0] + v0[0] * sigm(blo(g.x)); v0[1] = t0[1] + v0[1] * sigm(bhi(g.x)); v0[2] = t0[2] + v0[2] * sigm(blo(g.y)); v0[3] = t0[3] + v0[3] * sigm(bhi(g.y));
                    v1[0] = t1[0] + v1[0] * sigm(blo(g.z)); v1[1] = t1[1] + v1[1] * sigm(bhi(g.z)); v1[2] = t1[2] + v1[2] * sigm(blo(g.w)); v1[3] = t1[3] + v1[3] * sigm(bhi(g.w));
                    u32x4 w; w.x = cvt_pk_bf16(v0[0], v0[1]); w.y = cvt_pk_bf16(v0[2], v0[3]); w.z = cvt_pk_bf16(v1[0], v1[1]); w.w = cvt_pk_bf16(v1[2], v1[3]);
                    *(u32x4*)(out + o + bj * HALF) = w; } }
    }
};
struct EpiRes {
    static constexpr bool PERM = true, AFTER_DRAIN = false;
    const float* x; const float* ga; bf16_t* out; int mod_pitch, seq;
    __device__ __forceinline__ void operator()(const f32x4 (&acc)[2][2][4][2], const Unit& u, int wr, int wc, int fr, int fq) const {
        const int row0 = u.pm * BM + wr * 64 + fr, col0 = u.pn * BM + wc * 32 + 8 * fq;
        const float* gab = ga + (size_t)((u.pm * BM) / seq) * mod_pitch + col0;
        f32x4 gv[2][2];
#pragma unroll
        for (int bj = 0; bj < 2; ++bj)
#pragma unroll
            for (int n = 0; n < 2; ++n) gv[bj][n] = *(const f32x4*)(gab + bj * HALF + 4 * n);
#pragma unroll
        for (int ai = 0; ai < 2; ++ai)
#pragma unroll
            for (int m = 0; m < 4; ++m) { const size_t o = (size_t)(row0 + ai * HALF + m * 16) * 1024 + col0;
#pragma unroll
                for (int bj = 0; bj < 2; ++bj) { const f32x4 x0 = *(const f32x4*)(x + o + bj * HALF), x1_ = *(const f32x4*)(x + o + bj * HALF + 4);
                    const f32x4 v0 = x0 + gv[bj][0] * acc[ai][bj][m][0], v1 = x1_ + gv[bj][1] * acc[ai][bj][m][1];
                    u32x4 w; w.x = cvt_pk_bf16(v0[0], v0[1]); w.y = cvt_pk_bf16(v0[2], v0[3]); w.z = cvt_pk_bf16(v1[0], v1[1]); w.w = cvt_pk_bf16(v1[2], v1[3]);
                    *(u32x4*)(out + o + bj * HALF) = w; } }
    }
};
struct EpiSwiglu {
    static constexpr bool PERM = true, AFTER_DRAIN = false;
    const float* b1; bf16_t* act;
    __device__ __forceinline__ void operator()(const f32x4 (&acc)[2][2][4][2], const Unit& u, int wr, int wc, int fr, int fq) const {
        const int e = u.pn >> 3, j = u.pn & 7; const int row0 = u.pm * BM + wr * 64 + fr, f0 = 128 * j + wc * 32 + 8 * fq;
        const float* be = b1 + (size_t)e * 2048 + f0;
        const f32x4 bg0 = *(const f32x4*)(be), bg1 = *(const f32x4*)(be + 4), bl0 = *(const f32x4*)(be + 1024), bl1 = *(const f32x4*)(be + 1028);
#pragma unroll
        for (int ai = 0; ai < 2; ++ai)
#pragma unroll
            for (int m = 0; m < 4; ++m) {
                f32x4 g0 = acc[ai][0][m][0] + bg0, g1 = acc[ai][0][m][1] + bg1, l0 = acc[ai][1][m][0] + bl0, l1 = acc[ai][1][m][1] + bl1;
                float r[8];
#pragma unroll
                for (int q = 0; q < 4; ++q) { float gl = fminf(g0[q], 7.0f), li = fminf(fmaxf(l0[q], -7.0f), 7.0f); r[q] = gl * sigm(1.702f * gl) * (li + 1.0f);
                                              gl = fminf(g1[q], 7.0f); li = fminf(fmaxf(l1[q], -7.0f), 7.0f); r[4 + q] = gl * sigm(1.702f * gl) * (li + 1.0f); }
                u32x4 w; w.x = cvt_pk_bf16(r[0], r[1]); w.y = cvt_pk_bf16(r[2], r[3]); w.z = cvt_pk_bf16(r[4], r[5]); w.w = cvt_pk_bf16(r[6], r[7]);
                *(u32x4*)(act + (size_t)(row0 + ai * HALF + m * 16) * 1024 + f0) = w; }
    }
};
struct EpiY {
    static constexpr bool PERM = true, AFTER_DRAIN = false;
    const float* b2; const float* rw; bf16_t* y;
    __device__ __forceinline__ void operator()(const f32x4 (&acc)[2][2][4][2], const Unit& u, int wr, int wc, int fr, int fq) const {
        const int e = u.pn >> 2, j = u.pn & 3; const int row0 = u.pm * BM + wr * 64 + fr, col0 = 256 * j + wc * 32 + 8 * fq;
        const float* be = b2 + (size_t)e * 1024 + col0;
        f32x4 bv[2][2];
#pragma unroll
        for (int bj = 0; bj < 2; ++bj)
#pragma unroll
            for (int n = 0; n < 2; ++n) bv[bj][n] = *(const f32x4*)(be + bj * HALF + 4 * n);
#pragma unroll
        for (int ai = 0; ai < 2; ++ai)
#pragma unroll
            for (int m = 0; m < 4; ++m) { const int row = row0 + ai * HALF + m * 16; const float w_ = rw[row];
#pragma unroll
                for (int bj = 0; bj < 2; ++bj) { const f32x4 v0 = (acc[ai][bj][m][0] + bv[bj][0]) * w_, v1 = (acc[ai][bj][m][1] + bv[bj][1]) * w_;
                    u32x4 w; w.x = cvt_pk_bf16(v0[0], v0[1]); w.y = cvt_pk_bf16(v0[2], v0[3]); w.z = cvt_pk_bf16(v1[0], v1[1]); w.w = cvt_pk_bf16(v1[2], v1[3]);
                    *(u32x4*)(y + (size_t)row * 1024 + col0 + bj * HALF) = w; } }
    }
};


struct EpiSwiglu8 {
    static constexpr bool PERM = true, AFTER_DRAIN = false;
    const float* b1; unsigned char* act; float dq;
    __device__ __forceinline__ void operator()(const f32x4 (&acc)[2][2][4][2], const Unit& u, int wr, int wc, int fr, int fq) const {
        const int e = u.pn >> 3, j = u.pn & 7; const int row0 = u.pm * BM + wr * 64 + fr, f0 = 128 * j + wc * 32 + 8 * fq;
        const float* be = b1 + (size_t)e * 2048 + f0;
        const f32x4 bg0 = *(const f32x4*)(be), bg1 = *(const f32x4*)(be + 4), bl0 = *(const f32x4*)(be + 1024), bl1 = *(const f32x4*)(be + 1028);
#pragma unroll
        for (int ai = 0; ai < 2; ++ai)
#pragma unroll
            for (int m = 0; m < 4; ++m) {
                f32x4 g0 = acc[ai][0][m][0] * dq + bg0, g1 = acc[ai][0][m][1] * dq + bg1, l0 = acc[ai][1][m][0] * dq + bl0, l1 = acc[ai][1][m][1] * dq + bl1;
                float r[8];
#pragma unroll
                for (int q = 0; q < 4; ++q) { float gl = fminf(g0[q], 7.0f), li = fminf(fmaxf(l0[q], -7.0f), 7.0f); r[q] = 4.0f * gl * sigm(1.702f * gl) * (li + 1.0f);
                                              gl = fminf(g1[q], 7.0f); li = fminf(fmaxf(l1[q], -7.0f), 7.0f); r[4 + q] = 4.0f * gl * sigm(1.702f * gl) * (li + 1.0f); }
                u32x2 w; w.x = cvt4_fp8(r[0], r[1], r[2], r[3]); w.y = cvt4_fp8(r[4], r[5], r[6], r[7]);
                *(u32x2*)(act + (size_t)(row0 + ai * HALF + m * 16) * 1024 + f0) = w; }
    }
};
struct EpiY8 {
    static constexpr bool PERM = true, AFTER_DRAIN = false;
    const float* b2; const float* rw; unsigned char* y; float dq;
    __device__ __forceinline__ void operator()(const f32x4 (&acc)[2][2][4][2], const Unit& u, int wr, int wc, int fr, int fq) const {
        const int e = u.pn >> 2, j = u.pn & 3; const int row0 = u.pm * BM + wr * 64 + fr, col0 = 256 * j + wc * 32 + 8 * fq;
        const float* be = b2 + (size_t)e * 1024 + col0;
        f32x4 bv[2][2];
#pragma unroll
        for (int bj = 0; bj < 2; ++bj)
#pragma unroll
            for (int n = 0; n < 2; ++n) bv[bj][n] = *(const f32x4*)(be + bj * HALF + 4 * n);
#pragma unroll
        for (int ai = 0; ai < 2; ++ai)
#pragma unroll
            for (int m = 0; m < 4; ++m) { const int row = row0 + ai * HALF + m * 16; const float w_ = rw[row] * 32.0f;
#pragma unroll
                for (int bj = 0; bj < 2; ++bj) { const f32x4 v0 = (acc[ai][bj][m][0] * dq + bv[bj][0]) * w_, v1 = (acc[ai][bj][m][1] * dq + bv[bj][1]) * w_;
                    u32x2 w; w.x = cvt4_fp8(v0[0], v0[1], v0[2], v0[3]); w.y = cvt4_fp8(v1[0], v1[1], v1[2], v1[3]);
                    *(u32x2*)(y + (size_t)row * 1024 + col0 + bj * HALF) = w; } }
    }
};

struct EpiGateFused {
    static constexpr bool PERM = true, AFTER_DRAIN = false, HAS_MID = true;
    const bf16_t* gc; const bf16_t* gh; bf16_t* out;
    __device__ __forceinline__ void mid(f32x4 (&acc)[2][2][4][2], const Unit& u, int wr, int wc, int fr, int fq) const {
        const int row0 = u.pm * BM + wr * 64 + fr, col0 = u.pn * BM + wc * 32 + 8 * fq;
#pragma unroll
        for (int ai = 0; ai < 2; ++ai)
#pragma unroll
            for (int m = 0; m < 4; ++m) { const size_t o = (size_t)(row0 + ai * HALF + m * 16) * 1024 + col0;
#pragma unroll
                for (int bj = 0; bj < 2; ++bj) { const u32x4 a = *(const u32x4*)(gc + o + bj * HALF), b = *(const u32x4*)(gh + o + bj * HALF);
                    const unsigned aw[4] = {a.x, a.y, a.z, a.w}, bw[4] = {b.x, b.y, b.z, b.w};
#pragma unroll
                    for (int q = 0; q < 4; ++q) { const float r0 = (1.0f + __expf(-blo(bw[q]))) * __builtin_amdgcn_rcpf(1.0f + __expf(-blo(aw[q]))), r1 = (1.0f + __expf(-bhi(bw[q]))) * __builtin_amdgcn_rcpf(1.0f + __expf(-bhi(aw[q])));
                        acc[ai][bj][m][q >> 1][(2 * q) & 3] *= r0; acc[ai][bj][m][q >> 1][(2 * q + 1) & 3] *= r1; } } }
    }
    __device__ __forceinline__ void operator()(const f32x4 (&acc)[2][2][4][2], const Unit& u, int wr, int wc, int fr, int fq) const {
        const int row0 = u.pm * BM + wr * 64 + fr, col0 = u.pn * BM + wc * 32 + 8 * fq;
#pragma unroll
        for (int ai = 0; ai < 2; ++ai)
#pragma unroll
            for (int m = 0; m < 4; ++m) { const size_t o = (size_t)(row0 + ai * HALF + m * 16) * 1024 + col0;
#pragma unroll
                for (int bj = 0; bj < 2; ++bj) { const u32x4 g = *(const u32x4*)(gh + o + bj * HALF); f32x4 v0 = acc[ai][bj][m][0], v1 = acc[ai][bj][m][1];
                    v0[0] *= sigm(blo(g.x)); v0[1] *= sigm(bhi(g.x)); v0[2] *= sigm(blo(g.y)); v0[3] *= sigm(bhi(g.y));
                    v1[0] *= sigm(blo(g.z)); v1[1] *= sigm(bhi(g.z)); v1[2] *= sigm(blo(g.w)); v1[3] *= sigm(bhi(g.w));
                    u32x4 w; w.x = cvt_pk_bf16(v0[0], v0[1]); w.y = cvt_pk_bf16(v0[2], v0[3]); w.z = cvt_pk_bf16(v1[0], v1[1]); w.w = cvt_pk_bf16(v1[2], v1[3]);
                    *(u32x4*)(out + o + bj * HALF) = w; } }
    }
};

template <class T, class = void> struct has_mid { static constexpr bool value = false; };
template <class T> struct has_mid<T, decltype((void)T::HAS_MID)> { static constexpr bool value = true; };
template <class Epi, class Sched, bool ALIGN_EPI = false, bool SP2 = false, bool GATHER = false, bool FP8 = false>
__device__ __forceinline__ void gemm_phase(PG8_LAS unsigned char* lds, const Gemm g, const Sched& S, const Epi& E, const int wave_id, const PG8_LAS unsigned short* gtab = nullptr) {
    typedef int i32x4 __attribute__((ext_vector_type(4))); typedef int i32x8 __attribute__((ext_vector_type(8)));
    static_assert(!GATHER || SP2, "GATHER needs the SP2 loop");
    int lane = (int)__builtin_amdgcn_mbcnt_hi(~0u, __builtin_amdgcn_mbcnt_lo(~0u, 0u)); asm volatile("" : "+v"(lane));
    const int wid = wave_id, tid = wid * 64 + lane, wr = wid >> 2, wc = wid & 3, fr = lane & 15, fq = lane >> 4;
    const int K = g.K, nt = K / BK;
    unsigned voffA[2], voffB[2];
#pragma unroll
    for (int i = 0; i < 2; ++i) { int R, C; stage_rc(tid * 16 + i * 8192, R, C); const int Rb = Epi::PERM ? ((R & ~31) + perm32(R & 31)) : R;
        voffA[i] = (unsigned)(R * K + C) * 2u; voffB[i] = (unsigned)(Rb * K + C) * 2u; }
    unsigned vA0[2] = {0u, 0u}, vA1[2] = {0u, 0u}, xA0[2] = {0u, 0u}, xA1[2] = {0u, 0u};
#define PG8_GLOAD(d0, d1, ui_) do { int tz_ = wid * 64 + (int)__builtin_amdgcn_mbcnt_hi(~0u, __builtin_amdgcn_mbcnt_lo(~0u, 0u)); asm volatile("" : "+v"(tz_)); _Pragma("unroll") for (int _i = 0; _i < 2; ++_i) { int R_, C_; stage_rc(tz_ * 16 + _i * 8192, R_, C_); \
        d0[_i] = (unsigned)gtab[256 * (ui_) + R_] * (unsigned)(K * 2) + (unsigned)C_ * 2u; d1[_i] = (unsigned)gtab[256 * (ui_) + 128 + R_] * (unsigned)(K * 2) + (unsigned)C_ * 2u; } } while (0)
    const unsigned kstep = (unsigned)(BK * 2);
    const unsigned hstep = (unsigned)HALF * K * 2;
    const unsigned tstep = 2 * hstep;
    const __amdgpu_buffer_rsrc_t rsA = __builtin_amdgcn_make_buffer_rsrc((void*)g.A, 0, 0x7fffffff, 0x00020000), rsB = __builtin_amdgcn_make_buffer_rsrc((void*)g.Bt, 0, 0x7fffffff, 0x00020000);
    const unsigned ldsw = (unsigned)wid * 1024u;
    const int aoff = lds_byte(wr * 64 + fr, fq * 8), boff = lds_byte(wc * 32 + fr, fq * 8);
#define PG8_SA(b, h) (((b) * 2 + (h)) * HTB)
#define PG8_SB(b, h) ((4 + (b) * 2 + (h)) * HTB)
#define PG8_STAGE(bufoff, rs, soff, voff) do { _Pragma("unroll") for (int _i = 0; _i < 2; ++_i) \
        __builtin_amdgcn_raw_ptr_buffer_load_lds(rs, (PG8_LAS void*)(lds + (bufoff) + ldsw + _i * 8192), 16, (int)(voff)[_i], (int)(soff), 0, 0); } while (0)
#define PG8_LDA(dst, b, h) do { if constexpr (FP8) { _Pragma("unroll") for (int m = 0; m < 4; ++m) dst##_8[m] = __builtin_shufflevector(*(const PG8_LAS i32x4*)(lds + PG8_SA(b, h) + aoff + m * 2048), *(const PG8_LAS i32x4*)(lds + PG8_SA(b, h) + aoff + m * 2048 + 1024), 0, 1, 2, 3, 4, 5, 6, 7); } \
        else { _Pragma("unroll") for (int m = 0; m < 4; ++m) _Pragma("unroll") for (int k = 0; k < 2; ++k) dst[m][k] = *(const PG8_LAS bf16x8*)(lds + PG8_SA(b, h) + aoff + m * 2048 + k * 1024); } } while (0)
#define PG8_LDB(dst, b, h) do { if constexpr (FP8) { _Pragma("unroll") for (int n = 0; n < 2; ++n) dst##_8[n] = __builtin_shufflevector(*(const PG8_LAS i32x4*)(lds + PG8_SB(b, h) + boff + n * 2048), *(const PG8_LAS i32x4*)(lds + PG8_SB(b, h) + boff + n * 2048 + 1024), 0, 1, 2, 3, 4, 5, 6, 7); } \
        else { _Pragma("unroll") for (int n = 0; n < 2; ++n) _Pragma("unroll") for (int k = 0; k < 2; ++k) dst[n][k] = *(const PG8_LAS bf16x8*)(lds + PG8_SB(b, h) + boff + n * 2048 + k * 1024); } } while (0)
#define PG8_MMA(ai, bj, At, Bt) do { __builtin_amdgcn_s_setprio(1); if constexpr (FP8) { _Pragma("unroll") for (int m = 0; m < 4; ++m) _Pragma("unroll") for (int n = 0; n < 2; ++n) \
        asm volatile("v_mfma_scale_f32_16x16x128_f8f6f4 %0, %1, %2, %0, %3, %3 op_sel_hi:[0,0,0]" : "+v"(acc[ai][bj][m][n]) : "v"(Bt##_8[n]), "v"(At##_8[m]), "v"(sc8));     \
        } else { _Pragma("unroll") for (int m = 0; m < 4; ++m) _Pragma("unroll") for (int n = 0; n < 2; ++n) _Pragma("unroll") for (int k = 0; k < 2; ++k) \
        acc[ai][bj][m][n] = __builtin_amdgcn_mfma_f32_16x16x32_bf16(Bt[n][k], At[m][k], acc[ai][bj][m][n], 0, 0, 0); } __builtin_amdgcn_s_setprio(0); } while (0)
#define PG8_WAIT_V(n) asm volatile("s_waitcnt vmcnt(" #n ")" ::: "memory")
#define PG8_WAIT_L(n) asm volatile("s_waitcnt lgkmcnt(" #n ")" ::: "memory")
#define PG8_BAR __builtin_amdgcn_s_barrier()
#define PG8_SCHED __builtin_amdgcn_sched_barrier(0)
    Unit cur, nxt; int ui = 0;
    if (!S.next(0, cur)) return;
    f32x4 acc[2][2][4][2];
#pragma unroll
    for (int a = 0; a < 2; ++a)
#pragma unroll
        for (int b = 0; b < 2; ++b)
#pragma unroll
            for (int m = 0; m < 4; ++m)
#pragma unroll
                for (int n = 0; n < 2; ++n) acc[a][b][m][n] = (f32x4){0.f, 0.f, 0.f, 0.f};
    int sc8 = 0x7f7f7f7f; asm volatile("" : "+v"(sc8));
    bf16x8 At[4][2], B0[2][2], B1[2][2]; i32x8 At_8[4], B0_8[2], B1_8[2];
    unsigned cA = GATHER ? 0u : (unsigned)cur.pm * tstep, cB = (unsigned)cur.pn * tstep;
    S.a_ready(cur);
    if constexpr (GATHER) { PG8_GLOAD(vA0, vA1, 0); xA0[0] = vA0[0]; xA0[1] = vA0[1]; xA1[0] = vA1[0]; xA1[1] = vA1[1]; }
    if constexpr (SP2) {
        PG8_STAGE(PG8_SB(0, 0), rsB, cB, voffB); PG8_STAGE(PG8_SB(0, 1), rsB, cB + hstep, voffB);
        if constexpr (GATHER) { PG8_STAGE(PG8_SA(0, 0), rsA, cA, vA0); PG8_STAGE(PG8_SA(0, 1), rsA, cA, vA1); } else { PG8_STAGE(PG8_SA(0, 0), rsA, cA, voffA); PG8_STAGE(PG8_SA(0, 1), rsA, cA + hstep, voffA); }
        if (wr == 1) PG8_BAR;
        PG8_WAIT_V(2); PG8_BAR;
        PG8_STAGE(PG8_SB(1, 0), rsB, cB + kstep, voffB); if constexpr (GATHER) { PG8_STAGE(PG8_SA(1, 0), rsA, cA + kstep, vA0); } else { PG8_STAGE(PG8_SA(1, 0), rsA, cA + kstep, voffA); } PG8_STAGE(PG8_SB(1, 1), rsB, cB + hstep + kstep, voffB);
        PG8_WAIT_V(6); PG8_BAR;
    } else {
        PG8_STAGE(PG8_SB(0, 0), rsB, cB, voffB); PG8_STAGE(PG8_SA(0, 0), rsA, cA, voffA); PG8_STAGE(PG8_SB(0, 1), rsB, cB + hstep, voffB); PG8_STAGE(PG8_SA(0, 1), rsA, cA + hstep, voffA);
        if (wr == 1) PG8_BAR;
        PG8_WAIT_V(4); PG8_BAR;
        PG8_STAGE(PG8_SB(1, 0), rsB, cB + kstep, voffB); PG8_STAGE(PG8_SA(1, 0), rsA, cA + kstep, voffA); PG8_STAGE(PG8_SB(1, 1), rsB, cB + hstep + kstep, voffB);
        PG8_WAIT_V(6); PG8_BAR;
    }
    for (;;) {
        const bool has_next = S.next(ui + 1, nxt);
        const unsigned nA = GATHER ? cA : (has_next ? (unsigned)nxt.pm * tstep : cA), nB = has_next ? (unsigned)nxt.pn * tstep : cB;
        for (int t = 0; t < nt; t += 2) {
            const bool last = (t == nt - 2);
            const unsigned a1 = cA + (unsigned)(t + 1) * kstep;
            const unsigned a2 = last ? nA : cA + (unsigned)(t + 2) * kstep, b2 = last ? nB : cB + (unsigned)(t + 2) * kstep;
            const unsigned a3 = a2 + kstep, b3 = b2 + kstep;
            if (last && has_next) S.a_ready(nxt);
            if constexpr (has_mid<Epi>::value) { if (t == nt / 2) { int l3_ = (int)__builtin_amdgcn_mbcnt_hi(~0u, __builtin_amdgcn_mbcnt_lo(~0u, 0u)); asm volatile("" : "+v"(l3_)); E.mid(acc, cur, wr, wc, l3_ & 15, l3_ >> 4); } }
            if constexpr (GATHER) { if (last && has_next) { PG8_GLOAD(xA0, xA1, ui + 1); } }
            if constexpr (SP2) {
            PG8_LDB(B0, 0, 0); PG8_LDB(B1, 0, 1); PG8_SCHED; PG8_LDA(At, 0, 0); if constexpr (GATHER) { PG8_STAGE(PG8_SA(1, 1), rsA, a1, vA1); } else { PG8_STAGE(PG8_SA(1, 1), rsA, a1 + hstep, voffA); }
            PG8_WAIT_V(8); PG8_WAIT_L(0); PG8_BAR; PG8_MMA(0, 0, At, B0); PG8_MMA(0, 1, At, B1); PG8_BAR; PG8_SCHED;
            PG8_LDA(At, 0, 1); PG8_STAGE(PG8_SB(0, 0), rsB, b2, voffB); PG8_STAGE(PG8_SB(0, 1), rsB, b2 + hstep, voffB); if constexpr (GATHER) { PG8_STAGE(PG8_SA(0, 0), rsA, a2, xA0); } else { PG8_STAGE(PG8_SA(0, 0), rsA, a2, voffA); }
            PG8_WAIT_V(8); PG8_WAIT_L(0); PG8_BAR; PG8_MMA(1, 0, At, B0); PG8_MMA(1, 1, At, B1); PG8_BAR; PG8_SCHED;
            PG8_LDB(B0, 1, 0); PG8_LDB(B1, 1, 1); PG8_SCHED; PG8_LDA(At, 1, 0); if constexpr (GATHER) { PG8_STAGE(PG8_SA(0, 1), rsA, a2, xA1); } else { PG8_STAGE(PG8_SA(0, 1), rsA, a2 + hstep, voffA); }
            PG8_WAIT_V(8); PG8_WAIT_L(0); PG8_BAR; PG8_MMA(0, 0, At, B0); PG8_MMA(0, 1, At, B1); PG8_BAR; PG8_SCHED;
            PG8_LDA(At, 1, 1); PG8_STAGE(PG8_SB(1, 0), rsB, b3, voffB); PG8_STAGE(PG8_SB(1, 1), rsB, b3 + hstep, voffB); if constexpr (GATHER) { PG8_STAGE(PG8_SA(1, 0), rsA, a3, xA0); } else { PG8_STAGE(PG8_SA(1, 0), rsA, a3, voffA); }
            PG8_WAIT_V(8); PG8_WAIT_L(0); PG8_BAR; PG8_MMA(1, 0, At, B0); PG8_MMA(1, 1, At, B1); PG8_BAR; PG8_SCHED;
            } else {
            PG8_LDB(B0, 0, 0); PG8_SCHED; PG8_LDA(At, 0, 0); PG8_STAGE(PG8_SA(1, 1), rsA, a1 + hstep, voffA);
            PG8_WAIT_L(8); PG8_BAR; PG8_WAIT_L(0); PG8_MMA(0, 0, At, B0); PG8_BAR; PG8_SCHED;
            PG8_LDB(B1, 0, 1); PG8_STAGE(PG8_SB(0, 0), rsB, b2, voffB);
            PG8_BAR; PG8_WAIT_L(0); PG8_MMA(0, 1, At, B1); PG8_BAR;
            PG8_LDA(At, 0, 1); PG8_STAGE(PG8_SA(0, 0), rsA, a2, voffA);
            PG8_BAR; PG8_WAIT_L(0); PG8_MMA(1, 0, At, B0); PG8_BAR; PG8_SCHED;
            PG8_STAGE(PG8_SB(0, 1), rsB, b2 + hstep, voffB);
            PG8_WAIT_V(6); PG8_BAR; PG8_MMA(1, 1, At, B1); PG8_BAR;
            PG8_LDB(B0, 1, 0); PG8_SCHED; PG8_LDA(At, 1, 0); PG8_STAGE(PG8_SA(0, 1), rsA, a2 + hstep, voffA);
            PG8_WAIT_L(8); PG8_BAR; PG8_WAIT_L(0); PG8_MMA(0, 0, At, B0); PG8_BAR; PG8_SCHED;
            PG8_LDB(B1, 1, 1); PG8_STAGE(PG8_SB(1, 0), rsB, b3, voffB);
            PG8_BAR; PG8_WAIT_L(0); PG8_MMA(0, 1, At, B1); PG8_BAR;
            PG8_LDA(At, 1, 1); PG8_STAGE(PG8_SA(1, 0), rsA, a3, voffA);
            PG8_BAR; PG8_WAIT_L(0); PG8_MMA(1, 0, At, B0); PG8_BAR; PG8_SCHED;
            PG8_STAGE(PG8_SB(1, 1), rsB, b3 + hstep, voffB);
            PG8_WAIT_V(6); PG8_BAR; PG8_MMA(1, 1, At, B1); PG8_BAR;
            }
        }
        if constexpr (ALIGN_EPI) { if (wr == 0) PG8_BAR; }
        if constexpr (!Epi::AFTER_DRAIN) { int l2_ = (int)__builtin_amdgcn_mbcnt_hi(~0u, __builtin_amdgcn_mbcnt_lo(~0u, 0u)); asm volatile("" : "+v"(l2_));
            E(acc, cur, wr, wc, l2_ & 15, l2_ >> 4); S.done(cur); }
        if (!has_next) break;
#pragma unroll
        for (int a = 0; a < 2; ++a)
#pragma unroll
            for (int b = 0; b < 2; ++b)
#pragma unroll
                for (int m = 0; m < 4; ++m)
#pragma unroll
                    for (int n = 0; n < 2; ++n) acc[a][b][m][n] = (f32x4){0.f, 0.f, 0.f, 0.f};
        cur = nxt; cA = nA; cB = nB; ++ui;
        if constexpr (GATHER) { vA0[0] = xA0[0]; vA0[1] = xA0[1]; vA1[0] = xA1[0]; vA1[1] = xA1[1]; }
        if constexpr (ALIGN_EPI) { if (wr == 1) PG8_BAR; }
    }
    PG8_WAIT_V(0);
    if constexpr (!ALIGN_EPI) { if (wr == 0) PG8_BAR; }
    PG8_BAR;
    if constexpr (Epi::AFTER_DRAIN) { E.fused(acc, cur, wr, wc, fr, fq, lds, wid, lane); S.done(cur); }
#undef PG8_GLOAD
#undef PG8_SA
#undef PG8_SB
#undef PG8_STAGE
#undef PG8_LDA
#undef PG8_LDB
#undef PG8_MMA
#undef PG8_WAIT_V
#undef PG8_WAIT_L
#undef PG8_BAR
#undef PG8_SCHED
}
}
#define XB_TMO      128
#define XB_XCNT(j)  (256  + 64 * (j))
#define XB_XSUB(j)  (1280 + 64 * (j))
#define XB_XGEN(j)  (2304 + 64 * (j))
#define XB_TOP      3328
#define XB_TOPGEN   3392
#define XCD_BAR_WORDS 3456
#define XB_SPIN_CAP (1u << 18)

__device__ __forceinline__ unsigned xb_ld(unsigned* p)              { return __hip_atomic_load(p, __ATOMIC_RELAXED, __HIP_MEMORY_SCOPE_AGENT); }
__device__ __forceinline__ unsigned xb_add(unsigned* p, unsigned v) { return __hip_atomic_fetch_add(p, v, __ATOMIC_RELAXED, __HIP_MEMORY_SCOPE_AGENT); }
__device__ __forceinline__ unsigned xb_xcc_id() { return (unsigned)__builtin_amdgcn_s_getreg((3 << 11) | 20) & 0xFu; }
#define XB_SPIN(cond, bar) do { unsigned _sp = 0; while (cond) { __builtin_amdgcn_s_sleep(1); \
    if ((++_sp & 255u) == 0u) { if (xb_ld(&(bar)[XB_TMO])) break; if (_sp > XB_SPIN_CAP) { atomicAdd(&(bar)[XB_TMO], 1u); break; } } } } while (0)

struct XcdBarrier {
    unsigned* bar; unsigned x;
    volatile LAS unsigned* st;
};

__device__ __forceinline__ XcdBarrier xcd_barrier_post(unsigned* bar, volatile LAS unsigned* st, const bool leader  ) {
    XcdBarrier b; b.bar = bar; b.x = xb_xcc_id(); b.st = st;
    if (leader) (void)xb_add(&bar[XB_XCNT(b.x)], 1u);
    return b;
}
__device__ __forceinline__ void xcd_barrier_complete(unsigned* bar, unsigned x, unsigned& nloc, unsigned& nx) {
    const unsigned G = gridDim.x * gridDim.y * gridDim.z;
    unsigned sum, cnt, mine, sp = 0u;
    for (;;) {
        sum = 0u; cnt = 0u; mine = 0u;
#pragma unroll
        for (unsigned j = 0; j < 16; ++j) { const unsigned c = xb_ld(&bar[XB_XCNT(j)]); sum += c; cnt += (c > 0u) ? 1u : 0u; mine = (j == x) ? c : mine; }
        if (sum == G) break;
        __builtin_amdgcn_s_sleep(1);
        if ((++sp & 255u) == 0u) { if (xb_ld(&bar[XB_TMO])) break; if (sp > XB_SPIN_CAP) { atomicAdd(&bar[XB_TMO], 1u); break; } }
    }
    nloc = mine > 0u ? mine : 1u; nx = cnt > 0u ? cnt : 1u;
}

__device__ __forceinline__ void xcd_barrier(const XcdBarrier& b, const bool leader  ) {
    asm volatile("s_waitcnt vmcnt(0)" ::: "memory");
    __syncthreads();
    if (leader) {
        unsigned* bar = b.bar;
        __builtin_amdgcn_s_waitcnt(0);
        unsigned nloc = b.st[0], nx = b.st[1];
        if (nloc == 0u) { xcd_barrier_complete(bar, b.x, nloc, nx); b.st[0] = nloc; b.st[1] = nx; }
        const unsigned old = xb_add(&bar[XB_XSUB(b.x)], 1u);
        const unsigned gen = old / nloc;
        if (old + 1u == (gen + 1u) * nloc) {
            __builtin_amdgcn_fence(__ATOMIC_RELEASE, "agent");
            asm volatile("s_waitcnt vmcnt(0)" ::: "memory");
            const unsigned og = xb_add(&bar[XB_TOP], 1u);
            const unsigned tg = og / nx;
            if (og + 1u == (tg + 1u) * nx) xb_add(&bar[XB_TOPGEN], 1u);
            else XB_SPIN(xb_ld(&bar[XB_TOPGEN]) == tg, bar);
            __builtin_amdgcn_fence(__ATOMIC_ACQUIRE, "agent");
            xb_add(&bar[XB_XGEN(b.x)], 1u);
            asm volatile("s_waitcnt vmcnt(0)" ::: "memory");
        } else {
            XB_SPIN(xb_ld(&bar[XB_XGEN(b.x)]) == gen, bar);
            __builtin_amdgcn_fence(__ATOMIC_ACQUIRE, "agent");
            asm volatile("s_waitcnt vmcnt(0)" ::: "memory");
        }
    }
    __syncthreads();
}

#ifndef P_FP8_MASK
#define P_FP8_MASK 0xFFFFFFFFu
#endif =======================================================
struct Ctx { LAS unsigned char* lds; int tid, lane, wave, vcu, G; };

__device__ __forceinline__ void transpose_load64(const float* W, int ldw, int k0, int n0, LAS float* scr, int lane) {
#pragma unroll 8
    for (int i = 0; i < 16; ++i) { const int kk = 4 * i + (lane >> 4), nn = 4 * (lane & 15); const f32x4 v = *(const f32x4*)(W + (size_t)(k0 + kk) * ldw + n0 + nn);
        LAS float* d = scr + kk * 65 + nn; d[0] = v.x; d[1] = v.y; d[2] = v.z; d[3] = v.w; }
    LDS_WAIT();
}
__device__ __forceinline__ void transpose_item(const float* W, int ldw, int K, bf16_t* dst, int k0, int n0, LAS float* scr, int lane) {
    transpose_load64(W, ldw, k0, n0, scr, lane);
    const int c = lane & 7;
#pragma unroll
    for (int j = 0; j < 8; ++j) { const int n = (lane >> 3) + 8 * j; const LAS float* s = scr + (8 * c) * 65 + n;
        u32x4 o; o.x = pk2(s[0 * 65], s[1 * 65]); o.y = pk2(s[2 * 65], s[3 * 65]); o.z = pk2(s[4 * 65], s[5 * 65]); o.w = pk2(s[6 * 65], s[7 * 65]);
        *(u32x4*)(dst + (size_t)n * K + k0 + 8 * c) = o; }
    LDS_WAIT();
}
__device__ __forceinline__ void transpose_item8(const float* W, int ldw, int K, unsigned char* dst, int k0, int n0, float scale, LAS float* scr, int lane) {
    transpose_load64(W, ldw, k0, n0, scr, lane);
    const int c = lane & 3;
#pragma unroll
    for (int j = 0; j < 4; ++j) { const int n = (lane >> 2) + 16 * j; const LAS float* s = scr + (16 * c) * 65 + n;
        u32x4 o; o.x = cvt4_fp8(s[0 * 65] * scale, s[1 * 65] * scale, s[2 * 65] * scale, s[3 * 65] * scale); o.y = cvt4_fp8(s[4 * 65] * scale, s[5 * 65] * scale, s[6 * 65] * scale, s[7 * 65] * scale);
        o.z = cvt4_fp8(s[8 * 65] * scale, s[9 * 65] * scale, s[10 * 65] * scale, s[11 * 65] * scale); o.w = cvt4_fp8(s[12 * 65] * scale, s[13 * 65] * scale, s[14 * 65] * scale, s[15 * 65] * scale);
        *(u32x4*)(dst + (size_t)n * K + k0 + 16 * c) = o; }
    LDS_WAIT();
}

template <int PART>
__device__ __forceinline__ void ph_prologue(const Ctx& X, const float* c, const float* w_ada, const float* b_ada, float* mod,
                                            const float* w_in, const float* w_conv_out, const float* w_hgrn_out, const float* w_out, const float* w1, const float* w2, unsigned char* ws) {
    if (PART == 0 && X.vcu < 48) {
        LAS float* ca = (LAS float*)X.lds;
        LAS float* red = (LAS float*)(X.lds + 16384);
        for (int i = X.tid; i < 4096; i += 512) { const float v = c[i]; ca[i] = v * sigmoidf_(v); }
        __syncthreads();
        const int jj = X.tid & 127, kq = X.tid >> 7, j = X.vcu * 128 + jj;
        float a0 = 0.f, a1 = 0.f, a2 = 0.f, a3 = 0.f;
#pragma unroll 8
        for (int i = kq * 256; i < kq * 256 + 256; ++i) { const float w = w_ada[(size_t)i * NMOD + j]; a0 += ca[i] * w; a1 += ca[1024 + i] * w; a2 += ca[2048 + i] * w; a3 += ca[3072 + i] * w; }
        red[(kq * 4 + 0) * 128 + jj] = a0; red[(kq * 4 + 1) * 128 + jj] = a1; red[(kq * 4 + 2) * 128 + jj] = a2; red[(kq * 4 + 3) * 128 + jj] = a3;
        __syncthreads();
        { const int b = X.tid >> 7; mod[(size_t)b * NMOD + j] = b_ada[j] + red[(0 * 4 + b) * 128 + jj] + red[(1 * 4 + b) * 128 + jj] + red[(2 * 4 + b) * 128 + jj] + red[(3 * 4 + b) * 128 + jj]; }
        __syncthreads();
    }
    LAS float* scr = (LAS float*)(X.lds + X.wave * 16640);
    const int gw = X.vcu * 8 + X.wave, NGW = X.G * 8;
    constexpr int I_IN = 16 * 128, I_SQ = 16 * 16, I_W1 = 32 * 16 * 32, I_W2 = 32 * 16 * 16, NITEMS = I_IN + 3 * I_SQ + I_W1 + I_W2;
    constexpr int I_DENSE = I_IN + 3 * I_SQ;
    for (int it = (PART == 0 ? 0 : I_DENSE) + gw; it < (PART == 0 ? I_DENSE : NITEMS); it += NGW) {
        int r = it;
        if (r < I_IN) { const int kb = r >> 7, nb = r & 127, n0 = 64 * nb;
            const int rho0 = (n0 < 2048) ? 256 * ((n0 & 1023) >> 7) + 128 * (n0 >> 10) + (n0 & 127) : n0;
            if ((P_FP8_MASK >> (rho0 >> 8)) & 1u) transpose_item8(w_in, 8192, 1024, (unsigned char*)(ws + WS_WIN8) + (size_t)rho0 * 1024, 64 * kb, n0, 256.0f, scr, X.lane);
            else transpose_item(w_in, 8192, 1024, (bf16_t*)(ws + WS_WIN) + (size_t)rho0 * 1024, 64 * kb, n0, scr, X.lane);
            continue; } r -= I_IN;
        if (r < 3 * I_SQ) { const int which = r / I_SQ, q = r % I_SQ, kb = q >> 4, nb = q & 15;
            const float* W = which == 0 ? w_conv_out : (which == 1 ? w_hgrn_out : w_out);
            if (which == 2) transpose_item(W, 1024, 1024, (bf16_t*)(ws + WS_WO) + (size_t)(64 * nb) * 1024, 64 * kb, 64 * nb, scr, X.lane);
            else transpose_item(W, 1024, 2048, (bf16_t*)(ws + WS_WC) + (size_t)(64 * nb) * 2048 + which * 1024, 64 * kb, 64 * nb, scr, X.lane);
            continue; } r -= 3 * I_SQ;
        if (r < I_W1) { const int e = r >> 9, q = r & 511, kb = q >> 5, nb = q & 31, n0 = 64 * nb;
            const int rho0 = (n0 < 1024) ? 256 * (n0 >> 7) + (n0 & 127) : 256 * ((n0 - 1024) >> 7) + 128 + ((n0 - 1024) & 127);
            transpose_item8(w1 + (size_t)e * 1024 * 2048, 2048, 1024, (unsigned char*)(ws + WS_W1) + ((size_t)e * 2048 + rho0) * 1024, 64 * kb, n0, 256.0f, scr, X.lane); continue; } r -= I_W1;
        { const int e = r >> 8, q = r & 255, kb = q >> 4, nb = q & 15;
            transpose_item8(w2 + (size_t)e * 1024 * 1024, 1024, 1024, (unsigned char*)(ws + WS_W2) + ((size_t)e * 1024 + 64 * nb) * 1024, 64 * kb, 64 * nb, 256.0f, scr, X.lane); }
    }
    __syncthreads();
}

__device__ __forceinline__ void ph_norm_mod(const Ctx& X, const float* x, const float* g, const float* mod, int sh_off, int sc_off, bf16_t* out, unsigned char* out8) {
    for (int t = X.vcu * 8 + X.wave; t < T; t += X.G * 8) {
        const int b = t / SEQ, lane = X.lane;
        const f32x4* xr = (const f32x4*)(x + (size_t)t * D) + lane;
        f32x4 v[4]; float ss = 0.f;
#pragma unroll
        for (int j = 0; j < 4; ++j) { v[j] = xr[64 * j]; ss += (v[j].x * v[j].x + v[j].y * v[j].y) + (v[j].z * v[j].z + v[j].w * v[j].w); }
        const float r = rsqrtf(wave_sum(ss) * (1.0f / D) + EPS);
        const float* sh = mod + (size_t)b * NMOD + sh_off; const float* sc = mod + (size_t)b * NMOD + sc_off;
#pragma unroll
        for (int j = 0; j < 4; ++j) {
            const int col = 4 * (lane + 64 * j);
            const f32x4 gg = *(const f32x4*)(g + col), s1 = *(const f32x4*)(sc + col), s0 = *(const f32x4*)(sh + col);
            const f32x4 y = v[j] * r * gg * (s1 + 1.0f) + s0;
            if (P_FP8_MASK != 0xFFFFFFFFu) { u32x2 w; w.x = pk2(y.x, y.y); w.y = pk2(y.z, y.w); *(u32x2*)(out + (size_t)t * D + col) = w; }
            if (P_FP8_MASK != 0u) *(unsigned*)(out8 + (size_t)t * D + col) = cvt4_fp8(y.x * 16.0f, y.y * 16.0f, y.z * 16.0f, y.w * 16.0f);
        }
    }
}

typedef float f32x2 __attribute__((ext_vector_type(2)));
__device__ __forceinline__ void ph_conv(const Ctx& X, const bf16_t* pU, const float* dw, const float* dwb, const float* lng, const float* lnb, bf16_t* uc) {
    LAS float* sm = (LAS float*)X.lds;
    const int tid = X.tid, lane = X.lane, wid = X.wave, c0 = 2 * tid;
    float w[31][2];
#pragma unroll
    for (int j = 0; j < 31; ++j) { w[j][0] = dw[j * 1024 + c0]; w[j][1] = dw[j * 1024 + c0 + 1]; }
    const float bias0 = dwb[c0], bias1 = dwb[c0 + 1];
    unsigned raw[62];
#define CONV_LOAD(task_) do { const int b_ = (task_) >> 8, s0_ = ((task_) & 255) * 32; const bf16_t* q_ = pU + (size_t)(b_ * SEQ) * D + c0; \
        _Pragma("unroll") for (int i = 0; i < 62; ++i) { const int s_ = s0_ - 30 + i; raw[i] = (s_ >= 0) ? *(const unsigned*)(q_ + (size_t)s_ * D) : 0u; } } while (0)
    int task = X.vcu;
    if (task < T / 32) CONV_LOAD(task);
    for (; task < T / 32; task += X.G) {
        const int b = task >> 8, s0 = (task & 255) * 32;
#pragma unroll
        for (int st = 0; st < 4; ++st) {
            float u[38][2];
#pragma unroll
            for (int i = 0; i < 38; ++i) { u[i][0] = bflo(raw[8 * st + i]); u[i][1] = bfhi(raw[8 * st + i]); }
#pragma unroll
            for (int t = 0; t < 8; ++t) {
                float a0 = bias0, a1 = bias1;
#pragma unroll
                for (int j = 0; j < 31; ++j) { a0 += w[j][0] * u[t + j][0]; a1 += w[j][1] * u[t + j][1]; }
                *(LAS f32x2*)(sm + (8 * st + t) * 1024 + c0) = (f32x2){a0, a1};
            }
        }
        if (task + X.G < T / 32) CONV_LOAD(task + X.G);
        __syncthreads();
#pragma unroll 2
        for (int i = 0; i < 4; ++i) {
            const int t = wid * 4 + i;
            f32x4 v[4]; float s = 0.f;
#pragma unroll
            for (int j = 0; j < 4; ++j) { v[j] = *(const LAS f32x4*)(sm + t * 1024 + 4 * (lane + 64 * j)); s += (v[j].x + v[j].y) + (v[j].z + v[j].w); }
            const float mean = wave_sum(s) * (1.0f / D); float q = 0.f;
#pragma unroll
            for (int j = 0; j < 4; ++j) { v[j] = v[j] - mean; q += (v[j].x * v[j].x + v[j].y * v[j].y) + (v[j].z * v[j].z + v[j].w * v[j].w); }
            const float rstd = rsqrtf(wave_sum(q) * (1.0f / D) + EPS);
#pragma unroll
            for (int j = 0; j < 4; ++j) {
                const int col = 4 * (lane + 64 * j);
                const f32x4 gg = *(const f32x4*)(lng + col), bb = *(const f32x4*)(lnb + col);
                f32x4 y = v[j] * rstd * gg + bb;
                y.x *= sigmoidf_(y.x); y.y *= sigmoidf_(y.y); y.z *= sigmoidf_(y.z); y.w *= sigmoidf_(y.w);
                u32x2 o; o.x = pk2(y.x, y.y); o.y = pk2(y.z, y.w);
                *(u32x2*)(uc + (size_t)(b * SEQ + s0 + t) * (2 * D) + col) = o;
            }
        }
        __syncthreads();
    }
#undef CONV_LOAD
}

typedef short bf16x8 __attribute__((ext_vector_type(8)));
typedef short s16x4 __attribute__((ext_vector_type(4)));
constexpr int HG_QA = 0, HG_KA = 17408, HG_VR = 34816, HG_AB = 52224, HG_SPT = 61440, HG_O = 96256, HG_SEG = 130048;
constexpr size_t HM = (size_t)SEQ * 128;
__device__ __forceinline__ bf16x8 tr_frag(LAS unsigned char* base, int rs, int ks, int c16, int lane) {
    const int g = lane >> 4, q = (lane & 15) >> 2, p = lane & 3;
    LAS unsigned char* a = base + (32 * ks + 8 * g + q) * rs + (16 * c16 + 4 * p) * 2;
    const s16x4 lo = __builtin_amdgcn_ds_read_tr16_b64_v4i16((LAS s16x4*)a);
    const s16x4 hi = __builtin_amdgcn_ds_read_tr16_b64_v4i16((LAS s16x4*)(a + 4 * rs));
    return __builtin_shufflevector(lo, hi, 0, 1, 2, 3, 4, 5, 6, 7);
}
template <bool OUT>
__device__ __forceinline__ void ph_hgrn(const Ctx& X, int ntask, const bf16_t* pQ, const bf16_t* pF, const bf16_t* pI, const bf16_t* pG,
                                        const float* lb_param, const float* norm_g, const float* S0, float* dS, float* Dd, bf16_t* og) {
    LAS unsigned char* L = X.lds;
    LAS float* seg_s = (LAS float*)(L + HG_SEG);
    const int tid = X.tid, lane = X.lane, wave = X.wave, fr = lane & 15, fq = lane >> 4, wr = wave >> 1, wc = wave & 1;
    const int cp = tid & 63, seg = wave, tv = tid >> 3, vc = tid & 7;
    int idx = X.vcu; if (idx >= ntask) return;
    int ch = 0;
    unsigned zr[8], qr[8]; u32x4 vr0, vr1, gn0, gn1, gc0, gc1;
#define HG_LOAD(idx_, ch_) do { const int bh_ = (idx_) & 31, sc_ = (idx_) >> 5; const size_t tb_ = (size_t)bh_ * HM + (size_t)(sc_ * 256 + (ch_) * 64) * 128; \
        _Pragma("unroll") for (int i = 0; i < 8; ++i) { zr[i] = *(const unsigned*)(pF + tb_ + (size_t)(8 * seg + i) * 128 + 2 * cp); if (OUT) qr[i] = *(const unsigned*)(pQ + tb_ + (size_t)(8 * seg + i) * 128 + 2 * cp); } \
        { const u32x4* s_ = (const u32x4*)(pI + tb_ + (size_t)tv * 128 + vc * 16); vr0 = s_[0]; vr1 = s_[1]; } \
        if (OUT) { const u32x4* s_ = (const u32x4*)(pG + tb_ + (size_t)tv * 128 + vc * 16); gn0 = s_[0]; gn1 = s_[1]; } } while (0)
    HG_LOAD(idx, 0);
    float ngv[16];
    if (OUT) {
#pragma unroll
        for (int i = 0; i < 16; ++i) ngv[i] = norm_g[vc * 16 + i];
    }
    f32x4 S[8]; float oml0 = 0.f, oml1 = 0.f, gsum0 = 0.f, gsum1 = 0.f;
#pragma unroll 1
    for (;;) {
        const int sc = idx >> 5, bh = idx & 31, b = bh >> 3, h = bh & 7;
        if (ch == 0) {
            const int c0 = h * 128 + 2 * cp;
            oml0 = 1.0f - 1.0f / (1.0f + __expf(lb_param[1024 + c0] - lb_param[c0])); oml1 = 1.0f - 1.0f / (1.0f + __expf(lb_param[1025 + c0] - lb_param[c0 + 1]));
            gsum0 = 0.f; gsum1 = 0.f;
            if (OUT && sc > 0) { const float* s0 = S0 + (size_t)(bh * 32 + sc) * 16384;
#pragma unroll
                for (int vt = 0; vt < 8; ++vt)
#pragma unroll
                    for (int j = 0; j < 4; ++j) S[vt][j] = s0[(size_t)(16 * wave + fq * 4 + j) * 128 + vt * 16 + fr];
            } else {
#pragma unroll
                for (int vt = 0; vt < 8; ++vt) S[vt] = (f32x4){0.f, 0.f, 0.f, 0.f};
            }
        }
        float kk0[8], kk1[8], lf0[8], lf1[8], q0[8], q1[8];
        {
            float c0 = 0.f, c1 = 0.f;
#pragma unroll
            for (int i = 0; i < 8; ++i) {
                kk0[i] = oml0 * __builtin_amdgcn_rcpf(1.0f + __expf(bflo(zr[i]))); kk1[i] = oml1 * __builtin_amdgcn_rcpf(1.0f + __expf(bfhi(zr[i])));
                c0 += __logf(1.0f - kk0[i]); c1 += __logf(1.0f - kk1[i]); lf0[i] = c0; lf1[i] = c1;
                if (OUT) { q0[i] = bflo(qr[i]) * 0.08838834764831845f; q1[i] = bfhi(qr[i]) * 0.08838834764831845f; }
            }
            *(LAS f32x2*)(seg_s + seg * 128 + 2 * cp) = (f32x2){c0, c1};
        }
        if (OUT) { gc0 = gn0; gc1 = gn1; }
        const u32x4 vcur0 = vr0, vcur1 = vr1;
        __syncthreads();
        { LAS u32x4* d = (LAS u32x4*)(L + HG_VR + tv * 272 + vc * 32); d[0] = vcur0; d[1] = vcur1; }
        { int idx2 = idx, ch2 = ch + 1; if (ch2 == 4) { ch2 = 0; idx2 = idx + X.G; } if (idx2 < ntask) HG_LOAD(idx2, ch2); }
        {
            f32x2 ss[8];
#pragma unroll
            for (int s = 0; s < 8; ++s) ss[s] = *(const LAS f32x2*)(seg_s + s * 128 + 2 * cp);
            float off0 = 0.f, off1 = 0.f;
#pragma unroll
            for (int s = 0; s < 8; ++s) { off0 += (s < seg) ? ss[s].x : 0.f; off1 += (s < seg) ? ss[s].y : 0.f; }
            const float R0 = (ss[0].x + ss[1].x) + (ss[2].x + ss[3].x), R1 = (ss[0].y + ss[1].y) + (ss[2].y + ss[3].y);
            if (!OUT && seg == 0) { gsum0 += R0 + (ss[4].x + ss[5].x) + (ss[6].x + ss[7].x); gsum1 += R1 + (ss[4].y + ss[5].y) + (ss[6].y + ss[7].y); }
#pragma unroll
            for (int i = 0; i < 8; ++i) {
                const float G0 = off0 + lf0[i], G1 = off1 + lf1[i];
                const float ka0 = kk0[i] * __expf(fminf(R0 - G0, 80.0f)), ka1 = kk1[i] * __expf(fminf(R1 - G1, 80.0f));
                *(LAS unsigned*)(L + HG_KA + (8 * seg + i) * 272 + 4 * cp) = pk2(ka0, ka1);
                if (OUT) { const float qa0 = q0[i] * __expf(fminf(G0 - R0, 80.0f)), qa1 = q1[i] * __expf(fminf(G1 - R1, 80.0f));
                           *(LAS unsigned*)(L + HG_QA + (8 * seg + i) * 272 + 4 * cp) = pk2(qa0, qa1); }
            }
        }
        float eR[4], eL[4];
        {
            f32x4 r4 = (f32x4){0.f, 0.f, 0.f, 0.f}, l4 = (f32x4){0.f, 0.f, 0.f, 0.f};
#pragma unroll
            for (int s = 0; s < 4; ++s) { r4 += *(const LAS f32x4*)(seg_s + s * 128 + 16 * wave + 4 * fq); l4 += *(const LAS f32x4*)(seg_s + (s + 4) * 128 + 16 * wave + 4 * fq); }
#pragma unroll
            for (int j = 0; j < 4; ++j) { eR[j] = __expf(fmaxf(r4[j], -80.0f)); eL[j] = __expf(l4[j]); }
        }
#pragma unroll
        for (int vt = 0; vt < 8; ++vt) {
#pragma unroll
            for (int j = 0; j < 4; ++j) S[vt][j] *= eR[j];
            if (OUT) { u32x2 w; w.x = pk2(S[vt][0], S[vt][1]); w.y = pk2(S[vt][2], S[vt][3]);
                       *(LAS u32x2*)(L + HG_SPT + (vt * 16 + fr) * 272 + (16 * wave + 4 * fq) * 2) = w; }
        }
        __syncthreads();
        if (OUT) {
#pragma unroll
            for (int q2 = 0; q2 < 2; ++q2) {
                const int st = 2 * wc + q2;
                f32x4 acc = (f32x4){0.f, 0.f, 0.f, 0.f};
                if (st <= wr) {
#pragma unroll
                    for (int kq = 0; kq < 4; ++kq) {
                        const bf16x8 af = *(const LAS bf16x8*)(L + HG_KA + (st * 16 + fr) * 272 + kq * 64 + fq * 16);
                        const bf16x8 bq = *(const LAS bf16x8*)(L + HG_QA + (wr * 16 + fr) * 272 + kq * 64 + fq * 16);
                        acc = __builtin_amdgcn_mfma_f32_16x16x32_bf16(af, bq, acc, 0, 0, 0);
                    }
                    const int tt = wr * 16 + fr;
#pragma unroll
                    for (int j = 0; j < 4; ++j) { const int s_ = st * 16 + fq * 4 + j; acc[j] = (s_ <= tt) ? acc[j] : 0.f; }
                }
                u32x2 w; w.x = pk2(acc[0], acc[1]); w.y = pk2(acc[2], acc[3]);
                *(LAS u32x2*)(L + HG_AB + (wr * 16 + fr) * 144 + (st * 16 + fq * 4) * 2) = w;
            }
        }
        {
            bf16x8 aK[2];
#pragma unroll
            for (int ks = 0; ks < 2; ++ks) aK[ks] = tr_frag(L + HG_KA, 272, ks, wave, lane);
#pragma unroll
            for (int vt = 0; vt < 8; ++vt) {
#pragma unroll
                for (int ks = 0; ks < 2; ++ks) { const bf16x8 bv = tr_frag(L + HG_VR, 272, ks, vt, lane); S[vt] = __builtin_amdgcn_mfma_f32_16x16x32_bf16(aK[ks], bv, S[vt], 0, 0, 0); }
#pragma unroll
                for (int j = 0; j < 4; ++j) S[vt][j] *= eL[j];
            }
        }
        if (OUT) {
            __syncthreads();
            bf16x8 aA[2], aQ[4];
#pragma unroll
            for (int ks = 0; ks < 2; ++ks) aA[ks] = *(const LAS bf16x8*)(L + HG_AB + (wr * 16 + fr) * 144 + ks * 64 + fq * 16);
#pragma unroll
            for (int kq = 0; kq < 4; ++kq) aQ[kq] = *(const LAS bf16x8*)(L + HG_QA + (wr * 16 + fr) * 272 + kq * 64 + fq * 16);
#pragma unroll
            for (int n = 0; n < 4; ++n) {
                const int vt = wc * 4 + n;
                f32x4 o = (f32x4){0.f, 0.f, 0.f, 0.f};
#pragma unroll
                for (int ks = 0; ks < 2; ++ks) { const bf16x8 bv = tr_frag(L + HG_VR, 272, ks, vt, lane); o = __builtin_amdgcn_mfma_f32_16x16x32_bf16(aA[ks], bv, o, 0, 0, 0); }
#pragma unroll
                for (int kq = 0; kq < 4; ++kq) { const bf16x8 bs = *(const LAS bf16x8*)(L + HG_SPT + (vt * 16 + fr) * 272 + kq * 64 + fq * 16); o = __builtin_amdgcn_mfma_f32_16x16x32_bf16(aQ[kq], bs, o, 0, 0, 0); }
#pragma unroll
                for (int j = 0; j < 4; ++j) *(LAS float*)(L + HG_O + (wr * 16 + fq * 4 + j) * 528 + (vt * 16 + fr) * 4) = o[j];
            }
            __syncthreads();
            {
                f32x4 ov[4]; float ssq = 0.f;
#pragma unroll
                for (int i = 0; i < 4; ++i) { ov[i] = *(const LAS f32x4*)(L + HG_O + tv * 528 + vc * 64 + i * 16); ssq += (ov[i].x * ov[i].x + ov[i].y * ov[i].y) + (ov[i].z * ov[i].z + ov[i].w * ov[i].w); }
                ssq += __shfl_xor(ssq, 1); ssq += __shfl_xor(ssq, 2); ssq += __shfl_xor(ssq, 4);
                const float rstd = rsqrtf(ssq * (1.0f / 128.0f) + EPS);
                const unsigned gw[8] = {gc0.x, gc0.y, gc0.z, gc0.w, gc1.x, gc1.y, gc1.z, gc1.w};
                unsigned ow[8];
#pragma unroll
                for (int i = 0; i < 8; ++i) { const float g0 = bflo(gw[i]), g1 = bfhi(gw[i]);
                    const float y0 = ov[i >> 1][(2 * i) & 3] * rstd * ngv[2 * i] * g0 * __builtin_amdgcn_rcpf(1.0f + __expf(-g0));
                    const float y1 = ov[i >> 1][(2 * i + 1) & 3] * rstd * ngv[2 * i + 1] * g1 * __builtin_amdgcn_rcpf(1.0f + __expf(-g1));
                    ow[i] = pk2(y0, y1); }
                u32x4* d = (u32x4*)(og + (size_t)(b * SEQ + sc * 256 + ch * 64 + tv) * (2 * D) + h * 128 + vc * 16);
                d[0] = (u32x4){ow[0], ow[1], ow[2], ow[3]}; d[1] = (u32x4){ow[4], ow[5], ow[6], ow[7]};
            }
        }
        if (ch == 3) {
            if (!OUT) {
                float* ds = dS + (size_t)(bh * 32 + sc) * 16384;
#pragma unroll
                for (int vt = 0; vt < 8; ++vt)
#pragma unroll
                    for (int j = 0; j < 4; ++j) ds[(size_t)(16 * wave + fq * 4 + j) * 128 + vt * 16 + fr] = S[vt][j];
                if (seg == 0) *(f32x2*)(Dd + (size_t)(bh * 32 + sc) * 128 + 2 * cp) = (f32x2){__expf(gsum0), __expf(gsum1)};
            }
            idx += X.G; ch = 0; if (idx >= ntask) break;
        } else ++ch;
    }
#undef HG_LOAD
    __syncthreads();
}

__device__ __forceinline__ void ph_hg2(const Ctx& X, const float* dS, const float* Dd, float* S0) {
    for (int idx = X.vcu * 512 + X.tid; idx < 32 * 4096; idx += X.G * 512) {
        const int bh = idx >> 12, e4 = idx & 4095, k = e4 >> 5, v4 = (e4 & 31) * 4;
        f32x4 s = (f32x4){0.f, 0.f, 0.f, 0.f};
#pragma unroll 4
        for (int sc = 0; sc < 31; ++sc) { const float d = Dd[(size_t)(bh * 32 + sc) * 128 + k]; const f32x4 ds = *(const f32x4*)(dS + (size_t)(bh * 32 + sc) * 16384 + k * 128 + v4);
            s = s * d + ds; *(f32x4*)(S0 + (size_t)(bh * 32 + sc + 1) * 16384 + k * 128 + v4) = s; }
    }
}

__device__ __forceinline__ void ph_router_tables(const Ctx& X, const float* g_ffn, const float* mod, const float* w_router, const float* b_router, float* Bp, float* cb) {
    for (int i = X.vcu * 512 + X.tid; i < 4 * 1024 * 32; i += X.G * 512) { const int b = i >> 15, k = (i >> 5) & 1023;
        Bp[i] = g_ffn[k] * (1.0f + mod[(size_t)b * NMOD + 4 * D + k]) * w_router[i & 32767]; }
    const int gw = X.vcu * 8 + X.wave;
    if (gw < 128) { const int b = gw >> 5, e = gw & 31; float a = 0.f;
        for (int k = X.lane; k < 1024; k += 64) a += mod[(size_t)b * NMOD + 3 * D + k] * w_router[k * 32 + e];
        a = wave_sum(a); if (X.lane == 0) cb[gw] = a + b_router[e]; }
}

__device__ __forceinline__ void ph_route(const Ctx& X, const bf16_t* x1, const float* g_ffn, const float* mod, const float* Bp, const float* cb,
                                         unsigned char* h2, int* top_e, float* top_w, int* rank, int* hist_g) {
    LAS int* hist = (LAS int*)(X.lds + LDSCTL_OFF + 64);
    const int tid = X.tid, lane = X.lane, c = lane & 15, q = lane >> 4;
    for (int tile = X.vcu; tile < RT_NT; tile += X.G) {
        if (tid < 32) hist[tid] = 0;
        __syncthreads();
        const int tw = tile * RT_TILE + X.wave * 16, b = tw / SEQ;
        const bf16_t* xa = x1 + (size_t)(tw + c) * D + 4 * q;
        const float* bp = Bp + ((size_t)b * 1024 + 4 * q) * 32 + c;
        f32x4 acc0 = (f32x4){0.f, 0.f, 0.f, 0.f}, acc1 = acc0; float ss = 0.f;
#pragma unroll 4
        for (int m = 0; m < 64; ++m) {
            const u32x2 a2_ = *(const u32x2*)(xa + 16 * m); const f32x4 a4 = (f32x4){bflo(a2_.x), bfhi(a2_.x), bflo(a2_.y), bfhi(a2_.y)};
            float bv[8];
#pragma unroll
            for (int j = 0; j < 4; ++j) { bv[2 * j] = bp[(size_t)(16 * m + j) * 32]; bv[2 * j + 1] = bp[(size_t)(16 * m + j) * 32 + 16]; }
            ss += (a4.x * a4.x + a4.y * a4.y) + (a4.z * a4.z + a4.w * a4.w);
#pragma unroll
            for (int j = 0; j < 4; ++j) { acc0 = __builtin_amdgcn_mfma_f32_16x16x4f32(a4[j], bv[2 * j], acc0, 0, 0, 0); acc1 = __builtin_amdgcn_mfma_f32_16x16x4f32(a4[j], bv[2 * j + 1], acc1, 0, 0, 0); }
        }
        ss += __shfl_xor(ss, 16); ss += __shfl_xor(ss, 32);
        const float rs = rsqrtf(ss * (1.0f / D) + EPS);
        const float cb0 = cb[b * 32 + c], cb1 = cb[b * 32 + 16 + c];
#pragma unroll
        for (int reg = 0; reg < 4; ++reg) {
            const float rt = __shfl(rs, 4 * q + reg);
            float v0 = acc0[reg] * rt + cb0, v1 = acc1[reg] * rt + cb1;
            float sv[4]; int si[4];
#pragma unroll
            for (int rnd = 0; rnd < 4; ++rnd) {
                float bvv = v0; int bi = c; if (v1 > bvv) { bvv = v1; bi = 16 + c; }
#pragma unroll
                for (int o = 1; o < 16; o <<= 1) { const float ov = __shfl_xor(bvv, o); const int oi = __shfl_xor(bi, o); if (ov > bvv || (ov == bvv && oi < bi)) { bvv = ov; bi = oi; } }
                sv[rnd] = bvv; si[rnd] = bi; if (bi == c) v0 = -INFINITY; if (bi == 16 + c) v1 = -INFINITY;
            }
            const float e1 = __expf(sv[1] - sv[0]), e2 = __expf(sv[2] - sv[0]), e3 = __expf(sv[3] - sv[0]);
            const float inv = 1.0f / (1.0f + e1 + e2 + e3);
            if (c == 0) { const int t = tw + 4 * q + reg;
                const float ww[4] = {inv, e1 * inv, e2 * inv, e3 * inv};
#pragma unroll
                for (int rnd = 0; rnd < 4; ++rnd) { top_e[t * 4 + rnd] = si[rnd]; top_w[t * 4 + rnd] = ww[rnd]; rank[t * 4 + rnd] = atomicAdd((int*)&hist[si[rnd]], 1); }
            }
        }
        const float* sh = mod + (size_t)b * NMOD + 3 * D; const float* sc = mod + (size_t)b * NMOD + 4 * D;
#pragma unroll 4
        for (int i = 0; i < 16; ++i) {
            const float r = __shfl(rs, i);
            const u32x2* xr = (const u32x2*)(x1 + (size_t)(tw + i) * D) + lane;
#pragma unroll
            for (int j = 0; j < 4; ++j) {
                const int col = 4 * (lane + 64 * j);
                const f32x4 gg = *(const f32x4*)(g_ffn + col), s1 = *(const f32x4*)(sc + col), s0 = *(const f32x4*)(sh + col);
                const u32x2 xw = xr[64 * j]; const f32x4 xv = (f32x4){bflo(xw.x), bfhi(xw.x), bflo(xw.y), bfhi(xw.y)};
                const f32x4 y = (xv * r * gg * (s1 + 1.0f) + s0) * 16.0f;
                *(unsigned*)(h2 + (size_t)(tw + i) * D + col) = cvt4_fp8(y.x, y.y, y.z, y.w);
            }
        }
        __syncthreads();
        if (tid < 32) hist_g[tile * 32 + tid] = hist[tid];
        __syncthreads();
    }
}

__device__ __forceinline__ void ph_sort(const Ctx& X, const int* hist_g, const int* top_e, const float* top_w, const int* rank, int* row_tok, float* row_w, int* pair_row, int* blk_e) {
    LAS int* s_hist = (LAS int*)X.lds;
    LAS int* s_tot = s_hist + RT_NT * 32; LAS int* s_pre = s_tot + 32; LAS int* s_base = s_pre + 32; LAS int* s_pstart = s_base + 32; LAS int* s_pend = s_pstart + 32;
    const int tid = X.tid;
    for (int i = tid; i < RT_NT * 32; i += 512) s_hist[i] = hist_g[i];
    __syncthreads();
    for (int tile = X.vcu; tile < RT_NT; tile += X.G) {
        if (tid < 32) { int tot = 0, pre = 0; for (int i = 0; i < RT_NT; ++i) { const int c = s_hist[i * 32 + tid]; tot += c; if (i < tile) pre += c; } s_tot[tid] = tot; s_pre[tid] = pre; }
        __syncthreads();
        if (tid == 0) { int acc = 0; for (int e = 0; e < 32; ++e) { const int padded = (s_tot[e] + 255) / 256 * 256; s_pstart[e] = acc; s_base[e] = acc + s_pre[e]; acc += padded; s_pend[e] = acc; } }
        __syncthreads();
        { const int i = tid; const int idx = tile * RT_TILE * 4 + i; const int e = top_e[idx]; const int row = s_base[e] + rank[idx];
          row_tok[row] = idx >> 2; row_w[row] = top_w[idx]; pair_row[idx] = row; }
        if (tile < 32) { const int e = tile; for (int r = s_pstart[e] + s_tot[e] + tid; r < s_pend[e]; r += 512) { row_tok[r] = 0; row_w[r] = 0.f; } }
        if (tile == 32) { for (int blk = tid; blk < NBLK_MAX; blk += 512) { int e = -1; const int r = blk * 256; for (int q = 0; q < 32; ++q) if (r >= s_pstart[q] && r < s_pend[q]) e = q; blk_e[blk] = e; }
                          if (tid == 0) blk_e[NBLK_MAX] = s_pend[31] / 256; }
        __syncthreads();
    }
}

__device__ __forceinline__ void ph_final(const Ctx& X, const bf16_t* x1, const unsigned char* y, const int* pair_row, const float* mod, const float* g_final, float* out, const float oscale) {
    const int lane = X.lane;
    for (int t = X.vcu * 8 + X.wave; t < T; t += X.G * 8) {
        const int b = t / SEQ;
        const u32x2* xr = (const u32x2*)(x1 + (size_t)t * D) + lane;
        const float* ga = mod + (size_t)b * NMOD + 5 * D;
        int rows[4];
#pragma unroll
        for (int k = 0; k < 4; ++k) rows[k] = pair_row[t * 4 + k];
        f32x4 v[4]; float ss = 0.f;
#pragma unroll
        for (int j = 0; j < 4; ++j) {
            const int col = 4 * (lane + 64 * j);
            f32x4 m = (f32x4){0.f, 0.f, 0.f, 0.f};
#pragma unroll
            for (int k = 0; k < 4; ++k) { const int w = *(const int*)(y + (size_t)rows[k] * D + col); const f32x2 lo = __builtin_amdgcn_cvt_pk_f32_fp8(w, false), hi = __builtin_amdgcn_cvt_pk_f32_fp8(w, true); m.x += lo.x; m.y += lo.y; m.z += hi.x; m.w += hi.y; }
            const u32x2 xw = xr[64 * j];
            v[j] = (f32x4){bflo(xw.x), bfhi(xw.x), bflo(xw.y), bfhi(xw.y)} + *(const f32x4*)(ga + col) * (m * (1.0f / 32.0f));
            ss += (v[j].x * v[j].x + v[j].y * v[j].y) + (v[j].z * v[j].z + v[j].w * v[j].w);
        }
        const float r = rsqrtf(wave_sum(ss) * (1.0f / D) + EPS);
#pragma unroll
        for (int j = 0; j < 4; ++j) { const int col = 4 * (lane + 64 * j); *(f32x4*)(out + (size_t)t * D + col) = v[j] * (r * oscale) * *(const f32x4*)(g_final + col); }
    }
}

constexpr int N_PHASES = 13;
struct Args { const float* in[23]; float* out; unsigned char* ws; int ph_lo, ph_hi; };
__global__ void __launch_bounds__(512, 2) fwd(Args a) {
    extern __shared__ __attribute__((aligned(16))) unsigned char lds_raw[];
    Ctx X; X.lds = (LAS unsigned char*)lds_raw; X.tid = threadIdx.x; X.lane = X.tid & 63; X.wave = __builtin_amdgcn_readfirstlane(X.tid >> 6);
    X.G = gridDim.x; { const int bx = blockIdx.x; X.vcu = (X.G % 8 == 0) ? (bx % 8) * (X.G / 8) + bx / 8 : bx; }
    unsigned char* ws = a.ws;
    for (int u = X.tid; u < (LDS_BYTES - LDSCTL_OFF) / 4; u += 512) ((LAS unsigned*)(X.lds + LDSCTL_OFF))[u] = 0u;
    __syncthreads();
    XcdBarrier bar = xcd_barrier_post((unsigned*)(ws + WS_CTL) + CW_BAR, (volatile LAS unsigned*)(X.lds + LDSCTL_OFF), X.tid == 0);
    const int lo = a.ph_lo, hi = a.ph_hi; float probe_scale = 1.0f;
#define IN(k) (lo <= (k) && (k) < hi)
#define SEAM(k) do { if (IN(k) && IN((k) + 1)) xcd_barrier(bar, X.wave == 0 && (int)__builtin_amdgcn_mbcnt_hi(~0u, __builtin_amdgcn_mbcnt_lo(~0u, 0u)) == 0); } while (0)
#ifdef PROBE_PH
    unsigned long long* stamps = (unsigned long long*)(ws + WS_CTL + 32768);
    if (blockIdx.x == 0 && X.tid == 0) stamps[0] = __builtin_amdgcn_s_memrealtime();
#undef SEAM
#define SEAM(k) do { if (IN(k) && IN((k) + 1)) { xcd_barrier(bar, X.wave == 0 && (int)__builtin_amdgcn_mbcnt_hi(~0u, __builtin_amdgcn_mbcnt_lo(~0u, 0u)) == 0); \
        if (blockIdx.x == 0 && X.wave == 0 && (int)__builtin_amdgcn_mbcnt_hi(~0u, __builtin_amdgcn_mbcnt_lo(~0u, 0u)) == 0) stamps[(k) + 1] = __builtin_amdgcn_s_memrealtime(); } } while (0)
#endif
    const float* x = a.in[0]; const float* c = a.in[1]; const float* w_ada = a.in[2]; const float* b_ada = a.in[3];
    const float* g_mix = a.in[4]; const float* w_in = a.in[5]; const float* conv_dw = a.in[6]; const float* conv_dwb = a.in[7];
    const float* conv_ln_g = a.in[8]; const float* conv_ln_b = a.in[9]; const float* w_conv_out = a.in[10]; const float* lb_param = a.in[11];
    const float* hgrn_norm_g = a.in[12]; const float* w_hgrn_out = a.in[13]; const float* w_out = a.in[14]; const float* g_ffn = a.in[15];
    const float* w_router = a.in[16]; const float* b_router = a.in[17]; const float* w1 = a.in[18]; const float* b1 = a.in[19];
    const float* w2 = a.in[20]; const float* b2 = a.in[21]; const float* g_final = a.in[22];
    float* mod = (float*)(ws + WS_MOD); float* rt_bp = (float*)(ws + WS_BP); float* rt_cb = (float*)(ws + WS_CB);
    int* hist_g = (int*)(ws + WS_HIST); int* blk_e = (int*)(ws + WS_BLKE); int* top_e = (int*)(ws + WS_TOPE); float* top_w = (float*)(ws + WS_TOPW);
    int* rank = (int*)(ws + WS_RANK); int* pair_row = (int*)(ws + WS_PROW); int* row_tok = (int*)(ws + WS_RTOK); float* row_w = (float*)(ws + WS_RW);
    bf16_t* p = (bf16_t*)(ws + WS_P);
    bf16_t* h = (bf16_t*)(ws + WS_E); unsigned char* h8 = ws + WS_E + 64 * MiB; float* tmp = (float*)(ws + WS_E);
    float* hg_dS = (float*)(ws + WS_E); float* hg_S0 = (float*)(ws + WS_E + 64 * MiB); float* hg_D = (float*)(ws + WS_HGD);
    bf16_t* uc = (bf16_t*)(ws + WS_D); bf16_t* og = uc + D;   bf16_t* x1 = (bf16_t*)(ws + WS_D);
    bf16_t* merged = p;
    unsigned char* h2 = (unsigned char*)p;
    unsigned char* act = (unsigned char*)(p + PG);
    unsigned char* y = (unsigned char*)(p + PG) + (size_t)R_PAD * D;
    PG8_LAS unsigned char* ring = (PG8_LAS unsigned char*)lds_raw;

#ifndef REPMASK
#define REPMASK 0
#endif
#ifndef REPN
#define REPN 1
#endif
#define PH(k, ...) do { if (IN(k)) { _Pragma("unroll 1") for (int rep_ = 0; rep_ < ((((REPMASK) >> (k)) & 1) ? 1 + REPN : 1); ++rep_) { if (rep_) __syncthreads(); { int ln_ = (int)__builtin_amdgcn_mbcnt_hi(~0u, __builtin_amdgcn_mbcnt_lo(~0u, 0u)); asm volatile("" : "+v"(ln_)); X.lane = ln_; X.tid = X.wave * 64 + ln_; } __VA_ARGS__ } } SEAM(k); } while (0)
    PH(0, ph_prologue<0>(X, c, w_ada, b_ada, mod, w_in, w_conv_out, w_hgrn_out, w_out, w1, w2, ws););
    PH(1, ph_norm_mod(X, x, g_mix, mod, 0, D, h, h8); ph_router_tables(X, g_ffn, mod, w_router, b_router, rt_bp, rt_cb););
#ifndef STAGGER_TICKS
#define STAGGER_TICKS 0
#endif
    PH(2, { if (STAGGER_TICKS) { const unsigned long long t0_ = __builtin_amdgcn_s_memrealtime(), wait_ = (unsigned long long)(X.vcu & 3) * STAGGER_TICKS;
                while (__builtin_amdgcn_s_memrealtime() - t0_ < wait_) __builtin_amdgcn_s_sleep(8); }
        constexpr unsigned m8 = P_FP8_MASK; constexpr int n8 = __builtin_popcount(m8);
        if (n8 > 0) { pg8::Gemm g{(const bf16_t*)h8, (const bf16_t*)(ws + WS_WIN8), T, 8 * D, D / 2}; pg8::MaskOrder S; S.base.init(T, n8 * 256, X.G, (int)blockIdx.x); S.mask = m8;
            pg8::EpiSplitBf16 E{p, PG, 0x3cu, SEQ, 1.0f / 4096.0f}; pg8::gemm_phase<pg8::EpiSplitBf16, pg8::MaskOrder, true, true, false, true>(ring, g, S, E, X.wave); }
        if (n8 < 32) { pg8::Gemm g{h, (const bf16_t*)(ws + WS_WIN), T, 8 * D, D}; pg8::MaskOrder S; S.base.init(T, (32 - n8) * 256, X.G, (int)blockIdx.x); S.mask = ~m8;
            pg8::EpiSplitBf16 E{p, PG, 0x3cu, SEQ, 1.0f}; pg8::gemm_phase<pg8::EpiSplitBf16, pg8::MaskOrder, true, true>(ring, g, S, E, X.wave); } });
    PH(3, ph_conv(X, p + 0 * PG, conv_dw, conv_dwb, conv_ln_g, conv_ln_b, uc);
          if ((REPMASK >> 14) & 1) { __syncthreads(); ph_conv(X, p + 0 * PG, conv_dw, conv_dwb, conv_ln_g, conv_ln_b, uc); }
          ph_hgrn<false>(X, 31 * 32, p + 2 * PG, p + 3 * PG, p + 4 * PG, p + 5 * PG, lb_param, nullptr, nullptr, hg_dS, hg_D, nullptr);
          if ((REPMASK >> 15) & 1) { __syncthreads(); ph_hgrn<false>(X, 31 * 32, p + 2 * PG, p + 3 * PG, p + 4 * PG, p + 5 * PG, lb_param, nullptr, nullptr, hg_dS, hg_D, nullptr); });
    PH(4, ph_hg2(X, hg_dS, hg_D, hg_S0););
    PH(5, if ((X.vcu & 1) == 0) ph_prologue<1>(X, c, w_ada, b_ada, mod, w_in, w_conv_out, w_hgrn_out, w_out, w1, w2, ws);
          ph_hgrn<true>(X, 32 * 32, p + 2 * PG, p + 3 * PG, p + 4 * PG, p + 5 * PG, lb_param, hgrn_norm_g, hg_S0, nullptr, nullptr, og);
          if ((X.vcu & 1) != 0) ph_prologue<1>(X, c, w_ada, b_ada, mod, w_in, w_conv_out, w_hgrn_out, w_out, w1, w2, ws););
    PH(6, { pg8::Gemm g{uc, (const bf16_t*)(ws + WS_WC), T, D, 2 * D}; pg8::StaticOrder S; S.init(T, D, X.G, (int)blockIdx.x);
        pg8::EpiGateFused E{p + 6 * PG, p + 7 * PG, merged}; pg8::gemm_phase<pg8::EpiGateFused, pg8::StaticOrder, true, true>(ring, g, S, E, X.wave); });
    PH(7, { pg8::Gemm g{merged, (const bf16_t*)(ws + WS_WO), T, D, D}; pg8::StaticOrder S; S.init(T, D, X.G, (int)blockIdx.x);
        pg8::EpiRes E{x, mod + 2 * D, x1, NMOD, SEQ}; pg8::gemm_phase<pg8::EpiRes, pg8::StaticOrder, true, true>(ring, g, S, E, X.wave); });
    PH(8, ph_route(X, x1, g_ffn, mod, rt_bp, rt_cb, h2, top_e, top_w, rank, hist_g););
    PH(9, ph_sort(X, hist_g, top_e, top_w, rank, row_tok, row_w, pair_row, blk_e););
    PH(10, { const int nblk = blk_e[NBLK_MAX]; pg8::Gemm g{(const bf16_t*)h2, (const bf16_t*)(ws + WS_W1), T, 32 * 2048, D / 2}; pg8::MoeOrder S{blk_e, nblk, X.G, (int)blockIdx.x, 3};
        LAS unsigned short* gt = (LAS unsigned short*)(X.lds + LDSCTL_OFF + 256);
        _Pragma("unroll 1") for (int i = 0; i < 23; ++i) { pg8::Unit u; if (!S.next(i, u)) break; if (X.tid < 256) gt[256 * i + X.tid] = (unsigned short)row_tok[u.pm * 256 + X.tid]; }
        __syncthreads();
        pg8::EpiSwiglu8 E{b1, act, 1.0f / 4096.0f}; pg8::gemm_phase<pg8::EpiSwiglu8, pg8::MoeOrder, true, true, true, true>(ring, g, S, E, X.wave, (const PG8_LAS unsigned short*)gt); });
    PH(11, { const int nblk = blk_e[NBLK_MAX]; pg8::Gemm g{(const bf16_t*)act, (const bf16_t*)(ws + WS_W2), R_PAD, 32 * 1024, DFF / 2}; pg8::MoeOrder S{blk_e, nblk, X.G, (int)blockIdx.x, 2};
        pg8::EpiY8 E{b2, row_w, y, 1.0f / 1024.0f}; pg8::gemm_phase<pg8::EpiY8, pg8::MoeOrder, true, true, false, true>(ring, g, S, E, X.wave); });
#ifdef PROBE_PH
    { const unsigned long long* st_ = (const unsigned long long*)(ws + WS_CTL + 32768); const float dt_ = (float)(long long)(st_[PROBE_PH + 1] - st_[PROBE_PH]);
      probe_scale = 1.0f + dt_ * (1.0f / 200000.0f); }
#endif
    PH(12, ph_final(X, x1, y, pair_row, mod, g_final, a.out, probe_scale););
#undef PH
#undef IN
#undef SEAM
}

#ifndef MK_N_LAUNCHES
#define MK_N_LAUNCHES 1
#endif
extern "C" void kernel_launch(void* const* d_in, const int* in_sizes, int n_in, void* d_out, int out_size, void* d_ws, size_t ws_size, hipStream_t stream) {
    static int grid = 0;
    if (grid == 0) {
        if (n_in != 23 || out_size != T * D || ws_size < WS_END) { fprintf(stderr, "kernel_launch: unexpected n_in %d / out_size %d / ws_size %zu (< %zu); nothing launched\n", n_in, out_size, ws_size, (size_t)WS_END); grid = -1; return; }
        int dev = 0, cus = 0, per_cu = 0;
        if (hipGetDevice(&dev) != hipSuccess || hipDeviceGetAttribute(&cus, hipDeviceAttributeMultiprocessorCount, dev) != hipSuccess) { grid = -1; return; }
        if (hipFuncSetAttribute((const void*)fwd, hipFuncAttributeMaxDynamicSharedMemorySize, LDS_BYTES) != hipSuccess) { fprintf(stderr, "kernel_launch: hipFuncSetAttribute failed\n"); grid = -1; return; }
        if (hipOccupancyMaxActiveBlocksPerMultiprocessor(&per_cu, (const void*)fwd, 512, LDS_BYTES) != hipSuccess || per_cu < 1) { fprintf(stderr, "kernel_launch: occupancy query says %d blocks per CU\n", per_cu); }
        (void)hipGetLastError();
        grid = cus;
    }
    if (grid < 0) return;
    if (hipMemsetAsync((char*)d_ws + WS_CTL, 0, CTL_ZERO_BYTES, stream) != hipSuccess) return;
    Args a{};
    for (int i = 0; i < 23; ++i) a.in[i] = (const float*)d_in[i];
    a.out = (float*)d_out; a.ws = (unsigned char*)d_ws;
    if (MK_N_LAUNCHES == 1) { a.ph_lo = 0; a.ph_hi = N_PHASES; hipLaunchKernelGGL(fwd, dim3(grid), dim3(512), LDS_BYTES, stream, a); }
    else for (int ph = 0; ph < N_PHASES; ++ph) { a.ph_lo = ph; a.ph_hi = ph + 1; hipLaunchKernelGGL(fwd, dim3(grid), dim3(512), LDS_BYTES, stream, a); }
}
```

```cpp
#include <hip/hip_runtime.h>
#include <stdint.h>
#include <stdio.h>

#define GAS __attribute__((address_space(1)))
#define LAS __attribute__((address_space(3)))
typedef unsigned short bf16_t;
typedef unsigned u32x4 __attribute__((ext_vector_type(4)));
typedef unsigned u32x2 __attribute__((ext_vector_type(2)));
typedef float f32x4 __attribute__((ext_vector_type(4)));

constexpr int D = 1024, NBATCH = 4, SEQ = 8192, T = NBATCH * SEQ;
constexpr int NE = 32, DFF = 1024;
constexpr int NMOD = 6 * D;
constexpr int NBLK_MAX = 544, R_PAD = NBLK_MAX * 256;
constexpr int RT_TILE = 128, RT_NT = T / RT_TILE;
constexpr float EPS = 1e-6f;

constexpr size_t MiB = 1u << 20;
constexpr size_t WS_CTL = 0, CTL_ZERO_BYTES = 64 * 1024;
constexpr size_t WS_MOD = 1 * MiB;
constexpr size_t WS_CB = WS_MOD + 112 * 1024, WS_BP = WS_MOD + 128 * 1024;
constexpr size_t WS_HIST = 2 * MiB;
constexpr size_t WS_BLKE = WS_HIST + 64 * 1024;
constexpr size_t WS_TOPE = 3 * MiB;
constexpr size_t WS_TOPW = WS_TOPE + 512 * 1024;
constexpr size_t WS_RANK = WS_TOPW + 512 * 1024;
constexpr size_t WS_PROW = WS_RANK + 512 * 1024;
constexpr size_t WS_RTOK = 5 * MiB;
constexpr size_t WS_RW = 6 * MiB;
constexpr size_t WS_HGD = 7 * MiB;
constexpr size_t WS_WT = 8 * MiB;
constexpr size_t WS_WIN = WS_WT, WS_WC = WS_WT + 16 * MiB, WS_WH = WS_WT + 18 * MiB, WS_WO = WS_WT + 20 * MiB, WS_W1 = WS_WT + 22 * MiB, WS_WIN8 = WS_WT + 96 * MiB  , WS_W2 = WS_WT + 150 * MiB;
constexpr size_t WS_P = 224 * MiB;
constexpr size_t WS_E = WS_P + 512 * MiB;
constexpr size_t WS_D = WS_E + 128 * MiB;
constexpr size_t WS_END = WS_D + 128 * MiB;
constexpr size_t PG = (size_t)T * D;
constexpr int CW_BAR = 0;

constexpr int RING_BYTES = 135168, LDSCTL_OFF = RING_BYTES, LDS_BYTES = 147456;

__device__ __forceinline__ unsigned f2bf(float f) { unsigned u = __builtin_bit_cast(unsigned, f); return (u + 0x7fffu + ((u >> 16) & 1u)) >> 16; }
__device__ __forceinline__ unsigned pk2(float lo, float hi) { return f2bf(lo) | (f2bf(hi) << 16); }
__device__ __forceinline__ float bf2f(unsigned b) { return __builtin_bit_cast(float, b << 16); }
__device__ __forceinline__ float bflo(unsigned w) { return __builtin_bit_cast(float, w << 16); }
__device__ __forceinline__ float bfhi(unsigned w) { return __builtin_bit_cast(float, w & 0xffff0000u); }
__device__ __forceinline__ float sigmoidf_(float x) { return __builtin_amdgcn_rcpf(1.0f + __expf(-x)); }
__device__ __forceinline__ float wave_sum(float v) {
#pragma unroll
    for (int o = 1; o < 64; o <<= 1) v += __shfl_xor(v, o);
    return v;
}
__device__ __forceinline__ unsigned cvt4_fp8(float a, float b, float c, float d) {
    a = fminf(fmaxf(a, -448.f), 448.f); b = fminf(fmaxf(b, -448.f), 448.f); c = fminf(fmaxf(c, -448.f), 448.f); d = fminf(fmaxf(d, -448.f), 448.f);
    int w = 0; w = __builtin_amdgcn_cvt_pk_fp8_f32(a, b, w, false); w = __builtin_amdgcn_cvt_pk_fp8_f32(c, d, w, true); return (unsigned)w; }
#define LDS_WAIT() asm volatile("s_waitcnt lgkmcnt(0)" ::: "memory")
#define VM_WAIT() asm volatile("s_waitcnt vmcnt(0)" ::: "memory")

namespace pg8 {
#define PG8_LAS __attribute__((address_space(3)))
typedef unsigned short bf16_t;
typedef short bf16x8 __attribute__((ext_vector_type(8)));
typedef float f32x4 __attribute__((ext_vector_type(4)));
typedef unsigned u32x4 __attribute__((ext_vector_type(4)));
constexpr int BM = 256, BK = 64, HALF = 128, HTB = HALF * BK * 2  , STAGE_BYTES = 8 * HTB, NXCD = 8, WGM = 8;

__host__ __device__ __forceinline__ int lds_byte(int r, int c) { const int st = (r >> 4) * 2 + (c >> 5), rr = r & 15, cc = c & 31, ob = rr * 64 + cc * 2; return st * 1024 + (ob ^ (((ob >> 9) & 1) << 5)); }
__host__ __device__ __forceinline__ void stage_rc(int b, int& R, int& C) { const int st = b / 1024, sb = b % 1024, swz = sb ^ (((sb >> 9) & 1) << 5); R = (st >> 1) * 16 + swz / 64; C = (st & 1) * 32 + (swz % 64) / 2; }
__host__ __device__ __forceinline__ int perm32(int rho) { const int n = rho >> 4, i = rho & 15; return 8 * (i >> 2) + 4 * n + (i & 3); }

struct Unit { int pm, pn; };
struct Gemm { const bf16_t* A; const bf16_t* Bt; int M, N, K; };

struct StaticOrder {
    int nM, nN, nwg, G, c;
    __host__ __device__ void init(int M, int N, int G_, int c_) { nM = M / BM; nN = N / BM; nwg = nM * nN; G = G_; c = c_; }
    __host__ __device__ bool next(int i, Unit& u) const {
        const long L = (long)i * G + c; if (L >= nwg) return false;
        int wgid = (int)L; { const int q = nwg / NXCD, r = nwg % NXCD, xcd = wgid % NXCD, off = wgid / NXCD; wgid = (xcd < r ? xcd * (q + 1) : r * (q + 1) + (xcd - r) * q) + off; }
        const int nig = WGM * nN, gid = wgid / nig, fm = gid * WGM, gsz = (nM - fm) < WGM ? (nM - fm) : WGM;
        u.pm = fm + ((wgid % nig) % gsz); u.pn = (wgid % nig) / gsz; return true;
    }
    __device__ __forceinline__ void a_ready(const Unit&) const {}
    __device__ __forceinline__ void done(const Unit&) const {}
};


struct MaskOrder {
    StaticOrder base; unsigned mask;
    __device__ __forceinline__ bool next(int i, Unit& u) const {
        if (!base.next(i, u)) return false;
        unsigned m = mask; for (int k = 0; k < u.pn; ++k) m &= m - 1;
        u.pn = __builtin_ctz(m); return true;
    }
    __device__ __forceinline__ void a_ready(const Unit&) const {}
    __device__ __forceinline__ void done(const Unit&) const {}
};
struct MoeOrder {
    const int* blk_e; int nblk, G, c, lg;
    __device__ __forceinline__ bool next(int i, Unit& u) const {
        int blk, j;
        if (G == 256) { const int xcd = c & 7, idx = c >> 3, prb = 256 >> lg; blk = i * prb + xcd * (prb >> 3) + (idx >> lg); j = idx & ((1 << lg) - 1); }
        else { const long L = (long)i * G + c; blk = (int)(L >> lg); j = (int)(L & ((1 << lg) - 1)); }
        if (blk >= nblk) return false;
        const int e = blk_e[blk]; u.pm = blk; u.pn = (e << lg) + j; return true;
    }
    __device__ __forceinline__ void a_ready(const Unit&) const {}
    __device__ __forceinline__ void done(const Unit&) const {}
};

__device__ __forceinline__ unsigned cvt_pk_bf16(float lo, float hi) { unsigned r; asm volatile("v_cvt_pk_bf16_f32 %0, %1, %2" : "=v"(r) : "v"(lo), "v"(hi)); return r; }
__device__ __forceinline__ float sigm(float x) { return __builtin_amdgcn_rcpf(1.0f + __expf(-x)); }
__device__ __forceinline__ float blo(unsigned w) { return __builtin_bit_cast(float, w << 16); }
__device__ __forceinline__ float bhi(unsigned w) { return __builtin_bit_cast(float, w & 0xffff0000u); }

struct EpiSplitBf16 {
    static constexpr bool PERM = true, AFTER_DRAIN = false;
    bf16_t* O; size_t split_stride; unsigned hm_mask; int seq; float dq;
    __device__ __forceinline__ void operator()(const f32x4 (&acc)[2][2][4][2], const Unit& u, int wr, int wc, int fr, int fq) const {
        const int row0 = u.pm * BM + wr * 64 + fr; const int colt = u.pn * BM; const int t = colt >> 10;
        if (u.pn < 8) {
#pragma unroll
            for (int ai = 0; ai < 2; ++ai)
#pragma unroll
                for (int m = 0; m < 4; ++m) { const int row = row0 + ai * HALF + m * 16; float r[8];
#pragma unroll
                    for (int q = 0; q < 4; ++q) { r[q] = acc[ai][0][m][0][q] * dq * sigm(acc[ai][1][m][0][q] * dq); r[4 + q] = acc[ai][0][m][1][q] * dq * sigm(acc[ai][1][m][1][q] * dq); }
                    u32x4 w; w.x = cvt_pk_bf16(r[0], r[1]); w.y = cvt_pk_bf16(r[2], r[3]); w.z = cvt_pk_bf16(r[4], r[5]); w.w = cvt_pk_bf16(r[6], r[7]);
                    __builtin_nontemporal_store(w, (u32x4*)(O + (size_t)row * 1024 + 128 * u.pn + wc * 32 + 8 * fq)); }
            return;
        }
        bf16_t* base = O + (size_t)t * split_stride; const int cg = colt & 1023;
        const bool hm = (hm_mask >> t) & 1u;
        const int bb = (u.pm * BM) / seq;
#pragma unroll
        for (int ai = 0; ai < 2; ++ai)
#pragma unroll
            for (int m = 0; m < 4; ++m) { const int row = row0 + ai * HALF + m * 16;
#pragma unroll
                for (int bj = 0; bj < 2; ++bj) { const f32x4 v0 = acc[ai][bj][m][0] * dq, v1 = acc[ai][bj][m][1] * dq;
                    u32x4 w; w.x = cvt_pk_bf16(v0[0], v0[1]); w.y = cvt_pk_bf16(v0[2], v0[3]); w.z = cvt_pk_bf16(v1[0], v1[1]); w.w = cvt_pk_bf16(v1[2], v1[3]);
                    const size_t o = hm ? ((size_t)(bb * 8 + (cg >> 7) + bj) * seq + (row - bb * seq)) * 128 + wc * 32 + 8 * fq
                                        : (size_t)row * 1024 + cg + bj * HALF + wc * 32 + 8 * fq;
                    __builtin_nontemporal_store(w, (u32x4*)(base + o)); } }
    }
};
struct EpiGate1 {
    static constexpr bool PERM = true, AFTER_DRAIN = false;
    const bf16_t* gate; float* tmp;
    __device__ __forceinline__ void operator()(const f32x4 (&acc)[2][2][4][2], const Unit& u, int wr, int wc, int fr, int fq) const {
        const int row0 = u.pm * BM + wr * 64 + fr, col0 = u.pn * BM + wc * 32 + 8 * fq;
#pragma unroll
        for (int ai = 0; ai < 2; ++ai)
#pragma unroll
            for (int m = 0; m < 4; ++m) { const size_t o = (size_t)(row0 + ai * HALF + m * 16) * 1024 + col0;
#pragma unroll
                for (int bj = 0; bj < 2; ++bj) { const u32x4 g = *(const u32x4*)(gate + o + bj * HALF); f32x4 v0 = acc[ai][bj][m][0], v1 = acc[ai][bj][m][1];
                    v0[0] *= sigm(blo(g.x)); v0[1] *= sigm(bhi(g.x)); v0[2] *= sigm(blo(g.y)); v0[3] *= sigm(bhi(g.y));
                    v1[0] *= sigm(blo(g.z)); v1[1] *= sigm(bhi(g.z)); v1[2] *= sigm(blo(g.w)); v1[3] *= sigm(bhi(g.w));
                    *(f32x4*)(tmp + o + bj * HALF) = v0; *(f32x4*)(tmp + o + bj * HALF + 4) = v1; } }
    }
};
struct EpiGate2 {
    static constexpr bool PERM = true, AFTER_DRAIN = false;
    const bf16_t* gate; const float* tmp; bf16_t* out;
    __device__ __forceinline__ void operator()(const f32x4 (&acc)[2][2][4][2], const Unit& u, int wr, int wc, int fr, int fq) const {
        const int row0 = u.pm * BM + wr * 64 + fr, col0 = u.pn * BM + wc * 32 + 8 * fq;
#pragma unroll
        for (int ai = 0; ai < 2; ++ai)
#pragma unroll
            for (int m = 0; m < 4; ++m) { const size_t o = (size_t)(row0 + ai * HALF + m * 16) * 1024 + col0;
#pragma unroll
                for (int bj = 0; bj < 2; ++bj) { const u32x4 g = *(const u32x4*)(gate + o + bj * HALF); f32x4 v0 = acc[ai][bj][m][0], v1 = acc[ai][bj][m][1];
                    const f32x4 t0 = *(const f32x4*)(tmp + o + bj * HALF), t1 = *(const f32x4*)(tmp + o + bj * HALF + 4);
                    v0[0] = t0[0] + v0[0] * sigm(blo(g.x)); v0[1] = t0[1] + v0[1] * sigm(bhi(g.x)); v0[2] = t0[2] + v0[2] * sigm(blo(g.y)); v0[3] = t0[3] + v0[3] * sigm(bhi(g.y));
                    v1[0] = t1[0] + v1[0] * sigm(blo(g.z)); v1[1] = t1[1] + v1[1] * sigm(bhi(g.z)); v1[2] = t1[2] + v1[2] * sigm(blo(g.w)); v1[3] = t1[3] + v1[3] * sigm(bhi(g.w));
                    u32x4 w; w.x = cvt_pk_bf16(v0[0], v0[1]); w.y = cvt_pk_bf16(v0[2], v0[3]); w.z = cvt_pk_bf16(v1[0], v1[1]); w.w = cvt_pk_bf16(v1[2], v1[3]);
                    *(u32x4*)(out + o + bj * HALF) = w; } }
    }
};
struct EpiRes {
    static constexpr bool PERM = true, AFTER_DRAIN = false;
    const float* x; const float* ga; bf16_t* out; int mod_pitch, seq;
    __device__ __forceinline__ void operator()(const f32x4 (&acc)[2][2][4][2], const Unit& u, int wr, int wc, int fr, int fq) const {
        const int row0 = u.pm * BM + wr * 64 + fr, col0 = u.pn * BM + wc * 32 + 8 * fq;
        const float* gab = ga + (size_t)((u.pm * BM) / seq) * mod_pitch + col0;
        f32x4 gv[2][2];
#pragma unroll
        for (int bj = 0; bj < 2; ++bj)
#pragma unroll
            for (int n = 0; n < 2; ++n) gv[bj][n] = *(const f32x4*)(gab + bj * HALF + 4 * n);
#pragma unroll
        for (int ai = 0; ai < 2; ++ai) {
            f32x4 xv[4][2][2];
#pragma unroll
            for (int m = 0; m < 4; ++m)
#pragma unroll
                for (int bj = 0; bj < 2; ++bj) { const float* xp = x + (size_t)(row0 + ai * HALF + m * 16) * 1024 + col0 + bj * HALF; xv[m][bj][0] = *(const f32x4*)xp; xv[m][bj][1] = *(const f32x4*)(xp + 4); }
#pragma unroll
            for (int m = 0; m < 4; ++m) { const size_t o = (size_t)(row0 + ai * HALF + m * 16) * 1024 + col0;
#pragma unroll
                for (int bj = 0; bj < 2; ++bj) {
                    const f32x4 v0 = xv[m][bj][0] + gv[bj][0] * acc[ai][bj][m][0], v1 = xv[m][bj][1] + gv[bj][1] * acc[ai][bj][m][1];
                    u32x4 w; w.x = cvt_pk_bf16(v0[0], v0[1]); w.y = cvt_pk_bf16(v0[2], v0[3]); w.z = cvt_pk_bf16(v1[0], v1[1]); w.w = cvt_pk_bf16(v1[2], v1[3]);
                    *(u32x4*)(out + o + bj * HALF) = w; } }
        }
    }
};
struct EpiSwiglu {
    static constexpr bool PERM = true, AFTER_DRAIN = false;
    const float* b1; bf16_t* act;
    __device__ __forceinline__ void operator()(const f32x4 (&acc)[2][2][4][2], const Unit& u, int wr, int wc, int fr, int fq) const {
        const int e = u.pn >> 3, j = u.pn & 7; const int row0 = u.pm * BM + wr * 64 + fr, f0 = 128 * j + wc * 32 + 8 * fq;
        const float* be = b1 + (size_t)e * 2048 + f0;
        const f32x4 bg0 = *(const f32x4*)(be), bg1 = *(const f32x4*)(be + 4), bl0 = *(const f32x4*)(be + 1024), bl1 = *(const f32x4*)(be + 1028);
#pragma unroll
        for (int ai = 0; ai < 2; ++ai)
#pragma unroll
            for (int m = 0; m < 4; ++m) {
                f32x4 g0 = acc[ai][0][m][0] + bg0, g1 = acc[ai][0][m][1] + bg1, l0 = acc[ai][1][m][0] + bl0, l1 = acc[ai][1][m][1] + bl1;
                float r[8];
#pragma unroll
                for (int q = 0; q < 4; ++q) { float gl = fminf(g0[q], 7.0f), li = fminf(fmaxf(l0[q], -7.0f), 7.0f); r[q] = gl * sigm(1.702f * gl) * (li + 1.0f);
                                              gl = fminf(g1[q], 7.0f); li = fminf(fmaxf(l1[q], -7.0f), 7.0f); r[4 + q] = gl * sigm(1.702f * gl) * (li + 1.0f); }
                u32x4 w; w.x = cvt_pk_bf16(r[0], r[1]); w.y = cvt_pk_bf16(r[2], r[3]); w.z = cvt_pk_bf16(r[4], r[5]); w.w = cvt_pk_bf16(r[6], r[7]);
                *(u32x4*)(act + (size_t)(row0 + ai * HALF + m * 16) * 1024 + f0) = w; }
    }
};
struct EpiY {
    static constexpr bool PERM = true, AFTER_DRAIN = false;
    const float* b2; const float* rw; bf16_t* y;
    __device__ __forceinline__ void operator()(const f32x4 (&acc)[2][2][4][2], const Unit& u, int wr, int wc, int fr, int fq) const {
        const int e = u.pn >> 2, j = u.pn & 3; const int row0 = u.pm * BM + wr * 64 + fr, col0 = 256 * j + wc * 32 + 8 * fq;
        const float* be = b2 + (size_t)e * 1024 + col0;
        f32x4 bv[2][2];
#pragma unroll
        for (int bj = 0; bj < 2; ++bj)
#pragma unroll
            for (int n = 0; n < 2; ++n) bv[bj][n] = *(const f32x4*)(be + bj * HALF + 4 * n);
#pragma unroll
        for (int ai = 0; ai < 2; ++ai)
#pragma unroll
            for (int m = 0; m < 4; ++m) { const int row = row0 + ai * HALF + m * 16; const float w_ = rw[row];
#pragma unroll
                for (int bj = 0; bj < 2; ++bj) { const f32x4 v0 = (acc[ai][bj][m][0] + bv[bj][0]) * w_, v1 = (acc[ai][bj][m][1] + bv[bj][1]) * w_;
                    u32x4 w; w.x = cvt_pk_bf16(v0[0], v0[1]); w.y = cvt_pk_bf16(v0[2], v0[3]); w.z = cvt_pk_bf16(v1[0], v1[1]); w.w = cvt_pk_bf16(v1[2], v1[3]);
                    *(u32x4*)(y + (size_t)row * 1024 + col0 + bj * HALF) = w; } }
    }
};


struct EpiSwiglu8 {
    static constexpr bool PERM = true, AFTER_DRAIN = false;
    const float* b1; unsigned char* act; float dq;
    __device__ __forceinline__ void operator()(const f32x4 (&acc)[2][2][4][2], const Unit& u, int wr, int wc, int fr, int fq) const {
        const int e = u.pn >> 3, j = u.pn & 7; const int row0 = u.pm * BM + wr * 64 + fr, f0 = 128 * j + wc * 32 + 8 * fq;
        const float* be = b1 + (size_t)e * 2048 + f0;
        const f32x4 bg0 = *(const f32x4*)(be), bg1 = *(const f32x4*)(be + 4), bl0 = *(const f32x4*)(be + 1024), bl1 = *(const f32x4*)(be + 1028);
#pragma unroll
        for (int ai = 0; ai < 2; ++ai)
#pragma unroll
            for (int m = 0; m < 4; ++m) {
                f32x4 g0 = acc[ai][0][m][0] * dq + bg0, g1 = acc[ai][0][m][1] * dq + bg1, l0 = acc[ai][1][m][0] * dq + bl0, l1 = acc[ai][1][m][1] * dq + bl1;
                float r[8];
#pragma unroll
                for (int q = 0; q < 4; ++q) { float gl = fminf(g0[q], 7.0f), li = fminf(fmaxf(l0[q], -7.0f), 7.0f); r[q] = 4.0f * gl * sigm(1.702f * gl) * (li + 1.0f);
                                              gl = fminf(g1[q], 7.0f); li = fminf(fmaxf(l1[q], -7.0f), 7.0f); r[4 + q] = 4.0f * gl * sigm(1.702f * gl) * (li + 1.0f); }
                u32x2 w; w.x = cvt4_fp8(r[0], r[1], r[2], r[3]); w.y = cvt4_fp8(r[4], r[5], r[6], r[7]);
                *(u32x2*)(act + (size_t)(row0 + ai * HALF + m * 16) * 1024 + f0) = w; }
    }
};
struct EpiY8 {
    static constexpr bool PERM = true, AFTER_DRAIN = false;
    const float* b2; const float* rw; unsigned char* y; float dq;
    __device__ __forceinline__ void operator()(const f32x4 (&acc)[2][2][4][2], const Unit& u, int wr, int wc, int fr, int fq) const {
        const int e = u.pn >> 2, j = u.pn & 3; const int row0 = u.pm * BM + wr * 64 + fr, col0 = 256 * j + wc * 32 + 8 * fq;
        const float* be = b2 + (size_t)e * 1024 + col0;
        f32x4 bv[2][2];
#pragma unroll
        for (int bj = 0; bj < 2; ++bj)
#pragma unroll
            for (int n = 0; n < 2; ++n) bv[bj][n] = *(const f32x4*)(be + bj * HALF + 4 * n);
        float rwv[2][4];
#pragma unroll
        for (int ai = 0; ai < 2; ++ai)
#pragma unroll
            for (int m = 0; m < 4; ++m) rwv[ai][m] = rw[row0 + ai * HALF + m * 16] * 32.0f;
#pragma unroll
        for (int ai = 0; ai < 2; ++ai)
#pragma unroll
            for (int m = 0; m < 4; ++m) { const int row = row0 + ai * HALF + m * 16; const float w_ = rwv[ai][m];
#pragma unroll
                for (int bj = 0; bj < 2; ++bj) { const f32x4 v0 = (acc[ai][bj][m][0] * dq + bv[bj][0]) * w_, v1 = (acc[ai][bj][m][1] * dq + bv[bj][1]) * w_;
                    u32x2 w; w.x = cvt4_fp8(v0[0], v0[1], v0[2], v0[3]); w.y = cvt4_fp8(v1[0], v1[1], v1[2], v1[3]);
                    *(u32x2*)(y + (size_t)row * 1024 + col0 + bj * HALF) = w; } }
    }
};

struct EpiGateFused {
    static constexpr bool PERM = true, AFTER_DRAIN = false, HAS_MID = true;
    const bf16_t* gc; const bf16_t* gh; bf16_t* out;
    __device__ __forceinline__ void mid(f32x4 (&acc)[2][2][4][2], const Unit& u, int wr, int wc, int fr, int fq) const {
        const int row0 = u.pm * BM + wr * 64 + fr, col0 = u.pn * BM + wc * 32 + 8 * fq;
#pragma unroll
        for (int ai = 0; ai < 2; ++ai)
#pragma unroll
            for (int m = 0; m < 4; ++m) { const size_t o = (size_t)(row0 + ai * HALF + m * 16) * 1024 + col0;
#pragma unroll
                for (int bj = 0; bj < 2; ++bj) { const u32x4 a = *(const u32x4*)(gc + o + bj * HALF), b = *(const u32x4*)(gh + o + bj * HALF);
                    const unsigned aw[4] = {a.x, a.y, a.z, a.w}, bw[4] = {b.x, b.y, b.z, b.w};
#pragma unroll
                    for (int q = 0; q < 4; ++q) { const float r0 = (1.0f + __expf(-blo(bw[q]))) * __builtin_amdgcn_rcpf(1.0f + __expf(-blo(aw[q]))), r1 = (1.0f + __expf(-bhi(bw[q]))) * __builtin_amdgcn_rcpf(1.0f + __expf(-bhi(aw[q])));
                        acc[ai][bj][m][q >> 1][(2 * q) & 3] *= r0; acc[ai][bj][m][q >> 1][(2 * q + 1) & 3] *= r1; } } }
    }
    __device__ __forceinline__ void operator()(const f32x4 (&acc)[2][2][4][2], const Unit& u, int wr, int wc, int fr, int fq) const {
        const int row0 = u.pm * BM + wr * 64 + fr, col0 = u.pn * BM + wc * 32 + 8 * fq;
#pragma unroll
        for (int ai = 0; ai < 2; ++ai) {
            u32x4 gw[4][2];
#pragma unroll
            for (int m = 0; m < 4; ++m)
#pragma unroll
                for (int bj = 0; bj < 2; ++bj) gw[m][bj] = *(const u32x4*)(gh + (size_t)(row0 + ai * HALF + m * 16) * 1024 + col0 + bj * HALF);
#pragma unroll
            for (int m = 0; m < 4; ++m) { const size_t o = (size_t)(row0 + ai * HALF + m * 16) * 1024 + col0;
#pragma unroll
                for (int bj = 0; bj < 2; ++bj) { const u32x4 g = gw[m][bj]; f32x4 v0 = acc[ai][bj][m][0], v1 = acc[ai][bj][m][1];
                    v0[0] *= sigm(blo(g.x)); v0[1] *= sigm(bhi(g.x)); v0[2] *= sigm(blo(g.y)); v0[3] *= sigm(bhi(g.y));
                    v1[0] *= sigm(blo(g.z)); v1[1] *= sigm(bhi(g.z)); v1[2] *= sigm(blo(g.w)); v1[3] *= sigm(bhi(g.w));
                    u32x4 w; w.x = cvt_pk_bf16(v0[0], v0[1]); w.y = cvt_pk_bf16(v0[2], v0[3]); w.z = cvt_pk_bf16(v1[0], v1[1]); w.w = cvt_pk_bf16(v1[2], v1[3]);
                    *(u32x4*)(out + o + bj * HALF) = w; } }
        }
    }
};

template <class T, class = void> struct has_mid { static constexpr bool value = false; };
template <class T> struct has_mid<T, decltype((void)T::HAS_MID)> { static constexpr bool value = true; };
template <class Epi, class Sched, bool ALIGN_EPI = false, bool SP2 = false, bool GATHER = false, bool FP8 = false>
__device__ __forceinline__ void gemm_phase(PG8_LAS unsigned char* lds, const Gemm g, const Sched& S, const Epi& E, const int wave_id, const PG8_LAS unsigned short* gtab = nullptr) {
    typedef int i32x4 __attribute__((ext_vector_type(4))); typedef int i32x8 __attribute__((ext_vector_type(8)));
    static_assert(!GATHER || SP2, "GATHER needs the SP2 loop");
    int lane = (int)__builtin_amdgcn_mbcnt_hi(~0u, __builtin_amdgcn_mbcnt_lo(~0u, 0u)); asm volatile("" : "+v"(lane));
    const int wid = wave_id, tid = wid * 64 + lane, wr = wid >> 2, wc = wid & 3, fr = lane & 15, fq = lane >> 4;
    const int K = g.K, nt = K / BK;
    unsigned voffA[2], voffB[2];
#pragma unroll
    for (int i = 0; i < 2; ++i) { int R, C; stage_rc(tid * 16 + i * 8192, R, C); const int Rb = Epi::PERM ? ((R & ~31) + perm32(R & 31)) : R;
        voffA[i] = (unsigned)(R * K + C) * 2u; voffB[i] = (unsigned)(Rb * K + C) * 2u; }
    unsigned vA0[2] = {0u, 0u}, vA1[2] = {0u, 0u}, xA0[2] = {0u, 0u}, xA1[2] = {0u, 0u};
#define PG8_GLOAD(d0, d1, ui_) do { int tz_ = wid * 64 + (int)__builtin_amdgcn_mbcnt_hi(~0u, __builtin_amdgcn_mbcnt_lo(~0u, 0u)); asm volatile("" : "+v"(tz_)); _Pragma("unroll") for (int _i = 0; _i < 2; ++_i) { int R_, C_; stage_rc(tz_ * 16 + _i * 8192, R_, C_); \
        d0[_i] = (unsigned)gtab[256 * (ui_) + R_] * (unsigned)(K * 2) + (unsigned)C_ * 2u; d1[_i] = (unsigned)gtab[256 * (ui_) + 128 + R_] * (unsigned)(K * 2) + (unsigned)C_ * 2u; } } while (0)
    const unsigned kstep = (unsigned)(BK * 2);
    const unsigned hstep = (unsigned)HALF * K * 2;
    const unsigned tstep = 2 * hstep;
    const __amdgpu_buffer_rsrc_t rsA = __builtin_amdgcn_make_buffer_rsrc((void*)g.A, 0, 0x7fffffff, 0x00020000), rsB = __builtin_amdgcn_make_buffer_rsrc((void*)g.Bt, 0, 0x7fffffff, 0x00020000);
    const unsigned ldsw = (unsigned)wid * 1024u;
    const int aoff = lds_byte(wr * 64 + fr, fq * 8), boff = lds_byte(wc * 32 + fr, fq * 8);
#define PG8_SA(b, h) (((b) * 2 + (h)) * HTB)
#define PG8_SB(b, h) ((4 + (b) * 2 + (h)) * HTB)
#define PG8_STAGE(bufoff, rs, soff, voff) do { _Pragma("unroll") for (int _i = 0; _i < 2; ++_i) \
        __builtin_amdgcn_raw_ptr_buffer_load_lds(rs, (PG8_LAS void*)(lds + (bufoff) + ldsw + _i * 8192), 16, (int)(voff)[_i], (int)(soff), 0, 0); } while (0)
#define PG8_LDA(dst, b, h) do { if constexpr (FP8) { _Pragma("unroll") for (int m = 0; m < 4; ++m) dst##_8[m] = __builtin_shufflevector(*(const PG8_LAS i32x4*)(lds + PG8_SA(b, h) + aoff + m * 2048), *(const PG8_LAS i32x4*)(lds + PG8_SA(b, h) + aoff + m * 2048 + 1024), 0, 1, 2, 3, 4, 5, 6, 7); } \
        else { _Pragma("unroll") for (int m = 0; m < 4; ++m) _Pragma("unroll") for (int k = 0; k < 2; ++k) dst[m][k] = *(const PG8_LAS bf16x8*)(lds + PG8_SA(b, h) + aoff + m * 2048 + k * 1024); } } while (0)
#define PG8_LDB(dst, b, h) do { if constexpr (FP8) { _Pragma("unroll") for (int n = 0; n < 2; ++n) dst##_8[n] = __builtin_shufflevector(*(const PG8_LAS i32x4*)(lds + PG8_SB(b, h) + boff + n * 2048), *(const PG8_LAS i32x4*)(lds + PG8_SB(b, h) + boff + n * 2048 + 1024), 0, 1, 2, 3, 4, 5, 6, 7); } \
        else { _Pragma("unroll") for (int n = 0; n < 2; ++n) _Pragma("unroll") for (int k = 0; k < 2; ++k) dst[n][k] = *(const PG8_LAS bf16x8*)(lds + PG8_SB(b, h) + boff + n * 2048 + k * 1024); } } while (0)
#define PG8_MMA(ai, bj, At, Bt) do { __builtin_amdgcn_s_setprio(1); if constexpr (FP8) { _Pragma("unroll") for (int m = 0; m < 4; ++m) _Pragma("unroll") for (int n = 0; n < 2; ++n) \
        asm volatile("v_mfma_scale_f32_16x16x128_f8f6f4 %0, %1, %2, %0, %3, %3 op_sel_hi:[0,0,0]" : "+v"(acc[ai][bj][m][n]) : "v"(Bt##_8[n]), "v"(At##_8[m]), "v"(sc8));     \
        } else { _Pragma("unroll") for (int m = 0; m < 4; ++m) _Pragma("unroll") for (int n = 0; n < 2; ++n) _Pragma("unroll") for (int k = 0; k < 2; ++k) \
        acc[ai][bj][m][n] = __builtin_amdgcn_mfma_f32_16x16x32_bf16(Bt[n][k], At[m][k], acc[ai][bj][m][n], 0, 0, 0); } __builtin_amdgcn_s_setprio(0); } while (0)
#define PG8_WAIT_V(n) asm volatile("s_waitcnt vmcnt(" #n ")" ::: "memory")
#define PG8_WAIT_L(n) asm volatile("s_waitcnt lgkmcnt(" #n ")" ::: "memory")
#define PG8_BAR __builtin_amdgcn_s_barrier()
#define PG8_SCHED __builtin_amdgcn_sched_barrier(0)
    Unit cur, nxt; int ui = 0;
    if (!S.next(0, cur)) return;
    f32x4 acc[2][2][4][2];
#pragma unroll
    for (int a = 0; a < 2; ++a)
#pragma unroll
        for (int b = 0; b < 2; ++b)
#pragma unroll
            for (int m = 0; m < 4; ++m)
#pragma unroll
                for (int n = 0; n < 2; ++n) acc[a][b][m][n] = (f32x4){0.f, 0.f, 0.f, 0.f};
    int sc8 = 0x7f7f7f7f; asm volatile("" : "+v"(sc8));
    bf16x8 At[4][2], B0[2][2], B1[2][2]; i32x8 At_8[4], B0_8[2], B1_8[2];
    unsigned cA = GATHER ? 0u : (unsigned)cur.pm * tstep, cB = (unsigned)cur.pn * tstep;
    S.a_ready(cur);
    if constexpr (GATHER) { PG8_GLOAD(vA0, vA1, 0); xA0[0] = vA0[0]; xA0[1] = vA0[1]; xA1[0] = vA1[0]; xA1[1] = vA1[1]; }
    if constexpr (SP2) {
        PG8_STAGE(PG8_SB(0, 0), rsB, cB, voffB); PG8_STAGE(PG8_SB(0, 1), rsB, cB + hstep, voffB);
        if constexpr (GATHER) { PG8_STAGE(PG8_SA(0, 0), rsA, cA, vA0); PG8_STAGE(PG8_SA(0, 1), rsA, cA, vA1); } else { PG8_STAGE(PG8_SA(0, 0), rsA, cA, voffA); PG8_STAGE(PG8_SA(0, 1), rsA, cA + hstep, voffA); }
        if (wr == 1) PG8_BAR;
        PG8_WAIT_V(2); PG8_BAR;
        PG8_STAGE(PG8_SB(1, 0), rsB, cB + kstep, voffB); if constexpr (GATHER) { PG8_STAGE(PG8_SA(1, 0), rsA, cA + kstep, vA0); } else { PG8_STAGE(PG8_SA(1, 0), rsA, cA + kstep, voffA); } PG8_STAGE(PG8_SB(1, 1), rsB, cB + hstep + kstep, voffB);
        PG8_WAIT_V(6); PG8_BAR;
    } else {
        PG8_STAGE(PG8_SB(0, 0), rsB, cB, voffB); PG8_STAGE(PG8_SA(0, 0), rsA, cA, voffA); PG8_STAGE(PG8_SB(0, 1), rsB, cB + hstep, voffB); PG8_STAGE(PG8_SA(0, 1), rsA, cA + hstep, voffA);
        if (wr == 1) PG8_BAR;
        PG8_WAIT_V(4); PG8_BAR;
        PG8_STAGE(PG8_SB(1, 0), rsB, cB + kstep, voffB); PG8_STAGE(PG8_SA(1, 0), rsA, cA + kstep, voffA); PG8_STAGE(PG8_SB(1, 1), rsB, cB + hstep + kstep, voffB);
        PG8_WAIT_V(6); PG8_BAR;
    }
    for (;;) {
        const bool has_next = S.next(ui + 1, nxt);
        const unsigned nA = GATHER ? cA : (has_next ? (unsigned)nxt.pm * tstep : cA), nB = has_next ? (unsigned)nxt.pn * tstep : cB;
        for (int t = 0; t < nt; t += 2) {
            const bool last = (t == nt - 2);
            const unsigned a1 = cA + (unsigned)(t + 1) * kstep;
            const unsigned a2 = last ? nA : cA + (unsigned)(t + 2) * kstep, b2 = last ? nB : cB + (unsigned)(t + 2) * kstep;
            const unsigned a3 = a2 + kstep, b3 = b2 + kstep;
            if (last && has_next) S.a_ready(nxt);
            if constexpr (has_mid<Epi>::value) { if (t == nt / 2) { int l3_ = (int)__builtin_amdgcn_mbcnt_hi(~0u, __builtin_amdgcn_mbcnt_lo(~0u, 0u)); asm volatile("" : "+v"(l3_)); E.mid(acc, cur, wr, wc, l3_ & 15, l3_ >> 4); } }
            if constexpr (GATHER) { if (last && has_next) { PG8_GLOAD(xA0, xA1, ui + 1); } }
            if constexpr (SP2) {
            PG8_LDB(B0, 0, 0); PG8_LDB(B1, 0, 1); PG8_SCHED; PG8_LDA(At, 0, 0); if constexpr (GATHER) { PG8_STAGE(PG8_SA(1, 1), rsA, a1, vA1); } else { PG8_STAGE(PG8_SA(1, 1), rsA, a1 + hstep, voffA); }
            PG8_WAIT_V(8); PG8_WAIT_L(0); PG8_BAR; PG8_MMA(0, 0, At, B0); PG8_MMA(0, 1, At, B1); PG8_BAR; PG8_SCHED;
            PG8_LDA(At, 0, 1); PG8_STAGE(PG8_SB(0, 0), rsB, b2, voffB); PG8_STAGE(PG8_SB(0, 1), rsB, b2 + hstep, voffB); if constexpr (GATHER) { PG8_STAGE(PG8_SA(0, 0), rsA, a2, xA0); } else { PG8_STAGE(PG8_SA(0, 0), rsA, a2, voffA); }
            PG8_WAIT_V(8); PG8_WAIT_L(0); PG8_BAR; PG8_MMA(1, 0, At, B0); PG8_MMA(1, 1, At, B1); PG8_BAR; PG8_SCHED;
            PG8_LDB(B0, 1, 0); PG8_LDB(B1, 1, 1); PG8_SCHED; PG8_LDA(At, 1, 0); if constexpr (GATHER) { PG8_STAGE(PG8_SA(0, 1), rsA, a2, xA1); } else { PG8_STAGE(PG8_SA(0, 1), rsA, a2 + hstep, voffA); }
            PG8_WAIT_V(8); PG8_WAIT_L(0); PG8_BAR; PG8_MMA(0, 0, At, B0); PG8_MMA(0, 1, At, B1); PG8_BAR; PG8_SCHED;
            PG8_LDA(At, 1, 1); PG8_STAGE(PG8_SB(1, 0), rsB, b3, voffB); PG8_STAGE(PG8_SB(1, 1), rsB, b3 + hstep, voffB); if constexpr (GATHER) { PG8_STAGE(PG8_SA(1, 0), rsA, a3, xA0); } else { PG8_STAGE(PG8_SA(1, 0), rsA, a3, voffA); }
            PG8_WAIT_V(8); PG8_WAIT_L(0); PG8_BAR; PG8_MMA(1, 0, At, B0); PG8_MMA(1, 1, At, B1); PG8_BAR; PG8_SCHED;
            } else {
            PG8_LDB(B0, 0, 0); PG8_SCHED; PG8_LDA(At, 0, 0); PG8_STAGE(PG8_SA(1, 1), rsA, a1 + hstep, voffA);
            PG8_WAIT_L(8); PG8_BAR; PG8_WAIT_L(0); PG8_MMA(0, 0, At, B0); PG8_BAR; PG8_SCHED;
            PG8_LDB(B1, 0, 1); PG8_STAGE(PG8_SB(0, 0), rsB, b2, voffB);
            PG8_BAR; PG8_WAIT_L(0); PG8_MMA(0, 1, At, B1); PG8_BAR;
            PG8_LDA(At, 0, 1); PG8_STAGE(PG8_SA(0, 0), rsA, a2, voffA);
            PG8_BAR; PG8_WAIT_L(0); PG8_MMA(1, 0, At, B0); PG8_BAR; PG8_SCHED;
            PG8_STAGE(PG8_SB(0, 1), rsB, b2 + hstep, voffB);
            PG8_WAIT_V(6); PG8_BAR; PG8_MMA(1, 1, At, B1); PG8_BAR;
            PG8_LDB(B0, 1, 0); PG8_SCHED; PG8_LDA(At, 1, 0); PG8_STAGE(PG8_SA(0, 1), rsA, a2 + hstep, voffA);
            PG8_WAIT_L(8); PG8_BAR; PG8_WAIT_L(0); PG8_MMA(0, 0, At, B0); PG8_BAR; PG8_SCHED;
            PG8_LDB(B1, 1, 1); PG8_STAGE(PG8_SB(1, 0), rsB, b3, voffB);
            PG8_BAR; PG8_WAIT_L(0); PG8_MMA(0, 1, At, B1); PG8_BAR;
            PG8_LDA(At, 1, 1); PG8_STAGE(PG8_SA(1, 0), rsA, a3, voffA);
            PG8_BAR; PG8_WAIT_L(0); PG8_MMA(1, 0, At, B0); PG8_BAR; PG8_SCHED;
            PG8_STAGE(PG8_SB(1, 1), rsB, b3 + hstep, voffB);
            PG8_WAIT_V(6); PG8_BAR; PG8_MMA(1, 1, At, B1); PG8_BAR;
            }
        }
        if constexpr (ALIGN_EPI) { if (wr == 0) PG8_BAR; }
        if constexpr (!Epi::AFTER_DRAIN) { int l2_ = (int)__builtin_amdgcn_mbcnt_hi(~0u, __builtin_amdgcn_mbcnt_lo(~0u, 0u)); asm volatile("" : "+v"(l2_));
            E(acc, cur, wr, wc, l2_ & 15, l2_ >> 4); S.done(cur); }
        if (!has_next) break;
#pragma unroll
        for (int a = 0; a < 2; ++a)
#pragma unroll
            for (int b = 0; b < 2; ++b)
#pragma unroll
                for (int m = 0; m < 4; ++m)
#pragma unroll
                    for (int n = 0; n < 2; ++n) acc[a][b][m][n] = (f32x4){0.f, 0.f, 0.f, 0.f};
        cur = nxt; cA = nA; cB = nB; ++ui;
        if constexpr (GATHER) { vA0[0] = xA0[0]; vA0[1] = xA0[1]; vA1[0] = xA1[0]; vA1[1] = xA1[1]; }
        if constexpr (ALIGN_EPI) { if (wr == 1) PG8_BAR; }
    }
    PG8_WAIT_V(0);
    if constexpr (!ALIGN_EPI) { if (wr == 0) PG8_BAR; }
    PG8_BAR;
    if constexpr (Epi::AFTER_DRAIN) { E.fused(acc, cur, wr, wc, fr, fq, lds, wid, lane); S.done(cur); }
#undef PG8_GLOAD
#undef PG8_SA
#undef PG8_SB
#undef PG8_STAGE
#undef PG8_LDA
#undef PG8_LDB
#undef PG8_MMA
#undef PG8_WAIT_V
#undef PG8_WAIT_L
#undef PG8_BAR
#undef PG8_SCHED
}
}
#define XB_TMO      128
#define XB_XCNT(j)  (256  + 64 * (j))
#define XB_XSUB(j)  (1280 + 64 * (j))
#define XB_XGEN(j)  (2304 + 64 * (j))
#define XB_TOP      3328
#define XB_TOPGEN   3392
#define XCD_BAR_WORDS 3456
#define XB_SPIN_CAP (1u << 18)

__device__ __forceinline__ unsigned xb_ld(unsigned* p)              { return __hip_atomic_load(p, __ATOMIC_RELAXED, __HIP_MEMORY_SCOPE_AGENT); }
__device__ __forceinline__ unsigned xb_add(unsigned* p, unsigned v) { return __hip_atomic_fetch_add(p, v, __ATOMIC_RELAXED, __HIP_MEMORY_SCOPE_AGENT); }
__device__ __forceinline__ unsigned xb_xcc_id() { return (unsigned)__builtin_amdgcn_s_getreg((3 << 11) | 20) & 0xFu; }
#define XB_SPIN(cond, bar) do { unsigned _sp = 0; while (cond) { __builtin_amdgcn_s_sleep(1); \
    if ((++_sp & 255u) == 0u) { if (xb_ld(&(bar)[XB_TMO])) break; if (_sp > XB_SPIN_CAP) { atomicAdd(&(bar)[XB_TMO], 1u); break; } } } } while (0)

struct XcdBarrier {
    unsigned* bar; unsigned x;
    volatile LAS unsigned* st;
};

__device__ __forceinline__ XcdBarrier xcd_barrier_post(unsigned* bar, volatile LAS unsigned* st, const bool leader  ) {
    XcdBarrier b; b.bar = bar; b.x = xb_xcc_id(); b.st = st;
    if (leader) (void)xb_add(&bar[XB_XCNT(b.x)], 1u);
    return b;
}
__device__ __forceinline__ void xcd_barrier_complete(unsigned* bar, unsigned x, unsigned& nloc, unsigned& nx) {
    const unsigned G = gridDim.x * gridDim.y * gridDim.z;
    unsigned sum, cnt, mine, sp = 0u;
    for (;;) {
        sum = 0u; cnt = 0u; mine = 0u;
#pragma unroll
        for (unsigned j = 0; j < 16; ++j) { const unsigned c = xb_ld(&bar[XB_XCNT(j)]); sum += c; cnt += (c > 0u) ? 1u : 0u; mine = (j == x) ? c : mine; }
        if (sum == G) break;
        __builtin_amdgcn_s_sleep(1);
        if ((++sp & 255u) == 0u) { if (xb_ld(&bar[XB_TMO])) break; if (sp > XB_SPIN_CAP) { atomicAdd(&bar[XB_TMO], 1u); break; } }
    }
    nloc = mine > 0u ? mine : 1u; nx = cnt > 0u ? cnt : 1u;
}

__device__ __forceinline__ void xcd_barrier(const XcdBarrier& b, const bool leader  ) {
    asm volatile("s_waitcnt vmcnt(0)" ::: "memory");
    __syncthreads();
    if (leader) {
        unsigned* bar = b.bar;
        __builtin_amdgcn_s_waitcnt(0);
        unsigned nloc = b.st[0], nx = b.st[1];
        if (nloc == 0u) { xcd_barrier_complete(bar, b.x, nloc, nx); b.st[0] = nloc; b.st[1] = nx; }
        const unsigned old = xb_add(&bar[XB_XSUB(b.x)], 1u);
        const unsigned gen = old / nloc;
        if (old + 1u == (gen + 1u) * nloc) {
            __builtin_amdgcn_fence(__ATOMIC_RELEASE, "agent");
            asm volatile("s_waitcnt vmcnt(0)" ::: "memory");
            const unsigned og = xb_add(&bar[XB_TOP], 1u);
            const unsigned tg = og / nx;
            if (og + 1u == (tg + 1u) * nx) xb_add(&bar[XB_TOPGEN], 1u);
            else XB_SPIN(xb_ld(&bar[XB_TOPGEN]) == tg, bar);
            __builtin_amdgcn_fence(__ATOMIC_ACQUIRE, "agent");
            xb_add(&bar[XB_XGEN(b.x)], 1u);
            asm volatile("s_waitcnt vmcnt(0)" ::: "memory");
        } else {
            XB_SPIN(xb_ld(&bar[XB_XGEN(b.x)]) == gen, bar);
            __builtin_amdgcn_fence(__ATOMIC_ACQUIRE, "agent");
            asm volatile("s_waitcnt vmcnt(0)" ::: "memory");
        }
    }
    __syncthreads();
}

#ifndef P_FP8_MASK
#define P_FP8_MASK 0xFFFFFFFFu
#endif =======================================================
struct Ctx { LAS unsigned char* lds; int tid, lane, wave, vcu, G; };

__device__ __forceinline__ void transpose_load64(const float* W, int ldw, int k0, int n0, LAS float* scr, int lane) {
#pragma unroll 8
    for (int i = 0; i < 16; ++i) { const int kk = 4 * i + (lane >> 4), nn = 4 * (lane & 15); const f32x4 v = *(const f32x4*)(W + (size_t)(k0 + kk) * ldw + n0 + nn);
        LAS float* d = scr + kk * 65 + nn; d[0] = v.x; d[1] = v.y; d[2] = v.z; d[3] = v.w; }
    LDS_WAIT();
}
__device__ __forceinline__ void transpose_item(const float* W, int ldw, int K, bf16_t* dst, int k0, int n0, LAS float* scr, int lane) {
    transpose_load64(W, ldw, k0, n0, scr, lane);
    const int c = lane & 7;
#pragma unroll
    for (int j = 0; j < 8; ++j) { const int n = (lane >> 3) + 8 * j; const LAS float* s = scr + (8 * c) * 65 + n;
        u32x4 o; o.x = pk2(s[0 * 65], s[1 * 65]); o.y = pk2(s[2 * 65], s[3 * 65]); o.z = pk2(s[4 * 65], s[5 * 65]); o.w = pk2(s[6 * 65], s[7 * 65]);
        *(u32x4*)(dst + (size_t)n * K + k0 + 8 * c) = o; }
    LDS_WAIT();
}
__device__ __forceinline__ void transpose_item8(const float* W, int ldw, int K, unsigned char* dst, int k0, int n0, float scale, LAS float* scr, int lane) {
    transpose_load64(W, ldw, k0, n0, scr, lane);
    const int c = lane & 3;
#pragma unroll
    for (int j = 0; j < 4; ++j) { const int n = (lane >> 2) + 16 * j; const LAS float* s = scr + (16 * c) * 65 + n;
        u32x4 o; o.x = cvt4_fp8(s[0 * 65] * scale, s[1 * 65] * scale, s[2 * 65] * scale, s[3 * 65] * scale); o.y = cvt4_fp8(s[4 * 65] * scale, s[5 * 65] * scale, s[6 * 65] * scale, s[7 * 65] * scale);
        o.z = cvt4_fp8(s[8 * 65] * scale, s[9 * 65] * scale, s[10 * 65] * scale, s[11 * 65] * scale); o.w = cvt4_fp8(s[12 * 65] * scale, s[13 * 65] * scale, s[14 * 65] * scale, s[15 * 65] * scale);
        *(u32x4*)(dst + (size_t)n * K + k0 + 16 * c) = o; }
    LDS_WAIT();
}

template <int PART>
__device__ __forceinline__ void ph_prologue(const Ctx& X, const float* c, const float* w_ada, const float* b_ada, float* mod,
                                            const float* w_in, const float* w_conv_out, const float* w_hgrn_out, const float* w_out, const float* w1, const float* w2, unsigned char* ws) {
    if (PART == 0 && X.vcu < 48) {
        LAS float* ca = (LAS float*)X.lds;
        LAS float* red = (LAS float*)(X.lds + 16384);
        for (int i = X.tid; i < 4096; i += 512) { const float v = c[i]; ca[i] = v * sigmoidf_(v); }
        __syncthreads();
        const int jj = X.tid & 127, kq = X.tid >> 7, j = X.vcu * 128 + jj;
        float a0 = 0.f, a1 = 0.f, a2 = 0.f, a3 = 0.f;
#pragma unroll 8
        for (int i = kq * 256; i < kq * 256 + 256; ++i) { const float w = w_ada[(size_t)i * NMOD + j]; a0 += ca[i] * w; a1 += ca[1024 + i] * w; a2 += ca[2048 + i] * w; a3 += ca[3072 + i] * w; }
        red[(kq * 4 + 0) * 128 + jj] = a0; red[(kq * 4 + 1) * 128 + jj] = a1; red[(kq * 4 + 2) * 128 + jj] = a2; red[(kq * 4 + 3) * 128 + jj] = a3;
        __syncthreads();
        { const int b = X.tid >> 7; mod[(size_t)b * NMOD + j] = b_ada[j] + red[(0 * 4 + b) * 128 + jj] + red[(1 * 4 + b) * 128 + jj] + red[(2 * 4 + b) * 128 + jj] + red[(3 * 4 + b) * 128 + jj]; }
        __syncthreads();
    }
    LAS float* scr = (LAS float*)(X.lds + X.wave * 16640);
    const int gw = X.vcu * 8 + X.wave, NGW = X.G * 8;
    constexpr int I_IN = 16 * 128, I_SQ = 16 * 16, I_W1 = 32 * 16 * 32, I_W2 = 32 * 16 * 16, NITEMS = I_IN + 3 * I_SQ + I_W1 + I_W2;
    constexpr int I_DENSE = I_IN + 3 * I_SQ;
    for (int it = (PART == 0 ? 0 : I_DENSE) + gw; it < (PART == 0 ? I_DENSE : NITEMS); it += NGW) {
        int r = it;
        if (r < I_IN) { const int kb = r >> 7, nb = r & 127, n0 = 64 * nb;
            const int rho0 = (n0 < 2048) ? 256 * ((n0 & 1023) >> 7) + 128 * (n0 >> 10) + (n0 & 127) : n0;
            if ((P_FP8_MASK >> (rho0 >> 8)) & 1u) transpose_item8(w_in, 8192, 1024, (unsigned char*)(ws + WS_WIN8) + (size_t)rho0 * 1024, 64 * kb, n0, 256.0f, scr, X.lane);
            else transpose_item(w_in, 8192, 1024, (bf16_t*)(ws + WS_WIN) + (size_t)rho0 * 1024, 64 * kb, n0, scr, X.lane);
            continue; } r -= I_IN;
        if (r < 3 * I_SQ) { const int which = r / I_SQ, q = r % I_SQ, kb = q >> 4, nb = q & 15;
            const float* W = which == 0 ? w_conv_out : (which == 1 ? w_hgrn_out : w_out);
            if (which == 2) transpose_item(W, 1024, 1024, (bf16_t*)(ws + WS_WO) + (size_t)(64 * nb) * 1024, 64 * kb, 64 * nb, scr, X.lane);
            else transpose_item(W, 1024, 2048, (bf16_t*)(ws + WS_WC) + (size_t)(64 * nb) * 2048 + which * 1024, 64 * kb, 64 * nb, scr, X.lane);
            continue; } r -= 3 * I_SQ;
        if (r < I_W1) { const int e = r >> 9, q = r & 511, kb = q >> 5, nb = q & 31, n0 = 64 * nb;
            const int rho0 = (n0 < 1024) ? 256 * (n0 >> 7) + (n0 & 127) : 256 * ((n0 - 1024) >> 7) + 128 + ((n0 - 1024) & 127);
            transpose_item8(w1 + (size_t)e * 1024 * 2048, 2048, 1024, (unsigned char*)(ws + WS_W1) + ((size_t)e * 2048 + rho0) * 1024, 64 * kb, n0, 256.0f, scr, X.lane); continue; } r -= I_W1;
        { const int e = r >> 8, q = r & 255, kb = q >> 4, nb = q & 15;
            transpose_item8(w2 + (size_t)e * 1024 * 1024, 1024, 1024, (unsigned char*)(ws + WS_W2) + ((size_t)e * 1024 + 64 * nb) * 1024, 64 * kb, 64 * nb, 256.0f, scr, X.lane); }
    }
    __syncthreads();
}

__device__ __forceinline__ void ph_norm_mod(const Ctx& X, const float* x, const float* g, const float* mod, int sh_off, int sc_off, bf16_t* out, unsigned char* out8) {
    for (int t = X.vcu * 8 + X.wave; t < T; t += X.G * 8) {
        const int b = t / SEQ, lane = X.lane;
        const f32x4* xr = (const f32x4*)(x + (size_t)t * D) + lane;
        f32x4 v[4]; float ss = 0.f;
#pragma unroll
        for (int j = 0; j < 4; ++j) { v[j] = xr[64 * j]; ss += (v[j].x * v[j].x + v[j].y * v[j].y) + (v[j].z * v[j].z + v[j].w * v[j].w); }
        const float r = rsqrtf(wave_sum(ss) * (1.0f / D) + EPS);
        const float* sh = mod + (size_t)b * NMOD + sh_off; const float* sc = mod + (size_t)b * NMOD + sc_off;
#pragma unroll
        for (int j = 0; j < 4; ++j) {
            const int col = 4 * (lane + 64 * j);
            const f32x4 gg = *(const f32x4*)(g + col), s1 = *(const f32x4*)(sc + col), s0 = *(const f32x4*)(sh + col);
            const f32x4 y = v[j] * r * gg * (s1 + 1.0f) + s0;
            if (P_FP8_MASK != 0xFFFFFFFFu) { u32x2 w; w.x = pk2(y.x, y.y); w.y = pk2(y.z, y.w); *(u32x2*)(out + (size_t)t * D + col) = w; }
            if (P_FP8_MASK != 0u) *(unsigned*)(out8 + (size_t)t * D + col) = cvt4_fp8(y.x * 16.0f, y.y * 16.0f, y.z * 16.0f, y.w * 16.0f);
        }
    }
}

typedef float f32x2 __attribute__((ext_vector_type(2)));
__device__ __forceinline__ void ph_conv(const Ctx& X, const bf16_t* pU, const float* dw, const float* dwb, const float* lng, const float* lnb, bf16_t* uc) {
    LAS float* sm = (LAS float*)X.lds;
    const int tid = X.tid, lane = X.lane, wid = X.wave, c0 = 2 * tid;
    float w[31][2];
#pragma unroll
    for (int j = 0; j < 31; ++j) { w[j][0] = dw[j * 1024 + c0]; w[j][1] = dw[j * 1024 + c0 + 1]; }
    const float bias0 = dwb[c0], bias1 = dwb[c0 + 1];
    unsigned raw[62];
#define CONV_LOAD(task_) do { const int b_ = (task_) >> 8, s0_ = ((task_) & 255) * 32; const bf16_t* q_ = pU + (size_t)(b_ * SEQ) * D + c0; \
        _Pragma("unroll") for (int i = 0; i < 62; ++i) { const int s_ = s0_ - 30 + i; raw[i] = (s_ >= 0) ? *(const unsigned*)(q_ + (size_t)s_ * D) : 0u; } } while (0)
    int task = X.vcu;
    if (task < T / 32) CONV_LOAD(task);
    for (; task < T / 32; task += X.G) {
        const int b = task >> 8, s0 = (task & 255) * 32;
#pragma unroll
        for (int st = 0; st < 4; ++st) {
            float u[38][2];
#pragma unroll
            for (int i = 0; i < 38; ++i) { u[i][0] = bflo(raw[8 * st + i]); u[i][1] = bfhi(raw[8 * st + i]); }
#pragma unroll
            for (int t = 0; t < 8; ++t) {
                float a0 = bias0, a1 = bias1;
#pragma unroll
                for (int j = 0; j < 31; ++j) { a0 += w[j][0] * u[t + j][0]; a1 += w[j][1] * u[t + j][1]; }
                *(LAS f32x2*)(sm + (8 * st + t) * 1024 + c0) = (f32x2){a0, a1};
            }
        }
        if (task + X.G < T / 32) CONV_LOAD(task + X.G);
        __syncthreads();
#pragma unroll 2
        for (int i = 0; i < 4; ++i) {
            const int t = wid * 4 + i;
            f32x4 v[4]; float s = 0.f;
#pragma unroll
            for (int j = 0; j < 4; ++j) { v[j] = *(const LAS f32x4*)(sm + t * 1024 + 4 * (lane + 64 * j)); s += (v[j].x + v[j].y) + (v[j].z + v[j].w); }
            const float mean = wave_sum(s) * (1.0f / D); float q = 0.f;
#pragma unroll
            for (int j = 0; j < 4; ++j) { v[j] = v[j] - mean; q += (v[j].x * v[j].x + v[j].y * v[j].y) + (v[j].z * v[j].z + v[j].w * v[j].w); }
            const float rstd = rsqrtf(wave_sum(q) * (1.0f / D) + EPS);
#pragma unroll
            for (int j = 0; j < 4; ++j) {
                const int col = 4 * (lane + 64 * j);
                const f32x4 gg = *(const f32x4*)(lng + col), bb = *(const f32x4*)(lnb + col);
                f32x4 y = v[j] * rstd * gg + bb;
                y.x *= sigmoidf_(y.x); y.y *= sigmoidf_(y.y); y.z *= sigmoidf_(y.z); y.w *= sigmoidf_(y.w);
                u32x2 o; o.x = pk2(y.x, y.y); o.y = pk2(y.z, y.w);
                *(u32x2*)(uc + (size_t)(b * SEQ + s0 + t) * (2 * D) + col) = o;
            }
        }
        __syncthreads();
    }
#undef CONV_LOAD
}

typedef short bf16x8 __attribute__((ext_vector_type(8)));
typedef short s16x4 __attribute__((ext_vector_type(4)));
constexpr int HG_QA = 0, HG_KA = 17408, HG_VR = 34816, HG_AB = 52224, HG_SPT = 61440, HG_O = 96256, HG_SEG = 130048;
constexpr size_t HM = (size_t)SEQ * 128;
__device__ __forceinline__ bf16x8 tr_frag(LAS unsigned char* base, int rs, int ks, int c16, int lane) {
    const int g = lane >> 4, q = (lane & 15) >> 2, p = lane & 3;
    LAS unsigned char* a = base + (32 * ks + 8 * g + q) * rs + (16 * c16 + 4 * p) * 2;
    const s16x4 lo = __builtin_amdgcn_ds_read_tr16_b64_v4i16((LAS s16x4*)a);
    const s16x4 hi = __builtin_amdgcn_ds_read_tr16_b64_v4i16((LAS s16x4*)(a + 4 * rs));
    return __builtin_shufflevector(lo, hi, 0, 1, 2, 3, 4, 5, 6, 7);
}
template <bool OUT>
__device__ __forceinline__ void ph_hgrn(const Ctx& X, int ntask, const bf16_t* pQ, const bf16_t* pF, const bf16_t* pI, const bf16_t* pG,
                                        const float* lb_param, const float* norm_g, const float* S0, float* dS, float* Dd, bf16_t* og) {
    LAS unsigned char* L = X.lds;
    LAS float* seg_s = (LAS float*)(L + HG_SEG);
    const int tid = X.tid, lane = X.lane, wave = X.wave, fr = lane & 15, fq = lane >> 4, wr = wave >> 1, wc = wave & 1;
    const int cp = tid & 63, seg = wave, tv = tid >> 3, vc = tid & 7;
    int idx = X.vcu; if (idx >= ntask) return;
    int ch = 0;
    unsigned zr[8], qr[8]; u32x4 vr0, vr1, gn0, gn1, gc0, gc1;
#define HG_LOAD(idx_, ch_) do { const int bh_ = (idx_) & 31, sc_ = (idx_) >> 5; const size_t tb_ = (size_t)bh_ * HM + (size_t)(sc_ * 256 + (ch_) * 64) * 128; \
        _Pragma("unroll") for (int i = 0; i < 8; ++i) { zr[i] = *(const unsigned*)(pF + tb_ + (size_t)(8 * seg + i) * 128 + 2 * cp); if (OUT) qr[i] = *(const unsigned*)(pQ + tb_ + (size_t)(8 * seg + i) * 128 + 2 * cp); } \
        { const u32x4* s_ = (const u32x4*)(pI + tb_ + (size_t)tv * 128 + vc * 16); vr0 = s_[0]; vr1 = s_[1]; } \
        if (OUT) { const u32x4* s_ = (const u32x4*)(pG + tb_ + (size_t)tv * 128 + vc * 16); gn0 = s_[0]; gn1 = s_[1]; } } while (0)
    HG_LOAD(idx, 0);
    float ngv[16];
    if (OUT) {
#pragma unroll
        for (int i = 0; i < 16; ++i) ngv[i] = norm_g[vc * 16 + i];
    }
    f32x4 S[8]; float oml0 = 0.f, oml1 = 0.f, gsum0 = 0.f, gsum1 = 0.f;
#pragma unroll 1
    for (;;) {
        const int sc = idx >> 5, bh = idx & 31, b = bh >> 3, h = bh & 7;
        if (ch == 0) {
            const int c0 = h * 128 + 2 * cp;
            oml0 = 1.0f - 1.0f / (1.0f + __expf(lb_param[1024 + c0] - lb_param[c0])); oml1 = 1.0f - 1.0f / (1.0f + __expf(lb_param[1025 + c0] - lb_param[c0 + 1]));
            gsum0 = 0.f; gsum1 = 0.f;
            if (OUT && sc > 0) { const float* s0 = S0 + (size_t)(bh * 32 + sc) * 16384;
#pragma unroll
                for (int vt = 0; vt < 8; ++vt)
#pragma unroll
                    for (int j = 0; j < 4; ++j) S[vt][j] = s0[(size_t)(16 * wave + fq * 4 + j) * 128 + vt * 16 + fr];
            } else {
#pragma unroll
                for (int vt = 0; vt < 8; ++vt) S[vt] = (f32x4){0.f, 0.f, 0.f, 0.f};
            }
        }
        float kk0[8], kk1[8], lf0[8], lf1[8], q0[8], q1[8];
        {
            float c0 = 0.f, c1 = 0.f;
#pragma unroll
            for (int i = 0; i < 8; ++i) {
                kk0[i] = oml0 * __builtin_amdgcn_rcpf(1.0f + __expf(bflo(zr[i]))); kk1[i] = oml1 * __builtin_amdgcn_rcpf(1.0f + __expf(bfhi(zr[i])));
                c0 += __logf(1.0f - kk0[i]); c1 += __logf(1.0f - kk1[i]); lf0[i] = c0; lf1[i] = c1;
                if (OUT) { q0[i] = bflo(qr[i]) * 0.08838834764831845f; q1[i] = bfhi(qr[i]) * 0.08838834764831845f; }
            }
            *(LAS f32x2*)(seg_s + seg * 128 + 2 * cp) = (f32x2){c0, c1};
        }
        if (OUT) { gc0 = gn0; gc1 = gn1; }
        const u32x4 vcur0 = vr0, vcur1 = vr1;
        __syncthreads();
        { LAS u32x4* d = (LAS u32x4*)(L + HG_VR + tv * 272 + vc * 32); d[0] = vcur0; d[1] = vcur1; }
        { int idx2 = idx, ch2 = ch + 1; if (ch2 == 4) { ch2 = 0; idx2 = idx + X.G; } if (idx2 < ntask) HG_LOAD(idx2, ch2); }
        {
            f32x2 ss[8];
#pragma unroll
            for (int s = 0; s < 8; ++s) ss[s] = *(const LAS f32x2*)(seg_s + s * 128 + 2 * cp);
            float off0 = 0.f, off1 = 0.f;
#pragma unroll
            for (int s = 0; s < 8; ++s) { off0 += (s < seg) ? ss[s].x : 0.f; off1 += (s < seg) ? ss[s].y : 0.f; }
            const float R0 = (ss[0].x + ss[1].x) + (ss[2].x + ss[3].x), R1 = (ss[0].y + ss[1].y) + (ss[2].y + ss[3].y);
            if (!OUT && seg == 0) { gsum0 += R0 + (ss[4].x + ss[5].x) + (ss[6].x + ss[7].x); gsum1 += R1 + (ss[4].y + ss[5].y) + (ss[6].y + ss[7].y); }
#pragma unroll
            for (int i = 0; i < 8; ++i) {
                const float G0 = off0 + lf0[i], G1 = off1 + lf1[i];
                const float ka0 = kk0[i] * __expf(fminf(R0 - G0, 80.0f)), ka1 = kk1[i] * __expf(fminf(R1 - G1, 80.0f));
                *(LAS unsigned*)(L + HG_KA + (8 * seg + i) * 272 + 4 * cp) = pk2(ka0, ka1);
                if (OUT) { const float qa0 = q0[i] * __expf(fminf(G0 - R0, 80.0f)), qa1 = q1[i] * __expf(fminf(G1 - R1, 80.0f));
                           *(LAS unsigned*)(L + HG_QA + (8 * seg + i) * 272 + 4 * cp) = pk2(qa0, qa1); }
            }
        }
        float eR[4], eL[4];
        {
            f32x4 r4 = (f32x4){0.f, 0.f, 0.f, 0.f}, l4 = (f32x4){0.f, 0.f, 0.f, 0.f};
#pragma unroll
            for (int s = 0; s < 4; ++s) { r4 += *(const LAS f32x4*)(seg_s + s * 128 + 16 * wave + 4 * fq); l4 += *(const LAS f32x4*)(seg_s + (s + 4) * 128 + 16 * wave + 4 * fq); }
#pragma unroll
            for (int j = 0; j < 4; ++j) { eR[j] = __expf(fmaxf(r4[j], -80.0f)); eL[j] = __expf(l4[j]); }
        }
#pragma unroll
        for (int vt = 0; vt < 8; ++vt) {
#pragma unroll
            for (int j = 0; j < 4; ++j) S[vt][j] *= eR[j];
            if (OUT) { u32x2 w; w.x = pk2(S[vt][0], S[vt][1]); w.y = pk2(S[vt][2], S[vt][3]);
                       *(LAS u32x2*)(L + HG_SPT + (vt * 16 + fr) * 272 + (16 * wave + 4 * fq) * 2) = w; }
        }
        __syncthreads();
        if (OUT) {
#pragma unroll
            for (int q2 = 0; q2 < 2; ++q2) {
                const int st = 2 * wc + q2;
                f32x4 acc = (f32x4){0.f, 0.f, 0.f, 0.f};
                if (st <= wr) {
#pragma unroll
                    for (int kq = 0; kq < 4; ++kq) {
                        const bf16x8 af = *(const LAS bf16x8*)(L + HG_KA + (st * 16 + fr) * 272 + kq * 64 + fq * 16);
                        const bf16x8 bq = *(const LAS bf16x8*)(L + HG_QA + (wr * 16 + fr) * 272 + kq * 64 + fq * 16);
                        acc = __builtin_amdgcn_mfma_f32_16x16x32_bf16(af, bq, acc, 0, 0, 0);
                    }
                    const int tt = wr * 16 + fr;
#pragma unroll
                    for (int j = 0; j < 4; ++j) { const int s_ = st * 16 + fq * 4 + j; acc[j] = (s_ <= tt) ? acc[j] : 0.f; }
                }
                u32x2 w; w.x = pk2(acc[0], acc[1]); w.y = pk2(acc[2], acc[3]);
                *(LAS u32x2*)(L + HG_AB + (wr * 16 + fr) * 144 + (st * 16 + fq * 4) * 2) = w;
            }
        }
        {
            bf16x8 aK[2];
#pragma unroll
            for (int ks = 0; ks < 2; ++ks) aK[ks] = tr_frag(L + HG_KA, 272, ks, wave, lane);
#pragma unroll
            for (int vt = 0; vt < 8; ++vt) {
#pragma unroll
                for (int ks = 0; ks < 2; ++ks) { const bf16x8 bv = tr_frag(L + HG_VR, 272, ks, vt, lane); S[vt] = __builtin_amdgcn_mfma_f32_16x16x32_bf16(aK[ks], bv, S[vt], 0, 0, 0); }
#pragma unroll
                for (int j = 0; j < 4; ++j) S[vt][j] *= eL[j];
            }
        }
        if (OUT) {
            __syncthreads();
            bf16x8 aA[2], aQ[4];
#pragma unroll
            for (int ks = 0; ks < 2; ++ks) aA[ks] = *(const LAS bf16x8*)(L + HG_AB + (wr * 16 + fr) * 144 + ks * 64 + fq * 16);
#pragma unroll
            for (int kq = 0; kq < 4; ++kq) aQ[kq] = *(const LAS bf16x8*)(L + HG_QA + (wr * 16 + fr) * 272 + kq * 64 + fq * 16);
#pragma unroll
            for (int n = 0; n < 4; ++n) {
                const int vt = wc * 4 + n;
                f32x4 o = (f32x4){0.f, 0.f, 0.f, 0.f};
#pragma unroll
                for (int ks = 0; ks < 2; ++ks) { const bf16x8 bv = tr_frag(L + HG_VR, 272, ks, vt, lane); o = __builtin_amdgcn_mfma_f32_16x16x32_bf16(aA[ks], bv, o, 0, 0, 0); }
#pragma unroll
                for (int kq = 0; kq < 4; ++kq) { const bf16x8 bs = *(const LAS bf16x8*)(L + HG_SPT + (vt * 16 + fr) * 272 + kq * 64 + fq * 16); o = __builtin_amdgcn_mfma_f32_16x16x32_bf16(aQ[kq], bs, o, 0, 0, 0); }
#pragma unroll
                for (int j = 0; j < 4; ++j) *(LAS float*)(L + HG_O + (wr * 16 + fq * 4 + j) * 528 + (vt * 16 + fr) * 4) = o[j];
            }
            __syncthreads();
            {
                f32x4 ov[4]; float ssq = 0.f;
#pragma unroll
                for (int i = 0; i < 4; ++i) { ov[i] = *(const LAS f32x4*)(L + HG_O + tv * 528 + vc * 64 + i * 16); ssq += (ov[i].x * ov[i].x + ov[i].y * ov[i].y) + (ov[i].z * ov[i].z + ov[i].w * ov[i].w); }
                ssq += __shfl_xor(ssq, 1); ssq += __shfl_xor(ssq, 2); ssq += __shfl_xor(ssq, 4);
                const float rstd = rsqrtf(ssq * (1.0f / 128.0f) + EPS);
                const unsigned gw[8] = {gc0.x, gc0.y, gc0.z, gc0.w, gc1.x, gc1.y, gc1.z, gc1.w};
                unsigned ow[8];
#pragma unroll
                for (int i = 0; i < 8; ++i) { const float g0 = bflo(gw[i]), g1 = bfhi(gw[i]);
                    const float y0 = ov[i >> 1][(2 * i) & 3] * rstd * ngv[2 * i] * g0 * __builtin_amdgcn_rcpf(1.0f + __expf(-g0));
                    const float y1 = ov[i >> 1][(2 * i + 1) & 3] * rstd * ngv[2 * i + 1] * g1 * __builtin_amdgcn_rcpf(1.0f + __expf(-g1));
                    ow[i] = pk2(y0, y1); }
                u32x4* d = (u32x4*)(og + (size_t)(b * SEQ + sc * 256 + ch * 64 + tv) * (2 * D) + h * 128 + vc * 16);
                d[0] = (u32x4){ow[0], ow[1], ow[2], ow[3]}; d[1] = (u32x4){ow[4], ow[5], ow[6], ow[7]};
            }
        }
        if (ch == 3) {
            if (!OUT) {
                float* ds = dS + (size_t)(bh * 32 + sc) * 16384;
#pragma unroll
                for (int vt = 0; vt < 8; ++vt)
#pragma unroll
                    for (int j = 0; j < 4; ++j) ds[(size_t)(16 * wave + fq * 4 + j) * 128 + vt * 16 + fr] = S[vt][j];
                if (seg == 0) *(f32x2*)(Dd + (size_t)(bh * 32 + sc) * 128 + 2 * cp) = (f32x2){__expf(gsum0), __expf(gsum1)};
            }
            idx += X.G; ch = 0; if (idx >= ntask) break;
        } else ++ch;
    }
#undef HG_LOAD
    __syncthreads();
}

__device__ __forceinline__ void ph_hg2(const Ctx& X, const float* dS, const float* Dd, float* S0) {
    for (int idx = X.vcu * 512 + X.tid; idx < 32 * 4096; idx += X.G * 512) {
        const int bh = idx >> 12, e4 = idx & 4095, k = e4 >> 5, v4 = (e4 & 31) * 4;
        f32x4 s = (f32x4){0.f, 0.f, 0.f, 0.f};
#pragma unroll 4
        for (int sc = 0; sc < 31; ++sc) { const float d = Dd[(size_t)(bh * 32 + sc) * 128 + k]; const f32x4 ds = *(const f32x4*)(dS + (size_t)(bh * 32 + sc) * 16384 + k * 128 + v4);
            s = s * d + ds; *(f32x4*)(S0 + (size_t)(bh * 32 + sc + 1) * 16384 + k * 128 + v4) = s; }
    }
}

__device__ __forceinline__ void ph_router_tables(const Ctx& X, const float* g_ffn, const float* mod, const float* w_router, const float* b_router, float* Bp, float* cb) {
    for (int i = X.vcu * 512 + X.tid; i < 4 * 1024 * 32; i += X.G * 512) { const int b = i >> 15, k = (i >> 5) & 1023;
        Bp[i] = g_ffn[k] * (1.0f + mod[(size_t)b * NMOD + 4 * D + k]) * w_router[i & 32767]; }
    const int gw = X.vcu * 8 + X.wave;
    if (gw < 128) { const int b = gw >> 5, e = gw & 31; float a = 0.f;
        for (int k = X.lane; k < 1024; k += 64) a += mod[(size_t)b * NMOD + 3 * D + k] * w_router[k * 32 + e];
        a = wave_sum(a); if (X.lane == 0) cb[gw] = a + b_router[e]; }
}

__device__ __forceinline__ void ph_route(const Ctx& X, const bf16_t* x1, const float* g_ffn, const float* mod, const float* Bp, const float* cb,
                                         unsigned char* h2, int* top_e, float* top_w, int* rank, int* hist_g) {
    LAS int* hist = (LAS int*)(X.lds + LDSCTL_OFF + 64);
    const int tid = X.tid, lane = X.lane, c = lane & 15, q = lane >> 4;
    for (int tile = X.vcu; tile < RT_NT; tile += X.G) {
        if (tid < 32) hist[tid] = 0;
        __syncthreads();
        const int tw = tile * RT_TILE + X.wave * 16, b = tw / SEQ;
        const bf16_t* xa = x1 + (size_t)(tw + c) * D + 4 * q;
        const float* bp = Bp + ((size_t)b * 1024 + 4 * q) * 32 + c;
        f32x4 acc0 = (f32x4){0.f, 0.f, 0.f, 0.f}, acc1 = acc0; float ss = 0.f;
#pragma unroll 4
        for (int m = 0; m < 64; ++m) {
            const u32x2 a2_ = *(const u32x2*)(xa + 16 * m); const f32x4 a4 = (f32x4){bflo(a2_.x), bfhi(a2_.x), bflo(a2_.y), bfhi(a2_.y)};
            float bv[8];
#pragma unroll
            for (int j = 0; j < 4; ++j) { bv[2 * j] = bp[(size_t)(16 * m + j) * 32]; bv[2 * j + 1] = bp[(size_t)(16 * m + j) * 32 + 16]; }
            ss += (a4.x * a4.x + a4.y * a4.y) + (a4.z * a4.z + a4.w * a4.w);
#pragma unroll
            for (int j = 0; j < 4; ++j) { acc0 = __builtin_amdgcn_mfma_f32_16x16x4f32(a4[j], bv[2 * j], acc0, 0, 0, 0); acc1 = __builtin_amdgcn_mfma_f32_16x16x4f32(a4[j], bv[2 * j + 1], acc1, 0, 0, 0); }
        }
        ss += __shfl_xor(ss, 16); ss += __shfl_xor(ss, 32);
        const float rs = rsqrtf(ss * (1.0f / D) + EPS);
        const float cb0 = cb[b * 32 + c], cb1 = cb[b * 32 + 16 + c];
#pragma unroll
        for (int reg = 0; reg < 4; ++reg) {
            const float rt = __shfl(rs, 4 * q + reg);
            float v0 = acc0[reg] * rt + cb0, v1 = acc1[reg] * rt + cb1;
            float sv[4]; int si[4];
#pragma unroll
            for (int rnd = 0; rnd < 4; ++rnd) {
                float bvv = v0; int bi = c; if (v1 > bvv) { bvv = v1; bi = 16 + c; }
#pragma unroll
                for (int o = 1; o < 16; o <<= 1) { const float ov = __shfl_xor(bvv, o); const int oi = __shfl_xor(bi, o); if (ov > bvv || (ov == bvv && oi < bi)) { bvv = ov; bi = oi; } }
                sv[rnd] = bvv; si[rnd] = bi; if (bi == c) v0 = -INFINITY; if (bi == 16 + c) v1 = -INFINITY;
            }
            const float e1 = __expf(sv[1] - sv[0]), e2 = __expf(sv[2] - sv[0]), e3 = __expf(sv[3] - sv[0]);
            const float inv = 1.0f / (1.0f + e1 + e2 + e3);
            if (c == 0) { const int t = tw + 4 * q + reg;
                const float ww[4] = {inv, e1 * inv, e2 * inv, e3 * inv};
#pragma unroll
                for (int rnd = 0; rnd < 4; ++rnd) { top_e[t * 4 + rnd] = si[rnd]; top_w[t * 4 + rnd] = ww[rnd]; rank[t * 4 + rnd] = atomicAdd((int*)&hist[si[rnd]], 1); }
            }
        }
        const float* sh = mod + (size_t)b * NMOD + 3 * D; const float* sc = mod + (size_t)b * NMOD + 4 * D;
#pragma unroll 4
        for (int i = 0; i < 16; ++i) {
            const float r = __shfl(rs, i);
            const u32x2* xr = (const u32x2*)(x1 + (size_t)(tw + i) * D) + lane;
#pragma unroll
            for (int j = 0; j < 4; ++j) {
                const int col = 4 * (lane + 64 * j);
                const f32x4 gg = *(const f32x4*)(g_ffn + col), s1 = *(const f32x4*)(sc + col), s0 = *(const f32x4*)(sh + col);
                const u32x2 xw = xr[64 * j]; const f32x4 xv = (f32x4){bflo(xw.x), bfhi(xw.x), bflo(xw.y), bfhi(xw.y)};
                const f32x4 y = (xv * r * gg * (s1 + 1.0f) + s0) * 16.0f;
                *(unsigned*)(h2 + (size_t)(tw + i) * D + col) = cvt4_fp8(y.x, y.y, y.z, y.w);
            }
        }
        __syncthreads();
        if (tid < 32) hist_g[tile * 32 + tid] = hist[tid];
        __syncthreads();
    }
}

__device__ __forceinline__ void ph_sort(const Ctx& X, const int* hist_g, const int* top_e, const float* top_w, const int* rank, int* row_tok, float* row_w, int* pair_row, int* blk_e) {
    LAS int* s_hist = (LAS int*)X.lds;
    LAS int* s_tot = s_hist + RT_NT * 32; LAS int* s_pre = s_tot + 32; LAS int* s_base = s_pre + 32; LAS int* s_pstart = s_base + 32; LAS int* s_pend = s_pstart + 32;
    const int tid = X.tid;
    for (int i = tid; i < RT_NT * 32; i += 512) s_hist[i] = hist_g[i];
    __syncthreads();
    for (int tile = X.vcu; tile < RT_NT; tile += X.G) {
        if (tid < 32) { int tot = 0, pre = 0; for (int i = 0; i < RT_NT; ++i) { const int c = s_hist[i * 32 + tid]; tot += c; if (i < tile) pre += c; } s_tot[tid] = tot; s_pre[tid] = pre; }
        __syncthreads();
        if (tid == 0) { int acc = 0; for (int e = 0; e < 32; ++e) { const int padded = (s_tot[e] + 255) / 256 * 256; s_pstart[e] = acc; s_base[e] = acc + s_pre[e]; acc += padded; s_pend[e] = acc; } }
        __syncthreads();
        { const int i = tid; const int idx = tile * RT_TILE * 4 + i; const int e = top_e[idx]; const int row = s_base[e] + rank[idx];
          row_tok[row] = idx >> 2; row_w[row] = top_w[idx]; pair_row[idx] = row; }
        if (tile < 32) { const int e = tile; for (int r = s_pstart[e] + s_tot[e] + tid; r < s_pend[e]; r += 512) { row_tok[r] = 0; row_w[r] = 0.f; } }
        if (tile == 32) { for (int blk = tid; blk < NBLK_MAX; blk += 512) { int e = -1; const int r = blk * 256; for (int q = 0; q < 32; ++q) if (r >= s_pstart[q] && r < s_pend[q]) e = q; blk_e[blk] = e; }
                          if (tid == 0) blk_e[NBLK_MAX] = s_pend[31] / 256; }
        __syncthreads();
    }
}

__device__ __forceinline__ void ph_final(const Ctx& X, const bf16_t* x1, const unsigned char* y, const int* pair_row, const float* mod, const float* g_final, float* out, const float oscale) {
    const int lane = X.lane;
    for (int t = X.vcu * 8 + X.wave; t < T; t += X.G * 8) {
        const int b = t / SEQ;
        const u32x2* xr = (const u32x2*)(x1 + (size_t)t * D) + lane;
        const float* ga = mod + (size_t)b * NMOD + 5 * D;
        int rows[4];
#pragma unroll
        for (int k = 0; k < 4; ++k) rows[k] = pair_row[t * 4 + k];
        f32x4 v[4]; float ss = 0.f;
#pragma unroll
        for (int j = 0; j < 4; ++j) {
            const int col = 4 * (lane + 64 * j);
            f32x4 m = (f32x4){0.f, 0.f, 0.f, 0.f};
#pragma unroll
            for (int k = 0; k < 4; ++k) { const int w = *(const int*)(y + (size_t)rows[k] * D + col); const f32x2 lo = __builtin_amdgcn_cvt_pk_f32_fp8(w, false), hi = __builtin_amdgcn_cvt_pk_f32_fp8(w, true); m.x += lo.x; m.y += lo.y; m.z += hi.x; m.w += hi.y; }
            const u32x2 xw = xr[64 * j];
            v[j] = (f32x4){bflo(xw.x), bfhi(xw.x), bflo(xw.y), bfhi(xw.y)} + *(const f32x4*)(ga + col) * (m * (1.0f / 32.0f));
            ss += (v[j].x * v[j].x + v[j].y * v[j].y) + (v[j].z * v[j].z + v[j].w * v[j].w);
        }
        const float r = rsqrtf(wave_sum(ss) * (1.0f / D) + EPS);
#pragma unroll
        for (int j = 0; j < 4; ++j) { const int col = 4 * (lane + 64 * j); *(f32x4*)(out + (size_t)t * D + col) = v[j] * (r * oscale) * *(const f32x4*)(g_final + col); }
    }
}

constexpr int N_PHASES = 13;
struct Args { const float* in[23]; float* out; unsigned char* ws; int ph_lo, ph_hi; };
__global__ void __launch_bounds__(512, 2) fwd(Args a) {
    extern __shared__ __attribute__((aligned(16))) unsigned char lds_raw[];
    Ctx X; X.lds = (LAS unsigned char*)lds_raw; X.tid = threadIdx.x; X.lane = X.tid & 63; X.wave = __builtin_amdgcn_readfirstlane(X.tid >> 6);
    X.G = gridDim.x; { const int bx = blockIdx.x; X.vcu = (X.G % 8 == 0) ? (bx % 8) * (X.G / 8) + bx / 8 : bx; }
    unsigned char* ws = a.ws;
    for (int u = X.tid; u < (LDS_BYTES - LDSCTL_OFF) / 4; u += 512) ((LAS unsigned*)(X.lds + LDSCTL_OFF))[u] = 0u;
    __syncthreads();
    XcdBarrier bar = xcd_barrier_post((unsigned*)(ws + WS_CTL) + CW_BAR, (volatile LAS unsigned*)(X.lds + LDSCTL_OFF), X.tid == 0);
    const int lo = a.ph_lo, hi = a.ph_hi; float probe_scale = 1.0f;
#define IN(k) (lo <= (k) && (k) < hi)
#define SEAM(k) do { if (IN(k) && IN((k) + 1)) xcd_barrier(bar, X.wave == 0 && (int)__builtin_amdgcn_mbcnt_hi(~0u, __builtin_amdgcn_mbcnt_lo(~0u, 0u)) == 0); } while (0)
#ifdef PROBE_PH
    unsigned long long* stamps = (unsigned long long*)(ws + WS_CTL + 32768);
    if (blockIdx.x == 0 && X.tid == 0) stamps[0] = __builtin_amdgcn_s_memrealtime();
#undef SEAM
#define SEAM(k) do { if (IN(k) && IN((k) + 1)) { xcd_barrier(bar, X.wave == 0 && (int)__builtin_amdgcn_mbcnt_hi(~0u, __builtin_amdgcn_mbcnt_lo(~0u, 0u)) == 0); \
        if (blockIdx.x == 0 && X.wave == 0 && (int)__builtin_amdgcn_mbcnt_hi(~0u, __builtin_amdgcn_mbcnt_lo(~0u, 0u)) == 0) stamps[(k) + 1] = __builtin_amdgcn_s_memrealtime(); } } while (0)
#endif
    const float* x = a.in[0]; const float* c = a.in[1]; const float* w_ada = a.in[2]; const float* b_ada = a.in[3];
    const float* g_mix = a.in[4]; const float* w_in = a.in[5]; const float* conv_dw = a.in[6]; const float* conv_dwb = a.in[7];
    const float* conv_ln_g = a.in[8]; const float* conv_ln_b = a.in[9]; const float* w_conv_out = a.in[10]; const float* lb_param = a.in[11];
    const float* hgrn_norm_g = a.in[12]; const float* w_hgrn_out = a.in[13]; const float* w_out = a.in[14]; const float* g_ffn = a.in[15];
    const float* w_router = a.in[16]; const float* b_router = a.in[17]; const float* w1 = a.in[18]; const float* b1 = a.in[19];
    const float* w2 = a.in[20]; const float* b2 = a.in[21]; const float* g_final = a.in[22];
    float* mod = (float*)(ws + WS_MOD); float* rt_bp = (float*)(ws + WS_BP); float* rt_cb = (float*)(ws + WS_CB);
    int* hist_g = (int*)(ws + WS_HIST); int* blk_e = (int*)(ws + WS_BLKE); int* top_e = (int*)(ws + WS_TOPE); float* top_w = (float*)(ws + WS_TOPW);
    int* rank = (int*)(ws + WS_RANK); int* pair_row = (int*)(ws + WS_PROW); int* row_tok = (int*)(ws + WS_RTOK); float* row_w = (float*)(ws + WS_RW);
    bf16_t* p = (bf16_t*)(ws + WS_P);
    bf16_t* h = (bf16_t*)(ws + WS_E); unsigned char* h8 = ws + WS_E + 64 * MiB; float* tmp = (float*)(ws + WS_E);
    float* hg_dS = (float*)(ws + WS_E); float* hg_S0 = (float*)(ws + WS_E + 64 * MiB); float* hg_D = (float*)(ws + WS_HGD);
    bf16_t* uc = (bf16_t*)(ws + WS_D); bf16_t* og = uc + D;   bf16_t* x1 = (bf16_t*)(ws + WS_D);
    bf16_t* merged = p;
    unsigned char* h2 = (unsigned char*)p;
    unsigned char* act = (unsigned char*)(p + PG);
    unsigned char* y = (unsigned char*)(p + PG) + (size_t)R_PAD * D;
    PG8_LAS unsigned char* ring = (PG8_LAS unsigned char*)lds_raw;

#ifndef REPMASK
#define REPMASK 0
#endif
#ifndef REPN
#define REPN 1
#endif
#define PH(k, ...) do { if (IN(k)) { _Pragma("unroll 1") for (int rep_ = 0; rep_ < ((((REPMASK) >> (k)) & 1) ? 1 + REPN : 1); ++rep_) { if (rep_) __syncthreads(); { int ln_ = (int)__builtin_amdgcn_mbcnt_hi(~0u, __builtin_amdgcn_mbcnt_lo(~0u, 0u)); asm volatile("" : "+v"(ln_)); X.lane = ln_; X.tid = X.wave * 64 + ln_; } __VA_ARGS__ } } SEAM(k); } while (0)
    PH(0, ph_prologue<0>(X, c, w_ada, b_ada, mod, w_in, w_conv_out, w_hgrn_out, w_out, w1, w2, ws););
    PH(1, ph_norm_mod(X, x, g_mix, mod, 0, D, h, h8); ph_router_tables(X, g_ffn, mod, w_router, b_router, rt_bp, rt_cb););
#ifndef STAGGER_TICKS
#define STAGGER_TICKS 0
#endif
    PH(2, { if (STAGGER_TICKS) { const unsigned long long t0_ = __builtin_amdgcn_s_memrealtime(), wait_ = (unsigned long long)(X.vcu & 3) * STAGGER_TICKS;
                while (__builtin_amdgcn_s_memrealtime() - t0_ < wait_) __builtin_amdgcn_s_sleep(8); }
        constexpr unsigned m8 = P_FP8_MASK; constexpr int n8 = __builtin_popcount(m8);
        if (n8 > 0) { pg8::Gemm g{(const bf16_t*)h8, (const bf16_t*)(ws + WS_WIN8), T, 8 * D, D / 2}; pg8::MaskOrder S; S.base.init(T, n8 * 256, X.G, (int)blockIdx.x); S.mask = m8;
            pg8::EpiSplitBf16 E{p, PG, 0x3cu, SEQ, 1.0f / 4096.0f}; pg8::gemm_phase<pg8::EpiSplitBf16, pg8::MaskOrder, true, true, false, true>(ring, g, S, E, X.wave); }
        if (n8 < 32) { pg8::Gemm g{h, (const bf16_t*)(ws + WS_WIN), T, 8 * D, D}; pg8::MaskOrder S; S.base.init(T, (32 - n8) * 256, X.G, (int)blockIdx.x); S.mask = ~m8;
            pg8::EpiSplitBf16 E{p, PG, 0x3cu, SEQ, 1.0f}; pg8::gemm_phase<pg8::EpiSplitBf16, pg8::MaskOrder, true, true>(ring, g, S, E, X.wave); } });
    PH(3, ph_conv(X, p + 0 * PG, conv_dw, conv_dwb, conv_ln_g, conv_ln_b, uc);
          if ((REPMASK >> 14) & 1) { __syncthreads(); ph_conv(X, p + 0 * PG, conv_dw, conv_dwb, conv_ln_g, conv_ln_b, uc); }
          ph_hgrn<false>(X, 31 * 32, p + 2 * PG, p + 3 * PG, p + 4 * PG, p + 5 * PG, lb_param, nullptr, nullptr, hg_dS, hg_D, nullptr);
          if ((REPMASK >> 15) & 1) { __syncthreads(); ph_hgrn<false>(X, 31 * 32, p + 2 * PG, p + 3 * PG, p + 4 * PG, p + 5 * PG, lb_param, nullptr, nullptr, hg_dS, hg_D, nullptr); });
    PH(4, ph_hg2(X, hg_dS, hg_D, hg_S0););
    PH(5, if ((X.vcu & 1) == 0) ph_prologue<1>(X, c, w_ada, b_ada, mod, w_in, w_conv_out, w_hgrn_out, w_out, w1, w2, ws);
          ph_hgrn<true>(X, 32 * 32, p + 2 * PG, p + 3 * PG, p + 4 * PG, p + 5 * PG, lb_param, hgrn_norm_g, hg_S0, nullptr, nullptr, og);
          if ((X.vcu & 1) != 0) ph_prologue<1>(X, c, w_ada, b_ada, mod, w_in, w_conv_out, w_hgrn_out, w_out, w1, w2, ws););
    PH(6, { pg8::Gemm g{uc, (const bf16_t*)(ws + WS_WC), T, D, 2 * D}; pg8::StaticOrder S; S.init(T, D, X.G, (int)blockIdx.x);
        pg8::EpiGateFused E{p + 6 * PG, p + 7 * PG, merged}; pg8::gemm_phase<pg8::EpiGateFused, pg8::StaticOrder, true, true>(ring, g, S, E, X.wave); });
    PH(7, { pg8::Gemm g{merged, (const bf16_t*)(ws + WS_WO), T, D, D}; pg8::StaticOrder S; S.init(T, D, X.G, (int)blockIdx.x);
        pg8::EpiRes E{x, mod + 2 * D, x1, NMOD, SEQ}; pg8::gemm_phase<pg8::EpiRes, pg8::StaticOrder, true, true>(ring, g, S, E, X.wave); });
    PH(8, ph_route(X, x1, g_ffn, mod, rt_bp, rt_cb, h2, top_e, top_w, rank, hist_g););
    PH(9, ph_sort(X, hist_g, top_e, top_w, rank, row_tok, row_w, pair_row, blk_e););
    PH(10, { const int nblk = blk_e[NBLK_MAX]; pg8::Gemm g{(const bf16_t*)h2, (const bf16_t*)(ws + WS_W1), T, 32 * 2048, D / 2}; pg8::MoeOrder S{blk_e, nblk, X.G, (int)blockIdx.x, 3};
        LAS unsigned short* gt = (LAS unsigned short*)(X.lds + LDSCTL_OFF + 256);
        _Pragma("unroll 1") for (int i = 0; i < 23; ++i) { pg8::Unit u; if (!S.next(i, u)) break; if (X.tid < 256) gt[256 * i + X.tid] = (unsigned short)row_tok[u.pm * 256 + X.tid]; }
        __syncthreads();
        pg8::EpiSwiglu8 E{b1, act, 1.0f / 4096.0f}; pg8::gemm_phase<pg8::EpiSwiglu8, pg8::MoeOrder, true, true, true, true>(ring, g, S, E, X.wave, (const PG8_LAS unsigned short*)gt); });
    PH(11, { const int nblk = blk_e[NBLK_MAX]; pg8::Gemm g{(const bf16_t*)act, (const bf16_t*)(ws + WS_W2), R_PAD, 32 * 1024, DFF / 2}; pg8::MoeOrder S{blk_e, nblk, X.G, (int)blockIdx.x, 2};
        pg8::EpiY8 E{b2, row_w, y, 1.0f / 1024.0f}; pg8::gemm_phase<pg8::EpiY8, pg8::MoeOrder, true, true, false, true>(ring, g, S, E, X.wave); });
#ifdef PROBE_PH
    { const unsigned long long* st_ = (const unsigned long long*)(ws + WS_CTL + 32768); const float dt_ = (float)(long long)(st_[PROBE_PH + 1] - st_[PROBE_PH]);
      probe_scale = 1.0f + dt_ * (1.0f / 200000.0f); }
#endif
    PH(12, ph_final(X, x1, y, pair_row, mod, g_final, a.out, probe_scale););
#undef PH
#undef IN
#undef SEAM
}

#ifndef MK_N_LAUNCHES
#define MK_N_LAUNCHES 1
#endif
extern "C" void kernel_launch(void* const* d_in, const int* in_sizes, int n_in, void* d_out, int out_size, void* d_ws, size_t ws_size, hipStream_t stream) {
    static int grid = 0;
    if (grid == 0) {
        if (n_in != 23 || out_size != T * D || ws_size < WS_END) { fprintf(stderr, "kernel_launch: unexpected n_in %d / out_size %d / ws_size %zu (< %zu); nothing launched\n", n_in, out_size, ws_size, (size_t)WS_END); grid = -1; return; }
        int dev = 0, cus = 0, per_cu = 0;
        if (hipGetDevice(&dev) != hipSuccess || hipDeviceGetAttribute(&cus, hipDeviceAttributeMultiprocessorCount, dev) != hipSuccess) { grid = -1; return; }
        if (hipFuncSetAttribute((const void*)fwd, hipFuncAttributeMaxDynamicSharedMemorySize, LDS_BYTES) != hipSuccess) { fprintf(stderr, "kernel_launch: hipFuncSetAttribute failed\n"); grid = -1; return; }
        if (hipOccupancyMaxActiveBlocksPerMultiprocessor(&per_cu, (const void*)fwd, 512, LDS_BYTES) != hipSuccess || per_cu < 1) { fprintf(stderr, "kernel_launch: occupancy query says %d blocks per CU\n", per_cu); }
        (void)hipGetLastError();
        grid = cus;
    }
    if (grid < 0) return;
    if (hipMemsetAsync((char*)d_ws + WS_CTL, 0, CTL_ZERO_BYTES, stream) != hipSuccess) return;
    Args a{};
    for (int i = 0; i < 23; ++i) a.in[i] = (const float*)d_in[i];
    a.out = (float*)d_out; a.ws = (unsigned char*)d_ws;
    if (MK_N_LAUNCHES == 1) { a.ph_lo = 0; a.ph_hi = N_PHASES; hipLaunchKernelGGL(fwd, dim3(grid), dim3(512), LDS_BYTES, stream, a); }
    else for (int ph = 0; ph < N_PHASES; ++ph) { a.ph_lo = ph; a.ph_hi = ph + 1; hipLaunchKernelGGL(fwd, dim3(grid), dim3(512), LDS_BYTES, stream, a); }
}
```

```cpp
#include <hip/hip_runtime.h>
#include <stdint.h>
#include <stdio.h>

#define GAS __attribute__((address_space(1)))
#define LAS __attribute__((address_space(3)))
typedef unsigned short bf16_t;
typedef unsigned u32x4 __attribute__((ext_vector_type(4)));
typedef unsigned u32x2 __attribute__((ext_vector_type(2)));
typedef float f32x4 __attribute__((ext_vector_type(4)));

constexpr int D = 1024, NBATCH = 4, SEQ = 8192, T = NBATCH * SEQ;
constexpr int NE = 32, DFF = 1024;
constexpr int NMOD = 6 * D;
constexpr int NBLK_MAX = 544, R_PAD = NBLK_MAX * 256;
constexpr int RT_TILE = 128, RT_NT = T / RT_TILE;
constexpr float EPS = 1e-6f;

constexpr size_t MiB = 1u << 20;
constexpr size_t WS_CTL = 0, CTL_ZERO_BYTES = 64 * 1024;
constexpr size_t WS_MOD = 1 * MiB;
constexpr size_t WS_CB = WS_MOD + 112 * 1024, WS_BP = WS_MOD + 128 * 1024;
constexpr size_t WS_HSC = WS_MOD + 704 * 1024, WS_WSC = WS_MOD + 840 * 1024;
constexpr size_t WS_HIST = 2 * MiB;
constexpr size_t WS_BLKE = WS_HIST + 64 * 1024;
constexpr size_t WS_TOPE = 3 * MiB;
constexpr size_t WS_TOPW = WS_TOPE + 512 * 1024;
constexpr size_t WS_RANK = WS_TOPW + 512 * 1024;
constexpr size_t WS_PROW = WS_RANK + 512 * 1024;
constexpr size_t WS_RTOK = 5 * MiB;
constexpr size_t WS_RW = 6 * MiB;
constexpr size_t WS_HGD = 7 * MiB;
constexpr size_t WS_WT = 8 * MiB;
constexpr size_t WS_WIN = WS_WT, WS_WC = WS_WT + 16 * MiB, WS_WH = WS_WT + 18 * MiB, WS_WO = WS_WT + 20 * MiB, WS_W1 = WS_WT + 22 * MiB, WS_WIN8 = WS_WT + 96 * MiB  , WS_W2 = WS_WT + 150 * MiB;
constexpr size_t WS_P = 224 * MiB;
constexpr size_t WS_E = WS_P + 512 * MiB;
constexpr size_t WS_D = WS_E + 128 * MiB;
constexpr size_t WS_END = WS_D + 128 * MiB;
constexpr size_t PG = (size_t)T * D;
constexpr int CW_BAR = 0;

constexpr int RING_BYTES = 135168, LDSCTL_OFF = RING_BYTES, LDS_BYTES = 147456;

__device__ __forceinline__ unsigned f2bf(float f) { unsigned u = __builtin_bit_cast(unsigned, f); return (u + 0x7fffu + ((u >> 16) & 1u)) >> 16; }
typedef __bf16 bf16x2_hw __attribute__((ext_vector_type(2)));
__device__ __forceinline__ unsigned pk2(float lo, float hi) { const bf16x2_hw v = {(__bf16)lo, (__bf16)hi}; return __builtin_bit_cast(unsigned, v); }
__device__ __forceinline__ float bf2f(unsigned b) { return __builtin_bit_cast(float, b << 16); }
__device__ __forceinline__ float bflo(unsigned w) { return __builtin_bit_cast(float, w << 16); }
__device__ __forceinline__ float bfhi(unsigned w) { return __builtin_bit_cast(float, w & 0xffff0000u); }
__device__ __forceinline__ float sigmoidf_(float x) { return __builtin_amdgcn_rcpf(1.0f + __expf(-x)); }
__device__ __forceinline__ float wave_sum(float v) {
#pragma unroll
    for (int o = 1; o < 64; o <<= 1) v += __shfl_xor(v, o);
    return v;
}
__device__ __forceinline__ unsigned cvt4_fp8(float a, float b, float c, float d) {
    a = fminf(fmaxf(a, -448.f), 448.f); b = fminf(fmaxf(b, -448.f), 448.f); c = fminf(fmaxf(c, -448.f), 448.f); d = fminf(fmaxf(d, -448.f), 448.f);
    int w = 0; w = __builtin_amdgcn_cvt_pk_fp8_f32(a, b, w, false); w = __builtin_amdgcn_cvt_pk_fp8_f32(c, d, w, true); return (unsigned)w; }
__device__ __forceinline__ unsigned q4_i8(float a, float b, float c, float d) {
    const int ia = (int)__builtin_rintf(a), ib = (int)__builtin_rintf(b), ic = (int)__builtin_rintf(c), id = (int)__builtin_rintf(d);
    return (unsigned)(ia & 255) | ((unsigned)(ib & 255) << 8) | ((unsigned)(ic & 255) << 16) | ((unsigned)id << 24); }
#define LDS_WAIT() asm volatile("s_waitcnt lgkmcnt(0)" ::: "memory")
#define VM_WAIT() asm volatile("s_waitcnt vmcnt(0)" ::: "memory")

namespace pg8 {
#define PG8_LAS __attribute__((address_space(3)))
typedef unsigned short bf16_t;
typedef short bf16x8 __attribute__((ext_vector_type(8)));
typedef float f32x4 __attribute__((ext_vector_type(4)));
typedef unsigned u32x4 __attribute__((ext_vector_type(4)));
constexpr int BM = 256, BK = 64, HALF = 128, HTB = HALF * BK * 2  , STAGE_BYTES = 8 * HTB, NXCD = 8, WGM = 8;

__host__ __device__ __forceinline__ int lds_byte(int r, int c) { const int st = (r >> 4) * 2 + (c >> 5), rr = r & 15, cc = c & 31, ob = rr * 64 + cc * 2; return st * 1024 + (ob ^ (((ob >> 9) & 1) << 5)); }
__host__ __device__ __forceinline__ void stage_rc(int b, int& R, int& C) { const int st = b / 1024, sb = b % 1024, swz = sb ^ (((sb >> 9) & 1) << 5); R = (st >> 1) * 16 + swz / 64; C = (st & 1) * 32 + (swz % 64) / 2; }
__host__ __device__ __forceinline__ int perm32(int rho) { const int n = rho >> 4, i = rho & 15; return 8 * (i >> 2) + 4 * n + (i & 3); }

struct Unit { int pm, pn; };
struct Gemm { const bf16_t* A; const bf16_t* Bt; int M, N, K; };

struct StaticOrder {
    int nM, nN, nwg, G, c;
    __host__ __device__ void init(int M, int N, int G_, int c_) { nM = M / BM; nN = N / BM; nwg = nM * nN; G = G_; c = c_; }
    __host__ __device__ bool next(int i, Unit& u) const {
        const long L = (long)i * G + c; if (L >= nwg) return false;
        int wgid = (int)L; { const int q = nwg / NXCD, r = nwg % NXCD, xcd = wgid % NXCD, off = wgid / NXCD; wgid = (xcd < r ? xcd * (q + 1) : r * (q + 1) + (xcd - r) * q) + off; }
        const int nig = WGM * nN, gid = wgid / nig, fm = gid * WGM, gsz = (nM - fm) < WGM ? (nM - fm) : WGM;
        u.pm = fm + ((wgid % nig) % gsz); u.pn = (wgid % nig) / gsz; return true;
    }
    __device__ __forceinline__ void a_ready(const Unit&) const {}
    __device__ __forceinline__ void done(const Unit&) const {}
};


struct MaskOrder {
    StaticOrder base; unsigned mask;
    __device__ __forceinline__ bool next(int i, Unit& u) const {
        if (!base.next(i, u)) return false;
        unsigned m = mask; for (int k = 0; k < u.pn; ++k) m &= m - 1;
        u.pn = __builtin_ctz(m); return true;
    }
    __device__ __forceinline__ void a_ready(const Unit&) const {}
    __device__ __forceinline__ void done(const Unit&) const {}
};
struct MoeOrder {
    const int* blk_e; int nblk, G, c, lg;
    __device__ __forceinline__ bool next(int i, Unit& u) const {
        int blk, j;
        if (G == 256) { const int xcd = c & 7, idx = c >> 3, prb = 256 >> lg; blk = i * prb + xcd * (prb >> 3) + (idx >> lg); j = idx & ((1 << lg) - 1); }
        else { const long L = (long)i * G + c; blk = (int)(L >> lg); j = (int)(L & ((1 << lg) - 1)); }
        if (blk >= nblk) return false;
        const int e = blk_e[blk]; u.pm = blk; u.pn = (e << lg) + j; return true;
    }
    __device__ __forceinline__ void a_ready(const Unit&) const {}
    __device__ __forceinline__ void done(const Unit&) const {}
};

__device__ __forceinline__ unsigned cvt_pk_bf16(float lo, float hi) { unsigned r; asm volatile("v_cvt_pk_bf16_f32 %0, %1, %2" : "=v"(r) : "v"(lo), "v"(hi)); return r; }
__device__ __forceinline__ float sigm(float x) { return __builtin_amdgcn_rcpf(1.0f + __expf(-x)); }
__device__ __forceinline__ float blo(unsigned w) { return __builtin_bit_cast(float, w << 16); }
__device__ __forceinline__ float bhi(unsigned w) { return __builtin_bit_cast(float, w & 0xffff0000u); }

template <bool I8> struct EpiSplitBf16 {
    static constexpr bool PERM = true, AFTER_DRAIN = false;
    bf16_t* O; size_t split_stride; unsigned hm_mask; int seq; float dq;
    const float* rs; const float* cs;
    __device__ __forceinline__ void operator()(const f32x4 (&acc)[2][2][4][2], const Unit& u, int wr, int wc, int fr, int fq) const {
        const int row0 = u.pm * BM + wr * 64 + fr; const int colt = u.pn * BM; const int t = colt >> 10;
        f32x4 cv[2][2]; float rv[2][4];
#pragma unroll
        for (int bj = 0; bj < 2; ++bj)
#pragma unroll
            for (int n = 0; n < 2; ++n) cv[bj][n] = I8 ? *(const f32x4*)(cs + colt + bj * HALF + wc * 32 + 8 * fq + 4 * n) : (f32x4){dq, dq, dq, dq};
#pragma unroll
        for (int ai = 0; ai < 2; ++ai)
#pragma unroll
            for (int m = 0; m < 4; ++m) rv[ai][m] = I8 ? rs[row0 + ai * HALF + m * 16] : 1.0f;
#define PG8_DEQ(ai, bj, m, n) (acc[ai][bj][m][n] * cv[bj][n] * rv[ai][m])
        if (u.pn < 8) {
#pragma unroll
            for (int ai = 0; ai < 2; ++ai)
#pragma unroll
                for (int m = 0; m < 4; ++m) { const int row = row0 + ai * HALF + m * 16; float r[8];
                    const f32x4 a0 = PG8_DEQ(ai, 0, m, 0), a1 = PG8_DEQ(ai, 0, m, 1), b0 = PG8_DEQ(ai, 1, m, 0), b1 = PG8_DEQ(ai, 1, m, 1);
#pragma unroll
                    for (int q = 0; q < 4; ++q) { r[q] = a0[q] * sigm(b0[q]); r[4 + q] = a1[q] * sigm(b1[q]); }
                    u32x4 w; w.x = cvt_pk_bf16(r[0], r[1]); w.y = cvt_pk_bf16(r[2], r[3]); w.z = cvt_pk_bf16(r[4], r[5]); w.w = cvt_pk_bf16(r[6], r[7]);
                    __builtin_nontemporal_store(w, (u32x4*)(O + (size_t)row * 1024 + 128 * u.pn + wc * 32 + 8 * fq)); }
            return;
        }
        bf16_t* base = O + (size_t)t * split_stride; const int cg = colt & 1023;
        const bool hm = (hm_mask >> t) & 1u;
        const int bb = (u.pm * BM) / seq;
#pragma unroll
        for (int ai = 0; ai < 2; ++ai)
#pragma unroll
            for (int m = 0; m < 4; ++m) { const int row = row0 + ai * HALF + m * 16;
#pragma unroll
                for (int bj = 0; bj < 2; ++bj) { const f32x4 v0 = PG8_DEQ(ai, bj, m, 0), v1 = PG8_DEQ(ai, bj, m, 1);
                    u32x4 w; w.x = cvt_pk_bf16(v0[0], v0[1]); w.y = cvt_pk_bf16(v0[2], v0[3]); w.z = cvt_pk_bf16(v1[0], v1[1]); w.w = cvt_pk_bf16(v1[2], v1[3]);
                    const size_t o = hm ? ((size_t)(bb * 8 + (cg >> 7) + bj) * seq + (row - bb * seq)) * 128 + wc * 32 + 8 * fq
                                        : (size_t)row * 1024 + cg + bj * HALF + wc * 32 + 8 * fq;
                    __builtin_nontemporal_store(w, (u32x4*)(base + o)); } }
#undef PG8_DEQ
    }
};
struct EpiRes {
    static constexpr bool PERM = true, AFTER_DRAIN = false;
    const float* x; const float* ga; bf16_t* out; int mod_pitch, seq; float dq;
    __device__ __forceinline__ void operator()(const f32x4 (&acc)[2][2][4][2], const Unit& u, int wr, int wc, int fr, int fq) const {
        const int row0 = u.pm * BM + wr * 64 + fr, col0 = u.pn * BM + wc * 32 + 8 * fq;
        const float* gab = ga + (size_t)((u.pm * BM) / seq) * mod_pitch + col0;
        f32x4 gv[2][2];
#pragma unroll
        for (int bj = 0; bj < 2; ++bj)
#pragma unroll
            for (int n = 0; n < 2; ++n) gv[bj][n] = *(const f32x4*)(gab + bj * HALF + 4 * n) * dq;
#pragma unroll
        for (int ai = 0; ai < 2; ++ai) {
            f32x4 xv[4][2][2];
#pragma unroll
            for (int m = 0; m < 4; ++m)
#pragma unroll
                for (int bj = 0; bj < 2; ++bj) { const float* xp = x + (size_t)(row0 + ai * HALF + m * 16) * 1024 + col0 + bj * HALF; xv[m][bj][0] = *(const f32x4*)xp; xv[m][bj][1] = *(const f32x4*)(xp + 4); }
#pragma unroll
            for (int m = 0; m < 4; ++m) { const size_t o = (size_t)(row0 + ai * HALF + m * 16) * 1024 + col0;
#pragma unroll
                for (int bj = 0; bj < 2; ++bj) {
                    const f32x4 v0 = xv[m][bj][0] + gv[bj][0] * acc[ai][bj][m][0], v1 = xv[m][bj][1] + gv[bj][1] * acc[ai][bj][m][1];
                    u32x4 w; w.x = cvt_pk_bf16(v0[0], v0[1]); w.y = cvt_pk_bf16(v0[2], v0[3]); w.z = cvt_pk_bf16(v1[0], v1[1]); w.w = cvt_pk_bf16(v1[2], v1[3]);
                    *(u32x4*)(out + o + bj * HALF) = w; } }
        }
    }
};
struct EpiSwiglu8 {
    static constexpr bool PERM = true, AFTER_DRAIN = false;
    const float* b1; unsigned char* act; float dq;
    __device__ __forceinline__ void operator()(const f32x4 (&acc)[2][2][4][2], const Unit& u, int wr, int wc, int fr, int fq) const {
        const int e = u.pn >> 3, j = u.pn & 7; const int row0 = u.pm * BM + wr * 64 + fr, f0 = 128 * j + wc * 32 + 8 * fq;
        const float* be = b1 + (size_t)e * 2048 + f0;
        const f32x4 bg0 = *(const f32x4*)(be), bg1 = *(const f32x4*)(be + 4), bl0 = *(const f32x4*)(be + 1024), bl1 = *(const f32x4*)(be + 1028);
#pragma unroll
        for (int ai = 0; ai < 2; ++ai)
#pragma unroll
            for (int m = 0; m < 4; ++m) {
                f32x4 g0 = acc[ai][0][m][0] * dq + bg0, g1 = acc[ai][0][m][1] * dq + bg1, l0 = acc[ai][1][m][0] * dq + bl0, l1 = acc[ai][1][m][1] * dq + bl1;
                float r[8];
#pragma unroll
                for (int q = 0; q < 4; ++q) { float gl = fminf(g0[q], 7.0f), li = fminf(fmaxf(l0[q], -7.0f), 7.0f); r[q] = 4.0f * gl * sigm(1.702f * gl) * (li + 1.0f);
                                              gl = fminf(g1[q], 7.0f); li = fminf(fmaxf(l1[q], -7.0f), 7.0f); r[4 + q] = 4.0f * gl * sigm(1.702f * gl) * (li + 1.0f); }
                u32x2 w; w.x = cvt4_fp8(r[0], r[1], r[2], r[3]); w.y = cvt4_fp8(r[4], r[5], r[6], r[7]);
                *(u32x2*)(act + (size_t)(row0 + ai * HALF + m * 16) * 1024 + f0) = w; }
    }
};
struct EpiY8 {
    static constexpr bool PERM = true, AFTER_DRAIN = false;
    const float* b2; const float* rw; unsigned char* y; float dq;
    __device__ __forceinline__ void operator()(const f32x4 (&acc)[2][2][4][2], const Unit& u, int wr, int wc, int fr, int fq) const {
        const int e = u.pn >> 2, j = u.pn & 3; const int row0 = u.pm * BM + wr * 64 + fr, col0 = 256 * j + wc * 32 + 8 * fq;
        const float* be = b2 + (size_t)e * 1024 + col0;
        f32x4 bv[2][2];
#pragma unroll
        for (int bj = 0; bj < 2; ++bj)
#pragma unroll
            for (int n = 0; n < 2; ++n) bv[bj][n] = *(const f32x4*)(be + bj * HALF + 4 * n);
        float rwv[2][4];
#pragma unroll
        for (int ai = 0; ai < 2; ++ai)
#pragma unroll
            for (int m = 0; m < 4; ++m) rwv[ai][m] = rw[row0 + ai * HALF + m * 16] * 32.0f;
#pragma unroll
        for (int ai = 0; ai < 2; ++ai)
#pragma unroll
            for (int m = 0; m < 4; ++m) { const int row = row0 + ai * HALF + m * 16; const float w_ = rwv[ai][m];
#pragma unroll
                for (int bj = 0; bj < 2; ++bj) { const f32x4 v0 = (acc[ai][bj][m][0] * dq + bv[bj][0]) * w_, v1 = (acc[ai][bj][m][1] * dq + bv[bj][1]) * w_;
                    u32x2 w; w.x = cvt4_fp8(v0[0], v0[1], v0[2], v0[3]); w.y = cvt4_fp8(v1[0], v1[1], v1[2], v1[3]);
                    *(u32x2*)(y + (size_t)row * 1024 + col0 + bj * HALF) = w; } }
    }
};

template <bool OUT8> struct EpiGateFused {
    static constexpr bool PERM = true, AFTER_DRAIN = false, HAS_MID = true;
    const bf16_t* gc; const bf16_t* gh; bf16_t* out; float dq;
    __device__ __forceinline__ void mid(f32x4 (&acc)[2][2][4][2], const Unit& u, int wr, int wc, int fr, int fq) const {
        const int row0 = u.pm * BM + wr * 64 + fr, col0 = u.pn * BM + wc * 32 + 8 * fq;
#pragma unroll
        for (int ai = 0; ai < 2; ++ai)
#pragma unroll
            for (int m = 0; m < 4; ++m) { const size_t o = (size_t)(row0 + ai * HALF + m * 16) * 1024 + col0;
#pragma unroll
                for (int bj = 0; bj < 2; ++bj) { const u32x4 a = *(const u32x4*)(gc + o + bj * HALF), b = *(const u32x4*)(gh + o + bj * HALF);
                    const unsigned aw[4] = {a.x, a.y, a.z, a.w}, bw[4] = {b.x, b.y, b.z, b.w};
#pragma unroll
                    for (int q = 0; q < 4; ++q) { const float r0 = (1.0f + __expf(-blo(bw[q]))) * __builtin_amdgcn_rcpf(1.0f + __expf(-blo(aw[q]))), r1 = (1.0f + __expf(-bhi(bw[q]))) * __builtin_amdgcn_rcpf(1.0f + __expf(-bhi(aw[q])));
                        acc[ai][bj][m][q >> 1][(2 * q) & 3] *= r0; acc[ai][bj][m][q >> 1][(2 * q + 1) & 3] *= r1; } } }
    }
    __device__ __forceinline__ void operator()(const f32x4 (&acc)[2][2][4][2], const Unit& u, int wr, int wc, int fr, int fq) const {
        const int row0 = u.pm * BM + wr * 64 + fr, col0 = u.pn * BM + wc * 32 + 8 * fq;
#pragma unroll
        for (int ai = 0; ai < 2; ++ai) {
            u32x4 gw[4][2];
#pragma unroll
            for (int m = 0; m < 4; ++m)
#pragma unroll
                for (int bj = 0; bj < 2; ++bj) gw[m][bj] = *(const u32x4*)(gh + (size_t)(row0 + ai * HALF + m * 16) * 1024 + col0 + bj * HALF);
#pragma unroll
            for (int m = 0; m < 4; ++m) { const size_t o = (size_t)(row0 + ai * HALF + m * 16) * 1024 + col0;
#pragma unroll
                for (int bj = 0; bj < 2; ++bj) { const u32x4 g = gw[m][bj]; f32x4 v0 = acc[ai][bj][m][0], v1 = acc[ai][bj][m][1];
                    v0[0] *= sigm(blo(g.x)); v0[1] *= sigm(bhi(g.x)); v0[2] *= sigm(blo(g.y)); v0[3] *= sigm(bhi(g.y));
                    v1[0] *= sigm(blo(g.z)); v1[1] *= sigm(bhi(g.z)); v1[2] *= sigm(blo(g.w)); v1[3] *= sigm(bhi(g.w));
                    if (OUT8) { const float s_ = dq * 32.0f; u32x2 w; w.x = cvt4_fp8(v0[0] * s_, v0[1] * s_, v0[2] * s_, v0[3] * s_); w.y = cvt4_fp8(v1[0] * s_, v1[1] * s_, v1[2] * s_, v1[3] * s_);
                                *(u32x2*)((unsigned char*)out + o + bj * HALF) = w; }
                    else { u32x4 w; w.x = cvt_pk_bf16(v0[0] * dq, v0[1] * dq); w.y = cvt_pk_bf16(v0[2] * dq, v0[3] * dq); w.z = cvt_pk_bf16(v1[0] * dq, v1[1] * dq); w.w = cvt_pk_bf16(v1[2] * dq, v1[3] * dq);
                           *(u32x4*)(out + o + bj * HALF) = w; } } }
        }
    }
};

template <class T, class = void> struct has_mid { static constexpr bool value = false; };
template <class T> struct has_mid<T, decltype((void)T::HAS_MID)> { static constexpr bool value = true; };
template <class Epi, class Sched, bool ALIGN_EPI = false, bool SP2 = false, bool GATHER = false, int FP8 = 0  >
__device__ __forceinline__ void gemm_phase(PG8_LAS unsigned char* lds, const Gemm g, const Sched& S, const Epi& E, const int wave_id, const PG8_LAS unsigned short* gtab = nullptr) {
    typedef int i32x4 __attribute__((ext_vector_type(4))); typedef int i32x8 __attribute__((ext_vector_type(8)));
    static_assert(!GATHER || SP2, "GATHER needs the SP2 loop");
    int lane = (int)__builtin_amdgcn_mbcnt_hi(~0u, __builtin_amdgcn_mbcnt_lo(~0u, 0u)); asm volatile("" : "+v"(lane));
    const int wid = wave_id, tid = wid * 64 + lane, wr = wid >> 2, wc = wid & 3, fr = lane & 15, fq = lane >> 4;
    const int K = g.K, nt = K / BK;
    unsigned voffA[2], voffB[2];
#pragma unroll
    for (int i = 0; i < 2; ++i) { int R, C; stage_rc(tid * 16 + i * 8192, R, C); const int Rb = Epi::PERM ? ((R & ~31) + perm32(R & 31)) : R;
        voffA[i] = (unsigned)(R * K + C) * 2u; voffB[i] = (unsigned)(Rb * K + C) * 2u; }
    unsigned vA0[2] = {0u, 0u}, vA1[2] = {0u, 0u}, xA0[2] = {0u, 0u}, xA1[2] = {0u, 0u};
#define PG8_GLOAD(d0, d1, ui_) do { int tz_ = wid * 64 + (int)__builtin_amdgcn_mbcnt_hi(~0u, __builtin_amdgcn_mbcnt_lo(~0u, 0u)); asm volatile("" : "+v"(tz_)); _Pragma("unroll") for (int _i = 0; _i < 2; ++_i) { int R_, C_; stage_rc(tz_ * 16 + _i * 8192, R_, C_); \
        d0[_i] = (unsigned)gtab[256 * (ui_) + R_] * (unsigned)(K * 2) + (unsigned)C_ * 2u; d1[_i] = (unsigned)gtab[256 * (ui_) + 128 + R_] * (unsigned)(K * 2) + (unsigned)C_ * 2u; } } while (0)
    const unsigned kstep = (unsigned)(BK * 2);
    const unsigned hstep = (unsigned)HALF * K * 2;
    const unsigned tstep = 2 * hstep;
    const __amdgpu_buffer_rsrc_t rsA = __builtin_amdgcn_make_buffer_rsrc((void*)g.A, 0, 0x7fffffff, 0x00020000), rsB = __builtin_amdgcn_make_buffer_rsrc((void*)g.Bt, 0, 0x7fffffff, 0x00020000);
    const unsigned ldsw = (unsigned)wid * 1024u;
    const int aoff = lds_byte(wr * 64 + fr, fq * 8), boff = lds_byte(wc * 32 + fr, fq * 8);
#define PG8_SA(b, h) (((b) * 2 + (h)) * HTB)
#define PG8_SB(b, h) ((4 + (b) * 2 + (h)) * HTB)
#define PG8_STAGE(bufoff, rs, soff, voff) do { _Pragma("unroll") for (int _i = 0; _i < 2; ++_i) \
        __builtin_amdgcn_raw_ptr_buffer_load_lds(rs, (PG8_LAS void*)(lds + (bufoff) + ldsw + _i * 8192), 16, (int)(voff)[_i], (int)(soff), 0, 0); } while (0)
#define PG8_LDA(dst, b, h) do { if constexpr (FP8 == 1) { _Pragma("unroll") for (int m = 0; m < 4; ++m) dst##_8[m] = __builtin_shufflevector(*(const PG8_LAS i32x4*)(lds + PG8_SA(b, h) + aoff + m * 2048), *(const PG8_LAS i32x4*)(lds + PG8_SA(b, h) + aoff + m * 2048 + 1024), 0, 1, 2, 3, 4, 5, 6, 7); } \
        else { _Pragma("unroll") for (int m = 0; m < 4; ++m) _Pragma("unroll") for (int k = 0; k < 2; ++k) dst[m][k] = *(const PG8_LAS bf16x8*)(lds + PG8_SA(b, h) + aoff + m * 2048 + k * 1024); } } while (0)
#define PG8_LDB(dst, b, h) do { if constexpr (FP8 == 1) { _Pragma("unroll") for (int n = 0; n < 2; ++n) dst##_8[n] = __builtin_shufflevector(*(const PG8_LAS i32x4*)(lds + PG8_SB(b, h) + boff + n * 2048), *(const PG8_LAS i32x4*)(lds + PG8_SB(b, h) + boff + n * 2048 + 1024), 0, 1, 2, 3, 4, 5, 6, 7); } \
        else { _Pragma("unroll") for (int n = 0; n < 2; ++n) _Pragma("unroll") for (int k = 0; k < 2; ++k) dst[n][k] = *(const PG8_LAS bf16x8*)(lds + PG8_SB(b, h) + boff + n * 2048 + k * 1024); } } while (0)
#define PG8_MMA(ai, bj, At, Bt) do { __builtin_amdgcn_s_setprio(1); if constexpr (FP8 == 1) { _Pragma("unroll") for (int m = 0; m < 4; ++m) _Pragma("unroll") for (int n = 0; n < 2; ++n) \
        asm volatile("v_mfma_scale_f32_16x16x128_f8f6f4 %0, %1, %2, %0, %3, %3 op_sel_hi:[0,0,0]" : "+v"(acc[ai][bj][m][n]) : "v"(Bt##_8[n]), "v"(At##_8[m]), "v"(sc8));     \
        } else if constexpr (FP8 == 2) { _Pragma("unroll") for (int m = 0; m < 4; ++m) _Pragma("unroll") for (int n = 0; n < 2; ++n) _Pragma("unroll") for (int k = 0; k < 2; ++k) \
        acci[ai][bj][m][n] = __builtin_amdgcn_mfma_i32_16x16x64_i8(__builtin_bit_cast(i32x4, Bt[n][k]), __builtin_bit_cast(i32x4, At[m][k]), acci[ai][bj][m][n], 0, 0, 0); \
        } else { _Pragma("unroll") for (int m = 0; m < 4; ++m) _Pragma("unroll") for (int n = 0; n < 2; ++n) _Pragma("unroll") for (int k = 0; k < 2; ++k) \
        acc[ai][bj][m][n] = __builtin_amdgcn_mfma_f32_16x16x32_bf16(Bt[n][k], At[m][k], acc[ai][bj][m][n], 0, 0, 0); } __builtin_amdgcn_s_setprio(0); } while (0)
#define PG8_WAIT_V(n) asm volatile("s_waitcnt vmcnt(" #n ")" ::: "memory")
#define PG8_WAIT_L(n) asm volatile("s_waitcnt lgkmcnt(" #n ")" ::: "memory")
#define PG8_BAR __builtin_amdgcn_s_barrier()
#define PG8_SCHED __builtin_amdgcn_sched_barrier(0)
    Unit cur, nxt; int ui = 0;
    if (!S.next(0, cur)) return;
    f32x4 acc[2][2][4][2]; i32x4 acci[2][2][4][2];
#pragma unroll
    for (int a = 0; a < 2; ++a)
#pragma unroll
        for (int b = 0; b < 2; ++b)
#pragma unroll
            for (int m = 0; m < 4; ++m)
#pragma unroll
                for (int n = 0; n < 2; ++n) { acc[a][b][m][n] = (f32x4){0.f, 0.f, 0.f, 0.f}; acci[a][b][m][n] = (i32x4){0, 0, 0, 0}; }
    int sc8 = 0x7f7f7f7f; asm volatile("" : "+v"(sc8));
    bf16x8 At[4][2], B0[2][2], B1[2][2]; i32x8 At_8[4], B0_8[2], B1_8[2];
    unsigned cA = GATHER ? 0u : (unsigned)cur.pm * tstep, cB = (unsigned)cur.pn * tstep;
    S.a_ready(cur);
    if constexpr (GATHER) { PG8_GLOAD(vA0, vA1, 0); xA0[0] = vA0[0]; xA0[1] = vA0[1]; xA1[0] = vA1[0]; xA1[1] = vA1[1]; }
    if constexpr (SP2) {
        PG8_STAGE(PG8_SB(0, 0), rsB, cB, voffB); PG8_STAGE(PG8_SB(0, 1), rsB, cB + hstep, voffB);
        if constexpr (GATHER) { PG8_STAGE(PG8_SA(0, 0), rsA, cA, vA0); PG8_STAGE(PG8_SA(0, 1), rsA, cA, vA1); } else { PG8_STAGE(PG8_SA(0, 0), rsA, cA, voffA); PG8_STAGE(PG8_SA(0, 1), rsA, cA + hstep, voffA); }
        if (wr == 1) PG8_BAR;
        PG8_WAIT_V(2); PG8_BAR;
        PG8_STAGE(PG8_SB(1, 0), rsB, cB + kstep, voffB); if constexpr (GATHER) { PG8_STAGE(PG8_SA(1, 0), rsA, cA + kstep, vA0); } else { PG8_STAGE(PG8_SA(1, 0), rsA, cA + kstep, voffA); } PG8_STAGE(PG8_SB(1, 1), rsB, cB + hstep + kstep, voffB);
        PG8_WAIT_V(6); PG8_BAR;
    } else {
        PG8_STAGE(PG8_SB(0, 0), rsB, cB, voffB); PG8_STAGE(PG8_SA(0, 0), rsA, cA, voffA); PG8_STAGE(PG8_SB(0, 1), rsB, cB + hstep, voffB); PG8_STAGE(PG8_SA(0, 1), rsA, cA + hstep, voffA);
        if (wr == 1) PG8_BAR;
        PG8_WAIT_V(4); PG8_BAR;
        PG8_STAGE(PG8_SB(1, 0), rsB, cB + kstep, voffB); PG8_STAGE(PG8_SA(1, 0), rsA, cA + kstep, voffA); PG8_STAGE(PG8_SB(1, 1), rsB, cB + hstep + kstep, voffB);
        PG8_WAIT_V(6); PG8_BAR;
    }
    for (;;) {
        const bool has_next = S.next(ui + 1, nxt);
        const unsigned nA = GATHER ? cA : (has_next ? (unsigned)nxt.pm * tstep : cA), nB = has_next ? (unsigned)nxt.pn * tstep : cB;
        for (int t = 0; t < nt; t += 2) {
            const bool last = (t == nt - 2);
            const unsigned a1 = cA + (unsigned)(t + 1) * kstep;
            const unsigned a2 = last ? nA : cA + (unsigned)(t + 2) * kstep, b2 = last ? nB : cB + (unsigned)(t + 2) * kstep;
            const unsigned a3 = a2 + kstep, b3 = b2 + kstep;
            if (last && has_next) S.a_ready(nxt);
            if constexpr (has_mid<Epi>::value) { if (t == nt / 2) { int l3_ = (int)__builtin_amdgcn_mbcnt_hi(~0u, __builtin_amdgcn_mbcnt_lo(~0u, 0u)); asm volatile("" : "+v"(l3_)); E.mid(acc, cur, wr, wc, l3_ & 15, l3_ >> 4); } }
            if constexpr (GATHER) { if (last && has_next) { PG8_GLOAD(xA0, xA1, ui + 1); } }
            if constexpr (SP2) {
            PG8_LDB(B0, 0, 0); PG8_LDB(B1, 0, 1); PG8_SCHED; PG8_LDA(At, 0, 0); if constexpr (GATHER) { PG8_STAGE(PG8_SA(1, 1), rsA, a1, vA1); } else { PG8_STAGE(PG8_SA(1, 1), rsA, a1 + hstep, voffA); }
            PG8_WAIT_V(8); PG8_WAIT_L(0); PG8_BAR; PG8_MMA(0, 0, At, B0); PG8_MMA(0, 1, At, B1); PG8_BAR; PG8_SCHED;
            PG8_LDA(At, 0, 1); PG8_STAGE(PG8_SB(0, 0), rsB, b2, voffB); PG8_STAGE(PG8_SB(0, 1), rsB, b2 + hstep, voffB); if constexpr (GATHER) { PG8_STAGE(PG8_SA(0, 0), rsA, a2, xA0); } else { PG8_STAGE(PG8_SA(0, 0), rsA, a2, voffA); }
            PG8_WAIT_V(8); PG8_WAIT_L(0); PG8_BAR; PG8_MMA(1, 0, At, B0); PG8_MMA(1, 1, At, B1); PG8_BAR; PG8_SCHED;
            PG8_LDB(B0, 1, 0); PG8_LDB(B1, 1, 1); PG8_SCHED; PG8_LDA(At, 1, 0); if constexpr (GATHER) { PG8_STAGE(PG8_SA(0, 1), rsA, a2, xA1); } else { PG8_STAGE(PG8_SA(0, 1), rsA, a2 + hstep, voffA); }
            PG8_WAIT_V(8); PG8_WAIT_L(0); PG8_BAR; PG8_MMA(0, 0, At, B0); PG8_MMA(0, 1, At, B1); PG8_BAR; PG8_SCHED;
            PG8_LDA(At, 1, 1); PG8_STAGE(PG8_SB(1, 0), rsB, b3, voffB); PG8_STAGE(PG8_SB(1, 1), rsB, b3 + hstep, voffB); if constexpr (GATHER) { PG8_STAGE(PG8_SA(1, 0), rsA, a3, xA0); } else { PG8_STAGE(PG8_SA(1, 0), rsA, a3, voffA); }
            PG8_WAIT_V(8); PG8_WAIT_L(0); PG8_BAR; PG8_MMA(1, 0, At, B0); PG8_MMA(1, 1, At, B1); PG8_BAR; PG8_SCHED;
            } else {
            PG8_LDB(B0, 0, 0); PG8_SCHED; PG8_LDA(At, 0, 0); PG8_STAGE(PG8_SA(1, 1), rsA, a1 + hstep, voffA);
            PG8_WAIT_L(8); PG8_BAR; PG8_WAIT_L(0); PG8_MMA(0, 0, At, B0); PG8_BAR; PG8_SCHED;
            PG8_LDB(B1, 0, 1); PG8_STAGE(PG8_SB(0, 0), rsB, b2, voffB);
            PG8_BAR; PG8_WAIT_L(0); PG8_MMA(0, 1, At, B1); PG8_BAR;
            PG8_LDA(At, 0, 1); PG8_STAGE(PG8_SA(0, 0), rsA, a2, voffA);
            PG8_BAR; PG8_WAIT_L(0); PG8_MMA(1, 0, At, B0); PG8_BAR; PG8_SCHED;
            PG8_STAGE(PG8_SB(0, 1), rsB, b2 + hstep, voffB);
            PG8_WAIT_V(6); PG8_BAR; PG8_MMA(1, 1, At, B1); PG8_BAR;
            PG8_LDB(B0, 1, 0); PG8_SCHED; PG8_LDA(At, 1, 0); PG8_STAGE(PG8_SA(0, 1), rsA, a2 + hstep, voffA);
            PG8_WAIT_L(8); PG8_BAR; PG8_WAIT_L(0); PG8_MMA(0, 0, At, B0); PG8_BAR; PG8_SCHED;
            PG8_LDB(B1, 1, 1); PG8_STAGE(PG8_SB(1, 0), rsB, b3, voffB);
            PG8_BAR; PG8_WAIT_L(0); PG8_MMA(0, 1, At, B1); PG8_BAR;
            PG8_LDA(At, 1, 1); PG8_STAGE(PG8_SA(1, 0), rsA, a3, voffA);
            PG8_BAR; PG8_WAIT_L(0); PG8_MMA(1, 0, At, B0); PG8_BAR; PG8_SCHED;
            PG8_STAGE(PG8_SB(1, 1), rsB, b3 + hstep, voffB);
            PG8_WAIT_V(6); PG8_BAR; PG8_MMA(1, 1, At, B1); PG8_BAR;
            }
        }
        if constexpr (ALIGN_EPI) { if (wr == 0) PG8_BAR; }
        if constexpr (FP8 == 2) { _Pragma("unroll") for (int a = 0; a < 2; ++a) _Pragma("unroll") for (int bq = 0; bq < 2; ++bq) _Pragma("unroll") for (int m = 0; m < 4; ++m) _Pragma("unroll") for (int n = 0; n < 2; ++n) acc[a][bq][m][n] = __builtin_convertvector(acci[a][bq][m][n], f32x4); }
        if constexpr (FP8 == 1) asm volatile("s_nop 15\n\ts_nop 15" ::: "memory");
        if constexpr (!Epi::AFTER_DRAIN) { int l2_ = (int)__builtin_amdgcn_mbcnt_hi(~0u, __builtin_amdgcn_mbcnt_lo(~0u, 0u)); asm volatile("" : "+v"(l2_));
            E(acc, cur, wr, wc, l2_ & 15, l2_ >> 4); S.done(cur); }
        if (!has_next) break;
#pragma unroll
        for (int a = 0; a < 2; ++a)
#pragma unroll
            for (int b = 0; b < 2; ++b)
#pragma unroll
                for (int m = 0; m < 4; ++m)
#pragma unroll
                    for (int n = 0; n < 2; ++n) { acc[a][b][m][n] = (f32x4){0.f, 0.f, 0.f, 0.f}; acci[a][b][m][n] = (i32x4){0, 0, 0, 0}; }
        cur = nxt; cA = nA; cB = nB; ++ui;
        if constexpr (GATHER) { vA0[0] = xA0[0]; vA0[1] = xA0[1]; vA1[0] = xA1[0]; vA1[1] = xA1[1]; }
        if constexpr (ALIGN_EPI) { if (wr == 1) PG8_BAR; }
    }
    PG8_WAIT_V(0);
    if constexpr (!ALIGN_EPI) { if (wr == 0) PG8_BAR; }
    PG8_BAR;
    if constexpr (Epi::AFTER_DRAIN) { E.fused(acc, cur, wr, wc, fr, fq, lds, wid, lane); S.done(cur); }
#undef PG8_GLOAD
#undef PG8_SA
#undef PG8_SB
#undef PG8_STAGE
#undef PG8_LDA
#undef PG8_LDB
#undef PG8_MMA
#undef PG8_WAIT_V
#undef PG8_WAIT_L
#undef PG8_BAR
#undef PG8_SCHED
}
}
#define XB_TMO      128
#define XB_XCNT(j)  (256  + 64 * (j))
#define XB_XSUB(j)  (1280 + 64 * (j))
#define XB_XGEN(j)  (2304 + 64 * (j))
#define XB_TOP      3328
#define XB_TOPGEN   3392
#define XCD_BAR_WORDS 3456
#define XB_SPIN_CAP (1u << 18)

__device__ __forceinline__ unsigned xb_ld(unsigned* p)              { return __hip_atomic_load(p, __ATOMIC_RELAXED, __HIP_MEMORY_SCOPE_AGENT); }
__device__ __forceinline__ unsigned xb_add(unsigned* p, unsigned v) { return __hip_atomic_fetch_add(p, v, __ATOMIC_RELAXED, __HIP_MEMORY_SCOPE_AGENT); }
__device__ __forceinline__ unsigned xb_xcc_id() { return (unsigned)__builtin_amdgcn_s_getreg((3 << 11) | 20) & 0xFu; }
#define XB_SPIN(cond, bar) do { unsigned _sp = 0; while (cond) { __builtin_amdgcn_s_sleep(1); \
    if ((++_sp & 255u) == 0u) { if (xb_ld(&(bar)[XB_TMO])) break; if (_sp > XB_SPIN_CAP) { atomicAdd(&(bar)[XB_TMO], 1u); break; } } } } while (0)

struct XcdBarrier {
    unsigned* bar; unsigned x;
    volatile LAS unsigned* st;
};

__device__ __forceinline__ XcdBarrier xcd_barrier_post(unsigned* bar, volatile LAS unsigned* st, const bool leader  ) {
    XcdBarrier b; b.bar = bar; b.x = xb_xcc_id(); b.st = st;
    if (leader) (void)xb_add(&bar[XB_XCNT(b.x)], 1u);
    return b;
}
__device__ __forceinline__ void xcd_barrier_complete(unsigned* bar, unsigned x, unsigned& nloc, unsigned& nx) {
    const unsigned G = gridDim.x * gridDim.y * gridDim.z;
    unsigned sum, cnt, mine, sp = 0u;
    for (;;) {
        sum = 0u; cnt = 0u; mine = 0u;
#pragma unroll
        for (unsigned j = 0; j < 16; ++j) { const unsigned c = xb_ld(&bar[XB_XCNT(j)]); sum += c; cnt += (c > 0u) ? 1u : 0u; mine = (j == x) ? c : mine; }
        if (sum == G) break;
        __builtin_amdgcn_s_sleep(1);
        if ((++sp & 255u) == 0u) { if (xb_ld(&bar[XB_TMO])) break; if (sp > XB_SPIN_CAP) { atomicAdd(&bar[XB_TMO], 1u); break; } }
    }
    nloc = mine > 0u ? mine : 1u; nx = cnt > 0u ? cnt : 1u;
}

__device__ __forceinline__ void xcd_barrier(const XcdBarrier& b, const bool leader  ) {
    asm volatile("s_waitcnt vmcnt(0)" ::: "memory");
    __syncthreads();
    if (leader) {
        unsigned* bar = b.bar;
        __builtin_amdgcn_s_waitcnt(0);
        unsigned nloc = b.st[0], nx = b.st[1];
        if (nloc == 0u) { xcd_barrier_complete(bar, b.x, nloc, nx); b.st[0] = nloc; b.st[1] = nx; }
        const unsigned old = xb_add(&bar[XB_XSUB(b.x)], 1u);
        const unsigned gen = old / nloc;
        if (old + 1u == (gen + 1u) * nloc) {
            __builtin_amdgcn_fence(__ATOMIC_RELEASE, "agent");
            asm volatile("s_waitcnt vmcnt(0)" ::: "memory");
            const unsigned og = xb_add(&bar[XB_TOP], 1u);
            const unsigned tg = og / nx;
            if (og + 1u == (tg + 1u) * nx) xb_add(&bar[XB_TOPGEN], 1u);
            else XB_SPIN(xb_ld(&bar[XB_TOPGEN]) == tg, bar);
            __builtin_amdgcn_fence(__ATOMIC_ACQUIRE, "agent");
            xb_add(&bar[XB_XGEN(b.x)], 1u);
            asm volatile("s_waitcnt vmcnt(0)" ::: "memory");
        } else {
            XB_SPIN(xb_ld(&bar[XB_XGEN(b.x)]) == gen, bar);
            __builtin_amdgcn_fence(__ATOMIC_ACQUIRE, "agent");
            asm volatile("s_waitcnt vmcnt(0)" ::: "memory");
        }
    }
    __syncthreads();
}

#ifndef MIX_FP8
#define MIX_FP8 1
#endif
#ifndef RES_FP8
#define RES_FP8 1
#endif
#ifndef P_INT8
#define P_INT8 1
#endif
#ifndef P_FP8_MASK
#define P_FP8_MASK 0xFFFFFFFFu
#endif =======================================================
struct Ctx { LAS unsigned char* lds; int tid, lane, wave, vcu, G; };

__device__ __forceinline__ void transpose_load64(const float* W, int ldw, int k0, int n0, LAS float* scr, int lane) {
#pragma unroll 8
    for (int i = 0; i < 16; ++i) { const int kk = 4 * i + (lane >> 4), nn = 4 * (lane & 15); const f32x4 v = *(const f32x4*)(W + (size_t)(k0 + kk) * ldw + n0 + nn);
        LAS float* d = scr + kk * 65 + nn; d[0] = v.x; d[1] = v.y; d[2] = v.z; d[3] = v.w; }
    LDS_WAIT();
}
__device__ __forceinline__ void transpose_item(const float* W, int ldw, int K, bf16_t* dst, int k0, int n0, LAS float* scr, int lane) {
    transpose_load64(W, ldw, k0, n0, scr, lane);
    const int c = lane & 7;
#pragma unroll
    for (int j = 0; j < 8; ++j) { const int n = (lane >> 3) + 8 * j; const LAS float* s = scr + (8 * c) * 65 + n;
        u32x4 o; o.x = pk2(s[0 * 65], s[1 * 65]); o.y = pk2(s[2 * 65], s[3 * 65]); o.z = pk2(s[4 * 65], s[5 * 65]); o.w = pk2(s[6 * 65], s[7 * 65]);
        *(u32x4*)(dst + (size_t)n * K + k0 + 8 * c) = o; }
    LDS_WAIT();
}
__device__ __forceinline__ void transpose_item8(const float* W, int ldw, int K, unsigned char* dst, int k0, int n0, float scale, LAS float* scr, int lane) {
    (void)scr;
    const int kc = lane & 3, nq = lane >> 2;
    const float* s = W + (size_t)(k0 + 16 * kc) * ldw + n0 + 4 * nq;
    f32x4 v[16];
#pragma unroll
    for (int i = 0; i < 16; ++i) v[i] = *(const f32x4*)(s + (size_t)i * ldw);
#pragma unroll
    for (int j = 0; j < 4; ++j) {
        u32x4 o; o.x = cvt4_fp8(v[0][j] * scale, v[1][j] * scale, v[2][j] * scale, v[3][j] * scale); o.y = cvt4_fp8(v[4][j] * scale, v[5][j] * scale, v[6][j] * scale, v[7][j] * scale);
        o.z = cvt4_fp8(v[8][j] * scale, v[9][j] * scale, v[10][j] * scale, v[11][j] * scale); o.w = cvt4_fp8(v[12][j] * scale, v[13][j] * scale, v[14][j] * scale, v[15][j] * scale);
        *(u32x4*)(dst + (size_t)(4 * nq + j) * K + k0 + 16 * kc) = o; }
}

template <int PART>
__device__ __forceinline__ void ph_prologue(const Ctx& X, const float* c, const float* w_ada, const float* b_ada, float* mod,
                                            const float* w_in, const float* w_conv_out, const float* w_hgrn_out, const float* w_out, const float* w1, const float* w2, unsigned char* ws) {
    if (PART == 0 && X.vcu < NMOD / 32) {
        LAS float* ca = (LAS float*)X.lds;
        LAS float* red = (LAS float*)(X.lds + 16384);
        for (int i = X.tid; i < 4096; i += 512) { const float v = c[i]; ca[i] = v * sigmoidf_(v); }
        __syncthreads();
        const int jj = X.tid & 31, kp = X.tid >> 5, j = X.vcu * 32 + jj;
        float a0 = 0.f, a1 = 0.f, a2 = 0.f, a3 = 0.f;
#pragma unroll 16
        for (int i = kp * 64; i < kp * 64 + 64; ++i) { const float w = w_ada[(size_t)i * NMOD + j]; a0 += ca[i] * w; a1 += ca[1024 + i] * w; a2 += ca[2048 + i] * w; a3 += ca[3072 + i] * w; }
        red[(kp * 4 + 0) * 32 + jj] = a0; red[(kp * 4 + 1) * 32 + jj] = a1; red[(kp * 4 + 2) * 32 + jj] = a2; red[(kp * 4 + 3) * 32 + jj] = a3;
        __syncthreads();
        if (X.tid < 128) { const int b = X.tid >> 5; float r = b_ada[j];
#pragma unroll
            for (int q = 0; q < 16; ++q) r += red[(q * 4 + b) * 32 + jj];
            mod[(size_t)b * NMOD + j] = r; }
        __syncthreads();
    }
    LAS float* scr = (LAS float*)(X.lds + X.wave * 16640);
    const int gw = X.vcu * 8 + X.wave, NGW = X.G * 8;
    constexpr int I_IN = 16 * 128, I_SQ = 16 * 16, I_W1 = 32 * 16 * 32, I_W2 = 32 * 16 * 16, NITEMS = I_IN + 3 * I_SQ + I_W1 + I_W2;
    constexpr int I_DENSE = I_IN + 3 * I_SQ;
    for (int it = (PART == 0 ? (P_INT8 ? I_IN : 0) : I_DENSE) + gw; it < (PART == 0 ? I_DENSE : NITEMS); it += NGW) {
        int r = it;
        if (r < I_IN) { const int kb = r >> 7, nb = r & 127, n0 = 64 * nb;
            const int rho0 = (n0 < 2048) ? 256 * ((n0 & 1023) >> 7) + 128 * (n0 >> 10) + (n0 & 127) : n0;
            if ((P_FP8_MASK >> (rho0 >> 8)) & 1u) transpose_item8(w_in, 8192, 1024, (unsigned char*)(ws + WS_WIN8) + (size_t)rho0 * 1024, 64 * kb, n0, 256.0f, scr, X.lane);
            else transpose_item(w_in, 8192, 1024, (bf16_t*)(ws + WS_WIN) + (size_t)rho0 * 1024, 64 * kb, n0, scr, X.lane);
            continue; } r -= I_IN;
        if (r < 3 * I_SQ) { const int which = r / I_SQ, q = r % I_SQ, kb = q >> 4, nb = q & 15;
            const float* W = which == 0 ? w_conv_out : (which == 1 ? w_hgrn_out : w_out);
            if (which == 2) { if (RES_FP8) transpose_item8(W, 1024, 1024, (unsigned char*)(ws + WS_WO) + (size_t)(64 * nb) * 1024, 64 * kb, 64 * nb, 256.0f, scr, X.lane);
                              else transpose_item(W, 1024, 1024, (bf16_t*)(ws + WS_WO) + (size_t)(64 * nb) * 1024, 64 * kb, 64 * nb, scr, X.lane); }
            else if (MIX_FP8) transpose_item8(W, 1024, 2048, (unsigned char*)(ws + WS_WC) + (size_t)(64 * nb) * 2048 + which * 1024, 64 * kb, 64 * nb, 256.0f, scr, X.lane);
            else transpose_item(W, 1024, 2048, (bf16_t*)(ws + WS_WC) + (size_t)(64 * nb) * 2048 + which * 1024, 64 * kb, 64 * nb, scr, X.lane);
            continue; } r -= 3 * I_SQ;
        if (r < I_W1) { const int e = r >> 9, q = r & 511, kb = q >> 5, nb = q & 31, n0 = 64 * nb;
            const int rho0 = (n0 < 1024) ? 256 * (n0 >> 7) + (n0 & 127) : 256 * ((n0 - 1024) >> 7) + 128 + ((n0 - 1024) & 127);
            transpose_item8(w1 + (size_t)e * 1024 * 2048, 2048, 1024, (unsigned char*)(ws + WS_W1) + ((size_t)e * 2048 + rho0) * 1024, 64 * kb, n0, 256.0f, scr, X.lane); continue; } r -= I_W1;
        { const int e = r >> 8, q = r & 255, kb = q >> 4, nb = q & 15;
            transpose_item8(w2 + (size_t)e * 1024 * 1024, 1024, 1024, (unsigned char*)(ws + WS_W2) + ((size_t)e * 1024 + 64 * nb) * 1024, 64 * kb, 64 * nb, 256.0f, scr, X.lane); }
    }
    __syncthreads();
}

__device__ __forceinline__ void ph_norm_mod(const Ctx& X, const float* x, const float* g, const float* mod, int sh_off, int sc_off, bf16_t* out, unsigned char* out8, float* hsc) {
    for (int t = X.vcu * 8 + X.wave; t < T; t += X.G * 8) {
        const int b = t / SEQ, lane = X.lane;
        const f32x4* xr = (const f32x4*)(x + (size_t)t * D) + lane;
        f32x4 v[4]; float ss = 0.f;
#pragma unroll
        for (int j = 0; j < 4; ++j) { v[j] = xr[64 * j]; ss += (v[j].x * v[j].x + v[j].y * v[j].y) + (v[j].z * v[j].z + v[j].w * v[j].w); }
        const float r = rsqrtf(wave_sum(ss) * (1.0f / D) + EPS);
        const float* sh = mod + (size_t)b * NMOD + sh_off; const float* sc = mod + (size_t)b * NMOD + sc_off;
        float am = 0.f;
#pragma unroll
        for (int j = 0; j < 4; ++j) {
            const int col = 4 * (lane + 64 * j);
            const f32x4 gg = *(const f32x4*)(g + col), s1 = *(const f32x4*)(sc + col), s0 = *(const f32x4*)(sh + col);
            v[j] = v[j] * r * gg * (s1 + 1.0f) + s0;
            am = fmaxf(fmaxf(am, fmaxf(fabsf(v[j].x), fabsf(v[j].y))), fmaxf(fabsf(v[j].z), fabsf(v[j].w)));
        }
        if (P_INT8) {
#pragma unroll
            for (int o = 1; o < 64; o <<= 1) am = fmaxf(am, __shfl_xor(am, o));
            am = fmaxf(am, 1e-20f); const float qs = 127.0f / am;
            if (lane == 0) hsc[t] = am * (1.0f / 127.0f);
#pragma unroll
            for (int j = 0; j < 4; ++j) *(unsigned*)(out8 + (size_t)t * D + 4 * (lane + 64 * j)) = q4_i8(v[j].x * qs, v[j].y * qs, v[j].z * qs, v[j].w * qs);
        } else {
#pragma unroll
            for (int j = 0; j < 4; ++j) { const int col = 4 * (lane + 64 * j); const f32x4 y = v[j];
                if (P_FP8_MASK != 0xFFFFFFFFu) { u32x2 w; w.x = pk2(y.x, y.y); w.y = pk2(y.z, y.w); *(u32x2*)(out + (size_t)t * D + col) = w; }
                if (P_FP8_MASK != 0u) *(unsigned*)(out8 + (size_t)t * D + col) = cvt4_fp8(y.x * 16.0f, y.y * 16.0f, y.z * 16.0f, y.w * 16.0f); }
        }
    }
}

__device__ __forceinline__ void ph_win_i8(const Ctx& X, const float* w_in, unsigned char* ws) {
    LAS float* part = (LAS float*)(X.lds + 8 * 8704);
    LAS float* cmax = part + 512;
    float* wsc = (float*)(ws + WS_WSC); unsigned char* wt = ws + WS_WIN8;
    const int tid = X.tid, c = tid & 31, kq = tid >> 5;
    for (int cb = X.vcu; cb < 256; cb += X.G) {
        const int n0 = 32 * cb;
        const int rho0 = (n0 < 2048) ? 256 * ((n0 & 1023) >> 7) + 128 * (n0 >> 10) + (n0 & 127) : n0;
        float v[64]; const float* p_ = w_in + (size_t)(kq * 64) * 8192 + n0 + c;
#pragma unroll
        for (int i = 0; i < 64; ++i) v[i] = p_[(size_t)i * 8192];
        float m = 0.f;
#pragma unroll
        for (int i = 0; i < 64; ++i) m = fmaxf(m, fabsf(v[i]));
        part[kq * 32 + c] = m;
        __syncthreads();
        if (tid < 32) { float m2 = 0.f;
#pragma unroll
            for (int q = 0; q < 16; ++q) m2 = fmaxf(m2, part[q * 32 + tid]);
            m2 = fmaxf(m2, 1e-30f); cmax[tid] = m2; wsc[rho0 + tid] = m2 * (1.0f / 127.0f); }
        __syncthreads();
        const float qs = 127.0f / cmax[c];
        unsigned char* d = wt + (size_t)(rho0 + c) * 1024 + kq * 64;
#pragma unroll
        for (int q = 0; q < 4; ++q) { u32x4 o;
            o.x = q4_i8(v[16 * q + 0] * qs, v[16 * q + 1] * qs, v[16 * q + 2] * qs, v[16 * q + 3] * qs); o.y = q4_i8(v[16 * q + 4] * qs, v[16 * q + 5] * qs, v[16 * q + 6] * qs, v[16 * q + 7] * qs);
            o.z = q4_i8(v[16 * q + 8] * qs, v[16 * q + 9] * qs, v[16 * q + 10] * qs, v[16 * q + 11] * qs); o.w = q4_i8(v[16 * q + 12] * qs, v[16 * q + 13] * qs, v[16 * q + 14] * qs, v[16 * q + 15] * qs);
            *(u32x4*)(d + 16 * q) = o; }
        __syncthreads();
    }
}

typedef float f32x2 __attribute__((ext_vector_type(2)));
__device__ __forceinline__ void ph_conv(const Ctx& X, const bf16_t* pU, const float* dw, const float* dwb, const float* lng, const float* lnb, bf16_t* uc) {
    LAS float* sm = (LAS float*)X.lds;
    const int tid = X.tid, lane = X.lane, wid = X.wave, c0 = 2 * tid;
    float w[31][2];
#pragma unroll
    for (int j = 0; j < 31; ++j) { w[j][0] = dw[j * 1024 + c0]; w[j][1] = dw[j * 1024 + c0 + 1]; }
    const float bias0 = dwb[c0], bias1 = dwb[c0 + 1];
    unsigned raw[62];
#define CONV_LOAD(task_) do { const int b_ = (task_) >> 8, s0_ = ((task_) & 255) * 32; const bf16_t* q_ = pU + (size_t)(b_ * SEQ) * D + c0; \
        _Pragma("unroll") for (int i = 0; i < 62; ++i) { const int s_ = s0_ - 30 + i; raw[i] = (s_ >= 0) ? *(const unsigned*)(q_ + (size_t)s_ * D) : 0u; } } while (0)
    int task = X.vcu;
    if (task < T / 32) CONV_LOAD(task);
    for (; task < T / 32; task += X.G) {
        const int b = task >> 8, s0 = (task & 255) * 32;
#pragma unroll
        for (int st = 0; st < 4; ++st) {
            float u[38][2];
#pragma unroll
            for (int i = 0; i < 38; ++i) { u[i][0] = bflo(raw[8 * st + i]); u[i][1] = bfhi(raw[8 * st + i]); }
#pragma unroll
            for (int t = 0; t < 8; ++t) {
                float a0 = bias0, a1 = bias1;
#pragma unroll
                for (int j = 0; j < 31; ++j) { a0 += w[j][0] * u[t + j][0]; a1 += w[j][1] * u[t + j][1]; }
                *(LAS f32x2*)(sm + (8 * st + t) * 1024 + c0) = (f32x2){a0, a1};
            }
        }
        if (task + X.G < T / 32) CONV_LOAD(task + X.G);
        __syncthreads();
#pragma unroll 2
        for (int i = 0; i < 4; ++i) {
            const int t = wid * 4 + i;
            f32x4 v[4]; float s = 0.f;
#pragma unroll
            for (int j = 0; j < 4; ++j) { v[j] = *(const LAS f32x4*)(sm + t * 1024 + 4 * (lane + 64 * j)); s += (v[j].x + v[j].y) + (v[j].z + v[j].w); }
            const float mean = wave_sum(s) * (1.0f / D); float q = 0.f;
#pragma unroll
            for (int j = 0; j < 4; ++j) { v[j] = v[j] - mean; q += (v[j].x * v[j].x + v[j].y * v[j].y) + (v[j].z * v[j].z + v[j].w * v[j].w); }
            const float rstd = rsqrtf(wave_sum(q) * (1.0f / D) + EPS);
#pragma unroll
            for (int j = 0; j < 4; ++j) {
                const int col = 4 * (lane + 64 * j);
                const f32x4 gg = *(const f32x4*)(lng + col), bb = *(const f32x4*)(lnb + col);
                f32x4 y = v[j] * rstd * gg + bb;
                y.x *= sigmoidf_(y.x); y.y *= sigmoidf_(y.y); y.z *= sigmoidf_(y.z); y.w *= sigmoidf_(y.w);
                u32x2 o; o.x = pk2(y.x, y.y); o.y = pk2(y.z, y.w);
                if (MIX_FP8) *(unsigned*)((unsigned char*)uc + (size_t)(b * SEQ + s0 + t) * (2 * D) + col) = cvt4_fp8(y.x * 16.0f, y.y * 16.0f, y.z * 16.0f, y.w * 16.0f);
                else *(u32x2*)(uc + (size_t)(b * SEQ + s0 + t) * (2 * D) + col) = o;
            }
        }
        __syncthreads();
    }
#undef CONV_LOAD
}

typedef short bf16x8 __attribute__((ext_vector_type(8)));
typedef short s16x4 __attribute__((ext_vector_type(4)));
constexpr int HG_QA = 0, HG_KA = 17408, HG_VR = 34816, HG_AB = 52224, HG_SPT = 61440, HG_O = 96256, HG_SEG = 130048;
constexpr size_t HM = (size_t)SEQ * 128;
__device__ __forceinline__ bf16x8 tr_frag(LAS unsigned char* base, int rs, int ks, int c16, int lane) {
    const int g = lane >> 4, q = (lane & 15) >> 2, p = lane & 3;
    LAS unsigned char* a = base + (32 * ks + 8 * g + q) * rs + (16 * c16 + 4 * p) * 2;
    const s16x4 lo = __builtin_amdgcn_ds_read_tr16_b64_v4i16((LAS s16x4*)a);
    const s16x4 hi = __builtin_amdgcn_ds_read_tr16_b64_v4i16((LAS s16x4*)(a + 4 * rs));
    return __builtin_shufflevector(lo, hi, 0, 1, 2, 3, 4, 5, 6, 7);
}
template <bool OUT>
__device__ __forceinline__ void ph_hgrn(const Ctx& X, int ntask, const bf16_t* pQ, const bf16_t* pF, const bf16_t* pI, const bf16_t* pG,
                                        const float* lb_param, const float* norm_g, const float* S0, float* dS, float* Dd, bf16_t* og) {
    LAS unsigned char* L = X.lds;
    LAS float* seg_s = (LAS float*)(L + HG_SEG);
    const int tid = X.tid, lane = X.lane, wave = X.wave, fr = lane & 15, fq = lane >> 4, wr = wave >> 1, wc = wave & 1;
    const int cp = tid & 63, seg = wave, tv = tid >> 3, vc = tid & 7;
    int idx = X.vcu; if (idx >= ntask) return;
    int ch = 0;
    unsigned zr[8], qr[8]; u32x4 vr0, vr1, gn0, gn1, gc0, gc1;
#define HG_LOAD(idx_, ch_) do { const int bh_ = (idx_) & 31, sc_ = (idx_) >> 5; const size_t tb_ = (size_t)bh_ * HM + (size_t)(sc_ * 256 + (ch_) * 64) * 128; \
        _Pragma("unroll") for (int i = 0; i < 8; ++i) { zr[i] = *(const unsigned*)(pF + tb_ + (size_t)(8 * seg + i) * 128 + 2 * cp); if (OUT) qr[i] = *(const unsigned*)(pQ + tb_ + (size_t)(8 * seg + i) * 128 + 2 * cp); } \
        { const u32x4* s_ = (const u32x4*)(pI + tb_ + (size_t)tv * 128 + vc * 16); vr0 = s_[0]; vr1 = s_[1]; } \
        if (OUT) { const u32x4* s_ = (const u32x4*)(pG + tb_ + (size_t)tv * 128 + vc * 16); gn0 = s_[0]; gn1 = s_[1]; } } while (0)
    HG_LOAD(idx, 0);
    float ngv[16];
    if (OUT) {
#pragma unroll
        for (int i = 0; i < 16; ++i) ngv[i] = norm_g[vc * 16 + i];
    }
    f32x4 S[8]; float oml0 = 0.f, oml1 = 0.f, gsum0 = 0.f, gsum1 = 0.f;
#pragma unroll 1
    for (;;) {
        const int sc = idx >> 5, bh = idx & 31, b = bh >> 3, h = bh & 7;
        if (ch == 0) {
            const int c0 = h * 128 + 2 * cp;
            oml0 = 1.0f - 1.0f / (1.0f + __expf(lb_param[1024 + c0] - lb_param[c0])); oml1 = 1.0f - 1.0f / (1.0f + __expf(lb_param[1025 + c0] - lb_param[c0 + 1]));
            gsum0 = 0.f; gsum1 = 0.f;
            if (OUT && sc > 0) { const float* s0 = S0 + (size_t)(bh * 32 + sc) * 16384;
#pragma unroll
                for (int vt = 0; vt < 8; ++vt)
#pragma unroll
                    for (int j = 0; j < 4; ++j) S[vt][j] = s0[(size_t)(16 * wave + fq * 4 + j) * 128 + vt * 16 + fr];
            } else {
#pragma unroll
                for (int vt = 0; vt < 8; ++vt) S[vt] = (f32x4){0.f, 0.f, 0.f, 0.f};
            }
        }
        float kk0[8], kk1[8], lf0[8], lf1[8], q0[8], q1[8];
        {
            float c0 = 0.f, c1 = 0.f;
#pragma unroll
            for (int i = 0; i < 8; ++i) {
                kk0[i] = oml0 * __builtin_amdgcn_rcpf(1.0f + __expf(bflo(zr[i]))); kk1[i] = oml1 * __builtin_amdgcn_rcpf(1.0f + __expf(bfhi(zr[i])));
                c0 += __builtin_amdgcn_logf(1.0f - kk0[i]); c1 += __builtin_amdgcn_logf(1.0f - kk1[i]); lf0[i] = c0; lf1[i] = c1;
                if (OUT) { q0[i] = bflo(qr[i]) * 0.08838834764831845f; q1[i] = bfhi(qr[i]) * 0.08838834764831845f; }
            }
            *(LAS f32x2*)(seg_s + seg * 128 + 2 * cp) = (f32x2){c0, c1};
        }
        if (OUT) { gc0 = gn0; gc1 = gn1; }
        const u32x4 vcur0 = vr0, vcur1 = vr1;
        __syncthreads();
        { LAS u32x4* d = (LAS u32x4*)(L + HG_VR + tv * 272 + vc * 32); d[0] = vcur0; d[1] = vcur1; }
        { int idx2 = idx, ch2 = ch + 1; if (ch2 == 4) { ch2 = 0; idx2 = idx + X.G; } if (idx2 < ntask) HG_LOAD(idx2, ch2); }
        {
            f32x2 ss[8];
#pragma unroll
            for (int s = 0; s < 8; ++s) ss[s] = *(const LAS f32x2*)(seg_s + s * 128 + 2 * cp);
            float off0 = 0.f, off1 = 0.f;
#pragma unroll
            for (int s = 0; s < 8; ++s) { off0 += (s < seg) ? ss[s].x : 0.f; off1 += (s < seg) ? ss[s].y : 0.f; }
            const float R0 = (ss[0].x + ss[1].x) + (ss[2].x + ss[3].x), R1 = (ss[0].y + ss[1].y) + (ss[2].y + ss[3].y);
            if (!OUT && seg == 0) { gsum0 += R0 + (ss[4].x + ss[5].x) + (ss[6].x + ss[7].x); gsum1 += R1 + (ss[4].y + ss[5].y) + (ss[6].y + ss[7].y); }
#pragma unroll
            for (int i = 0; i < 8; ++i) {
                const float G0 = off0 + lf0[i], G1 = off1 + lf1[i];
                const float ka0 = kk0[i] * __builtin_amdgcn_exp2f(fminf(R0 - G0, 115.0f)), ka1 = kk1[i] * __builtin_amdgcn_exp2f(fminf(R1 - G1, 115.0f));
                *(LAS unsigned*)(L + HG_KA + (8 * seg + i) * 272 + 4 * cp) = pk2(ka0, ka1);
                if (OUT) { const float qa0 = q0[i] * __builtin_amdgcn_exp2f(fminf(G0 - R0, 115.0f)), qa1 = q1[i] * __builtin_amdgcn_exp2f(fminf(G1 - R1, 115.0f));
                           *(LAS unsigned*)(L + HG_QA + (8 * seg + i) * 272 + 4 * cp) = pk2(qa0, qa1); }
            }
        }
        float eR[4], eL[4];
        {
            f32x4 r4 = (f32x4){0.f, 0.f, 0.f, 0.f}, l4 = (f32x4){0.f, 0.f, 0.f, 0.f};
#pragma unroll
            for (int s = 0; s < 4; ++s) { r4 += *(const LAS f32x4*)(seg_s + s * 128 + 16 * wave + 4 * fq); l4 += *(const LAS f32x4*)(seg_s + (s + 4) * 128 + 16 * wave + 4 * fq); }
#pragma unroll
            for (int j = 0; j < 4; ++j) { eR[j] = __builtin_amdgcn_exp2f(fmaxf(r4[j], -115.0f)); eL[j] = __builtin_amdgcn_exp2f(l4[j]); }
        }
#pragma unroll
        for (int vt = 0; vt < 8; ++vt) {
#pragma unroll
            for (int j = 0; j < 4; ++j) S[vt][j] *= eR[j];
            if (OUT) { u32x2 w; w.x = pk2(S[vt][0], S[vt][1]); w.y = pk2(S[vt][2], S[vt][3]);
                       *(LAS u32x2*)(L + HG_SPT + (vt * 16 + fr) * 272 + (16 * wave + 4 * fq) * 2) = w; }
        }
        __syncthreads();
        if (OUT) {
#pragma unroll
            for (int q2 = 0; q2 < 2; ++q2) {
                const int st = 2 * wc + q2;
                f32x4 acc = (f32x4){0.f, 0.f, 0.f, 0.f};
                if (st <= wr) {
#pragma unroll
                    for (int kq = 0; kq < 4; ++kq) {
                        const bf16x8 af = *(const LAS bf16x8*)(L + HG_KA + (st * 16 + fr) * 272 + kq * 64 + fq * 16);
                        const bf16x8 bq = *(const LAS bf16x8*)(L + HG_QA + (wr * 16 + fr) * 272 + kq * 64 + fq * 16);
                        acc = __builtin_amdgcn_mfma_f32_16x16x32_bf16(af, bq, acc, 0, 0, 0);
                    }
                    const int tt = wr * 16 + fr;
#pragma unroll
                    for (int j = 0; j < 4; ++j) { const int s_ = st * 16 + fq * 4 + j; acc[j] = (s_ <= tt) ? acc[j] : 0.f; }
                }
                u32x2 w; w.x = pk2(acc[0], acc[1]); w.y = pk2(acc[2], acc[3]);
                *(LAS u32x2*)(L + HG_AB + (wr * 16 + fr) * 144 + (st * 16 + fq * 4) * 2) = w;
            }
        }
        {
            bf16x8 aK[2];
#pragma unroll
            for (int ks = 0; ks < 2; ++ks) aK[ks] = tr_frag(L + HG_KA, 272, ks, wave, lane);
#pragma unroll
            for (int vt = 0; vt < 8; ++vt) {
#pragma unroll
                for (int ks = 0; ks < 2; ++ks) { const bf16x8 bv = tr_frag(L + HG_VR, 272, ks, vt, lane); S[vt] = __builtin_amdgcn_mfma_f32_16x16x32_bf16(aK[ks], bv, S[vt], 0, 0, 0); }
#pragma unroll
                for (int j = 0; j < 4; ++j) S[vt][j] *= eL[j];
            }
        }
        if (OUT) {
            __syncthreads();
            bf16x8 aA[2], aQ[4];
#pragma unroll
            for (int ks = 0; ks < 2; ++ks) aA[ks] = *(const LAS bf16x8*)(L + HG_AB + (wr * 16 + fr) * 144 + ks * 64 + fq * 16);
#pragma unroll
            for (int kq = 0; kq < 4; ++kq) aQ[kq] = *(const LAS bf16x8*)(L + HG_QA + (wr * 16 + fr) * 272 + kq * 64 + fq * 16);
#pragma unroll
            for (int n = 0; n < 4; ++n) {
                const int vt = wc * 4 + n;
                f32x4 o = (f32x4){0.f, 0.f, 0.f, 0.f};
#pragma unroll
                for (int ks = 0; ks < 2; ++ks) { const bf16x8 bv = tr_frag(L + HG_VR, 272, ks, vt, lane); o = __builtin_amdgcn_mfma_f32_16x16x32_bf16(aA[ks], bv, o, 0, 0, 0); }
#pragma unroll
                for (int kq = 0; kq < 4; ++kq) { const bf16x8 bs = *(const LAS bf16x8*)(L + HG_SPT + (vt * 16 + fr) * 272 + kq * 64 + fq * 16); o = __builtin_amdgcn_mfma_f32_16x16x32_bf16(aQ[kq], bs, o, 0, 0, 0); }
#pragma unroll
                for (int j = 0; j < 4; ++j) *(LAS float*)(L + HG_O + (wr * 16 + fq * 4 + j) * 528 + (vt * 16 + fr) * 4) = o[j];
            }
            __syncthreads();
            {
                f32x4 ov[4]; float ssq = 0.f;
#pragma unroll
                for (int i = 0; i < 4; ++i) { ov[i] = *(const LAS f32x4*)(L + HG_O + tv * 528 + vc * 64 + i * 16); ssq += (ov[i].x * ov[i].x + ov[i].y * ov[i].y) + (ov[i].z * ov[i].z + ov[i].w * ov[i].w); }
                ssq += __shfl_xor(ssq, 1); ssq += __shfl_xor(ssq, 2); ssq += __shfl_xor(ssq, 4);
                const float rstd = rsqrtf(ssq * (1.0f / 128.0f) + EPS);
                const unsigned gw[8] = {gc0.x, gc0.y, gc0.z, gc0.w, gc1.x, gc1.y, gc1.z, gc1.w};
                unsigned ow[8]; float yv[16];
#pragma unroll
                for (int i = 0; i < 8; ++i) { const float g0 = bflo(gw[i]), g1 = bfhi(gw[i]);
                    const float y0 = ov[i >> 1][(2 * i) & 3] * rstd * ngv[2 * i] * g0 * __builtin_amdgcn_rcpf(1.0f + __expf(-g0));
                    const float y1 = ov[i >> 1][(2 * i + 1) & 3] * rstd * ngv[2 * i + 1] * g1 * __builtin_amdgcn_rcpf(1.0f + __expf(-g1));
                    ow[i] = pk2(y0, y1); yv[2 * i] = y0; yv[2 * i + 1] = y1; }
                if (MIX_FP8) { u32x4 o8; o8.x = cvt4_fp8(yv[0] * 16.0f, yv[1] * 16.0f, yv[2] * 16.0f, yv[3] * 16.0f); o8.y = cvt4_fp8(yv[4] * 16.0f, yv[5] * 16.0f, yv[6] * 16.0f, yv[7] * 16.0f);
                               o8.z = cvt4_fp8(yv[8] * 16.0f, yv[9] * 16.0f, yv[10] * 16.0f, yv[11] * 16.0f); o8.w = cvt4_fp8(yv[12] * 16.0f, yv[13] * 16.0f, yv[14] * 16.0f, yv[15] * 16.0f);
                               *(u32x4*)((unsigned char*)og + (size_t)(b * SEQ + sc * 256 + ch * 64 + tv) * (2 * D) + h * 128 + vc * 16) = o8; }
                else { u32x4* d = (u32x4*)(og + (size_t)(b * SEQ + sc * 256 + ch * 64 + tv) * (2 * D) + h * 128 + vc * 16);
                       d[0] = (u32x4){ow[0], ow[1], ow[2], ow[3]}; d[1] = (u32x4){ow[4], ow[5], ow[6], ow[7]}; }
            }
        }
        if (ch == 3) {
            if (!OUT) {
                float* ds = dS + (size_t)(bh * 32 + sc) * 16384;
#pragma unroll
                for (int vt = 0; vt < 8; ++vt)
#pragma unroll
                    for (int j = 0; j < 4; ++j) ds[(size_t)(16 * wave + fq * 4 + j) * 128 + vt * 16 + fr] = S[vt][j];
                if (seg == 0) *(f32x2*)(Dd + (size_t)(bh * 32 + sc) * 128 + 2 * cp) = (f32x2){__builtin_amdgcn_exp2f(gsum0), __builtin_amdgcn_exp2f(gsum1)};
            }
            idx += X.G; ch = 0; if (idx >= ntask) break;
        } else ++ch;
    }
#undef HG_LOAD
    __syncthreads();
}

__device__ __forceinline__ void ph_hg2(const Ctx& X, const float* dS, const float* Dd, float* S0) {
    for (int idx = X.vcu * 512 + X.tid; idx < 32 * 4096; idx += X.G * 512) {
        const int bh = idx >> 12, e4 = idx & 4095, k = e4 >> 5, v4 = (e4 & 31) * 4;
        f32x4 s = (f32x4){0.f, 0.f, 0.f, 0.f};
#pragma unroll 4
        for (int sc = 0; sc < 31; ++sc) { const float d = Dd[(size_t)(bh * 32 + sc) * 128 + k]; const f32x4 ds = *(const f32x4*)(dS + (size_t)(bh * 32 + sc) * 16384 + k * 128 + v4);
            s = s * d + ds; *(f32x4*)(S0 + (size_t)(bh * 32 + sc + 1) * 16384 + k * 128 + v4) = s; }
    }
}

__device__ __forceinline__ void ph_router_tables(const Ctx& X, const float* g_ffn, const float* mod, const float* w_router, const float* b_router, bf16_t* BpT, float* cb) {
    for (int i = X.vcu * 512 + X.tid; i < 4 * 32 * 1024; i += X.G * 512) { const int b = i >> 15, e = (i >> 10) & 31, k = i & 1023;
        const float v = g_ffn[k] * (1.0f + mod[(size_t)b * NMOD + 4 * D + k]) * w_router[k * 32 + e];
        const unsigned hi = pk2(v, 0.f) & 0xffffu; const float r1 = v - __uint_as_float(hi << 16);
        const unsigned mi = pk2(r1, 0.f) & 0xffffu; const float r2 = r1 - __uint_as_float(mi << 16);
        const unsigned lo = pk2(r2, 0.f) & 0xffffu;
        unsigned short* d = (unsigned short*)BpT + ((size_t)(b * 3) * 32 + e) * 1024 + k;
        d[0] = (unsigned short)hi; d[32 * 1024] = (unsigned short)mi; d[2 * 32 * 1024] = (unsigned short)lo; }
    const int gw = X.vcu * 8 + X.wave;
    if (gw < 128) { const int b = gw >> 5, e = gw & 31; float a = 0.f;
        for (int k = X.lane; k < 1024; k += 64) a += mod[(size_t)b * NMOD + 3 * D + k] * w_router[k * 32 + e];
        a = wave_sum(a); if (X.lane == 0) cb[gw] = a + b_router[e]; }
}

__device__ __forceinline__ void ph_route(const Ctx& X, const bf16_t* x1, const float* g_ffn, const float* mod, const bf16_t* BpT, const float* cb,
                                         unsigned char* h2, int* top_e, float* top_w, int* rank, int* hist_g) {
    LAS int* hist = (LAS int*)(X.lds + LDSCTL_OFF + 64);
    LAS unsigned char* L = X.lds;
    constexpr int RS = 1040;
    const int tid = X.tid, lane = X.lane, c = lane & 15, q = lane >> 4;
    for (int tile = X.vcu; tile < RT_NT; tile += X.G) {
        if (tid < 32) hist[tid] = 0;
        const int tw = tile * RT_TILE + X.wave * 16, b = tw / SEQ;
        const bf16_t* xa = x1 + (size_t)(tw + c) * D + 8 * q;
        f32x4 acc0 = (f32x4){0.f, 0.f, 0.f, 0.f}, acc1 = acc0, accS = acc0;
#pragma unroll 1
        for (int half = 0; half < 2; ++half) {
            bf16x8 a[16];
#pragma unroll
            for (int ks = 0; ks < 16; ++ks) a[ks] = *(const bf16x8*)(xa + 512 * half + 32 * ks);
            __syncthreads();
#pragma unroll
            for (int i = 0; i < 12; ++i) { const int id = tid + 512 * i, row = id >> 6, c16 = id & 63;
                const u32x4 v = *(const u32x4*)(BpT + ((size_t)(b * 96) + row) * 1024 + 512 * half + 8 * c16);
                *(LAS u32x4*)(L + row * RS + 16 * c16) = v; }
            __syncthreads();
#pragma unroll
            for (int ks = 0; ks < 16; ++ks) {
                bf16x8 bb[6];
#pragma unroll
                for (int j = 0; j < 6; ++j) bb[j] = *(const LAS bf16x8*)(L + (16 * j + c) * RS + 64 * ks + 16 * q);
                accS = __builtin_amdgcn_mfma_f32_16x16x32_bf16(a[ks], a[ks], accS, 0, 0, 0);
#pragma unroll
                for (int s_ = 2; s_ >= 0; --s_) { acc0 = __builtin_amdgcn_mfma_f32_16x16x32_bf16(a[ks], bb[2 * s_], acc0, 0, 0, 0); acc1 = __builtin_amdgcn_mfma_f32_16x16x32_bf16(a[ks], bb[2 * s_ + 1], acc1, 0, 0, 0); }
            }
        }
        const float dg = (c & 2) ? ((c & 1) ? accS[3] : accS[2]) : ((c & 1) ? accS[1] : accS[0]);
        const float ss = __shfl(dg, c + 16 * (c >> 2));
        const float rs = rsqrtf(ss * (1.0f / D) + EPS);
        const float cb0 = cb[b * 32 + c], cb1 = cb[b * 32 + 16 + c];
#pragma unroll
        for (int reg = 0; reg < 4; ++reg) {
            const float rt = __shfl(rs, 4 * q + reg);
            float v0 = acc0[reg] * rt + cb0, v1 = acc1[reg] * rt + cb1;
            float sv[4]; int si[4];
#pragma unroll
            for (int rnd = 0; rnd < 4; ++rnd) {
                float bvv = v0; int bi = c; if (v1 > bvv) { bvv = v1; bi = 16 + c; }
#pragma unroll
                for (int o = 1; o < 16; o <<= 1) { const float ov = __shfl_xor(bvv, o); const int oi = __shfl_xor(bi, o); if (ov > bvv || (ov == bvv && oi < bi)) { bvv = ov; bi = oi; } }
                sv[rnd] = bvv; si[rnd] = bi; if (bi == c) v0 = -INFINITY; if (bi == 16 + c) v1 = -INFINITY;
            }
            const float e1 = __expf(sv[1] - sv[0]), e2 = __expf(sv[2] - sv[0]), e3 = __expf(sv[3] - sv[0]);
            const float inv = 1.0f / (1.0f + e1 + e2 + e3);
            if (c == 0) { const int t = tw + 4 * q + reg;
                const float ww[4] = {inv, e1 * inv, e2 * inv, e3 * inv};
#pragma unroll
                for (int rnd = 0; rnd < 4; ++rnd) { top_e[t * 4 + rnd] = si[rnd]; top_w[t * 4 + rnd] = ww[rnd]; rank[t * 4 + rnd] = atomicAdd((int*)&hist[si[rnd]], 1); }
            }
        }
        const float* sh = mod + (size_t)b * NMOD + 3 * D; const float* sc = mod + (size_t)b * NMOD + 4 * D;
#pragma unroll 4
        for (int i = 0; i < 16; ++i) {
            const float r = __shfl(rs, i);
            const u32x2* xr = (const u32x2*)(x1 + (size_t)(tw + i) * D) + lane;
#pragma unroll
            for (int j = 0; j < 4; ++j) {
                const int col = 4 * (lane + 64 * j);
                const f32x4 gg = *(const f32x4*)(g_ffn + col), s1 = *(const f32x4*)(sc + col), s0 = *(const f32x4*)(sh + col);
                const u32x2 xw = xr[64 * j]; const f32x4 xv = (f32x4){bflo(xw.x), bfhi(xw.x), bflo(xw.y), bfhi(xw.y)};
                const f32x4 y = (xv * r * gg * (s1 + 1.0f) + s0) * 16.0f;
                *(unsigned*)(h2 + (size_t)(tw + i) * D + col) = cvt4_fp8(y.x, y.y, y.z, y.w);
            }
        }
        __syncthreads();
        if (tid < 32) hist_g[tile * 32 + tid] = hist[tid];
        __syncthreads();
    }
}

__device__ __forceinline__ void ph_sort(const Ctx& X, const int* hist_g, const int* top_e, const float* top_w, const int* rank, int* row_tok, float* row_w, int* pair_row, int* blk_e) {
    LAS int* s_hist = (LAS int*)X.lds;
    LAS int* s_tot = s_hist + RT_NT * 32; LAS int* s_pre = s_tot + 32; LAS int* s_base = s_pre + 32; LAS int* s_pstart = s_base + 32; LAS int* s_pend = s_pstart + 32;
    LAS int* s_ptot = s_pend + 32; LAS int* s_ppre = s_ptot + 16 * 32;
    const int tid = X.tid;
    for (int i = tid; i < RT_NT * 8; i += 512) ((LAS u32x4*)s_hist)[i] = ((const u32x4*)hist_g)[i];
    __syncthreads();
    for (int tile = X.vcu; tile < RT_NT; tile += X.G) {
        { const int e = tid & 31, part = tid >> 5; int tot = 0, pre = 0;
#pragma unroll 4
          for (int i = part * (RT_NT / 16); i < (part + 1) * (RT_NT / 16); ++i) { const int c = s_hist[i * 32 + e]; tot += c; pre += (i < tile) ? c : 0; }
          s_ptot[part * 32 + e] = tot; s_ppre[part * 32 + e] = pre; }
        __syncthreads();
        if (tid < 32) { int tot = 0, pre = 0;
#pragma unroll
            for (int k = 0; k < 16; ++k) { tot += s_ptot[k * 32 + tid]; pre += s_ppre[k * 32 + tid]; }
            const int padded = (tot + 255) / 256 * 256; int inc = padded;
#pragma unroll
            for (int o = 1; o < 32; o <<= 1) { const int v = __shfl_up(inc, o); if (tid >= o) inc += v; }
            s_tot[tid] = tot; s_pstart[tid] = inc - padded; s_base[tid] = inc - padded + pre; s_pend[tid] = inc; }
        __syncthreads();
        { const int i = tid; const int idx = tile * RT_TILE * 4 + i; const int e = top_e[idx]; const int row = s_base[e] + rank[idx];
          row_tok[row] = idx >> 2; row_w[row] = top_w[idx]; pair_row[idx] = row; }
        if (tile < 32) { const int e = tile; for (int r = s_pstart[e] + s_tot[e] + tid; r < s_pend[e]; r += 512) { row_tok[r] = 0; row_w[r] = 0.f; } }
        if (tile == 32) { for (int blk = tid; blk < NBLK_MAX; blk += 512) { int e = -1; const int r = blk * 256; for (int q = 0; q < 32; ++q) if (r >= s_pstart[q] && r < s_pend[q]) e = q; blk_e[blk] = e; }
                          if (tid == 0) blk_e[NBLK_MAX] = s_pend[31] / 256; }
        __syncthreads();
    }
}

__device__ __forceinline__ void ph_final(const Ctx& X, const bf16_t* x1, const unsigned char* y, const int* pair_row, const float* mod, const float* g_final, float* out, const float oscale) {
    const int lane = X.lane;
    for (int t = X.vcu * 8 + X.wave; t < T; t += X.G * 8) {
        const int b = t / SEQ;
        const u32x2* xr = (const u32x2*)(x1 + (size_t)t * D) + lane;
        const float* ga = mod + (size_t)b * NMOD + 5 * D;
        int rows[4];
#pragma unroll
        for (int k = 0; k < 4; ++k) rows[k] = pair_row[t * 4 + k];
        f32x4 v[4]; float ss = 0.f;
#pragma unroll
        for (int j = 0; j < 4; ++j) {
            const int col = 4 * (lane + 64 * j);
            f32x4 m = (f32x4){0.f, 0.f, 0.f, 0.f};
#pragma unroll
            for (int k = 0; k < 4; ++k) { const int w = *(const int*)(y + (size_t)rows[k] * D + col); const f32x2 lo = __builtin_amdgcn_cvt_pk_f32_fp8(w, false), hi = __builtin_amdgcn_cvt_pk_f32_fp8(w, true); m.x += lo.x; m.y += lo.y; m.z += hi.x; m.w += hi.y; }
            const u32x2 xw = xr[64 * j];
            v[j] = (f32x4){bflo(xw.x), bfhi(xw.x), bflo(xw.y), bfhi(xw.y)} + *(const f32x4*)(ga + col) * (m * (1.0f / 32.0f));
            ss += (v[j].x * v[j].x + v[j].y * v[j].y) + (v[j].z * v[j].z + v[j].w * v[j].w);
        }
        const float r = rsqrtf(wave_sum(ss) * (1.0f / D) + EPS);
#pragma unroll
        for (int j = 0; j < 4; ++j) { const int col = 4 * (lane + 64 * j); *(f32x4*)(out + (size_t)t * D + col) = v[j] * (r * oscale) * *(const f32x4*)(g_final + col); }
    }
}

constexpr int N_PHASES = 13;
struct Args { const float* in[23]; float* out; unsigned char* ws; int ph_lo, ph_hi; };
__global__ void __launch_bounds__(512, 2) fwd(Args a) {
    extern __shared__ __attribute__((aligned(16))) unsigned char lds_raw[];
    Ctx X; X.lds = (LAS unsigned char*)lds_raw; X.tid = threadIdx.x; X.lane = X.tid & 63; X.wave = __builtin_amdgcn_readfirstlane(X.tid >> 6);
    X.G = gridDim.x; { const int bx = blockIdx.x; X.vcu = (X.G % 8 == 0) ? (bx % 8) * (X.G / 8) + bx / 8 : bx; }
    unsigned char* ws = a.ws;
    for (int u = X.tid; u < (LDS_BYTES - LDSCTL_OFF) / 4; u += 512) ((LAS unsigned*)(X.lds + LDSCTL_OFF))[u] = 0u;
    __syncthreads();
    XcdBarrier bar = xcd_barrier_post((unsigned*)(ws + WS_CTL) + CW_BAR, (volatile LAS unsigned*)(X.lds + LDSCTL_OFF), X.tid == 0);
    const int lo = a.ph_lo, hi = a.ph_hi; float probe_scale = 1.0f;
#define IN(k) (lo <= (k) && (k) < hi)
#define SEAM(k) do { if (IN(k) && IN((k) + 1)) xcd_barrier(bar, X.wave == 0 && (int)__builtin_amdgcn_mbcnt_hi(~0u, __builtin_amdgcn_mbcnt_lo(~0u, 0u)) == 0); } while (0)
#ifdef PROBE_PH
    unsigned long long* stamps = (unsigned long long*)(ws + WS_CTL + 32768);
    if (blockIdx.x == 0 && X.tid == 0) stamps[0] = __builtin_amdgcn_s_memrealtime();
#undef SEAM
#define SEAM(k) do { if (IN(k) && IN((k) + 1)) { xcd_barrier(bar, X.wave == 0 && (int)__builtin_amdgcn_mbcnt_hi(~0u, __builtin_amdgcn_mbcnt_lo(~0u, 0u)) == 0); \
        if (blockIdx.x == 0 && X.wave == 0 && (int)__builtin_amdgcn_mbcnt_hi(~0u, __builtin_amdgcn_mbcnt_lo(~0u, 0u)) == 0) stamps[(k) + 1] = __builtin_amdgcn_s_memrealtime(); } } while (0)
#endif
    const float* x = a.in[0]; const float* c = a.in[1]; const float* w_ada = a.in[2]; const float* b_ada = a.in[3];
    const float* g_mix = a.in[4]; const float* w_in = a.in[5]; const float* conv_dw = a.in[6]; const float* conv_dwb = a.in[7];
    const float* conv_ln_g = a.in[8]; const float* conv_ln_b = a.in[9]; const float* w_conv_out = a.in[10]; const float* lb_param = a.in[11];
    const float* hgrn_norm_g = a.in[12]; const float* w_hgrn_out = a.in[13]; const float* w_out = a.in[14]; const float* g_ffn = a.in[15];
    const float* w_router = a.in[16]; const float* b_router = a.in[17]; const float* w1 = a.in[18]; const float* b1 = a.in[19];
    const float* w2 = a.in[20]; const float* b2 = a.in[21]; const float* g_final = a.in[22];
    float* mod = (float*)(ws + WS_MOD); bf16_t* rt_bp = (bf16_t*)(ws + WS_WH);     float* rt_cb = (float*)(ws + WS_CB);
    int* hist_g = (int*)(ws + WS_HIST); int* blk_e = (int*)(ws + WS_BLKE); int* top_e = (int*)(ws + WS_TOPE); float* top_w = (float*)(ws + WS_TOPW);
    int* rank = (int*)(ws + WS_RANK); int* pair_row = (int*)(ws + WS_PROW); int* row_tok = (int*)(ws + WS_RTOK); float* row_w = (float*)(ws + WS_RW);
    bf16_t* p = (bf16_t*)(ws + WS_P);
    bf16_t* h = (bf16_t*)(ws + WS_E); unsigned char* h8 = ws + WS_E + 64 * MiB; float* tmp = (float*)(ws + WS_E);
    float* hg_dS = (float*)(ws + WS_E); float* hg_S0 = (float*)(ws + WS_E + 64 * MiB); float* hg_D = (float*)(ws + WS_HGD);
    bf16_t* uc = (bf16_t*)(ws + WS_D); bf16_t* og = MIX_FP8 ? (bf16_t*)((unsigned char*)uc + D) : uc + D;   bf16_t* x1 = (bf16_t*)(ws + WS_D);
    bf16_t* merged = p;
    unsigned char* h2 = (unsigned char*)p;
    unsigned char* act = (unsigned char*)(p + PG);
    unsigned char* y = (unsigned char*)(p + PG) + (size_t)R_PAD * D;
    PG8_LAS unsigned char* ring = (PG8_LAS unsigned char*)lds_raw;

#ifndef REPMASK
#define REPMASK 0
#endif
#ifndef REPN
#define REPN 1
#endif
#define PH(k, ...) do { if (IN(k)) { _Pragma("unroll 1") for (int rep_ = 0; rep_ < ((((REPMASK) >> (k)) & 1) ? 1 + REPN : 1); ++rep_) { if (rep_) __syncthreads(); { int ln_ = (int)__builtin_amdgcn_mbcnt_hi(~0u, __builtin_amdgcn_mbcnt_lo(~0u, 0u)); asm volatile("" : "+v"(ln_)); X.lane = ln_; X.tid = X.wave * 64 + ln_; } __VA_ARGS__ } } SEAM(k); } while (0)
    PH(0, ph_prologue<0>(X, c, w_ada, b_ada, mod, w_in, w_conv_out, w_hgrn_out, w_out, w1, w2, ws); if (P_INT8) ph_win_i8(X, w_in, ws););
    PH(1, ph_norm_mod(X, x, g_mix, mod, 0, D, h, h8, (float*)(ws + WS_HSC)); ph_router_tables(X, g_ffn, mod, w_router, b_router, rt_bp, rt_cb););
#ifndef STAGGER_TICKS
#define STAGGER_TICKS 0
#endif
    PH(2, { if (STAGGER_TICKS) { const unsigned long long t0_ = __builtin_amdgcn_s_memrealtime(), wait_ = (unsigned long long)(X.vcu & 3) * STAGGER_TICKS;
                while (__builtin_amdgcn_s_memrealtime() - t0_ < wait_) __builtin_amdgcn_s_sleep(8); }
        if (P_INT8) { pg8::Gemm g{(const bf16_t*)h8, (const bf16_t*)(ws + WS_WIN8), T, 8 * D, D / 2}; pg8::StaticOrder S; S.init(T, 8 * D, X.G, (int)blockIdx.x);
            pg8::EpiSplitBf16<true> E{p, PG, 0x3cu, SEQ, 1.0f, (const float*)(ws + WS_HSC), (const float*)(ws + WS_WSC)}; pg8::gemm_phase<pg8::EpiSplitBf16<true>, pg8::StaticOrder, true, true, false, 2>(ring, g, S, E, X.wave); }
        else {
        constexpr unsigned m8 = P_FP8_MASK; constexpr int n8 = __builtin_popcount(m8);
        if (n8 > 0) { pg8::Gemm g{(const bf16_t*)h8, (const bf16_t*)(ws + WS_WIN8), T, 8 * D, D / 2}; pg8::MaskOrder S; S.base.init(T, n8 * 256, X.G, (int)blockIdx.x); S.mask = m8;
            pg8::EpiSplitBf16<false> E{p, PG, 0x3cu, SEQ, 1.0f / 4096.0f, nullptr, nullptr}; pg8::gemm_phase<pg8::EpiSplitBf16<false>, pg8::MaskOrder, true, true, false, 1>(ring, g, S, E, X.wave); }
        if (n8 < 32) { pg8::Gemm g{h, (const bf16_t*)(ws + WS_WIN), T, 8 * D, D}; pg8::MaskOrder S; S.base.init(T, (32 - n8) * 256, X.G, (int)blockIdx.x); S.mask = ~m8;
            pg8::EpiSplitBf16<false> E{p, PG, 0x3cu, SEQ, 1.0f, nullptr, nullptr}; pg8::gemm_phase<pg8::EpiSplitBf16<false>, pg8::MaskOrder, true, true>(ring, g, S, E, X.wave); } } });
    PH(3, ph_conv(X, p + 0 * PG, conv_dw, conv_dwb, conv_ln_g, conv_ln_b, uc);
          if ((REPMASK >> 14) & 1) { __syncthreads(); ph_conv(X, p + 0 * PG, conv_dw, conv_dwb, conv_ln_g, conv_ln_b, uc); }
          ph_hgrn<false>(X, 31 * 32, p + 2 * PG, p + 3 * PG, p + 4 * PG, p + 5 * PG, lb_param, nullptr, nullptr, hg_dS, hg_D, nullptr);
          if ((REPMASK >> 15) & 1) { __syncthreads(); ph_hgrn<false>(X, 31 * 32, p + 2 * PG, p + 3 * PG, p + 4 * PG, p + 5 * PG, lb_param, nullptr, nullptr, hg_dS, hg_D, nullptr); });
    PH(4, ph_hg2(X, hg_dS, hg_D, hg_S0););
    PH(5, if ((X.vcu & 1) == 0) ph_prologue<1>(X, c, w_ada, b_ada, mod, w_in, w_conv_out, w_hgrn_out, w_out, w1, w2, ws);
          ph_hgrn<true>(X, 32 * 32, p + 2 * PG, p + 3 * PG, p + 4 * PG, p + 5 * PG, lb_param, hgrn_norm_g, hg_S0, nullptr, nullptr, og);
          if ((X.vcu & 1) != 0) ph_prologue<1>(X, c, w_ada, b_ada, mod, w_in, w_conv_out, w_hgrn_out, w_out, w1, w2, ws););
    PH(6, { if (MIX_FP8) { pg8::Gemm g{uc, (const bf16_t*)(ws + WS_WC), T, D, D}; pg8::StaticOrder S; S.init(T, D, X.G, (int)blockIdx.x);
              pg8::EpiGateFused<RES_FP8 != 0> E{p + 6 * PG, p + 7 * PG, merged, 1.0f / 4096.0f}; pg8::gemm_phase<pg8::EpiGateFused<RES_FP8 != 0>, pg8::StaticOrder, true, true, false, 1>(ring, g, S, E, X.wave); }
            else { pg8::Gemm g{uc, (const bf16_t*)(ws + WS_WC), T, D, 2 * D}; pg8::StaticOrder S; S.init(T, D, X.G, (int)blockIdx.x);
              pg8::EpiGateFused<RES_FP8 != 0> E{p + 6 * PG, p + 7 * PG, merged, 1.0f}; pg8::gemm_phase<pg8::EpiGateFused<RES_FP8 != 0>, pg8::StaticOrder, true, true>(ring, g, S, E, X.wave); } });
    PH(7, { if (RES_FP8) { pg8::Gemm g{merged, (const bf16_t*)(ws + WS_WO), T, D, D / 2}; pg8::StaticOrder S; S.init(T, D, X.G, (int)blockIdx.x);
              pg8::EpiRes E{x, mod + 2 * D, x1, NMOD, SEQ, 1.0f / 8192.0f}; pg8::gemm_phase<pg8::EpiRes, pg8::StaticOrder, true, true, false, 1>(ring, g, S, E, X.wave); }
            else { pg8::Gemm g{merged, (const bf16_t*)(ws + WS_WO), T, D, D}; pg8::StaticOrder S; S.init(T, D, X.G, (int)blockIdx.x);
              pg8::EpiRes E{x, mod + 2 * D, x1, NMOD, SEQ, 1.0f}; pg8::gemm_phase<pg8::EpiRes, pg8::StaticOrder, true, true>(ring, g, S, E, X.wave); } });
    PH(8, ph_route(X, x1, g_ffn, mod, rt_bp, rt_cb, h2, top_e, top_w, rank, hist_g););
    PH(9, ph_sort(X, hist_g, top_e, top_w, rank, row_tok, row_w, pair_row, blk_e););
    PH(10, { const int nblk = blk_e[NBLK_MAX]; pg8::Gemm g{(const bf16_t*)h2, (const bf16_t*)(ws + WS_W1), T, 32 * 2048, D / 2}; pg8::MoeOrder S{blk_e, nblk, X.G, (int)blockIdx.x, 3};
        LAS unsigned short* gt = (LAS unsigned short*)(X.lds + LDSCTL_OFF + 256);
        _Pragma("unroll 1") for (int i = 0; i < 23; ++i) { pg8::Unit u; if (!S.next(i, u)) break; if (X.tid < 256) gt[256 * i + X.tid] = (unsigned short)row_tok[u.pm * 256 + X.tid]; }
        __syncthreads();
        pg8::EpiSwiglu8 E{b1, act, 1.0f / 4096.0f}; pg8::gemm_phase<pg8::EpiSwiglu8, pg8::MoeOrder, true, true, true, true>(ring, g, S, E, X.wave, (const PG8_LAS unsigned short*)gt); });
    PH(11, { const int nblk = blk_e[NBLK_MAX]; pg8::Gemm g{(const bf16_t*)act, (const bf16_t*)(ws + WS_W2), R_PAD, 32 * 1024, DFF / 2}; pg8::MoeOrder S{blk_e, nblk, X.G, (int)blockIdx.x, 2};
        pg8::EpiY8 E{b2, row_w, y, 1.0f / 1024.0f}; pg8::gemm_phase<pg8::EpiY8, pg8::MoeOrder, true, true, false, true>(ring, g, S, E, X.wave); });
#ifdef PROBE_PH
    { const unsigned long long* st_ = (const unsigned long long*)(ws + WS_CTL + 32768); const float dt_ = (float)(long long)(st_[PROBE_PH + 1] - st_[PROBE_PH]);
      probe_scale = 1.0f + dt_ * (1.0f / 200000.0f); }
#endif
    PH(12, ph_final(X, x1, y, pair_row, mod, g_final, a.out, probe_scale););
#undef PH
#undef IN
#undef SEAM
}

#ifndef MK_N_LAUNCHES
#define MK_N_LAUNCHES 1
#endif
extern "C" void kernel_launch(void* const* d_in, const int* in_sizes, int n_in, void* d_out, int out_size, void* d_ws, size_t ws_size, hipStream_t stream) {
    static int grid = 0;
    if (grid == 0) {
        if (n_in != 23 || out_size != T * D || ws_size < WS_END) { fprintf(stderr, "kernel_launch: unexpected n_in %d / out_size %d / ws_size %zu (< %zu); nothing launched\n", n_in, out_size, ws_size, (size_t)WS_END); grid = -1; return; }
        int dev = 0, cus = 0, per_cu = 0;
        if (hipGetDevice(&dev) != hipSuccess || hipDeviceGetAttribute(&cus, hipDeviceAttributeMultiprocessorCount, dev) != hipSuccess) { grid = -1; return; }
        if (hipFuncSetAttribute((const void*)fwd, hipFuncAttributeMaxDynamicSharedMemorySize, LDS_BYTES) != hipSuccess) { fprintf(stderr, "kernel_launch: hipFuncSetAttribute failed\n"); grid = -1; return; }
        if (hipOccupancyMaxActiveBlocksPerMultiprocessor(&per_cu, (const void*)fwd, 512, LDS_BYTES) != hipSuccess || per_cu < 1) { fprintf(stderr, "kernel_launch: occupancy query says %d blocks per CU\n", per_cu); }
        (void)hipGetLastError();
        grid = cus;
    }
    if (grid < 0) return;
    if (hipMemsetAsync((char*)d_ws + WS_CTL, 0, CTL_ZERO_BYTES, stream) != hipSuccess) return;
    Args a{};
    for (int i = 0; i < 23; ++i) a.in[i] = (const float*)d_in[i];
    a.out = (float*)d_out; a.ws = (unsigned char*)d_ws;
    if (MK_N_LAUNCHES == 1) { a.ph_lo = 0; a.ph_hi = N_PHASES; hipLaunchKernelGGL(fwd, dim3(grid), dim3(512), LDS_BYTES, stream, a); }
    else for (int ph = 0; ph < N_PHASES; ++ph) { a.ph_lo = ph; a.ph_hi = ph + 1; hipLaunchKernelGGL(fwd, dim3(grid), dim3(512), LDS_BYTES, stream, a); }
}
```

```cpp
#include <hip/hip_runtime.h>
#include <stdint.h>
#include <stdio.h>

#define GAS __attribute__((address_space(1)))
#define LAS __attribute__((address_space(3)))
typedef unsigned short bf16_t;
typedef unsigned u32x4 __attribute__((ext_vector_type(4)));
typedef unsigned u32x2 __attribute__((ext_vector_type(2)));
typedef float f32x4 __attribute__((ext_vector_type(4)));

constexpr int D = 1024, NBATCH = 4, SEQ = 8192, T = NBATCH * SEQ;
constexpr int NE = 32, DFF = 1024;
constexpr int NMOD = 6 * D;
constexpr int NBLK_MAX = 544, R_PAD = NBLK_MAX * 256;
constexpr int RT_TILE = 128, RT_NT = T / RT_TILE;
constexpr float EPS = 1e-6f;

constexpr size_t MiB = 1u << 20;
constexpr size_t WS_CTL = 0, CTL_ZERO_BYTES = 64 * 1024;
constexpr size_t WS_MOD = 1 * MiB;
constexpr size_t WS_CB = WS_MOD + 112 * 1024, WS_BP = WS_MOD + 128 * 1024;
constexpr size_t WS_HSC = WS_MOD + 704 * 1024, WS_WSC = WS_MOD + 840 * 1024;
constexpr size_t WS_HIST = 2 * MiB;
constexpr size_t WS_BLKE = WS_HIST + 64 * 1024;
constexpr size_t WS_TOPE = 3 * MiB;
constexpr size_t WS_TOPW = WS_TOPE + 512 * 1024;
constexpr size_t WS_RANK = WS_TOPW + 512 * 1024;
constexpr size_t WS_PROW = WS_RANK + 512 * 1024;
constexpr size_t WS_RTOK = 5 * MiB;
constexpr size_t WS_RW = 6 * MiB;
constexpr size_t WS_HGD = 7 * MiB;
constexpr size_t WS_WT = 8 * MiB;
constexpr size_t WS_WIN = WS_WT, WS_WC = WS_WT + 16 * MiB, WS_WH = WS_WT + 18 * MiB, WS_WO = WS_WT + 20 * MiB, WS_W1 = WS_WT + 22 * MiB, WS_WIN8 = WS_WT + 96 * MiB  , WS_W2 = WS_WT + 150 * MiB;
constexpr size_t WS_P = 224 * MiB;
constexpr size_t WS_E = WS_P + 512 * MiB;
constexpr size_t WS_D = WS_E + 128 * MiB;
constexpr size_t WS_END = WS_D + 128 * MiB;
constexpr size_t PG = (size_t)T * D;
constexpr int CW_BAR = 0;

constexpr int RING_BYTES = 135168, LDSCTL_OFF = RING_BYTES, LDS_BYTES = 147456;

__device__ __forceinline__ unsigned f2bf(float f) { unsigned u = __builtin_bit_cast(unsigned, f); return (u + 0x7fffu + ((u >> 16) & 1u)) >> 16; }
typedef __bf16 bf16x2_hw __attribute__((ext_vector_type(2)));
__device__ __forceinline__ unsigned pk2(float lo, float hi) { const bf16x2_hw v = {(__bf16)lo, (__bf16)hi}; return __builtin_bit_cast(unsigned, v); }
__device__ __forceinline__ float bf2f(unsigned b) { return __builtin_bit_cast(float, b << 16); }
__device__ __forceinline__ float bflo(unsigned w) { return __builtin_bit_cast(float, w << 16); }
__device__ __forceinline__ float bfhi(unsigned w) { return __builtin_bit_cast(float, w & 0xffff0000u); }
__device__ __forceinline__ float sigmoidf_(float x) { return __builtin_amdgcn_rcpf(1.0f + __expf(-x)); }
__device__ __forceinline__ float wave_sum(float v) {
#pragma unroll
    for (int o = 1; o < 64; o <<= 1) v += __shfl_xor(v, o);
    return v;
}
__device__ __forceinline__ unsigned cvt4_fp8(float a, float b, float c, float d) {
    a = fminf(fmaxf(a, -448.f), 448.f); b = fminf(fmaxf(b, -448.f), 448.f); c = fminf(fmaxf(c, -448.f), 448.f); d = fminf(fmaxf(d, -448.f), 448.f);
    int w = 0; w = __builtin_amdgcn_cvt_pk_fp8_f32(a, b, w, false); w = __builtin_amdgcn_cvt_pk_fp8_f32(c, d, w, true); return (unsigned)w; }
__device__ __forceinline__ unsigned q4_i8(float a, float b, float c, float d) {
    const int ia = (int)__builtin_rintf(a), ib = (int)__builtin_rintf(b), ic = (int)__builtin_rintf(c), id = (int)__builtin_rintf(d);
    return (unsigned)(ia & 255) | ((unsigned)(ib & 255) << 8) | ((unsigned)(ic & 255) << 16) | ((unsigned)id << 24); }
#define LDS_WAIT() asm volatile("s_waitcnt lgkmcnt(0)" ::: "memory")
#define VM_WAIT() asm volatile("s_waitcnt vmcnt(0)" ::: "memory")

namespace pg8 {
#define PG8_LAS __attribute__((address_space(3)))
typedef unsigned short bf16_t;
typedef short bf16x8 __attribute__((ext_vector_type(8)));
typedef float f32x4 __attribute__((ext_vector_type(4)));
typedef unsigned u32x4 __attribute__((ext_vector_type(4)));
constexpr int BM = 256, BK = 64, HALF = 128, HTB = HALF * BK * 2  , STAGE_BYTES = 8 * HTB, NXCD = 8, WGM = 8;

__host__ __device__ __forceinline__ int lds_byte(int r, int c) { const int st = (r >> 4) * 2 + (c >> 5), rr = r & 15, cc = c & 31, ob = rr * 64 + cc * 2; return st * 1024 + (ob ^ (((ob >> 9) & 1) << 5)); }
__host__ __device__ __forceinline__ void stage_rc(int b, int& R, int& C) { const int st = b / 1024, sb = b % 1024, swz = sb ^ (((sb >> 9) & 1) << 5); R = (st >> 1) * 16 + swz / 64; C = (st & 1) * 32 + (swz % 64) / 2; }
__host__ __device__ __forceinline__ int perm32(int rho) { const int n = rho >> 4, i = rho & 15; return 8 * (i >> 2) + 4 * n + (i & 3); }

struct Unit { int pm, pn; };
struct Gemm { const bf16_t* A; const bf16_t* Bt; int M, N, K; };

struct StaticOrder {
    int nM, nN, nwg, G, c;
    __host__ __device__ void init(int M, int N, int G_, int c_) { nM = M / BM; nN = N / BM; nwg = nM * nN; G = G_; c = c_; }
    __host__ __device__ bool next(int i, Unit& u) const {
        const long L = (long)i * G + c; if (L >= nwg) return false;
        int wgid = (int)L; { const int q = nwg / NXCD, r = nwg % NXCD, xcd = wgid % NXCD, off = wgid / NXCD; wgid = (xcd < r ? xcd * (q + 1) : r * (q + 1) + (xcd - r) * q) + off; }
        const int nig = WGM * nN, gid = wgid / nig, fm = gid * WGM, gsz = (nM - fm) < WGM ? (nM - fm) : WGM;
        u.pm = fm + ((wgid % nig) % gsz); u.pn = (wgid % nig) / gsz; return true;
    }
    __device__ __forceinline__ void a_ready(const Unit&) const {}
    __device__ __forceinline__ void done(const Unit&) const {}
};


struct MaskOrder {
    StaticOrder base; unsigned mask;
    __device__ __forceinline__ bool next(int i, Unit& u) const {
        if (!base.next(i, u)) return false;
        unsigned m = mask; for (int k = 0; k < u.pn; ++k) m &= m - 1;
        u.pn = __builtin_ctz(m); return true;
    }
    __device__ __forceinline__ void a_ready(const Unit&) const {}
    __device__ __forceinline__ void done(const Unit&) const {}
};
struct MoeOrder {
    const int* blk_e; int nblk, G, c, lg;
    __device__ __forceinline__ bool next(int i, Unit& u) const {
        int blk, j;
        if (G == 256) { const int xcd = c & 7, idx = c >> 3, prb = 256 >> lg; blk = i * prb + xcd * (prb >> 3) + (idx >> lg); j = idx & ((1 << lg) - 1); }
        else { const long L = (long)i * G + c; blk = (int)(L >> lg); j = (int)(L & ((1 << lg) - 1)); }
        if (blk >= nblk) return false;
        const int e = blk_e[blk]; u.pm = blk; u.pn = (e << lg) + j; return true;
    }
    __device__ __forceinline__ void a_ready(const Unit&) const {}
    __device__ __forceinline__ void done(const Unit&) const {}
};

__device__ __forceinline__ unsigned cvt_pk_bf16(float lo, float hi) { unsigned r; asm volatile("v_cvt_pk_bf16_f32 %0, %1, %2" : "=v"(r) : "v"(lo), "v"(hi)); return r; }
__device__ __forceinline__ float sigm(float x) { return __builtin_amdgcn_rcpf(1.0f + __expf(-x)); }
__device__ __forceinline__ float blo(unsigned w) { return __builtin_bit_cast(float, w << 16); }
__device__ __forceinline__ float bhi(unsigned w) { return __builtin_bit_cast(float, w & 0xffff0000u); }

template <bool I8> struct EpiSplitBf16 {
    static constexpr bool PERM = true, AFTER_DRAIN = false;
    bf16_t* O; size_t split_stride; unsigned hm_mask; int seq; float dq;
    const float* rs; const float* cs;
    __device__ __forceinline__ void operator()(const f32x4 (&acc)[2][2][4][2], const Unit& u, int wr, int wc, int fr, int fq) const {
        const int row0 = u.pm * BM + wr * 64 + fr; const int colt = u.pn * BM; const int t = colt >> 10;
        f32x4 cv[2][2]; float rv[2][4];
#pragma unroll
        for (int bj = 0; bj < 2; ++bj)
#pragma unroll
            for (int n = 0; n < 2; ++n) cv[bj][n] = I8 ? *(const f32x4*)(cs + colt + bj * HALF + wc * 32 + 8 * fq + 4 * n) : (f32x4){dq, dq, dq, dq};
#pragma unroll
        for (int ai = 0; ai < 2; ++ai)
#pragma unroll
            for (int m = 0; m < 4; ++m) rv[ai][m] = I8 ? rs[row0 + ai * HALF + m * 16] : 1.0f;
#define PG8_DEQ(ai, bj, m, n) (acc[ai][bj][m][n] * cv[bj][n] * rv[ai][m])
        if (u.pn < 8) {
#pragma unroll
            for (int ai = 0; ai < 2; ++ai)
#pragma unroll
                for (int m = 0; m < 4; ++m) { const int row = row0 + ai * HALF + m * 16; float r[8];
                    const f32x4 a0 = PG8_DEQ(ai, 0, m, 0), a1 = PG8_DEQ(ai, 0, m, 1), b0 = PG8_DEQ(ai, 1, m, 0), b1 = PG8_DEQ(ai, 1, m, 1);
#pragma unroll
                    for (int q = 0; q < 4; ++q) { r[q] = a0[q] * sigm(b0[q]); r[4 + q] = a1[q] * sigm(b1[q]); }
                    u32x4 w; w.x = cvt_pk_bf16(r[0], r[1]); w.y = cvt_pk_bf16(r[2], r[3]); w.z = cvt_pk_bf16(r[4], r[5]); w.w = cvt_pk_bf16(r[6], r[7]);
                    __builtin_nontemporal_store(w, (u32x4*)(O + (size_t)row * 1024 + 128 * u.pn + wc * 32 + 8 * fq)); }
            return;
        }
        bf16_t* base = O + (size_t)t * split_stride; const int cg = colt & 1023;
        const bool hm = (hm_mask >> t) & 1u;
        const int bb = (u.pm * BM) / seq;
#pragma unroll
        for (int ai = 0; ai < 2; ++ai)
#pragma unroll
            for (int m = 0; m < 4; ++m) { const int row = row0 + ai * HALF + m * 16;
#pragma unroll
                for (int bj = 0; bj < 2; ++bj) { const f32x4 v0 = PG8_DEQ(ai, bj, m, 0), v1 = PG8_DEQ(ai, bj, m, 1);
                    u32x4 w; w.x = cvt_pk_bf16(v0[0], v0[1]); w.y = cvt_pk_bf16(v0[2], v0[3]); w.z = cvt_pk_bf16(v1[0], v1[1]); w.w = cvt_pk_bf16(v1[2], v1[3]);
                    const size_t o = hm ? ((size_t)(bb * 8 + (cg >> 7) + bj) * seq + (row - bb * seq)) * 128 + wc * 32 + 8 * fq
                                        : (size_t)row * 1024 + cg + bj * HALF + wc * 32 + 8 * fq;
                    __builtin_nontemporal_store(w, (u32x4*)(base + o)); } }
#undef PG8_DEQ
    }
};
struct EpiRes {
    static constexpr bool PERM = true, AFTER_DRAIN = false;
    const float* x; const float* ga; bf16_t* out; int mod_pitch, seq; float dq;
    __device__ __forceinline__ void operator()(const f32x4 (&acc)[2][2][4][2], const Unit& u, int wr, int wc, int fr, int fq) const {
        const int row0 = u.pm * BM + wr * 64 + fr, col0 = u.pn * BM + wc * 32 + 8 * fq;
        const float* gab = ga + (size_t)((u.pm * BM) / seq) * mod_pitch + col0;
        f32x4 gv[2][2];
#pragma unroll
        for (int bj = 0; bj < 2; ++bj)
#pragma unroll
            for (int n = 0; n < 2; ++n) gv[bj][n] = *(const f32x4*)(gab + bj * HALF + 4 * n) * dq;
#pragma unroll
        for (int ai = 0; ai < 2; ++ai) {
            f32x4 xv[4][2][2];
#pragma unroll
            for (int m = 0; m < 4; ++m)
#pragma unroll
                for (int bj = 0; bj < 2; ++bj) { const float* xp = x + (size_t)(row0 + ai * HALF + m * 16) * 1024 + col0 + bj * HALF; xv[m][bj][0] = *(const f32x4*)xp; xv[m][bj][1] = *(const f32x4*)(xp + 4); }
#pragma unroll
            for (int m = 0; m < 4; ++m) { const size_t o = (size_t)(row0 + ai * HALF + m * 16) * 1024 + col0;
#pragma unroll
                for (int bj = 0; bj < 2; ++bj) {
                    const f32x4 v0 = xv[m][bj][0] + gv[bj][0] * acc[ai][bj][m][0], v1 = xv[m][bj][1] + gv[bj][1] * acc[ai][bj][m][1];
                    u32x4 w; w.x = cvt_pk_bf16(v0[0], v0[1]); w.y = cvt_pk_bf16(v0[2], v0[3]); w.z = cvt_pk_bf16(v1[0], v1[1]); w.w = cvt_pk_bf16(v1[2], v1[3]);
                    *(u32x4*)(out + o + bj * HALF) = w; } }
        }
    }
};
struct EpiSwiglu8 {
    static constexpr bool PERM = true, AFTER_DRAIN = false;
    const float* b1; unsigned char* act; float dq;
    __device__ __forceinline__ void operator()(const f32x4 (&acc)[2][2][4][2], const Unit& u, int wr, int wc, int fr, int fq) const {
        const int e = u.pn >> 3, j = u.pn & 7; const int row0 = u.pm * BM + wr * 64 + fr, f0 = 128 * j + wc * 32 + 8 * fq;
        const float* be = b1 + (size_t)e * 2048 + f0;
        const f32x4 bg0 = *(const f32x4*)(be), bg1 = *(const f32x4*)(be + 4), bl0 = *(const f32x4*)(be + 1024), bl1 = *(const f32x4*)(be + 1028);
#pragma unroll
        for (int ai = 0; ai < 2; ++ai)
#pragma unroll
            for (int m = 0; m < 4; ++m) {
                f32x4 g0 = acc[ai][0][m][0] * dq + bg0, g1 = acc[ai][0][m][1] * dq + bg1, l0 = acc[ai][1][m][0] * dq + bl0, l1 = acc[ai][1][m][1] * dq + bl1;
                float r[8];
#pragma unroll
                for (int q = 0; q < 4; ++q) { float gl = fminf(g0[q], 7.0f), li = fminf(fmaxf(l0[q], -7.0f), 7.0f); r[q] = 4.0f * gl * sigm(1.702f * gl) * (li + 1.0f);
                                              gl = fminf(g1[q], 7.0f); li = fminf(fmaxf(l1[q], -7.0f), 7.0f); r[4 + q] = 4.0f * gl * sigm(1.702f * gl) * (li + 1.0f); }
                u32x2 w; w.x = cvt4_fp8(r[0], r[1], r[2], r[3]); w.y = cvt4_fp8(r[4], r[5], r[6], r[7]);
                *(u32x2*)(act + (size_t)(row0 + ai * HALF + m * 16) * 1024 + f0) = w; }
    }
};
struct EpiY8 {
    static constexpr bool PERM = true, AFTER_DRAIN = false;
    const float* b2; const float* rw; unsigned char* y; float dq;
    __device__ __forceinline__ void operator()(const f32x4 (&acc)[2][2][4][2], const Unit& u, int wr, int wc, int fr, int fq) const {
        const int e = u.pn >> 2, j = u.pn & 3; const int row0 = u.pm * BM + wr * 64 + fr, col0 = 256 * j + wc * 32 + 8 * fq;
        const float* be = b2 + (size_t)e * 1024 + col0;
        f32x4 bv[2][2];
#pragma unroll
        for (int bj = 0; bj < 2; ++bj)
#pragma unroll
            for (int n = 0; n < 2; ++n) bv[bj][n] = *(const f32x4*)(be + bj * HALF + 4 * n);
        float rwv[2][4];
#pragma unroll
        for (int ai = 0; ai < 2; ++ai)
#pragma unroll
            for (int m = 0; m < 4; ++m) rwv[ai][m] = rw[row0 + ai * HALF + m * 16] * 32.0f;
#pragma unroll
        for (int ai = 0; ai < 2; ++ai)
#pragma unroll
            for (int m = 0; m < 4; ++m) { const int row = row0 + ai * HALF + m * 16; const float w_ = rwv[ai][m];
#pragma unroll
                for (int bj = 0; bj < 2; ++bj) { const f32x4 v0 = (acc[ai][bj][m][0] * dq + bv[bj][0]) * w_, v1 = (acc[ai][bj][m][1] * dq + bv[bj][1]) * w_;
                    u32x2 w; w.x = cvt4_fp8(v0[0], v0[1], v0[2], v0[3]); w.y = cvt4_fp8(v1[0], v1[1], v1[2], v1[3]);
                    *(u32x2*)(y + (size_t)row * 1024 + col0 + bj * HALF) = w; } }
    }
};

template <bool OUT8> struct EpiGateFused {
    static constexpr bool PERM = true, AFTER_DRAIN = false, HAS_MID = true;
    const bf16_t* gc; const bf16_t* gh; bf16_t* out; float dq;
    __device__ __forceinline__ void mid(f32x4 (&acc)[2][2][4][2], const Unit& u, int wr, int wc, int fr, int fq) const {
        const int row0 = u.pm * BM + wr * 64 + fr, col0 = u.pn * BM + wc * 32 + 8 * fq;
#pragma unroll
        for (int ai = 0; ai < 2; ++ai)
#pragma unroll
            for (int m = 0; m < 4; ++m) { const size_t o = (size_t)(row0 + ai * HALF + m * 16) * 1024 + col0;
#pragma unroll
                for (int bj = 0; bj < 2; ++bj) { const u32x4 a = *(const u32x4*)(gc + o + bj * HALF), b = *(const u32x4*)(gh + o + bj * HALF);
                    const unsigned aw[4] = {a.x, a.y, a.z, a.w}, bw[4] = {b.x, b.y, b.z, b.w};
#pragma unroll
                    for (int q = 0; q < 4; ++q) { const float r0 = (1.0f + __expf(-blo(bw[q]))) * __builtin_amdgcn_rcpf(1.0f + __expf(-blo(aw[q]))), r1 = (1.0f + __expf(-bhi(bw[q]))) * __builtin_amdgcn_rcpf(1.0f + __expf(-bhi(aw[q])));
                        acc[ai][bj][m][q >> 1][(2 * q) & 3] *= r0; acc[ai][bj][m][q >> 1][(2 * q + 1) & 3] *= r1; } } }
    }
    __device__ __forceinline__ void operator()(const f32x4 (&acc)[2][2][4][2], const Unit& u, int wr, int wc, int fr, int fq) const {
        const int row0 = u.pm * BM + wr * 64 + fr, col0 = u.pn * BM + wc * 32 + 8 * fq;
#pragma unroll
        for (int ai = 0; ai < 2; ++ai) {
            u32x4 gw[4][2];
#pragma unroll
            for (int m = 0; m < 4; ++m)
#pragma unroll
                for (int bj = 0; bj < 2; ++bj) gw[m][bj] = *(const u32x4*)(gh + (size_t)(row0 + ai * HALF + m * 16) * 1024 + col0 + bj * HALF);
#pragma unroll
            for (int m = 0; m < 4; ++m) { const size_t o = (size_t)(row0 + ai * HALF + m * 16) * 1024 + col0;
#pragma unroll
                for (int bj = 0; bj < 2; ++bj) { const u32x4 g = gw[m][bj]; f32x4 v0 = acc[ai][bj][m][0], v1 = acc[ai][bj][m][1];
                    v0[0] *= sigm(blo(g.x)); v0[1] *= sigm(bhi(g.x)); v0[2] *= sigm(blo(g.y)); v0[3] *= sigm(bhi(g.y));
                    v1[0] *= sigm(blo(g.z)); v1[1] *= sigm(bhi(g.z)); v1[2] *= sigm(blo(g.w)); v1[3] *= sigm(bhi(g.w));
                    if (OUT8) { const float s_ = dq * 32.0f; u32x2 w; w.x = cvt4_fp8(v0[0] * s_, v0[1] * s_, v0[2] * s_, v0[3] * s_); w.y = cvt4_fp8(v1[0] * s_, v1[1] * s_, v1[2] * s_, v1[3] * s_);
                                *(u32x2*)((unsigned char*)out + o + bj * HALF) = w; }
                    else { u32x4 w; w.x = cvt_pk_bf16(v0[0] * dq, v0[1] * dq); w.y = cvt_pk_bf16(v0[2] * dq, v0[3] * dq); w.z = cvt_pk_bf16(v1[0] * dq, v1[1] * dq); w.w = cvt_pk_bf16(v1[2] * dq, v1[3] * dq);
                           *(u32x4*)(out + o + bj * HALF) = w; } } }
        }
    }
};

template <class T, class = void> struct has_mid { static constexpr bool value = false; };
template <class T> struct has_mid<T, decltype((void)T::HAS_MID)> { static constexpr bool value = true; };
template <class Epi, class Sched, bool ALIGN_EPI = false, bool SP2 = false, bool GATHER = false, int FP8 = 0  >
__device__ __forceinline__ void gemm_phase(PG8_LAS unsigned char* lds, const Gemm g, const Sched& S, const Epi& E, const int wave_id, const PG8_LAS unsigned short* gtab = nullptr) {
    typedef int i32x4 __attribute__((ext_vector_type(4))); typedef int i32x8 __attribute__((ext_vector_type(8)));
    static_assert(!GATHER || SP2, "GATHER needs the SP2 loop");
    int lane = (int)__builtin_amdgcn_mbcnt_hi(~0u, __builtin_amdgcn_mbcnt_lo(~0u, 0u)); asm volatile("" : "+v"(lane));
    const int wid = wave_id, tid = wid * 64 + lane, wr = wid >> 2, wc = wid & 3, fr = lane & 15, fq = lane >> 4;
    const int K = g.K, nt = K / BK;
    unsigned voffA[2], voffB[2];
#pragma unroll
    for (int i = 0; i < 2; ++i) { int R, C; stage_rc(tid * 16 + i * 8192, R, C); const int Rb = Epi::PERM ? ((R & ~31) + perm32(R & 31)) : R;
        voffA[i] = (unsigned)(R * K + C) * 2u; voffB[i] = (unsigned)(Rb * K + C) * 2u; }
    unsigned vA0[2] = {0u, 0u}, vA1[2] = {0u, 0u}, xA0[2] = {0u, 0u}, xA1[2] = {0u, 0u};
#define PG8_GLOAD(d0, d1, ui_) do { int tz_ = wid * 64 + (int)__builtin_amdgcn_mbcnt_hi(~0u, __builtin_amdgcn_mbcnt_lo(~0u, 0u)); asm volatile("" : "+v"(tz_)); _Pragma("unroll") for (int _i = 0; _i < 2; ++_i) { int R_, C_; stage_rc(tz_ * 16 + _i * 8192, R_, C_); \
        d0[_i] = (unsigned)gtab[256 * (ui_) + R_] * (unsigned)(K * 2) + (unsigned)C_ * 2u; d1[_i] = (unsigned)gtab[256 * (ui_) + 128 + R_] * (unsigned)(K * 2) + (unsigned)C_ * 2u; } } while (0)
    const unsigned kstep = (unsigned)(BK * 2);
    const unsigned hstep = (unsigned)HALF * K * 2;
    const unsigned tstep = 2 * hstep;
    const __amdgpu_buffer_rsrc_t rsA = __builtin_amdgcn_make_buffer_rsrc((void*)g.A, 0, 0x7fffffff, 0x00020000), rsB = __builtin_amdgcn_make_buffer_rsrc((void*)g.Bt, 0, 0x7fffffff, 0x00020000);
    const unsigned ldsw = (unsigned)wid * 1024u;
    const int aoff = lds_byte(wr * 64 + fr, fq * 8), boff = lds_byte(wc * 32 + fr, fq * 8);
#define PG8_SA(b, h) (((b) * 2 + (h)) * HTB)
#define PG8_SB(b, h) ((4 + (b) * 2 + (h)) * HTB)
#define PG8_STAGE(bufoff, rs, soff, voff) do { _Pragma("unroll") for (int _i = 0; _i < 2; ++_i) \
        __builtin_amdgcn_raw_ptr_buffer_load_lds(rs, (PG8_LAS void*)(lds + (bufoff) + ldsw + _i * 8192), 16, (int)(voff)[_i], (int)(soff), 0, 0); } while (0)
#define PG8_LDA(dst, b, h) do { if constexpr (FP8 == 1) { _Pragma("unroll") for (int m = 0; m < 4; ++m) dst##_8[m] = __builtin_shufflevector(*(const PG8_LAS i32x4*)(lds + PG8_SA(b, h) + aoff + m * 2048), *(const PG8_LAS i32x4*)(lds + PG8_SA(b, h) + aoff + m * 2048 + 1024), 0, 1, 2, 3, 4, 5, 6, 7); } \
        else { _Pragma("unroll") for (int m = 0; m < 4; ++m) _Pragma("unroll") for (int k = 0; k < 2; ++k) dst[m][k] = *(const PG8_LAS bf16x8*)(lds + PG8_SA(b, h) + aoff + m * 2048 + k * 1024); } } while (0)
#define PG8_LDB(dst, b, h) do { if constexpr (FP8 == 1) { _Pragma("unroll") for (int n = 0; n < 2; ++n) dst##_8[n] = __builtin_shufflevector(*(const PG8_LAS i32x4*)(lds + PG8_SB(b, h) + boff + n * 2048), *(const PG8_LAS i32x4*)(lds + PG8_SB(b, h) + boff + n * 2048 + 1024), 0, 1, 2, 3, 4, 5, 6, 7); } \
        else { _Pragma("unroll") for (int n = 0; n < 2; ++n) _Pragma("unroll") for (int k = 0; k < 2; ++k) dst[n][k] = *(const PG8_LAS bf16x8*)(lds + PG8_SB(b, h) + boff + n * 2048 + k * 1024); } } while (0)
#define PG8_MMA(ai, bj, At, Bt) do { __builtin_amdgcn_s_setprio(1); if constexpr (FP8 == 1) { _Pragma("unroll") for (int m = 0; m < 4; ++m) _Pragma("unroll") for (int n = 0; n < 2; ++n) \
        asm volatile("v_mfma_scale_f32_16x16x128_f8f6f4 %0, %1, %2, %0, %3, %3 op_sel_hi:[0,0,0]" : "+v"(acc[ai][bj][m][n]) : "v"(Bt##_8[n]), "v"(At##_8[m]), "v"(sc8));     \
        } else if constexpr (FP8 == 2) { _Pragma("unroll") for (int m = 0; m < 4; ++m) _Pragma("unroll") for (int n = 0; n < 2; ++n) _Pragma("unroll") for (int k = 0; k < 2; ++k) \
        acci[ai][bj][m][n] = __builtin_amdgcn_mfma_i32_16x16x64_i8(__builtin_bit_cast(i32x4, Bt[n][k]), __builtin_bit_cast(i32x4, At[m][k]), acci[ai][bj][m][n], 0, 0, 0); \
        } else { _Pragma("unroll") for (int m = 0; m < 4; ++m) _Pragma("unroll") for (int n = 0; n < 2; ++n) _Pragma("unroll") for (int k = 0; k < 2; ++k) \
        acc[ai][bj][m][n] = __builtin_amdgcn_mfma_f32_16x16x32_bf16(Bt[n][k], At[m][k], acc[ai][bj][m][n], 0, 0, 0); } __builtin_amdgcn_s_setprio(0); } while (0)
#define PG8_WAIT_V(n) asm volatile("s_waitcnt vmcnt(" #n ")" ::: "memory")
#define PG8_WAIT_L(n) asm volatile("s_waitcnt lgkmcnt(" #n ")" ::: "memory")
#define PG8_BAR __builtin_amdgcn_s_barrier()
#define PG8_SCHED __builtin_amdgcn_sched_barrier(0)
    Unit cur, nxt; int ui = 0;
    if (!S.next(0, cur)) return;
    f32x4 acc[2][2][4][2]; i32x4 acci[2][2][4][2];
#pragma unroll
    for (int a = 0; a < 2; ++a)
#pragma unroll
        for (int b = 0; b < 2; ++b)
#pragma unroll
            for (int m = 0; m < 4; ++m)
#pragma unroll
                for (int n = 0; n < 2; ++n) { acc[a][b][m][n] = (f32x4){0.f, 0.f, 0.f, 0.f}; acci[a][b][m][n] = (i32x4){0, 0, 0, 0}; }
    int sc8 = 0x7f7f7f7f; asm volatile("" : "+v"(sc8));
    bf16x8 At[4][2], B0[2][2], B1[2][2]; i32x8 At_8[4], B0_8[2], B1_8[2];
    unsigned cA = GATHER ? 0u : (unsigned)cur.pm * tstep, cB = (unsigned)cur.pn * tstep;
    S.a_ready(cur);
    if constexpr (GATHER) { PG8_GLOAD(vA0, vA1, 0); xA0[0] = vA0[0]; xA0[1] = vA0[1]; xA1[0] = vA1[0]; xA1[1] = vA1[1]; }
    if constexpr (SP2) {
        PG8_STAGE(PG8_SB(0, 0), rsB, cB, voffB); PG8_STAGE(PG8_SB(0, 1), rsB, cB + hstep, voffB);
        if constexpr (GATHER) { PG8_STAGE(PG8_SA(0, 0), rsA, cA, vA0); PG8_STAGE(PG8_SA(0, 1), rsA, cA, vA1); } else { PG8_STAGE(PG8_SA(0, 0), rsA, cA, voffA); PG8_STAGE(PG8_SA(0, 1), rsA, cA + hstep, voffA); }
        if (wr == 1) PG8_BAR;
        PG8_WAIT_V(2); PG8_BAR;
        PG8_STAGE(PG8_SB(1, 0), rsB, cB + kstep, voffB); if constexpr (GATHER) { PG8_STAGE(PG8_SA(1, 0), rsA, cA + kstep, vA0); } else { PG8_STAGE(PG8_SA(1, 0), rsA, cA + kstep, voffA); } PG8_STAGE(PG8_SB(1, 1), rsB, cB + hstep + kstep, voffB);
        PG8_WAIT_V(6); PG8_BAR;
    } else {
        PG8_STAGE(PG8_SB(0, 0), rsB, cB, voffB); PG8_STAGE(PG8_SA(0, 0), rsA, cA, voffA); PG8_STAGE(PG8_SB(0, 1), rsB, cB + hstep, voffB); PG8_STAGE(PG8_SA(0, 1), rsA, cA + hstep, voffA);
        if (wr == 1) PG8_BAR;
        PG8_WAIT_V(4); PG8_BAR;
        PG8_STAGE(PG8_SB(1, 0), rsB, cB + kstep, voffB); PG8_STAGE(PG8_SA(1, 0), rsA, cA + kstep, voffA); PG8_STAGE(PG8_SB(1, 1), rsB, cB + hstep + kstep, voffB);
        PG8_WAIT_V(6); PG8_BAR;
    }
    for (;;) {
        const bool has_next = S.next(ui + 1, nxt);
        const unsigned nA = GATHER ? cA : (has_next ? (unsigned)nxt.pm * tstep : cA), nB = has_next ? (unsigned)nxt.pn * tstep : cB;
        for (int t = 0; t < nt; t += 2) {
            const bool last = (t == nt - 2);
            const unsigned a1 = cA + (unsigned)(t + 1) * kstep;
            const unsigned a2 = last ? nA : cA + (unsigned)(t + 2) * kstep, b2 = last ? nB : cB + (unsigned)(t + 2) * kstep;
            const unsigned a3 = a2 + kstep, b3 = b2 + kstep;
            if (last && has_next) S.a_ready(nxt);
            if constexpr (has_mid<Epi>::value) { if (t == nt / 2) { int l3_ = (int)__builtin_amdgcn_mbcnt_hi(~0u, __builtin_amdgcn_mbcnt_lo(~0u, 0u)); asm volatile("" : "+v"(l3_)); E.mid(acc, cur, wr, wc, l3_ & 15, l3_ >> 4); } }
            if constexpr (GATHER) { if (last && has_next) { PG8_GLOAD(xA0, xA1, ui + 1); } }
            if constexpr (SP2) {
            PG8_LDB(B0, 0, 0); PG8_LDB(B1, 0, 1); PG8_SCHED; PG8_LDA(At, 0, 0); if constexpr (GATHER) { PG8_STAGE(PG8_SA(1, 1), rsA, a1, vA1); } else { PG8_STAGE(PG8_SA(1, 1), rsA, a1 + hstep, voffA); }
            PG8_WAIT_V(8); PG8_WAIT_L(0); PG8_BAR; PG8_MMA(0, 0, At, B0); PG8_MMA(0, 1, At, B1); PG8_BAR; PG8_SCHED;
            PG8_LDA(At, 0, 1); PG8_STAGE(PG8_SB(0, 0), rsB, b2, voffB); PG8_STAGE(PG8_SB(0, 1), rsB, b2 + hstep, voffB); if constexpr (GATHER) { PG8_STAGE(PG8_SA(0, 0), rsA, a2, xA0); } else { PG8_STAGE(PG8_SA(0, 0), rsA, a2, voffA); }
            PG8_WAIT_V(8); PG8_WAIT_L(0); PG8_BAR; PG8_MMA(1, 0, At, B0); PG8_MMA(1, 1, At, B1); PG8_BAR; PG8_SCHED;
            PG8_LDB(B0, 1, 0); PG8_LDB(B1, 1, 1); PG8_SCHED; PG8_LDA(At, 1, 0); if constexpr (GATHER) { PG8_STAGE(PG8_SA(0, 1), rsA, a2, xA1); } else { PG8_STAGE(PG8_SA(0, 1), rsA, a2 + hstep, voffA); }
            PG8_WAIT_V(8); PG8_WAIT_L(0); PG8_BAR; PG8_MMA(0, 0, At, B0); PG8_MMA(0, 1, At, B1); PG8_BAR; PG8_SCHED;
            PG8_LDA(At, 1, 1); PG8_STAGE(PG8_SB(1, 0), rsB, b3, voffB); PG8_STAGE(PG8_SB(1, 1), rsB, b3 + hstep, voffB); if constexpr (GATHER) { PG8_STAGE(PG8_SA(1, 0), rsA, a3, xA0); } else { PG8_STAGE(PG8_SA(1, 0), rsA, a3, voffA); }
            PG8_WAIT_V(8); PG8_WAIT_L(0); PG8_BAR; PG8_MMA(1, 0, At, B0); PG8_MMA(1, 1, At, B1); PG8_BAR; PG8_SCHED;
            } else {
            PG8_LDB(B0, 0, 0); PG8_SCHED; PG8_LDA(At, 0, 0); PG8_STAGE(PG8_SA(1, 1), rsA, a1 + hstep, voffA);
            PG8_WAIT_L(8); PG8_BAR; PG8_WAIT_L(0); PG8_MMA(0, 0, At, B0); PG8_BAR; PG8_SCHED;
            PG8_LDB(B1, 0, 1); PG8_STAGE(PG8_SB(0, 0), rsB, b2, voffB);
            PG8_BAR; PG8_WAIT_L(0); PG8_MMA(0, 1, At, B1); PG8_BAR;
            PG8_LDA(At, 0, 1); PG8_STAGE(PG8_SA(0, 0), rsA, a2, voffA);
            PG8_BAR; PG8_WAIT_L(0); PG8_MMA(1, 0, At, B0); PG8_BAR; PG8_SCHED;
            PG8_STAGE(PG8_SB(0, 1), rsB, b2 + hstep, voffB);
            PG8_WAIT_V(6); PG8_BAR; PG8_MMA(1, 1, At, B1); PG8_BAR;
            PG8_LDB(B0, 1, 0); PG8_SCHED; PG8_LDA(At, 1, 0); PG8_STAGE(PG8_SA(0, 1), rsA, a2 + hstep, voffA);
            PG8_WAIT_L(8); PG8_BAR; PG8_WAIT_L(0); PG8_MMA(0, 0, At, B0); PG8_BAR; PG8_SCHED;
            PG8_LDB(B1, 1, 1); PG8_STAGE(PG8_SB(1, 0), rsB, b3, voffB);
            PG8_BAR; PG8_WAIT_L(0); PG8_MMA(0, 1, At, B1); PG8_BAR;
            PG8_LDA(At, 1, 1); PG8_STAGE(PG8_SA(1, 0), rsA, a3, voffA);
            PG8_BAR; PG8_WAIT_L(0); PG8_MMA(1, 0, At, B0); PG8_BAR; PG8_SCHED;
            PG8_STAGE(PG8_SB(1, 1), rsB, b3 + hstep, voffB);
            PG8_WAIT_V(6); PG8_BAR; PG8_MMA(1, 1, At, B1); PG8_BAR;
            }
        }
        if constexpr (ALIGN_EPI) { if (wr == 0) PG8_BAR; }
        if constexpr (FP8 == 2) { _Pragma("unroll") for (int a = 0; a < 2; ++a) _Pragma("unroll") for (int bq = 0; bq < 2; ++bq) _Pragma("unroll") for (int m = 0; m < 4; ++m) _Pragma("unroll") for (int n = 0; n < 2; ++n) acc[a][bq][m][n] = __builtin_convertvector(acci[a][bq][m][n], f32x4); }
        if constexpr (FP8 == 1) asm volatile("s_nop 15\n\ts_nop 15" ::: "memory");
        if constexpr (!Epi::AFTER_DRAIN) { int l2_ = (int)__builtin_amdgcn_mbcnt_hi(~0u, __builtin_amdgcn_mbcnt_lo(~0u, 0u)); asm volatile("" : "+v"(l2_));
            E(acc, cur, wr, wc, l2_ & 15, l2_ >> 4); S.done(cur); }
        if (!has_next) break;
#pragma unroll
        for (int a = 0; a < 2; ++a)
#pragma unroll
            for (int b = 0; b < 2; ++b)
#pragma unroll
                for (int m = 0; m < 4; ++m)
#pragma unroll
                    for (int n = 0; n < 2; ++n) { acc[a][b][m][n] = (f32x4){0.f, 0.f, 0.f, 0.f}; acci[a][b][m][n] = (i32x4){0, 0, 0, 0}; }
        cur = nxt; cA = nA; cB = nB; ++ui;
        if constexpr (GATHER) { vA0[0] = xA0[0]; vA0[1] = xA0[1]; vA1[0] = xA1[0]; vA1[1] = xA1[1]; }
        if constexpr (ALIGN_EPI) { if (wr == 1) PG8_BAR; }
    }
    PG8_WAIT_V(0);
    if constexpr (!ALIGN_EPI) { if (wr == 0) PG8_BAR; }
    PG8_BAR;
    if constexpr (Epi::AFTER_DRAIN) { E.fused(acc, cur, wr, wc, fr, fq, lds, wid, lane); S.done(cur); }
#undef PG8_GLOAD
#undef PG8_SA
#undef PG8_SB
#undef PG8_STAGE
#undef PG8_LDA
#undef PG8_LDB
#undef PG8_MMA
#undef PG8_WAIT_V
#undef PG8_WAIT_L
#undef PG8_BAR
#undef PG8_SCHED
}
}
#define XB_TMO      128
#define XB_XCNT(j)  (256  + 64 * (j))
#define XB_XSUB(j)  (1280 + 64 * (j))
#define XB_XGEN(j)  (2304 + 64 * (j))
#define XB_TOP      3328
#define XB_TOPGEN   3392
#define XCD_BAR_WORDS 3456
#define XB_SPIN_CAP (1u << 18)

__device__ __forceinline__ unsigned xb_ld(unsigned* p)              { return __hip_atomic_load(p, __ATOMIC_RELAXED, __HIP_MEMORY_SCOPE_AGENT); }
__device__ __forceinline__ unsigned xb_add(unsigned* p, unsigned v) { return __hip_atomic_fetch_add(p, v, __ATOMIC_RELAXED, __HIP_MEMORY_SCOPE_AGENT); }
__device__ __forceinline__ unsigned xb_xcc_id() { return (unsigned)__builtin_amdgcn_s_getreg((3 << 11) | 20) & 0xFu; }
#define XB_SPIN(cond, bar) do { unsigned _sp = 0; while (cond) { __builtin_amdgcn_s_sleep(1); \
    if ((++_sp & 255u) == 0u) { if (xb_ld(&(bar)[XB_TMO])) break; if (_sp > XB_SPIN_CAP) { atomicAdd(&(bar)[XB_TMO], 1u); break; } } } } while (0)

struct XcdBarrier {
    unsigned* bar; unsigned x;
    volatile LAS unsigned* st;
};

__device__ __forceinline__ XcdBarrier xcd_barrier_post(unsigned* bar, volatile LAS unsigned* st, const bool leader  ) {
    XcdBarrier b; b.bar = bar; b.x = xb_xcc_id(); b.st = st;
    if (leader) (void)xb_add(&bar[XB_XCNT(b.x)], 1u);
    return b;
}
__device__ __forceinline__ void xcd_barrier_complete(unsigned* bar, unsigned x, unsigned& nloc, unsigned& nx) {
    const unsigned G = gridDim.x * gridDim.y * gridDim.z;
    unsigned sum, cnt, mine, sp = 0u;
    for (;;) {
        sum = 0u; cnt = 0u; mine = 0u;
#pragma unroll
        for (unsigned j = 0; j < 16; ++j) { const unsigned c = xb_ld(&bar[XB_XCNT(j)]); sum += c; cnt += (c > 0u) ? 1u : 0u; mine = (j == x) ? c : mine; }
        if (sum == G) break;
        __builtin_amdgcn_s_sleep(1);
        if ((++sp & 255u) == 0u) { if (xb_ld(&bar[XB_TMO])) break; if (sp > XB_SPIN_CAP) { atomicAdd(&bar[XB_TMO], 1u); break; } }
    }
    nloc = mine > 0u ? mine : 1u; nx = cnt > 0u ? cnt : 1u;
}

__device__ __forceinline__ void xcd_barrier(const XcdBarrier& b, const bool leader  ) {
    asm volatile("s_waitcnt vmcnt(0)" ::: "memory");
    __syncthreads();
    if (leader) {
        unsigned* bar = b.bar;
        __builtin_amdgcn_s_waitcnt(0);
        unsigned nloc = b.st[0], nx = b.st[1];
        if (nloc == 0u) { xcd_barrier_complete(bar, b.x, nloc, nx); b.st[0] = nloc; b.st[1] = nx; }
        const unsigned old = xb_add(&bar[XB_XSUB(b.x)], 1u);
        const unsigned gen = old / nloc;
        if (old + 1u == (gen + 1u) * nloc) {
            __builtin_amdgcn_fence(__ATOMIC_RELEASE, "agent");
            asm volatile("s_waitcnt vmcnt(0)" ::: "memory");
            const unsigned og = xb_add(&bar[XB_TOP], 1u);
            const unsigned tg = og / nx;
            if (og + 1u == (tg + 1u) * nx) xb_add(&bar[XB_TOPGEN], 1u);
            else XB_SPIN(xb_ld(&bar[XB_TOPGEN]) == tg, bar);
            __builtin_amdgcn_fence(__ATOMIC_ACQUIRE, "agent");
            xb_add(&bar[XB_XGEN(b.x)], 1u);
            asm volatile("s_waitcnt vmcnt(0)" ::: "memory");
        } else {
            XB_SPIN(xb_ld(&bar[XB_XGEN(b.x)]) == gen, bar);
            __builtin_amdgcn_fence(__ATOMIC_ACQUIRE, "agent");
            asm volatile("s_waitcnt vmcnt(0)" ::: "memory");
        }
    }
    __syncthreads();
}

#ifndef MIX_FP8
#define MIX_FP8 1
#endif
#ifndef RES_FP8
#define RES_FP8 1
#endif
#ifndef P_INT8
#define P_INT8 1
#endif
#ifndef P_FP8_MASK
#define P_FP8_MASK 0xFFFFFFFFu
#endif =======================================================
struct Ctx { LAS unsigned char* lds; int tid, lane, wave, vcu, G; };

__device__ __forceinline__ void transpose_load64(const float* W, int ldw, int k0, int n0, LAS float* scr, int lane) {
#pragma unroll 8
    for (int i = 0; i < 16; ++i) { const int kk = 4 * i + (lane >> 4), nn = 4 * (lane & 15); const f32x4 v = *(const f32x4*)(W + (size_t)(k0 + kk) * ldw + n0 + nn);
        LAS float* d = scr + kk * 65 + nn; d[0] = v.x; d[1] = v.y; d[2] = v.z; d[3] = v.w; }
    LDS_WAIT();
}
__device__ __forceinline__ void transpose_item(const float* W, int ldw, int K, bf16_t* dst, int k0, int n0, LAS float* scr, int lane) {
    transpose_load64(W, ldw, k0, n0, scr, lane);
    const int c = lane & 7;
#pragma unroll
    for (int j = 0; j < 8; ++j) { const int n = (lane >> 3) + 8 * j; const LAS float* s = scr + (8 * c) * 65 + n;
        u32x4 o; o.x = pk2(s[0 * 65], s[1 * 65]); o.y = pk2(s[2 * 65], s[3 * 65]); o.z = pk2(s[4 * 65], s[5 * 65]); o.w = pk2(s[6 * 65], s[7 * 65]);
        *(u32x4*)(dst + (size_t)n * K + k0 + 8 * c) = o; }
    LDS_WAIT();
}
__device__ __forceinline__ void transpose_item8(const float* W, int ldw, int K, unsigned char* dst, int k0, int n0, float scale, LAS float* scr, int lane) {
    (void)scr;
    const int kc = lane & 3, nq = lane >> 2;
    const float* s = W + (size_t)(k0 + 16 * kc) * ldw + n0 + 4 * nq;
    f32x4 v[16];
#pragma unroll
    for (int i = 0; i < 16; ++i) v[i] = *(const f32x4*)(s + (size_t)i * ldw);
#pragma unroll
    for (int j = 0; j < 4; ++j) {
        u32x4 o; o.x = cvt4_fp8(v[0][j] * scale, v[1][j] * scale, v[2][j] * scale, v[3][j] * scale); o.y = cvt4_fp8(v[4][j] * scale, v[5][j] * scale, v[6][j] * scale, v[7][j] * scale);
        o.z = cvt4_fp8(v[8][j] * scale, v[9][j] * scale, v[10][j] * scale, v[11][j] * scale); o.w = cvt4_fp8(v[12][j] * scale, v[13][j] * scale, v[14][j] * scale, v[15][j] * scale);
        *(u32x4*)(dst + (size_t)(4 * nq + j) * K + k0 + 16 * kc) = o; }
}

template <int PART>
__device__ __forceinline__ void ph_prologue(const Ctx& X, const float* c, const float* w_ada, const float* b_ada, float* mod,
                                            const float* w_in, const float* w_conv_out, const float* w_hgrn_out, const float* w_out, const float* w1, const float* w2, unsigned char* ws) {
    if (PART == 0) for (int cbk = X.vcu; cbk < NMOD / 32; cbk += X.G) {
        LAS float* ca = (LAS float*)X.lds;
        LAS float* red = (LAS float*)(X.lds + 16384);
        for (int i = X.tid; i < 4096; i += 512) { const float v = c[i]; ca[i] = v * sigmoidf_(v); }
        __syncthreads();
        const int jj = X.tid & 31, kp = X.tid >> 5, j = cbk * 32 + jj;
        float a0 = 0.f, a1 = 0.f, a2 = 0.f, a3 = 0.f;
#pragma unroll 16
        for (int i = kp * 64; i < kp * 64 + 64; ++i) { const float w = w_ada[(size_t)i * NMOD + j]; a0 += ca[i] * w; a1 += ca[1024 + i] * w; a2 += ca[2048 + i] * w; a3 += ca[3072 + i] * w; }
        red[(kp * 4 + 0) * 32 + jj] = a0; red[(kp * 4 + 1) * 32 + jj] = a1; red[(kp * 4 + 2) * 32 + jj] = a2; red[(kp * 4 + 3) * 32 + jj] = a3;
        __syncthreads();
        if (X.tid < 128) { const int b = X.tid >> 5; float r = b_ada[j];
#pragma unroll
            for (int q = 0; q < 16; ++q) r += red[(q * 4 + b) * 32 + jj];
            mod[(size_t)b * NMOD + j] = r; }
        __syncthreads();
    }
    LAS float* scr = (LAS float*)(X.lds + X.wave * 16640);
    const bool split = PART == 0 && X.G > NMOD / 32;
    const int gw = split ? (X.vcu - NMOD / 32) * 8 + X.wave : X.vcu * 8 + X.wave, NGW = split ? (X.G - NMOD / 32) * 8 : X.G * 8;
    constexpr int I_IN = 16 * 128, I_SQ = 16 * 16, I_W1 = 32 * 16 * 32, I_W2 = 32 * 16 * 16, NITEMS = I_IN + 3 * I_SQ + I_W1 + I_W2;
    constexpr int I_DENSE = I_IN + 3 * I_SQ;
    if (!(split && X.vcu < NMOD / 32)) for (int it = (PART == 0 ? (P_INT8 ? I_IN : 0) : I_DENSE) + gw; it < (PART == 0 ? I_DENSE : NITEMS); it += NGW) {
        int r = it;
        if (r < I_IN) { const int kb = r >> 7, nb = r & 127, n0 = 64 * nb;
            const int rho0 = (n0 < 2048) ? 256 * ((n0 & 1023) >> 7) + 128 * (n0 >> 10) + (n0 & 127) : n0;
            if ((P_FP8_MASK >> (rho0 >> 8)) & 1u) transpose_item8(w_in, 8192, 1024, (unsigned char*)(ws + WS_WIN8) + (size_t)rho0 * 1024, 64 * kb, n0, 256.0f, scr, X.lane);
            else transpose_item(w_in, 8192, 1024, (bf16_t*)(ws + WS_WIN) + (size_t)rho0 * 1024, 64 * kb, n0, scr, X.lane);
            continue; } r -= I_IN;
        if (r < 3 * I_SQ) { const int which = r / I_SQ, q = r % I_SQ, kb = q >> 4, nb = q & 15;
            const float* W = which == 0 ? w_conv_out : (which == 1 ? w_hgrn_out : w_out);
            if (which == 2) { if (RES_FP8) transpose_item8(W, 1024, 1024, (unsigned char*)(ws + WS_WO) + (size_t)(64 * nb) * 1024, 64 * kb, 64 * nb, 256.0f, scr, X.lane);
                              else transpose_item(W, 1024, 1024, (bf16_t*)(ws + WS_WO) + (size_t)(64 * nb) * 1024, 64 * kb, 64 * nb, scr, X.lane); }
            else if (MIX_FP8) transpose_item8(W, 1024, 2048, (unsigned char*)(ws + WS_WC) + (size_t)(64 * nb) * 2048 + which * 1024, 64 * kb, 64 * nb, 256.0f, scr, X.lane);
            else transpose_item(W, 1024, 2048, (bf16_t*)(ws + WS_WC) + (size_t)(64 * nb) * 2048 + which * 1024, 64 * kb, 64 * nb, scr, X.lane);
            continue; } r -= 3 * I_SQ;
        if (r < I_W1) { const int e = r >> 9, q = r & 511, kb = q >> 5, nb = q & 31, n0 = 64 * nb;
            const int rho0 = (n0 < 1024) ? 256 * (n0 >> 7) + (n0 & 127) : 256 * ((n0 - 1024) >> 7) + 128 + ((n0 - 1024) & 127);
            transpose_item8(w1 + (size_t)e * 1024 * 2048, 2048, 1024, (unsigned char*)(ws + WS_W1) + ((size_t)e * 2048 + rho0) * 1024, 64 * kb, n0, 256.0f, scr, X.lane); continue; } r -= I_W1;
        { const int e = r >> 8, q = r & 255, kb = q >> 4, nb = q & 15;
            transpose_item8(w2 + (size_t)e * 1024 * 1024, 1024, 1024, (unsigned char*)(ws + WS_W2) + ((size_t)e * 1024 + 64 * nb) * 1024, 64 * kb, 64 * nb, 256.0f, scr, X.lane); }
    }
    __syncthreads();
}

__device__ __forceinline__ void ph_norm_mod(const Ctx& X, const float* x, const float* g, const float* mod, int sh_off, int sc_off, bf16_t* out, unsigned char* out8, float* hsc) {
    for (int t = X.vcu * 8 + X.wave; t < T; t += X.G * 8) {
        const int b = t / SEQ, lane = X.lane;
        const f32x4* xr = (const f32x4*)(x + (size_t)t * D) + lane;
        f32x4 v[4]; float ss = 0.f;
#pragma unroll
        for (int j = 0; j < 4; ++j) { v[j] = xr[64 * j]; ss += (v[j].x * v[j].x + v[j].y * v[j].y) + (v[j].z * v[j].z + v[j].w * v[j].w); }
        const float r = rsqrtf(wave_sum(ss) * (1.0f / D) + EPS);
        const float* sh = mod + (size_t)b * NMOD + sh_off; const float* sc = mod + (size_t)b * NMOD + sc_off;
        float am = 0.f;
#pragma unroll
        for (int j = 0; j < 4; ++j) {
            const int col = 4 * (lane + 64 * j);
            const f32x4 gg = *(const f32x4*)(g + col), s1 = *(const f32x4*)(sc + col), s0 = *(const f32x4*)(sh + col);
            v[j] = v[j] * r * gg * (s1 + 1.0f) + s0;
            am = fmaxf(fmaxf(am, fmaxf(fabsf(v[j].x), fabsf(v[j].y))), fmaxf(fabsf(v[j].z), fabsf(v[j].w)));
        }
        if (P_INT8) {
#pragma unroll
            for (int o = 1; o < 64; o <<= 1) am = fmaxf(am, __shfl_xor(am, o));
            am = fmaxf(am, 1e-20f); const float qs = 127.0f / am;
            if (lane == 0) hsc[t] = am * (1.0f / 127.0f);
#pragma unroll
            for (int j = 0; j < 4; ++j) *(unsigned*)(out8 + (size_t)t * D + 4 * (lane + 64 * j)) = q4_i8(v[j].x * qs, v[j].y * qs, v[j].z * qs, v[j].w * qs);
        } else {
#pragma unroll
            for (int j = 0; j < 4; ++j) { const int col = 4 * (lane + 64 * j); const f32x4 y = v[j];
                if (P_FP8_MASK != 0xFFFFFFFFu) { u32x2 w; w.x = pk2(y.x, y.y); w.y = pk2(y.z, y.w); *(u32x2*)(out + (size_t)t * D + col) = w; }
                if (P_FP8_MASK != 0u) *(unsigned*)(out8 + (size_t)t * D + col) = cvt4_fp8(y.x * 16.0f, y.y * 16.0f, y.z * 16.0f, y.w * 16.0f); }
        }
    }
}

__device__ __forceinline__ void ph_win_i8(const Ctx& X, const float* w_in, unsigned char* ws) {
    LAS float* part = (LAS float*)(X.lds + 8 * 8704);
    LAS float* cmax = part + 512;
    float* wsc = (float*)(ws + WS_WSC); unsigned char* wt = ws + WS_WIN8;
    const int tid = X.tid, c = tid & 31, kq = tid >> 5;
    for (int cb = X.vcu; cb < 256; cb += X.G) {
        const int n0 = 32 * cb;
        const int rho0 = (n0 < 2048) ? 256 * ((n0 & 1023) >> 7) + 128 * (n0 >> 10) + (n0 & 127) : n0;
        float v[64]; const float* p_ = w_in + (size_t)(kq * 64) * 8192 + n0 + c;
#pragma unroll
        for (int i = 0; i < 64; ++i) v[i] = p_[(size_t)i * 8192];
        float m = 0.f;
#pragma unroll
        for (int i = 0; i < 64; ++i) m = fmaxf(m, fabsf(v[i]));
        part[kq * 32 + c] = m;
        __syncthreads();
        if (tid < 32) { float m2 = 0.f;
#pragma unroll
            for (int q = 0; q < 16; ++q) m2 = fmaxf(m2, part[q * 32 + tid]);
            m2 = fmaxf(m2, 1e-30f); cmax[tid] = m2; wsc[rho0 + tid] = m2 * (1.0f / 127.0f); }
        __syncthreads();
        const float qs = 127.0f / cmax[c];
        unsigned char* d = wt + (size_t)(rho0 + c) * 1024 + kq * 64;
#pragma unroll
        for (int q = 0; q < 4; ++q) { u32x4 o;
            o.x = q4_i8(v[16 * q + 0] * qs, v[16 * q + 1] * qs, v[16 * q + 2] * qs, v[16 * q + 3] * qs); o.y = q4_i8(v[16 * q + 4] * qs, v[16 * q + 5] * qs, v[16 * q + 6] * qs, v[16 * q + 7] * qs);
            o.z = q4_i8(v[16 * q + 8] * qs, v[16 * q + 9] * qs, v[16 * q + 10] * qs, v[16 * q + 11] * qs); o.w = q4_i8(v[16 * q + 12] * qs, v[16 * q + 13] * qs, v[16 * q + 14] * qs, v[16 * q + 15] * qs);
            *(u32x4*)(d + 16 * q) = o; }
        __syncthreads();
    }
}

typedef float f32x2 __attribute__((ext_vector_type(2)));
__device__ __forceinline__ void ph_conv(const Ctx& X, const bf16_t* pU, const float* dw, const float* dwb, const float* lng, const float* lnb, bf16_t* uc) {
    LAS float* sm = (LAS float*)X.lds;
    const int tid = X.tid, lane = X.lane, wid = X.wave, c0 = 2 * tid;
    float w[31][2];
#pragma unroll
    for (int j = 0; j < 31; ++j) { w[j][0] = dw[j * 1024 + c0]; w[j][1] = dw[j * 1024 + c0 + 1]; }
    const float bias0 = dwb[c0], bias1 = dwb[c0 + 1];
    unsigned raw[62];
#define CONV_LOAD(task_) do { const int b_ = (task_) >> 8, s0_ = ((task_) & 255) * 32; const bf16_t* q_ = pU + (size_t)(b_ * SEQ) * D + c0; \
        _Pragma("unroll") for (int i = 0; i < 62; ++i) { const int s_ = s0_ - 30 + i; raw[i] = (s_ >= 0) ? *(const unsigned*)(q_ + (size_t)s_ * D) : 0u; } } while (0)
    int task = X.vcu;
    if (task < T / 32) CONV_LOAD(task);
    for (; task < T / 32; task += X.G) {
        const int b = task >> 8, s0 = (task & 255) * 32;
#pragma unroll
        for (int st = 0; st < 4; ++st) {
            float u[38][2];
#pragma unroll
            for (int i = 0; i < 38; ++i) { u[i][0] = bflo(raw[8 * st + i]); u[i][1] = bfhi(raw[8 * st + i]); }
#pragma unroll
            for (int t = 0; t < 8; ++t) {
                float a0 = bias0, a1 = bias1;
#pragma unroll
                for (int j = 0; j < 31; ++j) { a0 += w[j][0] * u[t + j][0]; a1 += w[j][1] * u[t + j][1]; }
                *(LAS f32x2*)(sm + (8 * st + t) * 1024 + c0) = (f32x2){a0, a1};
            }
        }
        if (task + X.G < T / 32) CONV_LOAD(task + X.G);
        __syncthreads();
#pragma unroll 2
        for (int i = 0; i < 4; ++i) {
            const int t = wid * 4 + i;
            f32x4 v[4]; float s = 0.f;
#pragma unroll
            for (int j = 0; j < 4; ++j) { v[j] = *(const LAS f32x4*)(sm + t * 1024 + 4 * (lane + 64 * j)); s += (v[j].x + v[j].y) + (v[j].z + v[j].w); }
            const float mean = wave_sum(s) * (1.0f / D); float q = 0.f;
#pragma unroll
            for (int j = 0; j < 4; ++j) { v[j] = v[j] - mean; q += (v[j].x * v[j].x + v[j].y * v[j].y) + (v[j].z * v[j].z + v[j].w * v[j].w); }
            const float rstd = rsqrtf(wave_sum(q) * (1.0f / D) + EPS);
#pragma unroll
            for (int j = 0; j < 4; ++j) {
                const int col = 4 * (lane + 64 * j);
                const f32x4 gg = *(const f32x4*)(lng + col), bb = *(const f32x4*)(lnb + col);
                f32x4 y = v[j] * rstd * gg + bb;
                y.x *= sigmoidf_(y.x); y.y *= sigmoidf_(y.y); y.z *= sigmoidf_(y.z); y.w *= sigmoidf_(y.w);
                u32x2 o; o.x = pk2(y.x, y.y); o.y = pk2(y.z, y.w);
                if (MIX_FP8) *(unsigned*)((unsigned char*)uc + (size_t)(b * SEQ + s0 + t) * (2 * D) + col) = cvt4_fp8(y.x * 16.0f, y.y * 16.0f, y.z * 16.0f, y.w * 16.0f);
                else *(u32x2*)(uc + (size_t)(b * SEQ + s0 + t) * (2 * D) + col) = o;
            }
        }
        __syncthreads();
    }
#undef CONV_LOAD
}

typedef short bf16x8 __attribute__((ext_vector_type(8)));
typedef short s16x4 __attribute__((ext_vector_type(4)));
constexpr int HG_QA = 0, HG_KA = 17408, HG_VR = 34816, HG_AB = 52224, HG_SPT = 61440, HG_O = 96256, HG_SEG = 130048;
constexpr size_t HM = (size_t)SEQ * 128;
__device__ __forceinline__ bf16x8 tr_frag(LAS unsigned char* base, int rs, int ks, int c16, int lane) {
    const int g = lane >> 4, q = (lane & 15) >> 2, p = lane & 3;
    LAS unsigned char* a = base + (32 * ks + 8 * g + q) * rs + (16 * c16 + 4 * p) * 2;
    const s16x4 lo = __builtin_amdgcn_ds_read_tr16_b64_v4i16((LAS s16x4*)a);
    const s16x4 hi = __builtin_amdgcn_ds_read_tr16_b64_v4i16((LAS s16x4*)(a + 4 * rs));
    return __builtin_shufflevector(lo, hi, 0, 1, 2, 3, 4, 5, 6, 7);
}
template <bool OUT>
__device__ __forceinline__ void ph_hgrn(const Ctx& X, int ntask, const bf16_t* pQ, const bf16_t* pF, const bf16_t* pI, const bf16_t* pG,
                                        const float* lb_param, const float* norm_g, const float* S0, float* dS, float* Dd, bf16_t* og) {
    LAS unsigned char* L = X.lds;
    LAS float* seg_s = (LAS float*)(L + HG_SEG);
    const int tid = X.tid, lane = X.lane, wave = X.wave, fr = lane & 15, fq = lane >> 4, wr = wave >> 1, wc = wave & 1;
    const int cp = tid & 63, seg = wave, tv = tid >> 3, vc = tid & 7;
    int idx = X.vcu; if (idx >= ntask) return;
    int ch = 0;
    unsigned zr[8], qr[8]; u32x4 vr0, vr1, gn0, gn1, gc0, gc1;
#define HG_LOAD(idx_, ch_) do { const int bh_ = (idx_) & 31, sc_ = (idx_) >> 5; const size_t tb_ = (size_t)bh_ * HM + (size_t)(sc_ * 256 + (ch_) * 64) * 128; \
        _Pragma("unroll") for (int i = 0; i < 8; ++i) { zr[i] = *(const unsigned*)(pF + tb_ + (size_t)(8 * seg + i) * 128 + 2 * cp); if (OUT) qr[i] = *(const unsigned*)(pQ + tb_ + (size_t)(8 * seg + i) * 128 + 2 * cp); } \
        { const u32x4* s_ = (const u32x4*)(pI + tb_ + (size_t)tv * 128 + vc * 16); vr0 = s_[0]; vr1 = s_[1]; } \
        if (OUT) { const u32x4* s_ = (const u32x4*)(pG + tb_ + (size_t)tv * 128 + vc * 16); gn0 = s_[0]; gn1 = s_[1]; } } while (0)
    HG_LOAD(idx, 0);
    float ngv[16];
    if (OUT) {
#pragma unroll
        for (int i = 0; i < 16; ++i) ngv[i] = norm_g[vc * 16 + i];
    }
    f32x4 S[8]; float oml0 = 0.f, oml1 = 0.f, gsum0 = 0.f, gsum1 = 0.f;
#pragma unroll 1
    for (;;) {
        const int sc = idx >> 5, bh = idx & 31, b = bh >> 3, h = bh & 7;
        if (ch == 0) {
            const int c0 = h * 128 + 2 * cp;
            oml0 = 1.0f - 1.0f / (1.0f + __expf(lb_param[1024 + c0] - lb_param[c0])); oml1 = 1.0f - 1.0f / (1.0f + __expf(lb_param[1025 + c0] - lb_param[c0 + 1]));
            gsum0 = 0.f; gsum1 = 0.f;
            if (OUT && sc > 0) { const float* s0 = S0 + (size_t)(bh * 32 + sc) * 16384;
#pragma unroll
                for (int vt = 0; vt < 8; ++vt)
#pragma unroll
                    for (int j = 0; j < 4; ++j) S[vt][j] = s0[(size_t)(16 * wave + fq * 4 + j) * 128 + vt * 16 + fr];
            } else {
#pragma unroll
                for (int vt = 0; vt < 8; ++vt) S[vt] = (f32x4){0.f, 0.f, 0.f, 0.f};
            }
        }
        float kk0[8], kk1[8], lf0[8], lf1[8], q0[8], q1[8];
        {
            float c0 = 0.f, c1 = 0.f;
#pragma unroll
            for (int i = 0; i < 8; ++i) {
                kk0[i] = oml0 * __builtin_amdgcn_rcpf(1.0f + __expf(bflo(zr[i]))); kk1[i] = oml1 * __builtin_amdgcn_rcpf(1.0f + __expf(bfhi(zr[i])));
                c0 += __builtin_amdgcn_logf(1.0f - kk0[i]); c1 += __builtin_amdgcn_logf(1.0f - kk1[i]); lf0[i] = c0; lf1[i] = c1;
                if (OUT) { q0[i] = bflo(qr[i]) * 0.08838834764831845f; q1[i] = bfhi(qr[i]) * 0.08838834764831845f; }
            }
            *(LAS f32x2*)(seg_s + seg * 128 + 2 * cp) = (f32x2){c0, c1};
        }
        if (OUT) { gc0 = gn0; gc1 = gn1; }
        const u32x4 vcur0 = vr0, vcur1 = vr1;
        __syncthreads();
        { LAS u32x4* d = (LAS u32x4*)(L + HG_VR + tv * 272 + vc * 32); d[0] = vcur0; d[1] = vcur1; }
        { int idx2 = idx, ch2 = ch + 1; if (ch2 == 4) { ch2 = 0; idx2 = idx + X.G; } if (idx2 < ntask) HG_LOAD(idx2, ch2); }
        {
            f32x2 ss[8];
#pragma unroll
            for (int s = 0; s < 8; ++s) ss[s] = *(const LAS f32x2*)(seg_s + s * 128 + 2 * cp);
            float off0 = 0.f, off1 = 0.f;
#pragma unroll
            for (int s = 0; s < 8; ++s) { off0 += (s < seg) ? ss[s].x : 0.f; off1 += (s < seg) ? ss[s].y : 0.f; }
            const float R0 = (ss[0].x + ss[1].x) + (ss[2].x + ss[3].x), R1 = (ss[0].y + ss[1].y) + (ss[2].y + ss[3].y);
            if (!OUT && seg == 0) { gsum0 += R0 + (ss[4].x + ss[5].x) + (ss[6].x + ss[7].x); gsum1 += R1 + (ss[4].y + ss[5].y) + (ss[6].y + ss[7].y); }
#pragma unroll
            for (int i = 0; i < 8; ++i) {
                const float G0 = off0 + lf0[i], G1 = off1 + lf1[i];
                const float ka0 = kk0[i] * __builtin_amdgcn_exp2f(fminf(R0 - G0, 115.0f)), ka1 = kk1[i] * __builtin_amdgcn_exp2f(fminf(R1 - G1, 115.0f));
                *(LAS unsigned*)(L + HG_KA + (8 * seg + i) * 272 + 4 * cp) = pk2(ka0, ka1);
                if (OUT) { const float qa0 = q0[i] * __builtin_amdgcn_exp2f(fminf(G0 - R0, 115.0f)), qa1 = q1[i] * __builtin_amdgcn_exp2f(fminf(G1 - R1, 115.0f));
                           *(LAS unsigned*)(L + HG_QA + (8 * seg + i) * 272 + 4 * cp) = pk2(qa0, qa1); }
            }
        }
        float eR[4], eL[4];
        {
            f32x4 r4 = (f32x4){0.f, 0.f, 0.f, 0.f}, l4 = (f32x4){0.f, 0.f, 0.f, 0.f};
#pragma unroll
            for (int s = 0; s < 4; ++s) { r4 += *(const LAS f32x4*)(seg_s + s * 128 + 16 * wave + 4 * fq); l4 += *(const LAS f32x4*)(seg_s + (s + 4) * 128 + 16 * wave + 4 * fq); }
#pragma unroll
            for (int j = 0; j < 4; ++j) { eR[j] = __builtin_amdgcn_exp2f(fmaxf(r4[j], -115.0f)); eL[j] = __builtin_amdgcn_exp2f(l4[j]); }
        }
#pragma unroll
        for (int vt = 0; vt < 8; ++vt) {
#pragma unroll
            for (int j = 0; j < 4; ++j) S[vt][j] *= eR[j];
            if (OUT) { u32x2 w; w.x = pk2(S[vt][0], S[vt][1]); w.y = pk2(S[vt][2], S[vt][3]);
                       *(LAS u32x2*)(L + HG_SPT + (vt * 16 + fr) * 272 + (16 * wave + 4 * fq) * 2) = w; }
        }
        __syncthreads();
        if (OUT) {
#pragma unroll
            for (int q2 = 0; q2 < 2; ++q2) {
                const int st = 2 * wc + q2;
                f32x4 acc = (f32x4){0.f, 0.f, 0.f, 0.f};
                if (st <= wr) {
#pragma unroll
                    for (int kq = 0; kq < 4; ++kq) {
                        const bf16x8 af = *(const LAS bf16x8*)(L + HG_KA + (st * 16 + fr) * 272 + kq * 64 + fq * 16);
                        const bf16x8 bq = *(const LAS bf16x8*)(L + HG_QA + (wr * 16 + fr) * 272 + kq * 64 + fq * 16);
                        acc = __builtin_amdgcn_mfma_f32_16x16x32_bf16(af, bq, acc, 0, 0, 0);
                    }
                    const int tt = wr * 16 + fr;
#pragma unroll
                    for (int j = 0; j < 4; ++j) { const int s_ = st * 16 + fq * 4 + j; acc[j] = (s_ <= tt) ? acc[j] : 0.f; }
                }
                u32x2 w; w.x = pk2(acc[0], acc[1]); w.y = pk2(acc[2], acc[3]);
                *(LAS u32x2*)(L + HG_AB + (wr * 16 + fr) * 144 + (st * 16 + fq * 4) * 2) = w;
            }
        }
        {
            bf16x8 aK[2];
#pragma unroll
            for (int ks = 0; ks < 2; ++ks) aK[ks] = tr_frag(L + HG_KA, 272, ks, wave, lane);
#pragma unroll
            for (int vt = 0; vt < 8; ++vt) {
#pragma unroll
                for (int ks = 0; ks < 2; ++ks) { const bf16x8 bv = tr_frag(L + HG_VR, 272, ks, vt, lane); S[vt] = __builtin_amdgcn_mfma_f32_16x16x32_bf16(aK[ks], bv, S[vt], 0, 0, 0); }
#pragma unroll
                for (int j = 0; j < 4; ++j) S[vt][j] *= eL[j];
            }
        }
        if (OUT) {
            __syncthreads();
            bf16x8 aA[2], aQ[4];
#pragma unroll
            for (int ks = 0; ks < 2; ++ks) aA[ks] = *(const LAS bf16x8*)(L + HG_AB + (wr * 16 + fr) * 144 + ks * 64 + fq * 16);
#pragma unroll
            for (int kq = 0; kq < 4; ++kq) aQ[kq] = *(const LAS bf16x8*)(L + HG_QA + (wr * 16 + fr) * 272 + kq * 64 + fq * 16);
#pragma unroll
            for (int n = 0; n < 4; ++n) {
                const int vt = wc * 4 + n;
                f32x4 o = (f32x4){0.f, 0.f, 0.f, 0.f};
#pragma unroll
                for (int ks = 0; ks < 2; ++ks) { const bf16x8 bv = tr_frag(L + HG_VR, 272, ks, vt, lane); o = __builtin_amdgcn_mfma_f32_16x16x32_bf16(aA[ks], bv, o, 0, 0, 0); }
#pragma unroll
                for (int kq = 0; kq < 4; ++kq) { const bf16x8 bs = *(const LAS bf16x8*)(L + HG_SPT + (vt * 16 + fr) * 272 + kq * 64 + fq * 16); o = __builtin_amdgcn_mfma_f32_16x16x32_bf16(aQ[kq], bs, o, 0, 0, 0); }
#pragma unroll
                for (int j = 0; j < 4; ++j) *(LAS float*)(L + HG_O + (wr * 16 + fq * 4 + j) * 528 + (vt * 16 + fr) * 4) = o[j];
            }
            __syncthreads();
            {
                f32x4 ov[4]; float ssq = 0.f;
#pragma unroll
                for (int i = 0; i < 4; ++i) { ov[i] = *(const LAS f32x4*)(L + HG_O + tv * 528 + vc * 64 + i * 16); ssq += (ov[i].x * ov[i].x + ov[i].y * ov[i].y) + (ov[i].z * ov[i].z + ov[i].w * ov[i].w); }
                ssq += __shfl_xor(ssq, 1); ssq += __shfl_xor(ssq, 2); ssq += __shfl_xor(ssq, 4);
                const float rstd = rsqrtf(ssq * (1.0f / 128.0f) + EPS);
                const unsigned gw[8] = {gc0.x, gc0.y, gc0.z, gc0.w, gc1.x, gc1.y, gc1.z, gc1.w};
                unsigned ow[8]; float yv[16];
#pragma unroll
                for (int i = 0; i < 8; ++i) { const float g0 = bflo(gw[i]), g1 = bfhi(gw[i]);
                    const float y0 = ov[i >> 1][(2 * i) & 3] * rstd * ngv[2 * i] * g0 * __builtin_amdgcn_rcpf(1.0f + __expf(-g0));
                    const float y1 = ov[i >> 1][(2 * i + 1) & 3] * rstd * ngv[2 * i + 1] * g1 * __builtin_amdgcn_rcpf(1.0f + __expf(-g1));
                    ow[i] = pk2(y0, y1); yv[2 * i] = y0; yv[2 * i + 1] = y1; }
                if (MIX_FP8) { u32x4 o8; o8.x = cvt4_fp8(yv[0] * 16.0f, yv[1] * 16.0f, yv[2] * 16.0f, yv[3] * 16.0f); o8.y = cvt4_fp8(yv[4] * 16.0f, yv[5] * 16.0f, yv[6] * 16.0f, yv[7] * 16.0f);
                               o8.z = cvt4_fp8(yv[8] * 16.0f, yv[9] * 16.0f, yv[10] * 16.0f, yv[11] * 16.0f); o8.w = cvt4_fp8(yv[12] * 16.0f, yv[13] * 16.0f, yv[14] * 16.0f, yv[15] * 16.0f);
                               *(u32x4*)((unsigned char*)og + (size_t)(b * SEQ + sc * 256 + ch * 64 + tv) * (2 * D) + h * 128 + vc * 16) = o8; }
                else { u32x4* d = (u32x4*)(og + (size_t)(b * SEQ + sc * 256 + ch * 64 + tv) * (2 * D) + h * 128 + vc * 16);
                       d[0] = (u32x4){ow[0], ow[1], ow[2], ow[3]}; d[1] = (u32x4){ow[4], ow[5], ow[6], ow[7]}; }
            }
        }
        if (ch == 3) {
            if (!OUT) {
                float* ds = dS + (size_t)(bh * 32 + sc) * 16384;
#pragma unroll
                for (int vt = 0; vt < 8; ++vt)
#pragma unroll
                    for (int j = 0; j < 4; ++j) ds[(size_t)(16 * wave + fq * 4 + j) * 128 + vt * 16 + fr] = S[vt][j];
                if (seg == 0) *(f32x2*)(Dd + (size_t)(bh * 32 + sc) * 128 + 2 * cp) = (f32x2){__builtin_amdgcn_exp2f(gsum0), __builtin_amdgcn_exp2f(gsum1)};
            }
            idx += X.G; ch = 0; if (idx >= ntask) break;
        } else ++ch;
    }
#undef HG_LOAD
    __syncthreads();
}

__device__ __forceinline__ void ph_hg2(const Ctx& X, const float* dS, const float* Dd, float* S0) {
    for (int idx = X.vcu * 512 + X.tid; idx < 32 * 4096; idx += X.G * 512) {
        const int bh = idx >> 12, e4 = idx & 4095, k = e4 >> 5, v4 = (e4 & 31) * 4;
        f32x4 s = (f32x4){0.f, 0.f, 0.f, 0.f};
#pragma unroll 4
        for (int sc = 0; sc < 31; ++sc) { const float d = Dd[(size_t)(bh * 32 + sc) * 128 + k]; const f32x4 ds = *(const f32x4*)(dS + (size_t)(bh * 32 + sc) * 16384 + k * 128 + v4);
            s = s * d + ds; *(f32x4*)(S0 + (size_t)(bh * 32 + sc + 1) * 16384 + k * 128 + v4) = s; }
    }
}

__device__ __forceinline__ void ph_router_tables(const Ctx& X, const float* g_ffn, const float* mod, const float* w_router, const float* b_router, bf16_t* BpT, float* cb) {
    for (int i = X.vcu * 512 + X.tid; i < 4 * 32 * 1024; i += X.G * 512) { const int b = i >> 15, e = (i >> 10) & 31, k = i & 1023;
        const float v = g_ffn[k] * (1.0f + mod[(size_t)b * NMOD + 4 * D + k]) * w_router[k * 32 + e];
        const unsigned hi = pk2(v, 0.f) & 0xffffu; const float r1 = v - __uint_as_float(hi << 16);
        const unsigned mi = pk2(r1, 0.f) & 0xffffu; const float r2 = r1 - __uint_as_float(mi << 16);
        const unsigned lo = pk2(r2, 0.f) & 0xffffu;
        unsigned short* d = (unsigned short*)BpT + ((size_t)(b * 3) * 32 + e) * 1024 + k;
        d[0] = (unsigned short)hi; d[32 * 1024] = (unsigned short)mi; d[2 * 32 * 1024] = (unsigned short)lo; }
    const int gw = X.vcu * 8 + X.wave;
    if (gw < 128) { const int b = gw >> 5, e = gw & 31; float a = 0.f;
        for (int k = X.lane; k < 1024; k += 64) a += mod[(size_t)b * NMOD + 3 * D + k] * w_router[k * 32 + e];
        a = wave_sum(a); if (X.lane == 0) cb[gw] = a + b_router[e]; }
}

__device__ __forceinline__ void ph_route(const Ctx& X, const bf16_t* x1, const float* g_ffn, const float* mod, const bf16_t* BpT, const float* cb,
                                         unsigned char* h2, int* top_e, float* top_w, int* rank, int* hist_g) {
    LAS int* hist = (LAS int*)(X.lds + LDSCTL_OFF + 64);
    LAS unsigned char* L = X.lds;
    constexpr int RS = 1040;
    const int tid = X.tid, lane = X.lane, c = lane & 15, q = lane >> 4;
    for (int tile = X.vcu; tile < RT_NT; tile += X.G) {
        if (tid < 32) hist[tid] = 0;
        const int tw = tile * RT_TILE + X.wave * 16, b = tw / SEQ;
        const bf16_t* xa = x1 + (size_t)(tw + c) * D + 8 * q;
        f32x4 acc0 = (f32x4){0.f, 0.f, 0.f, 0.f}, acc1 = acc0, accS = acc0;
#pragma unroll 1
        for (int half = 0; half < 2; ++half) {
            bf16x8 a[16];
#pragma unroll
            for (int ks = 0; ks < 16; ++ks) a[ks] = *(const bf16x8*)(xa + 512 * half + 32 * ks);
            __syncthreads();
#pragma unroll
            for (int i = 0; i < 12; ++i) { const int id = tid + 512 * i, row = id >> 6, c16 = id & 63;
                const u32x4 v = *(const u32x4*)(BpT + ((size_t)(b * 96) + row) * 1024 + 512 * half + 8 * c16);
                *(LAS u32x4*)(L + row * RS + 16 * c16) = v; }
            __syncthreads();
#pragma unroll
            for (int ks = 0; ks < 16; ++ks) {
                bf16x8 bb[6];
#pragma unroll
                for (int j = 0; j < 6; ++j) bb[j] = *(const LAS bf16x8*)(L + (16 * j + c) * RS + 64 * ks + 16 * q);
                accS = __builtin_amdgcn_mfma_f32_16x16x32_bf16(a[ks], a[ks], accS, 0, 0, 0);
#pragma unroll
                for (int s_ = 2; s_ >= 0; --s_) { acc0 = __builtin_amdgcn_mfma_f32_16x16x32_bf16(a[ks], bb[2 * s_], acc0, 0, 0, 0); acc1 = __builtin_amdgcn_mfma_f32_16x16x32_bf16(a[ks], bb[2 * s_ + 1], acc1, 0, 0, 0); }
            }
        }
        const float dg = (c & 2) ? ((c & 1) ? accS[3] : accS[2]) : ((c & 1) ? accS[1] : accS[0]);
        const float ss = __shfl(dg, c + 16 * (c >> 2));
        const float rs = rsqrtf(ss * (1.0f / D) + EPS);
        const float cb0 = cb[b * 32 + c], cb1 = cb[b * 32 + 16 + c];
#pragma unroll
        for (int reg = 0; reg < 4; ++reg) {
            const float rt = __shfl(rs, 4 * q + reg);
            float v0 = acc0[reg] * rt + cb0, v1 = acc1[reg] * rt + cb1;
            float sv[4]; int si[4];
#pragma unroll
            for (int rnd = 0; rnd < 4; ++rnd) {
                float bvv = v0; int bi = c; if (v1 > bvv) { bvv = v1; bi = 16 + c; }
#pragma unroll
                for (int o = 1; o < 16; o <<= 1) { const float ov = __shfl_xor(bvv, o); const int oi = __shfl_xor(bi, o); if (ov > bvv || (ov == bvv && oi < bi)) { bvv = ov; bi = oi; } }
                sv[rnd] = bvv; si[rnd] = bi; if (bi == c) v0 = -INFINITY; if (bi == 16 + c) v1 = -INFINITY;
            }
            const float e1 = __expf(sv[1] - sv[0]), e2 = __expf(sv[2] - sv[0]), e3 = __expf(sv[3] - sv[0]);
            const float inv = 1.0f / (1.0f + e1 + e2 + e3);
            if (c == 0) { const int t = tw + 4 * q + reg;
                const float ww[4] = {inv, e1 * inv, e2 * inv, e3 * inv};
#pragma unroll
                for (int rnd = 0; rnd < 4; ++rnd) { top_e[t * 4 + rnd] = si[rnd]; top_w[t * 4 + rnd] = ww[rnd]; rank[t * 4 + rnd] = atomicAdd((int*)&hist[si[rnd]], 1); }
            }
        }
        const float* sh = mod + (size_t)b * NMOD + 3 * D; const float* sc = mod + (size_t)b * NMOD + 4 * D;
#pragma unroll 4
        for (int i = 0; i < 16; ++i) {
            const float r = __shfl(rs, i);
            const u32x2* xr = (const u32x2*)(x1 + (size_t)(tw + i) * D) + lane;
#pragma unroll
            for (int j = 0; j < 4; ++j) {
                const int col = 4 * (lane + 64 * j);
                const f32x4 gg = *(const f32x4*)(g_ffn + col), s1 = *(const f32x4*)(sc + col), s0 = *(const f32x4*)(sh + col);
                const u32x2 xw = xr[64 * j]; const f32x4 xv = (f32x4){bflo(xw.x), bfhi(xw.x), bflo(xw.y), bfhi(xw.y)};
                const f32x4 y = (xv * r * gg * (s1 + 1.0f) + s0) * 16.0f;
                *(unsigned*)(h2 + (size_t)(tw + i) * D + col) = cvt4_fp8(y.x, y.y, y.z, y.w);
            }
        }
        __syncthreads();
        if (tid < 32) hist_g[tile * 32 + tid] = hist[tid];
        __syncthreads();
    }
}

__device__ __forceinline__ void ph_sort(const Ctx& X, const int* hist_g, const int* top_e, const float* top_w, const int* rank, int* row_tok, float* row_w, int* pair_row, int* blk_e) {
    LAS int* s_hist = (LAS int*)X.lds;
    LAS int* s_tot = s_hist + RT_NT * 32; LAS int* s_pre = s_tot + 32; LAS int* s_base = s_pre + 32; LAS int* s_pstart = s_base + 32; LAS int* s_pend = s_pstart + 32;
    LAS int* s_ptot = s_pend + 32; LAS int* s_ppre = s_ptot + 16 * 32;
    const int tid = X.tid;
    for (int i = tid; i < RT_NT * 8; i += 512) ((LAS u32x4*)s_hist)[i] = ((const u32x4*)hist_g)[i];
    __syncthreads();
    for (int tile = X.vcu; tile < RT_NT; tile += X.G) {
        { const int e = tid & 31, part = tid >> 5; int tot = 0, pre = 0;
#pragma unroll 4
          for (int i = part * (RT_NT / 16); i < (part + 1) * (RT_NT / 16); ++i) { const int c = s_hist[i * 32 + e]; tot += c; pre += (i < tile) ? c : 0; }
          s_ptot[part * 32 + e] = tot; s_ppre[part * 32 + e] = pre; }
        __syncthreads();
        if (tid < 32) { int tot = 0, pre = 0;
#pragma unroll
            for (int k = 0; k < 16; ++k) { tot += s_ptot[k * 32 + tid]; pre += s_ppre[k * 32 + tid]; }
            const int padded = (tot + 255) / 256 * 256; int inc = padded;
#pragma unroll
            for (int o = 1; o < 32; o <<= 1) { const int v = __shfl_up(inc, o); if (tid >= o) inc += v; }
            s_tot[tid] = tot; s_pstart[tid] = inc - padded; s_base[tid] = inc - padded + pre; s_pend[tid] = inc; }
        __syncthreads();
        { const int i = tid; const int idx = tile * RT_TILE * 4 + i; const int e = top_e[idx]; const int row = s_base[e] + rank[idx];
          row_tok[row] = idx >> 2; row_w[row] = top_w[idx]; pair_row[idx] = row; }
        if (tile < 32) { const int e = tile; for (int r = s_pstart[e] + s_tot[e] + tid; r < s_pend[e]; r += 512) { row_tok[r] = 0; row_w[r] = 0.f; } }
        if (tile == 32) { for (int blk = tid; blk < NBLK_MAX; blk += 512) { int e = -1; const int r = blk * 256; for (int q = 0; q < 32; ++q) if (r >= s_pstart[q] && r < s_pend[q]) e = q; blk_e[blk] = e; }
                          if (tid == 0) blk_e[NBLK_MAX] = s_pend[31] / 256; }
        __syncthreads();
    }
}

__device__ __forceinline__ void ph_final(const Ctx& X, const bf16_t* x1, const unsigned char* y, const int* pair_row, const float* mod, const float* g_final, float* out, const float oscale) {
    const int lane = X.lane;
    for (int t = X.vcu * 8 + X.wave; t < T; t += X.G * 8) {
        const int b = t / SEQ;
        const u32x2* xr = (const u32x2*)(x1 + (size_t)t * D) + lane;
        const float* ga = mod + (size_t)b * NMOD + 5 * D;
        int rows[4];
#pragma unroll
        for (int k = 0; k < 4; ++k) rows[k] = pair_row[t * 4 + k];
        f32x4 v[4]; float ss = 0.f;
#pragma unroll
        for (int j = 0; j < 4; ++j) {
            const int col = 4 * (lane + 64 * j);
            f32x4 m = (f32x4){0.f, 0.f, 0.f, 0.f};
#pragma unroll
            for (int k = 0; k < 4; ++k) { const int w = *(const int*)(y + (size_t)rows[k] * D + col); const f32x2 lo = __builtin_amdgcn_cvt_pk_f32_fp8(w, false), hi = __builtin_amdgcn_cvt_pk_f32_fp8(w, true); m.x += lo.x; m.y += lo.y; m.z += hi.x; m.w += hi.y; }
            const u32x2 xw = xr[64 * j];
            v[j] = (f32x4){bflo(xw.x), bfhi(xw.x), bflo(xw.y), bfhi(xw.y)} + *(const f32x4*)(ga + col) * (m * (1.0f / 32.0f));
            ss += (v[j].x * v[j].x + v[j].y * v[j].y) + (v[j].z * v[j].z + v[j].w * v[j].w);
        }
        const float r = rsqrtf(wave_sum(ss) * (1.0f / D) + EPS);
#pragma unroll
        for (int j = 0; j < 4; ++j) { const int col = 4 * (lane + 64 * j); *(f32x4*)(out + (size_t)t * D + col) = v[j] * (r * oscale) * *(const f32x4*)(g_final + col); }
    }
}

constexpr int N_PHASES = 13;
struct Args { const float* in[23]; float* out; unsigned char* ws; int ph_lo, ph_hi; };
__global__ void __launch_bounds__(512, 2) fwd(Args a) {
    extern __shared__ __attribute__((aligned(16))) unsigned char lds_raw[];
    Ctx X; X.lds = (LAS unsigned char*)lds_raw; X.tid = threadIdx.x; X.lane = X.tid & 63; X.wave = __builtin_amdgcn_readfirstlane(X.tid >> 6);
    X.G = gridDim.x; { const int bx = blockIdx.x; X.vcu = (X.G % 8 == 0) ? (bx % 8) * (X.G / 8) + bx / 8 : bx; }
    unsigned char* ws = a.ws;
    for (int u = X.tid; u < (LDS_BYTES - LDSCTL_OFF) / 4; u += 512) ((LAS unsigned*)(X.lds + LDSCTL_OFF))[u] = 0u;
    __syncthreads();
    XcdBarrier bar = xcd_barrier_post((unsigned*)(ws + WS_CTL) + CW_BAR, (volatile LAS unsigned*)(X.lds + LDSCTL_OFF), X.tid == 0);
    const int lo = a.ph_lo, hi = a.ph_hi; float probe_scale = 1.0f;
#define IN(k) (lo <= (k) && (k) < hi)
#define SEAM(k) do { if (IN(k) && IN((k) + 1)) xcd_barrier(bar, X.wave == 0 && (int)__builtin_amdgcn_mbcnt_hi(~0u, __builtin_amdgcn_mbcnt_lo(~0u, 0u)) == 0); } while (0)
#ifdef PROBE_PH
    unsigned long long* stamps = (unsigned long long*)(ws + WS_CTL + 32768);
    if (blockIdx.x == 0 && X.tid == 0) stamps[0] = __builtin_amdgcn_s_memrealtime();
#undef SEAM
#define SEAM(k) do { if (IN(k) && IN((k) + 1)) { xcd_barrier(bar, X.wave == 0 && (int)__builtin_amdgcn_mbcnt_hi(~0u, __builtin_amdgcn_mbcnt_lo(~0u, 0u)) == 0); \
        if (blockIdx.x == 0 && X.wave == 0 && (int)__builtin_amdgcn_mbcnt_hi(~0u, __builtin_amdgcn_mbcnt_lo(~0u, 0u)) == 0) stamps[(k) + 1] = __builtin_amdgcn_s_memrealtime(); } } while (0)
#endif
    const float* x = a.in[0]; const float* c = a.in[1]; const float* w_ada = a.in[2]; const float* b_ada = a.in[3];
    const float* g_mix = a.in[4]; const float* w_in = a.in[5]; const float* conv_dw = a.in[6]; const float* conv_dwb = a.in[7];
    const float* conv_ln_g = a.in[8]; const float* conv_ln_b = a.in[9]; const float* w_conv_out = a.in[10]; const float* lb_param = a.in[11];
    const float* hgrn_norm_g = a.in[12]; const float* w_hgrn_out = a.in[13]; const float* w_out = a.in[14]; const float* g_ffn = a.in[15];
    const float* w_router = a.in[16]; const float* b_router = a.in[17]; const float* w1 = a.in[18]; const float* b1 = a.in[19];
    const float* w2 = a.in[20]; const float* b2 = a.in[21]; const float* g_final = a.in[22];
    float* mod = (float*)(ws + WS_MOD); bf16_t* rt_bp = (bf16_t*)(ws + WS_WH);     float* rt_cb = (float*)(ws + WS_CB);
    int* hist_g = (int*)(ws + WS_HIST); int* blk_e = (int*)(ws + WS_BLKE); int* top_e = (int*)(ws + WS_TOPE); float* top_w = (float*)(ws + WS_TOPW);
    int* rank = (int*)(ws + WS_RANK); int* pair_row = (int*)(ws + WS_PROW); int* row_tok = (int*)(ws + WS_RTOK); float* row_w = (float*)(ws + WS_RW);
    bf16_t* p = (bf16_t*)(ws + WS_P);
    bf16_t* h = (bf16_t*)(ws + WS_E); unsigned char* h8 = ws + WS_E + 64 * MiB; float* tmp = (float*)(ws + WS_E);
    float* hg_dS = (float*)(ws + WS_E); float* hg_S0 = (float*)(ws + WS_E + 64 * MiB); float* hg_D = (float*)(ws + WS_HGD);
    bf16_t* uc = (bf16_t*)(ws + WS_D); bf16_t* og = MIX_FP8 ? (bf16_t*)((unsigned char*)uc + D) : uc + D;   bf16_t* x1 = (bf16_t*)(ws + WS_D);
    bf16_t* merged = p;
    unsigned char* h2 = (unsigned char*)p;
    unsigned char* act = (unsigned char*)(p + PG);
    unsigned char* y = (unsigned char*)(p + PG) + (size_t)R_PAD * D;
    PG8_LAS unsigned char* ring = (PG8_LAS unsigned char*)lds_raw;

#ifndef REPMASK
#define REPMASK 0
#endif
#ifndef REPN
#define REPN 1
#endif
#define PH(k, ...) do { if (IN(k)) { _Pragma("unroll 1") for (int rep_ = 0; rep_ < ((((REPMASK) >> (k)) & 1) ? 1 + REPN : 1); ++rep_) { if (rep_) __syncthreads(); { int ln_ = (int)__builtin_amdgcn_mbcnt_hi(~0u, __builtin_amdgcn_mbcnt_lo(~0u, 0u)); asm volatile("" : "+v"(ln_)); X.lane = ln_; X.tid = X.wave * 64 + ln_; } __VA_ARGS__ } } SEAM(k); } while (0)
    PH(0, ph_prologue<0>(X, c, w_ada, b_ada, mod, w_in, w_conv_out, w_hgrn_out, w_out, w1, w2, ws); if (P_INT8) ph_win_i8(X, w_in, ws););
    PH(1, ph_norm_mod(X, x, g_mix, mod, 0, D, h, h8, (float*)(ws + WS_HSC)); ph_router_tables(X, g_ffn, mod, w_router, b_router, rt_bp, rt_cb););
#ifndef STAGGER_TICKS
#define STAGGER_TICKS 0
#endif
    PH(2, { if (STAGGER_TICKS) { const unsigned long long t0_ = __builtin_amdgcn_s_memrealtime(), wait_ = (unsigned long long)(X.vcu & 3) * STAGGER_TICKS;
                while (__builtin_amdgcn_s_memrealtime() - t0_ < wait_) __builtin_amdgcn_s_sleep(8); }
        if (P_INT8) { pg8::Gemm g{(const bf16_t*)h8, (const bf16_t*)(ws + WS_WIN8), T, 8 * D, D / 2}; pg8::StaticOrder S; S.init(T, 8 * D, X.G, (int)blockIdx.x);
            pg8::EpiSplitBf16<true> E{p, PG, 0x3cu, SEQ, 1.0f, (const float*)(ws + WS_HSC), (const float*)(ws + WS_WSC)}; pg8::gemm_phase<pg8::EpiSplitBf16<true>, pg8::StaticOrder, true, true, false, 2>(ring, g, S, E, X.wave); }
        else {
        constexpr unsigned m8 = P_FP8_MASK; constexpr int n8 = __builtin_popcount(m8);
        if (n8 > 0) { pg8::Gemm g{(const bf16_t*)h8, (const bf16_t*)(ws + WS_WIN8), T, 8 * D, D / 2}; pg8::MaskOrder S; S.base.init(T, n8 * 256, X.G, (int)blockIdx.x); S.mask = m8;
            pg8::EpiSplitBf16<false> E{p, PG, 0x3cu, SEQ, 1.0f / 4096.0f, nullptr, nullptr}; pg8::gemm_phase<pg8::EpiSplitBf16<false>, pg8::MaskOrder, true, true, false, 1>(ring, g, S, E, X.wave); }
        if (n8 < 32) { pg8::Gemm g{h, (const bf16_t*)(ws + WS_WIN), T, 8 * D, D}; pg8::MaskOrder S; S.base.init(T, (32 - n8) * 256, X.G, (int)blockIdx.x); S.mask = ~m8;
            pg8::EpiSplitBf16<false> E{p, PG, 0x3cu, SEQ, 1.0f, nullptr, nullptr}; pg8::gemm_phase<pg8::EpiSplitBf16<false>, pg8::MaskOrder, true, true>(ring, g, S, E, X.wave); } } });
    PH(3, ph_conv(X, p + 0 * PG, conv_dw, conv_dwb, conv_ln_g, conv_ln_b, uc);
          if ((REPMASK >> 14) & 1) { __syncthreads(); ph_conv(X, p + 0 * PG, conv_dw, conv_dwb, conv_ln_g, conv_ln_b, uc); }
          ph_hgrn<false>(X, 31 * 32, p + 2 * PG, p + 3 * PG, p + 4 * PG, p + 5 * PG, lb_param, nullptr, nullptr, hg_dS, hg_D, nullptr);
          if ((REPMASK >> 15) & 1) { __syncthreads(); ph_hgrn<false>(X, 31 * 32, p + 2 * PG, p + 3 * PG, p + 4 * PG, p + 5 * PG, lb_param, nullptr, nullptr, hg_dS, hg_D, nullptr); });
    PH(4, ph_hg2(X, hg_dS, hg_D, hg_S0););
    PH(5, if ((X.vcu & 1) == 0) ph_prologue<1>(X, c, w_ada, b_ada, mod, w_in, w_conv_out, w_hgrn_out, w_out, w1, w2, ws);
          ph_hgrn<true>(X, 32 * 32, p + 2 * PG, p + 3 * PG, p + 4 * PG, p + 5 * PG, lb_param, hgrn_norm_g, hg_S0, nullptr, nullptr, og);
          if ((X.vcu & 1) != 0) ph_prologue<1>(X, c, w_ada, b_ada, mod, w_in, w_conv_out, w_hgrn_out, w_out, w1, w2, ws););
    PH(6, { if (MIX_FP8) { pg8::Gemm g{uc, (const bf16_t*)(ws + WS_WC), T, D, D}; pg8::StaticOrder S; S.init(T, D, X.G, (int)blockIdx.x);
              pg8::EpiGateFused<RES_FP8 != 0> E{p + 6 * PG, p + 7 * PG, merged, 1.0f / 4096.0f}; pg8::gemm_phase<pg8::EpiGateFused<RES_FP8 != 0>, pg8::StaticOrder, true, true, false, 1>(ring, g, S, E, X.wave); }
            else { pg8::Gemm g{uc, (const bf16_t*)(ws + WS_WC), T, D, 2 * D}; pg8::StaticOrder S; S.init(T, D, X.G, (int)blockIdx.x);
              pg8::EpiGateFused<RES_FP8 != 0> E{p + 6 * PG, p + 7 * PG, merged, 1.0f}; pg8::gemm_phase<pg8::EpiGateFused<RES_FP8 != 0>, pg8::StaticOrder, true, true>(ring, g, S, E, X.wave); } });
    PH(7, { if (RES_FP8) { pg8::Gemm g{merged, (const bf16_t*)(ws + WS_WO), T, D, D / 2}; pg8::StaticOrder S; S.init(T, D, X.G, (int)blockIdx.x);
              pg8::EpiRes E{x, mod + 2 * D, x1, NMOD, SEQ, 1.0f / 8192.0f}; pg8::gemm_phase<pg8::EpiRes, pg8::StaticOrder, true, true, false, 1>(ring, g, S, E, X.wave); }
            else { pg8::Gemm g{merged, (const bf16_t*)(ws + WS_WO), T, D, D}; pg8::StaticOrder S; S.init(T, D, X.G, (int)blockIdx.x);
              pg8::EpiRes E{x, mod + 2 * D, x1, NMOD, SEQ, 1.0f}; pg8::gemm_phase<pg8::EpiRes, pg8::StaticOrder, true, true>(ring, g, S, E, X.wave); } });
    PH(8, ph_route(X, x1, g_ffn, mod, rt_bp, rt_cb, h2, top_e, top_w, rank, hist_g););
    PH(9, ph_sort(X, hist_g, top_e, top_w, rank, row_tok, row_w, pair_row, blk_e););
    PH(10, { const int nblk = blk_e[NBLK_MAX]; pg8::Gemm g{(const bf16_t*)h2, (const bf16_t*)(ws + WS_W1), T, 32 * 2048, D / 2}; pg8::MoeOrder S{blk_e, nblk, X.G, (int)blockIdx.x, 3};
        LAS unsigned short* gt = (LAS unsigned short*)(X.lds + LDSCTL_OFF + 256);
        _Pragma("unroll 1") for (int i = 0; i < 23; ++i) { pg8::Unit u; if (!S.next(i, u)) break; if (X.tid < 256) gt[256 * i + X.tid] = (unsigned short)row_tok[u.pm * 256 + X.tid]; }
        __syncthreads();
        pg8::EpiSwiglu8 E{b1, act, 1.0f / 4096.0f}; pg8::gemm_phase<pg8::EpiSwiglu8, pg8::MoeOrder, true, true, true, true>(ring, g, S, E, X.wave, (const PG8_LAS unsigned short*)gt); });
    PH(11, { const int nblk = blk_e[NBLK_MAX]; pg8::Gemm g{(const bf16_t*)act, (const bf16_t*)(ws + WS_W2), R_PAD, 32 * 1024, DFF / 2}; pg8::MoeOrder S{blk_e, nblk, X.G, (int)blockIdx.x, 2};
        pg8::EpiY8 E{b2, row_w, y, 1.0f / 1024.0f}; pg8::gemm_phase<pg8::EpiY8, pg8::MoeOrder, true, true, false, true>(ring, g, S, E, X.wave); });
#ifdef PROBE_PH
    { const unsigned long long* st_ = (const unsigned long long*)(ws + WS_CTL + 32768); const float dt_ = (float)(long long)(st_[PROBE_PH + 1] - st_[PROBE_PH]);
      probe_scale = 1.0f + dt_ * (1.0f / 200000.0f); }
#endif
    PH(12, ph_final(X, x1, y, pair_row, mod, g_final, a.out, probe_scale););
#undef PH
#undef IN
#undef SEAM
}

#ifndef MK_N_LAUNCHES
#define MK_N_LAUNCHES 1
#endif
extern "C" void kernel_launch(void* const* d_in, const int* in_sizes, int n_in, void* d_out, int out_size, void* d_ws, size_t ws_size, hipStream_t stream) {
    static int grid = 0;
    if (grid == 0) {
        if (n_in != 23 || out_size != T * D || ws_size < WS_END) { fprintf(stderr, "kernel_launch: unexpected n_in %d / out_size %d / ws_size %zu (< %zu); nothing launched\n", n_in, out_size, ws_size, (size_t)WS_END); grid = -1; return; }
        int dev = 0, cus = 0, per_cu = 0;
        if (hipGetDevice(&dev) != hipSuccess || hipDeviceGetAttribute(&cus, hipDeviceAttributeMultiprocessorCount, dev) != hipSuccess) { grid = -1; return; }
        if (hipFuncSetAttribute((const void*)fwd, hipFuncAttributeMaxDynamicSharedMemorySize, LDS_BYTES) != hipSuccess) { fprintf(stderr, "kernel_launch: hipFuncSetAttribute failed\n"); grid = -1; return; }
        if (hipOccupancyMaxActiveBlocksPerMultiprocessor(&per_cu, (const void*)fwd, 512, LDS_BYTES) != hipSuccess || per_cu < 1) { fprintf(stderr, "kernel_launch: occupancy query says %d blocks per CU\n", per_cu); }
        (void)hipGetLastError();
        grid = cus;
    }
    if (grid < 0) return;
    if (hipMemsetAsync((char*)d_ws + WS_CTL, 0, CTL_ZERO_BYTES, stream) != hipSuccess) return;
    Args a{};
    for (int i = 0; i < 23; ++i) a.in[i] = (const float*)d_in[i];
    a.out = (float*)d_out; a.ws = (unsigned char*)d_ws;
    if (MK_N_LAUNCHES == 1) { a.ph_lo = 0; a.ph_hi = N_PHASES; hipLaunchKernelGGL(fwd, dim3(grid), dim3(512), LDS_BYTES, stream, a); }
    else for (int ph = 0; ph < N_PHASES; ++ph) { a.ph_lo = ph; a.ph_hi = ph + 1; hipLaunchKernelGGL(fwd, dim3(grid), dim3(512), LDS_BYTES, stream, a); }
}
```

```cpp
#include <hip/hip_runtime.h>
#include <stdint.h>
#include <stdio.h>

#define GAS __attribute__((address_space(1)))
#define LAS __attribute__((address_space(3)))
typedef unsigned short bf16_t;
typedef unsigned u32x4 __attribute__((ext_vector_type(4)));
typedef unsigned u32x2 __attribute__((ext_vector_type(2)));
typedef float f32x4 __attribute__((ext_vector_type(4)));

constexpr int D = 1024, NBATCH = 4, SEQ = 8192, T = NBATCH * SEQ;
constexpr int NE = 32, DFF = 1024;
constexpr int NMOD = 6 * D;
constexpr int NBLK_MAX = 544, R_PAD = NBLK_MAX * 256;
constexpr int RT_TILE = 128, RT_NT = T / RT_TILE;
constexpr float EPS = 1e-6f;

constexpr size_t MiB = 1u << 20;
constexpr size_t WS_CTL = 0, CTL_ZERO_BYTES = 64 * 1024;
constexpr size_t WS_MOD = 1 * MiB;
constexpr size_t WS_CB = WS_MOD + 112 * 1024, WS_BP = WS_MOD + 128 * 1024;
constexpr size_t WS_HSC = WS_MOD + 704 * 1024, WS_WSC = WS_MOD + 840 * 1024;
constexpr size_t WS_HIST = 2 * MiB;
constexpr size_t WS_BLKE = WS_HIST + 64 * 1024;
constexpr size_t WS_TOPE = 3 * MiB;
constexpr size_t WS_TOPW = WS_TOPE + 512 * 1024;
constexpr size_t WS_RANK = WS_TOPW + 512 * 1024;
constexpr size_t WS_PROW = WS_RANK + 512 * 1024;
constexpr size_t WS_RTOK = 5 * MiB;
constexpr size_t WS_RW = 6 * MiB;
constexpr size_t WS_HGD = 7 * MiB;
constexpr size_t WS_WT = 8 * MiB;
constexpr size_t WS_WIN = WS_WT, WS_WC = WS_WT + 16 * MiB, WS_WH = WS_WT + 18 * MiB, WS_WO = WS_WT + 20 * MiB, WS_W1 = WS_WT + 22 * MiB, WS_WIN8 = WS_WT + 96 * MiB  , WS_W2 = WS_WT + 150 * MiB;
constexpr size_t WS_P = 224 * MiB;
constexpr size_t WS_E = WS_P + 512 * MiB;
constexpr size_t WS_D = WS_E + 128 * MiB;
constexpr size_t WS_END = WS_D + 128 * MiB;
constexpr size_t PG = (size_t)T * D;
constexpr int CW_BAR = 0;

constexpr int RING_BYTES = 135168, LDSCTL_OFF = RING_BYTES, LDS_BYTES = 147456;

__device__ __forceinline__ unsigned f2bf(float f) { unsigned u = __builtin_bit_cast(unsigned, f); return (u + 0x7fffu + ((u >> 16) & 1u)) >> 16; }
typedef __bf16 bf16x2_hw __attribute__((ext_vector_type(2)));
__device__ __forceinline__ unsigned pk2(float lo, float hi) { const bf16x2_hw v = {(__bf16)lo, (__bf16)hi}; return __builtin_bit_cast(unsigned, v); }
__device__ __forceinline__ float bf2f(unsigned b) { return __builtin_bit_cast(float, b << 16); }
__device__ __forceinline__ float bflo(unsigned w) { return __builtin_bit_cast(float, w << 16); }
__device__ __forceinline__ float bfhi(unsigned w) { return __builtin_bit_cast(float, w & 0xffff0000u); }
__device__ __forceinline__ float sigmoidf_(float x) { return __builtin_amdgcn_rcpf(1.0f + __expf(-x)); }
__device__ __forceinline__ float wave_sum(float v) {
#pragma unroll
    for (int o = 1; o < 64; o <<= 1) v += __shfl_xor(v, o);
    return v;
}
__device__ __forceinline__ unsigned cvt4_fp8(float a, float b, float c, float d) {
    a = fminf(fmaxf(a, -448.f), 448.f); b = fminf(fmaxf(b, -448.f), 448.f); c = fminf(fmaxf(c, -448.f), 448.f); d = fminf(fmaxf(d, -448.f), 448.f);
    int w = 0; w = __builtin_amdgcn_cvt_pk_fp8_f32(a, b, w, false); w = __builtin_amdgcn_cvt_pk_fp8_f32(c, d, w, true); return (unsigned)w; }
__device__ __forceinline__ unsigned q4_i8(float a, float b, float c, float d) {
    const int ia = (int)__builtin_rintf(a), ib = (int)__builtin_rintf(b), ic = (int)__builtin_rintf(c), id = (int)__builtin_rintf(d);
    return (unsigned)(ia & 255) | ((unsigned)(ib & 255) << 8) | ((unsigned)(ic & 255) << 16) | ((unsigned)id << 24); }
#define LDS_WAIT() asm volatile("s_waitcnt lgkmcnt(0)" ::: "memory")
#define VM_WAIT() asm volatile("s_waitcnt vmcnt(0)" ::: "memory")

namespace pg8 {
#define PG8_LAS __attribute__((address_space(3)))
typedef unsigned short bf16_t;
typedef short bf16x8 __attribute__((ext_vector_type(8)));
typedef float f32x4 __attribute__((ext_vector_type(4)));
typedef unsigned u32x4 __attribute__((ext_vector_type(4)));
constexpr int BM = 256, BK = 64, HALF = 128, HTB = HALF * BK * 2  , STAGE_BYTES = 8 * HTB, NXCD = 8, WGM = 8;

__host__ __device__ __forceinline__ int lds_byte(int r, int c) { const int st = (r >> 4) * 2 + (c >> 5), rr = r & 15, cc = c & 31, ob = rr * 64 + cc * 2; return st * 1024 + (ob ^ (((ob >> 9) & 1) << 5)); }
__host__ __device__ __forceinline__ void stage_rc(int b, int& R, int& C) { const int st = b / 1024, sb = b % 1024, swz = sb ^ (((sb >> 9) & 1) << 5); R = (st >> 1) * 16 + swz / 64; C = (st & 1) * 32 + (swz % 64) / 2; }
__host__ __device__ __forceinline__ int perm32(int rho) { const int n = rho >> 4, i = rho & 15; return 8 * (i >> 2) + 4 * n + (i & 3); }

struct Unit { int pm, pn; };
struct Gemm { const bf16_t* A; const bf16_t* Bt; int M, N, K; };

struct StaticOrder {
    int nM, nN, nwg, G, c;
    __host__ __device__ void init(int M, int N, int G_, int c_) { nM = M / BM; nN = N / BM; nwg = nM * nN; G = G_; c = c_; }
    __host__ __device__ bool next(int i, Unit& u) const {
        const long L = (long)i * G + c; if (L >= nwg) return false;
        int wgid = (int)L; { const int q = nwg / NXCD, r = nwg % NXCD, xcd = wgid % NXCD, off = wgid / NXCD; wgid = (xcd < r ? xcd * (q + 1) : r * (q + 1) + (xcd - r) * q) + off; }
        const int nig = WGM * nN, gid = wgid / nig, fm = gid * WGM, gsz = (nM - fm) < WGM ? (nM - fm) : WGM;
        u.pm = fm + ((wgid % nig) % gsz); u.pn = (wgid % nig) / gsz; return true;
    }
    __device__ __forceinline__ void a_ready(const Unit&) const {}
    __device__ __forceinline__ void done(const Unit&) const {}
};


struct MaskOrder {
    StaticOrder base; unsigned mask;
    __device__ __forceinline__ bool next(int i, Unit& u) const {
        if (!base.next(i, u)) return false;
        unsigned m = mask; for (int k = 0; k < u.pn; ++k) m &= m - 1;
        u.pn = __builtin_ctz(m); return true;
    }
    __device__ __forceinline__ void a_ready(const Unit&) const {}
    __device__ __forceinline__ void done(const Unit&) const {}
};
struct MoeOrder {
    const int* blk_e; int nblk, G, c, lg;
    __device__ __forceinline__ bool next(int i, Unit& u) const {
        int blk, j;
        if (G == 256) { const int xcd = c & 7, idx = c >> 3, prb = 256 >> lg; blk = i * prb + xcd * (prb >> 3) + (idx >> lg); j = idx & ((1 << lg) - 1); }
        else { const long L = (long)i * G + c; blk = (int)(L >> lg); j = (int)(L & ((1 << lg) - 1)); }
        if (blk >= nblk) return false;
        const int e = blk_e[blk]; u.pm = blk; u.pn = (e << lg) + j; return true;
    }
    __device__ __forceinline__ void a_ready(const Unit&) const {}
    __device__ __forceinline__ void done(const Unit&) const {}
};

__device__ __forceinline__ unsigned cvt_pk_bf16(float lo, float hi) { unsigned r; asm volatile("v_cvt_pk_bf16_f32 %0, %1, %2" : "=v"(r) : "v"(lo), "v"(hi)); return r; }
__device__ __forceinline__ float sigm(float x) { return __builtin_amdgcn_rcpf(1.0f + __expf(-x)); }
__device__ __forceinline__ float blo(unsigned w) { return __builtin_bit_cast(float, w << 16); }
__device__ __forceinline__ float bhi(unsigned w) { return __builtin_bit_cast(float, w & 0xffff0000u); }

template <bool I8> struct EpiSplitBf16 {
    static constexpr bool PERM = true, AFTER_DRAIN = false;
    bf16_t* O; size_t split_stride; unsigned hm_mask; int seq; float dq;
    const float* rs; const float* cs;
    __device__ __forceinline__ void operator()(const f32x4 (&acc)[2][2][4][2], const Unit& u, int wr, int wc, int fr, int fq) const {
        const int row0 = u.pm * BM + wr * 64 + fr; const int colt = u.pn * BM; const int t = colt >> 10;
        f32x4 cv[2][2]; float rv[2][4];
#pragma unroll
        for (int bj = 0; bj < 2; ++bj)
#pragma unroll
            for (int n = 0; n < 2; ++n) cv[bj][n] = I8 ? *(const f32x4*)(cs + colt + bj * HALF + wc * 32 + 8 * fq + 4 * n) : (f32x4){dq, dq, dq, dq};
#pragma unroll
        for (int ai = 0; ai < 2; ++ai)
#pragma unroll
            for (int m = 0; m < 4; ++m) rv[ai][m] = I8 ? rs[row0 + ai * HALF + m * 16] : 1.0f;
#define PG8_DEQ(ai, bj, m, n) (acc[ai][bj][m][n] * cv[bj][n] * rv[ai][m])
        if (u.pn < 8) {
#pragma unroll
            for (int ai = 0; ai < 2; ++ai)
#pragma unroll
                for (int m = 0; m < 4; ++m) { const int row = row0 + ai * HALF + m * 16; float r[8];
                    const f32x4 a0 = PG8_DEQ(ai, 0, m, 0), a1 = PG8_DEQ(ai, 0, m, 1), b0 = PG8_DEQ(ai, 1, m, 0), b1 = PG8_DEQ(ai, 1, m, 1);
#pragma unroll
                    for (int q = 0; q < 4; ++q) { r[q] = a0[q] * sigm(b0[q]); r[4 + q] = a1[q] * sigm(b1[q]); }
                    u32x4 w; w.x = cvt_pk_bf16(r[0], r[1]); w.y = cvt_pk_bf16(r[2], r[3]); w.z = cvt_pk_bf16(r[4], r[5]); w.w = cvt_pk_bf16(r[6], r[7]);
                    __builtin_nontemporal_store(w, (u32x4*)(O + (size_t)row * 1024 + 128 * u.pn + wc * 32 + 8 * fq)); }
            return;
        }
        bf16_t* base = O + (size_t)t * split_stride; const int cg = colt & 1023;
        const bool hm = (hm_mask >> t) & 1u;
        const int bb = (u.pm * BM) / seq;
#pragma unroll
        for (int ai = 0; ai < 2; ++ai)
#pragma unroll
            for (int m = 0; m < 4; ++m) { const int row = row0 + ai * HALF + m * 16;
#pragma unroll
                for (int bj = 0; bj < 2; ++bj) { const f32x4 v0 = PG8_DEQ(ai, bj, m, 0), v1 = PG8_DEQ(ai, bj, m, 1);
                    u32x4 w; w.x = cvt_pk_bf16(v0[0], v0[1]); w.y = cvt_pk_bf16(v0[2], v0[3]); w.z = cvt_pk_bf16(v1[0], v1[1]); w.w = cvt_pk_bf16(v1[2], v1[3]);
                    const size_t o = hm ? ((size_t)(bb * 8 + (cg >> 7) + bj) * seq + (row - bb * seq)) * 128 + wc * 32 + 8 * fq
                                        : (size_t)row * 1024 + cg + bj * HALF + wc * 32 + 8 * fq;
                    __builtin_nontemporal_store(w, (u32x4*)(base + o)); } }
#undef PG8_DEQ
    }
};
struct EpiRes {
    static constexpr bool PERM = true, AFTER_DRAIN = false;
    const float* x; const float* ga; bf16_t* out; int mod_pitch, seq; float dq;
    __device__ __forceinline__ void operator()(const f32x4 (&acc)[2][2][4][2], const Unit& u, int wr, int wc, int fr, int fq) const {
        const int row0 = u.pm * BM + wr * 64 + fr, col0 = u.pn * BM + wc * 32 + 8 * fq;
        const float* gab = ga + (size_t)((u.pm * BM) / seq) * mod_pitch + col0;
        f32x4 gv[2][2];
#pragma unroll
        for (int bj = 0; bj < 2; ++bj)
#pragma unroll
            for (int n = 0; n < 2; ++n) gv[bj][n] = *(const f32x4*)(gab + bj * HALF + 4 * n) * dq;
#pragma unroll
        for (int ai = 0; ai < 2; ++ai) {
            f32x4 xv[4][2][2];
#pragma unroll
            for (int m = 0; m < 4; ++m)
#pragma unroll
                for (int bj = 0; bj < 2; ++bj) { const float* xp = x + (size_t)(row0 + ai * HALF + m * 16) * 1024 + col0 + bj * HALF; xv[m][bj][0] = *(const f32x4*)xp; xv[m][bj][1] = *(const f32x4*)(xp + 4); }
#pragma unroll
            for (int m = 0; m < 4; ++m) { const size_t o = (size_t)(row0 + ai * HALF + m * 16) * 1024 + col0;
#pragma unroll
                for (int bj = 0; bj < 2; ++bj) {
                    const f32x4 v0 = xv[m][bj][0] + gv[bj][0] * acc[ai][bj][m][0], v1 = xv[m][bj][1] + gv[bj][1] * acc[ai][bj][m][1];
                    u32x4 w; w.x = cvt_pk_bf16(v0[0], v0[1]); w.y = cvt_pk_bf16(v0[2], v0[3]); w.z = cvt_pk_bf16(v1[0], v1[1]); w.w = cvt_pk_bf16(v1[2], v1[3]);
                    *(u32x4*)(out + o + bj * HALF) = w; } }
        }
    }
};
struct EpiSwiglu8 {
    static constexpr bool PERM = true, AFTER_DRAIN = false;
    const float* b1; unsigned char* act; float dq;
    __device__ __forceinline__ void operator()(const f32x4 (&acc)[2][2][4][2], const Unit& u, int wr, int wc, int fr, int fq) const {
        const int e = u.pn >> 3, j = u.pn & 7; const int row0 = u.pm * BM + wr * 64 + fr, f0 = 128 * j + wc * 32 + 8 * fq;
        const float* be = b1 + (size_t)e * 2048 + f0;
        const f32x4 bg0 = *(const f32x4*)(be), bg1 = *(const f32x4*)(be + 4), bl0 = *(const f32x4*)(be + 1024), bl1 = *(const f32x4*)(be + 1028);
#pragma unroll
        for (int ai = 0; ai < 2; ++ai)
#pragma unroll
            for (int m = 0; m < 4; ++m) {
                f32x4 g0 = acc[ai][0][m][0] * dq + bg0, g1 = acc[ai][0][m][1] * dq + bg1, l0 = acc[ai][1][m][0] * dq + bl0, l1 = acc[ai][1][m][1] * dq + bl1;
                float r[8];
#pragma unroll
                for (int q = 0; q < 4; ++q) { float gl = fminf(g0[q], 7.0f), li = fminf(fmaxf(l0[q], -7.0f), 7.0f); r[q] = 4.0f * gl * sigm(1.702f * gl) * (li + 1.0f);
                                              gl = fminf(g1[q], 7.0f); li = fminf(fmaxf(l1[q], -7.0f), 7.0f); r[4 + q] = 4.0f * gl * sigm(1.702f * gl) * (li + 1.0f); }
                u32x2 w; w.x = cvt4_fp8(r[0], r[1], r[2], r[3]); w.y = cvt4_fp8(r[4], r[5], r[6], r[7]);
                *(u32x2*)(act + (size_t)(row0 + ai * HALF + m * 16) * 1024 + f0) = w; }
    }
};
struct EpiY8 {
    static constexpr bool PERM = true, AFTER_DRAIN = false;
    const float* b2; const float* rw; unsigned char* y; float dq;
    __device__ __forceinline__ void operator()(const f32x4 (&acc)[2][2][4][2], const Unit& u, int wr, int wc, int fr, int fq) const {
        const int e = u.pn >> 2, j = u.pn & 3; const int row0 = u.pm * BM + wr * 64 + fr, col0 = 256 * j + wc * 32 + 8 * fq;
        const float* be = b2 + (size_t)e * 1024 + col0;
        f32x4 bv[2][2];
#pragma unroll
        for (int bj = 0; bj < 2; ++bj)
#pragma unroll
            for (int n = 0; n < 2; ++n) bv[bj][n] = *(const f32x4*)(be + bj * HALF + 4 * n);
        float rwv[2][4];
#pragma unroll
        for (int ai = 0; ai < 2; ++ai)
#pragma unroll
            for (int m = 0; m < 4; ++m) rwv[ai][m] = rw[row0 + ai * HALF + m * 16] * 32.0f;
#pragma unroll
        for (int ai = 0; ai < 2; ++ai)
#pragma unroll
            for (int m = 0; m < 4; ++m) { const int row = row0 + ai * HALF + m * 16; const float w_ = rwv[ai][m];
#pragma unroll
                for (int bj = 0; bj < 2; ++bj) { const f32x4 v0 = (acc[ai][bj][m][0] * dq + bv[bj][0]) * w_, v1 = (acc[ai][bj][m][1] * dq + bv[bj][1]) * w_;
                    u32x2 w; w.x = cvt4_fp8(v0[0], v0[1], v0[2], v0[3]); w.y = cvt4_fp8(v1[0], v1[1], v1[2], v1[3]);
                    *(u32x2*)(y + (size_t)row * 1024 + col0 + bj * HALF) = w; } }
    }
};

template <bool OUT8> struct EpiGateFused {
    static constexpr bool PERM = true, AFTER_DRAIN = false, HAS_MID = true;
    const bf16_t* gc; const bf16_t* gh; bf16_t* out; float dq;
    __device__ __forceinline__ void mid(f32x4 (&acc)[2][2][4][2], const Unit& u, int wr, int wc, int fr, int fq) const {
        const int row0 = u.pm * BM + wr * 64 + fr, col0 = u.pn * BM + wc * 32 + 8 * fq;
#pragma unroll
        for (int ai = 0; ai < 2; ++ai)
#pragma unroll
            for (int m = 0; m < 4; ++m) { const size_t o = (size_t)(row0 + ai * HALF + m * 16) * 1024 + col0;
#pragma unroll
                for (int bj = 0; bj < 2; ++bj) { const u32x4 a = *(const u32x4*)(gc + o + bj * HALF), b = *(const u32x4*)(gh + o + bj * HALF);
                    const unsigned aw[4] = {a.x, a.y, a.z, a.w}, bw[4] = {b.x, b.y, b.z, b.w};
#pragma unroll
                    for (int q = 0; q < 4; ++q) { const float r0 = (1.0f + __expf(-blo(bw[q]))) * __builtin_amdgcn_rcpf(1.0f + __expf(-blo(aw[q]))), r1 = (1.0f + __expf(-bhi(bw[q]))) * __builtin_amdgcn_rcpf(1.0f + __expf(-bhi(aw[q])));
                        acc[ai][bj][m][q >> 1][(2 * q) & 3] *= r0; acc[ai][bj][m][q >> 1][(2 * q + 1) & 3] *= r1; } } }
    }
    __device__ __forceinline__ void operator()(const f32x4 (&acc)[2][2][4][2], const Unit& u, int wr, int wc, int fr, int fq) const {
        const int row0 = u.pm * BM + wr * 64 + fr, col0 = u.pn * BM + wc * 32 + 8 * fq;
#pragma unroll
        for (int ai = 0; ai < 2; ++ai) {
            u32x4 gw[4][2];
#pragma unroll
            for (int m = 0; m < 4; ++m)
#pragma unroll
                for (int bj = 0; bj < 2; ++bj) gw[m][bj] = *(const u32x4*)(gh + (size_t)(row0 + ai * HALF + m * 16) * 1024 + col0 + bj * HALF);
#pragma unroll
            for (int m = 0; m < 4; ++m) { const size_t o = (size_t)(row0 + ai * HALF + m * 16) * 1024 + col0;
#pragma unroll
                for (int bj = 0; bj < 2; ++bj) { const u32x4 g = gw[m][bj]; f32x4 v0 = acc[ai][bj][m][0], v1 = acc[ai][bj][m][1];
                    v0[0] *= sigm(blo(g.x)); v0[1] *= sigm(bhi(g.x)); v0[2] *= sigm(blo(g.y)); v0[3] *= sigm(bhi(g.y));
                    v1[0] *= sigm(blo(g.z)); v1[1] *= sigm(bhi(g.z)); v1[2] *= sigm(blo(g.w)); v1[3] *= sigm(bhi(g.w));
                    if (OUT8) { const float s_ = dq * 32.0f; u32x2 w; w.x = cvt4_fp8(v0[0] * s_, v0[1] * s_, v0[2] * s_, v0[3] * s_); w.y = cvt4_fp8(v1[0] * s_, v1[1] * s_, v1[2] * s_, v1[3] * s_);
                                *(u32x2*)((unsigned char*)out + o + bj * HALF) = w; }
                    else { u32x4 w; w.x = cvt_pk_bf16(v0[0] * dq, v0[1] * dq); w.y = cvt_pk_bf16(v0[2] * dq, v0[3] * dq); w.z = cvt_pk_bf16(v1[0] * dq, v1[1] * dq); w.w = cvt_pk_bf16(v1[2] * dq, v1[3] * dq);
                           *(u32x4*)(out + o + bj * HALF) = w; } } }
        }
    }
};

template <class T, class = void> struct has_mid { static constexpr bool value = false; };
template <class T> struct has_mid<T, decltype((void)T::HAS_MID)> { static constexpr bool value = true; };
template <class Epi, class Sched, bool ALIGN_EPI = false, bool SP2 = false, bool GATHER = false, int FP8 = 0  >
__device__ __forceinline__ void gemm_phase(PG8_LAS unsigned char* lds, const Gemm g, const Sched& S, const Epi& E, const int wave_id, const PG8_LAS unsigned short* gtab = nullptr) {
    typedef int i32x4 __attribute__((ext_vector_type(4))); typedef int i32x8 __attribute__((ext_vector_type(8)));
    static_assert(!GATHER || SP2, "GATHER needs the SP2 loop");
    int lane = (int)__builtin_amdgcn_mbcnt_hi(~0u, __builtin_amdgcn_mbcnt_lo(~0u, 0u)); asm volatile("" : "+v"(lane));
    const int wid = wave_id, tid = wid * 64 + lane, wr = wid >> 2, wc = wid & 3, fr = lane & 15, fq = lane >> 4;
    const int K = g.K, nt = K / BK;
    unsigned voffA[2], voffB[2];
#pragma unroll
    for (int i = 0; i < 2; ++i) { int R, C; stage_rc(tid * 16 + i * 8192, R, C); const int Rb = Epi::PERM ? ((R & ~31) + perm32(R & 31)) : R;
        voffA[i] = (unsigned)(R * K + C) * 2u; voffB[i] = (unsigned)(Rb * K + C) * 2u; }
    unsigned vA0[2] = {0u, 0u}, vA1[2] = {0u, 0u}, xA0[2] = {0u, 0u}, xA1[2] = {0u, 0u};
#define PG8_GLOAD(d0, d1, ui_) do { int tz_ = wid * 64 + (int)__builtin_amdgcn_mbcnt_hi(~0u, __builtin_amdgcn_mbcnt_lo(~0u, 0u)); asm volatile("" : "+v"(tz_)); _Pragma("unroll") for (int _i = 0; _i < 2; ++_i) { int R_, C_; stage_rc(tz_ * 16 + _i * 8192, R_, C_); \
        d0[_i] = (unsigned)gtab[256 * (ui_) + R_] * (unsigned)(K * 2) + (unsigned)C_ * 2u; d1[_i] = (unsigned)gtab[256 * (ui_) + 128 + R_] * (unsigned)(K * 2) + (unsigned)C_ * 2u; } } while (0)
    const unsigned kstep = (unsigned)(BK * 2);
    const unsigned hstep = (unsigned)HALF * K * 2;
    const unsigned tstep = 2 * hstep;
    const __amdgpu_buffer_rsrc_t rsA = __builtin_amdgcn_make_buffer_rsrc((void*)g.A, 0, 0x7fffffff, 0x00020000), rsB = __builtin_amdgcn_make_buffer_rsrc((void*)g.Bt, 0, 0x7fffffff, 0x00020000);
    const unsigned ldsw = (unsigned)wid * 1024u;
    const int aoff = lds_byte(wr * 64 + fr, fq * 8), boff = lds_byte(wc * 32 + fr, fq * 8);
#define PG8_SA(b, h) (((b) * 2 + (h)) * HTB)
#define PG8_SB(b, h) ((4 + (b) * 2 + (h)) * HTB)
#define PG8_STAGE(bufoff, rs, soff, voff) do { _Pragma("unroll") for (int _i = 0; _i < 2; ++_i) \
        __builtin_amdgcn_raw_ptr_buffer_load_lds(rs, (PG8_LAS void*)(lds + (bufoff) + ldsw + _i * 8192), 16, (int)(voff)[_i], (int)(soff), 0, 0); } while (0)
#define PG8_LDA(dst, b, h) do { if constexpr (FP8 == 1) { _Pragma("unroll") for (int m = 0; m < 4; ++m) dst##_8[m] = __builtin_shufflevector(*(const PG8_LAS i32x4*)(lds + PG8_SA(b, h) + aoff + m * 2048), *(const PG8_LAS i32x4*)(lds + PG8_SA(b, h) + aoff + m * 2048 + 1024), 0, 1, 2, 3, 4, 5, 6, 7); } \
        else { _Pragma("unroll") for (int m = 0; m < 4; ++m) _Pragma("unroll") for (int k = 0; k < 2; ++k) dst[m][k] = *(const PG8_LAS bf16x8*)(lds + PG8_SA(b, h) + aoff + m * 2048 + k * 1024); } } while (0)
#define PG8_LDB(dst, b, h) do { if constexpr (FP8 == 1) { _Pragma("unroll") for (int n = 0; n < 2; ++n) dst##_8[n] = __builtin_shufflevector(*(const PG8_LAS i32x4*)(lds + PG8_SB(b, h) + boff + n * 2048), *(const PG8_LAS i32x4*)(lds + PG8_SB(b, h) + boff + n * 2048 + 1024), 0, 1, 2, 3, 4, 5, 6, 7); } \
        else { _Pragma("unroll") for (int n = 0; n < 2; ++n) _Pragma("unroll") for (int k = 0; k < 2; ++k) dst[n][k] = *(const PG8_LAS bf16x8*)(lds + PG8_SB(b, h) + boff + n * 2048 + k * 1024); } } while (0)
#define PG8_MMA(ai, bj, At, Bt) do { __builtin_amdgcn_s_setprio(1); if constexpr (FP8 == 1) { _Pragma("unroll") for (int m = 0; m < 4; ++m) _Pragma("unroll") for (int n = 0; n < 2; ++n) \
        asm volatile("v_mfma_scale_f32_16x16x128_f8f6f4 %0, %1, %2, %0, %3, %3 op_sel_hi:[0,0,0]" : "+v"(acc[ai][bj][m][n]) : "v"(Bt##_8[n]), "v"(At##_8[m]), "v"(sc8));     \
        } else if constexpr (FP8 == 2) { _Pragma("unroll") for (int m = 0; m < 4; ++m) _Pragma("unroll") for (int n = 0; n < 2; ++n) _Pragma("unroll") for (int k = 0; k < 2; ++k) \
        acci[ai][bj][m][n] = __builtin_amdgcn_mfma_i32_16x16x64_i8(__builtin_bit_cast(i32x4, Bt[n][k]), __builtin_bit_cast(i32x4, At[m][k]), acci[ai][bj][m][n], 0, 0, 0); \
        } else { _Pragma("unroll") for (int m = 0; m < 4; ++m) _Pragma("unroll") for (int n = 0; n < 2; ++n) _Pragma("unroll") for (int k = 0; k < 2; ++k) \
        acc[ai][bj][m][n] = __builtin_amdgcn_mfma_f32_16x16x32_bf16(Bt[n][k], At[m][k], acc[ai][bj][m][n], 0, 0, 0); } __builtin_amdgcn_s_setprio(0); } while (0)
#define PG8_WAIT_V(n) asm volatile("s_waitcnt vmcnt(" #n ")" ::: "memory")
#define PG8_WAIT_L(n) asm volatile("s_waitcnt lgkmcnt(" #n ")" ::: "memory")
#define PG8_BAR __builtin_amdgcn_s_barrier()
#define PG8_SCHED __builtin_amdgcn_sched_barrier(0)
    Unit cur, nxt; int ui = 0;
    if (!S.next(0, cur)) return;
    f32x4 acc[2][2][4][2]; i32x4 acci[2][2][4][2];
#pragma unroll
    for (int a = 0; a < 2; ++a)
#pragma unroll
        for (int b = 0; b < 2; ++b)
#pragma unroll
            for (int m = 0; m < 4; ++m)
#pragma unroll
                for (int n = 0; n < 2; ++n) { acc[a][b][m][n] = (f32x4){0.f, 0.f, 0.f, 0.f}; acci[a][b][m][n] = (i32x4){0, 0, 0, 0}; }
    int sc8 = 0x7f7f7f7f; asm volatile("" : "+v"(sc8));
    bf16x8 At[4][2], B0[2][2], B1[2][2]; i32x8 At_8[4], B0_8[2], B1_8[2];
    unsigned cA = GATHER ? 0u : (unsigned)cur.pm * tstep, cB = (unsigned)cur.pn * tstep;
    S.a_ready(cur);
    if constexpr (GATHER) { PG8_GLOAD(vA0, vA1, 0); xA0[0] = vA0[0]; xA0[1] = vA0[1]; xA1[0] = vA1[0]; xA1[1] = vA1[1]; }
    if constexpr (SP2) {
        PG8_STAGE(PG8_SB(0, 0), rsB, cB, voffB); PG8_STAGE(PG8_SB(0, 1), rsB, cB + hstep, voffB);
        if constexpr (GATHER) { PG8_STAGE(PG8_SA(0, 0), rsA, cA, vA0); PG8_STAGE(PG8_SA(0, 1), rsA, cA, vA1); } else { PG8_STAGE(PG8_SA(0, 0), rsA, cA, voffA); PG8_STAGE(PG8_SA(0, 1), rsA, cA + hstep, voffA); }
        if (wr == 1) PG8_BAR;
        PG8_WAIT_V(2); PG8_BAR;
        PG8_STAGE(PG8_SB(1, 0), rsB, cB + kstep, voffB); if constexpr (GATHER) { PG8_STAGE(PG8_SA(1, 0), rsA, cA + kstep, vA0); } else { PG8_STAGE(PG8_SA(1, 0), rsA, cA + kstep, voffA); } PG8_STAGE(PG8_SB(1, 1), rsB, cB + hstep + kstep, voffB);
        PG8_WAIT_V(6); PG8_BAR;
    } else {
        PG8_STAGE(PG8_SB(0, 0), rsB, cB, voffB); PG8_STAGE(PG8_SA(0, 0), rsA, cA, voffA); PG8_STAGE(PG8_SB(0, 1), rsB, cB + hstep, voffB); PG8_STAGE(PG8_SA(0, 1), rsA, cA + hstep, voffA);
        if (wr == 1) PG8_BAR;
        PG8_WAIT_V(4); PG8_BAR;
        PG8_STAGE(PG8_SB(1, 0), rsB, cB + kstep, voffB); PG8_STAGE(PG8_SA(1, 0), rsA, cA + kstep, voffA); PG8_STAGE(PG8_SB(1, 1), rsB, cB + hstep + kstep, voffB);
        PG8_WAIT_V(6); PG8_BAR;
    }
    for (;;) {
        const bool has_next = S.next(ui + 1, nxt);
        const unsigned nA = GATHER ? cA : (has_next ? (unsigned)nxt.pm * tstep : cA), nB = has_next ? (unsigned)nxt.pn * tstep : cB;
        for (int t = 0; t < nt; t += 2) {
            const bool last = (t == nt - 2);
            const unsigned a1 = cA + (unsigned)(t + 1) * kstep;
            const unsigned a2 = last ? nA : cA + (unsigned)(t + 2) * kstep, b2 = last ? nB : cB + (unsigned)(t + 2) * kstep;
            const unsigned a3 = a2 + kstep, b3 = b2 + kstep;
            if (last && has_next) S.a_ready(nxt);
            if constexpr (has_mid<Epi>::value) { if (t == nt / 2) { int l3_ = (int)__builtin_amdgcn_mbcnt_hi(~0u, __builtin_amdgcn_mbcnt_lo(~0u, 0u)); asm volatile("" : "+v"(l3_)); E.mid(acc, cur, wr, wc, l3_ & 15, l3_ >> 4); } }
            if constexpr (GATHER) { if (last && has_next) { PG8_GLOAD(xA0, xA1, ui + 1); } }
            if constexpr (SP2) {
            PG8_LDB(B0, 0, 0); PG8_LDB(B1, 0, 1); PG8_SCHED; PG8_LDA(At, 0, 0); if constexpr (GATHER) { PG8_STAGE(PG8_SA(1, 1), rsA, a1, vA1); } else { PG8_STAGE(PG8_SA(1, 1), rsA, a1 + hstep, voffA); }
            PG8_WAIT_V(8); PG8_WAIT_L(0); PG8_BAR; PG8_MMA(0, 0, At, B0); PG8_MMA(0, 1, At, B1); PG8_BAR; PG8_SCHED;
            PG8_LDA(At, 0, 1); PG8_STAGE(PG8_SB(0, 0), rsB, b2, voffB); PG8_STAGE(PG8_SB(0, 1), rsB, b2 + hstep, voffB); if constexpr (GATHER) { PG8_STAGE(PG8_SA(0, 0), rsA, a2, xA0); } else { PG8_STAGE(PG8_SA(0, 0), rsA, a2, voffA); }
            PG8_WAIT_V(8); PG8_WAIT_L(0); PG8_BAR; PG8_MMA(1, 0, At, B0); PG8_MMA(1, 1, At, B1); PG8_BAR; PG8_SCHED;
            PG8_LDB(B0, 1, 0); PG8_LDB(B1, 1, 1); PG8_SCHED; PG8_LDA(At, 1, 0); if constexpr (GATHER) { PG8_STAGE(PG8_SA(0, 1), rsA, a2, xA1); } else { PG8_STAGE(PG8_SA(0, 1), rsA, a2 + hstep, voffA); }
            PG8_WAIT_V(8); PG8_WAIT_L(0); PG8_BAR; PG8_MMA(0, 0, At, B0); PG8_MMA(0, 1, At, B1); PG8_BAR; PG8_SCHED;
            PG8_LDA(At, 1, 1); PG8_STAGE(PG8_SB(1, 0), rsB, b3, voffB); PG8_STAGE(PG8_SB(1, 1), rsB, b3 + hstep, voffB); if constexpr (GATHER) { PG8_STAGE(PG8_SA(1, 0), rsA, a3, xA0); } else { PG8_STAGE(PG8_SA(1, 0), rsA, a3, voffA); }
            PG8_WAIT_V(8); PG8_WAIT_L(0); PG8_BAR; PG8_MMA(1, 0, At, B0); PG8_MMA(1, 1, At, B1); PG8_BAR; PG8_SCHED;
            } else {
            PG8_LDB(B0, 0, 0); PG8_SCHED; PG8_LDA(At, 0, 0); PG8_STAGE(PG8_SA(1, 1), rsA, a1 + hstep, voffA);
            PG8_WAIT_L(8); PG8_BAR; PG8_WAIT_L(0); PG8_MMA(0, 0, At, B0); PG8_BAR; PG8_SCHED;
            PG8_LDB(B1, 0, 1); PG8_STAGE(PG8_SB(0, 0), rsB, b2, voffB);
            PG8_BAR; PG8_WAIT_L(0); PG8_MMA(0, 1, At, B1); PG8_BAR;
            PG8_LDA(At, 0, 1); PG8_STAGE(PG8_SA(0, 0), rsA, a2, voffA);
            PG8_BAR; PG8_WAIT_L(0); PG8_MMA(1, 0, At, B0); PG8_BAR; PG8_SCHED;
            PG8_STAGE(PG8_SB(0, 1), rsB, b2 + hstep, voffB);
            PG8_WAIT_V(6); PG8_BAR; PG8_MMA(1, 1, At, B1); PG8_BAR;
            PG8_LDB(B0, 1, 0); PG8_SCHED; PG8_LDA(At, 1, 0); PG8_STAGE(PG8_SA(0, 1), rsA, a2 + hstep, voffA);
            PG8_WAIT_L(8); PG8_BAR; PG8_WAIT_L(0); PG8_MMA(0, 0, At, B0); PG8_BAR; PG8_SCHED;
            PG8_LDB(B1, 1, 1); PG8_STAGE(PG8_SB(1, 0), rsB, b3, voffB);
            PG8_BAR; PG8_WAIT_L(0); PG8_MMA(0, 1, At, B1); PG8_BAR;
            PG8_LDA(At, 1, 1); PG8_STAGE(PG8_SA(1, 0), rsA, a3, voffA);
            PG8_BAR; PG8_WAIT_L(0); PG8_MMA(1, 0, At, B0); PG8_BAR; PG8_SCHED;
            PG8_STAGE(PG8_SB(1, 1), rsB, b3 + hstep, voffB);
            PG8_WAIT_V(6); PG8_BAR; PG8_MMA(1, 1, At, B1); PG8_BAR;
            }
        }
        if constexpr (ALIGN_EPI) { if (wr == 0) PG8_BAR; }
        if constexpr (FP8 == 2) { _Pragma("unroll") for (int a = 0; a < 2; ++a) _Pragma("unroll") for (int bq = 0; bq < 2; ++bq) _Pragma("unroll") for (int m = 0; m < 4; ++m) _Pragma("unroll") for (int n = 0; n < 2; ++n) acc[a][bq][m][n] = __builtin_convertvector(acci[a][bq][m][n], f32x4); }
        if constexpr (FP8 == 1) asm volatile("s_nop 15\n\ts_nop 15" ::: "memory");
        if constexpr (!Epi::AFTER_DRAIN) { int l2_ = (int)__builtin_amdgcn_mbcnt_hi(~0u, __builtin_amdgcn_mbcnt_lo(~0u, 0u)); asm volatile("" : "+v"(l2_));
            E(acc, cur, wr, wc, l2_ & 15, l2_ >> 4); S.done(cur); }
        if (!has_next) break;
#pragma unroll
        for (int a = 0; a < 2; ++a)
#pragma unroll
            for (int b = 0; b < 2; ++b)
#pragma unroll
                for (int m = 0; m < 4; ++m)
#pragma unroll
                    for (int n = 0; n < 2; ++n) { acc[a][b][m][n] = (f32x4){0.f, 0.f, 0.f, 0.f}; acci[a][b][m][n] = (i32x4){0, 0, 0, 0}; }
        cur = nxt; cA = nA; cB = nB; ++ui;
        if constexpr (GATHER) { vA0[0] = xA0[0]; vA0[1] = xA0[1]; vA1[0] = xA1[0]; vA1[1] = xA1[1]; }
        if constexpr (ALIGN_EPI) { if (wr == 1) PG8_BAR; }
    }
    PG8_WAIT_V(0);
    if constexpr (!ALIGN_EPI) { if (wr == 0) PG8_BAR; }
    PG8_BAR;
    if constexpr (Epi::AFTER_DRAIN) { E.fused(acc, cur, wr, wc, fr, fq, lds, wid, lane); S.done(cur); }
#undef PG8_GLOAD
#undef PG8_SA
#undef PG8_SB
#undef PG8_STAGE
#undef PG8_LDA
#undef PG8_LDB
#undef PG8_MMA
#undef PG8_WAIT_V
#undef PG8_WAIT_L
#undef PG8_BAR
#undef PG8_SCHED
}
}
#define XB_TMO      128
#define XB_XCNT(j)  (256  + 64 * (j))
#define XB_XSUB(j)  (1280 + 64 * (j))
#define XB_XGEN(j)  (2304 + 64 * (j))
#define XB_TOP      3328
#define XB_TOPGEN   3392
#define XCD_BAR_WORDS 3456
#define XB_SPIN_CAP (1u << 18)

__device__ __forceinline__ unsigned xb_ld(unsigned* p)              { return __hip_atomic_load(p, __ATOMIC_RELAXED, __HIP_MEMORY_SCOPE_AGENT); }
__device__ __forceinline__ unsigned xb_add(unsigned* p, unsigned v) { return __hip_atomic_fetch_add(p, v, __ATOMIC_RELAXED, __HIP_MEMORY_SCOPE_AGENT); }
__device__ __forceinline__ unsigned xb_xcc_id() { return (unsigned)__builtin_amdgcn_s_getreg((3 << 11) | 20) & 0xFu; }
#define XB_SPIN(cond, bar) do { unsigned _sp = 0; while (cond) { __builtin_amdgcn_s_sleep(1); \
    if ((++_sp & 255u) == 0u) { if (xb_ld(&(bar)[XB_TMO])) break; if (_sp > XB_SPIN_CAP) { atomicAdd(&(bar)[XB_TMO], 1u); break; } } } } while (0)

struct XcdBarrier {
    unsigned* bar; unsigned x;
    volatile LAS unsigned* st;
};

__device__ __forceinline__ XcdBarrier xcd_barrier_post(unsigned* bar, volatile LAS unsigned* st, const bool leader  ) {
    XcdBarrier b; b.bar = bar; b.x = xb_xcc_id(); b.st = st;
    if (leader) (void)xb_add(&bar[XB_XCNT(b.x)], 1u);
    return b;
}
__device__ __forceinline__ void xcd_barrier_complete(unsigned* bar, unsigned x, unsigned& nloc, unsigned& nx) {
    const unsigned G = gridDim.x * gridDim.y * gridDim.z;
    unsigned sum, cnt, mine, sp = 0u;
    for (;;) {
        sum = 0u; cnt = 0u; mine = 0u;
#pragma unroll
        for (unsigned j = 0; j < 16; ++j) { const unsigned c = xb_ld(&bar[XB_XCNT(j)]); sum += c; cnt += (c > 0u) ? 1u : 0u; mine = (j == x) ? c : mine; }
        if (sum == G) break;
        __builtin_amdgcn_s_sleep(1);
        if ((++sp & 255u) == 0u) { if (xb_ld(&bar[XB_TMO])) break; if (sp > XB_SPIN_CAP) { atomicAdd(&bar[XB_TMO], 1u); break; } }
    }
    nloc = mine > 0u ? mine : 1u; nx = cnt > 0u ? cnt : 1u;
}

__device__ __forceinline__ void xcd_barrier(const XcdBarrier& b, const bool leader  ) {
    asm volatile("s_waitcnt vmcnt(0)" ::: "memory");
    __syncthreads();
    if (leader) {
        unsigned* bar = b.bar;
        __builtin_amdgcn_s_waitcnt(0);
        unsigned nloc = b.st[0], nx = b.st[1];
        if (nloc == 0u) { xcd_barrier_complete(bar, b.x, nloc, nx); b.st[0] = nloc; b.st[1] = nx; }
        const unsigned old = xb_add(&bar[XB_XSUB(b.x)], 1u);
        const unsigned gen = old / nloc;
        if (old + 1u == (gen + 1u) * nloc) {
            __builtin_amdgcn_fence(__ATOMIC_RELEASE, "agent");
            asm volatile("s_waitcnt vmcnt(0)" ::: "memory");
            const unsigned og = xb_add(&bar[XB_TOP], 1u);
            const unsigned tg = og / nx;
            if (og + 1u == (tg + 1u) * nx) xb_add(&bar[XB_TOPGEN], 1u);
            else XB_SPIN(xb_ld(&bar[XB_TOPGEN]) == tg, bar);
            __builtin_amdgcn_fence(__ATOMIC_ACQUIRE, "agent");
            xb_add(&bar[XB_XGEN(b.x)], 1u);
            asm volatile("s_waitcnt vmcnt(0)" ::: "memory");
        } else {
            XB_SPIN(xb_ld(&bar[XB_XGEN(b.x)]) == gen, bar);
            __builtin_amdgcn_fence(__ATOMIC_ACQUIRE, "agent");
            asm volatile("s_waitcnt vmcnt(0)" ::: "memory");
        }
    }
    __syncthreads();
}

#ifndef MIX_FP8
#define MIX_FP8 1
#endif
#ifndef RES_FP8
#define RES_FP8 1
#endif
#ifndef P_INT8
#define P_INT8 1
#endif
#ifndef P_FP8_MASK
#define P_FP8_MASK 0xFFFFFFFFu
#endif =======================================================
struct Ctx { LAS unsigned char* lds; int tid, lane, wave, vcu, G; };

__device__ __forceinline__ void transpose_load64(const float* W, int ldw, int k0, int n0, LAS float* scr, int lane) {
#pragma unroll 8
    for (int i = 0; i < 16; ++i) { const int kk = 4 * i + (lane >> 4), nn = 4 * (lane & 15); const f32x4 v = *(const f32x4*)(W + (size_t)(k0 + kk) * ldw + n0 + nn);
        LAS float* d = scr + kk * 65 + nn; d[0] = v.x; d[1] = v.y; d[2] = v.z; d[3] = v.w; }
    LDS_WAIT();
}
__device__ __forceinline__ void transpose_item(const float* W, int ldw, int K, bf16_t* dst, int k0, int n0, LAS float* scr, int lane) {
    transpose_load64(W, ldw, k0, n0, scr, lane);
    const int c = lane & 7;
#pragma unroll
    for (int j = 0; j < 8; ++j) { const int n = (lane >> 3) + 8 * j; const LAS float* s = scr + (8 * c) * 65 + n;
        u32x4 o; o.x = pk2(s[0 * 65], s[1 * 65]); o.y = pk2(s[2 * 65], s[3 * 65]); o.z = pk2(s[4 * 65], s[5 * 65]); o.w = pk2(s[6 * 65], s[7 * 65]);
        *(u32x4*)(dst + (size_t)n * K + k0 + 8 * c) = o; }
    LDS_WAIT();
}
__device__ __forceinline__ void transpose_item8(const float* W, int ldw, int K, unsigned char* dst, int k0, int n0, float scale, LAS float* scr, int lane) {
    (void)scr;
    const int kc = lane & 3, nq = lane >> 2;
    const float* s = W + (size_t)(k0 + 16 * kc) * ldw + n0 + 4 * nq;
    f32x4 v[16];
#pragma unroll
    for (int i = 0; i < 16; ++i) v[i] = *(const f32x4*)(s + (size_t)i * ldw);
#pragma unroll
    for (int j = 0; j < 4; ++j) {
        u32x4 o; o.x = cvt4_fp8(v[0][j] * scale, v[1][j] * scale, v[2][j] * scale, v[3][j] * scale); o.y = cvt4_fp8(v[4][j] * scale, v[5][j] * scale, v[6][j] * scale, v[7][j] * scale);
        o.z = cvt4_fp8(v[8][j] * scale, v[9][j] * scale, v[10][j] * scale, v[11][j] * scale); o.w = cvt4_fp8(v[12][j] * scale, v[13][j] * scale, v[14][j] * scale, v[15][j] * scale);
        *(u32x4*)(dst + (size_t)(4 * nq + j) * K + k0 + 16 * kc) = o; }
}

template <int PART>
__device__ __forceinline__ void ph_prologue(const Ctx& X, const float* c, const float* w_ada, const float* b_ada, float* mod,
                                            const float* w_in, const float* w_conv_out, const float* w_hgrn_out, const float* w_out, const float* w1, const float* w2, unsigned char* ws) {
    if (PART == 0) for (int cbk = X.vcu; cbk < NMOD / 32; cbk += X.G) {
        LAS float* ca = (LAS float*)X.lds;
        LAS float* red = (LAS float*)(X.lds + 16384);
        for (int i = X.tid; i < 4096; i += 512) { const float v = c[i]; ca[i] = v * sigmoidf_(v); }
        __syncthreads();
        const int jj = X.tid & 31, kp = X.tid >> 5, j = cbk * 32 + jj;
        float a0 = 0.f, a1 = 0.f, a2 = 0.f, a3 = 0.f;
#pragma unroll 16
        for (int i = kp * 64; i < kp * 64 + 64; ++i) { const float w = w_ada[(size_t)i * NMOD + j]; a0 += ca[i] * w; a1 += ca[1024 + i] * w; a2 += ca[2048 + i] * w; a3 += ca[3072 + i] * w; }
        red[(kp * 4 + 0) * 32 + jj] = a0; red[(kp * 4 + 1) * 32 + jj] = a1; red[(kp * 4 + 2) * 32 + jj] = a2; red[(kp * 4 + 3) * 32 + jj] = a3;
        __syncthreads();
        if (X.tid < 128) { const int b = X.tid >> 5; float r = b_ada[j];
#pragma unroll
            for (int q = 0; q < 16; ++q) r += red[(q * 4 + b) * 32 + jj];
            mod[(size_t)b * NMOD + j] = r; }
        __syncthreads();
    }
    LAS float* scr = (LAS float*)(X.lds + X.wave * 16640);
    const bool split = PART == 0 && X.G > NMOD / 32;
    const int gw = split ? (X.vcu - NMOD / 32) * 8 + X.wave : X.vcu * 8 + X.wave, NGW = split ? (X.G - NMOD / 32) * 8 : X.G * 8;
    constexpr int I_IN = 16 * 128, I_SQ = 16 * 16, I_W1 = 32 * 16 * 32, I_W2 = 32 * 16 * 16, NITEMS = I_IN + 3 * I_SQ + I_W1 + I_W2;
    constexpr int I_DENSE = I_IN + 3 * I_SQ;
    if (!(split && X.vcu < NMOD / 32)) for (int it = (PART == 0 ? (P_INT8 ? I_IN : 0) : I_DENSE) + gw; it < (PART == 0 ? I_DENSE : NITEMS); it += NGW) {
        int r = it;
        if (r < I_IN) { const int kb = r >> 7, nb = r & 127, n0 = 64 * nb;
            const int rho0 = (n0 < 2048) ? 256 * ((n0 & 1023) >> 7) + 128 * (n0 >> 10) + (n0 & 127) : n0;
            if ((P_FP8_MASK >> (rho0 >> 8)) & 1u) transpose_item8(w_in, 8192, 1024, (unsigned char*)(ws + WS_WIN8) + (size_t)rho0 * 1024, 64 * kb, n0, 256.0f, scr, X.lane);
            else transpose_item(w_in, 8192, 1024, (bf16_t*)(ws + WS_WIN) + (size_t)rho0 * 1024, 64 * kb, n0, scr, X.lane);
            continue; } r -= I_IN;
        if (r < 3 * I_SQ) { const int which = r / I_SQ, q = r % I_SQ, kb = q >> 4, nb = q & 15;
            const float* W = which == 0 ? w_conv_out : (which == 1 ? w_hgrn_out : w_out);
            if (which == 2) { if (RES_FP8) transpose_item8(W, 1024, 1024, (unsigned char*)(ws + WS_WO) + (size_t)(64 * nb) * 1024, 64 * kb, 64 * nb, 256.0f, scr, X.lane);
                              else transpose_item(W, 1024, 1024, (bf16_t*)(ws + WS_WO) + (size_t)(64 * nb) * 1024, 64 * kb, 64 * nb, scr, X.lane); }
            else if (MIX_FP8) transpose_item8(W, 1024, 2048, (unsigned char*)(ws + WS_WC) + (size_t)(64 * nb) * 2048 + which * 1024, 64 * kb, 64 * nb, 256.0f, scr, X.lane);
            else transpose_item(W, 1024, 2048, (bf16_t*)(ws + WS_WC) + (size_t)(64 * nb) * 2048 + which * 1024, 64 * kb, 64 * nb, scr, X.lane);
            continue; } r -= 3 * I_SQ;
        if (r < I_W1) { const int e = r >> 9, q = r & 511, kb = q >> 5, nb = q & 31, n0 = 64 * nb;
            const int rho0 = (n0 < 1024) ? 256 * (n0 >> 7) + (n0 & 127) : 256 * ((n0 - 1024) >> 7) + 128 + ((n0 - 1024) & 127);
            transpose_item8(w1 + (size_t)e * 1024 * 2048, 2048, 1024, (unsigned char*)(ws + WS_W1) + ((size_t)e * 2048 + rho0) * 1024, 64 * kb, n0, 256.0f, scr, X.lane); continue; } r -= I_W1;
        { const int e = r >> 8, q = r & 255, kb = q >> 4, nb = q & 15;
            transpose_item8(w2 + (size_t)e * 1024 * 1024, 1024, 1024, (unsigned char*)(ws + WS_W2) + ((size_t)e * 1024 + 64 * nb) * 1024, 64 * kb, 64 * nb, 256.0f, scr, X.lane); }
    }
    __syncthreads();
}

__device__ __forceinline__ void ph_norm_mod(const Ctx& X, const float* x, const float* g, const float* mod, int sh_off, int sc_off, bf16_t* out, unsigned char* out8, float* hsc) {
    for (int t = X.vcu * 8 + X.wave; t < T; t += X.G * 8) {
        const int b = t / SEQ, lane = X.lane;
        const f32x4* xr = (const f32x4*)(x + (size_t)t * D) + lane;
        f32x4 v[4]; float ss = 0.f;
#pragma unroll
        for (int j = 0; j < 4; ++j) { v[j] = xr[64 * j]; ss += (v[j].x * v[j].x + v[j].y * v[j].y) + (v[j].z * v[j].z + v[j].w * v[j].w); }
        const float r = rsqrtf(wave_sum(ss) * (1.0f / D) + EPS);
        const float* sh = mod + (size_t)b * NMOD + sh_off; const float* sc = mod + (size_t)b * NMOD + sc_off;
        float am = 0.f;
#pragma unroll
        for (int j = 0; j < 4; ++j) {
            const int col = 4 * (lane + 64 * j);
            const f32x4 gg = *(const f32x4*)(g + col), s1 = *(const f32x4*)(sc + col), s0 = *(const f32x4*)(sh + col);
            v[j] = v[j] * r * gg * (s1 + 1.0f) + s0;
            am = fmaxf(fmaxf(am, fmaxf(fabsf(v[j].x), fabsf(v[j].y))), fmaxf(fabsf(v[j].z), fabsf(v[j].w)));
        }
        if (P_INT8) {
#pragma unroll
            for (int o = 1; o < 64; o <<= 1) am = fmaxf(am, __shfl_xor(am, o));
            am = fmaxf(am, 1e-20f); const float qs = 127.0f / am;
            if (lane == 0) hsc[t] = am * (1.0f / 127.0f);
#pragma unroll
            for (int j = 0; j < 4; ++j) *(unsigned*)(out8 + (size_t)t * D + 4 * (lane + 64 * j)) = q4_i8(v[j].x * qs, v[j].y * qs, v[j].z * qs, v[j].w * qs);
        } else {
#pragma unroll
            for (int j = 0; j < 4; ++j) { const int col = 4 * (lane + 64 * j); const f32x4 y = v[j];
                if (P_FP8_MASK != 0xFFFFFFFFu) { u32x2 w; w.x = pk2(y.x, y.y); w.y = pk2(y.z, y.w); *(u32x2*)(out + (size_t)t * D + col) = w; }
                if (P_FP8_MASK != 0u) *(unsigned*)(out8 + (size_t)t * D + col) = cvt4_fp8(y.x * 16.0f, y.y * 16.0f, y.z * 16.0f, y.w * 16.0f); }
        }
    }
}

__device__ __forceinline__ void ph_win_i8(const Ctx& X, const float* w_in, unsigned char* ws) {
    LAS float* part = (LAS float*)(X.lds + 8 * 8704);
    LAS float* cmax = part + 512;
    float* wsc = (float*)(ws + WS_WSC); unsigned char* wt = ws + WS_WIN8;
    const int tid = X.tid, c = tid & 31, kq = tid >> 5;
    for (int cb = X.vcu; cb < 256; cb += X.G) {
        const int n0 = 32 * cb;
        const int rho0 = (n0 < 2048) ? 256 * ((n0 & 1023) >> 7) + 128 * (n0 >> 10) + (n0 & 127) : n0;
        float v[64]; const float* p_ = w_in + (size_t)(kq * 64) * 8192 + n0 + c;
#pragma unroll
        for (int i = 0; i < 64; ++i) v[i] = p_[(size_t)i * 8192];
        float m = 0.f;
#pragma unroll
        for (int i = 0; i < 64; ++i) m = fmaxf(m, fabsf(v[i]));
        part[kq * 32 + c] = m;
        __syncthreads();
        if (tid < 32) { float m2 = 0.f;
#pragma unroll
            for (int q = 0; q < 16; ++q) m2 = fmaxf(m2, part[q * 32 + tid]);
            m2 = fmaxf(m2, 1e-30f); cmax[tid] = m2; wsc[rho0 + tid] = m2 * (1.0f / 127.0f); }
        __syncthreads();
        const float qs = 127.0f / cmax[c];
        unsigned char* d = wt + (size_t)(rho0 + c) * 1024 + kq * 64;
#pragma unroll
        for (int q = 0; q < 4; ++q) { u32x4 o;
            o.x = q4_i8(v[16 * q + 0] * qs, v[16 * q + 1] * qs, v[16 * q + 2] * qs, v[16 * q + 3] * qs); o.y = q4_i8(v[16 * q + 4] * qs, v[16 * q + 5] * qs, v[16 * q + 6] * qs, v[16 * q + 7] * qs);
            o.z = q4_i8(v[16 * q + 8] * qs, v[16 * q + 9] * qs, v[16 * q + 10] * qs, v[16 * q + 11] * qs); o.w = q4_i8(v[16 * q + 12] * qs, v[16 * q + 13] * qs, v[16 * q + 14] * qs, v[16 * q + 15] * qs);
            *(u32x4*)(d + 16 * q) = o; }
        __syncthreads();
    }
}

typedef float f32x2 __attribute__((ext_vector_type(2)));
__device__ __forceinline__ void ph_conv(const Ctx& X, const bf16_t* pU, const float* dw, const float* dwb, const float* lng, const float* lnb, bf16_t* uc) {
    LAS float* sm = (LAS float*)X.lds;
    const int tid = X.tid, lane = X.lane, wid = X.wave, c0 = 2 * tid;
    float w[31][2];
#pragma unroll
    for (int j = 0; j < 31; ++j) { w[j][0] = dw[j * 1024 + c0]; w[j][1] = dw[j * 1024 + c0 + 1]; }
    const float bias0 = dwb[c0], bias1 = dwb[c0 + 1];
    unsigned raw[62];
#define CONV_LOAD(task_) do { const int b_ = (task_) >> 8, s0_ = ((task_) & 255) * 32; const bf16_t* q_ = pU + (size_t)(b_ * SEQ) * D + c0; \
        _Pragma("unroll") for (int i = 0; i < 62; ++i) { const int s_ = s0_ - 30 + i; raw[i] = (s_ >= 0) ? *(const unsigned*)(q_ + (size_t)s_ * D) : 0u; } } while (0)
    int task = X.vcu;
    if (task < T / 32) CONV_LOAD(task);
    for (; task < T / 32; task += X.G) {
        const int b = task >> 8, s0 = (task & 255) * 32;
#pragma unroll
        for (int st = 0; st < 4; ++st) {
            float u[38][2];
#pragma unroll
            for (int i = 0; i < 38; ++i) { u[i][0] = bflo(raw[8 * st + i]); u[i][1] = bfhi(raw[8 * st + i]); }
#pragma unroll
            for (int t = 0; t < 8; ++t) {
                float a0 = bias0, a1 = bias1;
#pragma unroll
                for (int j = 0; j < 31; ++j) { a0 += w[j][0] * u[t + j][0]; a1 += w[j][1] * u[t + j][1]; }
                *(LAS f32x2*)(sm + (8 * st + t) * 1024 + c0) = (f32x2){a0, a1};
            }
        }
        if (task + X.G < T / 32) CONV_LOAD(task + X.G);
        __syncthreads();
#pragma unroll 2
        for (int i = 0; i < 4; ++i) {
            const int t = wid * 4 + i;
            f32x4 v[4]; float s = 0.f;
#pragma unroll
            for (int j = 0; j < 4; ++j) { v[j] = *(const LAS f32x4*)(sm + t * 1024 + 4 * (lane + 64 * j)); s += (v[j].x + v[j].y) + (v[j].z + v[j].w); }
            const float mean = wave_sum(s) * (1.0f / D); float q = 0.f;
#pragma unroll
            for (int j = 0; j < 4; ++j) { v[j] = v[j] - mean; q += (v[j].x * v[j].x + v[j].y * v[j].y) + (v[j].z * v[j].z + v[j].w * v[j].w); }
            const float rstd = rsqrtf(wave_sum(q) * (1.0f / D) + EPS);
#pragma unroll
            for (int j = 0; j < 4; ++j) {
                const int col = 4 * (lane + 64 * j);
                const f32x4 gg = *(const f32x4*)(lng + col), bb = *(const f32x4*)(lnb + col);
                f32x4 y = v[j] * rstd * gg + bb;
                y.x *= sigmoidf_(y.x); y.y *= sigmoidf_(y.y); y.z *= sigmoidf_(y.z); y.w *= sigmoidf_(y.w);
                u32x2 o; o.x = pk2(y.x, y.y); o.y = pk2(y.z, y.w);
                if (MIX_FP8) *(unsigned*)((unsigned char*)uc + (size_t)(b * SEQ + s0 + t) * (2 * D) + col) = cvt4_fp8(y.x * 16.0f, y.y * 16.0f, y.z * 16.0f, y.w * 16.0f);
                else *(u32x2*)(uc + (size_t)(b * SEQ + s0 + t) * (2 * D) + col) = o;
            }
        }
        __syncthreads();
    }
#undef CONV_LOAD
}

typedef short bf16x8 __attribute__((ext_vector_type(8)));
typedef short s16x4 __attribute__((ext_vector_type(4)));
constexpr int HG_QA = 0, HG_KA = 17408, HG_VR = 34816, HG_AB = 52224, HG_SPT = 61440, HG_O = 96256, HG_SEG = 130048;
constexpr size_t HM = (size_t)SEQ * 128;
__device__ __forceinline__ bf16x8 tr_frag(LAS unsigned char* base, int rs, int ks, int c16, int lane) {
    const int g = lane >> 4, q = (lane & 15) >> 2, p = lane & 3;
    LAS unsigned char* a = base + (32 * ks + 8 * g + q) * rs + (16 * c16 + 4 * p) * 2;
    const s16x4 lo = __builtin_amdgcn_ds_read_tr16_b64_v4i16((LAS s16x4*)a);
    const s16x4 hi = __builtin_amdgcn_ds_read_tr16_b64_v4i16((LAS s16x4*)(a + 4 * rs));
    return __builtin_shufflevector(lo, hi, 0, 1, 2, 3, 4, 5, 6, 7);
}
template <bool OUT>
__device__ __forceinline__ void ph_hgrn(const Ctx& X, int ntask, const bf16_t* pQ, const bf16_t* pF, const bf16_t* pI, const bf16_t* pG,
                                        const float* lb_param, const float* norm_g, const float* S0, float* dS, float* Dd, bf16_t* og) {
    LAS unsigned char* L = X.lds;
    LAS float* seg_s = (LAS float*)(L + HG_SEG);
    const int tid = X.tid, lane = X.lane, wave = X.wave, fr = lane & 15, fq = lane >> 4, wr = wave >> 1, wc = wave & 1;
    const int cp = tid & 63, seg = wave, tv = tid >> 3, vc = tid & 7;
    int idx = X.vcu; if (idx >= ntask) return;
    int ch = 0;
    unsigned zr[8], qr[8]; u32x4 vr0, vr1, gn0, gn1, gc0, gc1;
#define HG_LOAD(idx_, ch_) do { const int bh_ = (idx_) & 31, sc_ = (idx_) >> 5; const size_t tb_ = (size_t)bh_ * HM + (size_t)(sc_ * 256 + (ch_) * 64) * 128; \
        _Pragma("unroll") for (int i = 0; i < 8; ++i) { zr[i] = *(const unsigned*)(pF + tb_ + (size_t)(8 * seg + i) * 128 + 2 * cp); if (OUT) qr[i] = *(const unsigned*)(pQ + tb_ + (size_t)(8 * seg + i) * 128 + 2 * cp); } \
        { const u32x4* s_ = (const u32x4*)(pI + tb_ + (size_t)tv * 128 + vc * 16); vr0 = s_[0]; vr1 = s_[1]; } \
        if (OUT) { const u32x4* s_ = (const u32x4*)(pG + tb_ + (size_t)tv * 128 + vc * 16); gn0 = s_[0]; gn1 = s_[1]; } } while (0)
    HG_LOAD(idx, 0);
    float ngv[16];
    if (OUT) {
#pragma unroll
        for (int i = 0; i < 16; ++i) ngv[i] = norm_g[vc * 16 + i];
    }
    f32x4 S[8]; float oml0 = 0.f, oml1 = 0.f, gsum0 = 0.f, gsum1 = 0.f;
#pragma unroll 1
    for (;;) {
        const int sc = idx >> 5, bh = idx & 31, b = bh >> 3, h = bh & 7;
        if (ch == 0) {
            const int c0 = h * 128 + 2 * cp;
            oml0 = 1.0f - 1.0f / (1.0f + __expf(lb_param[1024 + c0] - lb_param[c0])); oml1 = 1.0f - 1.0f / (1.0f + __expf(lb_param[1025 + c0] - lb_param[c0 + 1]));
            gsum0 = 0.f; gsum1 = 0.f;
            if (OUT && sc > 0) { const bf16_t* s0 = (const bf16_t*)S0 + (size_t)(bh * 32 + sc) * 16384;
#pragma unroll
                for (int vt = 0; vt < 8; ++vt) { const u32x2 w = *(const u32x2*)(s0 + (size_t)(vt * 16 + fr) * 128 + 16 * wave + fq * 4); S[vt] = (f32x4){bflo(w.x), bfhi(w.x), bflo(w.y), bfhi(w.y)}; }
            } else {
#pragma unroll
                for (int vt = 0; vt < 8; ++vt) S[vt] = (f32x4){0.f, 0.f, 0.f, 0.f};
            }
        }
        float kk0[8], kk1[8], lf0[8], lf1[8], q0[8], q1[8];
        {
            float c0 = 0.f, c1 = 0.f;
#pragma unroll
            for (int i = 0; i < 8; ++i) {
                kk0[i] = oml0 * __builtin_amdgcn_rcpf(1.0f + __expf(bflo(zr[i]))); kk1[i] = oml1 * __builtin_amdgcn_rcpf(1.0f + __expf(bfhi(zr[i])));
                c0 += __builtin_amdgcn_logf(1.0f - kk0[i]); c1 += __builtin_amdgcn_logf(1.0f - kk1[i]); lf0[i] = c0; lf1[i] = c1;
                if (OUT) { q0[i] = bflo(qr[i]) * 0.08838834764831845f; q1[i] = bfhi(qr[i]) * 0.08838834764831845f; }
            }
            *(LAS f32x2*)(seg_s + seg * 128 + 2 * cp) = (f32x2){c0, c1};
        }
        if (OUT) { gc0 = gn0; gc1 = gn1; }
        const u32x4 vcur0 = vr0, vcur1 = vr1;
        __syncthreads();
        { LAS u32x4* d = (LAS u32x4*)(L + HG_VR + tv * 272 + vc * 32); d[0] = vcur0; d[1] = vcur1; }
        { int idx2 = idx, ch2 = ch + 1; if (ch2 == 4) { ch2 = 0; idx2 = idx + X.G; } if (idx2 < ntask) HG_LOAD(idx2, ch2); }
        {
            f32x2 ss[8];
#pragma unroll
            for (int s = 0; s < 8; ++s) ss[s] = *(const LAS f32x2*)(seg_s + s * 128 + 2 * cp);
            float off0 = 0.f, off1 = 0.f;
#pragma unroll
            for (int s = 0; s < 8; ++s) { off0 += (s < seg) ? ss[s].x : 0.f; off1 += (s < seg) ? ss[s].y : 0.f; }
            const float R0 = (ss[0].x + ss[1].x) + (ss[2].x + ss[3].x), R1 = (ss[0].y + ss[1].y) + (ss[2].y + ss[3].y);
            if (!OUT && seg == 0) { gsum0 += R0 + (ss[4].x + ss[5].x) + (ss[6].x + ss[7].x); gsum1 += R1 + (ss[4].y + ss[5].y) + (ss[6].y + ss[7].y); }
#pragma unroll
            for (int i = 0; i < 8; ++i) {
                const float G0 = off0 + lf0[i], G1 = off1 + lf1[i];
                const float ka0 = kk0[i] * __builtin_amdgcn_exp2f(fminf(R0 - G0, 115.0f)), ka1 = kk1[i] * __builtin_amdgcn_exp2f(fminf(R1 - G1, 115.0f));
                *(LAS unsigned*)(L + HG_KA + (8 * seg + i) * 272 + 4 * cp) = pk2(ka0, ka1);
                if (OUT) { const float qa0 = q0[i] * __builtin_amdgcn_exp2f(fminf(G0 - R0, 115.0f)), qa1 = q1[i] * __builtin_amdgcn_exp2f(fminf(G1 - R1, 115.0f));
                           *(LAS unsigned*)(L + HG_QA + (8 * seg + i) * 272 + 4 * cp) = pk2(qa0, qa1); }
            }
        }
        float eR[4], eL[4];
        {
            f32x4 r4 = (f32x4){0.f, 0.f, 0.f, 0.f}, l4 = (f32x4){0.f, 0.f, 0.f, 0.f};
#pragma unroll
            for (int s = 0; s < 4; ++s) { r4 += *(const LAS f32x4*)(seg_s + s * 128 + 16 * wave + 4 * fq); l4 += *(const LAS f32x4*)(seg_s + (s + 4) * 128 + 16 * wave + 4 * fq); }
#pragma unroll
            for (int j = 0; j < 4; ++j) { eR[j] = __builtin_amdgcn_exp2f(fmaxf(r4[j], -115.0f)); eL[j] = __builtin_amdgcn_exp2f(l4[j]); }
        }
#pragma unroll
        for (int vt = 0; vt < 8; ++vt) {
#pragma unroll
            for (int j = 0; j < 4; ++j) S[vt][j] *= eR[j];
            if (OUT) { u32x2 w; w.x = pk2(S[vt][0], S[vt][1]); w.y = pk2(S[vt][2], S[vt][3]);
                       *(LAS u32x2*)(L + HG_SPT + (vt * 16 + fr) * 272 + (16 * wave + 4 * fq) * 2) = w; }
        }
        __syncthreads();
        if (OUT) {
#pragma unroll
            for (int q2 = 0; q2 < 2; ++q2) {
                const int st = 2 * wc + q2;
                f32x4 acc = (f32x4){0.f, 0.f, 0.f, 0.f};
                if (st <= wr) {
#pragma unroll
                    for (int kq = 0; kq < 4; ++kq) {
                        const bf16x8 af = *(const LAS bf16x8*)(L + HG_KA + (st * 16 + fr) * 272 + kq * 64 + fq * 16);
                        const bf16x8 bq = *(const LAS bf16x8*)(L + HG_QA + (wr * 16 + fr) * 272 + kq * 64 + fq * 16);
                        acc = __builtin_amdgcn_mfma_f32_16x16x32_bf16(af, bq, acc, 0, 0, 0);
                    }
                    const int tt = wr * 16 + fr;
#pragma unroll
                    for (int j = 0; j < 4; ++j) { const int s_ = st * 16 + fq * 4 + j; acc[j] = (s_ <= tt) ? acc[j] : 0.f; }
                }
                u32x2 w; w.x = pk2(acc[0], acc[1]); w.y = pk2(acc[2], acc[3]);
                *(LAS u32x2*)(L + HG_AB + (wr * 16 + fr) * 144 + (st * 16 + fq * 4) * 2) = w;
            }
        }
        {
            bf16x8 aK[2];
#pragma unroll
            for (int ks = 0; ks < 2; ++ks) aK[ks] = tr_frag(L + HG_KA, 272, ks, wave, lane);
#pragma unroll
            for (int vt = 0; vt < 8; ++vt) {
#pragma unroll
                for (int ks = 0; ks < 2; ++ks) { const bf16x8 bv = tr_frag(L + HG_VR, 272, ks, vt, lane); S[vt] = __builtin_amdgcn_mfma_f32_16x16x32_bf16(aK[ks], bv, S[vt], 0, 0, 0); }
#pragma unroll
                for (int j = 0; j < 4; ++j) S[vt][j] *= eL[j];
            }
        }
        if (OUT) {
            __syncthreads();
            bf16x8 aA[2], aQ[4];
#pragma unroll
            for (int ks = 0; ks < 2; ++ks) aA[ks] = *(const LAS bf16x8*)(L + HG_AB + (wr * 16 + fr) * 144 + ks * 64 + fq * 16);
#pragma unroll
            for (int kq = 0; kq < 4; ++kq) aQ[kq] = *(const LAS bf16x8*)(L + HG_QA + (wr * 16 + fr) * 272 + kq * 64 + fq * 16);
#pragma unroll
            for (int n = 0; n < 4; ++n) {
                const int vt = wc * 4 + n;
                f32x4 o = (f32x4){0.f, 0.f, 0.f, 0.f};
#pragma unroll
                for (int ks = 0; ks < 2; ++ks) { const bf16x8 bv = tr_frag(L + HG_VR, 272, ks, vt, lane); o = __builtin_amdgcn_mfma_f32_16x16x32_bf16(aA[ks], bv, o, 0, 0, 0); }
#pragma unroll
                for (int kq = 0; kq < 4; ++kq) { const bf16x8 bs = *(const LAS bf16x8*)(L + HG_SPT + (vt * 16 + fr) * 272 + kq * 64 + fq * 16); o = __builtin_amdgcn_mfma_f32_16x16x32_bf16(aQ[kq], bs, o, 0, 0, 0); }
#pragma unroll
                for (int j = 0; j < 4; ++j) *(LAS float*)(L + HG_O + (wr * 16 + fq * 4 + j) * 528 + (vt * 16 + fr) * 4) = o[j];
            }
            __syncthreads();
            {
                f32x4 ov[4]; float ssq = 0.f;
#pragma unroll
                for (int i = 0; i < 4; ++i) { ov[i] = *(const LAS f32x4*)(L + HG_O + tv * 528 + vc * 64 + i * 16); ssq += (ov[i].x * ov[i].x + ov[i].y * ov[i].y) + (ov[i].z * ov[i].z + ov[i].w * ov[i].w); }
                ssq += __shfl_xor(ssq, 1); ssq += __shfl_xor(ssq, 2); ssq += __shfl_xor(ssq, 4);
                const float rstd = rsqrtf(ssq * (1.0f / 128.0f) + EPS);
                const unsigned gw[8] = {gc0.x, gc0.y, gc0.z, gc0.w, gc1.x, gc1.y, gc1.z, gc1.w};
                unsigned ow[8]; float yv[16];
#pragma unroll
                for (int i = 0; i < 8; ++i) { const float g0 = bflo(gw[i]), g1 = bfhi(gw[i]);
                    const float y0 = ov[i >> 1][(2 * i) & 3] * rstd * ngv[2 * i] * g0 * __builtin_amdgcn_rcpf(1.0f + __expf(-g0));
                    const float y1 = ov[i >> 1][(2 * i + 1) & 3] * rstd * ngv[2 * i + 1] * g1 * __builtin_amdgcn_rcpf(1.0f + __expf(-g1));
                    ow[i] = pk2(y0, y1); yv[2 * i] = y0; yv[2 * i + 1] = y1; }
                if (MIX_FP8) { u32x4 o8; o8.x = cvt4_fp8(yv[0] * 16.0f, yv[1] * 16.0f, yv[2] * 16.0f, yv[3] * 16.0f); o8.y = cvt4_fp8(yv[4] * 16.0f, yv[5] * 16.0f, yv[6] * 16.0f, yv[7] * 16.0f);
                               o8.z = cvt4_fp8(yv[8] * 16.0f, yv[9] * 16.0f, yv[10] * 16.0f, yv[11] * 16.0f); o8.w = cvt4_fp8(yv[12] * 16.0f, yv[13] * 16.0f, yv[14] * 16.0f, yv[15] * 16.0f);
                               *(u32x4*)((unsigned char*)og + (size_t)(b * SEQ + sc * 256 + ch * 64 + tv) * (2 * D) + h * 128 + vc * 16) = o8; }
                else { u32x4* d = (u32x4*)(og + (size_t)(b * SEQ + sc * 256 + ch * 64 + tv) * (2 * D) + h * 128 + vc * 16);
                       d[0] = (u32x4){ow[0], ow[1], ow[2], ow[3]}; d[1] = (u32x4){ow[4], ow[5], ow[6], ow[7]}; }
            }
        }
        if (ch == 3) {
            if (!OUT) {
                bf16_t* ds = (bf16_t*)dS + (size_t)(bh * 32 + sc) * 16384;
#pragma unroll
                for (int vt = 0; vt < 8; ++vt) { u32x2 w; w.x = pk2(S[vt][0], S[vt][1]); w.y = pk2(S[vt][2], S[vt][3]); *(u32x2*)(ds + (size_t)(vt * 16 + fr) * 128 + 16 * wave + fq * 4) = w; }
                if (seg == 0) *(f32x2*)(Dd + (size_t)(bh * 32 + sc) * 128 + 2 * cp) = (f32x2){__builtin_amdgcn_exp2f(gsum0), __builtin_amdgcn_exp2f(gsum1)};
            }
            idx += X.G; ch = 0; if (idx >= ntask) break;
        } else ++ch;
    }
#undef HG_LOAD
    __syncthreads();
}

__device__ __forceinline__ void ph_hg2(const Ctx& X, const float* dS, const float* Dd, float* S0) {
    const bf16_t* dsb = (const bf16_t*)dS; bf16_t* s0b = (bf16_t*)S0;
    for (int idx = X.vcu * 512 + X.tid; idx < 32 * 4096; idx += X.G * 512) {
        const int bh = idx >> 12, e4 = (idx & 4095) * 4, k0 = e4 & 127;
        f32x4 s = (f32x4){0.f, 0.f, 0.f, 0.f};
#pragma unroll 8
        for (int sc = 0; sc < 31; ++sc) { const f32x4 d = *(const f32x4*)(Dd + (size_t)(bh * 32 + sc) * 128 + k0); const u32x2 w = *(const u32x2*)(dsb + (size_t)(bh * 32 + sc) * 16384 + e4);
            s = s * d + (f32x4){bflo(w.x), bfhi(w.x), bflo(w.y), bfhi(w.y)};
            u32x2 o; o.x = pk2(s.x, s.y); o.y = pk2(s.z, s.w); *(u32x2*)(s0b + (size_t)(bh * 32 + sc + 1) * 16384 + e4) = o; }
    }
}

__device__ __forceinline__ void ph_router_tables(const Ctx& X, const float* g_ffn, const float* mod, const float* w_router, const float* b_router, bf16_t* BpT, float* cb) {
    for (int i = X.vcu * 512 + X.tid; i < 4 * 32 * 1024; i += X.G * 512) { const int b = i >> 15, e = (i >> 10) & 31, k = i & 1023;
        const float v = g_ffn[k] * (1.0f + mod[(size_t)b * NMOD + 4 * D + k]) * w_router[k * 32 + e];
        const unsigned hi = pk2(v, 0.f) & 0xffffu; const float r1 = v - __uint_as_float(hi << 16);
        const unsigned mi = pk2(r1, 0.f) & 0xffffu; const float r2 = r1 - __uint_as_float(mi << 16);
        const unsigned lo = pk2(r2, 0.f) & 0xffffu;
        unsigned short* d = (unsigned short*)BpT + ((size_t)(b * 3) * 32 + e) * 1024 + k;
        d[0] = (unsigned short)hi; d[32 * 1024] = (unsigned short)mi; d[2 * 32 * 1024] = (unsigned short)lo; }
    const int gw = X.vcu * 8 + X.wave;
    if (gw < 128) { const int b = gw >> 5, e = gw & 31; float a = 0.f;
        for (int k = X.lane; k < 1024; k += 64) a += mod[(size_t)b * NMOD + 3 * D + k] * w_router[k * 32 + e];
        a = wave_sum(a); if (X.lane == 0) cb[gw] = a + b_router[e]; }
}

__device__ __forceinline__ void ph_route(const Ctx& X, const bf16_t* x1, const float* g_ffn, const float* mod, const bf16_t* BpT, const float* cb,
                                         unsigned char* h2, int* top_e, float* top_w, int* rank, int* hist_g) {
    LAS int* hist = (LAS int*)(X.lds + LDSCTL_OFF + 64);
    LAS unsigned char* L = X.lds;
    constexpr int RS = 1040;
    const int tid = X.tid, lane = X.lane, c = lane & 15, q = lane >> 4;
    for (int tile = X.vcu; tile < RT_NT; tile += X.G) {
        if (tid < 32) hist[tid] = 0;
        const int tw = tile * RT_TILE + X.wave * 16, b = tw / SEQ;
        const bf16_t* xa = x1 + (size_t)(tw + c) * D + 8 * q;
        f32x4 acc0 = (f32x4){0.f, 0.f, 0.f, 0.f}, acc1 = acc0, accS = acc0;
#pragma unroll 1
        for (int half = 0; half < 2; ++half) {
            bf16x8 a[16];
#pragma unroll
            for (int ks = 0; ks < 16; ++ks) a[ks] = *(const bf16x8*)(xa + 512 * half + 32 * ks);
            __syncthreads();
#pragma unroll
            for (int i = 0; i < 12; ++i) { const int id = tid + 512 * i, row = id >> 6, c16 = id & 63;
                const u32x4 v = *(const u32x4*)(BpT + ((size_t)(b * 96) + row) * 1024 + 512 * half + 8 * c16);
                *(LAS u32x4*)(L + row * RS + 16 * c16) = v; }
            __syncthreads();
#pragma unroll
            for (int ks = 0; ks < 16; ++ks) {
                bf16x8 bb[6];
#pragma unroll
                for (int j = 0; j < 6; ++j) bb[j] = *(const LAS bf16x8*)(L + (16 * j + c) * RS + 64 * ks + 16 * q);
                accS = __builtin_amdgcn_mfma_f32_16x16x32_bf16(a[ks], a[ks], accS, 0, 0, 0);
#pragma unroll
                for (int s_ = 2; s_ >= 0; --s_) { acc0 = __builtin_amdgcn_mfma_f32_16x16x32_bf16(a[ks], bb[2 * s_], acc0, 0, 0, 0); acc1 = __builtin_amdgcn_mfma_f32_16x16x32_bf16(a[ks], bb[2 * s_ + 1], acc1, 0, 0, 0); }
            }
        }
        const float dg = (c & 2) ? ((c & 1) ? accS[3] : accS[2]) : ((c & 1) ? accS[1] : accS[0]);
        const float ss = __shfl(dg, c + 16 * (c >> 2));
        const float rs = rsqrtf(ss * (1.0f / D) + EPS);
        const float cb0 = cb[b * 32 + c], cb1 = cb[b * 32 + 16 + c];
#pragma unroll
        for (int reg = 0; reg < 4; ++reg) {
            const float rt = __shfl(rs, 4 * q + reg);
            float v0 = acc0[reg] * rt + cb0, v1 = acc1[reg] * rt + cb1;
            float sv[4]; int si[4];
#pragma unroll
            for (int rnd = 0; rnd < 4; ++rnd) {
                float bvv = v0; int bi = c; if (v1 > bvv) { bvv = v1; bi = 16 + c; }
#pragma unroll
                for (int o = 1; o < 16; o <<= 1) { const float ov = __shfl_xor(bvv, o); const int oi = __shfl_xor(bi, o); if (ov > bvv || (ov == bvv && oi < bi)) { bvv = ov; bi = oi; } }
                sv[rnd] = bvv; si[rnd] = bi; if (bi == c) v0 = -INFINITY; if (bi == 16 + c) v1 = -INFINITY;
            }
            const float e1 = __expf(sv[1] - sv[0]), e2 = __expf(sv[2] - sv[0]), e3 = __expf(sv[3] - sv[0]);
            const float inv = 1.0f / (1.0f + e1 + e2 + e3);
            if (c == 0) { const int t = tw + 4 * q + reg;
                const float ww[4] = {inv, e1 * inv, e2 * inv, e3 * inv};
#pragma unroll
                for (int rnd = 0; rnd < 4; ++rnd) { top_e[t * 4 + rnd] = si[rnd]; top_w[t * 4 + rnd] = ww[rnd]; rank[t * 4 + rnd] = atomicAdd((int*)&hist[si[rnd]], 1); }
            }
        }
        const float* sh = mod + (size_t)b * NMOD + 3 * D; const float* sc = mod + (size_t)b * NMOD + 4 * D;
#pragma unroll 4
        for (int i = 0; i < 16; ++i) {
            const float r = __shfl(rs, i);
            const u32x2* xr = (const u32x2*)(x1 + (size_t)(tw + i) * D) + lane;
#pragma unroll
            for (int j = 0; j < 4; ++j) {
                const int col = 4 * (lane + 64 * j);
                const f32x4 gg = *(const f32x4*)(g_ffn + col), s1 = *(const f32x4*)(sc + col), s0 = *(const f32x4*)(sh + col);
                const u32x2 xw = xr[64 * j]; const f32x4 xv = (f32x4){bflo(xw.x), bfhi(xw.x), bflo(xw.y), bfhi(xw.y)};
                const f32x4 y = (xv * r * gg * (s1 + 1.0f) + s0) * 16.0f;
                *(unsigned*)(h2 + (size_t)(tw + i) * D + col) = cvt4_fp8(y.x, y.y, y.z, y.w);
            }
        }
        __syncthreads();
        if (tid < 32) hist_g[tile * 32 + tid] = hist[tid];
        __syncthreads();
    }
}

__device__ __forceinline__ void ph_sort(const Ctx& X, const int* hist_g, const int* top_e, const float* top_w, const int* rank, int* row_tok, float* row_w, int* pair_row, int* blk_e) {
    LAS int* s_hist = (LAS int*)X.lds;
    LAS int* s_tot = s_hist + RT_NT * 32; LAS int* s_pre = s_tot + 32; LAS int* s_base = s_pre + 32; LAS int* s_pstart = s_base + 32; LAS int* s_pend = s_pstart + 32;
    LAS int* s_ptot = s_pend + 32; LAS int* s_ppre = s_ptot + 16 * 32;
    const int tid = X.tid;
    for (int i = tid; i < RT_NT * 8; i += 512) ((LAS u32x4*)s_hist)[i] = ((const u32x4*)hist_g)[i];
    __syncthreads();
    for (int tile = X.vcu; tile < RT_NT; tile += X.G) {
        { const int e = tid & 31, part = tid >> 5; int tot = 0, pre = 0;
#pragma unroll 4
          for (int i = part * (RT_NT / 16); i < (part + 1) * (RT_NT / 16); ++i) { const int c = s_hist[i * 32 + e]; tot += c; pre += (i < tile) ? c : 0; }
          s_ptot[part * 32 + e] = tot; s_ppre[part * 32 + e] = pre; }
        __syncthreads();
        if (tid < 32) { int tot = 0, pre = 0;
#pragma unroll
            for (int k = 0; k < 16; ++k) { tot += s_ptot[k * 32 + tid]; pre += s_ppre[k * 32 + tid]; }
            const int padded = (tot + 255) / 256 * 256; int inc = padded;
#pragma unroll
            for (int o = 1; o < 32; o <<= 1) { const int v = __shfl_up(inc, o); if (tid >= o) inc += v; }
            s_tot[tid] = tot; s_pstart[tid] = inc - padded; s_base[tid] = inc - padded + pre; s_pend[tid] = inc; }
        __syncthreads();
        { const int i = tid; const int idx = tile * RT_TILE * 4 + i; const int e = top_e[idx]; const int row = s_base[e] + rank[idx];
          row_tok[row] = idx >> 2; row_w[row] = top_w[idx]; pair_row[idx] = row; }
        if (tile < 32) { const int e = tile; for (int r = s_pstart[e] + s_tot[e] + tid; r < s_pend[e]; r += 512) { row_tok[r] = 0; row_w[r] = 0.f; } }
        if (tile == 32) { for (int blk = tid; blk < NBLK_MAX; blk += 512) { int e = -1; const int r = blk * 256; for (int q = 0; q < 32; ++q) if (r >= s_pstart[q] && r < s_pend[q]) e = q; blk_e[blk] = e; }
                          if (tid == 0) blk_e[NBLK_MAX] = s_pend[31] / 256; }
        __syncthreads();
    }
}

__device__ __forceinline__ void ph_final(const Ctx& X, const bf16_t* x1, const unsigned char* y, const int* pair_row, const float* mod, const float* g_final, float* out, const float oscale) {
    const int lane = X.lane;
    for (int t = X.vcu * 8 + X.wave; t < T; t += X.G * 8) {
        const int b = t / SEQ;
        const u32x2* xr = (const u32x2*)(x1 + (size_t)t * D) + lane;
        const float* ga = mod + (size_t)b * NMOD + 5 * D;
        int rows[4];
#pragma unroll
        for (int k = 0; k < 4; ++k) rows[k] = pair_row[t * 4 + k];
        f32x4 v[4]; float ss = 0.f;
#pragma unroll
        for (int j = 0; j < 4; ++j) {
            const int col = 4 * (lane + 64 * j);
            f32x4 m = (f32x4){0.f, 0.f, 0.f, 0.f};
#pragma unroll
            for (int k = 0; k < 4; ++k) { const int w = *(const int*)(y + (size_t)rows[k] * D + col); const f32x2 lo = __builtin_amdgcn_cvt_pk_f32_fp8(w, false), hi = __builtin_amdgcn_cvt_pk_f32_fp8(w, true); m.x += lo.x; m.y += lo.y; m.z += hi.x; m.w += hi.y; }
            const u32x2 xw = xr[64 * j];
            v[j] = (f32x4){bflo(xw.x), bfhi(xw.x), bflo(xw.y), bfhi(xw.y)} + *(const f32x4*)(ga + col) * (m * (1.0f / 32.0f));
            ss += (v[j].x * v[j].x + v[j].y * v[j].y) + (v[j].z * v[j].z + v[j].w * v[j].w);
        }
        const float r = rsqrtf(wave_sum(ss) * (1.0f / D) + EPS);
#pragma unroll
        for (int j = 0; j < 4; ++j) { const int col = 4 * (lane + 64 * j); *(f32x4*)(out + (size_t)t * D + col) = v[j] * (r * oscale) * *(const f32x4*)(g_final + col); }
    }
}

constexpr int N_PHASES = 13;
struct Args { const float* in[23]; float* out; unsigned char* ws; int ph_lo, ph_hi; };
__global__ void __launch_bounds__(512, 2) fwd(Args a) {
    extern __shared__ __attribute__((aligned(16))) unsigned char lds_raw[];
    Ctx X; X.lds = (LAS unsigned char*)lds_raw; X.tid = threadIdx.x; X.lane = X.tid & 63; X.wave = __builtin_amdgcn_readfirstlane(X.tid >> 6);
    X.G = gridDim.x; { const int bx = blockIdx.x; X.vcu = (X.G % 8 == 0) ? (bx % 8) * (X.G / 8) + bx / 8 : bx; }
    unsigned char* ws = a.ws;
    for (int u = X.tid; u < (LDS_BYTES - LDSCTL_OFF) / 4; u += 512) ((LAS unsigned*)(X.lds + LDSCTL_OFF))[u] = 0u;
    __syncthreads();
    XcdBarrier bar = xcd_barrier_post((unsigned*)(ws + WS_CTL) + CW_BAR, (volatile LAS unsigned*)(X.lds + LDSCTL_OFF), X.tid == 0);
    const int lo = a.ph_lo, hi = a.ph_hi; float probe_scale = 1.0f;
#define IN(k) (lo <= (k) && (k) < hi)
#define SEAM(k) do { if (IN(k) && IN((k) + 1)) xcd_barrier(bar, X.wave == 0 && (int)__builtin_amdgcn_mbcnt_hi(~0u, __builtin_amdgcn_mbcnt_lo(~0u, 0u)) == 0); } while (0)
#ifdef PROBE_PH
    unsigned long long* stamps = (unsigned long long*)(ws + WS_CTL + 32768);
    if (blockIdx.x == 0 && X.tid == 0) stamps[0] = __builtin_amdgcn_s_memrealtime();
#undef SEAM
#define SEAM(k) do { if (IN(k) && IN((k) + 1)) { xcd_barrier(bar, X.wave == 0 && (int)__builtin_amdgcn_mbcnt_hi(~0u, __builtin_amdgcn_mbcnt_lo(~0u, 0u)) == 0); \
        if (blockIdx.x == 0 && X.wave == 0 && (int)__builtin_amdgcn_mbcnt_hi(~0u, __builtin_amdgcn_mbcnt_lo(~0u, 0u)) == 0) stamps[(k) + 1] = __builtin_amdgcn_s_memrealtime(); } } while (0)
#endif
    const float* x = a.in[0]; const float* c = a.in[1]; const float* w_ada = a.in[2]; const float* b_ada = a.in[3];
    const float* g_mix = a.in[4]; const float* w_in = a.in[5]; const float* conv_dw = a.in[6]; const float* conv_dwb = a.in[7];
    const float* conv_ln_g = a.in[8]; const float* conv_ln_b = a.in[9]; const float* w_conv_out = a.in[10]; const float* lb_param = a.in[11];
    const float* hgrn_norm_g = a.in[12]; const float* w_hgrn_out = a.in[13]; const float* w_out = a.in[14]; const float* g_ffn = a.in[15];
    const float* w_router = a.in[16]; const float* b_router = a.in[17]; const float* w1 = a.in[18]; const float* b1 = a.in[19];
    const float* w2 = a.in[20]; const float* b2 = a.in[21]; const float* g_final = a.in[22];
    float* mod = (float*)(ws + WS_MOD); bf16_t* rt_bp = (bf16_t*)(ws + WS_WH);     float* rt_cb = (float*)(ws + WS_CB);
    int* hist_g = (int*)(ws + WS_HIST); int* blk_e = (int*)(ws + WS_BLKE); int* top_e = (int*)(ws + WS_TOPE); float* top_w = (float*)(ws + WS_TOPW);
    int* rank = (int*)(ws + WS_RANK); int* pair_row = (int*)(ws + WS_PROW); int* row_tok = (int*)(ws + WS_RTOK); float* row_w = (float*)(ws + WS_RW);
    bf16_t* p = (bf16_t*)(ws + WS_P);
    bf16_t* h = (bf16_t*)(ws + WS_E); unsigned char* h8 = ws + WS_E + 64 * MiB; float* tmp = (float*)(ws + WS_E);
    float* hg_dS = (float*)(ws + WS_E); float* hg_S0 = (float*)(ws + WS_E + 64 * MiB); float* hg_D = (float*)(ws + WS_HGD);
    bf16_t* uc = (bf16_t*)(ws + WS_D); bf16_t* og = MIX_FP8 ? (bf16_t*)((unsigned char*)uc + D) : uc + D;   bf16_t* x1 = (bf16_t*)(ws + WS_D);
    bf16_t* merged = p;
    unsigned char* h2 = (unsigned char*)p;
    unsigned char* act = (unsigned char*)(p + PG);
    unsigned char* y = (unsigned char*)(p + PG) + (size_t)R_PAD * D;
    PG8_LAS unsigned char* ring = (PG8_LAS unsigned char*)lds_raw;

#ifndef REPMASK
#define REPMASK 0
#endif
#ifndef REPN
#define REPN 1
#endif
#define PH(k, ...) do { if (IN(k)) { _Pragma("unroll 1") for (int rep_ = 0; rep_ < ((((REPMASK) >> (k)) & 1) ? 1 + REPN : 1); ++rep_) { if (rep_) __syncthreads(); { int ln_ = (int)__builtin_amdgcn_mbcnt_hi(~0u, __builtin_amdgcn_mbcnt_lo(~0u, 0u)); asm volatile("" : "+v"(ln_)); X.lane = ln_; X.tid = X.wave * 64 + ln_; } __VA_ARGS__ } } SEAM(k); } while (0)
    PH(0, ph_prologue<0>(X, c, w_ada, b_ada, mod, w_in, w_conv_out, w_hgrn_out, w_out, w1, w2, ws); if (P_INT8) ph_win_i8(X, w_in, ws););
    PH(1, ph_norm_mod(X, x, g_mix, mod, 0, D, h, h8, (float*)(ws + WS_HSC)); ph_router_tables(X, g_ffn, mod, w_router, b_router, rt_bp, rt_cb););
#ifndef STAGGER_TICKS
#define STAGGER_TICKS 0
#endif
    PH(2, { if (STAGGER_TICKS) { const unsigned long long t0_ = __builtin_amdgcn_s_memrealtime(), wait_ = (unsigned long long)(X.vcu & 3) * STAGGER_TICKS;
                while (__builtin_amdgcn_s_memrealtime() - t0_ < wait_) __builtin_amdgcn_s_sleep(8); }
        if (P_INT8) { pg8::Gemm g{(const bf16_t*)h8, (const bf16_t*)(ws + WS_WIN8), T, 8 * D, D / 2}; pg8::StaticOrder S; S.init(T, 8 * D, X.G, (int)blockIdx.x);
            pg8::EpiSplitBf16<true> E{p, PG, 0x3cu, SEQ, 1.0f, (const float*)(ws + WS_HSC), (const float*)(ws + WS_WSC)}; pg8::gemm_phase<pg8::EpiSplitBf16<true>, pg8::StaticOrder, true, true, false, 2>(ring, g, S, E, X.wave); }
        else {
        constexpr unsigned m8 = P_FP8_MASK; constexpr int n8 = __builtin_popcount(m8);
        if (n8 > 0) { pg8::Gemm g{(const bf16_t*)h8, (const bf16_t*)(ws + WS_WIN8), T, 8 * D, D / 2}; pg8::MaskOrder S; S.base.init(T, n8 * 256, X.G, (int)blockIdx.x); S.mask = m8;
            pg8::EpiSplitBf16<false> E{p, PG, 0x3cu, SEQ, 1.0f / 4096.0f, nullptr, nullptr}; pg8::gemm_phase<pg8::EpiSplitBf16<false>, pg8::MaskOrder, true, true, false, 1>(ring, g, S, E, X.wave); }
        if (n8 < 32) { pg8::Gemm g{h, (const bf16_t*)(ws + WS_WIN), T, 8 * D, D}; pg8::MaskOrder S; S.base.init(T, (32 - n8) * 256, X.G, (int)blockIdx.x); S.mask = ~m8;
            pg8::EpiSplitBf16<false> E{p, PG, 0x3cu, SEQ, 1.0f, nullptr, nullptr}; pg8::gemm_phase<pg8::EpiSplitBf16<false>, pg8::MaskOrder, true, true>(ring, g, S, E, X.wave); } } });
    PH(3, ph_conv(X, p + 0 * PG, conv_dw, conv_dwb, conv_ln_g, conv_ln_b, uc);
          if ((REPMASK >> 14) & 1) { __syncthreads(); ph_conv(X, p + 0 * PG, conv_dw, conv_dwb, conv_ln_g, conv_ln_b, uc); }
          ph_hgrn<false>(X, 31 * 32, p + 2 * PG, p + 3 * PG, p + 4 * PG, p + 5 * PG, lb_param, nullptr, nullptr, hg_dS, hg_D, nullptr);
          if ((REPMASK >> 15) & 1) { __syncthreads(); ph_hgrn<false>(X, 31 * 32, p + 2 * PG, p + 3 * PG, p + 4 * PG, p + 5 * PG, lb_param, nullptr, nullptr, hg_dS, hg_D, nullptr); });
    PH(4, ph_hg2(X, hg_dS, hg_D, hg_S0););
    PH(5, if ((X.vcu & 1) == 0) ph_prologue<1>(X, c, w_ada, b_ada, mod, w_in, w_conv_out, w_hgrn_out, w_out, w1, w2, ws);
          ph_hgrn<true>(X, 32 * 32, p + 2 * PG, p + 3 * PG, p + 4 * PG, p + 5 * PG, lb_param, hgrn_norm_g, hg_S0, nullptr, nullptr, og);
          if ((X.vcu & 1) != 0) ph_prologue<1>(X, c, w_ada, b_ada, mod, w_in, w_conv_out, w_hgrn_out, w_out, w1, w2, ws););
    PH(6, { if (MIX_FP8) { pg8::Gemm g{uc, (const bf16_t*)(ws + WS_WC), T, D, D}; pg8::StaticOrder S; S.init(T, D, X.G, (int)blockIdx.x);
              pg8::EpiGateFused<RES_FP8 != 0> E{p + 6 * PG, p + 7 * PG, merged, 1.0f / 4096.0f}; pg8::gemm_phase<pg8::EpiGateFused<RES_FP8 != 0>, pg8::StaticOrder, true, true, false, 1>(ring, g, S, E, X.wave); }
            else { pg8::Gemm g{uc, (const bf16_t*)(ws + WS_WC), T, D, 2 * D}; pg8::StaticOrder S; S.init(T, D, X.G, (int)blockIdx.x);
              pg8::EpiGateFused<RES_FP8 != 0> E{p + 6 * PG, p + 7 * PG, merged, 1.0f}; pg8::gemm_phase<pg8::EpiGateFused<RES_FP8 != 0>, pg8::StaticOrder, true, true>(ring, g, S, E, X.wave); } });
    PH(7, { if (RES_FP8) { pg8::Gemm g{merged, (const bf16_t*)(ws + WS_WO), T, D, D / 2}; pg8::StaticOrder S; S.init(T, D, X.G, (int)blockIdx.x);
              pg8::EpiRes E{x, mod + 2 * D, x1, NMOD, SEQ, 1.0f / 8192.0f}; pg8::gemm_phase<pg8::EpiRes, pg8::StaticOrder, true, true, false, 1>(ring, g, S, E, X.wave); }
            else { pg8::Gemm g{merged, (const bf16_t*)(ws + WS_WO), T, D, D}; pg8::StaticOrder S; S.init(T, D, X.G, (int)blockIdx.x);
              pg8::EpiRes E{x, mod + 2 * D, x1, NMOD, SEQ, 1.0f}; pg8::gemm_phase<pg8::EpiRes, pg8::StaticOrder, true, true>(ring, g, S, E, X.wave); } });
    PH(8, ph_route(X, x1, g_ffn, mod, rt_bp, rt_cb, h2, top_e, top_w, rank, hist_g););
    PH(9, ph_sort(X, hist_g, top_e, top_w, rank, row_tok, row_w, pair_row, blk_e););
    PH(10, { const int nblk = blk_e[NBLK_MAX]; pg8::Gemm g{(const bf16_t*)h2, (const bf16_t*)(ws + WS_W1), T, 32 * 2048, D / 2}; pg8::MoeOrder S{blk_e, nblk, X.G, (int)blockIdx.x, 3};
        LAS unsigned short* gt = (LAS unsigned short*)(X.lds + LDSCTL_OFF + 256);
        _Pragma("unroll 1") for (int i = 0; i < 23; ++i) { pg8::Unit u; if (!S.next(i, u)) break; if (X.tid < 256) gt[256 * i + X.tid] = (unsigned short)row_tok[u.pm * 256 + X.tid]; }
        __syncthreads();
        pg8::EpiSwiglu8 E{b1, act, 1.0f / 4096.0f}; pg8::gemm_phase<pg8::EpiSwiglu8, pg8::MoeOrder, true, true, true, true>(ring, g, S, E, X.wave, (const PG8_LAS unsigned short*)gt); });
    PH(11, { const int nblk = blk_e[NBLK_MAX]; pg8::Gemm g{(const bf16_t*)act, (const bf16_t*)(ws + WS_W2), R_PAD, 32 * 1024, DFF / 2}; pg8::MoeOrder S{blk_e, nblk, X.G, (int)blockIdx.x, 2};
        pg8::EpiY8 E{b2, row_w, y, 1.0f / 1024.0f}; pg8::gemm_phase<pg8::EpiY8, pg8::MoeOrder, true, true, false, true>(ring, g, S, E, X.wave); });
#ifdef PROBE_PH
    { const unsigned long long* st_ = (const unsigned long long*)(ws + WS_CTL + 32768); const float dt_ = (float)(long long)(st_[PROBE_PH + 1] - st_[PROBE_PH]);
      probe_scale = 1.0f + dt_ * (1.0f / 200000.0f); }
#endif
    PH(12, ph_final(X, x1, y, pair_row, mod, g_final, a.out, probe_scale););
#undef PH
#undef IN
#undef SEAM
}

#ifndef MK_N_LAUNCHES
#define MK_N_LAUNCHES 1
#endif
extern "C" void kernel_launch(void* const* d_in, const int* in_sizes, int n_in, void* d_out, int out_size, void* d_ws, size_t ws_size, hipStream_t stream) {
    static int grid = 0;
    if (grid == 0) {
        if (n_in != 23 || out_size != T * D || ws_size < WS_END) { fprintf(stderr, "kernel_launch: unexpected n_in %d / out_size %d / ws_size %zu (< %zu); nothing launched\n", n_in, out_size, ws_size, (size_t)WS_END); grid = -1; return; }
        int dev = 0, cus = 0, per_cu = 0;
        if (hipGetDevice(&dev) != hipSuccess || hipDeviceGetAttribute(&cus, hipDeviceAttributeMultiprocessorCount, dev) != hipSuccess) { grid = -1; return; }
        if (hipFuncSetAttribute((const void*)fwd, hipFuncAttributeMaxDynamicSharedMemorySize, LDS_BYTES) != hipSuccess) { fprintf(stderr, "kernel_launch: hipFuncSetAttribute failed\n"); grid = -1; return; }
        if (hipOccupancyMaxActiveBlocksPerMultiprocessor(&per_cu, (const void*)fwd, 512, LDS_BYTES) != hipSuccess || per_cu < 1) { fprintf(stderr, "kernel_launch: occupancy query says %d blocks per CU\n", per_cu); }
        (void)hipGetLastError();
        grid = cus;
    }
    if (grid < 0) return;
    if (hipMemsetAsync((char*)d_ws + WS_CTL, 0, CTL_ZERO_BYTES, stream) != hipSuccess) return;
    Args a{};
    for (int i = 0; i < 23; ++i) a.in[i] = (const float*)d_in[i];
    a.out = (float*)d_out; a.ws = (unsigned char*)d_ws;
    if (MK_N_LAUNCHES == 1) { a.ph_lo = 0; a.ph_hi = N_PHASES; hipLaunchKernelGGL(fwd, dim3(grid), dim3(512), LDS_BYTES, stream, a); }
    else for (int ph = 0; ph < N_PHASES; ++ph) { a.ph_lo = ph; a.ph_hi = ph + 1; hipLaunchKernelGGL(fwd, dim3(grid), dim3(512), LDS_BYTES, stream, a); }
}
```

```cpp
#include <hip/hip_runtime.h>
#include <stdint.h>
#include <stdio.h>

#define GAS __attribute__((address_space(1)))
#define LAS __attribute__((address_space(3)))
typedef unsigned short bf16_t;
typedef unsigned u32x4 __attribute__((ext_vector_type(4)));
typedef unsigned u32x2 __attribute__((ext_vector_type(2)));
typedef float f32x4 __attribute__((ext_vector_type(4)));

constexpr int D = 1024, NBATCH = 4, SEQ = 8192, T = NBATCH * SEQ;
constexpr int NE = 32, DFF = 1024;
constexpr int NMOD = 6 * D;
constexpr int NBLK_MAX = 544, R_PAD = NBLK_MAX * 256;
constexpr int RT_TILE = 128, RT_NT = T / RT_TILE;
constexpr float EPS = 1e-6f;

constexpr size_t MiB = 1u << 20;
constexpr size_t WS_CTL = 0, CTL_ZERO_BYTES = 64 * 1024;
constexpr size_t WS_MOD = 1 * MiB;
constexpr size_t WS_CB = WS_MOD + 112 * 1024, WS_BP = WS_MOD + 128 * 1024;
constexpr size_t WS_HSC = WS_MOD + 704 * 1024, WS_WSC = WS_MOD + 840 * 1024;
constexpr size_t WS_HIST = 2 * MiB;
constexpr size_t WS_BLKE = WS_HIST + 64 * 1024;
constexpr size_t WS_TOPE = 3 * MiB;
constexpr size_t WS_TOPW = WS_TOPE + 512 * 1024;
constexpr size_t WS_RANK = WS_TOPW + 512 * 1024;
constexpr size_t WS_PROW = WS_RANK + 512 * 1024;
constexpr size_t WS_RTOK = 5 * MiB;
constexpr size_t WS_RW = 6 * MiB;
constexpr size_t WS_HGD = 7 * MiB;
constexpr size_t WS_WT = 8 * MiB;
constexpr size_t WS_WIN = WS_WT, WS_WC = WS_WT + 16 * MiB, WS_WH = WS_WT + 18 * MiB, WS_WO = WS_WT + 20 * MiB, WS_W1 = WS_WT + 22 * MiB, WS_WIN8 = WS_WT + 96 * MiB  , WS_W2 = WS_WT + 150 * MiB;
constexpr size_t WS_P = 224 * MiB;
constexpr size_t WS_E = WS_P + 512 * MiB;
constexpr size_t WS_D = WS_E + 128 * MiB;
constexpr size_t WS_END = WS_D + 128 * MiB;
constexpr size_t PG = (size_t)T * D;
constexpr int CW_BAR = 0;

constexpr int RING_BYTES = 135168, LDSCTL_OFF = RING_BYTES, LDS_BYTES = 147456;

__device__ __forceinline__ unsigned f2bf(float f) { unsigned u = __builtin_bit_cast(unsigned, f); return (u + 0x7fffu + ((u >> 16) & 1u)) >> 16; }
typedef __bf16 bf16x2_hw __attribute__((ext_vector_type(2)));
__device__ __forceinline__ unsigned pk2(float lo, float hi) { const bf16x2_hw v = {(__bf16)lo, (__bf16)hi}; return __builtin_bit_cast(unsigned, v); }
__device__ __forceinline__ float bf2f(unsigned b) { return __builtin_bit_cast(float, b << 16); }
__device__ __forceinline__ float bflo(unsigned w) { return __builtin_bit_cast(float, w << 16); }
__device__ __forceinline__ float bfhi(unsigned w) { return __builtin_bit_cast(float, w & 0xffff0000u); }
__device__ __forceinline__ float sigmoidf_(float x) { return __builtin_amdgcn_rcpf(1.0f + __expf(-x)); }
__device__ __forceinline__ float wave_sum(float v) {
#pragma unroll
    for (int o = 1; o < 64; o <<= 1) v += __shfl_xor(v, o);
    return v;
}
__device__ __forceinline__ unsigned cvt4_fp8(float a, float b, float c, float d) {
    a = fminf(fmaxf(a, -448.f), 448.f); b = fminf(fmaxf(b, -448.f), 448.f); c = fminf(fmaxf(c, -448.f), 448.f); d = fminf(fmaxf(d, -448.f), 448.f);
    int w = 0; w = __builtin_amdgcn_cvt_pk_fp8_f32(a, b, w, false); w = __builtin_amdgcn_cvt_pk_fp8_f32(c, d, w, true); return (unsigned)w; }
__device__ __forceinline__ unsigned q4_i8(float a, float b, float c, float d) {
    const int ia = (int)__builtin_rintf(a), ib = (int)__builtin_rintf(b), ic = (int)__builtin_rintf(c), id = (int)__builtin_rintf(d);
    return (unsigned)(ia & 255) | ((unsigned)(ib & 255) << 8) | ((unsigned)(ic & 255) << 16) | ((unsigned)id << 24); }
#define LDS_WAIT() asm volatile("s_waitcnt lgkmcnt(0)" ::: "memory")
#define VM_WAIT() asm volatile("s_waitcnt vmcnt(0)" ::: "memory")

namespace pg8 {
#define PG8_LAS __attribute__((address_space(3)))
typedef unsigned short bf16_t;
typedef short bf16x8 __attribute__((ext_vector_type(8)));
typedef float f32x4 __attribute__((ext_vector_type(4)));
typedef unsigned u32x4 __attribute__((ext_vector_type(4)));
constexpr int BM = 256, BK = 64, HALF = 128, HTB = HALF * BK * 2  , STAGE_BYTES = 8 * HTB, NXCD = 8, WGM = 8;

__host__ __device__ __forceinline__ int lds_byte(int r, int c) { const int st = (r >> 4) * 2 + (c >> 5), rr = r & 15, cc = c & 31, ob = rr * 64 + cc * 2; return st * 1024 + (ob ^ (((ob >> 9) & 1) << 5)); }
__host__ __device__ __forceinline__ void stage_rc(int b, int& R, int& C) { const int st = b / 1024, sb = b % 1024, swz = sb ^ (((sb >> 9) & 1) << 5); R = (st >> 1) * 16 + swz / 64; C = (st & 1) * 32 + (swz % 64) / 2; }
__host__ __device__ __forceinline__ int perm32(int rho) { const int n = rho >> 4, i = rho & 15; return 8 * (i >> 2) + 4 * n + (i & 3); }

struct Unit { int pm, pn; };
struct Gemm { const bf16_t* A; const bf16_t* Bt; int M, N, K; };

struct StaticOrder {
    int nM, nN, nwg, G, c;
    __host__ __device__ void init(int M, int N, int G_, int c_) { nM = M / BM; nN = N / BM; nwg = nM * nN; G = G_; c = c_; }
    __host__ __device__ bool next(int i, Unit& u) const {
        const long L = (long)i * G + c; if (L >= nwg) return false;
        int wgid = (int)L; { const int q = nwg / NXCD, r = nwg % NXCD, xcd = wgid % NXCD, off = wgid / NXCD; wgid = (xcd < r ? xcd * (q + 1) : r * (q + 1) + (xcd - r) * q) + off; }
        const int nig = WGM * nN, gid = wgid / nig, fm = gid * WGM, gsz = (nM - fm) < WGM ? (nM - fm) : WGM;
        u.pm = fm + ((wgid % nig) % gsz); u.pn = (wgid % nig) / gsz; return true;
    }
    __device__ __forceinline__ void a_ready(const Unit&) const {}
    __device__ __forceinline__ void done(const Unit&) const {}
};


struct MaskOrder {
    StaticOrder base; unsigned mask;
    __device__ __forceinline__ bool next(int i, Unit& u) const {
        if (!base.next(i, u)) return false;
        unsigned m = mask; for (int k = 0; k < u.pn; ++k) m &= m - 1;
        u.pn = __builtin_ctz(m); return true;
    }
    __device__ __forceinline__ void a_ready(const Unit&) const {}
    __device__ __forceinline__ void done(const Unit&) const {}
};
struct MoeOrder {
    const int* blk_e; int nblk, G, c, lg;
    __device__ __forceinline__ bool next(int i, Unit& u) const {
        int blk, j;
        if (G == 256) { const int xcd = c & 7, idx = c >> 3, prb = 256 >> lg; blk = i * prb + xcd * (prb >> 3) + (idx >> lg); j = idx & ((1 << lg) - 1); }
        else { const long L = (long)i * G + c; blk = (int)(L >> lg); j = (int)(L & ((1 << lg) - 1)); }
        if (blk >= nblk) return false;
        const int e = blk_e[blk]; u.pm = blk; u.pn = (e << lg) + j; return true;
    }
    __device__ __forceinline__ void a_ready(const Unit&) const {}
    __device__ __forceinline__ void done(const Unit&) const {}
};

__device__ __forceinline__ unsigned cvt_pk_bf16(float lo, float hi) { unsigned r; asm volatile("v_cvt_pk_bf16_f32 %0, %1, %2" : "=v"(r) : "v"(lo), "v"(hi)); return r; }
__device__ __forceinline__ float sigm(float x) { return __builtin_amdgcn_rcpf(1.0f + __expf(-x)); }
__device__ __forceinline__ float blo(unsigned w) { return __builtin_bit_cast(float, w << 16); }
__device__ __forceinline__ float bhi(unsigned w) { return __builtin_bit_cast(float, w & 0xffff0000u); }

template <bool I8> struct EpiSplitBf16 {
    static constexpr bool PERM = true, AFTER_DRAIN = false;
    bf16_t* O; size_t split_stride; unsigned hm_mask; int seq; float dq;
    const float* rs; const float* cs;
    __device__ __forceinline__ void operator()(const f32x4 (&acc)[2][2][4][2], const Unit& u, int wr, int wc, int fr, int fq) const {
        const int row0 = u.pm * BM + wr * 64 + fr; const int colt = u.pn * BM; const int t = colt >> 10;
        f32x4 cv[2][2]; float rv[2][4];
#pragma unroll
        for (int bj = 0; bj < 2; ++bj)
#pragma unroll
            for (int n = 0; n < 2; ++n) cv[bj][n] = I8 ? *(const f32x4*)(cs + colt + bj * HALF + wc * 32 + 8 * fq + 4 * n) : (f32x4){dq, dq, dq, dq};
#pragma unroll
        for (int ai = 0; ai < 2; ++ai)
#pragma unroll
            for (int m = 0; m < 4; ++m) rv[ai][m] = I8 ? rs[row0 + ai * HALF + m * 16] : 1.0f;
#define PG8_DEQ(ai, bj, m, n) (acc[ai][bj][m][n] * cv[bj][n] * rv[ai][m])
        if (u.pn < 8) {
#pragma unroll
            for (int ai = 0; ai < 2; ++ai)
#pragma unroll
                for (int m = 0; m < 4; ++m) { const int row = row0 + ai * HALF + m * 16; float r[8];
                    const f32x4 a0 = PG8_DEQ(ai, 0, m, 0), a1 = PG8_DEQ(ai, 0, m, 1), b0 = PG8_DEQ(ai, 1, m, 0), b1 = PG8_DEQ(ai, 1, m, 1);
#pragma unroll
                    for (int q = 0; q < 4; ++q) { r[q] = a0[q] * sigm(b0[q]); r[4 + q] = a1[q] * sigm(b1[q]); }
                    u32x4 w; w.x = cvt_pk_bf16(r[0], r[1]); w.y = cvt_pk_bf16(r[2], r[3]); w.z = cvt_pk_bf16(r[4], r[5]); w.w = cvt_pk_bf16(r[6], r[7]);
                    __builtin_nontemporal_store(w, (u32x4*)(O + (size_t)row * 1024 + 128 * u.pn + wc * 32 + 8 * fq)); }
            return;
        }
        bf16_t* base = O + (size_t)t * split_stride; const int cg = colt & 1023;
        const bool hm = (hm_mask >> t) & 1u;
        const int bb = (u.pm * BM) / seq;
#pragma unroll
        for (int ai = 0; ai < 2; ++ai)
#pragma unroll
            for (int m = 0; m < 4; ++m) { const int row = row0 + ai * HALF + m * 16;
#pragma unroll
                for (int bj = 0; bj < 2; ++bj) { const f32x4 v0 = PG8_DEQ(ai, bj, m, 0), v1 = PG8_DEQ(ai, bj, m, 1);
                    u32x4 w; w.x = cvt_pk_bf16(v0[0], v0[1]); w.y = cvt_pk_bf16(v0[2], v0[3]); w.z = cvt_pk_bf16(v1[0], v1[1]); w.w = cvt_pk_bf16(v1[2], v1[3]);
                    const size_t o = hm ? ((size_t)(bb * 8 + (cg >> 7) + bj) * seq + (row - bb * seq)) * 128 + wc * 32 + 8 * fq
                                        : (size_t)row * 1024 + cg + bj * HALF + wc * 32 + 8 * fq;
                    __builtin_nontemporal_store(w, (u32x4*)(base + o)); } }
#undef PG8_DEQ
    }
};
struct EpiRes {
    static constexpr bool PERM = true, AFTER_DRAIN = false;
    const float* x; const float* ga; bf16_t* out; int mod_pitch, seq; float dq;
    __device__ __forceinline__ void operator()(const f32x4 (&acc)[2][2][4][2], const Unit& u, int wr, int wc, int fr, int fq) const {
        const int row0 = u.pm * BM + wr * 64 + fr, col0 = u.pn * BM + wc * 32 + 8 * fq;
        const float* gab = ga + (size_t)((u.pm * BM) / seq) * mod_pitch + col0;
        f32x4 gv[2][2];
#pragma unroll
        for (int bj = 0; bj < 2; ++bj)
#pragma unroll
            for (int n = 0; n < 2; ++n) gv[bj][n] = *(const f32x4*)(gab + bj * HALF + 4 * n) * dq;
#pragma unroll
        for (int ai = 0; ai < 2; ++ai) {
            f32x4 xv[4][2][2];
#pragma unroll
            for (int m = 0; m < 4; ++m)
#pragma unroll
                for (int bj = 0; bj < 2; ++bj) { const float* xp = x + (size_t)(row0 + ai * HALF + m * 16) * 1024 + col0 + bj * HALF; xv[m][bj][0] = *(const f32x4*)xp; xv[m][bj][1] = *(const f32x4*)(xp + 4); }
#pragma unroll
            for (int m = 0; m < 4; ++m) { const size_t o = (size_t)(row0 + ai * HALF + m * 16) * 1024 + col0;
#pragma unroll
                for (int bj = 0; bj < 2; ++bj) {
                    const f32x4 v0 = xv[m][bj][0] + gv[bj][0] * acc[ai][bj][m][0], v1 = xv[m][bj][1] + gv[bj][1] * acc[ai][bj][m][1];
                    u32x4 w; w.x = cvt_pk_bf16(v0[0], v0[1]); w.y = cvt_pk_bf16(v0[2], v0[3]); w.z = cvt_pk_bf16(v1[0], v1[1]); w.w = cvt_pk_bf16(v1[2], v1[3]);
                    *(u32x4*)(out + o + bj * HALF) = w; } }
        }
    }
};
struct EpiSwiglu8 {
    static constexpr bool PERM = true, AFTER_DRAIN = false;
    const float* b1; unsigned char* act; float dq;
    __device__ __forceinline__ void operator()(const f32x4 (&acc)[2][2][4][2], const Unit& u, int wr, int wc, int fr, int fq) const {
        const int e = u.pn >> 3, j = u.pn & 7; const int row0 = u.pm * BM + wr * 64 + fr, f0 = 128 * j + wc * 32 + 8 * fq;
        const float* be = b1 + (size_t)e * 2048 + f0;
        const f32x4 bg0 = *(const f32x4*)(be), bg1 = *(const f32x4*)(be + 4), bl0 = *(const f32x4*)(be + 1024), bl1 = *(const f32x4*)(be + 1028);
#pragma unroll
        for (int ai = 0; ai < 2; ++ai)
#pragma unroll
            for (int m = 0; m < 4; ++m) {
                f32x4 g0 = acc[ai][0][m][0] * dq + bg0, g1 = acc[ai][0][m][1] * dq + bg1, l0 = acc[ai][1][m][0] * dq + bl0, l1 = acc[ai][1][m][1] * dq + bl1;
                float r[8];
#pragma unroll
                for (int q = 0; q < 4; ++q) { float gl = fminf(g0[q], 7.0f), li = fminf(fmaxf(l0[q], -7.0f), 7.0f); r[q] = 4.0f * gl * sigm(1.702f * gl) * (li + 1.0f);
                                              gl = fminf(g1[q], 7.0f); li = fminf(fmaxf(l1[q], -7.0f), 7.0f); r[4 + q] = 4.0f * gl * sigm(1.702f * gl) * (li + 1.0f); }
                u32x2 w; w.x = cvt4_fp8(r[0], r[1], r[2], r[3]); w.y = cvt4_fp8(r[4], r[5], r[6], r[7]);
                *(u32x2*)(act + (size_t)(row0 + ai * HALF + m * 16) * 1024 + f0) = w; }
    }
};
struct EpiY8 {
    static constexpr bool PERM = true, AFTER_DRAIN = false;
    const float* b2; const float* rw; unsigned char* y; float dq;
    __device__ __forceinline__ void operator()(const f32x4 (&acc)[2][2][4][2], const Unit& u, int wr, int wc, int fr, int fq) const {
        const int e = u.pn >> 2, j = u.pn & 3; const int row0 = u.pm * BM + wr * 64 + fr, col0 = 256 * j + wc * 32 + 8 * fq;
        const float* be = b2 + (size_t)e * 1024 + col0;
        f32x4 bv[2][2];
#pragma unroll
        for (int bj = 0; bj < 2; ++bj)
#pragma unroll
            for (int n = 0; n < 2; ++n) bv[bj][n] = *(const f32x4*)(be + bj * HALF + 4 * n);
        float rwv[2][4];
#pragma unroll
        for (int ai = 0; ai < 2; ++ai)
#pragma unroll
            for (int m = 0; m < 4; ++m) rwv[ai][m] = rw[row0 + ai * HALF + m * 16] * 32.0f;
#pragma unroll
        for (int ai = 0; ai < 2; ++ai)
#pragma unroll
            for (int m = 0; m < 4; ++m) { const int row = row0 + ai * HALF + m * 16; const float w_ = rwv[ai][m];
#pragma unroll
                for (int bj = 0; bj < 2; ++bj) { const f32x4 v0 = (acc[ai][bj][m][0] * dq + bv[bj][0]) * w_, v1 = (acc[ai][bj][m][1] * dq + bv[bj][1]) * w_;
                    u32x2 w; w.x = cvt4_fp8(v0[0], v0[1], v0[2], v0[3]); w.y = cvt4_fp8(v1[0], v1[1], v1[2], v1[3]);
                    *(u32x2*)(y + (size_t)row * 1024 + col0 + bj * HALF) = w; } }
    }
};

template <bool OUT8> struct EpiGateFused {
    static constexpr bool PERM = true, AFTER_DRAIN = false, HAS_MID = true;
    const bf16_t* gc; const bf16_t* gh; bf16_t* out; float dq;
    __device__ __forceinline__ void mid(f32x4 (&acc)[2][2][4][2], const Unit& u, int wr, int wc, int fr, int fq) const {
        const int row0 = u.pm * BM + wr * 64 + fr, col0 = u.pn * BM + wc * 32 + 8 * fq;
#pragma unroll
        for (int ai = 0; ai < 2; ++ai)
#pragma unroll
            for (int m = 0; m < 4; ++m) { const size_t o = (size_t)(row0 + ai * HALF + m * 16) * 1024 + col0;
#pragma unroll
                for (int bj = 0; bj < 2; ++bj) { const u32x4 a = *(const u32x4*)(gc + o + bj * HALF), b = *(const u32x4*)(gh + o + bj * HALF);
                    const unsigned aw[4] = {a.x, a.y, a.z, a.w}, bw[4] = {b.x, b.y, b.z, b.w};
#pragma unroll
                    for (int q = 0; q < 4; ++q) { const float r0 = (1.0f + __expf(-blo(bw[q]))) * __builtin_amdgcn_rcpf(1.0f + __expf(-blo(aw[q]))), r1 = (1.0f + __expf(-bhi(bw[q]))) * __builtin_amdgcn_rcpf(1.0f + __expf(-bhi(aw[q])));
                        acc[ai][bj][m][q >> 1][(2 * q) & 3] *= r0; acc[ai][bj][m][q >> 1][(2 * q + 1) & 3] *= r1; } } }
    }
    __device__ __forceinline__ void operator()(const f32x4 (&acc)[2][2][4][2], const Unit& u, int wr, int wc, int fr, int fq) const {
        const int row0 = u.pm * BM + wr * 64 + fr, col0 = u.pn * BM + wc * 32 + 8 * fq;
#pragma unroll
        for (int ai = 0; ai < 2; ++ai) {
            u32x4 gw[4][2];
#pragma unroll
            for (int m = 0; m < 4; ++m)
#pragma unroll
                for (int bj = 0; bj < 2; ++bj) gw[m][bj] = *(const u32x4*)(gh + (size_t)(row0 + ai * HALF + m * 16) * 1024 + col0 + bj * HALF);
#pragma unroll
            for (int m = 0; m < 4; ++m) { const size_t o = (size_t)(row0 + ai * HALF + m * 16) * 1024 + col0;
#pragma unroll
                for (int bj = 0; bj < 2; ++bj) { const u32x4 g = gw[m][bj]; f32x4 v0 = acc[ai][bj][m][0], v1 = acc[ai][bj][m][1];
                    v0[0] *= sigm(blo(g.x)); v0[1] *= sigm(bhi(g.x)); v0[2] *= sigm(blo(g.y)); v0[3] *= sigm(bhi(g.y));
                    v1[0] *= sigm(blo(g.z)); v1[1] *= sigm(bhi(g.z)); v1[2] *= sigm(blo(g.w)); v1[3] *= sigm(bhi(g.w));
                    if (OUT8) { const float s_ = dq * 32.0f; u32x2 w; w.x = cvt4_fp8(v0[0] * s_, v0[1] * s_, v0[2] * s_, v0[3] * s_); w.y = cvt4_fp8(v1[0] * s_, v1[1] * s_, v1[2] * s_, v1[3] * s_);
                                *(u32x2*)((unsigned char*)out + o + bj * HALF) = w; }
                    else { u32x4 w; w.x = cvt_pk_bf16(v0[0] * dq, v0[1] * dq); w.y = cvt_pk_bf16(v0[2] * dq, v0[3] * dq); w.z = cvt_pk_bf16(v1[0] * dq, v1[1] * dq); w.w = cvt_pk_bf16(v1[2] * dq, v1[3] * dq);
                           *(u32x4*)(out + o + bj * HALF) = w; } } }
        }
    }
};

template <class T, class = void> struct has_mid { static constexpr bool value = false; };
template <class T> struct has_mid<T, decltype((void)T::HAS_MID)> { static constexpr bool value = true; };
template <class Epi, class Sched, bool ALIGN_EPI = false, bool SP2 = false, bool GATHER = false, int FP8 = 0  >
__device__ __forceinline__ void gemm_phase(PG8_LAS unsigned char* lds, const Gemm g, const Sched& S, const Epi& E, const int wave_id, const PG8_LAS unsigned short* gtab = nullptr) {
    typedef int i32x4 __attribute__((ext_vector_type(4))); typedef int i32x8 __attribute__((ext_vector_type(8)));
    static_assert(!GATHER || SP2, "GATHER needs the SP2 loop");
    int lane = (int)__builtin_amdgcn_mbcnt_hi(~0u, __builtin_amdgcn_mbcnt_lo(~0u, 0u)); asm volatile("" : "+v"(lane));
    const int wid = wave_id, tid = wid * 64 + lane, wr = wid >> 2, wc = wid & 3, fr = lane & 15, fq = lane >> 4;
    const int K = g.K, nt = K / BK;
    unsigned voffA[2], voffB[2];
#pragma unroll
    for (int i = 0; i < 2; ++i) { int R, C; stage_rc(tid * 16 + i * 8192, R, C); const int Rb = Epi::PERM ? ((R & ~31) + perm32(R & 31)) : R;
        voffA[i] = (unsigned)(R * K + C) * 2u; voffB[i] = (unsigned)(Rb * K + C) * 2u; }
    unsigned vA0[2] = {0u, 0u}, vA1[2] = {0u, 0u}, xA0[2] = {0u, 0u}, xA1[2] = {0u, 0u};
#define PG8_GLOAD(d0, d1, ui_) do { int tz_ = wid * 64 + (int)__builtin_amdgcn_mbcnt_hi(~0u, __builtin_amdgcn_mbcnt_lo(~0u, 0u)); asm volatile("" : "+v"(tz_)); _Pragma("unroll") for (int _i = 0; _i < 2; ++_i) { int R_, C_; stage_rc(tz_ * 16 + _i * 8192, R_, C_); \
        d0[_i] = (unsigned)gtab[256 * (ui_) + R_] * (unsigned)(K * 2) + (unsigned)C_ * 2u; d1[_i] = (unsigned)gtab[256 * (ui_) + 128 + R_] * (unsigned)(K * 2) + (unsigned)C_ * 2u; } } while (0)
    const unsigned kstep = (unsigned)(BK * 2);
    const unsigned hstep = (unsigned)HALF * K * 2;
    const unsigned tstep = 2 * hstep;
    const __amdgpu_buffer_rsrc_t rsA = __builtin_amdgcn_make_buffer_rsrc((void*)g.A, 0, 0x7fffffff, 0x00020000), rsB = __builtin_amdgcn_make_buffer_rsrc((void*)g.Bt, 0, 0x7fffffff, 0x00020000);
    const unsigned ldsw = (unsigned)wid * 1024u;
    const int aoff = lds_byte(wr * 64 + fr, fq * 8), boff = lds_byte(wc * 32 + fr, fq * 8);
#define PG8_SA(b, h) (((b) * 2 + (h)) * HTB)
#define PG8_SB(b, h) ((4 + (b) * 2 + (h)) * HTB)
#define PG8_STAGE(bufoff, rs, soff, voff) do { _Pragma("unroll") for (int _i = 0; _i < 2; ++_i) \
        __builtin_amdgcn_raw_ptr_buffer_load_lds(rs, (PG8_LAS void*)(lds + (bufoff) + ldsw + _i * 8192), 16, (int)(voff)[_i], (int)(soff), 0, 0); } while (0)
#define PG8_LDA(dst, b, h) do { if constexpr (FP8 == 1) { _Pragma("unroll") for (int m = 0; m < 4; ++m) dst##_8[m] = __builtin_shufflevector(*(const PG8_LAS i32x4*)(lds + PG8_SA(b, h) + aoff + m * 2048), *(const PG8_LAS i32x4*)(lds + PG8_SA(b, h) + aoff + m * 2048 + 1024), 0, 1, 2, 3, 4, 5, 6, 7); } \
        else { _Pragma("unroll") for (int m = 0; m < 4; ++m) _Pragma("unroll") for (int k = 0; k < 2; ++k) dst[m][k] = *(const PG8_LAS bf16x8*)(lds + PG8_SA(b, h) + aoff + m * 2048 + k * 1024); } } while (0)
#define PG8_LDB(dst, b, h) do { if constexpr (FP8 == 1) { _Pragma("unroll") for (int n = 0; n < 2; ++n) dst##_8[n] = __builtin_shufflevector(*(const PG8_LAS i32x4*)(lds + PG8_SB(b, h) + boff + n * 2048), *(const PG8_LAS i32x4*)(lds + PG8_SB(b, h) + boff + n * 2048 + 1024), 0, 1, 2, 3, 4, 5, 6, 7); } \
        else { _Pragma("unroll") for (int n = 0; n < 2; ++n) _Pragma("unroll") for (int k = 0; k < 2; ++k) dst[n][k] = *(const PG8_LAS bf16x8*)(lds + PG8_SB(b, h) + boff + n * 2048 + k * 1024); } } while (0)
#define PG8_MMA(ai, bj, At, Bt) do { __builtin_amdgcn_s_setprio(1); if constexpr (FP8 == 1) { _Pragma("unroll") for (int m = 0; m < 4; ++m) _Pragma("unroll") for (int n = 0; n < 2; ++n) \
        asm volatile("v_mfma_scale_f32_16x16x128_f8f6f4 %0, %1, %2, %0, %3, %3 op_sel_hi:[0,0,0]" : "+v"(acc[ai][bj][m][n]) : "v"(Bt##_8[n]), "v"(At##_8[m]), "v"(sc8));     \
        } else if constexpr (FP8 == 2) { _Pragma("unroll") for (int m = 0; m < 4; ++m) _Pragma("unroll") for (int n = 0; n < 2; ++n) _Pragma("unroll") for (int k = 0; k < 2; ++k) \
        acci[ai][bj][m][n] = __builtin_amdgcn_mfma_i32_16x16x64_i8(__builtin_bit_cast(i32x4, Bt[n][k]), __builtin_bit_cast(i32x4, At[m][k]), acci[ai][bj][m][n], 0, 0, 0); \
        } else { _Pragma("unroll") for (int m = 0; m < 4; ++m) _Pragma("unroll") for (int n = 0; n < 2; ++n) _Pragma("unroll") for (int k = 0; k < 2; ++k) \
        acc[ai][bj][m][n] = __builtin_amdgcn_mfma_f32_16x16x32_bf16(Bt[n][k], At[m][k], acc[ai][bj][m][n], 0, 0, 0); } __builtin_amdgcn_s_setprio(0); } while (0)
#define PG8_WAIT_V(n) asm volatile("s_waitcnt vmcnt(" #n ")" ::: "memory")
#define PG8_WAIT_L(n) asm volatile("s_waitcnt lgkmcnt(" #n ")" ::: "memory")
#define PG8_BAR __builtin_amdgcn_s_barrier()
#define PG8_SCHED __builtin_amdgcn_sched_barrier(0)
    Unit cur, nxt; int ui = 0;
    if (!S.next(0, cur)) return;
    f32x4 acc[2][2][4][2]; i32x4 acci[2][2][4][2];
#pragma unroll
    for (int a = 0; a < 2; ++a)
#pragma unroll
        for (int b = 0; b < 2; ++b)
#pragma unroll
            for (int m = 0; m < 4; ++m)
#pragma unroll
                for (int n = 0; n < 2; ++n) { acc[a][b][m][n] = (f32x4){0.f, 0.f, 0.f, 0.f}; acci[a][b][m][n] = (i32x4){0, 0, 0, 0}; }
    int sc8 = 0x7f7f7f7f; asm volatile("" : "+v"(sc8));
    bf16x8 At[4][2], B0[2][2], B1[2][2]; i32x8 At_8[4], B0_8[2], B1_8[2];
    unsigned cA = GATHER ? 0u : (unsigned)cur.pm * tstep, cB = (unsigned)cur.pn * tstep;
    S.a_ready(cur);
    if constexpr (GATHER) { PG8_GLOAD(vA0, vA1, 0); xA0[0] = vA0[0]; xA0[1] = vA0[1]; xA1[0] = vA1[0]; xA1[1] = vA1[1]; }
    if constexpr (SP2) {
        PG8_STAGE(PG8_SB(0, 0), rsB, cB, voffB); PG8_STAGE(PG8_SB(0, 1), rsB, cB + hstep, voffB);
        if constexpr (GATHER) { PG8_STAGE(PG8_SA(0, 0), rsA, cA, vA0); PG8_STAGE(PG8_SA(0, 1), rsA, cA, vA1); } else { PG8_STAGE(PG8_SA(0, 0), rsA, cA, voffA); PG8_STAGE(PG8_SA(0, 1), rsA, cA + hstep, voffA); }
        if (wr == 1) PG8_BAR;
        PG8_WAIT_V(2); PG8_BAR;
        PG8_STAGE(PG8_SB(1, 0), rsB, cB + kstep, voffB); if constexpr (GATHER) { PG8_STAGE(PG8_SA(1, 0), rsA, cA + kstep, vA0); } else { PG8_STAGE(PG8_SA(1, 0), rsA, cA + kstep, voffA); } PG8_STAGE(PG8_SB(1, 1), rsB, cB + hstep + kstep, voffB);
        PG8_WAIT_V(6); PG8_BAR;
    } else {
        PG8_STAGE(PG8_SB(0, 0), rsB, cB, voffB); PG8_STAGE(PG8_SA(0, 0), rsA, cA, voffA); PG8_STAGE(PG8_SB(0, 1), rsB, cB + hstep, voffB); PG8_STAGE(PG8_SA(0, 1), rsA, cA + hstep, voffA);
        if (wr == 1) PG8_BAR;
        PG8_WAIT_V(4); PG8_BAR;
        PG8_STAGE(PG8_SB(1, 0), rsB, cB + kstep, voffB); PG8_STAGE(PG8_SA(1, 0), rsA, cA + kstep, voffA); PG8_STAGE(PG8_SB(1, 1), rsB, cB + hstep + kstep, voffB);
        PG8_WAIT_V(6); PG8_BAR;
    }
    for (;;) {
        const bool has_next = S.next(ui + 1, nxt);
        const unsigned nA = GATHER ? cA : (has_next ? (unsigned)nxt.pm * tstep : cA), nB = has_next ? (unsigned)nxt.pn * tstep : cB;
        for (int t = 0; t < nt; t += 2) {
            const bool last = (t == nt - 2);
            const unsigned a1 = cA + (unsigned)(t + 1) * kstep;
            const unsigned a2 = last ? nA : cA + (unsigned)(t + 2) * kstep, b2 = last ? nB : cB + (unsigned)(t + 2) * kstep;
            const unsigned a3 = a2 + kstep, b3 = b2 + kstep;
            if (last && has_next) S.a_ready(nxt);
            if constexpr (has_mid<Epi>::value) { if (t == nt / 2) { int l3_ = (int)__builtin_amdgcn_mbcnt_hi(~0u, __builtin_amdgcn_mbcnt_lo(~0u, 0u)); asm volatile("" : "+v"(l3_)); E.mid(acc, cur, wr, wc, l3_ & 15, l3_ >> 4); } }
            if constexpr (GATHER) { if (last && has_next) { PG8_GLOAD(xA0, xA1, ui + 1); } }
            if constexpr (SP2) {
            PG8_LDB(B0, 0, 0); PG8_LDB(B1, 0, 1); PG8_SCHED; PG8_LDA(At, 0, 0); if constexpr (GATHER) { PG8_STAGE(PG8_SA(1, 1), rsA, a1, vA1); } else { PG8_STAGE(PG8_SA(1, 1), rsA, a1 + hstep, voffA); }
            PG8_WAIT_V(8); PG8_WAIT_L(0); PG8_BAR; PG8_MMA(0, 0, At, B0); PG8_MMA(0, 1, At, B1); PG8_BAR; PG8_SCHED;
            PG8_LDA(At, 0, 1); PG8_STAGE(PG8_SB(0, 0), rsB, b2, voffB); PG8_STAGE(PG8_SB(0, 1), rsB, b2 + hstep, voffB); if constexpr (GATHER) { PG8_STAGE(PG8_SA(0, 0), rsA, a2, xA0); } else { PG8_STAGE(PG8_SA(0, 0), rsA, a2, voffA); }
            PG8_WAIT_V(8); PG8_WAIT_L(0); PG8_BAR; PG8_MMA(1, 0, At, B0); PG8_MMA(1, 1, At, B1); PG8_BAR; PG8_SCHED;
            PG8_LDB(B0, 1, 0); PG8_LDB(B1, 1, 1); PG8_SCHED; PG8_LDA(At, 1, 0); if constexpr (GATHER) { PG8_STAGE(PG8_SA(0, 1), rsA, a2, xA1); } else { PG8_STAGE(PG8_SA(0, 1), rsA, a2 + hstep, voffA); }
            PG8_WAIT_V(8); PG8_WAIT_L(0); PG8_BAR; PG8_MMA(0, 0, At, B0); PG8_MMA(0, 1, At, B1); PG8_BAR; PG8_SCHED;
            PG8_LDA(At, 1, 1); PG8_STAGE(PG8_SB(1, 0), rsB, b3, voffB); PG8_STAGE(PG8_SB(1, 1), rsB, b3 + hstep, voffB); if constexpr (GATHER) { PG8_STAGE(PG8_SA(1, 0), rsA, a3, xA0); } else { PG8_STAGE(PG8_SA(1, 0), rsA, a3, voffA); }
            PG8_WAIT_V(8); PG8_WAIT_L(0); PG8_BAR; PG8_MMA(1, 0, At, B0); PG8_MMA(1, 1, At, B1); PG8_BAR; PG8_SCHED;
            } else {
            PG8_LDB(B0, 0, 0); PG8_SCHED; PG8_LDA(At, 0, 0); PG8_STAGE(PG8_SA(1, 1), rsA, a1 + hstep, voffA);
            PG8_WAIT_L(8); PG8_BAR; PG8_WAIT_L(0); PG8_MMA(0, 0, At, B0); PG8_BAR; PG8_SCHED;
            PG8_LDB(B1, 0, 1); PG8_STAGE(PG8_SB(0, 0), rsB, b2, voffB);
            PG8_BAR; PG8_WAIT_L(0); PG8_MMA(0, 1, At, B1); PG8_BAR;
            PG8_LDA(At, 0, 1); PG8_STAGE(PG8_SA(0, 0), rsA, a2, voffA);
            PG8_BAR; PG8_WAIT_L(0); PG8_MMA(1, 0, At, B0); PG8_BAR; PG8_SCHED;
            PG8_STAGE(PG8_SB(0, 1), rsB, b2 + hstep, voffB);
            PG8_WAIT_V(6); PG8_BAR; PG8_MMA(1, 1, At, B1); PG8_BAR;
            PG8_LDB(B0, 1, 0); PG8_SCHED; PG8_LDA(At, 1, 0); PG8_STAGE(PG8_SA(0, 1), rsA, a2 + hstep, voffA);
            PG8_WAIT_L(8); PG8_BAR; PG8_WAIT_L(0); PG8_MMA(0, 0, At, B0); PG8_BAR; PG8_SCHED;
            PG8_LDB(B1, 1, 1); PG8_STAGE(PG8_SB(1, 0), rsB, b3, voffB);
            PG8_BAR; PG8_WAIT_L(0); PG8_MMA(0, 1, At, B1); PG8_BAR;
            PG8_LDA(At, 1, 1); PG8_STAGE(PG8_SA(1, 0), rsA, a3, voffA);
            PG8_BAR; PG8_WAIT_L(0); PG8_MMA(1, 0, At, B0); PG8_BAR; PG8_SCHED;
            PG8_STAGE(PG8_SB(1, 1), rsB, b3 + hstep, voffB);
            PG8_WAIT_V(6); PG8_BAR; PG8_MMA(1, 1, At, B1); PG8_BAR;
            }
        }
        if constexpr (ALIGN_EPI) { if (wr == 0) PG8_BAR; }
        if constexpr (FP8 == 2) { _Pragma("unroll") for (int a = 0; a < 2; ++a) _Pragma("unroll") for (int bq = 0; bq < 2; ++bq) _Pragma("unroll") for (int m = 0; m < 4; ++m) _Pragma("unroll") for (int n = 0; n < 2; ++n) acc[a][bq][m][n] = __builtin_convertvector(acci[a][bq][m][n], f32x4); }
        if constexpr (FP8 == 1) asm volatile("s_nop 15\n\ts_nop 15" ::: "memory");
        if constexpr (!Epi::AFTER_DRAIN) { int l2_ = (int)__builtin_amdgcn_mbcnt_hi(~0u, __builtin_amdgcn_mbcnt_lo(~0u, 0u)); asm volatile("" : "+v"(l2_));
            E(acc, cur, wr, wc, l2_ & 15, l2_ >> 4); S.done(cur); }
        if (!has_next) break;
#pragma unroll
        for (int a = 0; a < 2; ++a)
#pragma unroll
            for (int b = 0; b < 2; ++b)
#pragma unroll
                for (int m = 0; m < 4; ++m)
#pragma unroll
                    for (int n = 0; n < 2; ++n) { acc[a][b][m][n] = (f32x4){0.f, 0.f, 0.f, 0.f}; acci[a][b][m][n] = (i32x4){0, 0, 0, 0}; }
        cur = nxt; cA = nA; cB = nB; ++ui;
        if constexpr (GATHER) { vA0[0] = xA0[0]; vA0[1] = xA0[1]; vA1[0] = xA1[0]; vA1[1] = xA1[1]; }
        if constexpr (ALIGN_EPI) { if (wr == 1) PG8_BAR; }
    }
    PG8_WAIT_V(0);
    if constexpr (!ALIGN_EPI) { if (wr == 0) PG8_BAR; }
    PG8_BAR;
    if constexpr (Epi::AFTER_DRAIN) { E.fused(acc, cur, wr, wc, fr, fq, lds, wid, lane); S.done(cur); }
#undef PG8_GLOAD
#undef PG8_SA
#undef PG8_SB
#undef PG8_STAGE
#undef PG8_LDA
#undef PG8_LDB
#undef PG8_MMA
#undef PG8_WAIT_V
#undef PG8_WAIT_L
#undef PG8_BAR
#undef PG8_SCHED
}
}
#define XB_TMO      128
#define XB_XCNT(j)  (256  + 64 * (j))
#define XB_XSUB(j)  (1280 + 64 * (j))
#define XB_XGEN(j)  (2304 + 64 * (j))
#define XB_TOP      3328
#define XB_TOPGEN   3392
#define XCD_BAR_WORDS 3456
#define XB_SPIN_CAP (1u << 18)

__device__ __forceinline__ unsigned xb_ld(unsigned* p)              { return __hip_atomic_load(p, __ATOMIC_RELAXED, __HIP_MEMORY_SCOPE_AGENT); }
__device__ __forceinline__ unsigned xb_add(unsigned* p, unsigned v) { return __hip_atomic_fetch_add(p, v, __ATOMIC_RELAXED, __HIP_MEMORY_SCOPE_AGENT); }
__device__ __forceinline__ unsigned xb_xcc_id() { return (unsigned)__builtin_amdgcn_s_getreg((3 << 11) | 20) & 0xFu; }
#define XB_SPIN(cond, bar) do { unsigned _sp = 0; while (cond) { __builtin_amdgcn_s_sleep(1); \
    if ((++_sp & 255u) == 0u) { if (xb_ld(&(bar)[XB_TMO])) break; if (_sp > XB_SPIN_CAP) { atomicAdd(&(bar)[XB_TMO], 1u); break; } } } } while (0)

struct XcdBarrier {
    unsigned* bar; unsigned x;
    volatile LAS unsigned* st;
};

__device__ __forceinline__ XcdBarrier xcd_barrier_post(unsigned* bar, volatile LAS unsigned* st, const bool leader  ) {
    XcdBarrier b; b.bar = bar; b.x = xb_xcc_id(); b.st = st;
    if (leader) (void)xb_add(&bar[XB_XCNT(b.x)], 1u);
    return b;
}
__device__ __forceinline__ void xcd_barrier_complete(unsigned* bar, unsigned x, unsigned& nloc, unsigned& nx) {
    const unsigned G = gridDim.x * gridDim.y * gridDim.z;
    unsigned sum, cnt, mine, sp = 0u;
    for (;;) {
        sum = 0u; cnt = 0u; mine = 0u;
#pragma unroll
        for (unsigned j = 0; j < 16; ++j) { const unsigned c = xb_ld(&bar[XB_XCNT(j)]); sum += c; cnt += (c > 0u) ? 1u : 0u; mine = (j == x) ? c : mine; }
        if (sum == G) break;
        __builtin_amdgcn_s_sleep(1);
        if ((++sp & 255u) == 0u) { if (xb_ld(&bar[XB_TMO])) break; if (sp > XB_SPIN_CAP) { atomicAdd(&bar[XB_TMO], 1u); break; } }
    }
    nloc = mine > 0u ? mine : 1u; nx = cnt > 0u ? cnt : 1u;
}

__device__ __forceinline__ void xcd_barrier(const XcdBarrier& b, const bool leader  ) {
    asm volatile("s_waitcnt vmcnt(0)" ::: "memory");
    __syncthreads();
    if (leader) {
        unsigned* bar = b.bar;
        __builtin_amdgcn_s_waitcnt(0);
        unsigned nloc = b.st[0], nx = b.st[1];
        if (nloc == 0u) { xcd_barrier_complete(bar, b.x, nloc, nx); b.st[0] = nloc; b.st[1] = nx; }
        const unsigned old = xb_add(&bar[XB_XSUB(b.x)], 1u);
        const unsigned gen = old / nloc;
        if (old + 1u == (gen + 1u) * nloc) {
            __builtin_amdgcn_fence(__ATOMIC_RELEASE, "agent");
            asm volatile("s_waitcnt vmcnt(0)" ::: "memory");
            const unsigned og = xb_add(&bar[XB_TOP], 1u);
            const unsigned tg = og / nx;
            if (og + 1u == (tg + 1u) * nx) xb_add(&bar[XB_TOPGEN], 1u);
            else XB_SPIN(xb_ld(&bar[XB_TOPGEN]) == tg, bar);
            __builtin_amdgcn_fence(__ATOMIC_ACQUIRE, "agent");
            xb_add(&bar[XB_XGEN(b.x)], 1u);
            asm volatile("s_waitcnt vmcnt(0)" ::: "memory");
        } else {
            XB_SPIN(xb_ld(&bar[XB_XGEN(b.x)]) == gen, bar);
            __builtin_amdgcn_fence(__ATOMIC_ACQUIRE, "agent");
            asm volatile("s_waitcnt vmcnt(0)" ::: "memory");
        }
    }
    __syncthreads();
}

#ifndef MIX_FP8
#define MIX_FP8 1
#endif
#ifndef RES_FP8
#define RES_FP8 1
#endif
#ifndef P_INT8
#define P_INT8 1
#endif
#ifndef P_FP8_MASK
#define P_FP8_MASK 0xFFFFFFFFu
#endif =======================================================
struct Ctx { LAS unsigned char* lds; int tid, lane, wave, vcu, G; };

__device__ __forceinline__ void transpose_load64(const float* W, int ldw, int k0, int n0, LAS float* scr, int lane) {
#pragma unroll 8
    for (int i = 0; i < 16; ++i) { const int kk = 4 * i + (lane >> 4), nn = 4 * (lane & 15); const f32x4 v = *(const f32x4*)(W + (size_t)(k0 + kk) * ldw + n0 + nn);
        LAS float* d = scr + kk * 65 + nn; d[0] = v.x; d[1] = v.y; d[2] = v.z; d[3] = v.w; }
    LDS_WAIT();
}
__device__ __forceinline__ void transpose_item(const float* W, int ldw, int K, bf16_t* dst, int k0, int n0, LAS float* scr, int lane) {
    transpose_load64(W, ldw, k0, n0, scr, lane);
    const int c = lane & 7;
#pragma unroll
    for (int j = 0; j < 8; ++j) { const int n = (lane >> 3) + 8 * j; const LAS float* s = scr + (8 * c) * 65 + n;
        u32x4 o; o.x = pk2(s[0 * 65], s[1 * 65]); o.y = pk2(s[2 * 65], s[3 * 65]); o.z = pk2(s[4 * 65], s[5 * 65]); o.w = pk2(s[6 * 65], s[7 * 65]);
        *(u32x4*)(dst + (size_t)n * K + k0 + 8 * c) = o; }
    LDS_WAIT();
}
__device__ __forceinline__ void transpose_item8(const float* W, int ldw, int K, unsigned char* dst, int k0, int n0, float scale, LAS float* scr, int lane) {
    (void)scr;
    const int kc = lane & 3, nq = lane >> 2;
    const float* s = W + (size_t)(k0 + 16 * kc) * ldw + n0 + 4 * nq;
    f32x4 v[16];
#pragma unroll
    for (int i = 0; i < 16; ++i) v[i] = *(const f32x4*)(s + (size_t)i * ldw);
#pragma unroll
    for (int j = 0; j < 4; ++j) {
        u32x4 o; o.x = cvt4_fp8(v[0][j] * scale, v[1][j] * scale, v[2][j] * scale, v[3][j] * scale); o.y = cvt4_fp8(v[4][j] * scale, v[5][j] * scale, v[6][j] * scale, v[7][j] * scale);
        o.z = cvt4_fp8(v[8][j] * scale, v[9][j] * scale, v[10][j] * scale, v[11][j] * scale); o.w = cvt4_fp8(v[12][j] * scale, v[13][j] * scale, v[14][j] * scale, v[15][j] * scale);
        *(u32x4*)(dst + (size_t)(4 * nq + j) * K + k0 + 16 * kc) = o; }
}

template <int PART>
__device__ __forceinline__ void ph_prologue(const Ctx& X, const float* c, const float* w_ada, const float* b_ada, float* mod,
                                            const float* w_in, const float* w_conv_out, const float* w_hgrn_out, const float* w_out, const float* w1, const float* w2, unsigned char* ws) {
    if (PART == 0) for (int cbk = X.vcu; cbk < NMOD / 32; cbk += X.G) {
        LAS float* ca = (LAS float*)X.lds;
        LAS float* red = (LAS float*)(X.lds + 16384);
        for (int i = X.tid; i < 4096; i += 512) { const float v = c[i]; ca[i] = v * sigmoidf_(v); }
        __syncthreads();
        const int jj = X.tid & 31, kp = X.tid >> 5, j = cbk * 32 + jj;
        float a0 = 0.f, a1 = 0.f, a2 = 0.f, a3 = 0.f;
#pragma unroll 16
        for (int i = kp * 64; i < kp * 64 + 64; ++i) { const float w = w_ada[(size_t)i * NMOD + j]; a0 += ca[i] * w; a1 += ca[1024 + i] * w; a2 += ca[2048 + i] * w; a3 += ca[3072 + i] * w; }
        red[(kp * 4 + 0) * 32 + jj] = a0; red[(kp * 4 + 1) * 32 + jj] = a1; red[(kp * 4 + 2) * 32 + jj] = a2; red[(kp * 4 + 3) * 32 + jj] = a3;
        __syncthreads();
        if (X.tid < 128) { const int b = X.tid >> 5; float r = b_ada[j];
#pragma unroll
            for (int q = 0; q < 16; ++q) r += red[(q * 4 + b) * 32 + jj];
            mod[(size_t)b * NMOD + j] = r; }
        __syncthreads();
    }
    LAS float* scr = (LAS float*)(X.lds + X.wave * 16640);
    const bool split = PART == 0 && X.G > NMOD / 32;
    const int gw = split ? (X.vcu - NMOD / 32) * 8 + X.wave : X.vcu * 8 + X.wave, NGW = split ? (X.G - NMOD / 32) * 8 : X.G * 8;
    constexpr int I_IN = 16 * 128, I_SQ = 16 * 16, I_W1 = 32 * 16 * 32, I_W2 = 32 * 16 * 16, NITEMS = I_IN + 3 * I_SQ + I_W1 + I_W2;
    constexpr int I_DENSE = I_IN + 3 * I_SQ;
    if (!(split && X.vcu < NMOD / 32)) for (int it = (PART == 0 ? (P_INT8 ? I_IN : 0) : I_DENSE) + gw; it < (PART == 0 ? I_DENSE : NITEMS); it += NGW) {
        int r = it;
        if (r < I_IN) { const int kb = r >> 7, nb = r & 127, n0 = 64 * nb;
            const int rho0 = (n0 < 2048) ? 256 * ((n0 & 1023) >> 7) + 128 * (n0 >> 10) + (n0 & 127) : n0;
            if ((P_FP8_MASK >> (rho0 >> 8)) & 1u) transpose_item8(w_in, 8192, 1024, (unsigned char*)(ws + WS_WIN8) + (size_t)rho0 * 1024, 64 * kb, n0, 256.0f, scr, X.lane);
            else transpose_item(w_in, 8192, 1024, (bf16_t*)(ws + WS_WIN) + (size_t)rho0 * 1024, 64 * kb, n0, scr, X.lane);
            continue; } r -= I_IN;
        if (r < 3 * I_SQ) { const int which = r / I_SQ, q = r % I_SQ, kb = q >> 4, nb = q & 15;
            const float* W = which == 0 ? w_conv_out : (which == 1 ? w_hgrn_out : w_out);
            if (which == 2) { if (RES_FP8) transpose_item8(W, 1024, 1024, (unsigned char*)(ws + WS_WO) + (size_t)(64 * nb) * 1024, 64 * kb, 64 * nb, 256.0f, scr, X.lane);
                              else transpose_item(W, 1024, 1024, (bf16_t*)(ws + WS_WO) + (size_t)(64 * nb) * 1024, 64 * kb, 64 * nb, scr, X.lane); }
            else if (MIX_FP8) transpose_item8(W, 1024, 2048, (unsigned char*)(ws + WS_WC) + (size_t)(64 * nb) * 2048 + which * 1024, 64 * kb, 64 * nb, 256.0f, scr, X.lane);
            else transpose_item(W, 1024, 2048, (bf16_t*)(ws + WS_WC) + (size_t)(64 * nb) * 2048 + which * 1024, 64 * kb, 64 * nb, scr, X.lane);
            continue; } r -= 3 * I_SQ;
        if (r < I_W1) { const int e = r >> 9, q = r & 511, kb = q >> 5, nb = q & 31, n0 = 64 * nb;
            const int rho0 = (n0 < 1024) ? 256 * (n0 >> 7) + (n0 & 127) : 256 * ((n0 - 1024) >> 7) + 128 + ((n0 - 1024) & 127);
            transpose_item8(w1 + (size_t)e * 1024 * 2048, 2048, 1024, (unsigned char*)(ws + WS_W1) + ((size_t)e * 2048 + rho0) * 1024, 64 * kb, n0, 256.0f, scr, X.lane); continue; } r -= I_W1;
        { const int e = r >> 8, q = r & 255, kb = q >> 4, nb = q & 15;
            transpose_item8(w2 + (size_t)e * 1024 * 1024, 1024, 1024, (unsigned char*)(ws + WS_W2) + ((size_t)e * 1024 + 64 * nb) * 1024, 64 * kb, 64 * nb, 256.0f, scr, X.lane); }
    }
    __syncthreads();
}

__device__ __forceinline__ void ph_norm_mod(const Ctx& X, const float* x, const float* g, const float* mod, int sh_off, int sc_off, bf16_t* out, unsigned char* out8, float* hsc) {
    for (int t = X.vcu * 8 + X.wave; t < T; t += X.G * 8) {
        const int b = t / SEQ, lane = X.lane;
        const f32x4* xr = (const f32x4*)(x + (size_t)t * D) + lane;
        f32x4 v[4]; float ss = 0.f;
#pragma unroll
        for (int j = 0; j < 4; ++j) { v[j] = xr[64 * j]; ss += (v[j].x * v[j].x + v[j].y * v[j].y) + (v[j].z * v[j].z + v[j].w * v[j].w); }
        const float r = rsqrtf(wave_sum(ss) * (1.0f / D) + EPS);
        const float* sh = mod + (size_t)b * NMOD + sh_off; const float* sc = mod + (size_t)b * NMOD + sc_off;
        float am = 0.f;
#pragma unroll
        for (int j = 0; j < 4; ++j) {
            const int col = 4 * (lane + 64 * j);
            const f32x4 gg = *(const f32x4*)(g + col), s1 = *(const f32x4*)(sc + col), s0 = *(const f32x4*)(sh + col);
            v[j] = v[j] * r * gg * (s1 + 1.0f) + s0;
            am = fmaxf(fmaxf(am, fmaxf(fabsf(v[j].x), fabsf(v[j].y))), fmaxf(fabsf(v[j].z), fabsf(v[j].w)));
        }
        if (P_INT8) {
#pragma unroll
            for (int o = 1; o < 64; o <<= 1) am = fmaxf(am, __shfl_xor(am, o));
            am = fmaxf(am, 1e-20f); const float qs = 127.0f / am;
            if (lane == 0) hsc[t] = am * (1.0f / 127.0f);
#pragma unroll
            for (int j = 0; j < 4; ++j) *(unsigned*)(out8 + (size_t)t * D + 4 * (lane + 64 * j)) = q4_i8(v[j].x * qs, v[j].y * qs, v[j].z * qs, v[j].w * qs);
        } else {
#pragma unroll
            for (int j = 0; j < 4; ++j) { const int col = 4 * (lane + 64 * j); const f32x4 y = v[j];
                if (P_FP8_MASK != 0xFFFFFFFFu) { u32x2 w; w.x = pk2(y.x, y.y); w.y = pk2(y.z, y.w); *(u32x2*)(out + (size_t)t * D + col) = w; }
                if (P_FP8_MASK != 0u) *(unsigned*)(out8 + (size_t)t * D + col) = cvt4_fp8(y.x * 16.0f, y.y * 16.0f, y.z * 16.0f, y.w * 16.0f); }
        }
    }
}

__device__ __forceinline__ void ph_win_i8(const Ctx& X, const float* w_in, unsigned char* ws) {
    LAS float* part = (LAS float*)(X.lds + 8 * 8704);
    LAS float* cmax = part + 512;
    float* wsc = (float*)(ws + WS_WSC); unsigned char* wt = ws + WS_WIN8;
    const int tid = X.tid, c = tid & 31, kq = tid >> 5;
    for (int cb = X.vcu; cb < 256; cb += X.G) {
        const int n0 = 32 * cb;
        const int rho0 = (n0 < 2048) ? 256 * ((n0 & 1023) >> 7) + 128 * (n0 >> 10) + (n0 & 127) : n0;
        float v[64]; const float* p_ = w_in + (size_t)(kq * 64) * 8192 + n0 + c;
#pragma unroll
        for (int i = 0; i < 64; ++i) v[i] = p_[(size_t)i * 8192];
        float m = 0.f;
#pragma unroll
        for (int i = 0; i < 64; ++i) m = fmaxf(m, fabsf(v[i]));
        part[kq * 32 + c] = m;
        __syncthreads();
        if (tid < 32) { float m2 = 0.f;
#pragma unroll
            for (int q = 0; q < 16; ++q) m2 = fmaxf(m2, part[q * 32 + tid]);
            m2 = fmaxf(m2, 1e-30f); cmax[tid] = m2; wsc[rho0 + tid] = m2 * (1.0f / 127.0f); }
        __syncthreads();
        const float qs = 127.0f / cmax[c];
        unsigned char* d = wt + (size_t)(rho0 + c) * 1024 + kq * 64;
#pragma unroll
        for (int q = 0; q < 4; ++q) { u32x4 o;
            o.x = q4_i8(v[16 * q + 0] * qs, v[16 * q + 1] * qs, v[16 * q + 2] * qs, v[16 * q + 3] * qs); o.y = q4_i8(v[16 * q + 4] * qs, v[16 * q + 5] * qs, v[16 * q + 6] * qs, v[16 * q + 7] * qs);
            o.z = q4_i8(v[16 * q + 8] * qs, v[16 * q + 9] * qs, v[16 * q + 10] * qs, v[16 * q + 11] * qs); o.w = q4_i8(v[16 * q + 12] * qs, v[16 * q + 13] * qs, v[16 * q + 14] * qs, v[16 * q + 15] * qs);
            *(u32x4*)(d + 16 * q) = o; }
        __syncthreads();
    }
}

typedef float f32x2 __attribute__((ext_vector_type(2)));
__device__ __forceinline__ void ph_conv(const Ctx& X, const bf16_t* pU, const float* dw, const float* dwb, const float* lng, const float* lnb, bf16_t* uc) {
    LAS float* sm = (LAS float*)X.lds;
    const int tid = X.tid, lane = X.lane, wid = X.wave, c0 = 2 * tid;
    float w[31][2];
#pragma unroll
    for (int j = 0; j < 31; ++j) { w[j][0] = dw[j * 1024 + c0]; w[j][1] = dw[j * 1024 + c0 + 1]; }
    const float bias0 = dwb[c0], bias1 = dwb[c0 + 1];
    unsigned raw[62];
#define CONV_LOAD(task_) do { const int b_ = (task_) >> 8, s0_ = ((task_) & 255) * 32; const bf16_t* q_ = pU + (size_t)(b_ * SEQ) * D + c0; \
        _Pragma("unroll") for (int i = 0; i < 62; ++i) { const int s_ = s0_ - 30 + i; raw[i] = (s_ >= 0) ? *(const unsigned*)(q_ + (size_t)s_ * D) : 0u; } } while (0)
#define CONV_LOAD_NEXT(task_) do { const int b_ = (task_) >> 8, s0_ = ((task_) & 255) * 32; const bf16_t* q_ = pU + (size_t)(b_ * SEQ) * D + c0; \
        _Pragma("unroll") for (int i = 0; i < 30; ++i) raw[i] = raw[i + 32]; \
        _Pragma("unroll") for (int i = 30; i < 62; ++i) raw[i] = *(const unsigned*)(q_ + (size_t)(s0_ - 30 + i) * D); } while (0)
    for (int run = X.vcu; run < T / 128; run += X.G) {
      CONV_LOAD(4 * run);
      for (int kq = 0; kq < 4; ++kq) {
        const int task = 4 * run + kq;
        const int b = task >> 8, s0 = (task & 255) * 32;
#pragma unroll
        for (int st = 0; st < 4; ++st) {
            float u[38][2];
#pragma unroll
            for (int i = 0; i < 38; ++i) { u[i][0] = bflo(raw[8 * st + i]); u[i][1] = bfhi(raw[8 * st + i]); }
#pragma unroll
            for (int t = 0; t < 8; ++t) {
                float a0 = bias0, a1 = bias1;
#pragma unroll
                for (int j = 0; j < 31; ++j) { a0 += w[j][0] * u[t + j][0]; a1 += w[j][1] * u[t + j][1]; }
                *(LAS f32x2*)(sm + (8 * st + t) * 1024 + c0) = (f32x2){a0, a1};
            }
        }
        if (kq < 3) CONV_LOAD_NEXT(task + 1);
        __syncthreads();
#pragma unroll 2
        for (int i = 0; i < 4; ++i) {
            const int t = wid * 4 + i;
            f32x4 v[4]; float s = 0.f;
#pragma unroll
            for (int j = 0; j < 4; ++j) { v[j] = *(const LAS f32x4*)(sm + t * 1024 + 4 * (lane + 64 * j)); s += (v[j].x + v[j].y) + (v[j].z + v[j].w); }
            const float mean = wave_sum(s) * (1.0f / D); float q = 0.f;
#pragma unroll
            for (int j = 0; j < 4; ++j) { v[j] = v[j] - mean; q += (v[j].x * v[j].x + v[j].y * v[j].y) + (v[j].z * v[j].z + v[j].w * v[j].w); }
            const float rstd = rsqrtf(wave_sum(q) * (1.0f / D) + EPS);
#pragma unroll
            for (int j = 0; j < 4; ++j) {
                const int col = 4 * (lane + 64 * j);
                const f32x4 gg = *(const f32x4*)(lng + col), bb = *(const f32x4*)(lnb + col);
                f32x4 y = v[j] * rstd * gg + bb;
                y.x *= sigmoidf_(y.x); y.y *= sigmoidf_(y.y); y.z *= sigmoidf_(y.z); y.w *= sigmoidf_(y.w);
                u32x2 o; o.x = pk2(y.x, y.y); o.y = pk2(y.z, y.w);
                if (MIX_FP8) *(unsigned*)((unsigned char*)uc + (size_t)(b * SEQ + s0 + t) * (2 * D) + col) = cvt4_fp8(y.x * 16.0f, y.y * 16.0f, y.z * 16.0f, y.w * 16.0f);
                else *(u32x2*)(uc + (size_t)(b * SEQ + s0 + t) * (2 * D) + col) = o;
            }
        }
        __syncthreads();
      }
    }
#undef CONV_LOAD
#undef CONV_LOAD_NEXT
}

typedef short bf16x8 __attribute__((ext_vector_type(8)));
typedef short s16x4 __attribute__((ext_vector_type(4)));
constexpr int HG_QA = 0, HG_KA = 17408, HG_VR = 34816, HG_AB = 52224, HG_SPT = 61440, HG_O = 96256, HG_SEG = 130048;
constexpr size_t HM = (size_t)SEQ * 128;
__device__ __forceinline__ bf16x8 tr_frag(LAS unsigned char* base, int rs, int ks, int c16, int lane) {
    const int g = lane >> 4, q = (lane & 15) >> 2, p = lane & 3;
    LAS unsigned char* a = base + (32 * ks + 8 * g + q) * rs + (16 * c16 + 4 * p) * 2;
    const s16x4 lo = __builtin_amdgcn_ds_read_tr16_b64_v4i16((LAS s16x4*)a);
    const s16x4 hi = __builtin_amdgcn_ds_read_tr16_b64_v4i16((LAS s16x4*)(a + 4 * rs));
    return __builtin_shufflevector(lo, hi, 0, 1, 2, 3, 4, 5, 6, 7);
}
template <bool OUT>
__device__ __forceinline__ void ph_hgrn(const Ctx& X, int ntask, const bf16_t* pQ, const bf16_t* pF, const bf16_t* pI, const bf16_t* pG,
                                        const float* lb_param, const float* norm_g, const float* S0, float* dS, float* Dd, bf16_t* og) {
    LAS unsigned char* L = X.lds;
    LAS float* seg_s = (LAS float*)(L + HG_SEG);
    const int tid = X.tid, lane = X.lane, wave = X.wave, fr = lane & 15, fq = lane >> 4, wr = wave >> 1, wc = wave & 1;
    const int cp = tid & 63, seg = wave, tv = tid >> 3, vc = tid & 7;
    int idx = X.vcu; if (idx >= ntask) return;
    int ch = 0;
    unsigned zr[8], qr[8]; u32x4 vr0, vr1, gn0, gn1, gc0, gc1;
#define HG_LOAD(idx_, ch_) do { const int bh_ = (idx_) & 31, sc_ = (idx_) >> 5; const size_t tb_ = (size_t)bh_ * HM + (size_t)(sc_ * 256 + (ch_) * 64) * 128; \
        _Pragma("unroll") for (int i = 0; i < 8; ++i) { zr[i] = *(const unsigned*)(pF + tb_ + (size_t)(8 * seg + i) * 128 + 2 * cp); if (OUT) qr[i] = *(const unsigned*)(pQ + tb_ + (size_t)(8 * seg + i) * 128 + 2 * cp); } \
        { const u32x4* s_ = (const u32x4*)(pI + tb_ + (size_t)tv * 128 + vc * 16); vr0 = s_[0]; vr1 = s_[1]; } \
        if (OUT) { const u32x4* s_ = (const u32x4*)(pG + tb_ + (size_t)tv * 128 + vc * 16); gn0 = s_[0]; gn1 = s_[1]; } } while (0)
    HG_LOAD(idx, 0);
    float ngv[16];
    if (OUT) {
#pragma unroll
        for (int i = 0; i < 16; ++i) ngv[i] = norm_g[vc * 16 + i];
    }
    f32x4 S[8]; float oml0 = 0.f, oml1 = 0.f, gsum0 = 0.f, gsum1 = 0.f;
#pragma unroll 1
    for (;;) {
        const int sc = idx >> 5, bh = idx & 31, b = bh >> 3, h = bh & 7;
        if (ch == 0) {
            const int c0 = h * 128 + 2 * cp;
            oml0 = 1.0f - 1.0f / (1.0f + __expf(lb_param[1024 + c0] - lb_param[c0])); oml1 = 1.0f - 1.0f / (1.0f + __expf(lb_param[1025 + c0] - lb_param[c0 + 1]));
            gsum0 = 0.f; gsum1 = 0.f;
            if (OUT && sc > 0) { const bf16_t* s0 = (const bf16_t*)S0 + (size_t)(bh * 32 + sc) * 16384;
#pragma unroll
                for (int vt = 0; vt < 8; ++vt) { const u32x2 w = *(const u32x2*)(s0 + (size_t)(vt * 16 + fr) * 128 + 16 * wave + fq * 4); S[vt] = (f32x4){bflo(w.x), bfhi(w.x), bflo(w.y), bfhi(w.y)}; }
            } else {
#pragma unroll
                for (int vt = 0; vt < 8; ++vt) S[vt] = (f32x4){0.f, 0.f, 0.f, 0.f};
            }
        }
        float kk0[8], kk1[8], lf0[8], lf1[8], q0[8], q1[8];
        {
            float c0 = 0.f, c1 = 0.f;
#pragma unroll
            for (int i = 0; i < 8; ++i) {
                kk0[i] = oml0 * __builtin_amdgcn_rcpf(1.0f + __expf(bflo(zr[i]))); kk1[i] = oml1 * __builtin_amdgcn_rcpf(1.0f + __expf(bfhi(zr[i])));
                c0 += __builtin_amdgcn_logf(1.0f - kk0[i]); c1 += __builtin_amdgcn_logf(1.0f - kk1[i]); lf0[i] = c0; lf1[i] = c1;
                if (OUT) { q0[i] = bflo(qr[i]) * 0.08838834764831845f; q1[i] = bfhi(qr[i]) * 0.08838834764831845f; }
            }
            *(LAS f32x2*)(seg_s + seg * 128 + 2 * cp) = (f32x2){c0, c1};
        }
        if (OUT) { gc0 = gn0; gc1 = gn1; }
        const u32x4 vcur0 = vr0, vcur1 = vr1;
        __syncthreads();
        { LAS u32x4* d = (LAS u32x4*)(L + HG_VR + tv * 272 + vc * 32); d[0] = vcur0; d[1] = vcur1; }
        { int idx2 = idx, ch2 = ch + 1; if (ch2 == 4) { ch2 = 0; idx2 = idx + X.G; } if (idx2 < ntask) HG_LOAD(idx2, ch2); }
        {
            f32x2 ss[8];
#pragma unroll
            for (int s = 0; s < 8; ++s) ss[s] = *(const LAS f32x2*)(seg_s + s * 128 + 2 * cp);
            float off0 = 0.f, off1 = 0.f;
#pragma unroll
            for (int s = 0; s < 8; ++s) { off0 += (s < seg) ? ss[s].x : 0.f; off1 += (s < seg) ? ss[s].y : 0.f; }
            const float R0 = (ss[0].x + ss[1].x) + (ss[2].x + ss[3].x), R1 = (ss[0].y + ss[1].y) + (ss[2].y + ss[3].y);
            if (!OUT && seg == 0) { gsum0 += R0 + (ss[4].x + ss[5].x) + (ss[6].x + ss[7].x); gsum1 += R1 + (ss[4].y + ss[5].y) + (ss[6].y + ss[7].y); }
#pragma unroll
            for (int i = 0; i < 8; ++i) {
                const float G0 = off0 + lf0[i], G1 = off1 + lf1[i];
                const float ka0 = kk0[i] * __builtin_amdgcn_exp2f(fminf(R0 - G0, 115.0f)), ka1 = kk1[i] * __builtin_amdgcn_exp2f(fminf(R1 - G1, 115.0f));
                *(LAS unsigned*)(L + HG_KA + (8 * seg + i) * 272 + 4 * cp) = pk2(ka0, ka1);
                if (OUT) { const float qa0 = q0[i] * __builtin_amdgcn_exp2f(fminf(G0 - R0, 115.0f)), qa1 = q1[i] * __builtin_amdgcn_exp2f(fminf(G1 - R1, 115.0f));
                           *(LAS unsigned*)(L + HG_QA + (8 * seg + i) * 272 + 4 * cp) = pk2(qa0, qa1); }
            }
        }
        float eR[4], eL[4];
        {
            f32x4 r4 = (f32x4){0.f, 0.f, 0.f, 0.f}, l4 = (f32x4){0.f, 0.f, 0.f, 0.f};
#pragma unroll
            for (int s = 0; s < 4; ++s) { r4 += *(const LAS f32x4*)(seg_s + s * 128 + 16 * wave + 4 * fq); l4 += *(const LAS f32x4*)(seg_s + (s + 4) * 128 + 16 * wave + 4 * fq); }
#pragma unroll
            for (int j = 0; j < 4; ++j) { eR[j] = __builtin_amdgcn_exp2f(fmaxf(r4[j], -115.0f)); eL[j] = __builtin_amdgcn_exp2f(l4[j]); }
        }
#pragma unroll
        for (int vt = 0; vt < 8; ++vt) {
#pragma unroll
            for (int j = 0; j < 4; ++j) S[vt][j] *= eR[j];
            if (OUT) { u32x2 w; w.x = pk2(S[vt][0], S[vt][1]); w.y = pk2(S[vt][2], S[vt][3]);
                       *(LAS u32x2*)(L + HG_SPT + (vt * 16 + fr) * 272 + (16 * wave + 4 * fq) * 2) = w; }
        }
        __syncthreads();
        if (OUT) {
#pragma unroll
            for (int q2 = 0; q2 < 2; ++q2) {
                const int st = 2 * wc + q2;
                f32x4 acc = (f32x4){0.f, 0.f, 0.f, 0.f};
                if (st <= wr) {
#pragma unroll
                    for (int kq = 0; kq < 4; ++kq) {
                        const bf16x8 af = *(const LAS bf16x8*)(L + HG_KA + (st * 16 + fr) * 272 + kq * 64 + fq * 16);
                        const bf16x8 bq = *(const LAS bf16x8*)(L + HG_QA + (wr * 16 + fr) * 272 + kq * 64 + fq * 16);
                        acc = __builtin_amdgcn_mfma_f32_16x16x32_bf16(af, bq, acc, 0, 0, 0);
                    }
                    const int tt = wr * 16 + fr;
#pragma unroll
                    for (int j = 0; j < 4; ++j) { const int s_ = st * 16 + fq * 4 + j; acc[j] = (s_ <= tt) ? acc[j] : 0.f; }
                }
                u32x2 w; w.x = pk2(acc[0], acc[1]); w.y = pk2(acc[2], acc[3]);
                *(LAS u32x2*)(L + HG_AB + (wr * 16 + fr) * 144 + (st * 16 + fq * 4) * 2) = w;
            }
        }
        {
            bf16x8 aK[2];
#pragma unroll
            for (int ks = 0; ks < 2; ++ks) aK[ks] = tr_frag(L + HG_KA, 272, ks, wave, lane);
#pragma unroll
            for (int vt = 0; vt < 8; ++vt) {
#pragma unroll
                for (int ks = 0; ks < 2; ++ks) { const bf16x8 bv = tr_frag(L + HG_VR, 272, ks, vt, lane); S[vt] = __builtin_amdgcn_mfma_f32_16x16x32_bf16(aK[ks], bv, S[vt], 0, 0, 0); }
#pragma unroll
                for (int j = 0; j < 4; ++j) S[vt][j] *= eL[j];
            }
        }
        if (OUT) {
            __syncthreads();
            bf16x8 aA[2], aQ[4];
#pragma unroll
            for (int ks = 0; ks < 2; ++ks) aA[ks] = *(const LAS bf16x8*)(L + HG_AB + (wr * 16 + fr) * 144 + ks * 64 + fq * 16);
#pragma unroll
            for (int kq = 0; kq < 4; ++kq) aQ[kq] = *(const LAS bf16x8*)(L + HG_QA + (wr * 16 + fr) * 272 + kq * 64 + fq * 16);
#pragma unroll
            for (int n = 0; n < 4; ++n) {
                const int vt = wc * 4 + n;
                f32x4 o = (f32x4){0.f, 0.f, 0.f, 0.f};
#pragma unroll
                for (int ks = 0; ks < 2; ++ks) { const bf16x8 bv = tr_frag(L + HG_VR, 272, ks, vt, lane); o = __builtin_amdgcn_mfma_f32_16x16x32_bf16(aA[ks], bv, o, 0, 0, 0); }
#pragma unroll
                for (int kq = 0; kq < 4; ++kq) { const bf16x8 bs = *(const LAS bf16x8*)(L + HG_SPT + (vt * 16 + fr) * 272 + kq * 64 + fq * 16); o = __builtin_amdgcn_mfma_f32_16x16x32_bf16(aQ[kq], bs, o, 0, 0, 0); }
#pragma unroll
                for (int j = 0; j < 4; ++j) *(LAS float*)(L + HG_O + (wr * 16 + fq * 4 + j) * 528 + (vt * 16 + fr) * 4) = o[j];
            }
            __syncthreads();
            {
                f32x4 ov[4]; float ssq = 0.f;
#pragma unroll
                for (int i = 0; i < 4; ++i) { ov[i] = *(const LAS f32x4*)(L + HG_O + tv * 528 + vc * 64 + i * 16); ssq += (ov[i].x * ov[i].x + ov[i].y * ov[i].y) + (ov[i].z * ov[i].z + ov[i].w * ov[i].w); }
                ssq += __shfl_xor(ssq, 1); ssq += __shfl_xor(ssq, 2); ssq += __shfl_xor(ssq, 4);
                const float rstd = rsqrtf(ssq * (1.0f / 128.0f) + EPS);
                const unsigned gw[8] = {gc0.x, gc0.y, gc0.z, gc0.w, gc1.x, gc1.y, gc1.z, gc1.w};
                unsigned ow[8]; float yv[16];
#pragma unroll
                for (int i = 0; i < 8; ++i) { const float g0 = bflo(gw[i]), g1 = bfhi(gw[i]);
                    const float y0 = ov[i >> 1][(2 * i) & 3] * rstd * ngv[2 * i] * g0 * __builtin_amdgcn_rcpf(1.0f + __expf(-g0));
                    const float y1 = ov[i >> 1][(2 * i + 1) & 3] * rstd * ngv[2 * i + 1] * g1 * __builtin_amdgcn_rcpf(1.0f + __expf(-g1));
                    ow[i] = pk2(y0, y1); yv[2 * i] = y0; yv[2 * i + 1] = y1; }
                if (MIX_FP8) { u32x4 o8; o8.x = cvt4_fp8(yv[0] * 16.0f, yv[1] * 16.0f, yv[2] * 16.0f, yv[3] * 16.0f); o8.y = cvt4_fp8(yv[4] * 16.0f, yv[5] * 16.0f, yv[6] * 16.0f, yv[7] * 16.0f);
                               o8.z = cvt4_fp8(yv[8] * 16.0f, yv[9] * 16.0f, yv[10] * 16.0f, yv[11] * 16.0f); o8.w = cvt4_fp8(yv[12] * 16.0f, yv[13] * 16.0f, yv[14] * 16.0f, yv[15] * 16.0f);
                               *(u32x4*)((unsigned char*)og + (size_t)(b * SEQ + sc * 256 + ch * 64 + tv) * (2 * D) + h * 128 + vc * 16) = o8; }
                else { u32x4* d = (u32x4*)(og + (size_t)(b * SEQ + sc * 256 + ch * 64 + tv) * (2 * D) + h * 128 + vc * 16);
                       d[0] = (u32x4){ow[0], ow[1], ow[2], ow[3]}; d[1] = (u32x4){ow[4], ow[5], ow[6], ow[7]}; }
            }
        }
        if (ch == 3) {
            if (!OUT) {
                bf16_t* ds = (bf16_t*)dS + (size_t)(bh * 32 + sc) * 16384;
#pragma unroll
                for (int vt = 0; vt < 8; ++vt) { u32x2 w; w.x = pk2(S[vt][0], S[vt][1]); w.y = pk2(S[vt][2], S[vt][3]); *(u32x2*)(ds + (size_t)(vt * 16 + fr) * 128 + 16 * wave + fq * 4) = w; }
                if (seg == 0) *(f32x2*)(Dd + (size_t)(bh * 32 + sc) * 128 + 2 * cp) = (f32x2){__builtin_amdgcn_exp2f(gsum0), __builtin_amdgcn_exp2f(gsum1)};
            }
            idx += X.G; ch = 0; if (idx >= ntask) break;
        } else ++ch;
    }
#undef HG_LOAD
    __syncthreads();
}

__device__ __forceinline__ void ph_hg2(const Ctx& X, const float* dS, const float* Dd, float* S0) {
    const bf16_t* dsb = (const bf16_t*)dS; bf16_t* s0b = (bf16_t*)S0;
    for (int idx = X.vcu * 512 + X.tid; idx < 32 * 4096; idx += X.G * 512) {
        const int bh = idx >> 12, e4 = (idx & 4095) * 4, k0 = e4 & 127;
        f32x4 s = (f32x4){0.f, 0.f, 0.f, 0.f};
#pragma unroll 8
        for (int sc = 0; sc < 31; ++sc) { const f32x4 d = *(const f32x4*)(Dd + (size_t)(bh * 32 + sc) * 128 + k0); const u32x2 w = *(const u32x2*)(dsb + (size_t)(bh * 32 + sc) * 16384 + e4);
            s = s * d + (f32x4){bflo(w.x), bfhi(w.x), bflo(w.y), bfhi(w.y)};
            u32x2 o; o.x = pk2(s.x, s.y); o.y = pk2(s.z, s.w); *(u32x2*)(s0b + (size_t)(bh * 32 + sc + 1) * 16384 + e4) = o; }
    }
}

__device__ __forceinline__ void ph_router_tables(const Ctx& X, const float* g_ffn, const float* mod, const float* w_router, const float* b_router, bf16_t* BpT, float* cb) {
    for (int i = X.vcu * 512 + X.tid; i < 4 * 32 * 1024; i += X.G * 512) { const int b = i >> 15, e = (i >> 10) & 31, k = i & 1023;
        const float v = g_ffn[k] * (1.0f + mod[(size_t)b * NMOD + 4 * D + k]) * w_router[k * 32 + e];
        const unsigned hi = pk2(v, 0.f) & 0xffffu; const float r1 = v - __uint_as_float(hi << 16);
        const unsigned mi = pk2(r1, 0.f) & 0xffffu; const float r2 = r1 - __uint_as_float(mi << 16);
        const unsigned lo = pk2(r2, 0.f) & 0xffffu;
        unsigned short* d = (unsigned short*)BpT + ((size_t)(b * 3) * 32 + e) * 1024 + k;
        d[0] = (unsigned short)hi; d[32 * 1024] = (unsigned short)mi; d[2 * 32 * 1024] = (unsigned short)lo; }
    const int gw = X.vcu * 8 + X.wave;
    if (gw < 128) { const int b = gw >> 5, e = gw & 31; float a = 0.f;
        for (int k = X.lane; k < 1024; k += 64) a += mod[(size_t)b * NMOD + 3 * D + k] * w_router[k * 32 + e];
        a = wave_sum(a); if (X.lane == 0) cb[gw] = a + b_router[e]; }
}

__device__ __forceinline__ void ph_route(const Ctx& X, const bf16_t* x1, const float* g_ffn, const float* mod, const bf16_t* BpT, const float* cb,
                                         unsigned char* h2, int* top_e, float* top_w, int* rank, int* hist_g) {
    LAS int* hist = (LAS int*)(X.lds + LDSCTL_OFF + 64);
    LAS unsigned char* L = X.lds;
    constexpr int RS = 1040;
    const int tid = X.tid, lane = X.lane, c = lane & 15, q = lane >> 4;
    for (int tile = X.vcu; tile < RT_NT; tile += X.G) {
        if (tid < 32) hist[tid] = 0;
        const int tw = tile * RT_TILE + X.wave * 16, b = tw / SEQ;
        const bf16_t* xa = x1 + (size_t)(tw + c) * D + 8 * q;
        f32x4 acc0 = (f32x4){0.f, 0.f, 0.f, 0.f}, acc1 = acc0, accS = acc0;
#pragma unroll 1
        for (int half = 0; half < 2; ++half) {
            bf16x8 a[16];
#pragma unroll
            for (int ks = 0; ks < 16; ++ks) a[ks] = *(const bf16x8*)(xa + 512 * half + 32 * ks);
            __syncthreads();
#pragma unroll
            for (int i = 0; i < 12; ++i) { const int id = tid + 512 * i, row = id >> 6, c16 = id & 63;
                const u32x4 v = *(const u32x4*)(BpT + ((size_t)(b * 96) + row) * 1024 + 512 * half + 8 * c16);
                *(LAS u32x4*)(L + row * RS + 16 * c16) = v; }
            __syncthreads();
#pragma unroll
            for (int ks = 0; ks < 16; ++ks) {
                bf16x8 bb[6];
#pragma unroll
                for (int j = 0; j < 6; ++j) bb[j] = *(const LAS bf16x8*)(L + (16 * j + c) * RS + 64 * ks + 16 * q);
                accS = __builtin_amdgcn_mfma_f32_16x16x32_bf16(a[ks], a[ks], accS, 0, 0, 0);
#pragma unroll
                for (int s_ = 2; s_ >= 0; --s_) { acc0 = __builtin_amdgcn_mfma_f32_16x16x32_bf16(a[ks], bb[2 * s_], acc0, 0, 0, 0); acc1 = __builtin_amdgcn_mfma_f32_16x16x32_bf16(a[ks], bb[2 * s_ + 1], acc1, 0, 0, 0); }
            }
        }
        const float dg = (c & 2) ? ((c & 1) ? accS[3] : accS[2]) : ((c & 1) ? accS[1] : accS[0]);
        const float ss = __shfl(dg, c + 16 * (c >> 2));
        const float rs = rsqrtf(ss * (1.0f / D) + EPS);
        const float cb0 = cb[b * 32 + c], cb1 = cb[b * 32 + 16 + c];
#pragma unroll
        for (int reg = 0; reg < 4; ++reg) {
            const float rt = __shfl(rs, 4 * q + reg);
            float v0 = acc0[reg] * rt + cb0, v1 = acc1[reg] * rt + cb1;
            float sv[4]; int si[4];
#pragma unroll
            for (int rnd = 0; rnd < 4; ++rnd) {
                float bvv = v0; int bi = c; if (v1 > bvv) { bvv = v1; bi = 16 + c; }
#pragma unroll
                for (int o = 1; o < 16; o <<= 1) { const float ov = __shfl_xor(bvv, o); const int oi = __shfl_xor(bi, o); if (ov > bvv || (ov == bvv && oi < bi)) { bvv = ov; bi = oi; } }
                sv[rnd] = bvv; si[rnd] = bi; if (bi == c) v0 = -INFINITY; if (bi == 16 + c) v1 = -INFINITY;
            }
            const float e1 = __expf(sv[1] - sv[0]), e2 = __expf(sv[2] - sv[0]), e3 = __expf(sv[3] - sv[0]);
            const float inv = 1.0f / (1.0f + e1 + e2 + e3);
            if (c == 0) { const int t = tw + 4 * q + reg;
                const float ww[4] = {inv, e1 * inv, e2 * inv, e3 * inv};
#pragma unroll
                for (int rnd = 0; rnd < 4; ++rnd) { top_e[t * 4 + rnd] = si[rnd]; top_w[t * 4 + rnd] = ww[rnd]; rank[t * 4 + rnd] = atomicAdd((int*)&hist[si[rnd]], 1); }
            }
        }
        const float* sh = mod + (size_t)b * NMOD + 3 * D; const float* sc = mod + (size_t)b * NMOD + 4 * D;
#pragma unroll 4
        for (int i = 0; i < 16; ++i) {
            const float r = __shfl(rs, i);
            const u32x2* xr = (const u32x2*)(x1 + (size_t)(tw + i) * D) + lane;
#pragma unroll
            for (int j = 0; j < 4; ++j) {
                const int col = 4 * (lane + 64 * j);
                const f32x4 gg = *(const f32x4*)(g_ffn + col), s1 = *(const f32x4*)(sc + col), s0 = *(const f32x4*)(sh + col);
                const u32x2 xw = xr[64 * j]; const f32x4 xv = (f32x4){bflo(xw.x), bfhi(xw.x), bflo(xw.y), bfhi(xw.y)};
                const f32x4 y = (xv * r * gg * (s1 + 1.0f) + s0) * 16.0f;
                *(unsigned*)(h2 + (size_t)(tw + i) * D + col) = cvt4_fp8(y.x, y.y, y.z, y.w);
            }
        }
        __syncthreads();
        if (tid < 32) hist_g[tile * 32 + tid] = hist[tid];
        __syncthreads();
    }
}

__device__ __forceinline__ void ph_sort(const Ctx& X, const int* hist_g, const int* top_e, const float* top_w, const int* rank, int* row_tok, float* row_w, int* pair_row, int* blk_e) {
    LAS int* s_hist = (LAS int*)X.lds;
    LAS int* s_tot = s_hist + RT_NT * 32; LAS int* s_pre = s_tot + 32; LAS int* s_base = s_pre + 32; LAS int* s_pstart = s_base + 32; LAS int* s_pend = s_pstart + 32;
    LAS int* s_ptot = s_pend + 32; LAS int* s_ppre = s_ptot + 16 * 32;
    const int tid = X.tid;
    for (int i = tid; i < RT_NT * 8; i += 512) ((LAS u32x4*)s_hist)[i] = ((const u32x4*)hist_g)[i];
    __syncthreads();
    for (int tile = X.vcu; tile < RT_NT; tile += X.G) {
        { const int e = tid & 31, part = tid >> 5; int tot = 0, pre = 0;
#pragma unroll 4
          for (int i = part * (RT_NT / 16); i < (part + 1) * (RT_NT / 16); ++i) { const int c = s_hist[i * 32 + e]; tot += c; pre += (i < tile) ? c : 0; }
          s_ptot[part * 32 + e] = tot; s_ppre[part * 32 + e] = pre; }
        __syncthreads();
        if (tid < 32) { int tot = 0, pre = 0;
#pragma unroll
            for (int k = 0; k < 16; ++k) { tot += s_ptot[k * 32 + tid]; pre += s_ppre[k * 32 + tid]; }
            const int padded = (tot + 255) / 256 * 256; int inc = padded;
#pragma unroll
            for (int o = 1; o < 32; o <<= 1) { const int v = __shfl_up(inc, o); if (tid >= o) inc += v; }
            s_tot[tid] = tot; s_pstart[tid] = inc - padded; s_base[tid] = inc - padded + pre; s_pend[tid] = inc; }
        __syncthreads();
        { const int i = tid; const int idx = tile * RT_TILE * 4 + i; const int e = top_e[idx]; const int row = s_base[e] + rank[idx];
          row_tok[row] = idx >> 2; row_w[row] = top_w[idx]; pair_row[idx] = row; }
        if (tile < 32) { const int e = tile; for (int r = s_pstart[e] + s_tot[e] + tid; r < s_pend[e]; r += 512) { row_tok[r] = 0; row_w[r] = 0.f; } }
        if (tile == 32) { for (int blk = tid; blk < NBLK_MAX; blk += 512) { int e = -1; const int r = blk * 256; for (int q = 0; q < 32; ++q) if (r >= s_pstart[q] && r < s_pend[q]) e = q; blk_e[blk] = e; }
                          if (tid == 0) blk_e[NBLK_MAX] = s_pend[31] / 256; }
        __syncthreads();
    }
}

__device__ __forceinline__ void ph_final(const Ctx& X, const bf16_t* x1, const unsigned char* y, const int* pair_row, const float* mod, const float* g_final, float* out, const float oscale) {
    const int lane = X.lane;
    for (int t = X.vcu * 8 + X.wave; t < T; t += X.G * 8) {
        const int b = t / SEQ;
        const u32x2* xr = (const u32x2*)(x1 + (size_t)t * D) + lane;
        const float* ga = mod + (size_t)b * NMOD + 5 * D;
        int rows[4];
#pragma unroll
        for (int k = 0; k < 4; ++k) rows[k] = pair_row[t * 4 + k];
        f32x4 v[4]; float ss = 0.f;
#pragma unroll
        for (int j = 0; j < 4; ++j) {
            const int col = 4 * (lane + 64 * j);
            f32x4 m = (f32x4){0.f, 0.f, 0.f, 0.f};
#pragma unroll
            for (int k = 0; k < 4; ++k) { const int w = *(const int*)(y + (size_t)rows[k] * D + col); const f32x2 lo = __builtin_amdgcn_cvt_pk_f32_fp8(w, false), hi = __builtin_amdgcn_cvt_pk_f32_fp8(w, true); m.x += lo.x; m.y += lo.y; m.z += hi.x; m.w += hi.y; }
            const u32x2 xw = xr[64 * j];
            v[j] = (f32x4){bflo(xw.x), bfhi(xw.x), bflo(xw.y), bfhi(xw.y)} + *(const f32x4*)(ga + col) * (m * (1.0f / 32.0f));
            ss += (v[j].x * v[j].x + v[j].y * v[j].y) + (v[j].z * v[j].z + v[j].w * v[j].w);
        }
        const float r = rsqrtf(wave_sum(ss) * (1.0f / D) + EPS);
#pragma unroll
        for (int j = 0; j < 4; ++j) { const int col = 4 * (lane + 64 * j); *(f32x4*)(out + (size_t)t * D + col) = v[j] * (r * oscale) * *(const f32x4*)(g_final + col); }
    }
}

constexpr int N_PHASES = 13;
struct Args { const float* in[23]; float* out; unsigned char* ws; int ph_lo, ph_hi; };
__global__ void __launch_bounds__(512, 2) fwd(Args a) {
    extern __shared__ __attribute__((aligned(16))) unsigned char lds_raw[];
    Ctx X; X.lds = (LAS unsigned char*)lds_raw; X.tid = threadIdx.x; X.lane = X.tid & 63; X.wave = __builtin_amdgcn_readfirstlane(X.tid >> 6);
    X.G = gridDim.x; { const int bx = blockIdx.x; X.vcu = (X.G % 8 == 0) ? (bx % 8) * (X.G / 8) + bx / 8 : bx; }
    unsigned char* ws = a.ws;
    for (int u = X.tid; u < (LDS_BYTES - LDSCTL_OFF) / 4; u += 512) ((LAS unsigned*)(X.lds + LDSCTL_OFF))[u] = 0u;
    __syncthreads();
    XcdBarrier bar = xcd_barrier_post((unsigned*)(ws + WS_CTL) + CW_BAR, (volatile LAS unsigned*)(X.lds + LDSCTL_OFF), X.tid == 0);
    const int lo = a.ph_lo, hi = a.ph_hi; float probe_scale = 1.0f;
#define IN(k) (lo <= (k) && (k) < hi)
#define SEAM(k) do { if (IN(k) && IN((k) + 1)) xcd_barrier(bar, X.wave == 0 && (int)__builtin_amdgcn_mbcnt_hi(~0u, __builtin_amdgcn_mbcnt_lo(~0u, 0u)) == 0); } while (0)
#ifdef PROBE_PH
    unsigned long long* stamps = (unsigned long long*)(ws + WS_CTL + 32768);
    if (blockIdx.x == 0 && X.tid == 0) stamps[0] = __builtin_amdgcn_s_memrealtime();
#undef SEAM
#define SEAM(k) do { if (IN(k) && IN((k) + 1)) { xcd_barrier(bar, X.wave == 0 && (int)__builtin_amdgcn_mbcnt_hi(~0u, __builtin_amdgcn_mbcnt_lo(~0u, 0u)) == 0); \
        if (blockIdx.x == 0 && X.wave == 0 && (int)__builtin_amdgcn_mbcnt_hi(~0u, __builtin_amdgcn_mbcnt_lo(~0u, 0u)) == 0) stamps[(k) + 1] = __builtin_amdgcn_s_memrealtime(); } } while (0)
#endif
    const float* x = a.in[0]; const float* c = a.in[1]; const float* w_ada = a.in[2]; const float* b_ada = a.in[3];
    const float* g_mix = a.in[4]; const float* w_in = a.in[5]; const float* conv_dw = a.in[6]; const float* conv_dwb = a.in[7];
    const float* conv_ln_g = a.in[8]; const float* conv_ln_b = a.in[9]; const float* w_conv_out = a.in[10]; const float* lb_param = a.in[11];
    const float* hgrn_norm_g = a.in[12]; const float* w_hgrn_out = a.in[13]; const float* w_out = a.in[14]; const float* g_ffn = a.in[15];
    const float* w_router = a.in[16]; const float* b_router = a.in[17]; const float* w1 = a.in[18]; const float* b1 = a.in[19];
    const float* w2 = a.in[20]; const float* b2 = a.in[21]; const float* g_final = a.in[22];
    float* mod = (float*)(ws + WS_MOD); bf16_t* rt_bp = (bf16_t*)(ws + WS_WH);     float* rt_cb = (float*)(ws + WS_CB);
    int* hist_g = (int*)(ws + WS_HIST); int* blk_e = (int*)(ws + WS_BLKE); int* top_e = (int*)(ws + WS_TOPE); float* top_w = (float*)(ws + WS_TOPW);
    int* rank = (int*)(ws + WS_RANK); int* pair_row = (int*)(ws + WS_PROW); int* row_tok = (int*)(ws + WS_RTOK); float* row_w = (float*)(ws + WS_RW);
    bf16_t* p = (bf16_t*)(ws + WS_P);
    bf16_t* h = (bf16_t*)(ws + WS_E); unsigned char* h8 = ws + WS_E + 64 * MiB; float* tmp = (float*)(ws + WS_E);
    float* hg_dS = (float*)(ws + WS_E); float* hg_S0 = (float*)(ws + WS_E + 64 * MiB); float* hg_D = (float*)(ws + WS_HGD);
    bf16_t* uc = (bf16_t*)(ws + WS_D); bf16_t* og = MIX_FP8 ? (bf16_t*)((unsigned char*)uc + D) : uc + D;   bf16_t* x1 = (bf16_t*)(ws + WS_D);
    bf16_t* merged = p;
    unsigned char* h2 = (unsigned char*)p;
    unsigned char* act = (unsigned char*)(p + PG);
    unsigned char* y = (unsigned char*)(p + PG) + (size_t)R_PAD * D;
    PG8_LAS unsigned char* ring = (PG8_LAS unsigned char*)lds_raw;

#ifndef REPMASK
#define REPMASK 0
#endif
#ifndef REPN
#define REPN 1
#endif
#define PH(k, ...) do { if (IN(k)) { _Pragma("unroll 1") for (int rep_ = 0; rep_ < ((((REPMASK) >> (k)) & 1) ? 1 + REPN : 1); ++rep_) { if (rep_) __syncthreads(); { int ln_ = (int)__builtin_amdgcn_mbcnt_hi(~0u, __builtin_amdgcn_mbcnt_lo(~0u, 0u)); asm volatile("" : "+v"(ln_)); X.lane = ln_; X.tid = X.wave * 64 + ln_; } __VA_ARGS__ } } SEAM(k); } while (0)
    PH(0, ph_prologue<0>(X, c, w_ada, b_ada, mod, w_in, w_conv_out, w_hgrn_out, w_out, w1, w2, ws); if (P_INT8) ph_win_i8(X, w_in, ws););
    PH(1, ph_norm_mod(X, x, g_mix, mod, 0, D, h, h8, (float*)(ws + WS_HSC)); ph_router_tables(X, g_ffn, mod, w_router, b_router, rt_bp, rt_cb););
#ifndef STAGGER_TICKS
#define STAGGER_TICKS 0
#endif
    PH(2, { if (STAGGER_TICKS) { const unsigned long long t0_ = __builtin_amdgcn_s_memrealtime(), wait_ = (unsigned long long)(X.vcu & 3) * STAGGER_TICKS;
                while (__builtin_amdgcn_s_memrealtime() - t0_ < wait_) __builtin_amdgcn_s_sleep(8); }
        if (P_INT8) { pg8::Gemm g{(const bf16_t*)h8, (const bf16_t*)(ws + WS_WIN8), T, 8 * D, D / 2}; pg8::StaticOrder S; S.init(T, 8 * D, X.G, (int)blockIdx.x);
            pg8::EpiSplitBf16<true> E{p, PG, 0x3cu, SEQ, 1.0f, (const float*)(ws + WS_HSC), (const float*)(ws + WS_WSC)}; pg8::gemm_phase<pg8::EpiSplitBf16<true>, pg8::StaticOrder, true, true, false, 2>(ring, g, S, E, X.wave); }
        else {
        constexpr unsigned m8 = P_FP8_MASK; constexpr int n8 = __builtin_popcount(m8);
        if (n8 > 0) { pg8::Gemm g{(const bf16_t*)h8, (const bf16_t*)(ws + WS_WIN8), T, 8 * D, D / 2}; pg8::MaskOrder S; S.base.init(T, n8 * 256, X.G, (int)blockIdx.x); S.mask = m8;
            pg8::EpiSplitBf16<false> E{p, PG, 0x3cu, SEQ, 1.0f / 4096.0f, nullptr, nullptr}; pg8::gemm_phase<pg8::EpiSplitBf16<false>, pg8::MaskOrder, true, true, false, 1>(ring, g, S, E, X.wave); }
        if (n8 < 32) { pg8::Gemm g{h, (const bf16_t*)(ws + WS_WIN), T, 8 * D, D}; pg8::MaskOrder S; S.base.init(T, (32 - n8) * 256, X.G, (int)blockIdx.x); S.mask = ~m8;
            pg8::EpiSplitBf16<false> E{p, PG, 0x3cu, SEQ, 1.0f, nullptr, nullptr}; pg8::gemm_phase<pg8::EpiSplitBf16<false>, pg8::MaskOrder, true, true>(ring, g, S, E, X.wave); } } });
    PH(3, ph_conv(X, p + 0 * PG, conv_dw, conv_dwb, conv_ln_g, conv_ln_b, uc);
          if ((REPMASK >> 14) & 1) { __syncthreads(); ph_conv(X, p + 0 * PG, conv_dw, conv_dwb, conv_ln_g, conv_ln_b, uc); }
          ph_hgrn<false>(X, 31 * 32, p + 2 * PG, p + 3 * PG, p + 4 * PG, p + 5 * PG, lb_param, nullptr, nullptr, hg_dS, hg_D, nullptr);
          if ((REPMASK >> 15) & 1) { __syncthreads(); ph_hgrn<false>(X, 31 * 32, p + 2 * PG, p + 3 * PG, p + 4 * PG, p + 5 * PG, lb_param, nullptr, nullptr, hg_dS, hg_D, nullptr); });
    PH(4, ph_hg2(X, hg_dS, hg_D, hg_S0););
    PH(5, if ((X.vcu & 1) == 0) ph_prologue<1>(X, c, w_ada, b_ada, mod, w_in, w_conv_out, w_hgrn_out, w_out, w1, w2, ws);
          ph_hgrn<true>(X, 32 * 32, p + 2 * PG, p + 3 * PG, p + 4 * PG, p + 5 * PG, lb_param, hgrn_norm_g, hg_S0, nullptr, nullptr, og);
          if ((X.vcu & 1) != 0) ph_prologue<1>(X, c, w_ada, b_ada, mod, w_in, w_conv_out, w_hgrn_out, w_out, w1, w2, ws););
    PH(6, { if (MIX_FP8) { pg8::Gemm g{uc, (const bf16_t*)(ws + WS_WC), T, D, D}; pg8::StaticOrder S; S.init(T, D, X.G, (int)blockIdx.x);
              pg8::EpiGateFused<RES_FP8 != 0> E{p + 6 * PG, p + 7 * PG, merged, 1.0f / 4096.0f}; pg8::gemm_phase<pg8::EpiGateFused<RES_FP8 != 0>, pg8::StaticOrder, true, true, false, 1>(ring, g, S, E, X.wave); }
            else { pg8::Gemm g{uc, (const bf16_t*)(ws + WS_WC), T, D, 2 * D}; pg8::StaticOrder S; S.init(T, D, X.G, (int)blockIdx.x);
              pg8::EpiGateFused<RES_FP8 != 0> E{p + 6 * PG, p + 7 * PG, merged, 1.0f}; pg8::gemm_phase<pg8::EpiGateFused<RES_FP8 != 0>, pg8::StaticOrder, true, true>(ring, g, S, E, X.wave); } });
    PH(7, { if (RES_FP8) { pg8::Gemm g{merged, (const bf16_t*)(ws + WS_WO), T, D, D / 2}; pg8::StaticOrder S; S.init(T, D, X.G, (int)blockIdx.x);
              pg8::EpiRes E{x, mod + 2 * D, x1, NMOD, SEQ, 1.0f / 8192.0f}; pg8::gemm_phase<pg8::EpiRes, pg8::StaticOrder, true, true, false, 1>(ring, g, S, E, X.wave); }
            else { pg8::Gemm g{merged, (const bf16_t*)(ws + WS_WO), T, D, D}; pg8::StaticOrder S; S.init(T, D, X.G, (int)blockIdx.x);
              pg8::EpiRes E{x, mod + 2 * D, x1, NMOD, SEQ, 1.0f}; pg8::gemm_phase<pg8::EpiRes, pg8::StaticOrder, true, true>(ring, g, S, E, X.wave); } });
    PH(8, ph_route(X, x1, g_ffn, mod, rt_bp, rt_cb, h2, top_e, top_w, rank, hist_g););
    PH(9, ph_sort(X, hist_g, top_e, top_w, rank, row_tok, row_w, pair_row, blk_e););
    PH(10, { const int nblk = blk_e[NBLK_MAX]; pg8::Gemm g{(const bf16_t*)h2, (const bf16_t*)(ws + WS_W1), T, 32 * 2048, D / 2}; pg8::MoeOrder S{blk_e, nblk, X.G, (int)blockIdx.x, 3};
        LAS unsigned short* gt = (LAS unsigned short*)(X.lds + LDSCTL_OFF + 256);
        _Pragma("unroll 1") for (int i = 0; i < 23; ++i) { pg8::Unit u; if (!S.next(i, u)) break; if (X.tid < 256) gt[256 * i + X.tid] = (unsigned short)row_tok[u.pm * 256 + X.tid]; }
        __syncthreads();
        pg8::EpiSwiglu8 E{b1, act, 1.0f / 4096.0f}; pg8::gemm_phase<pg8::EpiSwiglu8, pg8::MoeOrder, true, true, true, true>(ring, g, S, E, X.wave, (const PG8_LAS unsigned short*)gt); });
    PH(11, { const int nblk = blk_e[NBLK_MAX]; pg8::Gemm g{(const bf16_t*)act, (const bf16_t*)(ws + WS_W2), R_PAD, 32 * 1024, DFF / 2}; pg8::MoeOrder S{blk_e, nblk, X.G, (int)blockIdx.x, 2};
        pg8::EpiY8 E{b2, row_w, y, 1.0f / 1024.0f}; pg8::gemm_phase<pg8::EpiY8, pg8::MoeOrder, true, true, false, true>(ring, g, S, E, X.wave); });
#ifdef PROBE_PH
    { const unsigned long long* st_ = (const unsigned long long*)(ws + WS_CTL + 32768); const float dt_ = (float)(long long)(st_[PROBE_PH + 1] - st_[PROBE_PH]);
      probe_scale = 1.0f + dt_ * (1.0f / 200000.0f); }
#endif
    PH(12, ph_final(X, x1, y, pair_row, mod, g_final, a.out, probe_scale););
#undef PH
#undef IN
#undef SEAM
}

#ifndef MK_N_LAUNCHES
#define MK_N_LAUNCHES 1
#endif
extern "C" void kernel_launch(void* const* d_in, const int* in_sizes, int n_in, void* d_out, int out_size, void* d_ws, size_t ws_size, hipStream_t stream) {
    static int grid = 0;
    if (grid == 0) {
        if (n_in != 23 || out_size != T * D || ws_size < WS_END) { fprintf(stderr, "kernel_launch: unexpected n_in %d / out_size %d / ws_size %zu (< %zu); nothing launched\n", n_in, out_size, ws_size, (size_t)WS_END); grid = -1; return; }
        int dev = 0, cus = 0, per_cu = 0;
        if (hipGetDevice(&dev) != hipSuccess || hipDeviceGetAttribute(&cus, hipDeviceAttributeMultiprocessorCount, dev) != hipSuccess) { grid = -1; return; }
        if (hipFuncSetAttribute((const void*)fwd, hipFuncAttributeMaxDynamicSharedMemorySize, LDS_BYTES) != hipSuccess) { fprintf(stderr, "kernel_launch: hipFuncSetAttribute failed\n"); grid = -1; return; }
        if (hipOccupancyMaxActiveBlocksPerMultiprocessor(&per_cu, (const void*)fwd, 512, LDS_BYTES) != hipSuccess || per_cu < 1) { fprintf(stderr, "kernel_launch: occupancy query says %d blocks per CU\n", per_cu); }
        (void)hipGetLastError();
        grid = cus;
    }
    if (grid < 0) return;
    if (hipMemsetAsync((char*)d_ws + WS_CTL, 0, CTL_ZERO_BYTES, stream) != hipSuccess) return;
    Args a{};
    for (int i = 0; i < 23; ++i) a.in[i] = (const float*)d_in[i];
    a.out = (float*)d_out; a.ws = (unsigned char*)d_ws;
    if (MK_N_LAUNCHES == 1) { a.ph_lo = 0; a.ph_hi = N_PHASES; hipLaunchKernelGGL(fwd, dim3(grid), dim3(512), LDS_BYTES, stream, a); }
    else for (int ph = 0; ph < N_PHASES; ++ph) { a.ph_lo = ph; a.ph_hi = ph + 1; hipLaunchKernelGGL(fwd, dim3(grid), dim3(512), LDS_BYTES, stream, a); }
}
```

```cpp
#include <hip/hip_runtime.h>
#include <stdint.h>
#include <stdio.h>

#define GAS __attribute__((address_space(1)))
#define LAS __attribute__((address_space(3)))
typedef unsigned short bf16_t;
typedef unsigned u32x4 __attribute__((ext_vector_type(4)));
typedef unsigned u32x2 __attribute__((ext_vector_type(2)));
typedef float f32x4 __attribute__((ext_vector_type(4)));

constexpr int D = 1024, NBATCH = 4, SEQ = 8192, T = NBATCH * SEQ;
constexpr int NE = 32, DFF = 1024;
constexpr int NMOD = 6 * D;
constexpr int NBLK_MAX = 544, R_PAD = NBLK_MAX * 256;
constexpr int RT_TILE = 128, RT_NT = T / RT_TILE;
constexpr float EPS = 1e-6f;

constexpr size_t MiB = 1u << 20;
constexpr size_t WS_CTL = 0, CTL_ZERO_BYTES = 64 * 1024;
constexpr size_t WS_MOD = 1 * MiB;
constexpr size_t WS_CB = WS_MOD + 112 * 1024, WS_BP = WS_MOD + 128 * 1024;
constexpr size_t WS_HSC = WS_MOD + 704 * 1024, WS_WSC = WS_MOD + 840 * 1024;
constexpr size_t WS_HIST = 2 * MiB;
constexpr size_t WS_BLKE = WS_HIST + 64 * 1024;
constexpr size_t WS_TOPE = 3 * MiB;
constexpr size_t WS_TOPW = WS_TOPE + 512 * 1024;
constexpr size_t WS_RANK = WS_TOPW + 512 * 1024;
constexpr size_t WS_PROW = WS_RANK + 512 * 1024;
constexpr size_t WS_RTOK = 5 * MiB;
constexpr size_t WS_RW = 6 * MiB;
constexpr size_t WS_HGD = 7 * MiB;
constexpr size_t WS_WT = 8 * MiB;
constexpr size_t WS_WIN = WS_WT, WS_WC = WS_WT + 16 * MiB, WS_WH = WS_WT + 18 * MiB, WS_WO = WS_WT + 20 * MiB, WS_W1 = WS_WT + 22 * MiB, WS_WIN8 = WS_WT + 96 * MiB  , WS_W2 = WS_WT + 150 * MiB;
constexpr size_t WS_P = 224 * MiB;
constexpr size_t WS_E = WS_P + 512 * MiB;
constexpr size_t WS_D = WS_E + 128 * MiB;
constexpr size_t WS_END = WS_D + 128 * MiB;
constexpr size_t PG = (size_t)T * D;
constexpr int CW_BAR = 0;

constexpr int RING_BYTES = 135168, LDSCTL_OFF = RING_BYTES, LDS_BYTES = 147456;

__device__ __forceinline__ unsigned f2bf(float f) { unsigned u = __builtin_bit_cast(unsigned, f); return (u + 0x7fffu + ((u >> 16) & 1u)) >> 16; }
typedef __bf16 bf16x2_hw __attribute__((ext_vector_type(2)));
__device__ __forceinline__ unsigned pk2(float lo, float hi) { const bf16x2_hw v = {(__bf16)lo, (__bf16)hi}; return __builtin_bit_cast(unsigned, v); }
__device__ __forceinline__ float bf2f(unsigned b) { return __builtin_bit_cast(float, b << 16); }
__device__ __forceinline__ float bflo(unsigned w) { return __builtin_bit_cast(float, w << 16); }
__device__ __forceinline__ float bfhi(unsigned w) { return __builtin_bit_cast(float, w & 0xffff0000u); }
__device__ __forceinline__ float sigmoidf_(float x) { return __builtin_amdgcn_rcpf(1.0f + __expf(-x)); }
__device__ __forceinline__ float wave_sum(float v) {
#pragma unroll
    for (int o = 1; o < 64; o <<= 1) v += __shfl_xor(v, o);
    return v;
}
__device__ __forceinline__ unsigned cvt4_fp8(float a, float b, float c, float d) {
    a = fminf(fmaxf(a, -448.f), 448.f); b = fminf(fmaxf(b, -448.f), 448.f); c = fminf(fmaxf(c, -448.f), 448.f); d = fminf(fmaxf(d, -448.f), 448.f);
    int w = 0; w = __builtin_amdgcn_cvt_pk_fp8_f32(a, b, w, false); w = __builtin_amdgcn_cvt_pk_fp8_f32(c, d, w, true); return (unsigned)w; }
__device__ __forceinline__ unsigned q4_i8(float a, float b, float c, float d) {
    const int ia = (int)__builtin_rintf(a), ib = (int)__builtin_rintf(b), ic = (int)__builtin_rintf(c), id = (int)__builtin_rintf(d);
    return (unsigned)(ia & 255) | ((unsigned)(ib & 255) << 8) | ((unsigned)(ic & 255) << 16) | ((unsigned)id << 24); }
#define LDS_WAIT() asm volatile("s_waitcnt lgkmcnt(0)" ::: "memory")
#define VM_WAIT() asm volatile("s_waitcnt vmcnt(0)" ::: "memory")

namespace pg8 {
#define PG8_LAS __attribute__((address_space(3)))
typedef unsigned short bf16_t;
typedef short bf16x8 __attribute__((ext_vector_type(8)));
typedef float f32x4 __attribute__((ext_vector_type(4)));
typedef unsigned u32x4 __attribute__((ext_vector_type(4)));
constexpr int BM = 256, BK = 64, HALF = 128, HTB = HALF * BK * 2  , STAGE_BYTES = 8 * HTB, NXCD = 8, WGM = 8;

__host__ __device__ __forceinline__ int lds_byte(int r, int c) { const int st = (r >> 4) * 2 + (c >> 5), rr = r & 15, cc = c & 31, ob = rr * 64 + cc * 2; return st * 1024 + (ob ^ (((ob >> 9) & 1) << 5)); }
__host__ __device__ __forceinline__ void stage_rc(int b, int& R, int& C) { const int st = b / 1024, sb = b % 1024, swz = sb ^ (((sb >> 9) & 1) << 5); R = (st >> 1) * 16 + swz / 64; C = (st & 1) * 32 + (swz % 64) / 2; }
__host__ __device__ __forceinline__ int perm32(int rho) { const int n = rho >> 4, i = rho & 15; return 8 * (i >> 2) + 4 * n + (i & 3); }

struct Unit { int pm, pn; };
struct Gemm { const bf16_t* A; const bf16_t* Bt; int M, N, K; };

struct StaticOrder {
    int nM, nN, nwg, G, c;
    __host__ __device__ void init(int M, int N, int G_, int c_) { nM = M / BM; nN = N / BM; nwg = nM * nN; G = G_; c = c_; }
    __host__ __device__ bool next(int i, Unit& u) const {
        const long L = (long)i * G + c; if (L >= nwg) return false;
        int wgid = (int)L; { const int q = nwg / NXCD, r = nwg % NXCD, xcd = wgid % NXCD, off = wgid / NXCD; wgid = (xcd < r ? xcd * (q + 1) : r * (q + 1) + (xcd - r) * q) + off; }
        const int nig = WGM * nN, gid = wgid / nig, fm = gid * WGM, gsz = (nM - fm) < WGM ? (nM - fm) : WGM;
        u.pm = fm + ((wgid % nig) % gsz); u.pn = (wgid % nig) / gsz; return true;
    }
    __device__ __forceinline__ void a_ready(const Unit&) const {}
    __device__ __forceinline__ void done(const Unit&) const {}
};


struct MaskOrder {
    StaticOrder base; unsigned mask;
    __device__ __forceinline__ bool next(int i, Unit& u) const {
        if (!base.next(i, u)) return false;
        unsigned m = mask; for (int k = 0; k < u.pn; ++k) m &= m - 1;
        u.pn = __builtin_ctz(m); return true;
    }
    __device__ __forceinline__ void a_ready(const Unit&) const {}
    __device__ __forceinline__ void done(const Unit&) const {}
};
struct MoeOrder {
    const int* blk_e; int nblk, G, c, lg;
    __device__ __forceinline__ bool next(int i, Unit& u) const {
        int blk, j;
        if (G == 256) { const int xcd = c & 7, idx = c >> 3, prb = 256 >> lg; blk = i * prb + xcd * (prb >> 3) + (idx >> lg); j = idx & ((1 << lg) - 1); }
        else { const long L = (long)i * G + c; blk = (int)(L >> lg); j = (int)(L & ((1 << lg) - 1)); }
        if (blk >= nblk) return false;
        const int e = blk_e[blk]; u.pm = blk; u.pn = (e << lg) + j; return true;
    }
    __device__ __forceinline__ void a_ready(const Unit&) const {}
    __device__ __forceinline__ void done(const Unit&) const {}
};

__device__ __forceinline__ unsigned cvt_pk_bf16(float lo, float hi) { unsigned r; asm volatile("v_cvt_pk_bf16_f32 %0, %1, %2" : "=v"(r) : "v"(lo), "v"(hi)); return r; }
__device__ __forceinline__ float sigm(float x) { return __builtin_amdgcn_rcpf(1.0f + __expf(-x)); }
__device__ __forceinline__ float blo(unsigned w) { return __builtin_bit_cast(float, w << 16); }
__device__ __forceinline__ float bhi(unsigned w) { return __builtin_bit_cast(float, w & 0xffff0000u); }

template <bool I8> struct EpiSplitBf16 {
    static constexpr bool PERM = true, AFTER_DRAIN = false;
    bf16_t* O; size_t split_stride; unsigned hm_mask; int seq; float dq;
    const float* rs; const float* cs;
    __device__ __forceinline__ void operator()(const f32x4 (&acc)[2][2][4][2], const Unit& u, int wr, int wc, int fr, int fq) const {
        const int row0 = u.pm * BM + wr * 64 + fr; const int colt = u.pn * BM; const int t = colt >> 10;
        f32x4 cv[2][2]; float rv[2][4];
#pragma unroll
        for (int bj = 0; bj < 2; ++bj)
#pragma unroll
            for (int n = 0; n < 2; ++n) cv[bj][n] = I8 ? *(const f32x4*)(cs + colt + bj * HALF + wc * 32 + 8 * fq + 4 * n) : (f32x4){dq, dq, dq, dq};
#pragma unroll
        for (int ai = 0; ai < 2; ++ai)
#pragma unroll
            for (int m = 0; m < 4; ++m) rv[ai][m] = I8 ? rs[row0 + ai * HALF + m * 16] : 1.0f;
#define PG8_DEQ(ai, bj, m, n) (acc[ai][bj][m][n] * cv[bj][n] * rv[ai][m])
        if (u.pn < 8) {
#pragma unroll
            for (int ai = 0; ai < 2; ++ai)
#pragma unroll
                for (int m = 0; m < 4; ++m) { const int row = row0 + ai * HALF + m * 16; float r[8];
                    const f32x4 a0 = PG8_DEQ(ai, 0, m, 0), a1 = PG8_DEQ(ai, 0, m, 1), b0 = PG8_DEQ(ai, 1, m, 0), b1 = PG8_DEQ(ai, 1, m, 1);
#pragma unroll
                    for (int q = 0; q < 4; ++q) { r[q] = a0[q] * sigm(b0[q]); r[4 + q] = a1[q] * sigm(b1[q]); }
                    u32x4 w; w.x = cvt_pk_bf16(r[0], r[1]); w.y = cvt_pk_bf16(r[2], r[3]); w.z = cvt_pk_bf16(r[4], r[5]); w.w = cvt_pk_bf16(r[6], r[7]);
                    __builtin_nontemporal_store(w, (u32x4*)(O + (size_t)row * 1024 + 128 * u.pn + wc * 32 + 8 * fq)); }
            return;
        }
        bf16_t* base = O + (size_t)t * split_stride; const int cg = colt & 1023;
        const bool hm = (hm_mask >> t) & 1u;
        const int bb = (u.pm * BM) / seq;
#pragma unroll
        for (int ai = 0; ai < 2; ++ai)
#pragma unroll
            for (int m = 0; m < 4; ++m) { const int row = row0 + ai * HALF + m * 16;
#pragma unroll
                for (int bj = 0; bj < 2; ++bj) { const f32x4 v0 = PG8_DEQ(ai, bj, m, 0), v1 = PG8_DEQ(ai, bj, m, 1);
                    u32x4 w; w.x = cvt_pk_bf16(v0[0], v0[1]); w.y = cvt_pk_bf16(v0[2], v0[3]); w.z = cvt_pk_bf16(v1[0], v1[1]); w.w = cvt_pk_bf16(v1[2], v1[3]);
                    const size_t o = hm ? ((size_t)(bb * 8 + (cg >> 7) + bj) * seq + (row - bb * seq)) * 128 + wc * 32 + 8 * fq
                                        : (size_t)row * 1024 + cg + bj * HALF + wc * 32 + 8 * fq;
                    __builtin_nontemporal_store(w, (u32x4*)(base + o)); } }
#undef PG8_DEQ
    }
};
struct EpiRes {
    static constexpr bool PERM = true, AFTER_DRAIN = false;
    const float* x; const float* ga; bf16_t* out; int mod_pitch, seq; float dq;
    __device__ __forceinline__ void operator()(const f32x4 (&acc)[2][2][4][2], const Unit& u, int wr, int wc, int fr, int fq) const {
        const int row0 = u.pm * BM + wr * 64 + fr, col0 = u.pn * BM + wc * 32 + 8 * fq;
        const float* gab = ga + (size_t)((u.pm * BM) / seq) * mod_pitch + col0;
        f32x4 gv[2][2];
#pragma unroll
        for (int bj = 0; bj < 2; ++bj)
#pragma unroll
            for (int n = 0; n < 2; ++n) gv[bj][n] = *(const f32x4*)(gab + bj * HALF + 4 * n) * dq;
#pragma unroll
        for (int ai = 0; ai < 2; ++ai) {
            f32x4 xv[4][2][2];
#pragma unroll
            for (int m = 0; m < 4; ++m)
#pragma unroll
                for (int bj = 0; bj < 2; ++bj) { const float* xp = x + (size_t)(row0 + ai * HALF + m * 16) * 1024 + col0 + bj * HALF; xv[m][bj][0] = *(const f32x4*)xp; xv[m][bj][1] = *(const f32x4*)(xp + 4); }
#pragma unroll
            for (int m = 0; m < 4; ++m) { const size_t o = (size_t)(row0 + ai * HALF + m * 16) * 1024 + col0;
#pragma unroll
                for (int bj = 0; bj < 2; ++bj) {
                    const f32x4 v0 = xv[m][bj][0] + gv[bj][0] * acc[ai][bj][m][0], v1 = xv[m][bj][1] + gv[bj][1] * acc[ai][bj][m][1];
                    u32x4 w; w.x = cvt_pk_bf16(v0[0], v0[1]); w.y = cvt_pk_bf16(v0[2], v0[3]); w.z = cvt_pk_bf16(v1[0], v1[1]); w.w = cvt_pk_bf16(v1[2], v1[3]);
                    *(u32x4*)(out + o + bj * HALF) = w; } }
        }
    }
};
struct EpiSwiglu8 {
    static constexpr bool PERM = true, AFTER_DRAIN = false;
    const float* b1; unsigned char* act; float dq;
    __device__ __forceinline__ void operator()(const f32x4 (&acc)[2][2][4][2], const Unit& u, int wr, int wc, int fr, int fq) const {
        const int e = u.pn >> 3, j = u.pn & 7; const int row0 = u.pm * BM + wr * 64 + fr, f0 = 128 * j + wc * 32 + 8 * fq;
        const float* be = b1 + (size_t)e * 2048 + f0;
        const f32x4 bg0 = *(const f32x4*)(be), bg1 = *(const f32x4*)(be + 4), bl0 = *(const f32x4*)(be + 1024), bl1 = *(const f32x4*)(be + 1028);
#pragma unroll
        for (int ai = 0; ai < 2; ++ai)
#pragma unroll
            for (int m = 0; m < 4; ++m) {
                f32x4 g0 = acc[ai][0][m][0] * dq + bg0, g1 = acc[ai][0][m][1] * dq + bg1, l0 = acc[ai][1][m][0] * dq + bl0, l1 = acc[ai][1][m][1] * dq + bl1;
                float r[8];
#pragma unroll
                for (int q = 0; q < 4; ++q) { float gl = fminf(g0[q], 7.0f), li = fminf(fmaxf(l0[q], -7.0f), 7.0f); r[q] = 4.0f * gl * sigm(1.702f * gl) * (li + 1.0f);
                                              gl = fminf(g1[q], 7.0f); li = fminf(fmaxf(l1[q], -7.0f), 7.0f); r[4 + q] = 4.0f * gl * sigm(1.702f * gl) * (li + 1.0f); }
                u32x2 w; w.x = cvt4_fp8(r[0], r[1], r[2], r[3]); w.y = cvt4_fp8(r[4], r[5], r[6], r[7]);
                *(u32x2*)(act + (size_t)(row0 + ai * HALF + m * 16) * 1024 + f0) = w; }
    }
};
struct EpiY8 {
    static constexpr bool PERM = true, AFTER_DRAIN = false;
    const float* b2; const float* rw; unsigned char* y; float dq;
    __device__ __forceinline__ void operator()(const f32x4 (&acc)[2][2][4][2], const Unit& u, int wr, int wc, int fr, int fq) const {
        const int e = u.pn >> 2, j = u.pn & 3; const int row0 = u.pm * BM + wr * 64 + fr, col0 = 256 * j + wc * 32 + 8 * fq;
        const float* be = b2 + (size_t)e * 1024 + col0;
        f32x4 bv[2][2];
#pragma unroll
        for (int bj = 0; bj < 2; ++bj)
#pragma unroll
            for (int n = 0; n < 2; ++n) bv[bj][n] = *(const f32x4*)(be + bj * HALF + 4 * n);
        float rwv[2][4];
#pragma unroll
        for (int ai = 0; ai < 2; ++ai)
#pragma unroll
            for (int m = 0; m < 4; ++m) rwv[ai][m] = rw[row0 + ai * HALF + m * 16] * 32.0f;
#pragma unroll
        for (int ai = 0; ai < 2; ++ai)
#pragma unroll
            for (int m = 0; m < 4; ++m) { const int row = row0 + ai * HALF + m * 16; const float w_ = rwv[ai][m];
#pragma unroll
                for (int bj = 0; bj < 2; ++bj) { const f32x4 v0 = (acc[ai][bj][m][0] * dq + bv[bj][0]) * w_, v1 = (acc[ai][bj][m][1] * dq + bv[bj][1]) * w_;
                    u32x2 w; w.x = cvt4_fp8(v0[0], v0[1], v0[2], v0[3]); w.y = cvt4_fp8(v1[0], v1[1], v1[2], v1[3]);
                    *(u32x2*)(y + (size_t)row * 1024 + col0 + bj * HALF) = w; } }
    }
};

template <bool OUT8> struct EpiGateFused {
    static constexpr bool PERM = true, AFTER_DRAIN = false, HAS_MID = true;
    const bf16_t* gc; const bf16_t* gh; bf16_t* out; float dq;
    __device__ __forceinline__ void mid(f32x4 (&acc)[2][2][4][2], const Unit& u, int wr, int wc, int fr, int fq) const {
        const int row0 = u.pm * BM + wr * 64 + fr, col0 = u.pn * BM + wc * 32 + 8 * fq;
#pragma unroll
        for (int ai = 0; ai < 2; ++ai)
#pragma unroll
            for (int m = 0; m < 4; ++m) { const size_t o = (size_t)(row0 + ai * HALF + m * 16) * 1024 + col0;
#pragma unroll
                for (int bj = 0; bj < 2; ++bj) { const u32x4 a = *(const u32x4*)(gc + o + bj * HALF), b = *(const u32x4*)(gh + o + bj * HALF);
                    const unsigned aw[4] = {a.x, a.y, a.z, a.w}, bw[4] = {b.x, b.y, b.z, b.w};
#pragma unroll
                    for (int q = 0; q < 4; ++q) { const float r0 = (1.0f + __expf(-blo(bw[q]))) * __builtin_amdgcn_rcpf(1.0f + __expf(-blo(aw[q]))), r1 = (1.0f + __expf(-bhi(bw[q]))) * __builtin_amdgcn_rcpf(1.0f + __expf(-bhi(aw[q])));
                        acc[ai][bj][m][q >> 1][(2 * q) & 3] *= r0; acc[ai][bj][m][q >> 1][(2 * q + 1) & 3] *= r1; } } }
    }
    __device__ __forceinline__ void operator()(const f32x4 (&acc)[2][2][4][2], const Unit& u, int wr, int wc, int fr, int fq) const {
        const int row0 = u.pm * BM + wr * 64 + fr, col0 = u.pn * BM + wc * 32 + 8 * fq;
#pragma unroll
        for (int ai = 0; ai < 2; ++ai) {
            u32x4 gw[4][2];
#pragma unroll
            for (int m = 0; m < 4; ++m)
#pragma unroll
                for (int bj = 0; bj < 2; ++bj) gw[m][bj] = *(const u32x4*)(gh + (size_t)(row0 + ai * HALF + m * 16) * 1024 + col0 + bj * HALF);
#pragma unroll
            for (int m = 0; m < 4; ++m) { const size_t o = (size_t)(row0 + ai * HALF + m * 16) * 1024 + col0;
#pragma unroll
                for (int bj = 0; bj < 2; ++bj) { const u32x4 g = gw[m][bj]; f32x4 v0 = acc[ai][bj][m][0], v1 = acc[ai][bj][m][1];
                    v0[0] *= sigm(blo(g.x)); v0[1] *= sigm(bhi(g.x)); v0[2] *= sigm(blo(g.y)); v0[3] *= sigm(bhi(g.y));
                    v1[0] *= sigm(blo(g.z)); v1[1] *= sigm(bhi(g.z)); v1[2] *= sigm(blo(g.w)); v1[3] *= sigm(bhi(g.w));
                    if (OUT8) { const float s_ = dq * 32.0f; u32x2 w; w.x = cvt4_fp8(v0[0] * s_, v0[1] * s_, v0[2] * s_, v0[3] * s_); w.y = cvt4_fp8(v1[0] * s_, v1[1] * s_, v1[2] * s_, v1[3] * s_);
                                *(u32x2*)((unsigned char*)out + o + bj * HALF) = w; }
                    else { u32x4 w; w.x = cvt_pk_bf16(v0[0] * dq, v0[1] * dq); w.y = cvt_pk_bf16(v0[2] * dq, v0[3] * dq); w.z = cvt_pk_bf16(v1[0] * dq, v1[1] * dq); w.w = cvt_pk_bf16(v1[2] * dq, v1[3] * dq);
                           *(u32x4*)(out + o + bj * HALF) = w; } } }
        }
    }
};

template <class T, class = void> struct has_mid { static constexpr bool value = false; };
template <class T> struct has_mid<T, decltype((void)T::HAS_MID)> { static constexpr bool value = true; };
template <class Epi, class Sched, bool ALIGN_EPI = false, bool SP2 = false, bool GATHER = false, int FP8 = 0  >
__device__ __forceinline__ void gemm_phase(PG8_LAS unsigned char* lds, const Gemm g, const Sched& S, const Epi& E, const int wave_id, const PG8_LAS unsigned short* gtab = nullptr) {
    typedef int i32x4 __attribute__((ext_vector_type(4))); typedef int i32x8 __attribute__((ext_vector_type(8)));
    static_assert(!GATHER || SP2, "GATHER needs the SP2 loop");
    int lane = (int)__builtin_amdgcn_mbcnt_hi(~0u, __builtin_amdgcn_mbcnt_lo(~0u, 0u)); asm volatile("" : "+v"(lane));
    const int wid = wave_id, tid = wid * 64 + lane, wr = wid >> 2, wc = wid & 3, fr = lane & 15, fq = lane >> 4;
    const int K = g.K, nt = K / BK;
    unsigned voffA[2], voffB[2];
#pragma unroll
    for (int i = 0; i < 2; ++i) { int R, C; stage_rc(tid * 16 + i * 8192, R, C); const int Rb = Epi::PERM ? ((R & ~31) + perm32(R & 31)) : R;
        voffA[i] = (unsigned)(R * K + C) * 2u; voffB[i] = (unsigned)(Rb * K + C) * 2u; }
    unsigned vA0[2] = {0u, 0u}, vA1[2] = {0u, 0u}, xA0[2] = {0u, 0u}, xA1[2] = {0u, 0u};
#define PG8_GLOAD(d0, d1, ui_) do { int tz_ = wid * 64 + (int)__builtin_amdgcn_mbcnt_hi(~0u, __builtin_amdgcn_mbcnt_lo(~0u, 0u)); asm volatile("" : "+v"(tz_)); _Pragma("unroll") for (int _i = 0; _i < 2; ++_i) { int R_, C_; stage_rc(tz_ * 16 + _i * 8192, R_, C_); \
        d0[_i] = (unsigned)gtab[256 * (ui_) + R_] * (unsigned)(K * 2) + (unsigned)C_ * 2u; d1[_i] = (unsigned)gtab[256 * (ui_) + 128 + R_] * (unsigned)(K * 2) + (unsigned)C_ * 2u; } } while (0)
    const unsigned kstep = (unsigned)(BK * 2);
    const unsigned hstep = (unsigned)HALF * K * 2;
    const unsigned tstep = 2 * hstep;
    const __amdgpu_buffer_rsrc_t rsA = __builtin_amdgcn_make_buffer_rsrc((void*)g.A, 0, 0x7fffffff, 0x00020000), rsB = __builtin_amdgcn_make_buffer_rsrc((void*)g.Bt, 0, 0x7fffffff, 0x00020000);
    const unsigned ldsw = (unsigned)wid * 1024u;
    const int aoff = lds_byte(wr * 64 + fr, fq * 8), boff = lds_byte(wc * 32 + fr, fq * 8);
#define PG8_SA(b, h) (((b) * 2 + (h)) * HTB)
#define PG8_SB(b, h) ((4 + (b) * 2 + (h)) * HTB)
#define PG8_STAGE(bufoff, rs, soff, voff) do { _Pragma("unroll") for (int _i = 0; _i < 2; ++_i) \
        __builtin_amdgcn_raw_ptr_buffer_load_lds(rs, (PG8_LAS void*)(lds + (bufoff) + ldsw + _i * 8192), 16, (int)(voff)[_i], (int)(soff), 0, 0); } while (0)
#define PG8_LDA(dst, b, h) do { if constexpr (FP8 == 1) { _Pragma("unroll") for (int m = 0; m < 4; ++m) dst##_8[m] = __builtin_shufflevector(*(const PG8_LAS i32x4*)(lds + PG8_SA(b, h) + aoff + m * 2048), *(const PG8_LAS i32x4*)(lds + PG8_SA(b, h) + aoff + m * 2048 + 1024), 0, 1, 2, 3, 4, 5, 6, 7); } \
        else { _Pragma("unroll") for (int m = 0; m < 4; ++m) _Pragma("unroll") for (int k = 0; k < 2; ++k) dst[m][k] = *(const PG8_LAS bf16x8*)(lds + PG8_SA(b, h) + aoff + m * 2048 + k * 1024); } } while (0)
#define PG8_LDB(dst, b, h) do { if constexpr (FP8 == 1) { _Pragma("unroll") for (int n = 0; n < 2; ++n) dst##_8[n] = __builtin_shufflevector(*(const PG8_LAS i32x4*)(lds + PG8_SB(b, h) + boff + n * 2048), *(const PG8_LAS i32x4*)(lds + PG8_SB(b, h) + boff + n * 2048 + 1024), 0, 1, 2, 3, 4, 5, 6, 7); } \
        else { _Pragma("unroll") for (int n = 0; n < 2; ++n) _Pragma("unroll") for (int k = 0; k < 2; ++k) dst[n][k] = *(const PG8_LAS bf16x8*)(lds + PG8_SB(b, h) + boff + n * 2048 + k * 1024); } } while (0)
#define PG8_MMA(ai, bj, At, Bt) do { __builtin_amdgcn_s_setprio(1); if constexpr (FP8 == 1) { _Pragma("unroll") for (int m = 0; m < 4; ++m) _Pragma("unroll") for (int n = 0; n < 2; ++n) \
        asm volatile("v_mfma_scale_f32_16x16x128_f8f6f4 %0, %1, %2, %0, %3, %3 op_sel_hi:[0,0,0]" : "+v"(acc[ai][bj][m][n]) : "v"(Bt##_8[n]), "v"(At##_8[m]), "v"(sc8));     \
        } else if constexpr (FP8 == 2) { _Pragma("unroll") for (int m = 0; m < 4; ++m) _Pragma("unroll") for (int n = 0; n < 2; ++n) _Pragma("unroll") for (int k = 0; k < 2; ++k) \
        acci[ai][bj][m][n] = __builtin_amdgcn_mfma_i32_16x16x64_i8(__builtin_bit_cast(i32x4, Bt[n][k]), __builtin_bit_cast(i32x4, At[m][k]), acci[ai][bj][m][n], 0, 0, 0); \
        } else { _Pragma("unroll") for (int m = 0; m < 4; ++m) _Pragma("unroll") for (int n = 0; n < 2; ++n) _Pragma("unroll") for (int k = 0; k < 2; ++k) \
        acc[ai][bj][m][n] = __builtin_amdgcn_mfma_f32_16x16x32_bf16(Bt[n][k], At[m][k], acc[ai][bj][m][n], 0, 0, 0); } __builtin_amdgcn_s_setprio(0); } while (0)
#define PG8_WAIT_V(n) asm volatile("s_waitcnt vmcnt(" #n ")" ::: "memory")
#define PG8_WAIT_L(n) asm volatile("s_waitcnt lgkmcnt(" #n ")" ::: "memory")
#define PG8_BAR __builtin_amdgcn_s_barrier()
#define PG8_SCHED __builtin_amdgcn_sched_barrier(0)
    Unit cur, nxt; int ui = 0;
    if (!S.next(0, cur)) return;
    f32x4 acc[2][2][4][2]; i32x4 acci[2][2][4][2];
#pragma unroll
    for (int a = 0; a < 2; ++a)
#pragma unroll
        for (int b = 0; b < 2; ++b)
#pragma unroll
            for (int m = 0; m < 4; ++m)
#pragma unroll
                for (int n = 0; n < 2; ++n) { acc[a][b][m][n] = (f32x4){0.f, 0.f, 0.f, 0.f}; acci[a][b][m][n] = (i32x4){0, 0, 0, 0}; }
    int sc8 = 0x7f7f7f7f; asm volatile("" : "+v"(sc8));
    bf16x8 At[4][2], B0[2][2], B1[2][2]; i32x8 At_8[4], B0_8[2], B1_8[2];
    unsigned cA = GATHER ? 0u : (unsigned)cur.pm * tstep, cB = (unsigned)cur.pn * tstep;
    S.a_ready(cur);
    if constexpr (GATHER) { PG8_GLOAD(vA0, vA1, 0); xA0[0] = vA0[0]; xA0[1] = vA0[1]; xA1[0] = vA1[0]; xA1[1] = vA1[1]; }
    if constexpr (SP2) {
        PG8_STAGE(PG8_SB(0, 0), rsB, cB, voffB); PG8_STAGE(PG8_SB(0, 1), rsB, cB + hstep, voffB);
        if constexpr (GATHER) { PG8_STAGE(PG8_SA(0, 0), rsA, cA, vA0); PG8_STAGE(PG8_SA(0, 1), rsA, cA, vA1); } else { PG8_STAGE(PG8_SA(0, 0), rsA, cA, voffA); PG8_STAGE(PG8_SA(0, 1), rsA, cA + hstep, voffA); }
        if (wr == 1) PG8_BAR;
        PG8_WAIT_V(2); PG8_BAR;
        PG8_STAGE(PG8_SB(1, 0), rsB, cB + kstep, voffB); if constexpr (GATHER) { PG8_STAGE(PG8_SA(1, 0), rsA, cA + kstep, vA0); } else { PG8_STAGE(PG8_SA(1, 0), rsA, cA + kstep, voffA); } PG8_STAGE(PG8_SB(1, 1), rsB, cB + hstep + kstep, voffB);
        PG8_WAIT_V(6); PG8_BAR;
    } else {
        PG8_STAGE(PG8_SB(0, 0), rsB, cB, voffB); PG8_STAGE(PG8_SA(0, 0), rsA, cA, voffA); PG8_STAGE(PG8_SB(0, 1), rsB, cB + hstep, voffB); PG8_STAGE(PG8_SA(0, 1), rsA, cA + hstep, voffA);
        if (wr == 1) PG8_BAR;
        PG8_WAIT_V(4); PG8_BAR;
        PG8_STAGE(PG8_SB(1, 0), rsB, cB + kstep, voffB); PG8_STAGE(PG8_SA(1, 0), rsA, cA + kstep, voffA); PG8_STAGE(PG8_SB(1, 1), rsB, cB + hstep + kstep, voffB);
        PG8_WAIT_V(6); PG8_BAR;
    }
    for (;;) {
        const bool has_next = S.next(ui + 1, nxt);
        const unsigned nA = GATHER ? cA : (has_next ? (unsigned)nxt.pm * tstep : cA), nB = has_next ? (unsigned)nxt.pn * tstep : cB;
        for (int t = 0; t < nt; t += 2) {
            const bool last = (t == nt - 2);
            const unsigned a1 = cA + (unsigned)(t + 1) * kstep;
            const unsigned a2 = last ? nA : cA + (unsigned)(t + 2) * kstep, b2 = last ? nB : cB + (unsigned)(t + 2) * kstep;
            const unsigned a3 = a2 + kstep, b3 = b2 + kstep;
            if (last && has_next) S.a_ready(nxt);
            if constexpr (has_mid<Epi>::value) { if (t == nt / 2) { int l3_ = (int)__builtin_amdgcn_mbcnt_hi(~0u, __builtin_amdgcn_mbcnt_lo(~0u, 0u)); asm volatile("" : "+v"(l3_)); E.mid(acc, cur, wr, wc, l3_ & 15, l3_ >> 4); } }
            if constexpr (GATHER) { if (last && has_next) { PG8_GLOAD(xA0, xA1, ui + 1); } }
            if constexpr (SP2) {
            PG8_LDB(B0, 0, 0); PG8_LDB(B1, 0, 1); PG8_SCHED; PG8_LDA(At, 0, 0); if constexpr (GATHER) { PG8_STAGE(PG8_SA(1, 1), rsA, a1, vA1); } else { PG8_STAGE(PG8_SA(1, 1), rsA, a1 + hstep, voffA); }
            PG8_WAIT_V(8); PG8_WAIT_L(0); PG8_BAR; PG8_MMA(0, 0, At, B0); PG8_MMA(0, 1, At, B1); PG8_BAR; PG8_SCHED;
            PG8_LDA(At, 0, 1); PG8_STAGE(PG8_SB(0, 0), rsB, b2, voffB); PG8_STAGE(PG8_SB(0, 1), rsB, b2 + hstep, voffB); if constexpr (GATHER) { PG8_STAGE(PG8_SA(0, 0), rsA, a2, xA0); } else { PG8_STAGE(PG8_SA(0, 0), rsA, a2, voffA); }
            PG8_WAIT_V(8); PG8_WAIT_L(0); PG8_BAR; PG8_MMA(1, 0, At, B0); PG8_MMA(1, 1, At, B1); PG8_BAR; PG8_SCHED;
            PG8_LDB(B0, 1, 0); PG8_LDB(B1, 1, 1); PG8_SCHED; PG8_LDA(At, 1, 0); if constexpr (GATHER) { PG8_STAGE(PG8_SA(0, 1), rsA, a2, xA1); } else { PG8_STAGE(PG8_SA(0, 1), rsA, a2 + hstep, voffA); }
            PG8_WAIT_V(8); PG8_WAIT_L(0); PG8_BAR; PG8_MMA(0, 0, At, B0); PG8_MMA(0, 1, At, B1); PG8_BAR; PG8_SCHED;
            PG8_LDA(At, 1, 1); PG8_STAGE(PG8_SB(1, 0), rsB, b3, voffB); PG8_STAGE(PG8_SB(1, 1), rsB, b3 + hstep, voffB); if constexpr (GATHER) { PG8_STAGE(PG8_SA(1, 0), rsA, a3, xA0); } else { PG8_STAGE(PG8_SA(1, 0), rsA, a3, voffA); }
            PG8_WAIT_V(8); PG8_WAIT_L(0); PG8_BAR; PG8_MMA(1, 0, At, B0); PG8_MMA(1, 1, At, B1); PG8_BAR; PG8_SCHED;
            } else {
            PG8_LDB(B0, 0, 0); PG8_SCHED; PG8_LDA(At, 0, 0); PG8_STAGE(PG8_SA(1, 1), rsA, a1 + hstep, voffA);
            PG8_WAIT_L(8); PG8_BAR; PG8_WAIT_L(0); PG8_MMA(0, 0, At, B0); PG8_BAR; PG8_SCHED;
            PG8_LDB(B1, 0, 1); PG8_STAGE(PG8_SB(0, 0), rsB, b2, voffB);
            PG8_BAR; PG8_WAIT_L(0); PG8_MMA(0, 1, At, B1); PG8_BAR;
            PG8_LDA(At, 0, 1); PG8_STAGE(PG8_SA(0, 0), rsA, a2, voffA);
            PG8_BAR; PG8_WAIT_L(0); PG8_MMA(1, 0, At, B0); PG8_BAR; PG8_SCHED;
            PG8_STAGE(PG8_SB(0, 1), rsB, b2 + hstep, voffB);
            PG8_WAIT_V(6); PG8_BAR; PG8_MMA(1, 1, At, B1); PG8_BAR;
            PG8_LDB(B0, 1, 0); PG8_SCHED; PG8_LDA(At, 1, 0); PG8_STAGE(PG8_SA(0, 1), rsA, a2 + hstep, voffA);
            PG8_WAIT_L(8); PG8_BAR; PG8_WAIT_L(0); PG8_MMA(0, 0, At, B0); PG8_BAR; PG8_SCHED;
            PG8_LDB(B1, 1, 1); PG8_STAGE(PG8_SB(1, 0), rsB, b3, voffB);
            PG8_BAR; PG8_WAIT_L(0); PG8_MMA(0, 1, At, B1); PG8_BAR;
            PG8_LDA(At, 1, 1); PG8_STAGE(PG8_SA(1, 0), rsA, a3, voffA);
            PG8_BAR; PG8_WAIT_L(0); PG8_MMA(1, 0, At, B0); PG8_BAR; PG8_SCHED;
            PG8_STAGE(PG8_SB(1, 1), rsB, b3 + hstep, voffB);
            PG8_WAIT_V(6); PG8_BAR; PG8_MMA(1, 1, At, B1); PG8_BAR;
            }
        }
        if constexpr (ALIGN_EPI) { if (wr == 0) PG8_BAR; }
        if constexpr (FP8 == 2) { _Pragma("unroll") for (int a = 0; a < 2; ++a) _Pragma("unroll") for (int bq = 0; bq < 2; ++bq) _Pragma("unroll") for (int m = 0; m < 4; ++m) _Pragma("unroll") for (int n = 0; n < 2; ++n) acc[a][bq][m][n] = __builtin_convertvector(acci[a][bq][m][n], f32x4); }
        if constexpr (FP8 == 1) asm volatile("s_nop 15\n\ts_nop 15" ::: "memory");
        if constexpr (!Epi::AFTER_DRAIN) { int l2_ = (int)__builtin_amdgcn_mbcnt_hi(~0u, __builtin_amdgcn_mbcnt_lo(~0u, 0u)); asm volatile("" : "+v"(l2_));
            E(acc, cur, wr, wc, l2_ & 15, l2_ >> 4); S.done(cur); }
        if (!has_next) break;
#pragma unroll
        for (int a = 0; a < 2; ++a)
#pragma unroll
            for (int b = 0; b < 2; ++b)
#pragma unroll
                for (int m = 0; m < 4; ++m)
#pragma unroll
                    for (int n = 0; n < 2; ++n) { acc[a][b][m][n] = (f32x4){0.f, 0.f, 0.f, 0.f}; acci[a][b][m][n] = (i32x4){0, 0, 0, 0}; }
        cur = nxt; cA = nA; cB = nB; ++ui;
        if constexpr (GATHER) { vA0[0] = xA0[0]; vA0[1] = xA0[1]; vA1[0] = xA1[0]; vA1[1] = xA1[1]; }
        if constexpr (ALIGN_EPI) { if (wr == 1) PG8_BAR; }
    }
    PG8_WAIT_V(0);
    if constexpr (!ALIGN_EPI) { if (wr == 0) PG8_BAR; }
    PG8_BAR;
    if constexpr (Epi::AFTER_DRAIN) { E.fused(acc, cur, wr, wc, fr, fq, lds, wid, lane); S.done(cur); }
#undef PG8_GLOAD
#undef PG8_SA
#undef PG8_SB
#undef PG8_STAGE
#undef PG8_LDA
#undef PG8_LDB
#undef PG8_MMA
#undef PG8_WAIT_V
#undef PG8_WAIT_L
#undef PG8_BAR
#undef PG8_SCHED
}
}
#define XB_TMO      128
#define XB_XCNT(j)  (256  + 64 * (j))
#define XB_XSUB(j)  (1280 + 64 * (j))
#define XB_XGEN(j)  (2304 + 64 * (j))
#define XB_TOP      3328
#define XB_TOPGEN   3392
#define XCD_BAR_WORDS 3456
#define XB_SPIN_CAP (1u << 18)

__device__ __forceinline__ unsigned xb_ld(unsigned* p)              { return __hip_atomic_load(p, __ATOMIC_RELAXED, __HIP_MEMORY_SCOPE_AGENT); }
__device__ __forceinline__ unsigned xb_add(unsigned* p, unsigned v) { return __hip_atomic_fetch_add(p, v, __ATOMIC_RELAXED, __HIP_MEMORY_SCOPE_AGENT); }
__device__ __forceinline__ unsigned xb_xcc_id() { return (unsigned)__builtin_amdgcn_s_getreg((3 << 11) | 20) & 0xFu; }
#define XB_SPIN(cond, bar) do { unsigned _sp = 0; while (cond) { __builtin_amdgcn_s_sleep(1); \
    if ((++_sp & 255u) == 0u) { if (xb_ld(&(bar)[XB_TMO])) break; if (_sp > XB_SPIN_CAP) { atomicAdd(&(bar)[XB_TMO], 1u); break; } } } } while (0)

struct XcdBarrier {
    unsigned* bar; unsigned x;
    volatile LAS unsigned* st;
};

__device__ __forceinline__ XcdBarrier xcd_barrier_post(unsigned* bar, volatile LAS unsigned* st, const bool leader  ) {
    XcdBarrier b; b.bar = bar; b.x = xb_xcc_id(); b.st = st;
    if (leader) (void)xb_add(&bar[XB_XCNT(b.x)], 1u);
    return b;
}
__device__ __forceinline__ void xcd_barrier_complete(unsigned* bar, unsigned x, unsigned& nloc, unsigned& nx) {
    const unsigned G = gridDim.x * gridDim.y * gridDim.z;
    unsigned sum, cnt, mine, sp = 0u;
    for (;;) {
        sum = 0u; cnt = 0u; mine = 0u;
#pragma unroll
        for (unsigned j = 0; j < 16; ++j) { const unsigned c = xb_ld(&bar[XB_XCNT(j)]); sum += c; cnt += (c > 0u) ? 1u : 0u; mine = (j == x) ? c : mine; }
        if (sum == G) break;
        __builtin_amdgcn_s_sleep(1);
        if ((++sp & 255u) == 0u) { if (xb_ld(&bar[XB_TMO])) break; if (sp > XB_SPIN_CAP) { atomicAdd(&bar[XB_TMO], 1u); break; } }
    }
    nloc = mine > 0u ? mine : 1u; nx = cnt > 0u ? cnt : 1u;
}

__device__ __forceinline__ void xcd_barrier(const XcdBarrier& b, const bool leader  ) {
    asm volatile("s_waitcnt vmcnt(0)" ::: "memory");
    __syncthreads();
    if (leader) {
        unsigned* bar = b.bar;
        __builtin_amdgcn_s_waitcnt(0);
        unsigned nloc = b.st[0], nx = b.st[1];
        if (nloc == 0u) { xcd_barrier_complete(bar, b.x, nloc, nx); b.st[0] = nloc; b.st[1] = nx; }
        const unsigned old = xb_add(&bar[XB_XSUB(b.x)], 1u);
        const unsigned gen = old / nloc;
        if (old + 1u == (gen + 1u) * nloc) {
            __builtin_amdgcn_fence(__ATOMIC_RELEASE, "agent");
            asm volatile("s_waitcnt vmcnt(0)" ::: "memory");
            const unsigned og = xb_add(&bar[XB_TOP], 1u);
            const unsigned tg = og / nx;
            if (og + 1u == (tg + 1u) * nx) xb_add(&bar[XB_TOPGEN], 1u);
            else XB_SPIN(xb_ld(&bar[XB_TOPGEN]) == tg, bar);
            __builtin_amdgcn_fence(__ATOMIC_ACQUIRE, "agent");
            xb_add(&bar[XB_XGEN(b.x)], 1u);
            asm volatile("s_waitcnt vmcnt(0)" ::: "memory");
        } else {
            XB_SPIN(xb_ld(&bar[XB_XGEN(b.x)]) == gen, bar);
            __builtin_amdgcn_fence(__ATOMIC_ACQUIRE, "agent");
            asm volatile("s_waitcnt vmcnt(0)" ::: "memory");
        }
    }
    __syncthreads();
}

#ifndef MIX_FP8
#define MIX_FP8 1
#endif
#ifndef RES_FP8
#define RES_FP8 1
#endif
#ifndef P_INT8
#define P_INT8 1
#endif
#ifndef P_FP8_MASK
#define P_FP8_MASK 0xFFFFFFFFu
#endif =======================================================
struct Ctx { LAS unsigned char* lds; int tid, lane, wave, vcu, G; };

__device__ __forceinline__ void transpose_load64(const float* W, int ldw, int k0, int n0, LAS float* scr, int lane) {
#pragma unroll 8
    for (int i = 0; i < 16; ++i) { const int kk = 4 * i + (lane >> 4), nn = 4 * (lane & 15); const f32x4 v = *(const f32x4*)(W + (size_t)(k0 + kk) * ldw + n0 + nn);
        LAS float* d = scr + kk * 65 + nn; d[0] = v.x; d[1] = v.y; d[2] = v.z; d[3] = v.w; }
    LDS_WAIT();
}
__device__ __forceinline__ void transpose_item(const float* W, int ldw, int K, bf16_t* dst, int k0, int n0, LAS float* scr, int lane) {
    transpose_load64(W, ldw, k0, n0, scr, lane);
    const int c = lane & 7;
#pragma unroll
    for (int j = 0; j < 8; ++j) { const int n = (lane >> 3) + 8 * j; const LAS float* s = scr + (8 * c) * 65 + n;
        u32x4 o; o.x = pk2(s[0 * 65], s[1 * 65]); o.y = pk2(s[2 * 65], s[3 * 65]); o.z = pk2(s[4 * 65], s[5 * 65]); o.w = pk2(s[6 * 65], s[7 * 65]);
        *(u32x4*)(dst + (size_t)n * K + k0 + 8 * c) = o; }
    LDS_WAIT();
}
__device__ __forceinline__ void transpose_item8(const float* W, int ldw, int K, unsigned char* dst, int k0, int n0, float scale, LAS float* scr, int lane) {
    (void)scr;
    const int kc = lane & 3, nq = lane >> 2;
    const float* s = W + (size_t)(k0 + 16 * kc) * ldw + n0 + 4 * nq;
    f32x4 v[16];
#pragma unroll
    for (int i = 0; i < 16; ++i) v[i] = *(const f32x4*)(s + (size_t)i * ldw);
#pragma unroll
    for (int j = 0; j < 4; ++j) {
        u32x4 o; o.x = cvt4_fp8(v[0][j] * scale, v[1][j] * scale, v[2][j] * scale, v[3][j] * scale); o.y = cvt4_fp8(v[4][j] * scale, v[5][j] * scale, v[6][j] * scale, v[7][j] * scale);
        o.z = cvt4_fp8(v[8][j] * scale, v[9][j] * scale, v[10][j] * scale, v[11][j] * scale); o.w = cvt4_fp8(v[12][j] * scale, v[13][j] * scale, v[14][j] * scale, v[15][j] * scale);
        *(u32x4*)(dst + (size_t)(4 * nq + j) * K + k0 + 16 * kc) = o; }
}

template <int PART>
__device__ __forceinline__ void ph_prologue(const Ctx& X, const float* c, const float* w_ada, const float* b_ada, float* mod,
                                            const float* w_in, const float* w_conv_out, const float* w_hgrn_out, const float* w_out, const float* w1, const float* w2, unsigned char* ws) {
    if (PART == 0) for (int cbk = X.vcu; cbk < NMOD / 32; cbk += X.G) {
        LAS float* ca = (LAS float*)X.lds;
        LAS float* red = (LAS float*)(X.lds + 16384);
        for (int i = X.tid; i < 4096; i += 512) { const float v = c[i]; ca[i] = v * sigmoidf_(v); }
        __syncthreads();
        const int jj = X.tid & 31, kp = X.tid >> 5, j = cbk * 32 + jj;
        float a0 = 0.f, a1 = 0.f, a2 = 0.f, a3 = 0.f;
#pragma unroll 16
        for (int i = kp * 64; i < kp * 64 + 64; ++i) { const float w = w_ada[(size_t)i * NMOD + j]; a0 += ca[i] * w; a1 += ca[1024 + i] * w; a2 += ca[2048 + i] * w; a3 += ca[3072 + i] * w; }
        red[(kp * 4 + 0) * 32 + jj] = a0; red[(kp * 4 + 1) * 32 + jj] = a1; red[(kp * 4 + 2) * 32 + jj] = a2; red[(kp * 4 + 3) * 32 + jj] = a3;
        __syncthreads();
        if (X.tid < 128) { const int b = X.tid >> 5; float r = b_ada[j];
#pragma unroll
            for (int q = 0; q < 16; ++q) r += red[(q * 4 + b) * 32 + jj];
            mod[(size_t)b * NMOD + j] = r; }
        __syncthreads();
    }
    LAS float* scr = (LAS float*)(X.lds + X.wave * 16640);
    const bool split = PART == 0 && X.G > NMOD / 32;
    const int gw = split ? (X.vcu - NMOD / 32) * 8 + X.wave : X.vcu * 8 + X.wave, NGW = split ? (X.G - NMOD / 32) * 8 : X.G * 8;
    constexpr int I_IN = 16 * 128, I_SQ = 16 * 16, I_W1 = 32 * 16 * 32, I_W2 = 32 * 16 * 16, NITEMS = I_IN + 3 * I_SQ + I_W1 + I_W2;
    constexpr int I_DENSE = I_IN + 3 * I_SQ;
    if (!(split && X.vcu < NMOD / 32)) for (int it = (PART == 0 ? (P_INT8 ? I_IN : 0) : I_DENSE) + gw; it < (PART == 0 ? I_DENSE : NITEMS); it += NGW) {
        int r = it;
        if (r < I_IN) { const int kb = r >> 7, nb = r & 127, n0 = 64 * nb;
            const int rho0 = (n0 < 2048) ? 256 * ((n0 & 1023) >> 7) + 128 * (n0 >> 10) + (n0 & 127) : n0;
            if ((P_FP8_MASK >> (rho0 >> 8)) & 1u) transpose_item8(w_in, 8192, 1024, (unsigned char*)(ws + WS_WIN8) + (size_t)rho0 * 1024, 64 * kb, n0, 256.0f, scr, X.lane);
            else transpose_item(w_in, 8192, 1024, (bf16_t*)(ws + WS_WIN) + (size_t)rho0 * 1024, 64 * kb, n0, scr, X.lane);
            continue; } r -= I_IN;
        if (r < 3 * I_SQ) { const int which = r / I_SQ, q = r % I_SQ, kb = q >> 4, nb = q & 15;
            const float* W = which == 0 ? w_conv_out : (which == 1 ? w_hgrn_out : w_out);
            if (which == 2) { if (RES_FP8) transpose_item8(W, 1024, 1024, (unsigned char*)(ws + WS_WO) + (size_t)(64 * nb) * 1024, 64 * kb, 64 * nb, 256.0f, scr, X.lane);
                              else transpose_item(W, 1024, 1024, (bf16_t*)(ws + WS_WO) + (size_t)(64 * nb) * 1024, 64 * kb, 64 * nb, scr, X.lane); }
            else if (MIX_FP8) transpose_item8(W, 1024, 2048, (unsigned char*)(ws + WS_WC) + (size_t)(64 * nb) * 2048 + which * 1024, 64 * kb, 64 * nb, 256.0f, scr, X.lane);
            else transpose_item(W, 1024, 2048, (bf16_t*)(ws + WS_WC) + (size_t)(64 * nb) * 2048 + which * 1024, 64 * kb, 64 * nb, scr, X.lane);
            continue; } r -= 3 * I_SQ;
        if (r < I_W1) { const int e = r >> 9, q = r & 511, kb = q >> 5, nb = q & 31, n0 = 64 * nb;
            const int rho0 = (n0 < 1024) ? 256 * (n0 >> 7) + (n0 & 127) : 256 * ((n0 - 1024) >> 7) + 128 + ((n0 - 1024) & 127);
            transpose_item8(w1 + (size_t)e * 1024 * 2048, 2048, 1024, (unsigned char*)(ws + WS_W1) + ((size_t)e * 2048 + rho0) * 1024, 64 * kb, n0, 256.0f, scr, X.lane); continue; } r -= I_W1;
        { const int e = r >> 8, q = r & 255, kb = q >> 4, nb = q & 15;
            transpose_item8(w2 + (size_t)e * 1024 * 1024, 1024, 1024, (unsigned char*)(ws + WS_W2) + ((size_t)e * 1024 + 64 * nb) * 1024, 64 * kb, 64 * nb, 256.0f, scr, X.lane); }
    }
    __syncthreads();
}

__device__ __forceinline__ void ph_norm_mod(const Ctx& X, const float* x, const float* g, const float* mod, int sh_off, int sc_off, bf16_t* out, unsigned char* out8, float* hsc) {
    for (int t = X.vcu * 8 + X.wave; t < T; t += X.G * 8) {
        const int b = t / SEQ, lane = X.lane;
        const f32x4* xr = (const f32x4*)(x + (size_t)t * D) + lane;
        f32x4 v[4]; float ss = 0.f;
#pragma unroll
        for (int j = 0; j < 4; ++j) { v[j] = xr[64 * j]; ss += (v[j].x * v[j].x + v[j].y * v[j].y) + (v[j].z * v[j].z + v[j].w * v[j].w); }
        const float r = rsqrtf(wave_sum(ss) * (1.0f / D) + EPS);
        const float* sh = mod + (size_t)b * NMOD + sh_off; const float* sc = mod + (size_t)b * NMOD + sc_off;
        float am = 0.f;
#pragma unroll
        for (int j = 0; j < 4; ++j) {
            const int col = 4 * (lane + 64 * j);
            const f32x4 gg = *(const f32x4*)(g + col), s1 = *(const f32x4*)(sc + col), s0 = *(const f32x4*)(sh + col);
            v[j] = v[j] * r * gg * (s1 + 1.0f) + s0;
            am = fmaxf(fmaxf(am, fmaxf(fabsf(v[j].x), fabsf(v[j].y))), fmaxf(fabsf(v[j].z), fabsf(v[j].w)));
        }
        if (P_INT8) {
#pragma unroll
            for (int o = 1; o < 64; o <<= 1) am = fmaxf(am, __shfl_xor(am, o));
            am = fmaxf(am, 1e-20f); const float qs = 127.0f / am;
            if (lane == 0) hsc[t] = am * (1.0f / 127.0f);
#pragma unroll
            for (int j = 0; j < 4; ++j) *(unsigned*)(out8 + (size_t)t * D + 4 * (lane + 64 * j)) = q4_i8(v[j].x * qs, v[j].y * qs, v[j].z * qs, v[j].w * qs);
        } else {
#pragma unroll
            for (int j = 0; j < 4; ++j) { const int col = 4 * (lane + 64 * j); const f32x4 y = v[j];
                if (P_FP8_MASK != 0xFFFFFFFFu) { u32x2 w; w.x = pk2(y.x, y.y); w.y = pk2(y.z, y.w); *(u32x2*)(out + (size_t)t * D + col) = w; }
                if (P_FP8_MASK != 0u) *(unsigned*)(out8 + (size_t)t * D + col) = cvt4_fp8(y.x * 16.0f, y.y * 16.0f, y.z * 16.0f, y.w * 16.0f); }
        }
    }
}

__device__ __forceinline__ void ph_win_i8(const Ctx& X, const float* w_in, unsigned char* ws) {
    LAS float* part = (LAS float*)(X.lds + 8 * 8704);
    LAS float* cmax = part + 512;
    float* wsc = (float*)(ws + WS_WSC); unsigned char* wt = ws + WS_WIN8;
    const int tid = X.tid, c = tid & 31, kq = tid >> 5;
    for (int cb = X.vcu; cb < 256; cb += X.G) {
        const int n0 = 32 * cb;
        const int rho0 = (n0 < 2048) ? 256 * ((n0 & 1023) >> 7) + 128 * (n0 >> 10) + (n0 & 127) : n0;
        float v[64]; const float* p_ = w_in + (size_t)(kq * 64) * 8192 + n0 + c;
#pragma unroll
        for (int i = 0; i < 64; ++i) v[i] = p_[(size_t)i * 8192];
        float m = 0.f;
#pragma unroll
        for (int i = 0; i < 64; ++i) m = fmaxf(m, fabsf(v[i]));
        part[kq * 32 + c] = m;
        __syncthreads();
        if (tid < 32) { float m2 = 0.f;
#pragma unroll
            for (int q = 0; q < 16; ++q) m2 = fmaxf(m2, part[q * 32 + tid]);
            m2 = fmaxf(m2, 1e-30f); cmax[tid] = m2; wsc[rho0 + tid] = m2 * (1.0f / 127.0f); }
        __syncthreads();
        const float qs = 127.0f / cmax[c];
        unsigned char* d = wt + (size_t)(rho0 + c) * 1024 + kq * 64;
#pragma unroll
        for (int q = 0; q < 4; ++q) { u32x4 o;
            o.x = q4_i8(v[16 * q + 0] * qs, v[16 * q + 1] * qs, v[16 * q + 2] * qs, v[16 * q + 3] * qs); o.y = q4_i8(v[16 * q + 4] * qs, v[16 * q + 5] * qs, v[16 * q + 6] * qs, v[16 * q + 7] * qs);
            o.z = q4_i8(v[16 * q + 8] * qs, v[16 * q + 9] * qs, v[16 * q + 10] * qs, v[16 * q + 11] * qs); o.w = q4_i8(v[16 * q + 12] * qs, v[16 * q + 13] * qs, v[16 * q + 14] * qs, v[16 * q + 15] * qs);
            *(u32x4*)(d + 16 * q) = o; }
        __syncthreads();
    }
}

typedef float f32x2 __attribute__((ext_vector_type(2)));
__device__ __forceinline__ void ph_conv(const Ctx& X, const bf16_t* pU, const float* dw, const float* dwb, const float* lng, const float* lnb, bf16_t* uc) {
    LAS float* sm = (LAS float*)X.lds;
    const int tid = X.tid, lane = X.lane, wid = X.wave, c0 = 2 * tid;
    float w[31][2];
#pragma unroll
    for (int j = 0; j < 31; ++j) { w[j][0] = dw[j * 1024 + c0]; w[j][1] = dw[j * 1024 + c0 + 1]; }
    const float bias0 = dwb[c0], bias1 = dwb[c0 + 1];
    unsigned raw[62];
#define CONV_LOAD(task_) do { const int b_ = (task_) >> 8, s0_ = ((task_) & 255) * 32; const bf16_t* q_ = pU + (size_t)(b_ * SEQ) * D + c0; \
        _Pragma("unroll") for (int i = 0; i < 62; ++i) { const int s_ = s0_ - 30 + i; raw[i] = (s_ >= 0) ? *(const unsigned*)(q_ + (size_t)s_ * D) : 0u; } } while (0)
#define CONV_LOAD_NEXT(task_) do { const int b_ = (task_) >> 8, s0_ = ((task_) & 255) * 32; const bf16_t* q_ = pU + (size_t)(b_ * SEQ) * D + c0; \
        _Pragma("unroll") for (int i = 0; i < 30; ++i) raw[i] = raw[i + 32]; \
        _Pragma("unroll") for (int i = 30; i < 62; ++i) raw[i] = *(const unsigned*)(q_ + (size_t)(s0_ - 30 + i) * D); } while (0)
    for (int run = X.vcu; run < T / 128; run += X.G) {
      CONV_LOAD(4 * run);
      for (int kq = 0; kq < 4; ++kq) {
        const int task = 4 * run + kq;
        const int b = task >> 8, s0 = (task & 255) * 32;
#pragma unroll
        for (int st = 0; st < 4; ++st) {
            float u[38][2];
#pragma unroll
            for (int i = 0; i < 38; ++i) { u[i][0] = bflo(raw[8 * st + i]); u[i][1] = bfhi(raw[8 * st + i]); }
#pragma unroll
            for (int t = 0; t < 8; ++t) {
                float a0 = bias0, a1 = bias1;
#pragma unroll
                for (int j = 0; j < 31; ++j) { a0 += w[j][0] * u[t + j][0]; a1 += w[j][1] * u[t + j][1]; }
                *(LAS f32x2*)(sm + (8 * st + t) * 1024 + c0) = (f32x2){a0, a1};
            }
        }
        if (kq < 3) CONV_LOAD_NEXT(task + 1);
        __syncthreads();
#pragma unroll 2
        for (int i = 0; i < 4; ++i) {
            const int t = wid * 4 + i;
            f32x4 v[4]; float s = 0.f;
#pragma unroll
            for (int j = 0; j < 4; ++j) { v[j] = *(const LAS f32x4*)(sm + t * 1024 + 4 * (lane + 64 * j)); s += (v[j].x + v[j].y) + (v[j].z + v[j].w); }
            const float mean = wave_sum(s) * (1.0f / D); float q = 0.f;
#pragma unroll
            for (int j = 0; j < 4; ++j) { v[j] = v[j] - mean; q += (v[j].x * v[j].x + v[j].y * v[j].y) + (v[j].z * v[j].z + v[j].w * v[j].w); }
            const float rstd = rsqrtf(wave_sum(q) * (1.0f / D) + EPS);
#pragma unroll
            for (int j = 0; j < 4; ++j) {
                const int col = 4 * (lane + 64 * j);
                const f32x4 gg = *(const f32x4*)(lng + col), bb = *(const f32x4*)(lnb + col);
                f32x4 y = v[j] * rstd * gg + bb;
                y.x *= sigmoidf_(y.x); y.y *= sigmoidf_(y.y); y.z *= sigmoidf_(y.z); y.w *= sigmoidf_(y.w);
                u32x2 o; o.x = pk2(y.x, y.y); o.y = pk2(y.z, y.w);
                if (MIX_FP8) *(unsigned*)((unsigned char*)uc + (size_t)(b * SEQ + s0 + t) * (2 * D) + col) = cvt4_fp8(y.x * 16.0f, y.y * 16.0f, y.z * 16.0f, y.w * 16.0f);
                else *(u32x2*)(uc + (size_t)(b * SEQ + s0 + t) * (2 * D) + col) = o;
            }
        }
        __syncthreads();
      }
    }
#undef CONV_LOAD
#undef CONV_LOAD_NEXT
}

typedef short bf16x8 __attribute__((ext_vector_type(8)));
typedef short s16x4 __attribute__((ext_vector_type(4)));
constexpr int HG_QA = 0, HG_KA = 17408, HG_VR = 34816, HG_AB = 52224, HG_SPT = 61440, HG_O = 96256, HG_SEG = 130048;
constexpr size_t HM = (size_t)SEQ * 128;
__device__ __forceinline__ bf16x8 tr_frag(LAS unsigned char* base, int rs, int ks, int c16, int lane) {
    const int g = lane >> 4, q = (lane & 15) >> 2, p = lane & 3;
    LAS unsigned char* a = base + (32 * ks + 8 * g + q) * rs + (16 * c16 + 4 * p) * 2;
    const s16x4 lo = __builtin_amdgcn_ds_read_tr16_b64_v4i16((LAS s16x4*)a);
    const s16x4 hi = __builtin_amdgcn_ds_read_tr16_b64_v4i16((LAS s16x4*)(a + 4 * rs));
    return __builtin_shufflevector(lo, hi, 0, 1, 2, 3, 4, 5, 6, 7);
}
template <bool OUT>
__device__ __forceinline__ void ph_hgrn(const Ctx& X, int ntask, const bf16_t* pQ, const bf16_t* pF, const bf16_t* pI, const bf16_t* pG,
                                        const float* lb_param, const float* norm_g, const float* S0, float* dS, float* Dd, bf16_t* og) {
    LAS unsigned char* L = X.lds;
    LAS float* seg_s = (LAS float*)(L + HG_SEG);
    const int tid = X.tid, lane = X.lane, wave = X.wave, fr = lane & 15, fq = lane >> 4, wr = wave >> 1, wc = wave & 1;
    const int cp = tid & 63, seg = wave, tv = tid >> 3, vc = tid & 7;
    int idx = X.vcu; if (idx >= ntask) return;
    int ch = 0;
    unsigned zr[8], qr[8]; u32x4 vr0, vr1, gn0, gn1, gc0, gc1;
#define HG_LOAD(idx_, ch_) do { const int bh_ = (idx_) & 31, sc_ = (idx_) >> 5; const size_t tb_ = (size_t)bh_ * HM + (size_t)(sc_ * 256 + (ch_) * 64) * 128; \
        _Pragma("unroll") for (int i = 0; i < 8; ++i) { zr[i] = *(const unsigned*)(pF + tb_ + (size_t)(8 * seg + i) * 128 + 2 * cp); if (OUT) qr[i] = *(const unsigned*)(pQ + tb_ + (size_t)(8 * seg + i) * 128 + 2 * cp); } \
        { const u32x4* s_ = (const u32x4*)(pI + tb_ + (size_t)tv * 128 + vc * 16); vr0 = s_[0]; vr1 = s_[1]; } \
        if (OUT) { const u32x4* s_ = (const u32x4*)(pG + tb_ + (size_t)tv * 128 + vc * 16); gn0 = s_[0]; gn1 = s_[1]; } } while (0)
    HG_LOAD(idx, 0);
    float ngv[16];
    if (OUT) {
#pragma unroll
        for (int i = 0; i < 16; ++i) ngv[i] = norm_g[vc * 16 + i];
    }
    f32x4 S[8]; float oml0 = 0.f, oml1 = 0.f, gsum0 = 0.f, gsum1 = 0.f;
#pragma unroll 1
    for (;;) {
        const int sc = idx >> 5, bh = idx & 31, b = bh >> 3, h = bh & 7;
        if (ch == 0) {
            const int c0 = h * 128 + 2 * cp;
            oml0 = 1.0f - 1.0f / (1.0f + __expf(lb_param[1024 + c0] - lb_param[c0])); oml1 = 1.0f - 1.0f / (1.0f + __expf(lb_param[1025 + c0] - lb_param[c0 + 1]));
            gsum0 = 0.f; gsum1 = 0.f;
            if (OUT && sc > 0) { const bf16_t* s0 = (const bf16_t*)S0 + (size_t)(bh * 32 + sc) * 16384;
#pragma unroll
                for (int vt = 0; vt < 8; ++vt) { const u32x2 w = *(const u32x2*)(s0 + (size_t)(vt * 16 + fr) * 128 + 16 * wave + fq * 4); S[vt] = (f32x4){bflo(w.x), bfhi(w.x), bflo(w.y), bfhi(w.y)}; }
            } else {
#pragma unroll
                for (int vt = 0; vt < 8; ++vt) S[vt] = (f32x4){0.f, 0.f, 0.f, 0.f};
            }
        }
        float kk0[8], kk1[8], lf0[8], lf1[8], q0[8], q1[8];
        {
            float c0 = 0.f, c1 = 0.f;
#pragma unroll
            for (int i = 0; i < 8; ++i) {
                kk0[i] = oml0 * __builtin_amdgcn_rcpf(1.0f + __expf(bflo(zr[i]))); kk1[i] = oml1 * __builtin_amdgcn_rcpf(1.0f + __expf(bfhi(zr[i])));
                c0 += __builtin_amdgcn_logf(1.0f - kk0[i]); c1 += __builtin_amdgcn_logf(1.0f - kk1[i]); lf0[i] = c0; lf1[i] = c1;
                if (OUT) { q0[i] = bflo(qr[i]) * 0.08838834764831845f; q1[i] = bfhi(qr[i]) * 0.08838834764831845f; }
            }
            *(LAS f32x2*)(seg_s + seg * 128 + 2 * cp) = (f32x2){c0, c1};
        }
        if (OUT) { gc0 = gn0; gc1 = gn1; }
        const u32x4 vcur0 = vr0, vcur1 = vr1;
        __syncthreads();
        { LAS u32x4* d = (LAS u32x4*)(L + HG_VR + tv * 272 + vc * 32); d[0] = vcur0; d[1] = vcur1; }
        { int idx2 = idx, ch2 = ch + 1; if (ch2 == 4) { ch2 = 0; idx2 = idx + X.G; } if (idx2 < ntask) HG_LOAD(idx2, ch2); }
        {
            f32x2 ss[8];
#pragma unroll
            for (int s = 0; s < 8; ++s) ss[s] = *(const LAS f32x2*)(seg_s + s * 128 + 2 * cp);
            float off0 = 0.f, off1 = 0.f;
#pragma unroll
            for (int s = 0; s < 8; ++s) { off0 += (s < seg) ? ss[s].x : 0.f; off1 += (s < seg) ? ss[s].y : 0.f; }
            const float R0 = (ss[0].x + ss[1].x) + (ss[2].x + ss[3].x), R1 = (ss[0].y + ss[1].y) + (ss[2].y + ss[3].y);
            if (!OUT && seg == 0) { gsum0 += R0 + (ss[4].x + ss[5].x) + (ss[6].x + ss[7].x); gsum1 += R1 + (ss[4].y + ss[5].y) + (ss[6].y + ss[7].y); }
#pragma unroll
            for (int i = 0; i < 8; ++i) {
                const float G0 = off0 + lf0[i], G1 = off1 + lf1[i];
                const float ka0 = kk0[i] * __builtin_amdgcn_exp2f(fminf(R0 - G0, 115.0f)), ka1 = kk1[i] * __builtin_amdgcn_exp2f(fminf(R1 - G1, 115.0f));
                *(LAS unsigned*)(L + HG_KA + (8 * seg + i) * 272 + 4 * cp) = pk2(ka0, ka1);
                if (OUT) { const float qa0 = q0[i] * __builtin_amdgcn_exp2f(fminf(G0 - R0, 115.0f)), qa1 = q1[i] * __builtin_amdgcn_exp2f(fminf(G1 - R1, 115.0f));
                           *(LAS unsigned*)(L + HG_QA + (8 * seg + i) * 272 + 4 * cp) = pk2(qa0, qa1); }
            }
        }
        float eR[4], eL[4];
        {
            f32x4 r4 = (f32x4){0.f, 0.f, 0.f, 0.f}, l4 = (f32x4){0.f, 0.f, 0.f, 0.f};
#pragma unroll
            for (int s = 0; s < 4; ++s) { r4 += *(const LAS f32x4*)(seg_s + s * 128 + 16 * wave + 4 * fq); l4 += *(const LAS f32x4*)(seg_s + (s + 4) * 128 + 16 * wave + 4 * fq); }
#pragma unroll
            for (int j = 0; j < 4; ++j) { eR[j] = __builtin_amdgcn_exp2f(fmaxf(r4[j], -115.0f)); eL[j] = __builtin_amdgcn_exp2f(l4[j]); }
        }
#pragma unroll
        for (int vt = 0; vt < 8; ++vt) {
#pragma unroll
            for (int j = 0; j < 4; ++j) S[vt][j] *= eR[j];
            if (OUT) { u32x2 w; w.x = pk2(S[vt][0], S[vt][1]); w.y = pk2(S[vt][2], S[vt][3]);
                       *(LAS u32x2*)(L + HG_SPT + (vt * 16 + fr) * 272 + (16 * wave + 4 * fq) * 2) = w; }
        }
        __syncthreads();
        if (OUT) {
#pragma unroll
            for (int q2 = 0; q2 < 2; ++q2) {
                const int st = 2 * wc + q2;
                f32x4 acc = (f32x4){0.f, 0.f, 0.f, 0.f};
                if (st <= wr) {
#pragma unroll
                    for (int kq = 0; kq < 4; ++kq) {
                        const bf16x8 af = *(const LAS bf16x8*)(L + HG_KA + (st * 16 + fr) * 272 + kq * 64 + fq * 16);
                        const bf16x8 bq = *(const LAS bf16x8*)(L + HG_QA + (wr * 16 + fr) * 272 + kq * 64 + fq * 16);
                        acc = __builtin_amdgcn_mfma_f32_16x16x32_bf16(af, bq, acc, 0, 0, 0);
                    }
                    const int tt = wr * 16 + fr;
#pragma unroll
                    for (int j = 0; j < 4; ++j) { const int s_ = st * 16 + fq * 4 + j; acc[j] = (s_ <= tt) ? acc[j] : 0.f; }
                }
                u32x2 w; w.x = pk2(acc[0], acc[1]); w.y = pk2(acc[2], acc[3]);
                *(LAS u32x2*)(L + HG_AB + (wr * 16 + fr) * 144 + (st * 16 + fq * 4) * 2) = w;
            }
        }
        {
            bf16x8 aK[2];
#pragma unroll
            for (int ks = 0; ks < 2; ++ks) aK[ks] = tr_frag(L + HG_KA, 272, ks, wave, lane);
#pragma unroll
            for (int vt = 0; vt < 8; ++vt) {
#pragma unroll
                for (int ks = 0; ks < 2; ++ks) { const bf16x8 bv = tr_frag(L + HG_VR, 272, ks, vt, lane); S[vt] = __builtin_amdgcn_mfma_f32_16x16x32_bf16(aK[ks], bv, S[vt], 0, 0, 0); }
#pragma unroll
                for (int j = 0; j < 4; ++j) S[vt][j] *= eL[j];
            }
        }
        if (OUT) {
            __syncthreads();
            bf16x8 aA[2], aQ[4];
#pragma unroll
            for (int ks = 0; ks < 2; ++ks) aA[ks] = *(const LAS bf16x8*)(L + HG_AB + (wr * 16 + fr) * 144 + ks * 64 + fq * 16);
#pragma unroll
            for (int kq = 0; kq < 4; ++kq) aQ[kq] = *(const LAS bf16x8*)(L + HG_QA + (wr * 16 + fr) * 272 + kq * 64 + fq * 16);
#pragma unroll
            for (int n = 0; n < 4; ++n) {
                const int vt = wc * 4 + n;
                f32x4 o = (f32x4){0.f, 0.f, 0.f, 0.f};
#pragma unroll
                for (int ks = 0; ks < 2; ++ks) { const bf16x8 bv = tr_frag(L + HG_VR, 272, ks, vt, lane); o = __builtin_amdgcn_mfma_f32_16x16x32_bf16(aA[ks], bv, o, 0, 0, 0); }
#pragma unroll
                for (int kq = 0; kq < 4; ++kq) { const bf16x8 bs = *(const LAS bf16x8*)(L + HG_SPT + (vt * 16 + fr) * 272 + kq * 64 + fq * 16); o = __builtin_amdgcn_mfma_f32_16x16x32_bf16(aQ[kq], bs, o, 0, 0, 0); }
#pragma unroll
                for (int j = 0; j < 4; ++j) *(LAS float*)(L + HG_O + (wr * 16 + fq * 4 + j) * 528 + (vt * 16 + fr) * 4) = o[j];
            }
            __syncthreads();
            {
                f32x4 ov[4]; float ssq = 0.f;
#pragma unroll
                for (int i = 0; i < 4; ++i) { ov[i] = *(const LAS f32x4*)(L + HG_O + tv * 528 + vc * 64 + i * 16); ssq += (ov[i].x * ov[i].x + ov[i].y * ov[i].y) + (ov[i].z * ov[i].z + ov[i].w * ov[i].w); }
                ssq += __shfl_xor(ssq, 1); ssq += __shfl_xor(ssq, 2); ssq += __shfl_xor(ssq, 4);
                const float rstd = rsqrtf(ssq * (1.0f / 128.0f) + EPS);
                const unsigned gw[8] = {gc0.x, gc0.y, gc0.z, gc0.w, gc1.x, gc1.y, gc1.z, gc1.w};
                unsigned ow[8]; float yv[16];
#pragma unroll
                for (int i = 0; i < 8; ++i) { const float g0 = bflo(gw[i]), g1 = bfhi(gw[i]);
                    const float y0 = ov[i >> 1][(2 * i) & 3] * rstd * ngv[2 * i] * g0 * __builtin_amdgcn_rcpf(1.0f + __expf(-g0));
                    const float y1 = ov[i >> 1][(2 * i + 1) & 3] * rstd * ngv[2 * i + 1] * g1 * __builtin_amdgcn_rcpf(1.0f + __expf(-g1));
                    ow[i] = pk2(y0, y1); yv[2 * i] = y0; yv[2 * i + 1] = y1; }
                if (MIX_FP8) { u32x4 o8; o8.x = cvt4_fp8(yv[0] * 16.0f, yv[1] * 16.0f, yv[2] * 16.0f, yv[3] * 16.0f); o8.y = cvt4_fp8(yv[4] * 16.0f, yv[5] * 16.0f, yv[6] * 16.0f, yv[7] * 16.0f);
                               o8.z = cvt4_fp8(yv[8] * 16.0f, yv[9] * 16.0f, yv[10] * 16.0f, yv[11] * 16.0f); o8.w = cvt4_fp8(yv[12] * 16.0f, yv[13] * 16.0f, yv[14] * 16.0f, yv[15] * 16.0f);
                               *(u32x4*)((unsigned char*)og + (size_t)(b * SEQ + sc * 256 + ch * 64 + tv) * (2 * D) + h * 128 + vc * 16) = o8; }
                else { u32x4* d = (u32x4*)(og + (size_t)(b * SEQ + sc * 256 + ch * 64 + tv) * (2 * D) + h * 128 + vc * 16);
                       d[0] = (u32x4){ow[0], ow[1], ow[2], ow[3]}; d[1] = (u32x4){ow[4], ow[5], ow[6], ow[7]}; }
            }
        }
        if (ch == 3) {
            if (!OUT) {
                bf16_t* ds = (bf16_t*)dS + (size_t)(bh * 32 + sc) * 16384;
#pragma unroll
                for (int vt = 0; vt < 8; ++vt) { u32x2 w; w.x = pk2(S[vt][0], S[vt][1]); w.y = pk2(S[vt][2], S[vt][3]); *(u32x2*)(ds + (size_t)(vt * 16 + fr) * 128 + 16 * wave + fq * 4) = w; }
                if (seg == 0) *(f32x2*)(Dd + (size_t)(bh * 32 + sc) * 128 + 2 * cp) = (f32x2){__builtin_amdgcn_exp2f(gsum0), __builtin_amdgcn_exp2f(gsum1)};
            }
            idx += X.G; ch = 0; if (idx >= ntask) break;
        } else ++ch;
    }
#undef HG_LOAD
    __syncthreads();
}

__device__ __forceinline__ void ph_hg2(const Ctx& X, const float* dS, const float* Dd, float* S0) {
    const bf16_t* dsb = (const bf16_t*)dS; bf16_t* s0b = (bf16_t*)S0;
    for (int idx = X.vcu * 512 + X.tid; idx < 32 * 4096; idx += X.G * 512) {
        const int bh = idx >> 12, e4 = (idx & 4095) * 4, k0 = e4 & 127;
        f32x4 s = (f32x4){0.f, 0.f, 0.f, 0.f};
#pragma unroll 8
        for (int sc = 0; sc < 31; ++sc) { const f32x4 d = *(const f32x4*)(Dd + (size_t)(bh * 32 + sc) * 128 + k0); const u32x2 w = *(const u32x2*)(dsb + (size_t)(bh * 32 + sc) * 16384 + e4);
            s = s * d + (f32x4){bflo(w.x), bfhi(w.x), bflo(w.y), bfhi(w.y)};
            u32x2 o; o.x = pk2(s.x, s.y); o.y = pk2(s.z, s.w); *(u32x2*)(s0b + (size_t)(bh * 32 + sc + 1) * 16384 + e4) = o; }
    }
}

__device__ __forceinline__ void ph_router_tables(const Ctx& X, const float* g_ffn, const float* mod, const float* w_router, const float* b_router, bf16_t* BpT, float* cb) {
    for (int i = X.vcu * 512 + X.tid; i < 4 * 32 * 1024; i += X.G * 512) { const int b = i >> 15, e = (i >> 10) & 31, k = i & 1023;
        const float v = g_ffn[k] * (1.0f + mod[(size_t)b * NMOD + 4 * D + k]) * w_router[k * 32 + e];
        const unsigned hi = pk2(v, 0.f) & 0xffffu; const float r1 = v - __uint_as_float(hi << 16);
        const unsigned mi = pk2(r1, 0.f) & 0xffffu; const float r2 = r1 - __uint_as_float(mi << 16);
        const unsigned lo = pk2(r2, 0.f) & 0xffffu;
        unsigned short* d = (unsigned short*)BpT + ((size_t)(b * 3) * 32 + e) * 1024 + k;
        d[0] = (unsigned short)hi; d[32 * 1024] = (unsigned short)mi; d[2 * 32 * 1024] = (unsigned short)lo; }
    const int gw = X.vcu * 8 + X.wave;
    if (gw < 128) { const int b = gw >> 5, e = gw & 31; float a = 0.f;
        for (int k = X.lane; k < 1024; k += 64) a += mod[(size_t)b * NMOD + 3 * D + k] * w_router[k * 32 + e];
        a = wave_sum(a); if (X.lane == 0) cb[gw] = a + b_router[e]; }
}

__device__ __forceinline__ void ph_route(const Ctx& X, const bf16_t* x1, const float* g_ffn, const float* mod, const bf16_t* BpT, const float* cb,
                                         unsigned char* h2, int* top_e, float* top_w, int* rank, int* hist_g) {
    LAS int* hist = (LAS int*)(X.lds + LDSCTL_OFF + 64);
    LAS unsigned char* L = X.lds;
    constexpr int RS = 1040;
    const int tid = X.tid, lane = X.lane, c = lane & 15, q = lane >> 4;
    for (int tile = X.vcu; tile < RT_NT; tile += X.G) {
        if (tid < 32) hist[tid] = 0;
        const int tw = tile * RT_TILE + X.wave * 16, b = tw / SEQ;
        const bf16_t* xa = x1 + (size_t)(tw + c) * D + 8 * q;
        f32x4 acc0 = (f32x4){0.f, 0.f, 0.f, 0.f}, acc1 = acc0, accS = acc0;
        u32x4 stg[12]; bf16x8 a[16];
#define RT_ISSUE(half_) do { _Pragma("unroll") for (int ks = 0; ks < 16; ++ks) a[ks] = *(const bf16x8*)(xa + 512 * (half_) + 32 * ks); \
            _Pragma("unroll") for (int i = 0; i < 12; ++i) { const int id = tid + 512 * i, row = id >> 6, c16 = id & 63; stg[i] = *(const u32x4*)(BpT + ((size_t)(b * 96) + row) * 1024 + 512 * (half_) + 8 * c16); } } while (0)
#define RT_PUT() do { _Pragma("unroll") for (int i = 0; i < 12; ++i) { const int id = tid + 512 * i, row = id >> 6, c16 = id & 63; *(LAS u32x4*)(L + row * RS + 16 * c16) = stg[i]; } } while (0)
#define RT_MMA(ks_, av_) do { bf16x8 bb[6]; _Pragma("unroll") for (int j = 0; j < 6; ++j) bb[j] = *(const LAS bf16x8*)(L + (16 * j + c) * RS + 64 * (ks_) + 16 * q);     \
            accS = __builtin_amdgcn_mfma_f32_16x16x32_bf16(av_, av_, accS, 0, 0, 0); \
            _Pragma("unroll") for (int s_ = 2; s_ >= 0; --s_) { acc0 = __builtin_amdgcn_mfma_f32_16x16x32_bf16(av_, bb[2 * s_], acc0, 0, 0, 0); acc1 = __builtin_amdgcn_mfma_f32_16x16x32_bf16(av_, bb[2 * s_ + 1], acc1, 0, 0, 0); } } while (0)
        RT_ISSUE(0);
        __syncthreads();
        RT_PUT();
        __syncthreads();
        {
            bf16x8 a0[16];
#pragma unroll
            for (int ks = 0; ks < 16; ++ks) a0[ks] = a[ks];
            RT_ISSUE(1);
#pragma unroll
            for (int ks = 0; ks < 16; ++ks) RT_MMA(ks, a0[ks]);
        }
        __syncthreads();
        RT_PUT();
        __syncthreads();
#pragma unroll
        for (int ks = 0; ks < 16; ++ks) RT_MMA(ks, a[ks]);
#undef RT_ISSUE
#undef RT_PUT
#undef RT_MMA
        const float dg = (c & 2) ? ((c & 1) ? accS[3] : accS[2]) : ((c & 1) ? accS[1] : accS[0]);
        const float ss = __shfl(dg, c + 16 * (c >> 2));
        const float rs = rsqrtf(ss * (1.0f / D) + EPS);
        const float cb0 = cb[b * 32 + c], cb1 = cb[b * 32 + 16 + c];
#pragma unroll
        for (int reg = 0; reg < 4; ++reg) {
            const float rt = __shfl(rs, 4 * q + reg);
            float v0 = acc0[reg] * rt + cb0, v1 = acc1[reg] * rt + cb1;
            float sv[4]; int si[4];
#pragma unroll
            for (int rnd = 0; rnd < 4; ++rnd) {
                float bvv = v0; int bi = c; if (v1 > bvv) { bvv = v1; bi = 16 + c; }
#pragma unroll
                for (int o = 1; o < 16; o <<= 1) { const float ov = __shfl_xor(bvv, o); const int oi = __shfl_xor(bi, o); if (ov > bvv || (ov == bvv && oi < bi)) { bvv = ov; bi = oi; } }
                sv[rnd] = bvv; si[rnd] = bi; if (bi == c) v0 = -INFINITY; if (bi == 16 + c) v1 = -INFINITY;
            }
            const float e1 = __expf(sv[1] - sv[0]), e2 = __expf(sv[2] - sv[0]), e3 = __expf(sv[3] - sv[0]);
            const float inv = 1.0f / (1.0f + e1 + e2 + e3);
            if (c == 0) { const int t = tw + 4 * q + reg;
                const float ww[4] = {inv, e1 * inv, e2 * inv, e3 * inv};
#pragma unroll
                for (int rnd = 0; rnd < 4; ++rnd) { top_e[t * 4 + rnd] = si[rnd]; top_w[t * 4 + rnd] = ww[rnd]; rank[t * 4 + rnd] = atomicAdd((int*)&hist[si[rnd]], 1); }
            }
        }
        const float* sh = mod + (size_t)b * NMOD + 3 * D; const float* sc = mod + (size_t)b * NMOD + 4 * D;
#pragma unroll 4
        for (int i = 0; i < 16; ++i) {
            const float r = __shfl(rs, i);
            const u32x2* xr = (const u32x2*)(x1 + (size_t)(tw + i) * D) + lane;
#pragma unroll
            for (int j = 0; j < 4; ++j) {
                const int col = 4 * (lane + 64 * j);
                const f32x4 gg = *(const f32x4*)(g_ffn + col), s1 = *(const f32x4*)(sc + col), s0 = *(const f32x4*)(sh + col);
                const u32x2 xw = xr[64 * j]; const f32x4 xv = (f32x4){bflo(xw.x), bfhi(xw.x), bflo(xw.y), bfhi(xw.y)};
                const f32x4 y = (xv * r * gg * (s1 + 1.0f) + s0) * 16.0f;
                *(unsigned*)(h2 + (size_t)(tw + i) * D + col) = cvt4_fp8(y.x, y.y, y.z, y.w);
            }
        }
        __syncthreads();
        if (tid < 32) hist_g[tile * 32 + tid] = hist[tid];
        __syncthreads();
    }
}

__device__ __forceinline__ void ph_sort(const Ctx& X, const int* hist_g, const int* top_e, const float* top_w, const int* rank, int* row_tok, float* row_w, int* pair_row, int* blk_e) {
    LAS int* s_hist = (LAS int*)X.lds;
    LAS int* s_tot = s_hist + RT_NT * 32; LAS int* s_pre = s_tot + 32; LAS int* s_base = s_pre + 32; LAS int* s_pstart = s_base + 32; LAS int* s_pend = s_pstart + 32;
    LAS int* s_ptot = s_pend + 32; LAS int* s_ppre = s_ptot + 16 * 32;
    const int tid = X.tid;
    for (int i = tid; i < RT_NT * 8; i += 512) ((LAS u32x4*)s_hist)[i] = ((const u32x4*)hist_g)[i];
    __syncthreads();
    for (int tile = X.vcu; tile < RT_NT; tile += X.G) {
        { const int e = tid & 31, part = tid >> 5; int tot = 0, pre = 0;
#pragma unroll 4
          for (int i = part * (RT_NT / 16); i < (part + 1) * (RT_NT / 16); ++i) { const int c = s_hist[i * 32 + e]; tot += c; pre += (i < tile) ? c : 0; }
          s_ptot[part * 32 + e] = tot; s_ppre[part * 32 + e] = pre; }
        __syncthreads();
        if (tid < 32) { int tot = 0, pre = 0;
#pragma unroll
            for (int k = 0; k < 16; ++k) { tot += s_ptot[k * 32 + tid]; pre += s_ppre[k * 32 + tid]; }
            const int padded = (tot + 255) / 256 * 256; int inc = padded;
#pragma unroll
            for (int o = 1; o < 32; o <<= 1) { const int v = __shfl_up(inc, o); if (tid >= o) inc += v; }
            s_tot[tid] = tot; s_pstart[tid] = inc - padded; s_base[tid] = inc - padded + pre; s_pend[tid] = inc; }
        __syncthreads();
        { const int i = tid; const int idx = tile * RT_TILE * 4 + i; const int e = top_e[idx]; const int row = s_base[e] + rank[idx];
          row_tok[row] = idx >> 2; row_w[row] = top_w[idx]; pair_row[idx] = row; }
        if (tile < 32) { const int e = tile; for (int r = s_pstart[e] + s_tot[e] + tid; r < s_pend[e]; r += 512) { row_tok[r] = 0; row_w[r] = 0.f; } }
        if (tile == 32) { for (int blk = tid; blk < NBLK_MAX; blk += 512) { int e = -1; const int r = blk * 256; for (int q = 0; q < 32; ++q) if (r >= s_pstart[q] && r < s_pend[q]) e = q; blk_e[blk] = e; }
                          if (tid == 0) blk_e[NBLK_MAX] = s_pend[31] / 256; }
        __syncthreads();
    }
}

__device__ __forceinline__ void ph_final(const Ctx& X, const bf16_t* x1, const unsigned char* y, const int* pair_row, const float* mod, const float* g_final, float* out, const float oscale) {
    const int lane = X.lane;
    for (int t = X.vcu * 8 + X.wave; t < T; t += X.G * 8) {
        const int b = t / SEQ;
        const u32x2* xr = (const u32x2*)(x1 + (size_t)t * D) + lane;
        const float* ga = mod + (size_t)b * NMOD + 5 * D;
        int rows[4];
#pragma unroll
        for (int k = 0; k < 4; ++k) rows[k] = pair_row[t * 4 + k];
        f32x4 v[4]; float ss = 0.f;
#pragma unroll
        for (int j = 0; j < 4; ++j) {
            const int col = 4 * (lane + 64 * j);
            f32x4 m = (f32x4){0.f, 0.f, 0.f, 0.f};
#pragma unroll
            for (int k = 0; k < 4; ++k) { const int w = *(const int*)(y + (size_t)rows[k] * D + col); const f32x2 lo = __builtin_amdgcn_cvt_pk_f32_fp8(w, false), hi = __builtin_amdgcn_cvt_pk_f32_fp8(w, true); m.x += lo.x; m.y += lo.y; m.z += hi.x; m.w += hi.y; }
            const u32x2 xw = xr[64 * j];
            v[j] = (f32x4){bflo(xw.x), bfhi(xw.x), bflo(xw.y), bfhi(xw.y)} + *(const f32x4*)(ga + col) * (m * (1.0f / 32.0f));
            ss += (v[j].x * v[j].x + v[j].y * v[j].y) + (v[j].z * v[j].z + v[j].w * v[j].w);
        }
        const float r = rsqrtf(wave_sum(ss) * (1.0f / D) + EPS);
#pragma unroll
        for (int j = 0; j < 4; ++j) { const int col = 4 * (lane + 64 * j); *(f32x4*)(out + (size_t)t * D + col) = v[j] * (r * oscale) * *(const f32x4*)(g_final + col); }
    }
}

constexpr int N_PHASES = 13;
struct Args { const float* in[23]; float* out; unsigned char* ws; int ph_lo, ph_hi; };
__global__ void __launch_bounds__(512, 2) fwd(Args a) {
    extern __shared__ __attribute__((aligned(16))) unsigned char lds_raw[];
    Ctx X; X.lds = (LAS unsigned char*)lds_raw; X.tid = threadIdx.x; X.lane = X.tid & 63; X.wave = __builtin_amdgcn_readfirstlane(X.tid >> 6);
    X.G = gridDim.x; { const int bx = blockIdx.x; X.vcu = (X.G % 8 == 0) ? (bx % 8) * (X.G / 8) + bx / 8 : bx; }
    unsigned char* ws = a.ws;
    for (int u = X.tid; u < (LDS_BYTES - LDSCTL_OFF) / 4; u += 512) ((LAS unsigned*)(X.lds + LDSCTL_OFF))[u] = 0u;
    __syncthreads();
    XcdBarrier bar = xcd_barrier_post((unsigned*)(ws + WS_CTL) + CW_BAR, (volatile LAS unsigned*)(X.lds + LDSCTL_OFF), X.tid == 0);
    const int lo = a.ph_lo, hi = a.ph_hi; float probe_scale = 1.0f;
#define IN(k) (lo <= (k) && (k) < hi)
#define SEAM(k) do { if (IN(k) && IN((k) + 1)) xcd_barrier(bar, X.wave == 0 && (int)__builtin_amdgcn_mbcnt_hi(~0u, __builtin_amdgcn_mbcnt_lo(~0u, 0u)) == 0); } while (0)
#ifdef PROBE_PH
    unsigned long long* stamps = (unsigned long long*)(ws + WS_CTL + 32768);
    if (blockIdx.x == 0 && X.tid == 0) stamps[0] = __builtin_amdgcn_s_memrealtime();
#undef SEAM
#define SEAM(k) do { if (IN(k) && IN((k) + 1)) { xcd_barrier(bar, X.wave == 0 && (int)__builtin_amdgcn_mbcnt_hi(~0u, __builtin_amdgcn_mbcnt_lo(~0u, 0u)) == 0); \
        if (blockIdx.x == 0 && X.wave == 0 && (int)__builtin_amdgcn_mbcnt_hi(~0u, __builtin_amdgcn_mbcnt_lo(~0u, 0u)) == 0) stamps[(k) + 1] = __builtin_amdgcn_s_memrealtime(); } } while (0)
#endif
    const float* x = a.in[0]; const float* c = a.in[1]; const float* w_ada = a.in[2]; const float* b_ada = a.in[3];
    const float* g_mix = a.in[4]; const float* w_in = a.in[5]; const float* conv_dw = a.in[6]; const float* conv_dwb = a.in[7];
    const float* conv_ln_g = a.in[8]; const float* conv_ln_b = a.in[9]; const float* w_conv_out = a.in[10]; const float* lb_param = a.in[11];
    const float* hgrn_norm_g = a.in[12]; const float* w_hgrn_out = a.in[13]; const float* w_out = a.in[14]; const float* g_ffn = a.in[15];
    const float* w_router = a.in[16]; const float* b_router = a.in[17]; const float* w1 = a.in[18]; const float* b1 = a.in[19];
    const float* w2 = a.in[20]; const float* b2 = a.in[21]; const float* g_final = a.in[22];
    float* mod = (float*)(ws + WS_MOD); bf16_t* rt_bp = (bf16_t*)(ws + WS_WH);     float* rt_cb = (float*)(ws + WS_CB);
    int* hist_g = (int*)(ws + WS_HIST); int* blk_e = (int*)(ws + WS_BLKE); int* top_e = (int*)(ws + WS_TOPE); float* top_w = (float*)(ws + WS_TOPW);
    int* rank = (int*)(ws + WS_RANK); int* pair_row = (int*)(ws + WS_PROW); int* row_tok = (int*)(ws + WS_RTOK); float* row_w = (float*)(ws + WS_RW);
    bf16_t* p = (bf16_t*)(ws + WS_P);
    bf16_t* h = (bf16_t*)(ws + WS_E); unsigned char* h8 = ws + WS_E + 64 * MiB; float* tmp = (float*)(ws + WS_E);
    float* hg_dS = (float*)(ws + WS_E); float* hg_S0 = (float*)(ws + WS_E + 64 * MiB); float* hg_D = (float*)(ws + WS_HGD);
    bf16_t* uc = (bf16_t*)(ws + WS_D); bf16_t* og = MIX_FP8 ? (bf16_t*)((unsigned char*)uc + D) : uc + D;   bf16_t* x1 = (bf16_t*)(ws + WS_D);
    bf16_t* merged = p;
    unsigned char* h2 = (unsigned char*)p;
    unsigned char* act = (unsigned char*)(p + PG);
    unsigned char* y = (unsigned char*)(p + PG) + (size_t)R_PAD * D;
    PG8_LAS unsigned char* ring = (PG8_LAS unsigned char*)lds_raw;

#ifndef REPMASK
#define REPMASK 0
#endif
#ifndef REPN
#define REPN 1
#endif
#define PH(k, ...) do { if (IN(k)) { _Pragma("unroll 1") for (int rep_ = 0; rep_ < ((((REPMASK) >> (k)) & 1) ? 1 + REPN : 1); ++rep_) { if (rep_) __syncthreads(); { int ln_ = (int)__builtin_amdgcn_mbcnt_hi(~0u, __builtin_amdgcn_mbcnt_lo(~0u, 0u)); asm volatile("" : "+v"(ln_)); X.lane = ln_; X.tid = X.wave * 64 + ln_; } __VA_ARGS__ } } SEAM(k); } while (0)
    PH(0, ph_prologue<0>(X, c, w_ada, b_ada, mod, w_in, w_conv_out, w_hgrn_out, w_out, w1, w2, ws); if (P_INT8) ph_win_i8(X, w_in, ws););
    PH(1, ph_norm_mod(X, x, g_mix, mod, 0, D, h, h8, (float*)(ws + WS_HSC)); ph_router_tables(X, g_ffn, mod, w_router, b_router, rt_bp, rt_cb););
#ifndef STAGGER_TICKS
#define STAGGER_TICKS 0
#endif
    PH(2, { if (STAGGER_TICKS) { const unsigned long long t0_ = __builtin_amdgcn_s_memrealtime(), wait_ = (unsigned long long)(X.vcu & 3) * STAGGER_TICKS;
                while (__builtin_amdgcn_s_memrealtime() - t0_ < wait_) __builtin_amdgcn_s_sleep(8); }
        if (P_INT8) { pg8::Gemm g{(const bf16_t*)h8, (const bf16_t*)(ws + WS_WIN8), T, 8 * D, D / 2}; pg8::StaticOrder S; S.init(T, 8 * D, X.G, (int)blockIdx.x);
            pg8::EpiSplitBf16<true> E{p, PG, 0x3cu, SEQ, 1.0f, (const float*)(ws + WS_HSC), (const float*)(ws + WS_WSC)}; pg8::gemm_phase<pg8::EpiSplitBf16<true>, pg8::StaticOrder, true, true, false, 2>(ring, g, S, E, X.wave); }
        else {
        constexpr unsigned m8 = P_FP8_MASK; constexpr int n8 = __builtin_popcount(m8);
        if (n8 > 0) { pg8::Gemm g{(const bf16_t*)h8, (const bf16_t*)(ws + WS_WIN8), T, 8 * D, D / 2}; pg8::MaskOrder S; S.base.init(T, n8 * 256, X.G, (int)blockIdx.x); S.mask = m8;
            pg8::EpiSplitBf16<false> E{p, PG, 0x3cu, SEQ, 1.0f / 4096.0f, nullptr, nullptr}; pg8::gemm_phase<pg8::EpiSplitBf16<false>, pg8::MaskOrder, true, true, false, 1>(ring, g, S, E, X.wave); }
        if (n8 < 32) { pg8::Gemm g{h, (const bf16_t*)(ws + WS_WIN), T, 8 * D, D}; pg8::MaskOrder S; S.base.init(T, (32 - n8) * 256, X.G, (int)blockIdx.x); S.mask = ~m8;
            pg8::EpiSplitBf16<false> E{p, PG, 0x3cu, SEQ, 1.0f, nullptr, nullptr}; pg8::gemm_phase<pg8::EpiSplitBf16<false>, pg8::MaskOrder, true, true>(ring, g, S, E, X.wave); } } });
    PH(3, ph_conv(X, p + 0 * PG, conv_dw, conv_dwb, conv_ln_g, conv_ln_b, uc);
          if ((REPMASK >> 14) & 1) { __syncthreads(); ph_conv(X, p + 0 * PG, conv_dw, conv_dwb, conv_ln_g, conv_ln_b, uc); }
          ph_hgrn<false>(X, 31 * 32, p + 2 * PG, p + 3 * PG, p + 4 * PG, p + 5 * PG, lb_param, nullptr, nullptr, hg_dS, hg_D, nullptr);
          if ((REPMASK >> 15) & 1) { __syncthreads(); ph_hgrn<false>(X, 31 * 32, p + 2 * PG, p + 3 * PG, p + 4 * PG, p + 5 * PG, lb_param, nullptr, nullptr, hg_dS, hg_D, nullptr); });
    PH(4, ph_hg2(X, hg_dS, hg_D, hg_S0););
    PH(5, if ((X.vcu & 1) == 0) ph_prologue<1>(X, c, w_ada, b_ada, mod, w_in, w_conv_out, w_hgrn_out, w_out, w1, w2, ws);
          ph_hgrn<true>(X, 32 * 32, p + 2 * PG, p + 3 * PG, p + 4 * PG, p + 5 * PG, lb_param, hgrn_norm_g, hg_S0, nullptr, nullptr, og);
          if ((X.vcu & 1) != 0) ph_prologue<1>(X, c, w_ada, b_ada, mod, w_in, w_conv_out, w_hgrn_out, w_out, w1, w2, ws););
    PH(6, { if (MIX_FP8) { pg8::Gemm g{uc, (const bf16_t*)(ws + WS_WC), T, D, D}; pg8::StaticOrder S; S.init(T, D, X.G, (int)blockIdx.x);
              pg8::EpiGateFused<RES_FP8 != 0> E{p + 6 * PG, p + 7 * PG, merged, 1.0f / 4096.0f}; pg8::gemm_phase<pg8::EpiGateFused<RES_FP8 != 0>, pg8::StaticOrder, true, true, false, 1>(ring, g, S, E, X.wave); }
            else { pg8::Gemm g{uc, (const bf16_t*)(ws + WS_WC), T, D, 2 * D}; pg8::StaticOrder S; S.init(T, D, X.G, (int)blockIdx.x);
              pg8::EpiGateFused<RES_FP8 != 0> E{p + 6 * PG, p + 7 * PG, merged, 1.0f}; pg8::gemm_phase<pg8::EpiGateFused<RES_FP8 != 0>, pg8::StaticOrder, true, true>(ring, g, S, E, X.wave); } });
    PH(7, { if (RES_FP8) { pg8::Gemm g{merged, (const bf16_t*)(ws + WS_WO), T, D, D / 2}; pg8::StaticOrder S; S.init(T, D, X.G, (int)blockIdx.x);
              pg8::EpiRes E{x, mod + 2 * D, x1, NMOD, SEQ, 1.0f / 8192.0f}; pg8::gemm_phase<pg8::EpiRes, pg8::StaticOrder, true, true, false, 1>(ring, g, S, E, X.wave); }
            else { pg8::Gemm g{merged, (const bf16_t*)(ws + WS_WO), T, D, D}; pg8::StaticOrder S; S.init(T, D, X.G, (int)blockIdx.x);
              pg8::EpiRes E{x, mod + 2 * D, x1, NMOD, SEQ, 1.0f}; pg8::gemm_phase<pg8::EpiRes, pg8::StaticOrder, true, true>(ring, g, S, E, X.wave); } });
    PH(8, ph_route(X, x1, g_ffn, mod, rt_bp, rt_cb, h2, top_e, top_w, rank, hist_g););
    PH(9, ph_sort(X, hist_g, top_e, top_w, rank, row_tok, row_w, pair_row, blk_e););
    PH(10, { const int nblk = blk_e[NBLK_MAX]; pg8::Gemm g{(const bf16_t*)h2, (const bf16_t*)(ws + WS_W1), T, 32 * 2048, D / 2}; pg8::MoeOrder S{blk_e, nblk, X.G, (int)blockIdx.x, 3};
        LAS unsigned short* gt = (LAS unsigned short*)(X.lds + LDSCTL_OFF + 256);
        _Pragma("unroll 1") for (int i = 0; i < 23; ++i) { pg8::Unit u; if (!S.next(i, u)) break; if (X.tid < 256) gt[256 * i + X.tid] = (unsigned short)row_tok[u.pm * 256 + X.tid]; }
        __syncthreads();
        pg8::EpiSwiglu8 E{b1, act, 1.0f / 4096.0f}; pg8::gemm_phase<pg8::EpiSwiglu8, pg8::MoeOrder, true, true, true, true>(ring, g, S, E, X.wave, (const PG8_LAS unsigned short*)gt); });
    PH(11, { const int nblk = blk_e[NBLK_MAX]; pg8::Gemm g{(const bf16_t*)act, (const bf16_t*)(ws + WS_W2), R_PAD, 32 * 1024, DFF / 2}; pg8::MoeOrder S{blk_e, nblk, X.G, (int)blockIdx.x, 2};
        pg8::EpiY8 E{b2, row_w, y, 1.0f / 1024.0f}; pg8::gemm_phase<pg8::EpiY8, pg8::MoeOrder, true, true, false, true>(ring, g, S, E, X.wave); });
#ifdef PROBE_PH
    { const unsigned long long* st_ = (const unsigned long long*)(ws + WS_CTL + 32768); const float dt_ = (float)(long long)(st_[PROBE_PH + 1] - st_[PROBE_PH]);
      probe_scale = 1.0f + dt_ * (1.0f / 200000.0f); }
#endif
    PH(12, ph_final(X, x1, y, pair_row, mod, g_final, a.out, probe_scale););
#undef PH
#undef IN
#undef SEAM
}

#ifndef MK_N_LAUNCHES
#define MK_N_LAUNCHES 1
#endif
extern "C" void kernel_launch(void* const* d_in, const int* in_sizes, int n_in, void* d_out, int out_size, void* d_ws, size_t ws_size, hipStream_t stream) {
    static int grid = 0;
    if (grid == 0) {
        if (n_in != 23 || out_size != T * D || ws_size < WS_END) { fprintf(stderr, "kernel_launch: unexpected n_in %d / out_size %d / ws_size %zu (< %zu); nothing launched\n", n_in, out_size, ws_size, (size_t)WS_END); grid = -1; return; }
        int dev = 0, cus = 0, per_cu = 0;
        if (hipGetDevice(&dev) != hipSuccess || hipDeviceGetAttribute(&cus, hipDeviceAttributeMultiprocessorCount, dev) != hipSuccess) { grid = -1; return; }
        if (hipFuncSetAttribute((const void*)fwd, hipFuncAttributeMaxDynamicSharedMemorySize, LDS_BYTES) != hipSuccess) { fprintf(stderr, "kernel_launch: hipFuncSetAttribute failed\n"); grid = -1; return; }
        if (hipOccupancyMaxActiveBlocksPerMultiprocessor(&per_cu, (const void*)fwd, 512, LDS_BYTES) != hipSuccess || per_cu < 1) { fprintf(stderr, "kernel_launch: occupancy query says %d blocks per CU\n", per_cu); }
        (void)hipGetLastError();
        grid = cus;
    }
    if (grid < 0) return;
    if (hipMemsetAsync((char*)d_ws + WS_CTL, 0, CTL_ZERO_BYTES, stream) != hipSuccess) return;
    Args a{};
    for (int i = 0; i < 23; ++i) a.in[i] = (const float*)d_in[i];
    a.out = (float*)d_out; a.ws = (unsigned char*)d_ws;
    if (MK_N_LAUNCHES == 1) { a.ph_lo = 0; a.ph_hi = N_PHASES; hipLaunchKernelGGL(fwd, dim3(grid), dim3(512), LDS_BYTES, stream, a); }
    else for (int ph = 0; ph < N_PHASES; ++ph) { a.ph_lo = ph; a.ph_hi = ph + 1; hipLaunchKernelGGL(fwd, dim3(grid), dim3(512), LDS_BYTES, stream, a); }
}
```
